# Optimizing an MI355X kernel written in HIP

```python
import math
import jax
import jax.numpy as jnp
from jax import lax
import numpy as np

D_MODEL = 1024
BATCH = 2
SEQ = 8192
DEPTH = 2

GRID_W = 64
CTX_LEN = 256
EPS = 1e-6
F32 = jnp.float32

F_GROUPS = 4
F_GROUP_DIM = D_MODEL // 16
F_WIDTH = F_GROUPS * F_GROUP_DIM
DA_HEADS = 4
DA_QK_DIM = D_MODEL // 16
DA_V_DIM = 2 * DA_QK_DIM
DA_QK_WIDTH = DA_HEADS * 2 * DA_QK_DIM
DA_WIDTH = DA_HEADS * DA_V_DIM
ATT_SCALE = DA_QK_DIM ** -0.5
QBLOCK = 128
ROPE_BASE = 10000.0
CV_WIDTH = D_MODEL // 4
CONV_TAPS = 31
POOL_WINDOWS = (2, 4, 8, 16)
P_GROUP_DIM = D_MODEL // 16
P_WIDTH = len(POOL_WINDOWS) * P_GROUP_DIM
N_BRANCH = 4
D_FF = ((8 * D_MODEL // 3 + 127) // 128) * 128
FFN_TAPS = 3

OFF_F = 0
OFF_Q = OFF_F + F_WIDTH
OFF_K = OFF_Q + DA_QK_WIDTH
OFF_V = OFF_K + DA_QK_WIDTH
OFF_C = OFF_V + DA_WIDTH
OFF_P = OFF_C + 2 * CV_WIDTH
OFF_G = OFF_P + P_WIDTH
IN_WIDTH = OFF_G + N_BRANCH * D_MODEL

kernel_name = "hybrid_fnet_diffattn_conformer_pool_dit"


def rmsnorm(x, g):
    xf = x.astype(F32)
    y = xf * lax.rsqrt(jnp.mean(xf * xf, axis=-1, keepdims=True) + EPS)
    return (y * g.astype(F32)).astype(x.dtype)


def layernorm(x, g, b):
    xf = x.astype(F32)
    mu = jnp.mean(xf, axis=-1, keepdims=True)
    var = jnp.mean(jnp.square(xf - mu), axis=-1, keepdims=True)
    return ((xf - mu) * lax.rsqrt(var + EPS) * g.astype(F32) + b.astype(F32)).astype(x.dtype)


def dwconv(x, w, b):
    taps = w.shape[0]
    pad = (taps - 1) // 2
    y = lax.conv_general_dilated(x, w[:, None, :].astype(x.dtype), (1,), [(pad, taps - 1 - pad)],
                                 dimension_numbers=('NWC', 'WIO', 'NWC'),
                                 feature_group_count=x.shape[-1])
    return y + b


def axial_tables(rows, dtype):
    nf = DA_QK_DIM // 4
    inv = ROPE_BASE ** (-jnp.arange(nf, dtype=F32) / nf)
    r = jnp.repeat(jnp.arange(rows, dtype=F32), GRID_W)
    col = jnp.tile(jnp.arange(GRID_W, dtype=F32), rows)
    ar = r[:, None] * inv
    ac = col[:, None] * inv
    sh = (rows * GRID_W, 1, 1, nf)
    return (jnp.cos(ar).reshape(sh).astype(dtype), jnp.sin(ar).reshape(sh).astype(dtype),
            jnp.cos(ac).reshape(sh).astype(dtype), jnp.sin(ac).reshape(sh).astype(dtype))


def rot_half(x, cos, sin):
    m = x.shape[-1] // 2
    x1, x2 = x[..., :m], x[..., m:]
    return jnp.concatenate([x1 * cos - x2 * sin, x2 * cos + x1 * sin], axis=-1)


def axial_rope(x, rope):
    cos_r, sin_r, cos_c, sin_c = rope
    n = x.shape[-1] // 2
    return jnp.concatenate([rot_half(x[..., :n], cos_r, sin_r), rot_half(x[..., n:], cos_c, sin_c)], axis=-1)


def diff_attention(q, k, v, lam):
    b, lq = q.shape[0], q.shape[1]
    nb = lq // QBLOCK
    qb = (q * ATT_SCALE).reshape(b, nb, QBLOCK, DA_HEADS, 2, DA_QK_DIM).swapaxes(0, 1)

    def block(qi):
        s = jnp.einsum('bqhmd,bkhmd->bhmqk', qi, k).astype(F32)
        pr = jax.nn.softmax(s, axis=-1)
        w = pr[:, :, 0] - lam * pr[:, :, 1]
        return jnp.einsum('bhqk,bkhd->bqhd', w.astype(v.dtype), v)

    o = lax.map(block, qb)
    return o.swapaxes(0, 1).reshape(b, lq, DA_HEADS, DA_V_DIM)


def fourier_mix(u):
    b, l, _ = u.shape
    ug = u.astype(F32).reshape(b, l, F_GROUPS, F_GROUP_DIM)
    y = jnp.real(jnp.fft.fft2(ug, axes=(1, 3), norm='ortho'))
    return y.reshape(b, l, F_WIDTH).astype(u.dtype)


def conformer_conv(u, dw_w, dw_b, ln_g, ln_b):
    a, gt = jnp.split(u, 2, axis=-1)
    z = a * jax.nn.sigmoid(gt)
    z = dwconv(z, dw_w, dw_b)
    z = layernorm(z, ln_g, ln_b)
    return jax.nn.silu(z)


def multiscale_pool(u, pool_w, pool_scale):
    b, l, _ = u.shape
    uf = u.astype(F32)
    csum = jnp.concatenate([jnp.zeros((b, 1, P_WIDTH), F32), jnp.cumsum(uf, axis=1)], axis=1)
    t = jnp.arange(l)
    means = []
    for g, win in enumerate(POOL_WINDOWS):
        lo = jnp.clip(t - win // 2, 0, l - 1)
        hi = jnp.clip(t + win - win // 2 - 1, 0, l - 1)
        cs = csum[..., g * P_GROUP_DIM:(g + 1) * P_GROUP_DIM]
        cnt = (hi - lo + 1).astype(F32)[None, :, None]
        means.append((cs[:, hi + 1] - cs[:, lo]) / cnt)
    d = (jnp.concatenate(means, axis=-1) - uf).astype(u.dtype)
    d = d.reshape(b, l, len(POOL_WINDOWS), P_GROUP_DIM)
    y = jnp.einsum('blgc,gcd->blgd', d, pool_w).reshape(b, l, P_WIDTH)
    return y * pool_scale


def token_mixer(p, k_ctx, v_ctx, rope, lam, lam_init, subln_g, conv_dw_w, conv_dw_b, conv_ln_g, conv_ln_b,
                pool_w, pool_scale, wo_f, wo_a, wo_c, wo_p, w_out):
    b, l, _ = p.shape
    u_f = p[..., OFF_F:OFF_Q]
    q = p[..., OFF_Q:OFF_K].reshape(b, l, DA_HEADS, 2, DA_QK_DIM)
    k = p[..., OFF_K:OFF_V].reshape(b, l, DA_HEADS, 2, DA_QK_DIM)
    v = p[..., OFF_V:OFF_C].reshape(b, l, DA_HEADS, DA_V_DIM)
    u_c = p[..., OFF_C:OFF_P]
    u_p = p[..., OFF_P:OFF_G]
    gates = jax.nn.sigmoid(p[..., OFF_G:].astype(F32)).astype(p.dtype).reshape(b, l, N_BRANCH, D_MODEL)
    if rope is None:
        keys, vals = k, v
    else:
        q = axial_rope(q, rope)
        keys = jnp.concatenate([k_ctx, axial_rope(k, rope)], axis=1)
        vals = jnp.concatenate([v_ctx, v], axis=1)
    o_a = diff_attention(q, keys, vals, lam)
    o_a = (rmsnorm(o_a, subln_g) * (1.0 - lam_init)).reshape(b, l, DA_WIDTH)
    y = (gates[:, :, 0] * (fourier_mix(u_f) @ wo_f)
         + gates[:, :, 1] * (o_a @ wo_a)
         + gates[:, :, 2] * (conformer_conv(u_c, conv_dw_w, conv_dw_b, conv_ln_g, conv_ln_b) @ wo_c)
         + gates[:, :, 3] * (multiscale_pool(u_p, pool_w, pool_scale) @ wo_p))
    return y @ w_out


def conv_ffn(h, w_up, dw_w, dw_b, w_down):
    val, gt = jnp.split(h @ w_up, 2, axis=-1)
    gt = jax.nn.gelu(dwconv(gt, dw_w, dw_b), approximate=False)
    return (val * gt) @ w_down


def setup_inputs(seed: int = 0) -> dict:
    key = jax.random.key(seed)
    ks = jax.random.split(key, 30)

    def nrm(i, shape, s):
        return jax.random.normal(ks[i], shape, F32) * s

    L, D = DEPTH, D_MODEL
    return {
        "x": nrm(0, (BATCH, SEQ, D), 1.0),
        "c": nrm(1, (BATCH, D), 1.0),
        "ctx": nrm(2, (BATCH, CTX_LEN, D), 1.0),
        "c_ctx": nrm(3, (D,), 1.0),
        "norm1_g": 1.0 + nrm(4, (L, D), 0.02),
        "norm2_g": 1.0 + nrm(5, (L, D), 0.02),
        "ada_w": nrm(6, (L, D, 6 * D), 0.5 * D ** -0.5),
        "ada_b": nrm(7, (L, 6 * D), 0.02),
        "w_in": nrm(8, (L, D, IN_WIDTH), D ** -0.5),
        "lam_q1": nrm(9, (L, DA_QK_DIM), 0.1),
        "lam_k1": nrm(10, (L, DA_QK_DIM), 0.1),
        "lam_q2": nrm(11, (L, DA_QK_DIM), 0.1),
        "lam_k2": nrm(12, (L, DA_QK_DIM), 0.1),
        "subln_g": 1.0 + nrm(13, (L, DA_V_DIM), 0.02),
        "conv_dw_w": nrm(14, (L, CONV_TAPS, CV_WIDTH), CONV_TAPS ** -0.5),
        "conv_dw_b": nrm(15, (L, CV_WIDTH), 0.02),
        "conv_ln_g": 1.0 + nrm(16, (L, CV_WIDTH), 0.02),
        "conv_ln_b": nrm(17, (L, CV_WIDTH), 0.02),
        "pool_w": nrm(18, (L, len(POOL_WINDOWS), P_GROUP_DIM, P_GROUP_DIM), P_GROUP_DIM ** -0.5),
        "pool_scale": 1.0 + nrm(19, (L, P_WIDTH), 0.02),
        "wo_f": nrm(20, (L, F_WIDTH, D), F_WIDTH ** -0.5),
        "wo_a": nrm(21, (L, DA_WIDTH, D), DA_WIDTH ** -0.5),
        "wo_c": nrm(22, (L, CV_WIDTH, D), CV_WIDTH ** -0.5),
        "wo_p": nrm(23, (L, P_WIDTH, D), P_WIDTH ** -0.5),
        "w_out": nrm(24, (L, D, D), D ** -0.5),
        "w_up": nrm(25, (L, D, 2 * D_FF), D ** -0.5),
        "ffn_dw_w": nrm(26, (L, FFN_TAPS, D_FF), FFN_TAPS ** -0.5),
        "ffn_dw_b": nrm(27, (L, D_FF), 0.02),
        "w_down": nrm(28, (L, D_FF, D), D_FF ** -0.5),
        "final_g": 1.0 + nrm(29, (D,), 0.02),
    }


def reference(x, c, ctx, c_ctx, norm1_g, norm2_g, ada_w, ada_b, w_in, lam_q1, lam_k1, lam_q2, lam_k2,
              subln_g, conv_dw_w, conv_dw_b, conv_ln_g, conv_ln_b, pool_w, pool_scale, wo_f, wo_a, wo_c,
              wo_p, w_out, w_up, ffn_dw_w, ffn_dw_b, w_down, final_g):
    b = x.shape[0]
    n_ctx = ctx.shape[1]
    rows = x.shape[1] // GRID_W
    rope = axial_tables(rows, x.dtype)
    for l in range(DEPTH):
        last = l == DEPTH - 1
        lam_init = 0.8 - 0.6 * math.exp(-0.3 * l)
        lam = (jnp.exp(jnp.sum(lam_q1[l].astype(F32) * lam_k1[l].astype(F32)))
               - jnp.exp(jnp.sum(lam_q2[l].astype(F32) * lam_k2[l].astype(F32))) + lam_init)
        mod_x = (jax.nn.silu(c) @ ada_w[l] + ada_b[l])[:, None, :]
        mod_c = (jax.nn.silu(c_ctx) @ ada_w[l] + ada_b[l])[None, None, :]
        sh1, sc1, g1, sh2, sc2, g2 = jnp.split(mod_x, 6, axis=-1)
        csh1, csc1, cg1, csh2, csc2, cg2 = jnp.split(mod_c, 6, axis=-1)

        hc = rmsnorm(ctx, norm1_g[l]) * (1.0 + csc1) + csh1
        if last:
            kv_c = hc @ w_in[l][:, OFF_K:OFF_C]
        else:
            pc = hc @ w_in[l]
            kv_c = pc[..., OFF_K:OFF_C]
        k_c = kv_c[..., :DA_QK_WIDTH].reshape(b, n_ctx, DA_HEADS, 2, DA_QK_DIM)
        v_c = kv_c[..., DA_QK_WIDTH:].reshape(b, n_ctx, DA_HEADS, DA_V_DIM)

        hx = rmsnorm(x, norm1_g[l]) * (1.0 + sc1) + sh1
        x = x + g1 * token_mixer(hx @ w_in[l], k_c, v_c, rope, lam, lam_init, subln_g[l], conv_dw_w[l],
                                 conv_dw_b[l], conv_ln_g[l], conv_ln_b[l], pool_w[l], pool_scale[l],
                                 wo_f[l], wo_a[l], wo_c[l], wo_p[l], w_out[l])
        hx2 = rmsnorm(x, norm2_g[l]) * (1.0 + sc2) + sh2
        x = x + g2 * conv_ffn(hx2, w_up[l], ffn_dw_w[l], ffn_dw_b[l], w_down[l])

        if not last:
            ctx = ctx + cg1 * token_mixer(pc, None, None, None, lam, lam_init, subln_g[l], conv_dw_w[l],
                                          conv_dw_b[l], conv_ln_g[l], conv_ln_b[l], pool_w[l], pool_scale[l],
                                          wo_f[l], wo_a[l], wo_c[l], wo_p[l], w_out[l])
            hc2 = rmsnorm(ctx, norm2_g[l]) * (1.0 + csc2) + csh2
            ctx = ctx + cg2 * conv_ffn(hc2, w_up[l], ffn_dw_w[l], ffn_dw_b[l], w_down[l])
    return rmsnorm(x, final_g)
```

```cpp
#include <hip/hip_runtime.h>
#include <cstdio>
#include <cstdint>

#define LAS __attribute__((address_space(3)))
#define GAS __attribute__((address_space(1)))
typedef unsigned short bf16_t;
typedef short bf16x8 __attribute__((ext_vector_type(8)));
typedef short s16x4 __attribute__((ext_vector_type(4)));
typedef float f32x2 __attribute__((ext_vector_type(2)));
typedef float f32x4 __attribute__((ext_vector_type(4)));
typedef float f32x16 __attribute__((ext_vector_type(16)));
typedef unsigned u32x2 __attribute__((ext_vector_type(2)));
typedef unsigned u32x4 __attribute__((ext_vector_type(4)));

#ifndef MK_N_LAUNCHES
#define MK_N_LAUNCHES 22
#endif

constexpr int DM = 1024, SEQ = 8192, NBATCH = 2, CTXL = 256;
constexpr int ML = NBATCH * SEQ;
constexpr int MC = NBATCH * CTXL;
constexpr int MT = ML + MC;
constexpr int NIN = 6656, DFF = 2816, KCAT = 1280;
constexpr int KVL = CTXL + SEQ;
constexpr float EPS = 1e-6f;

constexpr size_t MiB = 1u << 20;
constexpr size_t WS_CTL = 0, CTL_ZERO_BYTES = 1 * MiB;
constexpr size_t WS_MOD = 1 * MiB;
constexpr size_t WS_ROPE = WS_MOD + 2 * 3 * 6144 * 4;
constexpr size_t WS_TW = WS_ROPE + 192 * 32 * 4;
constexpr size_t WS_XC = 2 * MiB;
constexpr size_t WS_WA = 4 * MiB;
constexpr size_t WS_WCAT = 17 * MiB;
constexpr size_t WS_WOUT = WS_WCAT + (size_t)1024 * 1280 * 2;
constexpr size_t WS_WUPG = WS_WOUT + (size_t)1024 * 1024 * 2;
constexpr size_t WS_WUPV = WS_WUPG + (size_t)2816 * 1024 * 2;
constexpr size_t WS_WDN = WS_WUPV + (size_t)2816 * 1024 * 2;
constexpr size_t WS_HX = 38 * MiB;
constexpr size_t WS_FA = WS_HX;
constexpr size_t WS_Q = 71 * MiB;
constexpr size_t WS_K = WS_Q + (size_t)MT * 512 * 2;
constexpr size_t WS_V = WS_K + (size_t)MT * 512 * 2;
constexpr size_t WS_Y = 71 * MiB;
constexpr size_t WS_G = 121 * MiB;
constexpr size_t WS_ACAT = 187 * MiB;
constexpr size_t WS_UF = 229 * MiB;
constexpr size_t WS_ZG = WS_UF + (size_t)MT * 256 * 2;
constexpr size_t WS_UP = WS_ZG + (size_t)MT * 256 * 2;
constexpr size_t WS_GT = 71 * MiB;
constexpr size_t WS_H = 162 * MiB;
constexpr size_t WS_END = 256 * MiB;
static_assert(WS_TW + 8192 * 8 <= WS_XC && WS_WDN + (size_t)1024 * 2816 * 2 <= WS_HX && WS_V + (size_t)MT * 512 * 2 <= WS_G && WS_G + (size_t)MT * 4096 <= WS_ACAT, "ws map 1");
static_assert(WS_ACAT + (size_t)MT * 1280 * 2 <= WS_UF && WS_UP + (size_t)MT * 256 * 2 <= WS_END && WS_GT + (size_t)MT * 2816 * 2 <= WS_H && WS_H + (size_t)MT * 2816 * 2 <= WS_END, "ws map 2");
static_assert(WS_HX + (size_t)MT * 1024 * 2 <= WS_Q && (size_t)2 * 4 * 128 * 64 * 64 * 8 <= (size_t)MT * 1024 * 2, "ws map 3");
constexpr int CW_TMO = 0, CW_CODE = 1, CW_BAR = 4096;

constexpr int RING_BYTES = 131072, LDSCTL_OFF = RING_BYTES, MISC_OFF = LDSCTL_OFF + 320, LDS_BYTES = 147456;

__device__ __forceinline__ float bf2f(unsigned v) { return __uint_as_float(v << 16); }
__device__ __forceinline__ float sigm(float x) { return 1.0f / (1.0f + __expf(-x)); }
__host__ __device__ __forceinline__ int in_map(int n) {
    if (n < 256) return n;
    if (n < 1280) { const int base = n < 768 ? 256 : 768, r = n - base, comp = r >> 6, p = r & 63, pp = p >> 1, e = p & 1;
        return base + comp * 64 + (pp < 16 ? 0 : 32) + (pp & 15) + 16 * e; }
    if (n < 1792) return n;
    if (n < 2304) { const int r = n - 1792; return 1792 + (r & 1) * 256 + (r >> 1); }
    return n;
}
namespace pg8 {
#define PG8_LAS __attribute__((address_space(3)))
typedef unsigned short bf16_t;
typedef short bf16x8 __attribute__((ext_vector_type(8)));
typedef float f32x4 __attribute__((ext_vector_type(4)));
typedef unsigned u32x4 __attribute__((ext_vector_type(4)));
constexpr int BM = 256, BK = 64, HALF = 128, HTB = HALF * BK * 2  , STAGE_BYTES = 8 * HTB, NXCD = 8, WGM = 8;

__host__ __device__ __forceinline__ int lds_byte(int r, int c) { const int st = (r >> 4) * 2 + (c >> 5), rr = r & 15, cc = c & 31, ob = rr * 64 + cc * 2; return st * 1024 + (ob ^ (((ob >> 9) & 1) << 5)); }
__host__ __device__ __forceinline__ void stage_rc(int b, int& R, int& C) { const int st = b / 1024, sb = b % 1024, swz = sb ^ (((sb >> 9) & 1) << 5); R = (st >> 1) * 16 + swz / 64; C = (st & 1) * 32 + (swz % 64) / 2; }
__host__ __device__ __forceinline__ int perm32(int rho) { const int n = rho >> 4, i = rho & 15; return 8 * (i >> 2) + 4 * n + (i & 3); }

struct Unit { int pm, pn; };
struct Gemm { const bf16_t* A; const bf16_t* Bt; int M, N, K; };

struct StaticOrder {
    int nM, nN, nwg, G, c;
    __host__ __device__ void init(int M, int N, int G_, int c_) { nM = M / BM; nN = N / BM; nwg = nM * nN; G = G_; c = c_; }
    __host__ __device__ bool next(int i, Unit& u) const {
        const long L = (long)i * G + c; if (L >= nwg) return false;
        int wgid = (int)L; { const int q = nwg / NXCD, r = nwg % NXCD, xcd = wgid % NXCD, off = wgid / NXCD; wgid = (xcd < r ? xcd * (q + 1) : r * (q + 1) + (xcd - r) * q) + off; }
        const int nig = WGM * nN, gid = wgid / nig, fm = gid * WGM, gsz = (nM - fm) < WGM ? (nM - fm) : WGM;
        u.pm = fm + ((wgid % nig) % gsz); u.pn = (wgid % nig) / gsz; return true;
    }
    __device__ __forceinline__ void a_ready(const Unit&) const {}
    __device__ __forceinline__ void done(const Unit&) const {}
};
__device__ __forceinline__ unsigned cvt_pk_bf16(float lo, float hi) { unsigned r; asm volatile("v_cvt_pk_bf16_f32 %0, %1, %2" : "=v"(r) : "v"(lo), "v"(hi)); return r; }
typedef float f32x2 __attribute__((ext_vector_type(2)));
__device__ __forceinline__ f32x2 gelu_pk(f32x2 v) {
    const f32x2 av = __builtin_elementwise_abs(v), d = av * 0.2316418882f + 1.0f;
    f32x2 t; t.x = __builtin_amdgcn_rcpf(d.x); t.y = __builtin_amdgcn_rcpf(d.y);
    f32x2 q = t * 0.5307027145f + (-0.7265760135f); q = q * t + 0.7107068705f; q = q * t + (-0.142248368f); q = q * t + 0.127414796f; q = q * t;
    const f32x2 s = (v * v) * (-0.72134752044f);
    f32x2 e; e.x = __builtin_amdgcn_exp2f(s.x); e.y = __builtin_amdgcn_exp2f(s.y);
    const f32x2 m = v * (q * e), r = v - m;
    f32x2 o; o.x = v.x < 0.f ? m.x : r.x; o.y = v.y < 0.f ? m.y : r.y; return o;
}

typedef unsigned u32x2 __attribute__((ext_vector_type(2)));
__device__ __forceinline__ u32x4 pack8(const f32x4 a, const f32x4 b) { u32x4 w; w.x = cvt_pk_bf16(a[0], a[1]); w.y = cvt_pk_bf16(a[2], a[3]); w.z = cvt_pk_bf16(b[0], b[1]); w.w = cvt_pk_bf16(b[2], b[3]); return w; }

struct EpiIn {
    static constexpr bool PERM = true, AFTER_DRAIN = false, RESCALE = false;
    bf16_t *UF, *ZG, *UP, *Q, *K, *V; unsigned char* G; const float* rope;
    __device__ __forceinline__ void operator()(const f32x4 (&acc)[2][2][4][2], const Unit& u, int wr, int wc, int fr, int fq) const {
        const int pm = u.pm, pn = u.pn; const bool lat = pm < 64; const int R0 = pm * 256;
        const int kv0 = lat ? ((pm >> 5) * 8448 + 256 + ((pm & 31) << 8)) : ((pm - 64) * 8448);
        const int rl = wr * 64 + fr, cl = wc * 32 + 8 * fq;
        if (pn == 0 || pn == 9) {
            bf16_t* dst = (pn == 0 ? UF : UP);
#pragma unroll
            for (int ai = 0; ai < 2; ++ai)
#pragma unroll
                for (int m = 0; m < 4; ++m) { const int rr = ai * 128 + m * 16 + rl;
#pragma unroll
                    for (int bj = 0; bj < 2; ++bj) *(u32x4*)(dst + (size_t)(R0 + rr) * 256 + bj * 128 + cl) = pack8(acc[ai][bj][m][0], acc[ai][bj][m][1]); }
        } else if (pn <= 4) {
            const bool isq = pn <= 2; bf16_t* dst = isq ? Q : K; const int rowbase = isq ? R0 : kv0, colbase = (isq ? pn - 1 : pn - 3) * 256; const float sc = isq ? 0.125f : 1.0f;
#pragma unroll
            for (int ai = 0; ai < 2; ++ai)
#pragma unroll
                for (int m = 0; m < 4; ++m) { const int rr = ai * 128 + m * 16 + rl;
                    f32x4 cs = {1.f, 1.f, 1.f, 1.f}, sn = {0.f, 0.f, 0.f, 0.f};
                    if (lat) { const int t = (R0 & 8191) + rr; const int pos = (wc & 1) ? 128 + (t & 63) : (t >> 6);
                        cs = *(const f32x4*)(rope + pos * 32 + 4 * fq); sn = *(const f32x4*)(rope + pos * 32 + 16 + 4 * fq); }
                    cs = cs * sc; sn = sn * sc;
#pragma unroll
                    for (int bj = 0; bj < 2; ++bj) { const f32x4 a = acc[ai][bj][m][0], b = acc[ai][bj][m][1]; f32x4 oa, ob;
                        oa[0] = a[0] * cs[0] - a[1] * sn[0]; oa[1] = a[1] * cs[0] + a[0] * sn[0]; oa[2] = a[2] * cs[1] - a[3] * sn[1]; oa[3] = a[3] * cs[1] + a[2] * sn[1];
                        ob[0] = b[0] * cs[2] - b[1] * sn[2]; ob[1] = b[1] * cs[2] + b[0] * sn[2]; ob[2] = b[2] * cs[3] - b[3] * sn[3]; ob[3] = b[3] * cs[3] + b[2] * sn[3];
                        *(u32x4*)(dst + (size_t)(rowbase + rr) * 512 + colbase + bj * 128 + cl) = pack8(oa, ob); } }
        } else if (pn <= 6) {
#pragma unroll
            for (int ai = 0; ai < 2; ++ai)
#pragma unroll
                for (int m = 0; m < 4; ++m) { const int rr = ai * 128 + m * 16 + rl;
#pragma unroll
                    for (int bj = 0; bj < 2; ++bj) *(u32x4*)(V + (size_t)(kv0 + rr) * 512 + (pn - 5) * 256 + bj * 128 + cl) = pack8(acc[ai][bj][m][0], acc[ai][bj][m][1]); }
        } else if (pn <= 8) {
#pragma unroll
            for (int ai = 0; ai < 2; ++ai)
#pragma unroll
                for (int m = 0; m < 4; ++m) { const int rr = ai * 128 + m * 16 + rl;
#pragma unroll
                    for (int bj = 0; bj < 2; ++bj) { const f32x4 a = acc[ai][bj][m][0], b = acc[ai][bj][m][1];
                        u32x2 w; w.x = cvt_pk_bf16(a[0] * sigm(a[1]), a[2] * sigm(a[3])); w.y = cvt_pk_bf16(b[0] * sigm(b[1]), b[2] * sigm(b[3]));
                        *(u32x2*)(ZG + (size_t)(R0 + rr) * 256 + (pn - 7) * 128 + bj * 64 + (cl >> 1)) = w; } }
        } else {
#pragma unroll
            for (int ai = 0; ai < 2; ++ai)
#pragma unroll
                for (int m = 0; m < 4; ++m) { const int rr = ai * 128 + m * 16 + rl;
#pragma unroll
                    for (int bj = 0; bj < 2; ++bj) { u32x2 w;
#pragma unroll
                        for (int n = 0; n < 2; ++n) { const f32x4 a = acc[ai][bj][m][n]; unsigned q = 0;
#pragma unroll
                            for (int j = 0; j < 4; ++j) { float s = sigm(a[j]) * 255.0f + 0.5f; s = s < 1.0f ? 1.0f : s; q |= ((unsigned)s) << (8 * j); }
                            if (n == 0) w.x = q; else w.y = q; }
                        *(u32x2*)(G + (size_t)(R0 + rr) * 4096 + (pn - 10) * 256 + bj * 128 + cl) = w; } }
        }
    }
};

struct EpiBf {
    static constexpr bool PERM = true, AFTER_DRAIN = false, RESCALE = false;
    bf16_t* O; int ldc;
    __device__ __forceinline__ void operator()(const f32x4 (&acc)[2][2][4][2], const Unit& u, int wr, int wc, int fr, int fq) const {
        const int row0 = u.pm * 256 + wr * 64 + fr, col0 = u.pn * 256 + wc * 32 + 8 * fq;
#pragma unroll
        for (int ai = 0; ai < 2; ++ai)
#pragma unroll
            for (int m = 0; m < 4; ++m)
#pragma unroll
                for (int bj = 0; bj < 2; ++bj) *(u32x4*)(O + (size_t)(row0 + ai * 128 + m * 16) * ldc + col0 + bj * 128) = pack8(acc[ai][bj][m][0], acc[ai][bj][m][1]);
    }
};

struct EpiRes {
    static constexpr bool PERM = false, AFTER_DRAIN = false, RESCALE = false;
    const float* base_lat; const float* base_ctx; float* out_lat; float* out_ctx; const float* mod; int goff;
    __device__ __forceinline__ void operator()(const f32x4 (&acc)[2][2][4][2], const Unit& u, int wr, int wc, int fr, int fq) const {
        const int pm = u.pm; const bool lat = pm < 64; const int mrow = lat ? (pm >> 5) : 2;
        const float* base = lat ? base_lat + (size_t)pm * 256 * 1024 : base_ctx + (size_t)(pm - 64) * 256 * 1024;
        float* out = lat ? out_lat + (size_t)pm * 256 * 1024 : out_ctx + (size_t)(pm - 64) * 256 * 1024;
        const int col0 = u.pn * 256 + wc * 32 + 4 * fq;
        f32x4 gv[2][2];
#pragma unroll
        for (int bj = 0; bj < 2; ++bj)
#pragma unroll
            for (int n = 0; n < 2; ++n) gv[bj][n] = *(const f32x4*)(mod + mrow * 6144 + goff + col0 + bj * 128 + n * 16);
#pragma unroll
        for (int ai = 0; ai < 2; ++ai)
#pragma unroll
            for (int m = 0; m < 4; ++m) { const size_t ro = (size_t)(ai * 128 + wr * 64 + m * 16 + fr) * 1024 + col0;
#pragma unroll
                for (int bj = 0; bj < 2; ++bj)
#pragma unroll
                    for (int n = 0; n < 2; ++n) { const size_t off = ro + bj * 128 + n * 16; const f32x4 b = *(const f32x4*)(base + off); *(f32x4*)(out + off) = b + gv[bj][n] * acc[ai][bj][m][n]; } }
    }
};

struct EpiVal {
    static constexpr bool PERM = true, AFTER_DRAIN = false, RESCALE = false;
    const bf16_t* GT; bf16_t* H; const float* dww; const float* dwb;
    __device__ __forceinline__ void operator()(const f32x4 (&acc)[2][2][4][2], const Unit& u, int wr, int wc, int fr, int fq) const {
        const int pm = u.pm; const bool lat = pm < 64; const int R0 = pm * 256, t0 = lat ? (R0 & 8191) : 0, L = lat ? 8192 : 256;
        const int rl = wr * 64 + fr;
#pragma unroll
        for (int bj = 0; bj < 2; ++bj) { const int col = u.pn * 256 + bj * 128 + wc * 32 + 8 * fq;
            f32x4 w0[2], w1[2], w2[2], bb[2];
#pragma unroll
            for (int n = 0; n < 2; ++n) { w0[n] = *(const f32x4*)(dww + col + 4 * n); w1[n] = *(const f32x4*)(dww + 2816 + col + 4 * n); w2[n] = *(const f32x4*)(dww + 5632 + col + 4 * n); bb[n] = *(const f32x4*)(dwb + col + 4 * n); }
#pragma unroll
            for (int ai = 0; ai < 2; ++ai)
#pragma unroll
                for (int m = 0; m < 4; ++m) { const int rr = ai * 128 + m * 16 + rl, t = t0 + rr; const bf16_t* gp = GT + (size_t)(R0 + rr) * 2816 + col;
                    u32x4 gm = {0u, 0u, 0u, 0u}, gq = {0u, 0u, 0u, 0u}; const u32x4 g0 = *(const u32x4*)gp;
                    if (t > 0) gm = *(const u32x4*)(gp - 2816);
                    if (t < L - 1) gq = *(const u32x4*)(gp + 2816);
                    f32x4 o[2];
#pragma unroll
                    for (int n = 0; n < 2; ++n) { f32x4 c;
#pragma unroll
                        for (int j = 0; j < 4; ++j) { const int e = 4 * n + j; const unsigned wm = gm[e >> 1], wz = g0[e >> 1], wp = gq[e >> 1];
                            const float xm = (e & 1) ? __uint_as_float(wm & 0xffff0000u) : __uint_as_float(wm << 16), xz = (e & 1) ? __uint_as_float(wz & 0xffff0000u) : __uint_as_float(wz << 16),
                                        xp = (e & 1) ? __uint_as_float(wp & 0xffff0000u) : __uint_as_float(wp << 16);
                            c[j] = w0[n][j] * xm + w1[n][j] * xz + w2[n][j] * xp + bb[n][j]; }
                        const f32x2 ga = gelu_pk((f32x2){c[0], c[1]}), gb = gelu_pk((f32x2){c[2], c[3]});
                        const f32x4 v = acc[ai][bj][m][n]; o[n] = (f32x4){v[0] * ga.x, v[1] * ga.y, v[2] * gb.x, v[3] * gb.y}; }
                    *(u32x4*)(H + (size_t)(R0 + rr) * 2816 + col) = pack8(o[0], o[1]); }
        }
    }
};

struct EpiBranch {
    static constexpr bool PERM = true, AFTER_DRAIN = false, RESCALE = true;
    const unsigned char* G; bf16_t* Y;
    __device__ __forceinline__ void rescale(f32x4 (&acc)[2][2][4][2], const Unit& u, int t, int wr, int wc, int fr, int fq) const {
        const int bp = (t == 4) ? 0 : (t == 12) ? 1 : 2;
        const __amdgpu_buffer_rsrc_t rs = __builtin_amdgcn_make_buffer_rsrc((void*)G, 0, MT * 4096, 0x00020000);
        const int voff = (u.pm * 256 + wr * 64 + fr) * 4096 + u.pn * 256 + wc * 32 + 8 * fq;
#pragma unroll
        for (int ai = 0; ai < 2; ++ai)
#pragma unroll
            for (int m = 0; m < 4; ++m) {
#pragma unroll
                for (int bj = 0; bj < 2; ++bj) { const int so = (ai * 128 + m * 16) * 4096 + bj * 128 + bp * 1024;
                    const u32x2 p = __builtin_bit_cast(u32x2, __builtin_amdgcn_raw_buffer_load_b64(rs, voff, so, 0)), q = __builtin_bit_cast(u32x2, __builtin_amdgcn_raw_buffer_load_b64(rs, voff, so + 1024, 0));
#pragma unroll
                    for (int n = 0; n < 2; ++n) { const unsigned pw = n ? p.y : p.x, qw = n ? q.y : q.x;
#pragma unroll
                        for (int j = 0; j < 4; ++j) acc[ai][bj][m][n][j] *= (float)((pw >> (8 * j)) & 255u) * __builtin_amdgcn_rcpf((float)((qw >> (8 * j)) & 255u)); } }
                asm volatile("" ::: "memory"); }
    }
    __device__ __forceinline__ void operator()(const f32x4 (&acc)[2][2][4][2], const Unit& u, int wr, int wc, int fr, int fq) const {
        const int row0 = u.pm * 256 + wr * 64 + fr, col0 = u.pn * 256 + wc * 32 + 8 * fq;
#pragma unroll
        for (int ai = 0; ai < 2; ++ai)
#pragma unroll
            for (int m = 0; m < 4; ++m)
#pragma unroll
                for (int bj = 0; bj < 2; ++bj) { const size_t r = (size_t)(row0 + ai * 128 + m * 16); const u32x2 p = *(const u32x2*)(G + r * 4096 + 3072 + col0 + bj * 128);
                    f32x4 o[2];
#pragma unroll
                    for (int n = 0; n < 2; ++n) { const unsigned pw = n ? p.y : p.x;
#pragma unroll
                        for (int j = 0; j < 4; ++j) o[n][j] = acc[ai][bj][m][n][j] * ((float)((pw >> (8 * j)) & 255u) * (1.0f / 255.0f)); }
                    *(u32x4*)(Y + r * 1024 + col0 + bj * 128) = pack8(o[0], o[1]); }
    }
};

template <class Epi, class Sched, bool ALIGN_EPI = false, bool SP2 = false>
__device__ __forceinline__ void gemm_phase(PG8_LAS unsigned char* lds, const Gemm g, const Sched& S, const Epi& E, const int tid) {
    const int wid = __builtin_amdgcn_readfirstlane(tid >> 6), lane = tid & 63, wr = wid >> 2, wc = wid & 3, fr = lane & 15, fq = lane >> 4;
    const int K = g.K, nt = K / BK;
    unsigned voffA[2], voffB[2];
#pragma unroll
    for (int i = 0; i < 2; ++i) { int R, C; stage_rc(tid * 16 + i * 8192, R, C); const int Rb = Epi::PERM ? ((R & ~31) + perm32(R & 31)) : R;
        voffA[i] = (unsigned)(R * K + C) * 2u; voffB[i] = (unsigned)(Rb * K + C) * 2u; }
    const size_t kstep = (size_t)(BK * 2);
    const size_t hstep = (size_t)HALF * K * 2;
    const size_t tstep = 2 * hstep;
    const unsigned ldsw = (unsigned)wid * 1024u;
    const int aoff = lds_byte(wr * 64 + fr, fq * 8), boff = lds_byte(wc * 32 + fr, fq * 8);
#define PG8_SA(b, h) (((b) * 2 + (h)) * HTB)
#define PG8_SB(b, h) ((4 + (b) * 2 + (h)) * HTB)
#define PG8_STAGE(bufoff, gbase, voff) do { _Pragma("unroll") for (int _i = 0; _i < 2; ++_i) \
        __builtin_amdgcn_global_load_lds((const unsigned*)((const char*)(gbase) + (voff)[_i]), (PG8_LAS unsigned*)(lds + (bufoff) + ldsw + _i * 8192), 16, 0, 0); } while (0)
#define PG8_LDA(dst, b, h) do { _Pragma("unroll") for (int m = 0; m < 4; ++m) _Pragma("unroll") for (int k = 0; k < 2; ++k) dst[m][k] = *(const PG8_LAS bf16x8*)(lds + PG8_SA(b, h) + aoff + m * 2048 + k * 1024); } while (0)
#define PG8_LDB(dst, b, h) do { _Pragma("unroll") for (int n = 0; n < 2; ++n) _Pragma("unroll") for (int k = 0; k < 2; ++k) dst[n][k] = *(const PG8_LAS bf16x8*)(lds + PG8_SB(b, h) + boff + n * 2048 + k * 1024); } while (0)
#define PG8_MMA(ai, bj, At, Bt) do { __builtin_amdgcn_s_setprio(1); _Pragma("unroll") for (int m = 0; m < 4; ++m) _Pragma("unroll") for (int n = 0; n < 2; ++n) _Pragma("unroll") for (int k = 0; k < 2; ++k) \
        acc[ai][bj][m][n] = __builtin_amdgcn_mfma_f32_16x16x32_bf16(Bt[n][k], At[m][k], acc[ai][bj][m][n], 0, 0, 0); __builtin_amdgcn_s_setprio(0); } while (0)
#define PG8_WAIT_V(n) asm volatile("s_waitcnt vmcnt(" #n ")" ::: "memory")
#define PG8_WAIT_L(n) asm volatile("s_waitcnt lgkmcnt(" #n ")" ::: "memory")
#define PG8_BAR __builtin_amdgcn_s_barrier()
#define PG8_SCHED __builtin_amdgcn_sched_barrier(0)
    Unit cur, nxt; int ui = 0;
    if (!S.next(0, cur)) return;
    f32x4 acc[2][2][4][2];
#pragma unroll
    for (int a = 0; a < 2; ++a)
#pragma unroll
        for (int b = 0; b < 2; ++b)
#pragma unroll
            for (int m = 0; m < 4; ++m)
#pragma unroll
                for (int n = 0; n < 2; ++n) acc[a][b][m][n] = (f32x4){0.f, 0.f, 0.f, 0.f};
    bf16x8 At[4][2], B0[2][2], B1[2][2];
    const char* cA = (const char*)g.A + (size_t)cur.pm * tstep; const char* cB = (const char*)g.Bt + (size_t)cur.pn * tstep;
    S.a_ready(cur);
    if constexpr (SP2) {
        PG8_STAGE(PG8_SB(0, 0), cB, voffB); PG8_STAGE(PG8_SB(0, 1), cB + hstep, voffB); PG8_STAGE(PG8_SA(0, 0), cA, voffA); PG8_STAGE(PG8_SA(0, 1), cA + hstep, voffA);
        if (wr == 1) PG8_BAR;
        PG8_WAIT_V(2); PG8_BAR;
        PG8_STAGE(PG8_SB(1, 0), cB + kstep, voffB); PG8_STAGE(PG8_SA(1, 0), cA + kstep, voffA); PG8_STAGE(PG8_SB(1, 1), cB + hstep + kstep, voffB);
        PG8_WAIT_V(6); PG8_BAR;
    } else {
        PG8_STAGE(PG8_SB(0, 0), cB, voffB); PG8_STAGE(PG8_SA(0, 0), cA, voffA); PG8_STAGE(PG8_SB(0, 1), cB + hstep, voffB); PG8_STAGE(PG8_SA(0, 1), cA + hstep, voffA);
        if (wr == 1) PG8_BAR;
        PG8_WAIT_V(4); PG8_BAR;
        PG8_STAGE(PG8_SB(1, 0), cB + kstep, voffB); PG8_STAGE(PG8_SA(1, 0), cA + kstep, voffA); PG8_STAGE(PG8_SB(1, 1), cB + hstep + kstep, voffB);
        PG8_WAIT_V(6); PG8_BAR;
    }
    for (;;) {
        const bool has_next = S.next(ui + 1, nxt);
        const char* nA = has_next ? (const char*)g.A + (size_t)nxt.pm * tstep : cA; const char* nB = has_next ? (const char*)g.Bt + (size_t)nxt.pn * tstep : cB;
        for (int t = 0; t < nt; t += 2) {
            if constexpr (Epi::RESCALE) { if (t == 4 || t == 12 || t == 16) E.rescale(acc, cur, t, wr, wc, fr, fq); }
            const bool last = (t == nt - 2);
            const char* a1 = cA + (size_t)(t + 1) * kstep;
            const char* a2 = last ? nA : cA + (size_t)(t + 2) * kstep; const char* b2 = last ? nB : cB + (size_t)(t + 2) * kstep;
            const char* a3 = a2 + kstep; const char* b3 = b2 + kstep;
            if (last && has_next) S.a_ready(nxt);
            if constexpr (SP2) {
            PG8_LDB(B0, 0, 0); PG8_LDB(B1, 0, 1); PG8_SCHED; PG8_LDA(At, 0, 0); PG8_STAGE(PG8_SA(1, 1), a1 + hstep, voffA);
            PG8_WAIT_V(8); PG8_WAIT_L(0); PG8_BAR; PG8_MMA(0, 0, At, B0); PG8_MMA(0, 1, At, B1); PG8_BAR; PG8_SCHED;
            PG8_LDA(At, 0, 1); PG8_STAGE(PG8_SB(0, 0), b2, voffB); PG8_STAGE(PG8_SB(0, 1), b2 + hstep, voffB); PG8_STAGE(PG8_SA(0, 0), a2, voffA);
            PG8_WAIT_V(8); PG8_WAIT_L(0); PG8_BAR; PG8_MMA(1, 0, At, B0); PG8_MMA(1, 1, At, B1); PG8_BAR; PG8_SCHED;
            PG8_LDB(B0, 1, 0); PG8_LDB(B1, 1, 1); PG8_SCHED; PG8_LDA(At, 1, 0); PG8_STAGE(PG8_SA(0, 1), a2 + hstep, voffA);
            PG8_WAIT_V(8); PG8_WAIT_L(0); PG8_BAR; PG8_MMA(0, 0, At, B0); PG8_MMA(0, 1, At, B1); PG8_BAR; PG8_SCHED;
            PG8_LDA(At, 1, 1); PG8_STAGE(PG8_SB(1, 0), b3, voffB); PG8_STAGE(PG8_SB(1, 1), b3 + hstep, voffB); PG8_STAGE(PG8_SA(1, 0), a3, voffA);
            PG8_WAIT_V(8); PG8_WAIT_L(0); PG8_BAR; PG8_MMA(1, 0, At, B0); PG8_MMA(1, 1, At, B1); PG8_BAR; PG8_SCHED;
            } else {
            PG8_LDB(B0, 0, 0); PG8_SCHED; PG8_LDA(At, 0, 0); PG8_STAGE(PG8_SA(1, 1), a1 + hstep, voffA);
            PG8_WAIT_L(8); PG8_BAR; PG8_WAIT_L(0); PG8_MMA(0, 0, At, B0); PG8_BAR; PG8_SCHED;
            PG8_LDB(B1, 0, 1); PG8_STAGE(PG8_SB(0, 0), b2, voffB);
            PG8_BAR; PG8_WAIT_L(0); PG8_MMA(0, 1, At, B1); PG8_BAR;
            PG8_LDA(At, 0, 1); PG8_STAGE(PG8_SA(0, 0), a2, voffA);
            PG8_BAR; PG8_WAIT_L(0); PG8_MMA(1, 0, At, B0); PG8_BAR; PG8_SCHED;
            PG8_STAGE(PG8_SB(0, 1), b2 + hstep, voffB);
            PG8_WAIT_V(6); PG8_BAR; PG8_MMA(1, 1, At, B1); PG8_BAR;
            PG8_LDB(B0, 1, 0); PG8_SCHED; PG8_LDA(At, 1, 0); PG8_STAGE(PG8_SA(0, 1), a2 + hstep, voffA);
            PG8_WAIT_L(8); PG8_BAR; PG8_WAIT_L(0); PG8_MMA(0, 0, At, B0); PG8_BAR; PG8_SCHED;
            PG8_LDB(B1, 1, 1); PG8_STAGE(PG8_SB(1, 0), b3, voffB);
            PG8_BAR; PG8_WAIT_L(0); PG8_MMA(0, 1, At, B1); PG8_BAR;
            PG8_LDA(At, 1, 1); PG8_STAGE(PG8_SA(1, 0), a3, voffA);
            PG8_BAR; PG8_WAIT_L(0); PG8_MMA(1, 0, At, B0); PG8_BAR; PG8_SCHED;
            PG8_STAGE(PG8_SB(1, 1), b3 + hstep, voffB);
            PG8_WAIT_V(6); PG8_BAR; PG8_MMA(1, 1, At, B1); PG8_BAR;
            }
        }
        if constexpr (ALIGN_EPI) { if (wr == 0) PG8_BAR; }
        if constexpr (!Epi::AFTER_DRAIN) { E(acc, cur, wr, wc, fr, fq); S.done(cur); }
        if (!has_next) break;
#pragma unroll
        for (int a = 0; a < 2; ++a)
#pragma unroll
            for (int b = 0; b < 2; ++b)
#pragma unroll
                for (int m = 0; m < 4; ++m)
#pragma unroll
                    for (int n = 0; n < 2; ++n) acc[a][b][m][n] = (f32x4){0.f, 0.f, 0.f, 0.f};
        cur = nxt; cA = nA; cB = nB; ++ui;
        if constexpr (ALIGN_EPI) { if (wr == 1) PG8_BAR; }
    }
    PG8_WAIT_V(0);
    if constexpr (!ALIGN_EPI) { if (wr == 0) PG8_BAR; }
    PG8_BAR;
    if constexpr (Epi::AFTER_DRAIN) { E.fused(acc, cur, wr, wc, fr, fq, lds, wid, lane); S.done(cur); }
#undef PG8_SA
#undef PG8_SB
#undef PG8_STAGE
#undef PG8_LDA
#undef PG8_LDB
#undef PG8_MMA
#undef PG8_WAIT_V
#undef PG8_WAIT_L
#undef PG8_BAR
#undef PG8_SCHED
}
}
namespace att {
constexpr int NW = 8, QBLK = 32, KVBLK = 64, LDQ = 512, LDO = KCAT;
constexpr int SHM_V = 16384, SHM_K = 16384, SHM_ATTN = 2 * SHM_V + 2 * SHM_K + NW * 64 * 4;
constexpr float THR = 8.f;
#ifndef ATT_SDEPTH
#define ATT_SDEPTH 1
#endif
constexpr int SDEPTH = ATT_SDEPTH;
#define KSWZ(row, colB) ((row) * 256 + ((colB) ^ (((row) & 7) << 4)))
#define SBAR() __builtin_amdgcn_sched_barrier(0)
__device__ __forceinline__ int crow(int r, int hi) { return (r & 3) + 8 * (r >> 2) + 4 * hi; }
__device__ __forceinline__ unsigned cvtpk(float lo, float hi) { unsigned r; asm volatile("v_cvt_pk_bf16_f32 %0, %1, %2" : "=v"(r) : "v"(lo), "v"(hi)); return r; }

__device__ __forceinline__ void partialSM(f32x16& p0, f32x16& p1, float& m_reg, float& mn, float& alpha) {
  constexpr float C = 1.4426950408889634f;
  float pmax = p0[0];
#pragma unroll
  for (int r = 1; r < 16; ++r) pmax = fmaxf(pmax, p0[r]);
#pragma unroll
  for (int r = 0; r < 16; ++r) pmax = fmaxf(pmax, p1[r]);
  { auto rr = __builtin_amdgcn_permlane32_swap(__float_as_uint(pmax), __float_as_uint(pmax), false, false);
    pmax = fmaxf(__uint_as_float(rr[0]), __uint_as_float(rr[1])); }
  if (__builtin_expect(__all(pmax - m_reg <= THR), 1)) { mn = m_reg; alpha = 1.f; }
  else { mn = fmaxf(m_reg, pmax); alpha = __builtin_amdgcn_exp2f((m_reg - mn) * C); m_reg = mn; }
  const float mnC = -mn * C;
#pragma unroll
  for (int r = 0; r < 16; ++r) p0[r] = fmaf(p0[r], C, mnC);
#pragma unroll
  for (int r = 0; r < 16; ++r) p1[r] = fmaf(p1[r], C, mnC);
#pragma unroll
  for (int r = 0; r < 16; ++r) p0[r] = __builtin_amdgcn_exp2f(p0[r]);
}
__device__ __forceinline__ void finishSM(f32x16& p0, f32x16& p1, float alpha, float& l_reg, bf16x8& pa0, bf16x8& pa1, bf16x8& pa2, bf16x8& pa3) {
#pragma unroll
  for (int r = 0; r < 16; ++r) p1[r] = __builtin_amdgcn_exp2f(p1[r]);
  float ps = 0;
#pragma unroll
  for (int r = 0; r < 16; ++r) ps += p0[r];
#pragma unroll
  for (int r = 0; r < 16; ++r) ps += p1[r];
  { auto rr = __builtin_amdgcn_permlane32_swap(__float_as_uint(ps), __float_as_uint(ps), false, false);
    ps = __uint_as_float(rr[0]) + __uint_as_float(rr[1]); }
  l_reg = l_reg * alpha + ps;
#define PK4(P, BASE, OUT) do { unsigned a0 = cvtpk(P[BASE + 0], P[BASE + 1]), a1 = cvtpk(P[BASE + 2], P[BASE + 3]);   \
    unsigned b0 = cvtpk(P[BASE + 4], P[BASE + 5]), b1 = cvtpk(P[BASE + 6], P[BASE + 7]);                              \
    auto r0 = __builtin_amdgcn_permlane32_swap(a0, b0, false, false); auto r1 = __builtin_amdgcn_permlane32_swap(a1, b1, false, false); \
    u32x4 w = {r0[0], r1[0], r0[1], r1[1]}; OUT = *reinterpret_cast<bf16x8*>(&w); } while (0)
  PK4(p0, 0, pa0); PK4(p0, 8, pa1); PK4(p1, 0, pa2); PK4(p1, 8, pa3);
#undef PK4
}
__device__ __forceinline__ void qkt(f32x16& p0, f32x16& p1, const char* Ks, const bf16x8* qr, int r32, int hi, int kcol) {
  p0 = f32x16{}; p1 = f32x16{};
#pragma unroll
  for (int d0 = 0; d0 < 4; ++d0) { const int cb = kcol + (d0 * 16 + hi * 8) * 2;
    const bf16x8 b0 = *reinterpret_cast<const bf16x8*>(Ks + KSWZ(r32, cb));
    const bf16x8 b1 = *reinterpret_cast<const bf16x8*>(Ks + KSWZ(32 + r32, cb));
    p0 = __builtin_amdgcn_mfma_f32_32x32x16_bf16(b0, qr[d0], p0, 0, 0, 0);
    p1 = __builtin_amdgcn_mfma_f32_32x32x16_bf16(b1, qr[d0], p1, 0, 0, 0); }
}
__device__ __forceinline__ int v_st(int k, int c) { const int kk = (k & ~0xC) | ((k & 4) << 1) | ((k & 8) >> 1); return ((kk >> 3) * 4 + (c >> 5)) * 512 + ((kk & 7) * 32 + (c & 31)) * 2; }
__device__ __forceinline__ int v_rd_base(int lane) { return ((lane & 3) << 3) | (((lane >> 2) & 3) << 6) | (((lane >> 4) & 1) << 5) | (((lane >> 5) & 1) << 8); }
constexpr int v_rd_off(int d0, int ks, int half) { return d0 * 512 + ks * 4096 + half * 2048; }
template <int OFF> __device__ __forceinline__ s16x4 tr_read(int vb) {
  s16x4 r; asm volatile("ds_read_b64_tr_b16 %0, %1 offset:%2" : "=&v"(r) : "v"(vb), "i"(OFF) : "memory"); return r;
}
template <int D0> __device__ __forceinline__ void pv_one(f32x16& od, int vb, bf16x8 pa0, bf16x8 pa1, bf16x8 pa2, bf16x8 pa3) {
  const s16x4 l0 = tr_read<v_rd_off(D0, 0, 0)>(vb), h0 = tr_read<v_rd_off(D0, 0, 1)>(vb), l1 = tr_read<v_rd_off(D0, 1, 0)>(vb), h1 = tr_read<v_rd_off(D0, 1, 1)>(vb);
  const s16x4 l2 = tr_read<v_rd_off(D0, 2, 0)>(vb), h2 = tr_read<v_rd_off(D0, 2, 1)>(vb), l3 = tr_read<v_rd_off(D0, 3, 0)>(vb), h3 = tr_read<v_rd_off(D0, 3, 1)>(vb);
  asm volatile("s_waitcnt lgkmcnt(0)" ::: "memory"); SBAR();
#define PK(L, H) (bf16x8){L[0], L[1], L[2], L[3], H[0], H[1], H[2], H[3]}
  od = __builtin_amdgcn_mfma_f32_32x32x16_bf16(pa0, PK(l0, h0), od, 0, 0, 0);
  od = __builtin_amdgcn_mfma_f32_32x32x16_bf16(pa1, PK(l1, h1), od, 0, 0, 0);
  od = __builtin_amdgcn_mfma_f32_32x32x16_bf16(pa2, PK(l2, h2), od, 0, 0, 0);
  od = __builtin_amdgcn_mfma_f32_32x32x16_bf16(pa3, PK(l3, h3), od, 0, 0, 0);
#undef PK
}
__device__ __forceinline__ void pv_d0(f32x16* o, int vb, bf16x8 pa0, bf16x8 pa1, bf16x8 pa2, bf16x8 pa3) {
  pv_one<0>(o[0], vb, pa0, pa1, pa2, pa3); pv_one<1>(o[1], vb, pa0, pa1, pa2, pa3); pv_one<2>(o[2], vb, pa0, pa1, pa2, pa3); pv_one<3>(o[3], vb, pa0, pa1, pa2, pa3);
}

__device__ __forceinline__ void attn_unit(const bf16_t* __restrict__ Qb, const bf16_t* __restrict__ Kh, const bf16_t* __restrict__ Vh, int nkeys,
                                          bf16_t* __restrict__ Ob, float lam, float osc, const float* __restrict__ sg, char* lds, const int tid) {
  const int wid = __builtin_amdgcn_readfirstlane(tid >> 6), lane = tid & 63, r32 = lane & 31, hi = lane >> 5;
  const int comp = wid >> 2, qw = wid & 3, kcol = comp * 128;
  char* V_lds = lds; char* K_lds = lds + 2 * SHM_V;
  float* ws = (float*)(lds + 2 * SHM_V + 2 * SHM_K) + wid * 64; float* li_l = ws; float* al_l = ws + 32;
  float m_reg = -1e30f, l_reg = 0; f32x16 o[4] = {}; bf16x8 qr[4];
  const bf16_t* Qw = Qb + (long)(qw * QBLK + r32) * LDQ + comp * 64 + hi * 8;
#pragma unroll
  for (int d0 = 0; d0 < 4; ++d0) qr[d0] = *reinterpret_cast<const bf16x8*>(Qw + d0 * 16);
  const int sr = tid >> 4, sc = (tid & 15) * 8, vst0 = v_st(sr, sc), vst1 = v_st(32 + sr, sc);
  const int vb0 = (int)(uintptr_t)V_lds + v_rd_base(lane);
  struct { bf16x8 vs0, vs1, ks0, ks1; } sr_[SDEPTH];
#define SLOAD(i, k0) do { sr_[i].vs0 = *reinterpret_cast<const bf16x8*>(&Vh[(long)((k0) + sr) * LDQ + sc]); sr_[i].vs1 = *reinterpret_cast<const bf16x8*>(&Vh[(long)((k0) + 32 + sr) * LDQ + sc]); \
    sr_[i].ks0 = *reinterpret_cast<const bf16x8*>(&Kh[(long)((k0) + sr) * LDQ + sc]); sr_[i].ks1 = *reinterpret_cast<const bf16x8*>(&Kh[(long)((k0) + 32 + sr) * LDQ + sc]); } while (0)
#define SWRITE(b, i) do { *(bf16x8*)(V_lds + (b) * SHM_V + vst0) = sr_[i].vs0;          \
    *(bf16x8*)(V_lds + (b) * SHM_V + vst1) = sr_[i].vs1; const int kc = sc * 2;               \
    *(bf16x8*)(K_lds + (b) * SHM_K + KSWZ(sr, kc)) = sr_[i].ks0;                       \
    *(bf16x8*)(K_lds + (b) * SHM_K + KSWZ(32 + sr, kc)) = sr_[i].ks1; } while (0)
#define SWAIT() do { if constexpr (SDEPTH == 2) asm volatile("s_waitcnt vmcnt(4)" ::: "memory"); else asm volatile("s_waitcnt vmcnt(0)" ::: "memory"); } while (0)
#define RESC(a) do { if (__any((a) < 1.f)) { if (hi == 0) al_l[r32] = (a); asm volatile("s_waitcnt lgkmcnt(0)" ::: "memory"); \
    _Pragma("unroll") for (int d = 0; d < 4; ++d) _Pragma("unroll") for (int r = 0; r < 16; ++r) o[d][r] *= al_l[crow(r, hi)]; } } while (0)
  f32x16 pA0, pA1, pB0, pB1; float mnA, mnB, alA, alB; bf16x8 pa0, pa1, pa2, pa3; const int NT = nkeys / KVBLK;
  constexpr int SE = 0, SO = SDEPTH - 1;
  SLOAD(SE, 0); asm volatile("s_waitcnt vmcnt(0)" ::: "memory"); SWRITE(0, SE); __syncthreads();
  qkt(pA0, pA1, K_lds, qr, r32, hi, kcol); partialSM(pA0, pA1, m_reg, mnA, alA);
  SLOAD(SO, KVBLK); if constexpr (SDEPTH == 2) { if (2 < NT) SLOAD(SE, 2 * KVBLK); }
  SWAIT(); SWRITE(1, SO); __syncthreads();
  for (int j = 1; j + 1 < NT; j += 2) {
    SBAR(); qkt(pB0, pB1, K_lds + SHM_K, qr, r32, hi, kcol);
    finishSM(pA0, pA1, alA, l_reg, pa0, pa1, pa2, pa3); SBAR();
    SLOAD(SO, (j + SDEPTH) * KVBLK); SBAR();
    pv_d0(o, vb0, pa0, pa1, pa2, pa3); partialSM(pB0, pB1, m_reg, mnB, alB);
    __syncthreads(); SWAIT(); SWRITE(0, SE);
    RESC(alB); __syncthreads();
    SBAR(); qkt(pA0, pA1, K_lds, qr, r32, hi, kcol);
    finishSM(pB0, pB1, alB, l_reg, pa0, pa1, pa2, pa3); SBAR();
    if (SDEPTH == 1 || j + 3 < NT) SLOAD(SE, (j + 1 + SDEPTH) * KVBLK); SBAR();
    pv_d0(o, vb0 + SHM_V, pa0, pa1, pa2, pa3); partialSM(pA0, pA1, m_reg, mnA, alA);
    __syncthreads(); SWAIT(); SWRITE(1, SO);
    RESC(alA); __syncthreads();
  }
  SBAR(); qkt(pB0, pB1, K_lds + SHM_K, qr, r32, hi, kcol);
  finishSM(pA0, pA1, alA, l_reg, pa0, pa1, pa2, pa3); SBAR();
  pv_d0(o, vb0, pa0, pa1, pa2, pa3); partialSM(pB0, pB1, m_reg, mnB, alB);
  __syncthreads(); RESC(alB);
  finishSM(pB0, pB1, alB, l_reg, pa0, pa1, pa2, pa3); SBAR();
  pv_d0(o, vb0 + SHM_V, pa0, pa1, pa2, pa3);
  if (hi == 0) li_l[r32] = l_reg; asm volatile("s_waitcnt lgkmcnt(0)" ::: "memory");
  float rli[16];
#pragma unroll
  for (int r = 0; r < 16; ++r) rli[r] = __builtin_amdgcn_rcpf(li_l[crow(r, hi)]);
  __syncthreads();
  float* XO = (float*)lds + qw * (32 * 128);
  if (comp == 1) {
#pragma unroll
    for (int r = 0; r < 16; ++r)
#pragma unroll
      for (int d0 = 0; d0 < 4; ++d0) XO[crow(r, hi) * 128 + d0 * 32 + r32] = o[d0][r] * rli[r];
  }
  __syncthreads();
  if (comp == 0) {
    float ss[16];
#pragma unroll
    for (int r = 0; r < 16; ++r) { float s = 0.f;
#pragma unroll
      for (int d0 = 0; d0 < 4; ++d0) { const float v = o[d0][r] * rli[r] - lam * XO[crow(r, hi) * 128 + d0 * 32 + r32]; o[d0][r] = v; s += v * v; }
      ss[r] = s; }
#pragma unroll
    for (int r = 0; r < 16; ++r) { float s = ss[r]; s += __shfl_xor(s, 1); s += __shfl_xor(s, 2); s += __shfl_xor(s, 4); s += __shfl_xor(s, 8); s += __shfl_xor(s, 16);
      ss[r] = osc / sqrtf(s * (1.0f / 128.0f) + EPS); }
    float gam[4];
#pragma unroll
    for (int d0 = 0; d0 < 4; ++d0) gam[d0] = sg[d0 * 32 + r32];
    asm volatile("s_waitcnt lgkmcnt(0)" ::: "memory");
    bf16_t* stg = (bf16_t*)XO;
#pragma unroll
    for (int r = 0; r < 16; ++r)
#pragma unroll
      for (int d0 = 0; d0 < 4; ++d0) stg[crow(r, hi) * 128 + d0 * 32 + r32] = (bf16_t)(cvtpk(o[d0][r] * ss[r] * gam[d0], 0.f) & 0xffffu);
    asm volatile("s_waitcnt lgkmcnt(0)" ::: "memory");
#pragma unroll
    for (int i = 0; i < 8; ++i) { const int row = i * 4 + (lane >> 4), ch = lane & 15; const u32x4 v = *(const u32x4*)(stg + row * 128 + ch * 8);
      *(u32x4*)(Ob + (long)(qw * QBLK + row) * LDO + ch * 8) = v; }
  }
  __syncthreads();
#undef SLOAD
#undef SWRITE
#undef SWAIT
#undef RESC
}
#undef KSWZ
#undef SBAR
}
typedef GAS unsigned gu32;
#define RLX_AGENT __ATOMIC_RELAXED, __HIP_MEMORY_SCOPE_AGENT
constexpr int PT_OFF = LDSCTL_OFF + 1024;
__device__ __forceinline__ unsigned long long ldptr(volatile LAS unsigned long long* PT, int i) {
    const unsigned long long v = PT[i];
    const unsigned lo = __builtin_amdgcn_readfirstlane((unsigned)v), hi = __builtin_amdgcn_readfirstlane((unsigned)(v >> 32));
    return ((unsigned long long)hi << 32) | lo;
}
#define XB_TMO      128
#define XB_XCNT(j)  (256  + 64 * (j))
#define XB_XSUB(j)  (1280 + 64 * (j))
#define XB_XGEN(j)  (2304 + 64 * (j))
#define XB_TOP      3328
#define XB_TOPGEN   3392
#define XCD_BAR_WORDS 3456
#define XB_SPIN_CAP (1u << 18)

__device__ __forceinline__ unsigned xb_ld(unsigned* p)              { return __hip_atomic_load(p, __ATOMIC_RELAXED, __HIP_MEMORY_SCOPE_AGENT); }
__device__ __forceinline__ unsigned xb_add(unsigned* p, unsigned v) { return __hip_atomic_fetch_add(p, v, __ATOMIC_RELAXED, __HIP_MEMORY_SCOPE_AGENT); }
__device__ __forceinline__ unsigned xb_xcc_id() { return (unsigned)__builtin_amdgcn_s_getreg((3 << 11) | 20) & 0xFu; }
#define XB_SPIN(cond, bar) do { unsigned _sp = 0; while (cond) { __builtin_amdgcn_s_sleep(1); \
    if ((++_sp & 255u) == 0u) { if (xb_ld(&(bar)[XB_TMO])) break; if (_sp > XB_SPIN_CAP) { atomicAdd(&(bar)[XB_TMO], 1u); break; } } } } while (0)

struct XcdBarrier {
    unsigned* bar; unsigned x;
    volatile LAS unsigned* st;
};

__device__ __forceinline__ XcdBarrier xcd_barrier_post(unsigned* bar, volatile LAS unsigned* st) {
    XcdBarrier b; b.bar = bar; b.x = xb_xcc_id(); b.st = st;
    if (threadIdx.x == 0) (void)xb_add(&bar[XB_XCNT(b.x)], 1u);
    return b;
}
__device__ __forceinline__ void xcd_barrier_complete(unsigned* bar, unsigned x, unsigned& nloc, unsigned& nx) {
    const unsigned G = gridDim.x * gridDim.y * gridDim.z;
    unsigned sum, cnt, mine, sp = 0u;
    for (;;) {
        sum = 0u; cnt = 0u; mine = 0u;
#pragma unroll
        for (unsigned j = 0; j < 16; ++j) { const unsigned c = xb_ld(&bar[XB_XCNT(j)]); sum += c; cnt += (c > 0u) ? 1u : 0u; mine = (j == x) ? c : mine; }
        if (sum == G) break;
        __builtin_amdgcn_s_sleep(1);
        if ((++sp & 255u) == 0u) { if (xb_ld(&bar[XB_TMO])) break; if (sp > XB_SPIN_CAP) { atomicAdd(&bar[XB_TMO], 1u); break; } }
    }
    nloc = mine > 0u ? mine : 1u; nx = cnt > 0u ? cnt : 1u;
}

__device__ __forceinline__ void xcd_barrier(const XcdBarrier& b) {
    asm volatile("s_waitcnt vmcnt(0)" ::: "memory");
    __syncthreads();
    if (threadIdx.x == 0) {
        unsigned* bar = b.bar;
        __builtin_amdgcn_s_waitcnt(0);
        unsigned nloc = b.st[0], nx = b.st[1];
        if (nloc == 0u) { xcd_barrier_complete(bar, b.x, nloc, nx); b.st[0] = nloc; b.st[1] = nx; }
        const unsigned old = xb_add(&bar[XB_XSUB(b.x)], 1u);
        const unsigned gen = old / nloc;
        if (old + 1u == (gen + 1u) * nloc) {
            __builtin_amdgcn_fence(__ATOMIC_RELEASE, "agent");
            asm volatile("s_waitcnt vmcnt(0)" ::: "memory");
            const unsigned og = xb_add(&bar[XB_TOP], 1u);
            const unsigned tg = og / nx;
            if (og + 1u == (tg + 1u) * nx) xb_add(&bar[XB_TOPGEN], 1u);
            else XB_SPIN(xb_ld(&bar[XB_TOPGEN]) == tg, bar);
            __builtin_amdgcn_fence(__ATOMIC_ACQUIRE, "agent");
            xb_add(&bar[XB_XGEN(b.x)], 1u);
            asm volatile("s_waitcnt vmcnt(0)" ::: "memory");
        } else {
            XB_SPIN(xb_ld(&bar[XB_XGEN(b.x)]) == gen, bar);
            __builtin_amdgcn_fence(__ATOMIC_ACQUIRE, "agent");
            asm volatile("s_waitcnt vmcnt(0)" ::: "memory");
        }
    }
    __syncthreads();
}
__device__ __forceinline__ float wave_sum(float v) {
#pragma unroll
    for (int o = 1; o < 64; o <<= 1) v += __shfl_xor(v, o);
    return v;
}
__device__ __forceinline__ unsigned pk2(float lo, float hi) { unsigned r; asm volatile("v_cvt_pk_bf16_f32 %0, %1, %2" : "=v"(r) : "v"(lo), "v"(hi)); return r; }

template <int MAP  >
__device__ __forceinline__ void transpose_item(const float* W, int Nsrc, int coff, bf16_t* WT, int ldw, int koff, int nblk, LAS float* scr, int item, int lane) {
    const int kb = item / nblk, nb = item % nblk, k0 = 64 * kb, n0 = 32 * nb;
    const int nd = n0 + (lane & 31); const int scol = MAP ? in_map(nd) : nd + coff;
#pragma unroll 8
    for (int i = 0; i < 32; ++i) { const int kk = 2 * i + (lane >> 5); scr[kk * 33 + (lane & 31)] = W[(size_t)(k0 + kk) * Nsrc + scol]; }
    asm volatile("s_waitcnt lgkmcnt(0)" ::: "memory");
    const int c = lane & 7;
#pragma unroll
    for (int j = 0; j < 4; ++j) { const int n = (lane >> 3) + 8 * j; const LAS float* s = scr + (8 * c) * 33 + n;
        u32x4 o; o.x = pk2(s[0 * 33], s[1 * 33]); o.y = pk2(s[2 * 33], s[3 * 33]); o.z = pk2(s[4 * 33], s[5 * 33]); o.w = pk2(s[6 * 33], s[7 * 33]);
        *(u32x4*)(WT + (size_t)(n0 + n) * ldw + koff + k0 + 8 * c) = o; }
    asm volatile("s_waitcnt lgkmcnt(0)" ::: "memory");
}
struct WSrc { const float *w_in, *wo_f, *wo_a, *wo_c, *wo_p, *w_out, *w_up, *w_down; };
constexpr int IT_A = 16 * 208;
constexpr int IT_B0 = 4 * 32, IT_B1 = 8 * 32, IT_B2 = 4 * 32, IT_B3 = 4 * 32, IT_B4 = 16 * 32, IT_B5 = 16 * 88, IT_B6 = 16 * 88, IT_B7 = 44 * 32;
constexpr int IT_B = IT_B0 + IT_B1 + IT_B2 + IT_B3 + IT_B4 + IT_B5 + IT_B6 + IT_B7;
__device__ __forceinline__ void convert_A(const WSrc& S, unsigned char* ws, LAS float* scr, int gw, int NGW, int lane) {
    for (int it = gw; it < IT_A; it += NGW) transpose_item<1>(S.w_in, NIN, 0, (bf16_t*)(ws + WS_WA), 1024, 0, 208, scr, it, lane);
}
__device__ __forceinline__ void convert_B(const WSrc& S, unsigned char* ws, LAS float* scr, int gw, int NGW, int lane) {
    for (int it = gw; it < IT_B; it += NGW) { int r = it;
        if (r < IT_B0) { transpose_item<0>(S.wo_f, 1024, 0, (bf16_t*)(ws + WS_WCAT), KCAT, 0, 32, scr, r, lane); continue; } r -= IT_B0;
        if (r < IT_B1) { transpose_item<0>(S.wo_a, 1024, 0, (bf16_t*)(ws + WS_WCAT), KCAT, 256, 32, scr, r, lane); continue; } r -= IT_B1;
        if (r < IT_B2) { transpose_item<0>(S.wo_c, 1024, 0, (bf16_t*)(ws + WS_WCAT), KCAT, 768, 32, scr, r, lane); continue; } r -= IT_B2;
        if (r < IT_B3) { transpose_item<0>(S.wo_p, 1024, 0, (bf16_t*)(ws + WS_WCAT), KCAT, 1024, 32, scr, r, lane); continue; } r -= IT_B3;
        if (r < IT_B4) { transpose_item<0>(S.w_out, 1024, 0, (bf16_t*)(ws + WS_WOUT), 1024, 0, 32, scr, r, lane); continue; } r -= IT_B4;
        if (r < IT_B5) { transpose_item<0>(S.w_up, 2 * DFF, DFF, (bf16_t*)(ws + WS_WUPG), 1024, 0, 88, scr, r, lane); continue; } r -= IT_B5;
        if (r < IT_B6) { transpose_item<0>(S.w_up, 2 * DFF, 0, (bf16_t*)(ws + WS_WUPV), 1024, 0, 88, scr, r, lane); continue; } r -= IT_B6;
        transpose_item<0>(S.w_down, 1024, 0, (bf16_t*)(ws + WS_WDN), DFF, 0, 32, scr, r, lane);
    }
}

__device__ __forceinline__ void mod_phase(const float* c, const float* c_ctx, const float* ada_w, const float* ada_b, float* MOD, LAS unsigned char* lds, int vcu, int G, int tid, int wave, int lane) {
    LAS float* sil = (LAS float*)lds;
    LAS float* red = (LAS float*)(lds + 12288);
    for (int i = tid; i < 3072; i += 512) { const float v = i < 2048 ? c[i] : c_ctx[i - 2048]; sil[i] = v * sigm(v); }
    __syncthreads();
    for (int item = vcu; item < 192; item += G) {
        const int l = item / 96, n = (item % 96) * 64 + lane;
        const float* W = ada_w + (size_t)l * 1024 * 6144 + n;
        float a0 = 0.f, a1 = 0.f, a2 = 0.f;
        for (int k = wave * 128; k < wave * 128 + 128; k += 8) { float w[8];
#pragma unroll
            for (int i = 0; i < 8; ++i) w[i] = W[(size_t)(k + i) * 6144];
#pragma unroll
            for (int i = 0; i < 8; ++i) { a0 += sil[k + i] * w[i]; a1 += sil[1024 + k + i] * w[i]; a2 += sil[2048 + k + i] * w[i]; } }
        red[(wave * 3 + 0) * 64 + lane] = a0; red[(wave * 3 + 1) * 64 + lane] = a1; red[(wave * 3 + 2) * 64 + lane] = a2;
        __syncthreads();
        if (wave < 3) { float s = ada_b[l * 6144 + n];
#pragma unroll
            for (int w = 0; w < 8; ++w) s += red[(w * 3 + wave) * 64 + lane];
            MOD[(size_t)(l * 3 + wave) * 6144 + n] = s; }
        __syncthreads();
    }
}
__device__ __forceinline__ void tables_phase(float* ROPE, f32x2* TW, int gt, int NGT) {
    for (int i = gt; i < 192 * 16; i += NGT) { const int pos = i >> 4, f = i & 15; const float inv = powf(10000.0f, -(float)f / 16.0f); const float ang = (float)(pos < 128 ? pos : pos - 128) * inv;
        float s, c; sincosf(ang, &s, &c); ROPE[pos * 32 + f] = c; ROPE[pos * 32 + 16 + f] = s; }
    for (int i = gt; i < 8192; i += NGT) { float s, c; sincospif((float)i * (1.0f / 4096.0f), &s, &c); TW[i] = (f32x2){c, -s}; }
}

__device__ __forceinline__ void norm_phase(const float* src_lat, const float* src_ctx, int nrows, const float* gamma, const float* mod, int shoff, int scoff, bf16_t* HX, int gw, int NGW, int lane) {
    for (int m = gw; m < nrows; m += NGW) {
        const float* xr = m < ML ? src_lat + (size_t)m * DM : src_ctx + (size_t)(m - ML) * DM;
        const float* md = mod + (m < SEQ ? 0 : m < ML ? 1 : 2) * 6144;
        f32x4 v[4]; float s = 0.f;
#pragma unroll
        for (int j = 0; j < 4; ++j) { v[j] = ((const f32x4*)xr)[lane + 64 * j]; s += (v[j].x * v[j].x + v[j].y * v[j].y) + (v[j].z * v[j].z + v[j].w * v[j].w); }
        const float rstd = 1.0f / sqrtf(wave_sum(s) * (1.0f / DM) + EPS);
#pragma unroll
        for (int j = 0; j < 4; ++j) { const int col = 4 * lane + 256 * j;
            const f32x4 g = *(const f32x4*)(gamma + col), sc = *(const f32x4*)(md + scoff + col), sh = *(const f32x4*)(md + shoff + col);
            const f32x4 o = v[j] * rstd * g * (sc + 1.0f) + sh;
            u32x2 w; w.x = pk2(o.x, o.y); w.y = pk2(o.z, o.w); *(u32x2*)(HX + (size_t)m * DM + col) = w; }
    }
}
__device__ __forceinline__ void final_norm_phase(float* x, const float* gamma, int gw, int NGW, int lane) {
    for (int m = gw; m < ML; m += NGW) { f32x4* xr = (f32x4*)(x + (size_t)m * DM);
        f32x4 v[4]; float s = 0.f;
#pragma unroll
        for (int j = 0; j < 4; ++j) { v[j] = xr[lane + 64 * j]; s += (v[j].x * v[j].x + v[j].y * v[j].y) + (v[j].z * v[j].z + v[j].w * v[j].w); }
        const float rstd = 1.0f / sqrtf(wave_sum(s) * (1.0f / DM) + EPS);
#pragma unroll
        for (int j = 0; j < 4; ++j) { const f32x4 g = *(const f32x4*)(gamma + 4 * lane + 256 * j); xr[lane + 64 * j] = v[j] * rstd * g; }
    }
}

__device__ __forceinline__ void fft1_item(int item, const bf16_t* UF, const f32x2* TW, f32x2* FA, LAS unsigned char* lds, int tid, int wave, int lane) {
    const int b = item >> 8, g = (item >> 6) & 3, l2 = item & 63;
    LAS float* xs = (LAS float*)lds; LAS f32x2* w128 = (LAS f32x2*)(lds + 32768);
    for (int i = tid; i < 128 * 64; i += 512) { const int l1 = i >> 6, c = i & 63; xs[i] = bf2f(UF[(size_t)(b * SEQ + 64 * l1 + l2) * 256 + g * 64 + c]); }
    if (tid < 128) { float s, c; sincospif((float)tid * (1.0f / 64.0f), &s, &c); w128[tid] = (f32x2){c, s}; }
    __syncthreads();
    float re[16], im[16];
#pragma unroll
    for (int j = 0; j < 16; ++j) { re[j] = 0.f; im[j] = 0.f; }
    const int kb = wave * 16;
    for (int l1 = 0; l1 < 128; ++l1) { const float x = xs[l1 * 64 + lane];
#pragma unroll
        for (int j = 0; j < 16; ++j) { const f32x2 cs = w128[((kb + j) * l1) & 127]; re[j] += x * cs.x; im[j] -= x * cs.y; } }
#pragma unroll
    for (int j = 0; j < 16; ++j) { const int k1 = kb + j; const f32x2 t = TW[k1 * l2];
        FA[((size_t)((b * 4 + g) * 128 + k1) * 64 + l2) * 64 + lane] = (f32x2){re[j] * t.x - im[j] * t.y, re[j] * t.y + im[j] * t.x}; }
    __syncthreads();
}
__device__ __forceinline__ void fft2_item(int item, const f32x2* FA, bf16_t* ACAT, LAS unsigned char* lds, int tid, int wave, int lane) {
    const int b = item >> 9, g = (item >> 7) & 3, k1 = item & 127;
    LAS f32x2* As = (LAS f32x2*)lds; LAS f32x2* Zs = (LAS f32x2*)(lds + 32768); LAS f32x2* w64 = (LAS f32x2*)(lds + 65536);
    const f32x2* src = FA + (size_t)((b * 4 + g) * 128 + k1) * 4096;
    for (int i = tid; i < 4096; i += 512) As[i] = src[i];
    if (tid < 64) { float s, c; sincospif((float)tid * (1.0f / 32.0f), &s, &c); w64[tid] = (f32x2){c, s}; }
    __syncthreads();
    float zr[8], zi[8];
#pragma unroll
    for (int j = 0; j < 8; ++j) { zr[j] = 0.f; zi[j] = 0.f; }
    const int kb = wave * 8;
    for (int l2 = 0; l2 < 64; ++l2) { const f32x2 a = As[l2 * 64 + lane];
#pragma unroll
        for (int j = 0; j < 8; ++j) { const f32x2 cs = w64[((kb + j) * l2) & 63]; zr[j] += a.x * cs.x + a.y * cs.y; zi[j] += a.y * cs.x - a.x * cs.y; } }
#pragma unroll
    for (int j = 0; j < 8; ++j) Zs[(kb + j) * 64 + lane] = (f32x2){zr[j], zi[j]};
    __syncthreads();
    float y[8];
#pragma unroll
    for (int j = 0; j < 8; ++j) y[j] = 0.f;
    for (int c = 0; c < 64; ++c) { const f32x2 cs = w64[(lane * c) & 63];
#pragma unroll
        for (int j = 0; j < 8; ++j) { const f32x2 z = Zs[(kb + j) * 64 + c]; y[j] += z.x * cs.x + z.y * cs.y; } }
    const float scale = 0.001381067932f;
#pragma unroll
    for (int j = 0; j < 8; ++j) { const int k = k1 + 128 * (kb + j); ACAT[(size_t)(b * SEQ + k) * KCAT + g * 64 + lane] = (bf16_t)(pk2(y[j] * scale, 0.f) & 0xffffu); }
    __syncthreads();
}
__device__ __forceinline__ void ctxdft_item(int item, const bf16_t* UF, bf16_t* ACAT, LAS unsigned char* lds, int tid, int wave, int lane) {
    const int b = item >> 4, g = (item >> 2) & 3, kc = item & 3;
    LAS float* xs = (LAS float*)lds; LAS f32x2* Zs = (LAS f32x2*)(lds + 65536); LAS f32x2* w256 = (LAS f32x2*)(lds + 98304); LAS f32x2* w64 = (LAS f32x2*)(lds + 98304 + 2048);
    for (int i = tid; i < 256 * 64; i += 512) { const int l = i >> 6, c = i & 63; xs[i] = bf2f(UF[(size_t)(ML + b * CTXL + l) * 256 + g * 64 + c]); }
    if (tid < 256) { float s, c; sincospif((float)tid * (1.0f / 128.0f), &s, &c); w256[tid] = (f32x2){c, s}; }
    if (tid < 64) { float s, c; sincospif((float)tid * (1.0f / 32.0f), &s, &c); w64[tid] = (f32x2){c, s}; }
    __syncthreads();
    float zr[8], zi[8];
#pragma unroll
    for (int j = 0; j < 8; ++j) { zr[j] = 0.f; zi[j] = 0.f; }
    const int kb = 64 * kc + wave * 8;
    for (int l = 0; l < 256; ++l) { const float x = xs[l * 64 + lane];
#pragma unroll
        for (int j = 0; j < 8; ++j) { const f32x2 cs = w256[((kb + j) * l) & 255]; zr[j] += x * cs.x; zi[j] -= x * cs.y; } }
#pragma unroll
    for (int j = 0; j < 8; ++j) Zs[(wave * 8 + j) * 64 + lane] = (f32x2){zr[j], zi[j]};
    __syncthreads();
    float y[8];
#pragma unroll
    for (int j = 0; j < 8; ++j) y[j] = 0.f;
    for (int c = 0; c < 64; ++c) { const f32x2 cs = w64[(lane * c) & 63];
#pragma unroll
        for (int j = 0; j < 8; ++j) { const f32x2 z = Zs[(wave * 8 + j) * 64 + c]; y[j] += z.x * cs.x + z.y * cs.y; } }
#pragma unroll
    for (int j = 0; j < 8; ++j) ACAT[(size_t)(ML + b * CTXL + kb + j) * KCAT + g * 64 + lane] = (bf16_t)(pk2(y[j] * (1.0f / 128.0f), 0.f) & 0xffffu);
    __syncthreads();
}

__device__ __forceinline__ void conv_item(int item, const bf16_t* ZG, const float* cw  , const float* cb, const float* lng, const float* lnb, bf16_t* ACAT, LAS unsigned char* lds, int tid, int wave, int lane) {
    const int row0 = item * 64; const bool lat = row0 < ML; const int s0 = lat ? (row0 & ~(SEQ - 1)) : (ML + ((row0 - ML) & ~(CTXL - 1))), s1 = s0 + (lat ? SEQ : CTXL);
    LAS float* zt = (LAS float*)lds;
    for (int i = tid; i < 94 * 256; i += 512) { const int rr = i >> 8, c = i & 255, gr = row0 - 15 + rr; zt[i] = (gr >= s0 && gr < s1) ? bf2f(ZG[(size_t)gr * 256 + c]) : 0.f; }
    const int c = tid & 255, half = tid >> 8;
    float w[31];
#pragma unroll
    for (int t = 0; t < 31; ++t) w[t] = cw[t * 256 + c];
    float acc[32]; const float bias = cb[c];
#pragma unroll
    for (int r = 0; r < 32; ++r) acc[r] = bias;
    __syncthreads();
#pragma unroll
    for (int rr = 0; rr < 62; ++rr) { const float v = zt[(half * 32 + rr) * 256 + c];
#pragma unroll
        for (int r = 0; r < 32; ++r) { if (rr - r >= 0 && rr - r < 31) acc[r] += w[rr - r] * v; } }
    __syncthreads();
#pragma unroll
    for (int r = 0; r < 32; ++r) zt[(half * 32 + r) * 256 + c] = acc[r];
    __syncthreads();
    const f32x4 gg = *(const f32x4*)(lng + 4 * lane), bb = *(const f32x4*)(lnb + 4 * lane);
#pragma unroll
    for (int i = 0; i < 8; ++i) { const int r = wave * 8 + i; const f32x4 v = *(const LAS f32x4*)(zt + r * 256 + 4 * lane);
        const float mu = wave_sum((v.x + v.y) + (v.z + v.w)) * (1.0f / 256.0f); const f32x4 d = v - mu;
        const float var = wave_sum((d.x * d.x + d.y * d.y) + (d.z * d.z + d.w * d.w)) * (1.0f / 256.0f); const float rs = 1.0f / sqrtf(var + EPS);
        f32x4 o = d * rs * gg + bb; o.x *= sigm(o.x); o.y *= sigm(o.y); o.z *= sigm(o.z); o.w *= sigm(o.w);
        u32x2 pw; pw.x = pk2(o.x, o.y); pw.y = pk2(o.z, o.w); *(u32x2*)(ACAT + (size_t)(row0 + r) * KCAT + 768 + 4 * lane) = pw; }
    __syncthreads();
}
__device__ __forceinline__ void pool_item(int item, const bf16_t* UP, const float* pw  , const float* psc, bf16_t* ACAT, LAS unsigned char* lds, int tid, int wave, int lane) {
    const int row0 = item * 32; const bool lat = row0 < ML; const int s0 = lat ? (row0 & ~(SEQ - 1)) : (ML + ((row0 - ML) & ~(CTXL - 1))), L = lat ? SEQ : CTXL, s1 = s0 + L;
    LAS float* ut = (LAS float*)lds;
    LAS float* dt = (LAS float*)(lds + 49152);
    for (int i = tid; i < 48 * 256; i += 512) { const int rr = i >> 8, c = i & 255, gr = row0 - 8 + rr; ut[i] = (gr >= s0 && gr < s1) ? bf2f(UP[(size_t)gr * 256 + c]) : 0.f; }
    __syncthreads();
    { const int c = tid & 255, half = tid >> 8, g = c >> 6, hw = 1 << g;
#pragma unroll 4
      for (int r = 0; r < 16; ++r) { const int lr = half * 16 + r, tt = row0 + lr - s0; float s = 0.f;
          for (int o = -hw; o < hw; ++o) s += ut[(lr + 8 + o) * 256 + c];
          const int lo = tt - hw < 0 ? 0 : tt - hw, hi = tt + hw - 1 > L - 1 ? L - 1 : tt + hw - 1;
          dt[lr * 256 + c] = s / (float)(hi - lo + 1) - ut[(lr + 8) * 256 + c]; } }
    __syncthreads();
    { const int m = tid & 63, g = (tid >> 6) & 3, half = tid >> 8; float acc[16];
#pragma unroll
      for (int r = 0; r < 16; ++r) acc[r] = 0.f;
      const float* pwg = pw + g * 4096 + m;
      for (int cc = 0; cc < 64; ++cc) { const float wv = pwg[cc * 64];
#pragma unroll
          for (int r = 0; r < 16; ++r) acc[r] += dt[(half * 16 + r) * 256 + g * 64 + cc] * wv; }
      const float sc = psc[g * 64 + m];
#pragma unroll
      for (int r = 0; r < 16; ++r) ACAT[(size_t)(row0 + half * 16 + r) * KCAT + 1024 + g * 64 + m] = (bf16_t)(pk2(acc[r] * sc, 0.f) & 0xffffu); }
    __syncthreads();
}
constexpr int NPHASE = 22;
struct Args { const float* in[30]; float* out; unsigned char* ws; int ph_lo, ph_hi, li, pad; };
__global__ void __launch_bounds__(512, 2) fwd_kernel(Args args) {
    extern __shared__ __attribute__((aligned(16))) unsigned char lds[];
    LAS unsigned char* L = (LAS unsigned char*)lds;
    volatile LAS unsigned* MISC = (volatile LAS unsigned*)(L + MISC_OFF);
    const int tid0 = threadIdx.x;
    const int G = gridDim.x, bx0 = blockIdx.x, vcu0 = (G % 8 == 0) ? (bx0 % 8) * (G / 8) + bx0 / 8 : bx0;
    const int NGW = G * 8;
    gu32* ctl = (gu32*)(args.ws + WS_CTL);
    for (int u = tid0; u < (LDS_BYTES - LDSCTL_OFF) / 4; u += 512) ((LAS unsigned*)(L + LDSCTL_OFF))[u] = 0u;
    __syncthreads();
    volatile LAS unsigned long long* PT = (volatile LAS unsigned long long*)(L + PT_OFF);
    if (tid0 == 0) {
#define PTW(i) PT[i] = (unsigned long long)args.in[i];
        PTW(0) PTW(1) PTW(2) PTW(3) PTW(4) PTW(5) PTW(6) PTW(7) PTW(8) PTW(9) PTW(10) PTW(11) PTW(12) PTW(13) PTW(14) PTW(15) PTW(16) PTW(17) PTW(18) PTW(19)
        PTW(20) PTW(21) PTW(22) PTW(23) PTW(24) PTW(25) PTW(26) PTW(27) PTW(28) PTW(29)
#undef PTW
        PT[30] = (unsigned long long)args.out; PT[31] = (unsigned long long)args.ws;
    }
    __syncthreads();
#define FRESH() int tid = tid0, vcu = vcu0, bx = bx0; asm volatile("" : "+v"(tid), "+s"(vcu), "+s"(bx)); const int lane = tid & 63, wave = __builtin_amdgcn_readfirstlane(tid >> 6), gw = vcu * 8 + wave; (void)lane; (void)gw; (void)bx; \
    LAS float* scr = (LAS float*)(L + wave * 16384); (void)scr;
#define PTR(i) ((const float*)(const GAS float*)ldptr(PT, (i)))
#define OUTP ((float*)(GAS float*)ldptr(PT, 30))
#define WSP ((unsigned char*)(GAS unsigned char*)ldptr(PT, 31))
    XcdBarrier bar; bar.bar = (unsigned*)(ctl + CW_BAR) + args.li * XCD_BAR_WORDS; bar.x = 0; bar.st = nullptr;
    if (MK_N_LAUNCHES != NPHASE) bar = xcd_barrier_post((unsigned*)(ctl + CW_BAR) + args.li * XCD_BAR_WORDS, MISC + 8);
#define GRID_BAR() do { if (MK_N_LAUNCHES == NPHASE) { if (tid0 == 0) __hip_atomic_store(ctl + CW_TMO, 0xBADBA0u, RLX_AGENT); } else { xcd_barrier(bar); } } while (0)
    const int lo = args.ph_lo, hi = args.ph_hi;
#ifndef PHASE_MASK
#define PHASE_MASK 0xFFF
#endif
#ifndef ATTM
#define ATTM 3
#endif
#ifndef X1M
#define X1M 31
#endif
#define PH_EN(kind) ((PHASE_MASK >> (kind)) & 1)
#define IN(k) (lo <= (k) && (k) < hi)
#define BOTH(k) (IN(k) && IN((k) + 1))
#define WSRC(S, l) WSrc S; S.w_in = PTR(8) + (size_t)(l) * 1024 * NIN; S.wo_f = PTR(20) + (size_t)(l) * 256 * 1024; S.wo_a = PTR(21) + (size_t)(l) * 512 * 1024; \
    S.wo_c = PTR(22) + (size_t)(l) * 256 * 1024; S.wo_p = PTR(23) + (size_t)(l) * 256 * 1024; S.w_out = PTR(24) + (size_t)(l) * 1024 * 1024; \
    S.w_up = PTR(25) + (size_t)(l) * 1024 * 2 * DFF; S.w_down = PTR(28) + (size_t)(l) * DFF * 1024;
#define ws WSP
#define MOD ((float*)(WSP + WS_MOD))
#define ROPE ((float*)(WSP + WS_ROPE))
#define TW ((f32x2*)(WSP + WS_TW))
#define XC ((float*)(WSP + WS_XC))
#define HX ((bf16_t*)(WSP + WS_HX))
#define FA ((f32x2*)(WSP + WS_FA))
#define Qb ((bf16_t*)(WSP + WS_Q))
#define Kb ((bf16_t*)(WSP + WS_K))
#define Vb ((bf16_t*)(WSP + WS_V))
#define Yb ((bf16_t*)(WSP + WS_Y))
#define Gb (WSP + WS_G)
#define ACAT ((bf16_t*)(WSP + WS_ACAT))
#define UF ((bf16_t*)(WSP + WS_UF))
#define ZG ((bf16_t*)(WSP + WS_ZG))
#define UP ((bf16_t*)(WSP + WS_UP))
#define GT ((bf16_t*)(WSP + WS_GT))
#define Hb ((bf16_t*)(WSP + WS_H))

    if (PH_EN(0) && IN(0)) { FRESH();
        mod_phase(PTR(1), PTR(3), PTR(6), PTR(7), MOD, L, vcu, G, tid, wave, lane);
        tables_phase(ROPE, TW, vcu * 512 + tid, G * 512);
        WSRC(S0, 0); convert_A(S0, ws, scr, gw, NGW, lane); convert_B(S0, ws, scr, gw, NGW, lane);
        if (BOTH(0)) GRID_BAR();
    }
#pragma nounroll
    for (int l = 0; l < 2; ++l) {
        const int pb = 1 + 10 * l;
#define mod (MOD + l * 3 * 6144)
#define xl ((l == 0) ? PTR(0) : (const float*)OUTP)
#define xc ((l == 0) ? PTR(2) : (const float*)XC)
        const int Mact = (l == 0) ? MT : ML;
        if (PH_EN(1) && IN(pb)) { FRESH(); norm_phase(xl, xc, MT, PTR(4) + l * DM, mod, 0, 1024, HX, gw, NGW, lane); if (BOTH(pb)) GRID_BAR(); }
        if (PH_EN(2) && IN(pb + 1)) { FRESH();
            pg8::Gemm g{HX, (const bf16_t*)(ws + WS_WA), MT, NIN, 1024}; pg8::StaticOrder S; S.init(MT, NIN, G, bx);
            pg8::EpiIn E{UF, ZG, UP, Qb, Kb, Vb, Gb, ROPE};
            pg8::gemm_phase<pg8::EpiIn, pg8::StaticOrder, true, true>(L, g, S, E, tid);
            if (BOTH(pb + 1)) GRID_BAR();
        }
        if (PH_EN(3) && IN(pb + 2)) { FRESH();
            if (X1M & 1) for (int it = vcu; it < 512; it += G) fft1_item(it, UF, TW, FA, L, tid, wave, lane);
            if (X1M & 2) for (int it = vcu; it < Mact / 64; it += G) conv_item(it, ZG, PTR(14) + l * 31 * 256, PTR(15) + l * 256, PTR(16) + l * 256, PTR(17) + l * 256, ACAT, L, tid, wave, lane);
            if (X1M & 4) for (int it = (vcu + 248) % G; it < Mact / 32; it += G) pool_item(it, UP, PTR(18) + l * 4 * 4096, PTR(19) + l * 256, ACAT, L, tid, wave, lane);
            if ((X1M & 8) && l == 0) for (int it = (vcu + 224) % G; it < 32; it += G) ctxdft_item(it, UF, ACAT, L, tid, wave, lane);
            WSRC(S1, 1);
            if (!(X1M & 16)) {} else if (l == 0) convert_A(S1, ws, scr, gw, NGW, lane); else convert_B(S1, ws, scr, gw, NGW, lane);
            if (BOTH(pb + 2)) GRID_BAR();
        }
        if (PH_EN(4) && IN(pb + 3)) { FRESH();
            if (ATTM & 1) for (int it = vcu; it < 1024; it += G) fft2_item(it, FA, ACAT, L, tid, wave, lane);
            const float lam_init = (l == 0) ? 0.2f : 0.35550906759096926f;
            const float d1 = wave_sum(PTR(9)[l * 64 + lane] * PTR(10)[l * 64 + lane]), d2 = wave_sum(PTR(11)[l * 64 + lane] * PTR(12)[l * 64 + lane]);
            const float lam = __builtin_bit_cast(float, __builtin_amdgcn_readfirstlane(__builtin_bit_cast(int, expf(d1) - expf(d2) + lam_init)));
            const int nun = 512 + (l == 0 ? 16 : 0);
            if (ATTM & 2) for (int u = vcu; u < nun; u += G) {
                int b, h, row0, nkeys;
                if (u < 512) { const int x = (u & 255) >> 5, qb = (u & 31) + 32 * (u >> 8); b = x >> 2; h = x & 3; row0 = b * SEQ + qb * 128; nkeys = KVL; }
                else { const int v = u - 512; b = v >> 3; h = (v >> 1) & 3; row0 = ML + b * CTXL + (v & 1) * 128; nkeys = CTXL; }
                att::attn_unit(Qb + (size_t)row0 * 512 + h * 128, Kb + (size_t)b * KVL * 512 + h * 128, Vb + (size_t)b * KVL * 512 + h * 128, nkeys,
                               ACAT + (size_t)row0 * KCAT + 256 + h * 128, lam, 1.0f - lam_init, PTR(13) + l * 128, (char*)lds, tid);
            }
            if (BOTH(pb + 3)) GRID_BAR();
        }
        if (PH_EN(5) && IN(pb + 4)) { FRESH();
            pg8::Gemm g{ACAT, (const bf16_t*)(ws + WS_WCAT), Mact, 1024, KCAT}; pg8::StaticOrder S; S.init(Mact, 1024, G, bx);
            pg8::EpiBranch E{Gb, Yb};
            pg8::gemm_phase<pg8::EpiBranch, pg8::StaticOrder, true, true>(L, g, S, E, tid);
            if (BOTH(pb + 4)) GRID_BAR();
        }
        if (PH_EN(6) && IN(pb + 5)) { FRESH();
            pg8::Gemm g{Yb, (const bf16_t*)(ws + WS_WOUT), Mact, 1024, 1024}; pg8::StaticOrder S; S.init(Mact, 1024, G, bx);
            pg8::EpiRes E{xl, xc, OUTP, XC, mod, 2048};
            pg8::gemm_phase<pg8::EpiRes, pg8::StaticOrder, true, true>(L, g, S, E, tid);
            if (BOTH(pb + 5)) GRID_BAR();
        }
        if (PH_EN(7) && IN(pb + 6)) { FRESH(); norm_phase(OUTP, XC, Mact, PTR(5) + l * DM, mod, 3072, 4096, HX, gw, NGW, lane); if (BOTH(pb + 6)) GRID_BAR(); }
        if (PH_EN(8) && IN(pb + 7)) { FRESH();
            pg8::Gemm g{HX, (const bf16_t*)(ws + WS_WUPG), Mact, DFF, 1024}; pg8::StaticOrder S; S.init(Mact, DFF, G, bx);
            pg8::EpiBf E{GT, DFF};
            pg8::gemm_phase<pg8::EpiBf, pg8::StaticOrder, true, true>(L, g, S, E, tid);
            if (BOTH(pb + 7)) GRID_BAR();
        }
        if (PH_EN(9) && IN(pb + 8)) { FRESH();
            pg8::Gemm g{HX, (const bf16_t*)(ws + WS_WUPV), Mact, DFF, 1024}; pg8::StaticOrder S; S.init(Mact, DFF, G, bx);
            pg8::EpiVal E{GT, Hb, PTR(26) + l * 3 * DFF, PTR(27) + l * DFF};
            pg8::gemm_phase<pg8::EpiVal, pg8::StaticOrder, true, true>(L, g, S, E, tid);
            if (BOTH(pb + 8)) GRID_BAR();
        }
        if (PH_EN(10) && IN(pb + 9)) { FRESH();
            pg8::Gemm g{Hb, (const bf16_t*)(ws + WS_WDN), Mact, 1024, DFF}; pg8::StaticOrder S; S.init(Mact, 1024, G, bx);
            pg8::EpiRes E{OUTP, XC, OUTP, XC, mod, 5120};
            pg8::gemm_phase<pg8::EpiRes, pg8::StaticOrder, true, true>(L, g, S, E, tid);
            if (BOTH(pb + 9)) GRID_BAR();
        }
    }
    if (PH_EN(11) && IN(21)) { FRESH(); final_norm_phase(OUTP, PTR(29), gw, NGW, lane); }
#undef IN
#undef BOTH
#undef mod
#undef xl
#undef xc
#undef ws
#undef MOD
#undef ROPE
#undef TW
#undef XC
#undef HX
#undef FA
#undef Qb
#undef Kb
#undef Vb
#undef Yb
#undef Gb
#undef ACAT
#undef UF
#undef ZG
#undef UP
#undef GT
#undef Hb
#undef PTR
#undef OUTP
#undef WSP
}

extern "C" void kernel_launch(void* const* d_in, const int* in_sizes, int n_in, void* d_out, int out_size, void* d_ws, size_t ws_size, hipStream_t stream) {
    static int grid = 0;
    if (grid == 0) {
        if (n_in != 30 || in_sizes[0] != ML * DM || out_size != ML * DM || ws_size < WS_END) {
            fprintf(stderr, "kernel_launch: unexpected shapes: n_in %d in0 %d out %d ws %zu (need >= %zu)\n", n_in, n_in > 0 ? in_sizes[0] : -1, out_size, ws_size, (size_t)WS_END); grid = -1; return; }
        int dev = 0, cus = 0, per_cu = 0;
        if (hipGetDevice(&dev) != hipSuccess || hipDeviceGetAttribute(&cus, hipDeviceAttributeMultiprocessorCount, dev) != hipSuccess) { grid = -1; return; }
        if (hipFuncSetAttribute((const void*)fwd_kernel, hipFuncAttributeMaxDynamicSharedMemorySize, LDS_BYTES) != hipSuccess) { fprintf(stderr, "kernel_launch: hipFuncSetAttribute failed\n"); grid = -1; return; }
        if (hipOccupancyMaxActiveBlocksPerMultiprocessor(&per_cu, (const void*)fwd_kernel, 512, LDS_BYTES) != hipSuccess || per_cu < 1) {
            fprintf(stderr, "kernel_launch: occupancy query reports %d blocks per CU\n", per_cu); (void)hipGetLastError(); grid = -1; return; }
        grid = cus;
    }
    if (grid < 0) return;
    (void)hipMemsetAsync((char*)d_ws + WS_CTL, 0, CTL_ZERO_BYTES, stream);
    Args a{};
    for (int i = 0; i < 30; ++i) a.in[i] = (const float*)d_in[i];
    a.out = (float*)d_out; a.ws = (unsigned char*)d_ws;
    for (int li = 0; li < MK_N_LAUNCHES; ++li) {
        if (MK_N_LAUNCHES == NPHASE) { a.ph_lo = li; a.ph_hi = li + 1; a.li = 0; }
        else { a.ph_lo = (int)((long)NPHASE * li / MK_N_LAUNCHES); a.ph_hi = (int)((long)NPHASE * (li + 1) / MK_N_LAUNCHES); a.li = li; }
        hipLaunchKernelGGL(fwd_kernel, dim3(grid), dim3(512), LDS_BYTES, stream, a);
    }
}
```

```cpp
#include <hip/hip_runtime.h>
#include <cstdio>
#include <cstdint>

#define LAS __attribute__((address_space(3)))
#define GAS __attribute__((address_space(1)))
typedef unsigned short bf16_t;
typedef short bf16x8 __attribute__((ext_vector_type(8)));
typedef short s16x4 __attribute__((ext_vector_type(4)));
typedef float f32x2 __attribute__((ext_vector_type(2)));
typedef float f32x4 __attribute__((ext_vector_type(4)));
typedef float f32x16 __attribute__((ext_vector_type(16)));
typedef unsigned u32x2 __attribute__((ext_vector_type(2)));
typedef unsigned u32x4 __attribute__((ext_vector_type(4)));

#ifndef MK_N_LAUNCHES
#define MK_N_LAUNCHES 1
#endif

constexpr int DM = 1024, SEQ = 8192, NBATCH = 2, CTXL = 256;
constexpr int ML = NBATCH * SEQ;
constexpr int MC = NBATCH * CTXL;
constexpr int MT = ML + MC;
constexpr int NIN = 6656, DFF = 2816, KCAT = 1280;
constexpr int KVL = CTXL + SEQ;
constexpr float EPS = 1e-6f;

constexpr size_t MiB = 1u << 20;
constexpr size_t WS_CTL = 0, CTL_ZERO_BYTES = 1 * MiB;
constexpr size_t WS_MOD = 1 * MiB;
constexpr size_t WS_ROPE = WS_MOD + 2 * 3 * 6144 * 4;
constexpr size_t WS_TW = WS_ROPE + 192 * 32 * 4;
constexpr size_t WS_XC = 2 * MiB;
constexpr size_t WS_WA = 4 * MiB;
constexpr size_t WS_WCAT = 17 * MiB;
constexpr size_t WS_WOUT = WS_WCAT + (size_t)1024 * 1280 * 2;
constexpr size_t WS_WUPG = WS_WOUT + (size_t)1024 * 1024 * 2;
constexpr size_t WS_WUPV = WS_WUPG + (size_t)2816 * 1024 * 2;
constexpr size_t WS_WDN = WS_WUPV + (size_t)2816 * 1024 * 2;
constexpr size_t WS_HX = 38 * MiB;
constexpr size_t WS_FA = WS_HX;
constexpr size_t WS_Q = 71 * MiB;
constexpr size_t WS_K = WS_Q + (size_t)MT * 512 * 2;
constexpr size_t WS_V = WS_K + (size_t)MT * 512 * 2;
constexpr size_t WS_Y = 71 * MiB;
constexpr size_t WS_G = 121 * MiB;
constexpr size_t WS_ACAT = 187 * MiB;
constexpr size_t WS_UF = 229 * MiB;
constexpr size_t WS_ZG = WS_UF + (size_t)MT * 256 * 2;
constexpr size_t WS_UP = WS_ZG + (size_t)MT * 256 * 2;
constexpr size_t WS_GT = 71 * MiB;
constexpr size_t WS_H = 162 * MiB;
constexpr size_t WS_END = 256 * MiB;
static_assert(WS_TW + 8192 * 8 <= WS_XC && WS_WDN + (size_t)1024 * 2816 * 2 <= WS_HX && WS_V + (size_t)MT * 512 * 2 <= WS_G && WS_G + (size_t)MT * 4096 <= WS_ACAT, "ws map 1");
static_assert(WS_ACAT + (size_t)MT * 1280 * 2 <= WS_UF && WS_UP + (size_t)MT * 256 * 2 <= WS_END && WS_GT + (size_t)MT * 2816 * 2 <= WS_H && WS_H + (size_t)MT * 2816 * 2 <= WS_END, "ws map 2");
static_assert(WS_HX + (size_t)MT * 1024 * 2 <= WS_Q && (size_t)2 * 4 * 128 * 64 * 64 * 8 <= (size_t)MT * 1024 * 2, "ws map 3");
constexpr int CW_TMO = 0, CW_CODE = 1, CW_BAR = 4096;

constexpr int RING_BYTES = 131072, LDSCTL_OFF = RING_BYTES, MISC_OFF = LDSCTL_OFF + 320, LDS_BYTES = 147456;

__device__ __forceinline__ float bf2f(unsigned v) { return __uint_as_float(v << 16); }
__device__ __forceinline__ float sigm(float x) { return 1.0f / (1.0f + __expf(-x)); }
__host__ __device__ __forceinline__ int in_map(int n) {
    if (n < 256) return n;
    if (n < 1280) { const int base = n < 768 ? 256 : 768, r = n - base, comp = r >> 6, p = r & 63, pp = p >> 1, e = p & 1;
        return base + comp * 64 + (pp < 16 ? 0 : 32) + (pp & 15) + 16 * e; }
    if (n < 1792) return n;
    if (n < 2304) { const int r = n - 1792; return 1792 + (r & 1) * 256 + (r >> 1); }
    return n;
}
namespace pg8 {
#define PG8_LAS __attribute__((address_space(3)))
typedef unsigned short bf16_t;
typedef short bf16x8 __attribute__((ext_vector_type(8)));
typedef float f32x4 __attribute__((ext_vector_type(4)));
typedef unsigned u32x4 __attribute__((ext_vector_type(4)));
constexpr int BM = 256, BK = 64, HALF = 128, HTB = HALF * BK * 2  , STAGE_BYTES = 8 * HTB, NXCD = 8, WGM = 8;

__host__ __device__ __forceinline__ int lds_byte(int r, int c) { const int st = (r >> 4) * 2 + (c >> 5), rr = r & 15, cc = c & 31, ob = rr * 64 + cc * 2; return st * 1024 + (ob ^ (((ob >> 9) & 1) << 5)); }
__host__ __device__ __forceinline__ void stage_rc(int b, int& R, int& C) { const int st = b / 1024, sb = b % 1024, swz = sb ^ (((sb >> 9) & 1) << 5); R = (st >> 1) * 16 + swz / 64; C = (st & 1) * 32 + (swz % 64) / 2; }
__host__ __device__ __forceinline__ int perm32(int rho) { const int n = rho >> 4, i = rho & 15; return 8 * (i >> 2) + 4 * n + (i & 3); }

struct Unit { int pm, pn; };
struct Gemm { const bf16_t* A; const bf16_t* Bt; int M, N, K; };

struct StaticOrder {
    int nM, nN, nwg, G, c;
    __host__ __device__ void init(int M, int N, int G_, int c_) { nM = M / BM; nN = N / BM; nwg = nM * nN; G = G_; c = c_; }
    __host__ __device__ bool next(int i, Unit& u) const {
        const long L = (long)i * G + c; if (L >= nwg) return false;
        int wgid = (int)L; { const int q = nwg / NXCD, r = nwg % NXCD, xcd = wgid % NXCD, off = wgid / NXCD; wgid = (xcd < r ? xcd * (q + 1) : r * (q + 1) + (xcd - r) * q) + off; }
        const int nig = WGM * nN, gid = wgid / nig, fm = gid * WGM, gsz = (nM - fm) < WGM ? (nM - fm) : WGM;
        u.pm = fm + ((wgid % nig) % gsz); u.pn = (wgid % nig) / gsz; return true;
    }
    __device__ __forceinline__ void a_ready(const Unit&) const {}
    __device__ __forceinline__ void done(const Unit&) const {}
};
__device__ __forceinline__ unsigned cvt_pk_bf16(float lo, float hi) { unsigned r; asm volatile("v_cvt_pk_bf16_f32 %0, %1, %2" : "=v"(r) : "v"(lo), "v"(hi)); return r; }
typedef float f32x2 __attribute__((ext_vector_type(2)));
__device__ __forceinline__ f32x2 gelu_pk(f32x2 v) {
    const f32x2 av = __builtin_elementwise_abs(v), d = av * 0.2316418882f + 1.0f;
    f32x2 t; t.x = __builtin_amdgcn_rcpf(d.x); t.y = __builtin_amdgcn_rcpf(d.y);
    f32x2 q = t * 0.5307027145f + (-0.7265760135f); q = q * t + 0.7107068705f; q = q * t + (-0.142248368f); q = q * t + 0.127414796f; q = q * t;
    const f32x2 s = (v * v) * (-0.72134752044f);
    f32x2 e; e.x = __builtin_amdgcn_exp2f(s.x); e.y = __builtin_amdgcn_exp2f(s.y);
    const f32x2 m = v * (q * e), r = v - m;
    f32x2 o; o.x = v.x < 0.f ? m.x : r.x; o.y = v.y < 0.f ? m.y : r.y; return o;
}

typedef unsigned u32x2 __attribute__((ext_vector_type(2)));
__device__ __forceinline__ u32x4 pack8(const f32x4 a, const f32x4 b) { u32x4 w; w.x = cvt_pk_bf16(a[0], a[1]); w.y = cvt_pk_bf16(a[2], a[3]); w.z = cvt_pk_bf16(b[0], b[1]); w.w = cvt_pk_bf16(b[2], b[3]); return w; }

struct EpiIn {
    static constexpr bool PERM = true, AFTER_DRAIN = false, RESCALE = false;
    bf16_t *UF, *ZG, *UP, *Q, *K, *V; unsigned char* G; const float* rope;
    __device__ __forceinline__ void operator()(const f32x4 (&acc)[2][2][4][2], const Unit& u, int wr, int wc, int fr, int fq) const {
        const int pm = u.pm, pn = u.pn; const bool lat = pm < 64; const int R0 = pm * 256;
        const int kv0 = lat ? ((pm >> 5) * 8448 + 256 + ((pm & 31) << 8)) : ((pm - 64) * 8448);
        const int rl = wr * 64 + fr, cl = wc * 32 + 8 * fq;
        if (pn == 0 || pn == 9) {
            bf16_t* dst = (pn == 0 ? UF : UP);
#pragma unroll
            for (int ai = 0; ai < 2; ++ai)
#pragma unroll
                for (int m = 0; m < 4; ++m) { const int rr = ai * 128 + m * 16 + rl;
#pragma unroll
                    for (int bj = 0; bj < 2; ++bj) *(u32x4*)(dst + (size_t)(R0 + rr) * 256 + bj * 128 + cl) = pack8(acc[ai][bj][m][0], acc[ai][bj][m][1]); }
        } else if (pn <= 4) {
            const bool isq = pn <= 2; bf16_t* dst = isq ? Q : K; const int rowbase = isq ? R0 : kv0, colbase = (isq ? pn - 1 : pn - 3) * 256; const float sc = isq ? 0.125f : 1.0f;
#pragma unroll
            for (int ai = 0; ai < 2; ++ai)
#pragma unroll
                for (int m = 0; m < 4; ++m) { const int rr = ai * 128 + m * 16 + rl;
                    f32x4 cs = {1.f, 1.f, 1.f, 1.f}, sn = {0.f, 0.f, 0.f, 0.f};
                    if (lat) { const int t = (R0 & 8191) + rr; const int pos = (wc & 1) ? 128 + (t & 63) : (t >> 6);
                        cs = *(const f32x4*)(rope + pos * 32 + 4 * fq); sn = *(const f32x4*)(rope + pos * 32 + 16 + 4 * fq); }
                    cs = cs * sc; sn = sn * sc;
#pragma unroll
                    for (int bj = 0; bj < 2; ++bj) { const f32x4 a = acc[ai][bj][m][0], b = acc[ai][bj][m][1]; f32x4 oa, ob;
                        oa[0] = a[0] * cs[0] - a[1] * sn[0]; oa[1] = a[1] * cs[0] + a[0] * sn[0]; oa[2] = a[2] * cs[1] - a[3] * sn[1]; oa[3] = a[3] * cs[1] + a[2] * sn[1];
                        ob[0] = b[0] * cs[2] - b[1] * sn[2]; ob[1] = b[1] * cs[2] + b[0] * sn[2]; ob[2] = b[2] * cs[3] - b[3] * sn[3]; ob[3] = b[3] * cs[3] + b[2] * sn[3];
                        *(u32x4*)(dst + (size_t)(rowbase + rr) * 512 + colbase + bj * 128 + cl) = pack8(oa, ob); } }
        } else if (pn <= 6) {
#pragma unroll
            for (int ai = 0; ai < 2; ++ai)
#pragma unroll
                for (int m = 0; m < 4; ++m) { const int rr = ai * 128 + m * 16 + rl;
#pragma unroll
                    for (int bj = 0; bj < 2; ++bj) *(u32x4*)(V + (size_t)(kv0 + rr) * 512 + (pn - 5) * 256 + bj * 128 + cl) = pack8(acc[ai][bj][m][0], acc[ai][bj][m][1]); }
        } else if (pn <= 8) {
#pragma unroll
            for (int ai = 0; ai < 2; ++ai)
#pragma unroll
                for (int m = 0; m < 4; ++m) { const int rr = ai * 128 + m * 16 + rl;
#pragma unroll
                    for (int bj = 0; bj < 2; ++bj) { const f32x4 a = acc[ai][bj][m][0], b = acc[ai][bj][m][1];
                        u32x2 w; w.x = cvt_pk_bf16(a[0] * sigm(a[1]), a[2] * sigm(a[3])); w.y = cvt_pk_bf16(b[0] * sigm(b[1]), b[2] * sigm(b[3]));
                        *(u32x2*)(ZG + (size_t)(R0 + rr) * 256 + (pn - 7) * 128 + bj * 64 + (cl >> 1)) = w; } }
        } else {
#pragma unroll
            for (int ai = 0; ai < 2; ++ai)
#pragma unroll
                for (int m = 0; m < 4; ++m) { const int rr = ai * 128 + m * 16 + rl;
#pragma unroll
                    for (int bj = 0; bj < 2; ++bj) { u32x2 w;
#pragma unroll
                        for (int n = 0; n < 2; ++n) { const f32x4 a = acc[ai][bj][m][n]; unsigned q = 0;
#pragma unroll
                            for (int j = 0; j < 4; ++j) { float s = sigm(a[j]) * 255.0f + 0.5f; s = s < 1.0f ? 1.0f : s; q |= ((unsigned)s) << (8 * j); }
                            if (n == 0) w.x = q; else w.y = q; }
                        *(u32x2*)(G + (size_t)(R0 + rr) * 4096 + (pn - 10) * 256 + bj * 128 + cl) = w; } }
        }
    }
};

struct EpiBf {
    static constexpr bool PERM = true, AFTER_DRAIN = false, RESCALE = false;
    bf16_t* O; int ldc;
    __device__ __forceinline__ void operator()(const f32x4 (&acc)[2][2][4][2], const Unit& u, int wr, int wc, int fr, int fq) const {
        const int row0 = u.pm * 256 + wr * 64 + fr, col0 = u.pn * 256 + wc * 32 + 8 * fq;
#pragma unroll
        for (int ai = 0; ai < 2; ++ai)
#pragma unroll
            for (int m = 0; m < 4; ++m)
#pragma unroll
                for (int bj = 0; bj < 2; ++bj) *(u32x4*)(O + (size_t)(row0 + ai * 128 + m * 16) * ldc + col0 + bj * 128) = pack8(acc[ai][bj][m][0], acc[ai][bj][m][1]);
    }
};

struct EpiRes {
    static constexpr bool PERM = false, AFTER_DRAIN = false, RESCALE = false;
    const float* base_lat; const float* base_ctx; float* out_lat; float* out_ctx; const float* mod; int goff;
    __device__ __forceinline__ void operator()(const f32x4 (&acc)[2][2][4][2], const Unit& u, int wr, int wc, int fr, int fq) const {
        const int pm = u.pm; const bool lat = pm < 64; const int mrow = lat ? (pm >> 5) : 2;
        const float* base = lat ? base_lat + (size_t)pm * 256 * 1024 : base_ctx + (size_t)(pm - 64) * 256 * 1024;
        float* out = lat ? out_lat + (size_t)pm * 256 * 1024 : out_ctx + (size_t)(pm - 64) * 256 * 1024;
        const int col0 = u.pn * 256 + wc * 32 + 4 * fq;
        f32x4 gv[2][2];
#pragma unroll
        for (int bj = 0; bj < 2; ++bj)
#pragma unroll
            for (int n = 0; n < 2; ++n) gv[bj][n] = *(const f32x4*)(mod + mrow * 6144 + goff + col0 + bj * 128 + n * 16);
#pragma unroll
        for (int ai = 0; ai < 2; ++ai)
#pragma unroll
            for (int m = 0; m < 4; ++m) { const size_t ro = (size_t)(ai * 128 + wr * 64 + m * 16 + fr) * 1024 + col0;
#pragma unroll
                for (int bj = 0; bj < 2; ++bj)
#pragma unroll
                    for (int n = 0; n < 2; ++n) { const size_t off = ro + bj * 128 + n * 16; const f32x4 b = *(const f32x4*)(base + off); *(f32x4*)(out + off) = b + gv[bj][n] * acc[ai][bj][m][n]; } }
    }
};

struct EpiVal {
    static constexpr bool PERM = true, AFTER_DRAIN = false, RESCALE = false;
    const bf16_t* GT; bf16_t* H; const float* dww; const float* dwb;
    __device__ __forceinline__ void operator()(const f32x4 (&acc)[2][2][4][2], const Unit& u, int wr, int wc, int fr, int fq) const {
        const int pm = u.pm; const bool lat = pm < 64; const int R0 = pm * 256, t0 = lat ? (R0 & 8191) : 0, L = lat ? 8192 : 256;
        const int rl = wr * 64 + fr;
#pragma unroll
        for (int bj = 0; bj < 2; ++bj) { const int col = u.pn * 256 + bj * 128 + wc * 32 + 8 * fq;
            f32x4 w0[2], w1[2], w2[2], bb[2];
#pragma unroll
            for (int n = 0; n < 2; ++n) { w0[n] = *(const f32x4*)(dww + col + 4 * n); w1[n] = *(const f32x4*)(dww + 2816 + col + 4 * n); w2[n] = *(const f32x4*)(dww + 5632 + col + 4 * n); bb[n] = *(const f32x4*)(dwb + col + 4 * n); }
#pragma unroll
            for (int ai = 0; ai < 2; ++ai)
#pragma unroll
                for (int m = 0; m < 4; ++m) { const int rr = ai * 128 + m * 16 + rl, t = t0 + rr; const bf16_t* gp = GT + (size_t)(R0 + rr) * 2816 + col;
                    u32x4 gm = {0u, 0u, 0u, 0u}, gq = {0u, 0u, 0u, 0u}; const u32x4 g0 = *(const u32x4*)gp;
                    if (t > 0) gm = *(const u32x4*)(gp - 2816);
                    if (t < L - 1) gq = *(const u32x4*)(gp + 2816);
                    f32x4 o[2];
#pragma unroll
                    for (int n = 0; n < 2; ++n) { f32x4 c;
#pragma unroll
                        for (int j = 0; j < 4; ++j) { const int e = 4 * n + j; const unsigned wm = gm[e >> 1], wz = g0[e >> 1], wp = gq[e >> 1];
                            const float xm = (e & 1) ? __uint_as_float(wm & 0xffff0000u) : __uint_as_float(wm << 16), xz = (e & 1) ? __uint_as_float(wz & 0xffff0000u) : __uint_as_float(wz << 16),
                                        xp = (e & 1) ? __uint_as_float(wp & 0xffff0000u) : __uint_as_float(wp << 16);
                            c[j] = w0[n][j] * xm + w1[n][j] * xz + w2[n][j] * xp + bb[n][j]; }
                        const f32x2 ga = gelu_pk((f32x2){c[0], c[1]}), gb = gelu_pk((f32x2){c[2], c[3]});
                        const f32x4 v = acc[ai][bj][m][n]; o[n] = (f32x4){v[0] * ga.x, v[1] * ga.y, v[2] * gb.x, v[3] * gb.y}; }
                    *(u32x4*)(H + (size_t)(R0 + rr) * 2816 + col) = pack8(o[0], o[1]); }
        }
    }
};

struct EpiBranch {
    static constexpr bool PERM = true, AFTER_DRAIN = false, RESCALE = true;
    const unsigned char* G; bf16_t* Y;
    __device__ __forceinline__ void rescale(f32x4 (&acc)[2][2][4][2], const Unit& u, int t, int wr, int wc, int fr, int fq) const {
        const int bp = (t == 4) ? 0 : (t == 12) ? 1 : 2;
        const __amdgpu_buffer_rsrc_t rs = __builtin_amdgcn_make_buffer_rsrc((void*)G, 0, MT * 4096, 0x00020000);
        const int voff = (u.pm * 256 + wr * 64 + fr) * 4096 + u.pn * 256 + wc * 32 + 8 * fq;
#pragma unroll
        for (int ai = 0; ai < 2; ++ai)
#pragma unroll
            for (int m = 0; m < 4; ++m) {
#pragma unroll
                for (int bj = 0; bj < 2; ++bj) { const int so = (ai * 128 + m * 16) * 4096 + bj * 128 + bp * 1024;
                    const u32x2 p = __builtin_bit_cast(u32x2, __builtin_amdgcn_raw_buffer_load_b64(rs, voff, so, 0)), q = __builtin_bit_cast(u32x2, __builtin_amdgcn_raw_buffer_load_b64(rs, voff, so + 1024, 0));
#pragma unroll
                    for (int n = 0; n < 2; ++n) { const unsigned pw = n ? p.y : p.x, qw = n ? q.y : q.x;
#pragma unroll
                        for (int j = 0; j < 4; ++j) acc[ai][bj][m][n][j] *= (float)((pw >> (8 * j)) & 255u) * __builtin_amdgcn_rcpf((float)((qw >> (8 * j)) & 255u)); } }
                asm volatile("" ::: "memory"); }
    }
    __device__ __forceinline__ void operator()(const f32x4 (&acc)[2][2][4][2], const Unit& u, int wr, int wc, int fr, int fq) const {
        const int row0 = u.pm * 256 + wr * 64 + fr, col0 = u.pn * 256 + wc * 32 + 8 * fq;
#pragma unroll
        for (int ai = 0; ai < 2; ++ai)
#pragma unroll
            for (int m = 0; m < 4; ++m)
#pragma unroll
                for (int bj = 0; bj < 2; ++bj) { const size_t r = (size_t)(row0 + ai * 128 + m * 16); const u32x2 p = *(const u32x2*)(G + r * 4096 + 3072 + col0 + bj * 128);
                    f32x4 o[2];
#pragma unroll
                    for (int n = 0; n < 2; ++n) { const unsigned pw = n ? p.y : p.x;
#pragma unroll
                        for (int j = 0; j < 4; ++j) o[n][j] = acc[ai][bj][m][n][j] * ((float)((pw >> (8 * j)) & 255u) * (1.0f / 255.0f)); }
                    *(u32x4*)(Y + r * 1024 + col0 + bj * 128) = pack8(o[0], o[1]); }
    }
};

template <class Epi, class Sched, bool ALIGN_EPI = false, bool SP2 = false>
__device__ __forceinline__ void gemm_phase(PG8_LAS unsigned char* lds, const Gemm g, const Sched& S, const Epi& E, const int tid) {
    const int wid = __builtin_amdgcn_readfirstlane(tid >> 6), lane = tid & 63, wr = wid >> 2, wc = wid & 3, fr = lane & 15, fq = lane >> 4;
    const int K = g.K, nt = K / BK;
    unsigned voffA[2], voffB[2];
#pragma unroll
    for (int i = 0; i < 2; ++i) { int R, C; stage_rc(tid * 16 + i * 8192, R, C); const int Rb = Epi::PERM ? ((R & ~31) + perm32(R & 31)) : R;
        voffA[i] = (unsigned)(R * K + C) * 2u; voffB[i] = (unsigned)(Rb * K + C) * 2u; }
    const size_t kstep = (size_t)(BK * 2);
    const size_t hstep = (size_t)HALF * K * 2;
    const size_t tstep = 2 * hstep;
    const unsigned ldsw = (unsigned)wid * 1024u;
    const int aoff = lds_byte(wr * 64 + fr, fq * 8), boff = lds_byte(wc * 32 + fr, fq * 8);
#define PG8_SA(b, h) (((b) * 2 + (h)) * HTB)
#define PG8_SB(b, h) ((4 + (b) * 2 + (h)) * HTB)
#define PG8_STAGE(bufoff, gbase, voff) do { _Pragma("unroll") for (int _i = 0; _i < 2; ++_i) \
        __builtin_amdgcn_global_load_lds((const unsigned*)((const char*)(gbase) + (voff)[_i]), (PG8_LAS unsigned*)(lds + (bufoff) + ldsw + _i * 8192), 16, 0, 0); } while (0)
#define PG8_LDA(dst, b, h) do { _Pragma("unroll") for (int m = 0; m < 4; ++m) _Pragma("unroll") for (int k = 0; k < 2; ++k) dst[m][k] = *(const PG8_LAS bf16x8*)(lds + PG8_SA(b, h) + aoff + m * 2048 + k * 1024); } while (0)
#define PG8_LDB(dst, b, h) do { _Pragma("unroll") for (int n = 0; n < 2; ++n) _Pragma("unroll") for (int k = 0; k < 2; ++k) dst[n][k] = *(const PG8_LAS bf16x8*)(lds + PG8_SB(b, h) + boff + n * 2048 + k * 1024); } while (0)
#define PG8_MMA(ai, bj, At, Bt) do { __builtin_amdgcn_s_setprio(1); _Pragma("unroll") for (int m = 0; m < 4; ++m) _Pragma("unroll") for (int n = 0; n < 2; ++n) _Pragma("unroll") for (int k = 0; k < 2; ++k) \
        acc[ai][bj][m][n] = __builtin_amdgcn_mfma_f32_16x16x32_bf16(Bt[n][k], At[m][k], acc[ai][bj][m][n], 0, 0, 0); __builtin_amdgcn_s_setprio(0); } while (0)
#define PG8_WAIT_V(n) asm volatile("s_waitcnt vmcnt(" #n ")" ::: "memory")
#define PG8_WAIT_L(n) asm volatile("s_waitcnt lgkmcnt(" #n ")" ::: "memory")
#define PG8_BAR __builtin_amdgcn_s_barrier()
#define PG8_SCHED __builtin_amdgcn_sched_barrier(0)
    Unit cur, nxt; int ui = 0;
    if (!S.next(0, cur)) return;
    f32x4 acc[2][2][4][2];
#pragma unroll
    for (int a = 0; a < 2; ++a)
#pragma unroll
        for (int b = 0; b < 2; ++b)
#pragma unroll
            for (int m = 0; m < 4; ++m)
#pragma unroll
                for (int n = 0; n < 2; ++n) acc[a][b][m][n] = (f32x4){0.f, 0.f, 0.f, 0.f};
    bf16x8 At[4][2], B0[2][2], B1[2][2];
    const char* cA = (const char*)g.A + (size_t)cur.pm * tstep; const char* cB = (const char*)g.Bt + (size_t)cur.pn * tstep;
    S.a_ready(cur);
    if constexpr (SP2) {
        PG8_STAGE(PG8_SB(0, 0), cB, voffB); PG8_STAGE(PG8_SB(0, 1), cB + hstep, voffB); PG8_STAGE(PG8_SA(0, 0), cA, voffA); PG8_STAGE(PG8_SA(0, 1), cA + hstep, voffA);
        if (wr == 1) PG8_BAR;
        PG8_WAIT_V(2); PG8_BAR;
        PG8_STAGE(PG8_SB(1, 0), cB + kstep, voffB); PG8_STAGE(PG8_SA(1, 0), cA + kstep, voffA); PG8_STAGE(PG8_SB(1, 1), cB + hstep + kstep, voffB);
        PG8_WAIT_V(6); PG8_BAR;
    } else {
        PG8_STAGE(PG8_SB(0, 0), cB, voffB); PG8_STAGE(PG8_SA(0, 0), cA, voffA); PG8_STAGE(PG8_SB(0, 1), cB + hstep, voffB); PG8_STAGE(PG8_SA(0, 1), cA + hstep, voffA);
        if (wr == 1) PG8_BAR;
        PG8_WAIT_V(4); PG8_BAR;
        PG8_STAGE(PG8_SB(1, 0), cB + kstep, voffB); PG8_STAGE(PG8_SA(1, 0), cA + kstep, voffA); PG8_STAGE(PG8_SB(1, 1), cB + hstep + kstep, voffB);
        PG8_WAIT_V(6); PG8_BAR;
    }
    for (;;) {
        const bool has_next = S.next(ui + 1, nxt);
        const char* nA = has_next ? (const char*)g.A + (size_t)nxt.pm * tstep : cA; const char* nB = has_next ? (const char*)g.Bt + (size_t)nxt.pn * tstep : cB;
        for (int t = 0; t < nt; t += 2) {
            if constexpr (Epi::RESCALE) { if (t == 4 || t == 12 || t == 16) E.rescale(acc, cur, t, wr, wc, fr, fq); }
            const bool last = (t == nt - 2);
            const char* a1 = cA + (size_t)(t + 1) * kstep;
            const char* a2 = last ? nA : cA + (size_t)(t + 2) * kstep; const char* b2 = last ? nB : cB + (size_t)(t + 2) * kstep;
            const char* a3 = a2 + kstep; const char* b3 = b2 + kstep;
            if (last && has_next) S.a_ready(nxt);
            if constexpr (SP2) {
            PG8_LDB(B0, 0, 0); PG8_LDB(B1, 0, 1); PG8_SCHED; PG8_LDA(At, 0, 0); PG8_STAGE(PG8_SA(1, 1), a1 + hstep, voffA);
            PG8_WAIT_V(8); PG8_WAIT_L(0); PG8_BAR; PG8_MMA(0, 0, At, B0); PG8_MMA(0, 1, At, B1); PG8_BAR; PG8_SCHED;
            PG8_LDA(At, 0, 1); PG8_STAGE(PG8_SB(0, 0), b2, voffB); PG8_STAGE(PG8_SB(0, 1), b2 + hstep, voffB); PG8_STAGE(PG8_SA(0, 0), a2, voffA);
            PG8_WAIT_V(8); PG8_WAIT_L(0); PG8_BAR; PG8_MMA(1, 0, At, B0); PG8_MMA(1, 1, At, B1); PG8_BAR; PG8_SCHED;
            PG8_LDB(B0, 1, 0); PG8_LDB(B1, 1, 1); PG8_SCHED; PG8_LDA(At, 1, 0); PG8_STAGE(PG8_SA(0, 1), a2 + hstep, voffA);
            PG8_WAIT_V(8); PG8_WAIT_L(0); PG8_BAR; PG8_MMA(0, 0, At, B0); PG8_MMA(0, 1, At, B1); PG8_BAR; PG8_SCHED;
            PG8_LDA(At, 1, 1); PG8_STAGE(PG8_SB(1, 0), b3, voffB); PG8_STAGE(PG8_SB(1, 1), b3 + hstep, voffB); PG8_STAGE(PG8_SA(1, 0), a3, voffA);
            PG8_WAIT_V(8); PG8_WAIT_L(0); PG8_BAR; PG8_MMA(1, 0, At, B0); PG8_MMA(1, 1, At, B1); PG8_BAR; PG8_SCHED;
            } else {
            PG8_LDB(B0, 0, 0); PG8_SCHED; PG8_LDA(At, 0, 0); PG8_STAGE(PG8_SA(1, 1), a1 + hstep, voffA);
            PG8_WAIT_L(8); PG8_BAR; PG8_WAIT_L(0); PG8_MMA(0, 0, At, B0); PG8_BAR; PG8_SCHED;
            PG8_LDB(B1, 0, 1); PG8_STAGE(PG8_SB(0, 0), b2, voffB);
            PG8_BAR; PG8_WAIT_L(0); PG8_MMA(0, 1, At, B1); PG8_BAR;
            PG8_LDA(At, 0, 1); PG8_STAGE(PG8_SA(0, 0), a2, voffA);
            PG8_BAR; PG8_WAIT_L(0); PG8_MMA(1, 0, At, B0); PG8_BAR; PG8_SCHED;
            PG8_STAGE(PG8_SB(0, 1), b2 + hstep, voffB);
            PG8_WAIT_V(6); PG8_BAR; PG8_MMA(1, 1, At, B1); PG8_BAR;
            PG8_LDB(B0, 1, 0); PG8_SCHED; PG8_LDA(At, 1, 0); PG8_STAGE(PG8_SA(0, 1), a2 + hstep, voffA);
            PG8_WAIT_L(8); PG8_BAR; PG8_WAIT_L(0); PG8_MMA(0, 0, At, B0); PG8_BAR; PG8_SCHED;
            PG8_LDB(B1, 1, 1); PG8_STAGE(PG8_SB(1, 0), b3, voffB);
            PG8_BAR; PG8_WAIT_L(0); PG8_MMA(0, 1, At, B1); PG8_BAR;
            PG8_LDA(At, 1, 1); PG8_STAGE(PG8_SA(1, 0), a3, voffA);
            PG8_BAR; PG8_WAIT_L(0); PG8_MMA(1, 0, At, B0); PG8_BAR; PG8_SCHED;
            PG8_STAGE(PG8_SB(1, 1), b3 + hstep, voffB);
            PG8_WAIT_V(6); PG8_BAR; PG8_MMA(1, 1, At, B1); PG8_BAR;
            }
        }
        if constexpr (ALIGN_EPI) { if (wr == 0) PG8_BAR; }
        if constexpr (!Epi::AFTER_DRAIN) { E(acc, cur, wr, wc, fr, fq); S.done(cur); }
        if (!has_next) break;
#pragma unroll
        for (int a = 0; a < 2; ++a)
#pragma unroll
            for (int b = 0; b < 2; ++b)
#pragma unroll
                for (int m = 0; m < 4; ++m)
#pragma unroll
                    for (int n = 0; n < 2; ++n) acc[a][b][m][n] = (f32x4){0.f, 0.f, 0.f, 0.f};
        cur = nxt; cA = nA; cB = nB; ++ui;
        if constexpr (ALIGN_EPI) { if (wr == 1) PG8_BAR; }
    }
    PG8_WAIT_V(0);
    if constexpr (!ALIGN_EPI) { if (wr == 0) PG8_BAR; }
    PG8_BAR;
    if constexpr (Epi::AFTER_DRAIN) { E.fused(acc, cur, wr, wc, fr, fq, lds, wid, lane); S.done(cur); }
#undef PG8_SA
#undef PG8_SB
#undef PG8_STAGE
#undef PG8_LDA
#undef PG8_LDB
#undef PG8_MMA
#undef PG8_WAIT_V
#undef PG8_WAIT_L
#undef PG8_BAR
#undef PG8_SCHED
}
}
namespace att {
constexpr int NW = 8, QBLK = 32, KVBLK = 64, LDQ = 512, LDO = KCAT;
constexpr int SHM_V = 16384, SHM_K = 16384, SHM_ATTN = 2 * SHM_V + 2 * SHM_K + NW * 64 * 4;
constexpr float THR = 8.f;
#ifndef ATT_SDEPTH
#define ATT_SDEPTH 1
#endif
constexpr int SDEPTH = ATT_SDEPTH;
#define KSWZ(row, colB) ((row) * 256 + ((colB) ^ (((row) & 7) << 4)))
#define SBAR() __builtin_amdgcn_sched_barrier(0)
__device__ __forceinline__ int crow(int r, int hi) { return (r & 3) + 8 * (r >> 2) + 4 * hi; }
__device__ __forceinline__ unsigned cvtpk(float lo, float hi) { unsigned r; asm volatile("v_cvt_pk_bf16_f32 %0, %1, %2" : "=v"(r) : "v"(lo), "v"(hi)); return r; }

__device__ __forceinline__ void partialSM(f32x16& p0, f32x16& p1, float& m_reg, float& mn, float& alpha) {
  constexpr float C = 1.4426950408889634f;
  float pmax = p0[0];
#pragma unroll
  for (int r = 1; r < 16; ++r) pmax = fmaxf(pmax, p0[r]);
#pragma unroll
  for (int r = 0; r < 16; ++r) pmax = fmaxf(pmax, p1[r]);
  { auto rr = __builtin_amdgcn_permlane32_swap(__float_as_uint(pmax), __float_as_uint(pmax), false, false);
    pmax = fmaxf(__uint_as_float(rr[0]), __uint_as_float(rr[1])); }
  if (__builtin_expect(__all(pmax - m_reg <= THR), 1)) { mn = m_reg; alpha = 1.f; }
  else { mn = fmaxf(m_reg, pmax); alpha = __builtin_amdgcn_exp2f((m_reg - mn) * C); m_reg = mn; }
  const float mnC = -mn * C;
#pragma unroll
  for (int r = 0; r < 16; ++r) p0[r] = fmaf(p0[r], C, mnC);
#pragma unroll
  for (int r = 0; r < 16; ++r) p1[r] = fmaf(p1[r], C, mnC);
#pragma unroll
  for (int r = 0; r < 16; ++r) p0[r] = __builtin_amdgcn_exp2f(p0[r]);
}
__device__ __forceinline__ void finishSM(f32x16& p0, f32x16& p1, float alpha, float& l_reg, bf16x8& pa0, bf16x8& pa1, bf16x8& pa2, bf16x8& pa3) {
#pragma unroll
  for (int r = 0; r < 16; ++r) p1[r] = __builtin_amdgcn_exp2f(p1[r]);
  float ps = 0;
#pragma unroll
  for (int r = 0; r < 16; ++r) ps += p0[r];
#pragma unroll
  for (int r = 0; r < 16; ++r) ps += p1[r];
  { auto rr = __builtin_amdgcn_permlane32_swap(__float_as_uint(ps), __float_as_uint(ps), false, false);
    ps = __uint_as_float(rr[0]) + __uint_as_float(rr[1]); }
  l_reg = l_reg * alpha + ps;
#define PK4(P, BASE, OUT) do { unsigned a0 = cvtpk(P[BASE + 0], P[BASE + 1]), a1 = cvtpk(P[BASE + 2], P[BASE + 3]);   \
    unsigned b0 = cvtpk(P[BASE + 4], P[BASE + 5]), b1 = cvtpk(P[BASE + 6], P[BASE + 7]);                              \
    auto r0 = __builtin_amdgcn_permlane32_swap(a0, b0, false, false); auto r1 = __builtin_amdgcn_permlane32_swap(a1, b1, false, false); \
    u32x4 w = {r0[0], r1[0], r0[1], r1[1]}; OUT = *reinterpret_cast<bf16x8*>(&w); } while (0)
  PK4(p0, 0, pa0); PK4(p0, 8, pa1); PK4(p1, 0, pa2); PK4(p1, 8, pa3);
#undef PK4
}
__device__ __forceinline__ void qkt(f32x16& p0, f32x16& p1, const char* Ks, const bf16x8* qr, int r32, int hi, int kcol) {
  p0 = f32x16{}; p1 = f32x16{};
#pragma unroll
  for (int d0 = 0; d0 < 4; ++d0) { const int cb = kcol + (d0 * 16 + hi * 8) * 2;
    const bf16x8 b0 = *reinterpret_cast<const bf16x8*>(Ks + KSWZ(r32, cb));
    const bf16x8 b1 = *reinterpret_cast<const bf16x8*>(Ks + KSWZ(32 + r32, cb));
    p0 = __builtin_amdgcn_mfma_f32_32x32x16_bf16(b0, qr[d0], p0, 0, 0, 0);
    p1 = __builtin_amdgcn_mfma_f32_32x32x16_bf16(b1, qr[d0], p1, 0, 0, 0); }
}
__device__ __forceinline__ int v_st(int k, int c) { const int kk = (k & ~0xC) | ((k & 4) << 1) | ((k & 8) >> 1); return ((kk >> 3) * 4 + (c >> 5)) * 512 + ((kk & 7) * 32 + (c & 31)) * 2; }
__device__ __forceinline__ int v_rd_base(int lane) { return ((lane & 3) << 3) | (((lane >> 2) & 3) << 6) | (((lane >> 4) & 1) << 5) | (((lane >> 5) & 1) << 8); }
constexpr int v_rd_off(int d0, int ks, int half) { return d0 * 512 + ks * 4096 + half * 2048; }
template <int OFF> __device__ __forceinline__ s16x4 tr_read(int vb) {
  s16x4 r; asm volatile("ds_read_b64_tr_b16 %0, %1 offset:%2" : "=&v"(r) : "v"(vb), "i"(OFF) : "memory"); return r;
}
template <int D0> __device__ __forceinline__ void pv_one(f32x16& od, int vb, bf16x8 pa0, bf16x8 pa1, bf16x8 pa2, bf16x8 pa3) {
  const s16x4 l0 = tr_read<v_rd_off(D0, 0, 0)>(vb), h0 = tr_read<v_rd_off(D0, 0, 1)>(vb), l1 = tr_read<v_rd_off(D0, 1, 0)>(vb), h1 = tr_read<v_rd_off(D0, 1, 1)>(vb);
  const s16x4 l2 = tr_read<v_rd_off(D0, 2, 0)>(vb), h2 = tr_read<v_rd_off(D0, 2, 1)>(vb), l3 = tr_read<v_rd_off(D0, 3, 0)>(vb), h3 = tr_read<v_rd_off(D0, 3, 1)>(vb);
  asm volatile("s_waitcnt lgkmcnt(0)" ::: "memory"); SBAR();
#define PK(L, H) (bf16x8){L[0], L[1], L[2], L[3], H[0], H[1], H[2], H[3]}
  od = __builtin_amdgcn_mfma_f32_32x32x16_bf16(pa0, PK(l0, h0), od, 0, 0, 0);
  od = __builtin_amdgcn_mfma_f32_32x32x16_bf16(pa1, PK(l1, h1), od, 0, 0, 0);
  od = __builtin_amdgcn_mfma_f32_32x32x16_bf16(pa2, PK(l2, h2), od, 0, 0, 0);
  od = __builtin_amdgcn_mfma_f32_32x32x16_bf16(pa3, PK(l3, h3), od, 0, 0, 0);
#undef PK
}
__device__ __forceinline__ void pv_d0(f32x16* o, int vb, bf16x8 pa0, bf16x8 pa1, bf16x8 pa2, bf16x8 pa3) {
  pv_one<0>(o[0], vb, pa0, pa1, pa2, pa3); pv_one<1>(o[1], vb, pa0, pa1, pa2, pa3); pv_one<2>(o[2], vb, pa0, pa1, pa2, pa3); pv_one<3>(o[3], vb, pa0, pa1, pa2, pa3);
}

__device__ __forceinline__ void attn_unit(const bf16_t* __restrict__ Qb, const bf16_t* __restrict__ Kh, const bf16_t* __restrict__ Vh, int nkeys,
                                          bf16_t* __restrict__ Ob, float lam, float osc, const float* __restrict__ sg, char* lds, const int tid) {
  const int wid = __builtin_amdgcn_readfirstlane(tid >> 6), lane = tid & 63, r32 = lane & 31, hi = lane >> 5;
  const int comp = wid >> 2, qw = wid & 3, kcol = comp * 128;
  char* V_lds = lds; char* K_lds = lds + 2 * SHM_V;
  float* ws = (float*)(lds + 2 * SHM_V + 2 * SHM_K) + wid * 64; float* li_l = ws; float* al_l = ws + 32;
  float m_reg = -1e30f, l_reg = 0; f32x16 o[4] = {}; bf16x8 qr[4];
  const bf16_t* Qw = Qb + (long)(qw * QBLK + r32) * LDQ + comp * 64 + hi * 8;
#pragma unroll
  for (int d0 = 0; d0 < 4; ++d0) qr[d0] = *reinterpret_cast<const bf16x8*>(Qw + d0 * 16);
  const int sr = tid >> 4, sc = (tid & 15) * 8, vst0 = v_st(sr, sc), vst1 = v_st(32 + sr, sc);
  const int vb0 = (int)(uintptr_t)V_lds + v_rd_base(lane);
  struct { bf16x8 vs0, vs1, ks0, ks1; } sr_[SDEPTH];
#define SLOAD(i, k0) do { sr_[i].vs0 = *reinterpret_cast<const bf16x8*>(&Vh[(long)((k0) + sr) * LDQ + sc]); sr_[i].vs1 = *reinterpret_cast<const bf16x8*>(&Vh[(long)((k0) + 32 + sr) * LDQ + sc]); \
    sr_[i].ks0 = *reinterpret_cast<const bf16x8*>(&Kh[(long)((k0) + sr) * LDQ + sc]); sr_[i].ks1 = *reinterpret_cast<const bf16x8*>(&Kh[(long)((k0) + 32 + sr) * LDQ + sc]); } while (0)
#define SWRITE(b, i) do { *(bf16x8*)(V_lds + (b) * SHM_V + vst0) = sr_[i].vs0;          \
    *(bf16x8*)(V_lds + (b) * SHM_V + vst1) = sr_[i].vs1; const int kc = sc * 2;               \
    *(bf16x8*)(K_lds + (b) * SHM_K + KSWZ(sr, kc)) = sr_[i].ks0;                       \
    *(bf16x8*)(K_lds + (b) * SHM_K + KSWZ(32 + sr, kc)) = sr_[i].ks1; } while (0)
#define SWAIT() do { if constexpr (SDEPTH == 2) asm volatile("s_waitcnt vmcnt(4)" ::: "memory"); else asm volatile("s_waitcnt vmcnt(0)" ::: "memory"); } while (0)
#define RESC(a) do { if (__any((a) < 1.f)) { if (hi == 0) al_l[r32] = (a); asm volatile("s_waitcnt lgkmcnt(0)" ::: "memory"); \
    _Pragma("unroll") for (int d = 0; d < 4; ++d) _Pragma("unroll") for (int r = 0; r < 16; ++r) o[d][r] *= al_l[crow(r, hi)]; } } while (0)
  f32x16 pA0, pA1, pB0, pB1; float mnA, mnB, alA, alB; bf16x8 pa0, pa1, pa2, pa3; const int NT = nkeys / KVBLK;
  constexpr int SE = 0, SO = SDEPTH - 1;
  SLOAD(SE, 0); asm volatile("s_waitcnt vmcnt(0)" ::: "memory"); SWRITE(0, SE); __syncthreads();
  qkt(pA0, pA1, K_lds, qr, r32, hi, kcol); partialSM(pA0, pA1, m_reg, mnA, alA);
  SLOAD(SO, KVBLK); if constexpr (SDEPTH == 2) { if (2 < NT) SLOAD(SE, 2 * KVBLK); }
  SWAIT(); SWRITE(1, SO); __syncthreads();
  for (int j = 1; j + 1 < NT; j += 2) {
    SBAR(); qkt(pB0, pB1, K_lds + SHM_K, qr, r32, hi, kcol);
    finishSM(pA0, pA1, alA, l_reg, pa0, pa1, pa2, pa3); SBAR();
    SLOAD(SO, (j + SDEPTH) * KVBLK); SBAR();
    pv_d0(o, vb0, pa0, pa1, pa2, pa3); partialSM(pB0, pB1, m_reg, mnB, alB);
    __syncthreads(); SWAIT(); SWRITE(0, SE);
    RESC(alB); __syncthreads();
    SBAR(); qkt(pA0, pA1, K_lds, qr, r32, hi, kcol);
    finishSM(pB0, pB1, alB, l_reg, pa0, pa1, pa2, pa3); SBAR();
    if (SDEPTH == 1 || j + 3 < NT) SLOAD(SE, (j + 1 + SDEPTH) * KVBLK); SBAR();
    pv_d0(o, vb0 + SHM_V, pa0, pa1, pa2, pa3); partialSM(pA0, pA1, m_reg, mnA, alA);
    __syncthreads(); SWAIT(); SWRITE(1, SO);
    RESC(alA); __syncthreads();
  }
  SBAR(); qkt(pB0, pB1, K_lds + SHM_K, qr, r32, hi, kcol);
  finishSM(pA0, pA1, alA, l_reg, pa0, pa1, pa2, pa3); SBAR();
  pv_d0(o, vb0, pa0, pa1, pa2, pa3); partialSM(pB0, pB1, m_reg, mnB, alB);
  __syncthreads(); RESC(alB);
  finishSM(pB0, pB1, alB, l_reg, pa0, pa1, pa2, pa3); SBAR();
  pv_d0(o, vb0 + SHM_V, pa0, pa1, pa2, pa3);
  if (hi == 0) li_l[r32] = l_reg; asm volatile("s_waitcnt lgkmcnt(0)" ::: "memory");
  float rli[16];
#pragma unroll
  for (int r = 0; r < 16; ++r) rli[r] = __builtin_amdgcn_rcpf(li_l[crow(r, hi)]);
  __syncthreads();
  float* XO = (float*)lds + qw * (32 * 128);
  if (comp == 1) {
#pragma unroll
    for (int r = 0; r < 16; ++r)
#pragma unroll
      for (int d0 = 0; d0 < 4; ++d0) XO[crow(r, hi) * 128 + d0 * 32 + r32] = o[d0][r] * rli[r];
  }
  __syncthreads();
  if (comp == 0) {
    float ss[16];
#pragma unroll
    for (int r = 0; r < 16; ++r) { float s = 0.f;
#pragma unroll
      for (int d0 = 0; d0 < 4; ++d0) { const float v = o[d0][r] * rli[r] - lam * XO[crow(r, hi) * 128 + d0 * 32 + r32]; o[d0][r] = v; s += v * v; }
      ss[r] = s; }
#pragma unroll
    for (int r = 0; r < 16; ++r) { float s = ss[r]; s += __shfl_xor(s, 1); s += __shfl_xor(s, 2); s += __shfl_xor(s, 4); s += __shfl_xor(s, 8); s += __shfl_xor(s, 16);
      ss[r] = osc / sqrtf(s * (1.0f / 128.0f) + EPS); }
    float gam[4];
#pragma unroll
    for (int d0 = 0; d0 < 4; ++d0) gam[d0] = sg[d0 * 32 + r32];
    asm volatile("s_waitcnt lgkmcnt(0)" ::: "memory");
    bf16_t* stg = (bf16_t*)XO;
#pragma unroll
    for (int r = 0; r < 16; ++r)
#pragma unroll
      for (int d0 = 0; d0 < 4; ++d0) stg[crow(r, hi) * 128 + d0 * 32 + r32] = (bf16_t)(cvtpk(o[d0][r] * ss[r] * gam[d0], 0.f) & 0xffffu);
    asm volatile("s_waitcnt lgkmcnt(0)" ::: "memory");
#pragma unroll
    for (int i = 0; i < 8; ++i) { const int row = i * 4 + (lane >> 4), ch = lane & 15; const u32x4 v = *(const u32x4*)(stg + row * 128 + ch * 8);
      *(u32x4*)(Ob + (long)(qw * QBLK + row) * LDO + ch * 8) = v; }
  }
  __syncthreads();
#undef SLOAD
#undef SWRITE
#undef SWAIT
#undef RESC
}
#undef KSWZ
#undef SBAR
}
typedef GAS unsigned gu32;
#define RLX_AGENT __ATOMIC_RELAXED, __HIP_MEMORY_SCOPE_AGENT
constexpr int PT_OFF = LDSCTL_OFF + 1024;
__device__ __forceinline__ unsigned long long ldptr(volatile LAS unsigned long long* PT, int i) {
    const unsigned long long v = PT[i];
    const unsigned lo = __builtin_amdgcn_readfirstlane((unsigned)v), hi = __builtin_amdgcn_readfirstlane((unsigned)(v >> 32));
    return ((unsigned long long)hi << 32) | lo;
}
#define XB_TMO      128
#define XB_XCNT(j)  (256  + 64 * (j))
#define XB_XSUB(j)  (1280 + 64 * (j))
#define XB_XGEN(j)  (2304 + 64 * (j))
#define XB_TOP      3328
#define XB_TOPGEN   3392
#define XCD_BAR_WORDS 3456
#define XB_SPIN_CAP (1u << 18)

__device__ __forceinline__ unsigned xb_ld(unsigned* p)              { return __hip_atomic_load(p, __ATOMIC_RELAXED, __HIP_MEMORY_SCOPE_AGENT); }
__device__ __forceinline__ unsigned xb_add(unsigned* p, unsigned v) { return __hip_atomic_fetch_add(p, v, __ATOMIC_RELAXED, __HIP_MEMORY_SCOPE_AGENT); }
__device__ __forceinline__ unsigned xb_xcc_id() { return (unsigned)__builtin_amdgcn_s_getreg((3 << 11) | 20) & 0xFu; }
#define XB_SPIN(cond, bar) do { unsigned _sp = 0; while (cond) { __builtin_amdgcn_s_sleep(1); \
    if ((++_sp & 255u) == 0u) { if (xb_ld(&(bar)[XB_TMO])) break; if (_sp > XB_SPIN_CAP) { atomicAdd(&(bar)[XB_TMO], 1u); break; } } } } while (0)

struct XcdBarrier {
    unsigned* bar; unsigned x;
    volatile LAS unsigned* st;
};

__device__ __forceinline__ XcdBarrier xcd_barrier_post(unsigned* bar, volatile LAS unsigned* st) {
    XcdBarrier b; b.bar = bar; b.x = xb_xcc_id(); b.st = st;
    if (threadIdx.x == 0) (void)xb_add(&bar[XB_XCNT(b.x)], 1u);
    return b;
}
__device__ __forceinline__ void xcd_barrier_complete(unsigned* bar, unsigned x, unsigned& nloc, unsigned& nx) {
    const unsigned G = gridDim.x * gridDim.y * gridDim.z;
    unsigned sum, cnt, mine, sp = 0u;
    for (;;) {
        sum = 0u; cnt = 0u; mine = 0u;
#pragma unroll
        for (unsigned j = 0; j < 16; ++j) { const unsigned c = xb_ld(&bar[XB_XCNT(j)]); sum += c; cnt += (c > 0u) ? 1u : 0u; mine = (j == x) ? c : mine; }
        if (sum == G) break;
        __builtin_amdgcn_s_sleep(1);
        if ((++sp & 255u) == 0u) { if (xb_ld(&bar[XB_TMO])) break; if (sp > XB_SPIN_CAP) { atomicAdd(&bar[XB_TMO], 1u); break; } }
    }
    nloc = mine > 0u ? mine : 1u; nx = cnt > 0u ? cnt : 1u;
}

__device__ __forceinline__ void xcd_barrier(const XcdBarrier& b) {
    asm volatile("s_waitcnt vmcnt(0)" ::: "memory");
    __syncthreads();
    if (threadIdx.x == 0) {
        unsigned* bar = b.bar;
        __builtin_amdgcn_s_waitcnt(0);
        unsigned nloc = b.st[0], nx = b.st[1];
        if (nloc == 0u) { xcd_barrier_complete(bar, b.x, nloc, nx); b.st[0] = nloc; b.st[1] = nx; }
        const unsigned old = xb_add(&bar[XB_XSUB(b.x)], 1u);
        const unsigned gen = old / nloc;
        if (old + 1u == (gen + 1u) * nloc) {
            __builtin_amdgcn_fence(__ATOMIC_RELEASE, "agent");
            asm volatile("s_waitcnt vmcnt(0)" ::: "memory");
            const unsigned og = xb_add(&bar[XB_TOP], 1u);
            const unsigned tg = og / nx;
            if (og + 1u == (tg + 1u) * nx) xb_add(&bar[XB_TOPGEN], 1u);
            else XB_SPIN(xb_ld(&bar[XB_TOPGEN]) == tg, bar);
            __builtin_amdgcn_fence(__ATOMIC_ACQUIRE, "agent");
            xb_add(&bar[XB_XGEN(b.x)], 1u);
            asm volatile("s_waitcnt vmcnt(0)" ::: "memory");
        } else {
            XB_SPIN(xb_ld(&bar[XB_XGEN(b.x)]) == gen, bar);
            __builtin_amdgcn_fence(__ATOMIC_ACQUIRE, "agent");
            asm volatile("s_waitcnt vmcnt(0)" ::: "memory");
        }
    }
    __syncthreads();
}
__device__ __forceinline__ float wave_sum(float v) {
#pragma unroll
    for (int o = 1; o < 64; o <<= 1) v += __shfl_xor(v, o);
    return v;
}
__device__ __forceinline__ unsigned pk2(float lo, float hi) { unsigned r; asm volatile("v_cvt_pk_bf16_f32 %0, %1, %2" : "=v"(r) : "v"(lo), "v"(hi)); return r; }

template <int MAP  >
__device__ __forceinline__ void transpose_item(const float* W, int Nsrc, int coff, bf16_t* WT, int ldw, int koff, int nblk, LAS float* scr, int item, int lane) {
    const int kb = item / nblk, nb = item % nblk, k0 = 64 * kb, n0 = 32 * nb;
    const int nd = n0 + (lane & 31); const int scol = MAP ? in_map(nd) : nd + coff;
#pragma unroll 8
    for (int i = 0; i < 32; ++i) { const int kk = 2 * i + (lane >> 5); scr[kk * 33 + (lane & 31)] = W[(size_t)(k0 + kk) * Nsrc + scol]; }
    asm volatile("s_waitcnt lgkmcnt(0)" ::: "memory");
    const int c = lane & 7;
#pragma unroll
    for (int j = 0; j < 4; ++j) { const int n = (lane >> 3) + 8 * j; const LAS float* s = scr + (8 * c) * 33 + n;
        u32x4 o; o.x = pk2(s[0 * 33], s[1 * 33]); o.y = pk2(s[2 * 33], s[3 * 33]); o.z = pk2(s[4 * 33], s[5 * 33]); o.w = pk2(s[6 * 33], s[7 * 33]);
        *(u32x4*)(WT + (size_t)(n0 + n) * ldw + koff + k0 + 8 * c) = o; }
    asm volatile("s_waitcnt lgkmcnt(0)" ::: "memory");
}
struct WSrc { const float *w_in, *wo_f, *wo_a, *wo_c, *wo_p, *w_out, *w_up, *w_down; };
constexpr int IT_A = 16 * 208;
constexpr int IT_B0 = 4 * 32, IT_B1 = 8 * 32, IT_B2 = 4 * 32, IT_B3 = 4 * 32, IT_B4 = 16 * 32, IT_B5 = 16 * 88, IT_B6 = 16 * 88, IT_B7 = 44 * 32;
constexpr int IT_B = IT_B0 + IT_B1 + IT_B2 + IT_B3 + IT_B4 + IT_B5 + IT_B6 + IT_B7;
__device__ __forceinline__ void convert_A(const WSrc& S, unsigned char* ws, LAS float* scr, int gw, int NGW, int lane) {
    for (int it = gw; it < IT_A; it += NGW) transpose_item<1>(S.w_in, NIN, 0, (bf16_t*)(ws + WS_WA), 1024, 0, 208, scr, it, lane);
}
__device__ __forceinline__ void convert_B(const WSrc& S, unsigned char* ws, LAS float* scr, int gw, int NGW, int lane) {
    for (int it = gw; it < IT_B; it += NGW) { int r = it;
        if (r < IT_B0) { transpose_item<0>(S.wo_f, 1024, 0, (bf16_t*)(ws + WS_WCAT), KCAT, 0, 32, scr, r, lane); continue; } r -= IT_B0;
        if (r < IT_B1) { transpose_item<0>(S.wo_a, 1024, 0, (bf16_t*)(ws + WS_WCAT), KCAT, 256, 32, scr, r, lane); continue; } r -= IT_B1;
        if (r < IT_B2) { transpose_item<0>(S.wo_c, 1024, 0, (bf16_t*)(ws + WS_WCAT), KCAT, 768, 32, scr, r, lane); continue; } r -= IT_B2;
        if (r < IT_B3) { transpose_item<0>(S.wo_p, 1024, 0, (bf16_t*)(ws + WS_WCAT), KCAT, 1024, 32, scr, r, lane); continue; } r -= IT_B3;
        if (r < IT_B4) { transpose_item<0>(S.w_out, 1024, 0, (bf16_t*)(ws + WS_WOUT), 1024, 0, 32, scr, r, lane); continue; } r -= IT_B4;
        if (r < IT_B5) { transpose_item<0>(S.w_up, 2 * DFF, DFF, (bf16_t*)(ws + WS_WUPG), 1024, 0, 88, scr, r, lane); continue; } r -= IT_B5;
        if (r < IT_B6) { transpose_item<0>(S.w_up, 2 * DFF, 0, (bf16_t*)(ws + WS_WUPV), 1024, 0, 88, scr, r, lane); continue; } r -= IT_B6;
        transpose_item<0>(S.w_down, 1024, 0, (bf16_t*)(ws + WS_WDN), DFF, 0, 32, scr, r, lane);
    }
}

__device__ __forceinline__ void mod_phase(const float* c, const float* c_ctx, const float* ada_w, const float* ada_b, float* MOD, LAS unsigned char* lds, int vcu, int G, int tid, int wave, int lane) {
    LAS float* sil = (LAS float*)lds;
    LAS float* red = (LAS float*)(lds + 12288);
    for (int i = tid; i < 3072; i += 512) { const float v = i < 2048 ? c[i] : c_ctx[i - 2048]; sil[i] = v * sigm(v); }
    __syncthreads();
    for (int item = vcu; item < 192; item += G) {
        const int l = item / 96, n = (item % 96) * 64 + lane;
        const float* W = ada_w + (size_t)l * 1024 * 6144 + n;
        float a0 = 0.f, a1 = 0.f, a2 = 0.f;
        for (int k = wave * 128; k < wave * 128 + 128; k += 8) { float w[8];
#pragma unroll
            for (int i = 0; i < 8; ++i) w[i] = W[(size_t)(k + i) * 6144];
#pragma unroll
            for (int i = 0; i < 8; ++i) { a0 += sil[k + i] * w[i]; a1 += sil[1024 + k + i] * w[i]; a2 += sil[2048 + k + i] * w[i]; } }
        red[(wave * 3 + 0) * 64 + lane] = a0; red[(wave * 3 + 1) * 64 + lane] = a1; red[(wave * 3 + 2) * 64 + lane] = a2;
        __syncthreads();
        if (wave < 3) { float s = ada_b[l * 6144 + n];
#pragma unroll
            for (int w = 0; w < 8; ++w) s += red[(w * 3 + wave) * 64 + lane];
            MOD[(size_t)(l * 3 + wave) * 6144 + n] = s; }
        __syncthreads();
    }
}
__device__ __forceinline__ void tables_phase(float* ROPE, f32x2* TW, int gt, int NGT) {
    for (int i = gt; i < 192 * 16; i += NGT) { const int pos = i >> 4, f = i & 15; const float inv = powf(10000.0f, -(float)f / 16.0f); const float ang = (float)(pos < 128 ? pos : pos - 128) * inv;
        float s, c; sincosf(ang, &s, &c); ROPE[pos * 32 + f] = c; ROPE[pos * 32 + 16 + f] = s; }
    for (int i = gt; i < 8192; i += NGT) { float s, c; sincospif((float)i * (1.0f / 4096.0f), &s, &c); TW[i] = (f32x2){c, -s}; }
}

__device__ __forceinline__ void norm_phase(const float* src_lat, const float* src_ctx, int nrows, const float* gamma, const float* mod, int shoff, int scoff, bf16_t* HX, int gw, int NGW, int lane) {
    for (int m = gw; m < nrows; m += NGW) {
        const float* xr = m < ML ? src_lat + (size_t)m * DM : src_ctx + (size_t)(m - ML) * DM;
        const float* md = mod + (m < SEQ ? 0 : m < ML ? 1 : 2) * 6144;
        f32x4 v[4]; float s = 0.f;
#pragma unroll
        for (int j = 0; j < 4; ++j) { v[j] = ((const f32x4*)xr)[lane + 64 * j]; s += (v[j].x * v[j].x + v[j].y * v[j].y) + (v[j].z * v[j].z + v[j].w * v[j].w); }
        const float rstd = 1.0f / sqrtf(wave_sum(s) * (1.0f / DM) + EPS);
#pragma unroll
        for (int j = 0; j < 4; ++j) { const int col = 4 * lane + 256 * j;
            const f32x4 g = *(const f32x4*)(gamma + col), sc = *(const f32x4*)(md + scoff + col), sh = *(const f32x4*)(md + shoff + col);
            const f32x4 o = v[j] * rstd * g * (sc + 1.0f) + sh;
            u32x2 w; w.x = pk2(o.x, o.y); w.y = pk2(o.z, o.w); *(u32x2*)(HX + (size_t)m * DM + col) = w; }
    }
}
__device__ __forceinline__ void final_norm_phase(float* x, const float* gamma, int gw, int NGW, int lane) {
    for (int m = gw; m < ML; m += NGW) { f32x4* xr = (f32x4*)(x + (size_t)m * DM);
        f32x4 v[4]; float s = 0.f;
#pragma unroll
        for (int j = 0; j < 4; ++j) { v[j] = xr[lane + 64 * j]; s += (v[j].x * v[j].x + v[j].y * v[j].y) + (v[j].z * v[j].z + v[j].w * v[j].w); }
        const float rstd = 1.0f / sqrtf(wave_sum(s) * (1.0f / DM) + EPS);
#pragma unroll
        for (int j = 0; j < 4; ++j) { const f32x4 g = *(const f32x4*)(gamma + 4 * lane + 256 * j); xr[lane + 64 * j] = v[j] * rstd * g; }
    }
}

__device__ __forceinline__ void fft1_item(int item, const bf16_t* UF, const f32x2* TW, f32x2* FA, LAS unsigned char* lds, int tid, int wave, int lane) {
    const int b = item >> 8, g = (item >> 6) & 3, l2 = item & 63;
    LAS float* xs = (LAS float*)lds; LAS f32x2* w128 = (LAS f32x2*)(lds + 32768);
    for (int i = tid; i < 128 * 64; i += 512) { const int l1 = i >> 6, c = i & 63; xs[i] = bf2f(UF[(size_t)(b * SEQ + 64 * l1 + l2) * 256 + g * 64 + c]); }
    if (tid < 128) { float s, c; sincospif((float)tid * (1.0f / 64.0f), &s, &c); w128[tid] = (f32x2){c, s}; }
    __syncthreads();
    float re[16], im[16];
#pragma unroll
    for (int j = 0; j < 16; ++j) { re[j] = 0.f; im[j] = 0.f; }
    const int kb = wave * 16;
    for (int l1 = 0; l1 < 128; ++l1) { const float x = xs[l1 * 64 + lane];
#pragma unroll
        for (int j = 0; j < 16; ++j) { const f32x2 cs = w128[((kb + j) * l1) & 127]; re[j] += x * cs.x; im[j] -= x * cs.y; } }
#pragma unroll
    for (int j = 0; j < 16; ++j) { const int k1 = kb + j; const f32x2 t = TW[k1 * l2];
        FA[((size_t)((b * 4 + g) * 128 + k1) * 64 + l2) * 64 + lane] = (f32x2){re[j] * t.x - im[j] * t.y, re[j] * t.y + im[j] * t.x}; }
    __syncthreads();
}
__device__ __forceinline__ void fft2_item(int item, const f32x2* FA, bf16_t* ACAT, LAS unsigned char* lds, int tid, int wave, int lane) {
    const int b = item >> 9, g = (item >> 7) & 3, k1 = item & 127;
    LAS f32x2* As = (LAS f32x2*)lds; LAS f32x2* Zs = (LAS f32x2*)(lds + 32768); LAS f32x2* w64 = (LAS f32x2*)(lds + 65536);
    const f32x2* src = FA + (size_t)((b * 4 + g) * 128 + k1) * 4096;
    for (int i = tid; i < 4096; i += 512) As[i] = src[i];
    if (tid < 64) { float s, c; sincospif((float)tid * (1.0f / 32.0f), &s, &c); w64[tid] = (f32x2){c, s}; }
    __syncthreads();
    float zr[8], zi[8];
#pragma unroll
    for (int j = 0; j < 8; ++j) { zr[j] = 0.f; zi[j] = 0.f; }
    const int kb = wave * 8;
    for (int l2 = 0; l2 < 64; ++l2) { const f32x2 a = As[l2 * 64 + lane];
#pragma unroll
        for (int j = 0; j < 8; ++j) { const f32x2 cs = w64[((kb + j) * l2) & 63]; zr[j] += a.x * cs.x + a.y * cs.y; zi[j] += a.y * cs.x - a.x * cs.y; } }
#pragma unroll
    for (int j = 0; j < 8; ++j) Zs[(kb + j) * 64 + lane] = (f32x2){zr[j], zi[j]};
    __syncthreads();
    float y[8];
#pragma unroll
    for (int j = 0; j < 8; ++j) y[j] = 0.f;
    for (int c = 0; c < 64; ++c) { const f32x2 cs = w64[(lane * c) & 63];
#pragma unroll
        for (int j = 0; j < 8; ++j) { const f32x2 z = Zs[(kb + j) * 64 + c]; y[j] += z.x * cs.x + z.y * cs.y; } }
    const float scale = 0.001381067932f;
#pragma unroll
    for (int j = 0; j < 8; ++j) { const int k = k1 + 128 * (kb + j); ACAT[(size_t)(b * SEQ + k) * KCAT + g * 64 + lane] = (bf16_t)(pk2(y[j] * scale, 0.f) & 0xffffu); }
    __syncthreads();
}
__device__ __forceinline__ void ctxdft_item(int item, const bf16_t* UF, bf16_t* ACAT, LAS unsigned char* lds, int tid, int wave, int lane) {
    const int b = item >> 4, g = (item >> 2) & 3, kc = item & 3;
    LAS float* xs = (LAS float*)lds; LAS f32x2* Zs = (LAS f32x2*)(lds + 65536); LAS f32x2* w256 = (LAS f32x2*)(lds + 98304); LAS f32x2* w64 = (LAS f32x2*)(lds + 98304 + 2048);
    for (int i = tid; i < 256 * 64; i += 512) { const int l = i >> 6, c = i & 63; xs[i] = bf2f(UF[(size_t)(ML + b * CTXL + l) * 256 + g * 64 + c]); }
    if (tid < 256) { float s, c; sincospif((float)tid * (1.0f / 128.0f), &s, &c); w256[tid] = (f32x2){c, s}; }
    if (tid < 64) { float s, c; sincospif((float)tid * (1.0f / 32.0f), &s, &c); w64[tid] = (f32x2){c, s}; }
    __syncthreads();
    float zr[8], zi[8];
#pragma unroll
    for (int j = 0; j < 8; ++j) { zr[j] = 0.f; zi[j] = 0.f; }
    const int kb = 64 * kc + wave * 8;
    for (int l = 0; l < 256; ++l) { const float x = xs[l * 64 + lane];
#pragma unroll
        for (int j = 0; j < 8; ++j) { const f32x2 cs = w256[((kb + j) * l) & 255]; zr[j] += x * cs.x; zi[j] -= x * cs.y; } }
#pragma unroll
    for (int j = 0; j < 8; ++j) Zs[(wave * 8 + j) * 64 + lane] = (f32x2){zr[j], zi[j]};
    __syncthreads();
    float y[8];
#pragma unroll
    for (int j = 0; j < 8; ++j) y[j] = 0.f;
    for (int c = 0; c < 64; ++c) { const f32x2 cs = w64[(lane * c) & 63];
#pragma unroll
        for (int j = 0; j < 8; ++j) { const f32x2 z = Zs[(wave * 8 + j) * 64 + c]; y[j] += z.x * cs.x + z.y * cs.y; } }
#pragma unroll
    for (int j = 0; j < 8; ++j) ACAT[(size_t)(ML + b * CTXL + kb + j) * KCAT + g * 64 + lane] = (bf16_t)(pk2(y[j] * (1.0f / 128.0f), 0.f) & 0xffffu);
    __syncthreads();
}

__device__ __forceinline__ void conv_item(int item, const bf16_t* ZG, const float* cw  , const float* cb, const float* lng, const float* lnb, bf16_t* ACAT, LAS unsigned char* lds, int tid, int wave, int lane) {
    const int row0 = item * 64; const bool lat = row0 < ML; const int s0 = lat ? (row0 & ~(SEQ - 1)) : (ML + ((row0 - ML) & ~(CTXL - 1))), s1 = s0 + (lat ? SEQ : CTXL);
    LAS float* zt = (LAS float*)lds;
    for (int i = tid; i < 94 * 256; i += 512) { const int rr = i >> 8, c = i & 255, gr = row0 - 15 + rr; zt[i] = (gr >= s0 && gr < s1) ? bf2f(ZG[(size_t)gr * 256 + c]) : 0.f; }
    const int c = tid & 255, half = tid >> 8;
    float w[31];
#pragma unroll
    for (int t = 0; t < 31; ++t) w[t] = cw[t * 256 + c];
    float acc[32]; const float bias = cb[c];
#pragma unroll
    for (int r = 0; r < 32; ++r) acc[r] = bias;
    __syncthreads();
#pragma unroll
    for (int rr = 0; rr < 62; ++rr) { const float v = zt[(half * 32 + rr) * 256 + c];
#pragma unroll
        for (int r = 0; r < 32; ++r) { if (rr - r >= 0 && rr - r < 31) acc[r] += w[rr - r] * v; } }
    __syncthreads();
#pragma unroll
    for (int r = 0; r < 32; ++r) zt[(half * 32 + r) * 256 + c] = acc[r];
    __syncthreads();
    const f32x4 gg = *(const f32x4*)(lng + 4 * lane), bb = *(const f32x4*)(lnb + 4 * lane);
#pragma unroll
    for (int i = 0; i < 8; ++i) { const int r = wave * 8 + i; const f32x4 v = *(const LAS f32x4*)(zt + r * 256 + 4 * lane);
        const float mu = wave_sum((v.x + v.y) + (v.z + v.w)) * (1.0f / 256.0f); const f32x4 d = v - mu;
        const float var = wave_sum((d.x * d.x + d.y * d.y) + (d.z * d.z + d.w * d.w)) * (1.0f / 256.0f); const float rs = 1.0f / sqrtf(var + EPS);
        f32x4 o = d * rs * gg + bb; o.x *= sigm(o.x); o.y *= sigm(o.y); o.z *= sigm(o.z); o.w *= sigm(o.w);
        u32x2 pw; pw.x = pk2(o.x, o.y); pw.y = pk2(o.z, o.w); *(u32x2*)(ACAT + (size_t)(row0 + r) * KCAT + 768 + 4 * lane) = pw; }
    __syncthreads();
}
__device__ __forceinline__ void pool_item(int item, const bf16_t* UP, const float* pw  , const float* psc, bf16_t* ACAT, LAS unsigned char* lds, int tid, int wave, int lane) {
    const int row0 = item * 32; const bool lat = row0 < ML; const int s0 = lat ? (row0 & ~(SEQ - 1)) : (ML + ((row0 - ML) & ~(CTXL - 1))), L = lat ? SEQ : CTXL, s1 = s0 + L;
    LAS float* ut = (LAS float*)lds;
    LAS float* dt = (LAS float*)(lds + 49152);
    for (int i = tid; i < 48 * 256; i += 512) { const int rr = i >> 8, c = i & 255, gr = row0 - 8 + rr; ut[i] = (gr >= s0 && gr < s1) ? bf2f(UP[(size_t)gr * 256 + c]) : 0.f; }
    __syncthreads();
    { const int c = tid & 255, half = tid >> 8, g = c >> 6, hw = 1 << g;
#pragma unroll 4
      for (int r = 0; r < 16; ++r) { const int lr = half * 16 + r, tt = row0 + lr - s0; float s = 0.f;
          for (int o = -hw; o < hw; ++o) s += ut[(lr + 8 + o) * 256 + c];
          const int lo = tt - hw < 0 ? 0 : tt - hw, hi = tt + hw - 1 > L - 1 ? L - 1 : tt + hw - 1;
          dt[lr * 256 + c] = s / (float)(hi - lo + 1) - ut[(lr + 8) * 256 + c]; } }
    __syncthreads();
    { const int m = tid & 63, g = (tid >> 6) & 3, half = tid >> 8; float acc[16];
#pragma unroll
      for (int r = 0; r < 16; ++r) acc[r] = 0.f;
      const float* pwg = pw + g * 4096 + m;
      for (int cc = 0; cc < 64; ++cc) { const float wv = pwg[cc * 64];
#pragma unroll
          for (int r = 0; r < 16; ++r) acc[r] += dt[(half * 16 + r) * 256 + g * 64 + cc] * wv; }
      const float sc = psc[g * 64 + m];
#pragma unroll
      for (int r = 0; r < 16; ++r) ACAT[(size_t)(row0 + half * 16 + r) * KCAT + 1024 + g * 64 + m] = (bf16_t)(pk2(acc[r] * sc, 0.f) & 0xffffu); }
    __syncthreads();
}
constexpr int NPHASE = 22;
struct Args { const float* in[30]; float* out; unsigned char* ws; int ph_lo, ph_hi, li, pad; };
__global__ void __launch_bounds__(512, 2) fwd_kernel(Args args) {
    extern __shared__ __attribute__((aligned(16))) unsigned char lds[];
    LAS unsigned char* L = (LAS unsigned char*)lds;
    volatile LAS unsigned* MISC = (volatile LAS unsigned*)(L + MISC_OFF);
    const int tid0 = threadIdx.x;
    const int G = gridDim.x, bx0 = blockIdx.x, vcu0 = (G % 8 == 0) ? (bx0 % 8) * (G / 8) + bx0 / 8 : bx0;
    const int NGW = G * 8;
    gu32* ctl = (gu32*)(args.ws + WS_CTL);
    for (int u = tid0; u < (LDS_BYTES - LDSCTL_OFF) / 4; u += 512) ((LAS unsigned*)(L + LDSCTL_OFF))[u] = 0u;
    __syncthreads();
    volatile LAS unsigned long long* PT = (volatile LAS unsigned long long*)(L + PT_OFF);
    if (tid0 == 0) {
#define PTW(i) PT[i] = (unsigned long long)args.in[i];
        PTW(0) PTW(1) PTW(2) PTW(3) PTW(4) PTW(5) PTW(6) PTW(7) PTW(8) PTW(9) PTW(10) PTW(11) PTW(12) PTW(13) PTW(14) PTW(15) PTW(16) PTW(17) PTW(18) PTW(19)
        PTW(20) PTW(21) PTW(22) PTW(23) PTW(24) PTW(25) PTW(26) PTW(27) PTW(28) PTW(29)
#undef PTW
        PT[30] = (unsigned long long)args.out; PT[31] = (unsigned long long)args.ws;
    }
    __syncthreads();
#define FRESH() int tid = tid0, vcu = vcu0, bx = bx0; asm volatile("" : "+v"(tid), "+s"(vcu), "+s"(bx)); const int lane = tid & 63, wave = __builtin_amdgcn_readfirstlane(tid >> 6), gw = vcu * 8 + wave; (void)lane; (void)gw; (void)bx; \
    LAS float* scr = (LAS float*)(L + wave * 16384); (void)scr;
#define PTR(i) ((const float*)(const GAS float*)ldptr(PT, (i)))
#define OUTP ((float*)(GAS float*)ldptr(PT, 30))
#define WSP ((unsigned char*)(GAS unsigned char*)ldptr(PT, 31))
    XcdBarrier bar; bar.bar = (unsigned*)(ctl + CW_BAR) + args.li * XCD_BAR_WORDS; bar.x = 0; bar.st = nullptr;
    if (MK_N_LAUNCHES != NPHASE) bar = xcd_barrier_post((unsigned*)(ctl + CW_BAR) + args.li * XCD_BAR_WORDS, MISC + 8);
#define GRID_BAR() do { if (MK_N_LAUNCHES == NPHASE) { if (tid0 == 0) __hip_atomic_store(ctl + CW_TMO, 0xBADBA0u, RLX_AGENT); } else { xcd_barrier(bar); } } while (0)
    const int lo = args.ph_lo, hi = args.ph_hi;
#ifndef PHASE_MASK
#define PHASE_MASK 0xFFF
#endif
#ifndef ATTM
#define ATTM 3
#endif
#ifndef X1M
#define X1M 31
#endif
#define PH_EN(kind) ((PHASE_MASK >> (kind)) & 1)
#define IN(k) (lo <= (k) && (k) < hi)
#define BOTH(k) (IN(k) && IN((k) + 1))
#define WSRC(S, l) WSrc S; S.w_in = PTR(8) + (size_t)(l) * 1024 * NIN; S.wo_f = PTR(20) + (size_t)(l) * 256 * 1024; S.wo_a = PTR(21) + (size_t)(l) * 512 * 1024; \
    S.wo_c = PTR(22) + (size_t)(l) * 256 * 1024; S.wo_p = PTR(23) + (size_t)(l) * 256 * 1024; S.w_out = PTR(24) + (size_t)(l) * 1024 * 1024; \
    S.w_up = PTR(25) + (size_t)(l) * 1024 * 2 * DFF; S.w_down = PTR(28) + (size_t)(l) * DFF * 1024;
#define ws WSP
#define MOD ((float*)(WSP + WS_MOD))
#define ROPE ((float*)(WSP + WS_ROPE))
#define TW ((f32x2*)(WSP + WS_TW))
#define XC ((float*)(WSP + WS_XC))
#define HX ((bf16_t*)(WSP + WS_HX))
#define FA ((f32x2*)(WSP + WS_FA))
#define Qb ((bf16_t*)(WSP + WS_Q))
#define Kb ((bf16_t*)(WSP + WS_K))
#define Vb ((bf16_t*)(WSP + WS_V))
#define Yb ((bf16_t*)(WSP + WS_Y))
#define Gb (WSP + WS_G)
#define ACAT ((bf16_t*)(WSP + WS_ACAT))
#define UF ((bf16_t*)(WSP + WS_UF))
#define ZG ((bf16_t*)(WSP + WS_ZG))
#define UP ((bf16_t*)(WSP + WS_UP))
#define GT ((bf16_t*)(WSP + WS_GT))
#define Hb ((bf16_t*)(WSP + WS_H))

    if (PH_EN(0) && IN(0)) { FRESH();
        mod_phase(PTR(1), PTR(3), PTR(6), PTR(7), MOD, L, vcu, G, tid, wave, lane);
        tables_phase(ROPE, TW, vcu * 512 + tid, G * 512);
        WSRC(S0, 0); convert_A(S0, ws, scr, gw, NGW, lane); convert_B(S0, ws, scr, gw, NGW, lane);
        if (BOTH(0)) GRID_BAR();
    }
#pragma nounroll
    for (int l = 0; l < 2; ++l) {
        const int pb = 1 + 10 * l;
#define mod (MOD + l * 3 * 6144)
#define xl ((l == 0) ? PTR(0) : (const float*)OUTP)
#define xc ((l == 0) ? PTR(2) : (const float*)XC)
        const int Mact = (l == 0) ? MT : ML;
        if (PH_EN(1) && IN(pb)) { FRESH(); norm_phase(xl, xc, MT, PTR(4) + l * DM, mod, 0, 1024, HX, gw, NGW, lane); if (BOTH(pb)) GRID_BAR(); }
        if (PH_EN(2) && IN(pb + 1)) { FRESH();
            pg8::Gemm g{HX, (const bf16_t*)(ws + WS_WA), MT, NIN, 1024}; pg8::StaticOrder S; S.init(MT, NIN, G, bx);
            pg8::EpiIn E{UF, ZG, UP, Qb, Kb, Vb, Gb, ROPE};
            pg8::gemm_phase<pg8::EpiIn, pg8::StaticOrder, true, true>(L, g, S, E, tid);
            if (BOTH(pb + 1)) GRID_BAR();
        }
        if (PH_EN(3) && IN(pb + 2)) { FRESH();
            if (X1M & 1) for (int it = vcu; it < 512; it += G) fft1_item(it, UF, TW, FA, L, tid, wave, lane);
            if (X1M & 2) for (int it = vcu; it < Mact / 64; it += G) conv_item(it, ZG, PTR(14) + l * 31 * 256, PTR(15) + l * 256, PTR(16) + l * 256, PTR(17) + l * 256, ACAT, L, tid, wave, lane);
            if (X1M & 4) for (int it = (vcu + 248) % G; it < Mact / 32; it += G) pool_item(it, UP, PTR(18) + l * 4 * 4096, PTR(19) + l * 256, ACAT, L, tid, wave, lane);
            if ((X1M & 8) && l == 0) for (int it = (vcu + 224) % G; it < 32; it += G) ctxdft_item(it, UF, ACAT, L, tid, wave, lane);
            WSRC(S1, 1);
            if (!(X1M & 16)) {} else if (l == 0) convert_A(S1, ws, scr, gw, NGW, lane); else convert_B(S1, ws, scr, gw, NGW, lane);
            if (BOTH(pb + 2)) GRID_BAR();
        }
        if (PH_EN(4) && IN(pb + 3)) { FRESH();
            if (ATTM & 1) for (int it = vcu; it < 1024; it += G) fft2_item(it, FA, ACAT, L, tid, wave, lane);
            const float lam_init = (l == 0) ? 0.2f : 0.35550906759096926f;
            const float d1 = wave_sum(PTR(9)[l * 64 + lane] * PTR(10)[l * 64 + lane]), d2 = wave_sum(PTR(11)[l * 64 + lane] * PTR(12)[l * 64 + lane]);
            const float lam = __builtin_bit_cast(float, __builtin_amdgcn_readfirstlane(__builtin_bit_cast(int, expf(d1) - expf(d2) + lam_init)));
            const int nun = 512 + (l == 0 ? 16 : 0);
            if (ATTM & 2) for (int u = vcu; u < nun; u += G) {
                int b, h, row0, nkeys;
                if (u < 512) { const int x = (u & 255) >> 5, qb = (u & 31) + 32 * (u >> 8); b = x >> 2; h = x & 3; row0 = b * SEQ + qb * 128; nkeys = KVL; }
                else { const int v = u - 512; b = v >> 3; h = (v >> 1) & 3; row0 = ML + b * CTXL + (v & 1) * 128; nkeys = CTXL; }
                att::attn_unit(Qb + (size_t)row0 * 512 + h * 128, Kb + (size_t)b * KVL * 512 + h * 128, Vb + (size_t)b * KVL * 512 + h * 128, nkeys,
                               ACAT + (size_t)row0 * KCAT + 256 + h * 128, lam, 1.0f - lam_init, PTR(13) + l * 128, (char*)lds, tid);
            }
            if (BOTH(pb + 3)) GRID_BAR();
        }
        if (PH_EN(5) && IN(pb + 4)) { FRESH();
            pg8::Gemm g{ACAT, (const bf16_t*)(ws + WS_WCAT), Mact, 1024, KCAT}; pg8::StaticOrder S; S.init(Mact, 1024, G, bx);
            pg8::EpiBranch E{Gb, Yb};
            pg8::gemm_phase<pg8::EpiBranch, pg8::StaticOrder, true, true>(L, g, S, E, tid);
            if (BOTH(pb + 4)) GRID_BAR();
        }
        if (PH_EN(6) && IN(pb + 5)) { FRESH();
            pg8::Gemm g{Yb, (const bf16_t*)(ws + WS_WOUT), Mact, 1024, 1024}; pg8::StaticOrder S; S.init(Mact, 1024, G, bx);
            pg8::EpiRes E{xl, xc, OUTP, XC, mod, 2048};
            pg8::gemm_phase<pg8::EpiRes, pg8::StaticOrder, true, true>(L, g, S, E, tid);
            if (BOTH(pb + 5)) GRID_BAR();
        }
        if (PH_EN(7) && IN(pb + 6)) { FRESH(); norm_phase(OUTP, XC, Mact, PTR(5) + l * DM, mod, 3072, 4096, HX, gw, NGW, lane); if (BOTH(pb + 6)) GRID_BAR(); }
        if (PH_EN(8) && IN(pb + 7)) { FRESH();
            pg8::Gemm g{HX, (const bf16_t*)(ws + WS_WUPG), Mact, DFF, 1024}; pg8::StaticOrder S; S.init(Mact, DFF, G, bx);
            pg8::EpiBf E{GT, DFF};
            pg8::gemm_phase<pg8::EpiBf, pg8::StaticOrder, true, true>(L, g, S, E, tid);
            if (BOTH(pb + 7)) GRID_BAR();
        }
        if (PH_EN(9) && IN(pb + 8)) { FRESH();
            pg8::Gemm g{HX, (const bf16_t*)(ws + WS_WUPV), Mact, DFF, 1024}; pg8::StaticOrder S; S.init(Mact, DFF, G, bx);
            pg8::EpiVal E{GT, Hb, PTR(26) + l * 3 * DFF, PTR(27) + l * DFF};
            pg8::gemm_phase<pg8::EpiVal, pg8::StaticOrder, true, true>(L, g, S, E, tid);
            if (BOTH(pb + 8)) GRID_BAR();
        }
        if (PH_EN(10) && IN(pb + 9)) { FRESH();
            pg8::Gemm g{Hb, (const bf16_t*)(ws + WS_WDN), Mact, 1024, DFF}; pg8::StaticOrder S; S.init(Mact, 1024, G, bx);
            pg8::EpiRes E{OUTP, XC, OUTP, XC, mod, 5120};
            pg8::gemm_phase<pg8::EpiRes, pg8::StaticOrder, true, true>(L, g, S, E, tid);
            if (BOTH(pb + 9)) GRID_BAR();
        }
    }
    if (PH_EN(11) && IN(21)) { FRESH(); final_norm_phase(OUTP, PTR(29), gw, NGW, lane); }
#undef IN
#undef BOTH
#undef mod
#undef xl
#undef xc
#undef ws
#undef MOD
#undef ROPE
#undef TW
#undef XC
#undef HX
#undef FA
#undef Qb
#undef Kb
#undef Vb
#undef Yb
#undef Gb
#undef ACAT
#undef UF
#undef ZG
#undef UP
#undef GT
#undef Hb
#undef PTR
#undef OUTP
#undef WSP
}

extern "C" void kernel_launch(void* const* d_in, const int* in_sizes, int n_in, void* d_out, int out_size, void* d_ws, size_t ws_size, hipStream_t stream) {
    static int grid = 0;
    if (grid == 0) {
        if (n_in != 30 || in_sizes[0] != ML * DM || out_size != ML * DM || ws_size < WS_END) {
            fprintf(stderr, "kernel_launch: unexpected shapes: n_in %d in0 %d out %d ws %zu (need >= %zu)\n", n_in, n_in > 0 ? in_sizes[0] : -1, out_size, ws_size, (size_t)WS_END); grid = -1; return; }
        int dev = 0, cus = 0, per_cu = 0;
        if (hipGetDevice(&dev) != hipSuccess || hipDeviceGetAttribute(&cus, hipDeviceAttributeMultiprocessorCount, dev) != hipSuccess) { grid = -1; return; }
        if (hipFuncSetAttribute((const void*)fwd_kernel, hipFuncAttributeMaxDynamicSharedMemorySize, LDS_BYTES) != hipSuccess) { fprintf(stderr, "kernel_launch: hipFuncSetAttribute failed\n"); grid = -1; return; }
        if (hipOccupancyMaxActiveBlocksPerMultiprocessor(&per_cu, (const void*)fwd_kernel, 512, LDS_BYTES) != hipSuccess || per_cu < 1) {
            fprintf(stderr, "kernel_launch: occupancy query reports %d blocks per CU\n", per_cu); (void)hipGetLastError(); grid = -1; return; }
        grid = cus;
    }
    if (grid < 0) return;
    (void)hipMemsetAsync((char*)d_ws + WS_CTL, 0, CTL_ZERO_BYTES, stream);
    Args a{};
    for (int i = 0; i < 30; ++i) a.in[i] = (const float*)d_in[i];
    a.out = (float*)d_out; a.ws = (unsigned char*)d_ws;
    for (int li = 0; li < MK_N_LAUNCHES; ++li) {
        if (MK_N_LAUNCHES == NPHASE) { a.ph_lo = li; a.ph_hi = li + 1; a.li = 0; }
        else { a.ph_lo = (int)((long)NPHASE * li / MK_N_LAUNCHES); a.ph_hi = (int)((long)NPHASE * (li + 1) / MK_N_LAUNCHES); a.li = li; }
        hipLaunchKernelGGL(fwd_kernel, dim3(grid), dim3(512), LDS_BYTES, stream, a);
    }
}
```

```cpp
#include <hip/hip_runtime.h>
#include <cstdio>
#include <cstdint>

#define LAS __attribute__((address_space(3)))
#define GAS __attribute__((address_space(1)))
typedef unsigned short bf16_t;
typedef short bf16x8 __attribute__((ext_vector_type(8)));
typedef short s16x4 __attribute__((ext_vector_type(4)));
typedef float f32x2 __attribute__((ext_vector_type(2)));
typedef float f32x4 __attribute__((ext_vector_type(4)));
typedef float f32x16 __attribute__((ext_vector_type(16)));
typedef unsigned u32x2 __attribute__((ext_vector_type(2)));
typedef unsigned u32x4 __attribute__((ext_vector_type(4)));

#ifndef MK_N_LAUNCHES
#define MK_N_LAUNCHES 1
#endif

constexpr int DM = 1024, SEQ = 8192, NBATCH = 2, CTXL = 256;
constexpr int ML = NBATCH * SEQ;
constexpr int MC = NBATCH * CTXL;
constexpr int MT = ML + MC;
constexpr int NIN = 6656, DFF = 2816, KCAT = 1280;
constexpr int KVL = CTXL + SEQ;
constexpr float EPS = 1e-6f;

constexpr size_t MiB = 1u << 20;
constexpr size_t WS_CTL = 0, CTL_ZERO_BYTES = 1 * MiB;
constexpr size_t WS_MOD = 1 * MiB;
constexpr size_t WS_ROPE = WS_MOD + 2 * 3 * 6144 * 4;
constexpr size_t WS_TW = WS_ROPE + 192 * 32 * 4;
constexpr size_t WS_XC = 2 * MiB;
constexpr size_t WS_WA = 4 * MiB;
constexpr size_t WS_WCAT = 17 * MiB;
constexpr size_t WS_WOUT = WS_WCAT + (size_t)1024 * 1280 * 2;
constexpr size_t WS_WUPG = WS_WOUT + (size_t)1024 * 1024 * 2;
constexpr size_t WS_WUPV = WS_WUPG + (size_t)2816 * 1024 * 2;
constexpr size_t WS_WDN = WS_WUPV + (size_t)2816 * 1024 * 2;
constexpr size_t WS_HX = 38 * MiB;
constexpr size_t WS_FA = WS_HX;
constexpr size_t WS_Q = 71 * MiB;
constexpr size_t WS_K = WS_Q + (size_t)MT * 512 * 2;
constexpr size_t WS_V = WS_K + (size_t)MT * 512 * 2;
constexpr size_t WS_Y = 71 * MiB;
constexpr size_t WS_G = 121 * MiB;
constexpr size_t WS_ACAT = 187 * MiB;
constexpr size_t WS_UF = 229 * MiB;
constexpr size_t WS_ZG = WS_UF + (size_t)MT * 256 * 2;
constexpr size_t WS_UP = WS_ZG + (size_t)MT * 256 * 2;
constexpr size_t WS_GT = 71 * MiB;
constexpr size_t WS_H = 162 * MiB;
constexpr size_t WS_END = 256 * MiB;
static_assert(WS_TW + 8192 * 8 <= WS_XC && WS_WDN + (size_t)1024 * 2816 * 2 <= WS_HX && WS_V + (size_t)MT * 512 * 2 <= WS_G && WS_G + (size_t)MT * 4096 <= WS_ACAT, "ws map 1");
static_assert(WS_ACAT + (size_t)MT * 1280 * 2 <= WS_UF && WS_UP + (size_t)MT * 256 * 2 <= WS_END && WS_GT + (size_t)MT * 2816 * 2 <= WS_H && WS_H + (size_t)MT * 2816 * 2 <= WS_END, "ws map 2");
static_assert(WS_HX + (size_t)MT * 1024 * 2 <= WS_Q && (size_t)2 * 4 * 128 * 64 * 64 * 8 <= (size_t)MT * 1024 * 2, "ws map 3");
constexpr int CW_TMO = 0, CW_CODE = 1, CW_BAR = 4096;

constexpr int RING_BYTES = 131072, LDSCTL_OFF = RING_BYTES, MISC_OFF = LDSCTL_OFF + 320, LDS_BYTES = 147456;

typedef __bf16 bf16x2_t __attribute__((ext_vector_type(2)));
__device__ __forceinline__ unsigned cvt2bf(float lo, float hi) { const f32x2 v = {lo, hi}; return __builtin_bit_cast(unsigned, __builtin_convertvector(v, bf16x2_t)); }
__device__ __forceinline__ float bf2f(unsigned v) { return __uint_as_float(v << 16); }
__device__ __forceinline__ float sigm(float x) { return 1.0f / (1.0f + __expf(-x)); }
__host__ __device__ __forceinline__ int in_map(int n) {
    if (n < 256) return n;
    if (n < 1280) { const int base = n < 768 ? 256 : 768, r = n - base, comp = r >> 6, p = r & 63, pp = p >> 1, e = p & 1;
        return base + comp * 64 + (pp < 16 ? 0 : 32) + (pp & 15) + 16 * e; }
    if (n < 1792) return n;
    if (n < 2304) { const int r = n - 1792; return 1792 + (r & 1) * 256 + (r >> 1); }
    return n;
}
namespace pg8 {
#define PG8_LAS __attribute__((address_space(3)))
typedef unsigned short bf16_t;
typedef short bf16x8 __attribute__((ext_vector_type(8)));
typedef float f32x4 __attribute__((ext_vector_type(4)));
typedef unsigned u32x4 __attribute__((ext_vector_type(4)));
constexpr int BM = 256, BK = 64, HALF = 128, HTB = HALF * BK * 2  , STAGE_BYTES = 8 * HTB, NXCD = 8, WGM = 8;

__host__ __device__ __forceinline__ int lds_byte(int r, int c) { const int st = (r >> 4) * 2 + (c >> 5), rr = r & 15, cc = c & 31, ob = rr * 64 + cc * 2; return st * 1024 + (ob ^ (((ob >> 9) & 1) << 5)); }
__host__ __device__ __forceinline__ void stage_rc(int b, int& R, int& C) { const int st = b / 1024, sb = b % 1024, swz = sb ^ (((sb >> 9) & 1) << 5); R = (st >> 1) * 16 + swz / 64; C = (st & 1) * 32 + (swz % 64) / 2; }
__host__ __device__ __forceinline__ int perm32(int rho) { const int n = rho >> 4, i = rho & 15; return 8 * (i >> 2) + 4 * n + (i & 3); }

struct Unit { int pm, pn; };
struct Gemm { const bf16_t* A; const bf16_t* Bt; int M, N, K; };

struct StaticOrder {
    int nM, nN, nwg, G, c;
    __host__ __device__ void init(int M, int N, int G_, int c_) { nM = M / BM; nN = N / BM; nwg = nM * nN; G = G_; c = c_; }
    __host__ __device__ bool next(int i, Unit& u) const {
        const long L = (long)i * G + c; if (L >= nwg) return false;
        int wgid = (int)L; { const int q = nwg / NXCD, r = nwg % NXCD, xcd = wgid % NXCD, off = wgid / NXCD; wgid = (xcd < r ? xcd * (q + 1) : r * (q + 1) + (xcd - r) * q) + off; }
        const int nig = WGM * nN, gid = wgid / nig, fm = gid * WGM, gsz = (nM - fm) < WGM ? (nM - fm) : WGM;
        u.pm = fm + ((wgid % nig) % gsz); u.pn = (wgid % nig) / gsz; return true;
    }
    __device__ __forceinline__ void a_ready(const Unit&) const {}
    __device__ __forceinline__ void done(const Unit&) const {}
};
__device__ __forceinline__ unsigned cvt_pk_bf16(float lo, float hi) { return cvt2bf(lo, hi); }
typedef float f32x2 __attribute__((ext_vector_type(2)));
__device__ __forceinline__ f32x2 gelu_pk(f32x2 v) {
    const f32x2 av = __builtin_elementwise_abs(v), d = av * 0.2316418882f + 1.0f;
    f32x2 t; t.x = __builtin_amdgcn_rcpf(d.x); t.y = __builtin_amdgcn_rcpf(d.y);
    f32x2 q = t * 0.5307027145f + (-0.7265760135f); q = q * t + 0.7107068705f; q = q * t + (-0.142248368f); q = q * t + 0.127414796f; q = q * t;
    const f32x2 s = (v * v) * (-0.72134752044f);
    f32x2 e; e.x = __builtin_amdgcn_exp2f(s.x); e.y = __builtin_amdgcn_exp2f(s.y);
    const f32x2 m = v * (q * e), r = v - m;
    f32x2 o; o.x = v.x < 0.f ? m.x : r.x; o.y = v.y < 0.f ? m.y : r.y; return o;
}

typedef unsigned u32x2 __attribute__((ext_vector_type(2)));
__device__ __forceinline__ u32x4 pack8(const f32x4 a, const f32x4 b) { u32x4 w; w.x = cvt_pk_bf16(a[0], a[1]); w.y = cvt_pk_bf16(a[2], a[3]); w.z = cvt_pk_bf16(b[0], b[1]); w.w = cvt_pk_bf16(b[2], b[3]); return w; }

struct EpiIn {
    static constexpr bool PERM = true, AFTER_DRAIN = false, RESCALE = false;
    bf16_t *UF, *ZG, *UP, *Q, *K, *V; unsigned char* G; const float* rope;
    __device__ __forceinline__ void operator()(const f32x4 (&acc)[2][2][4][2], const Unit& u, int wr, int wc, int fr, int fq) const {
        const int pm = u.pm, pn = u.pn; const bool lat = pm < 64; const int R0 = pm * 256;
        const int kv0 = lat ? ((pm >> 5) * 8448 + 256 + ((pm & 31) << 8)) : ((pm - 64) * 8448);
        const int rl = wr * 64 + fr, cl = wc * 32 + 8 * fq;
        if (pn == 0 || pn == 9) {
            bf16_t* dst = (pn == 0 ? UF : UP);
#pragma unroll
            for (int ai = 0; ai < 2; ++ai)
#pragma unroll
                for (int m = 0; m < 4; ++m) { const int rr = ai * 128 + m * 16 + rl;
#pragma unroll
                    for (int bj = 0; bj < 2; ++bj) *(u32x4*)(dst + (size_t)(R0 + rr) * 256 + bj * 128 + cl) = pack8(acc[ai][bj][m][0], acc[ai][bj][m][1]); }
        } else if (pn <= 4) {
            const bool isq = pn <= 2; bf16_t* dst = isq ? Q : K; const int rowbase = isq ? R0 : kv0, colbase = (isq ? pn - 1 : pn - 3) * 256; const float sc = isq ? 0.125f : 1.0f;
#pragma unroll
            for (int ai = 0; ai < 2; ++ai)
#pragma unroll
                for (int m = 0; m < 4; ++m) { const int rr = ai * 128 + m * 16 + rl;
                    f32x4 cs = {1.f, 1.f, 1.f, 1.f}, sn = {0.f, 0.f, 0.f, 0.f};
                    if (lat) { const int t = (R0 & 8191) + rr; const int pos = (wc & 1) ? 128 + (t & 63) : (t >> 6);
                        cs = *(const f32x4*)(rope + pos * 32 + 4 * fq); sn = *(const f32x4*)(rope + pos * 32 + 16 + 4 * fq); }
                    cs = cs * sc; sn = sn * sc;
#pragma unroll
                    for (int bj = 0; bj < 2; ++bj) { const f32x4 a = acc[ai][bj][m][0], b = acc[ai][bj][m][1]; f32x4 oa, ob;
                        oa[0] = a[0] * cs[0] - a[1] * sn[0]; oa[1] = a[1] * cs[0] + a[0] * sn[0]; oa[2] = a[2] * cs[1] - a[3] * sn[1]; oa[3] = a[3] * cs[1] + a[2] * sn[1];
                        ob[0] = b[0] * cs[2] - b[1] * sn[2]; ob[1] = b[1] * cs[2] + b[0] * sn[2]; ob[2] = b[2] * cs[3] - b[3] * sn[3]; ob[3] = b[3] * cs[3] + b[2] * sn[3];
                        *(u32x4*)(dst + (size_t)(rowbase + rr) * 512 + colbase + bj * 128 + cl) = pack8(oa, ob); } }
        } else if (pn <= 6) {
#pragma unroll
            for (int ai = 0; ai < 2; ++ai)
#pragma unroll
                for (int m = 0; m < 4; ++m) { const int rr = ai * 128 + m * 16 + rl;
#pragma unroll
                    for (int bj = 0; bj < 2; ++bj) *(u32x4*)(V + (size_t)(kv0 + rr) * 512 + (pn - 5) * 256 + bj * 128 + cl) = pack8(acc[ai][bj][m][0], acc[ai][bj][m][1]); }
        } else if (pn <= 8) {
#pragma unroll
            for (int ai = 0; ai < 2; ++ai)
#pragma unroll
                for (int m = 0; m < 4; ++m) { const int rr = ai * 128 + m * 16 + rl;
#pragma unroll
                    for (int bj = 0; bj < 2; ++bj) { const f32x4 a = acc[ai][bj][m][0], b = acc[ai][bj][m][1];
                        u32x2 w; w.x = cvt_pk_bf16(a[0] * sigm(a[1]), a[2] * sigm(a[3])); w.y = cvt_pk_bf16(b[0] * sigm(b[1]), b[2] * sigm(b[3]));
                        *(u32x2*)(ZG + (size_t)(R0 + rr) * 256 + (pn - 7) * 128 + bj * 64 + (cl >> 1)) = w; } }
        } else {
#pragma unroll
            for (int ai = 0; ai < 2; ++ai)
#pragma unroll
                for (int m = 0; m < 4; ++m) { const int rr = ai * 128 + m * 16 + rl;
#pragma unroll
                    for (int bj = 0; bj < 2; ++bj) { u32x2 w;
#pragma unroll
                        for (int n = 0; n < 2; ++n) { const f32x4 a = acc[ai][bj][m][n]; unsigned q = 0;
#pragma unroll
                            for (int j = 0; j < 4; ++j) { float s = sigm(a[j]) * 255.0f + 0.5f; s = s < 1.0f ? 1.0f : s; q |= ((unsigned)s) << (8 * j); }
                            if (n == 0) w.x = q; else w.y = q; }
                        *(u32x2*)(G + (size_t)(R0 + rr) * 4096 + (pn - 10) * 256 + bj * 128 + cl) = w; } }
        }
    }
};

struct EpiBf {
    static constexpr bool PERM = true, AFTER_DRAIN = false, RESCALE = false;
    bf16_t* O; int ldc;
    __device__ __forceinline__ void operator()(const f32x4 (&acc)[2][2][4][2], const Unit& u, int wr, int wc, int fr, int fq) const {
        const int row0 = u.pm * 256 + wr * 64 + fr, col0 = u.pn * 256 + wc * 32 + 8 * fq;
#pragma unroll
        for (int ai = 0; ai < 2; ++ai)
#pragma unroll
            for (int m = 0; m < 4; ++m)
#pragma unroll
                for (int bj = 0; bj < 2; ++bj) *(u32x4*)(O + (size_t)(row0 + ai * 128 + m * 16) * ldc + col0 + bj * 128) = pack8(acc[ai][bj][m][0], acc[ai][bj][m][1]);
    }
};

struct EpiRes {
    static constexpr bool PERM = false, AFTER_DRAIN = false, RESCALE = false;
    const float* base_lat; const float* base_ctx; float* out_lat; float* out_ctx; const float* mod; int goff;
    __device__ __forceinline__ void operator()(const f32x4 (&acc)[2][2][4][2], const Unit& u, int wr, int wc, int fr, int fq) const {
        const int pm = u.pm; const bool lat = pm < 64; const int mrow = lat ? (pm >> 5) : 2;
        const float* base = lat ? base_lat + (size_t)pm * 256 * 1024 : base_ctx + (size_t)(pm - 64) * 256 * 1024;
        float* out = lat ? out_lat + (size_t)pm * 256 * 1024 : out_ctx + (size_t)(pm - 64) * 256 * 1024;
        const int col0 = u.pn * 256 + wc * 32 + 4 * fq;
        f32x4 gv[2][2];
#pragma unroll
        for (int bj = 0; bj < 2; ++bj)
#pragma unroll
            for (int n = 0; n < 2; ++n) gv[bj][n] = *(const f32x4*)(mod + mrow * 6144 + goff + col0 + bj * 128 + n * 16);
#pragma unroll
        for (int ai = 0; ai < 2; ++ai)
#pragma unroll
            for (int m = 0; m < 4; ++m) { const size_t ro = (size_t)(ai * 128 + wr * 64 + m * 16 + fr) * 1024 + col0;
#pragma unroll
                for (int bj = 0; bj < 2; ++bj)
#pragma unroll
                    for (int n = 0; n < 2; ++n) { const size_t off = ro + bj * 128 + n * 16; const f32x4 b = *(const f32x4*)(base + off); *(f32x4*)(out + off) = b + gv[bj][n] * acc[ai][bj][m][n]; } }
    }
};

struct EpiVal {
    static constexpr bool PERM = true, AFTER_DRAIN = false, RESCALE = false;
    const bf16_t* GT; bf16_t* H; const float* dww; const float* dwb;
    __device__ __forceinline__ void operator()(const f32x4 (&acc)[2][2][4][2], const Unit& u, int wr, int wc, int fr, int fq) const {
        const int pm = u.pm; const bool lat = pm < 64; const int R0 = pm * 256, t0 = lat ? (R0 & 8191) : 0, L = lat ? 8192 : 256;
        const int rl = wr * 64 + fr;
#pragma unroll
        for (int bj = 0; bj < 2; ++bj) { const int col = u.pn * 256 + bj * 128 + wc * 32 + 8 * fq;
            f32x4 w0[2], w1[2], w2[2], bb[2];
#pragma unroll
            for (int n = 0; n < 2; ++n) { w0[n] = *(const f32x4*)(dww + col + 4 * n); w1[n] = *(const f32x4*)(dww + 2816 + col + 4 * n); w2[n] = *(const f32x4*)(dww + 5632 + col + 4 * n); bb[n] = *(const f32x4*)(dwb + col + 4 * n); }
#pragma unroll
            for (int ai = 0; ai < 2; ++ai)
#pragma unroll
                for (int m = 0; m < 4; ++m) { const int rr = ai * 128 + m * 16 + rl, t = t0 + rr; const bf16_t* gp = GT + (size_t)(R0 + rr) * 2816 + col;
                    u32x4 gm = {0u, 0u, 0u, 0u}, gq = {0u, 0u, 0u, 0u}; const u32x4 g0 = *(const u32x4*)gp;
                    if (t > 0) gm = *(const u32x4*)(gp - 2816);
                    if (t < L - 1) gq = *(const u32x4*)(gp + 2816);
                    f32x4 o[2];
#pragma unroll
                    for (int n = 0; n < 2; ++n) { f32x4 c;
#pragma unroll
                        for (int j = 0; j < 4; ++j) { const int e = 4 * n + j; const unsigned wm = gm[e >> 1], wz = g0[e >> 1], wp = gq[e >> 1];
                            const float xm = (e & 1) ? __uint_as_float(wm & 0xffff0000u) : __uint_as_float(wm << 16), xz = (e & 1) ? __uint_as_float(wz & 0xffff0000u) : __uint_as_float(wz << 16),
                                        xp = (e & 1) ? __uint_as_float(wp & 0xffff0000u) : __uint_as_float(wp << 16);
                            c[j] = w0[n][j] * xm + w1[n][j] * xz + w2[n][j] * xp + bb[n][j]; }
                        const f32x2 ga = gelu_pk((f32x2){c[0], c[1]}), gb = gelu_pk((f32x2){c[2], c[3]});
                        const f32x4 v = acc[ai][bj][m][n]; o[n] = (f32x4){v[0] * ga.x, v[1] * ga.y, v[2] * gb.x, v[3] * gb.y}; }
                    *(u32x4*)(H + (size_t)(R0 + rr) * 2816 + col) = pack8(o[0], o[1]); }
        }
    }
};

struct EpiBranch {
    static constexpr bool PERM = true, AFTER_DRAIN = false, RESCALE = true;
    const unsigned char* G; bf16_t* Y;
    __device__ __forceinline__ void rescale(f32x4 (&acc)[2][2][4][2], const Unit& u, int t, int wr, int wc, int fr, int fq) const {
        const int bp = (t == 4) ? 0 : (t == 12) ? 1 : 2;
        const __amdgpu_buffer_rsrc_t rs = __builtin_amdgcn_make_buffer_rsrc((void*)G, 0, MT * 4096, 0x00020000);
        const int voff = (u.pm * 256 + wr * 64 + fr) * 4096 + u.pn * 256 + wc * 32 + 8 * fq;
#pragma unroll
        for (int ai = 0; ai < 2; ++ai)
#pragma unroll
            for (int m = 0; m < 4; ++m) {
#pragma unroll
                for (int bj = 0; bj < 2; ++bj) { const int so = (ai * 128 + m * 16) * 4096 + bj * 128 + bp * 1024;
                    const u32x2 p = __builtin_bit_cast(u32x2, __builtin_amdgcn_raw_buffer_load_b64(rs, voff, so, 0)), q = __builtin_bit_cast(u32x2, __builtin_amdgcn_raw_buffer_load_b64(rs, voff, so + 1024, 0));
#pragma unroll
                    for (int n = 0; n < 2; ++n) { const unsigned pw = n ? p.y : p.x, qw = n ? q.y : q.x;
#pragma unroll
                        for (int j = 0; j < 4; ++j) acc[ai][bj][m][n][j] *= (float)((pw >> (8 * j)) & 255u) * __builtin_amdgcn_rcpf((float)((qw >> (8 * j)) & 255u)); } }
                asm volatile("" ::: "memory"); }
    }
    __device__ __forceinline__ void operator()(const f32x4 (&acc)[2][2][4][2], const Unit& u, int wr, int wc, int fr, int fq) const {
        const int row0 = u.pm * 256 + wr * 64 + fr, col0 = u.pn * 256 + wc * 32 + 8 * fq;
#pragma unroll
        for (int ai = 0; ai < 2; ++ai)
#pragma unroll
            for (int m = 0; m < 4; ++m)
#pragma unroll
                for (int bj = 0; bj < 2; ++bj) { const size_t r = (size_t)(row0 + ai * 128 + m * 16); const u32x2 p = *(const u32x2*)(G + r * 4096 + 3072 + col0 + bj * 128);
                    f32x4 o[2];
#pragma unroll
                    for (int n = 0; n < 2; ++n) { const unsigned pw = n ? p.y : p.x;
#pragma unroll
                        for (int j = 0; j < 4; ++j) o[n][j] = acc[ai][bj][m][n][j] * ((float)((pw >> (8 * j)) & 255u) * (1.0f / 255.0f)); }
                    *(u32x4*)(Y + r * 1024 + col0 + bj * 128) = pack8(o[0], o[1]); }
    }
};

template <class Epi, class Sched, bool ALIGN_EPI = false, bool SP2 = false>
__device__ __forceinline__ void gemm_phase(PG8_LAS unsigned char* lds, const Gemm g, const Sched& S, const Epi& E, const int tid) {
    const int wid = __builtin_amdgcn_readfirstlane(tid >> 6), lane = tid & 63, wr = wid >> 2, wc = wid & 3, fr = lane & 15, fq = lane >> 4;
    const int K = g.K, nt = K / BK;
    unsigned voffA[2], voffB[2];
#pragma unroll
    for (int i = 0; i < 2; ++i) { int R, C; stage_rc(tid * 16 + i * 8192, R, C); const int Rb = Epi::PERM ? ((R & ~31) + perm32(R & 31)) : R;
        voffA[i] = (unsigned)(R * K + C) * 2u; voffB[i] = (unsigned)(Rb * K + C) * 2u; }
    const size_t kstep = (size_t)(BK * 2);
    const size_t hstep = (size_t)HALF * K * 2;
    const size_t tstep = 2 * hstep;
    const unsigned ldsw = (unsigned)wid * 1024u;
    const int aoff = lds_byte(wr * 64 + fr, fq * 8), boff = lds_byte(wc * 32 + fr, fq * 8);
#define PG8_SA(b, h) (((b) * 2 + (h)) * HTB)
#define PG8_SB(b, h) ((4 + (b) * 2 + (h)) * HTB)
#define PG8_STAGE(bufoff, gbase, voff) do { _Pragma("unroll") for (int _i = 0; _i < 2; ++_i) \
        __builtin_amdgcn_global_load_lds((const unsigned*)((const char*)(gbase) + (voff)[_i]), (PG8_LAS unsigned*)(lds + (bufoff) + ldsw + _i * 8192), 16, 0, 0); } while (0)
#define PG8_LDA(dst, b, h) do { _Pragma("unroll") for (int m = 0; m < 4; ++m) _Pragma("unroll") for (int k = 0; k < 2; ++k) dst[m][k] = *(const PG8_LAS bf16x8*)(lds + PG8_SA(b, h) + aoff + m * 2048 + k * 1024); } while (0)
#define PG8_LDB(dst, b, h) do { _Pragma("unroll") for (int n = 0; n < 2; ++n) _Pragma("unroll") for (int k = 0; k < 2; ++k) dst[n][k] = *(const PG8_LAS bf16x8*)(lds + PG8_SB(b, h) + boff + n * 2048 + k * 1024); } while (0)
#define PG8_MMA(ai, bj, At, Bt) do { __builtin_amdgcn_s_setprio(1); _Pragma("unroll") for (int m = 0; m < 4; ++m) _Pragma("unroll") for (int n = 0; n < 2; ++n) _Pragma("unroll") for (int k = 0; k < 2; ++k) \
        acc[ai][bj][m][n] = __builtin_amdgcn_mfma_f32_16x16x32_bf16(Bt[n][k], At[m][k], acc[ai][bj][m][n], 0, 0, 0); __builtin_amdgcn_s_setprio(0); } while (0)
#define PG8_WAIT_V(n) asm volatile("s_waitcnt vmcnt(" #n ")" ::: "memory")
#define PG8_WAIT_L(n) asm volatile("s_waitcnt lgkmcnt(" #n ")" ::: "memory")
#define PG8_BAR __builtin_amdgcn_s_barrier()
#define PG8_SCHED __builtin_amdgcn_sched_barrier(0)
    Unit cur, nxt; int ui = 0;
    if (!S.next(0, cur)) return;
    f32x4 acc[2][2][4][2];
#pragma unroll
    for (int a = 0; a < 2; ++a)
#pragma unroll
        for (int b = 0; b < 2; ++b)
#pragma unroll
            for (int m = 0; m < 4; ++m)
#pragma unroll
                for (int n = 0; n < 2; ++n) acc[a][b][m][n] = (f32x4){0.f, 0.f, 0.f, 0.f};
    bf16x8 At[4][2], B0[2][2], B1[2][2];
    const char* cA = (const char*)g.A + (size_t)cur.pm * tstep; const char* cB = (const char*)g.Bt + (size_t)cur.pn * tstep;
    S.a_ready(cur);
    if constexpr (SP2) {
        PG8_STAGE(PG8_SB(0, 0), cB, voffB); PG8_STAGE(PG8_SB(0, 1), cB + hstep, voffB); PG8_STAGE(PG8_SA(0, 0), cA, voffA); PG8_STAGE(PG8_SA(0, 1), cA + hstep, voffA);
        if (wr == 1) PG8_BAR;
        PG8_WAIT_V(2); PG8_BAR;
        PG8_STAGE(PG8_SB(1, 0), cB + kstep, voffB); PG8_STAGE(PG8_SA(1, 0), cA + kstep, voffA); PG8_STAGE(PG8_SB(1, 1), cB + hstep + kstep, voffB);
        PG8_WAIT_V(6); PG8_BAR;
    } else {
        PG8_STAGE(PG8_SB(0, 0), cB, voffB); PG8_STAGE(PG8_SA(0, 0), cA, voffA); PG8_STAGE(PG8_SB(0, 1), cB + hstep, voffB); PG8_STAGE(PG8_SA(0, 1), cA + hstep, voffA);
        if (wr == 1) PG8_BAR;
        PG8_WAIT_V(4); PG8_BAR;
        PG8_STAGE(PG8_SB(1, 0), cB + kstep, voffB); PG8_STAGE(PG8_SA(1, 0), cA + kstep, voffA); PG8_STAGE(PG8_SB(1, 1), cB + hstep + kstep, voffB);
        PG8_WAIT_V(6); PG8_BAR;
    }
    for (;;) {
        const bool has_next = S.next(ui + 1, nxt);
        const char* nA = has_next ? (const char*)g.A + (size_t)nxt.pm * tstep : cA; const char* nB = has_next ? (const char*)g.Bt + (size_t)nxt.pn * tstep : cB;
        for (int t = 0; t < nt; t += 2) {
            if constexpr (Epi::RESCALE) { if (t == 4 || t == 12 || t == 16) E.rescale(acc, cur, t, wr, wc, fr, fq); }
            const bool last = (t == nt - 2);
            const char* a1 = cA + (size_t)(t + 1) * kstep;
            const char* a2 = last ? nA : cA + (size_t)(t + 2) * kstep; const char* b2 = last ? nB : cB + (size_t)(t + 2) * kstep;
            const char* a3 = a2 + kstep; const char* b3 = b2 + kstep;
            if (last && has_next) S.a_ready(nxt);
            if constexpr (SP2) {
            PG8_LDB(B0, 0, 0); PG8_LDB(B1, 0, 1); PG8_SCHED; PG8_LDA(At, 0, 0); PG8_STAGE(PG8_SA(1, 1), a1 + hstep, voffA);
            PG8_WAIT_V(8); PG8_WAIT_L(0); PG8_BAR; PG8_MMA(0, 0, At, B0); PG8_MMA(0, 1, At, B1); PG8_BAR; PG8_SCHED;
            PG8_LDA(At, 0, 1); PG8_STAGE(PG8_SB(0, 0), b2, voffB); PG8_STAGE(PG8_SB(0, 1), b2 + hstep, voffB); PG8_STAGE(PG8_SA(0, 0), a2, voffA);
            PG8_WAIT_V(8); PG8_WAIT_L(0); PG8_BAR; PG8_MMA(1, 0, At, B0); PG8_MMA(1, 1, At, B1); PG8_BAR; PG8_SCHED;
            PG8_LDB(B0, 1, 0); PG8_LDB(B1, 1, 1); PG8_SCHED; PG8_LDA(At, 1, 0); PG8_STAGE(PG8_SA(0, 1), a2 + hstep, voffA);
            PG8_WAIT_V(8); PG8_WAIT_L(0); PG8_BAR; PG8_MMA(0, 0, At, B0); PG8_MMA(0, 1, At, B1); PG8_BAR; PG8_SCHED;
            PG8_LDA(At, 1, 1); PG8_STAGE(PG8_SB(1, 0), b3, voffB); PG8_STAGE(PG8_SB(1, 1), b3 + hstep, voffB); PG8_STAGE(PG8_SA(1, 0), a3, voffA);
            PG8_WAIT_V(8); PG8_WAIT_L(0); PG8_BAR; PG8_MMA(1, 0, At, B0); PG8_MMA(1, 1, At, B1); PG8_BAR; PG8_SCHED;
            } else {
            PG8_LDB(B0, 0, 0); PG8_SCHED; PG8_LDA(At, 0, 0); PG8_STAGE(PG8_SA(1, 1), a1 + hstep, voffA);
            PG8_WAIT_L(8); PG8_BAR; PG8_WAIT_L(0); PG8_MMA(0, 0, At, B0); PG8_BAR; PG8_SCHED;
            PG8_LDB(B1, 0, 1); PG8_STAGE(PG8_SB(0, 0), b2, voffB);
            PG8_BAR; PG8_WAIT_L(0); PG8_MMA(0, 1, At, B1); PG8_BAR;
            PG8_LDA(At, 0, 1); PG8_STAGE(PG8_SA(0, 0), a2, voffA);
            PG8_BAR; PG8_WAIT_L(0); PG8_MMA(1, 0, At, B0); PG8_BAR; PG8_SCHED;
            PG8_STAGE(PG8_SB(0, 1), b2 + hstep, voffB);
            PG8_WAIT_V(6); PG8_BAR; PG8_MMA(1, 1, At, B1); PG8_BAR;
            PG8_LDB(B0, 1, 0); PG8_SCHED; PG8_LDA(At, 1, 0); PG8_STAGE(PG8_SA(0, 1), a2 + hstep, voffA);
            PG8_WAIT_L(8); PG8_BAR; PG8_WAIT_L(0); PG8_MMA(0, 0, At, B0); PG8_BAR; PG8_SCHED;
            PG8_LDB(B1, 1, 1); PG8_STAGE(PG8_SB(1, 0), b3, voffB);
            PG8_BAR; PG8_WAIT_L(0); PG8_MMA(0, 1, At, B1); PG8_BAR;
            PG8_LDA(At, 1, 1); PG8_STAGE(PG8_SA(1, 0), a3, voffA);
            PG8_BAR; PG8_WAIT_L(0); PG8_MMA(1, 0, At, B0); PG8_BAR; PG8_SCHED;
            PG8_STAGE(PG8_SB(1, 1), b3 + hstep, voffB);
            PG8_WAIT_V(6); PG8_BAR; PG8_MMA(1, 1, At, B1); PG8_BAR;
            }
        }
        if constexpr (ALIGN_EPI) { if (wr == 0) PG8_BAR; }
        if constexpr (!Epi::AFTER_DRAIN) { E(acc, cur, wr, wc, fr, fq); S.done(cur); }
        if (!has_next) break;
#pragma unroll
        for (int a = 0; a < 2; ++a)
#pragma unroll
            for (int b = 0; b < 2; ++b)
#pragma unroll
                for (int m = 0; m < 4; ++m)
#pragma unroll
                    for (int n = 0; n < 2; ++n) acc[a][b][m][n] = (f32x4){0.f, 0.f, 0.f, 0.f};
        cur = nxt; cA = nA; cB = nB; ++ui;
        if constexpr (ALIGN_EPI) { if (wr == 1) PG8_BAR; }
    }
    PG8_WAIT_V(0);
    if constexpr (!ALIGN_EPI) { if (wr == 0) PG8_BAR; }
    PG8_BAR;
    if constexpr (Epi::AFTER_DRAIN) { E.fused(acc, cur, wr, wc, fr, fq, lds, wid, lane); S.done(cur); }
#undef PG8_SA
#undef PG8_SB
#undef PG8_STAGE
#undef PG8_LDA
#undef PG8_LDB
#undef PG8_MMA
#undef PG8_WAIT_V
#undef PG8_WAIT_L
#undef PG8_BAR
#undef PG8_SCHED
}
}
namespace att {
constexpr int NW = 8, QBLK = 32, KVBLK = 64, LDQ = 512, LDO = KCAT;
constexpr int SHM_V = 16384, SHM_K = 16384, SHM_ATTN = 2 * SHM_V + 2 * SHM_K + NW * 64 * 4;
constexpr float THR = 8.f;
#ifndef ATT_SDEPTH
#define ATT_SDEPTH 1
#endif
constexpr int SDEPTH = ATT_SDEPTH;
#define KSWZ(row, colB) ((row) * 256 + ((colB) ^ (((row) & 7) << 4)))
#define SBAR() __builtin_amdgcn_sched_barrier(0)
__device__ __forceinline__ int crow(int r, int hi) { return (r & 3) + 8 * (r >> 2) + 4 * hi; }
__device__ __forceinline__ unsigned cvtpk(float lo, float hi) { return cvt2bf(lo, hi); }

__device__ __forceinline__ void partialSM(f32x16& p0, f32x16& p1, float& m_reg, float& mn, float& alpha) {
  constexpr float C = 1.4426950408889634f;
  float pmax = p0[0];
#pragma unroll
  for (int r = 1; r < 16; ++r) pmax = fmaxf(pmax, p0[r]);
#pragma unroll
  for (int r = 0; r < 16; ++r) pmax = fmaxf(pmax, p1[r]);
  { auto rr = __builtin_amdgcn_permlane32_swap(__float_as_uint(pmax), __float_as_uint(pmax), false, false);
    pmax = fmaxf(__uint_as_float(rr[0]), __uint_as_float(rr[1])); }
  if (__builtin_expect(__all(pmax - m_reg <= THR), 1)) { mn = m_reg; alpha = 1.f; }
  else { mn = fmaxf(m_reg, pmax); alpha = __builtin_amdgcn_exp2f((m_reg - mn) * C); m_reg = mn; }
  const float mnC = -mn * C;
#pragma unroll
  for (int r = 0; r < 16; ++r) p0[r] = fmaf(p0[r], C, mnC);
#pragma unroll
  for (int r = 0; r < 16; ++r) p1[r] = fmaf(p1[r], C, mnC);
#pragma unroll
  for (int r = 0; r < 16; ++r) p0[r] = __builtin_amdgcn_exp2f(p0[r]);
}
__device__ __forceinline__ void finishSM(f32x16& p0, f32x16& p1, float alpha, float& l_reg, bf16x8& pa0, bf16x8& pa1, bf16x8& pa2, bf16x8& pa3) {
#pragma unroll
  for (int r = 0; r < 16; ++r) p1[r] = __builtin_amdgcn_exp2f(p1[r]);
  float ps = 0;
#pragma unroll
  for (int r = 0; r < 16; ++r) ps += p0[r];
#pragma unroll
  for (int r = 0; r < 16; ++r) ps += p1[r];
  { auto rr = __builtin_amdgcn_permlane32_swap(__float_as_uint(ps), __float_as_uint(ps), false, false);
    ps = __uint_as_float(rr[0]) + __uint_as_float(rr[1]); }
  l_reg = l_reg * alpha + ps;
#define PK4(P, BASE, OUT) do { unsigned a0 = cvtpk(P[BASE + 0], P[BASE + 1]), a1 = cvtpk(P[BASE + 2], P[BASE + 3]);   \
    unsigned b0 = cvtpk(P[BASE + 4], P[BASE + 5]), b1 = cvtpk(P[BASE + 6], P[BASE + 7]);                              \
    auto r0 = __builtin_amdgcn_permlane32_swap(a0, b0, false, false); auto r1 = __builtin_amdgcn_permlane32_swap(a1, b1, false, false); \
    u32x4 w = {r0[0], r1[0], r0[1], r1[1]}; OUT = *reinterpret_cast<bf16x8*>(&w); } while (0)
  PK4(p0, 0, pa0); PK4(p0, 8, pa1); PK4(p1, 0, pa2); PK4(p1, 8, pa3);
#undef PK4
}
__device__ __forceinline__ void qkt(f32x16& p0, f32x16& p1, const char* Ks, const bf16x8* qr, int r32, int hi, int kcol) {
  p0 = f32x16{}; p1 = f32x16{};
#pragma unroll
  for (int d0 = 0; d0 < 4; ++d0) { const int cb = kcol + (d0 * 16 + hi * 8) * 2;
    const bf16x8 b0 = *reinterpret_cast<const bf16x8*>(Ks + KSWZ(r32, cb));
    const bf16x8 b1 = *reinterpret_cast<const bf16x8*>(Ks + KSWZ(32 + r32, cb));
    p0 = __builtin_amdgcn_mfma_f32_32x32x16_bf16(b0, qr[d0], p0, 0, 0, 0);
    p1 = __builtin_amdgcn_mfma_f32_32x32x16_bf16(b1, qr[d0], p1, 0, 0, 0); }
}
__device__ __forceinline__ int v_st(int k, int c) { const int kk = (k & ~0xC) | ((k & 4) << 1) | ((k & 8) >> 1); return ((kk >> 3) * 4 + (c >> 5)) * 512 + ((kk & 7) * 32 + (c & 31)) * 2; }
__device__ __forceinline__ int v_rd_base(int lane) { return ((lane & 3) << 3) | (((lane >> 2) & 3) << 6) | (((lane >> 4) & 1) << 5) | (((lane >> 5) & 1) << 8); }
constexpr int v_rd_off(int d0, int ks, int half) { return d0 * 512 + ks * 4096 + half * 2048; }
template <int OFF> __device__ __forceinline__ s16x4 tr_read(int vb) {
  s16x4 r; asm volatile("ds_read_b64_tr_b16 %0, %1 offset:%2" : "=&v"(r) : "v"(vb), "i"(OFF) : "memory"); return r;
}
template <int D0> __device__ __forceinline__ void pv_one(f32x16& od, int vb, bf16x8 pa0, bf16x8 pa1, bf16x8 pa2, bf16x8 pa3) {
  const s16x4 l0 = tr_read<v_rd_off(D0, 0, 0)>(vb), h0 = tr_read<v_rd_off(D0, 0, 1)>(vb), l1 = tr_read<v_rd_off(D0, 1, 0)>(vb), h1 = tr_read<v_rd_off(D0, 1, 1)>(vb);
  const s16x4 l2 = tr_read<v_rd_off(D0, 2, 0)>(vb), h2 = tr_read<v_rd_off(D0, 2, 1)>(vb), l3 = tr_read<v_rd_off(D0, 3, 0)>(vb), h3 = tr_read<v_rd_off(D0, 3, 1)>(vb);
  asm volatile("s_waitcnt lgkmcnt(0)" ::: "memory"); SBAR();
#define PK(L, H) (bf16x8){L[0], L[1], L[2], L[3], H[0], H[1], H[2], H[3]}
  od = __builtin_amdgcn_mfma_f32_32x32x16_bf16(pa0, PK(l0, h0), od, 0, 0, 0);
  od = __builtin_amdgcn_mfma_f32_32x32x16_bf16(pa1, PK(l1, h1), od, 0, 0, 0);
  od = __builtin_amdgcn_mfma_f32_32x32x16_bf16(pa2, PK(l2, h2), od, 0, 0, 0);
  od = __builtin_amdgcn_mfma_f32_32x32x16_bf16(pa3, PK(l3, h3), od, 0, 0, 0);
#undef PK
}
__device__ __forceinline__ void pv_d0(f32x16* o, int vb, bf16x8 pa0, bf16x8 pa1, bf16x8 pa2, bf16x8 pa3) {
  pv_one<0>(o[0], vb, pa0, pa1, pa2, pa3); pv_one<1>(o[1], vb, pa0, pa1, pa2, pa3); pv_one<2>(o[2], vb, pa0, pa1, pa2, pa3); pv_one<3>(o[3], vb, pa0, pa1, pa2, pa3);
}

__device__ __forceinline__ void attn_unit(const bf16_t* __restrict__ Qb, const bf16_t* __restrict__ Kh, const bf16_t* __restrict__ Vh, int nkeys,
                                          bf16_t* __restrict__ Ob, float lam, float osc, const float* __restrict__ sg, char* lds, const int tid) {
  const int wid = __builtin_amdgcn_readfirstlane(tid >> 6), lane = tid & 63, r32 = lane & 31, hi = lane >> 5;
  const int comp = wid >> 2, qw = wid & 3, kcol = comp * 128;
  char* V_lds = lds; char* K_lds = lds + 2 * SHM_V;
  float* ws = (float*)(lds + 2 * SHM_V + 2 * SHM_K) + wid * 64; float* li_l = ws; float* al_l = ws + 32;
  float m_reg = -1e30f, l_reg = 0; f32x16 o[4] = {}; bf16x8 qr[4];
  const bf16_t* Qw = Qb + (long)(qw * QBLK + r32) * LDQ + comp * 64 + hi * 8;
#pragma unroll
  for (int d0 = 0; d0 < 4; ++d0) qr[d0] = *reinterpret_cast<const bf16x8*>(Qw + d0 * 16);
  const int sr = tid >> 4, sc = (tid & 15) * 8, vst0 = v_st(sr, sc), vst1 = v_st(32 + sr, sc);
  const int vb0 = (int)(uintptr_t)V_lds + v_rd_base(lane);
  struct { bf16x8 vs0, vs1, ks0, ks1; } sr_[SDEPTH];
#define SLOAD(i, k0) do { sr_[i].vs0 = *reinterpret_cast<const bf16x8*>(&Vh[(long)((k0) + sr) * LDQ + sc]); sr_[i].vs1 = *reinterpret_cast<const bf16x8*>(&Vh[(long)((k0) + 32 + sr) * LDQ + sc]); \
    sr_[i].ks0 = *reinterpret_cast<const bf16x8*>(&Kh[(long)((k0) + sr) * LDQ + sc]); sr_[i].ks1 = *reinterpret_cast<const bf16x8*>(&Kh[(long)((k0) + 32 + sr) * LDQ + sc]); } while (0)
#define SWRITE(b, i) do { *(bf16x8*)(V_lds + (b) * SHM_V + vst0) = sr_[i].vs0;          \
    *(bf16x8*)(V_lds + (b) * SHM_V + vst1) = sr_[i].vs1; const int kc = sc * 2;               \
    *(bf16x8*)(K_lds + (b) * SHM_K + KSWZ(sr, kc)) = sr_[i].ks0;                       \
    *(bf16x8*)(K_lds + (b) * SHM_K + KSWZ(32 + sr, kc)) = sr_[i].ks1; } while (0)
#define SWAIT() do { if constexpr (SDEPTH == 2) asm volatile("s_waitcnt vmcnt(4)" ::: "memory"); else asm volatile("s_waitcnt vmcnt(0)" ::: "memory"); } while (0)
#define RESC(a) do { if (__any((a) < 1.f)) { if (hi == 0) al_l[r32] = (a); asm volatile("s_waitcnt lgkmcnt(0)" ::: "memory"); \
    _Pragma("unroll") for (int d = 0; d < 4; ++d) _Pragma("unroll") for (int r = 0; r < 16; ++r) o[d][r] *= al_l[crow(r, hi)]; } } while (0)
  f32x16 pA0, pA1, pB0, pB1; float mnA, mnB, alA, alB; bf16x8 pa0, pa1, pa2, pa3; const int NT = nkeys / KVBLK;
  constexpr int SE = 0, SO = SDEPTH - 1;
  SLOAD(SE, 0); asm volatile("s_waitcnt vmcnt(0)" ::: "memory"); SWRITE(0, SE); __syncthreads();
  qkt(pA0, pA1, K_lds, qr, r32, hi, kcol); partialSM(pA0, pA1, m_reg, mnA, alA);
  SLOAD(SO, KVBLK); if constexpr (SDEPTH == 2) { if (2 < NT) SLOAD(SE, 2 * KVBLK); }
  SWAIT(); SWRITE(1, SO); __syncthreads();
  for (int j = 1; j + 1 < NT; j += 2) {
    SBAR(); qkt(pB0, pB1, K_lds + SHM_K, qr, r32, hi, kcol);
    finishSM(pA0, pA1, alA, l_reg, pa0, pa1, pa2, pa3); SBAR();
    SLOAD(SO, (j + SDEPTH) * KVBLK); SBAR();
    pv_d0(o, vb0, pa0, pa1, pa2, pa3); partialSM(pB0, pB1, m_reg, mnB, alB);
    __syncthreads(); SWAIT(); SWRITE(0, SE);
    RESC(alB); __syncthreads();
    SBAR(); qkt(pA0, pA1, K_lds, qr, r32, hi, kcol);
    finishSM(pB0, pB1, alB, l_reg, pa0, pa1, pa2, pa3); SBAR();
    if (SDEPTH == 1 || j + 3 < NT) SLOAD(SE, (j + 1 + SDEPTH) * KVBLK); SBAR();
    pv_d0(o, vb0 + SHM_V, pa0, pa1, pa2, pa3); partialSM(pA0, pA1, m_reg, mnA, alA);
    __syncthreads(); SWAIT(); SWRITE(1, SO);
    RESC(alA); __syncthreads();
  }
  SBAR(); qkt(pB0, pB1, K_lds + SHM_K, qr, r32, hi, kcol);
  finishSM(pA0, pA1, alA, l_reg, pa0, pa1, pa2, pa3); SBAR();
  pv_d0(o, vb0, pa0, pa1, pa2, pa3); partialSM(pB0, pB1, m_reg, mnB, alB);
  __syncthreads(); RESC(alB);
  finishSM(pB0, pB1, alB, l_reg, pa0, pa1, pa2, pa3); SBAR();
  pv_d0(o, vb0 + SHM_V, pa0, pa1, pa2, pa3);
  if (hi == 0) li_l[r32] = l_reg; asm volatile("s_waitcnt lgkmcnt(0)" ::: "memory");
  float rli[16];
#pragma unroll
  for (int r = 0; r < 16; ++r) rli[r] = __builtin_amdgcn_rcpf(li_l[crow(r, hi)]);
  __syncthreads();
  float* XO = (float*)lds + qw * (32 * 128);
  if (comp == 1) {
#pragma unroll
    for (int r = 0; r < 16; ++r)
#pragma unroll
      for (int d0 = 0; d0 < 4; ++d0) XO[crow(r, hi) * 128 + d0 * 32 + r32] = o[d0][r] * rli[r];
  }
  __syncthreads();
  if (comp == 0) {
    float ss[16];
#pragma unroll
    for (int r = 0; r < 16; ++r) { float s = 0.f;
#pragma unroll
      for (int d0 = 0; d0 < 4; ++d0) { const float v = o[d0][r] * rli[r] - lam * XO[crow(r, hi) * 128 + d0 * 32 + r32]; o[d0][r] = v; s += v * v; }
      ss[r] = s; }
#pragma unroll
    for (int r = 0; r < 16; ++r) { float s = ss[r]; s += __shfl_xor(s, 1); s += __shfl_xor(s, 2); s += __shfl_xor(s, 4); s += __shfl_xor(s, 8); s += __shfl_xor(s, 16);
      ss[r] = osc / sqrtf(s * (1.0f / 128.0f) + EPS); }
    float gam[4];
#pragma unroll
    for (int d0 = 0; d0 < 4; ++d0) gam[d0] = sg[d0 * 32 + r32];
    asm volatile("s_waitcnt lgkmcnt(0)" ::: "memory");
    bf16_t* stg = (bf16_t*)XO;
#pragma unroll
    for (int r = 0; r < 16; ++r)
#pragma unroll
      for (int d0 = 0; d0 < 4; ++d0) stg[crow(r, hi) * 128 + d0 * 32 + r32] = (bf16_t)(cvtpk(o[d0][r] * ss[r] * gam[d0], 0.f) & 0xffffu);
    asm volatile("s_waitcnt lgkmcnt(0)" ::: "memory");
#pragma unroll
    for (int i = 0; i < 8; ++i) { const int row = i * 4 + (lane >> 4), ch = lane & 15; const u32x4 v = *(const u32x4*)(stg + row * 128 + ch * 8);
      *(u32x4*)(Ob + (long)(qw * QBLK + row) * LDO + ch * 8) = v; }
  }
  __syncthreads();
#undef SLOAD
#undef SWRITE
#undef SWAIT
#undef RESC
}
#undef KSWZ
#undef SBAR
}
typedef GAS unsigned gu32;
#define RLX_AGENT __ATOMIC_RELAXED, __HIP_MEMORY_SCOPE_AGENT
constexpr int PT_OFF = LDSCTL_OFF + 1024;
__device__ __forceinline__ unsigned long long ldptr(volatile LAS unsigned long long* PT, int i) {
    const unsigned long long v = PT[i];
    const unsigned lo = __builtin_amdgcn_readfirstlane((unsigned)v), hi = __builtin_amdgcn_readfirstlane((unsigned)(v >> 32));
    return ((unsigned long long)hi << 32) | lo;
}
#define XB_TMO      128
#define XB_XCNT(j)  (256  + 64 * (j))
#define XB_XSUB(j)  (1280 + 64 * (j))
#define XB_XGEN(j)  (2304 + 64 * (j))
#define XB_TOP      3328
#define XB_TOPGEN   3392
#define XCD_BAR_WORDS 3456
#define XB_SPIN_CAP (1u << 18)

__device__ __forceinline__ unsigned xb_ld(unsigned* p)              { return __hip_atomic_load(p, __ATOMIC_RELAXED, __HIP_MEMORY_SCOPE_AGENT); }
__device__ __forceinline__ unsigned xb_add(unsigned* p, unsigned v) { return __hip_atomic_fetch_add(p, v, __ATOMIC_RELAXED, __HIP_MEMORY_SCOPE_AGENT); }
__device__ __forceinline__ unsigned xb_xcc_id() { return (unsigned)__builtin_amdgcn_s_getreg((3 << 11) | 20) & 0xFu; }
#define XB_SPIN(cond, bar) do { unsigned _sp = 0; while (cond) { __builtin_amdgcn_s_sleep(1); \
    if ((++_sp & 255u) == 0u) { if (xb_ld(&(bar)[XB_TMO])) break; if (_sp > XB_SPIN_CAP) { atomicAdd(&(bar)[XB_TMO], 1u); break; } } } } while (0)

struct XcdBarrier {
    unsigned* bar; unsigned x;
    volatile LAS unsigned* st;
};

__device__ __forceinline__ XcdBarrier xcd_barrier_post(unsigned* bar, volatile LAS unsigned* st) {
    XcdBarrier b; b.bar = bar; b.x = xb_xcc_id(); b.st = st;
    if (threadIdx.x == 0) (void)xb_add(&bar[XB_XCNT(b.x)], 1u);
    return b;
}
__device__ __forceinline__ void xcd_barrier_complete(unsigned* bar, unsigned x, unsigned& nloc, unsigned& nx) {
    const unsigned G = gridDim.x * gridDim.y * gridDim.z;
    unsigned sum, cnt, mine, sp = 0u;
    for (;;) {
        sum = 0u; cnt = 0u; mine = 0u;
#pragma unroll
        for (unsigned j = 0; j < 16; ++j) { const unsigned c = xb_ld(&bar[XB_XCNT(j)]); sum += c; cnt += (c > 0u) ? 1u : 0u; mine = (j == x) ? c : mine; }
        if (sum == G) break;
        __builtin_amdgcn_s_sleep(1);
        if ((++sp & 255u) == 0u) { if (xb_ld(&bar[XB_TMO])) break; if (sp > XB_SPIN_CAP) { atomicAdd(&bar[XB_TMO], 1u); break; } }
    }
    nloc = mine > 0u ? mine : 1u; nx = cnt > 0u ? cnt : 1u;
}

__device__ __forceinline__ void xcd_barrier(const XcdBarrier& b) {
    asm volatile("s_waitcnt vmcnt(0)" ::: "memory");
    __syncthreads();
    if (threadIdx.x == 0) {
        unsigned* bar = b.bar;
        __builtin_amdgcn_s_waitcnt(0);
        unsigned nloc = b.st[0], nx = b.st[1];
        if (nloc == 0u) { xcd_barrier_complete(bar, b.x, nloc, nx); b.st[0] = nloc; b.st[1] = nx; }
        const unsigned old = xb_add(&bar[XB_XSUB(b.x)], 1u);
        const unsigned gen = old / nloc;
        if (old + 1u == (gen + 1u) * nloc) {
            __builtin_amdgcn_fence(__ATOMIC_RELEASE, "agent");
            asm volatile("s_waitcnt vmcnt(0)" ::: "memory");
            const unsigned og = xb_add(&bar[XB_TOP], 1u);
            const unsigned tg = og / nx;
            if (og + 1u == (tg + 1u) * nx) xb_add(&bar[XB_TOPGEN], 1u);
            else XB_SPIN(xb_ld(&bar[XB_TOPGEN]) == tg, bar);
            __builtin_amdgcn_fence(__ATOMIC_ACQUIRE, "agent");
            xb_add(&bar[XB_XGEN(b.x)], 1u);
            asm volatile("s_waitcnt vmcnt(0)" ::: "memory");
        } else {
            XB_SPIN(xb_ld(&bar[XB_XGEN(b.x)]) == gen, bar);
            __builtin_amdgcn_fence(__ATOMIC_ACQUIRE, "agent");
            asm volatile("s_waitcnt vmcnt(0)" ::: "memory");
        }
    }
    __syncthreads();
}
__device__ __forceinline__ float wave_sum(float v) {
#pragma unroll
    for (int o = 1; o < 64; o <<= 1) v += __shfl_xor(v, o);
    return v;
}
__device__ __forceinline__ unsigned pk2(float lo, float hi) { return cvt2bf(lo, hi); }

template <int MAP  >
__device__ __forceinline__ void transpose_item(const float* W, int Nsrc, int coff, bf16_t* WT, int ldw, int koff, int nblk, LAS float* scr, int item, int lane) {
    const int kb = item / nblk, nb = item % nblk, k0 = 64 * kb, n0 = 32 * nb;
    const int nd = n0 + (lane & 31); const int scol = MAP ? in_map(nd) : nd + coff;
#pragma unroll 8
    for (int i = 0; i < 32; ++i) { const int kk = 2 * i + (lane >> 5); scr[kk * 33 + (lane & 31)] = W[(size_t)(k0 + kk) * Nsrc + scol]; }
    asm volatile("s_waitcnt lgkmcnt(0)" ::: "memory");
    const int c = lane & 7;
#pragma unroll
    for (int j = 0; j < 4; ++j) { const int n = (lane >> 3) + 8 * j; const LAS float* s = scr + (8 * c) * 33 + n;
        u32x4 o; o.x = pk2(s[0 * 33], s[1 * 33]); o.y = pk2(s[2 * 33], s[3 * 33]); o.z = pk2(s[4 * 33], s[5 * 33]); o.w = pk2(s[6 * 33], s[7 * 33]);
        *(u32x4*)(WT + (size_t)(n0 + n) * ldw + koff + k0 + 8 * c) = o; }
    asm volatile("s_waitcnt lgkmcnt(0)" ::: "memory");
}
struct WSrc { const float *w_in, *wo_f, *wo_a, *wo_c, *wo_p, *w_out, *w_up, *w_down; };
constexpr int IT_A = 16 * 208;
constexpr int IT_B0 = 4 * 32, IT_B1 = 8 * 32, IT_B2 = 4 * 32, IT_B3 = 4 * 32, IT_B4 = 16 * 32, IT_B5 = 16 * 88, IT_B6 = 16 * 88, IT_B7 = 44 * 32;
constexpr int IT_B = IT_B0 + IT_B1 + IT_B2 + IT_B3 + IT_B4 + IT_B5 + IT_B6 + IT_B7;
__device__ __forceinline__ void convert_A(const WSrc& S, unsigned char* ws, LAS float* scr, int gw, int NGW, int lane) {
    for (int it = gw; it < IT_A; it += NGW) transpose_item<1>(S.w_in, NIN, 0, (bf16_t*)(ws + WS_WA), 1024, 0, 208, scr, it, lane);
}
__device__ __forceinline__ void convert_B(const WSrc& S, unsigned char* ws, LAS float* scr, int gw, int NGW, int lane) {
    for (int it = gw; it < IT_B; it += NGW) { int r = it;
        if (r < IT_B0) { transpose_item<0>(S.wo_f, 1024, 0, (bf16_t*)(ws + WS_WCAT), KCAT, 0, 32, scr, r, lane); continue; } r -= IT_B0;
        if (r < IT_B1) { transpose_item<0>(S.wo_a, 1024, 0, (bf16_t*)(ws + WS_WCAT), KCAT, 256, 32, scr, r, lane); continue; } r -= IT_B1;
        if (r < IT_B2) { transpose_item<0>(S.wo_c, 1024, 0, (bf16_t*)(ws + WS_WCAT), KCAT, 768, 32, scr, r, lane); continue; } r -= IT_B2;
        if (r < IT_B3) { transpose_item<0>(S.wo_p, 1024, 0, (bf16_t*)(ws + WS_WCAT), KCAT, 1024, 32, scr, r, lane); continue; } r -= IT_B3;
        if (r < IT_B4) { transpose_item<0>(S.w_out, 1024, 0, (bf16_t*)(ws + WS_WOUT), 1024, 0, 32, scr, r, lane); continue; } r -= IT_B4;
        if (r < IT_B5) { transpose_item<0>(S.w_up, 2 * DFF, DFF, (bf16_t*)(ws + WS_WUPG), 1024, 0, 88, scr, r, lane); continue; } r -= IT_B5;
        if (r < IT_B6) { transpose_item<0>(S.w_up, 2 * DFF, 0, (bf16_t*)(ws + WS_WUPV), 1024, 0, 88, scr, r, lane); continue; } r -= IT_B6;
        transpose_item<0>(S.w_down, 1024, 0, (bf16_t*)(ws + WS_WDN), DFF, 0, 32, scr, r, lane);
    }
}

__device__ __forceinline__ void mod_phase(const float* c, const float* c_ctx, const float* ada_w, const float* ada_b, float* MOD, LAS unsigned char* lds, int vcu, int G, int tid, int wave, int lane) {
    LAS float* sil = (LAS float*)lds;
    LAS float* red = (LAS float*)(lds + 12288);
    for (int i = tid; i < 3072; i += 512) { const float v = i < 2048 ? c[i] : c_ctx[i - 2048]; sil[i] = v * sigm(v); }
    __syncthreads();
    for (int item = vcu; item < 192; item += G) {
        const int l = item / 96, n = (item % 96) * 64 + lane;
        const float* W = ada_w + (size_t)l * 1024 * 6144 + n;
        float a0 = 0.f, a1 = 0.f, a2 = 0.f;
        for (int k = wave * 128; k < wave * 128 + 128; k += 8) { float w[8];
#pragma unroll
            for (int i = 0; i < 8; ++i) w[i] = W[(size_t)(k + i) * 6144];
#pragma unroll
            for (int i = 0; i < 8; ++i) { a0 += sil[k + i] * w[i]; a1 += sil[1024 + k + i] * w[i]; a2 += sil[2048 + k + i] * w[i]; } }
        red[(wave * 3 + 0) * 64 + lane] = a0; red[(wave * 3 + 1) * 64 + lane] = a1; red[(wave * 3 + 2) * 64 + lane] = a2;
        __syncthreads();
        if (wave < 3) { float s = ada_b[l * 6144 + n];
#pragma unroll
            for (int w = 0; w < 8; ++w) s += red[(w * 3 + wave) * 64 + lane];
            MOD[(size_t)(l * 3 + wave) * 6144 + n] = s; }
        __syncthreads();
    }
}
__device__ __forceinline__ void tables_phase(float* ROPE, f32x2* TW, int gt, int NGT) {
    for (int i = gt; i < 192 * 16; i += NGT) { const int pos = i >> 4, f = i & 15; const float inv = powf(10000.0f, -(float)f / 16.0f); const float ang = (float)(pos < 128 ? pos : pos - 128) * inv;
        float s, c; sincosf(ang, &s, &c); ROPE[pos * 32 + f] = c; ROPE[pos * 32 + 16 + f] = s; }
    for (int i = gt; i < 8192; i += NGT) { float s, c; sincospif((float)i * (1.0f / 4096.0f), &s, &c); TW[i] = (f32x2){c, -s}; }
}

__device__ __forceinline__ void norm_phase(const float* src_lat, const float* src_ctx, int nrows, const float* gamma, const float* mod, int shoff, int scoff, bf16_t* HX, int gw, int NGW, int lane) {
    for (int m = gw; m < nrows; m += NGW) {
        const float* xr = m < ML ? src_lat + (size_t)m * DM : src_ctx + (size_t)(m - ML) * DM;
        const float* md = mod + (m < SEQ ? 0 : m < ML ? 1 : 2) * 6144;
        f32x4 v[4]; float s = 0.f;
#pragma unroll
        for (int j = 0; j < 4; ++j) { v[j] = ((const f32x4*)xr)[lane + 64 * j]; s += (v[j].x * v[j].x + v[j].y * v[j].y) + (v[j].z * v[j].z + v[j].w * v[j].w); }
        const float rstd = 1.0f / sqrtf(wave_sum(s) * (1.0f / DM) + EPS);
#pragma unroll
        for (int j = 0; j < 4; ++j) { const int col = 4 * lane + 256 * j;
            const f32x4 g = *(const f32x4*)(gamma + col), sc = *(const f32x4*)(md + scoff + col), sh = *(const f32x4*)(md + shoff + col);
            const f32x4 o = v[j] * rstd * g * (sc + 1.0f) + sh;
            u32x2 w; w.x = pk2(o.x, o.y); w.y = pk2(o.z, o.w); *(u32x2*)(HX + (size_t)m * DM + col) = w; }
    }
}
__device__ __forceinline__ void final_norm_phase(float* x, const float* gamma, int gw, int NGW, int lane) {
    for (int m = gw; m < ML; m += NGW) { f32x4* xr = (f32x4*)(x + (size_t)m * DM);
        f32x4 v[4]; float s = 0.f;
#pragma unroll
        for (int j = 0; j < 4; ++j) { v[j] = xr[lane + 64 * j]; s += (v[j].x * v[j].x + v[j].y * v[j].y) + (v[j].z * v[j].z + v[j].w * v[j].w); }
        const float rstd = 1.0f / sqrtf(wave_sum(s) * (1.0f / DM) + EPS);
#pragma unroll
        for (int j = 0; j < 4; ++j) { const f32x4 g = *(const f32x4*)(gamma + 4 * lane + 256 * j); xr[lane + 64 * j] = v[j] * rstd * g; }
    }
}

#define SWZ(row, colB) ((row) * 256 + ((colB) ^ (((row) & 7) << 4)))
__device__ __forceinline__ int crow_(int r, int hi) { return (r & 3) + 8 * (r >> 2) + 4 * hi; }
__device__ __forceinline__ bf16x8 pack_bf8(const float* v) { u32x4 w; w.x = pk2(v[0], v[1]); w.y = pk2(v[2], v[3]); w.z = pk2(v[4], v[5]); w.w = pk2(v[6], v[7]); return __builtin_bit_cast(bf16x8, w); }
__device__ __forceinline__ void fft1_phase(const bf16_t* UF, const f32x2* TW, unsigned* FA, LAS unsigned char* lds, int vcu, int G, int tid, int wave, int lane) {
    const int tr = wave >> 1, tc = wave & 1, r32 = lane & 31, hi = lane >> 5;
    bf16x8 aRe[8], aIm[8];
#pragma unroll
    for (int ks = 0; ks < 8; ++ks) { float cv[8], sv[8];
#pragma unroll
        for (int j = 0; j < 8; ++j) { const int idx = ((32 * tr + r32) * (16 * ks + 8 * hi + j)) & 127; float s, c; sincospif((float)idx * (1.0f / 64.0f), &s, &c); cv[j] = c; sv[j] = -s; }
        aRe[ks] = pack_bf8(cv); aIm[ks] = pack_bf8(sv); }
    for (int item = vcu; item < 512; item += G) {
        const int b = item >> 8, g = (item >> 6) & 3, l2 = item & 63;
#pragma unroll
        for (int i = 0; i < 2; ++i) { const int q = tid + 512 * i, l1 = q >> 3, c8 = (q & 7) * 8;
            const u32x4 v = *(const u32x4*)(UF + (size_t)(b * SEQ + 64 * l1 + l2) * 256 + g * 64 + c8);
#pragma unroll
            for (int e = 0; e < 8; ++e) { const unsigned w = v[e >> 1]; *(LAS bf16_t*)(lds + SWZ(c8 + e, l1 * 2)) = (bf16_t)((e & 1) ? (w >> 16) : (w & 0xffffu)); } }
        __syncthreads();
        f32x16 re = {}, im = {};
#pragma unroll
        for (int ks = 0; ks < 8; ++ks) { const bf16x8 bx = *(const LAS bf16x8*)(lds + SWZ(32 * tc + r32, (16 * ks + 8 * hi) * 2));
            re = __builtin_amdgcn_mfma_f32_32x32x16_bf16(aRe[ks], bx, re, 0, 0, 0); im = __builtin_amdgcn_mfma_f32_32x32x16_bf16(aIm[ks], bx, im, 0, 0, 0); }
        unsigned* dst = FA + ((size_t)((b * 4 + g) * 64 + l2) * 128) * 64 + 32 * tc + r32;
#pragma unroll
        for (int r = 0; r < 16; ++r) { const int k1 = 32 * tr + crow_(r, hi); const f32x2 t = TW[k1 * l2];
            dst[(size_t)k1 * 64] = pk2(re[r] * t.x - im[r] * t.y, re[r] * t.y + im[r] * t.x); }
        __syncthreads();
    }
}
__device__ __forceinline__ void fft2_phase(const unsigned* FA, bf16_t* ACAT, LAS unsigned char* lds, int vcu, int G, int tid, int wave, int lane) {
    const int tr = wave >> 1, tc = wave & 1, r32 = lane & 31, hi = lane >> 5;
    bf16x8 a2[8], b3[8];
#pragma unroll
    for (int ks = 0; ks < 8; ++ks) { float av[8], bv[8];
#pragma unroll
        for (int j = 0; j < 8; ++j) { const int R = 32 * tr + r32, k = 16 * ks + 8 * hi + j, k2 = R & 63, ll = k & 63; float s, c; sincospif((float)((k2 * ll) & 63) * (1.0f / 32.0f), &s, &c);
            av[j] = (R < 64) ? ((k < 64) ? c : s) : ((k < 64) ? -s : c);
            const int m = 32 * tc + r32; float s2, c2; sincospif((float)((m * ll) & 63) * (1.0f / 32.0f), &s2, &c2); bv[j] = (k < 64) ? c2 : s2; }
        a2[ks] = pack_bf8(av); b3[ks] = pack_bf8(bv); }
    LAS unsigned char* Bt = lds;
    LAS unsigned char* Zt = lds + 16384;
    for (int item = vcu; item < 1024; item += G) {
        const int b = item >> 9, g = (item >> 7) & 3, k1 = item & 127;
#pragma unroll
        for (int i = 0; i < 2; ++i) { const int q = tid + 512 * i, l2 = q >> 4, c4 = (q & 15) * 4;
            const u32x4 v = *(const u32x4*)(FA + ((size_t)((b * 4 + g) * 64 + l2) * 128 + k1) * 64 + c4);
#pragma unroll
            for (int e = 0; e < 4; ++e) { *(LAS bf16_t*)(Bt + SWZ(c4 + e, l2 * 2)) = (bf16_t)(v[e] & 0xffffu); *(LAS bf16_t*)(Bt + SWZ(c4 + e, (64 + l2) * 2)) = (bf16_t)(v[e] >> 16); } }
        __syncthreads();
        f32x16 z = {};
#pragma unroll
        for (int ks = 0; ks < 8; ++ks) { const bf16x8 bx = *(const LAS bf16x8*)(Bt + SWZ(32 * tc + r32, (16 * ks + 8 * hi) * 2)); z = __builtin_amdgcn_mfma_f32_32x32x16_bf16(a2[ks], bx, z, 0, 0, 0); }
#pragma unroll
        for (int r = 0; r < 16; ++r) { const int R = 32 * tr + crow_(r, hi); *(LAS bf16_t*)(Zt + SWZ(R & 63, ((R >> 6) * 64 + 32 * tc + r32) * 2)) = (bf16_t)(pk2(z[r], 0.f) & 0xffffu); }
        __syncthreads();
        if (wave < 4) { f32x16 y = {};
#pragma unroll
            for (int ks = 0; ks < 8; ++ks) { const bf16x8 ax = *(const LAS bf16x8*)(Zt + SWZ(32 * tr + r32, (16 * ks + 8 * hi) * 2)); y = __builtin_amdgcn_mfma_f32_32x32x16_bf16(ax, b3[ks], y, 0, 0, 0); }
#pragma unroll
            for (int r = 0; r < 16; ++r) { const int k2 = 32 * tr + crow_(r, hi); ACAT[(size_t)(b * SEQ + k1 + 128 * k2) * KCAT + g * 64 + 32 * tc + r32] = (bf16_t)(pk2(y[r] * 0.001381067932f, 0.f) & 0xffffu); } }
        __syncthreads();
    }
}
__device__ __forceinline__ void ctxdft_item(int item, const bf16_t* UF, bf16_t* ACAT, LAS unsigned char* lds, int tid, int wave, int lane) {
    const int b = item >> 4, g = (item >> 2) & 3, kc = item & 3;
    LAS float* xs = (LAS float*)lds; LAS f32x2* Zs = (LAS f32x2*)(lds + 65536); LAS f32x2* w256 = (LAS f32x2*)(lds + 98304); LAS f32x2* w64 = (LAS f32x2*)(lds + 98304 + 2048);
    for (int i = tid; i < 256 * 64; i += 512) { const int l = i >> 6, c = i & 63; xs[i] = bf2f(UF[(size_t)(ML + b * CTXL + l) * 256 + g * 64 + c]); }
    if (tid < 256) { float s, c; sincospif((float)tid * (1.0f / 128.0f), &s, &c); w256[tid] = (f32x2){c, s}; }
    if (tid < 64) { float s, c; sincospif((float)tid * (1.0f / 32.0f), &s, &c); w64[tid] = (f32x2){c, s}; }
    __syncthreads();
    float zr[8], zi[8];
#pragma unroll
    for (int j = 0; j < 8; ++j) { zr[j] = 0.f; zi[j] = 0.f; }
    const int kb = 64 * kc + wave * 8;
    for (int l = 0; l < 256; ++l) { const float x = xs[l * 64 + lane];
#pragma unroll
        for (int j = 0; j < 8; ++j) { const f32x2 cs = w256[((kb + j) * l) & 255]; zr[j] += x * cs.x; zi[j] -= x * cs.y; } }
#pragma unroll
    for (int j = 0; j < 8; ++j) Zs[(wave * 8 + j) * 64 + lane] = (f32x2){zr[j], zi[j]};
    __syncthreads();
    float y[8];
#pragma unroll
    for (int j = 0; j < 8; ++j) y[j] = 0.f;
    for (int c = 0; c < 64; ++c) { const f32x2 cs = w64[(lane * c) & 63];
#pragma unroll
        for (int j = 0; j < 8; ++j) { const f32x2 z = Zs[(wave * 8 + j) * 64 + c]; y[j] += z.x * cs.x + z.y * cs.y; } }
#pragma unroll
    for (int j = 0; j < 8; ++j) ACAT[(size_t)(ML + b * CTXL + kb + j) * KCAT + g * 64 + lane] = (bf16_t)(pk2(y[j] * (1.0f / 128.0f), 0.f) & 0xffffu);
    __syncthreads();
}

__device__ __forceinline__ void conv_item(int item, const bf16_t* ZG, const float* cw  , const float* cb, const float* lng, const float* lnb, bf16_t* ACAT, LAS unsigned char* lds, int tid, int wave, int lane) {
    const int row0 = item * 64; const bool lat = row0 < ML; const int s0 = lat ? (row0 & ~(SEQ - 1)) : (ML + ((row0 - ML) & ~(CTXL - 1))), s1 = s0 + (lat ? SEQ : CTXL);
    LAS float* zt = (LAS float*)lds;
#pragma unroll
    for (int i = 0; i < 6; ++i) { const int q = tid + 512 * i; if (q < 94 * 32) { const int rr = q >> 5, c8 = (q & 31) * 8, gr = row0 - 15 + rr;
        u32x4 v = {0u, 0u, 0u, 0u}; if (gr >= s0 && gr < s1) v = *(const u32x4*)(ZG + (size_t)gr * 256 + c8);
        *(LAS f32x4*)(zt + rr * 256 + c8) = (f32x4){bf2f(v.x & 0xffffu), __uint_as_float(v.x & 0xffff0000u), bf2f(v.y & 0xffffu), __uint_as_float(v.y & 0xffff0000u)};
        *(LAS f32x4*)(zt + rr * 256 + c8 + 4) = (f32x4){bf2f(v.z & 0xffffu), __uint_as_float(v.z & 0xffff0000u), bf2f(v.w & 0xffffu), __uint_as_float(v.w & 0xffff0000u)}; } }
    const int c = tid & 255, half = tid >> 8;
    float w[31];
#pragma unroll
    for (int t = 0; t < 31; ++t) w[t] = cw[t * 256 + c];
    float acc[32]; const float bias = cb[c];
#pragma unroll
    for (int r = 0; r < 32; ++r) acc[r] = bias;
    __syncthreads();
#pragma unroll
    for (int rr = 0; rr < 62; ++rr) { const float v = zt[(half * 32 + rr) * 256 + c];
#pragma unroll
        for (int r = 0; r < 32; ++r) { if (rr - r >= 0 && rr - r < 31) acc[r] += w[rr - r] * v; } }
    __syncthreads();
#pragma unroll
    for (int r = 0; r < 32; ++r) zt[(half * 32 + r) * 256 + c] = acc[r];
    __syncthreads();
    const f32x4 gg = *(const f32x4*)(lng + 4 * lane), bb = *(const f32x4*)(lnb + 4 * lane);
#pragma unroll
    for (int i = 0; i < 8; ++i) { const int r = wave * 8 + i; const f32x4 v = *(const LAS f32x4*)(zt + r * 256 + 4 * lane);
        const float mu = wave_sum((v.x + v.y) + (v.z + v.w)) * (1.0f / 256.0f); const f32x4 d = v - mu;
        const float var = wave_sum((d.x * d.x + d.y * d.y) + (d.z * d.z + d.w * d.w)) * (1.0f / 256.0f); const float rs = 1.0f / sqrtf(var + EPS);
        f32x4 o = d * rs * gg + bb; o.x *= sigm(o.x); o.y *= sigm(o.y); o.z *= sigm(o.z); o.w *= sigm(o.w);
        u32x2 pw; pw.x = pk2(o.x, o.y); pw.y = pk2(o.z, o.w); *(u32x2*)(ACAT + (size_t)(row0 + r) * KCAT + 768 + 4 * lane) = pw; }
    __syncthreads();
}
__device__ __forceinline__ void pool_phase(const bf16_t* UP, const float* pw  , const float* psc, bf16_t* ACAT, int nitems, int first, LAS unsigned char* lds, int G, int tid, int wave, int lane) {
    const int g = wave >> 1, tc = wave & 1, r32 = lane & 31, hi = lane >> 5;
    bf16x8 bw[4];
#pragma unroll
    for (int ks = 0; ks < 4; ++ks) { float v[8];
#pragma unroll
        for (int j = 0; j < 8; ++j) v[j] = pw[g * 4096 + (16 * ks + 8 * hi + j) * 64 + 32 * tc + r32];
        bw[ks] = pack_bf8(v); }
    const float osc = psc[g * 64 + 32 * tc + r32];
    LAS float* ut = (LAS float*)lds;
    LAS unsigned char* dt = lds + 81920;
    for (int item = first; item < nitems; item += G) {
        const int row0 = item * 64; const bool lat = row0 < ML; const int s0 = lat ? (row0 & ~(SEQ - 1)) : (ML + ((row0 - ML) & ~(CTXL - 1))), L = lat ? SEQ : CTXL, s1 = s0 + L;
#pragma unroll
        for (int i = 0; i < 5; ++i) { const int q = tid + 512 * i, rr = q >> 5, c8 = (q & 31) * 8, gr = row0 - 8 + rr;
            u32x4 v = {0u, 0u, 0u, 0u}; if (gr >= s0 && gr < s1) v = *(const u32x4*)(UP + (size_t)gr * 256 + c8);
            *(LAS f32x4*)(ut + rr * 256 + c8) = (f32x4){bf2f(v.x & 0xffffu), __uint_as_float(v.x & 0xffff0000u), bf2f(v.y & 0xffffu), __uint_as_float(v.y & 0xffff0000u)};
            *(LAS f32x4*)(ut + rr * 256 + c8 + 4) = (f32x4){bf2f(v.z & 0xffffu), __uint_as_float(v.z & 0xffff0000u), bf2f(v.w & 0xffffu), __uint_as_float(v.w & 0xffff0000u)}; }
        __syncthreads();
#pragma unroll
        for (int i = 0; i < 4; ++i) { const int q = tid + 512 * i, lr = q >> 5, c8 = (q & 31) * 8, gg = c8 >> 6, hw = 1 << gg, tt = row0 + lr - s0;
            f32x4 sa = {0.f, 0.f, 0.f, 0.f}, sb = {0.f, 0.f, 0.f, 0.f};
            for (int o = -hw; o < hw; ++o) { sa += *(const LAS f32x4*)(ut + (lr + 8 + o) * 256 + c8); sb += *(const LAS f32x4*)(ut + (lr + 8 + o) * 256 + c8 + 4); }
            const int lo = tt - hw < 0 ? 0 : tt - hw, hh = tt + hw - 1 > L - 1 ? L - 1 : tt + hw - 1; const float inv = 1.0f / (float)(hh - lo + 1);
            const f32x4 ua = *(const LAS f32x4*)(ut + (lr + 8) * 256 + c8), ub = *(const LAS f32x4*)(ut + (lr + 8) * 256 + c8 + 4);
            const f32x4 da = sa * inv - ua, db = sb * inv - ub;
            u32x4 w; w.x = pk2(da.x, da.y); w.y = pk2(da.z, da.w); w.z = pk2(db.x, db.y); w.w = pk2(db.z, db.w);
            *(LAS u32x4*)(dt + lr * 512 + ((((c8 >> 3) ^ (lr & 7)) << 4))) = w; }
        __syncthreads();
#pragma unroll
        for (int rt = 0; rt < 2; ++rt) { f32x16 y = {};
#pragma unroll
            for (int ks = 0; ks < 4; ++ks) { const int row = 32 * rt + r32, ch = (g * 64 + 16 * ks + 8 * hi) >> 3;
                const bf16x8 ax = *(const LAS bf16x8*)(dt + row * 512 + ((ch ^ (row & 7)) << 4)); y = __builtin_amdgcn_mfma_f32_32x32x16_bf16(ax, bw[ks], y, 0, 0, 0); }
#pragma unroll
            for (int r = 0; r < 16; ++r) ACAT[(size_t)(row0 + 32 * rt + crow_(r, hi)) * KCAT + 1024 + g * 64 + 32 * tc + r32] = (bf16_t)(pk2(y[r] * osc, 0.f) & 0xffffu); }
        __syncthreads();
    }
}
constexpr int NPHASE = 22;
struct Args { const float* in[30]; float* out; unsigned char* ws; int ph_lo, ph_hi, li, pad; };
__global__ void __launch_bounds__(512, 2) fwd_kernel(Args args) {
    extern __shared__ __attribute__((aligned(16))) unsigned char lds[];
    LAS unsigned char* L = (LAS unsigned char*)lds;
    volatile LAS unsigned* MISC = (volatile LAS unsigned*)(L + MISC_OFF);
    const int tid0 = threadIdx.x;
    const int G = gridDim.x, bx0 = blockIdx.x, vcu0 = (G % 8 == 0) ? (bx0 % 8) * (G / 8) + bx0 / 8 : bx0;
    const int NGW = G * 8;
    gu32* ctl = (gu32*)(args.ws + WS_CTL);
    for (int u = tid0; u < (LDS_BYTES - LDSCTL_OFF) / 4; u += 512) ((LAS unsigned*)(L + LDSCTL_OFF))[u] = 0u;
    __syncthreads();
    volatile LAS unsigned long long* PT = (volatile LAS unsigned long long*)(L + PT_OFF);
    if (tid0 == 0) {
#define PTW(i) PT[i] = (unsigned long long)args.in[i];
        PTW(0) PTW(1) PTW(2) PTW(3) PTW(4) PTW(5) PTW(6) PTW(7) PTW(8) PTW(9) PTW(10) PTW(11) PTW(12) PTW(13) PTW(14) PTW(15) PTW(16) PTW(17) PTW(18) PTW(19)
        PTW(20) PTW(21) PTW(22) PTW(23) PTW(24) PTW(25) PTW(26) PTW(27) PTW(28) PTW(29)
#undef PTW
        PT[30] = (unsigned long long)args.out; PT[31] = (unsigned long long)args.ws;
    }
    __syncthreads();
#define FRESH() int tid = tid0, vcu = vcu0, bx = bx0; asm volatile("" : "+v"(tid), "+s"(vcu), "+s"(bx)); const int lane = tid & 63, wave = __builtin_amdgcn_readfirstlane(tid >> 6), gw = vcu * 8 + wave; (void)lane; (void)gw; (void)bx; \
    LAS float* scr = (LAS float*)(L + wave * 16384); (void)scr;
#define PTR(i) ((const float*)(const GAS float*)ldptr(PT, (i)))
#define OUTP ((float*)(GAS float*)ldptr(PT, 30))
#define WSP ((unsigned char*)(GAS unsigned char*)ldptr(PT, 31))
    XcdBarrier bar; bar.bar = (unsigned*)(ctl + CW_BAR) + args.li * XCD_BAR_WORDS; bar.x = 0; bar.st = nullptr;
    if (MK_N_LAUNCHES != NPHASE) bar = xcd_barrier_post((unsigned*)(ctl + CW_BAR) + args.li * XCD_BAR_WORDS, MISC + 8);
#define GRID_BAR() do { if (MK_N_LAUNCHES == NPHASE) { if (tid0 == 0) __hip_atomic_store(ctl + CW_TMO, 0xBADBA0u, RLX_AGENT); } else { xcd_barrier(bar); } } while (0)
    const int lo = args.ph_lo, hi = args.ph_hi;
#ifndef PHASE_MASK
#define PHASE_MASK 0xFFF
#endif
#ifndef ATTM
#define ATTM 3
#endif
#ifndef X1REP
#define X1REP 0
#endif
#ifndef X1M
#define X1M 31
#endif
#define PH_EN(kind) ((PHASE_MASK >> (kind)) & 1)
#ifndef REP_MASK
#define REP_MASK 0
#endif
#define NREP(kind) (((REP_MASK >> (kind)) & 1) ? 2 : 1)
#define IN(k) (lo <= (k) && (k) < hi)
#define BOTH(k) (IN(k) && IN((k) + 1))
#define WSRC(S, l) WSrc S; S.w_in = PTR(8) + (size_t)(l) * 1024 * NIN; S.wo_f = PTR(20) + (size_t)(l) * 256 * 1024; S.wo_a = PTR(21) + (size_t)(l) * 512 * 1024; \
    S.wo_c = PTR(22) + (size_t)(l) * 256 * 1024; S.wo_p = PTR(23) + (size_t)(l) * 256 * 1024; S.w_out = PTR(24) + (size_t)(l) * 1024 * 1024; \
    S.w_up = PTR(25) + (size_t)(l) * 1024 * 2 * DFF; S.w_down = PTR(28) + (size_t)(l) * DFF * 1024;
#define ws WSP
#define MOD ((float*)(WSP + WS_MOD))
#define ROPE ((float*)(WSP + WS_ROPE))
#define TW ((f32x2*)(WSP + WS_TW))
#define XC ((float*)(WSP + WS_XC))
#define HX ((bf16_t*)(WSP + WS_HX))
#define FA ((f32x2*)(WSP + WS_FA))
#define Qb ((bf16_t*)(WSP + WS_Q))
#define Kb ((bf16_t*)(WSP + WS_K))
#define Vb ((bf16_t*)(WSP + WS_V))
#define Yb ((bf16_t*)(WSP + WS_Y))
#define Gb (WSP + WS_G)
#define ACAT ((bf16_t*)(WSP + WS_ACAT))
#define UF ((bf16_t*)(WSP + WS_UF))
#define ZG ((bf16_t*)(WSP + WS_ZG))
#define UP ((bf16_t*)(WSP + WS_UP))
#define GT ((bf16_t*)(WSP + WS_GT))
#define Hb ((bf16_t*)(WSP + WS_H))

    for (int rep = 0; rep < NREP(0); ++rep) if (PH_EN(0) && IN(0)) { FRESH();
        mod_phase(PTR(1), PTR(3), PTR(6), PTR(7), MOD, L, vcu, G, tid, wave, lane);
        tables_phase(ROPE, TW, vcu * 512 + tid, G * 512);
        WSRC(S0, 0); convert_A(S0, ws, scr, gw, NGW, lane); convert_B(S0, ws, scr, gw, NGW, lane);
        if (BOTH(0)) GRID_BAR();
    }
#pragma nounroll
    for (int l = 0; l < 2; ++l) {
        const int pb = 1 + 10 * l;
#define mod (MOD + l * 3 * 6144)
#define xl ((l == 0) ? PTR(0) : (const float*)OUTP)
#define xc ((l == 0) ? PTR(2) : (const float*)XC)
        const int Mact = (l == 0) ? MT : ML;
        for (int rep = 0; rep < NREP(1); ++rep) if (PH_EN(1) && IN(pb)) { FRESH(); norm_phase(xl, xc, MT, PTR(4) + l * DM, mod, 0, 1024, HX, gw, NGW, lane); if (BOTH(pb)) GRID_BAR(); }
        for (int rep = 0; rep < NREP(2); ++rep) if (PH_EN(2) && IN(pb + 1)) { FRESH();
            pg8::Gemm g{HX, (const bf16_t*)(ws + WS_WA), MT, NIN, 1024}; pg8::StaticOrder S; S.init(MT, NIN, G, bx);
            pg8::EpiIn E{UF, ZG, UP, Qb, Kb, Vb, Gb, ROPE};
            pg8::gemm_phase<pg8::EpiIn, pg8::StaticOrder, true, true>(L, g, S, E, tid);
            if (BOTH(pb + 1)) GRID_BAR();
        }
        for (int rep = 0; rep < NREP(3); ++rep) if (PH_EN(3) && IN(pb + 2)) { FRESH();
            for (int r1 = 0; r1 < ((X1REP & 1) ? 2 : 1); ++r1) if (X1M & 1) fft1_phase(UF, TW, (unsigned*)FA, L, vcu, G, tid, wave, lane);
            for (int r1 = 0; r1 < ((X1REP & 2) ? 2 : 1); ++r1) if (X1M & 2) for (int it = vcu; it < Mact / 64; it += G) conv_item(it, ZG, PTR(14) + l * 31 * 256, PTR(15) + l * 256, PTR(16) + l * 256, PTR(17) + l * 256, ACAT, L, tid, wave, lane);
            for (int r1 = 0; r1 < ((X1REP & 4) ? 2 : 1); ++r1) if (X1M & 4) pool_phase(UP, PTR(18) + l * 4 * 4096, PTR(19) + l * 256, ACAT, Mact / 64, (vcu + 248) % G, L, G, tid, wave, lane);
            if ((X1M & 8) && l == 0) for (int it = (vcu + 224) % G; it < 32; it += G) ctxdft_item(it, UF, ACAT, L, tid, wave, lane);
            WSRC(S1, 1);
            for (int r1 = 0; r1 < ((X1REP & 16) ? 2 : 1); ++r1) if (!(X1M & 16)) {} else if (l == 0) convert_A(S1, ws, scr, gw, NGW, lane); else convert_B(S1, ws, scr, gw, NGW, lane);
            if (BOTH(pb + 2)) GRID_BAR();
        }
        for (int rep = 0; rep < NREP(4); ++rep) if (PH_EN(4) && IN(pb + 3)) { FRESH();
            if (ATTM & 1) fft2_phase((const unsigned*)FA, ACAT, L, vcu, G, tid, wave, lane);
            const float lam_init = (l == 0) ? 0.2f : 0.35550906759096926f;
            const float d1 = wave_sum(PTR(9)[l * 64 + lane] * PTR(10)[l * 64 + lane]), d2 = wave_sum(PTR(11)[l * 64 + lane] * PTR(12)[l * 64 + lane]);
            const float lam = __builtin_bit_cast(float, __builtin_amdgcn_readfirstlane(__builtin_bit_cast(int, expf(d1) - expf(d2) + lam_init)));
            const int nun = 512 + (l == 0 ? 16 : 0);
            if (ATTM & 2) for (int u = vcu; u < nun; u += G) {
                int b, h, row0, nkeys;
                if (u < 512) { const int x = (u & 255) >> 5, qb = (u & 31) + 32 * (u >> 8); b = x >> 2; h = x & 3; row0 = b * SEQ + qb * 128; nkeys = KVL; }
                else { const int v = u - 512; b = v >> 3; h = (v >> 1) & 3; row0 = ML + b * CTXL + (v & 1) * 128; nkeys = CTXL; }
                att::attn_unit(Qb + (size_t)row0 * 512 + h * 128, Kb + (size_t)b * KVL * 512 + h * 128, Vb + (size_t)b * KVL * 512 + h * 128, nkeys,
                               ACAT + (size_t)row0 * KCAT + 256 + h * 128, lam, 1.0f - lam_init, PTR(13) + l * 128, (char*)lds, tid);
            }
            if (BOTH(pb + 3)) GRID_BAR();
        }
        for (int rep = 0; rep < NREP(5); ++rep) if (PH_EN(5) && IN(pb + 4)) { FRESH();
            pg8::Gemm g{ACAT, (const bf16_t*)(ws + WS_WCAT), Mact, 1024, KCAT}; pg8::StaticOrder S; S.init(Mact, 1024, G, bx);
            pg8::EpiBranch E{Gb, Yb};
            pg8::gemm_phase<pg8::EpiBranch, pg8::StaticOrder, true, true>(L, g, S, E, tid);
            if (BOTH(pb + 4)) GRID_BAR();
        }
        for (int rep = 0; rep < (l == 0 ? NREP(6) : 1); ++rep) if (PH_EN(6) && IN(pb + 5)) { FRESH();
            pg8::Gemm g{Yb, (const bf16_t*)(ws + WS_WOUT), Mact, 1024, 1024}; pg8::StaticOrder S; S.init(Mact, 1024, G, bx);
            pg8::EpiRes E{xl, xc, OUTP, XC, mod, 2048};
            pg8::gemm_phase<pg8::EpiRes, pg8::StaticOrder, true, true>(L, g, S, E, tid);
            if (BOTH(pb + 5)) GRID_BAR();
        }
        for (int rep = 0; rep < NREP(7); ++rep) if (PH_EN(7) && IN(pb + 6)) { FRESH(); norm_phase(OUTP, XC, Mact, PTR(5) + l * DM, mod, 3072, 4096, HX, gw, NGW, lane); if (BOTH(pb + 6)) GRID_BAR(); }
        for (int rep = 0; rep < NREP(8); ++rep) if (PH_EN(8) && IN(pb + 7)) { FRESH();
            pg8::Gemm g{HX, (const bf16_t*)(ws + WS_WUPG), Mact, DFF, 1024}; pg8::StaticOrder S; S.init(Mact, DFF, G, bx);
            pg8::EpiBf E{GT, DFF};
            pg8::gemm_phase<pg8::EpiBf, pg8::StaticOrder, true, true>(L, g, S, E, tid);
            if (BOTH(pb + 7)) GRID_BAR();
        }
        for (int rep = 0; rep < NREP(9); ++rep) if (PH_EN(9) && IN(pb + 8)) { FRESH();
            pg8::Gemm g{HX, (const bf16_t*)(ws + WS_WUPV), Mact, DFF, 1024}; pg8::StaticOrder S; S.init(Mact, DFF, G, bx);
            pg8::EpiVal E{GT, Hb, PTR(26) + l * 3 * DFF, PTR(27) + l * DFF};
            pg8::gemm_phase<pg8::EpiVal, pg8::StaticOrder, true, true>(L, g, S, E, tid);
            if (BOTH(pb + 8)) GRID_BAR();
        }
        if (PH_EN(10) && IN(pb + 9)) { FRESH();
            pg8::Gemm g{Hb, (const bf16_t*)(ws + WS_WDN), Mact, 1024, DFF}; pg8::StaticOrder S; S.init(Mact, 1024, G, bx);
            pg8::EpiRes E{OUTP, XC, OUTP, XC, mod, 5120};
            pg8::gemm_phase<pg8::EpiRes, pg8::StaticOrder, true, true>(L, g, S, E, tid);
            if (BOTH(pb + 9)) GRID_BAR();
        }
    }
    if (PH_EN(11) && IN(21)) { FRESH(); final_norm_phase(OUTP, PTR(29), gw, NGW, lane); }
#undef IN
#undef BOTH
#undef mod
#undef xl
#undef xc
#undef ws
#undef MOD
#undef ROPE
#undef TW
#undef XC
#undef HX
#undef FA
#undef Qb
#undef Kb
#undef Vb
#undef Yb
#undef Gb
#undef ACAT
#undef UF
#undef ZG
#undef UP
#undef GT
#undef Hb
#undef PTR
#undef OUTP
#undef WSP
}

extern "C" void kernel_launch(void* const* d_in, const int* in_sizes, int n_in, void* d_out, int out_size, void* d_ws, size_t ws_size, hipStream_t stream) {
    static int grid = 0;
    if (grid == 0) {
        if (n_in != 30 || in_sizes[0] != ML * DM || out_size != ML * DM || ws_size < WS_END) {
            fprintf(stderr, "kernel_launch: unexpected shapes: n_in %d in0 %d out %d ws %zu (need >= %zu)\n", n_in, n_in > 0 ? in_sizes[0] : -1, out_size, ws_size, (size_t)WS_END); grid = -1; return; }
        int dev = 0, cus = 0, per_cu = 0;
        if (hipGetDevice(&dev) != hipSuccess || hipDeviceGetAttribute(&cus, hipDeviceAttributeMultiprocessorCount, dev) != hipSuccess) { grid = -1; return; }
        if (hipFuncSetAttribute((const void*)fwd_kernel, hipFuncAttributeMaxDynamicSharedMemorySize, LDS_BYTES) != hipSuccess) { fprintf(stderr, "kernel_launch: hipFuncSetAttribute failed\n"); grid = -1; return; }
        if (hipOccupancyMaxActiveBlocksPerMultiprocessor(&per_cu, (const void*)fwd_kernel, 512, LDS_BYTES) != hipSuccess || per_cu < 1) {
            fprintf(stderr, "kernel_launch: occupancy query reports %d blocks per CU\n", per_cu); (void)hipGetLastError(); grid = -1; return; }
        grid = cus;
    }
    if (grid < 0) return;
    (void)hipMemsetAsync((char*)d_ws + WS_CTL, 0, CTL_ZERO_BYTES, stream);
    Args a{};
    for (int i = 0; i < 30; ++i) a.in[i] = (const float*)d_in[i];
    a.out = (float*)d_out; a.ws = (unsigned char*)d_ws;
    for (int li = 0; li < MK_N_LAUNCHES; ++li) {
        if (MK_N_LAUNCHES == NPHASE) { a.ph_lo = li; a.ph_hi = li + 1; a.li = 0; }
        else { a.ph_lo = (int)((long)NPHASE * li / MK_N_LAUNCHES); a.ph_hi = (int)((long)NPHASE * (li + 1) / MK_N_LAUNCHES); a.li = li; }
        hipLaunchKernelGGL(fwd_kernel, dim3(grid), dim3(512), LDS_BYTES, stream, a);
    }
}
```

```cpp
#include <hip/hip_runtime.h>
#include <cstdio>
#include <cstdint>

#define LAS __attribute__((address_space(3)))
#define GAS __attribute__((address_space(1)))
typedef unsigned short bf16_t;
typedef short bf16x8 __attribute__((ext_vector_type(8)));
typedef short s16x4 __attribute__((ext_vector_type(4)));
typedef float f32x2 __attribute__((ext_vector_type(2)));
typedef float f32x4 __attribute__((ext_vector_type(4)));
typedef float f32x16 __attribute__((ext_vector_type(16)));
typedef unsigned u32x2 __attribute__((ext_vector_type(2)));
typedef unsigned u32x4 __attribute__((ext_vector_type(4)));

#ifndef ATT_V
#define ATT_V 2
#endif
#ifndef MK_N_LAUNCHES
#define MK_N_LAUNCHES 1
#endif

constexpr int DM = 1024, SEQ = 8192, NBATCH = 2, CTXL = 256;
constexpr int ML = NBATCH * SEQ;
constexpr int MC = NBATCH * CTXL;
constexpr int MT = ML + MC;
constexpr int NIN = 6656, DFF = 2816, KCAT = 1280;
constexpr int KVL = CTXL + SEQ;
constexpr float EPS = 1e-6f;

constexpr size_t MiB = 1u << 20;
constexpr size_t WS_CTL = 0, CTL_ZERO_BYTES = 1 * MiB;
constexpr size_t WS_MOD = 1 * MiB;
constexpr size_t WS_ROPE = WS_MOD + 2 * 3 * 6144 * 4;
constexpr size_t WS_TW = WS_ROPE + 192 * 32 * 4;
constexpr size_t WS_XC = 2 * MiB;
constexpr size_t WS_WA = 4 * MiB;
constexpr size_t WS_WCAT = 17 * MiB;
constexpr size_t WS_WOUT = WS_WCAT + (size_t)1024 * 1280 * 2;
constexpr size_t WS_WUPG = WS_WOUT + (size_t)1024 * 1024 * 2;
constexpr size_t WS_WUPV = WS_WUPG + (size_t)2816 * 1024 * 2;
constexpr size_t WS_WDN = WS_WUPV + (size_t)2816 * 1024 * 2;
constexpr size_t WS_HX = 38 * MiB;
constexpr size_t WS_FA = WS_HX;
constexpr size_t WS_Q = 71 * MiB;
constexpr size_t WS_K = WS_Q + (size_t)MT * 512 * 2;
constexpr size_t WS_V = WS_K + (size_t)MT * 512 * 2;
constexpr size_t WS_Y = 71 * MiB;
constexpr size_t WS_G = 121 * MiB;
constexpr size_t WS_ACAT = 187 * MiB;
constexpr size_t WS_UF = 229 * MiB;
constexpr size_t WS_ZG = WS_UF + (size_t)MT * 256 * 2;
constexpr size_t WS_UP = WS_ZG + (size_t)MT * 256 * 2;
constexpr size_t WS_GT = 71 * MiB;
constexpr size_t WS_H = 162 * MiB;
constexpr size_t WS_END = 256 * MiB;
static_assert(WS_TW + 8192 * 8 <= WS_XC && WS_WDN + (size_t)1024 * 2816 * 2 <= WS_HX && WS_V + (size_t)MT * 512 * 2 <= WS_G && WS_G + (size_t)MT * 4096 <= WS_ACAT, "ws map 1");
static_assert(WS_ACAT + (size_t)MT * 1280 * 2 <= WS_UF && WS_UP + (size_t)MT * 256 * 2 <= WS_END && WS_GT + (size_t)MT * 2816 * 2 <= WS_H && WS_H + (size_t)MT * 2816 * 2 <= WS_END, "ws map 2");
static_assert(WS_HX + (size_t)MT * 1024 * 2 <= WS_Q && (size_t)2 * 4 * 128 * 64 * 64 * 8 <= (size_t)MT * 1024 * 2, "ws map 3");
constexpr int CW_TMO = 0, CW_CODE = 1, CW_BAR = 4096;

constexpr int RING_BYTES = 131072, LDSCTL_OFF = RING_BYTES, MISC_OFF = LDSCTL_OFF + 320, LDS_BYTES = 147456;

typedef __bf16 bf16x2_t __attribute__((ext_vector_type(2)));
__device__ __forceinline__ unsigned cvt2bf(float lo, float hi) { const f32x2 v = {lo, hi}; return __builtin_bit_cast(unsigned, __builtin_convertvector(v, bf16x2_t)); }
template <int M> __device__ __forceinline__ float swz_xor(float v) { return __int_as_float(__builtin_amdgcn_ds_swizzle(__float_as_int(v), (M << 10) | 0x1f)); }
__device__ __forceinline__ float bf2f(unsigned v) { return __uint_as_float(v << 16); }
__device__ __forceinline__ float sigm(float x) { return 1.0f / (1.0f + __expf(-x)); }
__host__ __device__ __forceinline__ int in_map(int n) {
    if (n < 256) return n;
    if (n < 1280) { const int base = n < 768 ? 256 : 768, r = n - base, comp = r >> 6, p = r & 63, pp = p >> 1, e = p & 1;
        return base + comp * 64 + (pp < 16 ? 0 : 32) + (pp & 15) + 16 * e; }
    if (n < 1792) return n;
    if (n < 2304) { const int r = n - 1792; return 1792 + (r & 1) * 256 + (r >> 1); }
    return n;
}
namespace pg8 {
#define PG8_LAS __attribute__((address_space(3)))
typedef unsigned short bf16_t;
typedef short bf16x8 __attribute__((ext_vector_type(8)));
typedef float f32x4 __attribute__((ext_vector_type(4)));
typedef unsigned u32x4 __attribute__((ext_vector_type(4)));
constexpr int BM = 256, BK = 64, HALF = 128, HTB = HALF * BK * 2  , STAGE_BYTES = 8 * HTB, NXCD = 8, WGM = 8;

__host__ __device__ __forceinline__ int lds_byte(int r, int c) { const int st = (r >> 4) * 2 + (c >> 5), rr = r & 15, cc = c & 31, ob = rr * 64 + cc * 2; return st * 1024 + (ob ^ (((ob >> 9) & 1) << 5)); }
__host__ __device__ __forceinline__ void stage_rc(int b, int& R, int& C) { const int st = b / 1024, sb = b % 1024, swz = sb ^ (((sb >> 9) & 1) << 5); R = (st >> 1) * 16 + swz / 64; C = (st & 1) * 32 + (swz % 64) / 2; }
__host__ __device__ __forceinline__ int perm32(int rho) { const int n = rho >> 4, i = rho & 15; return 8 * (i >> 2) + 4 * n + (i & 3); }

struct Unit { int pm, pn; };
struct Gemm { const bf16_t* A; const bf16_t* Bt; int M, N, K; };

struct StaticOrder {
    int nM, nN, nwg, G, c;
    __host__ __device__ void init(int M, int N, int G_, int c_) { nM = M / BM; nN = N / BM; nwg = nM * nN; G = G_; c = c_; }
    __host__ __device__ bool next(int i, Unit& u) const {
        const long L = (long)i * G + c; if (L >= nwg) return false;
        int wgid = (int)L; { const int q = nwg / NXCD, r = nwg % NXCD, xcd = wgid % NXCD, off = wgid / NXCD; wgid = (xcd < r ? xcd * (q + 1) : r * (q + 1) + (xcd - r) * q) + off; }
        const int nig = WGM * nN, gid = wgid / nig, fm = gid * WGM, gsz = (nM - fm) < WGM ? (nM - fm) : WGM;
        u.pm = fm + ((wgid % nig) % gsz); u.pn = (wgid % nig) / gsz; return true;
    }
    __device__ __forceinline__ void a_ready(const Unit&) const {}
    __device__ __forceinline__ void done(const Unit&) const {}
};
__device__ __forceinline__ unsigned cvt_pk_bf16(float lo, float hi) { return cvt2bf(lo, hi); }
typedef float f32x2 __attribute__((ext_vector_type(2)));
__device__ __forceinline__ f32x2 gelu_pk(f32x2 v) {
    const f32x2 av = __builtin_elementwise_abs(v), d = av * 0.2316418882f + 1.0f;
    f32x2 t; t.x = __builtin_amdgcn_rcpf(d.x); t.y = __builtin_amdgcn_rcpf(d.y);
    f32x2 q = t * 0.5307027145f + (-0.7265760135f); q = q * t + 0.7107068705f; q = q * t + (-0.142248368f); q = q * t + 0.127414796f; q = q * t;
    const f32x2 s = (v * v) * (-0.72134752044f);
    f32x2 e; e.x = __builtin_amdgcn_exp2f(s.x); e.y = __builtin_amdgcn_exp2f(s.y);
    const f32x2 m = v * (q * e), r = v - m;
    f32x2 o; o.x = v.x < 0.f ? m.x : r.x; o.y = v.y < 0.f ? m.y : r.y; return o;
}

typedef unsigned u32x2 __attribute__((ext_vector_type(2)));
__device__ __forceinline__ u32x4 pack8(const f32x4 a, const f32x4 b) { u32x4 w; w.x = cvt_pk_bf16(a[0], a[1]); w.y = cvt_pk_bf16(a[2], a[3]); w.z = cvt_pk_bf16(b[0], b[1]); w.w = cvt_pk_bf16(b[2], b[3]); return w; }

struct EpiIn {
    static constexpr bool PERM = true, AFTER_DRAIN = false, RESCALE = false;
    bf16_t *UF, *ZG, *UP, *Q, *K, *V; unsigned char* G; const float* rope;
    __device__ __forceinline__ void operator()(const f32x4 (&acc)[2][2][4][2], const Unit& u, int wr, int wc, int fr, int fq) const {
        const int pm = u.pm, pn = u.pn; const bool lat = pm < 64; const int R0 = pm * 256;
        const int kv0 = lat ? ((pm >> 5) * 8448 + 256 + ((pm & 31) << 8)) : ((pm - 64) * 8448);
        const int rl = wr * 64 + fr, cl = wc * 32 + 8 * fq;
        if (pn == 0 || pn == 9) {
            bf16_t* dst = (pn == 0 ? UF : UP);
#pragma unroll
            for (int ai = 0; ai < 2; ++ai)
#pragma unroll
                for (int m = 0; m < 4; ++m) { const int rr = ai * 128 + m * 16 + rl;
#pragma unroll
                    for (int bj = 0; bj < 2; ++bj) *(u32x4*)(dst + (size_t)(R0 + rr) * 256 + bj * 128 + cl) = pack8(acc[ai][bj][m][0], acc[ai][bj][m][1]); }
        } else if (pn <= 4) {
            const bool isq = pn <= 2; bf16_t* dst = isq ? Q : K; const int rowbase = isq ? R0 : kv0, colbase = (isq ? pn - 1 : pn - 3) * 256; const float sc = isq ? (ATT_V == 2 ? 0.18033688011112042f : 0.125f) : 1.0f;
#pragma unroll
            for (int ai = 0; ai < 2; ++ai)
#pragma unroll
                for (int m = 0; m < 4; ++m) { const int rr = ai * 128 + m * 16 + rl;
                    f32x4 cs = {1.f, 1.f, 1.f, 1.f}, sn = {0.f, 0.f, 0.f, 0.f};
                    if (lat) { const int t = (R0 & 8191) + rr; const int pos = (wc & 1) ? 128 + (t & 63) : (t >> 6);
                        cs = *(const f32x4*)(rope + pos * 32 + 4 * fq); sn = *(const f32x4*)(rope + pos * 32 + 16 + 4 * fq); }
                    cs = cs * sc; sn = sn * sc;
#pragma unroll
                    for (int bj = 0; bj < 2; ++bj) { const f32x4 a = acc[ai][bj][m][0], b = acc[ai][bj][m][1]; f32x4 oa, ob;
                        oa[0] = a[0] * cs[0] - a[1] * sn[0]; oa[1] = a[1] * cs[0] + a[0] * sn[0]; oa[2] = a[2] * cs[1] - a[3] * sn[1]; oa[3] = a[3] * cs[1] + a[2] * sn[1];
                        ob[0] = b[0] * cs[2] - b[1] * sn[2]; ob[1] = b[1] * cs[2] + b[0] * sn[2]; ob[2] = b[2] * cs[3] - b[3] * sn[3]; ob[3] = b[3] * cs[3] + b[2] * sn[3];
                        *(u32x4*)(dst + (size_t)(rowbase + rr) * 512 + colbase + bj * 128 + cl) = pack8(oa, ob); } }
        } else if (pn <= 6) {
#pragma unroll
            for (int ai = 0; ai < 2; ++ai)
#pragma unroll
                for (int m = 0; m < 4; ++m) { const int rr = ai * 128 + m * 16 + rl;
#pragma unroll
                    for (int bj = 0; bj < 2; ++bj) *(u32x4*)(V + (size_t)(kv0 + rr) * 512 + (pn - 5) * 256 + bj * 128 + cl) = pack8(acc[ai][bj][m][0], acc[ai][bj][m][1]); }
        } else if (pn <= 8) {
#pragma unroll
            for (int ai = 0; ai < 2; ++ai)
#pragma unroll
                for (int m = 0; m < 4; ++m) { const int rr = ai * 128 + m * 16 + rl;
#pragma unroll
                    for (int bj = 0; bj < 2; ++bj) { const f32x4 a = acc[ai][bj][m][0], b = acc[ai][bj][m][1];
                        u32x2 w; w.x = cvt_pk_bf16(a[0] * sigm(a[1]), a[2] * sigm(a[3])); w.y = cvt_pk_bf16(b[0] * sigm(b[1]), b[2] * sigm(b[3]));
                        *(u32x2*)(ZG + (size_t)(R0 + rr) * 256 + (pn - 7) * 128 + bj * 64 + (cl >> 1)) = w; } }
        } else {
#pragma unroll
            for (int ai = 0; ai < 2; ++ai)
#pragma unroll
                for (int m = 0; m < 4; ++m) { const int rr = ai * 128 + m * 16 + rl;
#pragma unroll
                    for (int bj = 0; bj < 2; ++bj) { u32x2 w;
#pragma unroll
                        for (int n = 0; n < 2; ++n) { const f32x4 a = acc[ai][bj][m][n]; unsigned q = 0;
#pragma unroll
                            for (int j = 0; j < 4; ++j) { float s = sigm(a[j]) * 255.0f + 0.5f; s = s < 1.0f ? 1.0f : s; q |= ((unsigned)s) << (8 * j); }
                            if (n == 0) w.x = q; else w.y = q; }
                        *(u32x2*)(G + (size_t)(R0 + rr) * 4096 + (pn - 10) * 256 + bj * 128 + cl) = w; } }
        }
    }
};

struct EpiBf {
    static constexpr bool PERM = true, AFTER_DRAIN = false, RESCALE = false;
    bf16_t* O; int ldc;
    __device__ __forceinline__ void operator()(const f32x4 (&acc)[2][2][4][2], const Unit& u, int wr, int wc, int fr, int fq) const {
        const int row0 = u.pm * 256 + wr * 64 + fr, col0 = u.pn * 256 + wc * 32 + 8 * fq;
#pragma unroll
        for (int ai = 0; ai < 2; ++ai)
#pragma unroll
            for (int m = 0; m < 4; ++m)
#pragma unroll
                for (int bj = 0; bj < 2; ++bj) *(u32x4*)(O + (size_t)(row0 + ai * 128 + m * 16) * ldc + col0 + bj * 128) = pack8(acc[ai][bj][m][0], acc[ai][bj][m][1]);
    }
};

struct EpiRes {
    static constexpr bool PERM = false, AFTER_DRAIN = false, RESCALE = false;
    const float* base_lat; const float* base_ctx; float* out_lat; float* out_ctx; const float* mod; int goff;
    __device__ __forceinline__ void operator()(const f32x4 (&acc)[2][2][4][2], const Unit& u, int wr, int wc, int fr, int fq) const {
        const int pm = u.pm; const bool lat = pm < 64; const int mrow = lat ? (pm >> 5) : 2;
        const float* base = lat ? base_lat + (size_t)pm * 256 * 1024 : base_ctx + (size_t)(pm - 64) * 256 * 1024;
        float* out = lat ? out_lat + (size_t)pm * 256 * 1024 : out_ctx + (size_t)(pm - 64) * 256 * 1024;
        const int col0 = u.pn * 256 + wc * 32 + 4 * fq;
        f32x4 gv[2][2];
#pragma unroll
        for (int bj = 0; bj < 2; ++bj)
#pragma unroll
            for (int n = 0; n < 2; ++n) gv[bj][n] = *(const f32x4*)(mod + mrow * 6144 + goff + col0 + bj * 128 + n * 16);
#pragma unroll
        for (int ai = 0; ai < 2; ++ai)
#pragma unroll
            for (int m = 0; m < 4; ++m) { const size_t ro = (size_t)(ai * 128 + wr * 64 + m * 16 + fr) * 1024 + col0;
#pragma unroll
                for (int bj = 0; bj < 2; ++bj)
#pragma unroll
                    for (int n = 0; n < 2; ++n) { const size_t off = ro + bj * 128 + n * 16; const f32x4 b = *(const f32x4*)(base + off); *(f32x4*)(out + off) = b + gv[bj][n] * acc[ai][bj][m][n]; } }
    }
};

struct EpiVal {
    static constexpr bool PERM = true, AFTER_DRAIN = false, RESCALE = false;
    const bf16_t* GT; bf16_t* H; const float* dww; const float* dwb;
    __device__ __forceinline__ void operator()(const f32x4 (&acc)[2][2][4][2], const Unit& u, int wr, int wc, int fr, int fq) const {
        const int pm = u.pm; const bool lat = pm < 64; const int R0 = pm * 256, t0 = lat ? (R0 & 8191) : 0, L = lat ? 8192 : 256;
        const int rl = wr * 64 + fr;
#pragma unroll
        for (int bj = 0; bj < 2; ++bj) { const int col = u.pn * 256 + bj * 128 + wc * 32 + 8 * fq;
            f32x4 w0[2], w1[2], w2[2], bb[2];
#pragma unroll
            for (int n = 0; n < 2; ++n) { w0[n] = *(const f32x4*)(dww + col + 4 * n); w1[n] = *(const f32x4*)(dww + 2816 + col + 4 * n); w2[n] = *(const f32x4*)(dww + 5632 + col + 4 * n); bb[n] = *(const f32x4*)(dwb + col + 4 * n); }
#pragma unroll
            for (int ai = 0; ai < 2; ++ai)
#pragma unroll
                for (int m = 0; m < 4; ++m) { const int rr = ai * 128 + m * 16 + rl, t = t0 + rr; const bf16_t* gp = GT + (size_t)(R0 + rr) * 2816 + col;
                    u32x4 gm = {0u, 0u, 0u, 0u}, gq = {0u, 0u, 0u, 0u}; const u32x4 g0 = *(const u32x4*)gp;
                    if (t > 0) gm = *(const u32x4*)(gp - 2816);
                    if (t < L - 1) gq = *(const u32x4*)(gp + 2816);
                    f32x4 o[2];
#pragma unroll
                    for (int n = 0; n < 2; ++n) { f32x4 c;
#pragma unroll
                        for (int j = 0; j < 4; ++j) { const int e = 4 * n + j; const unsigned wm = gm[e >> 1], wz = g0[e >> 1], wp = gq[e >> 1];
                            const float xm = (e & 1) ? __uint_as_float(wm & 0xffff0000u) : __uint_as_float(wm << 16), xz = (e & 1) ? __uint_as_float(wz & 0xffff0000u) : __uint_as_float(wz << 16),
                                        xp = (e & 1) ? __uint_as_float(wp & 0xffff0000u) : __uint_as_float(wp << 16);
                            c[j] = w0[n][j] * xm + w1[n][j] * xz + w2[n][j] * xp + bb[n][j]; }
                        const f32x2 ga = gelu_pk((f32x2){c[0], c[1]}), gb = gelu_pk((f32x2){c[2], c[3]});
                        const f32x4 v = acc[ai][bj][m][n]; o[n] = (f32x4){v[0] * ga.x, v[1] * ga.y, v[2] * gb.x, v[3] * gb.y}; }
                    *(u32x4*)(H + (size_t)(R0 + rr) * 2816 + col) = pack8(o[0], o[1]); }
        }
    }
};

struct EpiBranch {
    static constexpr bool PERM = true, AFTER_DRAIN = false, RESCALE = true;
    const unsigned char* G; bf16_t* Y;
    __device__ __forceinline__ void rescale(f32x4 (&acc)[2][2][4][2], const Unit& u, int t, int wr, int wc, int fr, int fq) const {
        const int bp = (t == 4) ? 0 : (t == 12) ? 1 : 2;
        const __amdgpu_buffer_rsrc_t rs = __builtin_amdgcn_make_buffer_rsrc((void*)G, 0, MT * 4096, 0x00020000);
        const int voff = (u.pm * 256 + wr * 64 + fr) * 4096 + u.pn * 256 + wc * 32 + 8 * fq;
#pragma unroll
        for (int ai = 0; ai < 2; ++ai)
#pragma unroll
            for (int m = 0; m < 4; ++m) {
#pragma unroll
                for (int bj = 0; bj < 2; ++bj) { const int so = (ai * 128 + m * 16) * 4096 + bj * 128 + bp * 1024;
                    const u32x2 p = __builtin_bit_cast(u32x2, __builtin_amdgcn_raw_buffer_load_b64(rs, voff, so, 0)), q = __builtin_bit_cast(u32x2, __builtin_amdgcn_raw_buffer_load_b64(rs, voff, so + 1024, 0));
#pragma unroll
                    for (int n = 0; n < 2; ++n) { const unsigned pw = n ? p.y : p.x, qw = n ? q.y : q.x;
#pragma unroll
                        for (int j = 0; j < 4; ++j) acc[ai][bj][m][n][j] *= (float)((pw >> (8 * j)) & 255u) * __builtin_amdgcn_rcpf((float)((qw >> (8 * j)) & 255u)); } }
                asm volatile("" ::: "memory"); }
    }
    __device__ __forceinline__ void operator()(const f32x4 (&acc)[2][2][4][2], const Unit& u, int wr, int wc, int fr, int fq) const {
        const int row0 = u.pm * 256 + wr * 64 + fr, col0 = u.pn * 256 + wc * 32 + 8 * fq;
#pragma unroll
        for (int ai = 0; ai < 2; ++ai)
#pragma unroll
            for (int m = 0; m < 4; ++m)
#pragma unroll
                for (int bj = 0; bj < 2; ++bj) { const size_t r = (size_t)(row0 + ai * 128 + m * 16); const u32x2 p = *(const u32x2*)(G + r * 4096 + 3072 + col0 + bj * 128);
                    f32x4 o[2];
#pragma unroll
                    for (int n = 0; n < 2; ++n) { const unsigned pw = n ? p.y : p.x;
#pragma unroll
                        for (int j = 0; j < 4; ++j) o[n][j] = acc[ai][bj][m][n][j] * ((float)((pw >> (8 * j)) & 255u) * (1.0f / 255.0f)); }
                    *(u32x4*)(Y + r * 1024 + col0 + bj * 128) = pack8(o[0], o[1]); }
    }
};

template <class Epi, class Sched, bool ALIGN_EPI = false, bool SP2 = false>
__device__ __forceinline__ void gemm_phase(PG8_LAS unsigned char* lds, const Gemm g, const Sched& S, const Epi& E, const int tid) {
    const int wid = __builtin_amdgcn_readfirstlane(tid >> 6), lane = tid & 63, wr = wid >> 2, wc = wid & 3, fr = lane & 15, fq = lane >> 4;
    const int K = g.K, nt = K / BK;
    unsigned voffA[2], voffB[2];
#pragma unroll
    for (int i = 0; i < 2; ++i) { int R, C; stage_rc(tid * 16 + i * 8192, R, C); const int Rb = Epi::PERM ? ((R & ~31) + perm32(R & 31)) : R;
        voffA[i] = (unsigned)(R * K + C) * 2u; voffB[i] = (unsigned)(Rb * K + C) * 2u; }
    const size_t kstep = (size_t)(BK * 2);
    const size_t hstep = (size_t)HALF * K * 2;
    const size_t tstep = 2 * hstep;
    const unsigned ldsw = (unsigned)wid * 1024u;
    const int aoff = lds_byte(wr * 64 + fr, fq * 8), boff = lds_byte(wc * 32 + fr, fq * 8);
#define PG8_SA(b, h) (((b) * 2 + (h)) * HTB)
#define PG8_SB(b, h) ((4 + (b) * 2 + (h)) * HTB)
#define PG8_STAGE(bufoff, gbase, voff) do { _Pragma("unroll") for (int _i = 0; _i < 2; ++_i) \
        __builtin_amdgcn_global_load_lds((const unsigned*)((const char*)(gbase) + (voff)[_i]), (PG8_LAS unsigned*)(lds + (bufoff) + ldsw + _i * 8192), 16, 0, 0); } while (0)
#define PG8_LDA(dst, b, h) do { _Pragma("unroll") for (int m = 0; m < 4; ++m) _Pragma("unroll") for (int k = 0; k < 2; ++k) dst[m][k] = *(const PG8_LAS bf16x8*)(lds + PG8_SA(b, h) + aoff + m * 2048 + k * 1024); } while (0)
#define PG8_LDB(dst, b, h) do { _Pragma("unroll") for (int n = 0; n < 2; ++n) _Pragma("unroll") for (int k = 0; k < 2; ++k) dst[n][k] = *(const PG8_LAS bf16x8*)(lds + PG8_SB(b, h) + boff + n * 2048 + k * 1024); } while (0)
#define PG8_MMA(ai, bj, At, Bt) do { __builtin_amdgcn_s_setprio(1); _Pragma("unroll") for (int m = 0; m < 4; ++m) _Pragma("unroll") for (int n = 0; n < 2; ++n) _Pragma("unroll") for (int k = 0; k < 2; ++k) \
        acc[ai][bj][m][n] = __builtin_amdgcn_mfma_f32_16x16x32_bf16(Bt[n][k], At[m][k], acc[ai][bj][m][n], 0, 0, 0); __builtin_amdgcn_s_setprio(0); } while (0)
#define PG8_WAIT_V(n) asm volatile("s_waitcnt vmcnt(" #n ")" ::: "memory")
#define PG8_WAIT_L(n) asm volatile("s_waitcnt lgkmcnt(" #n ")" ::: "memory")
#define PG8_BAR __builtin_amdgcn_s_barrier()
#define PG8_SCHED __builtin_amdgcn_sched_barrier(0)
    Unit cur, nxt; int ui = 0;
    if (!S.next(0, cur)) return;
    f32x4 acc[2][2][4][2];
#pragma unroll
    for (int a = 0; a < 2; ++a)
#pragma unroll
        for (int b = 0; b < 2; ++b)
#pragma unroll
            for (int m = 0; m < 4; ++m)
#pragma unroll
                for (int n = 0; n < 2; ++n) acc[a][b][m][n] = (f32x4){0.f, 0.f, 0.f, 0.f};
    bf16x8 At[4][2], B0[2][2], B1[2][2];
    const char* cA = (const char*)g.A + (size_t)cur.pm * tstep; const char* cB = (const char*)g.Bt + (size_t)cur.pn * tstep;
    S.a_ready(cur);
    if constexpr (SP2) {
        PG8_STAGE(PG8_SB(0, 0), cB, voffB); PG8_STAGE(PG8_SB(0, 1), cB + hstep, voffB); PG8_STAGE(PG8_SA(0, 0), cA, voffA); PG8_STAGE(PG8_SA(0, 1), cA + hstep, voffA);
        if (wr == 1) PG8_BAR;
        PG8_WAIT_V(2); PG8_BAR;
        PG8_STAGE(PG8_SB(1, 0), cB + kstep, voffB); PG8_STAGE(PG8_SA(1, 0), cA + kstep, voffA); PG8_STAGE(PG8_SB(1, 1), cB + hstep + kstep, voffB);
        PG8_WAIT_V(6); PG8_BAR;
    } else {
        PG8_STAGE(PG8_SB(0, 0), cB, voffB); PG8_STAGE(PG8_SA(0, 0), cA, voffA); PG8_STAGE(PG8_SB(0, 1), cB + hstep, voffB); PG8_STAGE(PG8_SA(0, 1), cA + hstep, voffA);
        if (wr == 1) PG8_BAR;
        PG8_WAIT_V(4); PG8_BAR;
        PG8_STAGE(PG8_SB(1, 0), cB + kstep, voffB); PG8_STAGE(PG8_SA(1, 0), cA + kstep, voffA); PG8_STAGE(PG8_SB(1, 1), cB + hstep + kstep, voffB);
        PG8_WAIT_V(6); PG8_BAR;
    }
    for (;;) {
        const bool has_next = S.next(ui + 1, nxt);
        const char* nA = has_next ? (const char*)g.A + (size_t)nxt.pm * tstep : cA; const char* nB = has_next ? (const char*)g.Bt + (size_t)nxt.pn * tstep : cB;
        for (int t = 0; t < nt; t += 2) {
            if constexpr (Epi::RESCALE) { if (t == 4 || t == 12 || t == 16) E.rescale(acc, cur, t, wr, wc, fr, fq); }
            const bool last = (t == nt - 2);
            const char* a1 = cA + (size_t)(t + 1) * kstep;
            const char* a2 = last ? nA : cA + (size_t)(t + 2) * kstep; const char* b2 = last ? nB : cB + (size_t)(t + 2) * kstep;
            const char* a3 = a2 + kstep; const char* b3 = b2 + kstep;
            if (last && has_next) S.a_ready(nxt);
            if constexpr (SP2) {
            PG8_LDB(B0, 0, 0); PG8_LDB(B1, 0, 1); PG8_SCHED; PG8_LDA(At, 0, 0); PG8_STAGE(PG8_SA(1, 1), a1 + hstep, voffA);
            PG8_WAIT_V(8); PG8_WAIT_L(0); PG8_BAR; PG8_MMA(0, 0, At, B0); PG8_MMA(0, 1, At, B1); PG8_BAR; PG8_SCHED;
            PG8_LDA(At, 0, 1); PG8_STAGE(PG8_SB(0, 0), b2, voffB); PG8_STAGE(PG8_SB(0, 1), b2 + hstep, voffB); PG8_STAGE(PG8_SA(0, 0), a2, voffA);
            PG8_WAIT_V(8); PG8_WAIT_L(0); PG8_BAR; PG8_MMA(1, 0, At, B0); PG8_MMA(1, 1, At, B1); PG8_BAR; PG8_SCHED;
            PG8_LDB(B0, 1, 0); PG8_LDB(B1, 1, 1); PG8_SCHED; PG8_LDA(At, 1, 0); PG8_STAGE(PG8_SA(0, 1), a2 + hstep, voffA);
            PG8_WAIT_V(8); PG8_WAIT_L(0); PG8_BAR; PG8_MMA(0, 0, At, B0); PG8_MMA(0, 1, At, B1); PG8_BAR; PG8_SCHED;
            PG8_LDA(At, 1, 1); PG8_STAGE(PG8_SB(1, 0), b3, voffB); PG8_STAGE(PG8_SB(1, 1), b3 + hstep, voffB); PG8_STAGE(PG8_SA(1, 0), a3, voffA);
            PG8_WAIT_V(8); PG8_WAIT_L(0); PG8_BAR; PG8_MMA(1, 0, At, B0); PG8_MMA(1, 1, At, B1); PG8_BAR; PG8_SCHED;
            } else {
            PG8_LDB(B0, 0, 0); PG8_SCHED; PG8_LDA(At, 0, 0); PG8_STAGE(PG8_SA(1, 1), a1 + hstep, voffA);
            PG8_WAIT_L(8); PG8_BAR; PG8_WAIT_L(0); PG8_MMA(0, 0, At, B0); PG8_BAR; PG8_SCHED;
            PG8_LDB(B1, 0, 1); PG8_STAGE(PG8_SB(0, 0), b2, voffB);
            PG8_BAR; PG8_WAIT_L(0); PG8_MMA(0, 1, At, B1); PG8_BAR;
            PG8_LDA(At, 0, 1); PG8_STAGE(PG8_SA(0, 0), a2, voffA);
            PG8_BAR; PG8_WAIT_L(0); PG8_MMA(1, 0, At, B0); PG8_BAR; PG8_SCHED;
            PG8_STAGE(PG8_SB(0, 1), b2 + hstep, voffB);
            PG8_WAIT_V(6); PG8_BAR; PG8_MMA(1, 1, At, B1); PG8_BAR;
            PG8_LDB(B0, 1, 0); PG8_SCHED; PG8_LDA(At, 1, 0); PG8_STAGE(PG8_SA(0, 1), a2 + hstep, voffA);
            PG8_WAIT_L(8); PG8_BAR; PG8_WAIT_L(0); PG8_MMA(0, 0, At, B0); PG8_BAR; PG8_SCHED;
            PG8_LDB(B1, 1, 1); PG8_STAGE(PG8_SB(1, 0), b3, voffB);
            PG8_BAR; PG8_WAIT_L(0); PG8_MMA(0, 1, At, B1); PG8_BAR;
            PG8_LDA(At, 1, 1); PG8_STAGE(PG8_SA(1, 0), a3, voffA);
            PG8_BAR; PG8_WAIT_L(0); PG8_MMA(1, 0, At, B0); PG8_BAR; PG8_SCHED;
            PG8_STAGE(PG8_SB(1, 1), b3 + hstep, voffB);
            PG8_WAIT_V(6); PG8_BAR; PG8_MMA(1, 1, At, B1); PG8_BAR;
            }
        }
        if constexpr (ALIGN_EPI) { if (wr == 0) PG8_BAR; }
        if constexpr (!Epi::AFTER_DRAIN) { E(acc, cur, wr, wc, fr, fq); S.done(cur); }
        if (!has_next) break;
#pragma unroll
        for (int a = 0; a < 2; ++a)
#pragma unroll
            for (int b = 0; b < 2; ++b)
#pragma unroll
                for (int m = 0; m < 4; ++m)
#pragma unroll
                    for (int n = 0; n < 2; ++n) acc[a][b][m][n] = (f32x4){0.f, 0.f, 0.f, 0.f};
        cur = nxt; cA = nA; cB = nB; ++ui;
        if constexpr (ALIGN_EPI) { if (wr == 1) PG8_BAR; }
    }
    PG8_WAIT_V(0);
    if constexpr (!ALIGN_EPI) { if (wr == 0) PG8_BAR; }
    PG8_BAR;
    if constexpr (Epi::AFTER_DRAIN) { E.fused(acc, cur, wr, wc, fr, fq, lds, wid, lane); S.done(cur); }
#undef PG8_SA
#undef PG8_SB
#undef PG8_STAGE
#undef PG8_LDA
#undef PG8_LDB
#undef PG8_MMA
#undef PG8_WAIT_V
#undef PG8_WAIT_L
#undef PG8_BAR
#undef PG8_SCHED
}
}
namespace att {
constexpr int NW = 8, QBLK = 32, KVBLK = 64, LDQ = 512, LDO = KCAT;
constexpr int SHM_V = 16384, SHM_K = 16384, SHM_ATTN = 3 * SHM_V + 2 * SHM_K + NW * 64 * 4;
constexpr float THR = 8.f;
#ifndef ATT_SDEPTH
#define ATT_SDEPTH 1
#endif
constexpr int SDEPTH = ATT_SDEPTH;
#define KSWZ(row, colB) ((row) * 256 + ((colB) ^ (((row) & 7) << 4)))
#define SBAR() __builtin_amdgcn_sched_barrier(0)
__device__ __forceinline__ int crow(int r, int hi) { return (r & 3) + 8 * (r >> 2) + 4 * hi; }
__device__ __forceinline__ unsigned cvtpk(float lo, float hi) { return cvt2bf(lo, hi); }

__device__ __forceinline__ void partialSM(f32x16& p0, f32x16& p1, float& m_reg, float& mn, float& alpha) {
  constexpr float C = 1.4426950408889634f;
  float pmax = p0[0];
#pragma unroll
  for (int r = 1; r < 16; ++r) pmax = fmaxf(pmax, p0[r]);
#pragma unroll
  for (int r = 0; r < 16; ++r) pmax = fmaxf(pmax, p1[r]);
  { auto rr = __builtin_amdgcn_permlane32_swap(__float_as_uint(pmax), __float_as_uint(pmax), false, false);
    pmax = fmaxf(__uint_as_float(rr[0]), __uint_as_float(rr[1])); }
  if (__builtin_expect(__all(pmax - m_reg <= THR), 1)) { mn = m_reg; alpha = 1.f; }
  else { mn = fmaxf(m_reg, pmax); alpha = __builtin_amdgcn_exp2f((m_reg - mn) * C); m_reg = mn; }
  const float mnC = -mn * C;
#pragma unroll
  for (int r = 0; r < 16; ++r) p0[r] = fmaf(p0[r], C, mnC);
#pragma unroll
  for (int r = 0; r < 16; ++r) p1[r] = fmaf(p1[r], C, mnC);
#pragma unroll
  for (int r = 0; r < 16; ++r) p0[r] = __builtin_amdgcn_exp2f(p0[r]);
}
__device__ __forceinline__ void finishSM(f32x16& p0, f32x16& p1, float alpha, float& l_reg, bf16x8& pa0, bf16x8& pa1, bf16x8& pa2, bf16x8& pa3) {
#pragma unroll
  for (int r = 0; r < 16; ++r) p1[r] = __builtin_amdgcn_exp2f(p1[r]);
  float ps = 0;
#pragma unroll
  for (int r = 0; r < 16; ++r) ps += p0[r];
#pragma unroll
  for (int r = 0; r < 16; ++r) ps += p1[r];
  { auto rr = __builtin_amdgcn_permlane32_swap(__float_as_uint(ps), __float_as_uint(ps), false, false);
    ps = __uint_as_float(rr[0]) + __uint_as_float(rr[1]); }
  l_reg = l_reg * alpha + ps;
#define PK4(P, BASE, OUT) do { unsigned a0 = cvtpk(P[BASE + 0], P[BASE + 1]), a1 = cvtpk(P[BASE + 2], P[BASE + 3]);   \
    unsigned b0 = cvtpk(P[BASE + 4], P[BASE + 5]), b1 = cvtpk(P[BASE + 6], P[BASE + 7]);                              \
    auto r0 = __builtin_amdgcn_permlane32_swap(a0, b0, false, false); auto r1 = __builtin_amdgcn_permlane32_swap(a1, b1, false, false); \
    u32x4 w = {r0[0], r1[0], r0[1], r1[1]}; OUT = *reinterpret_cast<bf16x8*>(&w); } while (0)
  PK4(p0, 0, pa0); PK4(p0, 8, pa1); PK4(p1, 0, pa2); PK4(p1, 8, pa3);
#undef PK4
}
__device__ __forceinline__ void qkt(f32x16& p0, f32x16& p1, const char* Ks, const bf16x8* qr, int r32, int hi, int kcol) {
  p0 = f32x16{}; p1 = f32x16{};
#pragma unroll
  for (int d0 = 0; d0 < 4; ++d0) { const int cb = kcol + (d0 * 16 + hi * 8) * 2;
    const bf16x8 b0 = *reinterpret_cast<const bf16x8*>(Ks + KSWZ(r32, cb));
    const bf16x8 b1 = *reinterpret_cast<const bf16x8*>(Ks + KSWZ(32 + r32, cb));
    p0 = __builtin_amdgcn_mfma_f32_32x32x16_bf16(b0, qr[d0], p0, 0, 0, 0);
    p1 = __builtin_amdgcn_mfma_f32_32x32x16_bf16(b1, qr[d0], p1, 0, 0, 0); }
}
__device__ __forceinline__ int v_st(int k, int c) { const int kk = (k & ~0xC) | ((k & 4) << 1) | ((k & 8) >> 1); return ((kk >> 3) * 4 + (c >> 5)) * 512 + ((kk & 7) * 32 + (c & 31)) * 2; }
__device__ __forceinline__ int v_rd_base(int lane) { return ((lane & 3) << 3) | (((lane >> 2) & 3) << 6) | (((lane >> 4) & 1) << 5) | (((lane >> 5) & 1) << 8); }
constexpr int v_rd_off(int d0, int ks, int half) { return d0 * 512 + ks * 4096 + half * 2048; }
template <int OFF> __device__ __forceinline__ s16x4 tr_read(int vb) {
  s16x4 r; asm volatile("ds_read_b64_tr_b16 %0, %1 offset:%2" : "=&v"(r) : "v"(vb), "i"(OFF) : "memory"); return r;
}
template <int D0> __device__ __forceinline__ void pv_one(f32x16& od, int vb, bf16x8 pa0, bf16x8 pa1, bf16x8 pa2, bf16x8 pa3) {
  const s16x4 l0 = tr_read<v_rd_off(D0, 0, 0)>(vb), h0 = tr_read<v_rd_off(D0, 0, 1)>(vb), l1 = tr_read<v_rd_off(D0, 1, 0)>(vb), h1 = tr_read<v_rd_off(D0, 1, 1)>(vb);
  const s16x4 l2 = tr_read<v_rd_off(D0, 2, 0)>(vb), h2 = tr_read<v_rd_off(D0, 2, 1)>(vb), l3 = tr_read<v_rd_off(D0, 3, 0)>(vb), h3 = tr_read<v_rd_off(D0, 3, 1)>(vb);
  asm volatile("s_waitcnt lgkmcnt(0)" ::: "memory"); SBAR();
#define PK(L, H) (bf16x8){L[0], L[1], L[2], L[3], H[0], H[1], H[2], H[3]}
  od = __builtin_amdgcn_mfma_f32_32x32x16_bf16(pa0, PK(l0, h0), od, 0, 0, 0);
  od = __builtin_amdgcn_mfma_f32_32x32x16_bf16(pa1, PK(l1, h1), od, 0, 0, 0);
  od = __builtin_amdgcn_mfma_f32_32x32x16_bf16(pa2, PK(l2, h2), od, 0, 0, 0);
  od = __builtin_amdgcn_mfma_f32_32x32x16_bf16(pa3, PK(l3, h3), od, 0, 0, 0);
#undef PK
}
__device__ __forceinline__ void pv_d0(f32x16* o, int vb, bf16x8 pa0, bf16x8 pa1, bf16x8 pa2, bf16x8 pa3) {
  pv_one<0>(o[0], vb, pa0, pa1, pa2, pa3); pv_one<1>(o[1], vb, pa0, pa1, pa2, pa3); pv_one<2>(o[2], vb, pa0, pa1, pa2, pa3); pv_one<3>(o[3], vb, pa0, pa1, pa2, pa3);
}

template <int VAR>
__device__ __forceinline__ void attn_unit(const bf16_t* __restrict__ Qb, const bf16_t* __restrict__ Kh, const bf16_t* __restrict__ Vh, int nkeys,
                                          bf16_t* __restrict__ Ob, float lam, float osc, const float* __restrict__ sg, char* lds, const int tid) {
  const int wid = __builtin_amdgcn_readfirstlane(tid >> 6), lane = tid & 63, r32 = lane & 31, hi = lane >> 5;
  const int comp = wid >> 2, qw = wid & 3, kcol = comp * 128;
  char* K_lds = lds; char* V_lds = lds + 2 * SHM_K;
  float* ws = (float*)(lds + 2 * SHM_K + 3 * SHM_V) + wid * 64; float* li_l = ws; float* al_l = ws + 32;
  float m_reg = -1e30f, l_reg = 0; f32x16 o[4] = {}; bf16x8 qr[4];
  const bf16_t* Qw = Qb + (long)(qw * QBLK + r32) * LDQ + comp * 64 + hi * 8;
#pragma unroll
  for (int d0 = 0; d0 < 4; ++d0) qr[d0] = *reinterpret_cast<const bf16x8*>(Qw + d0 * 16);
  const int sr = tid >> 4, sc = (tid & 15) * 8, vst0 = v_st(sr, sc), vst1 = v_st(32 + sr, sc);
  const int vb0 = (int)(uintptr_t)V_lds + v_rd_base(lane);
  bf16x8 sk0 = {}, sk1 = {}, sv0 = {}, sv1 = {};
#define LOADK(t) do { if constexpr (!(VAR & 8)) { sk0 = *reinterpret_cast<const bf16x8*>(&Kh[(long)((t) * KVBLK + sr) * LDQ + sc]); sk1 = *reinterpret_cast<const bf16x8*>(&Kh[(long)((t) * KVBLK + 32 + sr) * LDQ + sc]); } } while (0)
#define LOADV(t) do { if constexpr (!(VAR & 8)) { sv0 = *reinterpret_cast<const bf16x8*>(&Vh[(long)((t) * KVBLK + sr) * LDQ + sc]); sv1 = *reinterpret_cast<const bf16x8*>(&Vh[(long)((t) * KVBLK + 32 + sr) * LDQ + sc]); } } while (0)
#define WRITEK(slot) do { if constexpr (!(VAR & 8)) { *(bf16x8*)(K_lds + (slot) * SHM_K + KSWZ(sr, sc * 2)) = sk0; *(bf16x8*)(K_lds + (slot) * SHM_K + KSWZ(32 + sr, sc * 2)) = sk1; } } while (0)
#define WRITEV(off) do { if constexpr (!(VAR & 8)) { *(bf16x8*)(V_lds + (off) + vst0) = sv0; *(bf16x8*)(V_lds + (off) + vst1) = sv1; } } while (0)
#define VMW() asm volatile("s_waitcnt vmcnt(0)" ::: "memory")
#define QKT(P0, P1, KS) do { if constexpr (VAR & 4) { P0 = f32x16{}; P1 = f32x16{}; asm volatile("" : "+v"(P0), "+v"(P1)); } else qkt(P0, P1, KS, qr, r32, hi, kcol); } while (0)
#define PSM(P0, P1, MN, AL) do { if constexpr (VAR & 1) { MN = m_reg; AL = 1.f; asm volatile("" : "+v"(P0), "+v"(P1)); } else partialSM(P0, P1, m_reg, MN, AL); } while (0)
#define FSM(P0, P1, AL) do { if constexpr (VAR & 1) { asm volatile("" : "+v"(P0), "+v"(P1)); pa0 = __builtin_bit_cast(bf16x8, (f32x4){P0[0], P0[1], P0[2], P0[3]}); pa1 = __builtin_bit_cast(bf16x8, (f32x4){P0[4], P0[5], P0[6], P0[7]}); pa2 = __builtin_bit_cast(bf16x8, (f32x4){P1[0], P1[1], P1[2], P1[3]}); pa3 = __builtin_bit_cast(bf16x8, (f32x4){P1[4], P1[5], P1[6], P1[7]}); } else finishSM(P0, P1, AL, l_reg, pa0, pa1, pa2, pa3); } while (0)
#define PV(OFF) do { if constexpr (VAR & 2) { asm volatile("" : "+v"(pa0), "+v"(pa1), "+v"(pa2), "+v"(pa3)); } else pv_d0(o, vb0 + (OFF), pa0, pa1, pa2, pa3); } while (0)
#define RESC(a) do { if (__any((a) < 1.f)) { if (hi == 0) al_l[r32] = (a); asm volatile("s_waitcnt lgkmcnt(0)" ::: "memory"); \
    _Pragma("unroll") for (int d = 0; d < 4; ++d) _Pragma("unroll") for (int r = 0; r < 16; ++r) o[d][r] *= al_l[crow(r, hi)]; } } while (0)
  f32x16 pA0, pA1, pB0, pB1; float mnA, mnB, alA, alB; bf16x8 pa0, pa1, pa2, pa3; const int NT = nkeys / KVBLK;
  LOADK(0); VMW(); WRITEK(0); LOADK(1); LOADV(0);
  __syncthreads();
  if (comp == 1) __syncthreads();
  VMW(); WRITEK(1); WRITEV(0);
  SBAR(); QKT(pA0, pA1, K_lds); SBAR();
  __syncthreads();
  LOADK(2); LOADV(1); SBAR();
  PSM(pA0, pA1, mnA, alA);
  __syncthreads();
  int va = 0, vb = SHM_V, vc = 2 * SHM_V;
  for (int j = 1; j + 1 < NT; j += 2) {
    VMW(); WRITEK(0); WRITEV(vb);
    SBAR(); QKT(pB0, pB1, K_lds + SHM_K);
    FSM(pA0, pA1, alA); SBAR();
    __syncthreads();
    LOADK(j + 2); LOADV(j + 1); SBAR();
    PV(va); PSM(pB0, pB1, mnB, alB);
    RESC(alB);
    __syncthreads();
    VMW(); WRITEK(1); WRITEV(vc);
    SBAR(); QKT(pA0, pA1, K_lds);
    FSM(pB0, pB1, alB); SBAR();
    __syncthreads();
    if (j + 3 < NT) LOADK(j + 3);
    LOADV(j + 2); SBAR();
    PV(vb); PSM(pA0, pA1, mnA, alA);
    RESC(alA);
    __syncthreads();
    { const int t = va; va = vc; vc = vb; vb = t; }
  }
  VMW(); WRITEV(vb);
  SBAR(); QKT(pB0, pB1, K_lds + SHM_K);
  FSM(pA0, pA1, alA); SBAR();
  __syncthreads();
  PV(va); PSM(pB0, pB1, mnB, alB);
  RESC(alB);
  __syncthreads();
  FSM(pB0, pB1, alB); SBAR();
  PV(vb);
  if (comp == 0) __syncthreads();
  if (hi == 0) li_l[r32] = l_reg; asm volatile("s_waitcnt lgkmcnt(0)" ::: "memory");
  float rli[16];
#pragma unroll
  for (int r = 0; r < 16; ++r) rli[r] = __builtin_amdgcn_rcpf(li_l[crow(r, hi)]);
  __syncthreads();
  float* XO = (float*)lds + qw * (32 * 128);
  if (comp == 1) {
#pragma unroll
    for (int r = 0; r < 16; ++r)
#pragma unroll
      for (int d0 = 0; d0 < 4; ++d0) XO[crow(r, hi) * 128 + d0 * 32 + r32] = o[d0][r] * rli[r];
  }
  __syncthreads();
  if (comp == 0) {
    float ss[16];
#pragma unroll
    for (int r = 0; r < 16; ++r) { float s = 0.f;
#pragma unroll
      for (int d0 = 0; d0 < 4; ++d0) { const float v = o[d0][r] * rli[r] - lam * XO[crow(r, hi) * 128 + d0 * 32 + r32]; o[d0][r] = v; s += v * v; }
      ss[r] = s; }
#pragma unroll
    for (int r = 0; r < 16; ++r) { float s = ss[r]; s += swz_xor<1>(s); s += swz_xor<2>(s); s += swz_xor<4>(s); s += swz_xor<8>(s); s += swz_xor<16>(s);
      ss[r] = osc / sqrtf(s * (1.0f / 128.0f) + EPS); }
    float gam[4];
#pragma unroll
    for (int d0 = 0; d0 < 4; ++d0) gam[d0] = sg[d0 * 32 + r32];
    asm volatile("s_waitcnt lgkmcnt(0)" ::: "memory");
    bf16_t* stg = (bf16_t*)XO;
#pragma unroll
    for (int r = 0; r < 16; ++r)
#pragma unroll
      for (int d0 = 0; d0 < 4; ++d0) stg[crow(r, hi) * 128 + d0 * 32 + r32] = (bf16_t)(cvtpk(o[d0][r] * ss[r] * gam[d0], 0.f) & 0xffffu);
    asm volatile("s_waitcnt lgkmcnt(0)" ::: "memory");
#pragma unroll
    for (int i = 0; i < 8; ++i) { const int row = i * 4 + (lane >> 4), ch = lane & 15; const u32x4 v = *(const u32x4*)(stg + row * 128 + ch * 8);
      if constexpr (VAR & 16) { asm volatile("" :: "v"(v.x), "v"(v.y), "v"(v.z), "v"(v.w)); } else *(u32x4*)(Ob + (long)(qw * QBLK + row) * LDO + ch * 8) = v; }
  }
  __syncthreads();
#undef LOADK
#undef LOADV
#undef WRITEK
#undef WRITEV
#undef VMW
#undef QKT
#undef PSM
#undef FSM
#undef PV
#undef RESC
}
#undef KSWZ
#undef SBAR
}
namespace att2 {
using att::crow; using att::v_st; using att::v_rd_base; using att::v_rd_off;
constexpr int NW = 8, QBLK = 32, KVBLK = 64, LDQ = 512, LDO = KCAT, SHM_K = 16384, SHM_V = 16384;
constexpr float THRL = 8.0f;
typedef short v4i16_t __attribute__((ext_vector_type(4)));
typedef __attribute__((address_space(3))) const char* lds_cptr;
typedef __attribute__((address_space(3))) char* lds_ptr;
#define SBAR() __builtin_amdgcn_sched_barrier(0)
#define KSWZ(row, colB) ((row) * 256 + ((colB) ^ (((row) & 7) << 4)))
__device__ __forceinline__ s16x4 vtr(lds_cptr p) { return __builtin_bit_cast(s16x4, __builtin_amdgcn_ds_read_tr16_b64_v4i16((__attribute__((address_space(3))) v4i16_t*)p)); }
__device__ __forceinline__ bf16x8 ldk(lds_cptr p) { return *(const __attribute__((address_space(3))) bf16x8*)p; }
#define MF(D, A, B, C) do { if constexpr (VAR & 4) { asm volatile("" : "+v"(D)); } else D = __builtin_amdgcn_mfma_f32_32x32x16_bf16(A, B, C, 0, 0, 0); } while (0)
#define VF(L, H) (bf16x8){L[0], L[1], L[2], L[3], H[0], H[1], H[2], H[3]}

template <int VAR>
__device__ __forceinline__ void attn_unit(const bf16_t* __restrict__ Qb, const bf16_t* __restrict__ Kh, const bf16_t* __restrict__ Vh, int nkeys,
                                          bf16_t* __restrict__ Ob, float lam, float osc, const float* __restrict__ sg, char* lds, const int tid) {
  const int wid = __builtin_amdgcn_readfirstlane(tid >> 6), lane = tid & 63, r32 = lane & 31, hi = lane >> 5;
  const int comp = wid >> 2, qw = wid & 3, kcol = comp * 128;
  const lds_ptr L3 = (lds_ptr)(unsigned)(uintptr_t)lds;
  float* ws = (float*)(lds + 2 * SHM_K + 3 * SHM_V) + wid * 64; float* li_l = ws; float* al_l = ws + 32;
  float mhat = 0.f, l_reg = 0.f; f32x16 o[4] = {}; bf16x8 qr[4]; f32x16 negm = {};
  const bf16_t* Qw = Qb + (long)(qw * QBLK + r32) * LDQ + comp * 64 + hi * 8;
#pragma unroll
  for (int d0 = 0; d0 < 4; ++d0) qr[d0] = *reinterpret_cast<const bf16x8*>(Qw + d0 * 16);
  const int sr = tid >> 4, sc = (tid & 15) * 8;
  const lds_ptr kw0 = L3 + KSWZ(sr, sc * 2), kw1 = L3 + KSWZ(32 + sr, sc * 2), vw0 = L3 + 2 * SHM_K + v_st(sr, sc), vw1 = L3 + 2 * SHM_K + v_st(32 + sr, sc);
  lds_cptr kq[4];
#pragma unroll
  for (int d0 = 0; d0 < 4; ++d0) kq[d0] = L3 + r32 * 256 + ((kcol + d0 * 32 + hi * 16) ^ ((r32 & 7) << 4));
  const lds_cptr vp0 = L3 + 2 * SHM_K + v_rd_base(lane);
  bf16x8 sk0 = {}, sk1 = {}, sv0 = {}, sv1 = {};
#define LOADK(t) do { if constexpr (!(VAR & 8)) { sk0 = *reinterpret_cast<const bf16x8*>(&Kh[(long)((t) * KVBLK + sr) * LDQ + sc]); sk1 = *reinterpret_cast<const bf16x8*>(&Kh[(long)((t) * KVBLK + 32 + sr) * LDQ + sc]); } } while (0)
#define LOADV(t) do { if constexpr (!(VAR & 8)) { sv0 = *reinterpret_cast<const bf16x8*>(&Vh[(long)((t) * KVBLK + sr) * LDQ + sc]); sv1 = *reinterpret_cast<const bf16x8*>(&Vh[(long)((t) * KVBLK + 32 + sr) * LDQ + sc]); } } while (0)
#define WRITEK(slot) do { if constexpr (!(VAR & 8)) { *(__attribute__((address_space(3))) bf16x8*)(kw0 + (slot) * SHM_K) = sk0; *(__attribute__((address_space(3))) bf16x8*)(kw1 + (slot) * SHM_K) = sk1; } } while (0)
#define WRITEV(off) do { if constexpr (!(VAR & 8)) { *(__attribute__((address_space(3))) bf16x8*)(vw0 + (off)) = sv0; *(__attribute__((address_space(3))) bf16x8*)(vw1 + (off)) = sv1; } } while (0)
#define VMW() asm volatile("s_waitcnt vmcnt(0)" ::: "memory")
#define LB() do { if constexpr (!(VAR & 32)) __syncthreads(); } while (0)
  f32x16 pA0, pA1, pB0, pB1; u32x4 pw0 = {}, pw1 = {}, pw2 = {}, pw3 = {}; const int NT = nkeys / KVBLK; bool resc = false;
#define KF(KOFF, d0, half) ldk(kq[d0] + (KOFF) + 8192 * (half))
#define PKA(P, B, A0, A1) do { if constexpr (!(VAR & 1)) { A0 = cvt2bf(P[B + 0], P[B + 1]); A1 = cvt2bf(P[B + 2], P[B + 3]); sacc += P[B + 0]; sacc += P[B + 1]; sacc += P[B + 2]; sacc += P[B + 3]; } } while (0)
#define PKB(P, B, A0, A1, PW) do { if constexpr (!(VAR & 1)) { const unsigned b0_ = cvt2bf(P[B + 4], P[B + 5]), b1_ = cvt2bf(P[B + 6], P[B + 7]); \
    auto r0_ = __builtin_amdgcn_permlane32_swap(A0, b0_, false, false); auto r1_ = __builtin_amdgcn_permlane32_swap(A1, b1_, false, false); \
    PW = (u32x4){r0_[0], r1_[0], r0_[1], r1_[1]}; sacc += P[B + 4]; sacc += P[B + 5]; sacc += P[B + 6]; sacc += P[B + 7]; } } while (0)
#define H1(C0, C1, P0, P1, KOFF, FIN) do { \
    float sacc = 0.f; unsigned a0_ = 0, a1_ = 0; \
    bf16x8 f0 = KF(KOFF, 0, 0), f1 = KF(KOFF, 0, 1), f2 = KF(KOFF, 1, 0); SBAR(); \
    MF(C0, f0, qr[0], negm); { f0 = KF(KOFF, 1, 1); if (FIN) PKA(P0, 0, a0_, a1_); } SBAR(); \
    MF(C1, f1, qr[0], negm); { f1 = KF(KOFF, 2, 0); if (FIN) PKB(P0, 0, a0_, a1_, pw0); } SBAR(); \
    MF(C0, f2, qr[1], C0);   { f2 = KF(KOFF, 2, 1); if (FIN) PKA(P0, 8, a0_, a1_); } SBAR(); \
    MF(C1, f0, qr[1], C1);   { f0 = KF(KOFF, 3, 0); if (FIN) PKB(P0, 8, a0_, a1_, pw1); } SBAR(); \
    MF(C0, f1, qr[2], C0);   { f1 = KF(KOFF, 3, 1); if (FIN) PKA(P1, 0, a0_, a1_); } SBAR(); \
    MF(C1, f2, qr[2], C1);   { if (FIN) PKB(P1, 0, a0_, a1_, pw2); } SBAR(); \
    MF(C0, f0, qr[3], C0);   { if (FIN) PKA(P1, 8, a0_, a1_); } SBAR(); \
    MF(C1, f1, qr[3], C1);   { if (FIN) PKB(P1, 8, a0_, a1_, pw3); } SBAR(); \
    if (FIN) { auto rr_ = __builtin_amdgcn_permlane32_swap(__float_as_uint(sacc), __float_as_uint(sacc), false, false); l_reg += __uint_as_float(rr_[0]) + __uint_as_float(rr_[1]); } \
  } while (0)
#define VRD(VOFF, ks, d0, LO, HI) do { LO = vtr(vp0 + (VOFF) + v_rd_off(d0, ks, 0)); HI = vtr(vp0 + (VOFF) + v_rd_off(d0, ks, 1)); } while (0)
#define PAF(k) __builtin_bit_cast(bf16x8, pw##k)
#define MX3(a, b, c) ((VAR & 2) ? (a) : fmaxf(fmaxf((a), (b)), (c)))
#define EX(X, i) do { if constexpr (!(VAR & 2)) X[i] = __builtin_amdgcn_exp2f(X[i]); } while (0)
#define PIN2(X, Y) asm volatile("" : "+v"(X), "+v"(Y))
#define H2(C0, C1, VOFF, DOPV, FIRST) do { \
    s16x4 l0, h0, l1, h1, l2, h2; float ma, mb, rm; \
    if (DOPV) { VRD(VOFF, 0, 0, l0, h0); VRD(VOFF, 0, 1, l1, h1); VRD(VOFF, 0, 2, l2, h2); } SBAR(); \
    if (DOPV) { MF(o[0], PAF(0), VF(l0, h0), o[0]); VRD(VOFF, 0, 3, l0, h0); } ma = MX3(C0[0], C0[1], C1[0]); mb = MX3(C0[2], C0[3], C1[1]); ma = MX3(ma, C1[2], C1[3]); mb = MX3(mb, C0[4], C0[5]); SBAR(); \
    if (DOPV) { MF(o[1], PAF(0), VF(l1, h1), o[1]); VRD(VOFF, 1, 0, l1, h1); } ma = MX3(ma, C0[6], C0[7]); mb = MX3(mb, C1[4], C1[5]); ma = MX3(ma, C1[6], C1[7]); mb = MX3(mb, C0[8], C0[9]); SBAR(); \
    if (DOPV) { MF(o[2], PAF(0), VF(l2, h2), o[2]); VRD(VOFF, 1, 1, l2, h2); } ma = MX3(ma, C0[10], C0[11]); mb = MX3(mb, C1[8], C1[9]); ma = MX3(ma, C1[10], C1[11]); mb = MX3(mb, C0[12], C0[13]); SBAR(); \
    if (DOPV) { MF(o[3], PAF(0), VF(l0, h0), o[3]); VRD(VOFF, 1, 2, l0, h0); } ma = MX3(ma, C0[14], C0[15]); mb = MX3(mb, C1[12], C1[13]); ma = MX3(ma, C1[14], C1[15]); rm = fmaxf(ma, mb); SBAR(); \
    if (DOPV) { MF(o[0], PAF(1), VF(l1, h1), o[0]); VRD(VOFF, 1, 3, l1, h1); } \
    { auto rr_ = __builtin_amdgcn_permlane32_swap(__float_as_uint(rm), __float_as_uint(rm), false, false); rm = fmaxf(__uint_as_float(rr_[0]), __uint_as_float(rr_[1])); } SBAR(); \
    resc = false; \
    if (FIRST || __builtin_expect(__any(rm > THRL), 0)) { const float dl = FIRST ? rm : fmaxf(rm, 0.f); mhat += dl; \
      _Pragma("unroll") for (int r = 0; r < 16; ++r) { C0[r] -= dl; C1[r] -= dl; } \
      _Pragma("unroll") for (int r = 0; r < 16; ++r) negm[r] = -mhat; \
      if (!(FIRST)) { const float f = __builtin_amdgcn_exp2f(-dl); l_reg *= f; if (hi == 0) al_l[r32] = f; resc = true; } } \
    SBAR(); \
    if (DOPV) { MF(o[1], PAF(1), VF(l2, h2), o[1]); VRD(VOFF, 2, 0, l2, h2); } EX(C0, 0); EX(C0, 1); EX(C0, 2); PIN2(C0, C1); SBAR(); \
    if (DOPV) { MF(o[2], PAF(1), VF(l0, h0), o[2]); VRD(VOFF, 2, 1, l0, h0); } EX(C0, 3); EX(C0, 4); EX(C0, 5); PIN2(C0, C1); SBAR(); \
    if (DOPV) { MF(o[3], PAF(1), VF(l1, h1), o[3]); VRD(VOFF, 2, 2, l1, h1); } EX(C0, 6); EX(C0, 7); EX(C0, 8); PIN2(C0, C1); SBAR(); \
    if (DOPV) { MF(o[0], PAF(2), VF(l2, h2), o[0]); VRD(VOFF, 2, 3, l2, h2); } EX(C0, 9); EX(C0, 10); EX(C0, 11); PIN2(C0, C1); SBAR(); \
    if (DOPV) { MF(o[1], PAF(2), VF(l0, h0), o[1]); VRD(VOFF, 3, 0, l0, h0); } EX(C0, 12); EX(C0, 13); EX(C0, 14); PIN2(C0, C1); SBAR(); \
    if (DOPV) { MF(o[2], PAF(2), VF(l1, h1), o[2]); VRD(VOFF, 3, 1, l1, h1); } EX(C0, 15); EX(C1, 0); EX(C1, 1); PIN2(C0, C1); SBAR(); \
    if (DOPV) { MF(o[3], PAF(2), VF(l2, h2), o[3]); VRD(VOFF, 3, 2, l2, h2); } EX(C1, 2); EX(C1, 3); EX(C1, 4); PIN2(C0, C1); SBAR(); \
    if (DOPV) { MF(o[0], PAF(3), VF(l0, h0), o[0]); VRD(VOFF, 3, 3, l0, h0); } EX(C1, 5); EX(C1, 6); EX(C1, 7); PIN2(C0, C1); SBAR(); \
    if (DOPV) { MF(o[1], PAF(3), VF(l1, h1), o[1]); } EX(C1, 8); EX(C1, 9); EX(C1, 10); PIN2(C0, C1); SBAR(); \
    if (DOPV) { MF(o[2], PAF(3), VF(l2, h2), o[2]); } EX(C1, 11); EX(C1, 12); EX(C1, 13); PIN2(C0, C1); SBAR(); \
    if (DOPV) { MF(o[3], PAF(3), VF(l0, h0), o[3]); } EX(C1, 14); EX(C1, 15); PIN2(C0, C1); SBAR(); \
    if (resc) { asm volatile("s_waitcnt lgkmcnt(0)" ::: "memory"); \
      _Pragma("unroll") for (int d = 0; d < 4; ++d) _Pragma("unroll") for (int r = 0; r < 16; ++r) o[d][r] *= al_l[crow(r, hi)]; } \
  } while (0)
#define PVONLY(VOFF) do { _Pragma("unroll") for (int ks = 0; ks < 4; ++ks) _Pragma("unroll") for (int d0 = 0; d0 < 4; ++d0) { s16x4 l_, h_; VRD(VOFF, ks, d0, l_, h_); \
      const bf16x8 pa_ = ks == 0 ? PAF(0) : ks == 1 ? PAF(1) : ks == 2 ? PAF(2) : PAF(3); MF(o[d0], pa_, VF(l_, h_), o[d0]); } } while (0)

  LOADK(0); VMW(); WRITEK(0); LOADK(1); LOADV(0);
  __syncthreads();
  if (comp == 1) __syncthreads();
  VMW(); WRITEK(1); WRITEV(0); SBAR();
  H1(pA0, pA1, pB0, pB1, 0, false);
  __syncthreads();
  LOADK(2); LOADV(1); SBAR();
  H2(pA0, pA1, 0, false, true);
  __syncthreads();
  int va = 0, vb = SHM_V, vc = 2 * SHM_V;
  for (int j = 1; j + 1 < NT; j += 2) {
    VMW(); WRITEK(0); WRITEV(vb); SBAR();
    H1(pB0, pB1, pA0, pA1, SHM_K, true);
    LB();
    LOADK(j + 2); LOADV(j + 1); SBAR();
    H2(pB0, pB1, va, true, false);
    LB();
    VMW(); WRITEK(1); WRITEV(vc); SBAR();
    H1(pA0, pA1, pB0, pB1, 0, true);
    LB();
    if (j + 3 < NT) LOADK(j + 3);
    LOADV(j + 2); SBAR();
    H2(pA0, pA1, vb, true, false);
    LB();
    { const int t = va; va = vc; vc = vb; vb = t; }
  }
  VMW(); WRITEV(vb); SBAR();
  H1(pB0, pB1, pA0, pA1, SHM_K, true);
  __syncthreads();
  H2(pB0, pB1, va, true, false);
  __syncthreads();
  { float sacc = 0.f; unsigned a0_ = 0, a1_ = 0;
    PKA(pB0, 0, a0_, a1_); PKB(pB0, 0, a0_, a1_, pw0); PKA(pB0, 8, a0_, a1_); PKB(pB0, 8, a0_, a1_, pw1); PKA(pB1, 0, a0_, a1_); PKB(pB1, 0, a0_, a1_, pw2); PKA(pB1, 8, a0_, a1_); PKB(pB1, 8, a0_, a1_, pw3);
    auto rr_ = __builtin_amdgcn_permlane32_swap(__float_as_uint(sacc), __float_as_uint(sacc), false, false); l_reg += __uint_as_float(rr_[0]) + __uint_as_float(rr_[1]); }
  SBAR(); PVONLY(vb);
  if (comp == 0) __syncthreads();
  if (hi == 0) li_l[r32] = l_reg; asm volatile("s_waitcnt lgkmcnt(0)" ::: "memory");
  float rli[16];
#pragma unroll
  for (int r = 0; r < 16; ++r) rli[r] = __builtin_amdgcn_rcpf(li_l[crow(r, hi)]);
  __syncthreads();
  float* XO = (float*)lds + qw * (32 * 128);
  if (comp == 1) {
#pragma unroll
    for (int r = 0; r < 16; ++r)
#pragma unroll
      for (int d0 = 0; d0 < 4; ++d0) XO[crow(r, hi) * 128 + d0 * 32 + r32] = o[d0][r] * rli[r];
  }
  __syncthreads();
  if (comp == 0) {
    float ss[16];
#pragma unroll
    for (int r = 0; r < 16; ++r) { float s = 0.f;
#pragma unroll
      for (int d0 = 0; d0 < 4; ++d0) { const float v = o[d0][r] * rli[r] - lam * XO[crow(r, hi) * 128 + d0 * 32 + r32]; o[d0][r] = v; s += v * v; }
      ss[r] = s; }
#pragma unroll
    for (int r = 0; r < 16; ++r) { float s = ss[r]; s += swz_xor<1>(s); s += swz_xor<2>(s); s += swz_xor<4>(s); s += swz_xor<8>(s); s += swz_xor<16>(s);
      ss[r] = osc / sqrtf(s * (1.0f / 128.0f) + EPS); }
    float gam[4];
#pragma unroll
    for (int d0 = 0; d0 < 4; ++d0) gam[d0] = sg[d0 * 32 + r32];
    asm volatile("s_waitcnt lgkmcnt(0)" ::: "memory");
    bf16_t* stg = (bf16_t*)XO;
#pragma unroll
    for (int r = 0; r < 16; ++r)
#pragma unroll
      for (int d0 = 0; d0 < 4; ++d0) stg[crow(r, hi) * 128 + d0 * 32 + r32] = (bf16_t)(cvt2bf(o[d0][r] * ss[r] * gam[d0], 0.f) & 0xffffu);
    asm volatile("s_waitcnt lgkmcnt(0)" ::: "memory");
#pragma unroll
    for (int i = 0; i < 8; ++i) { const int row = i * 4 + (lane >> 4), ch = lane & 15; const u32x4 v = *(const u32x4*)(stg + row * 128 + ch * 8);
      if constexpr (VAR & 16) { asm volatile("" :: "v"(v.x), "v"(v.y), "v"(v.z), "v"(v.w)); } else *(u32x4*)(Ob + (long)(qw * QBLK + row) * LDO + ch * 8) = v; }
  }
  __syncthreads();
#undef LOADK
#undef LOADV
#undef WRITEK
#undef WRITEV
#undef VMW
#undef LB
#undef KF
#undef PKA
#undef PKB
#undef H1
#undef VRD
#undef PAF
#undef MX3
#undef EX
#undef PIN2
#undef H2
#undef PVONLY
}
#undef SBAR
#undef KSWZ
#undef MF
#undef VF
}
typedef GAS unsigned gu32;
#define RLX_AGENT __ATOMIC_RELAXED, __HIP_MEMORY_SCOPE_AGENT
constexpr int PT_OFF = LDSCTL_OFF + 1024;
__device__ __forceinline__ unsigned long long ldptr(volatile LAS unsigned long long* PT, int i) {
    const unsigned long long v = PT[i];
    const unsigned lo = __builtin_amdgcn_readfirstlane((unsigned)v), hi = __builtin_amdgcn_readfirstlane((unsigned)(v >> 32));
    return ((unsigned long long)hi << 32) | lo;
}
#define XB_TMO      128
#define XB_XCNT(j)  (256  + 64 * (j))
#define XB_XSUB(j)  (1280 + 64 * (j))
#define XB_XGEN(j)  (2304 + 64 * (j))
#define XB_TOP      3328
#define XB_TOPGEN   3392
#define XCD_BAR_WORDS 3456
#define XB_SPIN_CAP (1u << 18)

__device__ __forceinline__ unsigned xb_ld(unsigned* p)              { return __hip_atomic_load(p, __ATOMIC_RELAXED, __HIP_MEMORY_SCOPE_AGENT); }
__device__ __forceinline__ unsigned xb_add(unsigned* p, unsigned v) { return __hip_atomic_fetch_add(p, v, __ATOMIC_RELAXED, __HIP_MEMORY_SCOPE_AGENT); }
__device__ __forceinline__ unsigned xb_xcc_id() { return (unsigned)__builtin_amdgcn_s_getreg((3 << 11) | 20) & 0xFu; }
#define XB_SPIN(cond, bar) do { unsigned _sp = 0; while (cond) { __builtin_amdgcn_s_sleep(1); \
    if ((++_sp & 255u) == 0u) { if (xb_ld(&(bar)[XB_TMO])) break; if (_sp > XB_SPIN_CAP) { atomicAdd(&(bar)[XB_TMO], 1u); break; } } } } while (0)

struct XcdBarrier {
    unsigned* bar; unsigned x;
    volatile LAS unsigned* st;
};

__device__ __forceinline__ XcdBarrier xcd_barrier_post(unsigned* bar, volatile LAS unsigned* st) {
    XcdBarrier b; b.bar = bar; b.x = xb_xcc_id(); b.st = st;
    if (threadIdx.x == 0) (void)xb_add(&bar[XB_XCNT(b.x)], 1u);
    return b;
}
__device__ __forceinline__ void xcd_barrier_complete(unsigned* bar, unsigned x, unsigned& nloc, unsigned& nx) {
    const unsigned G = gridDim.x * gridDim.y * gridDim.z;
    unsigned sum, cnt, mine, sp = 0u;
    for (;;) {
        sum = 0u; cnt = 0u; mine = 0u;
#pragma unroll
        for (unsigned j = 0; j < 16; ++j) { const unsigned c = xb_ld(&bar[XB_XCNT(j)]); sum += c; cnt += (c > 0u) ? 1u : 0u; mine = (j == x) ? c : mine; }
        if (sum == G) break;
        __builtin_amdgcn_s_sleep(1);
        if ((++sp & 255u) == 0u) { if (xb_ld(&bar[XB_TMO])) break; if (sp > XB_SPIN_CAP) { atomicAdd(&bar[XB_TMO], 1u); break; } }
    }
    nloc = mine > 0u ? mine : 1u; nx = cnt > 0u ? cnt : 1u;
}

__device__ __forceinline__ void xcd_barrier(const XcdBarrier& b) {
    asm volatile("s_waitcnt vmcnt(0)" ::: "memory");
    __syncthreads();
    if (threadIdx.x == 0) {
        unsigned* bar = b.bar;
        __builtin_amdgcn_s_waitcnt(0);
        unsigned nloc = b.st[0], nx = b.st[1];
        if (nloc == 0u) { xcd_barrier_complete(bar, b.x, nloc, nx); b.st[0] = nloc; b.st[1] = nx; }
        const unsigned old = xb_add(&bar[XB_XSUB(b.x)], 1u);
        const unsigned gen = old / nloc;
        if (old + 1u == (gen + 1u) * nloc) {
            __builtin_amdgcn_fence(__ATOMIC_RELEASE, "agent");
            asm volatile("s_waitcnt vmcnt(0)" ::: "memory");
            const unsigned og = xb_add(&bar[XB_TOP], 1u);
            const unsigned tg = og / nx;
            if (og + 1u == (tg + 1u) * nx) xb_add(&bar[XB_TOPGEN], 1u);
            else XB_SPIN(xb_ld(&bar[XB_TOPGEN]) == tg, bar);
            __builtin_amdgcn_fence(__ATOMIC_ACQUIRE, "agent");
            xb_add(&bar[XB_XGEN(b.x)], 1u);
            asm volatile("s_waitcnt vmcnt(0)" ::: "memory");
        } else {
            XB_SPIN(xb_ld(&bar[XB_XGEN(b.x)]) == gen, bar);
            __builtin_amdgcn_fence(__ATOMIC_ACQUIRE, "agent");
            asm volatile("s_waitcnt vmcnt(0)" ::: "memory");
        }
    }
    __syncthreads();
}
__device__ __forceinline__ float wave_sum(float v) {
    v += swz_xor<1>(v); v += swz_xor<2>(v); v += swz_xor<4>(v); v += swz_xor<8>(v); v += swz_xor<16>(v);
    auto rr = __builtin_amdgcn_permlane32_swap(__float_as_uint(v), __float_as_uint(v), false, false);
    return __uint_as_float(rr[0]) + __uint_as_float(rr[1]);
}
__device__ __forceinline__ unsigned pk2(float lo, float hi) { return cvt2bf(lo, hi); }

template <int MAP  >
__device__ __forceinline__ void transpose_item(const float* W, int Nsrc, int coff, bf16_t* WT, int ldw, int koff, int nblk, LAS float* scr, int item, int lane) {
    const int kb = item / nblk, nb = item % nblk, k0 = 64 * kb, n0 = 32 * nb;
    const int nd = n0 + (lane & 31); const int scol = MAP ? in_map(nd) : nd + coff;
#pragma unroll 8
    for (int i = 0; i < 32; ++i) { const int kk = 2 * i + (lane >> 5); scr[kk * 33 + (lane & 31)] = W[(size_t)(k0 + kk) * Nsrc + scol]; }
    asm volatile("s_waitcnt lgkmcnt(0)" ::: "memory");
    const int c = lane & 7;
#pragma unroll
    for (int j = 0; j < 4; ++j) { const int n = (lane >> 3) + 8 * j; const LAS float* s = scr + (8 * c) * 33 + n;
        u32x4 o; o.x = pk2(s[0 * 33], s[1 * 33]); o.y = pk2(s[2 * 33], s[3 * 33]); o.z = pk2(s[4 * 33], s[5 * 33]); o.w = pk2(s[6 * 33], s[7 * 33]);
        *(u32x4*)(WT + (size_t)(n0 + n) * ldw + koff + k0 + 8 * c) = o; }
    asm volatile("s_waitcnt lgkmcnt(0)" ::: "memory");
}
struct WSrc { const float *w_in, *wo_f, *wo_a, *wo_c, *wo_p, *w_out, *w_up, *w_down; };
constexpr int IT_A = 16 * 208;
constexpr int IT_B0 = 4 * 32, IT_B1 = 8 * 32, IT_B2 = 4 * 32, IT_B3 = 4 * 32, IT_B4 = 16 * 32, IT_B5 = 16 * 88, IT_B6 = 16 * 88, IT_B7 = 44 * 32;
constexpr int IT_B = IT_B0 + IT_B1 + IT_B2 + IT_B3 + IT_B4 + IT_B5 + IT_B6 + IT_B7;
__device__ __forceinline__ void convert_A(const WSrc& S, unsigned char* ws, LAS float* scr, int gw, int NGW, int lane) {
    for (int it = gw; it < IT_A; it += NGW) transpose_item<1>(S.w_in, NIN, 0, (bf16_t*)(ws + WS_WA), 1024, 0, 208, scr, it, lane);
}
__device__ __forceinline__ void convert_B(const WSrc& S, unsigned char* ws, LAS float* scr, int gw, int NGW, int lane) {
    for (int it = gw; it < IT_B; it += NGW) { int r = it;
        if (r < IT_B0) { transpose_item<0>(S.wo_f, 1024, 0, (bf16_t*)(ws + WS_WCAT), KCAT, 0, 32, scr, r, lane); continue; } r -= IT_B0;
        if (r < IT_B1) { transpose_item<0>(S.wo_a, 1024, 0, (bf16_t*)(ws + WS_WCAT), KCAT, 256, 32, scr, r, lane); continue; } r -= IT_B1;
        if (r < IT_B2) { transpose_item<0>(S.wo_c, 1024, 0, (bf16_t*)(ws + WS_WCAT), KCAT, 768, 32, scr, r, lane); continue; } r -= IT_B2;
        if (r < IT_B3) { transpose_item<0>(S.wo_p, 1024, 0, (bf16_t*)(ws + WS_WCAT), KCAT, 1024, 32, scr, r, lane); continue; } r -= IT_B3;
        if (r < IT_B4) { transpose_item<0>(S.w_out, 1024, 0, (bf16_t*)(ws + WS_WOUT), 1024, 0, 32, scr, r, lane); continue; } r -= IT_B4;
        if (r < IT_B5) { transpose_item<0>(S.w_up, 2 * DFF, DFF, (bf16_t*)(ws + WS_WUPG), 1024, 0, 88, scr, r, lane); continue; } r -= IT_B5;
        if (r < IT_B6) { transpose_item<0>(S.w_up, 2 * DFF, 0, (bf16_t*)(ws + WS_WUPV), 1024, 0, 88, scr, r, lane); continue; } r -= IT_B6;
        transpose_item<0>(S.w_down, 1024, 0, (bf16_t*)(ws + WS_WDN), DFF, 0, 32, scr, r, lane);
    }
}

__device__ __forceinline__ void mod_phase(const float* c, const float* c_ctx, const float* ada_w, const float* ada_b, float* MOD, LAS unsigned char* lds, int vcu, int G, int tid, int wave, int lane) {
    LAS float* sil = (LAS float*)lds;
    LAS float* red = (LAS float*)(lds + 12288);
    for (int i = tid; i < 3072; i += 512) { const float v = i < 2048 ? c[i] : c_ctx[i - 2048]; sil[i] = v * sigm(v); }
    __syncthreads();
    for (int item = vcu; item < 192; item += G) {
        const int l = item / 96, n = (item % 96) * 64 + lane;
        const float* W = ada_w + (size_t)l * 1024 * 6144 + n;
        float a0 = 0.f, a1 = 0.f, a2 = 0.f;
        for (int k = wave * 128; k < wave * 128 + 128; k += 8) { float w[8];
#pragma unroll
            for (int i = 0; i < 8; ++i) w[i] = W[(size_t)(k + i) * 6144];
#pragma unroll
            for (int i = 0; i < 8; ++i) { a0 += sil[k + i] * w[i]; a1 += sil[1024 + k + i] * w[i]; a2 += sil[2048 + k + i] * w[i]; } }
        red[(wave * 3 + 0) * 64 + lane] = a0; red[(wave * 3 + 1) * 64 + lane] = a1; red[(wave * 3 + 2) * 64 + lane] = a2;
        __syncthreads();
        if (wave < 3) { float s = ada_b[l * 6144 + n];
#pragma unroll
            for (int w = 0; w < 8; ++w) s += red[(w * 3 + wave) * 64 + lane];
            MOD[(size_t)(l * 3 + wave) * 6144 + n] = s; }
        __syncthreads();
    }
}
__device__ __forceinline__ void tables_phase(float* ROPE, f32x2* TW, int gt, int NGT) {
    for (int i = gt; i < 192 * 16; i += NGT) { const int pos = i >> 4, f = i & 15; const float inv = powf(10000.0f, -(float)f / 16.0f); const float ang = (float)(pos < 128 ? pos : pos - 128) * inv;
        float s, c; sincosf(ang, &s, &c); ROPE[pos * 32 + f] = c; ROPE[pos * 32 + 16 + f] = s; }
    for (int i = gt; i < 8192; i += NGT) { float s, c; sincospif((float)i * (1.0f / 4096.0f), &s, &c); TW[i] = (f32x2){c, -s}; }
}

__device__ __forceinline__ void norm_phase(const float* src_lat, const float* src_ctx, int nrows, const float* gamma, const float* mod, int shoff, int scoff, bf16_t* HX, int gw, int NGW, int lane) {
    for (int m = gw; m < nrows; m += NGW) {
        const float* xr = m < ML ? src_lat + (size_t)m * DM : src_ctx + (size_t)(m - ML) * DM;
        const float* md = mod + (m < SEQ ? 0 : m < ML ? 1 : 2) * 6144;
        f32x4 v[4]; float s = 0.f;
#pragma unroll
        for (int j = 0; j < 4; ++j) { v[j] = ((const f32x4*)xr)[lane + 64 * j]; s += (v[j].x * v[j].x + v[j].y * v[j].y) + (v[j].z * v[j].z + v[j].w * v[j].w); }
        const float rstd = 1.0f / sqrtf(wave_sum(s) * (1.0f / DM) + EPS);
#pragma unroll
        for (int j = 0; j < 4; ++j) { const int col = 4 * lane + 256 * j;
            const f32x4 g = *(const f32x4*)(gamma + col), sc = *(const f32x4*)(md + scoff + col), sh = *(const f32x4*)(md + shoff + col);
            const f32x4 o = v[j] * rstd * g * (sc + 1.0f) + sh;
            u32x2 w; w.x = pk2(o.x, o.y); w.y = pk2(o.z, o.w); *(u32x2*)(HX + (size_t)m * DM + col) = w; }
    }
}
__device__ __forceinline__ void final_norm_phase(float* x, const float* gamma, int gw, int NGW, int lane) {
    for (int m = gw; m < ML; m += NGW) { f32x4* xr = (f32x4*)(x + (size_t)m * DM);
        f32x4 v[4]; float s = 0.f;
#pragma unroll
        for (int j = 0; j < 4; ++j) { v[j] = xr[lane + 64 * j]; s += (v[j].x * v[j].x + v[j].y * v[j].y) + (v[j].z * v[j].z + v[j].w * v[j].w); }
        const float rstd = 1.0f / sqrtf(wave_sum(s) * (1.0f / DM) + EPS);
#pragma unroll
        for (int j = 0; j < 4; ++j) { const f32x4 g = *(const f32x4*)(gamma + 4 * lane + 256 * j); xr[lane + 64 * j] = v[j] * rstd * g; }
    }
}

#define SWZ(row, colB) ((row) * 256 + ((colB) ^ (((row) & 7) << 4)))
__device__ __forceinline__ int crow_(int r, int hi) { return (r & 3) + 8 * (r >> 2) + 4 * hi; }
__device__ __forceinline__ bf16x8 pack_bf8(const float* v) { u32x4 w; w.x = pk2(v[0], v[1]); w.y = pk2(v[2], v[3]); w.z = pk2(v[4], v[5]); w.w = pk2(v[6], v[7]); return __builtin_bit_cast(bf16x8, w); }
__device__ __forceinline__ void fft1_phase(const bf16_t* UF, const f32x2* TW, unsigned* FA, LAS unsigned char* lds, int vcu, int G, int tid, int wave, int lane) {
    const int tr = wave >> 1, tc = wave & 1, r32 = lane & 31, hi = lane >> 5;
    bf16x8 aRe[8], aIm[8];
#pragma unroll
    for (int ks = 0; ks < 8; ++ks) { float cv[8], sv[8];
#pragma unroll
        for (int j = 0; j < 8; ++j) { const int idx = ((32 * tr + r32) * (16 * ks + 8 * hi + j)) & 127; float s, c; sincospif((float)idx * (1.0f / 64.0f), &s, &c); cv[j] = c; sv[j] = -s; }
        aRe[ks] = pack_bf8(cv); aIm[ks] = pack_bf8(sv); }
    for (int item = vcu; item < 512; item += G) {
        const int b = item >> 8, g = (item >> 6) & 3, l2 = item & 63;
#pragma unroll
        for (int i = 0; i < 2; ++i) { const int q = tid + 512 * i, l1 = q >> 3, c8 = (q & 7) * 8;
            const u32x4 v = *(const u32x4*)(UF + (size_t)(b * SEQ + 64 * l1 + l2) * 256 + g * 64 + c8);
#pragma unroll
            for (int e = 0; e < 8; ++e) { const unsigned w = v[e >> 1]; *(LAS bf16_t*)(lds + SWZ(c8 + e, l1 * 2)) = (bf16_t)((e & 1) ? (w >> 16) : (w & 0xffffu)); } }
        __syncthreads();
        f32x16 re = {}, im = {};
#pragma unroll
        for (int ks = 0; ks < 8; ++ks) { const bf16x8 bx = *(const LAS bf16x8*)(lds + SWZ(32 * tc + r32, (16 * ks + 8 * hi) * 2));
            re = __builtin_amdgcn_mfma_f32_32x32x16_bf16(aRe[ks], bx, re, 0, 0, 0); im = __builtin_amdgcn_mfma_f32_32x32x16_bf16(aIm[ks], bx, im, 0, 0, 0); }
        unsigned* dst = FA + ((size_t)((b * 4 + g) * 64 + l2) * 128) * 64 + 32 * tc + r32;
#pragma unroll
        for (int r = 0; r < 16; ++r) { const int k1 = 32 * tr + crow_(r, hi); const f32x2 t = TW[k1 * l2];
            dst[(size_t)k1 * 64] = pk2(re[r] * t.x - im[r] * t.y, re[r] * t.y + im[r] * t.x); }
        __syncthreads();
    }
}
__device__ __forceinline__ void fft2_phase(const unsigned* FA, bf16_t* ACAT, LAS unsigned char* lds, int vcu, int G, int tid, int wave, int lane) {
    const int tr = wave >> 1, tc = wave & 1, r32 = lane & 31, hi = lane >> 5;
    bf16x8 a2[8], b3[8];
#pragma unroll
    for (int ks = 0; ks < 8; ++ks) { float av[8], bv[8];
#pragma unroll
        for (int j = 0; j < 8; ++j) { const int R = 32 * tr + r32, k = 16 * ks + 8 * hi + j, k2 = R & 63, ll = k & 63; float s, c; sincospif((float)((k2 * ll) & 63) * (1.0f / 32.0f), &s, &c);
            av[j] = (R < 64) ? ((k < 64) ? c : s) : ((k < 64) ? -s : c);
            const int m = 32 * tc + r32; float s2, c2; sincospif((float)((m * ll) & 63) * (1.0f / 32.0f), &s2, &c2); bv[j] = (k < 64) ? c2 : s2; }
        a2[ks] = pack_bf8(av); b3[ks] = pack_bf8(bv); }
    LAS unsigned char* Bt = lds;
    LAS unsigned char* Zt = lds + 16384;
    for (int item = vcu; item < 1024; item += G) {
        const int b = item >> 9, g = (item >> 7) & 3, k1 = item & 127;
#pragma unroll
        for (int i = 0; i < 2; ++i) { const int q = tid + 512 * i, l2 = q >> 4, c4 = (q & 15) * 4;
            const u32x4 v = *(const u32x4*)(FA + ((size_t)((b * 4 + g) * 64 + l2) * 128 + k1) * 64 + c4);
#pragma unroll
            for (int e = 0; e < 4; ++e) { *(LAS bf16_t*)(Bt + SWZ(c4 + e, l2 * 2)) = (bf16_t)(v[e] & 0xffffu); *(LAS bf16_t*)(Bt + SWZ(c4 + e, (64 + l2) * 2)) = (bf16_t)(v[e] >> 16); } }
        __syncthreads();
        f32x16 z = {};
#pragma unroll
        for (int ks = 0; ks < 8; ++ks) { const bf16x8 bx = *(const LAS bf16x8*)(Bt + SWZ(32 * tc + r32, (16 * ks + 8 * hi) * 2)); z = __builtin_amdgcn_mfma_f32_32x32x16_bf16(a2[ks], bx, z, 0, 0, 0); }
#pragma unroll
        for (int r = 0; r < 16; ++r) { const int R = 32 * tr + crow_(r, hi); *(LAS bf16_t*)(Zt + SWZ(R & 63, ((R >> 6) * 64 + 32 * tc + r32) * 2)) = (bf16_t)(pk2(z[r], 0.f) & 0xffffu); }
        __syncthreads();
        if (wave < 4) { f32x16 y = {};
#pragma unroll
            for (int ks = 0; ks < 8; ++ks) { const bf16x8 ax = *(const LAS bf16x8*)(Zt + SWZ(32 * tr + r32, (16 * ks + 8 * hi) * 2)); y = __builtin_amdgcn_mfma_f32_32x32x16_bf16(ax, b3[ks], y, 0, 0, 0); }
#pragma unroll
            for (int r = 0; r < 16; ++r) { const int k2 = 32 * tr + crow_(r, hi); ACAT[(size_t)(b * SEQ + k1 + 128 * k2) * KCAT + g * 64 + 32 * tc + r32] = (bf16_t)(pk2(y[r] * 0.001381067932f, 0.f) & 0xffffu); } }
        __syncthreads();
    }
}
__device__ __forceinline__ void ctxdft_item(int item, const bf16_t* UF, bf16_t* ACAT, LAS unsigned char* lds, int tid, int wave, int lane) {
    const int b = item >> 4, g = (item >> 2) & 3, kc = item & 3;
    const int tr = wave >> 1, tc = wave & 1, r32 = lane & 31, hi = lane >> 5;
    LAS unsigned char* Xt = lds;
    LAS unsigned char* Zt = lds + 32768;
#pragma unroll
    for (int i = 0; i < 4; ++i) { const int q = tid + 512 * i, l = q >> 3, c8 = (q & 7) * 8;
        const u32x4 v = *(const u32x4*)(UF + (size_t)(ML + b * CTXL + l) * 256 + g * 64 + c8);
#pragma unroll
        for (int e = 0; e < 8; ++e) { const unsigned w = v[e >> 1]; const int row = c8 + e; *(LAS bf16_t*)(Xt + row * 512 + ((((l >> 3) ^ (row & 7)) << 4) | ((l & 7) * 2))) = (bf16_t)((e & 1) ? (w >> 16) : (w & 0xffffu)); } }
    __syncthreads();
    f32x16 z = {};
    const int R = 32 * tr + r32, kk = 64 * kc + (R & 63);
#pragma unroll 4
    for (int ks = 0; ks < 16; ++ks) { float av[8];
#pragma unroll
        for (int j = 0; j < 8; ++j) { const int l = 16 * ks + 8 * hi + j; float s, c; sincospif((float)((kk * l) & 255) * (1.0f / 128.0f), &s, &c); av[j] = (R < 64) ? c : -s; }
        const int row = 32 * tc + r32, ch = (16 * ks + 8 * hi) >> 3;
        const bf16x8 bx = *(const LAS bf16x8*)(Xt + row * 512 + ((ch ^ (row & 7)) << 4));
        z = __builtin_amdgcn_mfma_f32_32x32x16_bf16(pack_bf8(av), bx, z, 0, 0, 0); }
#pragma unroll
    for (int r = 0; r < 16; ++r) { const int Rr = 32 * tr + crow_(r, hi); *(LAS bf16_t*)(Zt + SWZ(Rr & 63, ((Rr >> 6) * 64 + 32 * tc + r32) * 2)) = (bf16_t)(pk2(z[r], 0.f) & 0xffffu); }
    __syncthreads();
    if (wave < 4) { f32x16 y = {};
#pragma unroll
        for (int ks = 0; ks < 8; ++ks) { float bv[8];
#pragma unroll
            for (int j = 0; j < 8; ++j) { const int k = 16 * ks + 8 * hi + j, m = 32 * tc + r32; float s2, c2; sincospif((float)((m * (k & 63)) & 63) * (1.0f / 32.0f), &s2, &c2); bv[j] = (k < 64) ? c2 : s2; }
            const bf16x8 ax = *(const LAS bf16x8*)(Zt + SWZ(32 * tr + r32, (16 * ks + 8 * hi) * 2)); y = __builtin_amdgcn_mfma_f32_32x32x16_bf16(ax, pack_bf8(bv), y, 0, 0, 0); }
#pragma unroll
        for (int r = 0; r < 16; ++r) { const int k = 64 * kc + 32 * tr + crow_(r, hi); ACAT[(size_t)(ML + b * CTXL + k) * KCAT + g * 64 + 32 * tc + r32] = (bf16_t)(pk2(y[r] * (1.0f / 128.0f), 0.f) & 0xffffu); } }
    __syncthreads();
}

__device__ __forceinline__ void conv_item(int item, const bf16_t* ZG, const float* cw  , const float* cb, const float* lng, const float* lnb, bf16_t* ACAT, LAS unsigned char* lds, int tid, int wave, int lane) {
    const int row0 = item * 64; const bool lat = row0 < ML; const int s0 = lat ? (row0 & ~(SEQ - 1)) : (ML + ((row0 - ML) & ~(CTXL - 1))), s1 = s0 + (lat ? SEQ : CTXL);
    LAS float* zt = (LAS float*)lds;
#pragma unroll
    for (int i = 0; i < 6; ++i) { const int q = tid + 512 * i; if (q < 94 * 32) { const int rr = q >> 5, c8 = (q & 31) * 8, gr = row0 - 15 + rr;
        u32x4 v = {0u, 0u, 0u, 0u}; if (gr >= s0 && gr < s1) v = *(const u32x4*)(ZG + (size_t)gr * 256 + c8);
        *(LAS f32x4*)(zt + rr * 256 + c8) = (f32x4){bf2f(v.x & 0xffffu), __uint_as_float(v.x & 0xffff0000u), bf2f(v.y & 0xffffu), __uint_as_float(v.y & 0xffff0000u)};
        *(LAS f32x4*)(zt + rr * 256 + c8 + 4) = (f32x4){bf2f(v.z & 0xffffu), __uint_as_float(v.z & 0xffff0000u), bf2f(v.w & 0xffffu), __uint_as_float(v.w & 0xffff0000u)}; } }
    const int c = tid & 255, half = tid >> 8;
    float w[31];
#pragma unroll
    for (int t = 0; t < 31; ++t) w[t] = cw[t * 256 + c];
    float acc[32]; const float bias = cb[c];
    __syncthreads();
#pragma unroll
    for (int r0 = 0; r0 < 32; r0 += 4) { float v[34];
#pragma unroll
        for (int i = 0; i < 34; ++i) v[i] = zt[(half * 32 + r0 + i) * 256 + c];
        float a0 = bias, a1 = bias, a2 = bias, a3 = bias;
#pragma unroll
        for (int t = 0; t < 31; ++t) { a0 += w[t] * v[t]; a1 += w[t] * v[t + 1]; a2 += w[t] * v[t + 2]; a3 += w[t] * v[t + 3]; }
        acc[r0] = a0; acc[r0 + 1] = a1; acc[r0 + 2] = a2; acc[r0 + 3] = a3; }
    __syncthreads();
#pragma unroll
    for (int r = 0; r < 32; ++r) zt[(half * 32 + r) * 256 + c] = acc[r];
    __syncthreads();
    const f32x4 gg = *(const f32x4*)(lng + 4 * lane), bb = *(const f32x4*)(lnb + 4 * lane);
#pragma unroll
    for (int i = 0; i < 8; ++i) { const int r = wave * 8 + i; const f32x4 v = *(const LAS f32x4*)(zt + r * 256 + 4 * lane);
        const float mu = wave_sum((v.x + v.y) + (v.z + v.w)) * (1.0f / 256.0f); const f32x4 d = v - mu;
        const float var = wave_sum((d.x * d.x + d.y * d.y) + (d.z * d.z + d.w * d.w)) * (1.0f / 256.0f); const float rs = 1.0f / sqrtf(var + EPS);
        f32x4 o = d * rs * gg + bb; o.x *= sigm(o.x); o.y *= sigm(o.y); o.z *= sigm(o.z); o.w *= sigm(o.w);
        u32x2 pw; pw.x = pk2(o.x, o.y); pw.y = pk2(o.z, o.w); *(u32x2*)(ACAT + (size_t)(row0 + r) * KCAT + 768 + 4 * lane) = pw; }
    __syncthreads();
}
__device__ __forceinline__ void pool_phase(const bf16_t* UP, const float* pw  , const float* psc, bf16_t* ACAT, int nitems, int first, LAS unsigned char* lds, int G, int tid, int wave, int lane) {
    const int g = wave >> 1, tc = wave & 1, r32 = lane & 31, hi = lane >> 5;
    bf16x8 bw[4];
#pragma unroll
    for (int ks = 0; ks < 4; ++ks) { float v[8];
#pragma unroll
        for (int j = 0; j < 8; ++j) v[j] = pw[g * 4096 + (16 * ks + 8 * hi + j) * 64 + 32 * tc + r32];
        bw[ks] = pack_bf8(v); }
    const float osc = psc[g * 64 + 32 * tc + r32];
    LAS float* ut = (LAS float*)lds;
    LAS unsigned char* dt = lds + 81920;
    for (int item = first; item < nitems; item += G) {
        const int row0 = item * 64; const bool lat = row0 < ML; const int s0 = lat ? (row0 & ~(SEQ - 1)) : (ML + ((row0 - ML) & ~(CTXL - 1))), L = lat ? SEQ : CTXL, s1 = s0 + L;
#pragma unroll
        for (int i = 0; i < 5; ++i) { const int q = tid + 512 * i, rr = q >> 5, c8 = (q & 31) * 8, gr = row0 - 8 + rr;
            u32x4 v = {0u, 0u, 0u, 0u}; if (gr >= s0 && gr < s1) v = *(const u32x4*)(UP + (size_t)gr * 256 + c8);
            *(LAS f32x4*)(ut + rr * 256 + c8) = (f32x4){bf2f(v.x & 0xffffu), __uint_as_float(v.x & 0xffff0000u), bf2f(v.y & 0xffffu), __uint_as_float(v.y & 0xffff0000u)};
            *(LAS f32x4*)(ut + rr * 256 + c8 + 4) = (f32x4){bf2f(v.z & 0xffffu), __uint_as_float(v.z & 0xffff0000u), bf2f(v.w & 0xffffu), __uint_as_float(v.w & 0xffff0000u)}; }
        __syncthreads();
#pragma unroll
        for (int i = 0; i < 4; ++i) { const int q = tid + 512 * i, lr = q >> 5, c8 = (q & 31) * 8, gg = c8 >> 6, hw = 1 << gg, tt = row0 + lr - s0;
            f32x4 sa = {0.f, 0.f, 0.f, 0.f}, sb = {0.f, 0.f, 0.f, 0.f};
            for (int o = -hw; o < hw; ++o) { sa += *(const LAS f32x4*)(ut + (lr + 8 + o) * 256 + c8); sb += *(const LAS f32x4*)(ut + (lr + 8 + o) * 256 + c8 + 4); }
            const int lo = tt - hw < 0 ? 0 : tt - hw, hh = tt + hw - 1 > L - 1 ? L - 1 : tt + hw - 1; const float inv = 1.0f / (float)(hh - lo + 1);
            const f32x4 ua = *(const LAS f32x4*)(ut + (lr + 8) * 256 + c8), ub = *(const LAS f32x4*)(ut + (lr + 8) * 256 + c8 + 4);
            const f32x4 da = sa * inv - ua, db = sb * inv - ub;
            u32x4 w; w.x = pk2(da.x, da.y); w.y = pk2(da.z, da.w); w.z = pk2(db.x, db.y); w.w = pk2(db.z, db.w);
            *(LAS u32x4*)(dt + lr * 512 + ((((c8 >> 3) ^ (lr & 7)) << 4))) = w; }
        __syncthreads();
#pragma unroll
        for (int rt = 0; rt < 2; ++rt) { f32x16 y = {};
#pragma unroll
            for (int ks = 0; ks < 4; ++ks) { const int row = 32 * rt + r32, ch = (g * 64 + 16 * ks + 8 * hi) >> 3;
                const bf16x8 ax = *(const LAS bf16x8*)(dt + row * 512 + ((ch ^ (row & 7)) << 4)); y = __builtin_amdgcn_mfma_f32_32x32x16_bf16(ax, bw[ks], y, 0, 0, 0); }
#pragma unroll
            for (int r = 0; r < 16; ++r) ACAT[(size_t)(row0 + 32 * rt + crow_(r, hi)) * KCAT + 1024 + g * 64 + 32 * tc + r32] = (bf16_t)(pk2(y[r] * osc, 0.f) & 0xffffu); }
        __syncthreads();
    }
}
constexpr int NPHASE = 22;
struct Args { const float* in[30]; float* out; unsigned char* ws; int ph_lo, ph_hi, li, pad; };
__global__ void __launch_bounds__(512, 2) __attribute__((amdgpu_waves_per_eu(2, 2))) fwd_kernel(Args args) {
    extern __shared__ __attribute__((aligned(16))) unsigned char lds[];
    LAS unsigned char* L = (LAS unsigned char*)lds;
    volatile LAS unsigned* MISC = (volatile LAS unsigned*)(L + MISC_OFF);
    const int tid0 = threadIdx.x; const int wave0 = __builtin_amdgcn_readfirstlane(tid0 >> 6);
    const int G = gridDim.x, bx0 = blockIdx.x, vcu0 = (G % 8 == 0) ? (bx0 % 8) * (G / 8) + bx0 / 8 : bx0;
    const int NGW = G * 8;
    gu32* ctl = (gu32*)(args.ws + WS_CTL);
    for (int u = tid0; u < (LDS_BYTES - LDSCTL_OFF) / 4; u += 512) ((LAS unsigned*)(L + LDSCTL_OFF))[u] = 0u;
    __syncthreads();
    volatile LAS unsigned long long* PT = (volatile LAS unsigned long long*)(L + PT_OFF);
    if (tid0 < 32) PT[tid0] = ((const __attribute__((address_space(4))) unsigned long long*)__builtin_amdgcn_kernarg_segment_ptr())[tid0];
    __syncthreads();
#define FRESH() int tid, vcu = vcu0, bx = bx0; asm volatile("v_mbcnt_lo_u32_b32 %0, -1, 0\n\tv_mbcnt_hi_u32_b32 %0, -1, %0" : "=v"(tid)); tid += wave0 * 64; asm volatile("" : "+v"(tid), "+s"(vcu), "+s"(bx)); const int lane = tid & 63, wave = __builtin_amdgcn_readfirstlane(tid >> 6), gw = vcu * 8 + wave; (void)lane; (void)gw; (void)bx; \
    LAS float* scr = (LAS float*)(L + wave * 16384); (void)scr;
#define PTR(i) ((const float*)(const GAS float*)ldptr(PT, (i)))
#define OUTP ((float*)(GAS float*)ldptr(PT, 30))
#define WSP ((unsigned char*)(GAS unsigned char*)ldptr(PT, 31))
    XcdBarrier bar; bar.bar = (unsigned*)(ctl + CW_BAR) + args.li * XCD_BAR_WORDS; bar.x = 0; bar.st = nullptr;
    if (MK_N_LAUNCHES != NPHASE) bar = xcd_barrier_post((unsigned*)(ctl + CW_BAR) + args.li * XCD_BAR_WORDS, MISC + 8);
#define GRID_BAR() do { if (MK_N_LAUNCHES == NPHASE) { if (tid0 == 0) __hip_atomic_store(ctl + CW_TMO, 0xBADBA0u, RLX_AGENT); } else { xcd_barrier(bar); } } while (0)
    const int lo = args.ph_lo, hi = args.ph_hi;
#ifndef PHASE_MASK
#define PHASE_MASK 0xFFF
#endif
#ifndef ATTM
#define ATTM 3
#endif
#ifndef X1REP
#define X1REP 0
#endif
#ifndef X1M
#define X1M 31
#endif
#define PH_EN(kind) ((PHASE_MASK >> (kind)) & 1)
#ifndef REP_MASK
#define REP_MASK 0
#endif
#define NREP(kind) (((REP_MASK >> (kind)) & 1) ? 2 : 1)
#define IN(k) (lo <= (k) && (k) < hi)
#define BOTH(k) (IN(k) && IN((k) + 1))
#define WSRC(S, l) WSrc S; S.w_in = PTR(8) + (size_t)(l) * 1024 * NIN; S.wo_f = PTR(20) + (size_t)(l) * 256 * 1024; S.wo_a = PTR(21) + (size_t)(l) * 512 * 1024; \
    S.wo_c = PTR(22) + (size_t)(l) * 256 * 1024; S.wo_p = PTR(23) + (size_t)(l) * 256 * 1024; S.w_out = PTR(24) + (size_t)(l) * 1024 * 1024; \
    S.w_up = PTR(25) + (size_t)(l) * 1024 * 2 * DFF; S.w_down = PTR(28) + (size_t)(l) * DFF * 1024;
#define ws WSP
#define MOD ((float*)(WSP + WS_MOD))
#define ROPE ((float*)(WSP + WS_ROPE))
#define TW ((f32x2*)(WSP + WS_TW))
#define XC ((float*)(WSP + WS_XC))
#define HX ((bf16_t*)(WSP + WS_HX))
#define FA ((f32x2*)(WSP + WS_FA))
#define Qb ((bf16_t*)(WSP + WS_Q))
#define Kb ((bf16_t*)(WSP + WS_K))
#define Vb ((bf16_t*)(WSP + WS_V))
#define Yb ((bf16_t*)(WSP + WS_Y))
#define Gb (WSP + WS_G)
#define ACAT ((bf16_t*)(WSP + WS_ACAT))
#define UF ((bf16_t*)(WSP + WS_UF))
#define ZG ((bf16_t*)(WSP + WS_ZG))
#define UP ((bf16_t*)(WSP + WS_UP))
#define GT ((bf16_t*)(WSP + WS_GT))
#define Hb ((bf16_t*)(WSP + WS_H))

    for (int rep = 0; rep < NREP(0); ++rep) if (PH_EN(0) && IN(0)) { FRESH();
        mod_phase(PTR(1), PTR(3), PTR(6), PTR(7), MOD, L, vcu, G, tid, wave, lane);
        tables_phase(ROPE, TW, vcu * 512 + tid, G * 512);
        WSRC(S0, 0); convert_A(S0, ws, scr, gw, NGW, lane); convert_B(S0, ws, scr, gw, NGW, lane);
        if (BOTH(0)) GRID_BAR();
    }
#pragma nounroll
    for (int l = 0; l < 2; ++l) {
        const int pb = 1 + 10 * l;
#define mod (MOD + l * 3 * 6144)
#define xl ((l == 0) ? PTR(0) : (const float*)OUTP)
#define xc ((l == 0) ? PTR(2) : (const float*)XC)
        const int Mact = (l == 0) ? MT : ML;
        for (int rep = 0; rep < NREP(1); ++rep) if (PH_EN(1) && IN(pb)) { FRESH(); norm_phase(xl, xc, MT, PTR(4) + l * DM, mod, 0, 1024, HX, gw, NGW, lane); if (BOTH(pb)) GRID_BAR(); }
        for (int rep = 0; rep < NREP(2); ++rep) if (PH_EN(2) && IN(pb + 1)) { FRESH();
            pg8::Gemm g{HX, (const bf16_t*)(ws + WS_WA), MT, NIN, 1024}; pg8::StaticOrder S; S.init(MT, NIN, G, bx);
            pg8::EpiIn E{UF, ZG, UP, Qb, Kb, Vb, Gb, ROPE};
            pg8::gemm_phase<pg8::EpiIn, pg8::StaticOrder, true, true>(L, g, S, E, tid);
            if (BOTH(pb + 1)) GRID_BAR();
        }
        for (int rep = 0; rep < NREP(3); ++rep) if (PH_EN(3) && IN(pb + 2)) { FRESH();
            for (int r1 = 0; r1 < ((X1REP & 1) ? 2 : 1); ++r1) if (X1M & 1) fft1_phase(UF, TW, (unsigned*)FA, L, vcu, G, tid, wave, lane);
            for (int r1 = 0; r1 < ((X1REP & 2) ? 2 : 1); ++r1) if (X1M & 2) for (int it = vcu; it < Mact / 64; it += G) conv_item(it, ZG, PTR(14) + l * 31 * 256, PTR(15) + l * 256, PTR(16) + l * 256, PTR(17) + l * 256, ACAT, L, tid, wave, lane);
            for (int r1 = 0; r1 < ((X1REP & 4) ? 2 : 1); ++r1) if (X1M & 4) pool_phase(UP, PTR(18) + l * 4 * 4096, PTR(19) + l * 256, ACAT, Mact / 64, (vcu + 248) % G, L, G, tid, wave, lane);
            if ((X1M & 8) && l == 0) for (int it = (vcu + 224) % G; it < 32; it += G) ctxdft_item(it, UF, ACAT, L, tid, wave, lane);
            WSRC(S1, 1);
            for (int r1 = 0; r1 < ((X1REP & 16) ? 2 : 1); ++r1) if (!(X1M & 16)) {} else if (l == 0) convert_A(S1, ws, scr, gw, NGW, lane); else convert_B(S1, ws, scr, gw, NGW, lane);
            if (BOTH(pb + 2)) GRID_BAR();
        }
        for (int rep = 0; rep < NREP(4); ++rep) if (PH_EN(4) && IN(pb + 3)) { FRESH();
            if (ATTM & 1) fft2_phase((const unsigned*)FA, ACAT, L, vcu, G, tid, wave, lane);
            const float lam_init = (l == 0) ? 0.2f : 0.35550906759096926f;
            const float d1 = wave_sum(PTR(9)[l * 64 + lane] * PTR(10)[l * 64 + lane]), d2 = wave_sum(PTR(11)[l * 64 + lane] * PTR(12)[l * 64 + lane]);
            const float lam = __builtin_bit_cast(float, __builtin_amdgcn_readfirstlane(__builtin_bit_cast(int, expf(d1) - expf(d2) + lam_init)));
            const int nun = 512 + (l == 0 ? 16 : 0);
            if (ATTM & 2) for (int u = vcu; u < nun; u += G) {
                int b, h, row0, nkeys;
                if (u < 512) { const int x = (u & 255) >> 5, qb = (u & 31) + 32 * (u >> 8); b = x >> 2; h = x & 3; row0 = b * SEQ + qb * 128; nkeys = KVL; }
                else { const int v = u - 512; b = v >> 3; h = (v >> 1) & 3; row0 = ML + b * CTXL + (v & 1) * 128; nkeys = CTXL; }
#if ATT_V == 2
                att2::attn_unit<0>(Qb + (size_t)row0 * 512 + h * 128,
#else
                att::attn_unit<0>(Qb + (size_t)row0 * 512 + h * 128,
#endif
                               Kb + (size_t)b * KVL * 512 + h * 128, Vb + (size_t)b * KVL * 512 + h * 128, nkeys,
                               ACAT + (size_t)row0 * KCAT + 256 + h * 128, lam, 1.0f - lam_init, PTR(13) + l * 128, (char*)lds, tid);
            }
#if defined(ATT_PROBE)
            int tid2 = tid, vcu2 = vcu; asm volatile("" : "+v"(tid2), "+s"(vcu2));
            for (int u = vcu2; u < 512; u += G) {
                const int x = (u & 255) >> 5, qb = (u & 31) + 32 * (u >> 8), b = x >> 2, h = x & 3, row0 = b * SEQ + qb * 128;
                att2::attn_unit<ATT_PROBE>(Qb + (size_t)row0 * 512 + h * 128, Kb + (size_t)b * KVL * 512 + h * 128, Vb + (size_t)b * KVL * 512 + h * 128, KVL,
                               Hb + (size_t)row0 * KCAT + 256 + h * 128, lam, 1.0f - lam_init, PTR(13) + l * 128, (char*)lds, tid2);
            }
#endif
            if (BOTH(pb + 3)) GRID_BAR();
        }
        for (int rep = 0; rep < NREP(5); ++rep) if (PH_EN(5) && IN(pb + 4)) { FRESH();
            pg8::Gemm g{ACAT, (const bf16_t*)(ws + WS_WCAT), Mact, 1024, KCAT}; pg8::StaticOrder S; S.init(Mact, 1024, G, bx);
            pg8::EpiBranch E{Gb, Yb};
            pg8::gemm_phase<pg8::EpiBranch, pg8::StaticOrder, true, true>(L, g, S, E, tid);
            if (BOTH(pb + 4)) GRID_BAR();
        }
        for (int rep = 0; rep < (l == 0 ? NREP(6) : 1); ++rep) if (PH_EN(6) && IN(pb + 5)) { FRESH();
            pg8::Gemm g{Yb, (const bf16_t*)(ws + WS_WOUT), Mact, 1024, 1024}; pg8::StaticOrder S; S.init(Mact, 1024, G, bx);
            pg8::EpiRes E{xl, xc, OUTP, XC, mod, 2048};
            pg8::gemm_phase<pg8::EpiRes, pg8::StaticOrder, true, true>(L, g, S, E, tid);
            if (BOTH(pb + 5)) GRID_BAR();
        }
        for (int rep = 0; rep < NREP(7); ++rep) if (PH_EN(7) && IN(pb + 6)) { FRESH(); norm_phase(OUTP, XC, Mact, PTR(5) + l * DM, mod, 3072, 4096, HX, gw, NGW, lane); if (BOTH(pb + 6)) GRID_BAR(); }
        for (int rep = 0; rep < NREP(8); ++rep) if (PH_EN(8) && IN(pb + 7)) { FRESH();
            pg8::Gemm g{HX, (const bf16_t*)(ws + WS_WUPG), Mact, DFF, 1024}; pg8::StaticOrder S; S.init(Mact, DFF, G, bx);
            pg8::EpiBf E{GT, DFF};
            pg8::gemm_phase<pg8::EpiBf, pg8::StaticOrder, true, true>(L, g, S, E, tid);
            if (BOTH(pb + 7)) GRID_BAR();
        }
        for (int rep = 0; rep < NREP(9); ++rep) if (PH_EN(9) && IN(pb + 8)) { FRESH();
            pg8::Gemm g{HX, (const bf16_t*)(ws + WS_WUPV), Mact, DFF, 1024}; pg8::StaticOrder S; S.init(Mact, DFF, G, bx);
            pg8::EpiVal E{GT, Hb, PTR(26) + l * 3 * DFF, PTR(27) + l * DFF};
            pg8::gemm_phase<pg8::EpiVal, pg8::StaticOrder, true, true>(L, g, S, E, tid);
            if (BOTH(pb + 8)) GRID_BAR();
        }
        if (PH_EN(10) && IN(pb + 9)) { FRESH();
            pg8::Gemm g{Hb, (const bf16_t*)(ws + WS_WDN), Mact, 1024, DFF}; pg8::StaticOrder S; S.init(Mact, 1024, G, bx);
            pg8::EpiRes E{OUTP, XC, OUTP, XC, mod, 5120};
            pg8::gemm_phase<pg8::EpiRes, pg8::StaticOrder, true, true>(L, g, S, E, tid);
            if (BOTH(pb + 9)) GRID_BAR();
        }
    }
    if (PH_EN(11) && IN(21)) { FRESH(); final_norm_phase(OUTP, PTR(29), gw, NGW, lane); }
#undef IN
#undef BOTH
#undef mod
#undef xl
#undef xc
#undef ws
#undef MOD
#undef ROPE
#undef TW
#undef XC
#undef HX
#undef FA
#undef Qb
#undef Kb
#undef Vb
#undef Yb
#undef Gb
#undef ACAT
#undef UF
#undef ZG
#undef UP
#undef GT
#undef Hb
#undef PTR
#undef OUTP
#undef WSP
}

extern "C" void kernel_launch(void* const* d_in, const int* in_sizes, int n_in, void* d_out, int out_size, void* d_ws, size_t ws_size, hipStream_t stream) {
    static int grid = 0;
    if (grid == 0) {
        if (n_in != 30 || in_sizes[0] != ML * DM || out_size != ML * DM || ws_size < WS_END) {
            fprintf(stderr, "kernel_launch: unexpected shapes: n_in %d in0 %d out %d ws %zu (need >= %zu)\n", n_in, n_in > 0 ? in_sizes[0] : -1, out_size, ws_size, (size_t)WS_END); grid = -1; return; }
        int dev = 0, cus = 0, per_cu = 0;
        if (hipGetDevice(&dev) != hipSuccess || hipDeviceGetAttribute(&cus, hipDeviceAttributeMultiprocessorCount, dev) != hipSuccess) { grid = -1; return; }
        if (hipFuncSetAttribute((const void*)fwd_kernel, hipFuncAttributeMaxDynamicSharedMemorySize, LDS_BYTES) != hipSuccess) { fprintf(stderr, "kernel_launch: hipFuncSetAttribute failed\n"); grid = -1; return; }
        if (hipOccupancyMaxActiveBlocksPerMultiprocessor(&per_cu, (const void*)fwd_kernel, 512, LDS_BYTES) != hipSuccess || per_cu < 1) {
            fprintf(stderr, "kernel_launch: occupancy query reports %d blocks per CU\n", per_cu); (void)hipGetLastError(); grid = -1; return; }
        grid = cus;
    }
    if (grid < 0) return;
    (void)hipMemsetAsync((char*)d_ws + WS_CTL, 0, CTL_ZERO_BYTES, stream);
    Args a{};
    for (int i = 0; i < 30; ++i) a.in[i] = (const float*)d_in[i];
    a.out = (float*)d_out; a.ws = (unsigned char*)d_ws;
    for (int li = 0; li < MK_N_LAUNCHES; ++li) {
        if (MK_N_LAUNCHES == NPHASE) { a.ph_lo = li; a.ph_hi = li + 1; a.li = 0; }
        else { a.ph_lo = (int)((long)NPHASE * li / MK_N_LAUNCHES); a.ph_hi = (int)((long)NPHASE * (li + 1) / MK_N_LAUNCHES); a.li = li; }
        hipLaunchKernelGGL(fwd_kernel, dim3(grid), dim3(512), LDS_BYTES, stream, a);
    }
}
```

```cpp
#include <hip/hip_runtime.h>
#include <cstdio>
#include <cstdint>

#define LAS __attribute__((address_space(3)))
#define GAS __attribute__((address_space(1)))
typedef unsigned short bf16_t;
typedef short bf16x8 __attribute__((ext_vector_type(8)));
typedef short s16x4 __attribute__((ext_vector_type(4)));
typedef float f32x2 __attribute__((ext_vector_type(2)));
typedef float f32x4 __attribute__((ext_vector_type(4)));
typedef float f32x16 __attribute__((ext_vector_type(16)));
typedef unsigned u32x2 __attribute__((ext_vector_type(2)));
typedef unsigned u32x4 __attribute__((ext_vector_type(4)));

#ifndef ATT_V
#define ATT_V 2
#endif
#ifndef MK_N_LAUNCHES
#define MK_N_LAUNCHES 1
#endif

constexpr int DM = 1024, SEQ = 8192, NBATCH = 2, CTXL = 256;
constexpr int ML = NBATCH * SEQ;
constexpr int MC = NBATCH * CTXL;
constexpr int MT = ML + MC;
constexpr int NIN = 6656, DFF = 2816, KCAT = 1280;
constexpr int KVL = CTXL + SEQ;
constexpr float EPS = 1e-6f;

constexpr size_t MiB = 1u << 20;
constexpr size_t WS_CTL = 0, CTL_ZERO_BYTES = 1 * MiB;
constexpr size_t WS_MOD = 1 * MiB;
constexpr size_t WS_ROPE = WS_MOD + 2 * 3 * 6144 * 4;
constexpr size_t WS_TW = WS_ROPE + 192 * 32 * 4;
constexpr size_t WS_XC = 2 * MiB;
constexpr size_t WS_WA = 4 * MiB;
constexpr size_t WS_WCAT = 17 * MiB;
constexpr size_t WS_WOUT = WS_WCAT + (size_t)1024 * 1280 * 2;
constexpr size_t WS_WUPG = WS_WOUT + (size_t)1024 * 1024 * 2;
constexpr size_t WS_WUPV = WS_WUPG + (size_t)2816 * 1024 * 2;
constexpr size_t WS_WDN = WS_WUPV + (size_t)2816 * 1024 * 2;
constexpr size_t WS_HX = 38 * MiB;
constexpr size_t WS_FA = WS_HX;
constexpr size_t WS_Q = 71 * MiB;
constexpr size_t WS_K = WS_Q + (size_t)MT * 512 * 2;
constexpr size_t WS_V = WS_K + (size_t)MT * 512 * 2;
constexpr size_t WS_Y = 71 * MiB;
constexpr size_t WS_G = 121 * MiB;
constexpr size_t WS_ACAT = 187 * MiB;
constexpr size_t WS_UF = 229 * MiB;
constexpr size_t WS_ZG = WS_UF + (size_t)MT * 256 * 2;
constexpr size_t WS_UP = WS_ZG + (size_t)MT * 256 * 2;
constexpr size_t WS_GT = 71 * MiB;
constexpr size_t WS_H = 162 * MiB;
constexpr size_t WS_END = 256 * MiB;
static_assert(WS_TW + 8192 * 8 <= WS_XC && WS_WDN + (size_t)1024 * 2816 * 2 <= WS_HX && WS_V + (size_t)MT * 512 * 2 <= WS_G && WS_G + (size_t)MT * 4096 <= WS_ACAT, "ws map 1");
static_assert(WS_ACAT + (size_t)MT * 1280 * 2 <= WS_UF && WS_UP + (size_t)MT * 256 * 2 <= WS_END && WS_GT + (size_t)MT * 2816 * 2 <= WS_H && WS_H + (size_t)MT * 2816 * 2 <= WS_END, "ws map 2");
static_assert(WS_HX + (size_t)MT * 1024 * 2 <= WS_Q && (size_t)2 * 4 * 128 * 64 * 64 * 8 <= (size_t)MT * 1024 * 2, "ws map 3");
constexpr int CW_TMO = 0, CW_CODE = 1, CW_BAR = 4096;

constexpr int RING_BYTES = 131072, LDSCTL_OFF = RING_BYTES, MISC_OFF = LDSCTL_OFF + 320, LDS_BYTES = 147456;

typedef __bf16 bf16x2_t __attribute__((ext_vector_type(2)));
__device__ __forceinline__ unsigned cvt2bf(float lo, float hi) { const f32x2 v = {lo, hi}; return __builtin_bit_cast(unsigned, __builtin_convertvector(v, bf16x2_t)); }
template <int M> __device__ __forceinline__ float swz_xor(float v) { return __int_as_float(__builtin_amdgcn_ds_swizzle(__float_as_int(v), (M << 10) | 0x1f)); }
__device__ __forceinline__ float bf2f(unsigned v) { return __uint_as_float(v << 16); }
__device__ __forceinline__ float sigm(float x) { return 1.0f / (1.0f + __expf(-x)); }
__host__ __device__ __forceinline__ int in_map(int n) {
    if (n < 256) return n;
    if (n < 1280) { const int base = n < 768 ? 256 : 768, r = n - base, comp = r >> 6, p = r & 63, pp = p >> 1, e = p & 1;
        return base + comp * 64 + (pp < 16 ? 0 : 32) + (pp & 15) + 16 * e; }
    if (n < 1792) return n;
    if (n < 2304) { const int r = n - 1792; return 1792 + (r & 1) * 256 + (r >> 1); }
    return n;
}
namespace pg8 {
#define PG8_LAS __attribute__((address_space(3)))
typedef unsigned short bf16_t;
typedef short bf16x8 __attribute__((ext_vector_type(8)));
typedef float f32x4 __attribute__((ext_vector_type(4)));
typedef unsigned u32x4 __attribute__((ext_vector_type(4)));
constexpr int BM = 256, BK = 64, HALF = 128, HTB = HALF * BK * 2  , STAGE_BYTES = 8 * HTB, NXCD = 8, WGM = 8;

__host__ __device__ __forceinline__ int lds_byte(int r, int c) { const int st = (r >> 4) * 2 + (c >> 5), rr = r & 15, cc = c & 31, ob = rr * 64 + cc * 2; return st * 1024 + (ob ^ (((ob >> 9) & 1) << 5)); }
__host__ __device__ __forceinline__ void stage_rc(int b, int& R, int& C) { const int st = b / 1024, sb = b % 1024, swz = sb ^ (((sb >> 9) & 1) << 5); R = (st >> 1) * 16 + swz / 64; C = (st & 1) * 32 + (swz % 64) / 2; }
__host__ __device__ __forceinline__ int perm32(int rho) { const int n = rho >> 4, i = rho & 15; return 8 * (i >> 2) + 4 * n + (i & 3); }

struct Unit { int pm, pn; };
struct Gemm { const bf16_t* A; const bf16_t* Bt; int M, N, K; };

struct StaticOrder {
    int nM, nN, nwg, G, c;
    __host__ __device__ void init(int M, int N, int G_, int c_) { nM = M / BM; nN = N / BM; nwg = nM * nN; G = G_; c = c_; }
    __host__ __device__ bool next(int i, Unit& u) const {
        const long L = (long)i * G + c; if (L >= nwg) return false;
        int wgid = (int)L; { const int q = nwg / NXCD, r = nwg % NXCD, xcd = wgid % NXCD, off = wgid / NXCD; wgid = (xcd < r ? xcd * (q + 1) : r * (q + 1) + (xcd - r) * q) + off; }
        const int nig = WGM * nN, gid = wgid / nig, fm = gid * WGM, gsz = (nM - fm) < WGM ? (nM - fm) : WGM;
        u.pm = fm + ((wgid % nig) % gsz); u.pn = (wgid % nig) / gsz; return true;
    }
    __device__ __forceinline__ void a_ready(const Unit&) const {}
    __device__ __forceinline__ void done(const Unit&) const {}
};
__device__ __forceinline__ unsigned cvt_pk_bf16(float lo, float hi) { return cvt2bf(lo, hi); }
typedef float f32x2 __attribute__((ext_vector_type(2)));
__device__ __forceinline__ f32x2 gelu_pk(f32x2 v) {
    const f32x2 av = __builtin_elementwise_abs(v), d = av * 0.2316418882f + 1.0f;
    f32x2 t; t.x = __builtin_amdgcn_rcpf(d.x); t.y = __builtin_amdgcn_rcpf(d.y);
    f32x2 q = t * 0.5307027145f + (-0.7265760135f); q = q * t + 0.7107068705f; q = q * t + (-0.142248368f); q = q * t + 0.127414796f; q = q * t;
    const f32x2 s = (v * v) * (-0.72134752044f);
    f32x2 e; e.x = __builtin_amdgcn_exp2f(s.x); e.y = __builtin_amdgcn_exp2f(s.y);
    const f32x2 m = v * (q * e), r = v - m;
    f32x2 o; o.x = v.x < 0.f ? m.x : r.x; o.y = v.y < 0.f ? m.y : r.y; return o;
}

typedef unsigned u32x2 __attribute__((ext_vector_type(2)));
__device__ __forceinline__ u32x4 pack8(const f32x4 a, const f32x4 b) { u32x4 w; w.x = cvt_pk_bf16(a[0], a[1]); w.y = cvt_pk_bf16(a[2], a[3]); w.z = cvt_pk_bf16(b[0], b[1]); w.w = cvt_pk_bf16(b[2], b[3]); return w; }

struct EpiIn {
    static constexpr bool PERM = true, AFTER_DRAIN = false, RESCALE = false;
    bf16_t *UF, *ZG, *UP, *Q, *K, *V; unsigned char* G; const float* rope;
    __device__ __forceinline__ void operator()(const f32x4 (&acc)[2][2][4][2], const Unit& u, int wr, int wc, int fr, int fq) const {
        const int pm = u.pm, pn = u.pn; const bool lat = pm < 64; const int R0 = pm * 256;
        const int kv0 = lat ? ((pm >> 5) * 8448 + 256 + ((pm & 31) << 8)) : ((pm - 64) * 8448);
        const int rl = wr * 64 + fr, cl = wc * 32 + 8 * fq;
        if (pn == 0 || pn == 9) {
            bf16_t* dst = (pn == 0 ? UF : UP);
#pragma unroll
            for (int ai = 0; ai < 2; ++ai)
#pragma unroll
                for (int m = 0; m < 4; ++m) { const int rr = ai * 128 + m * 16 + rl;
#pragma unroll
                    for (int bj = 0; bj < 2; ++bj) *(u32x4*)(dst + (size_t)(R0 + rr) * 256 + bj * 128 + cl) = pack8(acc[ai][bj][m][0], acc[ai][bj][m][1]); }
        } else if (pn <= 4) {
            const bool isq = pn <= 2; bf16_t* dst = isq ? Q : K; const int rowbase = isq ? R0 : kv0, colbase = (isq ? pn - 1 : pn - 3) * 256; const float sc = isq ? (ATT_V == 2 ? 0.18033688011112042f : 0.125f) : 1.0f;
#pragma unroll
            for (int ai = 0; ai < 2; ++ai)
#pragma unroll
                for (int m = 0; m < 4; ++m) { const int rr = ai * 128 + m * 16 + rl;
                    f32x4 cs = {1.f, 1.f, 1.f, 1.f}, sn = {0.f, 0.f, 0.f, 0.f};
                    if (lat) { const int t = (R0 & 8191) + rr; const int pos = (wc & 1) ? 128 + (t & 63) : (t >> 6);
                        cs = *(const f32x4*)(rope + pos * 32 + 4 * fq); sn = *(const f32x4*)(rope + pos * 32 + 16 + 4 * fq); }
                    cs = cs * sc; sn = sn * sc;
#pragma unroll
                    for (int bj = 0; bj < 2; ++bj) { const f32x4 a = acc[ai][bj][m][0], b = acc[ai][bj][m][1]; f32x4 oa, ob;
                        oa[0] = a[0] * cs[0] - a[1] * sn[0]; oa[1] = a[1] * cs[0] + a[0] * sn[0]; oa[2] = a[2] * cs[1] - a[3] * sn[1]; oa[3] = a[3] * cs[1] + a[2] * sn[1];
                        ob[0] = b[0] * cs[2] - b[1] * sn[2]; ob[1] = b[1] * cs[2] + b[0] * sn[2]; ob[2] = b[2] * cs[3] - b[3] * sn[3]; ob[3] = b[3] * cs[3] + b[2] * sn[3];
                        *(u32x4*)(dst + (size_t)(rowbase + rr) * 512 + colbase + bj * 128 + cl) = pack8(oa, ob); } }
        } else if (pn <= 6) {
#pragma unroll
            for (int ai = 0; ai < 2; ++ai)
#pragma unroll
                for (int m = 0; m < 4; ++m) { const int rr = ai * 128 + m * 16 + rl;
#pragma unroll
                    for (int bj = 0; bj < 2; ++bj) *(u32x4*)(V + (size_t)(kv0 + rr) * 512 + (pn - 5) * 256 + bj * 128 + cl) = pack8(acc[ai][bj][m][0], acc[ai][bj][m][1]); }
        } else if (pn <= 8) {
#pragma unroll
            for (int ai = 0; ai < 2; ++ai)
#pragma unroll
                for (int m = 0; m < 4; ++m) { const int rr = ai * 128 + m * 16 + rl;
#pragma unroll
                    for (int bj = 0; bj < 2; ++bj) { const f32x4 a = acc[ai][bj][m][0], b = acc[ai][bj][m][1];
                        u32x2 w; w.x = cvt_pk_bf16(a[0] * sigm(a[1]), a[2] * sigm(a[3])); w.y = cvt_pk_bf16(b[0] * sigm(b[1]), b[2] * sigm(b[3]));
                        *(u32x2*)(ZG + (size_t)(R0 + rr) * 256 + (pn - 7) * 128 + bj * 64 + (cl >> 1)) = w; } }
        } else {
#pragma unroll
            for (int ai = 0; ai < 2; ++ai)
#pragma unroll
                for (int m = 0; m < 4; ++m) { const int rr = ai * 128 + m * 16 + rl;
#pragma unroll
                    for (int bj = 0; bj < 2; ++bj) { u32x2 w;
#pragma unroll
                        for (int n = 0; n < 2; ++n) { const f32x4 a = acc[ai][bj][m][n]; unsigned q = 0;
#pragma unroll
                            for (int j = 0; j < 4; ++j) { float s = sigm(a[j]) * 255.0f + 0.5f; s = s < 1.0f ? 1.0f : s; q |= ((unsigned)s) << (8 * j); }
                            if (n == 0) w.x = q; else w.y = q; }
                        *(u32x2*)(G + (size_t)(R0 + rr) * 4096 + (pn - 10) * 256 + bj * 128 + cl) = w; } }
        }
    }
};

struct EpiBf {
    static constexpr bool PERM = true, AFTER_DRAIN = false, RESCALE = false;
    bf16_t* O; int ldc;
    __device__ __forceinline__ void operator()(const f32x4 (&acc)[2][2][4][2], const Unit& u, int wr, int wc, int fr, int fq) const {
        const int row0 = u.pm * 256 + wr * 64 + fr, col0 = u.pn * 256 + wc * 32 + 8 * fq;
#pragma unroll
        for (int ai = 0; ai < 2; ++ai)
#pragma unroll
            for (int m = 0; m < 4; ++m)
#pragma unroll
                for (int bj = 0; bj < 2; ++bj) *(u32x4*)(O + (size_t)(row0 + ai * 128 + m * 16) * ldc + col0 + bj * 128) = pack8(acc[ai][bj][m][0], acc[ai][bj][m][1]);
    }
};

struct EpiRes {
    static constexpr bool PERM = false, AFTER_DRAIN = false, RESCALE = false;
    const float* base_lat; const float* base_ctx; float* out_lat; float* out_ctx; const float* mod; int goff;
    __device__ __forceinline__ void operator()(const f32x4 (&acc)[2][2][4][2], const Unit& u, int wr, int wc, int fr, int fq) const {
        const int pm = u.pm; const bool lat = pm < 64; const int mrow = lat ? (pm >> 5) : 2;
        const float* base = lat ? base_lat + (size_t)pm * 256 * 1024 : base_ctx + (size_t)(pm - 64) * 256 * 1024;
        float* out = lat ? out_lat + (size_t)pm * 256 * 1024 : out_ctx + (size_t)(pm - 64) * 256 * 1024;
        const int col0 = u.pn * 256 + wc * 32 + 4 * fq;
        f32x4 gv[2][2];
#pragma unroll
        for (int bj = 0; bj < 2; ++bj)
#pragma unroll
            for (int n = 0; n < 2; ++n) gv[bj][n] = *(const f32x4*)(mod + mrow * 6144 + goff + col0 + bj * 128 + n * 16);
#pragma unroll
        for (int ai = 0; ai < 2; ++ai)
#pragma unroll
            for (int m = 0; m < 4; ++m) { const size_t ro = (size_t)(ai * 128 + wr * 64 + m * 16 + fr) * 1024 + col0;
#pragma unroll
                for (int bj = 0; bj < 2; ++bj)
#pragma unroll
                    for (int n = 0; n < 2; ++n) { const size_t off = ro + bj * 128 + n * 16; const f32x4 b = *(const f32x4*)(base + off); *(f32x4*)(out + off) = b + gv[bj][n] * acc[ai][bj][m][n]; } }
    }
};

struct EpiVal {
    static constexpr bool PERM = true, AFTER_DRAIN = false, RESCALE = false;
    const bf16_t* GT; bf16_t* H; const float* dww; const float* dwb;
    __device__ __forceinline__ void operator()(const f32x4 (&acc)[2][2][4][2], const Unit& u, int wr, int wc, int fr, int fq) const {
        const int pm = u.pm; const bool lat = pm < 64; const int R0 = pm * 256, t0 = lat ? (R0 & 8191) : 0, L = lat ? 8192 : 256;
        const int rl = wr * 64 + fr;
#pragma unroll
        for (int bj = 0; bj < 2; ++bj) { const int col = u.pn * 256 + bj * 128 + wc * 32 + 8 * fq;
            f32x4 w0[2], w1[2], w2[2], bb[2];
#pragma unroll
            for (int n = 0; n < 2; ++n) { w0[n] = *(const f32x4*)(dww + col + 4 * n); w1[n] = *(const f32x4*)(dww + 2816 + col + 4 * n); w2[n] = *(const f32x4*)(dww + 5632 + col + 4 * n); bb[n] = *(const f32x4*)(dwb + col + 4 * n); }
#pragma unroll
            for (int ai = 0; ai < 2; ++ai) {
#pragma unroll
              for (int mh = 0; mh < 4; mh += 2) {
                u32x4 gm[4], g0[4], gq[4];
#pragma unroll
                for (int m = mh; m < mh + 2; ++m) { const int rr = ai * 128 + m * 16 + rl, t = t0 + rr; const bf16_t* gp = GT + (size_t)(R0 + rr) * 2816 + col;
                    gm[m] = (u32x4){0u, 0u, 0u, 0u}; gq[m] = (u32x4){0u, 0u, 0u, 0u}; g0[m] = *(const u32x4*)gp;
                    if (t > 0) gm[m] = *(const u32x4*)(gp - 2816);
                    if (t < L - 1) gq[m] = *(const u32x4*)(gp + 2816); }
                asm volatile("" ::: "memory");
#pragma unroll
                for (int m = mh; m < mh + 2; ++m) { const int rr = ai * 128 + m * 16 + rl;
                    f32x4 o[2];
#pragma unroll
                    for (int n = 0; n < 2; ++n) { f32x4 c;
#pragma unroll
                        for (int j = 0; j < 4; ++j) { const int e = 4 * n + j; const unsigned wm = gm[m][e >> 1], wz = g0[m][e >> 1], wp = gq[m][e >> 1];
                            const float xm = (e & 1) ? __uint_as_float(wm & 0xffff0000u) : __uint_as_float(wm << 16), xz = (e & 1) ? __uint_as_float(wz & 0xffff0000u) : __uint_as_float(wz << 16),
                                        xp = (e & 1) ? __uint_as_float(wp & 0xffff0000u) : __uint_as_float(wp << 16);
                            c[j] = w0[n][j] * xm + w1[n][j] * xz + w2[n][j] * xp + bb[n][j]; }
                        const f32x2 ga = gelu_pk((f32x2){c[0], c[1]}), gb = gelu_pk((f32x2){c[2], c[3]});
                        const f32x4 v = acc[ai][bj][m][n]; o[n] = (f32x4){v[0] * ga.x, v[1] * ga.y, v[2] * gb.x, v[3] * gb.y}; }
                    *(u32x4*)(H + (size_t)(R0 + rr) * 2816 + col) = pack8(o[0], o[1]); }
                asm volatile("" ::: "memory");
              }
            }
        }
    }
};

struct EpiBranch {
    static constexpr bool PERM = true, AFTER_DRAIN = false, RESCALE = true;
    const unsigned char* G; bf16_t* Y;
    __device__ __forceinline__ void rescale(f32x4 (&acc)[2][2][4][2], const Unit& u, int t, int wr, int wc, int fr, int fq) const {
        const int bp = (t == 4) ? 0 : (t == 12) ? 1 : 2;
        const __amdgpu_buffer_rsrc_t rs = __builtin_amdgcn_make_buffer_rsrc((void*)G, 0, MT * 4096, 0x00020000);
        const int voff = (u.pm * 256 + wr * 64 + fr) * 4096 + u.pn * 256 + wc * 32 + 8 * fq;
#pragma unroll
        for (int ai = 0; ai < 2; ++ai)
#pragma unroll
            for (int m = 0; m < 4; ++m) {
#pragma unroll
                for (int bj = 0; bj < 2; ++bj) { const int so = (ai * 128 + m * 16) * 4096 + bj * 128 + bp * 1024;
                    const u32x2 p = __builtin_bit_cast(u32x2, __builtin_amdgcn_raw_buffer_load_b64(rs, voff, so, 0)), q = __builtin_bit_cast(u32x2, __builtin_amdgcn_raw_buffer_load_b64(rs, voff, so + 1024, 0));
#pragma unroll
                    for (int n = 0; n < 2; ++n) { const unsigned pw = n ? p.y : p.x, qw = n ? q.y : q.x;
#pragma unroll
                        for (int j = 0; j < 4; ++j) acc[ai][bj][m][n][j] *= (float)((pw >> (8 * j)) & 255u) * __builtin_amdgcn_rcpf((float)((qw >> (8 * j)) & 255u)); } }
                asm volatile("" ::: "memory"); }
    }
    __device__ __forceinline__ void operator()(const f32x4 (&acc)[2][2][4][2], const Unit& u, int wr, int wc, int fr, int fq) const {
        const int row0 = u.pm * 256 + wr * 64 + fr, col0 = u.pn * 256 + wc * 32 + 8 * fq;
#pragma unroll
        for (int ai = 0; ai < 2; ++ai)
#pragma unroll
            for (int m = 0; m < 4; ++m)
#pragma unroll
                for (int bj = 0; bj < 2; ++bj) { const size_t r = (size_t)(row0 + ai * 128 + m * 16); const u32x2 p = *(const u32x2*)(G + r * 4096 + 3072 + col0 + bj * 128);
                    f32x4 o[2];
#pragma unroll
                    for (int n = 0; n < 2; ++n) { const unsigned pw = n ? p.y : p.x;
#pragma unroll
                        for (int j = 0; j < 4; ++j) o[n][j] = acc[ai][bj][m][n][j] * ((float)((pw >> (8 * j)) & 255u) * (1.0f / 255.0f)); }
                    *(u32x4*)(Y + r * 1024 + col0 + bj * 128) = pack8(o[0], o[1]); }
    }
};

template <class Epi, class Sched, bool ALIGN_EPI = false, bool SP2 = false>
__device__ __forceinline__ void gemm_phase(PG8_LAS unsigned char* lds, const Gemm g, const Sched& S, const Epi& E, const int tid) {
    const int wid = __builtin_amdgcn_readfirstlane(tid >> 6), lane = tid & 63, wr = wid >> 2, wc = wid & 3, fr = lane & 15, fq = lane >> 4;
    const int K = g.K, nt = K / BK;
    unsigned voffA[2], voffB[2];
#pragma unroll
    for (int i = 0; i < 2; ++i) { int R, C; stage_rc(tid * 16 + i * 8192, R, C); const int Rb = Epi::PERM ? ((R & ~31) + perm32(R & 31)) : R;
        voffA[i] = (unsigned)(R * K + C) * 2u; voffB[i] = (unsigned)(Rb * K + C) * 2u; }
    const size_t kstep = (size_t)(BK * 2);
    const size_t hstep = (size_t)HALF * K * 2;
    const size_t tstep = 2 * hstep;
    const unsigned ldsw = (unsigned)wid * 1024u;
    const int aoff = lds_byte(wr * 64 + fr, fq * 8), boff = lds_byte(wc * 32 + fr, fq * 8);
#define PG8_SA(b, h) (((b) * 2 + (h)) * HTB)
#define PG8_SB(b, h) ((4 + (b) * 2 + (h)) * HTB)
#define PG8_STAGE(bufoff, gbase, voff) do { _Pragma("unroll") for (int _i = 0; _i < 2; ++_i) \
        __builtin_amdgcn_global_load_lds((const unsigned*)((const char*)(gbase) + (voff)[_i]), (PG8_LAS unsigned*)(lds + (bufoff) + ldsw + _i * 8192), 16, 0, 0); } while (0)
#define PG8_LDA(dst, b, h) do { _Pragma("unroll") for (int m = 0; m < 4; ++m) _Pragma("unroll") for (int k = 0; k < 2; ++k) dst[m][k] = *(const PG8_LAS bf16x8*)(lds + PG8_SA(b, h) + aoff + m * 2048 + k * 1024); } while (0)
#define PG8_LDB(dst, b, h) do { _Pragma("unroll") for (int n = 0; n < 2; ++n) _Pragma("unroll") for (int k = 0; k < 2; ++k) dst[n][k] = *(const PG8_LAS bf16x8*)(lds + PG8_SB(b, h) + boff + n * 2048 + k * 1024); } while (0)
#define PG8_MMA(ai, bj, At, Bt) do { __builtin_amdgcn_s_setprio(1); _Pragma("unroll") for (int m = 0; m < 4; ++m) _Pragma("unroll") for (int n = 0; n < 2; ++n) _Pragma("unroll") for (int k = 0; k < 2; ++k) \
        acc[ai][bj][m][n] = __builtin_amdgcn_mfma_f32_16x16x32_bf16(Bt[n][k], At[m][k], acc[ai][bj][m][n], 0, 0, 0); __builtin_amdgcn_s_setprio(0); } while (0)
#define PG8_WAIT_V(n) asm volatile("s_waitcnt vmcnt(" #n ")" ::: "memory")
#define PG8_WAIT_L(n) asm volatile("s_waitcnt lgkmcnt(" #n ")" ::: "memory")
#define PG8_BAR __builtin_amdgcn_s_barrier()
#define PG8_SCHED __builtin_amdgcn_sched_barrier(0)
    Unit cur, nxt; int ui = 0;
    if (!S.next(0, cur)) return;
    f32x4 acc[2][2][4][2];
#pragma unroll
    for (int a = 0; a < 2; ++a)
#pragma unroll
        for (int b = 0; b < 2; ++b)
#pragma unroll
            for (int m = 0; m < 4; ++m)
#pragma unroll
                for (int n = 0; n < 2; ++n) acc[a][b][m][n] = (f32x4){0.f, 0.f, 0.f, 0.f};
    bf16x8 At[4][2], B0[2][2], B1[2][2];
    const char* cA = (const char*)g.A + (size_t)cur.pm * tstep; const char* cB = (const char*)g.Bt + (size_t)cur.pn * tstep;
    S.a_ready(cur);
    if constexpr (SP2) {
        PG8_STAGE(PG8_SB(0, 0), cB, voffB); PG8_STAGE(PG8_SB(0, 1), cB + hstep, voffB); PG8_STAGE(PG8_SA(0, 0), cA, voffA); PG8_STAGE(PG8_SA(0, 1), cA + hstep, voffA);
        if (wr == 1) PG8_BAR;
        PG8_WAIT_V(2); PG8_BAR;
        PG8_STAGE(PG8_SB(1, 0), cB + kstep, voffB); PG8_STAGE(PG8_SA(1, 0), cA + kstep, voffA); PG8_STAGE(PG8_SB(1, 1), cB + hstep + kstep, voffB);
        PG8_WAIT_V(6); PG8_BAR;
    } else {
        PG8_STAGE(PG8_SB(0, 0), cB, voffB); PG8_STAGE(PG8_SA(0, 0), cA, voffA); PG8_STAGE(PG8_SB(0, 1), cB + hstep, voffB); PG8_STAGE(PG8_SA(0, 1), cA + hstep, voffA);
        if (wr == 1) PG8_BAR;
        PG8_WAIT_V(4); PG8_BAR;
        PG8_STAGE(PG8_SB(1, 0), cB + kstep, voffB); PG8_STAGE(PG8_SA(1, 0), cA + kstep, voffA); PG8_STAGE(PG8_SB(1, 1), cB + hstep + kstep, voffB);
        PG8_WAIT_V(6); PG8_BAR;
    }
    for (;;) {
        const bool has_next = S.next(ui + 1, nxt);
        const char* nA = has_next ? (const char*)g.A + (size_t)nxt.pm * tstep : cA; const char* nB = has_next ? (const char*)g.Bt + (size_t)nxt.pn * tstep : cB;
        for (int t = 0; t < nt; t += 2) {
            if constexpr (Epi::RESCALE) { if (t == 4 || t == 12 || t == 16) E.rescale(acc, cur, t, wr, wc, fr, fq); }
            const bool last = (t == nt - 2);
            const char* a1 = cA + (size_t)(t + 1) * kstep;
            const char* a2 = last ? nA : cA + (size_t)(t + 2) * kstep; const char* b2 = last ? nB : cB + (size_t)(t + 2) * kstep;
            const char* a3 = a2 + kstep; const char* b3 = b2 + kstep;
            if (last && has_next) S.a_ready(nxt);
            if constexpr (SP2) {
            PG8_LDB(B0, 0, 0); PG8_LDB(B1, 0, 1); PG8_SCHED; PG8_LDA(At, 0, 0); PG8_STAGE(PG8_SA(1, 1), a1 + hstep, voffA);
            PG8_WAIT_V(8); PG8_WAIT_L(0); PG8_BAR; PG8_MMA(0, 0, At, B0); PG8_MMA(0, 1, At, B1); PG8_BAR; PG8_SCHED;
            PG8_LDA(At, 0, 1); PG8_STAGE(PG8_SB(0, 0), b2, voffB); PG8_STAGE(PG8_SB(0, 1), b2 + hstep, voffB); PG8_STAGE(PG8_SA(0, 0), a2, voffA);
            PG8_WAIT_V(8); PG8_WAIT_L(0); PG8_BAR; PG8_MMA(1, 0, At, B0); PG8_MMA(1, 1, At, B1); PG8_BAR; PG8_SCHED;
            PG8_LDB(B0, 1, 0); PG8_LDB(B1, 1, 1); PG8_SCHED; PG8_LDA(At, 1, 0); PG8_STAGE(PG8_SA(0, 1), a2 + hstep, voffA);
            PG8_WAIT_V(8); PG8_WAIT_L(0); PG8_BAR; PG8_MMA(0, 0, At, B0); PG8_MMA(0, 1, At, B1); PG8_BAR; PG8_SCHED;
            PG8_LDA(At, 1, 1); PG8_STAGE(PG8_SB(1, 0), b3, voffB); PG8_STAGE(PG8_SB(1, 1), b3 + hstep, voffB); PG8_STAGE(PG8_SA(1, 0), a3, voffA);
            PG8_WAIT_V(8); PG8_WAIT_L(0); PG8_BAR; PG8_MMA(1, 0, At, B0); PG8_MMA(1, 1, At, B1); PG8_BAR; PG8_SCHED;
            } else {
            PG8_LDB(B0, 0, 0); PG8_SCHED; PG8_LDA(At, 0, 0); PG8_STAGE(PG8_SA(1, 1), a1 + hstep, voffA);
            PG8_WAIT_L(8); PG8_BAR; PG8_WAIT_L(0); PG8_MMA(0, 0, At, B0); PG8_BAR; PG8_SCHED;
            PG8_LDB(B1, 0, 1); PG8_STAGE(PG8_SB(0, 0), b2, voffB);
            PG8_BAR; PG8_WAIT_L(0); PG8_MMA(0, 1, At, B1); PG8_BAR;
            PG8_LDA(At, 0, 1); PG8_STAGE(PG8_SA(0, 0), a2, voffA);
            PG8_BAR; PG8_WAIT_L(0); PG8_MMA(1, 0, At, B0); PG8_BAR; PG8_SCHED;
            PG8_STAGE(PG8_SB(0, 1), b2 + hstep, voffB);
            PG8_WAIT_V(6); PG8_BAR; PG8_MMA(1, 1, At, B1); PG8_BAR;
            PG8_LDB(B0, 1, 0); PG8_SCHED; PG8_LDA(At, 1, 0); PG8_STAGE(PG8_SA(0, 1), a2 + hstep, voffA);
            PG8_WAIT_L(8); PG8_BAR; PG8_WAIT_L(0); PG8_MMA(0, 0, At, B0); PG8_BAR; PG8_SCHED;
            PG8_LDB(B1, 1, 1); PG8_STAGE(PG8_SB(1, 0), b3, voffB);
            PG8_BAR; PG8_WAIT_L(0); PG8_MMA(0, 1, At, B1); PG8_BAR;
            PG8_LDA(At, 1, 1); PG8_STAGE(PG8_SA(1, 0), a3, voffA);
            PG8_BAR; PG8_WAIT_L(0); PG8_MMA(1, 0, At, B0); PG8_BAR; PG8_SCHED;
            PG8_STAGE(PG8_SB(1, 1), b3 + hstep, voffB);
            PG8_WAIT_V(6); PG8_BAR; PG8_MMA(1, 1, At, B1); PG8_BAR;
            }
        }
        if constexpr (ALIGN_EPI) { if (wr == 0) PG8_BAR; }
        if constexpr (!Epi::AFTER_DRAIN) { E(acc, cur, wr, wc, fr, fq); S.done(cur); }
        if (!has_next) break;
#pragma unroll
        for (int a = 0; a < 2; ++a)
#pragma unroll
            for (int b = 0; b < 2; ++b)
#pragma unroll
                for (int m = 0; m < 4; ++m)
#pragma unroll
                    for (int n = 0; n < 2; ++n) acc[a][b][m][n] = (f32x4){0.f, 0.f, 0.f, 0.f};
        cur = nxt; cA = nA; cB = nB; ++ui;
        if constexpr (ALIGN_EPI) { if (wr == 1) PG8_BAR; }
    }
    PG8_WAIT_V(0);
    if constexpr (!ALIGN_EPI) { if (wr == 0) PG8_BAR; }
    PG8_BAR;
    if constexpr (Epi::AFTER_DRAIN) { E.fused(acc, cur, wr, wc, fr, fq, lds, wid, lane); S.done(cur); }
#undef PG8_SA
#undef PG8_SB
#undef PG8_STAGE
#undef PG8_LDA
#undef PG8_LDB
#undef PG8_MMA
#undef PG8_WAIT_V
#undef PG8_WAIT_L
#undef PG8_BAR
#undef PG8_SCHED
}
}
namespace att {
constexpr int NW = 8, QBLK = 32, KVBLK = 64, LDQ = 512, LDO = KCAT;
constexpr int SHM_V = 16384, SHM_K = 16384, SHM_ATTN = 3 * SHM_V + 2 * SHM_K + NW * 64 * 4;
constexpr float THR = 8.f;
#ifndef ATT_SDEPTH
#define ATT_SDEPTH 1
#endif
constexpr int SDEPTH = ATT_SDEPTH;
#define KSWZ(row, colB) ((row) * 256 + ((colB) ^ (((row) & 7) << 4)))
#define SBAR() __builtin_amdgcn_sched_barrier(0)
__device__ __forceinline__ int crow(int r, int hi) { return (r & 3) + 8 * (r >> 2) + 4 * hi; }
__device__ __forceinline__ unsigned cvtpk(float lo, float hi) { return cvt2bf(lo, hi); }

__device__ __forceinline__ void partialSM(f32x16& p0, f32x16& p1, float& m_reg, float& mn, float& alpha) {
  constexpr float C = 1.4426950408889634f;
  float pmax = p0[0];
#pragma unroll
  for (int r = 1; r < 16; ++r) pmax = fmaxf(pmax, p0[r]);
#pragma unroll
  for (int r = 0; r < 16; ++r) pmax = fmaxf(pmax, p1[r]);
  { auto rr = __builtin_amdgcn_permlane32_swap(__float_as_uint(pmax), __float_as_uint(pmax), false, false);
    pmax = fmaxf(__uint_as_float(rr[0]), __uint_as_float(rr[1])); }
  if (__builtin_expect(__all(pmax - m_reg <= THR), 1)) { mn = m_reg; alpha = 1.f; }
  else { mn = fmaxf(m_reg, pmax); alpha = __builtin_amdgcn_exp2f((m_reg - mn) * C); m_reg = mn; }
  const float mnC = -mn * C;
#pragma unroll
  for (int r = 0; r < 16; ++r) p0[r] = fmaf(p0[r], C, mnC);
#pragma unroll
  for (int r = 0; r < 16; ++r) p1[r] = fmaf(p1[r], C, mnC);
#pragma unroll
  for (int r = 0; r < 16; ++r) p0[r] = __builtin_amdgcn_exp2f(p0[r]);
}
__device__ __forceinline__ void finishSM(f32x16& p0, f32x16& p1, float alpha, float& l_reg, bf16x8& pa0, bf16x8& pa1, bf16x8& pa2, bf16x8& pa3) {
#pragma unroll
  for (int r = 0; r < 16; ++r) p1[r] = __builtin_amdgcn_exp2f(p1[r]);
  float ps = 0;
#pragma unroll
  for (int r = 0; r < 16; ++r) ps += p0[r];
#pragma unroll
  for (int r = 0; r < 16; ++r) ps += p1[r];
  { auto rr = __builtin_amdgcn_permlane32_swap(__float_as_uint(ps), __float_as_uint(ps), false, false);
    ps = __uint_as_float(rr[0]) + __uint_as_float(rr[1]); }
  l_reg = l_reg * alpha + ps;
#define PK4(P, BASE, OUT) do { unsigned a0 = cvtpk(P[BASE + 0], P[BASE + 1]), a1 = cvtpk(P[BASE + 2], P[BASE + 3]);   \
    unsigned b0 = cvtpk(P[BASE + 4], P[BASE + 5]), b1 = cvtpk(P[BASE + 6], P[BASE + 7]);                              \
    auto r0 = __builtin_amdgcn_permlane32_swap(a0, b0, false, false); auto r1 = __builtin_amdgcn_permlane32_swap(a1, b1, false, false); \
    u32x4 w = {r0[0], r1[0], r0[1], r1[1]}; OUT = *reinterpret_cast<bf16x8*>(&w); } while (0)
  PK4(p0, 0, pa0); PK4(p0, 8, pa1); PK4(p1, 0, pa2); PK4(p1, 8, pa3);
#undef PK4
}
__device__ __forceinline__ void qkt(f32x16& p0, f32x16& p1, const char* Ks, const bf16x8* qr, int r32, int hi, int kcol) {
  p0 = f32x16{}; p1 = f32x16{};
#pragma unroll
  for (int d0 = 0; d0 < 4; ++d0) { const int cb = kcol + (d0 * 16 + hi * 8) * 2;
    const bf16x8 b0 = *reinterpret_cast<const bf16x8*>(Ks + KSWZ(r32, cb));
    const bf16x8 b1 = *reinterpret_cast<const bf16x8*>(Ks + KSWZ(32 + r32, cb));
    p0 = __builtin_amdgcn_mfma_f32_32x32x16_bf16(b0, qr[d0], p0, 0, 0, 0);
    p1 = __builtin_amdgcn_mfma_f32_32x32x16_bf16(b1, qr[d0], p1, 0, 0, 0); }
}
__device__ __forceinline__ int v_st(int k, int c) { const int kk = (k & ~0xC) | ((k & 4) << 1) | ((k & 8) >> 1); return ((kk >> 3) * 4 + (c >> 5)) * 512 + ((kk & 7) * 32 + (c & 31)) * 2; }
__device__ __forceinline__ int v_rd_base(int lane) { return ((lane & 3) << 3) | (((lane >> 2) & 3) << 6) | (((lane >> 4) & 1) << 5) | (((lane >> 5) & 1) << 8); }
constexpr int v_rd_off(int d0, int ks, int half) { return d0 * 512 + ks * 4096 + half * 2048; }
template <int OFF> __device__ __forceinline__ s16x4 tr_read(int vb) {
  s16x4 r; asm volatile("ds_read_b64_tr_b16 %0, %1 offset:%2" : "=&v"(r) : "v"(vb), "i"(OFF) : "memory"); return r;
}
template <int D0> __device__ __forceinline__ void pv_one(f32x16& od, int vb, bf16x8 pa0, bf16x8 pa1, bf16x8 pa2, bf16x8 pa3) {
  const s16x4 l0 = tr_read<v_rd_off(D0, 0, 0)>(vb), h0 = tr_read<v_rd_off(D0, 0, 1)>(vb), l1 = tr_read<v_rd_off(D0, 1, 0)>(vb), h1 = tr_read<v_rd_off(D0, 1, 1)>(vb);
  const s16x4 l2 = tr_read<v_rd_off(D0, 2, 0)>(vb), h2 = tr_read<v_rd_off(D0, 2, 1)>(vb), l3 = tr_read<v_rd_off(D0, 3, 0)>(vb), h3 = tr_read<v_rd_off(D0, 3, 1)>(vb);
  asm volatile("s_waitcnt lgkmcnt(0)" ::: "memory"); SBAR();
#define PK(L, H) (bf16x8){L[0], L[1], L[2], L[3], H[0], H[1], H[2], H[3]}
  od = __builtin_amdgcn_mfma_f32_32x32x16_bf16(pa0, PK(l0, h0), od, 0, 0, 0);
  od = __builtin_amdgcn_mfma_f32_32x32x16_bf16(pa1, PK(l1, h1), od, 0, 0, 0);
  od = __builtin_amdgcn_mfma_f32_32x32x16_bf16(pa2, PK(l2, h2), od, 0, 0, 0);
  od = __builtin_amdgcn_mfma_f32_32x32x16_bf16(pa3, PK(l3, h3), od, 0, 0, 0);
#undef PK
}
__device__ __forceinline__ void pv_d0(f32x16* o, int vb, bf16x8 pa0, bf16x8 pa1, bf16x8 pa2, bf16x8 pa3) {
  pv_one<0>(o[0], vb, pa0, pa1, pa2, pa3); pv_one<1>(o[1], vb, pa0, pa1, pa2, pa3); pv_one<2>(o[2], vb, pa0, pa1, pa2, pa3); pv_one<3>(o[3], vb, pa0, pa1, pa2, pa3);
}

template <int VAR>
__device__ __forceinline__ void attn_unit(const bf16_t* __restrict__ Qb, const bf16_t* __restrict__ Kh, const bf16_t* __restrict__ Vh, int nkeys,
                                          bf16_t* __restrict__ Ob, float lam, float osc, const float* __restrict__ sg, char* lds, const int tid) {
  const int wid = __builtin_amdgcn_readfirstlane(tid >> 6), lane = tid & 63, r32 = lane & 31, hi = lane >> 5;
  const int comp = wid >> 2, qw = wid & 3, kcol = comp * 128;
  char* K_lds = lds; char* V_lds = lds + 2 * SHM_K;
  float* ws = (float*)(lds + 2 * SHM_K + 3 * SHM_V) + wid * 64; float* li_l = ws; float* al_l = ws + 32;
  float m_reg = -1e30f, l_reg = 0; f32x16 o[4] = {}; bf16x8 qr[4];
  const bf16_t* Qw = Qb + (long)(qw * QBLK + r32) * LDQ + comp * 64 + hi * 8;
#pragma unroll
  for (int d0 = 0; d0 < 4; ++d0) qr[d0] = *reinterpret_cast<const bf16x8*>(Qw + d0 * 16);
  const int sr = tid >> 4, sc = (tid & 15) * 8, vst0 = v_st(sr, sc), vst1 = v_st(32 + sr, sc);
  const int vb0 = (int)(uintptr_t)V_lds + v_rd_base(lane);
  bf16x8 sk0 = {}, sk1 = {}, sv0 = {}, sv1 = {};
#define LOADK(t) do { if constexpr (!(VAR & 8)) { sk0 = *reinterpret_cast<const bf16x8*>(&Kh[(long)((t) * KVBLK + sr) * LDQ + sc]); sk1 = *reinterpret_cast<const bf16x8*>(&Kh[(long)((t) * KVBLK + 32 + sr) * LDQ + sc]); } } while (0)
#define LOADV(t) do { if constexpr (!(VAR & 8)) { sv0 = *reinterpret_cast<const bf16x8*>(&Vh[(long)((t) * KVBLK + sr) * LDQ + sc]); sv1 = *reinterpret_cast<const bf16x8*>(&Vh[(long)((t) * KVBLK + 32 + sr) * LDQ + sc]); } } while (0)
#define WRITEK(slot) do { if constexpr (!(VAR & 8)) { *(bf16x8*)(K_lds + (slot) * SHM_K + KSWZ(sr, sc * 2)) = sk0; *(bf16x8*)(K_lds + (slot) * SHM_K + KSWZ(32 + sr, sc * 2)) = sk1; } } while (0)
#define WRITEV(off) do { if constexpr (!(VAR & 8)) { *(bf16x8*)(V_lds + (off) + vst0) = sv0; *(bf16x8*)(V_lds + (off) + vst1) = sv1; } } while (0)
#define VMW() asm volatile("s_waitcnt vmcnt(0)" ::: "memory")
#define QKT(P0, P1, KS) do { if constexpr (VAR & 4) { P0 = f32x16{}; P1 = f32x16{}; asm volatile("" : "+v"(P0), "+v"(P1)); } else qkt(P0, P1, KS, qr, r32, hi, kcol); } while (0)
#define PSM(P0, P1, MN, AL) do { if constexpr (VAR & 1) { MN = m_reg; AL = 1.f; asm volatile("" : "+v"(P0), "+v"(P1)); } else partialSM(P0, P1, m_reg, MN, AL); } while (0)
#define FSM(P0, P1, AL) do { if constexpr (VAR & 1) { asm volatile("" : "+v"(P0), "+v"(P1)); pa0 = __builtin_bit_cast(bf16x8, (f32x4){P0[0], P0[1], P0[2], P0[3]}); pa1 = __builtin_bit_cast(bf16x8, (f32x4){P0[4], P0[5], P0[6], P0[7]}); pa2 = __builtin_bit_cast(bf16x8, (f32x4){P1[0], P1[1], P1[2], P1[3]}); pa3 = __builtin_bit_cast(bf16x8, (f32x4){P1[4], P1[5], P1[6], P1[7]}); } else finishSM(P0, P1, AL, l_reg, pa0, pa1, pa2, pa3); } while (0)
#define PV(OFF) do { if constexpr (VAR & 2) { asm volatile("" : "+v"(pa0), "+v"(pa1), "+v"(pa2), "+v"(pa3)); } else pv_d0(o, vb0 + (OFF), pa0, pa1, pa2, pa3); } while (0)
#define RESC(a) do { if (__any((a) < 1.f)) { if (hi == 0) al_l[r32] = (a); asm volatile("s_waitcnt lgkmcnt(0)" ::: "memory"); \
    _Pragma("unroll") for (int d = 0; d < 4; ++d) _Pragma("unroll") for (int r = 0; r < 16; ++r) o[d][r] *= al_l[crow(r, hi)]; } } while (0)
  f32x16 pA0, pA1, pB0, pB1; float mnA, mnB, alA, alB; bf16x8 pa0, pa1, pa2, pa3; const int NT = nkeys / KVBLK;
  LOADK(0); VMW(); WRITEK(0); LOADK(1); LOADV(0);
  __syncthreads();
  if (comp == 1) __syncthreads();
  VMW(); WRITEK(1); WRITEV(0);
  SBAR(); QKT(pA0, pA1, K_lds); SBAR();
  __syncthreads();
  LOADK(2); LOADV(1); SBAR();
  PSM(pA0, pA1, mnA, alA);
  __syncthreads();
  int va = 0, vb = SHM_V, vc = 2 * SHM_V;
  for (int j = 1; j + 1 < NT; j += 2) {
    VMW(); WRITEK(0); WRITEV(vb);
    SBAR(); QKT(pB0, pB1, K_lds + SHM_K);
    FSM(pA0, pA1, alA); SBAR();
    __syncthreads();
    LOADK(j + 2); LOADV(j + 1); SBAR();
    PV(va); PSM(pB0, pB1, mnB, alB);
    RESC(alB);
    __syncthreads();
    VMW(); WRITEK(1); WRITEV(vc);
    SBAR(); QKT(pA0, pA1, K_lds);
    FSM(pB0, pB1, alB); SBAR();
    __syncthreads();
    if (j + 3 < NT) LOADK(j + 3);
    LOADV(j + 2); SBAR();
    PV(vb); PSM(pA0, pA1, mnA, alA);
    RESC(alA);
    __syncthreads();
    { const int t = va; va = vc; vc = vb; vb = t; }
  }
  VMW(); WRITEV(vb);
  SBAR(); QKT(pB0, pB1, K_lds + SHM_K);
  FSM(pA0, pA1, alA); SBAR();
  __syncthreads();
  PV(va); PSM(pB0, pB1, mnB, alB);
  RESC(alB);
  __syncthreads();
  FSM(pB0, pB1, alB); SBAR();
  PV(vb);
  if (comp == 0) __syncthreads();
  if (hi == 0) li_l[r32] = l_reg; asm volatile("s_waitcnt lgkmcnt(0)" ::: "memory");
  float rli[16];
#pragma unroll
  for (int r = 0; r < 16; ++r) rli[r] = __builtin_amdgcn_rcpf(li_l[crow(r, hi)]);
  __syncthreads();
  float* XO = (float*)lds + qw * (32 * 128);
  if (comp == 1) {
#pragma unroll
    for (int r = 0; r < 16; ++r)
#pragma unroll
      for (int d0 = 0; d0 < 4; ++d0) XO[crow(r, hi) * 128 + d0 * 32 + r32] = o[d0][r] * rli[r];
  }
  __syncthreads();
  if (comp == 0) {
    float ss[16];
#pragma unroll
    for (int r = 0; r < 16; ++r) { float s = 0.f;
#pragma unroll
      for (int d0 = 0; d0 < 4; ++d0) { const float v = o[d0][r] * rli[r] - lam * XO[crow(r, hi) * 128 + d0 * 32 + r32]; o[d0][r] = v; s += v * v; }
      ss[r] = s; }
#pragma unroll
    for (int r = 0; r < 16; ++r) { float s = ss[r]; s += swz_xor<1>(s); s += swz_xor<2>(s); s += swz_xor<4>(s); s += swz_xor<8>(s); s += swz_xor<16>(s);
      ss[r] = osc / sqrtf(s * (1.0f / 128.0f) + EPS); }
    float gam[4];
#pragma unroll
    for (int d0 = 0; d0 < 4; ++d0) gam[d0] = sg[d0 * 32 + r32];
    asm volatile("s_waitcnt lgkmcnt(0)" ::: "memory");
    bf16_t* stg = (bf16_t*)XO;
#pragma unroll
    for (int r = 0; r < 16; ++r)
#pragma unroll
      for (int d0 = 0; d0 < 4; ++d0) stg[crow(r, hi) * 128 + d0 * 32 + r32] = (bf16_t)(cvtpk(o[d0][r] * ss[r] * gam[d0], 0.f) & 0xffffu);
    asm volatile("s_waitcnt lgkmcnt(0)" ::: "memory");
#pragma unroll
    for (int i = 0; i < 8; ++i) { const int row = i * 4 + (lane >> 4), ch = lane & 15; const u32x4 v = *(const u32x4*)(stg + row * 128 + ch * 8);
      if constexpr (VAR & 16) { asm volatile("" :: "v"(v.x), "v"(v.y), "v"(v.z), "v"(v.w)); } else *(u32x4*)(Ob + (long)(qw * QBLK + row) * LDO + ch * 8) = v; }
  }
  __syncthreads();
#undef LOADK
#undef LOADV
#undef WRITEK
#undef WRITEV
#undef VMW
#undef QKT
#undef PSM
#undef FSM
#undef PV
#undef RESC
}
#undef KSWZ
#undef SBAR
}
namespace att2 {
using att::crow; using att::v_st; using att::v_rd_base; using att::v_rd_off;
constexpr int NW = 8, QBLK = 32, KVBLK = 64, LDQ = 512, LDO = KCAT, SHM_K = 16384, SHM_V = 16384;
constexpr float THRL = 8.0f;
#ifndef ATT_STAGGER
#define ATT_STAGGER 1
#endif
typedef short v4i16_t __attribute__((ext_vector_type(4)));
typedef __attribute__((address_space(3))) const char* lds_cptr;
typedef __attribute__((address_space(3))) char* lds_ptr;
#define SBAR() __builtin_amdgcn_sched_barrier(0)
#define KSWZ(row, colB) ((row) * 256 + ((colB) ^ (((row) & 7) << 4)))
__device__ __forceinline__ s16x4 vtr(lds_cptr p) { return __builtin_bit_cast(s16x4, __builtin_amdgcn_ds_read_tr16_b64_v4i16((__attribute__((address_space(3))) v4i16_t*)p)); }
__device__ __forceinline__ bf16x8 ldk(lds_cptr p) { return *(const __attribute__((address_space(3))) bf16x8*)p; }
#define MF(D, A, B, C) do { if constexpr (VAR & 4) { asm volatile("" : "+v"(D)); } else D = __builtin_amdgcn_mfma_f32_32x32x16_bf16(A, B, C, 0, 0, 0); } while (0)
#define VF(L, H) (bf16x8){L[0], L[1], L[2], L[3], H[0], H[1], H[2], H[3]}

__device__ __forceinline__ int vkey(int g) { const int s_ = g >> 5, kk = ((s_ >> 2) << 3) | ((g >> 2) & 7); return (kk & ~0xC) | ((kk & 4) << 1) | ((kk & 8) >> 1); }
template <int VAR>
__device__ __forceinline__ void attn_unit(const bf16_t* __restrict__ Qb, const bf16_t* __restrict__ Kh, const bf16_t* __restrict__ Vh, int nkeys,
                                          bf16_t* __restrict__ Ob, float lam, float osc, const float* __restrict__ sg, char* lds, const int tid) {
  const int wid = __builtin_amdgcn_readfirstlane(tid >> 6), lane = tid & 63, r32 = lane & 31, hi = lane >> 5;
  const int comp = wid >> 2, qw = wid & 3, kcol = comp * 128;
  const lds_ptr L3 = (lds_ptr)(unsigned)(uintptr_t)lds;
  float* ws = (float*)(lds + 3 * SHM_K + 3 * SHM_V) + wid * 64; float* li_l = ws; float* al_l = ws + 32;
  float mhat = 0.f, l_reg = 0.f; f32x16 o[4] = {}; bf16x8 qr[4]; f32x16 negm = {};
  const bf16_t* Qw = Qb + (long)(qw * QBLK + r32) * LDQ + comp * 64 + hi * 8;
#pragma unroll
  for (int d0 = 0; d0 < 4; ++d0) qr[d0] = *reinterpret_cast<const bf16x8*>(Qw + d0 * 16);
  const int sr = tid >> 4, sc = (tid & 15) * 8;
  const int kr0 = 4 * wid + (lane >> 4), kr1 = kr0 + 32;
  const bf16_t* ksrc0 = Kh + (long)kr0 * LDQ + (((lane & 15) ^ (kr0 & 7)) << 3); const bf16_t* ksrc1 = Kh + (long)kr1 * LDQ + (((lane & 15) ^ (kr1 & 7)) << 3);
  const int g0_ = 64 * wid + lane, g1_ = g0_ + 512;
  const int vk0 = vkey(g0_), vk1 = vkey(g1_);
  const bf16_t* vsrc0 = Vh + (long)vk0 * LDQ + ((g0_ >> 5) & 3) * 32 + (g0_ & 3) * 8; const bf16_t* vsrc1 = Vh + (long)vk1 * LDQ + ((g1_ >> 5) & 3) * 32 + (g1_ & 3) * 8;
  const unsigned kd0 = (unsigned)(uintptr_t)lds + wid * 1024, kd1 = kd0 + 8192, vd0 = (unsigned)(uintptr_t)lds + 3 * SHM_K + wid * 1024, vd1 = vd0 + 8192;
  lds_cptr kq[4];
#pragma unroll
  for (int d0 = 0; d0 < 4; ++d0) kq[d0] = L3 + r32 * 256 + ((kcol + d0 * 32 + hi * 16) ^ ((r32 & 7) << 4));
  const lds_cptr vp0 = L3 + 3 * SHM_K + v_rd_base(lane);
#define GLDS(src, dst) __builtin_amdgcn_global_load_lds((const unsigned*)(src), (__attribute__((address_space(3))) unsigned*)(dst), 16, 0, 0)
#define DMAK(t, slot) do { if constexpr (!(VAR & 8)) { GLDS(ksrc0 + (long)(t) * KVBLK * LDQ, (unsigned)__builtin_amdgcn_readfirstlane(kd0 + (slot) * SHM_K)); GLDS(ksrc1 + (long)(t) * KVBLK * LDQ, (unsigned)__builtin_amdgcn_readfirstlane(kd1 + (slot) * SHM_K)); } } while (0)
#define DMAV(t, off) do { if constexpr (!(VAR & 8)) { GLDS(vsrc0 + (long)(t) * KVBLK * LDQ, (unsigned)__builtin_amdgcn_readfirstlane(vd0 + (off))); GLDS(vsrc1 + (long)(t) * KVBLK * LDQ, (unsigned)__builtin_amdgcn_readfirstlane(vd1 + (off))); } } while (0)
#define VMW() asm volatile("s_waitcnt vmcnt(0)" ::: "memory")
#define BARW(n) do { asm volatile("s_waitcnt vmcnt(" #n ") lgkmcnt(0)" ::: "memory"); __builtin_amdgcn_s_barrier(); asm volatile("" ::: "memory"); } while (0)
  f32x16 pA0, pA1, pB0, pB1; u32x4 pw0 = {}, pw1 = {}, pw2 = {}, pw3 = {}; const int NT = nkeys / KVBLK; bool resc = false;
#define KF(KOFF, d0, half) ldk(kq[d0] + (KOFF) + 8192 * (half))
#define PKA(P, B, A0, A1) do { if constexpr (!(VAR & 1)) { A0 = cvt2bf(P[B + 0], P[B + 1]); A1 = cvt2bf(P[B + 2], P[B + 3]); sacc += P[B + 0]; sacc += P[B + 1]; sacc += P[B + 2]; sacc += P[B + 3]; } } while (0)
#define PKB(P, B, A0, A1, PW) do { if constexpr (!(VAR & 1)) { const unsigned b0_ = cvt2bf(P[B + 4], P[B + 5]), b1_ = cvt2bf(P[B + 6], P[B + 7]); \
    auto r0_ = __builtin_amdgcn_permlane32_swap(A0, b0_, false, false); auto r1_ = __builtin_amdgcn_permlane32_swap(A1, b1_, false, false); \
    PW = (u32x4){r0_[0], r1_[0], r0_[1], r1_[1]}; sacc += P[B + 4]; sacc += P[B + 5]; sacc += P[B + 6]; sacc += P[B + 7]; } } while (0)
#define H1(C0, C1, P0, P1, KOFF, FIN) do { \
    float sacc = 0.f; unsigned a0_ = 0, a1_ = 0; \
    bf16x8 f0 = KF(KOFF, 0, 0), f1 = KF(KOFF, 0, 1), f2 = KF(KOFF, 1, 0); SBAR(); \
    MF(C0, f0, qr[0], negm); { f0 = KF(KOFF, 1, 1); if (FIN) PKA(P0, 0, a0_, a1_); } SBAR(); \
    MF(C1, f1, qr[0], negm); { f1 = KF(KOFF, 2, 0); if (FIN) PKB(P0, 0, a0_, a1_, pw0); } SBAR(); \
    MF(C0, f2, qr[1], C0);   { f2 = KF(KOFF, 2, 1); if (FIN) PKA(P0, 8, a0_, a1_); } SBAR(); \
    MF(C1, f0, qr[1], C1);   { f0 = KF(KOFF, 3, 0); if (FIN) PKB(P0, 8, a0_, a1_, pw1); } SBAR(); \
    MF(C0, f1, qr[2], C0);   { f1 = KF(KOFF, 3, 1); if (FIN) PKA(P1, 0, a0_, a1_); } SBAR(); \
    MF(C1, f2, qr[2], C1);   { if (FIN) PKB(P1, 0, a0_, a1_, pw2); } SBAR(); \
    MF(C0, f0, qr[3], C0);   { if (FIN) PKA(P1, 8, a0_, a1_); } SBAR(); \
    MF(C1, f1, qr[3], C1);   { if (FIN) PKB(P1, 8, a0_, a1_, pw3); } SBAR(); \
    if (FIN) { auto rr_ = __builtin_amdgcn_permlane32_swap(__float_as_uint(sacc), __float_as_uint(sacc), false, false); l_reg += __uint_as_float(rr_[0]) + __uint_as_float(rr_[1]); } \
  } while (0)
#define VRD(VOFF, ks, d0, LO, HI) do { LO = vtr(vp0 + (VOFF) + v_rd_off(d0, ks, 0)); HI = vtr(vp0 + (VOFF) + v_rd_off(d0, ks, 1)); } while (0)
#define PAF(k) __builtin_bit_cast(bf16x8, pw##k)
#define MX3(a, b, c) ((VAR & 2) ? (a) : fmaxf(fmaxf((a), (b)), (c)))
#define EX(X, i) do { if constexpr (!(VAR & 2)) X[i] = __builtin_amdgcn_exp2f(X[i]); } while (0)
#define PIN2(X, Y) asm volatile("" : "+v"(X), "+v"(Y))
#define H2(C0, C1, VOFF, DOPV, FIRST) do { \
    s16x4 l0, h0, l1, h1, l2, h2; float ma, mb, rm; \
    if (DOPV) { VRD(VOFF, 0, 0, l0, h0); VRD(VOFF, 0, 1, l1, h1); VRD(VOFF, 0, 2, l2, h2); } SBAR(); \
    if (DOPV) { MF(o[0], PAF(0), VF(l0, h0), o[0]); VRD(VOFF, 0, 3, l0, h0); } ma = MX3(C0[0], C0[1], C1[0]); mb = MX3(C0[2], C0[3], C1[1]); ma = MX3(ma, C1[2], C1[3]); mb = MX3(mb, C0[4], C0[5]); SBAR(); \
    if (DOPV) { MF(o[1], PAF(0), VF(l1, h1), o[1]); VRD(VOFF, 1, 0, l1, h1); } ma = MX3(ma, C0[6], C0[7]); mb = MX3(mb, C1[4], C1[5]); ma = MX3(ma, C1[6], C1[7]); mb = MX3(mb, C0[8], C0[9]); SBAR(); \
    if (DOPV) { MF(o[2], PAF(0), VF(l2, h2), o[2]); VRD(VOFF, 1, 1, l2, h2); } ma = MX3(ma, C0[10], C0[11]); mb = MX3(mb, C1[8], C1[9]); ma = MX3(ma, C1[10], C1[11]); mb = MX3(mb, C0[12], C0[13]); SBAR(); \
    if (DOPV) { MF(o[3], PAF(0), VF(l0, h0), o[3]); VRD(VOFF, 1, 2, l0, h0); } ma = MX3(ma, C0[14], C0[15]); mb = MX3(mb, C1[12], C1[13]); ma = MX3(ma, C1[14], C1[15]); rm = fmaxf(ma, mb); SBAR(); \
    if (DOPV) { MF(o[0], PAF(1), VF(l1, h1), o[0]); VRD(VOFF, 1, 3, l1, h1); } \
    { auto rr_ = __builtin_amdgcn_permlane32_swap(__float_as_uint(rm), __float_as_uint(rm), false, false); rm = fmaxf(__uint_as_float(rr_[0]), __uint_as_float(rr_[1])); } SBAR(); \
    resc = false; \
    if (FIRST || __builtin_expect(__any(rm > THRL), 0)) { const float dl = FIRST ? rm : fmaxf(rm, 0.f); mhat += dl; \
      _Pragma("unroll") for (int r = 0; r < 16; ++r) { C0[r] -= dl; C1[r] -= dl; } \
      _Pragma("unroll") for (int r = 0; r < 16; ++r) negm[r] = -mhat; \
      if (!(FIRST)) { const float f = __builtin_amdgcn_exp2f(-dl); l_reg *= f; if (hi == 0) al_l[r32] = f; resc = true; } } \
    SBAR(); \
    if (DOPV) { MF(o[1], PAF(1), VF(l2, h2), o[1]); VRD(VOFF, 2, 0, l2, h2); } EX(C0, 0); EX(C0, 1); EX(C0, 2); PIN2(C0, C1); SBAR(); \
    if (DOPV) { MF(o[2], PAF(1), VF(l0, h0), o[2]); VRD(VOFF, 2, 1, l0, h0); } EX(C0, 3); EX(C0, 4); EX(C0, 5); PIN2(C0, C1); SBAR(); \
    if (DOPV) { MF(o[3], PAF(1), VF(l1, h1), o[3]); VRD(VOFF, 2, 2, l1, h1); } EX(C0, 6); EX(C0, 7); EX(C0, 8); PIN2(C0, C1); SBAR(); \
    if (DOPV) { MF(o[0], PAF(2), VF(l2, h2), o[0]); VRD(VOFF, 2, 3, l2, h2); } EX(C0, 9); EX(C0, 10); EX(C0, 11); PIN2(C0, C1); SBAR(); \
    if (DOPV) { MF(o[1], PAF(2), VF(l0, h0), o[1]); VRD(VOFF, 3, 0, l0, h0); } EX(C0, 12); EX(C0, 13); EX(C0, 14); PIN2(C0, C1); SBAR(); \
    if (DOPV) { MF(o[2], PAF(2), VF(l1, h1), o[2]); VRD(VOFF, 3, 1, l1, h1); } EX(C0, 15); EX(C1, 0); EX(C1, 1); PIN2(C0, C1); SBAR(); \
    if (DOPV) { MF(o[3], PAF(2), VF(l2, h2), o[3]); VRD(VOFF, 3, 2, l2, h2); } EX(C1, 2); EX(C1, 3); EX(C1, 4); PIN2(C0, C1); SBAR(); \
    if (DOPV) { MF(o[0], PAF(3), VF(l0, h0), o[0]); VRD(VOFF, 3, 3, l0, h0); } EX(C1, 5); EX(C1, 6); EX(C1, 7); PIN2(C0, C1); SBAR(); \
    if (DOPV) { MF(o[1], PAF(3), VF(l1, h1), o[1]); } EX(C1, 8); EX(C1, 9); EX(C1, 10); PIN2(C0, C1); SBAR(); \
    if (DOPV) { MF(o[2], PAF(3), VF(l2, h2), o[2]); } EX(C1, 11); EX(C1, 12); EX(C1, 13); PIN2(C0, C1); SBAR(); \
    if (DOPV) { MF(o[3], PAF(3), VF(l0, h0), o[3]); } EX(C1, 14); EX(C1, 15); PIN2(C0, C1); SBAR(); \
    if (resc) { asm volatile("s_waitcnt lgkmcnt(0)" ::: "memory"); \
      _Pragma("unroll") for (int d = 0; d < 4; ++d) _Pragma("unroll") for (int r = 0; r < 16; ++r) o[d][r] *= al_l[crow(r, hi)]; } \
  } while (0)
#define PVONLY(VOFF) do { _Pragma("unroll") for (int ks = 0; ks < 4; ++ks) _Pragma("unroll") for (int d0 = 0; d0 < 4; ++d0) { s16x4 l_, h_; VRD(VOFF, ks, d0, l_, h_); \
      const bf16x8 pa_ = ks == 0 ? PAF(0) : ks == 1 ? PAF(1) : ks == 2 ? PAF(2) : PAF(3); MF(o[d0], pa_, VF(l_, h_), o[d0]); } } while (0)

  DMAK(0, 0); DMAK(1, 1); DMAV(0, 0);
  BARW(0);
  if (ATT_STAGGER && comp == 1) __builtin_amdgcn_s_barrier();
  H1(pA0, pA1, pB0, pB1, 0, false);
  BARW(0);
  DMAK(2, 2); DMAV(1, SHM_V); SBAR();
  H2(pA0, pA1, 0, false, true);
  BARW(4);
  int va = 0, vb = SHM_V, vc = 2 * SHM_V;
  for (int j = 1; j + 1 < NT; j += 2) {
    H1(pB0, pB1, pA0, pA1, vb, true);
    BARW(0);
    DMAK(j + 2, va >> 14); DMAV(j + 1, vc); SBAR();
    H2(pB0, pB1, va, true, false);
    BARW(4);
    H1(pA0, pA1, pB0, pB1, vc, true);
    BARW(0);
    if (j + 3 < NT) DMAK(j + 3, vb >> 14);
    DMAV(j + 2, va); SBAR();
    H2(pA0, pA1, vb, true, false);
    BARW(4);
    { const int t = va; va = vc; vc = vb; vb = t; }
  }
  H1(pB0, pB1, pA0, pA1, vb, true);
  BARW(0);
  H2(pB0, pB1, va, true, false);
  BARW(0);
  { float sacc = 0.f; unsigned a0_ = 0, a1_ = 0;
    PKA(pB0, 0, a0_, a1_); PKB(pB0, 0, a0_, a1_, pw0); PKA(pB0, 8, a0_, a1_); PKB(pB0, 8, a0_, a1_, pw1); PKA(pB1, 0, a0_, a1_); PKB(pB1, 0, a0_, a1_, pw2); PKA(pB1, 8, a0_, a1_); PKB(pB1, 8, a0_, a1_, pw3);
    auto rr_ = __builtin_amdgcn_permlane32_swap(__float_as_uint(sacc), __float_as_uint(sacc), false, false); l_reg += __uint_as_float(rr_[0]) + __uint_as_float(rr_[1]); }
  SBAR(); PVONLY(vb);
  if (ATT_STAGGER && comp == 0) { asm volatile("s_waitcnt lgkmcnt(0)" ::: "memory"); __builtin_amdgcn_s_barrier(); }
  if (hi == 0) li_l[r32] = l_reg; asm volatile("s_waitcnt lgkmcnt(0)" ::: "memory");
  float rli[16];
#pragma unroll
  for (int r = 0; r < 16; ++r) rli[r] = __builtin_amdgcn_rcpf(li_l[crow(r, hi)]);
  __syncthreads();
  float* XO = (float*)lds + qw * (32 * 128);
  if (comp == 1) {
#pragma unroll
    for (int r = 0; r < 16; ++r)
#pragma unroll
      for (int d0 = 0; d0 < 4; ++d0) XO[crow(r, hi) * 128 + d0 * 32 + r32] = o[d0][r] * rli[r];
  }
  __syncthreads();
  if (comp == 0) {
    float ss[16];
#pragma unroll
    for (int r = 0; r < 16; ++r) { float s = 0.f;
#pragma unroll
      for (int d0 = 0; d0 < 4; ++d0) { const float v = o[d0][r] * rli[r] - lam * XO[crow(r, hi) * 128 + d0 * 32 + r32]; o[d0][r] = v; s += v * v; }
      ss[r] = s; }
#pragma unroll
    for (int r = 0; r < 16; ++r) { float s = ss[r]; s += swz_xor<1>(s); s += swz_xor<2>(s); s += swz_xor<4>(s); s += swz_xor<8>(s); s += swz_xor<16>(s);
      ss[r] = osc / sqrtf(s * (1.0f / 128.0f) + EPS); }
    float gam[4];
#pragma unroll
    for (int d0 = 0; d0 < 4; ++d0) gam[d0] = sg[d0 * 32 + r32];
    asm volatile("s_waitcnt lgkmcnt(0)" ::: "memory");
    bf16_t* stg = (bf16_t*)XO;
#pragma unroll
    for (int r = 0; r < 16; ++r)
#pragma unroll
      for (int d0 = 0; d0 < 4; ++d0) stg[crow(r, hi) * 128 + d0 * 32 + r32] = (bf16_t)(cvt2bf(o[d0][r] * ss[r] * gam[d0], 0.f) & 0xffffu);
    asm volatile("s_waitcnt lgkmcnt(0)" ::: "memory");
#pragma unroll
    for (int i = 0; i < 8; ++i) { const int row = i * 4 + (lane >> 4), ch = lane & 15; const u32x4 v = *(const u32x4*)(stg + row * 128 + ch * 8);
      if constexpr (VAR & 16) { asm volatile("" :: "v"(v.x), "v"(v.y), "v"(v.z), "v"(v.w)); } else *(u32x4*)(Ob + (long)(qw * QBLK + row) * LDO + ch * 8) = v; }
  }
  __syncthreads();
#undef GLDS
#undef DMAK
#undef DMAV
#undef VMW
#undef BARW
#undef KF
#undef PKA
#undef PKB
#undef H1
#undef VRD
#undef PAF
#undef MX3
#undef EX
#undef PIN2
#undef H2
#undef PVONLY
}
#undef SBAR
#undef KSWZ
#undef MF
#undef VF
}
typedef GAS unsigned gu32;
#define RLX_AGENT __ATOMIC_RELAXED, __HIP_MEMORY_SCOPE_AGENT
constexpr int PT_OFF = LDSCTL_OFF + 1024;
__device__ __forceinline__ unsigned long long ldptr(volatile LAS unsigned long long* PT, int i) {
    const unsigned long long v = PT[i];
    const unsigned lo = __builtin_amdgcn_readfirstlane((unsigned)v), hi = __builtin_amdgcn_readfirstlane((unsigned)(v >> 32));
    return ((unsigned long long)hi << 32) | lo;
}
#define XB_TMO      128
#define XB_XCNT(j)  (256  + 64 * (j))
#define XB_XSUB(j)  (1280 + 64 * (j))
#define XB_XGEN(j)  (2304 + 64 * (j))
#define XB_TOP      3328
#define XB_TOPGEN   3392
#define XCD_BAR_WORDS 3456
#define XB_SPIN_CAP (1u << 18)

__device__ __forceinline__ unsigned xb_ld(unsigned* p)              { return __hip_atomic_load(p, __ATOMIC_RELAXED, __HIP_MEMORY_SCOPE_AGENT); }
__device__ __forceinline__ unsigned xb_add(unsigned* p, unsigned v) { return __hip_atomic_fetch_add(p, v, __ATOMIC_RELAXED, __HIP_MEMORY_SCOPE_AGENT); }
__device__ __forceinline__ unsigned xb_xcc_id() { return (unsigned)__builtin_amdgcn_s_getreg((3 << 11) | 20) & 0xFu; }
#define XB_SPIN(cond, bar) do { unsigned _sp = 0; while (cond) { __builtin_amdgcn_s_sleep(1); \
    if ((++_sp & 255u) == 0u) { if (xb_ld(&(bar)[XB_TMO])) break; if (_sp > XB_SPIN_CAP) { atomicAdd(&(bar)[XB_TMO], 1u); break; } } } } while (0)

struct XcdBarrier {
    unsigned* bar; unsigned x;
    volatile LAS unsigned* st;
};

__device__ __forceinline__ XcdBarrier xcd_barrier_post(unsigned* bar, volatile LAS unsigned* st) {
    XcdBarrier b; b.bar = bar; b.x = xb_xcc_id(); b.st = st;
    if (threadIdx.x == 0) (void)xb_add(&bar[XB_XCNT(b.x)], 1u);
    return b;
}
__device__ __forceinline__ void xcd_barrier_complete(unsigned* bar, unsigned x, unsigned& nloc, unsigned& nx) {
    const unsigned G = gridDim.x * gridDim.y * gridDim.z;
    unsigned sum, cnt, mine, sp = 0u;
    for (;;) {
        sum = 0u; cnt = 0u; mine = 0u;
#pragma unroll
        for (unsigned j = 0; j < 16; ++j) { const unsigned c = xb_ld(&bar[XB_XCNT(j)]); sum += c; cnt += (c > 0u) ? 1u : 0u; mine = (j == x) ? c : mine; }
        if (sum == G) break;
        __builtin_amdgcn_s_sleep(1);
        if ((++sp & 255u) == 0u) { if (xb_ld(&bar[XB_TMO])) break; if (sp > XB_SPIN_CAP) { atomicAdd(&bar[XB_TMO], 1u); break; } }
    }
    nloc = mine > 0u ? mine : 1u; nx = cnt > 0u ? cnt : 1u;
}

__device__ __forceinline__ void xcd_barrier(const XcdBarrier& b) {
    asm volatile("s_waitcnt vmcnt(0)" ::: "memory");
    __syncthreads();
    if (threadIdx.x == 0) {
        unsigned* bar = b.bar;
        __builtin_amdgcn_s_waitcnt(0);
        unsigned nloc = b.st[0], nx = b.st[1];
        if (nloc == 0u) { xcd_barrier_complete(bar, b.x, nloc, nx); b.st[0] = nloc; b.st[1] = nx; }
        const unsigned old = xb_add(&bar[XB_XSUB(b.x)], 1u);
        const unsigned gen = old / nloc;
        if (old + 1u == (gen + 1u) * nloc) {
            __builtin_amdgcn_fence(__ATOMIC_RELEASE, "agent");
            asm volatile("s_waitcnt vmcnt(0)" ::: "memory");
            const unsigned og = xb_add(&bar[XB_TOP], 1u);
            const unsigned tg = og / nx;
            if (og + 1u == (tg + 1u) * nx) xb_add(&bar[XB_TOPGEN], 1u);
            else XB_SPIN(xb_ld(&bar[XB_TOPGEN]) == tg, bar);
            __builtin_amdgcn_fence(__ATOMIC_ACQUIRE, "agent");
            xb_add(&bar[XB_XGEN(b.x)], 1u);
            asm volatile("s_waitcnt vmcnt(0)" ::: "memory");
        } else {
            XB_SPIN(xb_ld(&bar[XB_XGEN(b.x)]) == gen, bar);
            __builtin_amdgcn_fence(__ATOMIC_ACQUIRE, "agent");
            asm volatile("s_waitcnt vmcnt(0)" ::: "memory");
        }
    }
    __syncthreads();
}
__device__ __forceinline__ float wave_sum(float v) {
    v += swz_xor<1>(v); v += swz_xor<2>(v); v += swz_xor<4>(v); v += swz_xor<8>(v); v += swz_xor<16>(v);
    auto rr = __builtin_amdgcn_permlane32_swap(__float_as_uint(v), __float_as_uint(v), false, false);
    return __uint_as_float(rr[0]) + __uint_as_float(rr[1]);
}
__device__ __forceinline__ unsigned pk2(float lo, float hi) { return cvt2bf(lo, hi); }

template <int MAP  >
__device__ __forceinline__ void transpose_item(const float* W, int Nsrc, int coff, bf16_t* WT, int ldw, int koff, int nblk, LAS float* scr, int item, int lane) {
    const int kb = item / nblk, nb = item % nblk, k0 = 64 * kb, n0 = 32 * nb;
    const int nd = n0 + (lane & 31); const int scol = MAP ? in_map(nd) : nd + coff;
    float wv[32];
#pragma unroll
    for (int i = 0; i < 32; ++i) wv[i] = W[(size_t)(k0 + 2 * i + (lane >> 5)) * Nsrc + scol];
#pragma unroll
    for (int i = 0; i < 32; ++i) scr[(2 * i + (lane >> 5)) * 33 + (lane & 31)] = wv[i];
    asm volatile("s_waitcnt lgkmcnt(0)" ::: "memory");
    const int c = lane & 7;
#pragma unroll
    for (int j = 0; j < 4; ++j) { const int n = (lane >> 3) + 8 * j; const LAS float* s = scr + (8 * c) * 33 + n;
        u32x4 o; o.x = pk2(s[0 * 33], s[1 * 33]); o.y = pk2(s[2 * 33], s[3 * 33]); o.z = pk2(s[4 * 33], s[5 * 33]); o.w = pk2(s[6 * 33], s[7 * 33]);
        *(u32x4*)(WT + (size_t)(n0 + n) * ldw + koff + k0 + 8 * c) = o; }
    asm volatile("s_waitcnt lgkmcnt(0)" ::: "memory");
}
struct WSrc { const float *w_in, *wo_f, *wo_a, *wo_c, *wo_p, *w_out, *w_up, *w_down; };
constexpr int IT_A = 16 * 208;
constexpr int IT_B0 = 4 * 32, IT_B1 = 8 * 32, IT_B2 = 4 * 32, IT_B3 = 4 * 32, IT_B4 = 16 * 32, IT_B5 = 16 * 88, IT_B6 = 16 * 88, IT_B7 = 44 * 32;
constexpr int IT_B = IT_B0 + IT_B1 + IT_B2 + IT_B3 + IT_B4 + IT_B5 + IT_B6 + IT_B7;
__device__ __forceinline__ void convert_A(const WSrc& S, unsigned char* ws, LAS float* scr, int gw, int NGW, int lane) {
    for (int it = gw; it < IT_A; it += NGW) transpose_item<1>(S.w_in, NIN, 0, (bf16_t*)(ws + WS_WA), 1024, 0, 208, scr, it, lane);
}
__device__ __forceinline__ void convert_B(const WSrc& S, unsigned char* ws, LAS float* scr, int gw, int NGW, int lane) {
    for (int it = gw; it < IT_B; it += NGW) { int r = it;
        if (r < IT_B0) { transpose_item<0>(S.wo_f, 1024, 0, (bf16_t*)(ws + WS_WCAT), KCAT, 0, 32, scr, r, lane); continue; } r -= IT_B0;
        if (r < IT_B1) { transpose_item<0>(S.wo_a, 1024, 0, (bf16_t*)(ws + WS_WCAT), KCAT, 256, 32, scr, r, lane); continue; } r -= IT_B1;
        if (r < IT_B2) { transpose_item<0>(S.wo_c, 1024, 0, (bf16_t*)(ws + WS_WCAT), KCAT, 768, 32, scr, r, lane); continue; } r -= IT_B2;
        if (r < IT_B3) { transpose_item<0>(S.wo_p, 1024, 0, (bf16_t*)(ws + WS_WCAT), KCAT, 1024, 32, scr, r, lane); continue; } r -= IT_B3;
        if (r < IT_B4) { transpose_item<0>(S.w_out, 1024, 0, (bf16_t*)(ws + WS_WOUT), 1024, 0, 32, scr, r, lane); continue; } r -= IT_B4;
        if (r < IT_B5) { transpose_item<0>(S.w_up, 2 * DFF, DFF, (bf16_t*)(ws + WS_WUPG), 1024, 0, 88, scr, r, lane); continue; } r -= IT_B5;
        if (r < IT_B6) { transpose_item<0>(S.w_up, 2 * DFF, 0, (bf16_t*)(ws + WS_WUPV), 1024, 0, 88, scr, r, lane); continue; } r -= IT_B6;
        transpose_item<0>(S.w_down, 1024, 0, (bf16_t*)(ws + WS_WDN), DFF, 0, 32, scr, r, lane);
    }
}

__device__ __forceinline__ void mod_phase(const float* c, const float* c_ctx, const float* ada_w, const float* ada_b, float* MOD, LAS unsigned char* lds, int vcu, int G, int tid, int wave, int lane) {
    LAS float* sil = (LAS float*)lds;
    LAS float* red = (LAS float*)(lds + 12288);
    for (int i = tid; i < 3072; i += 512) { const float v = i < 2048 ? c[i] : c_ctx[i - 2048]; sil[i] = v * sigm(v); }
    __syncthreads();
    for (int item = vcu; item < 192; item += G) {
        const int l = item / 96, n = (item % 96) * 64 + lane;
        const float* W = ada_w + (size_t)l * 1024 * 6144 + n;
        float a0 = 0.f, a1 = 0.f, a2 = 0.f;
        for (int k = wave * 128; k < wave * 128 + 128; k += 8) { float w[8];
#pragma unroll
            for (int i = 0; i < 8; ++i) w[i] = W[(size_t)(k + i) * 6144];
#pragma unroll
            for (int i = 0; i < 8; ++i) { a0 += sil[k + i] * w[i]; a1 += sil[1024 + k + i] * w[i]; a2 += sil[2048 + k + i] * w[i]; } }
        red[(wave * 3 + 0) * 64 + lane] = a0; red[(wave * 3 + 1) * 64 + lane] = a1; red[(wave * 3 + 2) * 64 + lane] = a2;
        __syncthreads();
        if (wave < 3) { float s = ada_b[l * 6144 + n];
#pragma unroll
            for (int w = 0; w < 8; ++w) s += red[(w * 3 + wave) * 64 + lane];
            MOD[(size_t)(l * 3 + wave) * 6144 + n] = s; }
        __syncthreads();
    }
}
__device__ __forceinline__ void tables_phase(float* ROPE, f32x2* TW, int gt, int NGT) {
    for (int i = gt; i < 192 * 16; i += NGT) { const int pos = i >> 4, f = i & 15; const float inv = powf(10000.0f, -(float)f / 16.0f); const float ang = (float)(pos < 128 ? pos : pos - 128) * inv;
        float s, c; sincosf(ang, &s, &c); ROPE[pos * 32 + f] = c; ROPE[pos * 32 + 16 + f] = s; }
    for (int i = gt; i < 8192; i += NGT) { float s, c; sincospif((float)i * (1.0f / 4096.0f), &s, &c); TW[i] = (f32x2){c, -s}; }
}

__device__ __forceinline__ void norm_phase(const float* src_lat, const float* src_ctx, int nrows, const float* gamma, const float* mod, int shoff, int scoff, bf16_t* HX, int gw, int NGW, int lane) {
    for (int m0 = gw; m0 < nrows; m0 += 4 * NGW) {
        f32x4 v[4][4]; float s[4];
#pragma unroll
        for (int u = 0; u < 4; ++u) { const int m = m0 + u * NGW; s[u] = 0.f;
            if (m < nrows) { const float* xr = m < ML ? src_lat + (size_t)m * DM : src_ctx + (size_t)(m - ML) * DM;
#pragma unroll
                for (int j = 0; j < 4; ++j) v[u][j] = ((const f32x4*)xr)[lane + 64 * j]; } }
#pragma unroll
        for (int u = 0; u < 4; ++u) { const int m = m0 + u * NGW; if (m < nrows) {
#pragma unroll
            for (int j = 0; j < 4; ++j) s[u] += (v[u][j].x * v[u][j].x + v[u][j].y * v[u][j].y) + (v[u][j].z * v[u][j].z + v[u][j].w * v[u][j].w);
            const float rstd = 1.0f / sqrtf(wave_sum(s[u]) * (1.0f / DM) + EPS);
            const float* md = mod + (m < SEQ ? 0 : m < ML ? 1 : 2) * 6144;
#pragma unroll
            for (int j = 0; j < 4; ++j) { const int col = 4 * lane + 256 * j;
                const f32x4 g = *(const f32x4*)(gamma + col), sc = *(const f32x4*)(md + scoff + col), sh = *(const f32x4*)(md + shoff + col);
                const f32x4 o = v[u][j] * rstd * g * (sc + 1.0f) + sh;
                u32x2 w; w.x = pk2(o.x, o.y); w.y = pk2(o.z, o.w); *(u32x2*)(HX + (size_t)m * DM + col) = w; } } }
    }
}
__device__ __forceinline__ void final_norm_phase(float* x, const float* gamma, int gw, int NGW, int lane) {
    for (int m0 = gw; m0 < ML; m0 += 4 * NGW) {
        f32x4 v[4][4];
#pragma unroll
        for (int u = 0; u < 4; ++u) { const int m = m0 + u * NGW; if (m < ML) {
#pragma unroll
            for (int j = 0; j < 4; ++j) v[u][j] = ((const f32x4*)(x + (size_t)m * DM))[lane + 64 * j]; } }
#pragma unroll
        for (int u = 0; u < 4; ++u) { const int m = m0 + u * NGW; if (m < ML) { float s = 0.f;
#pragma unroll
            for (int j = 0; j < 4; ++j) s += (v[u][j].x * v[u][j].x + v[u][j].y * v[u][j].y) + (v[u][j].z * v[u][j].z + v[u][j].w * v[u][j].w);
            const float rstd = 1.0f / sqrtf(wave_sum(s) * (1.0f / DM) + EPS);
#pragma unroll
            for (int j = 0; j < 4; ++j) { const f32x4 g = *(const f32x4*)(gamma + 4 * lane + 256 * j); ((f32x4*)(x + (size_t)m * DM))[lane + 64 * j] = v[u][j] * rstd * g; } } }
    }
}

#define SWZ(row, colB) ((row) * 256 + ((colB) ^ (((row) & 7) << 4)))
__device__ __forceinline__ int crow_(int r, int hi) { return (r & 3) + 8 * (r >> 2) + 4 * hi; }
__device__ __forceinline__ bf16x8 pack_bf8(const float* v) { u32x4 w; w.x = pk2(v[0], v[1]); w.y = pk2(v[2], v[3]); w.z = pk2(v[4], v[5]); w.w = pk2(v[6], v[7]); return __builtin_bit_cast(bf16x8, w); }
__device__ __forceinline__ void fft1_phase(const bf16_t* UF, const f32x2* TW, unsigned* FA, LAS unsigned char* lds, int vcu, int G, int tid, int wave, int lane) {
    const int tr = wave >> 1, tc = wave & 1, r32 = lane & 31, hi = lane >> 5;
    bf16x8 aRe[8], aIm[8];
#pragma unroll
    for (int ks = 0; ks < 8; ++ks) { float cv[8], sv[8];
#pragma unroll
        for (int j = 0; j < 8; ++j) { const int idx = ((32 * tr + r32) * (16 * ks + 8 * hi + j)) & 127; float s, c; sincospif((float)idx * (1.0f / 64.0f), &s, &c); cv[j] = c; sv[j] = -s; }
        aRe[ks] = pack_bf8(cv); aIm[ks] = pack_bf8(sv); }
    for (int item = vcu; item < 512; item += G) {
        const int b = item >> 8, g = (item >> 6) & 3, l2 = item & 63;
#pragma unroll
        for (int i = 0; i < 2; ++i) { const int q = tid + 512 * i, l1 = q >> 3, c8 = (q & 7) * 8;
            const u32x4 v = *(const u32x4*)(UF + (size_t)(b * SEQ + 64 * l1 + l2) * 256 + g * 64 + c8);
#pragma unroll
            for (int e = 0; e < 8; ++e) { const unsigned w = v[e >> 1]; *(LAS bf16_t*)(lds + SWZ(c8 + e, l1 * 2)) = (bf16_t)((e & 1) ? (w >> 16) : (w & 0xffffu)); } }
        __syncthreads();
        f32x16 re = {}, im = {};
#pragma unroll
        for (int ks = 0; ks < 8; ++ks) { const bf16x8 bx = *(const LAS bf16x8*)(lds + SWZ(32 * tc + r32, (16 * ks + 8 * hi) * 2));
            re = __builtin_amdgcn_mfma_f32_32x32x16_bf16(aRe[ks], bx, re, 0, 0, 0); im = __builtin_amdgcn_mfma_f32_32x32x16_bf16(aIm[ks], bx, im, 0, 0, 0); }
        unsigned* dst = FA + ((size_t)((b * 4 + g) * 64 + l2) * 128) * 64 + 32 * tc + r32;
#pragma unroll
        for (int r = 0; r < 16; ++r) { const int k1 = 32 * tr + crow_(r, hi); const f32x2 t = TW[k1 * l2];
            dst[(size_t)k1 * 64] = pk2(re[r] * t.x - im[r] * t.y, re[r] * t.y + im[r] * t.x); }
        __syncthreads();
    }
}
__device__ __forceinline__ void fft2_phase(const unsigned* FA, bf16_t* ACAT, LAS unsigned char* lds, int vcu, int G, int tid, int wave, int lane) {
    const int tr = wave >> 1, tc = wave & 1, r32 = lane & 31, hi = lane >> 5;
    bf16x8 a2[8], b3[8];
#pragma unroll
    for (int ks = 0; ks < 8; ++ks) { float av[8], bv[8];
#pragma unroll
        for (int j = 0; j < 8; ++j) { const int R = 32 * tr + r32, k = 16 * ks + 8 * hi + j, k2 = R & 63, ll = k & 63; float s, c; sincospif((float)((k2 * ll) & 63) * (1.0f / 32.0f), &s, &c);
            av[j] = (R < 64) ? ((k < 64) ? c : s) : ((k < 64) ? -s : c);
            const int m = 32 * tc + r32; float s2, c2; sincospif((float)((m * ll) & 63) * (1.0f / 32.0f), &s2, &c2); bv[j] = (k < 64) ? c2 : s2; }
        a2[ks] = pack_bf8(av); b3[ks] = pack_bf8(bv); }
    LAS unsigned char* Bt = lds;
    LAS unsigned char* Zt = lds + 16384;
    for (int item = vcu; item < 1024; item += G) {
        const int b = item >> 9, g = (item >> 7) & 3, k1 = item & 127;
#pragma unroll
        for (int i = 0; i < 2; ++i) { const int q = tid + 512 * i, l2 = q >> 4, c4 = (q & 15) * 4;
            const u32x4 v = *(const u32x4*)(FA + ((size_t)((b * 4 + g) * 64 + l2) * 128 + k1) * 64 + c4);
#pragma unroll
            for (int e = 0; e < 4; ++e) { *(LAS bf16_t*)(Bt + SWZ(c4 + e, l2 * 2)) = (bf16_t)(v[e] & 0xffffu); *(LAS bf16_t*)(Bt + SWZ(c4 + e, (64 + l2) * 2)) = (bf16_t)(v[e] >> 16); } }
        __syncthreads();
        f32x16 z = {};
#pragma unroll
        for (int ks = 0; ks < 8; ++ks) { const bf16x8 bx = *(const LAS bf16x8*)(Bt + SWZ(32 * tc + r32, (16 * ks + 8 * hi) * 2)); z = __builtin_amdgcn_mfma_f32_32x32x16_bf16(a2[ks], bx, z, 0, 0, 0); }
#pragma unroll
        for (int r = 0; r < 16; ++r) { const int R = 32 * tr + crow_(r, hi); *(LAS bf16_t*)(Zt + SWZ(R & 63, ((R >> 6) * 64 + 32 * tc + r32) * 2)) = (bf16_t)(pk2(z[r], 0.f) & 0xffffu); }
        __syncthreads();
        if (wave < 4) { f32x16 y = {};
#pragma unroll
            for (int ks = 0; ks < 8; ++ks) { const bf16x8 ax = *(const LAS bf16x8*)(Zt + SWZ(32 * tr + r32, (16 * ks + 8 * hi) * 2)); y = __builtin_amdgcn_mfma_f32_32x32x16_bf16(ax, b3[ks], y, 0, 0, 0); }
#pragma unroll
            for (int r = 0; r < 16; ++r) { const int k2 = 32 * tr + crow_(r, hi); ACAT[(size_t)(b * SEQ + k1 + 128 * k2) * KCAT + g * 64 + 32 * tc + r32] = (bf16_t)(pk2(y[r] * 0.001381067932f, 0.f) & 0xffffu); } }
        __syncthreads();
    }
}
__device__ __forceinline__ void ctxdft_item(int item, const bf16_t* UF, bf16_t* ACAT, LAS unsigned char* lds, int tid, int wave, int lane) {
    const int b = item >> 4, g = (item >> 2) & 3, kc = item & 3;
    const int tr = wave >> 1, tc = wave & 1, r32 = lane & 31, hi = lane >> 5;
    LAS unsigned char* Xt = lds;
    LAS unsigned char* Zt = lds + 32768;
#pragma unroll
    for (int i = 0; i < 4; ++i) { const int q = tid + 512 * i, l = q >> 3, c8 = (q & 7) * 8;
        const u32x4 v = *(const u32x4*)(UF + (size_t)(ML + b * CTXL + l) * 256 + g * 64 + c8);
#pragma unroll
        for (int e = 0; e < 8; ++e) { const unsigned w = v[e >> 1]; const int row = c8 + e; *(LAS bf16_t*)(Xt + row * 512 + ((((l >> 3) ^ (row & 7)) << 4) | ((l & 7) * 2))) = (bf16_t)((e & 1) ? (w >> 16) : (w & 0xffffu)); } }
    __syncthreads();
    f32x16 z = {};
    const int R = 32 * tr + r32, kk = 64 * kc + (R & 63);
#pragma unroll 4
    for (int ks = 0; ks < 16; ++ks) { float av[8];
#pragma unroll
        for (int j = 0; j < 8; ++j) { const int l = 16 * ks + 8 * hi + j; float s, c; sincospif((float)((kk * l) & 255) * (1.0f / 128.0f), &s, &c); av[j] = (R < 64) ? c : -s; }
        const int row = 32 * tc + r32, ch = (16 * ks + 8 * hi) >> 3;
        const bf16x8 bx = *(const LAS bf16x8*)(Xt + row * 512 + ((ch ^ (row & 7)) << 4));
        z = __builtin_amdgcn_mfma_f32_32x32x16_bf16(pack_bf8(av), bx, z, 0, 0, 0); }
#pragma unroll
    for (int r = 0; r < 16; ++r) { const int Rr = 32 * tr + crow_(r, hi); *(LAS bf16_t*)(Zt + SWZ(Rr & 63, ((Rr >> 6) * 64 + 32 * tc + r32) * 2)) = (bf16_t)(pk2(z[r], 0.f) & 0xffffu); }
    __syncthreads();
    if (wave < 4) { f32x16 y = {};
#pragma unroll
        for (int ks = 0; ks < 8; ++ks) { float bv[8];
#pragma unroll
            for (int j = 0; j < 8; ++j) { const int k = 16 * ks + 8 * hi + j, m = 32 * tc + r32; float s2, c2; sincospif((float)((m * (k & 63)) & 63) * (1.0f / 32.0f), &s2, &c2); bv[j] = (k < 64) ? c2 : s2; }
            const bf16x8 ax = *(const LAS bf16x8*)(Zt + SWZ(32 * tr + r32, (16 * ks + 8 * hi) * 2)); y = __builtin_amdgcn_mfma_f32_32x32x16_bf16(ax, pack_bf8(bv), y, 0, 0, 0); }
#pragma unroll
        for (int r = 0; r < 16; ++r) { const int k = 64 * kc + 32 * tr + crow_(r, hi); ACAT[(size_t)(ML + b * CTXL + k) * KCAT + g * 64 + 32 * tc + r32] = (bf16_t)(pk2(y[r] * (1.0f / 128.0f), 0.f) & 0xffffu); } }
    __syncthreads();
}

__device__ __forceinline__ void conv_item(int item, const bf16_t* ZG, const float* cw  , const float* cb, const float* lng, const float* lnb, bf16_t* ACAT, LAS unsigned char* lds, int tid, int wave, int lane) {
    const int row0 = item * 64; const bool lat = row0 < ML; const int s0 = lat ? (row0 & ~(SEQ - 1)) : (ML + ((row0 - ML) & ~(CTXL - 1))), s1 = s0 + (lat ? SEQ : CTXL);
    LAS float* zt = (LAS float*)lds;
#pragma unroll
    for (int i = 0; i < 6; ++i) { const int q = tid + 512 * i; if (q < 94 * 32) { const int rr = q >> 5, c8 = (q & 31) * 8, gr = row0 - 15 + rr;
        u32x4 v = {0u, 0u, 0u, 0u}; if (gr >= s0 && gr < s1) v = *(const u32x4*)(ZG + (size_t)gr * 256 + c8);
        *(LAS f32x4*)(zt + rr * 256 + c8) = (f32x4){bf2f(v.x & 0xffffu), __uint_as_float(v.x & 0xffff0000u), bf2f(v.y & 0xffffu), __uint_as_float(v.y & 0xffff0000u)};
        *(LAS f32x4*)(zt + rr * 256 + c8 + 4) = (f32x4){bf2f(v.z & 0xffffu), __uint_as_float(v.z & 0xffff0000u), bf2f(v.w & 0xffffu), __uint_as_float(v.w & 0xffff0000u)}; } }
    const int c = tid & 255, half = tid >> 8;
    float w[31];
#pragma unroll
    for (int t = 0; t < 31; ++t) w[t] = cw[t * 256 + c];
    float acc[32]; const float bias = cb[c];
    __syncthreads();
#pragma unroll
    for (int r0 = 0; r0 < 32; r0 += 4) { float v[34];
#pragma unroll
        for (int i = 0; i < 34; ++i) v[i] = zt[(half * 32 + r0 + i) * 256 + c];
        float a0 = bias, a1 = bias, a2 = bias, a3 = bias;
#pragma unroll
        for (int t = 0; t < 31; ++t) { a0 += w[t] * v[t]; a1 += w[t] * v[t + 1]; a2 += w[t] * v[t + 2]; a3 += w[t] * v[t + 3]; }
        acc[r0] = a0; acc[r0 + 1] = a1; acc[r0 + 2] = a2; acc[r0 + 3] = a3; }
    __syncthreads();
#pragma unroll
    for (int r = 0; r < 32; ++r) zt[(half * 32 + r) * 256 + c] = acc[r];
    __syncthreads();
    const f32x4 gg = *(const f32x4*)(lng + 4 * lane), bb = *(const f32x4*)(lnb + 4 * lane);
#pragma unroll
    for (int i = 0; i < 8; ++i) { const int r = wave * 8 + i; const f32x4 v = *(const LAS f32x4*)(zt + r * 256 + 4 * lane);
        const float mu = wave_sum((v.x + v.y) + (v.z + v.w)) * (1.0f / 256.0f); const f32x4 d = v - mu;
        const float var = wave_sum((d.x * d.x + d.y * d.y) + (d.z * d.z + d.w * d.w)) * (1.0f / 256.0f); const float rs = 1.0f / sqrtf(var + EPS);
        f32x4 o = d * rs * gg + bb; o.x *= sigm(o.x); o.y *= sigm(o.y); o.z *= sigm(o.z); o.w *= sigm(o.w);
        u32x2 pw; pw.x = pk2(o.x, o.y); pw.y = pk2(o.z, o.w); *(u32x2*)(ACAT + (size_t)(row0 + r) * KCAT + 768 + 4 * lane) = pw; }
    __syncthreads();
}
__device__ __forceinline__ void pool_phase(const bf16_t* UP, const float* pw  , const float* psc, bf16_t* ACAT, int nitems, int first, LAS unsigned char* lds, int G, int tid, int wave, int lane) {
    const int g = wave >> 1, tc = wave & 1, r32 = lane & 31, hi = lane >> 5;
    bf16x8 bw[4];
#pragma unroll
    for (int ks = 0; ks < 4; ++ks) { float v[8];
#pragma unroll
        for (int j = 0; j < 8; ++j) v[j] = pw[g * 4096 + (16 * ks + 8 * hi + j) * 64 + 32 * tc + r32];
        bw[ks] = pack_bf8(v); }
    const float osc = psc[g * 64 + 32 * tc + r32];
    LAS float* ut = (LAS float*)lds;
    LAS unsigned char* dt = lds + 81920;
    for (int item = first; item < nitems; item += G) {
        const int row0 = item * 64; const bool lat = row0 < ML; const int s0 = lat ? (row0 & ~(SEQ - 1)) : (ML + ((row0 - ML) & ~(CTXL - 1))), L = lat ? SEQ : CTXL, s1 = s0 + L;
#pragma unroll
        for (int i = 0; i < 5; ++i) { const int q = tid + 512 * i, rr = q >> 5, c8 = (q & 31) * 8, gr = row0 - 8 + rr;
            u32x4 v = {0u, 0u, 0u, 0u}; if (gr >= s0 && gr < s1) v = *(const u32x4*)(UP + (size_t)gr * 256 + c8);
            *(LAS f32x4*)(ut + rr * 256 + c8) = (f32x4){bf2f(v.x & 0xffffu), __uint_as_float(v.x & 0xffff0000u), bf2f(v.y & 0xffffu), __uint_as_float(v.y & 0xffff0000u)};
            *(LAS f32x4*)(ut + rr * 256 + c8 + 4) = (f32x4){bf2f(v.z & 0xffffu), __uint_as_float(v.z & 0xffff0000u), bf2f(v.w & 0xffffu), __uint_as_float(v.w & 0xffff0000u)}; }
        __syncthreads();
#pragma unroll
        for (int i = 0; i < 4; ++i) { const int q = tid + 512 * i, lr = q >> 5, c8 = (q & 31) * 8, gg = c8 >> 6, hw = 1 << gg, tt = row0 + lr - s0;
            f32x4 sa = {0.f, 0.f, 0.f, 0.f}, sb = {0.f, 0.f, 0.f, 0.f};
            for (int o = -hw; o < hw; ++o) { sa += *(const LAS f32x4*)(ut + (lr + 8 + o) * 256 + c8); sb += *(const LAS f32x4*)(ut + (lr + 8 + o) * 256 + c8 + 4); }
            const int lo = tt - hw < 0 ? 0 : tt - hw, hh = tt + hw - 1 > L - 1 ? L - 1 : tt + hw - 1; const float inv = 1.0f / (float)(hh - lo + 1);
            const f32x4 ua = *(const LAS f32x4*)(ut + (lr + 8) * 256 + c8), ub = *(const LAS f32x4*)(ut + (lr + 8) * 256 + c8 + 4);
            const f32x4 da = sa * inv - ua, db = sb * inv - ub;
            u32x4 w; w.x = pk2(da.x, da.y); w.y = pk2(da.z, da.w); w.z = pk2(db.x, db.y); w.w = pk2(db.z, db.w);
            *(LAS u32x4*)(dt + lr * 512 + ((((c8 >> 3) ^ (lr & 7)) << 4))) = w; }
        __syncthreads();
#pragma unroll
        for (int rt = 0; rt < 2; ++rt) { f32x16 y = {};
#pragma unroll
            for (int ks = 0; ks < 4; ++ks) { const int row = 32 * rt + r32, ch = (g * 64 + 16 * ks + 8 * hi) >> 3;
                const bf16x8 ax = *(const LAS bf16x8*)(dt + row * 512 + ((ch ^ (row & 7)) << 4)); y = __builtin_amdgcn_mfma_f32_32x32x16_bf16(ax, bw[ks], y, 0, 0, 0); }
#pragma unroll
            for (int r = 0; r < 16; ++r) ACAT[(size_t)(row0 + 32 * rt + crow_(r, hi)) * KCAT + 1024 + g * 64 + 32 * tc + r32] = (bf16_t)(pk2(y[r] * osc, 0.f) & 0xffffu); }
        __syncthreads();
    }
}
constexpr int NPHASE = 22;
struct Args { const float* in[30]; float* out; unsigned char* ws; int ph_lo, ph_hi, li, pad; };
__global__ void __launch_bounds__(512, 2) __attribute__((amdgpu_waves_per_eu(2, 2))) fwd_kernel(Args args) {
    extern __shared__ __attribute__((aligned(16))) unsigned char lds[];
    LAS unsigned char* L = (LAS unsigned char*)lds;
    volatile LAS unsigned* MISC = (volatile LAS unsigned*)(L + MISC_OFF);
    const int tid0 = threadIdx.x; const int wave0 = __builtin_amdgcn_readfirstlane(tid0 >> 6);
    const int G = gridDim.x, bx0 = blockIdx.x, vcu0 = (G % 8 == 0) ? (bx0 % 8) * (G / 8) + bx0 / 8 : bx0;
    const int NGW = G * 8;
    gu32* ctl = (gu32*)(args.ws + WS_CTL);
    for (int u = tid0; u < (LDS_BYTES - LDSCTL_OFF) / 4; u += 512) ((LAS unsigned*)(L + LDSCTL_OFF))[u] = 0u;
    __syncthreads();
    volatile LAS unsigned long long* PT = (volatile LAS unsigned long long*)(L + PT_OFF);
    if (tid0 < 32) PT[tid0] = ((const __attribute__((address_space(4))) unsigned long long*)__builtin_amdgcn_kernarg_segment_ptr())[tid0];
    __syncthreads();
#define FRESH() int tid, vcu = vcu0, bx = bx0; asm volatile("v_mbcnt_lo_u32_b32 %0, -1, 0\n\tv_mbcnt_hi_u32_b32 %0, -1, %0" : "=v"(tid)); tid += wave0 * 64; asm volatile("" : "+v"(tid), "+s"(vcu), "+s"(bx)); const int lane = tid & 63, wave = __builtin_amdgcn_readfirstlane(tid >> 6), gw = vcu * 8 + wave; (void)lane; (void)gw; (void)bx; \
    LAS float* scr = (LAS float*)(L + wave * 16384); (void)scr;
#define PTR(i) ((const float*)(const GAS float*)ldptr(PT, (i)))
#define OUTP ((float*)(GAS float*)ldptr(PT, 30))
#define WSP ((unsigned char*)(GAS unsigned char*)ldptr(PT, 31))
    XcdBarrier bar; bar.bar = (unsigned*)(ctl + CW_BAR) + args.li * XCD_BAR_WORDS; bar.x = 0; bar.st = nullptr;
    if (MK_N_LAUNCHES != NPHASE) bar = xcd_barrier_post((unsigned*)(ctl + CW_BAR) + args.li * XCD_BAR_WORDS, MISC + 8);
#define GRID_BAR() do { if (MK_N_LAUNCHES == NPHASE) { if (tid0 == 0) __hip_atomic_store(ctl + CW_TMO, 0xBADBA0u, RLX_AGENT); } else { xcd_barrier(bar); } } while (0)
    const int lo = args.ph_lo, hi = args.ph_hi;
#ifndef PHASE_MASK
#define PHASE_MASK 0xFFF
#endif
#ifndef ATTM
#define ATTM 3
#endif
#ifndef X1REP
#define X1REP 0
#endif
#ifndef X1M
#define X1M 31
#endif
#define PH_EN(kind) ((PHASE_MASK >> (kind)) & 1)
#ifndef REP_MASK
#define REP_MASK 0
#endif
#define NREP(kind) (((REP_MASK >> (kind)) & 1) ? 2 : 1)
#define IN(k) (lo <= (k) && (k) < hi)
#define BOTH(k) (IN(k) && IN((k) + 1))
#define WSRC(S, l) WSrc S; S.w_in = PTR(8) + (size_t)(l) * 1024 * NIN; S.wo_f = PTR(20) + (size_t)(l) * 256 * 1024; S.wo_a = PTR(21) + (size_t)(l) * 512 * 1024; \
    S.wo_c = PTR(22) + (size_t)(l) * 256 * 1024; S.wo_p = PTR(23) + (size_t)(l) * 256 * 1024; S.w_out = PTR(24) + (size_t)(l) * 1024 * 1024; \
    S.w_up = PTR(25) + (size_t)(l) * 1024 * 2 * DFF; S.w_down = PTR(28) + (size_t)(l) * DFF * 1024;
#define ws WSP
#define MOD ((float*)(WSP + WS_MOD))
#define ROPE ((float*)(WSP + WS_ROPE))
#define TW ((f32x2*)(WSP + WS_TW))
#define XC ((float*)(WSP + WS_XC))
#define HX ((bf16_t*)(WSP + WS_HX))
#define FA ((f32x2*)(WSP + WS_FA))
#define Qb ((bf16_t*)(WSP + WS_Q))
#define Kb ((bf16_t*)(WSP + WS_K))
#define Vb ((bf16_t*)(WSP + WS_V))
#define Yb ((bf16_t*)(WSP + WS_Y))
#define Gb (WSP + WS_G)
#define ACAT ((bf16_t*)(WSP + WS_ACAT))
#define UF ((bf16_t*)(WSP + WS_UF))
#define ZG ((bf16_t*)(WSP + WS_ZG))
#define UP ((bf16_t*)(WSP + WS_UP))
#define GT ((bf16_t*)(WSP + WS_GT))
#define Hb ((bf16_t*)(WSP + WS_H))

    for (int rep = 0; rep < NREP(0); ++rep) if (PH_EN(0) && IN(0)) { FRESH();
        mod_phase(PTR(1), PTR(3), PTR(6), PTR(7), MOD, L, vcu, G, tid, wave, lane);
        tables_phase(ROPE, TW, vcu * 512 + tid, G * 512);
        WSRC(S0, 0); convert_A(S0, ws, scr, gw, NGW, lane); convert_B(S0, ws, scr, gw, NGW, lane);
        if (BOTH(0)) GRID_BAR();
    }
#pragma nounroll
    for (int l = 0; l < 2; ++l) {
        const int pb = 1 + 10 * l;
#define mod (MOD + l * 3 * 6144)
#define xl ((l == 0) ? PTR(0) : (const float*)OUTP)
#define xc ((l == 0) ? PTR(2) : (const float*)XC)
        const int Mact = (l == 0) ? MT : ML;
        for (int rep = 0; rep < NREP(1); ++rep) if (PH_EN(1) && IN(pb)) { FRESH(); norm_phase(xl, xc, MT, PTR(4) + l * DM, mod, 0, 1024, HX, gw, NGW, lane); if (BOTH(pb)) GRID_BAR(); }
        for (int rep = 0; rep < NREP(2); ++rep) if (PH_EN(2) && IN(pb + 1)) { FRESH();
            pg8::Gemm g{HX, (const bf16_t*)(ws + WS_WA), MT, NIN, 1024}; pg8::StaticOrder S; S.init(MT, NIN, G, bx);
            pg8::EpiIn E{UF, ZG, UP, Qb, Kb, Vb, Gb, ROPE};
            pg8::gemm_phase<pg8::EpiIn, pg8::StaticOrder, true, true>(L, g, S, E, tid);
            if (BOTH(pb + 1)) GRID_BAR();
        }
        for (int rep = 0; rep < NREP(3); ++rep) if (PH_EN(3) && IN(pb + 2)) { FRESH();
            for (int r1 = 0; r1 < ((X1REP & 1) ? 2 : 1); ++r1) if (X1M & 1) fft1_phase(UF, TW, (unsigned*)FA, L, vcu, G, tid, wave, lane);
            for (int r1 = 0; r1 < ((X1REP & 2) ? 2 : 1); ++r1) if (X1M & 2) for (int it = vcu; it < Mact / 64; it += G) conv_item(it, ZG, PTR(14) + l * 31 * 256, PTR(15) + l * 256, PTR(16) + l * 256, PTR(17) + l * 256, ACAT, L, tid, wave, lane);
            for (int r1 = 0; r1 < ((X1REP & 4) ? 2 : 1); ++r1) if (X1M & 4) pool_phase(UP, PTR(18) + l * 4 * 4096, PTR(19) + l * 256, ACAT, Mact / 64, (vcu + 248) % G, L, G, tid, wave, lane);
            if ((X1M & 8) && l == 0) for (int it = (vcu + 224) % G; it < 32; it += G) ctxdft_item(it, UF, ACAT, L, tid, wave, lane);
            WSRC(S1, 1);
            for (int r1 = 0; r1 < ((X1REP & 16) ? 2 : 1); ++r1) if (!(X1M & 16)) {} else if (l == 0) convert_A(S1, ws, scr, gw, NGW, lane); else convert_B(S1, ws, scr, gw, NGW, lane);
            if (BOTH(pb + 2)) GRID_BAR();
        }
        for (int rep = 0; rep < NREP(4); ++rep) if (PH_EN(4) && IN(pb + 3)) { FRESH();
            if (ATTM & 1) fft2_phase((const unsigned*)FA, ACAT, L, vcu, G, tid, wave, lane);
            const float lam_init = (l == 0) ? 0.2f : 0.35550906759096926f;
            const float d1 = wave_sum(PTR(9)[l * 64 + lane] * PTR(10)[l * 64 + lane]), d2 = wave_sum(PTR(11)[l * 64 + lane] * PTR(12)[l * 64 + lane]);
            const float lam = __builtin_bit_cast(float, __builtin_amdgcn_readfirstlane(__builtin_bit_cast(int, expf(d1) - expf(d2) + lam_init)));
            const int nun = 512 + (l == 0 ? 16 : 0);
            if (ATTM & 2) for (int u = vcu; u < nun; u += G) {
                int b, h, row0, nkeys;
                if (u < 512) { const int x = (u & 255) >> 5, qb = (u & 31) + 32 * (u >> 8); b = x >> 2; h = x & 3; row0 = b * SEQ + qb * 128; nkeys = KVL; }
                else { const int v = u - 512; b = v >> 3; h = (v >> 1) & 3; row0 = ML + b * CTXL + (v & 1) * 128; nkeys = CTXL; }
#if ATT_V == 2
                att2::attn_unit<0>(Qb + (size_t)row0 * 512 + h * 128,
#else
                att::attn_unit<0>(Qb + (size_t)row0 * 512 + h * 128,
#endif
                               Kb + (size_t)b * KVL * 512 + h * 128, Vb + (size_t)b * KVL * 512 + h * 128, nkeys,
                               ACAT + (size_t)row0 * KCAT + 256 + h * 128, lam, 1.0f - lam_init, PTR(13) + l * 128, (char*)lds, tid);
            }
#if defined(ATT_PROBE)
            int tid2 = tid, vcu2 = vcu; asm volatile("" : "+v"(tid2), "+s"(vcu2));
            for (int u = vcu2; u < 512; u += G) {
                const int x = (u & 255) >> 5, qb = (u & 31) + 32 * (u >> 8), b = x >> 2, h = x & 3, row0 = b * SEQ + qb * 128;
                att2::attn_unit<ATT_PROBE>(Qb + (size_t)row0 * 512 + h * 128, Kb + (size_t)b * KVL * 512 + h * 128, Vb + (size_t)b * KVL * 512 + h * 128, KVL,
                               Hb + (size_t)row0 * KCAT + 256 + h * 128, lam, 1.0f - lam_init, PTR(13) + l * 128, (char*)lds, tid2);
            }
#endif
            if (BOTH(pb + 3)) GRID_BAR();
        }
        for (int rep = 0; rep < NREP(5); ++rep) if (PH_EN(5) && IN(pb + 4)) { FRESH();
            pg8::Gemm g{ACAT, (const bf16_t*)(ws + WS_WCAT), Mact, 1024, KCAT}; pg8::StaticOrder S; S.init(Mact, 1024, G, bx);
            pg8::EpiBranch E{Gb, Yb};
            pg8::gemm_phase<pg8::EpiBranch, pg8::StaticOrder, true, true>(L, g, S, E, tid);
            if (BOTH(pb + 4)) GRID_BAR();
        }
        for (int rep = 0; rep < (l == 0 ? NREP(6) : 1); ++rep) if (PH_EN(6) && IN(pb + 5)) { FRESH();
            pg8::Gemm g{Yb, (const bf16_t*)(ws + WS_WOUT), Mact, 1024, 1024}; pg8::StaticOrder S; S.init(Mact, 1024, G, bx);
            pg8::EpiRes E{xl, xc, OUTP, XC, mod, 2048};
            pg8::gemm_phase<pg8::EpiRes, pg8::StaticOrder, true, true>(L, g, S, E, tid);
            if (BOTH(pb + 5)) GRID_BAR();
        }
        for (int rep = 0; rep < NREP(7); ++rep) if (PH_EN(7) && IN(pb + 6)) { FRESH(); norm_phase(OUTP, XC, Mact, PTR(5) + l * DM, mod, 3072, 4096, HX, gw, NGW, lane); if (BOTH(pb + 6)) GRID_BAR(); }
        for (int rep = 0; rep < NREP(8); ++rep) if (PH_EN(8) && IN(pb + 7)) { FRESH();
            pg8::Gemm g{HX, (const bf16_t*)(ws + WS_WUPG), Mact, DFF, 1024}; pg8::StaticOrder S; S.init(Mact, DFF, G, bx);
            pg8::EpiBf E{GT, DFF};
            pg8::gemm_phase<pg8::EpiBf, pg8::StaticOrder, true, true>(L, g, S, E, tid);
            if (BOTH(pb + 7)) GRID_BAR();
        }
        for (int rep = 0; rep < NREP(9); ++rep) if (PH_EN(9) && IN(pb + 8)) { FRESH();
            pg8::Gemm g{HX, (const bf16_t*)(ws + WS_WUPV), Mact, DFF, 1024}; pg8::StaticOrder S; S.init(Mact, DFF, G, bx);
            pg8::EpiVal E{GT, Hb, PTR(26) + l * 3 * DFF, PTR(27) + l * DFF};
            pg8::gemm_phase<pg8::EpiVal, pg8::StaticOrder, true, true>(L, g, S, E, tid);
            if (BOTH(pb + 8)) GRID_BAR();
        }
        if (PH_EN(10) && IN(pb + 9)) { FRESH();
            pg8::Gemm g{Hb, (const bf16_t*)(ws + WS_WDN), Mact, 1024, DFF}; pg8::StaticOrder S; S.init(Mact, 1024, G, bx);
            pg8::EpiRes E{OUTP, XC, OUTP, XC, mod, 5120};
            pg8::gemm_phase<pg8::EpiRes, pg8::StaticOrder, true, true>(L, g, S, E, tid);
            if (BOTH(pb + 9)) GRID_BAR();
        }
    }
    if (PH_EN(11) && IN(21)) { FRESH(); final_norm_phase(OUTP, PTR(29), gw, NGW, lane); }
#undef IN
#undef BOTH
#undef mod
#undef xl
#undef xc
#undef ws
#undef MOD
#undef ROPE
#undef TW
#undef XC
#undef HX
#undef FA
#undef Qb
#undef Kb
#undef Vb
#undef Yb
#undef Gb
#undef ACAT
#undef UF
#undef ZG
#undef UP
#undef GT
#undef Hb
#undef PTR
#undef OUTP
#undef WSP
}

extern "C" void kernel_launch(void* const* d_in, const int* in_sizes, int n_in, void* d_out, int out_size, void* d_ws, size_t ws_size, hipStream_t stream) {
    static int grid = 0;
    if (grid == 0) {
        if (n_in != 30 || in_sizes[0] != ML * DM || out_size != ML * DM || ws_size < WS_END) {
            fprintf(stderr, "kernel_launch: unexpected shapes: n_in %d in0 %d out %d ws %zu (need >= %zu)\n", n_in, n_in > 0 ? in_sizes[0] : -1, out_size, ws_size, (size_t)WS_END); grid = -1; return; }
        int dev = 0, cus = 0, per_cu = 0;
        if (hipGetDevice(&dev) != hipSuccess || hipDeviceGetAttribute(&cus, hipDeviceAttributeMultiprocessorCount, dev) != hipSuccess) { grid = -1; return; }
        if (hipFuncSetAttribute((const void*)fwd_kernel, hipFuncAttributeMaxDynamicSharedMemorySize, LDS_BYTES) != hipSuccess) { fprintf(stderr, "kernel_launch: hipFuncSetAttribute failed\n"); grid = -1; return; }
        if (hipOccupancyMaxActiveBlocksPerMultiprocessor(&per_cu, (const void*)fwd_kernel, 512, LDS_BYTES) != hipSuccess || per_cu < 1) {
            fprintf(stderr, "kernel_launch: occupancy query reports %d blocks per CU\n", per_cu); (void)hipGetLastError(); grid = -1; return; }
        grid = cus;
    }
    if (grid < 0) return;
    (void)hipMemsetAsync((char*)d_ws + WS_CTL, 0, CTL_ZERO_BYTES, stream);
    Args a{};
    for (int i = 0; i < 30; ++i) a.in[i] = (const float*)d_in[i];
    a.out = (float*)d_out; a.ws = (unsigned char*)d_ws;
    for (int li = 0; li < MK_N_LAUNCHES; ++li) {
        if (MK_N_LAUNCHES == NPHASE) { a.ph_lo = li; a.ph_hi = li + 1; a.li = 0; }
        else { a.ph_lo = (int)((long)NPHASE * li / MK_N_LAUNCHES); a.ph_hi = (int)((long)NPHASE * (li + 1) / MK_N_LAUNCHES); a.li = li; }
        hipLaunchKernelGGL(fwd_kernel, dim3(grid), dim3(512), LDS_BYTES, stream, a);
    }
}
```

```cpp
#include <hip/hip_runtime.h>
#include <cstdio>
#include <cstdint>

#define LAS __attribute__((address_space(3)))
#define GAS __attribute__((address_space(1)))
typedef unsigned short bf16_t;
typedef short bf16x8 __attribute__((ext_vector_type(8)));
typedef short s16x4 __attribute__((ext_vector_type(4)));
typedef float f32x2 __attribute__((ext_vector_type(2)));
typedef float f32x4 __attribute__((ext_vector_type(4)));
typedef float f32x16 __attribute__((ext_vector_type(16)));
typedef unsigned u32x2 __attribute__((ext_vector_type(2)));
typedef unsigned u32x4 __attribute__((ext_vector_type(4)));

#ifndef ATT_V
#define ATT_V 2
#endif
#ifndef MK_N_LAUNCHES
#define MK_N_LAUNCHES 1
#endif

constexpr int DM = 1024, SEQ = 8192, NBATCH = 2, CTXL = 256;
constexpr int ML = NBATCH * SEQ;
constexpr int MC = NBATCH * CTXL;
constexpr int MT = ML + MC;
constexpr int NIN = 6656, DFF = 2816, KCAT = 1280;
constexpr int KVL = CTXL + SEQ;
constexpr float EPS = 1e-6f;

constexpr size_t MiB = 1u << 20;
constexpr size_t WS_CTL = 0, CTL_ZERO_BYTES = 1 * MiB;
constexpr size_t WS_MOD = 1 * MiB;
constexpr size_t WS_ROPE = WS_MOD + 2 * 3 * 6144 * 4;
constexpr size_t WS_TW = WS_ROPE + 192 * 32 * 4;
constexpr size_t WS_XC = 2 * MiB;
constexpr size_t WS_WA = 4 * MiB;
constexpr size_t WS_WCAT = 17 * MiB;
constexpr size_t WS_WOUT = WS_WCAT + (size_t)1024 * 1280 * 2;
constexpr size_t WS_WUPG = WS_WOUT + (size_t)1024 * 1024 * 2;
constexpr size_t WS_WUPV = WS_WUPG + (size_t)2816 * 1024 * 2;
constexpr size_t WS_WDN = WS_WUPV + (size_t)2816 * 1024 * 2;
constexpr size_t WS_HX = 38 * MiB;
constexpr size_t WS_FA = WS_HX;
constexpr size_t WS_Q = 71 * MiB;
constexpr size_t WS_K = WS_Q + (size_t)MT * 512 * 2;
constexpr size_t WS_V = WS_K + (size_t)MT * 512 * 2;
constexpr size_t WS_Y = 71 * MiB;
constexpr size_t WS_G = 121 * MiB;
constexpr size_t WS_ACAT = 187 * MiB;
constexpr size_t WS_UF = 229 * MiB;
constexpr size_t WS_ZG = WS_UF + (size_t)MT * 256 * 2;
constexpr size_t WS_UP = WS_ZG + (size_t)MT * 256 * 2;
constexpr size_t WS_GT = 71 * MiB;
constexpr size_t WS_H = 162 * MiB;
constexpr size_t WS_END = 256 * MiB;
static_assert(WS_TW + 8192 * 8 <= WS_XC && WS_WDN + (size_t)1024 * 2816 * 2 <= WS_HX && WS_V + (size_t)MT * 512 * 2 <= WS_G && WS_G + (size_t)MT * 4096 <= WS_ACAT, "ws map 1");
static_assert(WS_ACAT + (size_t)MT * 1280 * 2 <= WS_UF && WS_UP + (size_t)MT * 256 * 2 <= WS_END && WS_GT + (size_t)MT * 2816 * 2 <= WS_H && WS_H + (size_t)MT * 2816 * 2 <= WS_END, "ws map 2");
static_assert(WS_HX + (size_t)MT * 1024 * 2 <= WS_Q && (size_t)2 * 4 * 128 * 64 * 64 * 8 <= (size_t)MT * 1024 * 2, "ws map 3");
constexpr int CW_TMO = 0, CW_CODE = 1, CW_BAR = 4096;

constexpr int RING_BYTES = 131072, LDSCTL_OFF = RING_BYTES, MISC_OFF = LDSCTL_OFF + 320, LDS_BYTES = 147456;

typedef __bf16 bf16x2_t __attribute__((ext_vector_type(2)));
__device__ __forceinline__ unsigned cvt2bf(float lo, float hi) { const f32x2 v = {lo, hi}; return __builtin_bit_cast(unsigned, __builtin_convertvector(v, bf16x2_t)); }
template <int M> __device__ __forceinline__ float swz_xor(float v) { return __int_as_float(__builtin_amdgcn_ds_swizzle(__float_as_int(v), (M << 10) | 0x1f)); }
__device__ __forceinline__ float bf2f(unsigned v) { return __uint_as_float(v << 16); }
__device__ __forceinline__ float sigm(float x) { return __builtin_amdgcn_rcpf(1.0f + __builtin_amdgcn_exp2f(x * -1.4426950408889634f)); }
__host__ __device__ __forceinline__ int in_map(int n) {
    if (n < 256) return n;
    if (n < 1280) { const int base = n < 768 ? 256 : 768, r = n - base, comp = r >> 6, p = r & 63, pp = p >> 1, e = p & 1;
        return base + comp * 64 + (pp < 16 ? 0 : 32) + (pp & 15) + 16 * e; }
    if (n < 1792) return n;
    if (n < 2304) { const int r = n - 1792; return 1792 + (r & 1) * 256 + (r >> 1); }
    return n;
}
namespace pg8 {
#define PG8_LAS __attribute__((address_space(3)))
typedef unsigned short bf16_t;
typedef short bf16x8 __attribute__((ext_vector_type(8)));
typedef float f32x4 __attribute__((ext_vector_type(4)));
typedef unsigned u32x4 __attribute__((ext_vector_type(4)));
constexpr int BM = 256, BK = 64, HALF = 128, HTB = HALF * BK * 2  , STAGE_BYTES = 8 * HTB, NXCD = 8, WGM = 8;

__host__ __device__ __forceinline__ int lds_byte(int r, int c) { const int st = (r >> 4) * 2 + (c >> 5), rr = r & 15, cc = c & 31, ob = rr * 64 + cc * 2; return st * 1024 + (ob ^ (((ob >> 9) & 1) << 5)); }
__host__ __device__ __forceinline__ void stage_rc(int b, int& R, int& C) { const int st = b / 1024, sb = b % 1024, swz = sb ^ (((sb >> 9) & 1) << 5); R = (st >> 1) * 16 + swz / 64; C = (st & 1) * 32 + (swz % 64) / 2; }
__host__ __device__ __forceinline__ int perm32(int rho) { const int n = rho >> 4, i = rho & 15; return 8 * (i >> 2) + 4 * n + (i & 3); }

struct Unit { int pm, pn; };
struct Gemm { const bf16_t* A; const bf16_t* Bt; int M, N, K; };

struct StaticOrder {
    int nM, nN, nwg, G, c;
    __host__ __device__ void init(int M, int N, int G_, int c_) { nM = M / BM; nN = N / BM; nwg = nM * nN; G = G_; c = c_; }
    __host__ __device__ bool next(int i, Unit& u) const {
        const long L = (long)i * G + c; if (L >= nwg) return false;
        int wgid = (int)L; { const int q = nwg / NXCD, r = nwg % NXCD, xcd = wgid % NXCD, off = wgid / NXCD; wgid = (xcd < r ? xcd * (q + 1) : r * (q + 1) + (xcd - r) * q) + off; }
        const int nig = WGM * nN, gid = wgid / nig, fm = gid * WGM, gsz = (nM - fm) < WGM ? (nM - fm) : WGM;
        u.pm = fm + ((wgid % nig) % gsz); u.pn = (wgid % nig) / gsz; return true;
    }
    __device__ __forceinline__ void a_ready(const Unit&) const {}
    __device__ __forceinline__ void done(const Unit&) const {}
};
__device__ __forceinline__ unsigned cvt_pk_bf16(float lo, float hi) { return cvt2bf(lo, hi); }
typedef float f32x2 __attribute__((ext_vector_type(2)));
__device__ __forceinline__ f32x2 gelu_pk(f32x2 v) {
    const f32x2 av = __builtin_elementwise_abs(v), d = av * 0.2316418882f + 1.0f;
    f32x2 t; t.x = __builtin_amdgcn_rcpf(d.x); t.y = __builtin_amdgcn_rcpf(d.y);
    f32x2 q = t * 0.5307027145f + (-0.7265760135f); q = q * t + 0.7107068705f; q = q * t + (-0.142248368f); q = q * t + 0.127414796f; q = q * t;
    const f32x2 s = (v * v) * (-0.72134752044f);
    f32x2 e; e.x = __builtin_amdgcn_exp2f(s.x); e.y = __builtin_amdgcn_exp2f(s.y);
    const f32x2 m = v * (q * e), r = v - m;
    f32x2 o; o.x = v.x < 0.f ? m.x : r.x; o.y = v.y < 0.f ? m.y : r.y; return o;
}

typedef unsigned u32x2 __attribute__((ext_vector_type(2)));
__device__ __forceinline__ u32x4 pack8(const f32x4 a, const f32x4 b) { u32x4 w; w.x = cvt_pk_bf16(a[0], a[1]); w.y = cvt_pk_bf16(a[2], a[3]); w.z = cvt_pk_bf16(b[0], b[1]); w.w = cvt_pk_bf16(b[2], b[3]); return w; }

struct EpiIn {
    static constexpr bool PERM = true, AFTER_DRAIN = false, RESCALE = false;
    bf16_t *UF, *ZG, *UP, *Q, *K, *V; unsigned char* G; const float* rope;
    __device__ __forceinline__ void operator()(const f32x4 (&acc)[2][2][4][2], const Unit& u, int wr, int wc, int fr, int fq) const {
        const int pm = u.pm, pn = u.pn; const bool lat = pm < 64; const int R0 = pm * 256;
        const int kv0 = lat ? ((pm >> 5) * 8448 + 256 + ((pm & 31) << 8)) : ((pm - 64) * 8448);
        const int rl = wr * 64 + fr, cl = wc * 32 + 8 * fq;
        if (pn == 0 || pn == 9) {
            bf16_t* dst = (pn == 0 ? UF : UP);
#pragma unroll
            for (int ai = 0; ai < 2; ++ai)
#pragma unroll
                for (int m = 0; m < 4; ++m) { const int rr = ai * 128 + m * 16 + rl;
#pragma unroll
                    for (int bj = 0; bj < 2; ++bj) *(u32x4*)(dst + (size_t)(R0 + rr) * 256 + bj * 128 + cl) = pack8(acc[ai][bj][m][0], acc[ai][bj][m][1]); }
        } else if (pn <= 4) {
            const bool isq = pn <= 2; bf16_t* dst = isq ? Q : K; const int rowbase = isq ? R0 : kv0, colbase = (isq ? pn - 1 : pn - 3) * 256; const float sc = isq ? (ATT_V == 2 ? 0.18033688011112042f : 0.125f) : 1.0f;
#pragma unroll
            for (int ai = 0; ai < 2; ++ai)
#pragma unroll
                for (int m = 0; m < 4; ++m) { const int rr = ai * 128 + m * 16 + rl;
                    f32x4 cs = {1.f, 1.f, 1.f, 1.f}, sn = {0.f, 0.f, 0.f, 0.f};
                    if (lat) { const int t = (R0 & 8191) + rr; const int pos = (wc & 1) ? 128 + (t & 63) : (t >> 6);
                        cs = *(const f32x4*)(rope + pos * 32 + 4 * fq); sn = *(const f32x4*)(rope + pos * 32 + 16 + 4 * fq); }
                    cs = cs * sc; sn = sn * sc;
#pragma unroll
                    for (int bj = 0; bj < 2; ++bj) { const f32x4 a = acc[ai][bj][m][0], b = acc[ai][bj][m][1]; f32x4 oa, ob;
                        oa[0] = a[0] * cs[0] - a[1] * sn[0]; oa[1] = a[1] * cs[0] + a[0] * sn[0]; oa[2] = a[2] * cs[1] - a[3] * sn[1]; oa[3] = a[3] * cs[1] + a[2] * sn[1];
                        ob[0] = b[0] * cs[2] - b[1] * sn[2]; ob[1] = b[1] * cs[2] + b[0] * sn[2]; ob[2] = b[2] * cs[3] - b[3] * sn[3]; ob[3] = b[3] * cs[3] + b[2] * sn[3];
                        *(u32x4*)(dst + (size_t)(rowbase + rr) * 512 + colbase + bj * 128 + cl) = pack8(oa, ob); } }
        } else if (pn <= 6) {
#pragma unroll
            for (int ai = 0; ai < 2; ++ai)
#pragma unroll
                for (int m = 0; m < 4; ++m) { const int rr = ai * 128 + m * 16 + rl;
#pragma unroll
                    for (int bj = 0; bj < 2; ++bj) *(u32x4*)(V + (size_t)(kv0 + rr) * 512 + (pn - 5) * 256 + bj * 128 + cl) = pack8(acc[ai][bj][m][0], acc[ai][bj][m][1]); }
        } else if (pn <= 8) {
#pragma unroll
            for (int ai = 0; ai < 2; ++ai)
#pragma unroll
                for (int m = 0; m < 4; ++m) { const int rr = ai * 128 + m * 16 + rl;
#pragma unroll
                    for (int bj = 0; bj < 2; ++bj) { const f32x4 a = acc[ai][bj][m][0], b = acc[ai][bj][m][1];
                        u32x2 w; w.x = cvt_pk_bf16(a[0] * sigm(a[1]), a[2] * sigm(a[3])); w.y = cvt_pk_bf16(b[0] * sigm(b[1]), b[2] * sigm(b[3]));
                        *(u32x2*)(ZG + (size_t)(R0 + rr) * 256 + (pn - 7) * 128 + bj * 64 + (cl >> 1)) = w; } }
        } else {
#pragma unroll
            for (int ai = 0; ai < 2; ++ai)
#pragma unroll
                for (int m = 0; m < 4; ++m) { const int rr = ai * 128 + m * 16 + rl;
#pragma unroll
                    for (int bj = 0; bj < 2; ++bj) { u32x2 w;
#pragma unroll
                        for (int n = 0; n < 2; ++n) { const f32x4 a = acc[ai][bj][m][n]; unsigned q = 0;
#pragma unroll
                            for (int j = 0; j < 4; ++j) { float s = sigm(a[j]) * 255.0f + 0.5f; s = s < 1.0f ? 1.0f : s; q |= ((unsigned)s) << (8 * j); }
                            if (n == 0) w.x = q; else w.y = q; }
                        *(u32x2*)(G + (size_t)(R0 + rr) * 4096 + (pn - 10) * 256 + bj * 128 + cl) = w; } }
        }
    }
};

struct EpiBf {
    static constexpr bool PERM = true, AFTER_DRAIN = false, RESCALE = false;
    bf16_t* O; int ldc;
    __device__ __forceinline__ void operator()(const f32x4 (&acc)[2][2][4][2], const Unit& u, int wr, int wc, int fr, int fq) const {
        const int row0 = u.pm * 256 + wr * 64 + fr, col0 = u.pn * 256 + wc * 32 + 8 * fq;
#pragma unroll
        for (int ai = 0; ai < 2; ++ai)
#pragma unroll
            for (int m = 0; m < 4; ++m)
#pragma unroll
                for (int bj = 0; bj < 2; ++bj) *(u32x4*)(O + (size_t)(row0 + ai * 128 + m * 16) * ldc + col0 + bj * 128) = pack8(acc[ai][bj][m][0], acc[ai][bj][m][1]);
    }
};

struct EpiRes {
    static constexpr bool PERM = false, AFTER_DRAIN = false, RESCALE = false;
    const float* base_lat; const float* base_ctx; float* out_lat; float* out_ctx; const float* mod; int goff;
    __device__ __forceinline__ void operator()(const f32x4 (&acc)[2][2][4][2], const Unit& u, int wr, int wc, int fr, int fq) const {
        const int pm = u.pm; const bool lat = pm < 64; const int mrow = lat ? (pm >> 5) : 2;
        const float* base = lat ? base_lat + (size_t)pm * 256 * 1024 : base_ctx + (size_t)(pm - 64) * 256 * 1024;
        float* out = lat ? out_lat + (size_t)pm * 256 * 1024 : out_ctx + (size_t)(pm - 64) * 256 * 1024;
        const int col0 = u.pn * 256 + wc * 32 + 4 * fq;
        f32x4 gv[2][2];
#pragma unroll
        for (int bj = 0; bj < 2; ++bj)
#pragma unroll
            for (int n = 0; n < 2; ++n) gv[bj][n] = *(const f32x4*)(mod + mrow * 6144 + goff + col0 + bj * 128 + n * 16);
#pragma unroll
        for (int ai = 0; ai < 2; ++ai)
#pragma unroll
            for (int m = 0; m < 4; ++m) { const size_t ro = (size_t)(ai * 128 + wr * 64 + m * 16 + fr) * 1024 + col0;
#pragma unroll
                for (int bj = 0; bj < 2; ++bj)
#pragma unroll
                    for (int n = 0; n < 2; ++n) { const size_t off = ro + bj * 128 + n * 16; const f32x4 b = *(const f32x4*)(base + off); *(f32x4*)(out + off) = b + gv[bj][n] * acc[ai][bj][m][n]; } }
    }
};

struct EpiVal {
    static constexpr bool PERM = true, AFTER_DRAIN = false, RESCALE = false;
    const bf16_t* GT; bf16_t* H; const float* dww; const float* dwb;
    __device__ __forceinline__ void operator()(const f32x4 (&acc)[2][2][4][2], const Unit& u, int wr, int wc, int fr, int fq) const {
        const int pm = u.pm; const bool lat = pm < 64; const int R0 = pm * 256, t0 = lat ? (R0 & 8191) : 0, L = lat ? 8192 : 256;
        const int rl = wr * 64 + fr;
#pragma unroll
        for (int bj = 0; bj < 2; ++bj) { const int col = u.pn * 256 + bj * 128 + wc * 32 + 8 * fq;
            f32x4 w0[2], w1[2], w2[2], bb[2];
#pragma unroll
            for (int n = 0; n < 2; ++n) { w0[n] = *(const f32x4*)(dww + col + 4 * n); w1[n] = *(const f32x4*)(dww + 2816 + col + 4 * n); w2[n] = *(const f32x4*)(dww + 5632 + col + 4 * n); bb[n] = *(const f32x4*)(dwb + col + 4 * n); }
#pragma unroll
            for (int ai = 0; ai < 2; ++ai) {
#pragma unroll
              for (int mh = 0; mh < 4; mh += 2) {
                u32x4 gm[4], g0[4], gq[4];
#pragma unroll
                for (int m = mh; m < mh + 2; ++m) { const int rr = ai * 128 + m * 16 + rl, t = t0 + rr; const bf16_t* gp = GT + (size_t)(R0 + rr) * 2816 + col;
                    gm[m] = (u32x4){0u, 0u, 0u, 0u}; gq[m] = (u32x4){0u, 0u, 0u, 0u}; g0[m] = *(const u32x4*)gp;
                    if (t > 0) gm[m] = *(const u32x4*)(gp - 2816);
                    if (t < L - 1) gq[m] = *(const u32x4*)(gp + 2816); }
                asm volatile("" ::: "memory");
#pragma unroll
                for (int m = mh; m < mh + 2; ++m) { const int rr = ai * 128 + m * 16 + rl;
                    f32x4 o[2];
#pragma unroll
                    for (int n = 0; n < 2; ++n) { f32x4 c;
#pragma unroll
                        for (int j = 0; j < 4; ++j) { const int e = 4 * n + j; const unsigned wm = gm[m][e >> 1], wz = g0[m][e >> 1], wp = gq[m][e >> 1];
                            const float xm = (e & 1) ? __uint_as_float(wm & 0xffff0000u) : __uint_as_float(wm << 16), xz = (e & 1) ? __uint_as_float(wz & 0xffff0000u) : __uint_as_float(wz << 16),
                                        xp = (e & 1) ? __uint_as_float(wp & 0xffff0000u) : __uint_as_float(wp << 16);
                            c[j] = w0[n][j] * xm + w1[n][j] * xz + w2[n][j] * xp + bb[n][j]; }
                        const f32x2 ga = gelu_pk((f32x2){c[0], c[1]}), gb = gelu_pk((f32x2){c[2], c[3]});
                        const f32x4 v = acc[ai][bj][m][n]; o[n] = (f32x4){v[0] * ga.x, v[1] * ga.y, v[2] * gb.x, v[3] * gb.y}; }
                    *(u32x4*)(H + (size_t)(R0 + rr) * 2816 + col) = pack8(o[0], o[1]); }
                asm volatile("" ::: "memory");
              }
            }
        }
    }
};

struct EpiBranch {
    static constexpr bool PERM = true, AFTER_DRAIN = false, RESCALE = true;
    const unsigned char* G; bf16_t* Y;
    __device__ __forceinline__ void rescale(f32x4 (&acc)[2][2][4][2], const Unit& u, int t, int wr, int wc, int fr, int fq) const {
        const int bp = (t == 4) ? 0 : (t == 12) ? 1 : 2;
        const __amdgpu_buffer_rsrc_t rs = __builtin_amdgcn_make_buffer_rsrc((void*)G, 0, MT * 4096, 0x00020000);
        const int voff = (u.pm * 256 + wr * 64 + fr) * 4096 + u.pn * 256 + wc * 32 + 8 * fq;
#pragma unroll
        for (int ai = 0; ai < 2; ++ai)
#pragma unroll
            for (int m = 0; m < 4; ++m) {
#pragma unroll
                for (int bj = 0; bj < 2; ++bj) { const int so = (ai * 128 + m * 16) * 4096 + bj * 128 + bp * 1024;
                    const u32x2 p = __builtin_bit_cast(u32x2, __builtin_amdgcn_raw_buffer_load_b64(rs, voff, so, 0)), q = __builtin_bit_cast(u32x2, __builtin_amdgcn_raw_buffer_load_b64(rs, voff, so + 1024, 0));
#pragma unroll
                    for (int n = 0; n < 2; ++n) { const unsigned pw = n ? p.y : p.x, qw = n ? q.y : q.x;
#pragma unroll
                        for (int j = 0; j < 4; ++j) acc[ai][bj][m][n][j] *= (float)((pw >> (8 * j)) & 255u) * __builtin_amdgcn_rcpf((float)((qw >> (8 * j)) & 255u)); } }
                asm volatile("" ::: "memory"); }
    }
    __device__ __forceinline__ void operator()(const f32x4 (&acc)[2][2][4][2], const Unit& u, int wr, int wc, int fr, int fq) const {
        const int row0 = u.pm * 256 + wr * 64 + fr, col0 = u.pn * 256 + wc * 32 + 8 * fq;
#pragma unroll
        for (int ai = 0; ai < 2; ++ai)
#pragma unroll
            for (int m = 0; m < 4; ++m)
#pragma unroll
                for (int bj = 0; bj < 2; ++bj) { const size_t r = (size_t)(row0 + ai * 128 + m * 16); const u32x2 p = *(const u32x2*)(G + r * 4096 + 3072 + col0 + bj * 128);
                    f32x4 o[2];
#pragma unroll
                    for (int n = 0; n < 2; ++n) { const unsigned pw = n ? p.y : p.x;
#pragma unroll
                        for (int j = 0; j < 4; ++j) o[n][j] = acc[ai][bj][m][n][j] * ((float)((pw >> (8 * j)) & 255u) * (1.0f / 255.0f)); }
                    *(u32x4*)(Y + r * 1024 + col0 + bj * 128) = pack8(o[0], o[1]); }
    }
};

template <class Epi, class Sched, bool ALIGN_EPI = false, bool SP2 = false>
__device__ __forceinline__ void gemm_phase(PG8_LAS unsigned char* lds, const Gemm g, const Sched& S, const Epi& E, const int tid) {
    const int wid = __builtin_amdgcn_readfirstlane(tid >> 6), lane = tid & 63, wr = wid >> 2, wc = wid & 3, fr = lane & 15, fq = lane >> 4;
    const int K = g.K, nt = K / BK;
    unsigned voffA[2], voffB[2];
#pragma unroll
    for (int i = 0; i < 2; ++i) { int R, C; stage_rc(tid * 16 + i * 8192, R, C); const int Rb = Epi::PERM ? ((R & ~31) + perm32(R & 31)) : R;
        voffA[i] = (unsigned)(R * K + C) * 2u; voffB[i] = (unsigned)(Rb * K + C) * 2u; }
    const size_t kstep = (size_t)(BK * 2);
    const size_t hstep = (size_t)HALF * K * 2;
    const size_t tstep = 2 * hstep;
    const unsigned ldsw = (unsigned)wid * 1024u;
    const int aoff = lds_byte(wr * 64 + fr, fq * 8), boff = lds_byte(wc * 32 + fr, fq * 8);
#define PG8_SA(b, h) (((b) * 2 + (h)) * HTB)
#define PG8_SB(b, h) ((4 + (b) * 2 + (h)) * HTB)
#define PG8_STAGE(bufoff, gbase, voff) do { _Pragma("unroll") for (int _i = 0; _i < 2; ++_i) \
        __builtin_amdgcn_global_load_lds((const unsigned*)((const char*)(gbase) + (voff)[_i]), (PG8_LAS unsigned*)(lds + (bufoff) + ldsw + _i * 8192), 16, 0, 0); } while (0)
#define PG8_LDA(dst, b, h) do { _Pragma("unroll") for (int m = 0; m < 4; ++m) _Pragma("unroll") for (int k = 0; k < 2; ++k) dst[m][k] = *(const PG8_LAS bf16x8*)(lds + PG8_SA(b, h) + aoff + m * 2048 + k * 1024); } while (0)
#define PG8_LDB(dst, b, h) do { _Pragma("unroll") for (int n = 0; n < 2; ++n) _Pragma("unroll") for (int k = 0; k < 2; ++k) dst[n][k] = *(const PG8_LAS bf16x8*)(lds + PG8_SB(b, h) + boff + n * 2048 + k * 1024); } while (0)
#define PG8_MMA(ai, bj, At, Bt) do { __builtin_amdgcn_s_setprio(1); _Pragma("unroll") for (int m = 0; m < 4; ++m) _Pragma("unroll") for (int n = 0; n < 2; ++n) _Pragma("unroll") for (int k = 0; k < 2; ++k) \
        acc[ai][bj][m][n] = __builtin_amdgcn_mfma_f32_16x16x32_bf16(Bt[n][k], At[m][k], acc[ai][bj][m][n], 0, 0, 0); __builtin_amdgcn_s_setprio(0); } while (0)
#define PG8_WAIT_V(n) asm volatile("s_waitcnt vmcnt(" #n ")" ::: "memory")
#define PG8_WAIT_L(n) asm volatile("s_waitcnt lgkmcnt(" #n ")" ::: "memory")
#define PG8_BAR __builtin_amdgcn_s_barrier()
#define PG8_SCHED __builtin_amdgcn_sched_barrier(0)
    Unit cur, nxt; int ui = 0;
    if (!S.next(0, cur)) return;
    f32x4 acc[2][2][4][2];
#pragma unroll
    for (int a = 0; a < 2; ++a)
#pragma unroll
        for (int b = 0; b < 2; ++b)
#pragma unroll
            for (int m = 0; m < 4; ++m)
#pragma unroll
                for (int n = 0; n < 2; ++n) acc[a][b][m][n] = (f32x4){0.f, 0.f, 0.f, 0.f};
    bf16x8 At[4][2], B0[2][2], B1[2][2];
    const char* cA = (const char*)g.A + (size_t)cur.pm * tstep; const char* cB = (const char*)g.Bt + (size_t)cur.pn * tstep;
    S.a_ready(cur);
    if constexpr (SP2) {
        PG8_STAGE(PG8_SB(0, 0), cB, voffB); PG8_STAGE(PG8_SB(0, 1), cB + hstep, voffB); PG8_STAGE(PG8_SA(0, 0), cA, voffA); PG8_STAGE(PG8_SA(0, 1), cA + hstep, voffA);
        if (wr == 1) PG8_BAR;
        PG8_WAIT_V(2); PG8_BAR;
        PG8_STAGE(PG8_SB(1, 0), cB + kstep, voffB); PG8_STAGE(PG8_SA(1, 0), cA + kstep, voffA); PG8_STAGE(PG8_SB(1, 1), cB + hstep + kstep, voffB);
        PG8_WAIT_V(6); PG8_BAR;
    } else {
        PG8_STAGE(PG8_SB(0, 0), cB, voffB); PG8_STAGE(PG8_SA(0, 0), cA, voffA); PG8_STAGE(PG8_SB(0, 1), cB + hstep, voffB); PG8_STAGE(PG8_SA(0, 1), cA + hstep, voffA);
        if (wr == 1) PG8_BAR;
        PG8_WAIT_V(4); PG8_BAR;
        PG8_STAGE(PG8_SB(1, 0), cB + kstep, voffB); PG8_STAGE(PG8_SA(1, 0), cA + kstep, voffA); PG8_STAGE(PG8_SB(1, 1), cB + hstep + kstep, voffB);
        PG8_WAIT_V(6); PG8_BAR;
    }
    for (;;) {
        const bool has_next = S.next(ui + 1, nxt);
        const char* nA = has_next ? (const char*)g.A + (size_t)nxt.pm * tstep : cA; const char* nB = has_next ? (const char*)g.Bt + (size_t)nxt.pn * tstep : cB;
        for (int t = 0; t < nt; t += 2) {
            if constexpr (Epi::RESCALE) { if (t == 4 || t == 12 || t == 16) E.rescale(acc, cur, t, wr, wc, fr, fq); }
            const bool last = (t == nt - 2);
            const char* a1 = cA + (size_t)(t + 1) * kstep;
            const char* a2 = last ? nA : cA + (size_t)(t + 2) * kstep; const char* b2 = last ? nB : cB + (size_t)(t + 2) * kstep;
            const char* a3 = a2 + kstep; const char* b3 = b2 + kstep;
            if (last && has_next) S.a_ready(nxt);
            if constexpr (SP2) {
            PG8_LDB(B0, 0, 0); PG8_LDB(B1, 0, 1); PG8_SCHED; PG8_LDA(At, 0, 0); PG8_STAGE(PG8_SA(1, 1), a1 + hstep, voffA);
            PG8_WAIT_V(8); PG8_WAIT_L(0); PG8_BAR; PG8_MMA(0, 0, At, B0); PG8_MMA(0, 1, At, B1); PG8_BAR; PG8_SCHED;
            PG8_LDA(At, 0, 1); PG8_STAGE(PG8_SB(0, 0), b2, voffB); PG8_STAGE(PG8_SB(0, 1), b2 + hstep, voffB); PG8_STAGE(PG8_SA(0, 0), a2, voffA);
            PG8_WAIT_V(8); PG8_WAIT_L(0); PG8_BAR; PG8_MMA(1, 0, At, B0); PG8_MMA(1, 1, At, B1); PG8_BAR; PG8_SCHED;
            PG8_LDB(B0, 1, 0); PG8_LDB(B1, 1, 1); PG8_SCHED; PG8_LDA(At, 1, 0); PG8_STAGE(PG8_SA(0, 1), a2 + hstep, voffA);
            PG8_WAIT_V(8); PG8_WAIT_L(0); PG8_BAR; PG8_MMA(0, 0, At, B0); PG8_MMA(0, 1, At, B1); PG8_BAR; PG8_SCHED;
            PG8_LDA(At, 1, 1); PG8_STAGE(PG8_SB(1, 0), b3, voffB); PG8_STAGE(PG8_SB(1, 1), b3 + hstep, voffB); PG8_STAGE(PG8_SA(1, 0), a3, voffA);
            PG8_WAIT_V(8); PG8_WAIT_L(0); PG8_BAR; PG8_MMA(1, 0, At, B0); PG8_MMA(1, 1, At, B1); PG8_BAR; PG8_SCHED;
            } else {
            PG8_LDB(B0, 0, 0); PG8_SCHED; PG8_LDA(At, 0, 0); PG8_STAGE(PG8_SA(1, 1), a1 + hstep, voffA);
            PG8_WAIT_L(8); PG8_BAR; PG8_WAIT_L(0); PG8_MMA(0, 0, At, B0); PG8_BAR; PG8_SCHED;
            PG8_LDB(B1, 0, 1); PG8_STAGE(PG8_SB(0, 0), b2, voffB);
            PG8_BAR; PG8_WAIT_L(0); PG8_MMA(0, 1, At, B1); PG8_BAR;
            PG8_LDA(At, 0, 1); PG8_STAGE(PG8_SA(0, 0), a2, voffA);
            PG8_BAR; PG8_WAIT_L(0); PG8_MMA(1, 0, At, B0); PG8_BAR; PG8_SCHED;
            PG8_STAGE(PG8_SB(0, 1), b2 + hstep, voffB);
            PG8_WAIT_V(6); PG8_BAR; PG8_MMA(1, 1, At, B1); PG8_BAR;
            PG8_LDB(B0, 1, 0); PG8_SCHED; PG8_LDA(At, 1, 0); PG8_STAGE(PG8_SA(0, 1), a2 + hstep, voffA);
            PG8_WAIT_L(8); PG8_BAR; PG8_WAIT_L(0); PG8_MMA(0, 0, At, B0); PG8_BAR; PG8_SCHED;
            PG8_LDB(B1, 1, 1); PG8_STAGE(PG8_SB(1, 0), b3, voffB);
            PG8_BAR; PG8_WAIT_L(0); PG8_MMA(0, 1, At, B1); PG8_BAR;
            PG8_LDA(At, 1, 1); PG8_STAGE(PG8_SA(1, 0), a3, voffA);
            PG8_BAR; PG8_WAIT_L(0); PG8_MMA(1, 0, At, B0); PG8_BAR; PG8_SCHED;
            PG8_STAGE(PG8_SB(1, 1), b3 + hstep, voffB);
            PG8_WAIT_V(6); PG8_BAR; PG8_MMA(1, 1, At, B1); PG8_BAR;
            }
        }
        if constexpr (ALIGN_EPI) { if (wr == 0) PG8_BAR; }
        if constexpr (!Epi::AFTER_DRAIN) { E(acc, cur, wr, wc, fr, fq); S.done(cur); }
        if (!has_next) break;
#pragma unroll
        for (int a = 0; a < 2; ++a)
#pragma unroll
            for (int b = 0; b < 2; ++b)
#pragma unroll
                for (int m = 0; m < 4; ++m)
#pragma unroll
                    for (int n = 0; n < 2; ++n) acc[a][b][m][n] = (f32x4){0.f, 0.f, 0.f, 0.f};
        cur = nxt; cA = nA; cB = nB; ++ui;
        if constexpr (ALIGN_EPI) { if (wr == 1) PG8_BAR; }
    }
    PG8_WAIT_V(0);
    if constexpr (!ALIGN_EPI) { if (wr == 0) PG8_BAR; }
    PG8_BAR;
    if constexpr (Epi::AFTER_DRAIN) { E.fused(acc, cur, wr, wc, fr, fq, lds, wid, lane); S.done(cur); }
#undef PG8_SA
#undef PG8_SB
#undef PG8_STAGE
#undef PG8_LDA
#undef PG8_LDB
#undef PG8_MMA
#undef PG8_WAIT_V
#undef PG8_WAIT_L
#undef PG8_BAR
#undef PG8_SCHED
}
}
namespace att {
constexpr int NW = 8, QBLK = 32, KVBLK = 64, LDQ = 512, LDO = KCAT;
constexpr int SHM_V = 16384, SHM_K = 16384, SHM_ATTN = 3 * SHM_V + 2 * SHM_K + NW * 64 * 4;
constexpr float THR = 8.f;
#ifndef ATT_SDEPTH
#define ATT_SDEPTH 1
#endif
constexpr int SDEPTH = ATT_SDEPTH;
#define KSWZ(row, colB) ((row) * 256 + ((colB) ^ (((row) & 7) << 4)))
#define SBAR() __builtin_amdgcn_sched_barrier(0)
__device__ __forceinline__ int crow(int r, int hi) { return (r & 3) + 8 * (r >> 2) + 4 * hi; }
__device__ __forceinline__ unsigned cvtpk(float lo, float hi) { return cvt2bf(lo, hi); }

__device__ __forceinline__ void partialSM(f32x16& p0, f32x16& p1, float& m_reg, float& mn, float& alpha) {
  constexpr float C = 1.4426950408889634f;
  float pmax = p0[0];
#pragma unroll
  for (int r = 1; r < 16; ++r) pmax = fmaxf(pmax, p0[r]);
#pragma unroll
  for (int r = 0; r < 16; ++r) pmax = fmaxf(pmax, p1[r]);
  { auto rr = __builtin_amdgcn_permlane32_swap(__float_as_uint(pmax), __float_as_uint(pmax), false, false);
    pmax = fmaxf(__uint_as_float(rr[0]), __uint_as_float(rr[1])); }
  if (__builtin_expect(__all(pmax - m_reg <= THR), 1)) { mn = m_reg; alpha = 1.f; }
  else { mn = fmaxf(m_reg, pmax); alpha = __builtin_amdgcn_exp2f((m_reg - mn) * C); m_reg = mn; }
  const float mnC = -mn * C;
#pragma unroll
  for (int r = 0; r < 16; ++r) p0[r] = fmaf(p0[r], C, mnC);
#pragma unroll
  for (int r = 0; r < 16; ++r) p1[r] = fmaf(p1[r], C, mnC);
#pragma unroll
  for (int r = 0; r < 16; ++r) p0[r] = __builtin_amdgcn_exp2f(p0[r]);
}
__device__ __forceinline__ void finishSM(f32x16& p0, f32x16& p1, float alpha, float& l_reg, bf16x8& pa0, bf16x8& pa1, bf16x8& pa2, bf16x8& pa3) {
#pragma unroll
  for (int r = 0; r < 16; ++r) p1[r] = __builtin_amdgcn_exp2f(p1[r]);
  float ps = 0;
#pragma unroll
  for (int r = 0; r < 16; ++r) ps += p0[r];
#pragma unroll
  for (int r = 0; r < 16; ++r) ps += p1[r];
  { auto rr = __builtin_amdgcn_permlane32_swap(__float_as_uint(ps), __float_as_uint(ps), false, false);
    ps = __uint_as_float(rr[0]) + __uint_as_float(rr[1]); }
  l_reg = l_reg * alpha + ps;
#define PK4(P, BASE, OUT) do { unsigned a0 = cvtpk(P[BASE + 0], P[BASE + 1]), a1 = cvtpk(P[BASE + 2], P[BASE + 3]);   \
    unsigned b0 = cvtpk(P[BASE + 4], P[BASE + 5]), b1 = cvtpk(P[BASE + 6], P[BASE + 7]);                              \
    auto r0 = __builtin_amdgcn_permlane32_swap(a0, b0, false, false); auto r1 = __builtin_amdgcn_permlane32_swap(a1, b1, false, false); \
    u32x4 w = {r0[0], r1[0], r0[1], r1[1]}; OUT = *reinterpret_cast<bf16x8*>(&w); } while (0)
  PK4(p0, 0, pa0); PK4(p0, 8, pa1); PK4(p1, 0, pa2); PK4(p1, 8, pa3);
#undef PK4
}
__device__ __forceinline__ void qkt(f32x16& p0, f32x16& p1, const char* Ks, const bf16x8* qr, int r32, int hi, int kcol) {
  p0 = f32x16{}; p1 = f32x16{};
#pragma unroll
  for (int d0 = 0; d0 < 4; ++d0) { const int cb = kcol + (d0 * 16 + hi * 8) * 2;
    const bf16x8 b0 = *reinterpret_cast<const bf16x8*>(Ks + KSWZ(r32, cb));
    const bf16x8 b1 = *reinterpret_cast<const bf16x8*>(Ks + KSWZ(32 + r32, cb));
    p0 = __builtin_amdgcn_mfma_f32_32x32x16_bf16(b0, qr[d0], p0, 0, 0, 0);
    p1 = __builtin_amdgcn_mfma_f32_32x32x16_bf16(b1, qr[d0], p1, 0, 0, 0); }
}
__device__ __forceinline__ int v_st(int k, int c) { const int kk = (k & ~0xC) | ((k & 4) << 1) | ((k & 8) >> 1); return ((kk >> 3) * 4 + (c >> 5)) * 512 + ((kk & 7) * 32 + (c & 31)) * 2; }
__device__ __forceinline__ int v_rd_base(int lane) { return ((lane & 3) << 3) | (((lane >> 2) & 3) << 6) | (((lane >> 4) & 1) << 5) | (((lane >> 5) & 1) << 8); }
constexpr int v_rd_off(int d0, int ks, int half) { return d0 * 512 + ks * 4096 + half * 2048; }
template <int OFF> __device__ __forceinline__ s16x4 tr_read(int vb) {
  s16x4 r; asm volatile("ds_read_b64_tr_b16 %0, %1 offset:%2" : "=&v"(r) : "v"(vb), "i"(OFF) : "memory"); return r;
}
template <int D0> __device__ __forceinline__ void pv_one(f32x16& od, int vb, bf16x8 pa0, bf16x8 pa1, bf16x8 pa2, bf16x8 pa3) {
  const s16x4 l0 = tr_read<v_rd_off(D0, 0, 0)>(vb), h0 = tr_read<v_rd_off(D0, 0, 1)>(vb), l1 = tr_read<v_rd_off(D0, 1, 0)>(vb), h1 = tr_read<v_rd_off(D0, 1, 1)>(vb);
  const s16x4 l2 = tr_read<v_rd_off(D0, 2, 0)>(vb), h2 = tr_read<v_rd_off(D0, 2, 1)>(vb), l3 = tr_read<v_rd_off(D0, 3, 0)>(vb), h3 = tr_read<v_rd_off(D0, 3, 1)>(vb);
  asm volatile("s_waitcnt lgkmcnt(0)" ::: "memory"); SBAR();
#define PK(L, H) (bf16x8){L[0], L[1], L[2], L[3], H[0], H[1], H[2], H[3]}
  od = __builtin_amdgcn_mfma_f32_32x32x16_bf16(pa0, PK(l0, h0), od, 0, 0, 0);
  od = __builtin_amdgcn_mfma_f32_32x32x16_bf16(pa1, PK(l1, h1), od, 0, 0, 0);
  od = __builtin_amdgcn_mfma_f32_32x32x16_bf16(pa2, PK(l2, h2), od, 0, 0, 0);
  od = __builtin_amdgcn_mfma_f32_32x32x16_bf16(pa3, PK(l3, h3), od, 0, 0, 0);
#undef PK
}
__device__ __forceinline__ void pv_d0(f32x16* o, int vb, bf16x8 pa0, bf16x8 pa1, bf16x8 pa2, bf16x8 pa3) {
  pv_one<0>(o[0], vb, pa0, pa1, pa2, pa3); pv_one<1>(o[1], vb, pa0, pa1, pa2, pa3); pv_one<2>(o[2], vb, pa0, pa1, pa2, pa3); pv_one<3>(o[3], vb, pa0, pa1, pa2, pa3);
}

template <int VAR>
__device__ __forceinline__ void attn_unit(const bf16_t* __restrict__ Qb, const bf16_t* __restrict__ Kh, const bf16_t* __restrict__ Vh, int nkeys,
                                          bf16_t* __restrict__ Ob, float lam, float osc, const float* __restrict__ sg, char* lds, const int tid) {
  const int wid = __builtin_amdgcn_readfirstlane(tid >> 6), lane = tid & 63, r32 = lane & 31, hi = lane >> 5;
  const int comp = wid >> 2, qw = wid & 3, kcol = comp * 128;
  char* K_lds = lds; char* V_lds = lds + 2 * SHM_K;
  float* ws = (float*)(lds + 2 * SHM_K + 3 * SHM_V) + wid * 64; float* li_l = ws; float* al_l = ws + 32;
  float m_reg = -1e30f, l_reg = 0; f32x16 o[4] = {}; bf16x8 qr[4];
  const bf16_t* Qw = Qb + (long)(qw * QBLK + r32) * LDQ + comp * 64 + hi * 8;
#pragma unroll
  for (int d0 = 0; d0 < 4; ++d0) qr[d0] = *reinterpret_cast<const bf16x8*>(Qw + d0 * 16);
  const int sr = tid >> 4, sc = (tid & 15) * 8, vst0 = v_st(sr, sc), vst1 = v_st(32 + sr, sc);
  const int vb0 = (int)(uintptr_t)V_lds + v_rd_base(lane);
  bf16x8 sk0 = {}, sk1 = {}, sv0 = {}, sv1 = {};
#define LOADK(t) do { if constexpr (!(VAR & 8)) { sk0 = *reinterpret_cast<const bf16x8*>(&Kh[(long)((t) * KVBLK + sr) * LDQ + sc]); sk1 = *reinterpret_cast<const bf16x8*>(&Kh[(long)((t) * KVBLK + 32 + sr) * LDQ + sc]); } } while (0)
#define LOADV(t) do { if constexpr (!(VAR & 8)) { sv0 = *reinterpret_cast<const bf16x8*>(&Vh[(long)((t) * KVBLK + sr) * LDQ + sc]); sv1 = *reinterpret_cast<const bf16x8*>(&Vh[(long)((t) * KVBLK + 32 + sr) * LDQ + sc]); } } while (0)
#define WRITEK(slot) do { if constexpr (!(VAR & 8)) { *(bf16x8*)(K_lds + (slot) * SHM_K + KSWZ(sr, sc * 2)) = sk0; *(bf16x8*)(K_lds + (slot) * SHM_K + KSWZ(32 + sr, sc * 2)) = sk1; } } while (0)
#define WRITEV(off) do { if constexpr (!(VAR & 8)) { *(bf16x8*)(V_lds + (off) + vst0) = sv0; *(bf16x8*)(V_lds + (off) + vst1) = sv1; } } while (0)
#define VMW() asm volatile("s_waitcnt vmcnt(0)" ::: "memory")
#define QKT(P0, P1, KS) do { if constexpr (VAR & 4) { P0 = f32x16{}; P1 = f32x16{}; asm volatile("" : "+v"(P0), "+v"(P1)); } else qkt(P0, P1, KS, qr, r32, hi, kcol); } while (0)
#define PSM(P0, P1, MN, AL) do { if constexpr (VAR & 1) { MN = m_reg; AL = 1.f; asm volatile("" : "+v"(P0), "+v"(P1)); } else partialSM(P0, P1, m_reg, MN, AL); } while (0)
#define FSM(P0, P1, AL) do { if constexpr (VAR & 1) { asm volatile("" : "+v"(P0), "+v"(P1)); pa0 = __builtin_bit_cast(bf16x8, (f32x4){P0[0], P0[1], P0[2], P0[3]}); pa1 = __builtin_bit_cast(bf16x8, (f32x4){P0[4], P0[5], P0[6], P0[7]}); pa2 = __builtin_bit_cast(bf16x8, (f32x4){P1[0], P1[1], P1[2], P1[3]}); pa3 = __builtin_bit_cast(bf16x8, (f32x4){P1[4], P1[5], P1[6], P1[7]}); } else finishSM(P0, P1, AL, l_reg, pa0, pa1, pa2, pa3); } while (0)
#define PV(OFF) do { if constexpr (VAR & 2) { asm volatile("" : "+v"(pa0), "+v"(pa1), "+v"(pa2), "+v"(pa3)); } else pv_d0(o, vb0 + (OFF), pa0, pa1, pa2, pa3); } while (0)
#define RESC(a) do { if (__any((a) < 1.f)) { if (hi == 0) al_l[r32] = (a); asm volatile("s_waitcnt lgkmcnt(0)" ::: "memory"); \
    _Pragma("unroll") for (int d = 0; d < 4; ++d) _Pragma("unroll") for (int r = 0; r < 16; ++r) o[d][r] *= al_l[crow(r, hi)]; } } while (0)
  f32x16 pA0, pA1, pB0, pB1; float mnA, mnB, alA, alB; bf16x8 pa0, pa1, pa2, pa3; const int NT = nkeys / KVBLK;
  LOADK(0); VMW(); WRITEK(0); LOADK(1); LOADV(0);
  __syncthreads();
  if (comp == 1) __syncthreads();
  VMW(); WRITEK(1); WRITEV(0);
  SBAR(); QKT(pA0, pA1, K_lds); SBAR();
  __syncthreads();
  LOADK(2); LOADV(1); SBAR();
  PSM(pA0, pA1, mnA, alA);
  __syncthreads();
  int va = 0, vb = SHM_V, vc = 2 * SHM_V;
  for (int j = 1; j + 1 < NT; j += 2) {
    VMW(); WRITEK(0); WRITEV(vb);
    SBAR(); QKT(pB0, pB1, K_lds + SHM_K);
    FSM(pA0, pA1, alA); SBAR();
    __syncthreads();
    LOADK(j + 2); LOADV(j + 1); SBAR();
    PV(va); PSM(pB0, pB1, mnB, alB);
    RESC(alB);
    __syncthreads();
    VMW(); WRITEK(1); WRITEV(vc);
    SBAR(); QKT(pA0, pA1, K_lds);
    FSM(pB0, pB1, alB); SBAR();
    __syncthreads();
    if (j + 3 < NT) LOADK(j + 3);
    LOADV(j + 2); SBAR();
    PV(vb); PSM(pA0, pA1, mnA, alA);
    RESC(alA);
    __syncthreads();
    { const int t = va; va = vc; vc = vb; vb = t; }
  }
  VMW(); WRITEV(vb);
  SBAR(); QKT(pB0, pB1, K_lds + SHM_K);
  FSM(pA0, pA1, alA); SBAR();
  __syncthreads();
  PV(va); PSM(pB0, pB1, mnB, alB);
  RESC(alB);
  __syncthreads();
  FSM(pB0, pB1, alB); SBAR();
  PV(vb);
  if (comp == 0) __syncthreads();
  if (hi == 0) li_l[r32] = l_reg; asm volatile("s_waitcnt lgkmcnt(0)" ::: "memory");
  float rli[16];
#pragma unroll
  for (int r = 0; r < 16; ++r) rli[r] = __builtin_amdgcn_rcpf(li_l[crow(r, hi)]);
  __syncthreads();
  float* XO = (float*)lds + qw * (32 * 128);
  if (comp == 1) {
#pragma unroll
    for (int r = 0; r < 16; ++r)
#pragma unroll
      for (int d0 = 0; d0 < 4; ++d0) XO[crow(r, hi) * 128 + d0 * 32 + r32] = o[d0][r] * rli[r];
  }
  __syncthreads();
  if (comp == 0) {
    float ss[16];
#pragma unroll
    for (int r = 0; r < 16; ++r) { float s = 0.f;
#pragma unroll
      for (int d0 = 0; d0 < 4; ++d0) { const float v = o[d0][r] * rli[r] - lam * XO[crow(r, hi) * 128 + d0 * 32 + r32]; o[d0][r] = v; s += v * v; }
      ss[r] = s; }
#pragma unroll
    for (int r = 0; r < 16; ++r) { float s = ss[r]; s += swz_xor<1>(s); s += swz_xor<2>(s); s += swz_xor<4>(s); s += swz_xor<8>(s); s += swz_xor<16>(s);
      ss[r] = osc / sqrtf(s * (1.0f / 128.0f) + EPS); }
    float gam[4];
#pragma unroll
    for (int d0 = 0; d0 < 4; ++d0) gam[d0] = sg[d0 * 32 + r32];
    asm volatile("s_waitcnt lgkmcnt(0)" ::: "memory");
    bf16_t* stg = (bf16_t*)XO;
#pragma unroll
    for (int r = 0; r < 16; ++r)
#pragma unroll
      for (int d0 = 0; d0 < 4; ++d0) stg[crow(r, hi) * 128 + d0 * 32 + r32] = (bf16_t)(cvtpk(o[d0][r] * ss[r] * gam[d0], 0.f) & 0xffffu);
    asm volatile("s_waitcnt lgkmcnt(0)" ::: "memory");
#pragma unroll
    for (int i = 0; i < 8; ++i) { const int row = i * 4 + (lane >> 4), ch = lane & 15; const u32x4 v = *(const u32x4*)(stg + row * 128 + ch * 8);
      if constexpr (VAR & 16) { asm volatile("" :: "v"(v.x), "v"(v.y), "v"(v.z), "v"(v.w)); } else *(u32x4*)(Ob + (long)(qw * QBLK + row) * LDO + ch * 8) = v; }
  }
  __syncthreads();
#undef LOADK
#undef LOADV
#undef WRITEK
#undef WRITEV
#undef VMW
#undef QKT
#undef PSM
#undef FSM
#undef PV
#undef RESC
}
#undef KSWZ
#undef SBAR
}
namespace att2 {
using att::crow; using att::v_st; using att::v_rd_base; using att::v_rd_off;
constexpr int NW = 8, QBLK = 32, KVBLK = 64, LDQ = 512, LDO = KCAT, SHM_K = 16384, SHM_V = 16384;
constexpr float THRL = 8.0f;
#ifndef ATT_STAGGER
#define ATT_STAGGER 1
#endif
typedef short v4i16_t __attribute__((ext_vector_type(4)));
typedef __attribute__((address_space(3))) const char* lds_cptr;
typedef __attribute__((address_space(3))) char* lds_ptr;
#define SBAR() __builtin_amdgcn_sched_barrier(0)
#define KSWZ(row, colB) ((row) * 256 + ((colB) ^ (((row) & 7) << 4)))
__device__ __forceinline__ s16x4 vtr(lds_cptr p) { return __builtin_bit_cast(s16x4, __builtin_amdgcn_ds_read_tr16_b64_v4i16((__attribute__((address_space(3))) v4i16_t*)p)); }
__device__ __forceinline__ bf16x8 ldk(lds_cptr p) { return *(const __attribute__((address_space(3))) bf16x8*)p; }
#define MF(D, A, B, C) do { if constexpr (VAR & 4) { asm volatile("" : "+v"(D)); } else D = __builtin_amdgcn_mfma_f32_32x32x16_bf16(A, B, C, 0, 0, 0); } while (0)
#define VF(L, H) (bf16x8){L[0], L[1], L[2], L[3], H[0], H[1], H[2], H[3]}

__device__ __forceinline__ int vkey(int g) { const int s_ = g >> 5, kk = ((s_ >> 2) << 3) | ((g >> 2) & 7); return (kk & ~0xC) | ((kk & 4) << 1) | ((kk & 8) >> 1); }
template <int VAR>
__device__ __forceinline__ void attn_unit(const bf16_t* __restrict__ Qb, const bf16_t* __restrict__ Kh, const bf16_t* __restrict__ Vh, int nkeys,
                                          bf16_t* __restrict__ Ob, float lam, float osc, const float* __restrict__ sg, char* lds, const int tid) {
  const int wid = __builtin_amdgcn_readfirstlane(tid >> 6), lane = tid & 63, r32 = lane & 31, hi = lane >> 5;
  const int comp = wid >> 2, qw = wid & 3, kcol = comp * 128;
  const lds_ptr L3 = (lds_ptr)(unsigned)(uintptr_t)lds;
  float* ws = (float*)(lds + 3 * SHM_K + 3 * SHM_V) + wid * 64; float* li_l = ws; float* al_l = ws + 32;
  float mhat = 0.f, l_reg = 0.f; f32x16 o[4] = {}; bf16x8 qr[4]; f32x16 negm = {};
  const bf16_t* Qw = Qb + (long)(qw * QBLK + r32) * LDQ + comp * 64 + hi * 8;
#pragma unroll
  for (int d0 = 0; d0 < 4; ++d0) qr[d0] = *reinterpret_cast<const bf16x8*>(Qw + d0 * 16);
  const int sr = tid >> 4, sc = (tid & 15) * 8;
  const int kr0 = 4 * wid + (lane >> 4), kr1 = kr0 + 32;
  const bf16_t* ksrc0 = Kh + (long)kr0 * LDQ + (((lane & 15) ^ (kr0 & 7)) << 3); const bf16_t* ksrc1 = Kh + (long)kr1 * LDQ + (((lane & 15) ^ (kr1 & 7)) << 3);
  const int g0_ = 64 * wid + lane, g1_ = g0_ + 512;
  const int vk0 = vkey(g0_), vk1 = vkey(g1_);
  const bf16_t* vsrc0 = Vh + (long)vk0 * LDQ + ((g0_ >> 5) & 3) * 32 + (g0_ & 3) * 8; const bf16_t* vsrc1 = Vh + (long)vk1 * LDQ + ((g1_ >> 5) & 3) * 32 + (g1_ & 3) * 8;
  const unsigned kd0 = (unsigned)(uintptr_t)lds + wid * 1024, kd1 = kd0 + 8192, vd0 = (unsigned)(uintptr_t)lds + 3 * SHM_K + wid * 1024, vd1 = vd0 + 8192;
  lds_cptr kq[4];
#pragma unroll
  for (int d0 = 0; d0 < 4; ++d0) kq[d0] = L3 + r32 * 256 + ((kcol + d0 * 32 + hi * 16) ^ ((r32 & 7) << 4));
  const lds_cptr vp0 = L3 + 3 * SHM_K + v_rd_base(lane);
#define GLDS(src, dst) __builtin_amdgcn_global_load_lds((const unsigned*)(src), (__attribute__((address_space(3))) unsigned*)(dst), 16, 0, 0)
#define DMAK(t, slot) do { if constexpr (!(VAR & 8)) { GLDS(ksrc0 + (long)(t) * KVBLK * LDQ, (unsigned)__builtin_amdgcn_readfirstlane(kd0 + (slot) * SHM_K)); GLDS(ksrc1 + (long)(t) * KVBLK * LDQ, (unsigned)__builtin_amdgcn_readfirstlane(kd1 + (slot) * SHM_K)); } } while (0)
#define DMAV(t, off) do { if constexpr (!(VAR & 8)) { GLDS(vsrc0 + (long)(t) * KVBLK * LDQ, (unsigned)__builtin_amdgcn_readfirstlane(vd0 + (off))); GLDS(vsrc1 + (long)(t) * KVBLK * LDQ, (unsigned)__builtin_amdgcn_readfirstlane(vd1 + (off))); } } while (0)
#ifndef ATT_PRIO
#define ATT_PRIO 1
#endif
#define PRIO(x) do { if (ATT_PRIO == 1) __builtin_amdgcn_s_setprio(x); } while (0)
#define PRIO1(x) do { if (ATT_PRIO == 2) __builtin_amdgcn_s_setprio(x); } while (0)
#define VMW() asm volatile("s_waitcnt vmcnt(0)" ::: "memory")
#define BARW(n) do { asm volatile("s_waitcnt vmcnt(" #n ") lgkmcnt(0)" ::: "memory"); __builtin_amdgcn_s_barrier(); asm volatile("" ::: "memory"); } while (0)
  f32x16 pA0, pA1, pB0, pB1; u32x4 pw0 = {}, pw1 = {}, pw2 = {}, pw3 = {}; const int NT = nkeys / KVBLK; bool resc = false;
#define KF(KOFF, d0, half) ldk(kq[d0] + (KOFF) + 8192 * (half))
#define PKA(P, B, A0, A1) do { if constexpr (!(VAR & 1)) { A0 = cvt2bf(P[B + 0], P[B + 1]); A1 = cvt2bf(P[B + 2], P[B + 3]); sacc += P[B + 0]; sacc += P[B + 1]; sacc += P[B + 2]; sacc += P[B + 3]; } } while (0)
#define PKB(P, B, A0, A1, PW) do { if constexpr (!(VAR & 1)) { const unsigned b0_ = cvt2bf(P[B + 4], P[B + 5]), b1_ = cvt2bf(P[B + 6], P[B + 7]); \
    auto r0_ = __builtin_amdgcn_permlane32_swap(A0, b0_, false, false); auto r1_ = __builtin_amdgcn_permlane32_swap(A1, b1_, false, false); \
    PW = (u32x4){r0_[0], r1_[0], r0_[1], r1_[1]}; sacc += P[B + 4]; sacc += P[B + 5]; sacc += P[B + 6]; sacc += P[B + 7]; } } while (0)
#define H1(C0, C1, P0, P1, KOFF, FIN) do { \
    float sacc = 0.f; unsigned a0_ = 0, a1_ = 0; \
    bf16x8 f0 = KF(KOFF, 0, 0), f1 = KF(KOFF, 0, 1), f2 = KF(KOFF, 1, 0); SBAR(); \
    MF(C0, f0, qr[0], negm); { f0 = KF(KOFF, 1, 1); if (FIN) PKA(P0, 0, a0_, a1_); } SBAR(); \
    MF(C1, f1, qr[0], negm); { f1 = KF(KOFF, 2, 0); if (FIN) PKB(P0, 0, a0_, a1_, pw0); } SBAR(); \
    MF(C0, f2, qr[1], C0);   { f2 = KF(KOFF, 2, 1); if (FIN) PKA(P0, 8, a0_, a1_); } SBAR(); \
    MF(C1, f0, qr[1], C1);   { f0 = KF(KOFF, 3, 0); if (FIN) PKB(P0, 8, a0_, a1_, pw1); } SBAR(); \
    MF(C0, f1, qr[2], C0);   { f1 = KF(KOFF, 3, 1); if (FIN) PKA(P1, 0, a0_, a1_); } SBAR(); \
    MF(C1, f2, qr[2], C1);   { if (FIN) PKB(P1, 0, a0_, a1_, pw2); } SBAR(); \
    MF(C0, f0, qr[3], C0);   { if (FIN) PKA(P1, 8, a0_, a1_); } SBAR(); \
    MF(C1, f1, qr[3], C1);   { if (FIN) PKB(P1, 8, a0_, a1_, pw3); } SBAR(); \
    if (FIN) { auto rr_ = __builtin_amdgcn_permlane32_swap(__float_as_uint(sacc), __float_as_uint(sacc), false, false); l_reg += __uint_as_float(rr_[0]) + __uint_as_float(rr_[1]); } \
  } while (0)
#define VRD(VOFF, ks, d0, LO, HI) do { LO = vtr(vp0 + (VOFF) + v_rd_off(d0, ks, 0)); HI = vtr(vp0 + (VOFF) + v_rd_off(d0, ks, 1)); } while (0)
#define PAF(k) __builtin_bit_cast(bf16x8, pw##k)
#define MX3(a, b, c) ((VAR & 2) ? (a) : fmaxf(fmaxf((a), (b)), (c)))
#define EX(X, i) do { if constexpr (!(VAR & 2)) X[i] = __builtin_amdgcn_exp2f(X[i]); } while (0)
#define PIN2(X, Y) asm volatile("" : "+v"(X), "+v"(Y))
#define H2(C0, C1, VOFF, DOPV, FIRST) do { \
    s16x4 l0, h0, l1, h1, l2, h2; float ma, mb, rm; \
    if (DOPV) { VRD(VOFF, 0, 0, l0, h0); VRD(VOFF, 0, 1, l1, h1); VRD(VOFF, 0, 2, l2, h2); } SBAR(); \
    if (DOPV) { MF(o[0], PAF(0), VF(l0, h0), o[0]); VRD(VOFF, 0, 3, l0, h0); } ma = MX3(C0[0], C0[1], C1[0]); mb = MX3(C0[2], C0[3], C1[1]); ma = MX3(ma, C1[2], C1[3]); mb = MX3(mb, C0[4], C0[5]); SBAR(); \
    if (DOPV) { MF(o[1], PAF(0), VF(l1, h1), o[1]); VRD(VOFF, 1, 0, l1, h1); } ma = MX3(ma, C0[6], C0[7]); mb = MX3(mb, C1[4], C1[5]); ma = MX3(ma, C1[6], C1[7]); mb = MX3(mb, C0[8], C0[9]); SBAR(); \
    if (DOPV) { MF(o[2], PAF(0), VF(l2, h2), o[2]); VRD(VOFF, 1, 1, l2, h2); } ma = MX3(ma, C0[10], C0[11]); mb = MX3(mb, C1[8], C1[9]); ma = MX3(ma, C1[10], C1[11]); mb = MX3(mb, C0[12], C0[13]); SBAR(); \
    if (DOPV) { MF(o[3], PAF(0), VF(l0, h0), o[3]); VRD(VOFF, 1, 2, l0, h0); } ma = MX3(ma, C0[14], C0[15]); mb = MX3(mb, C1[12], C1[13]); ma = MX3(ma, C1[14], C1[15]); rm = fmaxf(ma, mb); SBAR(); \
    if (DOPV) { MF(o[0], PAF(1), VF(l1, h1), o[0]); VRD(VOFF, 1, 3, l1, h1); } \
    { auto rr_ = __builtin_amdgcn_permlane32_swap(__float_as_uint(rm), __float_as_uint(rm), false, false); rm = fmaxf(__uint_as_float(rr_[0]), __uint_as_float(rr_[1])); } SBAR(); \
    resc = false; \
    if (FIRST || __builtin_expect(__any(rm > THRL), 0)) { const float dl = FIRST ? rm : fmaxf(rm, 0.f); mhat += dl; \
      _Pragma("unroll") for (int r = 0; r < 16; ++r) { C0[r] -= dl; C1[r] -= dl; } \
      _Pragma("unroll") for (int r = 0; r < 16; ++r) negm[r] = -mhat; \
      if (!(FIRST)) { const float f = __builtin_amdgcn_exp2f(-dl); l_reg *= f; if (hi == 0) al_l[r32] = f; resc = true; } } \
    SBAR(); \
    if (DOPV) { MF(o[1], PAF(1), VF(l2, h2), o[1]); VRD(VOFF, 2, 0, l2, h2); } EX(C0, 0); EX(C0, 1); EX(C0, 2); PIN2(C0, C1); SBAR(); \
    if (DOPV) { MF(o[2], PAF(1), VF(l0, h0), o[2]); VRD(VOFF, 2, 1, l0, h0); } EX(C0, 3); EX(C0, 4); EX(C0, 5); PIN2(C0, C1); SBAR(); \
    if (DOPV) { MF(o[3], PAF(1), VF(l1, h1), o[3]); VRD(VOFF, 2, 2, l1, h1); } EX(C0, 6); EX(C0, 7); EX(C0, 8); PIN2(C0, C1); SBAR(); \
    if (DOPV) { MF(o[0], PAF(2), VF(l2, h2), o[0]); VRD(VOFF, 2, 3, l2, h2); } EX(C0, 9); EX(C0, 10); EX(C0, 11); PIN2(C0, C1); SBAR(); \
    if (DOPV) { MF(o[1], PAF(2), VF(l0, h0), o[1]); VRD(VOFF, 3, 0, l0, h0); } EX(C0, 12); EX(C0, 13); EX(C0, 14); PIN2(C0, C1); SBAR(); \
    if (DOPV) { MF(o[2], PAF(2), VF(l1, h1), o[2]); VRD(VOFF, 3, 1, l1, h1); } EX(C0, 15); EX(C1, 0); EX(C1, 1); PIN2(C0, C1); SBAR(); \
    if (DOPV) { MF(o[3], PAF(2), VF(l2, h2), o[3]); VRD(VOFF, 3, 2, l2, h2); } EX(C1, 2); EX(C1, 3); EX(C1, 4); PIN2(C0, C1); SBAR(); \
    if (DOPV) { MF(o[0], PAF(3), VF(l0, h0), o[0]); VRD(VOFF, 3, 3, l0, h0); } EX(C1, 5); EX(C1, 6); EX(C1, 7); PIN2(C0, C1); SBAR(); \
    if (DOPV) { MF(o[1], PAF(3), VF(l1, h1), o[1]); } EX(C1, 8); EX(C1, 9); EX(C1, 10); PIN2(C0, C1); SBAR(); \
    if (DOPV) { MF(o[2], PAF(3), VF(l2, h2), o[2]); } EX(C1, 11); EX(C1, 12); EX(C1, 13); PIN2(C0, C1); SBAR(); \
    if (DOPV) { MF(o[3], PAF(3), VF(l0, h0), o[3]); } EX(C1, 14); EX(C1, 15); PIN2(C0, C1); SBAR(); \
    if (resc) { asm volatile("s_waitcnt lgkmcnt(0)" ::: "memory"); \
      _Pragma("unroll") for (int d = 0; d < 4; ++d) _Pragma("unroll") for (int r = 0; r < 16; ++r) o[d][r] *= al_l[crow(r, hi)]; } \
  } while (0)
#define PVONLY(VOFF) do { _Pragma("unroll") for (int ks = 0; ks < 4; ++ks) _Pragma("unroll") for (int d0 = 0; d0 < 4; ++d0) { s16x4 l_, h_; VRD(VOFF, ks, d0, l_, h_); \
      const bf16x8 pa_ = ks == 0 ? PAF(0) : ks == 1 ? PAF(1) : ks == 2 ? PAF(2) : PAF(3); MF(o[d0], pa_, VF(l_, h_), o[d0]); } } while (0)

  DMAK(0, 0); DMAK(1, 1); DMAV(0, 0);
  BARW(0);
  if (ATT_STAGGER && comp == 1) __builtin_amdgcn_s_barrier();
  H1(pA0, pA1, pB0, pB1, 0, false);
  BARW(0);
  DMAK(2, 2); DMAV(1, SHM_V); SBAR();
  H2(pA0, pA1, 0, false, true);
  BARW(4);
  int va = 0, vb = SHM_V, vc = 2 * SHM_V;
  for (int j = 1; j + 1 < NT; j += 2) {
    PRIO1(1); H1(pB0, pB1, pA0, pA1, vb, true); PRIO1(0);
    BARW(0);
    DMAK(j + 2, va >> 14); DMAV(j + 1, vc); SBAR();
    PRIO(1); H2(pB0, pB1, va, true, false); PRIO(0);
    BARW(4);
    PRIO1(1); H1(pA0, pA1, pB0, pB1, vc, true); PRIO1(0);
    BARW(0);
    if (j + 3 < NT) DMAK(j + 3, vb >> 14);
    DMAV(j + 2, va); SBAR();
    PRIO(1); H2(pA0, pA1, vb, true, false); PRIO(0);
    BARW(4);
    { const int t = va; va = vc; vc = vb; vb = t; }
  }
  H1(pB0, pB1, pA0, pA1, vb, true);
  BARW(0);
  H2(pB0, pB1, va, true, false);
  BARW(0);
  { float sacc = 0.f; unsigned a0_ = 0, a1_ = 0;
    PKA(pB0, 0, a0_, a1_); PKB(pB0, 0, a0_, a1_, pw0); PKA(pB0, 8, a0_, a1_); PKB(pB0, 8, a0_, a1_, pw1); PKA(pB1, 0, a0_, a1_); PKB(pB1, 0, a0_, a1_, pw2); PKA(pB1, 8, a0_, a1_); PKB(pB1, 8, a0_, a1_, pw3);
    auto rr_ = __builtin_amdgcn_permlane32_swap(__float_as_uint(sacc), __float_as_uint(sacc), false, false); l_reg += __uint_as_float(rr_[0]) + __uint_as_float(rr_[1]); }
  SBAR(); PVONLY(vb);
  if (ATT_STAGGER && comp == 0) { asm volatile("s_waitcnt lgkmcnt(0)" ::: "memory"); __builtin_amdgcn_s_barrier(); }
  if (hi == 0) li_l[r32] = l_reg; asm volatile("s_waitcnt lgkmcnt(0)" ::: "memory");
  float rli[16];
#pragma unroll
  for (int r = 0; r < 16; ++r) rli[r] = __builtin_amdgcn_rcpf(li_l[crow(r, hi)]);
  __syncthreads();
  float* XO = (float*)lds + qw * (32 * 128);
  if (comp == 1) {
#pragma unroll
    for (int r = 0; r < 16; ++r)
#pragma unroll
      for (int d0 = 0; d0 < 4; ++d0) XO[crow(r, hi) * 128 + d0 * 32 + r32] = o[d0][r] * rli[r];
  }
  __syncthreads();
  if (comp == 0) {
    float ss[16];
#pragma unroll
    for (int r = 0; r < 16; ++r) { float s = 0.f;
#pragma unroll
      for (int d0 = 0; d0 < 4; ++d0) { const float v = o[d0][r] * rli[r] - lam * XO[crow(r, hi) * 128 + d0 * 32 + r32]; o[d0][r] = v; s += v * v; }
      ss[r] = s; }
#pragma unroll
    for (int r = 0; r < 16; ++r) { float s = ss[r]; s += swz_xor<1>(s); s += swz_xor<2>(s); s += swz_xor<4>(s); s += swz_xor<8>(s); s += swz_xor<16>(s);
      ss[r] = osc / sqrtf(s * (1.0f / 128.0f) + EPS); }
    float gam[4];
#pragma unroll
    for (int d0 = 0; d0 < 4; ++d0) gam[d0] = sg[d0 * 32 + r32];
    asm volatile("s_waitcnt lgkmcnt(0)" ::: "memory");
    bf16_t* stg = (bf16_t*)XO;
#pragma unroll
    for (int r = 0; r < 16; ++r)
#pragma unroll
      for (int d0 = 0; d0 < 4; ++d0) stg[crow(r, hi) * 128 + d0 * 32 + r32] = (bf16_t)(cvt2bf(o[d0][r] * ss[r] * gam[d0], 0.f) & 0xffffu);
    asm volatile("s_waitcnt lgkmcnt(0)" ::: "memory");
#pragma unroll
    for (int i = 0; i < 8; ++i) { const int row = i * 4 + (lane >> 4), ch = lane & 15; const u32x4 v = *(const u32x4*)(stg + row * 128 + ch * 8);
      if constexpr (VAR & 16) { asm volatile("" :: "v"(v.x), "v"(v.y), "v"(v.z), "v"(v.w)); } else *(u32x4*)(Ob + (long)(qw * QBLK + row) * LDO + ch * 8) = v; }
  }
  __syncthreads();
#undef GLDS
#undef DMAK
#undef DMAV
#undef VMW
#undef PRIO
#undef PRIO1
#undef BARW
#undef KF
#undef PKA
#undef PKB
#undef H1
#undef VRD
#undef PAF
#undef MX3
#undef EX
#undef PIN2
#undef H2
#undef PVONLY
}
#undef SBAR
#undef KSWZ
#undef MF
#undef VF
}
typedef GAS unsigned gu32;
#define RLX_AGENT __ATOMIC_RELAXED, __HIP_MEMORY_SCOPE_AGENT
constexpr int PT_OFF = LDSCTL_OFF + 1024;
__device__ __forceinline__ unsigned long long ldptr(volatile LAS unsigned long long* PT, int i) {
    const unsigned long long v = PT[i];
    const unsigned lo = __builtin_amdgcn_readfirstlane((unsigned)v), hi = __builtin_amdgcn_readfirstlane((unsigned)(v >> 32));
    return ((unsigned long long)hi << 32) | lo;
}
#define XB_TMO      128
#define XB_XCNT(j)  (256  + 64 * (j))
#define XB_XSUB(j)  (1280 + 64 * (j))
#define XB_XGEN(j)  (2304 + 64 * (j))
#define XB_TOP      3328
#define XB_TOPGEN   3392
#define XCD_BAR_WORDS 3456
#define XB_SPIN_CAP (1u << 18)

__device__ __forceinline__ unsigned xb_ld(unsigned* p)              { return __hip_atomic_load(p, __ATOMIC_RELAXED, __HIP_MEMORY_SCOPE_AGENT); }
__device__ __forceinline__ unsigned xb_add(unsigned* p, unsigned v) { return __hip_atomic_fetch_add(p, v, __ATOMIC_RELAXED, __HIP_MEMORY_SCOPE_AGENT); }
__device__ __forceinline__ unsigned xb_xcc_id() { return (unsigned)__builtin_amdgcn_s_getreg((3 << 11) | 20) & 0xFu; }
#define XB_SPIN(cond, bar) do { unsigned _sp = 0; while (cond) { __builtin_amdgcn_s_sleep(1); \
    if ((++_sp & 255u) == 0u) { if (xb_ld(&(bar)[XB_TMO])) break; if (_sp > XB_SPIN_CAP) { atomicAdd(&(bar)[XB_TMO], 1u); break; } } } } while (0)

struct XcdBarrier {
    unsigned* bar; unsigned x;
    volatile LAS unsigned* st;
};

__device__ __forceinline__ XcdBarrier xcd_barrier_post(unsigned* bar, volatile LAS unsigned* st) {
    XcdBarrier b; b.bar = bar; b.x = xb_xcc_id(); b.st = st;
    if (threadIdx.x == 0) (void)xb_add(&bar[XB_XCNT(b.x)], 1u);
    return b;
}
__device__ __forceinline__ void xcd_barrier_complete(unsigned* bar, unsigned x, unsigned& nloc, unsigned& nx) {
    const unsigned G = gridDim.x * gridDim.y * gridDim.z;
    unsigned sum, cnt, mine, sp = 0u;
    for (;;) {
        sum = 0u; cnt = 0u; mine = 0u;
#pragma unroll
        for (unsigned j = 0; j < 16; ++j) { const unsigned c = xb_ld(&bar[XB_XCNT(j)]); sum += c; cnt += (c > 0u) ? 1u : 0u; mine = (j == x) ? c : mine; }
        if (sum == G) break;
        __builtin_amdgcn_s_sleep(1);
        if ((++sp & 255u) == 0u) { if (xb_ld(&bar[XB_TMO])) break; if (sp > XB_SPIN_CAP) { atomicAdd(&bar[XB_TMO], 1u); break; } }
    }
    nloc = mine > 0u ? mine : 1u; nx = cnt > 0u ? cnt : 1u;
}

__device__ __forceinline__ void xcd_barrier(const XcdBarrier& b) {
    asm volatile("s_waitcnt vmcnt(0)" ::: "memory");
    __syncthreads();
    if (threadIdx.x == 0) {
        unsigned* bar = b.bar;
        __builtin_amdgcn_s_waitcnt(0);
        unsigned nloc = b.st[0], nx = b.st[1];
        if (nloc == 0u) { xcd_barrier_complete(bar, b.x, nloc, nx); b.st[0] = nloc; b.st[1] = nx; }
        const unsigned old = xb_add(&bar[XB_XSUB(b.x)], 1u);
        const unsigned gen = old / nloc;
        if (old + 1u == (gen + 1u) * nloc) {
            __builtin_amdgcn_fence(__ATOMIC_RELEASE, "agent");
            asm volatile("s_waitcnt vmcnt(0)" ::: "memory");
            const unsigned og = xb_add(&bar[XB_TOP], 1u);
            const unsigned tg = og / nx;
            if (og + 1u == (tg + 1u) * nx) xb_add(&bar[XB_TOPGEN], 1u);
            else XB_SPIN(xb_ld(&bar[XB_TOPGEN]) == tg, bar);
            __builtin_amdgcn_fence(__ATOMIC_ACQUIRE, "agent");
            xb_add(&bar[XB_XGEN(b.x)], 1u);
            asm volatile("s_waitcnt vmcnt(0)" ::: "memory");
        } else {
            XB_SPIN(xb_ld(&bar[XB_XGEN(b.x)]) == gen, bar);
            __builtin_amdgcn_fence(__ATOMIC_ACQUIRE, "agent");
            asm volatile("s_waitcnt vmcnt(0)" ::: "memory");
        }
    }
    __syncthreads();
}
__device__ __forceinline__ float wave_sum(float v) {
    v += swz_xor<1>(v); v += swz_xor<2>(v); v += swz_xor<4>(v); v += swz_xor<8>(v); v += swz_xor<16>(v);
    auto rr = __builtin_amdgcn_permlane32_swap(__float_as_uint(v), __float_as_uint(v), false, false);
    return __uint_as_float(rr[0]) + __uint_as_float(rr[1]);
}
__device__ __forceinline__ unsigned pk2(float lo, float hi) { return cvt2bf(lo, hi); }

template <int MAP  >
__device__ __forceinline__ void transpose_item(const float* W, int Nsrc, int coff, bf16_t* WT, int ldw, int koff, int nblk, LAS float* scr, int item, int lane) {
    const int kb = item / nblk, nb = item % nblk, k0 = 64 * kb, n0 = 32 * nb;
    const int nd = n0 + (lane & 31); const int scol = MAP ? in_map(nd) : nd + coff;
    float wv[32];
#pragma unroll
    for (int i = 0; i < 32; ++i) wv[i] = W[(size_t)(k0 + 2 * i + (lane >> 5)) * Nsrc + scol];
#pragma unroll
    for (int i = 0; i < 32; ++i) scr[(2 * i + (lane >> 5)) * 33 + (lane & 31)] = wv[i];
    asm volatile("s_waitcnt lgkmcnt(0)" ::: "memory");
    const int c = lane & 7;
#pragma unroll
    for (int j = 0; j < 4; ++j) { const int n = (lane >> 3) + 8 * j; const LAS float* s = scr + (8 * c) * 33 + n;
        u32x4 o; o.x = pk2(s[0 * 33], s[1 * 33]); o.y = pk2(s[2 * 33], s[3 * 33]); o.z = pk2(s[4 * 33], s[5 * 33]); o.w = pk2(s[6 * 33], s[7 * 33]);
        *(u32x4*)(WT + (size_t)(n0 + n) * ldw + koff + k0 + 8 * c) = o; }
    asm volatile("s_waitcnt lgkmcnt(0)" ::: "memory");
}
struct WSrc { const float *w_in, *wo_f, *wo_a, *wo_c, *wo_p, *w_out, *w_up, *w_down; };
constexpr int IT_A = 16 * 208;
constexpr int IT_B0 = 4 * 32, IT_B1 = 8 * 32, IT_B2 = 4 * 32, IT_B3 = 4 * 32, IT_B4 = 16 * 32, IT_B5 = 16 * 88, IT_B6 = 16 * 88, IT_B7 = 44 * 32;
constexpr int IT_B = IT_B0 + IT_B1 + IT_B2 + IT_B3 + IT_B4 + IT_B5 + IT_B6 + IT_B7;
__device__ __forceinline__ void convert_A(const WSrc& S, unsigned char* ws, LAS float* scr, int gw, int NGW, int lane) {
    for (int it = gw; it < IT_A; it += NGW) transpose_item<1>(S.w_in, NIN, 0, (bf16_t*)(ws + WS_WA), 1024, 0, 208, scr, it, lane);
}
__device__ __forceinline__ void convert_B(const WSrc& S, unsigned char* ws, LAS float* scr, int gw, int NGW, int lane) {
    for (int it = gw; it < IT_B; it += NGW) { int r = it;
        if (r < IT_B0) { transpose_item<0>(S.wo_f, 1024, 0, (bf16_t*)(ws + WS_WCAT), KCAT, 0, 32, scr, r, lane); continue; } r -= IT_B0;
        if (r < IT_B1) { transpose_item<0>(S.wo_a, 1024, 0, (bf16_t*)(ws + WS_WCAT), KCAT, 256, 32, scr, r, lane); continue; } r -= IT_B1;
        if (r < IT_B2) { transpose_item<0>(S.wo_c, 1024, 0, (bf16_t*)(ws + WS_WCAT), KCAT, 768, 32, scr, r, lane); continue; } r -= IT_B2;
        if (r < IT_B3) { transpose_item<0>(S.wo_p, 1024, 0, (bf16_t*)(ws + WS_WCAT), KCAT, 1024, 32, scr, r, lane); continue; } r -= IT_B3;
        if (r < IT_B4) { transpose_item<0>(S.w_out, 1024, 0, (bf16_t*)(ws + WS_WOUT), 1024, 0, 32, scr, r, lane); continue; } r -= IT_B4;
        if (r < IT_B5) { transpose_item<0>(S.w_up, 2 * DFF, DFF, (bf16_t*)(ws + WS_WUPG), 1024, 0, 88, scr, r, lane); continue; } r -= IT_B5;
        if (r < IT_B6) { transpose_item<0>(S.w_up, 2 * DFF, 0, (bf16_t*)(ws + WS_WUPV), 1024, 0, 88, scr, r, lane); continue; } r -= IT_B6;
        transpose_item<0>(S.w_down, 1024, 0, (bf16_t*)(ws + WS_WDN), DFF, 0, 32, scr, r, lane);
    }
}

__device__ __forceinline__ void mod_phase(const float* c, const float* c_ctx, const float* ada_w, const float* ada_b, float* MOD, LAS unsigned char* lds, int vcu, int G, int tid, int wave, int lane) {
    LAS float* sil = (LAS float*)lds;
    LAS float* red = (LAS float*)(lds + 12288);
    for (int i = tid; i < 3072; i += 512) { const float v = i < 2048 ? c[i] : c_ctx[i - 2048]; sil[i] = v * sigm(v); }
    __syncthreads();
    for (int item = vcu; item < 192; item += G) {
        const int l = item / 96, n = (item % 96) * 64 + lane;
        const float* W = ada_w + (size_t)l * 1024 * 6144 + n;
        float a0 = 0.f, a1 = 0.f, a2 = 0.f;
        for (int k = wave * 128; k < wave * 128 + 128; k += 8) { float w[8];
#pragma unroll
            for (int i = 0; i < 8; ++i) w[i] = W[(size_t)(k + i) * 6144];
#pragma unroll
            for (int i = 0; i < 8; ++i) { a0 += sil[k + i] * w[i]; a1 += sil[1024 + k + i] * w[i]; a2 += sil[2048 + k + i] * w[i]; } }
        red[(wave * 3 + 0) * 64 + lane] = a0; red[(wave * 3 + 1) * 64 + lane] = a1; red[(wave * 3 + 2) * 64 + lane] = a2;
        __syncthreads();
        if (wave < 3) { float s = ada_b[l * 6144 + n];
#pragma unroll
            for (int w = 0; w < 8; ++w) s += red[(w * 3 + wave) * 64 + lane];
            MOD[(size_t)(l * 3 + wave) * 6144 + n] = s; }
        __syncthreads();
    }
}
__device__ __forceinline__ void tables_phase(float* ROPE, f32x2* TW, int gt, int NGT) {
    for (int i = gt; i < 192 * 16; i += NGT) { const int pos = i >> 4, f = i & 15; const float inv = powf(10000.0f, -(float)f / 16.0f); const float ang = (float)(pos < 128 ? pos : pos - 128) * inv;
        float s, c; sincosf(ang, &s, &c); ROPE[pos * 32 + f] = c; ROPE[pos * 32 + 16 + f] = s; }
    for (int i = gt; i < 8192; i += NGT) { float s, c; sincospif((float)i * (1.0f / 4096.0f), &s, &c); TW[i] = (f32x2){c, -s}; }
}

__device__ __forceinline__ void norm_phase(const float* src_lat, const float* src_ctx, int nrows, const float* gamma, const float* mod, int shoff, int scoff, bf16_t* HX, int gw, int NGW, int lane) {
    for (int m0 = gw; m0 < nrows; m0 += 4 * NGW) {
        f32x4 v[4][4]; float s[4];
#pragma unroll
        for (int u = 0; u < 4; ++u) { const int m = m0 + u * NGW; s[u] = 0.f;
            if (m < nrows) { const float* xr = m < ML ? src_lat + (size_t)m * DM : src_ctx + (size_t)(m - ML) * DM;
#pragma unroll
                for (int j = 0; j < 4; ++j) v[u][j] = ((const f32x4*)xr)[lane + 64 * j]; } }
#pragma unroll
        for (int u = 0; u < 4; ++u) { const int m = m0 + u * NGW; if (m < nrows) {
#pragma unroll
            for (int j = 0; j < 4; ++j) s[u] += (v[u][j].x * v[u][j].x + v[u][j].y * v[u][j].y) + (v[u][j].z * v[u][j].z + v[u][j].w * v[u][j].w);
            const float rstd = 1.0f / sqrtf(wave_sum(s[u]) * (1.0f / DM) + EPS);
            const float* md = mod + (m < SEQ ? 0 : m < ML ? 1 : 2) * 6144;
#pragma unroll
            for (int j = 0; j < 4; ++j) { const int col = 4 * lane + 256 * j;
                const f32x4 g = *(const f32x4*)(gamma + col), sc = *(const f32x4*)(md + scoff + col), sh = *(const f32x4*)(md + shoff + col);
                const f32x4 o = v[u][j] * rstd * g * (sc + 1.0f) + sh;
                u32x2 w; w.x = pk2(o.x, o.y); w.y = pk2(o.z, o.w); *(u32x2*)(HX + (size_t)m * DM + col) = w; } } }
    }
}
__device__ __forceinline__ void final_norm_phase(float* x, const float* gamma, int gw, int NGW, int lane) {
    for (int m0 = gw; m0 < ML; m0 += 4 * NGW) {
        f32x4 v[4][4];
#pragma unroll
        for (int u = 0; u < 4; ++u) { const int m = m0 + u * NGW; if (m < ML) {
#pragma unroll
            for (int j = 0; j < 4; ++j) v[u][j] = ((const f32x4*)(x + (size_t)m * DM))[lane + 64 * j]; } }
#pragma unroll
        for (int u = 0; u < 4; ++u) { const int m = m0 + u * NGW; if (m < ML) { float s = 0.f;
#pragma unroll
            for (int j = 0; j < 4; ++j) s += (v[u][j].x * v[u][j].x + v[u][j].y * v[u][j].y) + (v[u][j].z * v[u][j].z + v[u][j].w * v[u][j].w);
            const float rstd = 1.0f / sqrtf(wave_sum(s) * (1.0f / DM) + EPS);
#pragma unroll
            for (int j = 0; j < 4; ++j) { const f32x4 g = *(const f32x4*)(gamma + 4 * lane + 256 * j); ((f32x4*)(x + (size_t)m * DM))[lane + 64 * j] = v[u][j] * rstd * g; } } }
    }
}

#define SWZ(row, colB) ((row) * 256 + ((colB) ^ (((row) & 7) << 4)))
__device__ __forceinline__ int crow_(int r, int hi) { return (r & 3) + 8 * (r >> 2) + 4 * hi; }
__device__ __forceinline__ bf16x8 pack_bf8(const float* v) { u32x4 w; w.x = pk2(v[0], v[1]); w.y = pk2(v[2], v[3]); w.z = pk2(v[4], v[5]); w.w = pk2(v[6], v[7]); return __builtin_bit_cast(bf16x8, w); }
__device__ __forceinline__ void fft1_phase(const bf16_t* UF, const f32x2* TW, unsigned* FA, LAS unsigned char* lds, int vcu, int G, int tid, int wave, int lane) {
    const int tr = wave >> 1, tc = wave & 1, r32 = lane & 31, hi = lane >> 5;
    bf16x8 aRe[8], aIm[8];
#pragma unroll
    for (int ks = 0; ks < 8; ++ks) { float cv[8], sv[8];
#pragma unroll
        for (int j = 0; j < 8; ++j) { const int idx = ((32 * tr + r32) * (16 * ks + 8 * hi + j)) & 127; float s, c; sincospif((float)idx * (1.0f / 64.0f), &s, &c); cv[j] = c; sv[j] = -s; }
        aRe[ks] = pack_bf8(cv); aIm[ks] = pack_bf8(sv); }
    for (int item = vcu; item < 512; item += G) {
        const int b = item >> 8, g = (item >> 6) & 3, l2 = item & 63;
#pragma unroll
        for (int i = 0; i < 2; ++i) { const int q = tid + 512 * i, l1 = q >> 3, c8 = (q & 7) * 8;
            const u32x4 v = *(const u32x4*)(UF + (size_t)(b * SEQ + 64 * l1 + l2) * 256 + g * 64 + c8);
#pragma unroll
            for (int e = 0; e < 8; ++e) { const unsigned w = v[e >> 1]; *(LAS bf16_t*)(lds + SWZ(c8 + e, l1 * 2)) = (bf16_t)((e & 1) ? (w >> 16) : (w & 0xffffu)); } }
        __syncthreads();
        f32x16 re = {}, im = {};
#pragma unroll
        for (int ks = 0; ks < 8; ++ks) { const bf16x8 bx = *(const LAS bf16x8*)(lds + SWZ(32 * tc + r32, (16 * ks + 8 * hi) * 2));
            re = __builtin_amdgcn_mfma_f32_32x32x16_bf16(aRe[ks], bx, re, 0, 0, 0); im = __builtin_amdgcn_mfma_f32_32x32x16_bf16(aIm[ks], bx, im, 0, 0, 0); }
        unsigned* dst = FA + ((size_t)((b * 4 + g) * 64 + l2) * 128) * 64 + 32 * tc + r32;
#pragma unroll
        for (int r = 0; r < 16; ++r) { const int k1 = 32 * tr + crow_(r, hi); const f32x2 t = TW[k1 * l2];
            dst[(size_t)k1 * 64] = pk2(re[r] * t.x - im[r] * t.y, re[r] * t.y + im[r] * t.x); }
        __syncthreads();
    }
}
__device__ __forceinline__ void fft2_phase(const unsigned* FA, bf16_t* ACAT, LAS unsigned char* lds, int vcu, int G, int tid, int wave, int lane) {
    const int tr = wave >> 1, tc = wave & 1, r32 = lane & 31, hi = lane >> 5;
    bf16x8 a2[8], b3[8];
#pragma unroll
    for (int ks = 0; ks < 8; ++ks) { float av[8], bv[8];
#pragma unroll
        for (int j = 0; j < 8; ++j) { const int R = 32 * tr + r32, k = 16 * ks + 8 * hi + j, k2 = R & 63, ll = k & 63; float s, c; sincospif((float)((k2 * ll) & 63) * (1.0f / 32.0f), &s, &c);
            av[j] = (R < 64) ? ((k < 64) ? c : s) : ((k < 64) ? -s : c);
            const int m = 32 * tc + r32; float s2, c2; sincospif((float)((m * ll) & 63) * (1.0f / 32.0f), &s2, &c2); bv[j] = (k < 64) ? c2 : s2; }
        a2[ks] = pack_bf8(av); b3[ks] = pack_bf8(bv); }
    LAS unsigned char* Bt = lds;
    LAS unsigned char* Zt = lds + 16384;
    for (int item = vcu; item < 1024; item += G) {
        const int b = item >> 9, g = (item >> 7) & 3, k1 = item & 127;
#pragma unroll
        for (int i = 0; i < 2; ++i) { const int q = tid + 512 * i, l2 = q >> 4, c4 = (q & 15) * 4;
            const u32x4 v = *(const u32x4*)(FA + ((size_t)((b * 4 + g) * 64 + l2) * 128 + k1) * 64 + c4);
#pragma unroll
            for (int e = 0; e < 4; ++e) { *(LAS bf16_t*)(Bt + SWZ(c4 + e, l2 * 2)) = (bf16_t)(v[e] & 0xffffu); *(LAS bf16_t*)(Bt + SWZ(c4 + e, (64 + l2) * 2)) = (bf16_t)(v[e] >> 16); } }
        __syncthreads();
        f32x16 z = {};
#pragma unroll
        for (int ks = 0; ks < 8; ++ks) { const bf16x8 bx = *(const LAS bf16x8*)(Bt + SWZ(32 * tc + r32, (16 * ks + 8 * hi) * 2)); z = __builtin_amdgcn_mfma_f32_32x32x16_bf16(a2[ks], bx, z, 0, 0, 0); }
#pragma unroll
        for (int r = 0; r < 16; ++r) { const int R = 32 * tr + crow_(r, hi); *(LAS bf16_t*)(Zt + SWZ(R & 63, ((R >> 6) * 64 + 32 * tc + r32) * 2)) = (bf16_t)(pk2(z[r], 0.f) & 0xffffu); }
        __syncthreads();
        if (wave < 4) { f32x16 y = {};
#pragma unroll
            for (int ks = 0; ks < 8; ++ks) { const bf16x8 ax = *(const LAS bf16x8*)(Zt + SWZ(32 * tr + r32, (16 * ks + 8 * hi) * 2)); y = __builtin_amdgcn_mfma_f32_32x32x16_bf16(ax, b3[ks], y, 0, 0, 0); }
#pragma unroll
            for (int r = 0; r < 16; ++r) { const int k2 = 32 * tr + crow_(r, hi); ACAT[(size_t)(b * SEQ + k1 + 128 * k2) * KCAT + g * 64 + 32 * tc + r32] = (bf16_t)(pk2(y[r] * 0.001381067932f, 0.f) & 0xffffu); } }
        __syncthreads();
    }
}
__device__ __forceinline__ void ctxdft_item(int item, const bf16_t* UF, bf16_t* ACAT, LAS unsigned char* lds, int tid, int wave, int lane) {
    const int b = item >> 4, g = (item >> 2) & 3, kc = item & 3;
    const int tr = wave >> 1, tc = wave & 1, r32 = lane & 31, hi = lane >> 5;
    LAS unsigned char* Xt = lds;
    LAS unsigned char* Zt = lds + 32768;
#pragma unroll
    for (int i = 0; i < 4; ++i) { const int q = tid + 512 * i, l = q >> 3, c8 = (q & 7) * 8;
        const u32x4 v = *(const u32x4*)(UF + (size_t)(ML + b * CTXL + l) * 256 + g * 64 + c8);
#pragma unroll
        for (int e = 0; e < 8; ++e) { const unsigned w = v[e >> 1]; const int row = c8 + e; *(LAS bf16_t*)(Xt + row * 512 + ((((l >> 3) ^ (row & 7)) << 4) | ((l & 7) * 2))) = (bf16_t)((e & 1) ? (w >> 16) : (w & 0xffffu)); } }
    __syncthreads();
    f32x16 z = {};
    const int R = 32 * tr + r32, kk = 64 * kc + (R & 63);
#pragma unroll 4
    for (int ks = 0; ks < 16; ++ks) { float av[8];
#pragma unroll
        for (int j = 0; j < 8; ++j) { const int l = 16 * ks + 8 * hi + j; float s, c; sincospif((float)((kk * l) & 255) * (1.0f / 128.0f), &s, &c); av[j] = (R < 64) ? c : -s; }
        const int row = 32 * tc + r32, ch = (16 * ks + 8 * hi) >> 3;
        const bf16x8 bx = *(const LAS bf16x8*)(Xt + row * 512 + ((ch ^ (row & 7)) << 4));
        z = __builtin_amdgcn_mfma_f32_32x32x16_bf16(pack_bf8(av), bx, z, 0, 0, 0); }
#pragma unroll
    for (int r = 0; r < 16; ++r) { const int Rr = 32 * tr + crow_(r, hi); *(LAS bf16_t*)(Zt + SWZ(Rr & 63, ((Rr >> 6) * 64 + 32 * tc + r32) * 2)) = (bf16_t)(pk2(z[r], 0.f) & 0xffffu); }
    __syncthreads();
    if (wave < 4) { f32x16 y = {};
#pragma unroll
        for (int ks = 0; ks < 8; ++ks) { float bv[8];
#pragma unroll
            for (int j = 0; j < 8; ++j) { const int k = 16 * ks + 8 * hi + j, m = 32 * tc + r32; float s2, c2; sincospif((float)((m * (k & 63)) & 63) * (1.0f / 32.0f), &s2, &c2); bv[j] = (k < 64) ? c2 : s2; }
            const bf16x8 ax = *(const LAS bf16x8*)(Zt + SWZ(32 * tr + r32, (16 * ks + 8 * hi) * 2)); y = __builtin_amdgcn_mfma_f32_32x32x16_bf16(ax, pack_bf8(bv), y, 0, 0, 0); }
#pragma unroll
        for (int r = 0; r < 16; ++r) { const int k = 64 * kc + 32 * tr + crow_(r, hi); ACAT[(size_t)(ML + b * CTXL + k) * KCAT + g * 64 + 32 * tc + r32] = (bf16_t)(pk2(y[r] * (1.0f / 128.0f), 0.f) & 0xffffu); } }
    __syncthreads();
}

__device__ __forceinline__ void conv_item(int item, const bf16_t* ZG, const float* cw  , const float* cb, const float* lng, const float* lnb, bf16_t* ACAT, LAS unsigned char* lds, int tid, int wave, int lane) {
    const int row0 = item * 64; const bool lat = row0 < ML; const int s0 = lat ? (row0 & ~(SEQ - 1)) : (ML + ((row0 - ML) & ~(CTXL - 1))), s1 = s0 + (lat ? SEQ : CTXL);
    LAS float* zt = (LAS float*)lds;
#pragma unroll
    for (int i = 0; i < 6; ++i) { const int q = tid + 512 * i; if (q < 94 * 32) { const int rr = q >> 5, c8 = (q & 31) * 8, gr = row0 - 15 + rr;
        u32x4 v = {0u, 0u, 0u, 0u}; if (gr >= s0 && gr < s1) v = *(const u32x4*)(ZG + (size_t)gr * 256 + c8);
        *(LAS f32x4*)(zt + rr * 256 + c8) = (f32x4){bf2f(v.x & 0xffffu), __uint_as_float(v.x & 0xffff0000u), bf2f(v.y & 0xffffu), __uint_as_float(v.y & 0xffff0000u)};
        *(LAS f32x4*)(zt + rr * 256 + c8 + 4) = (f32x4){bf2f(v.z & 0xffffu), __uint_as_float(v.z & 0xffff0000u), bf2f(v.w & 0xffffu), __uint_as_float(v.w & 0xffff0000u)}; } }
    const int c = tid & 255, half = tid >> 8;
    float w[31];
#pragma unroll
    for (int t = 0; t < 31; ++t) w[t] = cw[t * 256 + c];
    float acc[32]; const float bias = cb[c];
    __syncthreads();
#pragma unroll
    for (int r0 = 0; r0 < 32; r0 += 4) { float v[34];
#pragma unroll
        for (int i = 0; i < 34; ++i) v[i] = zt[(half * 32 + r0 + i) * 256 + c];
        float a0 = bias, a1 = bias, a2 = bias, a3 = bias;
#pragma unroll
        for (int t = 0; t < 31; ++t) { a0 += w[t] * v[t]; a1 += w[t] * v[t + 1]; a2 += w[t] * v[t + 2]; a3 += w[t] * v[t + 3]; }
        acc[r0] = a0; acc[r0 + 1] = a1; acc[r0 + 2] = a2; acc[r0 + 3] = a3; }
    __syncthreads();
#pragma unroll
    for (int r = 0; r < 32; ++r) zt[(half * 32 + r) * 256 + c] = acc[r];
    __syncthreads();
    const f32x4 gg = *(const f32x4*)(lng + 4 * lane), bb = *(const f32x4*)(lnb + 4 * lane);
#pragma unroll
    for (int i = 0; i < 8; ++i) { const int r = wave * 8 + i; const f32x4 v = *(const LAS f32x4*)(zt + r * 256 + 4 * lane);
        const float mu = wave_sum((v.x + v.y) + (v.z + v.w)) * (1.0f / 256.0f); const f32x4 d = v - mu;
        const float var = wave_sum((d.x * d.x + d.y * d.y) + (d.z * d.z + d.w * d.w)) * (1.0f / 256.0f); const float rs = 1.0f / sqrtf(var + EPS);
        f32x4 o = d * rs * gg + bb; o.x *= sigm(o.x); o.y *= sigm(o.y); o.z *= sigm(o.z); o.w *= sigm(o.w);
        u32x2 pw; pw.x = pk2(o.x, o.y); pw.y = pk2(o.z, o.w); *(u32x2*)(ACAT + (size_t)(row0 + r) * KCAT + 768 + 4 * lane) = pw; }
    __syncthreads();
}
__device__ __forceinline__ void pool_phase(const bf16_t* UP, const float* pw  , const float* psc, bf16_t* ACAT, int nitems, int first, LAS unsigned char* lds, int G, int tid, int wave, int lane) {
    const int g = wave >> 1, tc = wave & 1, r32 = lane & 31, hi = lane >> 5;
    bf16x8 bw[4];
#pragma unroll
    for (int ks = 0; ks < 4; ++ks) { float v[8];
#pragma unroll
        for (int j = 0; j < 8; ++j) v[j] = pw[g * 4096 + (16 * ks + 8 * hi + j) * 64 + 32 * tc + r32];
        bw[ks] = pack_bf8(v); }
    const float osc = psc[g * 64 + 32 * tc + r32];
    LAS float* ut = (LAS float*)lds;
    LAS unsigned char* dt = lds + 81920;
    for (int item = first; item < nitems; item += G) {
        const int row0 = item * 64; const bool lat = row0 < ML; const int s0 = lat ? (row0 & ~(SEQ - 1)) : (ML + ((row0 - ML) & ~(CTXL - 1))), L = lat ? SEQ : CTXL, s1 = s0 + L;
#pragma unroll
        for (int i = 0; i < 5; ++i) { const int q = tid + 512 * i, rr = q >> 5, c8 = (q & 31) * 8, gr = row0 - 8 + rr;
            u32x4 v = {0u, 0u, 0u, 0u}; if (gr >= s0 && gr < s1) v = *(const u32x4*)(UP + (size_t)gr * 256 + c8);
            *(LAS f32x4*)(ut + rr * 256 + c8) = (f32x4){bf2f(v.x & 0xffffu), __uint_as_float(v.x & 0xffff0000u), bf2f(v.y & 0xffffu), __uint_as_float(v.y & 0xffff0000u)};
            *(LAS f32x4*)(ut + rr * 256 + c8 + 4) = (f32x4){bf2f(v.z & 0xffffu), __uint_as_float(v.z & 0xffff0000u), bf2f(v.w & 0xffffu), __uint_as_float(v.w & 0xffff0000u)}; }
        __syncthreads();
#pragma unroll
        for (int i = 0; i < 4; ++i) { const int q = tid + 512 * i, lr = q >> 5, c8 = (q & 31) * 8, gg = c8 >> 6, hw = 1 << gg, tt = row0 + lr - s0;
            f32x4 sa = {0.f, 0.f, 0.f, 0.f}, sb = {0.f, 0.f, 0.f, 0.f};
            for (int o = -hw; o < hw; ++o) { sa += *(const LAS f32x4*)(ut + (lr + 8 + o) * 256 + c8); sb += *(const LAS f32x4*)(ut + (lr + 8 + o) * 256 + c8 + 4); }
            const int lo = tt - hw < 0 ? 0 : tt - hw, hh = tt + hw - 1 > L - 1 ? L - 1 : tt + hw - 1; const float inv = 1.0f / (float)(hh - lo + 1);
            const f32x4 ua = *(const LAS f32x4*)(ut + (lr + 8) * 256 + c8), ub = *(const LAS f32x4*)(ut + (lr + 8) * 256 + c8 + 4);
            const f32x4 da = sa * inv - ua, db = sb * inv - ub;
            u32x4 w; w.x = pk2(da.x, da.y); w.y = pk2(da.z, da.w); w.z = pk2(db.x, db.y); w.w = pk2(db.z, db.w);
            *(LAS u32x4*)(dt + lr * 512 + ((((c8 >> 3) ^ (lr & 7)) << 4))) = w; }
        __syncthreads();
#pragma unroll
        for (int rt = 0; rt < 2; ++rt) { f32x16 y = {};
#pragma unroll
            for (int ks = 0; ks < 4; ++ks) { const int row = 32 * rt + r32, ch = (g * 64 + 16 * ks + 8 * hi) >> 3;
                const bf16x8 ax = *(const LAS bf16x8*)(dt + row * 512 + ((ch ^ (row & 7)) << 4)); y = __builtin_amdgcn_mfma_f32_32x32x16_bf16(ax, bw[ks], y, 0, 0, 0); }
#pragma unroll
            for (int r = 0; r < 16; ++r) ACAT[(size_t)(row0 + 32 * rt + crow_(r, hi)) * KCAT + 1024 + g * 64 + 32 * tc + r32] = (bf16_t)(pk2(y[r] * osc, 0.f) & 0xffffu); }
        __syncthreads();
    }
}
constexpr int NPHASE = 22;
struct Args { const float* in[30]; float* out; unsigned char* ws; int ph_lo, ph_hi, li, pad; };
__global__ void __launch_bounds__(512, 2) __attribute__((amdgpu_waves_per_eu(2, 2))) fwd_kernel(Args args) {
    extern __shared__ __attribute__((aligned(16))) unsigned char lds[];
    LAS unsigned char* L = (LAS unsigned char*)lds;
    volatile LAS unsigned* MISC = (volatile LAS unsigned*)(L + MISC_OFF);
    const int tid0 = threadIdx.x; const int wave0 = __builtin_amdgcn_readfirstlane(tid0 >> 6);
    const int G = gridDim.x, bx0 = blockIdx.x, vcu0 = (G % 8 == 0) ? (bx0 % 8) * (G / 8) + bx0 / 8 : bx0;
    const int NGW = G * 8;
    gu32* ctl = (gu32*)(args.ws + WS_CTL);
    for (int u = tid0; u < (LDS_BYTES - LDSCTL_OFF) / 4; u += 512) ((LAS unsigned*)(L + LDSCTL_OFF))[u] = 0u;
    __syncthreads();
    volatile LAS unsigned long long* PT = (volatile LAS unsigned long long*)(L + PT_OFF);
    if (tid0 < 32) PT[tid0] = ((const __attribute__((address_space(4))) unsigned long long*)__builtin_amdgcn_kernarg_segment_ptr())[tid0];
    __syncthreads();
#define FRESH() int tid, vcu = vcu0, bx = bx0; asm volatile("v_mbcnt_lo_u32_b32 %0, -1, 0\n\tv_mbcnt_hi_u32_b32 %0, -1, %0" : "=v"(tid)); tid += wave0 * 64; asm volatile("" : "+v"(tid), "+s"(vcu), "+s"(bx)); const int lane = tid & 63, wave = __builtin_amdgcn_readfirstlane(tid >> 6), gw = vcu * 8 + wave; (void)lane; (void)gw; (void)bx; \
    LAS float* scr = (LAS float*)(L + wave * 16384); (void)scr;
#define PTR(i) ((const float*)(const GAS float*)ldptr(PT, (i)))
#define OUTP ((float*)(GAS float*)ldptr(PT, 30))
#define WSP ((unsigned char*)(GAS unsigned char*)ldptr(PT, 31))
    XcdBarrier bar; bar.bar = (unsigned*)(ctl + CW_BAR) + args.li * XCD_BAR_WORDS; bar.x = 0; bar.st = nullptr;
    if (MK_N_LAUNCHES != NPHASE) bar = xcd_barrier_post((unsigned*)(ctl + CW_BAR) + args.li * XCD_BAR_WORDS, MISC + 8);
#define GRID_BAR() do { if (MK_N_LAUNCHES == NPHASE) { if (tid0 == 0) __hip_atomic_store(ctl + CW_TMO, 0xBADBA0u, RLX_AGENT); } else { xcd_barrier(bar); } } while (0)
    const int lo = args.ph_lo, hi = args.ph_hi;
#ifndef PHASE_MASK
#define PHASE_MASK 0xFFF
#endif
#ifndef ATTM
#define ATTM 3
#endif
#ifndef X1REP
#define X1REP 0
#endif
#ifndef X1M
#define X1M 31
#endif
#define PH_EN(kind) ((PHASE_MASK >> (kind)) & 1)
#ifndef REP_MASK
#define REP_MASK 0
#endif
#define NREP(kind) (((REP_MASK >> (kind)) & 1) ? 2 : 1)
#define IN(k) (lo <= (k) && (k) < hi)
#define BOTH(k) (IN(k) && IN((k) + 1))
#define WSRC(S, l) WSrc S; S.w_in = PTR(8) + (size_t)(l) * 1024 * NIN; S.wo_f = PTR(20) + (size_t)(l) * 256 * 1024; S.wo_a = PTR(21) + (size_t)(l) * 512 * 1024; \
    S.wo_c = PTR(22) + (size_t)(l) * 256 * 1024; S.wo_p = PTR(23) + (size_t)(l) * 256 * 1024; S.w_out = PTR(24) + (size_t)(l) * 1024 * 1024; \
    S.w_up = PTR(25) + (size_t)(l) * 1024 * 2 * DFF; S.w_down = PTR(28) + (size_t)(l) * DFF * 1024;
#define ws WSP
#define MOD ((float*)(WSP + WS_MOD))
#define ROPE ((float*)(WSP + WS_ROPE))
#define TW ((f32x2*)(WSP + WS_TW))
#define XC ((float*)(WSP + WS_XC))
#define HX ((bf16_t*)(WSP + WS_HX))
#define FA ((f32x2*)(WSP + WS_FA))
#define Qb ((bf16_t*)(WSP + WS_Q))
#define Kb ((bf16_t*)(WSP + WS_K))
#define Vb ((bf16_t*)(WSP + WS_V))
#define Yb ((bf16_t*)(WSP + WS_Y))
#define Gb (WSP + WS_G)
#define ACAT ((bf16_t*)(WSP + WS_ACAT))
#define UF ((bf16_t*)(WSP + WS_UF))
#define ZG ((bf16_t*)(WSP + WS_ZG))
#define UP ((bf16_t*)(WSP + WS_UP))
#define GT ((bf16_t*)(WSP + WS_GT))
#define Hb ((bf16_t*)(WSP + WS_H))

    for (int rep = 0; rep < NREP(0); ++rep) if (PH_EN(0) && IN(0)) { FRESH();
        mod_phase(PTR(1), PTR(3), PTR(6), PTR(7), MOD, L, vcu, G, tid, wave, lane);
        tables_phase(ROPE, TW, vcu * 512 + tid, G * 512);
        WSRC(S0, 0); convert_A(S0, ws, scr, gw, NGW, lane); convert_B(S0, ws, scr, gw, NGW, lane);
        if (BOTH(0)) GRID_BAR();
    }
#pragma nounroll
    for (int l = 0; l < 2; ++l) {
        const int pb = 1 + 10 * l;
#define mod (MOD + l * 3 * 6144)
#define xl ((l == 0) ? PTR(0) : (const float*)OUTP)
#define xc ((l == 0) ? PTR(2) : (const float*)XC)
        const int Mact = (l == 0) ? MT : ML;
        for (int rep = 0; rep < NREP(1); ++rep) if (PH_EN(1) && IN(pb)) { FRESH(); norm_phase(xl, xc, MT, PTR(4) + l * DM, mod, 0, 1024, HX, gw, NGW, lane); if (BOTH(pb)) GRID_BAR(); }
        for (int rep = 0; rep < NREP(2); ++rep) if (PH_EN(2) && IN(pb + 1)) { FRESH();
            pg8::Gemm g{HX, (const bf16_t*)(ws + WS_WA), MT, NIN, 1024}; pg8::StaticOrder S; S.init(MT, NIN, G, bx);
            pg8::EpiIn E{UF, ZG, UP, Qb, Kb, Vb, Gb, ROPE};
            pg8::gemm_phase<pg8::EpiIn, pg8::StaticOrder, true, true>(L, g, S, E, tid);
            if (BOTH(pb + 1)) GRID_BAR();
        }
        for (int rep = 0; rep < NREP(3); ++rep) if (PH_EN(3) && IN(pb + 2)) { FRESH();
            for (int r1 = 0; r1 < ((X1REP & 1) ? 2 : 1); ++r1) if (X1M & 1) fft1_phase(UF, TW, (unsigned*)FA, L, vcu, G, tid, wave, lane);
            for (int r1 = 0; r1 < ((X1REP & 2) ? 2 : 1); ++r1) if (X1M & 2) for (int it = vcu; it < Mact / 64; it += G) conv_item(it, ZG, PTR(14) + l * 31 * 256, PTR(15) + l * 256, PTR(16) + l * 256, PTR(17) + l * 256, ACAT, L, tid, wave, lane);
            for (int r1 = 0; r1 < ((X1REP & 4) ? 2 : 1); ++r1) if (X1M & 4) pool_phase(UP, PTR(18) + l * 4 * 4096, PTR(19) + l * 256, ACAT, Mact / 64, (vcu + 248) % G, L, G, tid, wave, lane);
            if ((X1M & 8) && l == 0) for (int it = (vcu + 224) % G; it < 32; it += G) ctxdft_item(it, UF, ACAT, L, tid, wave, lane);
            WSRC(S1, 1);
            for (int r1 = 0; r1 < ((X1REP & 16) ? 2 : 1); ++r1) if (!(X1M & 16)) {} else if (l == 0) convert_A(S1, ws, scr, gw, NGW, lane); else convert_B(S1, ws, scr, gw, NGW, lane);
            if (BOTH(pb + 2)) GRID_BAR();
        }
        for (int rep = 0; rep < NREP(4); ++rep) if (PH_EN(4) && IN(pb + 3)) { FRESH();
            if (ATTM & 1) fft2_phase((const unsigned*)FA, ACAT, L, vcu, G, tid, wave, lane);
            const float lam_init = (l == 0) ? 0.2f : 0.35550906759096926f;
            const float d1 = wave_sum(PTR(9)[l * 64 + lane] * PTR(10)[l * 64 + lane]), d2 = wave_sum(PTR(11)[l * 64 + lane] * PTR(12)[l * 64 + lane]);
            const float lam = __builtin_bit_cast(float, __builtin_amdgcn_readfirstlane(__builtin_bit_cast(int, expf(d1) - expf(d2) + lam_init)));
            const int nun = 512 + (l == 0 ? 16 : 0);
            if (ATTM & 2) for (int u = vcu; u < nun; u += G) {
                int b, h, row0, nkeys;
                if (u < 512) { const int x = (u & 255) >> 5, qb = (u & 31) + 32 * (u >> 8); b = x >> 2; h = x & 3; row0 = b * SEQ + qb * 128; nkeys = KVL; }
                else { const int v = u - 512; b = v >> 3; h = (v >> 1) & 3; row0 = ML + b * CTXL + (v & 1) * 128; nkeys = CTXL; }
#if ATT_V == 2
                att2::attn_unit<0>(Qb + (size_t)row0 * 512 + h * 128,
#else
                att::attn_unit<0>(Qb + (size_t)row0 * 512 + h * 128,
#endif
                               Kb + (size_t)b * KVL * 512 + h * 128, Vb + (size_t)b * KVL * 512 + h * 128, nkeys,
                               ACAT + (size_t)row0 * KCAT + 256 + h * 128, lam, 1.0f - lam_init, PTR(13) + l * 128, (char*)lds, tid);
            }
#if defined(ATT_PROBE)
            int tid2 = tid, vcu2 = vcu; asm volatile("" : "+v"(tid2), "+s"(vcu2));
            for (int u = vcu2; u < 512; u += G) {
                const int x = (u & 255) >> 5, qb = (u & 31) + 32 * (u >> 8), b = x >> 2, h = x & 3, row0 = b * SEQ + qb * 128;
                att2::attn_unit<ATT_PROBE>(Qb + (size_t)row0 * 512 + h * 128, Kb + (size_t)b * KVL * 512 + h * 128, Vb + (size_t)b * KVL * 512 + h * 128, KVL,
                               Hb + (size_t)row0 * KCAT + 256 + h * 128, lam, 1.0f - lam_init, PTR(13) + l * 128, (char*)lds, tid2);
            }
#endif
            if (BOTH(pb + 3)) GRID_BAR();
        }
        for (int rep = 0; rep < NREP(5); ++rep) if (PH_EN(5) && IN(pb + 4)) { FRESH();
            pg8::Gemm g{ACAT, (const bf16_t*)(ws + WS_WCAT), Mact, 1024, KCAT}; pg8::StaticOrder S; S.init(Mact, 1024, G, bx);
            pg8::EpiBranch E{Gb, Yb};
            pg8::gemm_phase<pg8::EpiBranch, pg8::StaticOrder, true, true>(L, g, S, E, tid);
            if (BOTH(pb + 4)) GRID_BAR();
        }
        for (int rep = 0; rep < (l == 0 ? NREP(6) : 1); ++rep) if (PH_EN(6) && IN(pb + 5)) { FRESH();
            pg8::Gemm g{Yb, (const bf16_t*)(ws + WS_WOUT), Mact, 1024, 1024}; pg8::StaticOrder S; S.init(Mact, 1024, G, bx);
            pg8::EpiRes E{xl, xc, OUTP, XC, mod, 2048};
            pg8::gemm_phase<pg8::EpiRes, pg8::StaticOrder, true, true>(L, g, S, E, tid);
            if (BOTH(pb + 5)) GRID_BAR();
        }
        for (int rep = 0; rep < NREP(7); ++rep) if (PH_EN(7) && IN(pb + 6)) { FRESH(); norm_phase(OUTP, XC, Mact, PTR(5) + l * DM, mod, 3072, 4096, HX, gw, NGW, lane); if (BOTH(pb + 6)) GRID_BAR(); }
        for (int rep = 0; rep < NREP(8); ++rep) if (PH_EN(8) && IN(pb + 7)) { FRESH();
            pg8::Gemm g{HX, (const bf16_t*)(ws + WS_WUPG), Mact, DFF, 1024}; pg8::StaticOrder S; S.init(Mact, DFF, G, bx);
            pg8::EpiBf E{GT, DFF};
            pg8::gemm_phase<pg8::EpiBf, pg8::StaticOrder, true, true>(L, g, S, E, tid);
            if (BOTH(pb + 7)) GRID_BAR();
        }
        for (int rep = 0; rep < NREP(9); ++rep) if (PH_EN(9) && IN(pb + 8)) { FRESH();
            pg8::Gemm g{HX, (const bf16_t*)(ws + WS_WUPV), Mact, DFF, 1024}; pg8::StaticOrder S; S.init(Mact, DFF, G, bx);
            pg8::EpiVal E{GT, Hb, PTR(26) + l * 3 * DFF, PTR(27) + l * DFF};
            pg8::gemm_phase<pg8::EpiVal, pg8::StaticOrder, true, true>(L, g, S, E, tid);
            if (BOTH(pb + 8)) GRID_BAR();
        }
        if (PH_EN(10) && IN(pb + 9)) { FRESH();
            pg8::Gemm g{Hb, (const bf16_t*)(ws + WS_WDN), Mact, 1024, DFF}; pg8::StaticOrder S; S.init(Mact, 1024, G, bx);
            pg8::EpiRes E{OUTP, XC, OUTP, XC, mod, 5120};
            pg8::gemm_phase<pg8::EpiRes, pg8::StaticOrder, true, true>(L, g, S, E, tid);
            if (BOTH(pb + 9)) GRID_BAR();
        }
    }
    if (PH_EN(11) && IN(21)) { FRESH(); final_norm_phase(OUTP, PTR(29), gw, NGW, lane); }
#undef IN
#undef BOTH
#undef mod
#undef xl
#undef xc
#undef ws
#undef MOD
#undef ROPE
#undef TW
#undef XC
#undef HX
#undef FA
#undef Qb
#undef Kb
#undef Vb
#undef Yb
#undef Gb
#undef ACAT
#undef UF
#undef ZG
#undef UP
#undef GT
#undef Hb
#undef PTR
#undef OUTP
#undef WSP
}

extern "C" void kernel_launch(void* const* d_in, const int* in_sizes, int n_in, void* d_out, int out_size, void* d_ws, size_t ws_size, hipStream_t stream) {
    static int grid = 0;
    if (grid == 0) {
        if (n_in != 30 || in_sizes[0] != ML * DM || out_size != ML * DM || ws_size < WS_END) {
            fprintf(stderr, "kernel_launch: unexpected shapes: n_in %d in0 %d out %d ws %zu (need >= %zu)\n", n_in, n_in > 0 ? in_sizes[0] : -1, out_size, ws_size, (size_t)WS_END); grid = -1; return; }
        int dev = 0, cus = 0, per_cu = 0;
        if (hipGetDevice(&dev) != hipSuccess || hipDeviceGetAttribute(&cus, hipDeviceAttributeMultiprocessorCount, dev) != hipSuccess) { grid = -1; return; }
        if (hipFuncSetAttribute((const void*)fwd_kernel, hipFuncAttributeMaxDynamicSharedMemorySize, LDS_BYTES) != hipSuccess) { fprintf(stderr, "kernel_launch: hipFuncSetAttribute failed\n"); grid = -1; return; }
        if (hipOccupancyMaxActiveBlocksPerMultiprocessor(&per_cu, (const void*)fwd_kernel, 512, LDS_BYTES) != hipSuccess || per_cu < 1) {
            fprintf(stderr, "kernel_launch: occupancy query reports %d blocks per CU\n", per_cu); (void)hipGetLastError(); grid = -1; return; }
        grid = cus;
    }
    if (grid < 0) return;
    (void)hipMemsetAsync((char*)d_ws + WS_CTL, 0, CTL_ZERO_BYTES, stream);
    Args a{};
    for (int i = 0; i < 30; ++i) a.in[i] = (const float*)d_in[i];
    a.out = (float*)d_out; a.ws = (unsigned char*)d_ws;
    for (int li = 0; li < MK_N_LAUNCHES; ++li) {
        if (MK_N_LAUNCHES == NPHASE) { a.ph_lo = li; a.ph_hi = li + 1; a.li = 0; }
        else { a.ph_lo = (int)((long)NPHASE * li / MK_N_LAUNCHES); a.ph_hi = (int)((long)NPHASE * (li + 1) / MK_N_LAUNCHES); a.li = li; }
        hipLaunchKernelGGL(fwd_kernel, dim3(grid), dim3(512), LDS_BYTES, stream, a);
    }
}
```

```cpp
#include <hip/hip_runtime.h>
#include <cstdio>
#include <cstdint>

#define LAS __attribute__((address_space(3)))
#define GAS __attribute__((address_space(1)))
typedef unsigned short bf16_t;
typedef short bf16x8 __attribute__((ext_vector_type(8)));
typedef short s16x4 __attribute__((ext_vector_type(4)));
typedef float f32x2 __attribute__((ext_vector_type(2)));
typedef float f32x4 __attribute__((ext_vector_type(4)));
typedef float f32x16 __attribute__((ext_vector_type(16)));
typedef unsigned u32x2 __attribute__((ext_vector_type(2)));
typedef unsigned u32x4 __attribute__((ext_vector_type(4)));

#ifndef ATT_V
#define ATT_V 2
#endif
#ifndef MK_N_LAUNCHES
#define MK_N_LAUNCHES 1
#endif

constexpr int DM = 1024, SEQ = 8192, NBATCH = 2, CTXL = 256;
constexpr int ML = NBATCH * SEQ;
constexpr int MC = NBATCH * CTXL;
constexpr int MT = ML + MC;
constexpr int NIN = 6656, DFF = 2816, KCAT = 1280;
constexpr int KVL = CTXL + SEQ;
constexpr float EPS = 1e-6f;

constexpr size_t MiB = 1u << 20;
constexpr size_t WS_CTL = 0, CTL_ZERO_BYTES = 1 * MiB;
constexpr size_t WS_MOD = 1 * MiB;
constexpr size_t WS_ROPE = WS_MOD + 2 * 3 * 6144 * 4;
constexpr size_t WS_TW = WS_ROPE + 192 * 32 * 4;
constexpr size_t WS_XC = 2 * MiB;
constexpr size_t WS_WA = 4 * MiB;
constexpr size_t WS_WCAT = 17 * MiB;
constexpr size_t WS_WOUT = WS_WCAT + (size_t)1024 * 1280 * 2;
constexpr size_t WS_WUPG = WS_WOUT + (size_t)1024 * 1024 * 2;
constexpr size_t WS_WUPV = WS_WUPG + (size_t)2816 * 1024 * 2;
constexpr size_t WS_WDN = WS_WUPV + (size_t)2816 * 1024 * 2;
constexpr size_t WS_HX = 38 * MiB;
constexpr size_t WS_FA = WS_HX;
constexpr size_t WS_Q = 71 * MiB;
constexpr size_t WS_K = WS_Q + (size_t)MT * 512 * 2;
constexpr size_t WS_V = WS_K + (size_t)MT * 512 * 2;
constexpr size_t WS_Y = 71 * MiB;
constexpr size_t WS_G = 121 * MiB;
constexpr size_t WS_ACAT = 187 * MiB;
constexpr size_t WS_UF = 229 * MiB;
constexpr size_t WS_ZG = WS_UF + (size_t)MT * 256 * 2;
constexpr size_t WS_UP = WS_ZG + (size_t)MT * 256 * 2;
constexpr size_t WS_GT = 71 * MiB;
constexpr size_t WS_H = 162 * MiB;
constexpr size_t WS_END = 256 * MiB;
static_assert(WS_TW + 8192 * 8 <= WS_XC && WS_WDN + (size_t)1024 * 2816 * 2 <= WS_HX && WS_V + (size_t)MT * 512 * 2 <= WS_G && WS_G + (size_t)MT * 4096 <= WS_ACAT, "ws map 1");
static_assert(WS_ACAT + (size_t)MT * 1280 * 2 <= WS_UF && WS_UP + (size_t)MT * 256 * 2 <= WS_END && WS_GT + (size_t)MT * 2816 * 2 <= WS_H && WS_H + (size_t)MT * 2816 * 2 <= WS_END, "ws map 2");
static_assert(WS_HX + (size_t)MT * 1024 * 2 <= WS_Q && (size_t)2 * 4 * 128 * 64 * 64 * 8 <= (size_t)MT * 1024 * 2, "ws map 3");
constexpr int CW_TMO = 0, CW_CODE = 1, CW_BAR = 4096;

constexpr int RING_BYTES = 131072, LDSCTL_OFF = RING_BYTES, MISC_OFF = LDSCTL_OFF + 320, LDS_BYTES = 147456;

typedef __bf16 bf16x2_t __attribute__((ext_vector_type(2)));
__device__ __forceinline__ unsigned cvt2bf(float lo, float hi) { const f32x2 v = {lo, hi}; return __builtin_bit_cast(unsigned, __builtin_convertvector(v, bf16x2_t)); }
template <int M> __device__ __forceinline__ float swz_xor(float v) { return __int_as_float(__builtin_amdgcn_ds_swizzle(__float_as_int(v), (M << 10) | 0x1f)); }
__device__ __forceinline__ float bf2f(unsigned v) { return __uint_as_float(v << 16); }
__device__ __forceinline__ float sigm(float x) { return __builtin_amdgcn_rcpf(1.0f + __builtin_amdgcn_exp2f(x * -1.4426950408889634f)); }
__host__ __device__ __forceinline__ int in_map(int n) {
    if (n < 256) return n;
    if (n < 1280) { const int base = n < 768 ? 256 : 768, r = n - base, comp = r >> 6, p = r & 63, pp = p >> 1, e = p & 1;
        return base + comp * 64 + (pp < 16 ? 0 : 32) + (pp & 15) + 16 * e; }
    if (n < 1792) return n;
    if (n < 2304) { const int r = n - 1792; return 1792 + (r & 1) * 256 + (r >> 1); }
    return n;
}
namespace pg8 {
#define PG8_LAS __attribute__((address_space(3)))
typedef unsigned short bf16_t;
typedef short bf16x8 __attribute__((ext_vector_type(8)));
typedef float f32x4 __attribute__((ext_vector_type(4)));
typedef unsigned u32x4 __attribute__((ext_vector_type(4)));
constexpr int BM = 256, BK = 64, HALF = 128, HTB = HALF * BK * 2  , STAGE_BYTES = 8 * HTB, NXCD = 8, WGM = 8;

__host__ __device__ __forceinline__ int lds_byte(int r, int c) { const int st = (r >> 4) * 2 + (c >> 5), rr = r & 15, cc = c & 31, ob = rr * 64 + cc * 2; return st * 1024 + (ob ^ (((ob >> 9) & 1) << 5)); }
__host__ __device__ __forceinline__ void stage_rc(int b, int& R, int& C) { const int st = b / 1024, sb = b % 1024, swz = sb ^ (((sb >> 9) & 1) << 5); R = (st >> 1) * 16 + swz / 64; C = (st & 1) * 32 + (swz % 64) / 2; }
__host__ __device__ __forceinline__ int perm32(int rho) { const int n = rho >> 4, i = rho & 15; return 8 * (i >> 2) + 4 * n + (i & 3); }

struct Unit { int pm, pn, ko = 0, sl = 0; };
struct Gemm { const bf16_t* A; const bf16_t* Bt; int M, N, K, ld = 0; };

struct StaticOrder {
    int nM, nN, nwg, G, c;
    __host__ __device__ void init(int M, int N, int G_, int c_) { nM = M / BM; nN = N / BM; nwg = nM * nN; G = G_; c = c_; }
    __host__ __device__ bool next(int i, Unit& u) const {
        const long L = (long)i * G + c; if (L >= nwg) return false;
        int wgid = (int)L; { const int q = nwg / NXCD, r = nwg % NXCD, xcd = wgid % NXCD, off = wgid / NXCD; wgid = (xcd < r ? xcd * (q + 1) : r * (q + 1) + (xcd - r) * q) + off; }
        const int nig = WGM * nN, gid = wgid / nig, fm = gid * WGM, gsz = (nM - fm) < WGM ? (nM - fm) : WGM;
        u.pm = fm + ((wgid % nig) % gsz); u.pn = (wgid % nig) / gsz; return true;
    }
    __device__ __forceinline__ void a_ready(const Unit&) const {}
    __device__ __forceinline__ void done(const Unit&) const {}
};
__device__ __forceinline__ unsigned cvt_pk_bf16(float lo, float hi) { return cvt2bf(lo, hi); }
typedef float f32x2 __attribute__((ext_vector_type(2)));
__device__ __forceinline__ f32x2 gelu_pk(f32x2 v) {
    const f32x2 av = __builtin_elementwise_abs(v), d = av * 0.2316418882f + 1.0f;
    f32x2 t; t.x = __builtin_amdgcn_rcpf(d.x); t.y = __builtin_amdgcn_rcpf(d.y);
    f32x2 q = t * 0.5307027145f + (-0.7265760135f); q = q * t + 0.7107068705f; q = q * t + (-0.142248368f); q = q * t + 0.127414796f; q = q * t;
    const f32x2 s = (v * v) * (-0.72134752044f);
    f32x2 e; e.x = __builtin_amdgcn_exp2f(s.x); e.y = __builtin_amdgcn_exp2f(s.y);
    const f32x2 m = v * (q * e), r = v - m;
    f32x2 o; o.x = v.x < 0.f ? m.x : r.x; o.y = v.y < 0.f ? m.y : r.y; return o;
}

typedef unsigned u32x2 __attribute__((ext_vector_type(2)));
__device__ __forceinline__ u32x4 pack8(const f32x4 a, const f32x4 b) { u32x4 w; w.x = cvt_pk_bf16(a[0], a[1]); w.y = cvt_pk_bf16(a[2], a[3]); w.z = cvt_pk_bf16(b[0], b[1]); w.w = cvt_pk_bf16(b[2], b[3]); return w; }

struct EpiIn {
    static constexpr bool PERM = true, AFTER_DRAIN = false, RESCALE = false;
    bf16_t *UF, *ZG, *UP, *Q, *K, *V; unsigned char* G; const float* rope;
    __device__ __forceinline__ void operator()(const f32x4 (&acc)[2][2][4][2], const Unit& u, int wr, int wc, int fr, int fq) const {
        const int pm = u.pm, pn = u.pn; const bool lat = pm < 64; const int R0 = pm * 256;
        const int kv0 = lat ? ((pm >> 5) * 8448 + 256 + ((pm & 31) << 8)) : ((pm - 64) * 8448);
        const int rl = wr * 64 + fr, cl = wc * 32 + 8 * fq;
        if (pn == 0 || pn == 9) {
            bf16_t* dst = (pn == 0 ? UF : UP);
#pragma unroll
            for (int ai = 0; ai < 2; ++ai)
#pragma unroll
                for (int m = 0; m < 4; ++m) { const int rr = ai * 128 + m * 16 + rl;
#pragma unroll
                    for (int bj = 0; bj < 2; ++bj) *(u32x4*)(dst + (size_t)(R0 + rr) * 256 + bj * 128 + cl) = pack8(acc[ai][bj][m][0], acc[ai][bj][m][1]); }
        } else if (pn <= 4) {
            const bool isq = pn <= 2; bf16_t* dst = isq ? Q : K; const int rowbase = isq ? R0 : kv0, colbase = (isq ? pn - 1 : pn - 3) * 256; const float sc = isq ? (ATT_V == 2 ? 0.18033688011112042f : 0.125f) : 1.0f;
#pragma unroll
            for (int ai = 0; ai < 2; ++ai)
#pragma unroll
                for (int m = 0; m < 4; ++m) { const int rr = ai * 128 + m * 16 + rl;
                    f32x4 cs = {1.f, 1.f, 1.f, 1.f}, sn = {0.f, 0.f, 0.f, 0.f};
                    if (lat) { const int t = (R0 & 8191) + rr; const int pos = (wc & 1) ? 128 + (t & 63) : (t >> 6);
                        cs = *(const f32x4*)(rope + pos * 32 + 4 * fq); sn = *(const f32x4*)(rope + pos * 32 + 16 + 4 * fq); }
                    cs = cs * sc; sn = sn * sc;
#pragma unroll
                    for (int bj = 0; bj < 2; ++bj) { const f32x4 a = acc[ai][bj][m][0], b = acc[ai][bj][m][1]; f32x4 oa, ob;
                        oa[0] = a[0] * cs[0] - a[1] * sn[0]; oa[1] = a[1] * cs[0] + a[0] * sn[0]; oa[2] = a[2] * cs[1] - a[3] * sn[1]; oa[3] = a[3] * cs[1] + a[2] * sn[1];
                        ob[0] = b[0] * cs[2] - b[1] * sn[2]; ob[1] = b[1] * cs[2] + b[0] * sn[2]; ob[2] = b[2] * cs[3] - b[3] * sn[3]; ob[3] = b[3] * cs[3] + b[2] * sn[3];
                        *(u32x4*)(dst + (size_t)(rowbase + rr) * 512 + colbase + bj * 128 + cl) = pack8(oa, ob); } }
        } else if (pn <= 6) {
#pragma unroll
            for (int ai = 0; ai < 2; ++ai)
#pragma unroll
                for (int m = 0; m < 4; ++m) { const int rr = ai * 128 + m * 16 + rl;
#pragma unroll
                    for (int bj = 0; bj < 2; ++bj) *(u32x4*)(V + (size_t)(kv0 + rr) * 512 + (pn - 5) * 256 + bj * 128 + cl) = pack8(acc[ai][bj][m][0], acc[ai][bj][m][1]); }
        } else if (pn <= 8) {
#pragma unroll
            for (int ai = 0; ai < 2; ++ai)
#pragma unroll
                for (int m = 0; m < 4; ++m) { const int rr = ai * 128 + m * 16 + rl;
#pragma unroll
                    for (int bj = 0; bj < 2; ++bj) { const f32x4 a = acc[ai][bj][m][0], b = acc[ai][bj][m][1];
                        u32x2 w; w.x = cvt_pk_bf16(a[0] * sigm(a[1]), a[2] * sigm(a[3])); w.y = cvt_pk_bf16(b[0] * sigm(b[1]), b[2] * sigm(b[3]));
                        *(u32x2*)(ZG + (size_t)(R0 + rr) * 256 + (pn - 7) * 128 + bj * 64 + (cl >> 1)) = w; } }
        } else {
#pragma unroll
            for (int ai = 0; ai < 2; ++ai)
#pragma unroll
                for (int m = 0; m < 4; ++m) { const int rr = ai * 128 + m * 16 + rl;
#pragma unroll
                    for (int bj = 0; bj < 2; ++bj) { u32x2 w;
#pragma unroll
                        for (int n = 0; n < 2; ++n) { const f32x4 a = acc[ai][bj][m][n]; unsigned q = 0;
#pragma unroll
                            for (int j = 0; j < 4; ++j) { float s = sigm(a[j]) * 255.0f + 0.5f; s = s < 1.0f ? 1.0f : s; q |= ((unsigned)s) << (8 * j); }
                            if (n == 0) w.x = q; else w.y = q; }
                        *(u32x2*)(G + (size_t)(R0 + rr) * 4096 + (pn - 10) * 256 + bj * 128 + cl) = w; } }
        }
    }
};

struct EpiBf {
    static constexpr bool PERM = true, AFTER_DRAIN = false, RESCALE = false;
    bf16_t* O; int ldc;
    __device__ __forceinline__ void operator()(const f32x4 (&acc)[2][2][4][2], const Unit& u, int wr, int wc, int fr, int fq) const {
        const int row0 = u.pm * 256 + wr * 64 + fr, col0 = u.pn * 256 + wc * 32 + 8 * fq;
#pragma unroll
        for (int ai = 0; ai < 2; ++ai)
#pragma unroll
            for (int m = 0; m < 4; ++m)
#pragma unroll
                for (int bj = 0; bj < 2; ++bj) *(u32x4*)(O + (size_t)(row0 + ai * 128 + m * 16) * ldc + col0 + bj * 128) = pack8(acc[ai][bj][m][0], acc[ai][bj][m][1]);
    }
};

struct EpiRes {
    static constexpr bool PERM = false, AFTER_DRAIN = false, RESCALE = false;
    const float* base_lat; const float* base_ctx; float* out_lat; float* out_ctx; const float* mod; int goff;
    __device__ __forceinline__ void operator()(const f32x4 (&acc)[2][2][4][2], const Unit& u, int wr, int wc, int fr, int fq) const {
        const int pm = u.pm; const bool lat = pm < 64; const int mrow = lat ? (pm >> 5) : 2;
        const float* base = lat ? base_lat + (size_t)pm * 256 * 1024 : base_ctx + (size_t)(pm - 64) * 256 * 1024;
        float* out = lat ? out_lat + (size_t)pm * 256 * 1024 : out_ctx + (size_t)(pm - 64) * 256 * 1024;
        const int col0 = u.pn * 256 + wc * 32 + 4 * fq;
        f32x4 gv[2][2];
#pragma unroll
        for (int bj = 0; bj < 2; ++bj)
#pragma unroll
            for (int n = 0; n < 2; ++n) gv[bj][n] = *(const f32x4*)(mod + mrow * 6144 + goff + col0 + bj * 128 + n * 16);
#pragma unroll
        for (int ai = 0; ai < 2; ++ai)
#pragma unroll
            for (int m = 0; m < 4; ++m) { const size_t ro = (size_t)(ai * 128 + wr * 64 + m * 16 + fr) * 1024 + col0;
#pragma unroll
                for (int bj = 0; bj < 2; ++bj)
#pragma unroll
                    for (int n = 0; n < 2; ++n) { const size_t off = ro + bj * 128 + n * 16; const f32x4 b = *(const f32x4*)(base + off); *(f32x4*)(out + off) = b + gv[bj][n] * acc[ai][bj][m][n]; } }
    }
};

struct EpiVal {
    static constexpr bool PERM = true, AFTER_DRAIN = false, RESCALE = false;
    const bf16_t* GT; bf16_t* H; const float* dww; const float* dwb;
    __device__ __forceinline__ void operator()(const f32x4 (&acc)[2][2][4][2], const Unit& u, int wr, int wc, int fr, int fq) const {
        const int pm = u.pm; const bool lat = pm < 64; const int R0 = pm * 256, t0 = lat ? (R0 & 8191) : 0, L = lat ? 8192 : 256;
        const int rl = wr * 64 + fr;
#pragma unroll
        for (int bj = 0; bj < 2; ++bj) { const int col = u.pn * 256 + bj * 128 + wc * 32 + 8 * fq;
            f32x4 w0[2], w1[2], w2[2], bb[2];
#pragma unroll
            for (int n = 0; n < 2; ++n) { w0[n] = *(const f32x4*)(dww + col + 4 * n); w1[n] = *(const f32x4*)(dww + 2816 + col + 4 * n); w2[n] = *(const f32x4*)(dww + 5632 + col + 4 * n); bb[n] = *(const f32x4*)(dwb + col + 4 * n); }
#pragma unroll
            for (int ai = 0; ai < 2; ++ai) {
#pragma unroll
              for (int mh = 0; mh < 4; mh += 2) {
                u32x4 gm[4], g0[4], gq[4];
#pragma unroll
                for (int m = mh; m < mh + 2; ++m) { const int rr = ai * 128 + m * 16 + rl, t = t0 + rr; const bf16_t* gp = GT + (size_t)(R0 + rr) * 2816 + col;
                    gm[m] = (u32x4){0u, 0u, 0u, 0u}; gq[m] = (u32x4){0u, 0u, 0u, 0u}; g0[m] = *(const u32x4*)gp;
                    if (t > 0) gm[m] = *(const u32x4*)(gp - 2816);
                    if (t < L - 1) gq[m] = *(const u32x4*)(gp + 2816); }
                asm volatile("" ::: "memory");
#pragma unroll
                for (int m = mh; m < mh + 2; ++m) { const int rr = ai * 128 + m * 16 + rl;
                    f32x4 o[2];
#pragma unroll
                    for (int n = 0; n < 2; ++n) { f32x4 c;
#pragma unroll
                        for (int j = 0; j < 4; ++j) { const int e = 4 * n + j; const unsigned wm = gm[m][e >> 1], wz = g0[m][e >> 1], wp = gq[m][e >> 1];
                            const float xm = (e & 1) ? __uint_as_float(wm & 0xffff0000u) : __uint_as_float(wm << 16), xz = (e & 1) ? __uint_as_float(wz & 0xffff0000u) : __uint_as_float(wz << 16),
                                        xp = (e & 1) ? __uint_as_float(wp & 0xffff0000u) : __uint_as_float(wp << 16);
                            c[j] = w0[n][j] * xm + w1[n][j] * xz + w2[n][j] * xp + bb[n][j]; }
                        const f32x2 ga = gelu_pk((f32x2){c[0], c[1]}), gb = gelu_pk((f32x2){c[2], c[3]});
                        const f32x4 v = acc[ai][bj][m][n]; o[n] = (f32x4){v[0] * ga.x, v[1] * ga.y, v[2] * gb.x, v[3] * gb.y}; }
                    *(u32x4*)(H + (size_t)(R0 + rr) * 2816 + col) = pack8(o[0], o[1]); }
                asm volatile("" ::: "memory");
              }
            }
        }
    }
};

struct EpiBranch {
    static constexpr bool PERM = true, AFTER_DRAIN = false, RESCALE = true;
    const unsigned char* G; bf16_t* Y;
    __device__ __forceinline__ void rescale(f32x4 (&acc)[2][2][4][2], const Unit& u, int t, int wr, int wc, int fr, int fq) const {
        const int bp = (t == 4) ? 0 : (t == 12) ? 1 : 2;
        const __amdgpu_buffer_rsrc_t rs = __builtin_amdgcn_make_buffer_rsrc((void*)G, 0, MT * 4096, 0x00020000);
        const int voff = (u.pm * 256 + wr * 64 + fr) * 4096 + u.pn * 256 + wc * 32 + 8 * fq;
#pragma unroll
        for (int ai = 0; ai < 2; ++ai)
#pragma unroll
            for (int m = 0; m < 4; ++m) {
#pragma unroll
                for (int bj = 0; bj < 2; ++bj) { const int so = (ai * 128 + m * 16) * 4096 + bj * 128 + bp * 1024;
                    const u32x2 p = __builtin_bit_cast(u32x2, __builtin_amdgcn_raw_buffer_load_b64(rs, voff, so, 0)), q = __builtin_bit_cast(u32x2, __builtin_amdgcn_raw_buffer_load_b64(rs, voff, so + 1024, 0));
#pragma unroll
                    for (int n = 0; n < 2; ++n) { const unsigned pw = n ? p.y : p.x, qw = n ? q.y : q.x;
#pragma unroll
                        for (int j = 0; j < 4; ++j) acc[ai][bj][m][n][j] *= (float)((pw >> (8 * j)) & 255u) * __builtin_amdgcn_rcpf((float)((qw >> (8 * j)) & 255u)); } }
                asm volatile("" ::: "memory"); }
    }
    __device__ __forceinline__ void operator()(const f32x4 (&acc)[2][2][4][2], const Unit& u, int wr, int wc, int fr, int fq) const {
        const int row0 = u.pm * 256 + wr * 64 + fr, col0 = u.pn * 256 + wc * 32 + 8 * fq;
#pragma unroll
        for (int ai = 0; ai < 2; ++ai)
#pragma unroll
            for (int m = 0; m < 4; ++m)
#pragma unroll
                for (int bj = 0; bj < 2; ++bj) { const size_t r = (size_t)(row0 + ai * 128 + m * 16); const u32x2 p = *(const u32x2*)(G + r * 4096 + 3072 + col0 + bj * 128);
                    f32x4 o[2];
#pragma unroll
                    for (int n = 0; n < 2; ++n) { const unsigned pw = n ? p.y : p.x;
#pragma unroll
                        for (int j = 0; j < 4; ++j) o[n][j] = acc[ai][bj][m][n][j] * ((float)((pw >> (8 * j)) & 255u) * (1.0f / 255.0f)); }
                    *(u32x4*)(Y + r * 1024 + col0 + bj * 128) = pack8(o[0], o[1]); }
    }
};


struct SplitKOrder {
    int nsl, ksl, G, c;
    __device__ __forceinline__ bool next(int i, Unit& u) const { const int L = i * G + c; if (L >= 8 * nsl) return false; u.pm = (L >> 2) & 1; u.pn = L & 3; u.sl = L >> 3; u.ko = u.sl * ksl; return true; }
    __device__ __forceinline__ void a_ready(const Unit&) const {}
    __device__ __forceinline__ void done(const Unit&) const {}
};
struct EpiSlab {
    static constexpr bool PERM = false, AFTER_DRAIN = false, RESCALE = false;
    float* slab;
    __device__ __forceinline__ void operator()(const f32x4 (&acc)[2][2][4][2], const Unit& u, int wr, int wc, int fr, int fq) const {
        float* o = slab + (size_t)u.sl * 512 * 1024 + (size_t)(u.pm * 256 + wr * 64 + fr) * 1024 + u.pn * 256 + wc * 32 + 4 * fq;
#pragma unroll
        for (int ai = 0; ai < 2; ++ai)
#pragma unroll
            for (int m = 0; m < 4; ++m)
#pragma unroll
                for (int bj = 0; bj < 2; ++bj)
#pragma unroll
                    for (int n = 0; n < 2; ++n) *(f32x4*)(o + (size_t)(ai * 128 + m * 16) * 1024 + bj * 128 + n * 16) = acc[ai][bj][m][n];
    }
};
template <class Epi, class Sched, bool ALIGN_EPI = false, bool SP2 = false>
__device__ __forceinline__ void gemm_phase(PG8_LAS unsigned char* lds, const Gemm g, const Sched& S, const Epi& E, const int tid) {
    const int wid = __builtin_amdgcn_readfirstlane(tid >> 6), lane = tid & 63, wr = wid >> 2, wc = wid & 3, fr = lane & 15, fq = lane >> 4;
    const int K = g.ld ? g.ld : g.K  , nt = g.K / BK;
    unsigned voffA[2], voffB[2];
#pragma unroll
    for (int i = 0; i < 2; ++i) { int R, C; stage_rc(tid * 16 + i * 8192, R, C); const int Rb = Epi::PERM ? ((R & ~31) + perm32(R & 31)) : R;
        voffA[i] = (unsigned)(R * K + C) * 2u; voffB[i] = (unsigned)(Rb * K + C) * 2u; }
    const size_t kstep = (size_t)(BK * 2);
    const size_t hstep = (size_t)HALF * K * 2;
    const size_t tstep = 2 * hstep;
    const unsigned ldsw = (unsigned)wid * 1024u;
    const int aoff = lds_byte(wr * 64 + fr, fq * 8), boff = lds_byte(wc * 32 + fr, fq * 8);
#define PG8_SA(b, h) (((b) * 2 + (h)) * HTB)
#define PG8_SB(b, h) ((4 + (b) * 2 + (h)) * HTB)
#define PG8_STAGE(bufoff, gbase, voff) do { _Pragma("unroll") for (int _i = 0; _i < 2; ++_i) \
        __builtin_amdgcn_global_load_lds((const unsigned*)((const char*)(gbase) + (voff)[_i]), (PG8_LAS unsigned*)(lds + (bufoff) + ldsw + _i * 8192), 16, 0, 0); } while (0)
#define PG8_LDA(dst, b, h) do { _Pragma("unroll") for (int m = 0; m < 4; ++m) _Pragma("unroll") for (int k = 0; k < 2; ++k) dst[m][k] = *(const PG8_LAS bf16x8*)(lds + PG8_SA(b, h) + aoff + m * 2048 + k * 1024); } while (0)
#define PG8_LDB(dst, b, h) do { _Pragma("unroll") for (int n = 0; n < 2; ++n) _Pragma("unroll") for (int k = 0; k < 2; ++k) dst[n][k] = *(const PG8_LAS bf16x8*)(lds + PG8_SB(b, h) + boff + n * 2048 + k * 1024); } while (0)
#define PG8_MMA(ai, bj, At, Bt) do { __builtin_amdgcn_s_setprio(1); _Pragma("unroll") for (int m = 0; m < 4; ++m) _Pragma("unroll") for (int n = 0; n < 2; ++n) _Pragma("unroll") for (int k = 0; k < 2; ++k) \
        acc[ai][bj][m][n] = __builtin_amdgcn_mfma_f32_16x16x32_bf16(Bt[n][k], At[m][k], acc[ai][bj][m][n], 0, 0, 0); __builtin_amdgcn_s_setprio(0); } while (0)
#define PG8_WAIT_V(n) asm volatile("s_waitcnt vmcnt(" #n ")" ::: "memory")
#define PG8_WAIT_L(n) asm volatile("s_waitcnt lgkmcnt(" #n ")" ::: "memory")
#define PG8_BAR __builtin_amdgcn_s_barrier()
#define PG8_SCHED __builtin_amdgcn_sched_barrier(0)
    Unit cur, nxt; int ui = 0;
    if (!S.next(0, cur)) return;
    f32x4 acc[2][2][4][2];
#pragma unroll
    for (int a = 0; a < 2; ++a)
#pragma unroll
        for (int b = 0; b < 2; ++b)
#pragma unroll
            for (int m = 0; m < 4; ++m)
#pragma unroll
                for (int n = 0; n < 2; ++n) acc[a][b][m][n] = (f32x4){0.f, 0.f, 0.f, 0.f};
    bf16x8 At[4][2], B0[2][2], B1[2][2];
    const char* cA = (const char*)g.A + (size_t)cur.pm * tstep + (size_t)cur.ko * 2; const char* cB = (const char*)g.Bt + (size_t)cur.pn * tstep + (size_t)cur.ko * 2;
    S.a_ready(cur);
    if constexpr (SP2) {
        PG8_STAGE(PG8_SB(0, 0), cB, voffB); PG8_STAGE(PG8_SB(0, 1), cB + hstep, voffB); PG8_STAGE(PG8_SA(0, 0), cA, voffA); PG8_STAGE(PG8_SA(0, 1), cA + hstep, voffA);
        if (wr == 1) PG8_BAR;
        PG8_WAIT_V(2); PG8_BAR;
        PG8_STAGE(PG8_SB(1, 0), cB + kstep, voffB); PG8_STAGE(PG8_SA(1, 0), cA + kstep, voffA); PG8_STAGE(PG8_SB(1, 1), cB + hstep + kstep, voffB);
        PG8_WAIT_V(6); PG8_BAR;
    } else {
        PG8_STAGE(PG8_SB(0, 0), cB, voffB); PG8_STAGE(PG8_SA(0, 0), cA, voffA); PG8_STAGE(PG8_SB(0, 1), cB + hstep, voffB); PG8_STAGE(PG8_SA(0, 1), cA + hstep, voffA);
        if (wr == 1) PG8_BAR;
        PG8_WAIT_V(4); PG8_BAR;
        PG8_STAGE(PG8_SB(1, 0), cB + kstep, voffB); PG8_STAGE(PG8_SA(1, 0), cA + kstep, voffA); PG8_STAGE(PG8_SB(1, 1), cB + hstep + kstep, voffB);
        PG8_WAIT_V(6); PG8_BAR;
    }
    for (;;) {
        const bool has_next = S.next(ui + 1, nxt);
        const char* nA = has_next ? (const char*)g.A + (size_t)nxt.pm * tstep + (size_t)nxt.ko * 2 : cA; const char* nB = has_next ? (const char*)g.Bt + (size_t)nxt.pn * tstep + (size_t)nxt.ko * 2 : cB;
        for (int t = 0; t < nt; t += 2) {
            if constexpr (Epi::RESCALE) { if (t == 4 || t == 12 || t == 16) E.rescale(acc, cur, t, wr, wc, fr, fq); }
            const bool last = (t == nt - 2);
            const char* a1 = cA + (size_t)(t + 1) * kstep;
            const char* a2 = last ? nA : cA + (size_t)(t + 2) * kstep; const char* b2 = last ? nB : cB + (size_t)(t + 2) * kstep;
            const char* a3 = a2 + kstep; const char* b3 = b2 + kstep;
            if (last && has_next) S.a_ready(nxt);
            if constexpr (SP2) {
            PG8_LDB(B0, 0, 0); PG8_LDB(B1, 0, 1); PG8_SCHED; PG8_LDA(At, 0, 0); PG8_STAGE(PG8_SA(1, 1), a1 + hstep, voffA);
            PG8_WAIT_V(8); PG8_WAIT_L(0); PG8_BAR; PG8_MMA(0, 0, At, B0); PG8_MMA(0, 1, At, B1); PG8_BAR; PG8_SCHED;
            PG8_LDA(At, 0, 1); PG8_STAGE(PG8_SB(0, 0), b2, voffB); PG8_STAGE(PG8_SB(0, 1), b2 + hstep, voffB); PG8_STAGE(PG8_SA(0, 0), a2, voffA);
            PG8_WAIT_V(8); PG8_WAIT_L(0); PG8_BAR; PG8_MMA(1, 0, At, B0); PG8_MMA(1, 1, At, B1); PG8_BAR; PG8_SCHED;
            PG8_LDB(B0, 1, 0); PG8_LDB(B1, 1, 1); PG8_SCHED; PG8_LDA(At, 1, 0); PG8_STAGE(PG8_SA(0, 1), a2 + hstep, voffA);
            PG8_WAIT_V(8); PG8_WAIT_L(0); PG8_BAR; PG8_MMA(0, 0, At, B0); PG8_MMA(0, 1, At, B1); PG8_BAR; PG8_SCHED;
            PG8_LDA(At, 1, 1); PG8_STAGE(PG8_SB(1, 0), b3, voffB); PG8_STAGE(PG8_SB(1, 1), b3 + hstep, voffB); PG8_STAGE(PG8_SA(1, 0), a3, voffA);
            PG8_WAIT_V(8); PG8_WAIT_L(0); PG8_BAR; PG8_MMA(1, 0, At, B0); PG8_MMA(1, 1, At, B1); PG8_BAR; PG8_SCHED;
            } else {
            PG8_LDB(B0, 0, 0); PG8_SCHED; PG8_LDA(At, 0, 0); PG8_STAGE(PG8_SA(1, 1), a1 + hstep, voffA);
            PG8_WAIT_L(8); PG8_BAR; PG8_WAIT_L(0); PG8_MMA(0, 0, At, B0); PG8_BAR; PG8_SCHED;
            PG8_LDB(B1, 0, 1); PG8_STAGE(PG8_SB(0, 0), b2, voffB);
            PG8_BAR; PG8_WAIT_L(0); PG8_MMA(0, 1, At, B1); PG8_BAR;
            PG8_LDA(At, 0, 1); PG8_STAGE(PG8_SA(0, 0), a2, voffA);
            PG8_BAR; PG8_WAIT_L(0); PG8_MMA(1, 0, At, B0); PG8_BAR; PG8_SCHED;
            PG8_STAGE(PG8_SB(0, 1), b2 + hstep, voffB);
            PG8_WAIT_V(6); PG8_BAR; PG8_MMA(1, 1, At, B1); PG8_BAR;
            PG8_LDB(B0, 1, 0); PG8_SCHED; PG8_LDA(At, 1, 0); PG8_STAGE(PG8_SA(0, 1), a2 + hstep, voffA);
            PG8_WAIT_L(8); PG8_BAR; PG8_WAIT_L(0); PG8_MMA(0, 0, At, B0); PG8_BAR; PG8_SCHED;
            PG8_LDB(B1, 1, 1); PG8_STAGE(PG8_SB(1, 0), b3, voffB);
            PG8_BAR; PG8_WAIT_L(0); PG8_MMA(0, 1, At, B1); PG8_BAR;
            PG8_LDA(At, 1, 1); PG8_STAGE(PG8_SA(1, 0), a3, voffA);
            PG8_BAR; PG8_WAIT_L(0); PG8_MMA(1, 0, At, B0); PG8_BAR; PG8_SCHED;
            PG8_STAGE(PG8_SB(1, 1), b3 + hstep, voffB);
            PG8_WAIT_V(6); PG8_BAR; PG8_MMA(1, 1, At, B1); PG8_BAR;
            }
        }
        if constexpr (ALIGN_EPI) { if (wr == 0) PG8_BAR; }
        if constexpr (!Epi::AFTER_DRAIN) { E(acc, cur, wr, wc, fr, fq); S.done(cur); }
        if (!has_next) break;
#pragma unroll
        for (int a = 0; a < 2; ++a)
#pragma unroll
            for (int b = 0; b < 2; ++b)
#pragma unroll
                for (int m = 0; m < 4; ++m)
#pragma unroll
                    for (int n = 0; n < 2; ++n) acc[a][b][m][n] = (f32x4){0.f, 0.f, 0.f, 0.f};
        cur = nxt; cA = nA; cB = nB; ++ui;
        if constexpr (ALIGN_EPI) { if (wr == 1) PG8_BAR; }
    }
    PG8_WAIT_V(0);
    if constexpr (!ALIGN_EPI) { if (wr == 0) PG8_BAR; }
    PG8_BAR;
    if constexpr (Epi::AFTER_DRAIN) { E.fused(acc, cur, wr, wc, fr, fq, lds, wid, lane); S.done(cur); }
#undef PG8_SA
#undef PG8_SB
#undef PG8_STAGE
#undef PG8_LDA
#undef PG8_LDB
#undef PG8_MMA
#undef PG8_WAIT_V
#undef PG8_WAIT_L
#undef PG8_BAR
#undef PG8_SCHED
}
}
namespace att {
constexpr int NW = 8, QBLK = 32, KVBLK = 64, LDQ = 512, LDO = KCAT;
constexpr int SHM_V = 16384, SHM_K = 16384, SHM_ATTN = 3 * SHM_V + 2 * SHM_K + NW * 64 * 4;
constexpr float THR = 8.f;
#ifndef ATT_SDEPTH
#define ATT_SDEPTH 1
#endif
constexpr int SDEPTH = ATT_SDEPTH;
#define KSWZ(row, colB) ((row) * 256 + ((colB) ^ (((row) & 7) << 4)))
#define SBAR() __builtin_amdgcn_sched_barrier(0)
__device__ __forceinline__ int crow(int r, int hi) { return (r & 3) + 8 * (r >> 2) + 4 * hi; }
__device__ __forceinline__ unsigned cvtpk(float lo, float hi) { return cvt2bf(lo, hi); }

__device__ __forceinline__ void partialSM(f32x16& p0, f32x16& p1, float& m_reg, float& mn, float& alpha) {
  constexpr float C = 1.4426950408889634f;
  float pmax = p0[0];
#pragma unroll
  for (int r = 1; r < 16; ++r) pmax = fmaxf(pmax, p0[r]);
#pragma unroll
  for (int r = 0; r < 16; ++r) pmax = fmaxf(pmax, p1[r]);
  { auto rr = __builtin_amdgcn_permlane32_swap(__float_as_uint(pmax), __float_as_uint(pmax), false, false);
    pmax = fmaxf(__uint_as_float(rr[0]), __uint_as_float(rr[1])); }
  if (__builtin_expect(__all(pmax - m_reg <= THR), 1)) { mn = m_reg; alpha = 1.f; }
  else { mn = fmaxf(m_reg, pmax); alpha = __builtin_amdgcn_exp2f((m_reg - mn) * C); m_reg = mn; }
  const float mnC = -mn * C;
#pragma unroll
  for (int r = 0; r < 16; ++r) p0[r] = fmaf(p0[r], C, mnC);
#pragma unroll
  for (int r = 0; r < 16; ++r) p1[r] = fmaf(p1[r], C, mnC);
#pragma unroll
  for (int r = 0; r < 16; ++r) p0[r] = __builtin_amdgcn_exp2f(p0[r]);
}
__device__ __forceinline__ void finishSM(f32x16& p0, f32x16& p1, float alpha, float& l_reg, bf16x8& pa0, bf16x8& pa1, bf16x8& pa2, bf16x8& pa3) {
#pragma unroll
  for (int r = 0; r < 16; ++r) p1[r] = __builtin_amdgcn_exp2f(p1[r]);
  float ps = 0;
#pragma unroll
  for (int r = 0; r < 16; ++r) ps += p0[r];
#pragma unroll
  for (int r = 0; r < 16; ++r) ps += p1[r];
  { auto rr = __builtin_amdgcn_permlane32_swap(__float_as_uint(ps), __float_as_uint(ps), false, false);
    ps = __uint_as_float(rr[0]) + __uint_as_float(rr[1]); }
  l_reg = l_reg * alpha + ps;
#define PK4(P, BASE, OUT) do { unsigned a0 = cvtpk(P[BASE + 0], P[BASE + 1]), a1 = cvtpk(P[BASE + 2], P[BASE + 3]);   \
    unsigned b0 = cvtpk(P[BASE + 4], P[BASE + 5]), b1 = cvtpk(P[BASE + 6], P[BASE + 7]);                              \
    auto r0 = __builtin_amdgcn_permlane32_swap(a0, b0, false, false); auto r1 = __builtin_amdgcn_permlane32_swap(a1, b1, false, false); \
    u32x4 w = {r0[0], r1[0], r0[1], r1[1]}; OUT = *reinterpret_cast<bf16x8*>(&w); } while (0)
  PK4(p0, 0, pa0); PK4(p0, 8, pa1); PK4(p1, 0, pa2); PK4(p1, 8, pa3);
#undef PK4
}
__device__ __forceinline__ void qkt(f32x16& p0, f32x16& p1, const char* Ks, const bf16x8* qr, int r32, int hi, int kcol) {
  p0 = f32x16{}; p1 = f32x16{};
#pragma unroll
  for (int d0 = 0; d0 < 4; ++d0) { const int cb = kcol + (d0 * 16 + hi * 8) * 2;
    const bf16x8 b0 = *reinterpret_cast<const bf16x8*>(Ks + KSWZ(r32, cb));
    const bf16x8 b1 = *reinterpret_cast<const bf16x8*>(Ks + KSWZ(32 + r32, cb));
    p0 = __builtin_amdgcn_mfma_f32_32x32x16_bf16(b0, qr[d0], p0, 0, 0, 0);
    p1 = __builtin_amdgcn_mfma_f32_32x32x16_bf16(b1, qr[d0], p1, 0, 0, 0); }
}
__device__ __forceinline__ int v_st(int k, int c) { const int kk = (k & ~0xC) | ((k & 4) << 1) | ((k & 8) >> 1); return ((kk >> 3) * 4 + (c >> 5)) * 512 + ((kk & 7) * 32 + (c & 31)) * 2; }
__device__ __forceinline__ int v_rd_base(int lane) { return ((lane & 3) << 3) | (((lane >> 2) & 3) << 6) | (((lane >> 4) & 1) << 5) | (((lane >> 5) & 1) << 8); }
constexpr int v_rd_off(int d0, int ks, int half) { return d0 * 512 + ks * 4096 + half * 2048; }
template <int OFF> __device__ __forceinline__ s16x4 tr_read(int vb) {
  s16x4 r; asm volatile("ds_read_b64_tr_b16 %0, %1 offset:%2" : "=&v"(r) : "v"(vb), "i"(OFF) : "memory"); return r;
}
template <int D0> __device__ __forceinline__ void pv_one(f32x16& od, int vb, bf16x8 pa0, bf16x8 pa1, bf16x8 pa2, bf16x8 pa3) {
  const s16x4 l0 = tr_read<v_rd_off(D0, 0, 0)>(vb), h0 = tr_read<v_rd_off(D0, 0, 1)>(vb), l1 = tr_read<v_rd_off(D0, 1, 0)>(vb), h1 = tr_read<v_rd_off(D0, 1, 1)>(vb);
  const s16x4 l2 = tr_read<v_rd_off(D0, 2, 0)>(vb), h2 = tr_read<v_rd_off(D0, 2, 1)>(vb), l3 = tr_read<v_rd_off(D0, 3, 0)>(vb), h3 = tr_read<v_rd_off(D0, 3, 1)>(vb);
  asm volatile("s_waitcnt lgkmcnt(0)" ::: "memory"); SBAR();
#define PK(L, H) (bf16x8){L[0], L[1], L[2], L[3], H[0], H[1], H[2], H[3]}
  od = __builtin_amdgcn_mfma_f32_32x32x16_bf16(pa0, PK(l0, h0), od, 0, 0, 0);
  od = __builtin_amdgcn_mfma_f32_32x32x16_bf16(pa1, PK(l1, h1), od, 0, 0, 0);
  od = __builtin_amdgcn_mfma_f32_32x32x16_bf16(pa2, PK(l2, h2), od, 0, 0, 0);
  od = __builtin_amdgcn_mfma_f32_32x32x16_bf16(pa3, PK(l3, h3), od, 0, 0, 0);
#undef PK
}
__device__ __forceinline__ void pv_d0(f32x16* o, int vb, bf16x8 pa0, bf16x8 pa1, bf16x8 pa2, bf16x8 pa3) {
  pv_one<0>(o[0], vb, pa0, pa1, pa2, pa3); pv_one<1>(o[1], vb, pa0, pa1, pa2, pa3); pv_one<2>(o[2], vb, pa0, pa1, pa2, pa3); pv_one<3>(o[3], vb, pa0, pa1, pa2, pa3);
}

template <int VAR>
__device__ __forceinline__ void attn_unit(const bf16_t* __restrict__ Qb, const bf16_t* __restrict__ Kh, const bf16_t* __restrict__ Vh, int nkeys,
                                          bf16_t* __restrict__ Ob, float lam, float osc, const float* __restrict__ sg, char* lds, const int tid) {
  const int wid = __builtin_amdgcn_readfirstlane(tid >> 6), lane = tid & 63, r32 = lane & 31, hi = lane >> 5;
  const int comp = wid >> 2, qw = wid & 3, kcol = comp * 128;
  char* K_lds = lds; char* V_lds = lds + 2 * SHM_K;
  float* ws = (float*)(lds + 2 * SHM_K + 3 * SHM_V) + wid * 64; float* li_l = ws; float* al_l = ws + 32;
  float m_reg = -1e30f, l_reg = 0; f32x16 o[4] = {}; bf16x8 qr[4];
  const bf16_t* Qw = Qb + (long)(qw * QBLK + r32) * LDQ + comp * 64 + hi * 8;
#pragma unroll
  for (int d0 = 0; d0 < 4; ++d0) qr[d0] = *reinterpret_cast<const bf16x8*>(Qw + d0 * 16);
  const int sr = tid >> 4, sc = (tid & 15) * 8, vst0 = v_st(sr, sc), vst1 = v_st(32 + sr, sc);
  const int vb0 = (int)(uintptr_t)V_lds + v_rd_base(lane);
  bf16x8 sk0 = {}, sk1 = {}, sv0 = {}, sv1 = {};
#define LOADK(t) do { if constexpr (!(VAR & 8)) { sk0 = *reinterpret_cast<const bf16x8*>(&Kh[(long)((t) * KVBLK + sr) * LDQ + sc]); sk1 = *reinterpret_cast<const bf16x8*>(&Kh[(long)((t) * KVBLK + 32 + sr) * LDQ + sc]); } } while (0)
#define LOADV(t) do { if constexpr (!(VAR & 8)) { sv0 = *reinterpret_cast<const bf16x8*>(&Vh[(long)((t) * KVBLK + sr) * LDQ + sc]); sv1 = *reinterpret_cast<const bf16x8*>(&Vh[(long)((t) * KVBLK + 32 + sr) * LDQ + sc]); } } while (0)
#define WRITEK(slot) do { if constexpr (!(VAR & 8)) { *(bf16x8*)(K_lds + (slot) * SHM_K + KSWZ(sr, sc * 2)) = sk0; *(bf16x8*)(K_lds + (slot) * SHM_K + KSWZ(32 + sr, sc * 2)) = sk1; } } while (0)
#define WRITEV(off) do { if constexpr (!(VAR & 8)) { *(bf16x8*)(V_lds + (off) + vst0) = sv0; *(bf16x8*)(V_lds + (off) + vst1) = sv1; } } while (0)
#define VMW() asm volatile("s_waitcnt vmcnt(0)" ::: "memory")
#define QKT(P0, P1, KS) do { if constexpr (VAR & 4) { P0 = f32x16{}; P1 = f32x16{}; asm volatile("" : "+v"(P0), "+v"(P1)); } else qkt(P0, P1, KS, qr, r32, hi, kcol); } while (0)
#define PSM(P0, P1, MN, AL) do { if constexpr (VAR & 1) { MN = m_reg; AL = 1.f; asm volatile("" : "+v"(P0), "+v"(P1)); } else partialSM(P0, P1, m_reg, MN, AL); } while (0)
#define FSM(P0, P1, AL) do { if constexpr (VAR & 1) { asm volatile("" : "+v"(P0), "+v"(P1)); pa0 = __builtin_bit_cast(bf16x8, (f32x4){P0[0], P0[1], P0[2], P0[3]}); pa1 = __builtin_bit_cast(bf16x8, (f32x4){P0[4], P0[5], P0[6], P0[7]}); pa2 = __builtin_bit_cast(bf16x8, (f32x4){P1[0], P1[1], P1[2], P1[3]}); pa3 = __builtin_bit_cast(bf16x8, (f32x4){P1[4], P1[5], P1[6], P1[7]}); } else finishSM(P0, P1, AL, l_reg, pa0, pa1, pa2, pa3); } while (0)
#define PV(OFF) do { if constexpr (VAR & 2) { asm volatile("" : "+v"(pa0), "+v"(pa1), "+v"(pa2), "+v"(pa3)); } else pv_d0(o, vb0 + (OFF), pa0, pa1, pa2, pa3); } while (0)
#define RESC(a) do { if (__any((a) < 1.f)) { if (hi == 0) al_l[r32] = (a); asm volatile("s_waitcnt lgkmcnt(0)" ::: "memory"); \
    _Pragma("unroll") for (int d = 0; d < 4; ++d) _Pragma("unroll") for (int r = 0; r < 16; ++r) o[d][r] *= al_l[crow(r, hi)]; } } while (0)
  f32x16 pA0, pA1, pB0, pB1; float mnA, mnB, alA, alB; bf16x8 pa0, pa1, pa2, pa3; const int NT = nkeys / KVBLK;
  LOADK(0); VMW(); WRITEK(0); LOADK(1); LOADV(0);
  __syncthreads();
  if (comp == 1) __syncthreads();
  VMW(); WRITEK(1); WRITEV(0);
  SBAR(); QKT(pA0, pA1, K_lds); SBAR();
  __syncthreads();
  LOADK(2); LOADV(1); SBAR();
  PSM(pA0, pA1, mnA, alA);
  __syncthreads();
  int va = 0, vb = SHM_V, vc = 2 * SHM_V;
  for (int j = 1; j + 1 < NT; j += 2) {
    VMW(); WRITEK(0); WRITEV(vb);
    SBAR(); QKT(pB0, pB1, K_lds + SHM_K);
    FSM(pA0, pA1, alA); SBAR();
    __syncthreads();
    LOADK(j + 2); LOADV(j + 1); SBAR();
    PV(va); PSM(pB0, pB1, mnB, alB);
    RESC(alB);
    __syncthreads();
    VMW(); WRITEK(1); WRITEV(vc);
    SBAR(); QKT(pA0, pA1, K_lds);
    FSM(pB0, pB1, alB); SBAR();
    __syncthreads();
    if (j + 3 < NT) LOADK(j + 3);
    LOADV(j + 2); SBAR();
    PV(vb); PSM(pA0, pA1, mnA, alA);
    RESC(alA);
    __syncthreads();
    { const int t = va; va = vc; vc = vb; vb = t; }
  }
  VMW(); WRITEV(vb);
  SBAR(); QKT(pB0, pB1, K_lds + SHM_K);
  FSM(pA0, pA1, alA); SBAR();
  __syncthreads();
  PV(va); PSM(pB0, pB1, mnB, alB);
  RESC(alB);
  __syncthreads();
  FSM(pB0, pB1, alB); SBAR();
  PV(vb);
  if (comp == 0) __syncthreads();
  if (hi == 0) li_l[r32] = l_reg; asm volatile("s_waitcnt lgkmcnt(0)" ::: "memory");
  float rli[16];
#pragma unroll
  for (int r = 0; r < 16; ++r) rli[r] = __builtin_amdgcn_rcpf(li_l[crow(r, hi)]);
  __syncthreads();
  float* XO = (float*)lds + qw * (32 * 128);
  if (comp == 1) {
#pragma unroll
    for (int r = 0; r < 16; ++r)
#pragma unroll
      for (int d0 = 0; d0 < 4; ++d0) XO[crow(r, hi) * 128 + d0 * 32 + r32] = o[d0][r] * rli[r];
  }
  __syncthreads();
  if (comp == 0) {
    float ss[16];
#pragma unroll
    for (int r = 0; r < 16; ++r) { float s = 0.f;
#pragma unroll
      for (int d0 = 0; d0 < 4; ++d0) { const float v = o[d0][r] * rli[r] - lam * XO[crow(r, hi) * 128 + d0 * 32 + r32]; o[d0][r] = v; s += v * v; }
      ss[r] = s; }
#pragma unroll
    for (int r = 0; r < 16; ++r) { float s = ss[r]; s += swz_xor<1>(s); s += swz_xor<2>(s); s += swz_xor<4>(s); s += swz_xor<8>(s); s += swz_xor<16>(s);
      ss[r] = osc / sqrtf(s * (1.0f / 128.0f) + EPS); }
    float gam[4];
#pragma unroll
    for (int d0 = 0; d0 < 4; ++d0) gam[d0] = sg[d0 * 32 + r32];
    asm volatile("s_waitcnt lgkmcnt(0)" ::: "memory");
    bf16_t* stg = (bf16_t*)XO;
#pragma unroll
    for (int r = 0; r < 16; ++r)
#pragma unroll
      for (int d0 = 0; d0 < 4; ++d0) stg[crow(r, hi) * 128 + d0 * 32 + r32] = (bf16_t)(cvtpk(o[d0][r] * ss[r] * gam[d0], 0.f) & 0xffffu);
    asm volatile("s_waitcnt lgkmcnt(0)" ::: "memory");
#pragma unroll
    for (int i = 0; i < 8; ++i) { const int row = i * 4 + (lane >> 4), ch = lane & 15; const u32x4 v = *(const u32x4*)(stg + row * 128 + ch * 8);
      if constexpr (VAR & 16) { asm volatile("" :: "v"(v.x), "v"(v.y), "v"(v.z), "v"(v.w)); } else *(u32x4*)(Ob + (long)(qw * QBLK + row) * LDO + ch * 8) = v; }
  }
  __syncthreads();
#undef LOADK
#undef LOADV
#undef WRITEK
#undef WRITEV
#undef VMW
#undef QKT
#undef PSM
#undef FSM
#undef PV
#undef RESC
}
#undef KSWZ
#undef SBAR
}
namespace att2 {
using att::crow; using att::v_st; using att::v_rd_base; using att::v_rd_off;
constexpr int NW = 8, QBLK = 32, KVBLK = 64, LDQ = 512, LDO = KCAT, SHM_K = 16384, SHM_V = 16384;
constexpr float THRL = 8.0f;
#ifndef ATT_STAGGER
#define ATT_STAGGER 1
#endif
typedef short v4i16_t __attribute__((ext_vector_type(4)));
typedef __attribute__((address_space(3))) const char* lds_cptr;
typedef __attribute__((address_space(3))) char* lds_ptr;
#define SBAR() __builtin_amdgcn_sched_barrier(0)
#define KSWZ(row, colB) ((row) * 256 + ((colB) ^ (((row) & 7) << 4)))
__device__ __forceinline__ s16x4 vtr(lds_cptr p) { return __builtin_bit_cast(s16x4, __builtin_amdgcn_ds_read_tr16_b64_v4i16((__attribute__((address_space(3))) v4i16_t*)p)); }
__device__ __forceinline__ bf16x8 ldk(lds_cptr p) { return *(const __attribute__((address_space(3))) bf16x8*)p; }
#define MF(D, A, B, C) do { if constexpr (VAR & 4) { asm volatile("" : "+v"(D)); } else D = __builtin_amdgcn_mfma_f32_32x32x16_bf16(A, B, C, 0, 0, 0); } while (0)
#define VF(L, H) (bf16x8){L[0], L[1], L[2], L[3], H[0], H[1], H[2], H[3]}

__device__ __forceinline__ int vkey(int g) { const int s_ = g >> 5, kk = ((s_ >> 2) << 3) | ((g >> 2) & 7); return (kk & ~0xC) | ((kk & 4) << 1) | ((kk & 8) >> 1); }
template <int VAR>
__device__ __forceinline__ void attn_unit(const bf16_t* __restrict__ Qb, const bf16_t* __restrict__ Kh, const bf16_t* __restrict__ Vh, int nkeys,
                                          bf16_t* __restrict__ Ob, float lam, float osc, const float* __restrict__ sg, char* lds, const int tid) {
  const int wid = __builtin_amdgcn_readfirstlane(tid >> 6), lane = tid & 63, r32 = lane & 31, hi = lane >> 5;
  const int comp = wid >> 2, qw = wid & 3, kcol = comp * 128;
  const lds_ptr L3 = (lds_ptr)(unsigned)(uintptr_t)lds;
  float* ws = (float*)(lds + 3 * SHM_K + 3 * SHM_V) + wid * 64; float* li_l = ws; float* al_l = ws + 32;
  float mhat = 0.f, l_reg = 0.f; f32x16 o[4] = {}; bf16x8 qr[4]; f32x16 negm = {};
  const bf16_t* Qw = Qb + (long)(qw * QBLK + r32) * LDQ + comp * 64 + hi * 8;
#pragma unroll
  for (int d0 = 0; d0 < 4; ++d0) qr[d0] = *reinterpret_cast<const bf16x8*>(Qw + d0 * 16);
  const int sr = tid >> 4, sc = (tid & 15) * 8;
  const int kr0 = 4 * wid + (lane >> 4), kr1 = kr0 + 32;
  const bf16_t* ksrc0 = Kh + (long)kr0 * LDQ + (((lane & 15) ^ (kr0 & 7)) << 3); const bf16_t* ksrc1 = Kh + (long)kr1 * LDQ + (((lane & 15) ^ (kr1 & 7)) << 3);
  const int g0_ = 64 * wid + lane, g1_ = g0_ + 512;
  const int vk0 = vkey(g0_), vk1 = vkey(g1_);
  const bf16_t* vsrc0 = Vh + (long)vk0 * LDQ + ((g0_ >> 5) & 3) * 32 + (g0_ & 3) * 8; const bf16_t* vsrc1 = Vh + (long)vk1 * LDQ + ((g1_ >> 5) & 3) * 32 + (g1_ & 3) * 8;
  const unsigned kd0 = (unsigned)(uintptr_t)lds + wid * 1024, kd1 = kd0 + 8192, vd0 = (unsigned)(uintptr_t)lds + 3 * SHM_K + wid * 1024, vd1 = vd0 + 8192;
  lds_cptr kq[4];
#pragma unroll
  for (int d0 = 0; d0 < 4; ++d0) kq[d0] = L3 + r32 * 256 + ((kcol + d0 * 32 + hi * 16) ^ ((r32 & 7) << 4));
  const lds_cptr vp0 = L3 + 3 * SHM_K + v_rd_base(lane);
#define GLDS(src, dst) __builtin_amdgcn_global_load_lds((const unsigned*)(src), (__attribute__((address_space(3))) unsigned*)(dst), 16, 0, 0)
#define DMAK(t, slot) do { if constexpr (!(VAR & 8)) { GLDS(ksrc0 + (long)(t) * KVBLK * LDQ, (unsigned)__builtin_amdgcn_readfirstlane(kd0 + (slot) * SHM_K)); GLDS(ksrc1 + (long)(t) * KVBLK * LDQ, (unsigned)__builtin_amdgcn_readfirstlane(kd1 + (slot) * SHM_K)); } } while (0)
#define DMAV(t, off) do { if constexpr (!(VAR & 8)) { GLDS(vsrc0 + (long)(t) * KVBLK * LDQ, (unsigned)__builtin_amdgcn_readfirstlane(vd0 + (off))); GLDS(vsrc1 + (long)(t) * KVBLK * LDQ, (unsigned)__builtin_amdgcn_readfirstlane(vd1 + (off))); } } while (0)
#ifndef ATT_PRIO
#define ATT_PRIO 1
#endif
#define PRIO(x) do { if (ATT_PRIO == 1) __builtin_amdgcn_s_setprio(x); } while (0)
#define PRIO1(x) do { if (ATT_PRIO == 2) __builtin_amdgcn_s_setprio(x); } while (0)
#define VMW() asm volatile("s_waitcnt vmcnt(0)" ::: "memory")
#define BARW(n) do { asm volatile("s_waitcnt vmcnt(" #n ") lgkmcnt(0)" ::: "memory"); __builtin_amdgcn_s_barrier(); asm volatile("" ::: "memory"); } while (0)
  f32x16 pA0, pA1, pB0, pB1; u32x4 pw0 = {}, pw1 = {}, pw2 = {}, pw3 = {}; const int NT = nkeys / KVBLK; bool resc = false;
#define KF(KOFF, d0, half) ldk(kq[d0] + (KOFF) + 8192 * (half))
#define PKA(P, B, A0, A1) do { if constexpr (!(VAR & 1)) { A0 = cvt2bf(P[B + 0], P[B + 1]); A1 = cvt2bf(P[B + 2], P[B + 3]); sacc += P[B + 0]; sacc += P[B + 1]; sacc += P[B + 2]; sacc += P[B + 3]; } } while (0)
#define PKB(P, B, A0, A1, PW) do { if constexpr (!(VAR & 1)) { const unsigned b0_ = cvt2bf(P[B + 4], P[B + 5]), b1_ = cvt2bf(P[B + 6], P[B + 7]); \
    auto r0_ = __builtin_amdgcn_permlane32_swap(A0, b0_, false, false); auto r1_ = __builtin_amdgcn_permlane32_swap(A1, b1_, false, false); \
    PW = (u32x4){r0_[0], r1_[0], r0_[1], r1_[1]}; sacc += P[B + 4]; sacc += P[B + 5]; sacc += P[B + 6]; sacc += P[B + 7]; } } while (0)
#define H1(C0, C1, P0, P1, KOFF, FIN) do { \
    float sacc = 0.f; unsigned a0_ = 0, a1_ = 0; \
    bf16x8 f0 = KF(KOFF, 0, 0), f1 = KF(KOFF, 0, 1), f2 = KF(KOFF, 1, 0); SBAR(); \
    MF(C0, f0, qr[0], negm); { f0 = KF(KOFF, 1, 1); if (FIN) PKA(P0, 0, a0_, a1_); } SBAR(); \
    MF(C1, f1, qr[0], negm); { f1 = KF(KOFF, 2, 0); if (FIN) PKB(P0, 0, a0_, a1_, pw0); } SBAR(); \
    MF(C0, f2, qr[1], C0);   { f2 = KF(KOFF, 2, 1); if (FIN) PKA(P0, 8, a0_, a1_); } SBAR(); \
    MF(C1, f0, qr[1], C1);   { f0 = KF(KOFF, 3, 0); if (FIN) PKB(P0, 8, a0_, a1_, pw1); } SBAR(); \
    MF(C0, f1, qr[2], C0);   { f1 = KF(KOFF, 3, 1); if (FIN) PKA(P1, 0, a0_, a1_); } SBAR(); \
    MF(C1, f2, qr[2], C1);   { if (FIN) PKB(P1, 0, a0_, a1_, pw2); } SBAR(); \
    MF(C0, f0, qr[3], C0);   { if (FIN) PKA(P1, 8, a0_, a1_); } SBAR(); \
    MF(C1, f1, qr[3], C1);   { if (FIN) PKB(P1, 8, a0_, a1_, pw3); } SBAR(); \
    if (FIN) { auto rr_ = __builtin_amdgcn_permlane32_swap(__float_as_uint(sacc), __float_as_uint(sacc), false, false); l_reg += __uint_as_float(rr_[0]) + __uint_as_float(rr_[1]); } \
  } while (0)
#define VRD(VOFF, ks, d0, LO, HI) do { LO = vtr(vp0 + (VOFF) + v_rd_off(d0, ks, 0)); HI = vtr(vp0 + (VOFF) + v_rd_off(d0, ks, 1)); } while (0)
#define PAF(k) __builtin_bit_cast(bf16x8, pw##k)
#define MX3(a, b, c) ((VAR & 2) ? (a) : fmaxf(fmaxf((a), (b)), (c)))
#define EX(X, i) do { if constexpr (!(VAR & 2)) X[i] = __builtin_amdgcn_exp2f(X[i]); } while (0)
#define PIN2(X, Y) asm volatile("" : "+v"(X), "+v"(Y))
#define H2(C0, C1, VOFF, DOPV, FIRST) do { \
    s16x4 l0, h0, l1, h1, l2, h2; float ma, mb, rm; \
    if (DOPV) { VRD(VOFF, 0, 0, l0, h0); VRD(VOFF, 0, 1, l1, h1); VRD(VOFF, 0, 2, l2, h2); } SBAR(); \
    if (DOPV) { MF(o[0], PAF(0), VF(l0, h0), o[0]); VRD(VOFF, 0, 3, l0, h0); } ma = MX3(C0[0], C0[1], C1[0]); mb = MX3(C0[2], C0[3], C1[1]); ma = MX3(ma, C1[2], C1[3]); mb = MX3(mb, C0[4], C0[5]); SBAR(); \
    if (DOPV) { MF(o[1], PAF(0), VF(l1, h1), o[1]); VRD(VOFF, 1, 0, l1, h1); } ma = MX3(ma, C0[6], C0[7]); mb = MX3(mb, C1[4], C1[5]); ma = MX3(ma, C1[6], C1[7]); mb = MX3(mb, C0[8], C0[9]); SBAR(); \
    if (DOPV) { MF(o[2], PAF(0), VF(l2, h2), o[2]); VRD(VOFF, 1, 1, l2, h2); } ma = MX3(ma, C0[10], C0[11]); mb = MX3(mb, C1[8], C1[9]); ma = MX3(ma, C1[10], C1[11]); mb = MX3(mb, C0[12], C0[13]); SBAR(); \
    if (DOPV) { MF(o[3], PAF(0), VF(l0, h0), o[3]); VRD(VOFF, 1, 2, l0, h0); } ma = MX3(ma, C0[14], C0[15]); mb = MX3(mb, C1[12], C1[13]); ma = MX3(ma, C1[14], C1[15]); rm = fmaxf(ma, mb); SBAR(); \
    if (DOPV) { MF(o[0], PAF(1), VF(l1, h1), o[0]); VRD(VOFF, 1, 3, l1, h1); } \
    { auto rr_ = __builtin_amdgcn_permlane32_swap(__float_as_uint(rm), __float_as_uint(rm), false, false); rm = fmaxf(__uint_as_float(rr_[0]), __uint_as_float(rr_[1])); } SBAR(); \
    resc = false; \
    if (FIRST || __builtin_expect(__any(rm > THRL), 0)) { const float dl = FIRST ? rm : fmaxf(rm, 0.f); mhat += dl; \
      _Pragma("unroll") for (int r = 0; r < 16; ++r) { C0[r] -= dl; C1[r] -= dl; } \
      _Pragma("unroll") for (int r = 0; r < 16; ++r) negm[r] = -mhat; \
      if (!(FIRST)) { const float f = __builtin_amdgcn_exp2f(-dl); l_reg *= f; if (hi == 0) al_l[r32] = f; resc = true; } } \
    SBAR(); \
    if (DOPV) { MF(o[1], PAF(1), VF(l2, h2), o[1]); VRD(VOFF, 2, 0, l2, h2); } EX(C0, 0); EX(C0, 1); EX(C0, 2); PIN2(C0, C1); SBAR(); \
    if (DOPV) { MF(o[2], PAF(1), VF(l0, h0), o[2]); VRD(VOFF, 2, 1, l0, h0); } EX(C0, 3); EX(C0, 4); EX(C0, 5); PIN2(C0, C1); SBAR(); \
    if (DOPV) { MF(o[3], PAF(1), VF(l1, h1), o[3]); VRD(VOFF, 2, 2, l1, h1); } EX(C0, 6); EX(C0, 7); EX(C0, 8); PIN2(C0, C1); SBAR(); \
    if (DOPV) { MF(o[0], PAF(2), VF(l2, h2), o[0]); VRD(VOFF, 2, 3, l2, h2); } EX(C0, 9); EX(C0, 10); EX(C0, 11); PIN2(C0, C1); SBAR(); \
    if (DOPV) { MF(o[1], PAF(2), VF(l0, h0), o[1]); VRD(VOFF, 3, 0, l0, h0); } EX(C0, 12); EX(C0, 13); EX(C0, 14); PIN2(C0, C1); SBAR(); \
    if (DOPV) { MF(o[2], PAF(2), VF(l1, h1), o[2]); VRD(VOFF, 3, 1, l1, h1); } EX(C0, 15); EX(C1, 0); EX(C1, 1); PIN2(C0, C1); SBAR(); \
    if (DOPV) { MF(o[3], PAF(2), VF(l2, h2), o[3]); VRD(VOFF, 3, 2, l2, h2); } EX(C1, 2); EX(C1, 3); EX(C1, 4); PIN2(C0, C1); SBAR(); \
    if (DOPV) { MF(o[0], PAF(3), VF(l0, h0), o[0]); VRD(VOFF, 3, 3, l0, h0); } EX(C1, 5); EX(C1, 6); EX(C1, 7); PIN2(C0, C1); SBAR(); \
    if (DOPV) { MF(o[1], PAF(3), VF(l1, h1), o[1]); } EX(C1, 8); EX(C1, 9); EX(C1, 10); PIN2(C0, C1); SBAR(); \
    if (DOPV) { MF(o[2], PAF(3), VF(l2, h2), o[2]); } EX(C1, 11); EX(C1, 12); EX(C1, 13); PIN2(C0, C1); SBAR(); \
    if (DOPV) { MF(o[3], PAF(3), VF(l0, h0), o[3]); } EX(C1, 14); EX(C1, 15); PIN2(C0, C1); SBAR(); \
    if (resc) { asm volatile("s_waitcnt lgkmcnt(0)" ::: "memory"); \
      _Pragma("unroll") for (int d = 0; d < 4; ++d) _Pragma("unroll") for (int r = 0; r < 16; ++r) o[d][r] *= al_l[crow(r, hi)]; } \
  } while (0)
#define PVONLY(VOFF) do { _Pragma("unroll") for (int ks = 0; ks < 4; ++ks) _Pragma("unroll") for (int d0 = 0; d0 < 4; ++d0) { s16x4 l_, h_; VRD(VOFF, ks, d0, l_, h_); \
      const bf16x8 pa_ = ks == 0 ? PAF(0) : ks == 1 ? PAF(1) : ks == 2 ? PAF(2) : PAF(3); MF(o[d0], pa_, VF(l_, h_), o[d0]); } } while (0)

  DMAK(0, 0); DMAK(1, 1); DMAV(0, 0);
  BARW(0);
  if (ATT_STAGGER && comp == 1) __builtin_amdgcn_s_barrier();
  H1(pA0, pA1, pB0, pB1, 0, false);
  BARW(0);
  DMAK(2, 2); DMAV(1, SHM_V); SBAR();
  H2(pA0, pA1, 0, false, true);
  BARW(4);
  int va = 0, vb = SHM_V, vc = 2 * SHM_V;
  for (int j = 1; j + 1 < NT; j += 2) {
    PRIO1(1); H1(pB0, pB1, pA0, pA1, vb, true); PRIO1(0);
    BARW(0);
    DMAK(j + 2, va >> 14); DMAV(j + 1, vc); SBAR();
    PRIO(1); H2(pB0, pB1, va, true, false); PRIO(0);
    BARW(4);
    PRIO1(1); H1(pA0, pA1, pB0, pB1, vc, true); PRIO1(0);
    BARW(0);
    if (j + 3 < NT) DMAK(j + 3, vb >> 14);
    DMAV(j + 2, va); SBAR();
    PRIO(1); H2(pA0, pA1, vb, true, false); PRIO(0);
    BARW(4);
    { const int t = va; va = vc; vc = vb; vb = t; }
  }
  H1(pB0, pB1, pA0, pA1, vb, true);
  BARW(0);
  H2(pB0, pB1, va, true, false);
  BARW(0);
  { float sacc = 0.f; unsigned a0_ = 0, a1_ = 0;
    PKA(pB0, 0, a0_, a1_); PKB(pB0, 0, a0_, a1_, pw0); PKA(pB0, 8, a0_, a1_); PKB(pB0, 8, a0_, a1_, pw1); PKA(pB1, 0, a0_, a1_); PKB(pB1, 0, a0_, a1_, pw2); PKA(pB1, 8, a0_, a1_); PKB(pB1, 8, a0_, a1_, pw3);
    auto rr_ = __builtin_amdgcn_permlane32_swap(__float_as_uint(sacc), __float_as_uint(sacc), false, false); l_reg += __uint_as_float(rr_[0]) + __uint_as_float(rr_[1]); }
  SBAR(); PVONLY(vb);
  if (ATT_STAGGER && comp == 0) { asm volatile("s_waitcnt lgkmcnt(0)" ::: "memory"); __builtin_amdgcn_s_barrier(); }
  if (hi == 0) li_l[r32] = l_reg; asm volatile("s_waitcnt lgkmcnt(0)" ::: "memory");
  float rli[16];
#pragma unroll
  for (int r = 0; r < 16; ++r) rli[r] = __builtin_amdgcn_rcpf(li_l[crow(r, hi)]);
  __syncthreads();
  float* XO = (float*)lds + qw * (32 * 128);
  if (comp == 1) {
#pragma unroll
    for (int r = 0; r < 16; ++r)
#pragma unroll
      for (int d0 = 0; d0 < 4; ++d0) XO[crow(r, hi) * 128 + d0 * 32 + r32] = o[d0][r] * rli[r];
  }
  __syncthreads();
  if (comp == 0) {
    float ss[16];
#pragma unroll
    for (int r = 0; r < 16; ++r) { float s = 0.f;
#pragma unroll
      for (int d0 = 0; d0 < 4; ++d0) { const float v = o[d0][r] * rli[r] - lam * XO[crow(r, hi) * 128 + d0 * 32 + r32]; o[d0][r] = v; s += v * v; }
      ss[r] = s; }
#pragma unroll
    for (int r = 0; r < 16; ++r) { float s = ss[r]; s += swz_xor<1>(s); s += swz_xor<2>(s); s += swz_xor<4>(s); s += swz_xor<8>(s); s += swz_xor<16>(s);
      ss[r] = osc / sqrtf(s * (1.0f / 128.0f) + EPS); }
    float gam[4];
#pragma unroll
    for (int d0 = 0; d0 < 4; ++d0) gam[d0] = sg[d0 * 32 + r32];
    asm volatile("s_waitcnt lgkmcnt(0)" ::: "memory");
    bf16_t* stg = (bf16_t*)XO;
#pragma unroll
    for (int r = 0; r < 16; ++r)
#pragma unroll
      for (int d0 = 0; d0 < 4; ++d0) stg[crow(r, hi) * 128 + d0 * 32 + r32] = (bf16_t)(cvt2bf(o[d0][r] * ss[r] * gam[d0], 0.f) & 0xffffu);
    asm volatile("s_waitcnt lgkmcnt(0)" ::: "memory");
#pragma unroll
    for (int i = 0; i < 8; ++i) { const int row = i * 4 + (lane >> 4), ch = lane & 15; const u32x4 v = *(const u32x4*)(stg + row * 128 + ch * 8);
      if constexpr (VAR & 16) { asm volatile("" :: "v"(v.x), "v"(v.y), "v"(v.z), "v"(v.w)); } else *(u32x4*)(Ob + (long)(qw * QBLK + row) * LDO + ch * 8) = v; }
  }
  __syncthreads();
#undef GLDS
#undef DMAK
#undef DMAV
#undef VMW
#undef PRIO
#undef PRIO1
#undef BARW
#undef KF
#undef PKA
#undef PKB
#undef H1
#undef VRD
#undef PAF
#undef MX3
#undef EX
#undef PIN2
#undef H2
#undef PVONLY
}
#undef SBAR
#undef KSWZ
#undef MF
#undef VF
}
typedef GAS unsigned gu32;
#define RLX_AGENT __ATOMIC_RELAXED, __HIP_MEMORY_SCOPE_AGENT
constexpr int PT_OFF = LDSCTL_OFF + 1024;
__device__ __forceinline__ unsigned long long ldptr(volatile LAS unsigned long long* PT, int i) {
    const unsigned long long v = PT[i];
    const unsigned lo = __builtin_amdgcn_readfirstlane((unsigned)v), hi = __builtin_amdgcn_readfirstlane((unsigned)(v >> 32));
    return ((unsigned long long)hi << 32) | lo;
}
#define XB_TMO      128
#define XB_XCNT(j)  (256  + 64 * (j))
#define XB_XSUB(j)  (1280 + 64 * (j))
#define XB_XGEN(j)  (2304 + 64 * (j))
#define XB_TOP      3328
#define XB_TOPGEN   3392
#define XCD_BAR_WORDS 3456
#define XB_SPIN_CAP (1u << 18)

__device__ __forceinline__ unsigned xb_ld(unsigned* p)              { return __hip_atomic_load(p, __ATOMIC_RELAXED, __HIP_MEMORY_SCOPE_AGENT); }
__device__ __forceinline__ unsigned xb_add(unsigned* p, unsigned v) { return __hip_atomic_fetch_add(p, v, __ATOMIC_RELAXED, __HIP_MEMORY_SCOPE_AGENT); }
__device__ __forceinline__ unsigned xb_xcc_id() { return (unsigned)__builtin_amdgcn_s_getreg((3 << 11) | 20) & 0xFu; }
#define XB_SPIN(cond, bar) do { unsigned _sp = 0; while (cond) { __builtin_amdgcn_s_sleep(1); \
    if ((++_sp & 255u) == 0u) { if (xb_ld(&(bar)[XB_TMO])) break; if (_sp > XB_SPIN_CAP) { atomicAdd(&(bar)[XB_TMO], 1u); break; } } } } while (0)

struct XcdBarrier {
    unsigned* bar; unsigned x;
    volatile LAS unsigned* st;
};

__device__ __forceinline__ XcdBarrier xcd_barrier_post(unsigned* bar, volatile LAS unsigned* st) {
    XcdBarrier b; b.bar = bar; b.x = xb_xcc_id(); b.st = st;
    if (threadIdx.x == 0) (void)xb_add(&bar[XB_XCNT(b.x)], 1u);
    return b;
}
__device__ __forceinline__ void xcd_barrier_complete(unsigned* bar, unsigned x, unsigned& nloc, unsigned& nx) {
    const unsigned G = gridDim.x * gridDim.y * gridDim.z;
    unsigned sum, cnt, mine, sp = 0u;
    for (;;) {
        sum = 0u; cnt = 0u; mine = 0u;
#pragma unroll
        for (unsigned j = 0; j < 16; ++j) { const unsigned c = xb_ld(&bar[XB_XCNT(j)]); sum += c; cnt += (c > 0u) ? 1u : 0u; mine = (j == x) ? c : mine; }
        if (sum == G) break;
        __builtin_amdgcn_s_sleep(1);
        if ((++sp & 255u) == 0u) { if (xb_ld(&bar[XB_TMO])) break; if (sp > XB_SPIN_CAP) { atomicAdd(&bar[XB_TMO], 1u); break; } }
    }
    nloc = mine > 0u ? mine : 1u; nx = cnt > 0u ? cnt : 1u;
}

__device__ __forceinline__ void xcd_barrier(const XcdBarrier& b) {
    asm volatile("s_waitcnt vmcnt(0)" ::: "memory");
    __syncthreads();
    if (threadIdx.x == 0) {
        unsigned* bar = b.bar;
        __builtin_amdgcn_s_waitcnt(0);
        unsigned nloc = b.st[0], nx = b.st[1];
        if (nloc == 0u) { xcd_barrier_complete(bar, b.x, nloc, nx); b.st[0] = nloc; b.st[1] = nx; }
        const unsigned old = xb_add(&bar[XB_XSUB(b.x)], 1u);
        const unsigned gen = old / nloc;
        if (old + 1u == (gen + 1u) * nloc) {
            __builtin_amdgcn_fence(__ATOMIC_RELEASE, "agent");
            asm volatile("s_waitcnt vmcnt(0)" ::: "memory");
            const unsigned og = xb_add(&bar[XB_TOP], 1u);
            const unsigned tg = og / nx;
            if (og + 1u == (tg + 1u) * nx) xb_add(&bar[XB_TOPGEN], 1u);
            else XB_SPIN(xb_ld(&bar[XB_TOPGEN]) == tg, bar);
            __builtin_amdgcn_fence(__ATOMIC_ACQUIRE, "agent");
            xb_add(&bar[XB_XGEN(b.x)], 1u);
            asm volatile("s_waitcnt vmcnt(0)" ::: "memory");
        } else {
            XB_SPIN(xb_ld(&bar[XB_XGEN(b.x)]) == gen, bar);
            __builtin_amdgcn_fence(__ATOMIC_ACQUIRE, "agent");
            asm volatile("s_waitcnt vmcnt(0)" ::: "memory");
        }
    }
    __syncthreads();
}
__device__ __forceinline__ float wave_sum(float v) {
    v += swz_xor<1>(v); v += swz_xor<2>(v); v += swz_xor<4>(v); v += swz_xor<8>(v); v += swz_xor<16>(v);
    auto rr = __builtin_amdgcn_permlane32_swap(__float_as_uint(v), __float_as_uint(v), false, false);
    return __uint_as_float(rr[0]) + __uint_as_float(rr[1]);
}
__device__ __forceinline__ unsigned pk2(float lo, float hi) { return cvt2bf(lo, hi); }

template <int MAP  >
__device__ __forceinline__ void transpose_item(const float* W, int Nsrc, int coff, bf16_t* WT, int ldw, int koff, int nblk, LAS float* scr, int item, int lane) {
    const int kb = item / nblk, nb = item % nblk, k0 = 64 * kb, n0 = 32 * nb;
    const int nd = n0 + (lane & 31); const int scol = MAP ? in_map(nd) : nd + coff;
    float wv[32];
#pragma unroll
    for (int i = 0; i < 32; ++i) wv[i] = W[(size_t)(k0 + 2 * i + (lane >> 5)) * Nsrc + scol];
#pragma unroll
    for (int i = 0; i < 32; ++i) scr[(2 * i + (lane >> 5)) * 33 + (lane & 31)] = wv[i];
    asm volatile("s_waitcnt lgkmcnt(0)" ::: "memory");
    const int c = lane & 7;
#pragma unroll
    for (int j = 0; j < 4; ++j) { const int n = (lane >> 3) + 8 * j; const LAS float* s = scr + (8 * c) * 33 + n;
        u32x4 o; o.x = pk2(s[0 * 33], s[1 * 33]); o.y = pk2(s[2 * 33], s[3 * 33]); o.z = pk2(s[4 * 33], s[5 * 33]); o.w = pk2(s[6 * 33], s[7 * 33]);
        *(u32x4*)(WT + (size_t)(n0 + n) * ldw + koff + k0 + 8 * c) = o; }
    asm volatile("s_waitcnt lgkmcnt(0)" ::: "memory");
}
struct WSrc { const float *w_in, *wo_f, *wo_a, *wo_c, *wo_p, *w_out, *w_up, *w_down; };
constexpr int IT_A = 16 * 208;
constexpr int IT_B0 = 4 * 32, IT_B1 = 8 * 32, IT_B2 = 4 * 32, IT_B3 = 4 * 32, IT_B4 = 16 * 32, IT_B5 = 16 * 88, IT_B6 = 16 * 88, IT_B7 = 44 * 32;
constexpr int IT_B = IT_B0 + IT_B1 + IT_B2 + IT_B3 + IT_B4 + IT_B5 + IT_B6 + IT_B7;
__device__ __forceinline__ void convert_A(const WSrc& S, unsigned char* ws, LAS float* scr, int gw, int NGW, int lane) {
    for (int it = gw; it < IT_A; it += NGW) transpose_item<1>(S.w_in, NIN, 0, (bf16_t*)(ws + WS_WA), 1024, 0, 208, scr, it, lane);
}
__device__ __forceinline__ void convert_B(const WSrc& S, unsigned char* ws, LAS float* scr, int gw, int NGW, int lane) {
    for (int it = gw; it < IT_B; it += NGW) { int r = it;
        if (r < IT_B0) { transpose_item<0>(S.wo_f, 1024, 0, (bf16_t*)(ws + WS_WCAT), KCAT, 0, 32, scr, r, lane); continue; } r -= IT_B0;
        if (r < IT_B1) { transpose_item<0>(S.wo_a, 1024, 0, (bf16_t*)(ws + WS_WCAT), KCAT, 256, 32, scr, r, lane); continue; } r -= IT_B1;
        if (r < IT_B2) { transpose_item<0>(S.wo_c, 1024, 0, (bf16_t*)(ws + WS_WCAT), KCAT, 768, 32, scr, r, lane); continue; } r -= IT_B2;
        if (r < IT_B3) { transpose_item<0>(S.wo_p, 1024, 0, (bf16_t*)(ws + WS_WCAT), KCAT, 1024, 32, scr, r, lane); continue; } r -= IT_B3;
        if (r < IT_B4) { transpose_item<0>(S.w_out, 1024, 0, (bf16_t*)(ws + WS_WOUT), 1024, 0, 32, scr, r, lane); continue; } r -= IT_B4;
        if (r < IT_B5) { transpose_item<0>(S.w_up, 2 * DFF, DFF, (bf16_t*)(ws + WS_WUPG), 1024, 0, 88, scr, r, lane); continue; } r -= IT_B5;
        if (r < IT_B6) { transpose_item<0>(S.w_up, 2 * DFF, 0, (bf16_t*)(ws + WS_WUPV), 1024, 0, 88, scr, r, lane); continue; } r -= IT_B6;
        transpose_item<0>(S.w_down, 1024, 0, (bf16_t*)(ws + WS_WDN), DFF, 0, 32, scr, r, lane);
    }
}

__device__ __forceinline__ void mod_phase(const float* c, const float* c_ctx, const float* ada_w, const float* ada_b, float* MOD, LAS unsigned char* lds, int vcu, int G, int tid, int wave, int lane) {
    LAS float* sil = (LAS float*)lds;
    LAS float* red = (LAS float*)(lds + 12288);
    for (int i = tid; i < 3072; i += 512) { const float v = i < 2048 ? c[i] : c_ctx[i - 2048]; sil[i] = v * sigm(v); }
    __syncthreads();
    for (int item = vcu; item < 192; item += G) {
        const int l = item / 96, n = (item % 96) * 64 + lane;
        const float* W = ada_w + (size_t)l * 1024 * 6144 + n;
        float a0 = 0.f, a1 = 0.f, a2 = 0.f;
        for (int k = wave * 128; k < wave * 128 + 128; k += 8) { float w[8];
#pragma unroll
            for (int i = 0; i < 8; ++i) w[i] = W[(size_t)(k + i) * 6144];
#pragma unroll
            for (int i = 0; i < 8; ++i) { a0 += sil[k + i] * w[i]; a1 += sil[1024 + k + i] * w[i]; a2 += sil[2048 + k + i] * w[i]; } }
        red[(wave * 3 + 0) * 64 + lane] = a0; red[(wave * 3 + 1) * 64 + lane] = a1; red[(wave * 3 + 2) * 64 + lane] = a2;
        __syncthreads();
        if (wave < 3) { float s = ada_b[l * 6144 + n];
#pragma unroll
            for (int w = 0; w < 8; ++w) s += red[(w * 3 + wave) * 64 + lane];
            MOD[(size_t)(l * 3 + wave) * 6144 + n] = s; }
        __syncthreads();
    }
}
__device__ __forceinline__ void tables_phase(float* ROPE, f32x2* TW, int gt, int NGT) {
    for (int i = gt; i < 192 * 16; i += NGT) { const int pos = i >> 4, f = i & 15; const float inv = powf(10000.0f, -(float)f / 16.0f); const float ang = (float)(pos < 128 ? pos : pos - 128) * inv;
        float s, c; sincosf(ang, &s, &c); ROPE[pos * 32 + f] = c; ROPE[pos * 32 + 16 + f] = s; }
    for (int i = gt; i < 8192; i += NGT) { float s, c; sincospif((float)i * (1.0f / 4096.0f), &s, &c); TW[i] = (f32x2){c, -s}; }
}

__device__ __forceinline__ void norm_phase(const float* src_lat, const float* src_ctx, int nrows, const float* gamma, const float* mod, int shoff, int scoff, bf16_t* HX, int gw, int NGW, int lane,
                                           const float* slab = nullptr, int nsl = 0, const float* cgate = nullptr, float* ctx_out = nullptr) {
    for (int m0 = gw; m0 < nrows; m0 += 4 * NGW) {
        f32x4 v[4][4]; float s[4];
#pragma unroll
        for (int u = 0; u < 4; ++u) { const int m = m0 + u * NGW; s[u] = 0.f;
            if (m < nrows) { const float* xr = m < ML ? src_lat + (size_t)m * DM : src_ctx + (size_t)(m - ML) * DM;
#pragma unroll
                for (int j = 0; j < 4; ++j) v[u][j] = ((const f32x4*)xr)[lane + 64 * j];
                if (slab && m >= ML) {
#pragma unroll
                    for (int j = 0; j < 4; ++j) { f32x4 a = {0.f, 0.f, 0.f, 0.f};
                        for (int sl = 0; sl < nsl; ++sl) a += ((const f32x4*)(slab + (size_t)sl * 512 * 1024 + (size_t)(m - ML) * DM))[lane + 64 * j];
                        v[u][j] += ((const f32x4*)cgate)[lane + 64 * j] * a; ((f32x4*)(ctx_out + (size_t)(m - ML) * DM))[lane + 64 * j] = v[u][j]; } } } }
#pragma unroll
        for (int u = 0; u < 4; ++u) { const int m = m0 + u * NGW; if (m < nrows) {
#pragma unroll
            for (int j = 0; j < 4; ++j) s[u] += (v[u][j].x * v[u][j].x + v[u][j].y * v[u][j].y) + (v[u][j].z * v[u][j].z + v[u][j].w * v[u][j].w);
            const float rstd = 1.0f / sqrtf(wave_sum(s[u]) * (1.0f / DM) + EPS);
            const float* md = mod + (m < SEQ ? 0 : m < ML ? 1 : 2) * 6144;
#pragma unroll
            for (int j = 0; j < 4; ++j) { const int col = 4 * lane + 256 * j;
                const f32x4 g = *(const f32x4*)(gamma + col), sc = *(const f32x4*)(md + scoff + col), sh = *(const f32x4*)(md + shoff + col);
                const f32x4 o = v[u][j] * rstd * g * (sc + 1.0f) + sh;
                u32x2 w; w.x = pk2(o.x, o.y); w.y = pk2(o.z, o.w); *(u32x2*)(HX + (size_t)m * DM + col) = w; } } }
    }
}
__device__ __forceinline__ void final_norm_phase(float* x, const float* gamma, int gw, int NGW, int lane) {
    for (int m0 = gw; m0 < ML; m0 += 4 * NGW) {
        f32x4 v[4][4];
#pragma unroll
        for (int u = 0; u < 4; ++u) { const int m = m0 + u * NGW; if (m < ML) {
#pragma unroll
            for (int j = 0; j < 4; ++j) v[u][j] = ((const f32x4*)(x + (size_t)m * DM))[lane + 64 * j]; } }
#pragma unroll
        for (int u = 0; u < 4; ++u) { const int m = m0 + u * NGW; if (m < ML) { float s = 0.f;
#pragma unroll
            for (int j = 0; j < 4; ++j) s += (v[u][j].x * v[u][j].x + v[u][j].y * v[u][j].y) + (v[u][j].z * v[u][j].z + v[u][j].w * v[u][j].w);
            const float rstd = 1.0f / sqrtf(wave_sum(s) * (1.0f / DM) + EPS);
#pragma unroll
            for (int j = 0; j < 4; ++j) { const f32x4 g = *(const f32x4*)(gamma + 4 * lane + 256 * j); ((f32x4*)(x + (size_t)m * DM))[lane + 64 * j] = v[u][j] * rstd * g; } } }
    }
}

#define SWZ(row, colB) ((row) * 256 + ((colB) ^ (((row) & 7) << 4)))
__device__ __forceinline__ int crow_(int r, int hi) { return (r & 3) + 8 * (r >> 2) + 4 * hi; }
__device__ __forceinline__ bf16x8 pack_bf8(const float* v) { u32x4 w; w.x = pk2(v[0], v[1]); w.y = pk2(v[2], v[3]); w.z = pk2(v[4], v[5]); w.w = pk2(v[6], v[7]); return __builtin_bit_cast(bf16x8, w); }
__device__ __forceinline__ void fft1_phase(const bf16_t* UF, const f32x2* TW, unsigned* FA, LAS unsigned char* lds, int vcu, int G, int tid, int wave, int lane) {
    const int tr = wave >> 1, tc = wave & 1, r32 = lane & 31, hi = lane >> 5;
    bf16x8 aRe[8], aIm[8];
#pragma unroll
    for (int ks = 0; ks < 8; ++ks) { float cv[8], sv[8];
#pragma unroll
        for (int j = 0; j < 8; ++j) { const int idx = ((32 * tr + r32) * (16 * ks + 8 * hi + j)) & 127; float s, c; sincospif((float)idx * (1.0f / 64.0f), &s, &c); cv[j] = c; sv[j] = -s; }
        aRe[ks] = pack_bf8(cv); aIm[ks] = pack_bf8(sv); }
    for (int item = vcu; item < 512; item += G) {
        const int b = item >> 8, g = (item >> 6) & 3, l2 = item & 63;
#pragma unroll
        for (int i = 0; i < 2; ++i) { const int q = tid + 512 * i, l1 = q >> 3, c8 = (q & 7) * 8;
            const u32x4 v = *(const u32x4*)(UF + (size_t)(b * SEQ + 64 * l1 + l2) * 256 + g * 64 + c8);
#pragma unroll
            for (int e = 0; e < 8; ++e) { const unsigned w = v[e >> 1]; *(LAS bf16_t*)(lds + SWZ(c8 + e, l1 * 2)) = (bf16_t)((e & 1) ? (w >> 16) : (w & 0xffffu)); } }
        __syncthreads();
        f32x16 re = {}, im = {};
#pragma unroll
        for (int ks = 0; ks < 8; ++ks) { const bf16x8 bx = *(const LAS bf16x8*)(lds + SWZ(32 * tc + r32, (16 * ks + 8 * hi) * 2));
            re = __builtin_amdgcn_mfma_f32_32x32x16_bf16(aRe[ks], bx, re, 0, 0, 0); im = __builtin_amdgcn_mfma_f32_32x32x16_bf16(aIm[ks], bx, im, 0, 0, 0); }
        unsigned* dst = FA + ((size_t)((b * 4 + g) * 64 + l2) * 128) * 64 + 32 * tc + r32;
#pragma unroll
        for (int r = 0; r < 16; ++r) { const int k1 = 32 * tr + crow_(r, hi); const f32x2 t = TW[k1 * l2];
            dst[(size_t)k1 * 64] = pk2(re[r] * t.x - im[r] * t.y, re[r] * t.y + im[r] * t.x); }
        __syncthreads();
    }
}
__device__ __forceinline__ void fft2_phase(const unsigned* FA, bf16_t* ACAT, LAS unsigned char* lds, int vcu, int G, int tid, int wave, int lane) {
    const int tr = wave >> 1, tc = wave & 1, r32 = lane & 31, hi = lane >> 5;
    bf16x8 a2[8], b3[8];
#pragma unroll
    for (int ks = 0; ks < 8; ++ks) { float av[8], bv[8];
#pragma unroll
        for (int j = 0; j < 8; ++j) { const int R = 32 * tr + r32, k = 16 * ks + 8 * hi + j, k2 = R & 63, ll = k & 63; float s, c; sincospif((float)((k2 * ll) & 63) * (1.0f / 32.0f), &s, &c);
            av[j] = (R < 64) ? ((k < 64) ? c : s) : ((k < 64) ? -s : c);
            const int m = 32 * tc + r32; float s2, c2; sincospif((float)((m * ll) & 63) * (1.0f / 32.0f), &s2, &c2); bv[j] = (k < 64) ? c2 : s2; }
        a2[ks] = pack_bf8(av); b3[ks] = pack_bf8(bv); }
    LAS unsigned char* Bt = lds;
    LAS unsigned char* Zt = lds + 16384;
    for (int item = vcu; item < 1024; item += G) {
        const int b = item >> 9, g = (item >> 7) & 3, k1 = item & 127;
#pragma unroll
        for (int i = 0; i < 2; ++i) { const int q = tid + 512 * i, l2 = q >> 4, c4 = (q & 15) * 4;
            const u32x4 v = *(const u32x4*)(FA + ((size_t)((b * 4 + g) * 64 + l2) * 128 + k1) * 64 + c4);
#pragma unroll
            for (int e = 0; e < 4; ++e) { *(LAS bf16_t*)(Bt + SWZ(c4 + e, l2 * 2)) = (bf16_t)(v[e] & 0xffffu); *(LAS bf16_t*)(Bt + SWZ(c4 + e, (64 + l2) * 2)) = (bf16_t)(v[e] >> 16); } }
        __syncthreads();
        f32x16 z = {};
#pragma unroll
        for (int ks = 0; ks < 8; ++ks) { const bf16x8 bx = *(const LAS bf16x8*)(Bt + SWZ(32 * tc + r32, (16 * ks + 8 * hi) * 2)); z = __builtin_amdgcn_mfma_f32_32x32x16_bf16(a2[ks], bx, z, 0, 0, 0); }
#pragma unroll
        for (int r = 0; r < 16; ++r) { const int R = 32 * tr + crow_(r, hi); *(LAS bf16_t*)(Zt + SWZ(R & 63, ((R >> 6) * 64 + 32 * tc + r32) * 2)) = (bf16_t)(pk2(z[r], 0.f) & 0xffffu); }
        __syncthreads();
        if (wave < 4) { f32x16 y = {};
#pragma unroll
            for (int ks = 0; ks < 8; ++ks) { const bf16x8 ax = *(const LAS bf16x8*)(Zt + SWZ(32 * tr + r32, (16 * ks + 8 * hi) * 2)); y = __builtin_amdgcn_mfma_f32_32x32x16_bf16(ax, b3[ks], y, 0, 0, 0); }
#pragma unroll
            for (int r = 0; r < 16; ++r) { const int k2 = 32 * tr + crow_(r, hi); ACAT[(size_t)(b * SEQ + k1 + 128 * k2) * KCAT + g * 64 + 32 * tc + r32] = (bf16_t)(pk2(y[r] * 0.001381067932f, 0.f) & 0xffffu); } }
        __syncthreads();
    }
}
__device__ __forceinline__ void ctxdft_item(int item, const bf16_t* UF, bf16_t* ACAT, LAS unsigned char* lds, int tid, int wave, int lane) {
    const int b = item >> 4, g = (item >> 2) & 3, kc = item & 3;
    const int tr = wave >> 1, tc = wave & 1, r32 = lane & 31, hi = lane >> 5;
    LAS unsigned char* Xt = lds;
    LAS unsigned char* Zt = lds + 32768;
#pragma unroll
    for (int i = 0; i < 4; ++i) { const int q = tid + 512 * i, l = q >> 3, c8 = (q & 7) * 8;
        const u32x4 v = *(const u32x4*)(UF + (size_t)(ML + b * CTXL + l) * 256 + g * 64 + c8);
#pragma unroll
        for (int e = 0; e < 8; ++e) { const unsigned w = v[e >> 1]; const int row = c8 + e; *(LAS bf16_t*)(Xt + row * 512 + ((((l >> 3) ^ (row & 7)) << 4) | ((l & 7) * 2))) = (bf16_t)((e & 1) ? (w >> 16) : (w & 0xffffu)); } }
    __syncthreads();
    f32x16 z = {};
    const int R = 32 * tr + r32, kk = 64 * kc + (R & 63);
#pragma unroll 4
    for (int ks = 0; ks < 16; ++ks) { float av[8];
#pragma unroll
        for (int j = 0; j < 8; ++j) { const int l = 16 * ks + 8 * hi + j; float s, c; sincospif((float)((kk * l) & 255) * (1.0f / 128.0f), &s, &c); av[j] = (R < 64) ? c : -s; }
        const int row = 32 * tc + r32, ch = (16 * ks + 8 * hi) >> 3;
        const bf16x8 bx = *(const LAS bf16x8*)(Xt + row * 512 + ((ch ^ (row & 7)) << 4));
        z = __builtin_amdgcn_mfma_f32_32x32x16_bf16(pack_bf8(av), bx, z, 0, 0, 0); }
#pragma unroll
    for (int r = 0; r < 16; ++r) { const int Rr = 32 * tr + crow_(r, hi); *(LAS bf16_t*)(Zt + SWZ(Rr & 63, ((Rr >> 6) * 64 + 32 * tc + r32) * 2)) = (bf16_t)(pk2(z[r], 0.f) & 0xffffu); }
    __syncthreads();
    if (wave < 4) { f32x16 y = {};
#pragma unroll
        for (int ks = 0; ks < 8; ++ks) { float bv[8];
#pragma unroll
            for (int j = 0; j < 8; ++j) { const int k = 16 * ks + 8 * hi + j, m = 32 * tc + r32; float s2, c2; sincospif((float)((m * (k & 63)) & 63) * (1.0f / 32.0f), &s2, &c2); bv[j] = (k < 64) ? c2 : s2; }
            const bf16x8 ax = *(const LAS bf16x8*)(Zt + SWZ(32 * tr + r32, (16 * ks + 8 * hi) * 2)); y = __builtin_amdgcn_mfma_f32_32x32x16_bf16(ax, pack_bf8(bv), y, 0, 0, 0); }
#pragma unroll
        for (int r = 0; r < 16; ++r) { const int k = 64 * kc + 32 * tr + crow_(r, hi); ACAT[(size_t)(ML + b * CTXL + k) * KCAT + g * 64 + 32 * tc + r32] = (bf16_t)(pk2(y[r] * (1.0f / 128.0f), 0.f) & 0xffffu); } }
    __syncthreads();
}

__device__ __forceinline__ void conv_item(int item, const bf16_t* ZG, const float* cw  , const float* cb, const float* lng, const float* lnb, bf16_t* ACAT, LAS unsigned char* lds, int tid, int wave, int lane) {
    const int row0 = item * 64; const bool lat = row0 < ML; const int s0 = lat ? (row0 & ~(SEQ - 1)) : (ML + ((row0 - ML) & ~(CTXL - 1))), s1 = s0 + (lat ? SEQ : CTXL);
    LAS float* zt = (LAS float*)lds;
#pragma unroll
    for (int i = 0; i < 6; ++i) { const int q = tid + 512 * i; if (q < 94 * 32) { const int rr = q >> 5, c8 = (q & 31) * 8, gr = row0 - 15 + rr;
        u32x4 v = {0u, 0u, 0u, 0u}; if (gr >= s0 && gr < s1) v = *(const u32x4*)(ZG + (size_t)gr * 256 + c8);
        *(LAS f32x4*)(zt + rr * 256 + c8) = (f32x4){bf2f(v.x & 0xffffu), __uint_as_float(v.x & 0xffff0000u), bf2f(v.y & 0xffffu), __uint_as_float(v.y & 0xffff0000u)};
        *(LAS f32x4*)(zt + rr * 256 + c8 + 4) = (f32x4){bf2f(v.z & 0xffffu), __uint_as_float(v.z & 0xffff0000u), bf2f(v.w & 0xffffu), __uint_as_float(v.w & 0xffff0000u)}; } }
    const int c = tid & 255, half = tid >> 8;
    float w[31];
#pragma unroll
    for (int t = 0; t < 31; ++t) w[t] = cw[t * 256 + c];
    float acc[32]; const float bias = cb[c];
    __syncthreads();
#pragma unroll
    for (int r0 = 0; r0 < 32; r0 += 4) { float v[34];
#pragma unroll
        for (int i = 0; i < 34; ++i) v[i] = zt[(half * 32 + r0 + i) * 256 + c];
        float a0 = bias, a1 = bias, a2 = bias, a3 = bias;
#pragma unroll
        for (int t = 0; t < 31; ++t) { a0 += w[t] * v[t]; a1 += w[t] * v[t + 1]; a2 += w[t] * v[t + 2]; a3 += w[t] * v[t + 3]; }
        acc[r0] = a0; acc[r0 + 1] = a1; acc[r0 + 2] = a2; acc[r0 + 3] = a3; }
    __syncthreads();
#pragma unroll
    for (int r = 0; r < 32; ++r) zt[(half * 32 + r) * 256 + c] = acc[r];
    __syncthreads();
    const f32x4 gg = *(const f32x4*)(lng + 4 * lane), bb = *(const f32x4*)(lnb + 4 * lane);
#pragma unroll
    for (int i = 0; i < 8; ++i) { const int r = wave * 8 + i; const f32x4 v = *(const LAS f32x4*)(zt + r * 256 + 4 * lane);
        const float mu = wave_sum((v.x + v.y) + (v.z + v.w)) * (1.0f / 256.0f); const f32x4 d = v - mu;
        const float var = wave_sum((d.x * d.x + d.y * d.y) + (d.z * d.z + d.w * d.w)) * (1.0f / 256.0f); const float rs = 1.0f / sqrtf(var + EPS);
        f32x4 o = d * rs * gg + bb; o.x *= sigm(o.x); o.y *= sigm(o.y); o.z *= sigm(o.z); o.w *= sigm(o.w);
        u32x2 pw; pw.x = pk2(o.x, o.y); pw.y = pk2(o.z, o.w); *(u32x2*)(ACAT + (size_t)(row0 + r) * KCAT + 768 + 4 * lane) = pw; }
    __syncthreads();
}
__device__ __forceinline__ void pool_phase(const bf16_t* UP, const float* pw  , const float* psc, bf16_t* ACAT, int nitems, int first, LAS unsigned char* lds, int G, int tid, int wave, int lane) {
    const int g = wave >> 1, tc = wave & 1, r32 = lane & 31, hi = lane >> 5;
    bf16x8 bw[4];
#pragma unroll
    for (int ks = 0; ks < 4; ++ks) { float v[8];
#pragma unroll
        for (int j = 0; j < 8; ++j) v[j] = pw[g * 4096 + (16 * ks + 8 * hi + j) * 64 + 32 * tc + r32];
        bw[ks] = pack_bf8(v); }
    const float osc = psc[g * 64 + 32 * tc + r32];
    LAS float* ut = (LAS float*)lds;
    LAS unsigned char* dt = lds + 81920;
    for (int item = first; item < nitems; item += G) {
        const int row0 = item * 64; const bool lat = row0 < ML; const int s0 = lat ? (row0 & ~(SEQ - 1)) : (ML + ((row0 - ML) & ~(CTXL - 1))), L = lat ? SEQ : CTXL, s1 = s0 + L;
#pragma unroll
        for (int i = 0; i < 5; ++i) { const int q = tid + 512 * i, rr = q >> 5, c8 = (q & 31) * 8, gr = row0 - 8 + rr;
            u32x4 v = {0u, 0u, 0u, 0u}; if (gr >= s0 && gr < s1) v = *(const u32x4*)(UP + (size_t)gr * 256 + c8);
            *(LAS f32x4*)(ut + rr * 256 + c8) = (f32x4){bf2f(v.x & 0xffffu), __uint_as_float(v.x & 0xffff0000u), bf2f(v.y & 0xffffu), __uint_as_float(v.y & 0xffff0000u)};
            *(LAS f32x4*)(ut + rr * 256 + c8 + 4) = (f32x4){bf2f(v.z & 0xffffu), __uint_as_float(v.z & 0xffff0000u), bf2f(v.w & 0xffffu), __uint_as_float(v.w & 0xffff0000u)}; }
        __syncthreads();
#pragma unroll
        for (int i = 0; i < 4; ++i) { const int q = tid + 512 * i, lr = q >> 5, c8 = (q & 31) * 8, gg = c8 >> 6, hw = 1 << gg, tt = row0 + lr - s0;
            f32x4 sa = {0.f, 0.f, 0.f, 0.f}, sb = {0.f, 0.f, 0.f, 0.f};
            for (int o = -hw; o < hw; ++o) { sa += *(const LAS f32x4*)(ut + (lr + 8 + o) * 256 + c8); sb += *(const LAS f32x4*)(ut + (lr + 8 + o) * 256 + c8 + 4); }
            const int lo = tt - hw < 0 ? 0 : tt - hw, hh = tt + hw - 1 > L - 1 ? L - 1 : tt + hw - 1; const float inv = 1.0f / (float)(hh - lo + 1);
            const f32x4 ua = *(const LAS f32x4*)(ut + (lr + 8) * 256 + c8), ub = *(const LAS f32x4*)(ut + (lr + 8) * 256 + c8 + 4);
            const f32x4 da = sa * inv - ua, db = sb * inv - ub;
            u32x4 w; w.x = pk2(da.x, da.y); w.y = pk2(da.z, da.w); w.z = pk2(db.x, db.y); w.w = pk2(db.z, db.w);
            *(LAS u32x4*)(dt + lr * 512 + ((((c8 >> 3) ^ (lr & 7)) << 4))) = w; }
        __syncthreads();
#pragma unroll
        for (int rt = 0; rt < 2; ++rt) { f32x16 y = {};
#pragma unroll
            for (int ks = 0; ks < 4; ++ks) { const int row = 32 * rt + r32, ch = (g * 64 + 16 * ks + 8 * hi) >> 3;
                const bf16x8 ax = *(const LAS bf16x8*)(dt + row * 512 + ((ch ^ (row & 7)) << 4)); y = __builtin_amdgcn_mfma_f32_32x32x16_bf16(ax, bw[ks], y, 0, 0, 0); }
#pragma unroll
            for (int r = 0; r < 16; ++r) ACAT[(size_t)(row0 + 32 * rt + crow_(r, hi)) * KCAT + 1024 + g * 64 + 32 * tc + r32] = (bf16_t)(pk2(y[r] * osc, 0.f) & 0xffffu); }
        __syncthreads();
    }
}
constexpr int NPHASE = 22;
struct Args { const float* in[30]; float* out; unsigned char* ws; int ph_lo, ph_hi, li, pad; };
__global__ void __launch_bounds__(512, 2) __attribute__((amdgpu_waves_per_eu(2, 2))) fwd_kernel(Args args) {
    extern __shared__ __attribute__((aligned(16))) unsigned char lds[];
    LAS unsigned char* L = (LAS unsigned char*)lds;
    volatile LAS unsigned* MISC = (volatile LAS unsigned*)(L + MISC_OFF);
    const int tid0 = threadIdx.x; const int wave0 = __builtin_amdgcn_readfirstlane(tid0 >> 6);
    const int G = gridDim.x, bx0 = blockIdx.x, vcu0 = (G % 8 == 0) ? (bx0 % 8) * (G / 8) + bx0 / 8 : bx0;
    const int NGW = G * 8;
    gu32* ctl = (gu32*)(args.ws + WS_CTL);
    for (int u = tid0; u < (LDS_BYTES - LDSCTL_OFF) / 4; u += 512) ((LAS unsigned*)(L + LDSCTL_OFF))[u] = 0u;
    __syncthreads();
    volatile LAS unsigned long long* PT = (volatile LAS unsigned long long*)(L + PT_OFF);
    if (tid0 < 32) PT[tid0] = ((const __attribute__((address_space(4))) unsigned long long*)__builtin_amdgcn_kernarg_segment_ptr())[tid0];
    __syncthreads();
#define FRESH() int tid, vcu = vcu0, bx = bx0; asm volatile("v_mbcnt_lo_u32_b32 %0, -1, 0\n\tv_mbcnt_hi_u32_b32 %0, -1, %0" : "=v"(tid)); tid += wave0 * 64; asm volatile("" : "+v"(tid), "+s"(vcu), "+s"(bx)); const int lane = tid & 63, wave = __builtin_amdgcn_readfirstlane(tid >> 6), gw = vcu * 8 + wave; (void)lane; (void)gw; (void)bx; \
    LAS float* scr = (LAS float*)(L + wave * 16384); (void)scr;
#define PTR(i) ((const float*)(const GAS float*)ldptr(PT, (i)))
#define OUTP ((float*)(GAS float*)ldptr(PT, 30))
#define WSP ((unsigned char*)(GAS unsigned char*)ldptr(PT, 31))
    XcdBarrier bar; bar.bar = (unsigned*)(ctl + CW_BAR) + args.li * XCD_BAR_WORDS; bar.x = 0; bar.st = nullptr;
    if (MK_N_LAUNCHES != NPHASE) bar = xcd_barrier_post((unsigned*)(ctl + CW_BAR) + args.li * XCD_BAR_WORDS, MISC + 8);
#define GRID_BAR() do { if (MK_N_LAUNCHES == NPHASE) { if (tid0 == 0) __hip_atomic_store(ctl + CW_TMO, 0xBADBA0u, RLX_AGENT); } else { xcd_barrier(bar); } } while (0)
    const int lo = args.ph_lo, hi = args.ph_hi;
#ifndef PHASE_MASK
#define PHASE_MASK 0xFFF
#endif
#ifndef ATTM
#define ATTM 3
#endif
#ifndef X1REP
#define X1REP 0
#endif
#ifndef X1M
#define X1M 31
#endif
#define PH_EN(kind) ((PHASE_MASK >> (kind)) & 1)
#ifndef REP_MASK
#define REP_MASK 0
#endif
#define NREP(kind) (((REP_MASK >> (kind)) & 1) ? 2 : 1)
#define IN(k) (lo <= (k) && (k) < hi)
#define BOTH(k) (IN(k) && IN((k) + 1))
#define WSRC(S, l) WSrc S; S.w_in = PTR(8) + (size_t)(l) * 1024 * NIN; S.wo_f = PTR(20) + (size_t)(l) * 256 * 1024; S.wo_a = PTR(21) + (size_t)(l) * 512 * 1024; \
    S.wo_c = PTR(22) + (size_t)(l) * 256 * 1024; S.wo_p = PTR(23) + (size_t)(l) * 256 * 1024; S.w_out = PTR(24) + (size_t)(l) * 1024 * 1024; \
    S.w_up = PTR(25) + (size_t)(l) * 1024 * 2 * DFF; S.w_down = PTR(28) + (size_t)(l) * DFF * 1024;
#define ws WSP
#define MOD ((float*)(WSP + WS_MOD))
#define ROPE ((float*)(WSP + WS_ROPE))
#define TW ((f32x2*)(WSP + WS_TW))
#define XC ((float*)(WSP + WS_XC))
#define HX ((bf16_t*)(WSP + WS_HX))
#define FA ((f32x2*)(WSP + WS_FA))
#define Qb ((bf16_t*)(WSP + WS_Q))
#define Kb ((bf16_t*)(WSP + WS_K))
#define Vb ((bf16_t*)(WSP + WS_V))
#define Yb ((bf16_t*)(WSP + WS_Y))
#define Gb (WSP + WS_G)
#define ACAT ((bf16_t*)(WSP + WS_ACAT))
#define UF ((bf16_t*)(WSP + WS_UF))
#define ZG ((bf16_t*)(WSP + WS_ZG))
#define UP ((bf16_t*)(WSP + WS_UP))
#define GT ((bf16_t*)(WSP + WS_GT))
#define Hb ((bf16_t*)(WSP + WS_H))

    for (int rep = 0; rep < NREP(0); ++rep) if (PH_EN(0) && IN(0)) { FRESH();
        mod_phase(PTR(1), PTR(3), PTR(6), PTR(7), MOD, L, vcu, G, tid, wave, lane);
        tables_phase(ROPE, TW, vcu * 512 + tid, G * 512);
        for (int i = vcu * 512 + tid; i < MC * DM / 4; i += G * 512) ((f32x4*)XC)[i] = ((const f32x4*)PTR(2))[i];
        WSRC(S0, 0); convert_A(S0, ws, scr, gw, NGW, lane); convert_B(S0, ws, scr, gw, NGW, lane);
        if (BOTH(0)) GRID_BAR();
    }
#pragma nounroll
    for (int l = 0; l < 2; ++l) {
        const int pb = 1 + 10 * l;
#define mod (MOD + l * 3 * 6144)
#define xl ((l == 0) ? PTR(0) : (const float*)OUTP)
#define xc ((l == 0) ? PTR(2) : (const float*)XC)
        const int Mact = (l == 0) ? MT : ML;
        for (int rep = 0; rep < NREP(1); ++rep) if (PH_EN(1) && IN(pb)) { FRESH(); if (l == 0) norm_phase(xl, xc, MT, PTR(4) + l * DM, mod, 0, 1024, HX, gw, NGW, lane);
            else norm_phase(xl, xc, MT, PTR(4) + l * DM, mod, 0, 1024, HX, gw, NGW, lane, (const float*)Gb, 11, MOD + 2 * 6144 + 5120, XC);
            if (BOTH(pb)) GRID_BAR(); }
        for (int rep = 0; rep < NREP(2); ++rep) if (PH_EN(2) && IN(pb + 1)) { FRESH();
            pg8::Gemm g{HX, (const bf16_t*)(ws + WS_WA), MT, NIN, 1024}; pg8::StaticOrder S; S.init(MT, NIN, G, bx);
            pg8::EpiIn E{UF, ZG, UP, Qb, Kb, Vb, Gb, ROPE};
            pg8::gemm_phase<pg8::EpiIn, pg8::StaticOrder, true, true>(L, g, S, E, tid);
            if (BOTH(pb + 1)) GRID_BAR();
        }
        for (int rep = 0; rep < NREP(3); ++rep) if (PH_EN(3) && IN(pb + 2)) { FRESH();
            for (int r1 = 0; r1 < ((X1REP & 1) ? 2 : 1); ++r1) if (X1M & 1) fft1_phase(UF, TW, (unsigned*)FA, L, vcu, G, tid, wave, lane);
            for (int r1 = 0; r1 < ((X1REP & 2) ? 2 : 1); ++r1) if (X1M & 2) for (int it = vcu; it < Mact / 64; it += G) conv_item(it, ZG, PTR(14) + l * 31 * 256, PTR(15) + l * 256, PTR(16) + l * 256, PTR(17) + l * 256, ACAT, L, tid, wave, lane);
            for (int r1 = 0; r1 < ((X1REP & 4) ? 2 : 1); ++r1) if (X1M & 4) pool_phase(UP, PTR(18) + l * 4 * 4096, PTR(19) + l * 256, ACAT, Mact / 64, (vcu + 248) % G, L, G, tid, wave, lane);
            if ((X1M & 8) && l == 0) for (int it = (vcu + 224) % G; it < 32; it += G) ctxdft_item(it, UF, ACAT, L, tid, wave, lane);
            WSRC(S1, 1);
            for (int r1 = 0; r1 < ((X1REP & 16) ? 2 : 1); ++r1) if (!(X1M & 16)) {} else if (l == 0) convert_A(S1, ws, scr, gw, NGW, lane); else convert_B(S1, ws, scr, gw, NGW, lane);
            if (BOTH(pb + 2)) GRID_BAR();
        }
        for (int rep = 0; rep < NREP(4); ++rep) if (PH_EN(4) && IN(pb + 3)) { FRESH();
            if (ATTM & 1) fft2_phase((const unsigned*)FA, ACAT, L, vcu, G, tid, wave, lane);
            const float lam_init = (l == 0) ? 0.2f : 0.35550906759096926f;
            const float d1 = wave_sum(PTR(9)[l * 64 + lane] * PTR(10)[l * 64 + lane]), d2 = wave_sum(PTR(11)[l * 64 + lane] * PTR(12)[l * 64 + lane]);
            const float lam = __builtin_bit_cast(float, __builtin_amdgcn_readfirstlane(__builtin_bit_cast(int, expf(d1) - expf(d2) + lam_init)));
            const int nun = 512 + (l == 0 ? 16 : 0);
            if (ATTM & 2) for (int u = vcu; u < nun; u += G) {
                int b, h, row0, nkeys;
                if (u < 512) { const int x = (u & 255) >> 5, qb = (u & 31) + 32 * (u >> 8); b = x >> 2; h = x & 3; row0 = b * SEQ + qb * 128; nkeys = KVL; }
                else { const int v = u - 512; b = v >> 3; h = (v >> 1) & 3; row0 = ML + b * CTXL + (v & 1) * 128; nkeys = CTXL; }
#if ATT_V == 2
                att2::attn_unit<0>(Qb + (size_t)row0 * 512 + h * 128,
#else
                att::attn_unit<0>(Qb + (size_t)row0 * 512 + h * 128,
#endif
                               Kb + (size_t)b * KVL * 512 + h * 128, Vb + (size_t)b * KVL * 512 + h * 128, nkeys,
                               ACAT + (size_t)row0 * KCAT + 256 + h * 128, lam, 1.0f - lam_init, PTR(13) + l * 128, (char*)lds, tid);
            }
#if defined(ATT_PROBE)
            int tid2 = tid, vcu2 = vcu; asm volatile("" : "+v"(tid2), "+s"(vcu2));
            for (int u = vcu2; u < 512; u += G) {
                const int x = (u & 255) >> 5, qb = (u & 31) + 32 * (u >> 8), b = x >> 2, h = x & 3, row0 = b * SEQ + qb * 128;
                att2::attn_unit<ATT_PROBE>(Qb + (size_t)row0 * 512 + h * 128, Kb + (size_t)b * KVL * 512 + h * 128, Vb + (size_t)b * KVL * 512 + h * 128, KVL,
                               Hb + (size_t)row0 * KCAT + 256 + h * 128, lam, 1.0f - lam_init, PTR(13) + l * 128, (char*)lds, tid2);
            }
#endif
            if (BOTH(pb + 3)) GRID_BAR();
        }
        for (int rep = 0; rep < NREP(5); ++rep) if (PH_EN(5) && IN(pb + 4)) { FRESH();
            pg8::Gemm g{ACAT, (const bf16_t*)(ws + WS_WCAT), Mact, 1024, KCAT}; pg8::StaticOrder S; S.init(Mact, 1024, G, bx);
            pg8::EpiBranch E{Gb, Yb};
            pg8::gemm_phase<pg8::EpiBranch, pg8::StaticOrder, true, true>(L, g, S, E, tid);
            if (BOTH(pb + 4)) GRID_BAR();
        }
        for (int rep = 0; rep < (l == 0 ? NREP(6) : 1); ++rep) if (PH_EN(6) && IN(pb + 5)) { FRESH();
            pg8::Gemm g{Yb, (const bf16_t*)(ws + WS_WOUT), ML, 1024, 1024}; pg8::StaticOrder S; S.init(ML, 1024, G, bx);
            pg8::EpiRes E{xl, xc, OUTP, XC, mod, 2048};
            pg8::gemm_phase<pg8::EpiRes, pg8::StaticOrder, true, true>(L, g, S, E, tid);
            if (l == 0) {
                pg8::Gemm gc{Yb + (size_t)ML * 1024, (const bf16_t*)(ws + WS_WOUT), MC, 1024, 256, 1024}; pg8::SplitKOrder Sc{4, 256, G, bx};
                pg8::EpiSlab Ec{(float*)Gb};
                pg8::gemm_phase<pg8::EpiSlab, pg8::SplitKOrder, true, true>(L, gc, Sc, Ec, tid);
            }
            if (BOTH(pb + 5)) GRID_BAR();
        }
        for (int rep = 0; rep < NREP(7); ++rep) if (PH_EN(7) && IN(pb + 6)) { FRESH(); if (l == 0) norm_phase(OUTP, XC, Mact, PTR(5) + l * DM, mod, 3072, 4096, HX, gw, NGW, lane, (const float*)Gb, 4, mod + 2 * 6144 + 2048, XC);
            else norm_phase(OUTP, XC, Mact, PTR(5) + l * DM, mod, 3072, 4096, HX, gw, NGW, lane);
            if (BOTH(pb + 6)) GRID_BAR(); }
        for (int rep = 0; rep < NREP(8); ++rep) if (PH_EN(8) && IN(pb + 7)) { FRESH();
            pg8::Gemm g{HX, (const bf16_t*)(ws + WS_WUPG), Mact, DFF, 1024}; pg8::StaticOrder S; S.init(Mact, DFF, G, bx);
            pg8::EpiBf E{GT, DFF};
            pg8::gemm_phase<pg8::EpiBf, pg8::StaticOrder, true, true>(L, g, S, E, tid);
            if (BOTH(pb + 7)) GRID_BAR();
        }
        for (int rep = 0; rep < NREP(9); ++rep) if (PH_EN(9) && IN(pb + 8)) { FRESH();
            pg8::Gemm g{HX, (const bf16_t*)(ws + WS_WUPV), Mact, DFF, 1024}; pg8::StaticOrder S; S.init(Mact, DFF, G, bx);
            pg8::EpiVal E{GT, Hb, PTR(26) + l * 3 * DFF, PTR(27) + l * DFF};
            pg8::gemm_phase<pg8::EpiVal, pg8::StaticOrder, true, true>(L, g, S, E, tid);
            if (BOTH(pb + 8)) GRID_BAR();
        }
        if (PH_EN(10) && IN(pb + 9)) { FRESH();
            pg8::Gemm g{Hb, (const bf16_t*)(ws + WS_WDN), ML, 1024, DFF}; pg8::StaticOrder S; S.init(ML, 1024, G, bx);
            pg8::EpiRes E{OUTP, XC, OUTP, XC, mod, 5120};
            pg8::gemm_phase<pg8::EpiRes, pg8::StaticOrder, true, true>(L, g, S, E, tid);
            if (l == 0) {
                pg8::Gemm gc{Hb + (size_t)ML * DFF, (const bf16_t*)(ws + WS_WDN), MC, 1024, 256, DFF}; pg8::SplitKOrder Sc{11, 256, G, bx};
                pg8::EpiSlab Ec{(float*)Gb};
                pg8::gemm_phase<pg8::EpiSlab, pg8::SplitKOrder, true, true>(L, gc, Sc, Ec, tid);
            }
            if (BOTH(pb + 9)) GRID_BAR();
        }
    }
    if (PH_EN(11) && IN(21)) { FRESH(); final_norm_phase(OUTP, PTR(29), gw, NGW, lane); }
#undef IN
#undef BOTH
#undef mod
#undef xl
#undef xc
#undef ws
#undef MOD
#undef ROPE
#undef TW
#undef XC
#undef HX
#undef FA
#undef Qb
#undef Kb
#undef Vb
#undef Yb
#undef Gb
#undef ACAT
#undef UF
#undef ZG
#undef UP
#undef GT
#undef Hb
#undef PTR
#undef OUTP
#undef WSP
}

extern "C" void kernel_launch(void* const* d_in, const int* in_sizes, int n_in, void* d_out, int out_size, void* d_ws, size_t ws_size, hipStream_t stream) {
    static int grid = 0;
    if (grid == 0) {
        if (n_in != 30 || in_sizes[0] != ML * DM || out_size != ML * DM || ws_size < WS_END) {
            fprintf(stderr, "kernel_launch: unexpected shapes: n_in %d in0 %d out %d ws %zu (need >= %zu)\n", n_in, n_in > 0 ? in_sizes[0] : -1, out_size, ws_size, (size_t)WS_END); grid = -1; return; }
        int dev = 0, cus = 0, per_cu = 0;
        if (hipGetDevice(&dev) != hipSuccess || hipDeviceGetAttribute(&cus, hipDeviceAttributeMultiprocessorCount, dev) != hipSuccess) { grid = -1; return; }
        if (hipFuncSetAttribute((const void*)fwd_kernel, hipFuncAttributeMaxDynamicSharedMemorySize, LDS_BYTES) != hipSuccess) { fprintf(stderr, "kernel_launch: hipFuncSetAttribute failed\n"); grid = -1; return; }
        if (hipOccupancyMaxActiveBlocksPerMultiprocessor(&per_cu, (const void*)fwd_kernel, 512, LDS_BYTES) != hipSuccess || per_cu < 1) {
            fprintf(stderr, "kernel_launch: occupancy query reports %d blocks per CU\n", per_cu); (void)hipGetLastError(); grid = -1; return; }
        grid = cus;
    }
    if (grid < 0) return;
    (void)hipMemsetAsync((char*)d_ws + WS_CTL, 0, CTL_ZERO_BYTES, stream);
    Args a{};
    for (int i = 0; i < 30; ++i) a.in[i] = (const float*)d_in[i];
    a.out = (float*)d_out; a.ws = (unsigned char*)d_ws;
    for (int li = 0; li < MK_N_LAUNCHES; ++li) {
        if (MK_N_LAUNCHES == NPHASE) { a.ph_lo = li; a.ph_hi = li + 1; a.li = 0; }
        else { a.ph_lo = (int)((long)NPHASE * li / MK_N_LAUNCHES); a.ph_hi = (int)((long)NPHASE * (li + 1) / MK_N_LAUNCHES); a.li = li; }
        hipLaunchKernelGGL(fwd_kernel, dim3(grid), dim3(512), LDS_BYTES, stream, a);
    }
}
```

```cpp
#include <hip/hip_runtime.h>
#include <cstdio>
#include <cstdint>

#define LAS __attribute__((address_space(3)))
#define GAS __attribute__((address_space(1)))
typedef unsigned short bf16_t;
typedef short bf16x8 __attribute__((ext_vector_type(8)));
typedef short s16x4 __attribute__((ext_vector_type(4)));
typedef float f32x2 __attribute__((ext_vector_type(2)));
typedef float f32x4 __attribute__((ext_vector_type(4)));
typedef float f32x16 __attribute__((ext_vector_type(16)));
typedef unsigned u32x2 __attribute__((ext_vector_type(2)));
typedef unsigned u32x4 __attribute__((ext_vector_type(4)));

#ifndef ATT_V
#define ATT_V 2
#endif
#ifndef MK_N_LAUNCHES
#define MK_N_LAUNCHES 1
#endif

constexpr int DM = 1024, SEQ = 8192, NBATCH = 2, CTXL = 256;
constexpr int ML = NBATCH * SEQ;
constexpr int MC = NBATCH * CTXL;
constexpr int MT = ML + MC;
constexpr int NIN = 6656, DFF = 2816, KCAT = 1280;
constexpr int KVL = CTXL + SEQ;
constexpr float EPS = 1e-6f;

constexpr size_t MiB = 1u << 20;
constexpr size_t WS_CTL = 0, CTL_ZERO_BYTES = 1 * MiB;
constexpr size_t WS_MOD = 1 * MiB;
constexpr size_t WS_ROPE = WS_MOD + 2 * 3 * 6144 * 4;
constexpr size_t WS_TW = WS_ROPE + 192 * 32 * 4;
constexpr size_t WS_XC = 2 * MiB;
constexpr size_t WS_WA = 4 * MiB;
constexpr size_t WS_WCAT = 17 * MiB;
constexpr size_t WS_WOUT = WS_WCAT + (size_t)1024 * 1280 * 2;
constexpr size_t WS_WUPG = WS_WOUT + (size_t)1024 * 1024 * 2;
constexpr size_t WS_WUPV = WS_WUPG + (size_t)2816 * 1024 * 2;
constexpr size_t WS_WDN = WS_WUPV + (size_t)2816 * 1024 * 2;
constexpr size_t WS_HX = 38 * MiB;
constexpr size_t WS_FA = WS_HX;
constexpr size_t WS_Q = 71 * MiB;
constexpr size_t WS_K = WS_Q + (size_t)MT * 512 * 2;
constexpr size_t WS_V = WS_K + (size_t)MT * 512 * 2;
constexpr size_t WS_Y = 71 * MiB;
constexpr size_t WS_G = 121 * MiB;
constexpr size_t WS_ACAT = 187 * MiB;
constexpr size_t WS_UF = 229 * MiB;
constexpr size_t WS_ZG = WS_UF + (size_t)MT * 256 * 2;
constexpr size_t WS_UP = WS_ZG + (size_t)MT * 256 * 2;
constexpr size_t WS_GT = 71 * MiB;
constexpr size_t WS_H = 162 * MiB;
constexpr size_t WS_END = 256 * MiB;
static_assert(WS_TW + 8192 * 8 <= WS_XC && WS_WDN + (size_t)1024 * 2816 * 2 <= WS_HX && WS_V + (size_t)MT * 512 * 2 <= WS_G && WS_G + (size_t)MT * 4096 <= WS_ACAT, "ws map 1");
static_assert(WS_ACAT + (size_t)MT * 1280 * 2 <= WS_UF && WS_UP + (size_t)MT * 256 * 2 <= WS_END && WS_GT + (size_t)MT * 2816 * 2 <= WS_H && WS_H + (size_t)MT * 2816 * 2 <= WS_END, "ws map 2");
static_assert(WS_HX + (size_t)MT * 1024 * 2 <= WS_Q && (size_t)2 * 4 * 128 * 64 * 64 * 8 <= (size_t)MT * 1024 * 2, "ws map 3");
constexpr int CW_TMO = 0, CW_CODE = 1, CW_BAR = 4096;

constexpr int RING_BYTES = 131072, LDSCTL_OFF = RING_BYTES, MISC_OFF = LDSCTL_OFF + 320, LDS_BYTES = 147456;

typedef __bf16 bf16x2_t __attribute__((ext_vector_type(2)));
__device__ __forceinline__ unsigned cvt2bf(float lo, float hi) { const f32x2 v = {lo, hi}; return __builtin_bit_cast(unsigned, __builtin_convertvector(v, bf16x2_t)); }
template <int M> __device__ __forceinline__ float swz_xor(float v) { return __int_as_float(__builtin_amdgcn_ds_swizzle(__float_as_int(v), (M << 10) | 0x1f)); }
__device__ __forceinline__ float bf2f(unsigned v) { return __uint_as_float(v << 16); }
__device__ __forceinline__ float sigm(float x) { return __builtin_amdgcn_rcpf(1.0f + __builtin_amdgcn_exp2f(x * -1.4426950408889634f)); }
__host__ __device__ __forceinline__ int in_map(int n) {
    if (n < 256) return n;
    if (n < 1280) { const int base = n < 768 ? 256 : 768, r = n - base, comp = r >> 6, p = r & 63, pp = p >> 1, e = p & 1;
        return base + comp * 64 + (pp < 16 ? 0 : 32) + (pp & 15) + 16 * e; }
    if (n < 1792) return n;
    if (n < 2304) { const int r = n - 1792; return 1792 + (r & 1) * 256 + (r >> 1); }
    return n;
}
namespace pg8 {
#define PG8_LAS __attribute__((address_space(3)))
typedef unsigned short bf16_t;
typedef short bf16x8 __attribute__((ext_vector_type(8)));
typedef float f32x4 __attribute__((ext_vector_type(4)));
typedef unsigned u32x4 __attribute__((ext_vector_type(4)));
constexpr int BM = 256, BK = 64, HALF = 128, HTB = HALF * BK * 2  , STAGE_BYTES = 8 * HTB, NXCD = 8, WGM = 8;

__host__ __device__ __forceinline__ int lds_byte(int r, int c) { const int st = (r >> 4) * 2 + (c >> 5), rr = r & 15, cc = c & 31, ob = rr * 64 + cc * 2; return st * 1024 + (ob ^ (((ob >> 9) & 1) << 5)); }
__host__ __device__ __forceinline__ void stage_rc(int b, int& R, int& C) { const int st = b / 1024, sb = b % 1024, swz = sb ^ (((sb >> 9) & 1) << 5); R = (st >> 1) * 16 + swz / 64; C = (st & 1) * 32 + (swz % 64) / 2; }
__host__ __device__ __forceinline__ int perm32(int rho) { const int n = rho >> 4, i = rho & 15; return 8 * (i >> 2) + 4 * n + (i & 3); }

struct Unit { int pm, pn, ko = 0, sl = 0; };
struct Gemm { const bf16_t* A; const bf16_t* Bt; int M, N, K, ld = 0; };

struct StaticOrder {
    int nM, nN, nwg, G, c;
    __host__ __device__ void init(int M, int N, int G_, int c_) { nM = M / BM; nN = N / BM; nwg = nM * nN; G = G_; c = c_; }
    __host__ __device__ bool next(int i, Unit& u) const {
        const long L = (long)i * G + c; if (L >= nwg) return false;
        int wgid = (int)L; { const int q = nwg / NXCD, r = nwg % NXCD, xcd = wgid % NXCD, off = wgid / NXCD; wgid = (xcd < r ? xcd * (q + 1) : r * (q + 1) + (xcd - r) * q) + off; }
        const int nig = WGM * nN, gid = wgid / nig, fm = gid * WGM, gsz = (nM - fm) < WGM ? (nM - fm) : WGM;
        u.pm = fm + ((wgid % nig) % gsz); u.pn = (wgid % nig) / gsz; return true;
    }
    __device__ __forceinline__ void a_ready(const Unit&) const {}
    __device__ __forceinline__ void done(const Unit&) const {}
};
__device__ __forceinline__ unsigned cvt_pk_bf16(float lo, float hi) { return cvt2bf(lo, hi); }
typedef float f32x2 __attribute__((ext_vector_type(2)));
__device__ __forceinline__ f32x2 gelu_pk(f32x2 v) {
    const f32x2 av = __builtin_elementwise_abs(v), d = av * 0.2316418882f + 1.0f;
    f32x2 t; t.x = __builtin_amdgcn_rcpf(d.x); t.y = __builtin_amdgcn_rcpf(d.y);
    f32x2 q = t * 0.5307027145f + (-0.7265760135f); q = q * t + 0.7107068705f; q = q * t + (-0.142248368f); q = q * t + 0.127414796f; q = q * t;
    const f32x2 s = (v * v) * (-0.72134752044f);
    f32x2 e; e.x = __builtin_amdgcn_exp2f(s.x); e.y = __builtin_amdgcn_exp2f(s.y);
    const f32x2 m = v * (q * e), r = v - m;
    f32x2 o; o.x = v.x < 0.f ? m.x : r.x; o.y = v.y < 0.f ? m.y : r.y; return o;
}

typedef unsigned u32x2 __attribute__((ext_vector_type(2)));
__device__ __forceinline__ u32x4 pack8(const f32x4 a, const f32x4 b) { u32x4 w; w.x = cvt_pk_bf16(a[0], a[1]); w.y = cvt_pk_bf16(a[2], a[3]); w.z = cvt_pk_bf16(b[0], b[1]); w.w = cvt_pk_bf16(b[2], b[3]); return w; }

struct EpiIn {
    static constexpr bool PERM = true, AFTER_DRAIN = false, RESCALE = false;
    bf16_t *UF, *ZG, *UP, *Q, *K, *V; unsigned char* G; const float* rope;
    __device__ __forceinline__ void operator()(const f32x4 (&acc)[2][2][4][2], const Unit& u, int wr, int wc, int fr, int fq) const {
        const int pm = u.pm, pn = u.pn; const bool lat = pm < 64; const int R0 = pm * 256;
        const int kv0 = lat ? ((pm >> 5) * 8448 + 256 + ((pm & 31) << 8)) : ((pm - 64) * 8448);
        const int rl = wr * 64 + fr, cl = wc * 32 + 8 * fq;
        if (pn == 0 || pn == 9) {
            bf16_t* dst = (pn == 0 ? UF : UP);
#pragma unroll
            for (int ai = 0; ai < 2; ++ai)
#pragma unroll
                for (int m = 0; m < 4; ++m) { const int rr = ai * 128 + m * 16 + rl;
#pragma unroll
                    for (int bj = 0; bj < 2; ++bj) *(u32x4*)(dst + (size_t)(R0 + rr) * 256 + bj * 128 + cl) = pack8(acc[ai][bj][m][0], acc[ai][bj][m][1]); }
        } else if (pn <= 4) {
            const bool isq = pn <= 2; bf16_t* dst = isq ? Q : K; const int rowbase = isq ? R0 : kv0, colbase = (isq ? pn - 1 : pn - 3) * 256; const float sc = isq ? (ATT_V == 2 ? 0.18033688011112042f : 0.125f) : 1.0f;
#pragma unroll
            for (int ai = 0; ai < 2; ++ai)
#pragma unroll
                for (int m = 0; m < 4; ++m) { const int rr = ai * 128 + m * 16 + rl;
                    f32x4 cs = {1.f, 1.f, 1.f, 1.f}, sn = {0.f, 0.f, 0.f, 0.f};
                    if (lat) { const int t = (R0 & 8191) + rr; const int pos = (wc & 1) ? 128 + (t & 63) : (t >> 6);
                        cs = *(const f32x4*)(rope + pos * 32 + 4 * fq); sn = *(const f32x4*)(rope + pos * 32 + 16 + 4 * fq); }
                    cs = cs * sc; sn = sn * sc;
#pragma unroll
                    for (int bj = 0; bj < 2; ++bj) { const f32x4 a = acc[ai][bj][m][0], b = acc[ai][bj][m][1]; f32x4 oa, ob;
                        oa[0] = a[0] * cs[0] - a[1] * sn[0]; oa[1] = a[1] * cs[0] + a[0] * sn[0]; oa[2] = a[2] * cs[1] - a[3] * sn[1]; oa[3] = a[3] * cs[1] + a[2] * sn[1];
                        ob[0] = b[0] * cs[2] - b[1] * sn[2]; ob[1] = b[1] * cs[2] + b[0] * sn[2]; ob[2] = b[2] * cs[3] - b[3] * sn[3]; ob[3] = b[3] * cs[3] + b[2] * sn[3];
                        *(u32x4*)(dst + (size_t)(rowbase + rr) * 512 + colbase + bj * 128 + cl) = pack8(oa, ob); } }
        } else if (pn <= 6) {
#pragma unroll
            for (int ai = 0; ai < 2; ++ai)
#pragma unroll
                for (int m = 0; m < 4; ++m) { const int rr = ai * 128 + m * 16 + rl;
#pragma unroll
                    for (int bj = 0; bj < 2; ++bj) *(u32x4*)(V + (size_t)(kv0 + rr) * 512 + (pn - 5) * 256 + bj * 128 + cl) = pack8(acc[ai][bj][m][0], acc[ai][bj][m][1]); }
        } else if (pn <= 8) {
#pragma unroll
            for (int ai = 0; ai < 2; ++ai)
#pragma unroll
                for (int m = 0; m < 4; ++m) { const int rr = ai * 128 + m * 16 + rl;
#pragma unroll
                    for (int bj = 0; bj < 2; ++bj) { const f32x4 a = acc[ai][bj][m][0], b = acc[ai][bj][m][1];
                        u32x2 w; w.x = cvt_pk_bf16(a[0] * sigm(a[1]), a[2] * sigm(a[3])); w.y = cvt_pk_bf16(b[0] * sigm(b[1]), b[2] * sigm(b[3]));
                        *(u32x2*)(ZG + (size_t)(R0 + rr) * 256 + (pn - 7) * 128 + bj * 64 + (cl >> 1)) = w; } }
        } else {
#pragma unroll
            for (int ai = 0; ai < 2; ++ai)
#pragma unroll
                for (int m = 0; m < 4; ++m) { const int rr = ai * 128 + m * 16 + rl;
#pragma unroll
                    for (int bj = 0; bj < 2; ++bj) { u32x2 w;
#pragma unroll
                        for (int n = 0; n < 2; ++n) { const f32x4 a = acc[ai][bj][m][n]; unsigned q = 0;
#pragma unroll
                            for (int j = 0; j < 4; ++j) { float s = sigm(a[j]) * 255.0f + 0.5f; s = s < 1.0f ? 1.0f : s; q |= ((unsigned)s) << (8 * j); }
                            if (n == 0) w.x = q; else w.y = q; }
                        *(u32x2*)(G + (size_t)(R0 + rr) * 4096 + (pn - 10) * 256 + bj * 128 + cl) = w; } }
        }
    }
};

struct EpiBf {
    static constexpr bool PERM = true, AFTER_DRAIN = false, RESCALE = false;
    bf16_t* O; int ldc;
    __device__ __forceinline__ void operator()(const f32x4 (&acc)[2][2][4][2], const Unit& u, int wr, int wc, int fr, int fq) const {
        const int row0 = u.pm * 256 + wr * 64 + fr, col0 = u.pn * 256 + wc * 32 + 8 * fq;
#pragma unroll
        for (int ai = 0; ai < 2; ++ai)
#pragma unroll
            for (int m = 0; m < 4; ++m)
#pragma unroll
                for (int bj = 0; bj < 2; ++bj) *(u32x4*)(O + (size_t)(row0 + ai * 128 + m * 16) * ldc + col0 + bj * 128) = pack8(acc[ai][bj][m][0], acc[ai][bj][m][1]);
    }
};

struct EpiRes {
    static constexpr bool PERM = false, AFTER_DRAIN = false, RESCALE = false;
    const float* base_lat; const float* base_ctx; float* out_lat; float* out_ctx; const float* mod; int goff;
    __device__ __forceinline__ void operator()(const f32x4 (&acc)[2][2][4][2], const Unit& u, int wr, int wc, int fr, int fq) const {
        const int pm = u.pm; const bool lat = pm < 64; const int mrow = lat ? (pm >> 5) : 2;
        const float* base = lat ? base_lat + (size_t)pm * 256 * 1024 : base_ctx + (size_t)(pm - 64) * 256 * 1024;
        float* out = lat ? out_lat + (size_t)pm * 256 * 1024 : out_ctx + (size_t)(pm - 64) * 256 * 1024;
        const int col0 = u.pn * 256 + wc * 32 + 4 * fq;
        f32x4 gv[2][2];
#pragma unroll
        for (int bj = 0; bj < 2; ++bj)
#pragma unroll
            for (int n = 0; n < 2; ++n) gv[bj][n] = *(const f32x4*)(mod + mrow * 6144 + goff + col0 + bj * 128 + n * 16);
#pragma unroll
        for (int ai = 0; ai < 2; ++ai)
#pragma unroll
            for (int m = 0; m < 4; ++m) { const size_t ro = (size_t)(ai * 128 + wr * 64 + m * 16 + fr) * 1024 + col0;
#pragma unroll
                for (int bj = 0; bj < 2; ++bj)
#pragma unroll
                    for (int n = 0; n < 2; ++n) { const size_t off = ro + bj * 128 + n * 16; const f32x4 b = *(const f32x4*)(base + off); *(f32x4*)(out + off) = b + gv[bj][n] * acc[ai][bj][m][n]; } }
    }
};

struct EpiVal {
    static constexpr bool PERM = true, AFTER_DRAIN = false, RESCALE = false;
    const bf16_t* GT; bf16_t* H; const float* dww; const float* dwb;
    __device__ __forceinline__ void operator()(const f32x4 (&acc)[2][2][4][2], const Unit& u, int wr, int wc, int fr, int fq) const {
        const int pm = u.pm; const bool lat = pm < 64; const int R0 = pm * 256, t0 = lat ? (R0 & 8191) : 0, L = lat ? 8192 : 256;
        const int rl = wr * 64 + fr;
#pragma unroll
        for (int bj = 0; bj < 2; ++bj) { const int col = u.pn * 256 + bj * 128 + wc * 32 + 8 * fq;
            f32x4 w0[2], w1[2], w2[2], bb[2];
#pragma unroll
            for (int n = 0; n < 2; ++n) { w0[n] = *(const f32x4*)(dww + col + 4 * n); w1[n] = *(const f32x4*)(dww + 2816 + col + 4 * n); w2[n] = *(const f32x4*)(dww + 5632 + col + 4 * n); bb[n] = *(const f32x4*)(dwb + col + 4 * n); }
#pragma unroll
            for (int ai = 0; ai < 2; ++ai) {
#pragma unroll
              for (int mh = 0; mh < 4; mh += 2) {
                u32x4 gm[4], g0[4], gq[4];
#pragma unroll
                for (int m = mh; m < mh + 2; ++m) { const int rr = ai * 128 + m * 16 + rl, t = t0 + rr; const bf16_t* gp = GT + (size_t)(R0 + rr) * 2816 + col;
                    gm[m] = (u32x4){0u, 0u, 0u, 0u}; gq[m] = (u32x4){0u, 0u, 0u, 0u}; g0[m] = *(const u32x4*)gp;
                    if (t > 0) gm[m] = *(const u32x4*)(gp - 2816);
                    if (t < L - 1) gq[m] = *(const u32x4*)(gp + 2816); }
                asm volatile("" ::: "memory");
#pragma unroll
                for (int m = mh; m < mh + 2; ++m) { const int rr = ai * 128 + m * 16 + rl;
                    f32x4 o[2];
#pragma unroll
                    for (int n = 0; n < 2; ++n) { f32x4 c;
#pragma unroll
                        for (int j = 0; j < 4; ++j) { const int e = 4 * n + j; const unsigned wm = gm[m][e >> 1], wz = g0[m][e >> 1], wp = gq[m][e >> 1];
                            const float xm = (e & 1) ? __uint_as_float(wm & 0xffff0000u) : __uint_as_float(wm << 16), xz = (e & 1) ? __uint_as_float(wz & 0xffff0000u) : __uint_as_float(wz << 16),
                                        xp = (e & 1) ? __uint_as_float(wp & 0xffff0000u) : __uint_as_float(wp << 16);
                            c[j] = w0[n][j] * xm + w1[n][j] * xz + w2[n][j] * xp + bb[n][j]; }
                        const f32x2 ga = gelu_pk((f32x2){c[0], c[1]}), gb = gelu_pk((f32x2){c[2], c[3]});
                        const f32x4 v = acc[ai][bj][m][n]; o[n] = (f32x4){v[0] * ga.x, v[1] * ga.y, v[2] * gb.x, v[3] * gb.y}; }
                    *(u32x4*)(H + (size_t)(R0 + rr) * 2816 + col) = pack8(o[0], o[1]); }
                asm volatile("" ::: "memory");
              }
            }
        }
    }
};

struct EpiBranch {
    static constexpr bool PERM = true, AFTER_DRAIN = false, RESCALE = true;
    const unsigned char* G; bf16_t* Y;
    __device__ __forceinline__ void rescale(f32x4 (&acc)[2][2][4][2], const Unit& u, int t, int wr, int wc, int fr, int fq) const {
        const int bp = (t == 4) ? 0 : (t == 12) ? 1 : 2;
        const __amdgpu_buffer_rsrc_t rs = __builtin_amdgcn_make_buffer_rsrc((void*)G, 0, MT * 4096, 0x00020000);
        const int voff = (u.pm * 256 + wr * 64 + fr) * 4096 + u.pn * 256 + wc * 32 + 8 * fq;
#pragma unroll
        for (int ai = 0; ai < 2; ++ai)
#pragma unroll
            for (int m = 0; m < 4; ++m) {
#pragma unroll
                for (int bj = 0; bj < 2; ++bj) { const int so = (ai * 128 + m * 16) * 4096 + bj * 128 + bp * 1024;
                    const u32x2 p = __builtin_bit_cast(u32x2, __builtin_amdgcn_raw_buffer_load_b64(rs, voff, so, 0)), q = __builtin_bit_cast(u32x2, __builtin_amdgcn_raw_buffer_load_b64(rs, voff, so + 1024, 0));
#pragma unroll
                    for (int n = 0; n < 2; ++n) { const unsigned pw = n ? p.y : p.x, qw = n ? q.y : q.x;
#pragma unroll
                        for (int j = 0; j < 4; ++j) acc[ai][bj][m][n][j] *= (float)((pw >> (8 * j)) & 255u) * __builtin_amdgcn_rcpf((float)((qw >> (8 * j)) & 255u)); } }
                asm volatile("" ::: "memory"); }
    }
    __device__ __forceinline__ void operator()(const f32x4 (&acc)[2][2][4][2], const Unit& u, int wr, int wc, int fr, int fq) const {
        const int row0 = u.pm * 256 + wr * 64 + fr, col0 = u.pn * 256 + wc * 32 + 8 * fq;
#pragma unroll
        for (int ai = 0; ai < 2; ++ai)
#pragma unroll
            for (int m = 0; m < 4; ++m)
#pragma unroll
                for (int bj = 0; bj < 2; ++bj) { const size_t r = (size_t)(row0 + ai * 128 + m * 16); const u32x2 p = *(const u32x2*)(G + r * 4096 + 3072 + col0 + bj * 128);
                    f32x4 o[2];
#pragma unroll
                    for (int n = 0; n < 2; ++n) { const unsigned pw = n ? p.y : p.x;
#pragma unroll
                        for (int j = 0; j < 4; ++j) o[n][j] = acc[ai][bj][m][n][j] * ((float)((pw >> (8 * j)) & 255u) * (1.0f / 255.0f)); }
                    *(u32x4*)(Y + r * 1024 + col0 + bj * 128) = pack8(o[0], o[1]); }
    }
};


struct SplitKOrder {
    int nsl, ksl, G, c;
    __device__ __forceinline__ bool next(int i, Unit& u) const { const int L = i * G + c; if (L >= 8 * nsl) return false; u.pm = (L >> 2) & 1; u.pn = L & 3; u.sl = L >> 3; u.ko = u.sl * ksl; return true; }
    __device__ __forceinline__ void a_ready(const Unit&) const {}
    __device__ __forceinline__ void done(const Unit&) const {}
};
struct EpiSlab {
    static constexpr bool PERM = false, AFTER_DRAIN = false, RESCALE = false;
    float* slab;
    __device__ __forceinline__ void operator()(const f32x4 (&acc)[2][2][4][2], const Unit& u, int wr, int wc, int fr, int fq) const {
        float* o = slab + (size_t)u.sl * 512 * 1024 + (size_t)(u.pm * 256 + wr * 64 + fr) * 1024 + u.pn * 256 + wc * 32 + 4 * fq;
#pragma unroll
        for (int ai = 0; ai < 2; ++ai)
#pragma unroll
            for (int m = 0; m < 4; ++m)
#pragma unroll
                for (int bj = 0; bj < 2; ++bj)
#pragma unroll
                    for (int n = 0; n < 2; ++n) *(f32x4*)(o + (size_t)(ai * 128 + m * 16) * 1024 + bj * 128 + n * 16) = acc[ai][bj][m][n];
    }
};

struct BranchSliceOrder {
    int G, c;
    __device__ __forceinline__ bool next(int i, Unit& u) const { const int L = i * G + c; if (L >= 40) return false; u.pm = (L >> 2) & 1; u.pn = L & 3; u.sl = L >> 3; u.ko = u.sl * 256; return true; }
    __device__ __forceinline__ void a_ready(const Unit&) const {}
    __device__ __forceinline__ void done(const Unit&) const {}
};
template <class Epi, class Sched, bool ALIGN_EPI = false, bool SP2 = false>
__device__ __forceinline__ void gemm_phase(PG8_LAS unsigned char* lds, const Gemm g, const Sched& S, const Epi& E, const int tid) {
    const int wid = __builtin_amdgcn_readfirstlane(tid >> 6), lane = tid & 63, wr = wid >> 2, wc = wid & 3, fr = lane & 15, fq = lane >> 4;
    const int K = g.ld ? g.ld : g.K  , nt = g.K / BK;
    unsigned voffA[2], voffB[2];
#pragma unroll
    for (int i = 0; i < 2; ++i) { int R, C; stage_rc(tid * 16 + i * 8192, R, C); const int Rb = Epi::PERM ? ((R & ~31) + perm32(R & 31)) : R;
        voffA[i] = (unsigned)(R * K + C) * 2u; voffB[i] = (unsigned)(Rb * K + C) * 2u; }
    const size_t kstep = (size_t)(BK * 2);
    const size_t hstep = (size_t)HALF * K * 2;
    const size_t tstep = 2 * hstep;
    const unsigned ldsw = (unsigned)wid * 1024u;
    const int aoff = lds_byte(wr * 64 + fr, fq * 8), boff = lds_byte(wc * 32 + fr, fq * 8);
#define PG8_SA(b, h) (((b) * 2 + (h)) * HTB)
#define PG8_SB(b, h) ((4 + (b) * 2 + (h)) * HTB)
#define PG8_STAGE(bufoff, gbase, voff) do { _Pragma("unroll") for (int _i = 0; _i < 2; ++_i) \
        __builtin_amdgcn_global_load_lds((const unsigned*)((const char*)(gbase) + (voff)[_i]), (PG8_LAS unsigned*)(lds + (bufoff) + ldsw + _i * 8192), 16, 0, 0); } while (0)
#define PG8_LDA(dst, b, h) do { _Pragma("unroll") for (int m = 0; m < 4; ++m) _Pragma("unroll") for (int k = 0; k < 2; ++k) dst[m][k] = *(const PG8_LAS bf16x8*)(lds + PG8_SA(b, h) + aoff + m * 2048 + k * 1024); } while (0)
#define PG8_LDB(dst, b, h) do { _Pragma("unroll") for (int n = 0; n < 2; ++n) _Pragma("unroll") for (int k = 0; k < 2; ++k) dst[n][k] = *(const PG8_LAS bf16x8*)(lds + PG8_SB(b, h) + boff + n * 2048 + k * 1024); } while (0)
#define PG8_MMA(ai, bj, At, Bt) do { __builtin_amdgcn_s_setprio(1); _Pragma("unroll") for (int m = 0; m < 4; ++m) _Pragma("unroll") for (int n = 0; n < 2; ++n) _Pragma("unroll") for (int k = 0; k < 2; ++k) \
        acc[ai][bj][m][n] = __builtin_amdgcn_mfma_f32_16x16x32_bf16(Bt[n][k], At[m][k], acc[ai][bj][m][n], 0, 0, 0); __builtin_amdgcn_s_setprio(0); } while (0)
#define PG8_WAIT_V(n) asm volatile("s_waitcnt vmcnt(" #n ")" ::: "memory")
#define PG8_WAIT_L(n) asm volatile("s_waitcnt lgkmcnt(" #n ")" ::: "memory")
#define PG8_BAR __builtin_amdgcn_s_barrier()
#define PG8_SCHED __builtin_amdgcn_sched_barrier(0)
    Unit cur, nxt; int ui = 0;
    if (!S.next(0, cur)) return;
    f32x4 acc[2][2][4][2];
#pragma unroll
    for (int a = 0; a < 2; ++a)
#pragma unroll
        for (int b = 0; b < 2; ++b)
#pragma unroll
            for (int m = 0; m < 4; ++m)
#pragma unroll
                for (int n = 0; n < 2; ++n) acc[a][b][m][n] = (f32x4){0.f, 0.f, 0.f, 0.f};
    bf16x8 At[4][2], B0[2][2], B1[2][2];
    const char* cA = (const char*)g.A + (size_t)cur.pm * tstep + (size_t)cur.ko * 2; const char* cB = (const char*)g.Bt + (size_t)cur.pn * tstep + (size_t)cur.ko * 2;
    S.a_ready(cur);
    if constexpr (SP2) {
        PG8_STAGE(PG8_SB(0, 0), cB, voffB); PG8_STAGE(PG8_SB(0, 1), cB + hstep, voffB); PG8_STAGE(PG8_SA(0, 0), cA, voffA); PG8_STAGE(PG8_SA(0, 1), cA + hstep, voffA);
        if (wr == 1) PG8_BAR;
        PG8_WAIT_V(2); PG8_BAR;
        PG8_STAGE(PG8_SB(1, 0), cB + kstep, voffB); PG8_STAGE(PG8_SA(1, 0), cA + kstep, voffA); PG8_STAGE(PG8_SB(1, 1), cB + hstep + kstep, voffB);
        PG8_WAIT_V(6); PG8_BAR;
    } else {
        PG8_STAGE(PG8_SB(0, 0), cB, voffB); PG8_STAGE(PG8_SA(0, 0), cA, voffA); PG8_STAGE(PG8_SB(0, 1), cB + hstep, voffB); PG8_STAGE(PG8_SA(0, 1), cA + hstep, voffA);
        if (wr == 1) PG8_BAR;
        PG8_WAIT_V(4); PG8_BAR;
        PG8_STAGE(PG8_SB(1, 0), cB + kstep, voffB); PG8_STAGE(PG8_SA(1, 0), cA + kstep, voffA); PG8_STAGE(PG8_SB(1, 1), cB + hstep + kstep, voffB);
        PG8_WAIT_V(6); PG8_BAR;
    }
    for (;;) {
        const bool has_next = S.next(ui + 1, nxt);
        const char* nA = has_next ? (const char*)g.A + (size_t)nxt.pm * tstep + (size_t)nxt.ko * 2 : cA; const char* nB = has_next ? (const char*)g.Bt + (size_t)nxt.pn * tstep + (size_t)nxt.ko * 2 : cB;
        for (int t = 0; t < nt; t += 2) {
            if constexpr (Epi::RESCALE) { if (t == 4 || t == 12 || t == 16) E.rescale(acc, cur, t, wr, wc, fr, fq); }
            const bool last = (t == nt - 2);
            const char* a1 = cA + (size_t)(t + 1) * kstep;
            const char* a2 = last ? nA : cA + (size_t)(t + 2) * kstep; const char* b2 = last ? nB : cB + (size_t)(t + 2) * kstep;
            const char* a3 = a2 + kstep; const char* b3 = b2 + kstep;
            if (last && has_next) S.a_ready(nxt);
            if constexpr (SP2) {
            PG8_LDB(B0, 0, 0); PG8_LDB(B1, 0, 1); PG8_SCHED; PG8_LDA(At, 0, 0); PG8_STAGE(PG8_SA(1, 1), a1 + hstep, voffA);
            PG8_WAIT_V(8); PG8_WAIT_L(0); PG8_BAR; PG8_MMA(0, 0, At, B0); PG8_MMA(0, 1, At, B1); PG8_BAR; PG8_SCHED;
            PG8_LDA(At, 0, 1); PG8_STAGE(PG8_SB(0, 0), b2, voffB); PG8_STAGE(PG8_SB(0, 1), b2 + hstep, voffB); PG8_STAGE(PG8_SA(0, 0), a2, voffA);
            PG8_WAIT_V(8); PG8_WAIT_L(0); PG8_BAR; PG8_MMA(1, 0, At, B0); PG8_MMA(1, 1, At, B1); PG8_BAR; PG8_SCHED;
            PG8_LDB(B0, 1, 0); PG8_LDB(B1, 1, 1); PG8_SCHED; PG8_LDA(At, 1, 0); PG8_STAGE(PG8_SA(0, 1), a2 + hstep, voffA);
            PG8_WAIT_V(8); PG8_WAIT_L(0); PG8_BAR; PG8_MMA(0, 0, At, B0); PG8_MMA(0, 1, At, B1); PG8_BAR; PG8_SCHED;
            PG8_LDA(At, 1, 1); PG8_STAGE(PG8_SB(1, 0), b3, voffB); PG8_STAGE(PG8_SB(1, 1), b3 + hstep, voffB); PG8_STAGE(PG8_SA(1, 0), a3, voffA);
            PG8_WAIT_V(8); PG8_WAIT_L(0); PG8_BAR; PG8_MMA(1, 0, At, B0); PG8_MMA(1, 1, At, B1); PG8_BAR; PG8_SCHED;
            } else {
            PG8_LDB(B0, 0, 0); PG8_SCHED; PG8_LDA(At, 0, 0); PG8_STAGE(PG8_SA(1, 1), a1 + hstep, voffA);
            PG8_WAIT_L(8); PG8_BAR; PG8_WAIT_L(0); PG8_MMA(0, 0, At, B0); PG8_BAR; PG8_SCHED;
            PG8_LDB(B1, 0, 1); PG8_STAGE(PG8_SB(0, 0), b2, voffB);
            PG8_BAR; PG8_WAIT_L(0); PG8_MMA(0, 1, At, B1); PG8_BAR;
            PG8_LDA(At, 0, 1); PG8_STAGE(PG8_SA(0, 0), a2, voffA);
            PG8_BAR; PG8_WAIT_L(0); PG8_MMA(1, 0, At, B0); PG8_BAR; PG8_SCHED;
            PG8_STAGE(PG8_SB(0, 1), b2 + hstep, voffB);
            PG8_WAIT_V(6); PG8_BAR; PG8_MMA(1, 1, At, B1); PG8_BAR;
            PG8_LDB(B0, 1, 0); PG8_SCHED; PG8_LDA(At, 1, 0); PG8_STAGE(PG8_SA(0, 1), a2 + hstep, voffA);
            PG8_WAIT_L(8); PG8_BAR; PG8_WAIT_L(0); PG8_MMA(0, 0, At, B0); PG8_BAR; PG8_SCHED;
            PG8_LDB(B1, 1, 1); PG8_STAGE(PG8_SB(1, 0), b3, voffB);
            PG8_BAR; PG8_WAIT_L(0); PG8_MMA(0, 1, At, B1); PG8_BAR;
            PG8_LDA(At, 1, 1); PG8_STAGE(PG8_SA(1, 0), a3, voffA);
            PG8_BAR; PG8_WAIT_L(0); PG8_MMA(1, 0, At, B0); PG8_BAR; PG8_SCHED;
            PG8_STAGE(PG8_SB(1, 1), b3 + hstep, voffB);
            PG8_WAIT_V(6); PG8_BAR; PG8_MMA(1, 1, At, B1); PG8_BAR;
            }
        }
        if constexpr (ALIGN_EPI) { if (wr == 0) PG8_BAR; }
        if constexpr (!Epi::AFTER_DRAIN) { E(acc, cur, wr, wc, fr, fq); S.done(cur); }
        if (!has_next) break;
#pragma unroll
        for (int a = 0; a < 2; ++a)
#pragma unroll
            for (int b = 0; b < 2; ++b)
#pragma unroll
                for (int m = 0; m < 4; ++m)
#pragma unroll
                    for (int n = 0; n < 2; ++n) acc[a][b][m][n] = (f32x4){0.f, 0.f, 0.f, 0.f};
        cur = nxt; cA = nA; cB = nB; ++ui;
        if constexpr (ALIGN_EPI) { if (wr == 1) PG8_BAR; }
    }
    PG8_WAIT_V(0);
    if constexpr (!ALIGN_EPI) { if (wr == 0) PG8_BAR; }
    PG8_BAR;
    if constexpr (Epi::AFTER_DRAIN) { E.fused(acc, cur, wr, wc, fr, fq, lds, wid, lane); S.done(cur); }
#undef PG8_SA
#undef PG8_SB
#undef PG8_STAGE
#undef PG8_LDA
#undef PG8_LDB
#undef PG8_MMA
#undef PG8_WAIT_V
#undef PG8_WAIT_L
#undef PG8_BAR
#undef PG8_SCHED
}
}
namespace att {
constexpr int NW = 8, QBLK = 32, KVBLK = 64, LDQ = 512, LDO = KCAT;
constexpr int SHM_V = 16384, SHM_K = 16384, SHM_ATTN = 3 * SHM_V + 2 * SHM_K + NW * 64 * 4;
constexpr float THR = 8.f;
#ifndef ATT_SDEPTH
#define ATT_SDEPTH 1
#endif
constexpr int SDEPTH = ATT_SDEPTH;
#define KSWZ(row, colB) ((row) * 256 + ((colB) ^ (((row) & 7) << 4)))
#define SBAR() __builtin_amdgcn_sched_barrier(0)
__device__ __forceinline__ int crow(int r, int hi) { return (r & 3) + 8 * (r >> 2) + 4 * hi; }
__device__ __forceinline__ unsigned cvtpk(float lo, float hi) { return cvt2bf(lo, hi); }

__device__ __forceinline__ void partialSM(f32x16& p0, f32x16& p1, float& m_reg, float& mn, float& alpha) {
  constexpr float C = 1.4426950408889634f;
  float pmax = p0[0];
#pragma unroll
  for (int r = 1; r < 16; ++r) pmax = fmaxf(pmax, p0[r]);
#pragma unroll
  for (int r = 0; r < 16; ++r) pmax = fmaxf(pmax, p1[r]);
  { auto rr = __builtin_amdgcn_permlane32_swap(__float_as_uint(pmax), __float_as_uint(pmax), false, false);
    pmax = fmaxf(__uint_as_float(rr[0]), __uint_as_float(rr[1])); }
  if (__builtin_expect(__all(pmax - m_reg <= THR), 1)) { mn = m_reg; alpha = 1.f; }
  else { mn = fmaxf(m_reg, pmax); alpha = __builtin_amdgcn_exp2f((m_reg - mn) * C); m_reg = mn; }
  const float mnC = -mn * C;
#pragma unroll
  for (int r = 0; r < 16; ++r) p0[r] = fmaf(p0[r], C, mnC);
#pragma unroll
  for (int r = 0; r < 16; ++r) p1[r] = fmaf(p1[r], C, mnC);
#pragma unroll
  for (int r = 0; r < 16; ++r) p0[r] = __builtin_amdgcn_exp2f(p0[r]);
}
__device__ __forceinline__ void finishSM(f32x16& p0, f32x16& p1, float alpha, float& l_reg, bf16x8& pa0, bf16x8& pa1, bf16x8& pa2, bf16x8& pa3) {
#pragma unroll
  for (int r = 0; r < 16; ++r) p1[r] = __builtin_amdgcn_exp2f(p1[r]);
  float ps = 0;
#pragma unroll
  for (int r = 0; r < 16; ++r) ps += p0[r];
#pragma unroll
  for (int r = 0; r < 16; ++r) ps += p1[r];
  { auto rr = __builtin_amdgcn_permlane32_swap(__float_as_uint(ps), __float_as_uint(ps), false, false);
    ps = __uint_as_float(rr[0]) + __uint_as_float(rr[1]); }
  l_reg = l_reg * alpha + ps;
#define PK4(P, BASE, OUT) do { unsigned a0 = cvtpk(P[BASE + 0], P[BASE + 1]), a1 = cvtpk(P[BASE + 2], P[BASE + 3]);   \
    unsigned b0 = cvtpk(P[BASE + 4], P[BASE + 5]), b1 = cvtpk(P[BASE + 6], P[BASE + 7]);                              \
    auto r0 = __builtin_amdgcn_permlane32_swap(a0, b0, false, false); auto r1 = __builtin_amdgcn_permlane32_swap(a1, b1, false, false); \
    u32x4 w = {r0[0], r1[0], r0[1], r1[1]}; OUT = *reinterpret_cast<bf16x8*>(&w); } while (0)
  PK4(p0, 0, pa0); PK4(p0, 8, pa1); PK4(p1, 0, pa2); PK4(p1, 8, pa3);
#undef PK4
}
__device__ __forceinline__ void qkt(f32x16& p0, f32x16& p1, const char* Ks, const bf16x8* qr, int r32, int hi, int kcol) {
  p0 = f32x16{}; p1 = f32x16{};
#pragma unroll
  for (int d0 = 0; d0 < 4; ++d0) { const int cb = kcol + (d0 * 16 + hi * 8) * 2;
    const bf16x8 b0 = *reinterpret_cast<const bf16x8*>(Ks + KSWZ(r32, cb));
    const bf16x8 b1 = *reinterpret_cast<const bf16x8*>(Ks + KSWZ(32 + r32, cb));
    p0 = __builtin_amdgcn_mfma_f32_32x32x16_bf16(b0, qr[d0], p0, 0, 0, 0);
    p1 = __builtin_amdgcn_mfma_f32_32x32x16_bf16(b1, qr[d0], p1, 0, 0, 0); }
}
__device__ __forceinline__ int v_st(int k, int c) { const int kk = (k & ~0xC) | ((k & 4) << 1) | ((k & 8) >> 1); return ((kk >> 3) * 4 + (c >> 5)) * 512 + ((kk & 7) * 32 + (c & 31)) * 2; }
__device__ __forceinline__ int v_rd_base(int lane) { return ((lane & 3) << 3) | (((lane >> 2) & 3) << 6) | (((lane >> 4) & 1) << 5) | (((lane >> 5) & 1) << 8); }
constexpr int v_rd_off(int d0, int ks, int half) { return d0 * 512 + ks * 4096 + half * 2048; }
template <int OFF> __device__ __forceinline__ s16x4 tr_read(int vb) {
  s16x4 r; asm volatile("ds_read_b64_tr_b16 %0, %1 offset:%2" : "=&v"(r) : "v"(vb), "i"(OFF) : "memory"); return r;
}
template <int D0> __device__ __forceinline__ void pv_one(f32x16& od, int vb, bf16x8 pa0, bf16x8 pa1, bf16x8 pa2, bf16x8 pa3) {
  const s16x4 l0 = tr_read<v_rd_off(D0, 0, 0)>(vb), h0 = tr_read<v_rd_off(D0, 0, 1)>(vb), l1 = tr_read<v_rd_off(D0, 1, 0)>(vb), h1 = tr_read<v_rd_off(D0, 1, 1)>(vb);
  const s16x4 l2 = tr_read<v_rd_off(D0, 2, 0)>(vb), h2 = tr_read<v_rd_off(D0, 2, 1)>(vb), l3 = tr_read<v_rd_off(D0, 3, 0)>(vb), h3 = tr_read<v_rd_off(D0, 3, 1)>(vb);
  asm volatile("s_waitcnt lgkmcnt(0)" ::: "memory"); SBAR();
#define PK(L, H) (bf16x8){L[0], L[1], L[2], L[3], H[0], H[1], H[2], H[3]}
  od = __builtin_amdgcn_mfma_f32_32x32x16_bf16(pa0, PK(l0, h0), od, 0, 0, 0);
  od = __builtin_amdgcn_mfma_f32_32x32x16_bf16(pa1, PK(l1, h1), od, 0, 0, 0);
  od = __builtin_amdgcn_mfma_f32_32x32x16_bf16(pa2, PK(l2, h2), od, 0, 0, 0);
  od = __builtin_amdgcn_mfma_f32_32x32x16_bf16(pa3, PK(l3, h3), od, 0, 0, 0);
#undef PK
}
__device__ __forceinline__ void pv_d0(f32x16* o, int vb, bf16x8 pa0, bf16x8 pa1, bf16x8 pa2, bf16x8 pa3) {
  pv_one<0>(o[0], vb, pa0, pa1, pa2, pa3); pv_one<1>(o[1], vb, pa0, pa1, pa2, pa3); pv_one<2>(o[2], vb, pa0, pa1, pa2, pa3); pv_one<3>(o[3], vb, pa0, pa1, pa2, pa3);
}

template <int VAR>
__device__ __forceinline__ void attn_unit(const bf16_t* __restrict__ Qb, const bf16_t* __restrict__ Kh, const bf16_t* __restrict__ Vh, int nkeys,
                                          bf16_t* __restrict__ Ob, float lam, float osc, const float* __restrict__ sg, char* lds, const int tid) {
  const int wid = __builtin_amdgcn_readfirstlane(tid >> 6), lane = tid & 63, r32 = lane & 31, hi = lane >> 5;
  const int comp = wid >> 2, qw = wid & 3, kcol = comp * 128;
  char* K_lds = lds; char* V_lds = lds + 2 * SHM_K;
  float* ws = (float*)(lds + 2 * SHM_K + 3 * SHM_V) + wid * 64; float* li_l = ws; float* al_l = ws + 32;
  float m_reg = -1e30f, l_reg = 0; f32x16 o[4] = {}; bf16x8 qr[4];
  const bf16_t* Qw = Qb + (long)(qw * QBLK + r32) * LDQ + comp * 64 + hi * 8;
#pragma unroll
  for (int d0 = 0; d0 < 4; ++d0) qr[d0] = *reinterpret_cast<const bf16x8*>(Qw + d0 * 16);
  const int sr = tid >> 4, sc = (tid & 15) * 8, vst0 = v_st(sr, sc), vst1 = v_st(32 + sr, sc);
  const int vb0 = (int)(uintptr_t)V_lds + v_rd_base(lane);
  bf16x8 sk0 = {}, sk1 = {}, sv0 = {}, sv1 = {};
#define LOADK(t) do { if constexpr (!(VAR & 8)) { sk0 = *reinterpret_cast<const bf16x8*>(&Kh[(long)((t) * KVBLK + sr) * LDQ + sc]); sk1 = *reinterpret_cast<const bf16x8*>(&Kh[(long)((t) * KVBLK + 32 + sr) * LDQ + sc]); } } while (0)
#define LOADV(t) do { if constexpr (!(VAR & 8)) { sv0 = *reinterpret_cast<const bf16x8*>(&Vh[(long)((t) * KVBLK + sr) * LDQ + sc]); sv1 = *reinterpret_cast<const bf16x8*>(&Vh[(long)((t) * KVBLK + 32 + sr) * LDQ + sc]); } } while (0)
#define WRITEK(slot) do { if constexpr (!(VAR & 8)) { *(bf16x8*)(K_lds + (slot) * SHM_K + KSWZ(sr, sc * 2)) = sk0; *(bf16x8*)(K_lds + (slot) * SHM_K + KSWZ(32 + sr, sc * 2)) = sk1; } } while (0)
#define WRITEV(off) do { if constexpr (!(VAR & 8)) { *(bf16x8*)(V_lds + (off) + vst0) = sv0; *(bf16x8*)(V_lds + (off) + vst1) = sv1; } } while (0)
#define VMW() asm volatile("s_waitcnt vmcnt(0)" ::: "memory")
#define QKT(P0, P1, KS) do { if constexpr (VAR & 4) { P0 = f32x16{}; P1 = f32x16{}; asm volatile("" : "+v"(P0), "+v"(P1)); } else qkt(P0, P1, KS, qr, r32, hi, kcol); } while (0)
#define PSM(P0, P1, MN, AL) do { if constexpr (VAR & 1) { MN = m_reg; AL = 1.f; asm volatile("" : "+v"(P0), "+v"(P1)); } else partialSM(P0, P1, m_reg, MN, AL); } while (0)
#define FSM(P0, P1, AL) do { if constexpr (VAR & 1) { asm volatile("" : "+v"(P0), "+v"(P1)); pa0 = __builtin_bit_cast(bf16x8, (f32x4){P0[0], P0[1], P0[2], P0[3]}); pa1 = __builtin_bit_cast(bf16x8, (f32x4){P0[4], P0[5], P0[6], P0[7]}); pa2 = __builtin_bit_cast(bf16x8, (f32x4){P1[0], P1[1], P1[2], P1[3]}); pa3 = __builtin_bit_cast(bf16x8, (f32x4){P1[4], P1[5], P1[6], P1[7]}); } else finishSM(P0, P1, AL, l_reg, pa0, pa1, pa2, pa3); } while (0)
#define PV(OFF) do { if constexpr (VAR & 2) { asm volatile("" : "+v"(pa0), "+v"(pa1), "+v"(pa2), "+v"(pa3)); } else pv_d0(o, vb0 + (OFF), pa0, pa1, pa2, pa3); } while (0)
#define RESC(a) do { if (__any((a) < 1.f)) { if (hi == 0) al_l[r32] = (a); asm volatile("s_waitcnt lgkmcnt(0)" ::: "memory"); \
    _Pragma("unroll") for (int d = 0; d < 4; ++d) _Pragma("unroll") for (int r = 0; r < 16; ++r) o[d][r] *= al_l[crow(r, hi)]; } } while (0)
  f32x16 pA0, pA1, pB0, pB1; float mnA, mnB, alA, alB; bf16x8 pa0, pa1, pa2, pa3; const int NT = nkeys / KVBLK;
  LOADK(0); VMW(); WRITEK(0); LOADK(1); LOADV(0);
  __syncthreads();
  if (comp == 1) __syncthreads();
  VMW(); WRITEK(1); WRITEV(0);
  SBAR(); QKT(pA0, pA1, K_lds); SBAR();
  __syncthreads();
  LOADK(2); LOADV(1); SBAR();
  PSM(pA0, pA1, mnA, alA);
  __syncthreads();
  int va = 0, vb = SHM_V, vc = 2 * SHM_V;
  for (int j = 1; j + 1 < NT; j += 2) {
    VMW(); WRITEK(0); WRITEV(vb);
    SBAR(); QKT(pB0, pB1, K_lds + SHM_K);
    FSM(pA0, pA1, alA); SBAR();
    __syncthreads();
    LOADK(j + 2); LOADV(j + 1); SBAR();
    PV(va); PSM(pB0, pB1, mnB, alB);
    RESC(alB);
    __syncthreads();
    VMW(); WRITEK(1); WRITEV(vc);
    SBAR(); QKT(pA0, pA1, K_lds);
    FSM(pB0, pB1, alB); SBAR();
    __syncthreads();
    if (j + 3 < NT) LOADK(j + 3);
    LOADV(j + 2); SBAR();
    PV(vb); PSM(pA0, pA1, mnA, alA);
    RESC(alA);
    __syncthreads();
    { const int t = va; va = vc; vc = vb; vb = t; }
  }
  VMW(); WRITEV(vb);
  SBAR(); QKT(pB0, pB1, K_lds + SHM_K);
  FSM(pA0, pA1, alA); SBAR();
  __syncthreads();
  PV(va); PSM(pB0, pB1, mnB, alB);
  RESC(alB);
  __syncthreads();
  FSM(pB0, pB1, alB); SBAR();
  PV(vb);
  if (comp == 0) __syncthreads();
  if (hi == 0) li_l[r32] = l_reg; asm volatile("s_waitcnt lgkmcnt(0)" ::: "memory");
  float rli[16];
#pragma unroll
  for (int r = 0; r < 16; ++r) rli[r] = __builtin_amdgcn_rcpf(li_l[crow(r, hi)]);
  __syncthreads();
  float* XO = (float*)lds + qw * (32 * 128);
  if (comp == 1) {
#pragma unroll
    for (int r = 0; r < 16; ++r)
#pragma unroll
      for (int d0 = 0; d0 < 4; ++d0) XO[crow(r, hi) * 128 + d0 * 32 + r32] = o[d0][r] * rli[r];
  }
  __syncthreads();
  if (comp == 0) {
    float ss[16];
#pragma unroll
    for (int r = 0; r < 16; ++r) { float s = 0.f;
#pragma unroll
      for (int d0 = 0; d0 < 4; ++d0) { const float v = o[d0][r] * rli[r] - lam * XO[crow(r, hi) * 128 + d0 * 32 + r32]; o[d0][r] = v; s += v * v; }
      ss[r] = s; }
#pragma unroll
    for (int r = 0; r < 16; ++r) { float s = ss[r]; s += swz_xor<1>(s); s += swz_xor<2>(s); s += swz_xor<4>(s); s += swz_xor<8>(s); s += swz_xor<16>(s);
      ss[r] = osc / sqrtf(s * (1.0f / 128.0f) + EPS); }
    float gam[4];
#pragma unroll
    for (int d0 = 0; d0 < 4; ++d0) gam[d0] = sg[d0 * 32 + r32];
    asm volatile("s_waitcnt lgkmcnt(0)" ::: "memory");
    bf16_t* stg = (bf16_t*)XO;
#pragma unroll
    for (int r = 0; r < 16; ++r)
#pragma unroll
      for (int d0 = 0; d0 < 4; ++d0) stg[crow(r, hi) * 128 + d0 * 32 + r32] = (bf16_t)(cvtpk(o[d0][r] * ss[r] * gam[d0], 0.f) & 0xffffu);
    asm volatile("s_waitcnt lgkmcnt(0)" ::: "memory");
#pragma unroll
    for (int i = 0; i < 8; ++i) { const int row = i * 4 + (lane >> 4), ch = lane & 15; const u32x4 v = *(const u32x4*)(stg + row * 128 + ch * 8);
      if constexpr (VAR & 16) { asm volatile("" :: "v"(v.x), "v"(v.y), "v"(v.z), "v"(v.w)); } else *(u32x4*)(Ob + (long)(qw * QBLK + row) * LDO + ch * 8) = v; }
  }
  __syncthreads();
#undef LOADK
#undef LOADV
#undef WRITEK
#undef WRITEV
#undef VMW
#undef QKT
#undef PSM
#undef FSM
#undef PV
#undef RESC
}
#undef KSWZ
#undef SBAR
}
namespace att2 {
using att::crow; using att::v_st; using att::v_rd_base; using att::v_rd_off;
constexpr int NW = 8, QBLK = 32, KVBLK = 64, LDQ = 512, LDO = KCAT, SHM_K = 16384, SHM_V = 16384;
constexpr float THRL = 8.0f;
#ifndef ATT_STAGGER
#define ATT_STAGGER 1
#endif
typedef short v4i16_t __attribute__((ext_vector_type(4)));
typedef __attribute__((address_space(3))) const char* lds_cptr;
typedef __attribute__((address_space(3))) char* lds_ptr;
#define SBAR() __builtin_amdgcn_sched_barrier(0)
#define KSWZ(row, colB) ((row) * 256 + ((colB) ^ (((row) & 7) << 4)))
__device__ __forceinline__ s16x4 vtr(lds_cptr p) { return __builtin_bit_cast(s16x4, __builtin_amdgcn_ds_read_tr16_b64_v4i16((__attribute__((address_space(3))) v4i16_t*)p)); }
__device__ __forceinline__ bf16x8 ldk(lds_cptr p) { return *(const __attribute__((address_space(3))) bf16x8*)p; }
#define MF(D, A, B, C) do { if constexpr (VAR & 4) { asm volatile("" : "+v"(D)); } else D = __builtin_amdgcn_mfma_f32_32x32x16_bf16(A, B, C, 0, 0, 0); } while (0)
#define VF(L, H) (bf16x8){L[0], L[1], L[2], L[3], H[0], H[1], H[2], H[3]}

__device__ __forceinline__ int vkey(int g) { const int s_ = g >> 5, kk = ((s_ >> 2) << 3) | ((g >> 2) & 7); return (kk & ~0xC) | ((kk & 4) << 1) | ((kk & 8) >> 1); }
template <int VAR>
__device__ __forceinline__ void attn_unit(const bf16_t* __restrict__ Qb, const bf16_t* __restrict__ Kh, const bf16_t* __restrict__ Vh, int nkeys,
                                          bf16_t* __restrict__ Ob, float lam, float osc, const float* __restrict__ sg, char* lds, const int tid) {
  const int wid = __builtin_amdgcn_readfirstlane(tid >> 6), lane = tid & 63, r32 = lane & 31, hi = lane >> 5;
  const int comp = wid >> 2, qw = wid & 3, kcol = comp * 128;
  const lds_ptr L3 = (lds_ptr)(unsigned)(uintptr_t)lds;
  float* ws = (float*)(lds + 3 * SHM_K + 3 * SHM_V) + wid * 64; float* li_l = ws; float* al_l = ws + 32;
  float mhat = 0.f, l_reg = 0.f; f32x16 o[4] = {}; bf16x8 qr[4]; f32x16 negm = {};
  const bf16_t* Qw = Qb + (long)(qw * QBLK + r32) * LDQ + comp * 64 + hi * 8;
#pragma unroll
  for (int d0 = 0; d0 < 4; ++d0) qr[d0] = *reinterpret_cast<const bf16x8*>(Qw + d0 * 16);
  const int sr = tid >> 4, sc = (tid & 15) * 8;
  const int kr0 = 4 * wid + (lane >> 4), kr1 = kr0 + 32;
  const bf16_t* ksrc0 = Kh + (long)kr0 * LDQ + (((lane & 15) ^ (kr0 & 7)) << 3); const bf16_t* ksrc1 = Kh + (long)kr1 * LDQ + (((lane & 15) ^ (kr1 & 7)) << 3);
  const int g0_ = 64 * wid + lane, g1_ = g0_ + 512;
  const int vk0 = vkey(g0_), vk1 = vkey(g1_);
  const bf16_t* vsrc0 = Vh + (long)vk0 * LDQ + ((g0_ >> 5) & 3) * 32 + (g0_ & 3) * 8; const bf16_t* vsrc1 = Vh + (long)vk1 * LDQ + ((g1_ >> 5) & 3) * 32 + (g1_ & 3) * 8;
  const unsigned kd0 = (unsigned)(uintptr_t)lds + wid * 1024, kd1 = kd0 + 8192, vd0 = (unsigned)(uintptr_t)lds + 3 * SHM_K + wid * 1024, vd1 = vd0 + 8192;
  lds_cptr kq[4];
#pragma unroll
  for (int d0 = 0; d0 < 4; ++d0) kq[d0] = L3 + r32 * 256 + ((kcol + d0 * 32 + hi * 16) ^ ((r32 & 7) << 4));
  const lds_cptr vp0 = L3 + 3 * SHM_K + v_rd_base(lane);
#define GLDS(src, dst) __builtin_amdgcn_global_load_lds((const unsigned*)(src), (__attribute__((address_space(3))) unsigned*)(dst), 16, 0, 0)
#define DMAK(t, slot) do { if constexpr (!(VAR & 8)) { GLDS(ksrc0 + (long)(t) * KVBLK * LDQ, (unsigned)__builtin_amdgcn_readfirstlane(kd0 + (slot) * SHM_K)); GLDS(ksrc1 + (long)(t) * KVBLK * LDQ, (unsigned)__builtin_amdgcn_readfirstlane(kd1 + (slot) * SHM_K)); } } while (0)
#define DMAV(t, off) do { if constexpr (!(VAR & 8)) { GLDS(vsrc0 + (long)(t) * KVBLK * LDQ, (unsigned)__builtin_amdgcn_readfirstlane(vd0 + (off))); GLDS(vsrc1 + (long)(t) * KVBLK * LDQ, (unsigned)__builtin_amdgcn_readfirstlane(vd1 + (off))); } } while (0)
#ifndef ATT_PRIO
#define ATT_PRIO 1
#endif
#define PRIO(x) do { if (ATT_PRIO == 1) __builtin_amdgcn_s_setprio(x); } while (0)
#define PRIO1(x) do { if (ATT_PRIO == 2) __builtin_amdgcn_s_setprio(x); } while (0)
#define VMW() asm volatile("s_waitcnt vmcnt(0)" ::: "memory")
#define BARW(n) do { asm volatile("s_waitcnt vmcnt(" #n ") lgkmcnt(0)" ::: "memory"); __builtin_amdgcn_s_barrier(); asm volatile("" ::: "memory"); } while (0)
  f32x16 pA0, pA1, pB0, pB1; u32x4 pw0 = {}, pw1 = {}, pw2 = {}, pw3 = {}; const int NT = nkeys / KVBLK; bool resc = false;
#define KF(KOFF, d0, half) ldk(kq[d0] + (KOFF) + 8192 * (half))
#define PKA(P, B, A0, A1) do { if constexpr (!(VAR & 1)) { A0 = cvt2bf(P[B + 0], P[B + 1]); A1 = cvt2bf(P[B + 2], P[B + 3]); sacc += P[B + 0]; sacc += P[B + 1]; sacc += P[B + 2]; sacc += P[B + 3]; } } while (0)
#define PKB(P, B, A0, A1, PW) do { if constexpr (!(VAR & 1)) { const unsigned b0_ = cvt2bf(P[B + 4], P[B + 5]), b1_ = cvt2bf(P[B + 6], P[B + 7]); \
    auto r0_ = __builtin_amdgcn_permlane32_swap(A0, b0_, false, false); auto r1_ = __builtin_amdgcn_permlane32_swap(A1, b1_, false, false); \
    PW = (u32x4){r0_[0], r1_[0], r0_[1], r1_[1]}; sacc += P[B + 4]; sacc += P[B + 5]; sacc += P[B + 6]; sacc += P[B + 7]; } } while (0)
#define H1(C0, C1, P0, P1, KOFF, FIN) do { \
    float sacc = 0.f; unsigned a0_ = 0, a1_ = 0; \
    bf16x8 f0 = KF(KOFF, 0, 0), f1 = KF(KOFF, 0, 1), f2 = KF(KOFF, 1, 0); SBAR(); \
    MF(C0, f0, qr[0], negm); { f0 = KF(KOFF, 1, 1); if (FIN) PKA(P0, 0, a0_, a1_); } SBAR(); \
    MF(C1, f1, qr[0], negm); { f1 = KF(KOFF, 2, 0); if (FIN) PKB(P0, 0, a0_, a1_, pw0); } SBAR(); \
    MF(C0, f2, qr[1], C0);   { f2 = KF(KOFF, 2, 1); if (FIN) PKA(P0, 8, a0_, a1_); } SBAR(); \
    MF(C1, f0, qr[1], C1);   { f0 = KF(KOFF, 3, 0); if (FIN) PKB(P0, 8, a0_, a1_, pw1); } SBAR(); \
    MF(C0, f1, qr[2], C0);   { f1 = KF(KOFF, 3, 1); if (FIN) PKA(P1, 0, a0_, a1_); } SBAR(); \
    MF(C1, f2, qr[2], C1);   { if (FIN) PKB(P1, 0, a0_, a1_, pw2); } SBAR(); \
    MF(C0, f0, qr[3], C0);   { if (FIN) PKA(P1, 8, a0_, a1_); } SBAR(); \
    MF(C1, f1, qr[3], C1);   { if (FIN) PKB(P1, 8, a0_, a1_, pw3); } SBAR(); \
    if (FIN) { auto rr_ = __builtin_amdgcn_permlane32_swap(__float_as_uint(sacc), __float_as_uint(sacc), false, false); l_reg += __uint_as_float(rr_[0]) + __uint_as_float(rr_[1]); } \
  } while (0)
#define VRD(VOFF, ks, d0, LO, HI) do { LO = vtr(vp0 + (VOFF) + v_rd_off(d0, ks, 0)); HI = vtr(vp0 + (VOFF) + v_rd_off(d0, ks, 1)); } while (0)
#define PAF(k) __builtin_bit_cast(bf16x8, pw##k)
#define MX3(a, b, c) ((VAR & 2) ? (a) : fmaxf(fmaxf((a), (b)), (c)))
#define EX(X, i) do { if constexpr (!(VAR & 2)) X[i] = __builtin_amdgcn_exp2f(X[i]); } while (0)
#define PIN2(X, Y) asm volatile("" : "+v"(X), "+v"(Y))
#define H2(C0, C1, VOFF, DOPV, FIRST) do { \
    s16x4 l0, h0, l1, h1, l2, h2; float ma, mb, rm; \
    if (DOPV) { VRD(VOFF, 0, 0, l0, h0); VRD(VOFF, 0, 1, l1, h1); VRD(VOFF, 0, 2, l2, h2); } SBAR(); \
    if (DOPV) { MF(o[0], PAF(0), VF(l0, h0), o[0]); VRD(VOFF, 0, 3, l0, h0); } ma = MX3(C0[0], C0[1], C1[0]); mb = MX3(C0[2], C0[3], C1[1]); ma = MX3(ma, C1[2], C1[3]); mb = MX3(mb, C0[4], C0[5]); SBAR(); \
    if (DOPV) { MF(o[1], PAF(0), VF(l1, h1), o[1]); VRD(VOFF, 1, 0, l1, h1); } ma = MX3(ma, C0[6], C0[7]); mb = MX3(mb, C1[4], C1[5]); ma = MX3(ma, C1[6], C1[7]); mb = MX3(mb, C0[8], C0[9]); SBAR(); \
    if (DOPV) { MF(o[2], PAF(0), VF(l2, h2), o[2]); VRD(VOFF, 1, 1, l2, h2); } ma = MX3(ma, C0[10], C0[11]); mb = MX3(mb, C1[8], C1[9]); ma = MX3(ma, C1[10], C1[11]); mb = MX3(mb, C0[12], C0[13]); SBAR(); \
    if (DOPV) { MF(o[3], PAF(0), VF(l0, h0), o[3]); VRD(VOFF, 1, 2, l0, h0); } ma = MX3(ma, C0[14], C0[15]); mb = MX3(mb, C1[12], C1[13]); ma = MX3(ma, C1[14], C1[15]); rm = fmaxf(ma, mb); SBAR(); \
    if (DOPV) { MF(o[0], PAF(1), VF(l1, h1), o[0]); VRD(VOFF, 1, 3, l1, h1); } \
    { auto rr_ = __builtin_amdgcn_permlane32_swap(__float_as_uint(rm), __float_as_uint(rm), false, false); rm = fmaxf(__uint_as_float(rr_[0]), __uint_as_float(rr_[1])); } SBAR(); \
    resc = false; \
    if (FIRST || __builtin_expect(__any(rm > THRL), 0)) { const float dl = FIRST ? rm : fmaxf(rm, 0.f); mhat += dl; \
      _Pragma("unroll") for (int r = 0; r < 16; ++r) { C0[r] -= dl; C1[r] -= dl; } \
      _Pragma("unroll") for (int r = 0; r < 16; ++r) negm[r] = -mhat; \
      if (!(FIRST)) { const float f = __builtin_amdgcn_exp2f(-dl); l_reg *= f; if (hi == 0) al_l[r32] = f; resc = true; } } \
    SBAR(); \
    if (DOPV) { MF(o[1], PAF(1), VF(l2, h2), o[1]); VRD(VOFF, 2, 0, l2, h2); } EX(C0, 0); EX(C0, 1); EX(C0, 2); PIN2(C0, C1); SBAR(); \
    if (DOPV) { MF(o[2], PAF(1), VF(l0, h0), o[2]); VRD(VOFF, 2, 1, l0, h0); } EX(C0, 3); EX(C0, 4); EX(C0, 5); PIN2(C0, C1); SBAR(); \
    if (DOPV) { MF(o[3], PAF(1), VF(l1, h1), o[3]); VRD(VOFF, 2, 2, l1, h1); } EX(C0, 6); EX(C0, 7); EX(C0, 8); PIN2(C0, C1); SBAR(); \
    if (DOPV) { MF(o[0], PAF(2), VF(l2, h2), o[0]); VRD(VOFF, 2, 3, l2, h2); } EX(C0, 9); EX(C0, 10); EX(C0, 11); PIN2(C0, C1); SBAR(); \
    if (DOPV) { MF(o[1], PAF(2), VF(l0, h0), o[1]); VRD(VOFF, 3, 0, l0, h0); } EX(C0, 12); EX(C0, 13); EX(C0, 14); PIN2(C0, C1); SBAR(); \
    if (DOPV) { MF(o[2], PAF(2), VF(l1, h1), o[2]); VRD(VOFF, 3, 1, l1, h1); } EX(C0, 15); EX(C1, 0); EX(C1, 1); PIN2(C0, C1); SBAR(); \
    if (DOPV) { MF(o[3], PAF(2), VF(l2, h2), o[3]); VRD(VOFF, 3, 2, l2, h2); } EX(C1, 2); EX(C1, 3); EX(C1, 4); PIN2(C0, C1); SBAR(); \
    if (DOPV) { MF(o[0], PAF(3), VF(l0, h0), o[0]); VRD(VOFF, 3, 3, l0, h0); } EX(C1, 5); EX(C1, 6); EX(C1, 7); PIN2(C0, C1); SBAR(); \
    if (DOPV) { MF(o[1], PAF(3), VF(l1, h1), o[1]); } EX(C1, 8); EX(C1, 9); EX(C1, 10); PIN2(C0, C1); SBAR(); \
    if (DOPV) { MF(o[2], PAF(3), VF(l2, h2), o[2]); } EX(C1, 11); EX(C1, 12); EX(C1, 13); PIN2(C0, C1); SBAR(); \
    if (DOPV) { MF(o[3], PAF(3), VF(l0, h0), o[3]); } EX(C1, 14); EX(C1, 15); PIN2(C0, C1); SBAR(); \
    if (resc) { asm volatile("s_waitcnt lgkmcnt(0)" ::: "memory"); \
      _Pragma("unroll") for (int d = 0; d < 4; ++d) _Pragma("unroll") for (int r = 0; r < 16; ++r) o[d][r] *= al_l[crow(r, hi)]; } \
  } while (0)
#define PVONLY(VOFF) do { _Pragma("unroll") for (int ks = 0; ks < 4; ++ks) _Pragma("unroll") for (int d0 = 0; d0 < 4; ++d0) { s16x4 l_, h_; VRD(VOFF, ks, d0, l_, h_); \
      const bf16x8 pa_ = ks == 0 ? PAF(0) : ks == 1 ? PAF(1) : ks == 2 ? PAF(2) : PAF(3); MF(o[d0], pa_, VF(l_, h_), o[d0]); } } while (0)

  DMAK(0, 0); DMAK(1, 1); DMAV(0, 0);
  BARW(0);
  if (ATT_STAGGER && comp == 1) __builtin_amdgcn_s_barrier();
  H1(pA0, pA1, pB0, pB1, 0, false);
  BARW(0);
  DMAK(2, 2); DMAV(1, SHM_V); SBAR();
  H2(pA0, pA1, 0, false, true);
  BARW(4);
  int va = 0, vb = SHM_V, vc = 2 * SHM_V;
  for (int j = 1; j + 1 < NT; j += 2) {
    PRIO1(1); H1(pB0, pB1, pA0, pA1, vb, true); PRIO1(0);
    BARW(0);
    DMAK(j + 2, va >> 14); DMAV(j + 1, vc); SBAR();
    PRIO(1); H2(pB0, pB1, va, true, false); PRIO(0);
    BARW(4);
    PRIO1(1); H1(pA0, pA1, pB0, pB1, vc, true); PRIO1(0);
    BARW(0);
    if (j + 3 < NT) DMAK(j + 3, vb >> 14);
    DMAV(j + 2, va); SBAR();
    PRIO(1); H2(pA0, pA1, vb, true, false); PRIO(0);
    BARW(4);
    { const int t = va; va = vc; vc = vb; vb = t; }
  }
  H1(pB0, pB1, pA0, pA1, vb, true);
  BARW(0);
  H2(pB0, pB1, va, true, false);
  BARW(0);
  { float sacc = 0.f; unsigned a0_ = 0, a1_ = 0;
    PKA(pB0, 0, a0_, a1_); PKB(pB0, 0, a0_, a1_, pw0); PKA(pB0, 8, a0_, a1_); PKB(pB0, 8, a0_, a1_, pw1); PKA(pB1, 0, a0_, a1_); PKB(pB1, 0, a0_, a1_, pw2); PKA(pB1, 8, a0_, a1_); PKB(pB1, 8, a0_, a1_, pw3);
    auto rr_ = __builtin_amdgcn_permlane32_swap(__float_as_uint(sacc), __float_as_uint(sacc), false, false); l_reg += __uint_as_float(rr_[0]) + __uint_as_float(rr_[1]); }
  SBAR(); PVONLY(vb);
  if (ATT_STAGGER && comp == 0) { asm volatile("s_waitcnt lgkmcnt(0)" ::: "memory"); __builtin_amdgcn_s_barrier(); }
  if (hi == 0) li_l[r32] = l_reg; asm volatile("s_waitcnt lgkmcnt(0)" ::: "memory");
  float rli[16];
#pragma unroll
  for (int r = 0; r < 16; ++r) rli[r] = __builtin_amdgcn_rcpf(li_l[crow(r, hi)]);
  __syncthreads();
  float* XO = (float*)lds + qw * (32 * 128);
  if (comp == 1) {
#pragma unroll
    for (int r = 0; r < 16; ++r)
#pragma unroll
      for (int d0 = 0; d0 < 4; ++d0) XO[crow(r, hi) * 128 + d0 * 32 + r32] = o[d0][r] * rli[r];
  }
  __syncthreads();
  if (comp == 0) {
    float ss[16];
#pragma unroll
    for (int r = 0; r < 16; ++r) { float s = 0.f;
#pragma unroll
      for (int d0 = 0; d0 < 4; ++d0) { const float v = o[d0][r] * rli[r] - lam * XO[crow(r, hi) * 128 + d0 * 32 + r32]; o[d0][r] = v; s += v * v; }
      ss[r] = s; }
#pragma unroll
    for (int r = 0; r < 16; ++r) { float s = ss[r]; s += swz_xor<1>(s); s += swz_xor<2>(s); s += swz_xor<4>(s); s += swz_xor<8>(s); s += swz_xor<16>(s);
      ss[r] = osc / sqrtf(s * (1.0f / 128.0f) + EPS); }
    float gam[4];
#pragma unroll
    for (int d0 = 0; d0 < 4; ++d0) gam[d0] = sg[d0 * 32 + r32];
    asm volatile("s_waitcnt lgkmcnt(0)" ::: "memory");
    bf16_t* stg = (bf16_t*)XO;
#pragma unroll
    for (int r = 0; r < 16; ++r)
#pragma unroll
      for (int d0 = 0; d0 < 4; ++d0) stg[crow(r, hi) * 128 + d0 * 32 + r32] = (bf16_t)(cvt2bf(o[d0][r] * ss[r] * gam[d0], 0.f) & 0xffffu);
    asm volatile("s_waitcnt lgkmcnt(0)" ::: "memory");
#pragma unroll
    for (int i = 0; i < 8; ++i) { const int row = i * 4 + (lane >> 4), ch = lane & 15; const u32x4 v = *(const u32x4*)(stg + row * 128 + ch * 8);
      if constexpr (VAR & 16) { asm volatile("" :: "v"(v.x), "v"(v.y), "v"(v.z), "v"(v.w)); } else *(u32x4*)(Ob + (long)(qw * QBLK + row) * LDO + ch * 8) = v; }
  }
  __syncthreads();
#undef GLDS
#undef DMAK
#undef DMAV
#undef VMW
#undef PRIO
#undef PRIO1
#undef BARW
#undef KF
#undef PKA
#undef PKB
#undef H1
#undef VRD
#undef PAF
#undef MX3
#undef EX
#undef PIN2
#undef H2
#undef PVONLY
}
#undef SBAR
#undef KSWZ
#undef MF
#undef VF
}
typedef GAS unsigned gu32;
#define RLX_AGENT __ATOMIC_RELAXED, __HIP_MEMORY_SCOPE_AGENT
constexpr int PT_OFF = LDSCTL_OFF + 1024;
__device__ __forceinline__ unsigned long long ldptr(volatile LAS unsigned long long* PT, int i) {
    const unsigned long long v = PT[i];
    const unsigned lo = __builtin_amdgcn_readfirstlane((unsigned)v), hi = __builtin_amdgcn_readfirstlane((unsigned)(v >> 32));
    return ((unsigned long long)hi << 32) | lo;
}
#define XB_TMO      128
#define XB_XCNT(j)  (256  + 64 * (j))
#define XB_XSUB(j)  (1280 + 64 * (j))
#define XB_XGEN(j)  (2304 + 64 * (j))
#define XB_TOP      3328
#define XB_TOPGEN   3392
#define XCD_BAR_WORDS 3456
#define XB_SPIN_CAP (1u << 18)

__device__ __forceinline__ unsigned xb_ld(unsigned* p)              { return __hip_atomic_load(p, __ATOMIC_RELAXED, __HIP_MEMORY_SCOPE_AGENT); }
__device__ __forceinline__ unsigned xb_add(unsigned* p, unsigned v) { return __hip_atomic_fetch_add(p, v, __ATOMIC_RELAXED, __HIP_MEMORY_SCOPE_AGENT); }
__device__ __forceinline__ unsigned xb_xcc_id() { return (unsigned)__builtin_amdgcn_s_getreg((3 << 11) | 20) & 0xFu; }
#define XB_SPIN(cond, bar) do { unsigned _sp = 0; while (cond) { __builtin_amdgcn_s_sleep(1); \
    if ((++_sp & 255u) == 0u) { if (xb_ld(&(bar)[XB_TMO])) break; if (_sp > XB_SPIN_CAP) { atomicAdd(&(bar)[XB_TMO], 1u); break; } } } } while (0)

struct XcdBarrier {
    unsigned* bar; unsigned x;
    volatile LAS unsigned* st;
};

__device__ __forceinline__ XcdBarrier xcd_barrier_post(unsigned* bar, volatile LAS unsigned* st) {
    XcdBarrier b; b.bar = bar; b.x = xb_xcc_id(); b.st = st;
    if (threadIdx.x == 0) (void)xb_add(&bar[XB_XCNT(b.x)], 1u);
    return b;
}
__device__ __forceinline__ void xcd_barrier_complete(unsigned* bar, unsigned x, unsigned& nloc, unsigned& nx) {
    const unsigned G = gridDim.x * gridDim.y * gridDim.z;
    unsigned sum, cnt, mine, sp = 0u;
    for (;;) {
        sum = 0u; cnt = 0u; mine = 0u;
#pragma unroll
        for (unsigned j = 0; j < 16; ++j) { const unsigned c = xb_ld(&bar[XB_XCNT(j)]); sum += c; cnt += (c > 0u) ? 1u : 0u; mine = (j == x) ? c : mine; }
        if (sum == G) break;
        __builtin_amdgcn_s_sleep(1);
        if ((++sp & 255u) == 0u) { if (xb_ld(&bar[XB_TMO])) break; if (sp > XB_SPIN_CAP) { atomicAdd(&bar[XB_TMO], 1u); break; } }
    }
    nloc = mine > 0u ? mine : 1u; nx = cnt > 0u ? cnt : 1u;
}

__device__ __forceinline__ void xcd_barrier(const XcdBarrier& b) {
    asm volatile("s_waitcnt vmcnt(0)" ::: "memory");
    __syncthreads();
    if (threadIdx.x == 0) {
        unsigned* bar = b.bar;
        __builtin_amdgcn_s_waitcnt(0);
        unsigned nloc = b.st[0], nx = b.st[1];
        if (nloc == 0u) { xcd_barrier_complete(bar, b.x, nloc, nx); b.st[0] = nloc; b.st[1] = nx; }
        const unsigned old = xb_add(&bar[XB_XSUB(b.x)], 1u);
        const unsigned gen = old / nloc;
        if (old + 1u == (gen + 1u) * nloc) {
            __builtin_amdgcn_fence(__ATOMIC_RELEASE, "agent");
            asm volatile("s_waitcnt vmcnt(0)" ::: "memory");
            const unsigned og = xb_add(&bar[XB_TOP], 1u);
            const unsigned tg = og / nx;
            if (og + 1u == (tg + 1u) * nx) xb_add(&bar[XB_TOPGEN], 1u);
            else XB_SPIN(xb_ld(&bar[XB_TOPGEN]) == tg, bar);
            __builtin_amdgcn_fence(__ATOMIC_ACQUIRE, "agent");
            xb_add(&bar[XB_XGEN(b.x)], 1u);
            asm volatile("s_waitcnt vmcnt(0)" ::: "memory");
        } else {
            XB_SPIN(xb_ld(&bar[XB_XGEN(b.x)]) == gen, bar);
            __builtin_amdgcn_fence(__ATOMIC_ACQUIRE, "agent");
            asm volatile("s_waitcnt vmcnt(0)" ::: "memory");
        }
    }
    __syncthreads();
}
__device__ __forceinline__ float wave_sum(float v) {
    v += swz_xor<1>(v); v += swz_xor<2>(v); v += swz_xor<4>(v); v += swz_xor<8>(v); v += swz_xor<16>(v);
    auto rr = __builtin_amdgcn_permlane32_swap(__float_as_uint(v), __float_as_uint(v), false, false);
    return __uint_as_float(rr[0]) + __uint_as_float(rr[1]);
}
__device__ __forceinline__ unsigned pk2(float lo, float hi) { return cvt2bf(lo, hi); }

template <int MAP  >
__device__ __forceinline__ void transpose_item(const float* W, int Nsrc, int coff, bf16_t* WT, int ldw, int koff, int nblk, LAS float* scr, int item, int lane) {
    const int kb = item / nblk, nb = item % nblk, k0 = 64 * kb, n0 = 32 * nb;
    const int nd = n0 + (lane & 31); const int scol = MAP ? in_map(nd) : nd + coff;
    float wv[32];
#pragma unroll
    for (int i = 0; i < 32; ++i) wv[i] = W[(size_t)(k0 + 2 * i + (lane >> 5)) * Nsrc + scol];
#pragma unroll
    for (int i = 0; i < 32; ++i) scr[(2 * i + (lane >> 5)) * 33 + (lane & 31)] = wv[i];
    asm volatile("s_waitcnt lgkmcnt(0)" ::: "memory");
    const int c = lane & 7;
#pragma unroll
    for (int j = 0; j < 4; ++j) { const int n = (lane >> 3) + 8 * j; const LAS float* s = scr + (8 * c) * 33 + n;
        u32x4 o; o.x = pk2(s[0 * 33], s[1 * 33]); o.y = pk2(s[2 * 33], s[3 * 33]); o.z = pk2(s[4 * 33], s[5 * 33]); o.w = pk2(s[6 * 33], s[7 * 33]);
        *(u32x4*)(WT + (size_t)(n0 + n) * ldw + koff + k0 + 8 * c) = o; }
    asm volatile("s_waitcnt lgkmcnt(0)" ::: "memory");
}
struct WSrc { const float *w_in, *wo_f, *wo_a, *wo_c, *wo_p, *w_out, *w_up, *w_down; };
constexpr int IT_A = 16 * 208;
constexpr int IT_B0 = 4 * 32, IT_B1 = 8 * 32, IT_B2 = 4 * 32, IT_B3 = 4 * 32, IT_B4 = 16 * 32, IT_B5 = 16 * 88, IT_B6 = 16 * 88, IT_B7 = 44 * 32;
constexpr int IT_B = IT_B0 + IT_B1 + IT_B2 + IT_B3 + IT_B4 + IT_B5 + IT_B6 + IT_B7;
__device__ __forceinline__ void convert_A(const WSrc& S, unsigned char* ws, LAS float* scr, int gw, int NGW, int lane) {
    for (int it = gw; it < IT_A; it += NGW) transpose_item<1>(S.w_in, NIN, 0, (bf16_t*)(ws + WS_WA), 1024, 0, 208, scr, it, lane);
}
__device__ __forceinline__ void convert_B(const WSrc& S, unsigned char* ws, LAS float* scr, int gw, int NGW, int lane) {
    for (int it = gw; it < IT_B; it += NGW) { int r = it;
        if (r < IT_B0) { transpose_item<0>(S.wo_f, 1024, 0, (bf16_t*)(ws + WS_WCAT), KCAT, 0, 32, scr, r, lane); continue; } r -= IT_B0;
        if (r < IT_B1) { transpose_item<0>(S.wo_a, 1024, 0, (bf16_t*)(ws + WS_WCAT), KCAT, 256, 32, scr, r, lane); continue; } r -= IT_B1;
        if (r < IT_B2) { transpose_item<0>(S.wo_c, 1024, 0, (bf16_t*)(ws + WS_WCAT), KCAT, 768, 32, scr, r, lane); continue; } r -= IT_B2;
        if (r < IT_B3) { transpose_item<0>(S.wo_p, 1024, 0, (bf16_t*)(ws + WS_WCAT), KCAT, 1024, 32, scr, r, lane); continue; } r -= IT_B3;
        if (r < IT_B4) { transpose_item<0>(S.w_out, 1024, 0, (bf16_t*)(ws + WS_WOUT), 1024, 0, 32, scr, r, lane); continue; } r -= IT_B4;
        if (r < IT_B5) { transpose_item<0>(S.w_up, 2 * DFF, DFF, (bf16_t*)(ws + WS_WUPG), 1024, 0, 88, scr, r, lane); continue; } r -= IT_B5;
        if (r < IT_B6) { transpose_item<0>(S.w_up, 2 * DFF, 0, (bf16_t*)(ws + WS_WUPV), 1024, 0, 88, scr, r, lane); continue; } r -= IT_B6;
        transpose_item<0>(S.w_down, 1024, 0, (bf16_t*)(ws + WS_WDN), DFF, 0, 32, scr, r, lane);
    }
}

__device__ __forceinline__ void mod_phase(const float* c, const float* c_ctx, const float* ada_w, const float* ada_b, float* MOD, LAS unsigned char* lds, int vcu, int G, int tid, int wave, int lane) {
    LAS float* sil = (LAS float*)lds;
    LAS float* red = (LAS float*)(lds + 12288);
    for (int i = tid; i < 3072; i += 512) { const float v = i < 2048 ? c[i] : c_ctx[i - 2048]; sil[i] = v * sigm(v); }
    __syncthreads();
    for (int item = vcu; item < 192; item += G) {
        const int l = item / 96, n = (item % 96) * 64 + lane;
        const float* W = ada_w + (size_t)l * 1024 * 6144 + n;
        float a0 = 0.f, a1 = 0.f, a2 = 0.f;
        for (int k = wave * 128; k < wave * 128 + 128; k += 8) { float w[8];
#pragma unroll
            for (int i = 0; i < 8; ++i) w[i] = W[(size_t)(k + i) * 6144];
#pragma unroll
            for (int i = 0; i < 8; ++i) { a0 += sil[k + i] * w[i]; a1 += sil[1024 + k + i] * w[i]; a2 += sil[2048 + k + i] * w[i]; } }
        red[(wave * 3 + 0) * 64 + lane] = a0; red[(wave * 3 + 1) * 64 + lane] = a1; red[(wave * 3 + 2) * 64 + lane] = a2;
        __syncthreads();
        if (wave < 3) { float s = ada_b[l * 6144 + n];
#pragma unroll
            for (int w = 0; w < 8; ++w) s += red[(w * 3 + wave) * 64 + lane];
            MOD[(size_t)(l * 3 + wave) * 6144 + n] = s; }
        __syncthreads();
    }
}
__device__ __forceinline__ void tables_phase(float* ROPE, f32x2* TW, int gt, int NGT) {
    for (int i = gt; i < 192 * 16; i += NGT) { const int pos = i >> 4, f = i & 15; const float inv = powf(10000.0f, -(float)f / 16.0f); const float ang = (float)(pos < 128 ? pos : pos - 128) * inv;
        float s, c; sincosf(ang, &s, &c); ROPE[pos * 32 + f] = c; ROPE[pos * 32 + 16 + f] = s; }
    for (int i = gt; i < 8192; i += NGT) { float s, c; sincospif((float)i * (1.0f / 4096.0f), &s, &c); TW[i] = (f32x2){c, -s}; }
}

__device__ __forceinline__ void norm_phase(const float* src_lat, const float* src_ctx, int nrows, const float* gamma, const float* mod, int shoff, int scoff, bf16_t* HX, int gw, int NGW, int lane,
                                           const float* slab = nullptr, int nsl = 0, const float* cgate = nullptr, float* ctx_out = nullptr) {
    for (int m0 = gw; m0 < nrows; m0 += 4 * NGW) {
        f32x4 v[4][4]; float s[4];
#pragma unroll
        for (int u = 0; u < 4; ++u) { const int m = m0 + u * NGW; s[u] = 0.f;
            if (m < nrows) { const float* xr = m < ML ? src_lat + (size_t)m * DM : src_ctx + (size_t)(m - ML) * DM;
#pragma unroll
                for (int j = 0; j < 4; ++j) v[u][j] = ((const f32x4*)xr)[lane + 64 * j];
                if (slab && m >= ML) {
#pragma unroll
                    for (int j = 0; j < 4; ++j) { f32x4 a = {0.f, 0.f, 0.f, 0.f};
                        for (int sl = 0; sl < nsl; ++sl) a += ((const f32x4*)(slab + (size_t)sl * 512 * 1024 + (size_t)(m - ML) * DM))[lane + 64 * j];
                        v[u][j] += ((const f32x4*)cgate)[lane + 64 * j] * a; ((f32x4*)(ctx_out + (size_t)(m - ML) * DM))[lane + 64 * j] = v[u][j]; } } } }
#pragma unroll
        for (int u = 0; u < 4; ++u) { const int m = m0 + u * NGW; if (m < nrows) {
#pragma unroll
            for (int j = 0; j < 4; ++j) s[u] += (v[u][j].x * v[u][j].x + v[u][j].y * v[u][j].y) + (v[u][j].z * v[u][j].z + v[u][j].w * v[u][j].w);
            const float rstd = 1.0f / sqrtf(wave_sum(s[u]) * (1.0f / DM) + EPS);
            const float* md = mod + (m < SEQ ? 0 : m < ML ? 1 : 2) * 6144;
#pragma unroll
            for (int j = 0; j < 4; ++j) { const int col = 4 * lane + 256 * j;
                const f32x4 g = *(const f32x4*)(gamma + col), sc = *(const f32x4*)(md + scoff + col), sh = *(const f32x4*)(md + shoff + col);
                const f32x4 o = v[u][j] * rstd * g * (sc + 1.0f) + sh;
                u32x2 w; w.x = pk2(o.x, o.y); w.y = pk2(o.z, o.w); *(u32x2*)(HX + (size_t)m * DM + col) = w; } } }
    }
}
__device__ __forceinline__ void final_norm_phase(float* x, const float* gamma, int gw, int NGW, int lane) {
    for (int m0 = gw; m0 < ML; m0 += 4 * NGW) {
        f32x4 v[4][4];
#pragma unroll
        for (int u = 0; u < 4; ++u) { const int m = m0 + u * NGW; if (m < ML) {
#pragma unroll
            for (int j = 0; j < 4; ++j) v[u][j] = ((const f32x4*)(x + (size_t)m * DM))[lane + 64 * j]; } }
#pragma unroll
        for (int u = 0; u < 4; ++u) { const int m = m0 + u * NGW; if (m < ML) { float s = 0.f;
#pragma unroll
            for (int j = 0; j < 4; ++j) s += (v[u][j].x * v[u][j].x + v[u][j].y * v[u][j].y) + (v[u][j].z * v[u][j].z + v[u][j].w * v[u][j].w);
            const float rstd = 1.0f / sqrtf(wave_sum(s) * (1.0f / DM) + EPS);
#pragma unroll
            for (int j = 0; j < 4; ++j) { const f32x4 g = *(const f32x4*)(gamma + 4 * lane + 256 * j); ((f32x4*)(x + (size_t)m * DM))[lane + 64 * j] = v[u][j] * rstd * g; } } }
    }
}

#define SWZ(row, colB) ((row) * 256 + ((colB) ^ (((row) & 7) << 4)))
__device__ __forceinline__ int crow_(int r, int hi) { return (r & 3) + 8 * (r >> 2) + 4 * hi; }
__device__ __forceinline__ bf16x8 pack_bf8(const float* v) { u32x4 w; w.x = pk2(v[0], v[1]); w.y = pk2(v[2], v[3]); w.z = pk2(v[4], v[5]); w.w = pk2(v[6], v[7]); return __builtin_bit_cast(bf16x8, w); }
__device__ __forceinline__ void fft1_phase(const bf16_t* UF, const f32x2* TW, unsigned* FA, LAS unsigned char* lds, int vcu, int G, int tid, int wave, int lane) {
    const int tr = wave >> 1, tc = wave & 1, r32 = lane & 31, hi = lane >> 5;
    bf16x8 aRe[8], aIm[8];
#pragma unroll
    for (int ks = 0; ks < 8; ++ks) { float cv[8], sv[8];
#pragma unroll
        for (int j = 0; j < 8; ++j) { const int idx = ((32 * tr + r32) * (16 * ks + 8 * hi + j)) & 127; float s, c; sincospif((float)idx * (1.0f / 64.0f), &s, &c); cv[j] = c; sv[j] = -s; }
        aRe[ks] = pack_bf8(cv); aIm[ks] = pack_bf8(sv); }
    for (int item = vcu; item < 512; item += G) {
        const int b = item >> 8, g = (item >> 6) & 3, l2 = item & 63;
#pragma unroll
        for (int i = 0; i < 2; ++i) { const int q = tid + 512 * i, l1 = q >> 3, c8 = (q & 7) * 8;
            const u32x4 v = *(const u32x4*)(UF + (size_t)(b * SEQ + 64 * l1 + l2) * 256 + g * 64 + c8);
#pragma unroll
            for (int e = 0; e < 8; ++e) { const unsigned w = v[e >> 1]; *(LAS bf16_t*)(lds + SWZ(c8 + e, l1 * 2)) = (bf16_t)((e & 1) ? (w >> 16) : (w & 0xffffu)); } }
        __syncthreads();
        f32x16 re = {}, im = {};
#pragma unroll
        for (int ks = 0; ks < 8; ++ks) { const bf16x8 bx = *(const LAS bf16x8*)(lds + SWZ(32 * tc + r32, (16 * ks + 8 * hi) * 2));
            re = __builtin_amdgcn_mfma_f32_32x32x16_bf16(aRe[ks], bx, re, 0, 0, 0); im = __builtin_amdgcn_mfma_f32_32x32x16_bf16(aIm[ks], bx, im, 0, 0, 0); }
        unsigned* dst = FA + ((size_t)((b * 4 + g) * 64 + l2) * 128) * 64 + 32 * tc + r32;
#pragma unroll
        for (int r = 0; r < 16; ++r) { const int k1 = 32 * tr + crow_(r, hi); const f32x2 t = TW[k1 * l2];
            dst[(size_t)k1 * 64] = pk2(re[r] * t.x - im[r] * t.y, re[r] * t.y + im[r] * t.x); }
        __syncthreads();
    }
}
__device__ __forceinline__ void fft2_phase(const unsigned* FA, bf16_t* ACAT, LAS unsigned char* lds, int vcu, int G, int tid, int wave, int lane) {
    const int tr = wave >> 1, tc = wave & 1, r32 = lane & 31, hi = lane >> 5;
    bf16x8 a2[8], b3[8];
#pragma unroll
    for (int ks = 0; ks < 8; ++ks) { float av[8], bv[8];
#pragma unroll
        for (int j = 0; j < 8; ++j) { const int R = 32 * tr + r32, k = 16 * ks + 8 * hi + j, k2 = R & 63, ll = k & 63; float s, c; sincospif((float)((k2 * ll) & 63) * (1.0f / 32.0f), &s, &c);
            av[j] = (R < 64) ? ((k < 64) ? c : s) : ((k < 64) ? -s : c);
            const int m = 32 * tc + r32; float s2, c2; sincospif((float)((m * ll) & 63) * (1.0f / 32.0f), &s2, &c2); bv[j] = (k < 64) ? c2 : s2; }
        a2[ks] = pack_bf8(av); b3[ks] = pack_bf8(bv); }
    LAS unsigned char* Bt = lds;
    LAS unsigned char* Zt = lds + 16384;
    for (int item = vcu; item < 1024; item += G) {
        const int b = item >> 9, g = (item >> 7) & 3, k1 = item & 127;
#pragma unroll
        for (int i = 0; i < 2; ++i) { const int q = tid + 512 * i, l2 = q >> 4, c4 = (q & 15) * 4;
            const u32x4 v = *(const u32x4*)(FA + ((size_t)((b * 4 + g) * 64 + l2) * 128 + k1) * 64 + c4);
#pragma unroll
            for (int e = 0; e < 4; ++e) { *(LAS bf16_t*)(Bt + SWZ(c4 + e, l2 * 2)) = (bf16_t)(v[e] & 0xffffu); *(LAS bf16_t*)(Bt + SWZ(c4 + e, (64 + l2) * 2)) = (bf16_t)(v[e] >> 16); } }
        __syncthreads();
        f32x16 z = {};
#pragma unroll
        for (int ks = 0; ks < 8; ++ks) { const bf16x8 bx = *(const LAS bf16x8*)(Bt + SWZ(32 * tc + r32, (16 * ks + 8 * hi) * 2)); z = __builtin_amdgcn_mfma_f32_32x32x16_bf16(a2[ks], bx, z, 0, 0, 0); }
#pragma unroll
        for (int r = 0; r < 16; ++r) { const int R = 32 * tr + crow_(r, hi); *(LAS bf16_t*)(Zt + SWZ(R & 63, ((R >> 6) * 64 + 32 * tc + r32) * 2)) = (bf16_t)(pk2(z[r], 0.f) & 0xffffu); }
        __syncthreads();
        if (wave < 4) { f32x16 y = {};
#pragma unroll
            for (int ks = 0; ks < 8; ++ks) { const bf16x8 ax = *(const LAS bf16x8*)(Zt + SWZ(32 * tr + r32, (16 * ks + 8 * hi) * 2)); y = __builtin_amdgcn_mfma_f32_32x32x16_bf16(ax, b3[ks], y, 0, 0, 0); }
#pragma unroll
            for (int r = 0; r < 16; ++r) { const int k2 = 32 * tr + crow_(r, hi); ACAT[(size_t)(b * SEQ + k1 + 128 * k2) * KCAT + g * 64 + 32 * tc + r32] = (bf16_t)(pk2(y[r] * 0.001381067932f, 0.f) & 0xffffu); } }
        __syncthreads();
    }
}
__device__ __forceinline__ void ctxdft_item(int item, const bf16_t* UF, bf16_t* ACAT, LAS unsigned char* lds, int tid, int wave, int lane) {
    const int b = item >> 4, g = (item >> 2) & 3, kc = item & 3;
    const int tr = wave >> 1, tc = wave & 1, r32 = lane & 31, hi = lane >> 5;
    LAS unsigned char* Xt = lds;
    LAS unsigned char* Zt = lds + 32768;
#pragma unroll
    for (int i = 0; i < 4; ++i) { const int q = tid + 512 * i, l = q >> 3, c8 = (q & 7) * 8;
        const u32x4 v = *(const u32x4*)(UF + (size_t)(ML + b * CTXL + l) * 256 + g * 64 + c8);
#pragma unroll
        for (int e = 0; e < 8; ++e) { const unsigned w = v[e >> 1]; const int row = c8 + e; *(LAS bf16_t*)(Xt + row * 512 + ((((l >> 3) ^ (row & 7)) << 4) | ((l & 7) * 2))) = (bf16_t)((e & 1) ? (w >> 16) : (w & 0xffffu)); } }
    __syncthreads();
    f32x16 z = {};
    const int R = 32 * tr + r32, kk = 64 * kc + (R & 63);
#pragma unroll 4
    for (int ks = 0; ks < 16; ++ks) { float av[8];
#pragma unroll
        for (int j = 0; j < 8; ++j) { const int l = 16 * ks + 8 * hi + j; float s, c; sincospif((float)((kk * l) & 255) * (1.0f / 128.0f), &s, &c); av[j] = (R < 64) ? c : -s; }
        const int row = 32 * tc + r32, ch = (16 * ks + 8 * hi) >> 3;
        const bf16x8 bx = *(const LAS bf16x8*)(Xt + row * 512 + ((ch ^ (row & 7)) << 4));
        z = __builtin_amdgcn_mfma_f32_32x32x16_bf16(pack_bf8(av), bx, z, 0, 0, 0); }
#pragma unroll
    for (int r = 0; r < 16; ++r) { const int Rr = 32 * tr + crow_(r, hi); *(LAS bf16_t*)(Zt + SWZ(Rr & 63, ((Rr >> 6) * 64 + 32 * tc + r32) * 2)) = (bf16_t)(pk2(z[r], 0.f) & 0xffffu); }
    __syncthreads();
    if (wave < 4) { f32x16 y = {};
#pragma unroll
        for (int ks = 0; ks < 8; ++ks) { float bv[8];
#pragma unroll
            for (int j = 0; j < 8; ++j) { const int k = 16 * ks + 8 * hi + j, m = 32 * tc + r32; float s2, c2; sincospif((float)((m * (k & 63)) & 63) * (1.0f / 32.0f), &s2, &c2); bv[j] = (k < 64) ? c2 : s2; }
            const bf16x8 ax = *(const LAS bf16x8*)(Zt + SWZ(32 * tr + r32, (16 * ks + 8 * hi) * 2)); y = __builtin_amdgcn_mfma_f32_32x32x16_bf16(ax, pack_bf8(bv), y, 0, 0, 0); }
#pragma unroll
        for (int r = 0; r < 16; ++r) { const int k = 64 * kc + 32 * tr + crow_(r, hi); ACAT[(size_t)(ML + b * CTXL + k) * KCAT + g * 64 + 32 * tc + r32] = (bf16_t)(pk2(y[r] * (1.0f / 128.0f), 0.f) & 0xffffu); } }
    __syncthreads();
}

__device__ __forceinline__ void conv_item(int item, const bf16_t* ZG, const float* cw  , const float* cb, const float* lng, const float* lnb, bf16_t* ACAT, LAS unsigned char* lds, int tid, int wave, int lane) {
    const int row0 = item * 64; const bool lat = row0 < ML; const int s0 = lat ? (row0 & ~(SEQ - 1)) : (ML + ((row0 - ML) & ~(CTXL - 1))), s1 = s0 + (lat ? SEQ : CTXL);
    LAS float* zt = (LAS float*)lds;
#pragma unroll
    for (int i = 0; i < 6; ++i) { const int q = tid + 512 * i; if (q < 94 * 32) { const int rr = q >> 5, c8 = (q & 31) * 8, gr = row0 - 15 + rr;
        u32x4 v = {0u, 0u, 0u, 0u}; if (gr >= s0 && gr < s1) v = *(const u32x4*)(ZG + (size_t)gr * 256 + c8);
        *(LAS f32x4*)(zt + rr * 256 + c8) = (f32x4){bf2f(v.x & 0xffffu), __uint_as_float(v.x & 0xffff0000u), bf2f(v.y & 0xffffu), __uint_as_float(v.y & 0xffff0000u)};
        *(LAS f32x4*)(zt + rr * 256 + c8 + 4) = (f32x4){bf2f(v.z & 0xffffu), __uint_as_float(v.z & 0xffff0000u), bf2f(v.w & 0xffffu), __uint_as_float(v.w & 0xffff0000u)}; } }
    const int c = tid & 255, half = tid >> 8;
    float w[31];
#pragma unroll
    for (int t = 0; t < 31; ++t) w[t] = cw[t * 256 + c];
    float acc[32]; const float bias = cb[c];
    __syncthreads();
#pragma unroll
    for (int r0 = 0; r0 < 32; r0 += 4) { float v[34];
#pragma unroll
        for (int i = 0; i < 34; ++i) v[i] = zt[(half * 32 + r0 + i) * 256 + c];
        float a0 = bias, a1 = bias, a2 = bias, a3 = bias;
#pragma unroll
        for (int t = 0; t < 31; ++t) { a0 += w[t] * v[t]; a1 += w[t] * v[t + 1]; a2 += w[t] * v[t + 2]; a3 += w[t] * v[t + 3]; }
        acc[r0] = a0; acc[r0 + 1] = a1; acc[r0 + 2] = a2; acc[r0 + 3] = a3; }
    __syncthreads();
#pragma unroll
    for (int r = 0; r < 32; ++r) zt[(half * 32 + r) * 256 + c] = acc[r];
    __syncthreads();
    const f32x4 gg = *(const f32x4*)(lng + 4 * lane), bb = *(const f32x4*)(lnb + 4 * lane);
#pragma unroll
    for (int i = 0; i < 8; ++i) { const int r = wave * 8 + i; const f32x4 v = *(const LAS f32x4*)(zt + r * 256 + 4 * lane);
        const float mu = wave_sum((v.x + v.y) + (v.z + v.w)) * (1.0f / 256.0f); const f32x4 d = v - mu;
        const float var = wave_sum((d.x * d.x + d.y * d.y) + (d.z * d.z + d.w * d.w)) * (1.0f / 256.0f); const float rs = 1.0f / sqrtf(var + EPS);
        f32x4 o = d * rs * gg + bb; o.x *= sigm(o.x); o.y *= sigm(o.y); o.z *= sigm(o.z); o.w *= sigm(o.w);
        u32x2 pw; pw.x = pk2(o.x, o.y); pw.y = pk2(o.z, o.w); *(u32x2*)(ACAT + (size_t)(row0 + r) * KCAT + 768 + 4 * lane) = pw; }
    __syncthreads();
}
__device__ __forceinline__ void pool_phase(const bf16_t* UP, const float* pw  , const float* psc, bf16_t* ACAT, int nitems, int first, LAS unsigned char* lds, int G, int tid, int wave, int lane) {
    const int g = wave >> 1, tc = wave & 1, r32 = lane & 31, hi = lane >> 5;
    bf16x8 bw[4];
#pragma unroll
    for (int ks = 0; ks < 4; ++ks) { float v[8];
#pragma unroll
        for (int j = 0; j < 8; ++j) v[j] = pw[g * 4096 + (16 * ks + 8 * hi + j) * 64 + 32 * tc + r32];
        bw[ks] = pack_bf8(v); }
    const float osc = psc[g * 64 + 32 * tc + r32];
    LAS float* ut = (LAS float*)lds;
    LAS unsigned char* dt = lds + 81920;
    for (int item = first; item < nitems; item += G) {
        const int row0 = item * 64; const bool lat = row0 < ML; const int s0 = lat ? (row0 & ~(SEQ - 1)) : (ML + ((row0 - ML) & ~(CTXL - 1))), L = lat ? SEQ : CTXL, s1 = s0 + L;
#pragma unroll
        for (int i = 0; i < 5; ++i) { const int q = tid + 512 * i, rr = q >> 5, c8 = (q & 31) * 8, gr = row0 - 8 + rr;
            u32x4 v = {0u, 0u, 0u, 0u}; if (gr >= s0 && gr < s1) v = *(const u32x4*)(UP + (size_t)gr * 256 + c8);
            *(LAS f32x4*)(ut + rr * 256 + c8) = (f32x4){bf2f(v.x & 0xffffu), __uint_as_float(v.x & 0xffff0000u), bf2f(v.y & 0xffffu), __uint_as_float(v.y & 0xffff0000u)};
            *(LAS f32x4*)(ut + rr * 256 + c8 + 4) = (f32x4){bf2f(v.z & 0xffffu), __uint_as_float(v.z & 0xffff0000u), bf2f(v.w & 0xffffu), __uint_as_float(v.w & 0xffff0000u)}; }
        __syncthreads();
#pragma unroll
        for (int i = 0; i < 4; ++i) { const int q = tid + 512 * i, lr = q >> 5, c8 = (q & 31) * 8, gg = c8 >> 6, hw = 1 << gg, tt = row0 + lr - s0;
            f32x4 sa = {0.f, 0.f, 0.f, 0.f}, sb = {0.f, 0.f, 0.f, 0.f};
            for (int o = -hw; o < hw; ++o) { sa += *(const LAS f32x4*)(ut + (lr + 8 + o) * 256 + c8); sb += *(const LAS f32x4*)(ut + (lr + 8 + o) * 256 + c8 + 4); }
            const int lo = tt - hw < 0 ? 0 : tt - hw, hh = tt + hw - 1 > L - 1 ? L - 1 : tt + hw - 1; const float inv = 1.0f / (float)(hh - lo + 1);
            const f32x4 ua = *(const LAS f32x4*)(ut + (lr + 8) * 256 + c8), ub = *(const LAS f32x4*)(ut + (lr + 8) * 256 + c8 + 4);
            const f32x4 da = sa * inv - ua, db = sb * inv - ub;
            u32x4 w; w.x = pk2(da.x, da.y); w.y = pk2(da.z, da.w); w.z = pk2(db.x, db.y); w.w = pk2(db.z, db.w);
            *(LAS u32x4*)(dt + lr * 512 + ((((c8 >> 3) ^ (lr & 7)) << 4))) = w; }
        __syncthreads();
#pragma unroll
        for (int rt = 0; rt < 2; ++rt) { f32x16 y = {};
#pragma unroll
            for (int ks = 0; ks < 4; ++ks) { const int row = 32 * rt + r32, ch = (g * 64 + 16 * ks + 8 * hi) >> 3;
                const bf16x8 ax = *(const LAS bf16x8*)(dt + row * 512 + ((ch ^ (row & 7)) << 4)); y = __builtin_amdgcn_mfma_f32_32x32x16_bf16(ax, bw[ks], y, 0, 0, 0); }
#pragma unroll
            for (int r = 0; r < 16; ++r) ACAT[(size_t)(row0 + 32 * rt + crow_(r, hi)) * KCAT + 1024 + g * 64 + 32 * tc + r32] = (bf16_t)(pk2(y[r] * osc, 0.f) & 0xffffu); }
        __syncthreads();
    }
}

__device__ __forceinline__ void ctx_gate_combine(const float* slab, const unsigned char* Gc  , bf16_t* Yc, int gw, int NGW, int lane) {
    for (int r = gw; r < MC; r += NGW) {
#pragma unroll
        for (int j = 0; j < 4; ++j) { const int col = 4 * lane + 256 * j; f32x4 y = {0.f, 0.f, 0.f, 0.f};
#pragma unroll
            for (int sl = 0; sl < 5; ++sl) { const int b = sl == 0 ? 0 : sl <= 2 ? 1 : sl - 1;
                const f32x4 p = *(const f32x4*)(slab + (size_t)sl * 512 * 1024 + (size_t)r * 1024 + col); const unsigned q = *(const unsigned*)(Gc + (size_t)r * 4096 + b * 1024 + col);
                y[0] += p[0] * (float)(q & 255u); y[1] += p[1] * (float)((q >> 8) & 255u); y[2] += p[2] * (float)((q >> 16) & 255u); y[3] += p[3] * (float)(q >> 24); }
            y = y * (1.0f / 255.0f);
            u32x2 w; w.x = pk2(y[0], y[1]); w.y = pk2(y[2], y[3]); *(u32x2*)(Yc + (size_t)r * 1024 + col) = w; }
    }
}
constexpr int NPHASE = 22;
struct Args { const float* in[30]; float* out; unsigned char* ws; int ph_lo, ph_hi, li, pad; };
__global__ void __launch_bounds__(512, 2) __attribute__((amdgpu_waves_per_eu(2, 2))) fwd_kernel(Args args) {
    extern __shared__ __attribute__((aligned(16))) unsigned char lds[];
    LAS unsigned char* L = (LAS unsigned char*)lds;
    volatile LAS unsigned* MISC = (volatile LAS unsigned*)(L + MISC_OFF);
    const int tid0 = threadIdx.x; const int wave0 = __builtin_amdgcn_readfirstlane(tid0 >> 6);
    const int G = gridDim.x, bx0 = blockIdx.x, vcu0 = (G % 8 == 0) ? (bx0 % 8) * (G / 8) + bx0 / 8 : bx0;
    const int NGW = G * 8;
    gu32* ctl = (gu32*)(args.ws + WS_CTL);
    for (int u = tid0; u < (LDS_BYTES - LDSCTL_OFF) / 4; u += 512) ((LAS unsigned*)(L + LDSCTL_OFF))[u] = 0u;
    __syncthreads();
    volatile LAS unsigned long long* PT = (volatile LAS unsigned long long*)(L + PT_OFF);
    if (tid0 < 32) PT[tid0] = ((const __attribute__((address_space(4))) unsigned long long*)__builtin_amdgcn_kernarg_segment_ptr())[tid0];
    __syncthreads();
#define FRESH() int tid, vcu = vcu0, bx = bx0; asm volatile("v_mbcnt_lo_u32_b32 %0, -1, 0\n\tv_mbcnt_hi_u32_b32 %0, -1, %0" : "=v"(tid)); tid += wave0 * 64; asm volatile("" : "+v"(tid), "+s"(vcu), "+s"(bx)); const int lane = tid & 63, wave = __builtin_amdgcn_readfirstlane(tid >> 6), gw = vcu * 8 + wave; (void)lane; (void)gw; (void)bx; \
    LAS float* scr = (LAS float*)(L + wave * 16384); (void)scr;
#define PTR(i) ((const float*)(const GAS float*)ldptr(PT, (i)))
#define OUTP ((float*)(GAS float*)ldptr(PT, 30))
#define WSP ((unsigned char*)(GAS unsigned char*)ldptr(PT, 31))
    XcdBarrier bar; bar.bar = (unsigned*)(ctl + CW_BAR) + args.li * XCD_BAR_WORDS; bar.x = 0; bar.st = nullptr;
    if (MK_N_LAUNCHES != NPHASE) bar = xcd_barrier_post((unsigned*)(ctl + CW_BAR) + args.li * XCD_BAR_WORDS, MISC + 8);
#define GRID_BAR() do { if (MK_N_LAUNCHES == NPHASE) { if (tid0 == 0) __hip_atomic_store(ctl + CW_TMO, 0xBADBA0u, RLX_AGENT); } else { xcd_barrier(bar); } } while (0)
    const int lo = args.ph_lo, hi = args.ph_hi;
#ifndef PHASE_MASK
#define PHASE_MASK 0xFFF
#endif
#ifndef ATTM
#define ATTM 3
#endif
#ifndef X1REP
#define X1REP 0
#endif
#ifndef X1M
#define X1M 31
#endif
#define PH_EN(kind) ((PHASE_MASK >> (kind)) & 1)
#ifndef REP_MASK
#define REP_MASK 0
#endif
#define NREP(kind) (((REP_MASK >> (kind)) & 1) ? 2 : 1)
#define IN(k) (lo <= (k) && (k) < hi)
#define BOTH(k) (IN(k) && IN((k) + 1))
#define WSRC(S, l) WSrc S; S.w_in = PTR(8) + (size_t)(l) * 1024 * NIN; S.wo_f = PTR(20) + (size_t)(l) * 256 * 1024; S.wo_a = PTR(21) + (size_t)(l) * 512 * 1024; \
    S.wo_c = PTR(22) + (size_t)(l) * 256 * 1024; S.wo_p = PTR(23) + (size_t)(l) * 256 * 1024; S.w_out = PTR(24) + (size_t)(l) * 1024 * 1024; \
    S.w_up = PTR(25) + (size_t)(l) * 1024 * 2 * DFF; S.w_down = PTR(28) + (size_t)(l) * DFF * 1024;
#define ws WSP
#define MOD ((float*)(WSP + WS_MOD))
#define ROPE ((float*)(WSP + WS_ROPE))
#define TW ((f32x2*)(WSP + WS_TW))
#define XC ((float*)(WSP + WS_XC))
#define HX ((bf16_t*)(WSP + WS_HX))
#define FA ((f32x2*)(WSP + WS_FA))
#define Qb ((bf16_t*)(WSP + WS_Q))
#define Kb ((bf16_t*)(WSP + WS_K))
#define Vb ((bf16_t*)(WSP + WS_V))
#define Yb ((bf16_t*)(WSP + WS_Y))
#define Gb (WSP + WS_G)
#define ACAT ((bf16_t*)(WSP + WS_ACAT))
#define UF ((bf16_t*)(WSP + WS_UF))
#define ZG ((bf16_t*)(WSP + WS_ZG))
#define UP ((bf16_t*)(WSP + WS_UP))
#define GT ((bf16_t*)(WSP + WS_GT))
#define Hb ((bf16_t*)(WSP + WS_H))

    for (int rep = 0; rep < NREP(0); ++rep) if (PH_EN(0) && IN(0)) { FRESH();
        mod_phase(PTR(1), PTR(3), PTR(6), PTR(7), MOD, L, vcu, G, tid, wave, lane);
        tables_phase(ROPE, TW, vcu * 512 + tid, G * 512);
        for (int i = vcu * 512 + tid; i < MC * DM / 4; i += G * 512) ((f32x4*)XC)[i] = ((const f32x4*)PTR(2))[i];
        WSRC(S0, 0); convert_A(S0, ws, scr, gw, NGW, lane); convert_B(S0, ws, scr, gw, NGW, lane);
        if (BOTH(0)) GRID_BAR();
    }
#pragma nounroll
    for (int l = 0; l < 2; ++l) {
        const int pb = 1 + 10 * l;
#define mod (MOD + l * 3 * 6144)
#define xl ((l == 0) ? PTR(0) : (const float*)OUTP)
#define xc ((l == 0) ? PTR(2) : (const float*)XC)
        const int Mact = (l == 0) ? MT : ML;
        for (int rep = 0; rep < NREP(1); ++rep) if (PH_EN(1) && IN(pb)) { FRESH(); if (l == 0) norm_phase(xl, xc, MT, PTR(4) + l * DM, mod, 0, 1024, HX, gw, NGW, lane);
            else norm_phase(xl, xc, MT, PTR(4) + l * DM, mod, 0, 1024, HX, gw, NGW, lane, (const float*)Gb, 11, MOD + 2 * 6144 + 5120, XC);
            if (BOTH(pb)) GRID_BAR(); }
        for (int rep = 0; rep < NREP(2); ++rep) if (PH_EN(2) && IN(pb + 1)) { FRESH();
            pg8::Gemm g{HX, (const bf16_t*)(ws + WS_WA), MT, NIN, 1024}; pg8::StaticOrder S; S.init(MT, NIN, G, bx);
            pg8::EpiIn E{UF, ZG, UP, Qb, Kb, Vb, Gb, ROPE};
            pg8::gemm_phase<pg8::EpiIn, pg8::StaticOrder, true, true>(L, g, S, E, tid);
            if (BOTH(pb + 1)) GRID_BAR();
        }
        for (int rep = 0; rep < NREP(3); ++rep) if (PH_EN(3) && IN(pb + 2)) { FRESH();
            for (int r1 = 0; r1 < ((X1REP & 1) ? 2 : 1); ++r1) if (X1M & 1) fft1_phase(UF, TW, (unsigned*)FA, L, vcu, G, tid, wave, lane);
            for (int r1 = 0; r1 < ((X1REP & 2) ? 2 : 1); ++r1) if (X1M & 2) for (int it = vcu; it < Mact / 64; it += G) conv_item(it, ZG, PTR(14) + l * 31 * 256, PTR(15) + l * 256, PTR(16) + l * 256, PTR(17) + l * 256, ACAT, L, tid, wave, lane);
            for (int r1 = 0; r1 < ((X1REP & 4) ? 2 : 1); ++r1) if (X1M & 4) pool_phase(UP, PTR(18) + l * 4 * 4096, PTR(19) + l * 256, ACAT, Mact / 64, (vcu + 248) % G, L, G, tid, wave, lane);
            if ((X1M & 8) && l == 0) for (int it = (vcu + 224) % G; it < 32; it += G) ctxdft_item(it, UF, ACAT, L, tid, wave, lane);
            if (l == 0) {
                const float lam_init = 0.2f;
                const float d1 = wave_sum(PTR(9)[lane] * PTR(10)[lane]), d2 = wave_sum(PTR(11)[lane] * PTR(12)[lane]);
                const float lam = __builtin_bit_cast(float, __builtin_amdgcn_readfirstlane(__builtin_bit_cast(int, expf(d1) - expf(d2) + lam_init)));
                for (int v = (vcu + 200) % G; v < 16; v += G) { const int b = v >> 3, h = (v >> 1) & 3, row0 = ML + b * CTXL + (v & 1) * 128;
                    att2::attn_unit<0>(Qb + (size_t)row0 * 512 + h * 128, Kb + (size_t)b * KVL * 512 + h * 128, Vb + (size_t)b * KVL * 512 + h * 128, CTXL,
                                       ACAT + (size_t)row0 * KCAT + 256 + h * 128, lam, 1.0f - lam_init, PTR(13), (char*)lds, tid); }
            }
            WSRC(S1, 1);
            for (int r1 = 0; r1 < ((X1REP & 16) ? 2 : 1); ++r1) if (!(X1M & 16)) {} else if (l == 0) convert_A(S1, ws, scr, gw, NGW, lane); else convert_B(S1, ws, scr, gw, NGW, lane);
            if (BOTH(pb + 2)) GRID_BAR();
        }
        for (int rep = 0; rep < NREP(4); ++rep) if (PH_EN(4) && IN(pb + 3)) { FRESH();
            if (ATTM & 1) fft2_phase((const unsigned*)FA, ACAT, L, vcu, G, tid, wave, lane);
            const float lam_init = (l == 0) ? 0.2f : 0.35550906759096926f;
            const float d1 = wave_sum(PTR(9)[l * 64 + lane] * PTR(10)[l * 64 + lane]), d2 = wave_sum(PTR(11)[l * 64 + lane] * PTR(12)[l * 64 + lane]);
            const float lam = __builtin_bit_cast(float, __builtin_amdgcn_readfirstlane(__builtin_bit_cast(int, expf(d1) - expf(d2) + lam_init)));
            const int nun = 512;
            if (ATTM & 2) for (int u = vcu; u < nun; u += G) {
                int b, h, row0, nkeys;
                if (u < 512) { const int x = (u & 255) >> 5, qb = (u & 31) + 32 * (u >> 8); b = x >> 2; h = x & 3; row0 = b * SEQ + qb * 128; nkeys = KVL; }
                else { const int v = u - 512; b = v >> 3; h = (v >> 1) & 3; row0 = ML + b * CTXL + (v & 1) * 128; nkeys = CTXL; }
#if ATT_V == 2
                att2::attn_unit<0>(Qb + (size_t)row0 * 512 + h * 128,
#else
                att::attn_unit<0>(Qb + (size_t)row0 * 512 + h * 128,
#endif
                               Kb + (size_t)b * KVL * 512 + h * 128, Vb + (size_t)b * KVL * 512 + h * 128, nkeys,
                               ACAT + (size_t)row0 * KCAT + 256 + h * 128, lam, 1.0f - lam_init, PTR(13) + l * 128, (char*)lds, tid);
            }
            if (l == 0) {
                pg8::Gemm gc{ACAT + (size_t)ML * KCAT, (const bf16_t*)(ws + WS_WCAT), MC, 1024, 256, KCAT}; pg8::BranchSliceOrder Sc{G, bx};
                pg8::EpiSlab Ec{(float*)UF};
                pg8::gemm_phase<pg8::EpiSlab, pg8::BranchSliceOrder, true, true>(L, gc, Sc, Ec, tid);
            }
#if defined(ATT_PROBE)
            int tid2 = tid, vcu2 = vcu; asm volatile("" : "+v"(tid2), "+s"(vcu2));
            for (int u = vcu2; u < 512; u += G) {
                const int x = (u & 255) >> 5, qb = (u & 31) + 32 * (u >> 8), b = x >> 2, h = x & 3, row0 = b * SEQ + qb * 128;
                att2::attn_unit<ATT_PROBE>(Qb + (size_t)row0 * 512 + h * 128, Kb + (size_t)b * KVL * 512 + h * 128, Vb + (size_t)b * KVL * 512 + h * 128, KVL,
                               Hb + (size_t)row0 * KCAT + 256 + h * 128, lam, 1.0f - lam_init, PTR(13) + l * 128, (char*)lds, tid2);
            }
#endif
            if (BOTH(pb + 3)) GRID_BAR();
        }
        for (int rep = 0; rep < NREP(5); ++rep) if (PH_EN(5) && IN(pb + 4)) { FRESH();
            if (l == 0) ctx_gate_combine((const float*)UF, Gb + (size_t)ML * 4096, Yb + (size_t)ML * 1024, gw, NGW, lane);
            pg8::Gemm g{ACAT, (const bf16_t*)(ws + WS_WCAT), ML, 1024, KCAT}; pg8::StaticOrder S; S.init(ML, 1024, G, bx);
            pg8::EpiBranch E{Gb, Yb};
            pg8::gemm_phase<pg8::EpiBranch, pg8::StaticOrder, true, true>(L, g, S, E, tid);
            if (BOTH(pb + 4)) GRID_BAR();
        }
        for (int rep = 0; rep < (l == 0 ? NREP(6) : 1); ++rep) if (PH_EN(6) && IN(pb + 5)) { FRESH();
            pg8::Gemm g{Yb, (const bf16_t*)(ws + WS_WOUT), ML, 1024, 1024}; pg8::StaticOrder S; S.init(ML, 1024, G, bx);
            pg8::EpiRes E{xl, xc, OUTP, XC, mod, 2048};
            pg8::gemm_phase<pg8::EpiRes, pg8::StaticOrder, true, true>(L, g, S, E, tid);
            if (l == 0) {
                pg8::Gemm gc{Yb + (size_t)ML * 1024, (const bf16_t*)(ws + WS_WOUT), MC, 1024, 256, 1024}; pg8::SplitKOrder Sc{4, 256, G, bx};
                pg8::EpiSlab Ec{(float*)Gb};
                pg8::gemm_phase<pg8::EpiSlab, pg8::SplitKOrder, true, true>(L, gc, Sc, Ec, tid);
            }
            if (BOTH(pb + 5)) GRID_BAR();
        }
        for (int rep = 0; rep < NREP(7); ++rep) if (PH_EN(7) && IN(pb + 6)) { FRESH(); if (l == 0) norm_phase(OUTP, XC, Mact, PTR(5) + l * DM, mod, 3072, 4096, HX, gw, NGW, lane, (const float*)Gb, 4, mod + 2 * 6144 + 2048, XC);
            else norm_phase(OUTP, XC, Mact, PTR(5) + l * DM, mod, 3072, 4096, HX, gw, NGW, lane);
            if (BOTH(pb + 6)) GRID_BAR(); }
        for (int rep = 0; rep < NREP(8); ++rep) if (PH_EN(8) && IN(pb + 7)) { FRESH();
            pg8::Gemm g{HX, (const bf16_t*)(ws + WS_WUPG), Mact, DFF, 1024}; pg8::StaticOrder S; S.init(Mact, DFF, G, bx);
            pg8::EpiBf E{GT, DFF};
            pg8::gemm_phase<pg8::EpiBf, pg8::StaticOrder, true, true>(L, g, S, E, tid);
            if (BOTH(pb + 7)) GRID_BAR();
        }
        for (int rep = 0; rep < NREP(9); ++rep) if (PH_EN(9) && IN(pb + 8)) { FRESH();
            pg8::Gemm g{HX, (const bf16_t*)(ws + WS_WUPV), Mact, DFF, 1024}; pg8::StaticOrder S; S.init(Mact, DFF, G, bx);
            pg8::EpiVal E{GT, Hb, PTR(26) + l * 3 * DFF, PTR(27) + l * DFF};
            pg8::gemm_phase<pg8::EpiVal, pg8::StaticOrder, true, true>(L, g, S, E, tid);
            if (BOTH(pb + 8)) GRID_BAR();
        }
        if (PH_EN(10) && IN(pb + 9)) { FRESH();
            pg8::Gemm g{Hb, (const bf16_t*)(ws + WS_WDN), ML, 1024, DFF}; pg8::StaticOrder S; S.init(ML, 1024, G, bx);
            pg8::EpiRes E{OUTP, XC, OUTP, XC, mod, 5120};
            pg8::gemm_phase<pg8::EpiRes, pg8::StaticOrder, true, true>(L, g, S, E, tid);
            if (l == 0) {
                pg8::Gemm gc{Hb + (size_t)ML * DFF, (const bf16_t*)(ws + WS_WDN), MC, 1024, 256, DFF}; pg8::SplitKOrder Sc{11, 256, G, bx};
                pg8::EpiSlab Ec{(float*)Gb};
                pg8::gemm_phase<pg8::EpiSlab, pg8::SplitKOrder, true, true>(L, gc, Sc, Ec, tid);
            }
            if (BOTH(pb + 9)) GRID_BAR();
        }
    }
    if (PH_EN(11) && IN(21)) { FRESH(); final_norm_phase(OUTP, PTR(29), gw, NGW, lane); }
#undef IN
#undef BOTH
#undef mod
#undef xl
#undef xc
#undef ws
#undef MOD
#undef ROPE
#undef TW
#undef XC
#undef HX
#undef FA
#undef Qb
#undef Kb
#undef Vb
#undef Yb
#undef Gb
#undef ACAT
#undef UF
#undef ZG
#undef UP
#undef GT
#undef Hb
#undef PTR
#undef OUTP
#undef WSP
}

extern "C" void kernel_launch(void* const* d_in, const int* in_sizes, int n_in, void* d_out, int out_size, void* d_ws, size_t ws_size, hipStream_t stream) {
    static int grid = 0;
    if (grid == 0) {
        if (n_in != 30 || in_sizes[0] != ML * DM || out_size != ML * DM || ws_size < WS_END) {
            fprintf(stderr, "kernel_launch: unexpected shapes: n_in %d in0 %d out %d ws %zu (need >= %zu)\n", n_in, n_in > 0 ? in_sizes[0] : -1, out_size, ws_size, (size_t)WS_END); grid = -1; return; }
        int dev = 0, cus = 0, per_cu = 0;
        if (hipGetDevice(&dev) != hipSuccess || hipDeviceGetAttribute(&cus, hipDeviceAttributeMultiprocessorCount, dev) != hipSuccess) { grid = -1; return; }
        if (hipFuncSetAttribute((const void*)fwd_kernel, hipFuncAttributeMaxDynamicSharedMemorySize, LDS_BYTES) != hipSuccess) { fprintf(stderr, "kernel_launch: hipFuncSetAttribute failed\n"); grid = -1; return; }
        if (hipOccupancyMaxActiveBlocksPerMultiprocessor(&per_cu, (const void*)fwd_kernel, 512, LDS_BYTES) != hipSuccess || per_cu < 1) {
            fprintf(stderr, "kernel_launch: occupancy query reports %d blocks per CU\n", per_cu); (void)hipGetLastError(); grid = -1; return; }
        grid = cus;
    }
    if (grid < 0) return;
    (void)hipMemsetAsync((char*)d_ws + WS_CTL, 0, CTL_ZERO_BYTES, stream);
    Args a{};
    for (int i = 0; i < 30; ++i) a.in[i] = (const float*)d_in[i];
    a.out = (float*)d_out; a.ws = (unsigned char*)d_ws;
    for (int li = 0; li < MK_N_LAUNCHES; ++li) {
        if (MK_N_LAUNCHES == NPHASE) { a.ph_lo = li; a.ph_hi = li + 1; a.li = 0; }
        else { a.ph_lo = (int)((long)NPHASE * li / MK_N_LAUNCHES); a.ph_hi = (int)((long)NPHASE * (li + 1) / MK_N_LAUNCHES); a.li = li; }
        hipLaunchKernelGGL(fwd_kernel, dim3(grid), dim3(512), LDS_BYTES, stream, a);
    }
}
```

```cpp
#include <hip/hip_runtime.h>
#include <cstdio>
#include <cstdint>

#define LAS __attribute__((address_space(3)))
#define GAS __attribute__((address_space(1)))
typedef unsigned short bf16_t;
typedef short bf16x8 __attribute__((ext_vector_type(8)));
typedef short s16x4 __attribute__((ext_vector_type(4)));
typedef float f32x2 __attribute__((ext_vector_type(2)));
typedef float f32x4 __attribute__((ext_vector_type(4)));
typedef float f32x16 __attribute__((ext_vector_type(16)));
typedef unsigned u32x2 __attribute__((ext_vector_type(2)));
typedef unsigned u32x4 __attribute__((ext_vector_type(4)));

#ifndef ATT_V
#define ATT_V 2
#endif
#ifndef MK_N_LAUNCHES
#define MK_N_LAUNCHES 1
#endif

constexpr int DM = 1024, SEQ = 8192, NBATCH = 2, CTXL = 256;
constexpr int ML = NBATCH * SEQ;
constexpr int MC = NBATCH * CTXL;
constexpr int MT = ML + MC;
constexpr int NIN = 6656, DFF = 2816, KCAT = 1280;
constexpr int KVL = CTXL + SEQ;
constexpr float EPS = 1e-6f;

constexpr size_t MiB = 1u << 20;
constexpr size_t WS_CTL = 0, CTL_ZERO_BYTES = 1 * MiB;
constexpr size_t WS_MOD = 1 * MiB;
constexpr size_t WS_ROPE = WS_MOD + 2 * 3 * 6144 * 4;
constexpr size_t WS_TW = WS_ROPE + 192 * 32 * 4;
constexpr size_t WS_XC = 2 * MiB;
constexpr size_t WS_WA = 4 * MiB;
constexpr size_t WS_WCAT = 17 * MiB;
constexpr size_t WS_WOUT = WS_WCAT + (size_t)1024 * 1280 * 2;
constexpr size_t WS_WUPG = WS_WOUT + (size_t)1024 * 1024 * 2;
constexpr size_t WS_WUPV = WS_WUPG + (size_t)2816 * 1024 * 2;
constexpr size_t WS_WDN = WS_WUPV + (size_t)2816 * 1024 * 2;
constexpr size_t WS_HX = 38 * MiB;
constexpr size_t WS_FA = WS_HX;
constexpr size_t WS_Q = 71 * MiB;
constexpr size_t WS_K = WS_Q + (size_t)MT * 512 * 2;
constexpr size_t WS_V = WS_K + (size_t)MT * 512 * 2;
constexpr size_t WS_Y = 71 * MiB;
constexpr size_t WS_G = 121 * MiB;
constexpr size_t WS_ACAT = 187 * MiB;
constexpr size_t WS_UF = 229 * MiB;
constexpr size_t WS_ZG = WS_UF + (size_t)MT * 256 * 2;
constexpr size_t WS_UP = WS_ZG + (size_t)MT * 256 * 2;
constexpr size_t WS_GT = 71 * MiB;
constexpr size_t WS_H = 162 * MiB;
constexpr size_t WS_END = 256 * MiB;
static_assert(WS_TW + 8192 * 8 <= WS_XC && WS_WDN + (size_t)1024 * 2816 * 2 <= WS_HX && WS_V + (size_t)MT * 512 * 2 <= WS_G && WS_G + (size_t)MT * 4096 <= WS_ACAT, "ws map 1");
static_assert(WS_ACAT + (size_t)MT * 1280 * 2 <= WS_UF && WS_UP + (size_t)MT * 256 * 2 <= WS_END && WS_GT + (size_t)MT * 2816 * 2 <= WS_H && WS_H + (size_t)MT * 2816 * 2 <= WS_END, "ws map 2");
static_assert(WS_HX + (size_t)MT * 1024 * 2 <= WS_Q && (size_t)2 * 4 * 128 * 64 * 64 * 8 <= (size_t)MT * 1024 * 2, "ws map 3");
constexpr int CW_TMO = 0, CW_CODE = 1, CW_BAR = 4096;

constexpr int RING_BYTES = 131072, LDSCTL_OFF = RING_BYTES, MISC_OFF = LDSCTL_OFF + 320, LDS_BYTES = 147456;

typedef __bf16 bf16x2_t __attribute__((ext_vector_type(2)));
__device__ __forceinline__ unsigned cvt2bf(float lo, float hi) { const f32x2 v = {lo, hi}; return __builtin_bit_cast(unsigned, __builtin_convertvector(v, bf16x2_t)); }
template <int M> __device__ __forceinline__ float swz_xor(float v) { return __int_as_float(__builtin_amdgcn_ds_swizzle(__float_as_int(v), (M << 10) | 0x1f)); }
__device__ __forceinline__ float bf2f(unsigned v) { return __uint_as_float(v << 16); }
__device__ __forceinline__ float sigm(float x) { return __builtin_amdgcn_rcpf(1.0f + __builtin_amdgcn_exp2f(x * -1.4426950408889634f)); }
__host__ __device__ __forceinline__ int in_map(int n) {
    if (n < 256) return n;
    if (n < 1280) { const int base = n < 768 ? 256 : 768, r = n - base, comp = r >> 6, p = r & 63, pp = p >> 1, e = p & 1;
        return base + comp * 64 + (pp < 16 ? 0 : 32) + (pp & 15) + 16 * e; }
    if (n < 1792) return n;
    if (n < 2304) { const int r = n - 1792; return 1792 + (r & 1) * 256 + (r >> 1); }
    return n;
}
namespace pg8 {
#define PG8_LAS __attribute__((address_space(3)))
typedef unsigned short bf16_t;
typedef short bf16x8 __attribute__((ext_vector_type(8)));
typedef float f32x4 __attribute__((ext_vector_type(4)));
typedef unsigned u32x4 __attribute__((ext_vector_type(4)));
constexpr int BM = 256, BK = 64, HALF = 128, HTB = HALF * BK * 2  , STAGE_BYTES = 8 * HTB, NXCD = 8, WGM = 8;

__host__ __device__ __forceinline__ int lds_byte(int r, int c) { const int st = (r >> 4) * 2 + (c >> 5), rr = r & 15, cc = c & 31, ob = rr * 64 + cc * 2; return st * 1024 + (ob ^ (((ob >> 9) & 1) << 5)); }
__host__ __device__ __forceinline__ void stage_rc(int b, int& R, int& C) { const int st = b / 1024, sb = b % 1024, swz = sb ^ (((sb >> 9) & 1) << 5); R = (st >> 1) * 16 + swz / 64; C = (st & 1) * 32 + (swz % 64) / 2; }
__host__ __device__ __forceinline__ int perm32(int rho) { const int n = rho >> 4, i = rho & 15; return 8 * (i >> 2) + 4 * n + (i & 3); }

struct Unit { int pm, pn, ko = 0, sl = 0; };
struct Gemm { const bf16_t* A; const bf16_t* Bt; int M, N, K, ld = 0; };

struct StaticOrder {
    int nM, nN, nwg, G, c;
    __host__ __device__ void init(int M, int N, int G_, int c_) { nM = M / BM; nN = N / BM; nwg = nM * nN; G = G_; c = c_; }
    __host__ __device__ bool next(int i, Unit& u) const {
        const long L = (long)i * G + c; if (L >= nwg) return false;
        int wgid = (int)L; { const int q = nwg / NXCD, r = nwg % NXCD, xcd = wgid % NXCD, off = wgid / NXCD; wgid = (xcd < r ? xcd * (q + 1) : r * (q + 1) + (xcd - r) * q) + off; }
        const int nig = WGM * nN, gid = wgid / nig, fm = gid * WGM, gsz = (nM - fm) < WGM ? (nM - fm) : WGM;
        u.pm = fm + ((wgid % nig) % gsz); u.pn = (wgid % nig) / gsz; return true;
    }
    __device__ __forceinline__ void a_ready(const Unit&) const {}
    __device__ __forceinline__ void done(const Unit&) const {}
};
__device__ __forceinline__ unsigned cvt_pk_bf16(float lo, float hi) { return cvt2bf(lo, hi); }
typedef float f32x2 __attribute__((ext_vector_type(2)));
__device__ __forceinline__ f32x2 gelu_pk(f32x2 v) {
    const f32x2 av = __builtin_elementwise_abs(v), d = av * 0.2316418882f + 1.0f;
    f32x2 t; t.x = __builtin_amdgcn_rcpf(d.x); t.y = __builtin_amdgcn_rcpf(d.y);
    f32x2 q = t * 0.5307027145f + (-0.7265760135f); q = q * t + 0.7107068705f; q = q * t + (-0.142248368f); q = q * t + 0.127414796f; q = q * t;
    const f32x2 s = (v * v) * (-0.72134752044f);
    f32x2 e; e.x = __builtin_amdgcn_exp2f(s.x); e.y = __builtin_amdgcn_exp2f(s.y);
    const f32x2 m = v * (q * e), r = v - m;
    f32x2 o; o.x = v.x < 0.f ? m.x : r.x; o.y = v.y < 0.f ? m.y : r.y; return o;
}

typedef unsigned u32x2 __attribute__((ext_vector_type(2)));
__device__ __forceinline__ u32x4 pack8(const f32x4 a, const f32x4 b) { u32x4 w; w.x = cvt_pk_bf16(a[0], a[1]); w.y = cvt_pk_bf16(a[2], a[3]); w.z = cvt_pk_bf16(b[0], b[1]); w.w = cvt_pk_bf16(b[2], b[3]); return w; }

struct EpiIn {
    static constexpr bool PERM = true, AFTER_DRAIN = false, RESCALE = false;
    bf16_t *UF, *ZG, *UP, *Q, *K, *V; unsigned char* G; const float* rope;
    __device__ __forceinline__ void operator()(const f32x4 (&acc)[2][2][4][2], const Unit& u, int wr, int wc, int fr, int fq) const {
        const int pm = u.pm, pn = u.pn; const bool lat = pm < 64; const int R0 = pm * 256;
        const int kv0 = lat ? ((pm >> 5) * 8448 + 256 + ((pm & 31) << 8)) : ((pm - 64) * 8448);
        const int rl = wr * 64 + fr, cl = wc * 32 + 8 * fq;
        if (pn == 0 || pn == 9) {
            bf16_t* dst = (pn == 0 ? UF : UP);
#pragma unroll
            for (int ai = 0; ai < 2; ++ai)
#pragma unroll
                for (int m = 0; m < 4; ++m) { const int rr = ai * 128 + m * 16 + rl;
#pragma unroll
                    for (int bj = 0; bj < 2; ++bj) *(u32x4*)(dst + (size_t)(R0 + rr) * 256 + bj * 128 + cl) = pack8(acc[ai][bj][m][0], acc[ai][bj][m][1]); }
        } else if (pn <= 4) {
            const bool isq = pn <= 2; bf16_t* dst = isq ? Q : K; const int rowbase = isq ? R0 : kv0, colbase = (isq ? pn - 1 : pn - 3) * 256; const float sc = isq ? (ATT_V == 2 ? 0.18033688011112042f : 0.125f) : 1.0f;
#pragma unroll
            for (int ai = 0; ai < 2; ++ai)
#pragma unroll
                for (int m = 0; m < 4; ++m) { const int rr = ai * 128 + m * 16 + rl;
                    f32x4 cs = {1.f, 1.f, 1.f, 1.f}, sn = {0.f, 0.f, 0.f, 0.f};
                    if (lat) { const int t = (R0 & 8191) + rr; const int pos = (wc & 1) ? 128 + (t & 63) : (t >> 6);
                        cs = *(const f32x4*)(rope + pos * 32 + 4 * fq); sn = *(const f32x4*)(rope + pos * 32 + 16 + 4 * fq); }
                    cs = cs * sc; sn = sn * sc;
#pragma unroll
                    for (int bj = 0; bj < 2; ++bj) { const f32x4 a = acc[ai][bj][m][0], b = acc[ai][bj][m][1]; f32x4 oa, ob;
                        oa[0] = a[0] * cs[0] - a[1] * sn[0]; oa[1] = a[1] * cs[0] + a[0] * sn[0]; oa[2] = a[2] * cs[1] - a[3] * sn[1]; oa[3] = a[3] * cs[1] + a[2] * sn[1];
                        ob[0] = b[0] * cs[2] - b[1] * sn[2]; ob[1] = b[1] * cs[2] + b[0] * sn[2]; ob[2] = b[2] * cs[3] - b[3] * sn[3]; ob[3] = b[3] * cs[3] + b[2] * sn[3];
                        *(u32x4*)(dst + (size_t)(rowbase + rr) * 512 + colbase + bj * 128 + cl) = pack8(oa, ob); } }
        } else if (pn <= 6) {
#pragma unroll
            for (int ai = 0; ai < 2; ++ai)
#pragma unroll
                for (int m = 0; m < 4; ++m) { const int rr = ai * 128 + m * 16 + rl;
#pragma unroll
                    for (int bj = 0; bj < 2; ++bj) *(u32x4*)(V + (size_t)(kv0 + rr) * 512 + (pn - 5) * 256 + bj * 128 + cl) = pack8(acc[ai][bj][m][0], acc[ai][bj][m][1]); }
        } else if (pn <= 8) {
#pragma unroll
            for (int ai = 0; ai < 2; ++ai)
#pragma unroll
                for (int m = 0; m < 4; ++m) { const int rr = ai * 128 + m * 16 + rl;
#pragma unroll
                    for (int bj = 0; bj < 2; ++bj) { const f32x4 a = acc[ai][bj][m][0], b = acc[ai][bj][m][1];
                        u32x2 w; w.x = cvt_pk_bf16(a[0] * sigm(a[1]), a[2] * sigm(a[3])); w.y = cvt_pk_bf16(b[0] * sigm(b[1]), b[2] * sigm(b[3]));
                        *(u32x2*)(ZG + (size_t)(R0 + rr) * 256 + (pn - 7) * 128 + bj * 64 + (cl >> 1)) = w; } }
        } else {
#pragma unroll
            for (int ai = 0; ai < 2; ++ai)
#pragma unroll
                for (int m = 0; m < 4; ++m) { const int rr = ai * 128 + m * 16 + rl;
#pragma unroll
                    for (int bj = 0; bj < 2; ++bj) { u32x2 w;
#pragma unroll
                        for (int n = 0; n < 2; ++n) { const f32x4 a = acc[ai][bj][m][n]; unsigned q = 0;
#pragma unroll
                            for (int j = 0; j < 4; ++j) { float s = sigm(a[j]) * 255.0f + 0.5f; s = s < 1.0f ? 1.0f : s; q |= ((unsigned)s) << (8 * j); }
                            if (n == 0) w.x = q; else w.y = q; }
                        *(u32x2*)(G + (size_t)(R0 + rr) * 4096 + (pn - 10) * 256 + bj * 128 + cl) = w; } }
        }
    }
};

struct EpiBf {
    static constexpr bool PERM = true, AFTER_DRAIN = false, RESCALE = false;
    bf16_t* O; int ldc;
    __device__ __forceinline__ void operator()(const f32x4 (&acc)[2][2][4][2], const Unit& u, int wr, int wc, int fr, int fq) const {
        const int row0 = u.pm * 256 + wr * 64 + fr, col0 = u.pn * 256 + wc * 32 + 8 * fq;
#pragma unroll
        for (int ai = 0; ai < 2; ++ai)
#pragma unroll
            for (int m = 0; m < 4; ++m)
#pragma unroll
                for (int bj = 0; bj < 2; ++bj) *(u32x4*)(O + (size_t)(row0 + ai * 128 + m * 16) * ldc + col0 + bj * 128) = pack8(acc[ai][bj][m][0], acc[ai][bj][m][1]);
    }
};

struct EpiRes {
    static constexpr bool PERM = true, AFTER_DRAIN = false, RESCALE = false;
    const float* base_f32; const bf16_t* base_bf; const float* base_ctx; bf16_t* out_bf; float* out_ctx; const float* mod; int goff;
    __device__ __forceinline__ void operator()(const f32x4 (&acc)[2][2][4][2], const Unit& u, int wr, int wc, int fr, int fq) const {
        const int pm = u.pm; const bool lat = pm < 64; const int mrow = lat ? (pm >> 5) : 2;
        const int col0 = u.pn * 256 + wc * 32 + 8 * fq;
        f32x4 gv[2][2];
#pragma unroll
        for (int bj = 0; bj < 2; ++bj)
#pragma unroll
            for (int n = 0; n < 2; ++n) gv[bj][n] = *(const f32x4*)(mod + mrow * 6144 + goff + col0 + bj * 128 + 4 * n);
#pragma unroll
        for (int ai = 0; ai < 2; ++ai)
#pragma unroll
            for (int m = 0; m < 4; ++m) { const size_t ro = (size_t)((lat ? pm : pm - 64) * 256 + ai * 128 + wr * 64 + m * 16 + fr) * 1024 + col0;
#pragma unroll
                for (int bj = 0; bj < 2; ++bj) { const size_t off = ro + bj * 128; f32x4 b0, b1;
                    if (!lat) { b0 = *(const f32x4*)(base_ctx + off); b1 = *(const f32x4*)(base_ctx + off + 4); }
                    else if (base_f32) { b0 = *(const f32x4*)(base_f32 + off); b1 = *(const f32x4*)(base_f32 + off + 4); }
                    else { const u32x4 w = *(const u32x4*)(base_bf + off);
                        b0 = (f32x4){__uint_as_float(w.x << 16), __uint_as_float(w.x & 0xffff0000u), __uint_as_float(w.y << 16), __uint_as_float(w.y & 0xffff0000u)};
                        b1 = (f32x4){__uint_as_float(w.z << 16), __uint_as_float(w.z & 0xffff0000u), __uint_as_float(w.w << 16), __uint_as_float(w.w & 0xffff0000u)}; }
                    const f32x4 o0 = b0 + gv[bj][0] * acc[ai][bj][m][0], o1 = b1 + gv[bj][1] * acc[ai][bj][m][1];
                    if (lat) *(u32x4*)(out_bf + off) = pack8(o0, o1); else { *(f32x4*)(out_ctx + off) = o0; *(f32x4*)(out_ctx + off + 4) = o1; } } }
    }
};

struct EpiVal {
    static constexpr bool PERM = true, AFTER_DRAIN = false, RESCALE = false;
    const bf16_t* GT; bf16_t* H; const float* dww; const float* dwb;
    __device__ __forceinline__ void operator()(const f32x4 (&acc)[2][2][4][2], const Unit& u, int wr, int wc, int fr, int fq) const {
        const int pm = u.pm; const bool lat = pm < 64; const int R0 = pm * 256, t0 = lat ? (R0 & 8191) : 0, L = lat ? 8192 : 256;
        const int rl = wr * 64 + fr;
#pragma unroll
        for (int bj = 0; bj < 2; ++bj) { const int col = u.pn * 256 + bj * 128 + wc * 32 + 8 * fq;
            f32x4 w0[2], w1[2], w2[2], bb[2];
#pragma unroll
            for (int n = 0; n < 2; ++n) { w0[n] = *(const f32x4*)(dww + col + 4 * n); w1[n] = *(const f32x4*)(dww + 2816 + col + 4 * n); w2[n] = *(const f32x4*)(dww + 5632 + col + 4 * n); bb[n] = *(const f32x4*)(dwb + col + 4 * n); }
#pragma unroll
            for (int ai = 0; ai < 2; ++ai) {
#pragma unroll
              for (int mh = 0; mh < 4; mh += 2) {
                u32x4 gm[4], g0[4], gq[4];
#pragma unroll
                for (int m = mh; m < mh + 2; ++m) { const int rr = ai * 128 + m * 16 + rl, t = t0 + rr; const bf16_t* gp = GT + (size_t)(R0 + rr) * 2816 + col;
                    gm[m] = (u32x4){0u, 0u, 0u, 0u}; gq[m] = (u32x4){0u, 0u, 0u, 0u}; g0[m] = *(const u32x4*)gp;
                    if (t > 0) gm[m] = *(const u32x4*)(gp - 2816);
                    if (t < L - 1) gq[m] = *(const u32x4*)(gp + 2816); }
                asm volatile("" ::: "memory");
#pragma unroll
                for (int m = mh; m < mh + 2; ++m) { const int rr = ai * 128 + m * 16 + rl;
                    f32x4 o[2];
#pragma unroll
                    for (int n = 0; n < 2; ++n) { f32x4 c;
#pragma unroll
                        for (int j = 0; j < 4; ++j) { const int e = 4 * n + j; const unsigned wm = gm[m][e >> 1], wz = g0[m][e >> 1], wp = gq[m][e >> 1];
                            const float xm = (e & 1) ? __uint_as_float(wm & 0xffff0000u) : __uint_as_float(wm << 16), xz = (e & 1) ? __uint_as_float(wz & 0xffff0000u) : __uint_as_float(wz << 16),
                                        xp = (e & 1) ? __uint_as_float(wp & 0xffff0000u) : __uint_as_float(wp << 16);
                            c[j] = w0[n][j] * xm + w1[n][j] * xz + w2[n][j] * xp + bb[n][j]; }
                        const f32x2 ga = gelu_pk((f32x2){c[0], c[1]}), gb = gelu_pk((f32x2){c[2], c[3]});
                        const f32x4 v = acc[ai][bj][m][n]; o[n] = (f32x4){v[0] * ga.x, v[1] * ga.y, v[2] * gb.x, v[3] * gb.y}; }
                    *(u32x4*)(H + (size_t)(R0 + rr) * 2816 + col) = pack8(o[0], o[1]); }
                asm volatile("" ::: "memory");
              }
            }
        }
    }
};

struct EpiBranch {
    static constexpr bool PERM = true, AFTER_DRAIN = false, RESCALE = true;
    const unsigned char* G; bf16_t* Y;
    __device__ __forceinline__ void rescale(f32x4 (&acc)[2][2][4][2], const Unit& u, int t, int wr, int wc, int fr, int fq) const {
        const int bp = (t == 4) ? 0 : (t == 12) ? 1 : 2;
        const __amdgpu_buffer_rsrc_t rs = __builtin_amdgcn_make_buffer_rsrc((void*)G, 0, MT * 4096, 0x00020000);
        const int voff = (u.pm * 256 + wr * 64 + fr) * 4096 + u.pn * 256 + wc * 32 + 8 * fq;
        u32x2 p[2][4][2], q[2][4][2];
#pragma unroll
        for (int ai = 0; ai < 2; ++ai)
#pragma unroll
            for (int m = 0; m < 4; ++m)
#pragma unroll
                for (int bj = 0; bj < 2; ++bj) { const int so = (ai * 128 + m * 16) * 4096 + bj * 128 + bp * 1024;
                    p[ai][m][bj] = __builtin_bit_cast(u32x2, __builtin_amdgcn_raw_buffer_load_b64(rs, voff, so, 0)); q[ai][m][bj] = __builtin_bit_cast(u32x2, __builtin_amdgcn_raw_buffer_load_b64(rs, voff, so + 1024, 0)); }
        asm volatile("" ::: "memory");
#pragma unroll
        for (int ai = 0; ai < 2; ++ai)
#pragma unroll
            for (int m = 0; m < 4; ++m)
#pragma unroll
                for (int bj = 0; bj < 2; ++bj)
#pragma unroll
                    for (int n = 0; n < 2; ++n) { const unsigned pw = n ? p[ai][m][bj].y : p[ai][m][bj].x, qw = n ? q[ai][m][bj].y : q[ai][m][bj].x;
#pragma unroll
                        for (int j = 0; j < 4; ++j) acc[ai][bj][m][n][j] *= (float)((pw >> (8 * j)) & 255u) * __builtin_amdgcn_rcpf((float)((qw >> (8 * j)) & 255u)); }
        asm volatile("" ::: "memory");
    }
    __device__ __forceinline__ void operator()(const f32x4 (&acc)[2][2][4][2], const Unit& u, int wr, int wc, int fr, int fq) const {
        const int row0 = u.pm * 256 + wr * 64 + fr, col0 = u.pn * 256 + wc * 32 + 8 * fq;
#pragma unroll
        for (int ai = 0; ai < 2; ++ai)
#pragma unroll
            for (int m = 0; m < 4; ++m)
#pragma unroll
                for (int bj = 0; bj < 2; ++bj) { const size_t r = (size_t)(row0 + ai * 128 + m * 16); const u32x2 p = *(const u32x2*)(G + r * 4096 + 3072 + col0 + bj * 128);
                    f32x4 o[2];
#pragma unroll
                    for (int n = 0; n < 2; ++n) { const unsigned pw = n ? p.y : p.x;
#pragma unroll
                        for (int j = 0; j < 4; ++j) o[n][j] = acc[ai][bj][m][n][j] * ((float)((pw >> (8 * j)) & 255u) * (1.0f / 255.0f)); }
                    *(u32x4*)(Y + r * 1024 + col0 + bj * 128) = pack8(o[0], o[1]); }
    }
};


struct SplitKOrder {
    int nsl, ksl, G, c;
    __device__ __forceinline__ bool next(int i, Unit& u) const { const int L = i * G + c; if (L >= 8 * nsl) return false; u.pm = (L >> 2) & 1; u.pn = L & 3; u.sl = L >> 3; u.ko = u.sl * ksl; return true; }
    __device__ __forceinline__ void a_ready(const Unit&) const {}
    __device__ __forceinline__ void done(const Unit&) const {}
};
struct EpiSlab {
    static constexpr bool PERM = false, AFTER_DRAIN = false, RESCALE = false;
    float* slab;
    __device__ __forceinline__ void operator()(const f32x4 (&acc)[2][2][4][2], const Unit& u, int wr, int wc, int fr, int fq) const {
        float* o = slab + (size_t)u.sl * 512 * 1024 + (size_t)(u.pm * 256 + wr * 64 + fr) * 1024 + u.pn * 256 + wc * 32 + 4 * fq;
#pragma unroll
        for (int ai = 0; ai < 2; ++ai)
#pragma unroll
            for (int m = 0; m < 4; ++m)
#pragma unroll
                for (int bj = 0; bj < 2; ++bj)
#pragma unroll
                    for (int n = 0; n < 2; ++n) *(f32x4*)(o + (size_t)(ai * 128 + m * 16) * 1024 + bj * 128 + n * 16) = acc[ai][bj][m][n];
    }
};

struct BranchSliceOrder {
    int G, c;
    __device__ __forceinline__ bool next(int i, Unit& u) const { const int L = i * G + c; if (L >= 40) return false; u.pm = (L >> 2) & 1; u.pn = L & 3; u.sl = L >> 3; u.ko = u.sl * 256; return true; }
    __device__ __forceinline__ void a_ready(const Unit&) const {}
    __device__ __forceinline__ void done(const Unit&) const {}
};
template <class Epi, class Sched, bool ALIGN_EPI = false, bool SP2 = false>
__device__ __forceinline__ void gemm_phase(PG8_LAS unsigned char* lds, const Gemm g, const Sched& S, const Epi& E, const int tid) {
    const int wid = __builtin_amdgcn_readfirstlane(tid >> 6), lane = tid & 63, wr = wid >> 2, wc = wid & 3, fr = lane & 15, fq = lane >> 4;
    const int K = g.ld ? g.ld : g.K  , nt = g.K / BK;
    unsigned voffA[2], voffB[2];
#pragma unroll
    for (int i = 0; i < 2; ++i) { int R, C; stage_rc(tid * 16 + i * 8192, R, C); const int Rb = Epi::PERM ? ((R & ~31) + perm32(R & 31)) : R;
        voffA[i] = (unsigned)(R * K + C) * 2u; voffB[i] = (unsigned)(Rb * K + C) * 2u; }
    const size_t kstep = (size_t)(BK * 2);
    const size_t hstep = (size_t)HALF * K * 2;
    const size_t tstep = 2 * hstep;
    const unsigned ldsw = (unsigned)wid * 1024u;
    const int aoff = lds_byte(wr * 64 + fr, fq * 8), boff = lds_byte(wc * 32 + fr, fq * 8);
#define PG8_SA(b, h) (((b) * 2 + (h)) * HTB)
#define PG8_SB(b, h) ((4 + (b) * 2 + (h)) * HTB)
#define PG8_STAGE(bufoff, gbase, voff) do { _Pragma("unroll") for (int _i = 0; _i < 2; ++_i) \
        __builtin_amdgcn_global_load_lds((const unsigned*)((const char*)(gbase) + (voff)[_i]), (PG8_LAS unsigned*)(lds + (bufoff) + ldsw + _i * 8192), 16, 0, 0); } while (0)
#define PG8_LDA(dst, b, h) do { _Pragma("unroll") for (int m = 0; m < 4; ++m) _Pragma("unroll") for (int k = 0; k < 2; ++k) dst[m][k] = *(const PG8_LAS bf16x8*)(lds + PG8_SA(b, h) + aoff + m * 2048 + k * 1024); } while (0)
#define PG8_LDB(dst, b, h) do { _Pragma("unroll") for (int n = 0; n < 2; ++n) _Pragma("unroll") for (int k = 0; k < 2; ++k) dst[n][k] = *(const PG8_LAS bf16x8*)(lds + PG8_SB(b, h) + boff + n * 2048 + k * 1024); } while (0)
#define PG8_MMA(ai, bj, At, Bt) do { __builtin_amdgcn_s_setprio(1); _Pragma("unroll") for (int m = 0; m < 4; ++m) _Pragma("unroll") for (int n = 0; n < 2; ++n) _Pragma("unroll") for (int k = 0; k < 2; ++k) \
        acc[ai][bj][m][n] = __builtin_amdgcn_mfma_f32_16x16x32_bf16(Bt[n][k], At[m][k], acc[ai][bj][m][n], 0, 0, 0); __builtin_amdgcn_s_setprio(0); } while (0)
#define PG8_WAIT_V(n) asm volatile("s_waitcnt vmcnt(" #n ")" ::: "memory")
#define PG8_WAIT_L(n) asm volatile("s_waitcnt lgkmcnt(" #n ")" ::: "memory")
#define PG8_BAR __builtin_amdgcn_s_barrier()
#define PG8_SCHED __builtin_amdgcn_sched_barrier(0)
    Unit cur, nxt; int ui = 0;
    if (!S.next(0, cur)) return;
    f32x4 acc[2][2][4][2];
#pragma unroll
    for (int a = 0; a < 2; ++a)
#pragma unroll
        for (int b = 0; b < 2; ++b)
#pragma unroll
            for (int m = 0; m < 4; ++m)
#pragma unroll
                for (int n = 0; n < 2; ++n) acc[a][b][m][n] = (f32x4){0.f, 0.f, 0.f, 0.f};
    bf16x8 At[4][2], B0[2][2], B1[2][2];
    const char* cA = (const char*)g.A + (size_t)cur.pm * tstep + (size_t)cur.ko * 2; const char* cB = (const char*)g.Bt + (size_t)cur.pn * tstep + (size_t)cur.ko * 2;
    S.a_ready(cur);
    if constexpr (SP2) {
        PG8_STAGE(PG8_SB(0, 0), cB, voffB); PG8_STAGE(PG8_SB(0, 1), cB + hstep, voffB); PG8_STAGE(PG8_SA(0, 0), cA, voffA); PG8_STAGE(PG8_SA(0, 1), cA + hstep, voffA);
        if (wr == 1) PG8_BAR;
        PG8_WAIT_V(2); PG8_BAR;
        PG8_STAGE(PG8_SB(1, 0), cB + kstep, voffB); PG8_STAGE(PG8_SA(1, 0), cA + kstep, voffA); PG8_STAGE(PG8_SB(1, 1), cB + hstep + kstep, voffB);
        PG8_WAIT_V(6); PG8_BAR;
    } else {
        PG8_STAGE(PG8_SB(0, 0), cB, voffB); PG8_STAGE(PG8_SA(0, 0), cA, voffA); PG8_STAGE(PG8_SB(0, 1), cB + hstep, voffB); PG8_STAGE(PG8_SA(0, 1), cA + hstep, voffA);
        if (wr == 1) PG8_BAR;
        PG8_WAIT_V(4); PG8_BAR;
        PG8_STAGE(PG8_SB(1, 0), cB + kstep, voffB); PG8_STAGE(PG8_SA(1, 0), cA + kstep, voffA); PG8_STAGE(PG8_SB(1, 1), cB + hstep + kstep, voffB);
        PG8_WAIT_V(6); PG8_BAR;
    }
    for (;;) {
        const bool has_next = S.next(ui + 1, nxt);
        const char* nA = has_next ? (const char*)g.A + (size_t)nxt.pm * tstep + (size_t)nxt.ko * 2 : cA; const char* nB = has_next ? (const char*)g.Bt + (size_t)nxt.pn * tstep + (size_t)nxt.ko * 2 : cB;
        for (int t = 0; t < nt; t += 2) {
            if constexpr (Epi::RESCALE) { if (t == 4 || t == 12 || t == 16) E.rescale(acc, cur, t, wr, wc, fr, fq); }
            const bool last = (t == nt - 2);
            const char* a1 = cA + (size_t)(t + 1) * kstep;
            const char* a2 = last ? nA : cA + (size_t)(t + 2) * kstep; const char* b2 = last ? nB : cB + (size_t)(t + 2) * kstep;
            const char* a3 = a2 + kstep; const char* b3 = b2 + kstep;
            if (last && has_next) S.a_ready(nxt);
            if constexpr (SP2) {
            PG8_LDB(B0, 0, 0); PG8_LDB(B1, 0, 1); PG8_SCHED; PG8_LDA(At, 0, 0); PG8_STAGE(PG8_SA(1, 1), a1 + hstep, voffA);
            PG8_WAIT_V(8); PG8_WAIT_L(0); PG8_BAR; PG8_MMA(0, 0, At, B0); PG8_MMA(0, 1, At, B1); PG8_BAR; PG8_SCHED;
            PG8_LDA(At, 0, 1); PG8_STAGE(PG8_SB(0, 0), b2, voffB); PG8_STAGE(PG8_SB(0, 1), b2 + hstep, voffB); PG8_STAGE(PG8_SA(0, 0), a2, voffA);
            PG8_WAIT_V(8); PG8_WAIT_L(0); PG8_BAR; PG8_MMA(1, 0, At, B0); PG8_MMA(1, 1, At, B1); PG8_BAR; PG8_SCHED;
            PG8_LDB(B0, 1, 0); PG8_LDB(B1, 1, 1); PG8_SCHED; PG8_LDA(At, 1, 0); PG8_STAGE(PG8_SA(0, 1), a2 + hstep, voffA);
            PG8_WAIT_V(8); PG8_WAIT_L(0); PG8_BAR; PG8_MMA(0, 0, At, B0); PG8_MMA(0, 1, At, B1); PG8_BAR; PG8_SCHED;
            PG8_LDA(At, 1, 1); PG8_STAGE(PG8_SB(1, 0), b3, voffB); PG8_STAGE(PG8_SB(1, 1), b3 + hstep, voffB); PG8_STAGE(PG8_SA(1, 0), a3, voffA);
            PG8_WAIT_V(8); PG8_WAIT_L(0); PG8_BAR; PG8_MMA(1, 0, At, B0); PG8_MMA(1, 1, At, B1); PG8_BAR; PG8_SCHED;
            } else {
            PG8_LDB(B0, 0, 0); PG8_SCHED; PG8_LDA(At, 0, 0); PG8_STAGE(PG8_SA(1, 1), a1 + hstep, voffA);
            PG8_WAIT_L(8); PG8_BAR; PG8_WAIT_L(0); PG8_MMA(0, 0, At, B0); PG8_BAR; PG8_SCHED;
            PG8_LDB(B1, 0, 1); PG8_STAGE(PG8_SB(0, 0), b2, voffB);
            PG8_BAR; PG8_WAIT_L(0); PG8_MMA(0, 1, At, B1); PG8_BAR;
            PG8_LDA(At, 0, 1); PG8_STAGE(PG8_SA(0, 0), a2, voffA);
            PG8_BAR; PG8_WAIT_L(0); PG8_MMA(1, 0, At, B0); PG8_BAR; PG8_SCHED;
            PG8_STAGE(PG8_SB(0, 1), b2 + hstep, voffB);
            PG8_WAIT_V(6); PG8_BAR; PG8_MMA(1, 1, At, B1); PG8_BAR;
            PG8_LDB(B0, 1, 0); PG8_SCHED; PG8_LDA(At, 1, 0); PG8_STAGE(PG8_SA(0, 1), a2 + hstep, voffA);
            PG8_WAIT_L(8); PG8_BAR; PG8_WAIT_L(0); PG8_MMA(0, 0, At, B0); PG8_BAR; PG8_SCHED;
            PG8_LDB(B1, 1, 1); PG8_STAGE(PG8_SB(1, 0), b3, voffB);
            PG8_BAR; PG8_WAIT_L(0); PG8_MMA(0, 1, At, B1); PG8_BAR;
            PG8_LDA(At, 1, 1); PG8_STAGE(PG8_SA(1, 0), a3, voffA);
            PG8_BAR; PG8_WAIT_L(0); PG8_MMA(1, 0, At, B0); PG8_BAR; PG8_SCHED;
            PG8_STAGE(PG8_SB(1, 1), b3 + hstep, voffB);
            PG8_WAIT_V(6); PG8_BAR; PG8_MMA(1, 1, At, B1); PG8_BAR;
            }
        }
        if constexpr (ALIGN_EPI) { if (wr == 0) PG8_BAR; }
        if constexpr (!Epi::AFTER_DRAIN) { E(acc, cur, wr, wc, fr, fq); S.done(cur); }
        if (!has_next) break;
#pragma unroll
        for (int a = 0; a < 2; ++a)
#pragma unroll
            for (int b = 0; b < 2; ++b)
#pragma unroll
                for (int m = 0; m < 4; ++m)
#pragma unroll
                    for (int n = 0; n < 2; ++n) acc[a][b][m][n] = (f32x4){0.f, 0.f, 0.f, 0.f};
        cur = nxt; cA = nA; cB = nB; ++ui;
        if constexpr (ALIGN_EPI) { if (wr == 1) PG8_BAR; }
    }
    PG8_WAIT_V(0);
    if constexpr (!ALIGN_EPI) { if (wr == 0) PG8_BAR; }
    PG8_BAR;
    if constexpr (Epi::AFTER_DRAIN) { E.fused(acc, cur, wr, wc, fr, fq, lds, wid, lane); S.done(cur); }
#undef PG8_SA
#undef PG8_SB
#undef PG8_STAGE
#undef PG8_LDA
#undef PG8_LDB
#undef PG8_MMA
#undef PG8_WAIT_V
#undef PG8_WAIT_L
#undef PG8_BAR
#undef PG8_SCHED
}
}
namespace att {
constexpr int NW = 8, QBLK = 32, KVBLK = 64, LDQ = 512, LDO = KCAT;
constexpr int SHM_V = 16384, SHM_K = 16384, SHM_ATTN = 3 * SHM_V + 2 * SHM_K + NW * 64 * 4;
constexpr float THR = 8.f;
#ifndef ATT_SDEPTH
#define ATT_SDEPTH 1
#endif
constexpr int SDEPTH = ATT_SDEPTH;
#define KSWZ(row, colB) ((row) * 256 + ((colB) ^ (((row) & 7) << 4)))
#define SBAR() __builtin_amdgcn_sched_barrier(0)
__device__ __forceinline__ int crow(int r, int hi) { return (r & 3) + 8 * (r >> 2) + 4 * hi; }
__device__ __forceinline__ unsigned cvtpk(float lo, float hi) { return cvt2bf(lo, hi); }

__device__ __forceinline__ void partialSM(f32x16& p0, f32x16& p1, float& m_reg, float& mn, float& alpha) {
  constexpr float C = 1.4426950408889634f;
  float pmax = p0[0];
#pragma unroll
  for (int r = 1; r < 16; ++r) pmax = fmaxf(pmax, p0[r]);
#pragma unroll
  for (int r = 0; r < 16; ++r) pmax = fmaxf(pmax, p1[r]);
  { auto rr = __builtin_amdgcn_permlane32_swap(__float_as_uint(pmax), __float_as_uint(pmax), false, false);
    pmax = fmaxf(__uint_as_float(rr[0]), __uint_as_float(rr[1])); }
  if (__builtin_expect(__all(pmax - m_reg <= THR), 1)) { mn = m_reg; alpha = 1.f; }
  else { mn = fmaxf(m_reg, pmax); alpha = __builtin_amdgcn_exp2f((m_reg - mn) * C); m_reg = mn; }
  const float mnC = -mn * C;
#pragma unroll
  for (int r = 0; r < 16; ++r) p0[r] = fmaf(p0[r], C, mnC);
#pragma unroll
  for (int r = 0; r < 16; ++r) p1[r] = fmaf(p1[r], C, mnC);
#pragma unroll
  for (int r = 0; r < 16; ++r) p0[r] = __builtin_amdgcn_exp2f(p0[r]);
}
__device__ __forceinline__ void finishSM(f32x16& p0, f32x16& p1, float alpha, float& l_reg, bf16x8& pa0, bf16x8& pa1, bf16x8& pa2, bf16x8& pa3) {
#pragma unroll
  for (int r = 0; r < 16; ++r) p1[r] = __builtin_amdgcn_exp2f(p1[r]);
  float ps = 0;
#pragma unroll
  for (int r = 0; r < 16; ++r) ps += p0[r];
#pragma unroll
  for (int r = 0; r < 16; ++r) ps += p1[r];
  { auto rr = __builtin_amdgcn_permlane32_swap(__float_as_uint(ps), __float_as_uint(ps), false, false);
    ps = __uint_as_float(rr[0]) + __uint_as_float(rr[1]); }
  l_reg = l_reg * alpha + ps;
#define PK4(P, BASE, OUT) do { unsigned a0 = cvtpk(P[BASE + 0], P[BASE + 1]), a1 = cvtpk(P[BASE + 2], P[BASE + 3]);   \
    unsigned b0 = cvtpk(P[BASE + 4], P[BASE + 5]), b1 = cvtpk(P[BASE + 6], P[BASE + 7]);                              \
    auto r0 = __builtin_amdgcn_permlane32_swap(a0, b0, false, false); auto r1 = __builtin_amdgcn_permlane32_swap(a1, b1, false, false); \
    u32x4 w = {r0[0], r1[0], r0[1], r1[1]}; OUT = *reinterpret_cast<bf16x8*>(&w); } while (0)
  PK4(p0, 0, pa0); PK4(p0, 8, pa1); PK4(p1, 0, pa2); PK4(p1, 8, pa3);
#undef PK4
}
__device__ __forceinline__ void qkt(f32x16& p0, f32x16& p1, const char* Ks, const bf16x8* qr, int r32, int hi, int kcol) {
  p0 = f32x16{}; p1 = f32x16{};
#pragma unroll
  for (int d0 = 0; d0 < 4; ++d0) { const int cb = kcol + (d0 * 16 + hi * 8) * 2;
    const bf16x8 b0 = *reinterpret_cast<const bf16x8*>(Ks + KSWZ(r32, cb));
    const bf16x8 b1 = *reinterpret_cast<const bf16x8*>(Ks + KSWZ(32 + r32, cb));
    p0 = __builtin_amdgcn_mfma_f32_32x32x16_bf16(b0, qr[d0], p0, 0, 0, 0);
    p1 = __builtin_amdgcn_mfma_f32_32x32x16_bf16(b1, qr[d0], p1, 0, 0, 0); }
}
__device__ __forceinline__ int v_st(int k, int c) { const int kk = (k & ~0xC) | ((k & 4) << 1) | ((k & 8) >> 1); return ((kk >> 3) * 4 + (c >> 5)) * 512 + ((kk & 7) * 32 + (c & 31)) * 2; }
__device__ __forceinline__ int v_rd_base(int lane) { return ((lane & 3) << 3) | (((lane >> 2) & 3) << 6) | (((lane >> 4) & 1) << 5) | (((lane >> 5) & 1) << 8); }
constexpr int v_rd_off(int d0, int ks, int half) { return d0 * 512 + ks * 4096 + half * 2048; }
template <int OFF> __device__ __forceinline__ s16x4 tr_read(int vb) {
  s16x4 r; asm volatile("ds_read_b64_tr_b16 %0, %1 offset:%2" : "=&v"(r) : "v"(vb), "i"(OFF) : "memory"); return r;
}
template <int D0> __device__ __forceinline__ void pv_one(f32x16& od, int vb, bf16x8 pa0, bf16x8 pa1, bf16x8 pa2, bf16x8 pa3) {
  const s16x4 l0 = tr_read<v_rd_off(D0, 0, 0)>(vb), h0 = tr_read<v_rd_off(D0, 0, 1)>(vb), l1 = tr_read<v_rd_off(D0, 1, 0)>(vb), h1 = tr_read<v_rd_off(D0, 1, 1)>(vb);
  const s16x4 l2 = tr_read<v_rd_off(D0, 2, 0)>(vb), h2 = tr_read<v_rd_off(D0, 2, 1)>(vb), l3 = tr_read<v_rd_off(D0, 3, 0)>(vb), h3 = tr_read<v_rd_off(D0, 3, 1)>(vb);
  asm volatile("s_waitcnt lgkmcnt(0)" ::: "memory"); SBAR();
#define PK(L, H) (bf16x8){L[0], L[1], L[2], L[3], H[0], H[1], H[2], H[3]}
  od = __builtin_amdgcn_mfma_f32_32x32x16_bf16(pa0, PK(l0, h0), od, 0, 0, 0);
  od = __builtin_amdgcn_mfma_f32_32x32x16_bf16(pa1, PK(l1, h1), od, 0, 0, 0);
  od = __builtin_amdgcn_mfma_f32_32x32x16_bf16(pa2, PK(l2, h2), od, 0, 0, 0);
  od = __builtin_amdgcn_mfma_f32_32x32x16_bf16(pa3, PK(l3, h3), od, 0, 0, 0);
#undef PK
}
__device__ __forceinline__ void pv_d0(f32x16* o, int vb, bf16x8 pa0, bf16x8 pa1, bf16x8 pa2, bf16x8 pa3) {
  pv_one<0>(o[0], vb, pa0, pa1, pa2, pa3); pv_one<1>(o[1], vb, pa0, pa1, pa2, pa3); pv_one<2>(o[2], vb, pa0, pa1, pa2, pa3); pv_one<3>(o[3], vb, pa0, pa1, pa2, pa3);
}

template <int VAR>
__device__ __forceinline__ void attn_unit(const bf16_t* __restrict__ Qb, const bf16_t* __restrict__ Kh, const bf16_t* __restrict__ Vh, int nkeys,
                                          bf16_t* __restrict__ Ob, float lam, float osc, const float* __restrict__ sg, char* lds, const int tid) {
  const int wid = __builtin_amdgcn_readfirstlane(tid >> 6), lane = tid & 63, r32 = lane & 31, hi = lane >> 5;
  const int comp = wid >> 2, qw = wid & 3, kcol = comp * 128;
  char* K_lds = lds; char* V_lds = lds + 2 * SHM_K;
  float* ws = (float*)(lds + 2 * SHM_K + 3 * SHM_V) + wid * 64; float* li_l = ws; float* al_l = ws + 32;
  float m_reg = -1e30f, l_reg = 0; f32x16 o[4] = {}; bf16x8 qr[4];
  const bf16_t* Qw = Qb + (long)(qw * QBLK + r32) * LDQ + comp * 64 + hi * 8;
#pragma unroll
  for (int d0 = 0; d0 < 4; ++d0) qr[d0] = *reinterpret_cast<const bf16x8*>(Qw + d0 * 16);
  const int sr = tid >> 4, sc = (tid & 15) * 8, vst0 = v_st(sr, sc), vst1 = v_st(32 + sr, sc);
  const int vb0 = (int)(uintptr_t)V_lds + v_rd_base(lane);
  bf16x8 sk0 = {}, sk1 = {}, sv0 = {}, sv1 = {};
#define LOADK(t) do { if constexpr (!(VAR & 8)) { sk0 = *reinterpret_cast<const bf16x8*>(&Kh[(long)((t) * KVBLK + sr) * LDQ + sc]); sk1 = *reinterpret_cast<const bf16x8*>(&Kh[(long)((t) * KVBLK + 32 + sr) * LDQ + sc]); } } while (0)
#define LOADV(t) do { if constexpr (!(VAR & 8)) { sv0 = *reinterpret_cast<const bf16x8*>(&Vh[(long)((t) * KVBLK + sr) * LDQ + sc]); sv1 = *reinterpret_cast<const bf16x8*>(&Vh[(long)((t) * KVBLK + 32 + sr) * LDQ + sc]); } } while (0)
#define WRITEK(slot) do { if constexpr (!(VAR & 8)) { *(bf16x8*)(K_lds + (slot) * SHM_K + KSWZ(sr, sc * 2)) = sk0; *(bf16x8*)(K_lds + (slot) * SHM_K + KSWZ(32 + sr, sc * 2)) = sk1; } } while (0)
#define WRITEV(off) do { if constexpr (!(VAR & 8)) { *(bf16x8*)(V_lds + (off) + vst0) = sv0; *(bf16x8*)(V_lds + (off) + vst1) = sv1; } } while (0)
#define VMW() asm volatile("s_waitcnt vmcnt(0)" ::: "memory")
#define QKT(P0, P1, KS) do { if constexpr (VAR & 4) { P0 = f32x16{}; P1 = f32x16{}; asm volatile("" : "+v"(P0), "+v"(P1)); } else qkt(P0, P1, KS, qr, r32, hi, kcol); } while (0)
#define PSM(P0, P1, MN, AL) do { if constexpr (VAR & 1) { MN = m_reg; AL = 1.f; asm volatile("" : "+v"(P0), "+v"(P1)); } else partialSM(P0, P1, m_reg, MN, AL); } while (0)
#define FSM(P0, P1, AL) do { if constexpr (VAR & 1) { asm volatile("" : "+v"(P0), "+v"(P1)); pa0 = __builtin_bit_cast(bf16x8, (f32x4){P0[0], P0[1], P0[2], P0[3]}); pa1 = __builtin_bit_cast(bf16x8, (f32x4){P0[4], P0[5], P0[6], P0[7]}); pa2 = __builtin_bit_cast(bf16x8, (f32x4){P1[0], P1[1], P1[2], P1[3]}); pa3 = __builtin_bit_cast(bf16x8, (f32x4){P1[4], P1[5], P1[6], P1[7]}); } else finishSM(P0, P1, AL, l_reg, pa0, pa1, pa2, pa3); } while (0)
#define PV(OFF) do { if constexpr (VAR & 2) { asm volatile("" : "+v"(pa0), "+v"(pa1), "+v"(pa2), "+v"(pa3)); } else pv_d0(o, vb0 + (OFF), pa0, pa1, pa2, pa3); } while (0)
#define RESC(a) do { if (__any((a) < 1.f)) { if (hi == 0) al_l[r32] = (a); asm volatile("s_waitcnt lgkmcnt(0)" ::: "memory"); \
    _Pragma("unroll") for (int d = 0; d < 4; ++d) _Pragma("unroll") for (int r = 0; r < 16; ++r) o[d][r] *= al_l[crow(r, hi)]; } } while (0)
  f32x16 pA0, pA1, pB0, pB1; float mnA, mnB, alA, alB; bf16x8 pa0, pa1, pa2, pa3; const int NT = nkeys / KVBLK;
  LOADK(0); VMW(); WRITEK(0); LOADK(1); LOADV(0);
  __syncthreads();
  if (comp == 1) __syncthreads();
  VMW(); WRITEK(1); WRITEV(0);
  SBAR(); QKT(pA0, pA1, K_lds); SBAR();
  __syncthreads();
  LOADK(2); LOADV(1); SBAR();
  PSM(pA0, pA1, mnA, alA);
  __syncthreads();
  int va = 0, vb = SHM_V, vc = 2 * SHM_V;
  for (int j = 1; j + 1 < NT; j += 2) {
    VMW(); WRITEK(0); WRITEV(vb);
    SBAR(); QKT(pB0, pB1, K_lds + SHM_K);
    FSM(pA0, pA1, alA); SBAR();
    __syncthreads();
    LOADK(j + 2); LOADV(j + 1); SBAR();
    PV(va); PSM(pB0, pB1, mnB, alB);
    RESC(alB);
    __syncthreads();
    VMW(); WRITEK(1); WRITEV(vc);
    SBAR(); QKT(pA0, pA1, K_lds);
    FSM(pB0, pB1, alB); SBAR();
    __syncthreads();
    if (j + 3 < NT) LOADK(j + 3);
    LOADV(j + 2); SBAR();
    PV(vb); PSM(pA0, pA1, mnA, alA);
    RESC(alA);
    __syncthreads();
    { const int t = va; va = vc; vc = vb; vb = t; }
  }
  VMW(); WRITEV(vb);
  SBAR(); QKT(pB0, pB1, K_lds + SHM_K);
  FSM(pA0, pA1, alA); SBAR();
  __syncthreads();
  PV(va); PSM(pB0, pB1, mnB, alB);
  RESC(alB);
  __syncthreads();
  FSM(pB0, pB1, alB); SBAR();
  PV(vb);
  if (comp == 0) __syncthreads();
  if (hi == 0) li_l[r32] = l_reg; asm volatile("s_waitcnt lgkmcnt(0)" ::: "memory");
  float rli[16];
#pragma unroll
  for (int r = 0; r < 16; ++r) rli[r] = __builtin_amdgcn_rcpf(li_l[crow(r, hi)]);
  __syncthreads();
  float* XO = (float*)lds + qw * (32 * 128);
  if (comp == 1) {
#pragma unroll
    for (int r = 0; r < 16; ++r)
#pragma unroll
      for (int d0 = 0; d0 < 4; ++d0) XO[crow(r, hi) * 128 + d0 * 32 + r32] = o[d0][r] * rli[r];
  }
  __syncthreads();
  if (comp == 0) {
    float ss[16];
#pragma unroll
    for (int r = 0; r < 16; ++r) { float s = 0.f;
#pragma unroll
      for (int d0 = 0; d0 < 4; ++d0) { const float v = o[d0][r] * rli[r] - lam * XO[crow(r, hi) * 128 + d0 * 32 + r32]; o[d0][r] = v; s += v * v; }
      ss[r] = s; }
#pragma unroll
    for (int r = 0; r < 16; ++r) { float s = ss[r]; s += swz_xor<1>(s); s += swz_xor<2>(s); s += swz_xor<4>(s); s += swz_xor<8>(s); s += swz_xor<16>(s);
      ss[r] = osc / sqrtf(s * (1.0f / 128.0f) + EPS); }
    float gam[4];
#pragma unroll
    for (int d0 = 0; d0 < 4; ++d0) gam[d0] = sg[d0 * 32 + r32];
    asm volatile("s_waitcnt lgkmcnt(0)" ::: "memory");
    bf16_t* stg = (bf16_t*)XO;
#pragma unroll
    for (int r = 0; r < 16; ++r)
#pragma unroll
      for (int d0 = 0; d0 < 4; ++d0) stg[crow(r, hi) * 128 + d0 * 32 + r32] = (bf16_t)(cvtpk(o[d0][r] * ss[r] * gam[d0], 0.f) & 0xffffu);
    asm volatile("s_waitcnt lgkmcnt(0)" ::: "memory");
#pragma unroll
    for (int i = 0; i < 8; ++i) { const int row = i * 4 + (lane >> 4), ch = lane & 15; const u32x4 v = *(const u32x4*)(stg + row * 128 + ch * 8);
      if constexpr (VAR & 16) { asm volatile("" :: "v"(v.x), "v"(v.y), "v"(v.z), "v"(v.w)); } else *(u32x4*)(Ob + (long)(qw * QBLK + row) * LDO + ch * 8) = v; }
  }
  __syncthreads();
#undef LOADK
#undef LOADV
#undef WRITEK
#undef WRITEV
#undef VMW
#undef QKT
#undef PSM
#undef FSM
#undef PV
#undef RESC
}
#undef KSWZ
#undef SBAR
}
namespace att2 {
using att::crow; using att::v_st; using att::v_rd_base; using att::v_rd_off;
constexpr int NW = 8, QBLK = 32, KVBLK = 64, LDQ = 512, LDO = KCAT, SHM_K = 16384, SHM_V = 16384;
constexpr float THRL = 8.0f;
#ifndef ATT_STAGGER
#define ATT_STAGGER 1
#endif
typedef short v4i16_t __attribute__((ext_vector_type(4)));
typedef __attribute__((address_space(3))) const char* lds_cptr;
typedef __attribute__((address_space(3))) char* lds_ptr;
#define SBAR() __builtin_amdgcn_sched_barrier(0)
#define KSWZ(row, colB) ((row) * 256 + ((colB) ^ (((row) & 7) << 4)))
__device__ __forceinline__ s16x4 vtr(lds_cptr p) { return __builtin_bit_cast(s16x4, __builtin_amdgcn_ds_read_tr16_b64_v4i16((__attribute__((address_space(3))) v4i16_t*)p)); }
__device__ __forceinline__ bf16x8 ldk(lds_cptr p) { return *(const __attribute__((address_space(3))) bf16x8*)p; }
#define MF(D, A, B, C) do { if constexpr (VAR & 4) { asm volatile("" : "+v"(D)); } else D = __builtin_amdgcn_mfma_f32_32x32x16_bf16(A, B, C, 0, 0, 0); } while (0)
#define VF(L, H) (bf16x8){L[0], L[1], L[2], L[3], H[0], H[1], H[2], H[3]}

__device__ __forceinline__ int vkey(int g) { const int s_ = g >> 5, kk = ((s_ >> 2) << 3) | ((g >> 2) & 7); return (kk & ~0xC) | ((kk & 4) << 1) | ((kk & 8) >> 1); }
template <int VAR>
__device__ __forceinline__ void attn_unit(const bf16_t* __restrict__ Qb, const bf16_t* __restrict__ Kh, const bf16_t* __restrict__ Vh, int nkeys,
                                          bf16_t* __restrict__ Ob, float lam, float osc, const float* __restrict__ sg, char* lds, const int tid) {
  const int wid = __builtin_amdgcn_readfirstlane(tid >> 6), lane = tid & 63, r32 = lane & 31, hi = lane >> 5;
  const int comp = wid >> 2, qw = wid & 3, kcol = comp * 128;
  const lds_ptr L3 = (lds_ptr)(unsigned)(uintptr_t)lds;
  float* ws = (float*)(lds + 3 * SHM_K + 3 * SHM_V) + wid * 64; float* li_l = ws; float* al_l = ws + 32;
  float mhat = 0.f, l_reg = 0.f; f32x16 o[4] = {}; bf16x8 qr[4]; f32x16 negm = {};
  const bf16_t* Qw = Qb + (long)(qw * QBLK + r32) * LDQ + comp * 64 + hi * 8;
#pragma unroll
  for (int d0 = 0; d0 < 4; ++d0) qr[d0] = *reinterpret_cast<const bf16x8*>(Qw + d0 * 16);
  const int sr = tid >> 4, sc = (tid & 15) * 8;
  const int kr0 = 4 * wid + (lane >> 4), kr1 = kr0 + 32;
  const bf16_t* ksrc0 = Kh + (long)kr0 * LDQ + (((lane & 15) ^ (kr0 & 7)) << 3); const bf16_t* ksrc1 = Kh + (long)kr1 * LDQ + (((lane & 15) ^ (kr1 & 7)) << 3);
  const int g0_ = 64 * wid + lane, g1_ = g0_ + 512;
  const int vk0 = vkey(g0_), vk1 = vkey(g1_);
  const bf16_t* vsrc0 = Vh + (long)vk0 * LDQ + ((g0_ >> 5) & 3) * 32 + (g0_ & 3) * 8; const bf16_t* vsrc1 = Vh + (long)vk1 * LDQ + ((g1_ >> 5) & 3) * 32 + (g1_ & 3) * 8;
  const unsigned kd0 = (unsigned)(uintptr_t)lds + wid * 1024, kd1 = kd0 + 8192, vd0 = (unsigned)(uintptr_t)lds + 3 * SHM_K + wid * 1024, vd1 = vd0 + 8192;
  lds_cptr kq[4];
#pragma unroll
  for (int d0 = 0; d0 < 4; ++d0) kq[d0] = L3 + r32 * 256 + ((kcol + d0 * 32 + hi * 16) ^ ((r32 & 7) << 4));
  const lds_cptr vp0 = L3 + 3 * SHM_K + v_rd_base(lane);
#define GLDS(src, dst) __builtin_amdgcn_global_load_lds((const unsigned*)(src), (__attribute__((address_space(3))) unsigned*)(dst), 16, 0, 0)
#define DMAK(t, slot) do { if constexpr (!(VAR & 8)) { GLDS(ksrc0 + (long)(t) * KVBLK * LDQ, (unsigned)__builtin_amdgcn_readfirstlane(kd0 + (slot) * SHM_K)); GLDS(ksrc1 + (long)(t) * KVBLK * LDQ, (unsigned)__builtin_amdgcn_readfirstlane(kd1 + (slot) * SHM_K)); } } while (0)
#define DMAV(t, off) do { if constexpr (!(VAR & 8)) { GLDS(vsrc0 + (long)(t) * KVBLK * LDQ, (unsigned)__builtin_amdgcn_readfirstlane(vd0 + (off))); GLDS(vsrc1 + (long)(t) * KVBLK * LDQ, (unsigned)__builtin_amdgcn_readfirstlane(vd1 + (off))); } } while (0)
#ifndef ATT_PRIO
#define ATT_PRIO 1
#endif
#define PRIO(x) do { if (ATT_PRIO == 1) __builtin_amdgcn_s_setprio(x); } while (0)
#define PRIO1(x) do { if (ATT_PRIO == 2) __builtin_amdgcn_s_setprio(x); } while (0)
#define VMW() asm volatile("s_waitcnt vmcnt(0)" ::: "memory")
#define BARW(n) do { asm volatile("s_waitcnt vmcnt(" #n ") lgkmcnt(0)" ::: "memory"); __builtin_amdgcn_s_barrier(); asm volatile("" ::: "memory"); } while (0)
  f32x16 pA0, pA1, pB0, pB1; u32x4 pw0 = {}, pw1 = {}, pw2 = {}, pw3 = {}; const int NT = nkeys / KVBLK; bool resc = false;
#define KF(KOFF, d0, half) ldk(kq[d0] + (KOFF) + 8192 * (half))
#define PKA(P, B, A0, A1) do { if constexpr (!(VAR & 1)) { A0 = cvt2bf(P[B + 0], P[B + 1]); A1 = cvt2bf(P[B + 2], P[B + 3]); sacc += P[B + 0]; sacc += P[B + 1]; sacc += P[B + 2]; sacc += P[B + 3]; } } while (0)
#define PKB(P, B, A0, A1, PW) do { if constexpr (!(VAR & 1)) { const unsigned b0_ = cvt2bf(P[B + 4], P[B + 5]), b1_ = cvt2bf(P[B + 6], P[B + 7]); \
    auto r0_ = __builtin_amdgcn_permlane32_swap(A0, b0_, false, false); auto r1_ = __builtin_amdgcn_permlane32_swap(A1, b1_, false, false); \
    PW = (u32x4){r0_[0], r1_[0], r0_[1], r1_[1]}; sacc += P[B + 4]; sacc += P[B + 5]; sacc += P[B + 6]; sacc += P[B + 7]; } } while (0)
#define H1(C0, C1, P0, P1, KOFF, FIN) do { \
    float sacc = 0.f; unsigned a0_ = 0, a1_ = 0; \
    bf16x8 f0 = KF(KOFF, 0, 0), f1 = KF(KOFF, 0, 1), f2 = KF(KOFF, 1, 0); SBAR(); \
    MF(C0, f0, qr[0], negm); { f0 = KF(KOFF, 1, 1); if (FIN) PKA(P0, 0, a0_, a1_); } SBAR(); \
    MF(C1, f1, qr[0], negm); { f1 = KF(KOFF, 2, 0); if (FIN) PKB(P0, 0, a0_, a1_, pw0); } SBAR(); \
    MF(C0, f2, qr[1], C0);   { f2 = KF(KOFF, 2, 1); if (FIN) PKA(P0, 8, a0_, a1_); } SBAR(); \
    MF(C1, f0, qr[1], C1);   { f0 = KF(KOFF, 3, 0); if (FIN) PKB(P0, 8, a0_, a1_, pw1); } SBAR(); \
    MF(C0, f1, qr[2], C0);   { f1 = KF(KOFF, 3, 1); if (FIN) PKA(P1, 0, a0_, a1_); } SBAR(); \
    MF(C1, f2, qr[2], C1);   { if (FIN) PKB(P1, 0, a0_, a1_, pw2); } SBAR(); \
    MF(C0, f0, qr[3], C0);   { if (FIN) PKA(P1, 8, a0_, a1_); } SBAR(); \
    MF(C1, f1, qr[3], C1);   { if (FIN) PKB(P1, 8, a0_, a1_, pw3); } SBAR(); \
    if (FIN) { auto rr_ = __builtin_amdgcn_permlane32_swap(__float_as_uint(sacc), __float_as_uint(sacc), false, false); l_reg += __uint_as_float(rr_[0]) + __uint_as_float(rr_[1]); } \
  } while (0)
#define VRD(VOFF, ks, d0, LO, HI) do { LO = vtr(vp0 + (VOFF) + v_rd_off(d0, ks, 0)); HI = vtr(vp0 + (VOFF) + v_rd_off(d0, ks, 1)); } while (0)
#define PAF(k) __builtin_bit_cast(bf16x8, pw##k)
#define MX3(a, b, c) ((VAR & 2) ? (a) : fmaxf(fmaxf((a), (b)), (c)))
#define EX(X, i) do { if constexpr (!(VAR & 2)) X[i] = __builtin_amdgcn_exp2f(X[i]); } while (0)
#define PIN2(X, Y) asm volatile("" : "+v"(X), "+v"(Y))
#define H2(C0, C1, VOFF, DOPV, FIRST) do { \
    s16x4 l0, h0, l1, h1, l2, h2; float ma, mb, rm; \
    if (DOPV) { VRD(VOFF, 0, 0, l0, h0); VRD(VOFF, 0, 1, l1, h1); VRD(VOFF, 0, 2, l2, h2); } SBAR(); \
    if (DOPV) { MF(o[0], PAF(0), VF(l0, h0), o[0]); VRD(VOFF, 0, 3, l0, h0); } ma = MX3(C0[0], C0[1], C1[0]); mb = MX3(C0[2], C0[3], C1[1]); ma = MX3(ma, C1[2], C1[3]); mb = MX3(mb, C0[4], C0[5]); SBAR(); \
    if (DOPV) { MF(o[1], PAF(0), VF(l1, h1), o[1]); VRD(VOFF, 1, 0, l1, h1); } ma = MX3(ma, C0[6], C0[7]); mb = MX3(mb, C1[4], C1[5]); ma = MX3(ma, C1[6], C1[7]); mb = MX3(mb, C0[8], C0[9]); SBAR(); \
    if (DOPV) { MF(o[2], PAF(0), VF(l2, h2), o[2]); VRD(VOFF, 1, 1, l2, h2); } ma = MX3(ma, C0[10], C0[11]); mb = MX3(mb, C1[8], C1[9]); ma = MX3(ma, C1[10], C1[11]); mb = MX3(mb, C0[12], C0[13]); SBAR(); \
    if (DOPV) { MF(o[3], PAF(0), VF(l0, h0), o[3]); VRD(VOFF, 1, 2, l0, h0); } ma = MX3(ma, C0[14], C0[15]); mb = MX3(mb, C1[12], C1[13]); ma = MX3(ma, C1[14], C1[15]); rm = fmaxf(ma, mb); SBAR(); \
    if (DOPV) { MF(o[0], PAF(1), VF(l1, h1), o[0]); VRD(VOFF, 1, 3, l1, h1); } \
    { auto rr_ = __builtin_amdgcn_permlane32_swap(__float_as_uint(rm), __float_as_uint(rm), false, false); rm = fmaxf(__uint_as_float(rr_[0]), __uint_as_float(rr_[1])); } SBAR(); \
    resc = false; \
    if (FIRST || __builtin_expect(__any(rm > THRL), 0)) { const float dl = FIRST ? rm : fmaxf(rm, 0.f); mhat += dl; \
      _Pragma("unroll") for (int r = 0; r < 16; ++r) { C0[r] -= dl; C1[r] -= dl; } \
      _Pragma("unroll") for (int r = 0; r < 16; ++r) negm[r] = -mhat; \
      if (!(FIRST)) { const float f = __builtin_amdgcn_exp2f(-dl); l_reg *= f; if (hi == 0) al_l[r32] = f; resc = true; } } \
    SBAR(); \
    if (DOPV) { MF(o[1], PAF(1), VF(l2, h2), o[1]); VRD(VOFF, 2, 0, l2, h2); } EX(C0, 0); EX(C0, 1); EX(C0, 2); PIN2(C0, C1); SBAR(); \
    if (DOPV) { MF(o[2], PAF(1), VF(l0, h0), o[2]); VRD(VOFF, 2, 1, l0, h0); } EX(C0, 3); EX(C0, 4); EX(C0, 5); PIN2(C0, C1); SBAR(); \
    if (DOPV) { MF(o[3], PAF(1), VF(l1, h1), o[3]); VRD(VOFF, 2, 2, l1, h1); } EX(C0, 6); EX(C0, 7); EX(C0, 8); PIN2(C0, C1); SBAR(); \
    if (DOPV) { MF(o[0], PAF(2), VF(l2, h2), o[0]); VRD(VOFF, 2, 3, l2, h2); } EX(C0, 9); EX(C0, 10); EX(C0, 11); PIN2(C0, C1); SBAR(); \
    if (DOPV) { MF(o[1], PAF(2), VF(l0, h0), o[1]); VRD(VOFF, 3, 0, l0, h0); } EX(C0, 12); EX(C0, 13); EX(C0, 14); PIN2(C0, C1); SBAR(); \
    if (DOPV) { MF(o[2], PAF(2), VF(l1, h1), o[2]); VRD(VOFF, 3, 1, l1, h1); } EX(C0, 15); EX(C1, 0); EX(C1, 1); PIN2(C0, C1); SBAR(); \
    if (DOPV) { MF(o[3], PAF(2), VF(l2, h2), o[3]); VRD(VOFF, 3, 2, l2, h2); } EX(C1, 2); EX(C1, 3); EX(C1, 4); PIN2(C0, C1); SBAR(); \
    if (DOPV) { MF(o[0], PAF(3), VF(l0, h0), o[0]); VRD(VOFF, 3, 3, l0, h0); } EX(C1, 5); EX(C1, 6); EX(C1, 7); PIN2(C0, C1); SBAR(); \
    if (DOPV) { MF(o[1], PAF(3), VF(l1, h1), o[1]); } EX(C1, 8); EX(C1, 9); EX(C1, 10); PIN2(C0, C1); SBAR(); \
    if (DOPV) { MF(o[2], PAF(3), VF(l2, h2), o[2]); } EX(C1, 11); EX(C1, 12); EX(C1, 13); PIN2(C0, C1); SBAR(); \
    if (DOPV) { MF(o[3], PAF(3), VF(l0, h0), o[3]); } EX(C1, 14); EX(C1, 15); PIN2(C0, C1); SBAR(); \
    if (resc) { asm volatile("s_waitcnt lgkmcnt(0)" ::: "memory"); \
      _Pragma("unroll") for (int d = 0; d < 4; ++d) _Pragma("unroll") for (int r = 0; r < 16; ++r) o[d][r] *= al_l[crow(r, hi)]; } \
  } while (0)
#define PVONLY(VOFF) do { _Pragma("unroll") for (int ks = 0; ks < 4; ++ks) _Pragma("unroll") for (int d0 = 0; d0 < 4; ++d0) { s16x4 l_, h_; VRD(VOFF, ks, d0, l_, h_); \
      const bf16x8 pa_ = ks == 0 ? PAF(0) : ks == 1 ? PAF(1) : ks == 2 ? PAF(2) : PAF(3); MF(o[d0], pa_, VF(l_, h_), o[d0]); } } while (0)

  DMAK(0, 0); DMAK(1, 1); DMAV(0, 0);
  BARW(0);
  if (ATT_STAGGER && comp == 1) __builtin_amdgcn_s_barrier();
  H1(pA0, pA1, pB0, pB1, 0, false);
  BARW(0);
  DMAK(2, 2); DMAV(1, SHM_V); SBAR();
  H2(pA0, pA1, 0, false, true);
  BARW(4);
  int va = 0, vb = SHM_V, vc = 2 * SHM_V;
  for (int j = 1; j + 1 < NT; j += 2) {
    PRIO1(1); H1(pB0, pB1, pA0, pA1, vb, true); PRIO1(0);
    BARW(0);
    DMAK(j + 2, va >> 14); DMAV(j + 1, vc); SBAR();
    PRIO(1); H2(pB0, pB1, va, true, false); PRIO(0);
    BARW(4);
    PRIO1(1); H1(pA0, pA1, pB0, pB1, vc, true); PRIO1(0);
    BARW(0);
    if (j + 3 < NT) DMAK(j + 3, vb >> 14);
    DMAV(j + 2, va); SBAR();
    PRIO(1); H2(pA0, pA1, vb, true, false); PRIO(0);
    BARW(4);
    { const int t = va; va = vc; vc = vb; vb = t; }
  }
  H1(pB0, pB1, pA0, pA1, vb, true);
  BARW(0);
  H2(pB0, pB1, va, true, false);
  BARW(0);
  { float sacc = 0.f; unsigned a0_ = 0, a1_ = 0;
    PKA(pB0, 0, a0_, a1_); PKB(pB0, 0, a0_, a1_, pw0); PKA(pB0, 8, a0_, a1_); PKB(pB0, 8, a0_, a1_, pw1); PKA(pB1, 0, a0_, a1_); PKB(pB1, 0, a0_, a1_, pw2); PKA(pB1, 8, a0_, a1_); PKB(pB1, 8, a0_, a1_, pw3);
    auto rr_ = __builtin_amdgcn_permlane32_swap(__float_as_uint(sacc), __float_as_uint(sacc), false, false); l_reg += __uint_as_float(rr_[0]) + __uint_as_float(rr_[1]); }
  SBAR(); PVONLY(vb);
  if (ATT_STAGGER && comp == 0) { asm volatile("s_waitcnt lgkmcnt(0)" ::: "memory"); __builtin_amdgcn_s_barrier(); }
  if (hi == 0) li_l[r32] = l_reg; asm volatile("s_waitcnt lgkmcnt(0)" ::: "memory");
  float rli[16];
#pragma unroll
  for (int r = 0; r < 16; ++r) rli[r] = __builtin_amdgcn_rcpf(li_l[crow(r, hi)]);
  __syncthreads();
  float* XO = (float*)lds + qw * (32 * 128);
  if (comp == 1) {
#pragma unroll
    for (int r = 0; r < 16; ++r)
#pragma unroll
      for (int d0 = 0; d0 < 4; ++d0) XO[crow(r, hi) * 128 + d0 * 32 + r32] = o[d0][r] * rli[r];
  }
  __syncthreads();
  if (comp == 0) {
    float ss[16];
#pragma unroll
    for (int r = 0; r < 16; ++r) { float s = 0.f;
#pragma unroll
      for (int d0 = 0; d0 < 4; ++d0) { const float v = o[d0][r] * rli[r] - lam * XO[crow(r, hi) * 128 + d0 * 32 + r32]; o[d0][r] = v; s += v * v; }
      ss[r] = s; }
#pragma unroll
    for (int r = 0; r < 16; ++r) { float s = ss[r]; s += swz_xor<1>(s); s += swz_xor<2>(s); s += swz_xor<4>(s); s += swz_xor<8>(s); s += swz_xor<16>(s);
      ss[r] = osc / sqrtf(s * (1.0f / 128.0f) + EPS); }
    float gam[4];
#pragma unroll
    for (int d0 = 0; d0 < 4; ++d0) gam[d0] = sg[d0 * 32 + r32];
    asm volatile("s_waitcnt lgkmcnt(0)" ::: "memory");
    bf16_t* stg = (bf16_t*)XO;
#pragma unroll
    for (int r = 0; r < 16; ++r)
#pragma unroll
      for (int d0 = 0; d0 < 4; ++d0) stg[crow(r, hi) * 128 + d0 * 32 + r32] = (bf16_t)(cvt2bf(o[d0][r] * ss[r] * gam[d0], 0.f) & 0xffffu);
    asm volatile("s_waitcnt lgkmcnt(0)" ::: "memory");
#pragma unroll
    for (int i = 0; i < 8; ++i) { const int row = i * 4 + (lane >> 4), ch = lane & 15; const u32x4 v = *(const u32x4*)(stg + row * 128 + ch * 8);
      if constexpr (VAR & 16) { asm volatile("" :: "v"(v.x), "v"(v.y), "v"(v.z), "v"(v.w)); } else *(u32x4*)(Ob + (long)(qw * QBLK + row) * LDO + ch * 8) = v; }
  }
  __syncthreads();
#undef GLDS
#undef DMAK
#undef DMAV
#undef VMW
#undef PRIO
#undef PRIO1
#undef BARW
#undef KF
#undef PKA
#undef PKB
#undef H1
#undef VRD
#undef PAF
#undef MX3
#undef EX
#undef PIN2
#undef H2
#undef PVONLY
}
#undef SBAR
#undef KSWZ
#undef MF
#undef VF
}
typedef GAS unsigned gu32;
#define RLX_AGENT __ATOMIC_RELAXED, __HIP_MEMORY_SCOPE_AGENT
constexpr int PT_OFF = LDSCTL_OFF + 1024;
__device__ __forceinline__ unsigned long long ldptr(volatile LAS unsigned long long* PT, int i) {
    const unsigned long long v = PT[i];
    const unsigned lo = __builtin_amdgcn_readfirstlane((unsigned)v), hi = __builtin_amdgcn_readfirstlane((unsigned)(v >> 32));
    return ((unsigned long long)hi << 32) | lo;
}
#define XB_TMO      128
#define XB_XCNT(j)  (256  + 64 * (j))
#define XB_XSUB(j)  (1280 + 64 * (j))
#define XB_XGEN(j)  (2304 + 64 * (j))
#define XB_TOP      3328
#define XB_TOPGEN   3392
#define XCD_BAR_WORDS 3456
#define XB_SPIN_CAP (1u << 18)

__device__ __forceinline__ unsigned xb_ld(unsigned* p)              { return __hip_atomic_load(p, __ATOMIC_RELAXED, __HIP_MEMORY_SCOPE_AGENT); }
__device__ __forceinline__ unsigned xb_add(unsigned* p, unsigned v) { return __hip_atomic_fetch_add(p, v, __ATOMIC_RELAXED, __HIP_MEMORY_SCOPE_AGENT); }
__device__ __forceinline__ unsigned xb_xcc_id() { return (unsigned)__builtin_amdgcn_s_getreg((3 << 11) | 20) & 0xFu; }
#define XB_SPIN(cond, bar) do { unsigned _sp = 0; while (cond) { __builtin_amdgcn_s_sleep(1); \
    if ((++_sp & 255u) == 0u) { if (xb_ld(&(bar)[XB_TMO])) break; if (_sp > XB_SPIN_CAP) { atomicAdd(&(bar)[XB_TMO], 1u); break; } } } } while (0)

struct XcdBarrier {
    unsigned* bar; unsigned x;
    volatile LAS unsigned* st;
};

__device__ __forceinline__ XcdBarrier xcd_barrier_post(unsigned* bar, volatile LAS unsigned* st) {
    XcdBarrier b; b.bar = bar; b.x = xb_xcc_id(); b.st = st;
    if (threadIdx.x == 0) (void)xb_add(&bar[XB_XCNT(b.x)], 1u);
    return b;
}
__device__ __forceinline__ void xcd_barrier_complete(unsigned* bar, unsigned x, unsigned& nloc, unsigned& nx) {
    const unsigned G = gridDim.x * gridDim.y * gridDim.z;
    unsigned sum, cnt, mine, sp = 0u;
    for (;;) {
        sum = 0u; cnt = 0u; mine = 0u;
#pragma unroll
        for (unsigned j = 0; j < 16; ++j) { const unsigned c = xb_ld(&bar[XB_XCNT(j)]); sum += c; cnt += (c > 0u) ? 1u : 0u; mine = (j == x) ? c : mine; }
        if (sum == G) break;
        __builtin_amdgcn_s_sleep(1);
        if ((++sp & 255u) == 0u) { if (xb_ld(&bar[XB_TMO])) break; if (sp > XB_SPIN_CAP) { atomicAdd(&bar[XB_TMO], 1u); break; } }
    }
    nloc = mine > 0u ? mine : 1u; nx = cnt > 0u ? cnt : 1u;
}

__device__ __forceinline__ void xcd_barrier(const XcdBarrier& b) {
    asm volatile("s_waitcnt vmcnt(0)" ::: "memory");
    __syncthreads();
    if (threadIdx.x == 0) {
        unsigned* bar = b.bar;
        __builtin_amdgcn_s_waitcnt(0);
        unsigned nloc = b.st[0], nx = b.st[1];
        if (nloc == 0u) { xcd_barrier_complete(bar, b.x, nloc, nx); b.st[0] = nloc; b.st[1] = nx; }
        const unsigned old = xb_add(&bar[XB_XSUB(b.x)], 1u);
        const unsigned gen = old / nloc;
        if (old + 1u == (gen + 1u) * nloc) {
            __builtin_amdgcn_fence(__ATOMIC_RELEASE, "agent");
            asm volatile("s_waitcnt vmcnt(0)" ::: "memory");
            const unsigned og = xb_add(&bar[XB_TOP], 1u);
            const unsigned tg = og / nx;
            if (og + 1u == (tg + 1u) * nx) xb_add(&bar[XB_TOPGEN], 1u);
            else XB_SPIN(xb_ld(&bar[XB_TOPGEN]) == tg, bar);
            __builtin_amdgcn_fence(__ATOMIC_ACQUIRE, "agent");
            xb_add(&bar[XB_XGEN(b.x)], 1u);
            asm volatile("s_waitcnt vmcnt(0)" ::: "memory");
        } else {
            XB_SPIN(xb_ld(&bar[XB_XGEN(b.x)]) == gen, bar);
            __builtin_amdgcn_fence(__ATOMIC_ACQUIRE, "agent");
            asm volatile("s_waitcnt vmcnt(0)" ::: "memory");
        }
    }
    __syncthreads();
}
__device__ __forceinline__ float wave_sum(float v) {
    v += swz_xor<1>(v); v += swz_xor<2>(v); v += swz_xor<4>(v); v += swz_xor<8>(v); v += swz_xor<16>(v);
    auto rr = __builtin_amdgcn_permlane32_swap(__float_as_uint(v), __float_as_uint(v), false, false);
    return __uint_as_float(rr[0]) + __uint_as_float(rr[1]);
}
__device__ __forceinline__ unsigned pk2(float lo, float hi) { return cvt2bf(lo, hi); }

template <int MAP  >
__device__ __forceinline__ void transpose_item(const float* W, int Nsrc, int coff, bf16_t* WT, int ldw, int koff, int nblk, LAS float* scr, int item, int lane) {
    const int kb = item / nblk, nb = item % nblk, k0 = 64 * kb, n0 = 32 * nb;
    const int nd = n0 + (lane & 31); const int scol = MAP ? in_map(nd) : nd + coff;
    float wv[32];
#pragma unroll
    for (int i = 0; i < 32; ++i) wv[i] = W[(size_t)(k0 + 2 * i + (lane >> 5)) * Nsrc + scol];
#pragma unroll
    for (int i = 0; i < 32; ++i) scr[(2 * i + (lane >> 5)) * 33 + (lane & 31)] = wv[i];
    asm volatile("s_waitcnt lgkmcnt(0)" ::: "memory");
    const int c = lane & 7;
#pragma unroll
    for (int j = 0; j < 4; ++j) { const int n = (lane >> 3) + 8 * j; const LAS float* s = scr + (8 * c) * 33 + n;
        u32x4 o; o.x = pk2(s[0 * 33], s[1 * 33]); o.y = pk2(s[2 * 33], s[3 * 33]); o.z = pk2(s[4 * 33], s[5 * 33]); o.w = pk2(s[6 * 33], s[7 * 33]);
        *(u32x4*)(WT + (size_t)(n0 + n) * ldw + koff + k0 + 8 * c) = o; }
    asm volatile("s_waitcnt lgkmcnt(0)" ::: "memory");
}
struct WSrc { const float *w_in, *wo_f, *wo_a, *wo_c, *wo_p, *w_out, *w_up, *w_down; };
constexpr int IT_A = 16 * 208;
constexpr int IT_B0 = 4 * 32, IT_B1 = 8 * 32, IT_B2 = 4 * 32, IT_B3 = 4 * 32, IT_B4 = 16 * 32, IT_B5 = 16 * 88, IT_B6 = 16 * 88, IT_B7 = 44 * 32;
constexpr int IT_B = IT_B0 + IT_B1 + IT_B2 + IT_B3 + IT_B4 + IT_B5 + IT_B6 + IT_B7;
__device__ __forceinline__ void convert_A(const WSrc& S, unsigned char* ws, LAS float* scr, int gw, int NGW, int lane) {
    for (int it = gw; it < IT_A; it += NGW) transpose_item<1>(S.w_in, NIN, 0, (bf16_t*)(ws + WS_WA), 1024, 0, 208, scr, it, lane);
}
__device__ __forceinline__ void convert_B(const WSrc& S, unsigned char* ws, LAS float* scr, int gw, int NGW, int lane) {
    for (int it = gw; it < IT_B; it += NGW) { int r = it;
        if (r < IT_B0) { transpose_item<0>(S.wo_f, 1024, 0, (bf16_t*)(ws + WS_WCAT), KCAT, 0, 32, scr, r, lane); continue; } r -= IT_B0;
        if (r < IT_B1) { transpose_item<0>(S.wo_a, 1024, 0, (bf16_t*)(ws + WS_WCAT), KCAT, 256, 32, scr, r, lane); continue; } r -= IT_B1;
        if (r < IT_B2) { transpose_item<0>(S.wo_c, 1024, 0, (bf16_t*)(ws + WS_WCAT), KCAT, 768, 32, scr, r, lane); continue; } r -= IT_B2;
        if (r < IT_B3) { transpose_item<0>(S.wo_p, 1024, 0, (bf16_t*)(ws + WS_WCAT), KCAT, 1024, 32, scr, r, lane); continue; } r -= IT_B3;
        if (r < IT_B4) { transpose_item<0>(S.w_out, 1024, 0, (bf16_t*)(ws + WS_WOUT), 1024, 0, 32, scr, r, lane); continue; } r -= IT_B4;
        if (r < IT_B5) { transpose_item<0>(S.w_up, 2 * DFF, DFF, (bf16_t*)(ws + WS_WUPG), 1024, 0, 88, scr, r, lane); continue; } r -= IT_B5;
        if (r < IT_B6) { transpose_item<0>(S.w_up, 2 * DFF, 0, (bf16_t*)(ws + WS_WUPV), 1024, 0, 88, scr, r, lane); continue; } r -= IT_B6;
        transpose_item<0>(S.w_down, 1024, 0, (bf16_t*)(ws + WS_WDN), DFF, 0, 32, scr, r, lane);
    }
}

__device__ __forceinline__ void mod_phase(const float* c, const float* c_ctx, const float* ada_w, const float* ada_b, float* MOD, LAS unsigned char* lds, int vcu, int G, int tid, int wave, int lane) {
    LAS float* sil = (LAS float*)lds;
    LAS float* red = (LAS float*)(lds + 12288);
    for (int i = tid; i < 3072; i += 512) { const float v = i < 2048 ? c[i] : c_ctx[i - 2048]; sil[i] = v * sigm(v); }
    __syncthreads();
    for (int item = vcu; item < 192; item += G) {
        const int l = item / 96, n = (item % 96) * 64 + lane;
        const float* W = ada_w + (size_t)l * 1024 * 6144 + n;
        float a0 = 0.f, a1 = 0.f, a2 = 0.f;
        for (int k = wave * 128; k < wave * 128 + 128; k += 8) { float w[8];
#pragma unroll
            for (int i = 0; i < 8; ++i) w[i] = W[(size_t)(k + i) * 6144];
#pragma unroll
            for (int i = 0; i < 8; ++i) { a0 += sil[k + i] * w[i]; a1 += sil[1024 + k + i] * w[i]; a2 += sil[2048 + k + i] * w[i]; } }
        red[(wave * 3 + 0) * 64 + lane] = a0; red[(wave * 3 + 1) * 64 + lane] = a1; red[(wave * 3 + 2) * 64 + lane] = a2;
        __syncthreads();
        if (wave < 3) { float s = ada_b[l * 6144 + n];
#pragma unroll
            for (int w = 0; w < 8; ++w) s += red[(w * 3 + wave) * 64 + lane];
            MOD[(size_t)(l * 3 + wave) * 6144 + n] = s; }
        __syncthreads();
    }
}
__device__ __forceinline__ void tables_phase(float* ROPE, f32x2* TW, int gt, int NGT) {
    for (int i = gt; i < 192 * 16; i += NGT) { const int pos = i >> 4, f = i & 15; const float inv = powf(10000.0f, -(float)f / 16.0f); const float ang = (float)(pos < 128 ? pos : pos - 128) * inv;
        float s, c; sincosf(ang, &s, &c); ROPE[pos * 32 + f] = c; ROPE[pos * 32 + 16 + f] = s; }
    for (int i = gt; i < 8192; i += NGT) { float s, c; sincospif((float)i * (1.0f / 4096.0f), &s, &c); TW[i] = (f32x2){c, -s}; }
}

template <bool LATBF>
__device__ __forceinline__ void norm_phase(const void* src_lat_, const float* src_ctx, int nrows, const float* gamma, const float* mod, int shoff, int scoff, bf16_t* HX, int gw, int NGW, int lane,
                                           const float* slab = nullptr, int nsl = 0, const float* cgate = nullptr, float* ctx_out = nullptr) {
    for (int m0 = gw; m0 < nrows; m0 += 4 * NGW) {
        f32x4 v[4][4]; float s[4];
#pragma unroll
        for (int u = 0; u < 4; ++u) { const int m = m0 + u * NGW; s[u] = 0.f;
            if (m < nrows) {
                if (LATBF && m < ML) { const u32x2* xb = (const u32x2*)((const bf16_t*)src_lat_ + (size_t)m * DM);
#pragma unroll
                    for (int j = 0; j < 4; ++j) { const u32x2 w = xb[lane + 64 * j]; v[u][j] = (f32x4){__uint_as_float(w.x << 16), __uint_as_float(w.x & 0xffff0000u), __uint_as_float(w.y << 16), __uint_as_float(w.y & 0xffff0000u)}; } }
                else { const float* xr = m < ML ? (const float*)src_lat_ + (size_t)m * DM : src_ctx + (size_t)(m - ML) * DM;
#pragma unroll
                    for (int j = 0; j < 4; ++j) v[u][j] = ((const f32x4*)xr)[lane + 64 * j]; }
                if (slab && m >= ML) {
#pragma unroll
                    for (int j = 0; j < 4; ++j) { f32x4 a = {0.f, 0.f, 0.f, 0.f};
                        for (int sl = 0; sl < nsl; ++sl) a += ((const f32x4*)(slab + (size_t)sl * 512 * 1024 + (size_t)(m - ML) * DM))[lane + 64 * j];
                        v[u][j] += ((const f32x4*)cgate)[lane + 64 * j] * a; ((f32x4*)(ctx_out + (size_t)(m - ML) * DM))[lane + 64 * j] = v[u][j]; } } } }
#pragma unroll
        for (int u = 0; u < 4; ++u) { const int m = m0 + u * NGW; if (m < nrows) {
#pragma unroll
            for (int j = 0; j < 4; ++j) s[u] += (v[u][j].x * v[u][j].x + v[u][j].y * v[u][j].y) + (v[u][j].z * v[u][j].z + v[u][j].w * v[u][j].w);
            const float rstd = 1.0f / sqrtf(wave_sum(s[u]) * (1.0f / DM) + EPS);
            const float* md = mod + (m < SEQ ? 0 : m < ML ? 1 : 2) * 6144;
#pragma unroll
            for (int j = 0; j < 4; ++j) { const int col = 4 * lane + 256 * j;
                const f32x4 g = *(const f32x4*)(gamma + col), sc = *(const f32x4*)(md + scoff + col), sh = *(const f32x4*)(md + shoff + col);
                const f32x4 o = v[u][j] * rstd * g * (sc + 1.0f) + sh;
                u32x2 w; w.x = pk2(o.x, o.y); w.y = pk2(o.z, o.w); *(u32x2*)(HX + (size_t)m * DM + col) = w; } } }
    }
}
__device__ __forceinline__ void final_norm_phase(const bf16_t* xb, float* out, const float* gamma, int gw, int NGW, int lane) {
    for (int m0 = gw; m0 < ML; m0 += 4 * NGW) {
        f32x4 v[4][4];
#pragma unroll
        for (int u = 0; u < 4; ++u) { const int m = m0 + u * NGW; if (m < ML) { const u32x2* xr = (const u32x2*)(xb + (size_t)m * DM);
#pragma unroll
            for (int j = 0; j < 4; ++j) { const u32x2 w = xr[lane + 64 * j]; v[u][j] = (f32x4){__uint_as_float(w.x << 16), __uint_as_float(w.x & 0xffff0000u), __uint_as_float(w.y << 16), __uint_as_float(w.y & 0xffff0000u)}; } } }
#pragma unroll
        for (int u = 0; u < 4; ++u) { const int m = m0 + u * NGW; if (m < ML) { float s = 0.f;
#pragma unroll
            for (int j = 0; j < 4; ++j) s += (v[u][j].x * v[u][j].x + v[u][j].y * v[u][j].y) + (v[u][j].z * v[u][j].z + v[u][j].w * v[u][j].w);
            const float rstd = 1.0f / sqrtf(wave_sum(s) * (1.0f / DM) + EPS);
#pragma unroll
            for (int j = 0; j < 4; ++j) { const f32x4 g = *(const f32x4*)(gamma + 4 * lane + 256 * j); ((f32x4*)(out + (size_t)m * DM))[lane + 64 * j] = v[u][j] * rstd * g; } } }
    }
}

#define SWZ(row, colB) ((row) * 256 + ((colB) ^ (((row) & 7) << 4)))
__device__ __forceinline__ int crow_(int r, int hi) { return (r & 3) + 8 * (r >> 2) + 4 * hi; }
__device__ __forceinline__ bf16x8 pack_bf8(const float* v) { u32x4 w; w.x = pk2(v[0], v[1]); w.y = pk2(v[2], v[3]); w.z = pk2(v[4], v[5]); w.w = pk2(v[6], v[7]); return __builtin_bit_cast(bf16x8, w); }
__device__ __forceinline__ void fft1_phase(const bf16_t* UF, const f32x2* TW, unsigned* FA, LAS unsigned char* lds, int vcu, int G, int tid, int wave, int lane) {
    const int tr = wave >> 1, tc = wave & 1, r32 = lane & 31, hi = lane >> 5;
    bf16x8 aRe[8], aIm[8];
#pragma unroll
    for (int ks = 0; ks < 8; ++ks) { float cv[8], sv[8];
#pragma unroll
        for (int j = 0; j < 8; ++j) { const int idx = ((32 * tr + r32) * (16 * ks + 8 * hi + j)) & 127; float s, c; sincospif((float)idx * (1.0f / 64.0f), &s, &c); cv[j] = c; sv[j] = -s; }
        aRe[ks] = pack_bf8(cv); aIm[ks] = pack_bf8(sv); }
    for (int item = vcu; item < 512; item += G) {
        const int b = item >> 8, g = (item >> 6) & 3, l2 = item & 63;
#pragma unroll
        for (int i = 0; i < 2; ++i) { const int q = tid + 512 * i, l1 = q >> 3, c8 = (q & 7) * 8;
            const u32x4 v = *(const u32x4*)(UF + (size_t)(b * SEQ + 64 * l1 + l2) * 256 + g * 64 + c8);
#pragma unroll
            for (int e = 0; e < 8; ++e) { const unsigned w = v[e >> 1]; *(LAS bf16_t*)(lds + SWZ(c8 + e, l1 * 2)) = (bf16_t)((e & 1) ? (w >> 16) : (w & 0xffffu)); } }
        __syncthreads();
        f32x16 re = {}, im = {};
#pragma unroll
        for (int ks = 0; ks < 8; ++ks) { const bf16x8 bx = *(const LAS bf16x8*)(lds + SWZ(32 * tc + r32, (16 * ks + 8 * hi) * 2));
            re = __builtin_amdgcn_mfma_f32_32x32x16_bf16(aRe[ks], bx, re, 0, 0, 0); im = __builtin_amdgcn_mfma_f32_32x32x16_bf16(aIm[ks], bx, im, 0, 0, 0); }
        unsigned* dst = FA + ((size_t)((b * 4 + g) * 64 + l2) * 128) * 64 + 32 * tc + r32;
#pragma unroll
        for (int r = 0; r < 16; ++r) { const int k1 = 32 * tr + crow_(r, hi); const f32x2 t = TW[k1 * l2];
            dst[(size_t)k1 * 64] = pk2(re[r] * t.x - im[r] * t.y, re[r] * t.y + im[r] * t.x); }
        __syncthreads();
    }
}
__device__ __forceinline__ void fft2_phase(const unsigned* FA, bf16_t* ACAT, LAS unsigned char* lds, int vcu, int G, int tid, int wave, int lane) {
    const int tr = wave >> 1, tc = wave & 1, r32 = lane & 31, hi = lane >> 5;
    bf16x8 a2[8], b3[8];
#pragma unroll
    for (int ks = 0; ks < 8; ++ks) { float av[8], bv[8];
#pragma unroll
        for (int j = 0; j < 8; ++j) { const int R = 32 * tr + r32, k = 16 * ks + 8 * hi + j, k2 = R & 63, ll = k & 63; float s, c; sincospif((float)((k2 * ll) & 63) * (1.0f / 32.0f), &s, &c);
            av[j] = (R < 64) ? ((k < 64) ? c : s) : ((k < 64) ? -s : c);
            const int m = 32 * tc + r32; float s2, c2; sincospif((float)((m * ll) & 63) * (1.0f / 32.0f), &s2, &c2); bv[j] = (k < 64) ? c2 : s2; }
        a2[ks] = pack_bf8(av); b3[ks] = pack_bf8(bv); }
    LAS unsigned char* Bt = lds;
    LAS unsigned char* Zt = lds + 16384;
    for (int item = vcu; item < 1024; item += G) {
        const int b = item >> 9, g = (item >> 7) & 3, k1 = item & 127;
#pragma unroll
        for (int i = 0; i < 2; ++i) { const int q = tid + 512 * i, l2 = q >> 4, c4 = (q & 15) * 4;
            const u32x4 v = *(const u32x4*)(FA + ((size_t)((b * 4 + g) * 64 + l2) * 128 + k1) * 64 + c4);
#pragma unroll
            for (int e = 0; e < 4; ++e) { *(LAS bf16_t*)(Bt + SWZ(c4 + e, l2 * 2)) = (bf16_t)(v[e] & 0xffffu); *(LAS bf16_t*)(Bt + SWZ(c4 + e, (64 + l2) * 2)) = (bf16_t)(v[e] >> 16); } }
        __syncthreads();
        f32x16 z = {};
#pragma unroll
        for (int ks = 0; ks < 8; ++ks) { const bf16x8 bx = *(const LAS bf16x8*)(Bt + SWZ(32 * tc + r32, (16 * ks + 8 * hi) * 2)); z = __builtin_amdgcn_mfma_f32_32x32x16_bf16(a2[ks], bx, z, 0, 0, 0); }
#pragma unroll
        for (int r = 0; r < 16; ++r) { const int R = 32 * tr + crow_(r, hi); *(LAS bf16_t*)(Zt + SWZ(R & 63, ((R >> 6) * 64 + 32 * tc + r32) * 2)) = (bf16_t)(pk2(z[r], 0.f) & 0xffffu); }
        __syncthreads();
        if (wave < 4) { f32x16 y = {};
#pragma unroll
            for (int ks = 0; ks < 8; ++ks) { const bf16x8 ax = *(const LAS bf16x8*)(Zt + SWZ(32 * tr + r32, (16 * ks + 8 * hi) * 2)); y = __builtin_amdgcn_mfma_f32_32x32x16_bf16(ax, b3[ks], y, 0, 0, 0); }
#pragma unroll
            for (int r = 0; r < 16; ++r) { const int k2 = 32 * tr + crow_(r, hi); ACAT[(size_t)(b * SEQ + k1 + 128 * k2) * KCAT + g * 64 + 32 * tc + r32] = (bf16_t)(pk2(y[r] * 0.001381067932f, 0.f) & 0xffffu); } }
        __syncthreads();
    }
}
__device__ __forceinline__ void ctxdft_item(int item, const bf16_t* UF, bf16_t* ACAT, LAS unsigned char* lds, int tid, int wave, int lane) {
    const int b = item >> 4, g = (item >> 2) & 3, kc = item & 3;
    const int tr = wave >> 1, tc = wave & 1, r32 = lane & 31, hi = lane >> 5;
    LAS unsigned char* Xt = lds;
    LAS unsigned char* Zt = lds + 32768;
#pragma unroll
    for (int i = 0; i < 4; ++i) { const int q = tid + 512 * i, l = q >> 3, c8 = (q & 7) * 8;
        const u32x4 v = *(const u32x4*)(UF + (size_t)(ML + b * CTXL + l) * 256 + g * 64 + c8);
#pragma unroll
        for (int e = 0; e < 8; ++e) { const unsigned w = v[e >> 1]; const int row = c8 + e; *(LAS bf16_t*)(Xt + row * 512 + ((((l >> 3) ^ (row & 7)) << 4) | ((l & 7) * 2))) = (bf16_t)((e & 1) ? (w >> 16) : (w & 0xffffu)); } }
    __syncthreads();
    f32x16 z = {};
    const int R = 32 * tr + r32, kk = 64 * kc + (R & 63);
#pragma unroll 4
    for (int ks = 0; ks < 16; ++ks) { float av[8];
#pragma unroll
        for (int j = 0; j < 8; ++j) { const int l = 16 * ks + 8 * hi + j; float s, c; sincospif((float)((kk * l) & 255) * (1.0f / 128.0f), &s, &c); av[j] = (R < 64) ? c : -s; }
        const int row = 32 * tc + r32, ch = (16 * ks + 8 * hi) >> 3;
        const bf16x8 bx = *(const LAS bf16x8*)(Xt + row * 512 + ((ch ^ (row & 7)) << 4));
        z = __builtin_amdgcn_mfma_f32_32x32x16_bf16(pack_bf8(av), bx, z, 0, 0, 0); }
#pragma unroll
    for (int r = 0; r < 16; ++r) { const int Rr = 32 * tr + crow_(r, hi); *(LAS bf16_t*)(Zt + SWZ(Rr & 63, ((Rr >> 6) * 64 + 32 * tc + r32) * 2)) = (bf16_t)(pk2(z[r], 0.f) & 0xffffu); }
    __syncthreads();
    if (wave < 4) { f32x16 y = {};
#pragma unroll
        for (int ks = 0; ks < 8; ++ks) { float bv[8];
#pragma unroll
            for (int j = 0; j < 8; ++j) { const int k = 16 * ks + 8 * hi + j, m = 32 * tc + r32; float s2, c2; sincospif((float)((m * (k & 63)) & 63) * (1.0f / 32.0f), &s2, &c2); bv[j] = (k < 64) ? c2 : s2; }
            const bf16x8 ax = *(const LAS bf16x8*)(Zt + SWZ(32 * tr + r32, (16 * ks + 8 * hi) * 2)); y = __builtin_amdgcn_mfma_f32_32x32x16_bf16(ax, pack_bf8(bv), y, 0, 0, 0); }
#pragma unroll
        for (int r = 0; r < 16; ++r) { const int k = 64 * kc + 32 * tr + crow_(r, hi); ACAT[(size_t)(ML + b * CTXL + k) * KCAT + g * 64 + 32 * tc + r32] = (bf16_t)(pk2(y[r] * (1.0f / 128.0f), 0.f) & 0xffffu); } }
    __syncthreads();
}

__device__ __forceinline__ void conv_item(int item, const bf16_t* ZG, const float* cw  , const float* cb, const float* lng, const float* lnb, bf16_t* ACAT, LAS unsigned char* lds, int tid, int wave, int lane) {
    const int row0 = item * 64; const bool lat = row0 < ML; const int s0 = lat ? (row0 & ~(SEQ - 1)) : (ML + ((row0 - ML) & ~(CTXL - 1))), s1 = s0 + (lat ? SEQ : CTXL);
    LAS float* zt = (LAS float*)lds;
#pragma unroll
    for (int i = 0; i < 6; ++i) { const int q = tid + 512 * i; if (q < 94 * 32) { const int rr = q >> 5, c8 = (q & 31) * 8, gr = row0 - 15 + rr;
        u32x4 v = {0u, 0u, 0u, 0u}; if (gr >= s0 && gr < s1) v = *(const u32x4*)(ZG + (size_t)gr * 256 + c8);
        *(LAS f32x4*)(zt + rr * 256 + c8) = (f32x4){bf2f(v.x & 0xffffu), __uint_as_float(v.x & 0xffff0000u), bf2f(v.y & 0xffffu), __uint_as_float(v.y & 0xffff0000u)};
        *(LAS f32x4*)(zt + rr * 256 + c8 + 4) = (f32x4){bf2f(v.z & 0xffffu), __uint_as_float(v.z & 0xffff0000u), bf2f(v.w & 0xffffu), __uint_as_float(v.w & 0xffff0000u)}; } }
    const int c = tid & 255, half = tid >> 8;
    float w[31];
#pragma unroll
    for (int t = 0; t < 31; ++t) w[t] = cw[t * 256 + c];
    float acc[32]; const float bias = cb[c];
    __syncthreads();
#pragma unroll
    for (int r0 = 0; r0 < 32; r0 += 4) { float v[34];
#pragma unroll
        for (int i = 0; i < 34; ++i) v[i] = zt[(half * 32 + r0 + i) * 256 + c];
        float a0 = bias, a1 = bias, a2 = bias, a3 = bias;
#pragma unroll
        for (int t = 0; t < 31; ++t) { a0 += w[t] * v[t]; a1 += w[t] * v[t + 1]; a2 += w[t] * v[t + 2]; a3 += w[t] * v[t + 3]; }
        acc[r0] = a0; acc[r0 + 1] = a1; acc[r0 + 2] = a2; acc[r0 + 3] = a3; }
    __syncthreads();
#pragma unroll
    for (int r = 0; r < 32; ++r) zt[(half * 32 + r) * 256 + c] = acc[r];
    __syncthreads();
    const f32x4 gg = *(const f32x4*)(lng + 4 * lane), bb = *(const f32x4*)(lnb + 4 * lane);
#pragma unroll
    for (int i = 0; i < 8; ++i) { const int r = wave * 8 + i; const f32x4 v = *(const LAS f32x4*)(zt + r * 256 + 4 * lane);
        const float mu = wave_sum((v.x + v.y) + (v.z + v.w)) * (1.0f / 256.0f); const f32x4 d = v - mu;
        const float var = wave_sum((d.x * d.x + d.y * d.y) + (d.z * d.z + d.w * d.w)) * (1.0f / 256.0f); const float rs = 1.0f / sqrtf(var + EPS);
        f32x4 o = d * rs * gg + bb; o.x *= sigm(o.x); o.y *= sigm(o.y); o.z *= sigm(o.z); o.w *= sigm(o.w);
        u32x2 pw; pw.x = pk2(o.x, o.y); pw.y = pk2(o.z, o.w); *(u32x2*)(ACAT + (size_t)(row0 + r) * KCAT + 768 + 4 * lane) = pw; }
    __syncthreads();
}
__device__ __forceinline__ void pool_phase(const bf16_t* UP, const float* pw  , const float* psc, bf16_t* ACAT, int nitems, int first, LAS unsigned char* lds, int G, int tid, int wave, int lane) {
    const int g = wave >> 1, tc = wave & 1, r32 = lane & 31, hi = lane >> 5;
    bf16x8 bw[4];
#pragma unroll
    for (int ks = 0; ks < 4; ++ks) { float v[8];
#pragma unroll
        for (int j = 0; j < 8; ++j) v[j] = pw[g * 4096 + (16 * ks + 8 * hi + j) * 64 + 32 * tc + r32];
        bw[ks] = pack_bf8(v); }
    const float osc = psc[g * 64 + 32 * tc + r32];
    LAS float* ut = (LAS float*)lds;
    LAS unsigned char* dt = lds + 81920;
    for (int item = first; item < nitems; item += G) {
        const int row0 = item * 64; const bool lat = row0 < ML; const int s0 = lat ? (row0 & ~(SEQ - 1)) : (ML + ((row0 - ML) & ~(CTXL - 1))), L = lat ? SEQ : CTXL, s1 = s0 + L;
#pragma unroll
        for (int i = 0; i < 5; ++i) { const int q = tid + 512 * i, rr = q >> 5, c8 = (q & 31) * 8, gr = row0 - 8 + rr;
            u32x4 v = {0u, 0u, 0u, 0u}; if (gr >= s0 && gr < s1) v = *(const u32x4*)(UP + (size_t)gr * 256 + c8);
            *(LAS f32x4*)(ut + rr * 256 + c8) = (f32x4){bf2f(v.x & 0xffffu), __uint_as_float(v.x & 0xffff0000u), bf2f(v.y & 0xffffu), __uint_as_float(v.y & 0xffff0000u)};
            *(LAS f32x4*)(ut + rr * 256 + c8 + 4) = (f32x4){bf2f(v.z & 0xffffu), __uint_as_float(v.z & 0xffff0000u), bf2f(v.w & 0xffffu), __uint_as_float(v.w & 0xffff0000u)}; }
        __syncthreads();
#pragma unroll
        for (int i = 0; i < 4; ++i) { const int q = tid + 512 * i, lr = q >> 5, c8 = (q & 31) * 8, gg = c8 >> 6, hw = 1 << gg, tt = row0 + lr - s0;
            f32x4 sa = {0.f, 0.f, 0.f, 0.f}, sb = {0.f, 0.f, 0.f, 0.f};
            for (int o = -hw; o < hw; ++o) { sa += *(const LAS f32x4*)(ut + (lr + 8 + o) * 256 + c8); sb += *(const LAS f32x4*)(ut + (lr + 8 + o) * 256 + c8 + 4); }
            const int lo = tt - hw < 0 ? 0 : tt - hw, hh = tt + hw - 1 > L - 1 ? L - 1 : tt + hw - 1; const float inv = 1.0f / (float)(hh - lo + 1);
            const f32x4 ua = *(const LAS f32x4*)(ut + (lr + 8) * 256 + c8), ub = *(const LAS f32x4*)(ut + (lr + 8) * 256 + c8 + 4);
            const f32x4 da = sa * inv - ua, db = sb * inv - ub;
            u32x4 w; w.x = pk2(da.x, da.y); w.y = pk2(da.z, da.w); w.z = pk2(db.x, db.y); w.w = pk2(db.z, db.w);
            *(LAS u32x4*)(dt + lr * 512 + ((((c8 >> 3) ^ (lr & 7)) << 4))) = w; }
        __syncthreads();
#pragma unroll
        for (int rt = 0; rt < 2; ++rt) { f32x16 y = {};
#pragma unroll
            for (int ks = 0; ks < 4; ++ks) { const int row = 32 * rt + r32, ch = (g * 64 + 16 * ks + 8 * hi) >> 3;
                const bf16x8 ax = *(const LAS bf16x8*)(dt + row * 512 + ((ch ^ (row & 7)) << 4)); y = __builtin_amdgcn_mfma_f32_32x32x16_bf16(ax, bw[ks], y, 0, 0, 0); }
#pragma unroll
            for (int r = 0; r < 16; ++r) ACAT[(size_t)(row0 + 32 * rt + crow_(r, hi)) * KCAT + 1024 + g * 64 + 32 * tc + r32] = (bf16_t)(pk2(y[r] * osc, 0.f) & 0xffffu); }
        __syncthreads();
    }
}

__device__ __forceinline__ void ctx_gate_combine(const float* slab, const unsigned char* Gc  , bf16_t* Yc, int gw, int NGW, int lane) {
    for (int r = gw; r < MC; r += NGW) {
#pragma unroll
        for (int j = 0; j < 4; ++j) { const int col = 4 * lane + 256 * j; f32x4 y = {0.f, 0.f, 0.f, 0.f};
#pragma unroll
            for (int sl = 0; sl < 5; ++sl) { const int b = sl == 0 ? 0 : sl <= 2 ? 1 : sl - 1;
                const f32x4 p = *(const f32x4*)(slab + (size_t)sl * 512 * 1024 + (size_t)r * 1024 + col); const unsigned q = *(const unsigned*)(Gc + (size_t)r * 4096 + b * 1024 + col);
                y[0] += p[0] * (float)(q & 255u); y[1] += p[1] * (float)((q >> 8) & 255u); y[2] += p[2] * (float)((q >> 16) & 255u); y[3] += p[3] * (float)(q >> 24); }
            y = y * (1.0f / 255.0f);
            u32x2 w; w.x = pk2(y[0], y[1]); w.y = pk2(y[2], y[3]); *(u32x2*)(Yc + (size_t)r * 1024 + col) = w; }
    }
}
constexpr int NPHASE = 22;
struct Args { const float* in[30]; float* out; unsigned char* ws; int ph_lo, ph_hi, li, pad; };
__global__ void __launch_bounds__(512, 2) __attribute__((amdgpu_waves_per_eu(2, 2))) fwd_kernel(Args args) {
    extern __shared__ __attribute__((aligned(16))) unsigned char lds[];
    LAS unsigned char* L = (LAS unsigned char*)lds;
    volatile LAS unsigned* MISC = (volatile LAS unsigned*)(L + MISC_OFF);
    const int tid0 = threadIdx.x; const int wave0 = __builtin_amdgcn_readfirstlane(tid0 >> 6);
    const int G = gridDim.x, bx0 = blockIdx.x, vcu0 = (G % 8 == 0) ? (bx0 % 8) * (G / 8) + bx0 / 8 : bx0;
    const int NGW = G * 8;
    gu32* ctl = (gu32*)(args.ws + WS_CTL);
    for (int u = tid0; u < (LDS_BYTES - LDSCTL_OFF) / 4; u += 512) ((LAS unsigned*)(L + LDSCTL_OFF))[u] = 0u;
    __syncthreads();
    volatile LAS unsigned long long* PT = (volatile LAS unsigned long long*)(L + PT_OFF);
    if (tid0 < 32) PT[tid0] = ((const __attribute__((address_space(4))) unsigned long long*)__builtin_amdgcn_kernarg_segment_ptr())[tid0];
    __syncthreads();
#define FRESH() int tid, vcu = vcu0, bx = bx0; asm volatile("v_mbcnt_lo_u32_b32 %0, -1, 0\n\tv_mbcnt_hi_u32_b32 %0, -1, %0" : "=v"(tid)); tid += wave0 * 64; asm volatile("" : "+v"(tid), "+s"(vcu), "+s"(bx)); const int lane = tid & 63, wave = __builtin_amdgcn_readfirstlane(tid >> 6), gw = vcu * 8 + wave; (void)lane; (void)gw; (void)bx; \
    LAS float* scr = (LAS float*)(L + wave * 16384); (void)scr;
#define PTR(i) ((const float*)(const GAS float*)ldptr(PT, (i)))
#define OUTP ((float*)(GAS float*)ldptr(PT, 30))
#define WSP ((unsigned char*)(GAS unsigned char*)ldptr(PT, 31))
    XcdBarrier bar; bar.bar = (unsigned*)(ctl + CW_BAR) + args.li * XCD_BAR_WORDS; bar.x = 0; bar.st = nullptr;
    if (MK_N_LAUNCHES != NPHASE) bar = xcd_barrier_post((unsigned*)(ctl + CW_BAR) + args.li * XCD_BAR_WORDS, MISC + 8);
#define GRID_BAR() do { if (MK_N_LAUNCHES == NPHASE) { if (tid0 == 0) __hip_atomic_store(ctl + CW_TMO, 0xBADBA0u, RLX_AGENT); } else { xcd_barrier(bar); } } while (0)
    const int lo = args.ph_lo, hi = args.ph_hi;
#ifndef PHASE_MASK
#define PHASE_MASK 0xFFF
#endif
#ifndef ATTM
#define ATTM 3
#endif
#ifndef X1REP
#define X1REP 0
#endif
#ifndef X1M
#define X1M 31
#endif
#define PH_EN(kind) ((PHASE_MASK >> (kind)) & 1)
#ifndef REP_MASK
#define REP_MASK 0
#endif
#define NREP(kind) (((REP_MASK >> (kind)) & 1) ? 2 : 1)
#define IN(k) (lo <= (k) && (k) < hi)
#define BOTH(k) (IN(k) && IN((k) + 1))
#define WSRC(S, l) WSrc S; S.w_in = PTR(8) + (size_t)(l) * 1024 * NIN; S.wo_f = PTR(20) + (size_t)(l) * 256 * 1024; S.wo_a = PTR(21) + (size_t)(l) * 512 * 1024; \
    S.wo_c = PTR(22) + (size_t)(l) * 256 * 1024; S.wo_p = PTR(23) + (size_t)(l) * 256 * 1024; S.w_out = PTR(24) + (size_t)(l) * 1024 * 1024; \
    S.w_up = PTR(25) + (size_t)(l) * 1024 * 2 * DFF; S.w_down = PTR(28) + (size_t)(l) * DFF * 1024;
#define ws WSP
#define MOD ((float*)(WSP + WS_MOD))
#define ROPE ((float*)(WSP + WS_ROPE))
#define TW ((f32x2*)(WSP + WS_TW))
#define XC ((float*)(WSP + WS_XC))
#define HX ((bf16_t*)(WSP + WS_HX))
#define FA ((f32x2*)(WSP + WS_FA))
#define Qb ((bf16_t*)(WSP + WS_Q))
#define Kb ((bf16_t*)(WSP + WS_K))
#define Vb ((bf16_t*)(WSP + WS_V))
#define Yb ((bf16_t*)(WSP + WS_Y))
#define Gb (WSP + WS_G)
#define ACAT ((bf16_t*)(WSP + WS_ACAT))
#define UF ((bf16_t*)(WSP + WS_UF))
#define ZG ((bf16_t*)(WSP + WS_ZG))
#define UP ((bf16_t*)(WSP + WS_UP))
#define GT ((bf16_t*)(WSP + WS_GT))
#define Hb ((bf16_t*)(WSP + WS_H))

    for (int rep = 0; rep < NREP(0); ++rep) if (PH_EN(0) && IN(0)) { FRESH();
        mod_phase(PTR(1), PTR(3), PTR(6), PTR(7), MOD, L, vcu, G, tid, wave, lane);
        tables_phase(ROPE, TW, vcu * 512 + tid, G * 512);
        for (int i = vcu * 512 + tid; i < MC * DM / 4; i += G * 512) ((f32x4*)XC)[i] = ((const f32x4*)PTR(2))[i];
        WSRC(S0, 0); convert_A(S0, ws, scr, gw, NGW, lane); convert_B(S0, ws, scr, gw, NGW, lane);
        if (BOTH(0)) GRID_BAR();
    }
#pragma nounroll
    for (int l = 0; l < 2; ++l) {
        const int pb = 1 + 10 * l;
#define mod (MOD + l * 3 * 6144)
#define XBF ((bf16_t*)OUTP)
#define xc ((l == 0) ? PTR(2) : (const float*)XC)
        const int Mact = (l == 0) ? MT : ML;
        for (int rep = 0; rep < NREP(1); ++rep) if (PH_EN(1) && IN(pb)) { FRESH(); if (l == 0) norm_phase<false>(PTR(0), xc, MT, PTR(4) + l * DM, mod, 0, 1024, HX, gw, NGW, lane);
            else norm_phase<true>(XBF, xc, MT, PTR(4) + l * DM, mod, 0, 1024, HX, gw, NGW, lane, (const float*)Gb, 11, MOD + 2 * 6144 + 5120, XC);
            if (BOTH(pb)) GRID_BAR(); }
        for (int rep = 0; rep < NREP(2); ++rep) if (PH_EN(2) && IN(pb + 1)) { FRESH();
            pg8::Gemm g{HX, (const bf16_t*)(ws + WS_WA), MT, NIN, 1024}; pg8::StaticOrder S; S.init(MT, NIN, G, bx);
            pg8::EpiIn E{UF, ZG, UP, Qb, Kb, Vb, Gb, ROPE};
            pg8::gemm_phase<pg8::EpiIn, pg8::StaticOrder, true, true>(L, g, S, E, tid);
            if (BOTH(pb + 1)) GRID_BAR();
        }
        for (int rep = 0; rep < NREP(3); ++rep) if (PH_EN(3) && IN(pb + 2)) { FRESH();
            for (int r1 = 0; r1 < ((X1REP & 1) ? 2 : 1); ++r1) if (X1M & 1) fft1_phase(UF, TW, (unsigned*)FA, L, vcu, G, tid, wave, lane);
            for (int r1 = 0; r1 < ((X1REP & 2) ? 2 : 1); ++r1) if (X1M & 2) for (int it = vcu; it < Mact / 64; it += G) conv_item(it, ZG, PTR(14) + l * 31 * 256, PTR(15) + l * 256, PTR(16) + l * 256, PTR(17) + l * 256, ACAT, L, tid, wave, lane);
            for (int r1 = 0; r1 < ((X1REP & 4) ? 2 : 1); ++r1) if (X1M & 4) pool_phase(UP, PTR(18) + l * 4 * 4096, PTR(19) + l * 256, ACAT, Mact / 64, (vcu + 248) % G, L, G, tid, wave, lane);
            if ((X1M & 8) && l == 0) for (int it = (vcu + 224) % G; it < 32; it += G) ctxdft_item(it, UF, ACAT, L, tid, wave, lane);
            if (l == 0) {
                const float lam_init = 0.2f;
                const float d1 = wave_sum(PTR(9)[lane] * PTR(10)[lane]), d2 = wave_sum(PTR(11)[lane] * PTR(12)[lane]);
                const float lam = __builtin_bit_cast(float, __builtin_amdgcn_readfirstlane(__builtin_bit_cast(int, expf(d1) - expf(d2) + lam_init)));
                for (int v = (vcu + 200) % G; v < 16; v += G) { const int b = v >> 3, h = (v >> 1) & 3, row0 = ML + b * CTXL + (v & 1) * 128;
                    att2::attn_unit<0>(Qb + (size_t)row0 * 512 + h * 128, Kb + (size_t)b * KVL * 512 + h * 128, Vb + (size_t)b * KVL * 512 + h * 128, CTXL,
                                       ACAT + (size_t)row0 * KCAT + 256 + h * 128, lam, 1.0f - lam_init, PTR(13), (char*)lds, tid); }
            }
            WSRC(S1, 1);
            for (int r1 = 0; r1 < ((X1REP & 16) ? 2 : 1); ++r1) if (!(X1M & 16)) {} else if (l == 0) convert_A(S1, ws, scr, gw, NGW, lane); else convert_B(S1, ws, scr, gw, NGW, lane);
            if (BOTH(pb + 2)) GRID_BAR();
        }
        for (int rep = 0; rep < NREP(4); ++rep) if (PH_EN(4) && IN(pb + 3)) { FRESH();
            if (ATTM & 1) fft2_phase((const unsigned*)FA, ACAT, L, vcu, G, tid, wave, lane);
            const float lam_init = (l == 0) ? 0.2f : 0.35550906759096926f;
            const float d1 = wave_sum(PTR(9)[l * 64 + lane] * PTR(10)[l * 64 + lane]), d2 = wave_sum(PTR(11)[l * 64 + lane] * PTR(12)[l * 64 + lane]);
            const float lam = __builtin_bit_cast(float, __builtin_amdgcn_readfirstlane(__builtin_bit_cast(int, expf(d1) - expf(d2) + lam_init)));
            const int nun = 512;
            if (ATTM & 2) for (int u = vcu; u < nun; u += G) {
                int b, h, row0, nkeys;
                if (u < 512) { const int x = (u & 255) >> 5, qb = (u & 31) + 32 * (u >> 8); b = x >> 2; h = x & 3; row0 = b * SEQ + qb * 128; nkeys = KVL; }
                else { const int v = u - 512; b = v >> 3; h = (v >> 1) & 3; row0 = ML + b * CTXL + (v & 1) * 128; nkeys = CTXL; }
#if ATT_V == 2
                att2::attn_unit<0>(Qb + (size_t)row0 * 512 + h * 128,
#else
                att::attn_unit<0>(Qb + (size_t)row0 * 512 + h * 128,
#endif
                               Kb + (size_t)b * KVL * 512 + h * 128, Vb + (size_t)b * KVL * 512 + h * 128, nkeys,
                               ACAT + (size_t)row0 * KCAT + 256 + h * 128, lam, 1.0f - lam_init, PTR(13) + l * 128, (char*)lds, tid);
            }
            if (l == 0) {
                pg8::Gemm gc{ACAT + (size_t)ML * KCAT, (const bf16_t*)(ws + WS_WCAT), MC, 1024, 256, KCAT}; pg8::BranchSliceOrder Sc{G, bx};
                pg8::EpiSlab Ec{(float*)UF};
                pg8::gemm_phase<pg8::EpiSlab, pg8::BranchSliceOrder, true, true>(L, gc, Sc, Ec, tid);
            }
#if defined(ATT_PROBE)
            int tid2 = tid, vcu2 = vcu; asm volatile("" : "+v"(tid2), "+s"(vcu2));
            for (int u = vcu2; u < 512; u += G) {
                const int x = (u & 255) >> 5, qb = (u & 31) + 32 * (u >> 8), b = x >> 2, h = x & 3, row0 = b * SEQ + qb * 128;
                att2::attn_unit<ATT_PROBE>(Qb + (size_t)row0 * 512 + h * 128, Kb + (size_t)b * KVL * 512 + h * 128, Vb + (size_t)b * KVL * 512 + h * 128, KVL,
                               Hb + (size_t)row0 * KCAT + 256 + h * 128, lam, 1.0f - lam_init, PTR(13) + l * 128, (char*)lds, tid2);
            }
#endif
            if (BOTH(pb + 3)) GRID_BAR();
        }
        for (int rep = 0; rep < NREP(5); ++rep) if (PH_EN(5) && IN(pb + 4)) { FRESH();
            if (l == 0) ctx_gate_combine((const float*)UF, Gb + (size_t)ML * 4096, Yb + (size_t)ML * 1024, gw, NGW, lane);
            pg8::Gemm g{ACAT, (const bf16_t*)(ws + WS_WCAT), ML, 1024, KCAT}; pg8::StaticOrder S; S.init(ML, 1024, G, bx);
            pg8::EpiBranch E{Gb, Yb};
            pg8::gemm_phase<pg8::EpiBranch, pg8::StaticOrder, true, true>(L, g, S, E, tid);
            if (BOTH(pb + 4)) GRID_BAR();
        }
        for (int rep = 0; rep < (l == 0 ? NREP(6) : 1); ++rep) if (PH_EN(6) && IN(pb + 5)) { FRESH();
            pg8::Gemm g{Yb, (const bf16_t*)(ws + WS_WOUT), ML, 1024, 1024}; pg8::StaticOrder S; S.init(ML, 1024, G, bx);
            pg8::EpiRes E{l == 0 ? PTR(0) : (const float*)nullptr, XBF, xc, XBF, XC, mod, 2048};
            pg8::gemm_phase<pg8::EpiRes, pg8::StaticOrder, true, true>(L, g, S, E, tid);
            if (l == 0) {
                pg8::Gemm gc{Yb + (size_t)ML * 1024, (const bf16_t*)(ws + WS_WOUT), MC, 1024, 256, 1024}; pg8::SplitKOrder Sc{4, 256, G, bx};
                pg8::EpiSlab Ec{(float*)Gb};
                pg8::gemm_phase<pg8::EpiSlab, pg8::SplitKOrder, true, true>(L, gc, Sc, Ec, tid);
            }
            if (BOTH(pb + 5)) GRID_BAR();
        }
        for (int rep = 0; rep < NREP(7); ++rep) if (PH_EN(7) && IN(pb + 6)) { FRESH(); if (l == 0) norm_phase<true>(XBF, XC, Mact, PTR(5) + l * DM, mod, 3072, 4096, HX, gw, NGW, lane, (const float*)Gb, 4, mod + 2 * 6144 + 2048, XC);
            else norm_phase<true>(XBF, XC, Mact, PTR(5) + l * DM, mod, 3072, 4096, HX, gw, NGW, lane);
            if (BOTH(pb + 6)) GRID_BAR(); }
        for (int rep = 0; rep < NREP(8); ++rep) if (PH_EN(8) && IN(pb + 7)) { FRESH();
            pg8::Gemm g{HX, (const bf16_t*)(ws + WS_WUPG), Mact, DFF, 1024}; pg8::StaticOrder S; S.init(Mact, DFF, G, bx);
            pg8::EpiBf E{GT, DFF};
            pg8::gemm_phase<pg8::EpiBf, pg8::StaticOrder, true, true>(L, g, S, E, tid);
            if (BOTH(pb + 7)) GRID_BAR();
        }
        for (int rep = 0; rep < NREP(9); ++rep) if (PH_EN(9) && IN(pb + 8)) { FRESH();
            pg8::Gemm g{HX, (const bf16_t*)(ws + WS_WUPV), Mact, DFF, 1024}; pg8::StaticOrder S; S.init(Mact, DFF, G, bx);
            pg8::EpiVal E{GT, Hb, PTR(26) + l * 3 * DFF, PTR(27) + l * DFF};
            pg8::gemm_phase<pg8::EpiVal, pg8::StaticOrder, true, true>(L, g, S, E, tid);
            if (BOTH(pb + 8)) GRID_BAR();
        }
        if (PH_EN(10) && IN(pb + 9)) { FRESH();
            pg8::Gemm g{Hb, (const bf16_t*)(ws + WS_WDN), ML, 1024, DFF}; pg8::StaticOrder S; S.init(ML, 1024, G, bx);
            pg8::EpiRes E{(const float*)nullptr, XBF, XC, l == 0 ? XBF : HX, XC, mod, 5120};
            pg8::gemm_phase<pg8::EpiRes, pg8::StaticOrder, true, true>(L, g, S, E, tid);
            if (l == 0) {
                pg8::Gemm gc{Hb + (size_t)ML * DFF, (const bf16_t*)(ws + WS_WDN), MC, 1024, 256, DFF}; pg8::SplitKOrder Sc{11, 256, G, bx};
                pg8::EpiSlab Ec{(float*)Gb};
                pg8::gemm_phase<pg8::EpiSlab, pg8::SplitKOrder, true, true>(L, gc, Sc, Ec, tid);
            }
            if (BOTH(pb + 9)) GRID_BAR();
        }
    }
    if (PH_EN(11) && IN(21)) { FRESH(); final_norm_phase(HX, OUTP, PTR(29), gw, NGW, lane); }
#undef IN
#undef BOTH
#undef mod
#undef XBF
#undef xc
#undef ws
#undef MOD
#undef ROPE
#undef TW
#undef XC
#undef HX
#undef FA
#undef Qb
#undef Kb
#undef Vb
#undef Yb
#undef Gb
#undef ACAT
#undef UF
#undef ZG
#undef UP
#undef GT
#undef Hb
#undef PTR
#undef OUTP
#undef WSP
}

extern "C" void kernel_launch(void* const* d_in, const int* in_sizes, int n_in, void* d_out, int out_size, void* d_ws, size_t ws_size, hipStream_t stream) {
    static int grid = 0;
    if (grid == 0) {
        if (n_in != 30 || in_sizes[0] != ML * DM || out_size != ML * DM || ws_size < WS_END) {
            fprintf(stderr, "kernel_launch: unexpected shapes: n_in %d in0 %d out %d ws %zu (need >= %zu)\n", n_in, n_in > 0 ? in_sizes[0] : -1, out_size, ws_size, (size_t)WS_END); grid = -1; return; }
        int dev = 0, cus = 0, per_cu = 0;
        if (hipGetDevice(&dev) != hipSuccess || hipDeviceGetAttribute(&cus, hipDeviceAttributeMultiprocessorCount, dev) != hipSuccess) { grid = -1; return; }
        if (hipFuncSetAttribute((const void*)fwd_kernel, hipFuncAttributeMaxDynamicSharedMemorySize, LDS_BYTES) != hipSuccess) { fprintf(stderr, "kernel_launch: hipFuncSetAttribute failed\n"); grid = -1; return; }
        if (hipOccupancyMaxActiveBlocksPerMultiprocessor(&per_cu, (const void*)fwd_kernel, 512, LDS_BYTES) != hipSuccess || per_cu < 1) {
            fprintf(stderr, "kernel_launch: occupancy query reports %d blocks per CU\n", per_cu); (void)hipGetLastError(); grid = -1; return; }
        grid = cus;
    }
    if (grid < 0) return;
    (void)hipMemsetAsync((char*)d_ws + WS_CTL, 0, CTL_ZERO_BYTES, stream);
    Args a{};
    for (int i = 0; i < 30; ++i) a.in[i] = (const float*)d_in[i];
    a.out = (float*)d_out; a.ws = (unsigned char*)d_ws;
    for (int li = 0; li < MK_N_LAUNCHES; ++li) {
        if (MK_N_LAUNCHES == NPHASE) { a.ph_lo = li; a.ph_hi = li + 1; a.li = 0; }
        else { a.ph_lo = (int)((long)NPHASE * li / MK_N_LAUNCHES); a.ph_hi = (int)((long)NPHASE * (li + 1) / MK_N_LAUNCHES); a.li = li; }
        hipLaunchKernelGGL(fwd_kernel, dim3(grid), dim3(512), LDS_BYTES, stream, a);
    }
}
```

```cpp
#include <hip/hip_runtime.h>
#include <cstdio>
#include <cstdint>

#define LAS __attribute__((address_space(3)))
#define GAS __attribute__((address_space(1)))
typedef unsigned short bf16_t;
typedef short bf16x8 __attribute__((ext_vector_type(8)));
typedef short s16x4 __attribute__((ext_vector_type(4)));
typedef float f32x2 __attribute__((ext_vector_type(2)));
typedef float f32x4 __attribute__((ext_vector_type(4)));
typedef float f32x16 __attribute__((ext_vector_type(16)));
typedef unsigned u32x2 __attribute__((ext_vector_type(2)));
typedef unsigned u32x4 __attribute__((ext_vector_type(4)));

#ifndef ATT_V
#define ATT_V 2
#endif
#ifndef MK_N_LAUNCHES
#define MK_N_LAUNCHES 1
#endif

constexpr int DM = 1024, SEQ = 8192, NBATCH = 2, CTXL = 256;
constexpr int ML = NBATCH * SEQ;
constexpr int MC = NBATCH * CTXL;
constexpr int MT = ML + MC;
constexpr int NIN = 6656, DFF = 2816, KCAT = 1280;
constexpr int KVL = CTXL + SEQ;
constexpr float EPS = 1e-6f;

constexpr size_t MiB = 1u << 20;
constexpr size_t WS_CTL = 0, CTL_ZERO_BYTES = 1 * MiB;
constexpr size_t WS_MOD = 1 * MiB;
constexpr size_t WS_ROPE = WS_MOD + 2 * 3 * 6144 * 4;
constexpr size_t WS_TW = WS_ROPE + 192 * 32 * 4;
constexpr size_t WS_XC = 2 * MiB;
constexpr size_t WS_WA = 4 * MiB;
constexpr size_t WS_WCAT = 17 * MiB;
constexpr size_t WS_WOUT = WS_WCAT + (size_t)1024 * 1280 * 2;
constexpr size_t WS_WUPG = WS_WOUT + (size_t)1024 * 1024 * 2;
constexpr size_t WS_WUPV = WS_WUPG + (size_t)2816 * 1024 * 2;
constexpr size_t WS_WDN = WS_WUPV + (size_t)2816 * 1024 * 2;
constexpr size_t WS_HX = 38 * MiB;
constexpr size_t WS_FA = WS_HX;
constexpr size_t WS_Q = 71 * MiB;
constexpr size_t WS_K = WS_Q + (size_t)MT * 512 * 2;
constexpr size_t WS_V = WS_K + (size_t)MT * 512 * 2;
constexpr size_t WS_Y = 71 * MiB;
constexpr size_t WS_G = 121 * MiB;
constexpr size_t WS_ACAT = 187 * MiB;
constexpr size_t WS_UF = 229 * MiB;
constexpr size_t WS_ZG = WS_UF + (size_t)MT * 256 * 2;
constexpr size_t WS_UP = WS_ZG + (size_t)MT * 256 * 2;
constexpr size_t WS_GT = 71 * MiB;
constexpr size_t WS_H = 162 * MiB;
constexpr size_t WS_END = 256 * MiB;
static_assert(WS_TW + 8192 * 8 <= WS_XC && WS_WDN + (size_t)1024 * 2816 * 2 <= WS_HX && WS_V + (size_t)MT * 512 * 2 <= WS_G && WS_G + (size_t)MT * 4096 <= WS_ACAT, "ws map 1");
static_assert(WS_ACAT + (size_t)MT * 1280 * 2 <= WS_UF && WS_UP + (size_t)MT * 256 * 2 <= WS_END && WS_GT + (size_t)MT * 2816 * 2 <= WS_H && WS_H + (size_t)MT * 2816 * 2 <= WS_END, "ws map 2");
static_assert(WS_HX + (size_t)MT * 1024 * 2 <= WS_Q && (size_t)2 * 4 * 128 * 64 * 64 * 8 <= (size_t)MT * 1024 * 2, "ws map 3");
constexpr int CW_TMO = 0, CW_CODE = 1, CW_BAR = 4096;

constexpr int RING_BYTES = 131072, LDSCTL_OFF = RING_BYTES, MISC_OFF = LDSCTL_OFF + 320, LDS_BYTES = 147456;

typedef __bf16 bf16x2_t __attribute__((ext_vector_type(2)));
__device__ __forceinline__ unsigned cvt2bf(float lo, float hi) { const f32x2 v = {lo, hi}; return __builtin_bit_cast(unsigned, __builtin_convertvector(v, bf16x2_t)); }
template <int M> __device__ __forceinline__ float swz_xor(float v) { return __int_as_float(__builtin_amdgcn_ds_swizzle(__float_as_int(v), (M << 10) | 0x1f)); }
__device__ __forceinline__ float bf2f(unsigned v) { return __uint_as_float(v << 16); }
__device__ __forceinline__ float sigm(float x) { return __builtin_amdgcn_rcpf(1.0f + __builtin_amdgcn_exp2f(x * -1.4426950408889634f)); }
__host__ __device__ __forceinline__ int in_map(int n) {
    if (n < 256) return n;
    if (n < 1280) { const int base = n < 768 ? 256 : 768, r = n - base, comp = r >> 6, p = r & 63, pp = p >> 1, e = p & 1;
        return base + comp * 64 + (pp < 16 ? 0 : 32) + (pp & 15) + 16 * e; }
    if (n < 1792) return n;
    if (n < 2304) { const int r = n - 1792; return 1792 + (r & 1) * 256 + (r >> 1); }
    return n;
}
namespace pg8 {
#define PG8_LAS __attribute__((address_space(3)))
typedef unsigned short bf16_t;
typedef short bf16x8 __attribute__((ext_vector_type(8)));
typedef float f32x4 __attribute__((ext_vector_type(4)));
typedef unsigned u32x4 __attribute__((ext_vector_type(4)));
constexpr int BM = 256, BK = 64, HALF = 128, HTB = HALF * BK * 2  , STAGE_BYTES = 8 * HTB, NXCD = 8, WGM = 8;

__host__ __device__ __forceinline__ int lds_byte(int r, int c) { const int st = (r >> 4) * 2 + (c >> 5), rr = r & 15, cc = c & 31, ob = rr * 64 + cc * 2; return st * 1024 + (ob ^ (((ob >> 9) & 1) << 5)); }
__host__ __device__ __forceinline__ void stage_rc(int b, int& R, int& C) { const int st = b / 1024, sb = b % 1024, swz = sb ^ (((sb >> 9) & 1) << 5); R = (st >> 1) * 16 + swz / 64; C = (st & 1) * 32 + (swz % 64) / 2; }
__host__ __device__ __forceinline__ int perm32(int rho) { const int n = rho >> 4, i = rho & 15; return 8 * (i >> 2) + 4 * n + (i & 3); }

struct Unit { int pm, pn, ko = 0, sl = 0; };
struct Gemm { const bf16_t* A; const bf16_t* Bt; int M, N, K, ld = 0; };

struct StaticOrder {
    int nM, nN, nwg, G, c;
    __host__ __device__ void init(int M, int N, int G_, int c_) { nM = M / BM; nN = N / BM; nwg = nM * nN; G = G_; c = c_; }
    __host__ __device__ bool next(int i, Unit& u) const {
        const long L = (long)i * G + c; if (L >= nwg) return false;
        int wgid = (int)L; { const int q = nwg / NXCD, r = nwg % NXCD, xcd = wgid % NXCD, off = wgid / NXCD; wgid = (xcd < r ? xcd * (q + 1) : r * (q + 1) + (xcd - r) * q) + off; }
        const int nig = WGM * nN, gid = wgid / nig, fm = gid * WGM, gsz = (nM - fm) < WGM ? (nM - fm) : WGM;
        u.pm = fm + ((wgid % nig) % gsz); u.pn = (wgid % nig) / gsz; return true;
    }
    __device__ __forceinline__ void a_ready(const Unit&) const {}
    __device__ __forceinline__ void done(const Unit&) const {}
};
__device__ __forceinline__ unsigned cvt_pk_bf16(float lo, float hi) { return cvt2bf(lo, hi); }
typedef float f32x2 __attribute__((ext_vector_type(2)));
__device__ __forceinline__ f32x2 gelu_pk(f32x2 v) {
    const f32x2 av = __builtin_elementwise_abs(v), d = av * 0.2316418882f + 1.0f;
    f32x2 t; t.x = __builtin_amdgcn_rcpf(d.x); t.y = __builtin_amdgcn_rcpf(d.y);
    f32x2 q = t * 0.5307027145f + (-0.7265760135f); q = q * t + 0.7107068705f; q = q * t + (-0.142248368f); q = q * t + 0.127414796f; q = q * t;
    const f32x2 s = (v * v) * (-0.72134752044f);
    f32x2 e; e.x = __builtin_amdgcn_exp2f(s.x); e.y = __builtin_amdgcn_exp2f(s.y);
    const f32x2 m = v * (q * e), r = v - m;
    f32x2 o; o.x = v.x < 0.f ? m.x : r.x; o.y = v.y < 0.f ? m.y : r.y; return o;
}

typedef unsigned u32x2 __attribute__((ext_vector_type(2)));
__device__ __forceinline__ u32x4 pack8(const f32x4 a, const f32x4 b) { u32x4 w; w.x = cvt_pk_bf16(a[0], a[1]); w.y = cvt_pk_bf16(a[2], a[3]); w.z = cvt_pk_bf16(b[0], b[1]); w.w = cvt_pk_bf16(b[2], b[3]); return w; }

struct EpiIn {
    static constexpr bool PERM = true, AFTER_DRAIN = false, RESCALE = false;
    bf16_t *UF, *ZG, *UP, *Q, *K, *V; unsigned char* G; const float* rope;
    __device__ __forceinline__ void operator()(const f32x4 (&acc)[2][2][4][2], const Unit& u, int wr, int wc, int fr, int fq) const {
        const int pm = u.pm, pn = u.pn; const bool lat = pm < 64; const int R0 = pm * 256;
        const int kv0 = lat ? ((pm >> 5) * 8448 + 256 + ((pm & 31) << 8)) : ((pm - 64) * 8448);
        const int rl = wr * 64 + fr, cl = wc * 32 + 8 * fq;
        if (pn == 0 || pn == 9) {
            bf16_t* dst = (pn == 0 ? UF : UP);
#pragma unroll
            for (int ai = 0; ai < 2; ++ai)
#pragma unroll
                for (int m = 0; m < 4; ++m) { const int rr = ai * 128 + m * 16 + rl;
#pragma unroll
                    for (int bj = 0; bj < 2; ++bj) *(u32x4*)(dst + (size_t)(R0 + rr) * 256 + bj * 128 + cl) = pack8(acc[ai][bj][m][0], acc[ai][bj][m][1]); }
        } else if (pn <= 4) {
            const bool isq = pn <= 2; bf16_t* dst = isq ? Q : K; const int rowbase = isq ? R0 : kv0, colbase = (isq ? pn - 1 : pn - 3) * 256; const float sc = isq ? (ATT_V == 2 ? 0.18033688011112042f : 0.125f) : 1.0f;
#pragma unroll
            for (int ai = 0; ai < 2; ++ai)
#pragma unroll
                for (int m = 0; m < 4; ++m) { const int rr = ai * 128 + m * 16 + rl;
                    f32x4 cs = {1.f, 1.f, 1.f, 1.f}, sn = {0.f, 0.f, 0.f, 0.f};
                    if (lat) { const int t = (R0 & 8191) + rr; const int pos = (wc & 1) ? 128 + (t & 63) : (t >> 6);
                        cs = *(const f32x4*)(rope + pos * 32 + 4 * fq); sn = *(const f32x4*)(rope + pos * 32 + 16 + 4 * fq); }
                    cs = cs * sc; sn = sn * sc;
#pragma unroll
                    for (int bj = 0; bj < 2; ++bj) { const f32x4 a = acc[ai][bj][m][0], b = acc[ai][bj][m][1]; f32x4 oa, ob;
                        oa[0] = a[0] * cs[0] - a[1] * sn[0]; oa[1] = a[1] * cs[0] + a[0] * sn[0]; oa[2] = a[2] * cs[1] - a[3] * sn[1]; oa[3] = a[3] * cs[1] + a[2] * sn[1];
                        ob[0] = b[0] * cs[2] - b[1] * sn[2]; ob[1] = b[1] * cs[2] + b[0] * sn[2]; ob[2] = b[2] * cs[3] - b[3] * sn[3]; ob[3] = b[3] * cs[3] + b[2] * sn[3];
                        *(u32x4*)(dst + (size_t)(rowbase + rr) * 512 + colbase + bj * 128 + cl) = pack8(oa, ob); } }
        } else if (pn <= 6) {
#pragma unroll
            for (int ai = 0; ai < 2; ++ai)
#pragma unroll
                for (int m = 0; m < 4; ++m) { const int rr = ai * 128 + m * 16 + rl;
#pragma unroll
                    for (int bj = 0; bj < 2; ++bj) *(u32x4*)(V + (size_t)(kv0 + rr) * 512 + (pn - 5) * 256 + bj * 128 + cl) = pack8(acc[ai][bj][m][0], acc[ai][bj][m][1]); }
        } else if (pn <= 8) {
#pragma unroll
            for (int ai = 0; ai < 2; ++ai)
#pragma unroll
                for (int m = 0; m < 4; ++m) { const int rr = ai * 128 + m * 16 + rl;
#pragma unroll
                    for (int bj = 0; bj < 2; ++bj) { const f32x4 a = acc[ai][bj][m][0], b = acc[ai][bj][m][1];
                        u32x2 w; w.x = cvt_pk_bf16(a[0] * sigm(a[1]), a[2] * sigm(a[3])); w.y = cvt_pk_bf16(b[0] * sigm(b[1]), b[2] * sigm(b[3]));
                        *(u32x2*)(ZG + (size_t)(R0 + rr) * 256 + (pn - 7) * 128 + bj * 64 + (cl >> 1)) = w; } }
        } else {
#pragma unroll
            for (int ai = 0; ai < 2; ++ai)
#pragma unroll
                for (int m = 0; m < 4; ++m) { const int rr = ai * 128 + m * 16 + rl;
#pragma unroll
                    for (int bj = 0; bj < 2; ++bj) { u32x2 w;
#pragma unroll
                        for (int n = 0; n < 2; ++n) { const f32x4 a = acc[ai][bj][m][n]; unsigned q = 0;
#pragma unroll
                            for (int j = 0; j < 4; ++j) { float s = sigm(a[j]) * 255.0f + 0.5f; s = s < 1.0f ? 1.0f : s; q |= ((unsigned)s) << (8 * j); }
                            if (n == 0) w.x = q; else w.y = q; }
                        *(u32x2*)(G + (size_t)(R0 + rr) * 4096 + (pn - 10) * 256 + bj * 128 + cl) = w; } }
        }
    }
};

struct EpiBf {
    static constexpr bool PERM = true, AFTER_DRAIN = false, RESCALE = false;
    bf16_t* O; int ldc;
    __device__ __forceinline__ void operator()(const f32x4 (&acc)[2][2][4][2], const Unit& u, int wr, int wc, int fr, int fq) const {
        const int row0 = u.pm * 256 + wr * 64 + fr, col0 = u.pn * 256 + wc * 32 + 8 * fq;
#pragma unroll
        for (int ai = 0; ai < 2; ++ai)
#pragma unroll
            for (int m = 0; m < 4; ++m)
#pragma unroll
                for (int bj = 0; bj < 2; ++bj) *(u32x4*)(O + (size_t)(row0 + ai * 128 + m * 16) * ldc + col0 + bj * 128) = pack8(acc[ai][bj][m][0], acc[ai][bj][m][1]);
    }
};

struct EpiRes {
    static constexpr bool PERM = true, AFTER_DRAIN = false, RESCALE = false;
    const float* base_f32; const bf16_t* base_bf; const float* base_ctx; bf16_t* out_bf; float* out_ctx; const float* mod; int goff;
    __device__ __forceinline__ void operator()(const f32x4 (&acc)[2][2][4][2], const Unit& u, int wr, int wc, int fr, int fq) const {
        const int pm = u.pm; const bool lat = pm < 64; const int mrow = lat ? (pm >> 5) : 2;
        const int col0 = u.pn * 256 + wc * 32 + 8 * fq;
        f32x4 gv[2][2];
#pragma unroll
        for (int bj = 0; bj < 2; ++bj)
#pragma unroll
            for (int n = 0; n < 2; ++n) gv[bj][n] = *(const f32x4*)(mod + mrow * 6144 + goff + col0 + bj * 128 + 4 * n);
#pragma unroll
        for (int ai = 0; ai < 2; ++ai)
#pragma unroll
            for (int m = 0; m < 4; ++m) { const size_t ro = (size_t)((lat ? pm : pm - 64) * 256 + ai * 128 + wr * 64 + m * 16 + fr) * 1024 + col0;
#pragma unroll
                for (int bj = 0; bj < 2; ++bj) { const size_t off = ro + bj * 128; f32x4 b0, b1;
                    if (!lat) { b0 = *(const f32x4*)(base_ctx + off); b1 = *(const f32x4*)(base_ctx + off + 4); }
                    else if (base_f32) { b0 = *(const f32x4*)(base_f32 + off); b1 = *(const f32x4*)(base_f32 + off + 4); }
                    else { const u32x4 w = *(const u32x4*)(base_bf + off);
                        b0 = (f32x4){__uint_as_float(w.x << 16), __uint_as_float(w.x & 0xffff0000u), __uint_as_float(w.y << 16), __uint_as_float(w.y & 0xffff0000u)};
                        b1 = (f32x4){__uint_as_float(w.z << 16), __uint_as_float(w.z & 0xffff0000u), __uint_as_float(w.w << 16), __uint_as_float(w.w & 0xffff0000u)}; }
                    const f32x4 o0 = b0 + gv[bj][0] * acc[ai][bj][m][0], o1 = b1 + gv[bj][1] * acc[ai][bj][m][1];
                    if (lat) *(u32x4*)(out_bf + off) = pack8(o0, o1); else { *(f32x4*)(out_ctx + off) = o0; *(f32x4*)(out_ctx + off + 4) = o1; } } }
    }
};

struct EpiVal {
    static constexpr bool PERM = true, AFTER_DRAIN = false, RESCALE = false;
    const bf16_t* GT; bf16_t* H; const float* dww; const float* dwb;
    __device__ __forceinline__ void operator()(const f32x4 (&acc)[2][2][4][2], const Unit& u, int wr, int wc, int fr, int fq) const {
        const int pm = u.pm; const bool lat = pm < 64; const int R0 = pm * 256, t0 = lat ? (R0 & 8191) : 0, L = lat ? 8192 : 256;
        const int rl = wr * 64 + fr;
#pragma unroll
        for (int bj = 0; bj < 2; ++bj) { const int col = u.pn * 256 + bj * 128 + wc * 32 + 8 * fq;
            f32x4 w0[2], w1[2], w2[2], bb[2];
#pragma unroll
            for (int n = 0; n < 2; ++n) { w0[n] = *(const f32x4*)(dww + col + 4 * n); w1[n] = *(const f32x4*)(dww + 2816 + col + 4 * n); w2[n] = *(const f32x4*)(dww + 5632 + col + 4 * n); bb[n] = *(const f32x4*)(dwb + col + 4 * n); }
#pragma unroll
            for (int ai = 0; ai < 2; ++ai) {
#pragma unroll
              for (int mh = 0; mh < 4; mh += 2) {
                u32x4 gm[4], g0[4], gq[4];
#pragma unroll
                for (int m = mh; m < mh + 2; ++m) { const int rr = ai * 128 + m * 16 + rl, t = t0 + rr; const bf16_t* gp = GT + (size_t)(R0 + rr) * 2816 + col;
                    gm[m] = (u32x4){0u, 0u, 0u, 0u}; gq[m] = (u32x4){0u, 0u, 0u, 0u}; g0[m] = *(const u32x4*)gp;
                    if (t > 0) gm[m] = *(const u32x4*)(gp - 2816);
                    if (t < L - 1) gq[m] = *(const u32x4*)(gp + 2816); }
                asm volatile("" ::: "memory");
#pragma unroll
                for (int m = mh; m < mh + 2; ++m) { const int rr = ai * 128 + m * 16 + rl;
                    f32x4 o[2];
#pragma unroll
                    for (int n = 0; n < 2; ++n) { f32x4 c;
#pragma unroll
                        for (int j = 0; j < 4; ++j) { const int e = 4 * n + j; const unsigned wm = gm[m][e >> 1], wz = g0[m][e >> 1], wp = gq[m][e >> 1];
                            const float xm = (e & 1) ? __uint_as_float(wm & 0xffff0000u) : __uint_as_float(wm << 16), xz = (e & 1) ? __uint_as_float(wz & 0xffff0000u) : __uint_as_float(wz << 16),
                                        xp = (e & 1) ? __uint_as_float(wp & 0xffff0000u) : __uint_as_float(wp << 16);
                            c[j] = w0[n][j] * xm + w1[n][j] * xz + w2[n][j] * xp + bb[n][j]; }
                        const f32x2 ga = gelu_pk((f32x2){c[0], c[1]}), gb = gelu_pk((f32x2){c[2], c[3]});
                        const f32x4 v = acc[ai][bj][m][n]; o[n] = (f32x4){v[0] * ga.x, v[1] * ga.y, v[2] * gb.x, v[3] * gb.y}; }
                    *(u32x4*)(H + (size_t)(R0 + rr) * 2816 + col) = pack8(o[0], o[1]); }
                asm volatile("" ::: "memory");
              }
            }
        }
    }
};

struct EpiBranch {
    static constexpr bool PERM = true, AFTER_DRAIN = false, RESCALE = true;
    const unsigned char* G; bf16_t* Y;
    __device__ __forceinline__ void rescale(f32x4 (&acc)[2][2][4][2], const Unit& u, int t, int wr, int wc, int fr, int fq) const {
        const int bp = (t == 4) ? 0 : (t == 12) ? 1 : 2;
        const __amdgpu_buffer_rsrc_t rs = __builtin_amdgcn_make_buffer_rsrc((void*)G, 0, MT * 4096, 0x00020000);
        const int voff = (u.pm * 256 + wr * 64 + fr) * 4096 + u.pn * 256 + wc * 32 + 8 * fq;
        u32x2 p[2][4][2], q[2][4][2];
#pragma unroll
        for (int ai = 0; ai < 2; ++ai)
#pragma unroll
            for (int m = 0; m < 4; ++m)
#pragma unroll
                for (int bj = 0; bj < 2; ++bj) { const int so = (ai * 128 + m * 16) * 4096 + bj * 128 + bp * 1024;
                    p[ai][m][bj] = __builtin_bit_cast(u32x2, __builtin_amdgcn_raw_buffer_load_b64(rs, voff, so, 0)); q[ai][m][bj] = __builtin_bit_cast(u32x2, __builtin_amdgcn_raw_buffer_load_b64(rs, voff, so + 1024, 0)); }
        asm volatile("" ::: "memory");
#pragma unroll
        for (int ai = 0; ai < 2; ++ai)
#pragma unroll
            for (int m = 0; m < 4; ++m)
#pragma unroll
                for (int bj = 0; bj < 2; ++bj)
#pragma unroll
                    for (int n = 0; n < 2; ++n) { const unsigned pw = n ? p[ai][m][bj].y : p[ai][m][bj].x, qw = n ? q[ai][m][bj].y : q[ai][m][bj].x;
#pragma unroll
                        for (int j = 0; j < 4; ++j) acc[ai][bj][m][n][j] *= (float)((pw >> (8 * j)) & 255u) * __builtin_amdgcn_rcpf((float)((qw >> (8 * j)) & 255u)); }
        asm volatile("" ::: "memory");
    }
    __device__ __forceinline__ void operator()(const f32x4 (&acc)[2][2][4][2], const Unit& u, int wr, int wc, int fr, int fq) const {
        const int row0 = u.pm * 256 + wr * 64 + fr, col0 = u.pn * 256 + wc * 32 + 8 * fq;
#pragma unroll
        for (int ai = 0; ai < 2; ++ai)
#pragma unroll
            for (int m = 0; m < 4; ++m)
#pragma unroll
                for (int bj = 0; bj < 2; ++bj) { const size_t r = (size_t)(row0 + ai * 128 + m * 16); const u32x2 p = *(const u32x2*)(G + r * 4096 + 3072 + col0 + bj * 128);
                    f32x4 o[2];
#pragma unroll
                    for (int n = 0; n < 2; ++n) { const unsigned pw = n ? p.y : p.x;
#pragma unroll
                        for (int j = 0; j < 4; ++j) o[n][j] = acc[ai][bj][m][n][j] * ((float)((pw >> (8 * j)) & 255u) * (1.0f / 255.0f)); }
                    *(u32x4*)(Y + r * 1024 + col0 + bj * 128) = pack8(o[0], o[1]); }
    }
};


struct SplitKOrder {
    int nsl, ksl, G, c;
    __device__ __forceinline__ bool next(int i, Unit& u) const { const int L = i * G + c; if (L >= 8 * nsl) return false; u.pm = (L >> 2) & 1; u.pn = L & 3; u.sl = L >> 3; u.ko = u.sl * ksl; return true; }
    __device__ __forceinline__ void a_ready(const Unit&) const {}
    __device__ __forceinline__ void done(const Unit&) const {}
};
struct EpiSlab {
    static constexpr bool PERM = false, AFTER_DRAIN = false, RESCALE = false;
    float* slab;
    __device__ __forceinline__ void operator()(const f32x4 (&acc)[2][2][4][2], const Unit& u, int wr, int wc, int fr, int fq) const {
        float* o = slab + (size_t)u.sl * 512 * 1024 + (size_t)(u.pm * 256 + wr * 64 + fr) * 1024 + u.pn * 256 + wc * 32 + 4 * fq;
#pragma unroll
        for (int ai = 0; ai < 2; ++ai)
#pragma unroll
            for (int m = 0; m < 4; ++m)
#pragma unroll
                for (int bj = 0; bj < 2; ++bj)
#pragma unroll
                    for (int n = 0; n < 2; ++n) *(f32x4*)(o + (size_t)(ai * 128 + m * 16) * 1024 + bj * 128 + n * 16) = acc[ai][bj][m][n];
    }
};

struct BranchSliceOrder {
    int G, c;
    __device__ __forceinline__ bool next(int i, Unit& u) const { const int L = i * G + c; if (L >= 40) return false; u.pm = (L >> 2) & 1; u.pn = L & 3; u.sl = L >> 3; u.ko = u.sl * 256; return true; }
    __device__ __forceinline__ void a_ready(const Unit&) const {}
    __device__ __forceinline__ void done(const Unit&) const {}
};
template <class Epi, class Sched, bool ALIGN_EPI = false, bool SP2 = false>
__device__ __forceinline__ void gemm_phase(PG8_LAS unsigned char* lds, const Gemm g, const Sched& S, const Epi& E, const int tid) {
    const int wid = __builtin_amdgcn_readfirstlane(tid >> 6), lane = tid & 63, wr = wid >> 2, wc = wid & 3, fr = lane & 15, fq = lane >> 4;
    const int K = g.ld ? g.ld : g.K  , nt = g.K / BK;
    unsigned voffA[2], voffB[2];
#pragma unroll
    for (int i = 0; i < 2; ++i) { int R, C; stage_rc(tid * 16 + i * 8192, R, C); const int Rb = Epi::PERM ? ((R & ~31) + perm32(R & 31)) : R;
        voffA[i] = (unsigned)(R * K + C) * 2u; voffB[i] = (unsigned)(Rb * K + C) * 2u; }
    const size_t kstep = (size_t)(BK * 2);
    const size_t hstep = (size_t)HALF * K * 2;
    const size_t tstep = 2 * hstep;
    const unsigned ldsw = (unsigned)wid * 1024u;
    const int aoff = lds_byte(wr * 64 + fr, fq * 8), boff = lds_byte(wc * 32 + fr, fq * 8);
#define PG8_SA(b, h) (((b) * 2 + (h)) * HTB)
#define PG8_SB(b, h) ((4 + (b) * 2 + (h)) * HTB)
#define PG8_STAGE(bufoff, gbase, voff) do { _Pragma("unroll") for (int _i = 0; _i < 2; ++_i) \
        __builtin_amdgcn_global_load_lds((const unsigned*)((const char*)(gbase) + (voff)[_i]), (PG8_LAS unsigned*)(lds + (bufoff) + ldsw + _i * 8192), 16, 0, 0); } while (0)
#define PG8_LDA(dst, b, h) do { _Pragma("unroll") for (int m = 0; m < 4; ++m) _Pragma("unroll") for (int k = 0; k < 2; ++k) dst[m][k] = *(const PG8_LAS bf16x8*)(lds + PG8_SA(b, h) + aoff + m * 2048 + k * 1024); } while (0)
#define PG8_LDB(dst, b, h) do { _Pragma("unroll") for (int n = 0; n < 2; ++n) _Pragma("unroll") for (int k = 0; k < 2; ++k) dst[n][k] = *(const PG8_LAS bf16x8*)(lds + PG8_SB(b, h) + boff + n * 2048 + k * 1024); } while (0)
#define PG8_MMA(ai, bj, At, Bt) do { __builtin_amdgcn_s_setprio(1); _Pragma("unroll") for (int m = 0; m < 4; ++m) _Pragma("unroll") for (int n = 0; n < 2; ++n) _Pragma("unroll") for (int k = 0; k < 2; ++k) \
        acc[ai][bj][m][n] = __builtin_amdgcn_mfma_f32_16x16x32_bf16(Bt[n][k], At[m][k], acc[ai][bj][m][n], 0, 0, 0); __builtin_amdgcn_s_setprio(0); } while (0)
#define PG8_WAIT_V(n) asm volatile("s_waitcnt vmcnt(" #n ")" ::: "memory")
#define PG8_WAIT_L(n) asm volatile("s_waitcnt lgkmcnt(" #n ")" ::: "memory")
#define PG8_BAR __builtin_amdgcn_s_barrier()
#define PG8_SCHED __builtin_amdgcn_sched_barrier(0)
    Unit cur, nxt; int ui = 0;
    if (!S.next(0, cur)) return;
    f32x4 acc[2][2][4][2];
#pragma unroll
    for (int a = 0; a < 2; ++a)
#pragma unroll
        for (int b = 0; b < 2; ++b)
#pragma unroll
            for (int m = 0; m < 4; ++m)
#pragma unroll
                for (int n = 0; n < 2; ++n) acc[a][b][m][n] = (f32x4){0.f, 0.f, 0.f, 0.f};
    bf16x8 At[4][2], B0[2][2], B1[2][2];
    const char* cA = (const char*)g.A + (size_t)cur.pm * tstep + (size_t)cur.ko * 2; const char* cB = (const char*)g.Bt + (size_t)cur.pn * tstep + (size_t)cur.ko * 2;
    S.a_ready(cur);
    if constexpr (SP2) {
        PG8_STAGE(PG8_SB(0, 0), cB, voffB); PG8_STAGE(PG8_SB(0, 1), cB + hstep, voffB); PG8_STAGE(PG8_SA(0, 0), cA, voffA); PG8_STAGE(PG8_SA(0, 1), cA + hstep, voffA);
        if (wr == 1) PG8_BAR;
        PG8_WAIT_V(2); PG8_BAR;
        PG8_STAGE(PG8_SB(1, 0), cB + kstep, voffB); PG8_STAGE(PG8_SA(1, 0), cA + kstep, voffA); PG8_STAGE(PG8_SB(1, 1), cB + hstep + kstep, voffB);
        PG8_WAIT_V(6); PG8_BAR;
    } else {
        PG8_STAGE(PG8_SB(0, 0), cB, voffB); PG8_STAGE(PG8_SA(0, 0), cA, voffA); PG8_STAGE(PG8_SB(0, 1), cB + hstep, voffB); PG8_STAGE(PG8_SA(0, 1), cA + hstep, voffA);
        if (wr == 1) PG8_BAR;
        PG8_WAIT_V(4); PG8_BAR;
        PG8_STAGE(PG8_SB(1, 0), cB + kstep, voffB); PG8_STAGE(PG8_SA(1, 0), cA + kstep, voffA); PG8_STAGE(PG8_SB(1, 1), cB + hstep + kstep, voffB);
        PG8_WAIT_V(6); PG8_BAR;
    }
    for (;;) {
        const bool has_next = S.next(ui + 1, nxt);
        const char* nA = has_next ? (const char*)g.A + (size_t)nxt.pm * tstep + (size_t)nxt.ko * 2 : cA; const char* nB = has_next ? (const char*)g.Bt + (size_t)nxt.pn * tstep + (size_t)nxt.ko * 2 : cB;
        for (int t = 0; t < nt; t += 2) {
            if constexpr (Epi::RESCALE) { if (t == 4 || t == 12 || t == 16) E.rescale(acc, cur, t, wr, wc, fr, fq); }
            const bool last = (t == nt - 2);
            const char* a1 = cA + (size_t)(t + 1) * kstep;
            const char* a2 = last ? nA : cA + (size_t)(t + 2) * kstep; const char* b2 = last ? nB : cB + (size_t)(t + 2) * kstep;
            const char* a3 = a2 + kstep; const char* b3 = b2 + kstep;
            if (last && has_next) S.a_ready(nxt);
            if constexpr (SP2) {
            PG8_LDB(B0, 0, 0); PG8_LDB(B1, 0, 1); PG8_SCHED; PG8_LDA(At, 0, 0); PG8_STAGE(PG8_SA(1, 1), a1 + hstep, voffA);
            PG8_WAIT_V(8); PG8_WAIT_L(0); PG8_BAR; PG8_MMA(0, 0, At, B0); PG8_MMA(0, 1, At, B1); PG8_BAR; PG8_SCHED;
            PG8_LDA(At, 0, 1); PG8_STAGE(PG8_SB(0, 0), b2, voffB); PG8_STAGE(PG8_SB(0, 1), b2 + hstep, voffB); PG8_STAGE(PG8_SA(0, 0), a2, voffA);
            PG8_WAIT_V(8); PG8_WAIT_L(0); PG8_BAR; PG8_MMA(1, 0, At, B0); PG8_MMA(1, 1, At, B1); PG8_BAR; PG8_SCHED;
            PG8_LDB(B0, 1, 0); PG8_LDB(B1, 1, 1); PG8_SCHED; PG8_LDA(At, 1, 0); PG8_STAGE(PG8_SA(0, 1), a2 + hstep, voffA);
            PG8_WAIT_V(8); PG8_WAIT_L(0); PG8_BAR; PG8_MMA(0, 0, At, B0); PG8_MMA(0, 1, At, B1); PG8_BAR; PG8_SCHED;
            PG8_LDA(At, 1, 1); PG8_STAGE(PG8_SB(1, 0), b3, voffB); PG8_STAGE(PG8_SB(1, 1), b3 + hstep, voffB); PG8_STAGE(PG8_SA(1, 0), a3, voffA);
            PG8_WAIT_V(8); PG8_WAIT_L(0); PG8_BAR; PG8_MMA(1, 0, At, B0); PG8_MMA(1, 1, At, B1); PG8_BAR; PG8_SCHED;
            } else {
            PG8_LDB(B0, 0, 0); PG8_SCHED; PG8_LDA(At, 0, 0); PG8_STAGE(PG8_SA(1, 1), a1 + hstep, voffA);
            PG8_WAIT_L(8); PG8_BAR; PG8_WAIT_L(0); PG8_MMA(0, 0, At, B0); PG8_BAR; PG8_SCHED;
            PG8_LDB(B1, 0, 1); PG8_STAGE(PG8_SB(0, 0), b2, voffB);
            PG8_BAR; PG8_WAIT_L(0); PG8_MMA(0, 1, At, B1); PG8_BAR;
            PG8_LDA(At, 0, 1); PG8_STAGE(PG8_SA(0, 0), a2, voffA);
            PG8_BAR; PG8_WAIT_L(0); PG8_MMA(1, 0, At, B0); PG8_BAR; PG8_SCHED;
            PG8_STAGE(PG8_SB(0, 1), b2 + hstep, voffB);
            PG8_WAIT_V(6); PG8_BAR; PG8_MMA(1, 1, At, B1); PG8_BAR;
            PG8_LDB(B0, 1, 0); PG8_SCHED; PG8_LDA(At, 1, 0); PG8_STAGE(PG8_SA(0, 1), a2 + hstep, voffA);
            PG8_WAIT_L(8); PG8_BAR; PG8_WAIT_L(0); PG8_MMA(0, 0, At, B0); PG8_BAR; PG8_SCHED;
            PG8_LDB(B1, 1, 1); PG8_STAGE(PG8_SB(1, 0), b3, voffB);
            PG8_BAR; PG8_WAIT_L(0); PG8_MMA(0, 1, At, B1); PG8_BAR;
            PG8_LDA(At, 1, 1); PG8_STAGE(PG8_SA(1, 0), a3, voffA);
            PG8_BAR; PG8_WAIT_L(0); PG8_MMA(1, 0, At, B0); PG8_BAR; PG8_SCHED;
            PG8_STAGE(PG8_SB(1, 1), b3 + hstep, voffB);
            PG8_WAIT_V(6); PG8_BAR; PG8_MMA(1, 1, At, B1); PG8_BAR;
            }
        }
        if constexpr (ALIGN_EPI) { if (wr == 0) PG8_BAR; }
        if constexpr (!Epi::AFTER_DRAIN) { E(acc, cur, wr, wc, fr, fq); S.done(cur); }
        if (!has_next) break;
#pragma unroll
        for (int a = 0; a < 2; ++a)
#pragma unroll
            for (int b = 0; b < 2; ++b)
#pragma unroll
                for (int m = 0; m < 4; ++m)
#pragma unroll
                    for (int n = 0; n < 2; ++n) acc[a][b][m][n] = (f32x4){0.f, 0.f, 0.f, 0.f};
        cur = nxt; cA = nA; cB = nB; ++ui;
        if constexpr (ALIGN_EPI) { if (wr == 1) PG8_BAR; }
    }
    PG8_WAIT_V(0);
    if constexpr (!ALIGN_EPI) { if (wr == 0) PG8_BAR; }
    PG8_BAR;
    if constexpr (Epi::AFTER_DRAIN) { E.fused(acc, cur, wr, wc, fr, fq, lds, wid, lane); S.done(cur); }
#undef PG8_SA
#undef PG8_SB
#undef PG8_STAGE
#undef PG8_LDA
#undef PG8_LDB
#undef PG8_MMA
#undef PG8_WAIT_V
#undef PG8_WAIT_L
#undef PG8_BAR
#undef PG8_SCHED
}
}
namespace att {
constexpr int NW = 8, QBLK = 32, KVBLK = 64, LDQ = 512, LDO = KCAT;
constexpr int SHM_V = 16384, SHM_K = 16384, SHM_ATTN = 3 * SHM_V + 2 * SHM_K + NW * 64 * 4;
constexpr float THR = 8.f;
#ifndef ATT_SDEPTH
#define ATT_SDEPTH 1
#endif
constexpr int SDEPTH = ATT_SDEPTH;
#define KSWZ(row, colB) ((row) * 256 + ((colB) ^ (((row) & 7) << 4)))
#define SBAR() __builtin_amdgcn_sched_barrier(0)
__device__ __forceinline__ int crow(int r, int hi) { return (r & 3) + 8 * (r >> 2) + 4 * hi; }
__device__ __forceinline__ unsigned cvtpk(float lo, float hi) { return cvt2bf(lo, hi); }

__device__ __forceinline__ void partialSM(f32x16& p0, f32x16& p1, float& m_reg, float& mn, float& alpha) {
  constexpr float C = 1.4426950408889634f;
  float pmax = p0[0];
#pragma unroll
  for (int r = 1; r < 16; ++r) pmax = fmaxf(pmax, p0[r]);
#pragma unroll
  for (int r = 0; r < 16; ++r) pmax = fmaxf(pmax, p1[r]);
  { auto rr = __builtin_amdgcn_permlane32_swap(__float_as_uint(pmax), __float_as_uint(pmax), false, false);
    pmax = fmaxf(__uint_as_float(rr[0]), __uint_as_float(rr[1])); }
  if (__builtin_expect(__all(pmax - m_reg <= THR), 1)) { mn = m_reg; alpha = 1.f; }
  else { mn = fmaxf(m_reg, pmax); alpha = __builtin_amdgcn_exp2f((m_reg - mn) * C); m_reg = mn; }
  const float mnC = -mn * C;
#pragma unroll
  for (int r = 0; r < 16; ++r) p0[r] = fmaf(p0[r], C, mnC);
#pragma unroll
  for (int r = 0; r < 16; ++r) p1[r] = fmaf(p1[r], C, mnC);
#pragma unroll
  for (int r = 0; r < 16; ++r) p0[r] = __builtin_amdgcn_exp2f(p0[r]);
}
__device__ __forceinline__ void finishSM(f32x16& p0, f32x16& p1, float alpha, float& l_reg, bf16x8& pa0, bf16x8& pa1, bf16x8& pa2, bf16x8& pa3) {
#pragma unroll
  for (int r = 0; r < 16; ++r) p1[r] = __builtin_amdgcn_exp2f(p1[r]);
  float ps = 0;
#pragma unroll
  for (int r = 0; r < 16; ++r) ps += p0[r];
#pragma unroll
  for (int r = 0; r < 16; ++r) ps += p1[r];
  { auto rr = __builtin_amdgcn_permlane32_swap(__float_as_uint(ps), __float_as_uint(ps), false, false);
    ps = __uint_as_float(rr[0]) + __uint_as_float(rr[1]); }
  l_reg = l_reg * alpha + ps;
#define PK4(P, BASE, OUT) do { unsigned a0 = cvtpk(P[BASE + 0], P[BASE + 1]), a1 = cvtpk(P[BASE + 2], P[BASE + 3]);   \
    unsigned b0 = cvtpk(P[BASE + 4], P[BASE + 5]), b1 = cvtpk(P[BASE + 6], P[BASE + 7]);                              \
    auto r0 = __builtin_amdgcn_permlane32_swap(a0, b0, false, false); auto r1 = __builtin_amdgcn_permlane32_swap(a1, b1, false, false); \
    u32x4 w = {r0[0], r1[0], r0[1], r1[1]}; OUT = *reinterpret_cast<bf16x8*>(&w); } while (0)
  PK4(p0, 0, pa0); PK4(p0, 8, pa1); PK4(p1, 0, pa2); PK4(p1, 8, pa3);
#undef PK4
}
__device__ __forceinline__ void qkt(f32x16& p0, f32x16& p1, const char* Ks, const bf16x8* qr, int r32, int hi, int kcol) {
  p0 = f32x16{}; p1 = f32x16{};
#pragma unroll
  for (int d0 = 0; d0 < 4; ++d0) { const int cb = kcol + (d0 * 16 + hi * 8) * 2;
    const bf16x8 b0 = *reinterpret_cast<const bf16x8*>(Ks + KSWZ(r32, cb));
    const bf16x8 b1 = *reinterpret_cast<const bf16x8*>(Ks + KSWZ(32 + r32, cb));
    p0 = __builtin_amdgcn_mfma_f32_32x32x16_bf16(b0, qr[d0], p0, 0, 0, 0);
    p1 = __builtin_amdgcn_mfma_f32_32x32x16_bf16(b1, qr[d0], p1, 0, 0, 0); }
}
__device__ __forceinline__ int v_st(int k, int c) { const int kk = (k & ~0xC) | ((k & 4) << 1) | ((k & 8) >> 1); return ((kk >> 3) * 4 + (c >> 5)) * 512 + ((kk & 7) * 32 + (c & 31)) * 2; }
__device__ __forceinline__ int v_rd_base(int lane) { return ((lane & 3) << 3) | (((lane >> 2) & 3) << 6) | (((lane >> 4) & 1) << 5) | (((lane >> 5) & 1) << 8); }
constexpr int v_rd_off(int d0, int ks, int half) { return d0 * 512 + ks * 4096 + half * 2048; }
template <int OFF> __device__ __forceinline__ s16x4 tr_read(int vb) {
  s16x4 r; asm volatile("ds_read_b64_tr_b16 %0, %1 offset:%2" : "=&v"(r) : "v"(vb), "i"(OFF) : "memory"); return r;
}
template <int D0> __device__ __forceinline__ void pv_one(f32x16& od, int vb, bf16x8 pa0, bf16x8 pa1, bf16x8 pa2, bf16x8 pa3) {
  const s16x4 l0 = tr_read<v_rd_off(D0, 0, 0)>(vb), h0 = tr_read<v_rd_off(D0, 0, 1)>(vb), l1 = tr_read<v_rd_off(D0, 1, 0)>(vb), h1 = tr_read<v_rd_off(D0, 1, 1)>(vb);
  const s16x4 l2 = tr_read<v_rd_off(D0, 2, 0)>(vb), h2 = tr_read<v_rd_off(D0, 2, 1)>(vb), l3 = tr_read<v_rd_off(D0, 3, 0)>(vb), h3 = tr_read<v_rd_off(D0, 3, 1)>(vb);
  asm volatile("s_waitcnt lgkmcnt(0)" ::: "memory"); SBAR();
#define PK(L, H) (bf16x8){L[0], L[1], L[2], L[3], H[0], H[1], H[2], H[3]}
  od = __builtin_amdgcn_mfma_f32_32x32x16_bf16(pa0, PK(l0, h0), od, 0, 0, 0);
  od = __builtin_amdgcn_mfma_f32_32x32x16_bf16(pa1, PK(l1, h1), od, 0, 0, 0);
  od = __builtin_amdgcn_mfma_f32_32x32x16_bf16(pa2, PK(l2, h2), od, 0, 0, 0);
  od = __builtin_amdgcn_mfma_f32_32x32x16_bf16(pa3, PK(l3, h3), od, 0, 0, 0);
#undef PK
}
__device__ __forceinline__ void pv_d0(f32x16* o, int vb, bf16x8 pa0, bf16x8 pa1, bf16x8 pa2, bf16x8 pa3) {
  pv_one<0>(o[0], vb, pa0, pa1, pa2, pa3); pv_one<1>(o[1], vb, pa0, pa1, pa2, pa3); pv_one<2>(o[2], vb, pa0, pa1, pa2, pa3); pv_one<3>(o[3], vb, pa0, pa1, pa2, pa3);
}

template <int VAR>
__device__ __forceinline__ void attn_unit(const bf16_t* __restrict__ Qb, const bf16_t* __restrict__ Kh, const bf16_t* __restrict__ Vh, int nkeys,
                                          bf16_t* __restrict__ Ob, float lam, float osc, const float* __restrict__ sg, char* lds, const int tid) {
  const int wid = __builtin_amdgcn_readfirstlane(tid >> 6), lane = tid & 63, r32 = lane & 31, hi = lane >> 5;
  const int comp = wid >> 2, qw = wid & 3, kcol = comp * 128;
  char* K_lds = lds; char* V_lds = lds + 2 * SHM_K;
  float* ws = (float*)(lds + 2 * SHM_K + 3 * SHM_V) + wid * 64; float* li_l = ws; float* al_l = ws + 32;
  float m_reg = -1e30f, l_reg = 0; f32x16 o[4] = {}; bf16x8 qr[4];
  const bf16_t* Qw = Qb + (long)(qw * QBLK + r32) * LDQ + comp * 64 + hi * 8;
#pragma unroll
  for (int d0 = 0; d0 < 4; ++d0) qr[d0] = *reinterpret_cast<const bf16x8*>(Qw + d0 * 16);
  const int sr = tid >> 4, sc = (tid & 15) * 8, vst0 = v_st(sr, sc), vst1 = v_st(32 + sr, sc);
  const int vb0 = (int)(uintptr_t)V_lds + v_rd_base(lane);
  bf16x8 sk0 = {}, sk1 = {}, sv0 = {}, sv1 = {};
#define LOADK(t) do { if constexpr (!(VAR & 8)) { sk0 = *reinterpret_cast<const bf16x8*>(&Kh[(long)((t) * KVBLK + sr) * LDQ + sc]); sk1 = *reinterpret_cast<const bf16x8*>(&Kh[(long)((t) * KVBLK + 32 + sr) * LDQ + sc]); } } while (0)
#define LOADV(t) do { if constexpr (!(VAR & 8)) { sv0 = *reinterpret_cast<const bf16x8*>(&Vh[(long)((t) * KVBLK + sr) * LDQ + sc]); sv1 = *reinterpret_cast<const bf16x8*>(&Vh[(long)((t) * KVBLK + 32 + sr) * LDQ + sc]); } } while (0)
#define WRITEK(slot) do { if constexpr (!(VAR & 8)) { *(bf16x8*)(K_lds + (slot) * SHM_K + KSWZ(sr, sc * 2)) = sk0; *(bf16x8*)(K_lds + (slot) * SHM_K + KSWZ(32 + sr, sc * 2)) = sk1; } } while (0)
#define WRITEV(off) do { if constexpr (!(VAR & 8)) { *(bf16x8*)(V_lds + (off) + vst0) = sv0; *(bf16x8*)(V_lds + (off) + vst1) = sv1; } } while (0)
#define VMW() asm volatile("s_waitcnt vmcnt(0)" ::: "memory")
#define QKT(P0, P1, KS) do { if constexpr (VAR & 4) { P0 = f32x16{}; P1 = f32x16{}; asm volatile("" : "+v"(P0), "+v"(P1)); } else qkt(P0, P1, KS, qr, r32, hi, kcol); } while (0)
#define PSM(P0, P1, MN, AL) do { if constexpr (VAR & 1) { MN = m_reg; AL = 1.f; asm volatile("" : "+v"(P0), "+v"(P1)); } else partialSM(P0, P1, m_reg, MN, AL); } while (0)
#define FSM(P0, P1, AL) do { if constexpr (VAR & 1) { asm volatile("" : "+v"(P0), "+v"(P1)); pa0 = __builtin_bit_cast(bf16x8, (f32x4){P0[0], P0[1], P0[2], P0[3]}); pa1 = __builtin_bit_cast(bf16x8, (f32x4){P0[4], P0[5], P0[6], P0[7]}); pa2 = __builtin_bit_cast(bf16x8, (f32x4){P1[0], P1[1], P1[2], P1[3]}); pa3 = __builtin_bit_cast(bf16x8, (f32x4){P1[4], P1[5], P1[6], P1[7]}); } else finishSM(P0, P1, AL, l_reg, pa0, pa1, pa2, pa3); } while (0)
#define PV(OFF) do { if constexpr (VAR & 2) { asm volatile("" : "+v"(pa0), "+v"(pa1), "+v"(pa2), "+v"(pa3)); } else pv_d0(o, vb0 + (OFF), pa0, pa1, pa2, pa3); } while (0)
#define RESC(a) do { if (__any((a) < 1.f)) { if (hi == 0) al_l[r32] = (a); asm volatile("s_waitcnt lgkmcnt(0)" ::: "memory"); \
    _Pragma("unroll") for (int d = 0; d < 4; ++d) _Pragma("unroll") for (int r = 0; r < 16; ++r) o[d][r] *= al_l[crow(r, hi)]; } } while (0)
  f32x16 pA0, pA1, pB0, pB1; float mnA, mnB, alA, alB; bf16x8 pa0, pa1, pa2, pa3; const int NT = nkeys / KVBLK;
  LOADK(0); VMW(); WRITEK(0); LOADK(1); LOADV(0);
  __syncthreads();
  if (comp == 1) __syncthreads();
  VMW(); WRITEK(1); WRITEV(0);
  SBAR(); QKT(pA0, pA1, K_lds); SBAR();
  __syncthreads();
  LOADK(2); LOADV(1); SBAR();
  PSM(pA0, pA1, mnA, alA);
  __syncthreads();
  int va = 0, vb = SHM_V, vc = 2 * SHM_V;
  for (int j = 1; j + 1 < NT; j += 2) {
    VMW(); WRITEK(0); WRITEV(vb);
    SBAR(); QKT(pB0, pB1, K_lds + SHM_K);
    FSM(pA0, pA1, alA); SBAR();
    __syncthreads();
    LOADK(j + 2); LOADV(j + 1); SBAR();
    PV(va); PSM(pB0, pB1, mnB, alB);
    RESC(alB);
    __syncthreads();
    VMW(); WRITEK(1); WRITEV(vc);
    SBAR(); QKT(pA0, pA1, K_lds);
    FSM(pB0, pB1, alB); SBAR();
    __syncthreads();
    if (j + 3 < NT) LOADK(j + 3);
    LOADV(j + 2); SBAR();
    PV(vb); PSM(pA0, pA1, mnA, alA);
    RESC(alA);
    __syncthreads();
    { const int t = va; va = vc; vc = vb; vb = t; }
  }
  VMW(); WRITEV(vb);
  SBAR(); QKT(pB0, pB1, K_lds + SHM_K);
  FSM(pA0, pA1, alA); SBAR();
  __syncthreads();
  PV(va); PSM(pB0, pB1, mnB, alB);
  RESC(alB);
  __syncthreads();
  FSM(pB0, pB1, alB); SBAR();
  PV(vb);
  if (comp == 0) __syncthreads();
  if (hi == 0) li_l[r32] = l_reg; asm volatile("s_waitcnt lgkmcnt(0)" ::: "memory");
  float rli[16];
#pragma unroll
  for (int r = 0; r < 16; ++r) rli[r] = __builtin_amdgcn_rcpf(li_l[crow(r, hi)]);
  __syncthreads();
  float* XO = (float*)lds + qw * (32 * 128);
  if (comp == 1) {
#pragma unroll
    for (int r = 0; r < 16; ++r)
#pragma unroll
      for (int d0 = 0; d0 < 4; ++d0) XO[crow(r, hi) * 128 + d0 * 32 + r32] = o[d0][r] * rli[r];
  }
  __syncthreads();
  if (comp == 0) {
    float ss[16];
#pragma unroll
    for (int r = 0; r < 16; ++r) { float s = 0.f;
#pragma unroll
      for (int d0 = 0; d0 < 4; ++d0) { const float v = o[d0][r] * rli[r] - lam * XO[crow(r, hi) * 128 + d0 * 32 + r32]; o[d0][r] = v; s += v * v; }
      ss[r] = s; }
#pragma unroll
    for (int r = 0; r < 16; ++r) { float s = ss[r]; s += swz_xor<1>(s); s += swz_xor<2>(s); s += swz_xor<4>(s); s += swz_xor<8>(s); s += swz_xor<16>(s);
      ss[r] = osc / sqrtf(s * (1.0f / 128.0f) + EPS); }
    float gam[4];
#pragma unroll
    for (int d0 = 0; d0 < 4; ++d0) gam[d0] = sg[d0 * 32 + r32];
    asm volatile("s_waitcnt lgkmcnt(0)" ::: "memory");
    bf16_t* stg = (bf16_t*)XO;
#pragma unroll
    for (int r = 0; r < 16; ++r)
#pragma unroll
      for (int d0 = 0; d0 < 4; ++d0) stg[crow(r, hi) * 128 + d0 * 32 + r32] = (bf16_t)(cvtpk(o[d0][r] * ss[r] * gam[d0], 0.f) & 0xffffu);
    asm volatile("s_waitcnt lgkmcnt(0)" ::: "memory");
#pragma unroll
    for (int i = 0; i < 8; ++i) { const int row = i * 4 + (lane >> 4), ch = lane & 15; const u32x4 v = *(const u32x4*)(stg + row * 128 + ch * 8);
      if constexpr (VAR & 16) { asm volatile("" :: "v"(v.x), "v"(v.y), "v"(v.z), "v"(v.w)); } else *(u32x4*)(Ob + (long)(qw * QBLK + row) * LDO + ch * 8) = v; }
  }
  __syncthreads();
#undef LOADK
#undef LOADV
#undef WRITEK
#undef WRITEV
#undef VMW
#undef QKT
#undef PSM
#undef FSM
#undef PV
#undef RESC
}
#undef KSWZ
#undef SBAR
}
namespace att2 {
using att::crow; using att::v_st; using att::v_rd_base; using att::v_rd_off;
constexpr int NW = 8, QBLK = 32, KVBLK = 64, LDQ = 512, LDO = KCAT, SHM_K = 16384, SHM_V = 16384;
constexpr float THRL = 8.0f;
#ifndef ATT_STAGGER
#define ATT_STAGGER 1
#endif
typedef short v4i16_t __attribute__((ext_vector_type(4)));
typedef __attribute__((address_space(3))) const char* lds_cptr;
typedef __attribute__((address_space(3))) char* lds_ptr;
#define SBAR() __builtin_amdgcn_sched_barrier(0)
#define KSWZ(row, colB) ((row) * 256 + ((colB) ^ (((row) & 7) << 4)))
__device__ __forceinline__ s16x4 vtr(lds_cptr p) { return __builtin_bit_cast(s16x4, __builtin_amdgcn_ds_read_tr16_b64_v4i16((__attribute__((address_space(3))) v4i16_t*)p)); }
__device__ __forceinline__ bf16x8 ldk(lds_cptr p) { return *(const __attribute__((address_space(3))) bf16x8*)p; }
#define MF(D, A, B, C) do { if constexpr (VAR & 4) { asm volatile("" : "+v"(D)); } else D = __builtin_amdgcn_mfma_f32_32x32x16_bf16(A, B, C, 0, 0, 0); } while (0)
#define VF(L, H) (bf16x8){L[0], L[1], L[2], L[3], H[0], H[1], H[2], H[3]}

__device__ __forceinline__ int vkey(int g) { const int s_ = g >> 5, kk = ((s_ >> 2) << 3) | ((g >> 2) & 7); return (kk & ~0xC) | ((kk & 4) << 1) | ((kk & 8) >> 1); }
template <int VAR>
__device__ __forceinline__ void attn_unit(const bf16_t* __restrict__ Qb, const bf16_t* __restrict__ Kh, const bf16_t* __restrict__ Vh, int nkeys,
                                          bf16_t* __restrict__ Ob, float lam, float osc, const float* __restrict__ sg, char* lds, const int tid) {
  const int wid = __builtin_amdgcn_readfirstlane(tid >> 6), lane = tid & 63, r32 = lane & 31, hi = lane >> 5;
  const int comp = wid >> 2, qw = wid & 3, kcol = comp * 128;
  const lds_ptr L3 = (lds_ptr)(unsigned)(uintptr_t)lds;
  float* ws = (float*)(lds + 3 * SHM_K + 3 * SHM_V) + wid * 64; float* li_l = ws; float* al_l = ws + 32;
  float mhat = 0.f, l_reg = 0.f; f32x16 o[4] = {}; bf16x8 qr[4]; f32x16 negm = {};
  const bf16_t* Qw = Qb + (long)(qw * QBLK + r32) * LDQ + comp * 64 + hi * 8;
#pragma unroll
  for (int d0 = 0; d0 < 4; ++d0) qr[d0] = *reinterpret_cast<const bf16x8*>(Qw + d0 * 16);
  const int sr = tid >> 4, sc = (tid & 15) * 8;
  const int kr0 = 4 * wid + (lane >> 4), kr1 = kr0 + 32;
  const bf16_t* ksrc0 = Kh + (long)kr0 * LDQ + (((lane & 15) ^ (kr0 & 7)) << 3); const bf16_t* ksrc1 = Kh + (long)kr1 * LDQ + (((lane & 15) ^ (kr1 & 7)) << 3);
  const int g0_ = 64 * wid + lane, g1_ = g0_ + 512;
  const int vk0 = vkey(g0_), vk1 = vkey(g1_);
  const bf16_t* vsrc0 = Vh + (long)vk0 * LDQ + ((g0_ >> 5) & 3) * 32 + (g0_ & 3) * 8; const bf16_t* vsrc1 = Vh + (long)vk1 * LDQ + ((g1_ >> 5) & 3) * 32 + (g1_ & 3) * 8;
  const unsigned kd0 = (unsigned)(uintptr_t)lds + wid * 1024, kd1 = kd0 + 8192, vd0 = (unsigned)(uintptr_t)lds + 3 * SHM_K + wid * 1024, vd1 = vd0 + 8192;
  lds_cptr kq[4];
#pragma unroll
  for (int d0 = 0; d0 < 4; ++d0) kq[d0] = L3 + r32 * 256 + ((kcol + d0 * 32 + hi * 16) ^ ((r32 & 7) << 4));
  const lds_cptr vp0 = L3 + 3 * SHM_K + v_rd_base(lane);
#define GLDS(src, dst) __builtin_amdgcn_global_load_lds((const unsigned*)(src), (__attribute__((address_space(3))) unsigned*)(dst), 16, 0, 0)
#define DMAK(t, slot) do { if constexpr (!(VAR & 8)) { GLDS(ksrc0 + (long)(t) * KVBLK * LDQ, (unsigned)__builtin_amdgcn_readfirstlane(kd0 + (slot) * SHM_K)); GLDS(ksrc1 + (long)(t) * KVBLK * LDQ, (unsigned)__builtin_amdgcn_readfirstlane(kd1 + (slot) * SHM_K)); } } while (0)
#define DMAV(t, off) do { if constexpr (!(VAR & 8)) { GLDS(vsrc0 + (long)(t) * KVBLK * LDQ, (unsigned)__builtin_amdgcn_readfirstlane(vd0 + (off))); GLDS(vsrc1 + (long)(t) * KVBLK * LDQ, (unsigned)__builtin_amdgcn_readfirstlane(vd1 + (off))); } } while (0)
#ifndef ATT_PRIO
#define ATT_PRIO 1
#endif
#define PRIO(x) do { if (ATT_PRIO == 1) __builtin_amdgcn_s_setprio(x); } while (0)
#define PRIO1(x) do { if (ATT_PRIO == 2) __builtin_amdgcn_s_setprio(x); } while (0)
#define VMW() asm volatile("s_waitcnt vmcnt(0)" ::: "memory")
#define BARW(n) do { asm volatile("s_waitcnt vmcnt(" #n ") lgkmcnt(0)" ::: "memory"); __builtin_amdgcn_s_barrier(); asm volatile("" ::: "memory"); } while (0)
  f32x16 pA0, pA1, pB0, pB1; u32x4 pw0 = {}, pw1 = {}, pw2 = {}, pw3 = {}; const int NT = nkeys / KVBLK; bool resc = false;
#define KF(KOFF, d0, half) ldk(kq[d0] + (KOFF) + 8192 * (half))
#define PKA(P, B, A0, A1) do { if constexpr (!(VAR & 1)) { A0 = cvt2bf(P[B + 0], P[B + 1]); A1 = cvt2bf(P[B + 2], P[B + 3]); sacc += P[B + 0]; sacc += P[B + 1]; sacc += P[B + 2]; sacc += P[B + 3]; } } while (0)
#define PKB(P, B, A0, A1, PW) do { if constexpr (!(VAR & 1)) { const unsigned b0_ = cvt2bf(P[B + 4], P[B + 5]), b1_ = cvt2bf(P[B + 6], P[B + 7]); \
    auto r0_ = __builtin_amdgcn_permlane32_swap(A0, b0_, false, false); auto r1_ = __builtin_amdgcn_permlane32_swap(A1, b1_, false, false); \
    PW = (u32x4){r0_[0], r1_[0], r0_[1], r1_[1]}; sacc += P[B + 4]; sacc += P[B + 5]; sacc += P[B + 6]; sacc += P[B + 7]; } } while (0)
#define H1(C0, C1, P0, P1, KOFF, FIN) do { \
    float sacc = 0.f; unsigned a0_ = 0, a1_ = 0; \
    bf16x8 f0 = KF(KOFF, 0, 0), f1 = KF(KOFF, 0, 1), f2 = KF(KOFF, 1, 0); SBAR(); \
    MF(C0, f0, qr[0], negm); { f0 = KF(KOFF, 1, 1); if (FIN) PKA(P0, 0, a0_, a1_); } SBAR(); \
    MF(C1, f1, qr[0], negm); { f1 = KF(KOFF, 2, 0); if (FIN) PKB(P0, 0, a0_, a1_, pw0); } SBAR(); \
    MF(C0, f2, qr[1], C0);   { f2 = KF(KOFF, 2, 1); if (FIN) PKA(P0, 8, a0_, a1_); } SBAR(); \
    MF(C1, f0, qr[1], C1);   { f0 = KF(KOFF, 3, 0); if (FIN) PKB(P0, 8, a0_, a1_, pw1); } SBAR(); \
    MF(C0, f1, qr[2], C0);   { f1 = KF(KOFF, 3, 1); if (FIN) PKA(P1, 0, a0_, a1_); } SBAR(); \
    MF(C1, f2, qr[2], C1);   { if (FIN) PKB(P1, 0, a0_, a1_, pw2); } SBAR(); \
    MF(C0, f0, qr[3], C0);   { if (FIN) PKA(P1, 8, a0_, a1_); } SBAR(); \
    MF(C1, f1, qr[3], C1);   { if (FIN) PKB(P1, 8, a0_, a1_, pw3); } SBAR(); \
    if (FIN) { auto rr_ = __builtin_amdgcn_permlane32_swap(__float_as_uint(sacc), __float_as_uint(sacc), false, false); l_reg += __uint_as_float(rr_[0]) + __uint_as_float(rr_[1]); } \
  } while (0)
#define VRD(VOFF, ks, d0, LO, HI) do { LO = vtr(vp0 + (VOFF) + v_rd_off(d0, ks, 0)); HI = vtr(vp0 + (VOFF) + v_rd_off(d0, ks, 1)); } while (0)
#define PAF(k) __builtin_bit_cast(bf16x8, pw##k)
#define MX3(a, b, c) ((VAR & 2) ? (a) : fmaxf(fmaxf((a), (b)), (c)))
#define EX(X, i) do { if constexpr (!(VAR & 2)) X[i] = __builtin_amdgcn_exp2f(X[i]); } while (0)
#define PIN2(X, Y) asm volatile("" : "+v"(X), "+v"(Y))
#define H2(C0, C1, VOFF, DOPV, FIRST) do { \
    s16x4 l0, h0, l1, h1, l2, h2; float ma, mb, rm; \
    if (DOPV) { VRD(VOFF, 0, 0, l0, h0); VRD(VOFF, 0, 1, l1, h1); VRD(VOFF, 0, 2, l2, h2); } SBAR(); \
    if (DOPV) { MF(o[0], PAF(0), VF(l0, h0), o[0]); VRD(VOFF, 0, 3, l0, h0); } ma = MX3(C0[0], C0[1], C1[0]); mb = MX3(C0[2], C0[3], C1[1]); ma = MX3(ma, C1[2], C1[3]); mb = MX3(mb, C0[4], C0[5]); SBAR(); \
    if (DOPV) { MF(o[1], PAF(0), VF(l1, h1), o[1]); VRD(VOFF, 1, 0, l1, h1); } ma = MX3(ma, C0[6], C0[7]); mb = MX3(mb, C1[4], C1[5]); ma = MX3(ma, C1[6], C1[7]); mb = MX3(mb, C0[8], C0[9]); SBAR(); \
    if (DOPV) { MF(o[2], PAF(0), VF(l2, h2), o[2]); VRD(VOFF, 1, 1, l2, h2); } ma = MX3(ma, C0[10], C0[11]); mb = MX3(mb, C1[8], C1[9]); ma = MX3(ma, C1[10], C1[11]); mb = MX3(mb, C0[12], C0[13]); SBAR(); \
    if (DOPV) { MF(o[3], PAF(0), VF(l0, h0), o[3]); VRD(VOFF, 1, 2, l0, h0); } ma = MX3(ma, C0[14], C0[15]); mb = MX3(mb, C1[12], C1[13]); ma = MX3(ma, C1[14], C1[15]); rm = fmaxf(ma, mb); SBAR(); \
    if (DOPV) { MF(o[0], PAF(1), VF(l1, h1), o[0]); VRD(VOFF, 1, 3, l1, h1); } \
    { auto rr_ = __builtin_amdgcn_permlane32_swap(__float_as_uint(rm), __float_as_uint(rm), false, false); rm = fmaxf(__uint_as_float(rr_[0]), __uint_as_float(rr_[1])); } SBAR(); \
    resc = false; \
    if (FIRST || __builtin_expect(__any(rm > THRL), 0)) { const float dl = FIRST ? rm : fmaxf(rm, 0.f); mhat += dl; \
      _Pragma("unroll") for (int r = 0; r < 16; ++r) { C0[r] -= dl; C1[r] -= dl; } \
      _Pragma("unroll") for (int r = 0; r < 16; ++r) negm[r] = -mhat; \
      if (!(FIRST)) { const float f = __builtin_amdgcn_exp2f(-dl); l_reg *= f; if (hi == 0) al_l[r32] = f; resc = true; } } \
    SBAR(); \
    if (DOPV) { MF(o[1], PAF(1), VF(l2, h2), o[1]); VRD(VOFF, 2, 0, l2, h2); } EX(C0, 0); EX(C0, 1); EX(C0, 2); PIN2(C0, C1); SBAR(); \
    if (DOPV) { MF(o[2], PAF(1), VF(l0, h0), o[2]); VRD(VOFF, 2, 1, l0, h0); } EX(C0, 3); EX(C0, 4); EX(C0, 5); PIN2(C0, C1); SBAR(); \
    if (DOPV) { MF(o[3], PAF(1), VF(l1, h1), o[3]); VRD(VOFF, 2, 2, l1, h1); } EX(C0, 6); EX(C0, 7); EX(C0, 8); PIN2(C0, C1); SBAR(); \
    if (DOPV) { MF(o[0], PAF(2), VF(l2, h2), o[0]); VRD(VOFF, 2, 3, l2, h2); } EX(C0, 9); EX(C0, 10); EX(C0, 11); PIN2(C0, C1); SBAR(); \
    if (DOPV) { MF(o[1], PAF(2), VF(l0, h0), o[1]); VRD(VOFF, 3, 0, l0, h0); } EX(C0, 12); EX(C0, 13); EX(C0, 14); PIN2(C0, C1); SBAR(); \
    if (DOPV) { MF(o[2], PAF(2), VF(l1, h1), o[2]); VRD(VOFF, 3, 1, l1, h1); } EX(C0, 15); EX(C1, 0); EX(C1, 1); PIN2(C0, C1); SBAR(); \
    if (DOPV) { MF(o[3], PAF(2), VF(l2, h2), o[3]); VRD(VOFF, 3, 2, l2, h2); } EX(C1, 2); EX(C1, 3); EX(C1, 4); PIN2(C0, C1); SBAR(); \
    if (DOPV) { MF(o[0], PAF(3), VF(l0, h0), o[0]); VRD(VOFF, 3, 3, l0, h0); } EX(C1, 5); EX(C1, 6); EX(C1, 7); PIN2(C0, C1); SBAR(); \
    if (DOPV) { MF(o[1], PAF(3), VF(l1, h1), o[1]); } EX(C1, 8); EX(C1, 9); EX(C1, 10); PIN2(C0, C1); SBAR(); \
    if (DOPV) { MF(o[2], PAF(3), VF(l2, h2), o[2]); } EX(C1, 11); EX(C1, 12); EX(C1, 13); PIN2(C0, C1); SBAR(); \
    if (DOPV) { MF(o[3], PAF(3), VF(l0, h0), o[3]); } EX(C1, 14); EX(C1, 15); PIN2(C0, C1); SBAR(); \
    if (resc) { asm volatile("s_waitcnt lgkmcnt(0)" ::: "memory"); \
      _Pragma("unroll") for (int d = 0; d < 4; ++d) _Pragma("unroll") for (int r = 0; r < 16; ++r) o[d][r] *= al_l[crow(r, hi)]; } \
  } while (0)
#define PVONLY(VOFF) do { _Pragma("unroll") for (int ks = 0; ks < 4; ++ks) _Pragma("unroll") for (int d0 = 0; d0 < 4; ++d0) { s16x4 l_, h_; VRD(VOFF, ks, d0, l_, h_); \
      const bf16x8 pa_ = ks == 0 ? PAF(0) : ks == 1 ? PAF(1) : ks == 2 ? PAF(2) : PAF(3); MF(o[d0], pa_, VF(l_, h_), o[d0]); } } while (0)

  DMAK(0, 0); DMAK(1, 1); DMAV(0, 0);
  BARW(0);
  if (ATT_STAGGER && comp == 1) __builtin_amdgcn_s_barrier();
  H1(pA0, pA1, pB0, pB1, 0, false);
  BARW(0);
  DMAK(2, 2); DMAV(1, SHM_V); SBAR();
  H2(pA0, pA1, 0, false, true);
  BARW(4);
  int va = 0, vb = SHM_V, vc = 2 * SHM_V;
  for (int j = 1; j + 1 < NT; j += 2) {
    PRIO1(1); H1(pB0, pB1, pA0, pA1, vb, true); PRIO1(0);
    BARW(0);
    DMAK(j + 2, va >> 14); DMAV(j + 1, vc); SBAR();
    PRIO(1); H2(pB0, pB1, va, true, false); PRIO(0);
    BARW(4);
    PRIO1(1); H1(pA0, pA1, pB0, pB1, vc, true); PRIO1(0);
    BARW(0);
    if (j + 3 < NT) DMAK(j + 3, vb >> 14);
    DMAV(j + 2, va); SBAR();
    PRIO(1); H2(pA0, pA1, vb, true, false); PRIO(0);
    BARW(4);
    { const int t = va; va = vc; vc = vb; vb = t; }
  }
  H1(pB0, pB1, pA0, pA1, vb, true);
  BARW(0);
  H2(pB0, pB1, va, true, false);
  BARW(0);
  { float sacc = 0.f; unsigned a0_ = 0, a1_ = 0;
    PKA(pB0, 0, a0_, a1_); PKB(pB0, 0, a0_, a1_, pw0); PKA(pB0, 8, a0_, a1_); PKB(pB0, 8, a0_, a1_, pw1); PKA(pB1, 0, a0_, a1_); PKB(pB1, 0, a0_, a1_, pw2); PKA(pB1, 8, a0_, a1_); PKB(pB1, 8, a0_, a1_, pw3);
    auto rr_ = __builtin_amdgcn_permlane32_swap(__float_as_uint(sacc), __float_as_uint(sacc), false, false); l_reg += __uint_as_float(rr_[0]) + __uint_as_float(rr_[1]); }
  SBAR(); PVONLY(vb);
  if (ATT_STAGGER && comp == 0) { asm volatile("s_waitcnt lgkmcnt(0)" ::: "memory"); __builtin_amdgcn_s_barrier(); }
  if (hi == 0) li_l[r32] = l_reg; asm volatile("s_waitcnt lgkmcnt(0)" ::: "memory");
  float rli[16];
#pragma unroll
  for (int r = 0; r < 16; ++r) rli[r] = __builtin_amdgcn_rcpf(li_l[crow(r, hi)]);
  __syncthreads();
  float* XO = (float*)lds + qw * (32 * 128);
  if (comp == 1) {
#pragma unroll
    for (int r = 0; r < 16; ++r)
#pragma unroll
      for (int d0 = 0; d0 < 4; ++d0) XO[crow(r, hi) * 128 + d0 * 32 + r32] = o[d0][r] * rli[r];
  }
  __syncthreads();
  if (comp == 0) {
    float ss[16];
#pragma unroll
    for (int r = 0; r < 16; ++r) { float s = 0.f;
#pragma unroll
      for (int d0 = 0; d0 < 4; ++d0) { const float v = o[d0][r] * rli[r] - lam * XO[crow(r, hi) * 128 + d0 * 32 + r32]; o[d0][r] = v; s += v * v; }
      ss[r] = s; }
#pragma unroll
    for (int r = 0; r < 16; ++r) { float s = ss[r]; s += swz_xor<1>(s); s += swz_xor<2>(s); s += swz_xor<4>(s); s += swz_xor<8>(s); s += swz_xor<16>(s);
      ss[r] = osc / sqrtf(s * (1.0f / 128.0f) + EPS); }
    float gam[4];
#pragma unroll
    for (int d0 = 0; d0 < 4; ++d0) gam[d0] = sg[d0 * 32 + r32];
    asm volatile("s_waitcnt lgkmcnt(0)" ::: "memory");
    bf16_t* stg = (bf16_t*)XO;
#pragma unroll
    for (int r = 0; r < 16; ++r)
#pragma unroll
      for (int d0 = 0; d0 < 4; ++d0) stg[crow(r, hi) * 128 + d0 * 32 + r32] = (bf16_t)(cvt2bf(o[d0][r] * ss[r] * gam[d0], 0.f) & 0xffffu);
    asm volatile("s_waitcnt lgkmcnt(0)" ::: "memory");
#pragma unroll
    for (int i = 0; i < 8; ++i) { const int row = i * 4 + (lane >> 4), ch = lane & 15; const u32x4 v = *(const u32x4*)(stg + row * 128 + ch * 8);
      if constexpr (VAR & 16) { asm volatile("" :: "v"(v.x), "v"(v.y), "v"(v.z), "v"(v.w)); } else *(u32x4*)(Ob + (long)(qw * QBLK + row) * LDO + ch * 8) = v; }
  }
  __syncthreads();
#undef GLDS
#undef DMAK
#undef DMAV
#undef VMW
#undef PRIO
#undef PRIO1
#undef BARW
#undef KF
#undef PKA
#undef PKB
#undef H1
#undef VRD
#undef PAF
#undef MX3
#undef EX
#undef PIN2
#undef H2
#undef PVONLY
}
#undef SBAR
#undef KSWZ
#undef MF
#undef VF
}
typedef GAS unsigned gu32;
#define RLX_AGENT __ATOMIC_RELAXED, __HIP_MEMORY_SCOPE_AGENT
constexpr int PT_OFF = LDSCTL_OFF + 1024;
__device__ __forceinline__ unsigned long long ldptr(volatile LAS unsigned long long* PT, int i) {
    const unsigned long long v = PT[i];
    const unsigned lo = __builtin_amdgcn_readfirstlane((unsigned)v), hi = __builtin_amdgcn_readfirstlane((unsigned)(v >> 32));
    return ((unsigned long long)hi << 32) | lo;
}
#define XB_TMO      128
#define XB_XCNT(j)  (256  + 64 * (j))
#define XB_XSUB(j)  (1280 + 64 * (j))
#define XB_XGEN(j)  (2304 + 64 * (j))
#define XB_TOP      3328
#define XB_TOPGEN   3392
#define XCD_BAR_WORDS 3456
#define XB_SPIN_CAP (1u << 18)

__device__ __forceinline__ unsigned xb_ld(unsigned* p)              { return __hip_atomic_load(p, __ATOMIC_RELAXED, __HIP_MEMORY_SCOPE_AGENT); }
__device__ __forceinline__ unsigned xb_add(unsigned* p, unsigned v) { return __hip_atomic_fetch_add(p, v, __ATOMIC_RELAXED, __HIP_MEMORY_SCOPE_AGENT); }
__device__ __forceinline__ unsigned xb_xcc_id() { return (unsigned)__builtin_amdgcn_s_getreg((3 << 11) | 20) & 0xFu; }
#define XB_SPIN(cond, bar) do { unsigned _sp = 0; while (cond) { __builtin_amdgcn_s_sleep(1); \
    if ((++_sp & 255u) == 0u) { if (xb_ld(&(bar)[XB_TMO])) break; if (_sp > XB_SPIN_CAP) { atomicAdd(&(bar)[XB_TMO], 1u); break; } } } } while (0)

struct XcdBarrier {
    unsigned* bar; unsigned x;
    volatile LAS unsigned* st;
};

__device__ __forceinline__ XcdBarrier xcd_barrier_post(unsigned* bar, volatile LAS unsigned* st) {
    XcdBarrier b; b.bar = bar; b.x = xb_xcc_id(); b.st = st;
    if (threadIdx.x == 0) (void)xb_add(&bar[XB_XCNT(b.x)], 1u);
    return b;
}
__device__ __forceinline__ void xcd_barrier_complete(unsigned* bar, unsigned x, unsigned& nloc, unsigned& nx) {
    const unsigned G = gridDim.x * gridDim.y * gridDim.z;
    unsigned sum, cnt, mine, sp = 0u;
    for (;;) {
        sum = 0u; cnt = 0u; mine = 0u;
#pragma unroll
        for (unsigned j = 0; j < 16; ++j) { const unsigned c = xb_ld(&bar[XB_XCNT(j)]); sum += c; cnt += (c > 0u) ? 1u : 0u; mine = (j == x) ? c : mine; }
        if (sum == G) break;
        __builtin_amdgcn_s_sleep(1);
        if ((++sp & 255u) == 0u) { if (xb_ld(&bar[XB_TMO])) break; if (sp > XB_SPIN_CAP) { atomicAdd(&bar[XB_TMO], 1u); break; } }
    }
    nloc = mine > 0u ? mine : 1u; nx = cnt > 0u ? cnt : 1u;
}

__device__ __forceinline__ void xcd_barrier(const XcdBarrier& b) {
    asm volatile("s_waitcnt vmcnt(0)" ::: "memory");
    __syncthreads();
    if (threadIdx.x == 0) {
        unsigned* bar = b.bar;
        __builtin_amdgcn_s_waitcnt(0);
        unsigned nloc = b.st[0], nx = b.st[1];
        if (nloc == 0u) { xcd_barrier_complete(bar, b.x, nloc, nx); b.st[0] = nloc; b.st[1] = nx; }
        const unsigned old = xb_add(&bar[XB_XSUB(b.x)], 1u);
        const unsigned gen = old / nloc;
        if (old + 1u == (gen + 1u) * nloc) {
            __builtin_amdgcn_fence(__ATOMIC_RELEASE, "agent");
            asm volatile("s_waitcnt vmcnt(0)" ::: "memory");
            const unsigned og = xb_add(&bar[XB_TOP], 1u);
            const unsigned tg = og / nx;
            if (og + 1u == (tg + 1u) * nx) xb_add(&bar[XB_TOPGEN], 1u);
            else XB_SPIN(xb_ld(&bar[XB_TOPGEN]) == tg, bar);
            __builtin_amdgcn_fence(__ATOMIC_ACQUIRE, "agent");
            xb_add(&bar[XB_XGEN(b.x)], 1u);
            asm volatile("s_waitcnt vmcnt(0)" ::: "memory");
        } else {
            XB_SPIN(xb_ld(&bar[XB_XGEN(b.x)]) == gen, bar);
            __builtin_amdgcn_fence(__ATOMIC_ACQUIRE, "agent");
            asm volatile("s_waitcnt vmcnt(0)" ::: "memory");
        }
    }
    __syncthreads();
}
__device__ __forceinline__ float wave_sum(float v) {
    v += swz_xor<1>(v); v += swz_xor<2>(v); v += swz_xor<4>(v); v += swz_xor<8>(v); v += swz_xor<16>(v);
    auto rr = __builtin_amdgcn_permlane32_swap(__float_as_uint(v), __float_as_uint(v), false, false);
    return __uint_as_float(rr[0]) + __uint_as_float(rr[1]);
}
__device__ __forceinline__ unsigned pk2(float lo, float hi) { return cvt2bf(lo, hi); }

template <int MAP  >
__device__ __forceinline__ void transpose_item(const float* W, int Nsrc, int coff, bf16_t* WT, int ldw, int koff, int nblk, LAS float* scr, int item, int lane) {
    const int kb = item / nblk, nb = item % nblk, k0 = 64 * kb, n0 = 32 * nb;
    const int nd = n0 + (lane & 31); const int scol = MAP ? in_map(nd) : nd + coff;
    float wv[32];
#pragma unroll
    for (int i = 0; i < 32; ++i) wv[i] = W[(size_t)(k0 + 2 * i + (lane >> 5)) * Nsrc + scol];
#pragma unroll
    for (int i = 0; i < 32; ++i) scr[(2 * i + (lane >> 5)) * 33 + (lane & 31)] = wv[i];
    asm volatile("s_waitcnt lgkmcnt(0)" ::: "memory");
    const int c = lane & 7;
#pragma unroll
    for (int j = 0; j < 4; ++j) { const int n = (lane >> 3) + 8 * j; const LAS float* s = scr + (8 * c) * 33 + n;
        u32x4 o; o.x = pk2(s[0 * 33], s[1 * 33]); o.y = pk2(s[2 * 33], s[3 * 33]); o.z = pk2(s[4 * 33], s[5 * 33]); o.w = pk2(s[6 * 33], s[7 * 33]);
        *(u32x4*)(WT + (size_t)(n0 + n) * ldw + koff + k0 + 8 * c) = o; }
    asm volatile("s_waitcnt lgkmcnt(0)" ::: "memory");
}
struct WSrc { const float *w_in, *wo_f, *wo_a, *wo_c, *wo_p, *w_out, *w_up, *w_down; };
constexpr int IT_A = 16 * 208;
constexpr int IT_B0 = 4 * 32, IT_B1 = 8 * 32, IT_B2 = 4 * 32, IT_B3 = 4 * 32, IT_B4 = 16 * 32, IT_B5 = 16 * 88, IT_B6 = 16 * 88, IT_B7 = 44 * 32;
constexpr int IT_B = IT_B0 + IT_B1 + IT_B2 + IT_B3 + IT_B4 + IT_B5 + IT_B6 + IT_B7;
__device__ __forceinline__ void convert_A(const WSrc& S, unsigned char* ws, LAS float* scr, int gw, int NGW, int lane) {
    for (int it = gw; it < IT_A; it += NGW) transpose_item<1>(S.w_in, NIN, 0, (bf16_t*)(ws + WS_WA), 1024, 0, 208, scr, it, lane);
}
__device__ __forceinline__ void convert_B(const WSrc& S, unsigned char* ws, LAS float* scr, int gw, int NGW, int lane) {
    for (int it = gw; it < IT_B; it += NGW) { int r = it;
        if (r < IT_B0) { transpose_item<0>(S.wo_f, 1024, 0, (bf16_t*)(ws + WS_WCAT), KCAT, 0, 32, scr, r, lane); continue; } r -= IT_B0;
        if (r < IT_B1) { transpose_item<0>(S.wo_a, 1024, 0, (bf16_t*)(ws + WS_WCAT), KCAT, 256, 32, scr, r, lane); continue; } r -= IT_B1;
        if (r < IT_B2) { transpose_item<0>(S.wo_c, 1024, 0, (bf16_t*)(ws + WS_WCAT), KCAT, 768, 32, scr, r, lane); continue; } r -= IT_B2;
        if (r < IT_B3) { transpose_item<0>(S.wo_p, 1024, 0, (bf16_t*)(ws + WS_WCAT), KCAT, 1024, 32, scr, r, lane); continue; } r -= IT_B3;
        if (r < IT_B4) { transpose_item<0>(S.w_out, 1024, 0, (bf16_t*)(ws + WS_WOUT), 1024, 0, 32, scr, r, lane); continue; } r -= IT_B4;
        if (r < IT_B5) { transpose_item<0>(S.w_up, 2 * DFF, DFF, (bf16_t*)(ws + WS_WUPG), 1024, 0, 88, scr, r, lane); continue; } r -= IT_B5;
        if (r < IT_B6) { transpose_item<0>(S.w_up, 2 * DFF, 0, (bf16_t*)(ws + WS_WUPV), 1024, 0, 88, scr, r, lane); continue; } r -= IT_B6;
        transpose_item<0>(S.w_down, 1024, 0, (bf16_t*)(ws + WS_WDN), DFF, 0, 32, scr, r, lane);
    }
}

__device__ __forceinline__ void mod_phase(const float* c, const float* c_ctx, const float* ada_w, const float* ada_b, float* MOD, LAS unsigned char* lds, int vcu, int G, int tid, int wave, int lane) {
    LAS float* sil = (LAS float*)lds;
    LAS float* red = (LAS float*)(lds + 12288);
    for (int i = tid; i < 3072; i += 512) { const float v = i < 2048 ? c[i] : c_ctx[i - 2048]; sil[i] = v * sigm(v); }
    __syncthreads();
    for (int item = vcu; item < 192; item += G) {
        const int l = item / 96, n = (item % 96) * 64 + lane;
        const float* W = ada_w + (size_t)l * 1024 * 6144 + n;
        float a0 = 0.f, a1 = 0.f, a2 = 0.f;
        for (int k = wave * 128; k < wave * 128 + 128; k += 64) { float w[64];
#pragma unroll
            for (int i = 0; i < 64; ++i) w[i] = W[(size_t)(k + i) * 6144];
#pragma unroll
            for (int i = 0; i < 64; ++i) { a0 += sil[k + i] * w[i]; a1 += sil[1024 + k + i] * w[i]; a2 += sil[2048 + k + i] * w[i]; } }
        red[(wave * 3 + 0) * 64 + lane] = a0; red[(wave * 3 + 1) * 64 + lane] = a1; red[(wave * 3 + 2) * 64 + lane] = a2;
        __syncthreads();
        if (wave < 3) { float s = ada_b[l * 6144 + n];
#pragma unroll
            for (int w = 0; w < 8; ++w) s += red[(w * 3 + wave) * 64 + lane];
            MOD[(size_t)(l * 3 + wave) * 6144 + n] = s; }
        __syncthreads();
    }
}
__device__ __forceinline__ void tables_phase(float* ROPE, f32x2* TW, int gt, int NGT) {
    for (int i = gt; i < 192 * 16; i += NGT) { const int pos = i >> 4, f = i & 15; const float inv = powf(10000.0f, -(float)f / 16.0f); const float ang = (float)(pos < 128 ? pos : pos - 128) * inv;
        float s, c; sincosf(ang, &s, &c); ROPE[pos * 32 + f] = c; ROPE[pos * 32 + 16 + f] = s; }
    for (int i = gt; i < 8192; i += NGT) { float s, c; sincospif((float)i * (1.0f / 4096.0f), &s, &c); TW[i] = (f32x2){c, -s}; }
}

template <bool LATBF>
__device__ __forceinline__ void norm_phase(const void* src_lat_, const float* src_ctx, int nrows, const float* gamma, const float* mod, int shoff, int scoff, bf16_t* HX, int gw, int NGW, int lane,
                                           const float* slab = nullptr, int nsl = 0, const float* cgate = nullptr, float* ctx_out = nullptr) {
    for (int m0 = gw; m0 < nrows; m0 += 4 * NGW) {
        f32x4 v[4][4]; float s[4];
#pragma unroll
        for (int u = 0; u < 4; ++u) { const int m = m0 + u * NGW; s[u] = 0.f;
            if (m < nrows) {
                if (LATBF && m < ML) { const u32x2* xb = (const u32x2*)((const bf16_t*)src_lat_ + (size_t)m * DM);
#pragma unroll
                    for (int j = 0; j < 4; ++j) { const u32x2 w = xb[lane + 64 * j]; v[u][j] = (f32x4){__uint_as_float(w.x << 16), __uint_as_float(w.x & 0xffff0000u), __uint_as_float(w.y << 16), __uint_as_float(w.y & 0xffff0000u)}; } }
                else { const float* xr = m < ML ? (const float*)src_lat_ + (size_t)m * DM : src_ctx + (size_t)(m - ML) * DM;
#pragma unroll
                    for (int j = 0; j < 4; ++j) v[u][j] = ((const f32x4*)xr)[lane + 64 * j]; }
                if (slab && m >= ML) {
#pragma unroll
                    for (int j = 0; j < 4; ++j) { f32x4 a = {0.f, 0.f, 0.f, 0.f};
                        for (int sl = 0; sl < nsl; ++sl) a += ((const f32x4*)(slab + (size_t)sl * 512 * 1024 + (size_t)(m - ML) * DM))[lane + 64 * j];
                        v[u][j] += ((const f32x4*)cgate)[lane + 64 * j] * a; ((f32x4*)(ctx_out + (size_t)(m - ML) * DM))[lane + 64 * j] = v[u][j]; } } } }
#pragma unroll
        for (int u = 0; u < 4; ++u) { const int m = m0 + u * NGW; if (m < nrows) {
#pragma unroll
            for (int j = 0; j < 4; ++j) s[u] += (v[u][j].x * v[u][j].x + v[u][j].y * v[u][j].y) + (v[u][j].z * v[u][j].z + v[u][j].w * v[u][j].w);
            const float rstd = 1.0f / sqrtf(wave_sum(s[u]) * (1.0f / DM) + EPS);
            const float* md = mod + (m < SEQ ? 0 : m < ML ? 1 : 2) * 6144;
#pragma unroll
            for (int j = 0; j < 4; ++j) { const int col = 4 * lane + 256 * j;
                const f32x4 g = *(const f32x4*)(gamma + col), sc = *(const f32x4*)(md + scoff + col), sh = *(const f32x4*)(md + shoff + col);
                const f32x4 o = v[u][j] * rstd * g * (sc + 1.0f) + sh;
                u32x2 w; w.x = pk2(o.x, o.y); w.y = pk2(o.z, o.w); *(u32x2*)(HX + (size_t)m * DM + col) = w; } } }
    }
}
__device__ __forceinline__ void final_norm_phase(const bf16_t* xb, float* out, const float* gamma, int gw, int NGW, int lane) {
    for (int m0 = gw; m0 < ML; m0 += 4 * NGW) {
        f32x4 v[4][4];
#pragma unroll
        for (int u = 0; u < 4; ++u) { const int m = m0 + u * NGW; if (m < ML) { const u32x2* xr = (const u32x2*)(xb + (size_t)m * DM);
#pragma unroll
            for (int j = 0; j < 4; ++j) { const u32x2 w = xr[lane + 64 * j]; v[u][j] = (f32x4){__uint_as_float(w.x << 16), __uint_as_float(w.x & 0xffff0000u), __uint_as_float(w.y << 16), __uint_as_float(w.y & 0xffff0000u)}; } } }
#pragma unroll
        for (int u = 0; u < 4; ++u) { const int m = m0 + u * NGW; if (m < ML) { float s = 0.f;
#pragma unroll
            for (int j = 0; j < 4; ++j) s += (v[u][j].x * v[u][j].x + v[u][j].y * v[u][j].y) + (v[u][j].z * v[u][j].z + v[u][j].w * v[u][j].w);
            const float rstd = 1.0f / sqrtf(wave_sum(s) * (1.0f / DM) + EPS);
#pragma unroll
            for (int j = 0; j < 4; ++j) { const f32x4 g = *(const f32x4*)(gamma + 4 * lane + 256 * j); ((f32x4*)(out + (size_t)m * DM))[lane + 64 * j] = v[u][j] * rstd * g; } } }
    }
}

#define SWZ(row, colB) ((row) * 256 + ((colB) ^ (((row) & 7) << 4)))
__device__ __forceinline__ int crow_(int r, int hi) { return (r & 3) + 8 * (r >> 2) + 4 * hi; }
__device__ __forceinline__ bf16x8 pack_bf8(const float* v) { u32x4 w; w.x = pk2(v[0], v[1]); w.y = pk2(v[2], v[3]); w.z = pk2(v[4], v[5]); w.w = pk2(v[6], v[7]); return __builtin_bit_cast(bf16x8, w); }
__device__ __forceinline__ void fft1_phase(const bf16_t* UF, const f32x2* TW, unsigned* FA, LAS unsigned char* lds, int vcu, int G, int tid, int wave, int lane) {
    const int tr = wave >> 1, tc = wave & 1, r32 = lane & 31, hi = lane >> 5;
    bf16x8 aRe[8], aIm[8];
#pragma unroll
    for (int ks = 0; ks < 8; ++ks) { float cv[8], sv[8];
#pragma unroll
        for (int j = 0; j < 8; ++j) { const int idx = ((32 * tr + r32) * (16 * ks + 8 * hi + j)) & 127; float s, c; sincospif((float)idx * (1.0f / 64.0f), &s, &c); cv[j] = c; sv[j] = -s; }
        aRe[ks] = pack_bf8(cv); aIm[ks] = pack_bf8(sv); }
    for (int item = vcu; item < 512; item += G) {
        const int b = item >> 8, g = (item >> 6) & 3, l2 = item & 63;
#pragma unroll
        for (int i = 0; i < 2; ++i) { const int q = tid + 512 * i, l1 = q >> 3, c8 = (q & 7) * 8;
            const u32x4 v = *(const u32x4*)(UF + (size_t)(b * SEQ + 64 * l1 + l2) * 256 + g * 64 + c8);
#pragma unroll
            for (int e = 0; e < 8; ++e) { const unsigned w = v[e >> 1]; *(LAS bf16_t*)(lds + SWZ(c8 + e, l1 * 2)) = (bf16_t)((e & 1) ? (w >> 16) : (w & 0xffffu)); } }
        __syncthreads();
        f32x16 re = {}, im = {};
#pragma unroll
        for (int ks = 0; ks < 8; ++ks) { const bf16x8 bx = *(const LAS bf16x8*)(lds + SWZ(32 * tc + r32, (16 * ks + 8 * hi) * 2));
            re = __builtin_amdgcn_mfma_f32_32x32x16_bf16(aRe[ks], bx, re, 0, 0, 0); im = __builtin_amdgcn_mfma_f32_32x32x16_bf16(aIm[ks], bx, im, 0, 0, 0); }
        unsigned* dst = FA + ((size_t)((b * 4 + g) * 64 + l2) * 128) * 64 + 32 * tc + r32;
#pragma unroll
        for (int r = 0; r < 16; ++r) { const int k1 = 32 * tr + crow_(r, hi); const f32x2 t = TW[k1 * l2];
            dst[(size_t)k1 * 64] = pk2(re[r] * t.x - im[r] * t.y, re[r] * t.y + im[r] * t.x); }
        __syncthreads();
    }
}
__device__ __forceinline__ void fft2_phase(const unsigned* FA, bf16_t* ACAT, LAS unsigned char* lds, int vcu, int G, int tid, int wave, int lane) {
    const int tr = wave >> 1, tc = wave & 1, r32 = lane & 31, hi = lane >> 5;
    bf16x8 a2[8], b3[8];
#pragma unroll
    for (int ks = 0; ks < 8; ++ks) { float av[8], bv[8];
#pragma unroll
        for (int j = 0; j < 8; ++j) { const int R = 32 * tr + r32, k = 16 * ks + 8 * hi + j, k2 = R & 63, ll = k & 63; float s, c; sincospif((float)((k2 * ll) & 63) * (1.0f / 32.0f), &s, &c);
            av[j] = (R < 64) ? ((k < 64) ? c : s) : ((k < 64) ? -s : c);
            const int m = 32 * tc + r32; float s2, c2; sincospif((float)((m * ll) & 63) * (1.0f / 32.0f), &s2, &c2); bv[j] = (k < 64) ? c2 : s2; }
        a2[ks] = pack_bf8(av); b3[ks] = pack_bf8(bv); }
    LAS unsigned char* Bt = lds;
    LAS unsigned char* Zt = lds + 16384;
    for (int item = vcu; item < 1024; item += G) {
        const int b = item >> 9, g = (item >> 7) & 3, k1 = item & 127;
#pragma unroll
        for (int i = 0; i < 2; ++i) { const int q = tid + 512 * i, l2 = q >> 4, c4 = (q & 15) * 4;
            const u32x4 v = *(const u32x4*)(FA + ((size_t)((b * 4 + g) * 64 + l2) * 128 + k1) * 64 + c4);
#pragma unroll
            for (int e = 0; e < 4; ++e) { *(LAS bf16_t*)(Bt + SWZ(c4 + e, l2 * 2)) = (bf16_t)(v[e] & 0xffffu); *(LAS bf16_t*)(Bt + SWZ(c4 + e, (64 + l2) * 2)) = (bf16_t)(v[e] >> 16); } }
        __syncthreads();
        f32x16 z = {};
#pragma unroll
        for (int ks = 0; ks < 8; ++ks) { const bf16x8 bx = *(const LAS bf16x8*)(Bt + SWZ(32 * tc + r32, (16 * ks + 8 * hi) * 2)); z = __builtin_amdgcn_mfma_f32_32x32x16_bf16(a2[ks], bx, z, 0, 0, 0); }
#pragma unroll
        for (int r = 0; r < 16; ++r) { const int R = 32 * tr + crow_(r, hi); *(LAS bf16_t*)(Zt + SWZ(R & 63, ((R >> 6) * 64 + 32 * tc + r32) * 2)) = (bf16_t)(pk2(z[r], 0.f) & 0xffffu); }
        __syncthreads();
        if (wave < 4) { f32x16 y = {};
#pragma unroll
            for (int ks = 0; ks < 8; ++ks) { const bf16x8 ax = *(const LAS bf16x8*)(Zt + SWZ(32 * tr + r32, (16 * ks + 8 * hi) * 2)); y = __builtin_amdgcn_mfma_f32_32x32x16_bf16(ax, b3[ks], y, 0, 0, 0); }
#pragma unroll
            for (int r = 0; r < 16; ++r) { const int k2 = 32 * tr + crow_(r, hi); ACAT[(size_t)(b * SEQ + k1 + 128 * k2) * KCAT + g * 64 + 32 * tc + r32] = (bf16_t)(pk2(y[r] * 0.001381067932f, 0.f) & 0xffffu); } }
        __syncthreads();
    }
}
__device__ __forceinline__ void ctxdft_item(int item, const bf16_t* UF, bf16_t* ACAT, LAS unsigned char* lds, int tid, int wave, int lane) {
    const int b = item >> 4, g = (item >> 2) & 3, kc = item & 3;
    const int tr = wave >> 1, tc = wave & 1, r32 = lane & 31, hi = lane >> 5;
    LAS unsigned char* Xt = lds;
    LAS unsigned char* Zt = lds + 32768;
#pragma unroll
    for (int i = 0; i < 4; ++i) { const int q = tid + 512 * i, l = q >> 3, c8 = (q & 7) * 8;
        const u32x4 v = *(const u32x4*)(UF + (size_t)(ML + b * CTXL + l) * 256 + g * 64 + c8);
#pragma unroll
        for (int e = 0; e < 8; ++e) { const unsigned w = v[e >> 1]; const int row = c8 + e; *(LAS bf16_t*)(Xt + row * 512 + ((((l >> 3) ^ (row & 7)) << 4) | ((l & 7) * 2))) = (bf16_t)((e & 1) ? (w >> 16) : (w & 0xffffu)); } }
    __syncthreads();
    f32x16 z = {};
    const int R = 32 * tr + r32, kk = 64 * kc + (R & 63);
#pragma unroll 4
    for (int ks = 0; ks < 16; ++ks) { float av[8];
#pragma unroll
        for (int j = 0; j < 8; ++j) { const int l = 16 * ks + 8 * hi + j; float s, c; sincospif((float)((kk * l) & 255) * (1.0f / 128.0f), &s, &c); av[j] = (R < 64) ? c : -s; }
        const int row = 32 * tc + r32, ch = (16 * ks + 8 * hi) >> 3;
        const bf16x8 bx = *(const LAS bf16x8*)(Xt + row * 512 + ((ch ^ (row & 7)) << 4));
        z = __builtin_amdgcn_mfma_f32_32x32x16_bf16(pack_bf8(av), bx, z, 0, 0, 0); }
#pragma unroll
    for (int r = 0; r < 16; ++r) { const int Rr = 32 * tr + crow_(r, hi); *(LAS bf16_t*)(Zt + SWZ(Rr & 63, ((Rr >> 6) * 64 + 32 * tc + r32) * 2)) = (bf16_t)(pk2(z[r], 0.f) & 0xffffu); }
    __syncthreads();
    if (wave < 4) { f32x16 y = {};
#pragma unroll
        for (int ks = 0; ks < 8; ++ks) { float bv[8];
#pragma unroll
            for (int j = 0; j < 8; ++j) { const int k = 16 * ks + 8 * hi + j, m = 32 * tc + r32; float s2, c2; sincospif((float)((m * (k & 63)) & 63) * (1.0f / 32.0f), &s2, &c2); bv[j] = (k < 64) ? c2 : s2; }
            const bf16x8 ax = *(const LAS bf16x8*)(Zt + SWZ(32 * tr + r32, (16 * ks + 8 * hi) * 2)); y = __builtin_amdgcn_mfma_f32_32x32x16_bf16(ax, pack_bf8(bv), y, 0, 0, 0); }
#pragma unroll
        for (int r = 0; r < 16; ++r) { const int k = 64 * kc + 32 * tr + crow_(r, hi); ACAT[(size_t)(ML + b * CTXL + k) * KCAT + g * 64 + 32 * tc + r32] = (bf16_t)(pk2(y[r] * (1.0f / 128.0f), 0.f) & 0xffffu); } }
    __syncthreads();
}

__device__ __forceinline__ void conv_item(int item, const bf16_t* ZG, const float* cw  , const float* cb, const float* lng, const float* lnb, bf16_t* ACAT, LAS unsigned char* lds, int tid, int wave, int lane) {
    const int row0 = item * 64; const bool lat = row0 < ML; const int s0 = lat ? (row0 & ~(SEQ - 1)) : (ML + ((row0 - ML) & ~(CTXL - 1))), s1 = s0 + (lat ? SEQ : CTXL);
    LAS float* zt = (LAS float*)lds;
#pragma unroll
    for (int i = 0; i < 6; ++i) { const int q = tid + 512 * i; if (q < 94 * 32) { const int rr = q >> 5, c8 = (q & 31) * 8, gr = row0 - 15 + rr;
        u32x4 v = {0u, 0u, 0u, 0u}; if (gr >= s0 && gr < s1) v = *(const u32x4*)(ZG + (size_t)gr * 256 + c8);
        *(LAS f32x4*)(zt + rr * 256 + c8) = (f32x4){bf2f(v.x & 0xffffu), __uint_as_float(v.x & 0xffff0000u), bf2f(v.y & 0xffffu), __uint_as_float(v.y & 0xffff0000u)};
        *(LAS f32x4*)(zt + rr * 256 + c8 + 4) = (f32x4){bf2f(v.z & 0xffffu), __uint_as_float(v.z & 0xffff0000u), bf2f(v.w & 0xffffu), __uint_as_float(v.w & 0xffff0000u)}; } }
    const int c = tid & 255, half = tid >> 8;
    float w[31];
#pragma unroll
    for (int t = 0; t < 31; ++t) w[t] = cw[t * 256 + c];
    float acc[32]; const float bias = cb[c];
    __syncthreads();
#pragma unroll
    for (int r0 = 0; r0 < 32; r0 += 4) { float v[34];
#pragma unroll
        for (int i = 0; i < 34; ++i) v[i] = zt[(half * 32 + r0 + i) * 256 + c];
        float a0 = bias, a1 = bias, a2 = bias, a3 = bias;
#pragma unroll
        for (int t = 0; t < 31; ++t) { a0 += w[t] * v[t]; a1 += w[t] * v[t + 1]; a2 += w[t] * v[t + 2]; a3 += w[t] * v[t + 3]; }
        acc[r0] = a0; acc[r0 + 1] = a1; acc[r0 + 2] = a2; acc[r0 + 3] = a3; }
    __syncthreads();
#pragma unroll
    for (int r = 0; r < 32; ++r) zt[(half * 32 + r) * 256 + c] = acc[r];
    __syncthreads();
    const f32x4 gg = *(const f32x4*)(lng + 4 * lane), bb = *(const f32x4*)(lnb + 4 * lane);
#pragma unroll
    for (int i = 0; i < 8; ++i) { const int r = wave * 8 + i; const f32x4 v = *(const LAS f32x4*)(zt + r * 256 + 4 * lane);
        const float mu = wave_sum((v.x + v.y) + (v.z + v.w)) * (1.0f / 256.0f); const f32x4 d = v - mu;
        const float var = wave_sum((d.x * d.x + d.y * d.y) + (d.z * d.z + d.w * d.w)) * (1.0f / 256.0f); const float rs = 1.0f / sqrtf(var + EPS);
        f32x4 o = d * rs * gg + bb; o.x *= sigm(o.x); o.y *= sigm(o.y); o.z *= sigm(o.z); o.w *= sigm(o.w);
        u32x2 pw; pw.x = pk2(o.x, o.y); pw.y = pk2(o.z, o.w); *(u32x2*)(ACAT + (size_t)(row0 + r) * KCAT + 768 + 4 * lane) = pw; }
    __syncthreads();
}
__device__ __forceinline__ void pool_phase(const bf16_t* UP, const float* pw  , const float* psc, bf16_t* ACAT, int nitems, int first, LAS unsigned char* lds, int G, int tid, int wave, int lane) {
    const int g = wave >> 1, tc = wave & 1, r32 = lane & 31, hi = lane >> 5;
    bf16x8 bw[4];
#pragma unroll
    for (int ks = 0; ks < 4; ++ks) { float v[8];
#pragma unroll
        for (int j = 0; j < 8; ++j) v[j] = pw[g * 4096 + (16 * ks + 8 * hi + j) * 64 + 32 * tc + r32];
        bw[ks] = pack_bf8(v); }
    const float osc = psc[g * 64 + 32 * tc + r32];
    LAS float* ut = (LAS float*)lds;
    LAS unsigned char* dt = lds + 81920;
    for (int item = first; item < nitems; item += G) {
        const int row0 = item * 64; const bool lat = row0 < ML; const int s0 = lat ? (row0 & ~(SEQ - 1)) : (ML + ((row0 - ML) & ~(CTXL - 1))), L = lat ? SEQ : CTXL, s1 = s0 + L;
#pragma unroll
        for (int i = 0; i < 5; ++i) { const int q = tid + 512 * i, rr = q >> 5, c8 = (q & 31) * 8, gr = row0 - 8 + rr;
            u32x4 v = {0u, 0u, 0u, 0u}; if (gr >= s0 && gr < s1) v = *(const u32x4*)(UP + (size_t)gr * 256 + c8);
            *(LAS f32x4*)(ut + rr * 256 + c8) = (f32x4){bf2f(v.x & 0xffffu), __uint_as_float(v.x & 0xffff0000u), bf2f(v.y & 0xffffu), __uint_as_float(v.y & 0xffff0000u)};
            *(LAS f32x4*)(ut + rr * 256 + c8 + 4) = (f32x4){bf2f(v.z & 0xffffu), __uint_as_float(v.z & 0xffff0000u), bf2f(v.w & 0xffffu), __uint_as_float(v.w & 0xffff0000u)}; }
        __syncthreads();
#pragma unroll
        for (int i = 0; i < 4; ++i) { const int q = tid + 512 * i, lr = q >> 5, c8 = (q & 31) * 8, gg = c8 >> 6, hw = 1 << gg, tt = row0 + lr - s0;
            f32x4 sa = {0.f, 0.f, 0.f, 0.f}, sb = {0.f, 0.f, 0.f, 0.f};
            for (int o = -hw; o < hw; ++o) { sa += *(const LAS f32x4*)(ut + (lr + 8 + o) * 256 + c8); sb += *(const LAS f32x4*)(ut + (lr + 8 + o) * 256 + c8 + 4); }
            const int lo = tt - hw < 0 ? 0 : tt - hw, hh = tt + hw - 1 > L - 1 ? L - 1 : tt + hw - 1; const float inv = 1.0f / (float)(hh - lo + 1);
            const f32x4 ua = *(const LAS f32x4*)(ut + (lr + 8) * 256 + c8), ub = *(const LAS f32x4*)(ut + (lr + 8) * 256 + c8 + 4);
            const f32x4 da = sa * inv - ua, db = sb * inv - ub;
            u32x4 w; w.x = pk2(da.x, da.y); w.y = pk2(da.z, da.w); w.z = pk2(db.x, db.y); w.w = pk2(db.z, db.w);
            *(LAS u32x4*)(dt + lr * 512 + ((((c8 >> 3) ^ (lr & 7)) << 4))) = w; }
        __syncthreads();
#pragma unroll
        for (int rt = 0; rt < 2; ++rt) { f32x16 y = {};
#pragma unroll
            for (int ks = 0; ks < 4; ++ks) { const int row = 32 * rt + r32, ch = (g * 64 + 16 * ks + 8 * hi) >> 3;
                const bf16x8 ax = *(const LAS bf16x8*)(dt + row * 512 + ((ch ^ (row & 7)) << 4)); y = __builtin_amdgcn_mfma_f32_32x32x16_bf16(ax, bw[ks], y, 0, 0, 0); }
#pragma unroll
            for (int r = 0; r < 16; ++r) ACAT[(size_t)(row0 + 32 * rt + crow_(r, hi)) * KCAT + 1024 + g * 64 + 32 * tc + r32] = (bf16_t)(pk2(y[r] * osc, 0.f) & 0xffffu); }
        __syncthreads();
    }
}

__device__ __forceinline__ void ctx_gate_combine(const float* slab, const unsigned char* Gc  , bf16_t* Yc, int gw, int NGW, int lane) {
    for (int r = gw; r < MC; r += NGW) {
#pragma unroll
        for (int j = 0; j < 4; ++j) { const int col = 4 * lane + 256 * j; f32x4 y = {0.f, 0.f, 0.f, 0.f};
#pragma unroll
            for (int sl = 0; sl < 5; ++sl) { const int b = sl == 0 ? 0 : sl <= 2 ? 1 : sl - 1;
                const f32x4 p = *(const f32x4*)(slab + (size_t)sl * 512 * 1024 + (size_t)r * 1024 + col); const unsigned q = *(const unsigned*)(Gc + (size_t)r * 4096 + b * 1024 + col);
                y[0] += p[0] * (float)(q & 255u); y[1] += p[1] * (float)((q >> 8) & 255u); y[2] += p[2] * (float)((q >> 16) & 255u); y[3] += p[3] * (float)(q >> 24); }
            y = y * (1.0f / 255.0f);
            u32x2 w; w.x = pk2(y[0], y[1]); w.y = pk2(y[2], y[3]); *(u32x2*)(Yc + (size_t)r * 1024 + col) = w; }
    }
}
constexpr int NPHASE = 22;
struct Args { const float* in[30]; float* out; unsigned char* ws; int ph_lo, ph_hi, li, pad; };
__global__ void __launch_bounds__(512, 2) __attribute__((amdgpu_waves_per_eu(2, 2))) fwd_kernel(Args args) {
    extern __shared__ __attribute__((aligned(16))) unsigned char lds[];
    LAS unsigned char* L = (LAS unsigned char*)lds;
    volatile LAS unsigned* MISC = (volatile LAS unsigned*)(L + MISC_OFF);
    const int tid0 = threadIdx.x; const int wave0 = __builtin_amdgcn_readfirstlane(tid0 >> 6);
    const int G = gridDim.x, bx0 = blockIdx.x, vcu0 = (G % 8 == 0) ? (bx0 % 8) * (G / 8) + bx0 / 8 : bx0;
    const int NGW = G * 8;
    gu32* ctl = (gu32*)(args.ws + WS_CTL);
    for (int u = tid0; u < (LDS_BYTES - LDSCTL_OFF) / 4; u += 512) ((LAS unsigned*)(L + LDSCTL_OFF))[u] = 0u;
    __syncthreads();
    volatile LAS unsigned long long* PT = (volatile LAS unsigned long long*)(L + PT_OFF);
    if (tid0 < 32) PT[tid0] = ((const __attribute__((address_space(4))) unsigned long long*)__builtin_amdgcn_kernarg_segment_ptr())[tid0];
    __syncthreads();
#define FRESH() int tid, vcu = vcu0, bx = bx0; asm volatile("v_mbcnt_lo_u32_b32 %0, -1, 0\n\tv_mbcnt_hi_u32_b32 %0, -1, %0" : "=v"(tid)); tid += wave0 * 64; asm volatile("" : "+v"(tid), "+s"(vcu), "+s"(bx)); const int lane = tid & 63, wave = __builtin_amdgcn_readfirstlane(tid >> 6), gw = vcu * 8 + wave; (void)lane; (void)gw; (void)bx; \
    LAS float* scr = (LAS float*)(L + wave * 16384); (void)scr;
#define PTR(i) ((const float*)(const GAS float*)ldptr(PT, (i)))
#define OUTP ((float*)(GAS float*)ldptr(PT, 30))
#define WSP ((unsigned char*)(GAS unsigned char*)ldptr(PT, 31))
    XcdBarrier bar; bar.bar = (unsigned*)(ctl + CW_BAR) + args.li * XCD_BAR_WORDS; bar.x = 0; bar.st = nullptr;
    if (MK_N_LAUNCHES != NPHASE) bar = xcd_barrier_post((unsigned*)(ctl + CW_BAR) + args.li * XCD_BAR_WORDS, MISC + 8);
#define GRID_BAR() do { if (MK_N_LAUNCHES == NPHASE) { if (tid0 == 0) __hip_atomic_store(ctl + CW_TMO, 0xBADBA0u, RLX_AGENT); } else { xcd_barrier(bar); } } while (0)
    const int lo = args.ph_lo, hi = args.ph_hi;
#ifndef PHASE_MASK
#define PHASE_MASK 0xFFF
#endif
#ifndef ATTM
#define ATTM 3
#endif
#ifndef X1REP
#define X1REP 0
#endif
#ifndef X1M
#define X1M 31
#endif
#define PH_EN(kind) ((PHASE_MASK >> (kind)) & 1)
#ifndef REP_MASK
#define REP_MASK 0
#endif
#define NREP(kind) (((REP_MASK >> (kind)) & 1) ? 2 : 1)
#define IN(k) (lo <= (k) && (k) < hi)
#define BOTH(k) (IN(k) && IN((k) + 1))
#define WSRC(S, l) WSrc S; S.w_in = PTR(8) + (size_t)(l) * 1024 * NIN; S.wo_f = PTR(20) + (size_t)(l) * 256 * 1024; S.wo_a = PTR(21) + (size_t)(l) * 512 * 1024; \
    S.wo_c = PTR(22) + (size_t)(l) * 256 * 1024; S.wo_p = PTR(23) + (size_t)(l) * 256 * 1024; S.w_out = PTR(24) + (size_t)(l) * 1024 * 1024; \
    S.w_up = PTR(25) + (size_t)(l) * 1024 * 2 * DFF; S.w_down = PTR(28) + (size_t)(l) * DFF * 1024;
#define ws WSP
#define MOD ((float*)(WSP + WS_MOD))
#define ROPE ((float*)(WSP + WS_ROPE))
#define TW ((f32x2*)(WSP + WS_TW))
#define XC ((float*)(WSP + WS_XC))
#define HX ((bf16_t*)(WSP + WS_HX))
#define FA ((f32x2*)(WSP + WS_FA))
#define Qb ((bf16_t*)(WSP + WS_Q))
#define Kb ((bf16_t*)(WSP + WS_K))
#define Vb ((bf16_t*)(WSP + WS_V))
#define Yb ((bf16_t*)(WSP + WS_Y))
#define Gb (WSP + WS_G)
#define ACAT ((bf16_t*)(WSP + WS_ACAT))
#define UF ((bf16_t*)(WSP + WS_UF))
#define ZG ((bf16_t*)(WSP + WS_ZG))
#define UP ((bf16_t*)(WSP + WS_UP))
#define GT ((bf16_t*)(WSP + WS_GT))
#define Hb ((bf16_t*)(WSP + WS_H))

    for (int rep = 0; rep < NREP(0); ++rep) if (PH_EN(0) && IN(0)) { FRESH();
        mod_phase(PTR(1), PTR(3), PTR(6), PTR(7), MOD, L, vcu, G, tid, wave, lane);
        tables_phase(ROPE, TW, vcu * 512 + tid, G * 512);
        for (int i = vcu * 512 + tid; i < MC * DM / 4; i += G * 512) ((f32x4*)XC)[i] = ((const f32x4*)PTR(2))[i];
        WSRC(S0, 0); convert_A(S0, ws, scr, gw, NGW, lane); convert_B(S0, ws, scr, gw, NGW, lane);
        if (BOTH(0)) GRID_BAR();
    }
#pragma nounroll
    for (int l = 0; l < 2; ++l) {
        const int pb = 1 + 10 * l;
#define mod (MOD + l * 3 * 6144)
#define XBF ((bf16_t*)OUTP)
#define xc ((l == 0) ? PTR(2) : (const float*)XC)
        const int Mact = (l == 0) ? MT : ML;
        for (int rep = 0; rep < NREP(1); ++rep) if (PH_EN(1) && IN(pb)) { FRESH(); if (l == 0) norm_phase<false>(PTR(0), xc, MT, PTR(4) + l * DM, mod, 0, 1024, HX, gw, NGW, lane);
            else norm_phase<true>(XBF, xc, MT, PTR(4) + l * DM, mod, 0, 1024, HX, gw, NGW, lane, (const float*)Gb, 11, MOD + 2 * 6144 + 5120, XC);
            if (BOTH(pb)) GRID_BAR(); }
        for (int rep = 0; rep < NREP(2); ++rep) if (PH_EN(2) && IN(pb + 1)) { FRESH();
            pg8::Gemm g{HX, (const bf16_t*)(ws + WS_WA), MT, NIN, 1024}; pg8::StaticOrder S; S.init(MT, NIN, G, bx);
            pg8::EpiIn E{UF, ZG, UP, Qb, Kb, Vb, Gb, ROPE};
            pg8::gemm_phase<pg8::EpiIn, pg8::StaticOrder, true, true>(L, g, S, E, tid);
            if (BOTH(pb + 1)) GRID_BAR();
        }
        for (int rep = 0; rep < NREP(3); ++rep) if (PH_EN(3) && IN(pb + 2)) { FRESH();
            for (int r1 = 0; r1 < ((X1REP & 1) ? 2 : 1); ++r1) if (X1M & 1) fft1_phase(UF, TW, (unsigned*)FA, L, vcu, G, tid, wave, lane);
            for (int r1 = 0; r1 < ((X1REP & 2) ? 2 : 1); ++r1) if (X1M & 2) for (int it = vcu; it < Mact / 64; it += G) conv_item(it, ZG, PTR(14) + l * 31 * 256, PTR(15) + l * 256, PTR(16) + l * 256, PTR(17) + l * 256, ACAT, L, tid, wave, lane);
            for (int r1 = 0; r1 < ((X1REP & 4) ? 2 : 1); ++r1) if (X1M & 4) pool_phase(UP, PTR(18) + l * 4 * 4096, PTR(19) + l * 256, ACAT, Mact / 64, (vcu + 248) % G, L, G, tid, wave, lane);
            if ((X1M & 8) && l == 0) for (int it = (vcu + 224) % G; it < 32; it += G) ctxdft_item(it, UF, ACAT, L, tid, wave, lane);
            if (l == 0) {
                const float lam_init = 0.2f;
                const float d1 = wave_sum(PTR(9)[lane] * PTR(10)[lane]), d2 = wave_sum(PTR(11)[lane] * PTR(12)[lane]);
                const float lam = __builtin_bit_cast(float, __builtin_amdgcn_readfirstlane(__builtin_bit_cast(int, expf(d1) - expf(d2) + lam_init)));
                for (int v = (vcu + 200) % G; v < 16; v += G) { const int b = v >> 3, h = (v >> 1) & 3, row0 = ML + b * CTXL + (v & 1) * 128;
                    att2::attn_unit<0>(Qb + (size_t)row0 * 512 + h * 128, Kb + (size_t)b * KVL * 512 + h * 128, Vb + (size_t)b * KVL * 512 + h * 128, CTXL,
                                       ACAT + (size_t)row0 * KCAT + 256 + h * 128, lam, 1.0f - lam_init, PTR(13), (char*)lds, tid); }
            }
            if (BOTH(pb + 2)) GRID_BAR();
        }
        for (int rep = 0; rep < NREP(4); ++rep) if (PH_EN(4) && IN(pb + 3)) { FRESH();
            { WSRC(S1, 1);
              if (l == 0) convert_A(S1, ws, scr, gw, NGW, lane); else convert_B(S1, ws, scr, gw, NGW, lane); }
            if (ATTM & 1) fft2_phase((const unsigned*)FA, ACAT, L, vcu, G, tid, wave, lane);
            const float lam_init = (l == 0) ? 0.2f : 0.35550906759096926f;
            const float d1 = wave_sum(PTR(9)[l * 64 + lane] * PTR(10)[l * 64 + lane]), d2 = wave_sum(PTR(11)[l * 64 + lane] * PTR(12)[l * 64 + lane]);
            const float lam = __builtin_bit_cast(float, __builtin_amdgcn_readfirstlane(__builtin_bit_cast(int, expf(d1) - expf(d2) + lam_init)));
            const int nun = 512;
            if (ATTM & 2) for (int u = vcu; u < nun; u += G) {
                int b, h, row0, nkeys;
                if (u < 512) { const int x = (u & 255) >> 5, qb = (u & 31) + 32 * (u >> 8); b = x >> 2; h = x & 3; row0 = b * SEQ + qb * 128; nkeys = KVL; }
                else { const int v = u - 512; b = v >> 3; h = (v >> 1) & 3; row0 = ML + b * CTXL + (v & 1) * 128; nkeys = CTXL; }
#if ATT_V == 2
                att2::attn_unit<0>(Qb + (size_t)row0 * 512 + h * 128,
#else
                att::attn_unit<0>(Qb + (size_t)row0 * 512 + h * 128,
#endif
                               Kb + (size_t)b * KVL * 512 + h * 128, Vb + (size_t)b * KVL * 512 + h * 128, nkeys,
                               ACAT + (size_t)row0 * KCAT + 256 + h * 128, lam, 1.0f - lam_init, PTR(13) + l * 128, (char*)lds, tid);
            }
            if (l == 0) {
                pg8::Gemm gc{ACAT + (size_t)ML * KCAT, (const bf16_t*)(ws + WS_WCAT), MC, 1024, 256, KCAT}; pg8::BranchSliceOrder Sc{G, bx};
                pg8::EpiSlab Ec{(float*)UF};
                pg8::gemm_phase<pg8::EpiSlab, pg8::BranchSliceOrder, true, true>(L, gc, Sc, Ec, tid);
            }
#if defined(ATT_PROBE)
            int tid2 = tid, vcu2 = vcu; asm volatile("" : "+v"(tid2), "+s"(vcu2));
            for (int u = vcu2; u < 512; u += G) {
                const int x = (u & 255) >> 5, qb = (u & 31) + 32 * (u >> 8), b = x >> 2, h = x & 3, row0 = b * SEQ + qb * 128;
                att2::attn_unit<ATT_PROBE>(Qb + (size_t)row0 * 512 + h * 128, Kb + (size_t)b * KVL * 512 + h * 128, Vb + (size_t)b * KVL * 512 + h * 128, KVL,
                               Hb + (size_t)row0 * KCAT + 256 + h * 128, lam, 1.0f - lam_init, PTR(13) + l * 128, (char*)lds, tid2);
            }
#endif
            if (BOTH(pb + 3)) GRID_BAR();
        }
        for (int rep = 0; rep < NREP(5); ++rep) if (PH_EN(5) && IN(pb + 4)) { FRESH();
            if (l == 0) ctx_gate_combine((const float*)UF, Gb + (size_t)ML * 4096, Yb + (size_t)ML * 1024, gw, NGW, lane);
            pg8::Gemm g{ACAT, (const bf16_t*)(ws + WS_WCAT), ML, 1024, KCAT}; pg8::StaticOrder S; S.init(ML, 1024, G, bx);
            pg8::EpiBranch E{Gb, Yb};
            pg8::gemm_phase<pg8::EpiBranch, pg8::StaticOrder, true, true>(L, g, S, E, tid);
            if (BOTH(pb + 4)) GRID_BAR();
        }
        for (int rep = 0; rep < (l == 0 ? NREP(6) : 1); ++rep) if (PH_EN(6) && IN(pb + 5)) { FRESH();
            pg8::Gemm g{Yb, (const bf16_t*)(ws + WS_WOUT), ML, 1024, 1024}; pg8::StaticOrder S; S.init(ML, 1024, G, bx);
            pg8::EpiRes E{l == 0 ? PTR(0) : (const float*)nullptr, XBF, xc, XBF, XC, mod, 2048};
            pg8::gemm_phase<pg8::EpiRes, pg8::StaticOrder, true, true>(L, g, S, E, tid);
            if (l == 0) {
                pg8::Gemm gc{Yb + (size_t)ML * 1024, (const bf16_t*)(ws + WS_WOUT), MC, 1024, 256, 1024}; pg8::SplitKOrder Sc{4, 256, G, bx};
                pg8::EpiSlab Ec{(float*)Gb};
                pg8::gemm_phase<pg8::EpiSlab, pg8::SplitKOrder, true, true>(L, gc, Sc, Ec, tid);
            }
            if (BOTH(pb + 5)) GRID_BAR();
        }
        for (int rep = 0; rep < NREP(7); ++rep) if (PH_EN(7) && IN(pb + 6)) { FRESH(); if (l == 0) norm_phase<true>(XBF, XC, Mact, PTR(5) + l * DM, mod, 3072, 4096, HX, gw, NGW, lane, (const float*)Gb, 4, mod + 2 * 6144 + 2048, XC);
            else norm_phase<true>(XBF, XC, Mact, PTR(5) + l * DM, mod, 3072, 4096, HX, gw, NGW, lane);
            if (BOTH(pb + 6)) GRID_BAR(); }
        for (int rep = 0; rep < NREP(8); ++rep) if (PH_EN(8) && IN(pb + 7)) { FRESH();
            pg8::Gemm g{HX, (const bf16_t*)(ws + WS_WUPG), Mact, DFF, 1024}; pg8::StaticOrder S; S.init(Mact, DFF, G, bx);
            pg8::EpiBf E{GT, DFF};
            pg8::gemm_phase<pg8::EpiBf, pg8::StaticOrder, true, true>(L, g, S, E, tid);
            if (BOTH(pb + 7)) GRID_BAR();
        }
        for (int rep = 0; rep < NREP(9); ++rep) if (PH_EN(9) && IN(pb + 8)) { FRESH();
            pg8::Gemm g{HX, (const bf16_t*)(ws + WS_WUPV), Mact, DFF, 1024}; pg8::StaticOrder S; S.init(Mact, DFF, G, bx);
            pg8::EpiVal E{GT, Hb, PTR(26) + l * 3 * DFF, PTR(27) + l * DFF};
            pg8::gemm_phase<pg8::EpiVal, pg8::StaticOrder, true, true>(L, g, S, E, tid);
            if (BOTH(pb + 8)) GRID_BAR();
        }
        if (PH_EN(10) && IN(pb + 9)) { FRESH();
            pg8::Gemm g{Hb, (const bf16_t*)(ws + WS_WDN), ML, 1024, DFF}; pg8::StaticOrder S; S.init(ML, 1024, G, bx);
            pg8::EpiRes E{(const float*)nullptr, XBF, XC, l == 0 ? XBF : HX, XC, mod, 5120};
            pg8::gemm_phase<pg8::EpiRes, pg8::StaticOrder, true, true>(L, g, S, E, tid);
            if (l == 0) {
                pg8::Gemm gc{Hb + (size_t)ML * DFF, (const bf16_t*)(ws + WS_WDN), MC, 1024, 256, DFF}; pg8::SplitKOrder Sc{11, 256, G, bx};
                pg8::EpiSlab Ec{(float*)Gb};
                pg8::gemm_phase<pg8::EpiSlab, pg8::SplitKOrder, true, true>(L, gc, Sc, Ec, tid);
            }
            if (BOTH(pb + 9)) GRID_BAR();
        }
    }
    if (PH_EN(11) && IN(21)) { FRESH(); final_norm_phase(HX, OUTP, PTR(29), gw, NGW, lane); }
#undef IN
#undef BOTH
#undef mod
#undef XBF
#undef xc
#undef ws
#undef MOD
#undef ROPE
#undef TW
#undef XC
#undef HX
#undef FA
#undef Qb
#undef Kb
#undef Vb
#undef Yb
#undef Gb
#undef ACAT
#undef UF
#undef ZG
#undef UP
#undef GT
#undef Hb
#undef PTR
#undef OUTP
#undef WSP
}

extern "C" void kernel_launch(void* const* d_in, const int* in_sizes, int n_in, void* d_out, int out_size, void* d_ws, size_t ws_size, hipStream_t stream) {
    static int grid = 0;
    if (grid == 0) {
        if (n_in != 30 || in_sizes[0] != ML * DM || out_size != ML * DM || ws_size < WS_END) {
            fprintf(stderr, "kernel_launch: unexpected shapes: n_in %d in0 %d out %d ws %zu (need >= %zu)\n", n_in, n_in > 0 ? in_sizes[0] : -1, out_size, ws_size, (size_t)WS_END); grid = -1; return; }
        int dev = 0, cus = 0, per_cu = 0;
        if (hipGetDevice(&dev) != hipSuccess || hipDeviceGetAttribute(&cus, hipDeviceAttributeMultiprocessorCount, dev) != hipSuccess) { grid = -1; return; }
        if (hipFuncSetAttribute((const void*)fwd_kernel, hipFuncAttributeMaxDynamicSharedMemorySize, LDS_BYTES) != hipSuccess) { fprintf(stderr, "kernel_launch: hipFuncSetAttribute failed\n"); grid = -1; return; }
        if (hipOccupancyMaxActiveBlocksPerMultiprocessor(&per_cu, (const void*)fwd_kernel, 512, LDS_BYTES) != hipSuccess || per_cu < 1) {
            fprintf(stderr, "kernel_launch: occupancy query reports %d blocks per CU\n", per_cu); (void)hipGetLastError(); grid = -1; return; }
        grid = cus;
    }
    if (grid < 0) return;
    (void)hipMemsetAsync((char*)d_ws + WS_CTL, 0, CTL_ZERO_BYTES, stream);
    Args a{};
    for (int i = 0; i < 30; ++i) a.in[i] = (const float*)d_in[i];
    a.out = (float*)d_out; a.ws = (unsigned char*)d_ws;
    for (int li = 0; li < MK_N_LAUNCHES; ++li) {
        if (MK_N_LAUNCHES == NPHASE) { a.ph_lo = li; a.ph_hi = li + 1; a.li = 0; }
        else { a.ph_lo = (int)((long)NPHASE * li / MK_N_LAUNCHES); a.ph_hi = (int)((long)NPHASE * (li + 1) / MK_N_LAUNCHES); a.li = li; }
        hipLaunchKernelGGL(fwd_kernel, dim3(grid), dim3(512), LDS_BYTES, stream, a);
    }
}
```

```cpp
#include <hip/hip_runtime.h>
#include <cstdio>
#include <cstdint>

#define LAS __attribute__((address_space(3)))
#define GAS __attribute__((address_space(1)))
typedef unsigned short bf16_t;
typedef short bf16x8 __attribute__((ext_vector_type(8)));
typedef short s16x4 __attribute__((ext_vector_type(4)));
typedef float f32x2 __attribute__((ext_vector_type(2)));
typedef float f32x4 __attribute__((ext_vector_type(4)));
typedef float f32x16 __attribute__((ext_vector_type(16)));
typedef unsigned u32x2 __attribute__((ext_vector_type(2)));
typedef unsigned u32x4 __attribute__((ext_vector_type(4)));

#ifndef ATT_V
#define ATT_V 2
#endif
#ifndef MK_N_LAUNCHES
#define MK_N_LAUNCHES 1
#endif

constexpr int DM = 1024, SEQ = 8192, NBATCH = 2, CTXL = 256;
constexpr int ML = NBATCH * SEQ;
constexpr int MC = NBATCH * CTXL;
constexpr int MT = ML + MC;
constexpr int NIN = 6656, DFF = 2816, KCAT = 1280;
constexpr int KVL = CTXL + SEQ;
constexpr float EPS = 1e-6f;

constexpr size_t MiB = 1u << 20;
constexpr size_t WS_CTL = 0, CTL_ZERO_BYTES = 1 * MiB;
constexpr size_t WS_MOD = 1 * MiB;
constexpr size_t WS_ROPE = WS_MOD + 2 * 3 * 6144 * 4;
constexpr size_t WS_TW = WS_ROPE + 192 * 32 * 4;
constexpr size_t WS_XC = 2 * MiB;
constexpr size_t WS_WA = 4 * MiB;
constexpr size_t WS_WCAT = 17 * MiB;
constexpr size_t WS_WOUT = WS_WCAT + (size_t)1024 * 1280 * 2;
constexpr size_t WS_WUPG = WS_WOUT + (size_t)1024 * 1024 * 2;
constexpr size_t WS_WUPV = WS_WUPG + (size_t)2816 * 1024 * 2;
constexpr size_t WS_WDN = WS_WUPV + (size_t)2816 * 1024 * 2;
constexpr size_t WS_HX = 38 * MiB;
constexpr size_t WS_FA = WS_HX;
constexpr size_t WS_Q = 71 * MiB;
constexpr size_t WS_K = WS_Q + (size_t)MT * 512 * 2;
constexpr size_t WS_V = WS_K + (size_t)MT * 512 * 2;
constexpr size_t WS_Y = 71 * MiB;
constexpr size_t WS_G = 121 * MiB;
constexpr size_t WS_ACAT = 187 * MiB;
constexpr size_t WS_UF = 229 * MiB;
constexpr size_t WS_ZG = WS_UF + (size_t)MT * 256 * 2;
constexpr size_t WS_UP = WS_ZG + (size_t)MT * 256 * 2;
constexpr size_t WS_GT = 71 * MiB;
constexpr size_t WS_H = 162 * MiB;
constexpr size_t WS_END = 256 * MiB;
static_assert(WS_TW + 8192 * 8 <= WS_XC && WS_WDN + (size_t)1024 * 2816 * 2 <= WS_HX && WS_V + (size_t)MT * 512 * 2 <= WS_G && WS_G + (size_t)MT * 4096 <= WS_ACAT, "ws map 1");
static_assert(WS_ACAT + (size_t)MT * 1280 * 2 <= WS_UF && WS_UP + (size_t)MT * 256 * 2 <= WS_END && WS_GT + (size_t)MT * 2816 * 2 <= WS_H && WS_H + (size_t)MT * 2816 * 2 <= WS_END, "ws map 2");
static_assert(WS_HX + (size_t)MT * 1024 * 2 <= WS_Q && (size_t)2 * 4 * 128 * 64 * 64 * 8 <= (size_t)MT * 1024 * 2, "ws map 3");
constexpr int CW_TMO = 0, CW_CODE = 1, CW_BAR = 4096;

constexpr int RING_BYTES = 131072, LDSCTL_OFF = RING_BYTES, MISC_OFF = LDSCTL_OFF + 320, LDS_BYTES = 147456;

typedef __bf16 bf16x2_t __attribute__((ext_vector_type(2)));
__device__ __forceinline__ unsigned cvt2bf(float lo, float hi) { const f32x2 v = {lo, hi}; return __builtin_bit_cast(unsigned, __builtin_convertvector(v, bf16x2_t)); }
template <int M> __device__ __forceinline__ float swz_xor(float v) { return __int_as_float(__builtin_amdgcn_ds_swizzle(__float_as_int(v), (M << 10) | 0x1f)); }
__device__ __forceinline__ float bf2f(unsigned v) { return __uint_as_float(v << 16); }
__device__ __forceinline__ float sigm(float x) { return __builtin_amdgcn_rcpf(1.0f + __builtin_amdgcn_exp2f(x * -1.4426950408889634f)); }
__host__ __device__ __forceinline__ int in_map(int n) {
    if (n < 256) return n;
    if (n < 1280) { const int base = n < 768 ? 256 : 768, r = n - base, comp = r >> 6, p = r & 63, pp = p >> 1, e = p & 1;
        return base + comp * 64 + (pp < 16 ? 0 : 32) + (pp & 15) + 16 * e; }
    if (n < 1792) return n;
    if (n < 2304) { const int r = n - 1792; return 1792 + (r & 1) * 256 + (r >> 1); }
    return n;
}
namespace pg8 {
#define PG8_LAS __attribute__((address_space(3)))
typedef unsigned short bf16_t;
typedef short bf16x8 __attribute__((ext_vector_type(8)));
typedef float f32x4 __attribute__((ext_vector_type(4)));
typedef unsigned u32x4 __attribute__((ext_vector_type(4)));
constexpr int BM = 256, BK = 64, HALF = 128, HTB = HALF * BK * 2  , STAGE_BYTES = 8 * HTB, NXCD = 8, WGM = 8;

__host__ __device__ __forceinline__ int lds_byte(int r, int c) { const int st = (r >> 4) * 2 + (c >> 5), rr = r & 15, cc = c & 31, ob = rr * 64 + cc * 2; return st * 1024 + (ob ^ (((ob >> 9) & 1) << 5)); }
__host__ __device__ __forceinline__ void stage_rc(int b, int& R, int& C) { const int st = b / 1024, sb = b % 1024, swz = sb ^ (((sb >> 9) & 1) << 5); R = (st >> 1) * 16 + swz / 64; C = (st & 1) * 32 + (swz % 64) / 2; }
__host__ __device__ __forceinline__ int perm32(int rho) { const int n = rho >> 4, i = rho & 15; return 8 * (i >> 2) + 4 * n + (i & 3); }

struct Unit { int pm, pn, ko = 0, sl = 0; };
struct Gemm { const bf16_t* A; const bf16_t* Bt; int M, N, K, ld = 0; };

struct StaticOrder {
    int nM, nN, nwg, G, c;
    __host__ __device__ void init(int M, int N, int G_, int c_) { nM = M / BM; nN = N / BM; nwg = nM * nN; G = G_; c = c_; }
    __host__ __device__ bool next(int i, Unit& u) const {
        const long L = (long)i * G + c; if (L >= nwg) return false;
        int wgid = (int)L; { const int q = nwg / NXCD, r = nwg % NXCD, xcd = wgid % NXCD, off = wgid / NXCD; wgid = (xcd < r ? xcd * (q + 1) : r * (q + 1) + (xcd - r) * q) + off; }
        const int nig = WGM * nN, gid = wgid / nig, fm = gid * WGM, gsz = (nM - fm) < WGM ? (nM - fm) : WGM;
        u.pm = fm + ((wgid % nig) % gsz); u.pn = (wgid % nig) / gsz; return true;
    }
    __device__ __forceinline__ void a_ready(const Unit&) const {}
    __device__ __forceinline__ void done(const Unit&) const {}
};
__device__ __forceinline__ unsigned cvt_pk_bf16(float lo, float hi) { return cvt2bf(lo, hi); }
typedef float f32x2 __attribute__((ext_vector_type(2)));
__device__ __forceinline__ f32x2 gelu_pk(f32x2 v) {
    const f32x2 av = __builtin_elementwise_abs(v), d = av * 0.2316418882f + 1.0f;
    f32x2 t; t.x = __builtin_amdgcn_rcpf(d.x); t.y = __builtin_amdgcn_rcpf(d.y);
    f32x2 q = t * 0.5307027145f + (-0.7265760135f); q = q * t + 0.7107068705f; q = q * t + (-0.142248368f); q = q * t + 0.127414796f; q = q * t;
    const f32x2 s = (v * v) * (-0.72134752044f);
    f32x2 e; e.x = __builtin_amdgcn_exp2f(s.x); e.y = __builtin_amdgcn_exp2f(s.y);
    const f32x2 m = v * (q * e), r = v - m;
    f32x2 o; o.x = v.x < 0.f ? m.x : r.x; o.y = v.y < 0.f ? m.y : r.y; return o;
}

typedef unsigned u32x2 __attribute__((ext_vector_type(2)));
__device__ __forceinline__ u32x4 pack8(const f32x4 a, const f32x4 b) { u32x4 w; w.x = cvt_pk_bf16(a[0], a[1]); w.y = cvt_pk_bf16(a[2], a[3]); w.z = cvt_pk_bf16(b[0], b[1]); w.w = cvt_pk_bf16(b[2], b[3]); return w; }

struct EpiIn {
    static constexpr bool PERM = true, AFTER_DRAIN = false, RESCALE = false;
    bf16_t *UF, *ZG, *UP, *Q, *K, *V; unsigned char* G; const float* rope;
    __device__ __forceinline__ void operator()(const f32x4 (&acc)[2][2][4][2], const Unit& u, int wr, int wc, int fr, int fq) const {
        const int pm = u.pm, pn = u.pn; const bool lat = pm < 64; const int R0 = pm * 256;
        const int kv0 = lat ? ((pm >> 5) * 8448 + 256 + ((pm & 31) << 8)) : ((pm - 64) * 8448);
        const int rl = wr * 64 + fr, cl = wc * 32 + 8 * fq;
        if (pn == 0 || pn == 9) {
            bf16_t* dst = (pn == 0 ? UF : UP);
#pragma unroll
            for (int ai = 0; ai < 2; ++ai)
#pragma unroll
                for (int m = 0; m < 4; ++m) { const int rr = ai * 128 + m * 16 + rl;
#pragma unroll
                    for (int bj = 0; bj < 2; ++bj) *(u32x4*)(dst + (size_t)(R0 + rr) * 256 + bj * 128 + cl) = pack8(acc[ai][bj][m][0], acc[ai][bj][m][1]); }
        } else if (pn <= 4) {
            const bool isq = pn <= 2; bf16_t* dst = isq ? Q : K; const int rowbase = isq ? R0 : kv0, colbase = (isq ? pn - 1 : pn - 3) * 256; const float sc = isq ? (ATT_V == 2 ? 0.18033688011112042f : 0.125f) : 1.0f;
#pragma unroll
            for (int ai = 0; ai < 2; ++ai)
#pragma unroll
                for (int m = 0; m < 4; ++m) { const int rr = ai * 128 + m * 16 + rl;
                    f32x4 cs = {1.f, 1.f, 1.f, 1.f}, sn = {0.f, 0.f, 0.f, 0.f};
                    if (lat) { const int t = (R0 & 8191) + rr; const int pos = (wc & 1) ? 128 + (t & 63) : (t >> 6);
                        cs = *(const f32x4*)(rope + pos * 32 + 4 * fq); sn = *(const f32x4*)(rope + pos * 32 + 16 + 4 * fq); }
                    cs = cs * sc; sn = sn * sc;
#pragma unroll
                    for (int bj = 0; bj < 2; ++bj) { const f32x4 a = acc[ai][bj][m][0], b = acc[ai][bj][m][1]; f32x4 oa, ob;
                        oa[0] = a[0] * cs[0] - a[1] * sn[0]; oa[1] = a[1] * cs[0] + a[0] * sn[0]; oa[2] = a[2] * cs[1] - a[3] * sn[1]; oa[3] = a[3] * cs[1] + a[2] * sn[1];
                        ob[0] = b[0] * cs[2] - b[1] * sn[2]; ob[1] = b[1] * cs[2] + b[0] * sn[2]; ob[2] = b[2] * cs[3] - b[3] * sn[3]; ob[3] = b[3] * cs[3] + b[2] * sn[3];
                        *(u32x4*)(dst + (size_t)(rowbase + rr) * 512 + colbase + bj * 128 + cl) = pack8(oa, ob); } }
        } else if (pn <= 6) {
#pragma unroll
            for (int ai = 0; ai < 2; ++ai)
#pragma unroll
                for (int m = 0; m < 4; ++m) { const int rr = ai * 128 + m * 16 + rl;
#pragma unroll
                    for (int bj = 0; bj < 2; ++bj) *(u32x4*)(V + (size_t)(kv0 + rr) * 512 + (pn - 5) * 256 + bj * 128 + cl) = pack8(acc[ai][bj][m][0], acc[ai][bj][m][1]); }
        } else if (pn <= 8) {
#pragma unroll
            for (int ai = 0; ai < 2; ++ai)
#pragma unroll
                for (int m = 0; m < 4; ++m) { const int rr = ai * 128 + m * 16 + rl;
#pragma unroll
                    for (int bj = 0; bj < 2; ++bj) { const f32x4 a = acc[ai][bj][m][0], b = acc[ai][bj][m][1];
                        u32x2 w; w.x = cvt_pk_bf16(a[0] * sigm(a[1]), a[2] * sigm(a[3])); w.y = cvt_pk_bf16(b[0] * sigm(b[1]), b[2] * sigm(b[3]));
                        *(u32x2*)(ZG + (size_t)(R0 + rr) * 256 + (pn - 7) * 128 + bj * 64 + (cl >> 1)) = w; } }
        } else {
#pragma unroll
            for (int ai = 0; ai < 2; ++ai)
#pragma unroll
                for (int m = 0; m < 4; ++m) { const int rr = ai * 128 + m * 16 + rl;
#pragma unroll
                    for (int bj = 0; bj < 2; ++bj) { u32x2 w;
#pragma unroll
                        for (int n = 0; n < 2; ++n) { const f32x4 a = acc[ai][bj][m][n]; unsigned q = 0;
#pragma unroll
                            for (int j = 0; j < 4; ++j) { float s = sigm(a[j]) * 255.0f + 0.5f; s = s < 1.0f ? 1.0f : s; q |= ((unsigned)s) << (8 * j); }
                            if (n == 0) w.x = q; else w.y = q; }
                        *(u32x2*)(G + (size_t)(R0 + rr) * 4096 + (pn - 10) * 256 + bj * 128 + cl) = w; } }
        }
    }
};

struct EpiBf {
    static constexpr bool PERM = true, AFTER_DRAIN = false, RESCALE = false;
    bf16_t* O; int ldc;
    __device__ __forceinline__ void operator()(const f32x4 (&acc)[2][2][4][2], const Unit& u, int wr, int wc, int fr, int fq) const {
        const int row0 = u.pm * 256 + wr * 64 + fr, col0 = u.pn * 256 + wc * 32 + 8 * fq;
#pragma unroll
        for (int ai = 0; ai < 2; ++ai)
#pragma unroll
            for (int m = 0; m < 4; ++m)
#pragma unroll
                for (int bj = 0; bj < 2; ++bj) *(u32x4*)(O + (size_t)(row0 + ai * 128 + m * 16) * ldc + col0 + bj * 128) = pack8(acc[ai][bj][m][0], acc[ai][bj][m][1]);
    }
};

struct EpiRes {
    static constexpr bool PERM = true, AFTER_DRAIN = false, RESCALE = false;
    const float* base_f32; const bf16_t* base_bf; const float* base_ctx; bf16_t* out_bf; float* out_ctx; const float* mod; int goff;
    __device__ __forceinline__ void operator()(const f32x4 (&acc)[2][2][4][2], const Unit& u, int wr, int wc, int fr, int fq) const {
        const int pm = u.pm; const bool lat = pm < 64; const int mrow = lat ? (pm >> 5) : 2;
        const int col0 = u.pn * 256 + wc * 32 + 8 * fq;
        f32x4 gv[2][2];
#pragma unroll
        for (int bj = 0; bj < 2; ++bj)
#pragma unroll
            for (int n = 0; n < 2; ++n) gv[bj][n] = *(const f32x4*)(mod + mrow * 6144 + goff + col0 + bj * 128 + 4 * n);
#pragma unroll
        for (int ai = 0; ai < 2; ++ai)
#pragma unroll
            for (int m = 0; m < 4; ++m) { const size_t ro = (size_t)((lat ? pm : pm - 64) * 256 + ai * 128 + wr * 64 + m * 16 + fr) * 1024 + col0;
#pragma unroll
                for (int bj = 0; bj < 2; ++bj) { const size_t off = ro + bj * 128; f32x4 b0, b1;
                    if (!lat) { b0 = *(const f32x4*)(base_ctx + off); b1 = *(const f32x4*)(base_ctx + off + 4); }
                    else if (base_f32) { b0 = *(const f32x4*)(base_f32 + off); b1 = *(const f32x4*)(base_f32 + off + 4); }
                    else { const u32x4 w = *(const u32x4*)(base_bf + off);
                        b0 = (f32x4){__uint_as_float(w.x << 16), __uint_as_float(w.x & 0xffff0000u), __uint_as_float(w.y << 16), __uint_as_float(w.y & 0xffff0000u)};
                        b1 = (f32x4){__uint_as_float(w.z << 16), __uint_as_float(w.z & 0xffff0000u), __uint_as_float(w.w << 16), __uint_as_float(w.w & 0xffff0000u)}; }
                    const f32x4 o0 = b0 + gv[bj][0] * acc[ai][bj][m][0], o1 = b1 + gv[bj][1] * acc[ai][bj][m][1];
                    if (lat) *(u32x4*)(out_bf + off) = pack8(o0, o1); else { *(f32x4*)(out_ctx + off) = o0; *(f32x4*)(out_ctx + off + 4) = o1; } } }
    }
};

struct EpiVal {
    static constexpr bool PERM = true, AFTER_DRAIN = false, RESCALE = false;
    const bf16_t* GT; bf16_t* H; const float* dww; const float* dwb;
    __device__ __forceinline__ void operator()(const f32x4 (&acc)[2][2][4][2], const Unit& u, int wr, int wc, int fr, int fq) const {
        const int pm = u.pm; const bool lat = pm < 64; const int R0 = pm * 256, t0 = lat ? (R0 & 8191) : 0, L = lat ? 8192 : 256;
        const int rl = wr * 64 + fr;
#pragma unroll
        for (int bj = 0; bj < 2; ++bj) { const int col = u.pn * 256 + bj * 128 + wc * 32 + 8 * fq;
            f32x4 w0[2], w1[2], w2[2], bb[2];
#pragma unroll
            for (int n = 0; n < 2; ++n) { w0[n] = *(const f32x4*)(dww + col + 4 * n); w1[n] = *(const f32x4*)(dww + 2816 + col + 4 * n); w2[n] = *(const f32x4*)(dww + 5632 + col + 4 * n); bb[n] = *(const f32x4*)(dwb + col + 4 * n); }
#pragma unroll
            for (int ai = 0; ai < 2; ++ai) {
#pragma unroll
              for (int mh = 0; mh < 4; mh += 2) {
                u32x4 gm[4], g0[4], gq[4];
#pragma unroll
                for (int m = mh; m < mh + 2; ++m) { const int rr = ai * 128 + m * 16 + rl, t = t0 + rr; const bf16_t* gp = GT + (size_t)(R0 + rr) * 2816 + col;
                    gm[m] = (u32x4){0u, 0u, 0u, 0u}; gq[m] = (u32x4){0u, 0u, 0u, 0u}; g0[m] = *(const u32x4*)gp;
                    if (t > 0) gm[m] = *(const u32x4*)(gp - 2816);
                    if (t < L - 1) gq[m] = *(const u32x4*)(gp + 2816); }
                asm volatile("" ::: "memory");
#pragma unroll
                for (int m = mh; m < mh + 2; ++m) { const int rr = ai * 128 + m * 16 + rl;
                    f32x4 o[2];
#pragma unroll
                    for (int n = 0; n < 2; ++n) { f32x4 c;
#pragma unroll
                        for (int j = 0; j < 4; ++j) { const int e = 4 * n + j; const unsigned wm = gm[m][e >> 1], wz = g0[m][e >> 1], wp = gq[m][e >> 1];
                            const float xm = (e & 1) ? __uint_as_float(wm & 0xffff0000u) : __uint_as_float(wm << 16), xz = (e & 1) ? __uint_as_float(wz & 0xffff0000u) : __uint_as_float(wz << 16),
                                        xp = (e & 1) ? __uint_as_float(wp & 0xffff0000u) : __uint_as_float(wp << 16);
                            c[j] = w0[n][j] * xm + w1[n][j] * xz + w2[n][j] * xp + bb[n][j]; }
                        const f32x2 ga = gelu_pk((f32x2){c[0], c[1]}), gb = gelu_pk((f32x2){c[2], c[3]});
                        const f32x4 v = acc[ai][bj][m][n]; o[n] = (f32x4){v[0] * ga.x, v[1] * ga.y, v[2] * gb.x, v[3] * gb.y}; }
                    *(u32x4*)(H + (size_t)(R0 + rr) * 2816 + col) = pack8(o[0], o[1]); }
                asm volatile("" ::: "memory");
              }
            }
        }
    }
};

struct EpiBranch {
    static constexpr bool PERM = true, AFTER_DRAIN = false, RESCALE = true;
    const unsigned char* G; bf16_t* Y;
    __device__ __forceinline__ void rescale(f32x4 (&acc)[2][2][4][2], const Unit& u, int t, int wr, int wc, int fr, int fq) const {
        const int bp = (t == 4) ? 0 : (t == 12) ? 1 : 2;
        const __amdgpu_buffer_rsrc_t rs = __builtin_amdgcn_make_buffer_rsrc((void*)G, 0, MT * 4096, 0x00020000);
        const int voff = (u.pm * 256 + wr * 64 + fr) * 4096 + u.pn * 256 + wc * 32 + 8 * fq;
        u32x2 p[2][4][2], q[2][4][2];
#pragma unroll
        for (int ai = 0; ai < 2; ++ai)
#pragma unroll
            for (int m = 0; m < 4; ++m)
#pragma unroll
                for (int bj = 0; bj < 2; ++bj) { const int so = (ai * 128 + m * 16) * 4096 + bj * 128 + bp * 1024;
                    p[ai][m][bj] = __builtin_bit_cast(u32x2, __builtin_amdgcn_raw_buffer_load_b64(rs, voff, so, 0)); q[ai][m][bj] = __builtin_bit_cast(u32x2, __builtin_amdgcn_raw_buffer_load_b64(rs, voff, so + 1024, 0)); }
        asm volatile("" ::: "memory");
#pragma unroll
        for (int ai = 0; ai < 2; ++ai)
#pragma unroll
            for (int m = 0; m < 4; ++m)
#pragma unroll
                for (int bj = 0; bj < 2; ++bj)
#pragma unroll
                    for (int n = 0; n < 2; ++n) { const unsigned pw = n ? p[ai][m][bj].y : p[ai][m][bj].x, qw = n ? q[ai][m][bj].y : q[ai][m][bj].x;
#pragma unroll
                        for (int j = 0; j < 4; ++j) acc[ai][bj][m][n][j] *= (float)((pw >> (8 * j)) & 255u) * __builtin_amdgcn_rcpf((float)((qw >> (8 * j)) & 255u)); }
        asm volatile("" ::: "memory");
    }
    __device__ __forceinline__ void operator()(const f32x4 (&acc)[2][2][4][2], const Unit& u, int wr, int wc, int fr, int fq) const {
        const int row0 = u.pm * 256 + wr * 64 + fr, col0 = u.pn * 256 + wc * 32 + 8 * fq;
#pragma unroll
        for (int ai = 0; ai < 2; ++ai)
#pragma unroll
            for (int m = 0; m < 4; ++m)
#pragma unroll
                for (int bj = 0; bj < 2; ++bj) { const size_t r = (size_t)(row0 + ai * 128 + m * 16); const u32x2 p = *(const u32x2*)(G + r * 4096 + 3072 + col0 + bj * 128);
                    f32x4 o[2];
#pragma unroll
                    for (int n = 0; n < 2; ++n) { const unsigned pw = n ? p.y : p.x;
#pragma unroll
                        for (int j = 0; j < 4; ++j) o[n][j] = acc[ai][bj][m][n][j] * ((float)((pw >> (8 * j)) & 255u) * (1.0f / 255.0f)); }
                    *(u32x4*)(Y + r * 1024 + col0 + bj * 128) = pack8(o[0], o[1]); }
    }
};


struct SplitKOrder {
    int nsl, ksl, G, c;
    __device__ __forceinline__ bool next(int i, Unit& u) const { const int L = i * G + c; if (L >= 8 * nsl) return false; u.pm = (L >> 2) & 1; u.pn = L & 3; u.sl = L >> 3; u.ko = u.sl * ksl; return true; }
    __device__ __forceinline__ void a_ready(const Unit&) const {}
    __device__ __forceinline__ void done(const Unit&) const {}
};
struct EpiSlab {
    static constexpr bool PERM = false, AFTER_DRAIN = false, RESCALE = false;
    float* slab;
    __device__ __forceinline__ void operator()(const f32x4 (&acc)[2][2][4][2], const Unit& u, int wr, int wc, int fr, int fq) const {
        float* o = slab + (size_t)u.sl * 512 * 1024 + (size_t)(u.pm * 256 + wr * 64 + fr) * 1024 + u.pn * 256 + wc * 32 + 4 * fq;
#pragma unroll
        for (int ai = 0; ai < 2; ++ai)
#pragma unroll
            for (int m = 0; m < 4; ++m)
#pragma unroll
                for (int bj = 0; bj < 2; ++bj)
#pragma unroll
                    for (int n = 0; n < 2; ++n) *(f32x4*)(o + (size_t)(ai * 128 + m * 16) * 1024 + bj * 128 + n * 16) = acc[ai][bj][m][n];
    }
};

struct BranchSliceOrder {
    int G, c;
    __device__ __forceinline__ bool next(int i, Unit& u) const { const int L = i * G + c; if (L >= 40) return false; u.pm = (L >> 2) & 1; u.pn = L & 3; u.sl = L >> 3; u.ko = u.sl * 256; return true; }
    __device__ __forceinline__ void a_ready(const Unit&) const {}
    __device__ __forceinline__ void done(const Unit&) const {}
};
template <class Epi, class Sched, bool ALIGN_EPI = false, bool SP2 = false>
__device__ __forceinline__ void gemm_phase(PG8_LAS unsigned char* lds, const Gemm g, const Sched& S, const Epi& E, const int tid) {
    const int wid = __builtin_amdgcn_readfirstlane(tid >> 6), lane = tid & 63, wr = wid >> 2, wc = wid & 3, fr = lane & 15, fq = lane >> 4;
    const int K = g.ld ? g.ld : g.K  , nt = g.K / BK;
    unsigned voffA[2], voffB[2];
#pragma unroll
    for (int i = 0; i < 2; ++i) { int R, C; stage_rc(tid * 16 + i * 8192, R, C); const int Rb = Epi::PERM ? ((R & ~31) + perm32(R & 31)) : R;
        voffA[i] = (unsigned)(R * K + C) * 2u; voffB[i] = (unsigned)(Rb * K + C) * 2u; }
    const size_t kstep = (size_t)(BK * 2);
    const size_t hstep = (size_t)HALF * K * 2;
    const size_t tstep = 2 * hstep;
    const unsigned ldsw = (unsigned)wid * 1024u;
    const int aoff = lds_byte(wr * 64 + fr, fq * 8), boff = lds_byte(wc * 32 + fr, fq * 8);
#define PG8_SA(b, h) (((b) * 2 + (h)) * HTB)
#define PG8_SB(b, h) ((4 + (b) * 2 + (h)) * HTB)
#define PG8_STAGE(bufoff, gbase, voff) do { _Pragma("unroll") for (int _i = 0; _i < 2; ++_i) \
        __builtin_amdgcn_global_load_lds((const unsigned*)((const char*)(gbase) + (voff)[_i]), (PG8_LAS unsigned*)(lds + (bufoff) + ldsw + _i * 8192), 16, 0, 0); } while (0)
#define PG8_LDA(dst, b, h) do { _Pragma("unroll") for (int m = 0; m < 4; ++m) _Pragma("unroll") for (int k = 0; k < 2; ++k) dst[m][k] = *(const PG8_LAS bf16x8*)(lds + PG8_SA(b, h) + aoff + m * 2048 + k * 1024); } while (0)
#define PG8_LDB(dst, b, h) do { _Pragma("unroll") for (int n = 0; n < 2; ++n) _Pragma("unroll") for (int k = 0; k < 2; ++k) dst[n][k] = *(const PG8_LAS bf16x8*)(lds + PG8_SB(b, h) + boff + n * 2048 + k * 1024); } while (0)
#define PG8_MMA(ai, bj, At, Bt) do { __builtin_amdgcn_s_setprio(1); _Pragma("unroll") for (int m = 0; m < 4; ++m) _Pragma("unroll") for (int n = 0; n < 2; ++n) _Pragma("unroll") for (int k = 0; k < 2; ++k) \
        acc[ai][bj][m][n] = __builtin_amdgcn_mfma_f32_16x16x32_bf16(Bt[n][k], At[m][k], acc[ai][bj][m][n], 0, 0, 0); __builtin_amdgcn_s_setprio(0); } while (0)
#define PG8_WAIT_V(n) asm volatile("s_waitcnt vmcnt(" #n ")" ::: "memory")
#define PG8_WAIT_L(n) asm volatile("s_waitcnt lgkmcnt(" #n ")" ::: "memory")
#define PG8_BAR __builtin_amdgcn_s_barrier()
#define PG8_SCHED __builtin_amdgcn_sched_barrier(0)
    Unit cur, nxt; int ui = 0;
    if (!S.next(0, cur)) return;
    f32x4 acc[2][2][4][2];
#pragma unroll
    for (int a = 0; a < 2; ++a)
#pragma unroll
        for (int b = 0; b < 2; ++b)
#pragma unroll
            for (int m = 0; m < 4; ++m)
#pragma unroll
                for (int n = 0; n < 2; ++n) acc[a][b][m][n] = (f32x4){0.f, 0.f, 0.f, 0.f};
    bf16x8 At[4][2], B0[2][2], B1[2][2];
    const char* cA = (const char*)g.A + (size_t)cur.pm * tstep + (size_t)cur.ko * 2; const char* cB = (const char*)g.Bt + (size_t)cur.pn * tstep + (size_t)cur.ko * 2;
    S.a_ready(cur);
    if constexpr (SP2) {
        PG8_STAGE(PG8_SB(0, 0), cB, voffB); PG8_STAGE(PG8_SB(0, 1), cB + hstep, voffB); PG8_STAGE(PG8_SA(0, 0), cA, voffA); PG8_STAGE(PG8_SA(0, 1), cA + hstep, voffA);
        if (wr == 1) PG8_BAR;
        PG8_WAIT_V(2); PG8_BAR;
        PG8_STAGE(PG8_SB(1, 0), cB + kstep, voffB); PG8_STAGE(PG8_SA(1, 0), cA + kstep, voffA); PG8_STAGE(PG8_SB(1, 1), cB + hstep + kstep, voffB);
        PG8_WAIT_V(6); PG8_BAR;
    } else {
        PG8_STAGE(PG8_SB(0, 0), cB, voffB); PG8_STAGE(PG8_SA(0, 0), cA, voffA); PG8_STAGE(PG8_SB(0, 1), cB + hstep, voffB); PG8_STAGE(PG8_SA(0, 1), cA + hstep, voffA);
        if (wr == 1) PG8_BAR;
        PG8_WAIT_V(4); PG8_BAR;
        PG8_STAGE(PG8_SB(1, 0), cB + kstep, voffB); PG8_STAGE(PG8_SA(1, 0), cA + kstep, voffA); PG8_STAGE(PG8_SB(1, 1), cB + hstep + kstep, voffB);
        PG8_WAIT_V(6); PG8_BAR;
    }
    for (;;) {
        const bool has_next = S.next(ui + 1, nxt);
        const char* nA = has_next ? (const char*)g.A + (size_t)nxt.pm * tstep + (size_t)nxt.ko * 2 : cA; const char* nB = has_next ? (const char*)g.Bt + (size_t)nxt.pn * tstep + (size_t)nxt.ko * 2 : cB;
        for (int t = 0; t < nt; t += 2) {
            if constexpr (Epi::RESCALE) { if (t == 4 || t == 12 || t == 16) E.rescale(acc, cur, t, wr, wc, fr, fq); }
            const bool last = (t == nt - 2);
            const char* a1 = cA + (size_t)(t + 1) * kstep;
            const char* a2 = last ? nA : cA + (size_t)(t + 2) * kstep; const char* b2 = last ? nB : cB + (size_t)(t + 2) * kstep;
            const char* a3 = a2 + kstep; const char* b3 = b2 + kstep;
            if (last && has_next) S.a_ready(nxt);
            if constexpr (SP2) {
            PG8_LDB(B0, 0, 0); PG8_LDB(B1, 0, 1); PG8_SCHED; PG8_LDA(At, 0, 0); PG8_STAGE(PG8_SA(1, 1), a1 + hstep, voffA);
            PG8_WAIT_V(8); PG8_WAIT_L(0); PG8_BAR; PG8_MMA(0, 0, At, B0); PG8_MMA(0, 1, At, B1); PG8_BAR; PG8_SCHED;
            PG8_LDA(At, 0, 1); PG8_STAGE(PG8_SB(0, 0), b2, voffB); PG8_STAGE(PG8_SB(0, 1), b2 + hstep, voffB); PG8_STAGE(PG8_SA(0, 0), a2, voffA);
            PG8_WAIT_V(8); PG8_WAIT_L(0); PG8_BAR; PG8_MMA(1, 0, At, B0); PG8_MMA(1, 1, At, B1); PG8_BAR; PG8_SCHED;
            PG8_LDB(B0, 1, 0); PG8_LDB(B1, 1, 1); PG8_SCHED; PG8_LDA(At, 1, 0); PG8_STAGE(PG8_SA(0, 1), a2 + hstep, voffA);
            PG8_WAIT_V(8); PG8_WAIT_L(0); PG8_BAR; PG8_MMA(0, 0, At, B0); PG8_MMA(0, 1, At, B1); PG8_BAR; PG8_SCHED;
            PG8_LDA(At, 1, 1); PG8_STAGE(PG8_SB(1, 0), b3, voffB); PG8_STAGE(PG8_SB(1, 1), b3 + hstep, voffB); PG8_STAGE(PG8_SA(1, 0), a3, voffA);
            PG8_WAIT_V(8); PG8_WAIT_L(0); PG8_BAR; PG8_MMA(1, 0, At, B0); PG8_MMA(1, 1, At, B1); PG8_BAR; PG8_SCHED;
            } else {
            PG8_LDB(B0, 0, 0); PG8_SCHED; PG8_LDA(At, 0, 0); PG8_STAGE(PG8_SA(1, 1), a1 + hstep, voffA);
            PG8_WAIT_L(8); PG8_BAR; PG8_WAIT_L(0); PG8_MMA(0, 0, At, B0); PG8_BAR; PG8_SCHED;
            PG8_LDB(B1, 0, 1); PG8_STAGE(PG8_SB(0, 0), b2, voffB);
            PG8_BAR; PG8_WAIT_L(0); PG8_MMA(0, 1, At, B1); PG8_BAR;
            PG8_LDA(At, 0, 1); PG8_STAGE(PG8_SA(0, 0), a2, voffA);
            PG8_BAR; PG8_WAIT_L(0); PG8_MMA(1, 0, At, B0); PG8_BAR; PG8_SCHED;
            PG8_STAGE(PG8_SB(0, 1), b2 + hstep, voffB);
            PG8_WAIT_V(6); PG8_BAR; PG8_MMA(1, 1, At, B1); PG8_BAR;
            PG8_LDB(B0, 1, 0); PG8_SCHED; PG8_LDA(At, 1, 0); PG8_STAGE(PG8_SA(0, 1), a2 + hstep, voffA);
            PG8_WAIT_L(8); PG8_BAR; PG8_WAIT_L(0); PG8_MMA(0, 0, At, B0); PG8_BAR; PG8_SCHED;
            PG8_LDB(B1, 1, 1); PG8_STAGE(PG8_SB(1, 0), b3, voffB);
            PG8_BAR; PG8_WAIT_L(0); PG8_MMA(0, 1, At, B1); PG8_BAR;
            PG8_LDA(At, 1, 1); PG8_STAGE(PG8_SA(1, 0), a3, voffA);
            PG8_BAR; PG8_WAIT_L(0); PG8_MMA(1, 0, At, B0); PG8_BAR; PG8_SCHED;
            PG8_STAGE(PG8_SB(1, 1), b3 + hstep, voffB);
            PG8_WAIT_V(6); PG8_BAR; PG8_MMA(1, 1, At, B1); PG8_BAR;
            }
        }
        if constexpr (ALIGN_EPI) { if (wr == 0) PG8_BAR; }
        if constexpr (!Epi::AFTER_DRAIN) { E(acc, cur, wr, wc, fr, fq); S.done(cur); }
        if (!has_next) break;
#pragma unroll
        for (int a = 0; a < 2; ++a)
#pragma unroll
            for (int b = 0; b < 2; ++b)
#pragma unroll
                for (int m = 0; m < 4; ++m)
#pragma unroll
                    for (int n = 0; n < 2; ++n) acc[a][b][m][n] = (f32x4){0.f, 0.f, 0.f, 0.f};
        cur = nxt; cA = nA; cB = nB; ++ui;
        if constexpr (ALIGN_EPI) { if (wr == 1) PG8_BAR; }
    }
    PG8_WAIT_V(0);
    if constexpr (!ALIGN_EPI) { if (wr == 0) PG8_BAR; }
    PG8_BAR;
    if constexpr (Epi::AFTER_DRAIN) { E.fused(acc, cur, wr, wc, fr, fq, lds, wid, lane); S.done(cur); }
#undef PG8_SA
#undef PG8_SB
#undef PG8_STAGE
#undef PG8_LDA
#undef PG8_LDB
#undef PG8_MMA
#undef PG8_WAIT_V
#undef PG8_WAIT_L
#undef PG8_BAR
#undef PG8_SCHED
}
}
namespace att {
constexpr int NW = 8, QBLK = 32, KVBLK = 64, LDQ = 512, LDO = KCAT;
constexpr int SHM_V = 16384, SHM_K = 16384, SHM_ATTN = 3 * SHM_V + 2 * SHM_K + NW * 64 * 4;
constexpr float THR = 8.f;
#ifndef ATT_SDEPTH
#define ATT_SDEPTH 1
#endif
constexpr int SDEPTH = ATT_SDEPTH;
#define KSWZ(row, colB) ((row) * 256 + ((colB) ^ (((row) & 7) << 4)))
#define SBAR() __builtin_amdgcn_sched_barrier(0)
__device__ __forceinline__ int crow(int r, int hi) { return (r & 3) + 8 * (r >> 2) + 4 * hi; }
__device__ __forceinline__ unsigned cvtpk(float lo, float hi) { return cvt2bf(lo, hi); }

__device__ __forceinline__ void partialSM(f32x16& p0, f32x16& p1, float& m_reg, float& mn, float& alpha) {
  constexpr float C = 1.4426950408889634f;
  float pmax = p0[0];
#pragma unroll
  for (int r = 1; r < 16; ++r) pmax = fmaxf(pmax, p0[r]);
#pragma unroll
  for (int r = 0; r < 16; ++r) pmax = fmaxf(pmax, p1[r]);
  { auto rr = __builtin_amdgcn_permlane32_swap(__float_as_uint(pmax), __float_as_uint(pmax), false, false);
    pmax = fmaxf(__uint_as_float(rr[0]), __uint_as_float(rr[1])); }
  if (__builtin_expect(__all(pmax - m_reg <= THR), 1)) { mn = m_reg; alpha = 1.f; }
  else { mn = fmaxf(m_reg, pmax); alpha = __builtin_amdgcn_exp2f((m_reg - mn) * C); m_reg = mn; }
  const float mnC = -mn * C;
#pragma unroll
  for (int r = 0; r < 16; ++r) p0[r] = fmaf(p0[r], C, mnC);
#pragma unroll
  for (int r = 0; r < 16; ++r) p1[r] = fmaf(p1[r], C, mnC);
#pragma unroll
  for (int r = 0; r < 16; ++r) p0[r] = __builtin_amdgcn_exp2f(p0[r]);
}
__device__ __forceinline__ void finishSM(f32x16& p0, f32x16& p1, float alpha, float& l_reg, bf16x8& pa0, bf16x8& pa1, bf16x8& pa2, bf16x8& pa3) {
#pragma unroll
  for (int r = 0; r < 16; ++r) p1[r] = __builtin_amdgcn_exp2f(p1[r]);
  float ps = 0;
#pragma unroll
  for (int r = 0; r < 16; ++r) ps += p0[r];
#pragma unroll
  for (int r = 0; r < 16; ++r) ps += p1[r];
  { auto rr = __builtin_amdgcn_permlane32_swap(__float_as_uint(ps), __float_as_uint(ps), false, false);
    ps = __uint_as_float(rr[0]) + __uint_as_float(rr[1]); }
  l_reg = l_reg * alpha + ps;
#define PK4(P, BASE, OUT) do { unsigned a0 = cvtpk(P[BASE + 0], P[BASE + 1]), a1 = cvtpk(P[BASE + 2], P[BASE + 3]);   \
    unsigned b0 = cvtpk(P[BASE + 4], P[BASE + 5]), b1 = cvtpk(P[BASE + 6], P[BASE + 7]);                              \
    auto r0 = __builtin_amdgcn_permlane32_swap(a0, b0, false, false); auto r1 = __builtin_amdgcn_permlane32_swap(a1, b1, false, false); \
    u32x4 w = {r0[0], r1[0], r0[1], r1[1]}; OUT = *reinterpret_cast<bf16x8*>(&w); } while (0)
  PK4(p0, 0, pa0); PK4(p0, 8, pa1); PK4(p1, 0, pa2); PK4(p1, 8, pa3);
#undef PK4
}
__device__ __forceinline__ void qkt(f32x16& p0, f32x16& p1, const char* Ks, const bf16x8* qr, int r32, int hi, int kcol) {
  p0 = f32x16{}; p1 = f32x16{};
#pragma unroll
  for (int d0 = 0; d0 < 4; ++d0) { const int cb = kcol + (d0 * 16 + hi * 8) * 2;
    const bf16x8 b0 = *reinterpret_cast<const bf16x8*>(Ks + KSWZ(r32, cb));
    const bf16x8 b1 = *reinterpret_cast<const bf16x8*>(Ks + KSWZ(32 + r32, cb));
    p0 = __builtin_amdgcn_mfma_f32_32x32x16_bf16(b0, qr[d0], p0, 0, 0, 0);
    p1 = __builtin_amdgcn_mfma_f32_32x32x16_bf16(b1, qr[d0], p1, 0, 0, 0); }
}
__device__ __forceinline__ int v_st(int k, int c) { const int kk = (k & ~0xC) | ((k & 4) << 1) | ((k & 8) >> 1); return ((kk >> 3) * 4 + (c >> 5)) * 512 + ((kk & 7) * 32 + (c & 31)) * 2; }
__device__ __forceinline__ int v_rd_base(int lane) { return ((lane & 3) << 3) | (((lane >> 2) & 3) << 6) | (((lane >> 4) & 1) << 5) | (((lane >> 5) & 1) << 8); }
constexpr int v_rd_off(int d0, int ks, int half) { return d0 * 512 + ks * 4096 + half * 2048; }
template <int OFF> __device__ __forceinline__ s16x4 tr_read(int vb) {
  s16x4 r; asm volatile("ds_read_b64_tr_b16 %0, %1 offset:%2" : "=&v"(r) : "v"(vb), "i"(OFF) : "memory"); return r;
}
template <int D0> __device__ __forceinline__ void pv_one(f32x16& od, int vb, bf16x8 pa0, bf16x8 pa1, bf16x8 pa2, bf16x8 pa3) {
  const s16x4 l0 = tr_read<v_rd_off(D0, 0, 0)>(vb), h0 = tr_read<v_rd_off(D0, 0, 1)>(vb), l1 = tr_read<v_rd_off(D0, 1, 0)>(vb), h1 = tr_read<v_rd_off(D0, 1, 1)>(vb);
  const s16x4 l2 = tr_read<v_rd_off(D0, 2, 0)>(vb), h2 = tr_read<v_rd_off(D0, 2, 1)>(vb), l3 = tr_read<v_rd_off(D0, 3, 0)>(vb), h3 = tr_read<v_rd_off(D0, 3, 1)>(vb);
  asm volatile("s_waitcnt lgkmcnt(0)" ::: "memory"); SBAR();
#define PK(L, H) (bf16x8){L[0], L[1], L[2], L[3], H[0], H[1], H[2], H[3]}
  od = __builtin_amdgcn_mfma_f32_32x32x16_bf16(pa0, PK(l0, h0), od, 0, 0, 0);
  od = __builtin_amdgcn_mfma_f32_32x32x16_bf16(pa1, PK(l1, h1), od, 0, 0, 0);
  od = __builtin_amdgcn_mfma_f32_32x32x16_bf16(pa2, PK(l2, h2), od, 0, 0, 0);
  od = __builtin_amdgcn_mfma_f32_32x32x16_bf16(pa3, PK(l3, h3), od, 0, 0, 0);
#undef PK
}
__device__ __forceinline__ void pv_d0(f32x16* o, int vb, bf16x8 pa0, bf16x8 pa1, bf16x8 pa2, bf16x8 pa3) {
  pv_one<0>(o[0], vb, pa0, pa1, pa2, pa3); pv_one<1>(o[1], vb, pa0, pa1, pa2, pa3); pv_one<2>(o[2], vb, pa0, pa1, pa2, pa3); pv_one<3>(o[3], vb, pa0, pa1, pa2, pa3);
}

template <int VAR>
__device__ __forceinline__ void attn_unit(const bf16_t* __restrict__ Qb, const bf16_t* __restrict__ Kh, const bf16_t* __restrict__ Vh, int nkeys,
                                          bf16_t* __restrict__ Ob, float lam, float osc, const float* __restrict__ sg, char* lds, const int tid) {
  const int wid = __builtin_amdgcn_readfirstlane(tid >> 6), lane = tid & 63, r32 = lane & 31, hi = lane >> 5;
  const int comp = wid >> 2, qw = wid & 3, kcol = comp * 128;
  char* K_lds = lds; char* V_lds = lds + 2 * SHM_K;
  float* ws = (float*)(lds + 2 * SHM_K + 3 * SHM_V) + wid * 64; float* li_l = ws; float* al_l = ws + 32;
  float m_reg = -1e30f, l_reg = 0; f32x16 o[4] = {}; bf16x8 qr[4];
  const bf16_t* Qw = Qb + (long)(qw * QBLK + r32) * LDQ + comp * 64 + hi * 8;
#pragma unroll
  for (int d0 = 0; d0 < 4; ++d0) qr[d0] = *reinterpret_cast<const bf16x8*>(Qw + d0 * 16);
  const int sr = tid >> 4, sc = (tid & 15) * 8, vst0 = v_st(sr, sc), vst1 = v_st(32 + sr, sc);
  const int vb0 = (int)(uintptr_t)V_lds + v_rd_base(lane);
  bf16x8 sk0 = {}, sk1 = {}, sv0 = {}, sv1 = {};
#define LOADK(t) do { if constexpr (!(VAR & 8)) { sk0 = *reinterpret_cast<const bf16x8*>(&Kh[(long)((t) * KVBLK + sr) * LDQ + sc]); sk1 = *reinterpret_cast<const bf16x8*>(&Kh[(long)((t) * KVBLK + 32 + sr) * LDQ + sc]); } } while (0)
#define LOADV(t) do { if constexpr (!(VAR & 8)) { sv0 = *reinterpret_cast<const bf16x8*>(&Vh[(long)((t) * KVBLK + sr) * LDQ + sc]); sv1 = *reinterpret_cast<const bf16x8*>(&Vh[(long)((t) * KVBLK + 32 + sr) * LDQ + sc]); } } while (0)
#define WRITEK(slot) do { if constexpr (!(VAR & 8)) { *(bf16x8*)(K_lds + (slot) * SHM_K + KSWZ(sr, sc * 2)) = sk0; *(bf16x8*)(K_lds + (slot) * SHM_K + KSWZ(32 + sr, sc * 2)) = sk1; } } while (0)
#define WRITEV(off) do { if constexpr (!(VAR & 8)) { *(bf16x8*)(V_lds + (off) + vst0) = sv0; *(bf16x8*)(V_lds + (off) + vst1) = sv1; } } while (0)
#define VMW() asm volatile("s_waitcnt vmcnt(0)" ::: "memory")
#define QKT(P0, P1, KS) do { if constexpr (VAR & 4) { P0 = f32x16{}; P1 = f32x16{}; asm volatile("" : "+v"(P0), "+v"(P1)); } else qkt(P0, P1, KS, qr, r32, hi, kcol); } while (0)
#define PSM(P0, P1, MN, AL) do { if constexpr (VAR & 1) { MN = m_reg; AL = 1.f; asm volatile("" : "+v"(P0), "+v"(P1)); } else partialSM(P0, P1, m_reg, MN, AL); } while (0)
#define FSM(P0, P1, AL) do { if constexpr (VAR & 1) { asm volatile("" : "+v"(P0), "+v"(P1)); pa0 = __builtin_bit_cast(bf16x8, (f32x4){P0[0], P0[1], P0[2], P0[3]}); pa1 = __builtin_bit_cast(bf16x8, (f32x4){P0[4], P0[5], P0[6], P0[7]}); pa2 = __builtin_bit_cast(bf16x8, (f32x4){P1[0], P1[1], P1[2], P1[3]}); pa3 = __builtin_bit_cast(bf16x8, (f32x4){P1[4], P1[5], P1[6], P1[7]}); } else finishSM(P0, P1, AL, l_reg, pa0, pa1, pa2, pa3); } while (0)
#define PV(OFF) do { if constexpr (VAR & 2) { asm volatile("" : "+v"(pa0), "+v"(pa1), "+v"(pa2), "+v"(pa3)); } else pv_d0(o, vb0 + (OFF), pa0, pa1, pa2, pa3); } while (0)
#define RESC(a) do { if (__any((a) < 1.f)) { if (hi == 0) al_l[r32] = (a); asm volatile("s_waitcnt lgkmcnt(0)" ::: "memory"); \
    _Pragma("unroll") for (int d = 0; d < 4; ++d) _Pragma("unroll") for (int r = 0; r < 16; ++r) o[d][r] *= al_l[crow(r, hi)]; } } while (0)
  f32x16 pA0, pA1, pB0, pB1; float mnA, mnB, alA, alB; bf16x8 pa0, pa1, pa2, pa3; const int NT = nkeys / KVBLK;
  LOADK(0); VMW(); WRITEK(0); LOADK(1); LOADV(0);
  __syncthreads();
  if (comp == 1) __syncthreads();
  VMW(); WRITEK(1); WRITEV(0);
  SBAR(); QKT(pA0, pA1, K_lds); SBAR();
  __syncthreads();
  LOADK(2); LOADV(1); SBAR();
  PSM(pA0, pA1, mnA, alA);
  __syncthreads();
  int va = 0, vb = SHM_V, vc = 2 * SHM_V;
  for (int j = 1; j + 1 < NT; j += 2) {
    VMW(); WRITEK(0); WRITEV(vb);
    SBAR(); QKT(pB0, pB1, K_lds + SHM_K);
    FSM(pA0, pA1, alA); SBAR();
    __syncthreads();
    LOADK(j + 2); LOADV(j + 1); SBAR();
    PV(va); PSM(pB0, pB1, mnB, alB);
    RESC(alB);
    __syncthreads();
    VMW(); WRITEK(1); WRITEV(vc);
    SBAR(); QKT(pA0, pA1, K_lds);
    FSM(pB0, pB1, alB); SBAR();
    __syncthreads();
    if (j + 3 < NT) LOADK(j + 3);
    LOADV(j + 2); SBAR();
    PV(vb); PSM(pA0, pA1, mnA, alA);
    RESC(alA);
    __syncthreads();
    { const int t = va; va = vc; vc = vb; vb = t; }
  }
  VMW(); WRITEV(vb);
  SBAR(); QKT(pB0, pB1, K_lds + SHM_K);
  FSM(pA0, pA1, alA); SBAR();
  __syncthreads();
  PV(va); PSM(pB0, pB1, mnB, alB);
  RESC(alB);
  __syncthreads();
  FSM(pB0, pB1, alB); SBAR();
  PV(vb);
  if (comp == 0) __syncthreads();
  if (hi == 0) li_l[r32] = l_reg; asm volatile("s_waitcnt lgkmcnt(0)" ::: "memory");
  float rli[16];
#pragma unroll
  for (int r = 0; r < 16; ++r) rli[r] = __builtin_amdgcn_rcpf(li_l[crow(r, hi)]);
  __syncthreads();
  float* XO = (float*)lds + qw * (32 * 128);
  if (comp == 1) {
#pragma unroll
    for (int r = 0; r < 16; ++r)
#pragma unroll
      for (int d0 = 0; d0 < 4; ++d0) XO[crow(r, hi) * 128 + d0 * 32 + r32] = o[d0][r] * rli[r];
  }
  __syncthreads();
  if (comp == 0) {
    float ss[16];
#pragma unroll
    for (int r = 0; r < 16; ++r) { float s = 0.f;
#pragma unroll
      for (int d0 = 0; d0 < 4; ++d0) { const float v = o[d0][r] * rli[r] - lam * XO[crow(r, hi) * 128 + d0 * 32 + r32]; o[d0][r] = v; s += v * v; }
      ss[r] = s; }
#pragma unroll
    for (int r = 0; r < 16; ++r) { float s = ss[r]; s += swz_xor<1>(s); s += swz_xor<2>(s); s += swz_xor<4>(s); s += swz_xor<8>(s); s += swz_xor<16>(s);
      ss[r] = osc / sqrtf(s * (1.0f / 128.0f) + EPS); }
    float gam[4];
#pragma unroll
    for (int d0 = 0; d0 < 4; ++d0) gam[d0] = sg[d0 * 32 + r32];
    asm volatile("s_waitcnt lgkmcnt(0)" ::: "memory");
    bf16_t* stg = (bf16_t*)XO;
#pragma unroll
    for (int r = 0; r < 16; ++r)
#pragma unroll
      for (int d0 = 0; d0 < 4; ++d0) stg[crow(r, hi) * 128 + d0 * 32 + r32] = (bf16_t)(cvtpk(o[d0][r] * ss[r] * gam[d0], 0.f) & 0xffffu);
    asm volatile("s_waitcnt lgkmcnt(0)" ::: "memory");
#pragma unroll
    for (int i = 0; i < 8; ++i) { const int row = i * 4 + (lane >> 4), ch = lane & 15; const u32x4 v = *(const u32x4*)(stg + row * 128 + ch * 8);
      if constexpr (VAR & 16) { asm volatile("" :: "v"(v.x), "v"(v.y), "v"(v.z), "v"(v.w)); } else *(u32x4*)(Ob + (long)(qw * QBLK + row) * LDO + ch * 8) = v; }
  }
  __syncthreads();
#undef LOADK
#undef LOADV
#undef WRITEK
#undef WRITEV
#undef VMW
#undef QKT
#undef PSM
#undef FSM
#undef PV
#undef RESC
}
#undef KSWZ
#undef SBAR
}
namespace att2 {
using att::crow; using att::v_st; using att::v_rd_base; using att::v_rd_off;
constexpr int NW = 8, QBLK = 32, KVBLK = 64, LDQ = 512, LDO = KCAT, SHM_K = 16384, SHM_V = 16384;
constexpr float THRL = 8.0f;
#ifndef ATT_STAGGER
#define ATT_STAGGER 1
#endif
typedef short v4i16_t __attribute__((ext_vector_type(4)));
typedef __attribute__((address_space(3))) const char* lds_cptr;
typedef __attribute__((address_space(3))) char* lds_ptr;
#define SBAR() __builtin_amdgcn_sched_barrier(0)
#define KSWZ(row, colB) ((row) * 256 + ((colB) ^ (((row) & 7) << 4)))
__device__ __forceinline__ s16x4 vtr(lds_cptr p) { return __builtin_bit_cast(s16x4, __builtin_amdgcn_ds_read_tr16_b64_v4i16((__attribute__((address_space(3))) v4i16_t*)p)); }
__device__ __forceinline__ bf16x8 ldk(lds_cptr p) { return *(const __attribute__((address_space(3))) bf16x8*)p; }
#define MF(D, A, B, C) do { if constexpr (VAR & 4) { asm volatile("" : "+v"(D)); } else D = __builtin_amdgcn_mfma_f32_32x32x16_bf16(A, B, C, 0, 0, 0); } while (0)
#define VF(L, H) (bf16x8){L[0], L[1], L[2], L[3], H[0], H[1], H[2], H[3]}

__device__ __forceinline__ int vkey(int g) { const int s_ = g >> 5, kk = ((s_ >> 2) << 3) | ((g >> 2) & 7); return (kk & ~0xC) | ((kk & 4) << 1) | ((kk & 8) >> 1); }
template <int VAR>
__device__ __forceinline__ void attn_unit(const bf16_t* __restrict__ Qb, const bf16_t* __restrict__ Kh, const bf16_t* __restrict__ Vh, int nkeys,
                                          bf16_t* __restrict__ Ob, float lam, float osc, const float* __restrict__ sg, char* lds, const int tid) {
  const int wid = __builtin_amdgcn_readfirstlane(tid >> 6), lane = tid & 63, r32 = lane & 31, hi = lane >> 5;
  const int comp = wid >> 2, qw = wid & 3, kcol = comp * 128;
  const lds_ptr L3 = (lds_ptr)(unsigned)(uintptr_t)lds;
  float* ws = (float*)(lds + 3 * SHM_K + 3 * SHM_V) + wid * 64; float* li_l = ws; float* al_l = ws + 32;
  float mhat = 0.f, l_reg = 0.f; f32x16 o[4] = {}; bf16x8 qr[4]; f32x16 negm = {};
  const bf16_t* Qw = Qb + (long)(qw * QBLK + r32) * LDQ + comp * 64 + hi * 8;
#pragma unroll
  for (int d0 = 0; d0 < 4; ++d0) qr[d0] = *reinterpret_cast<const bf16x8*>(Qw + d0 * 16);
  const int sr = tid >> 4, sc = (tid & 15) * 8;
  const int kr0 = 4 * wid + (lane >> 4), kr1 = kr0 + 32;
  const bf16_t* ksrc0 = Kh + (long)kr0 * LDQ + (((lane & 15) ^ (kr0 & 7)) << 3); const bf16_t* ksrc1 = Kh + (long)kr1 * LDQ + (((lane & 15) ^ (kr1 & 7)) << 3);
  const int g0_ = 64 * wid + lane, g1_ = g0_ + 512;
  const int vk0 = vkey(g0_), vk1 = vkey(g1_);
  const bf16_t* vsrc0 = Vh + (long)vk0 * LDQ + ((g0_ >> 5) & 3) * 32 + (g0_ & 3) * 8; const bf16_t* vsrc1 = Vh + (long)vk1 * LDQ + ((g1_ >> 5) & 3) * 32 + (g1_ & 3) * 8;
  const unsigned kd0 = (unsigned)(uintptr_t)lds + wid * 1024, kd1 = kd0 + 8192, vd0 = (unsigned)(uintptr_t)lds + 3 * SHM_K + wid * 1024, vd1 = vd0 + 8192;
  lds_cptr kq[4];
#pragma unroll
  for (int d0 = 0; d0 < 4; ++d0) kq[d0] = L3 + r32 * 256 + ((kcol + d0 * 32 + hi * 16) ^ ((r32 & 7) << 4));
  const lds_cptr vp0 = L3 + 3 * SHM_K + v_rd_base(lane);
#define GLDS(src, dst) __builtin_amdgcn_global_load_lds((const unsigned*)(src), (__attribute__((address_space(3))) unsigned*)(dst), 16, 0, 0)
#define DMAK(t, slot) do { if constexpr (!(VAR & 8)) { GLDS(ksrc0 + (long)(t) * KVBLK * LDQ, (unsigned)__builtin_amdgcn_readfirstlane(kd0 + (slot) * SHM_K)); GLDS(ksrc1 + (long)(t) * KVBLK * LDQ, (unsigned)__builtin_amdgcn_readfirstlane(kd1 + (slot) * SHM_K)); } } while (0)
#define DMAV(t, off) do { if constexpr (!(VAR & 8)) { GLDS(vsrc0 + (long)(t) * KVBLK * LDQ, (unsigned)__builtin_amdgcn_readfirstlane(vd0 + (off))); GLDS(vsrc1 + (long)(t) * KVBLK * LDQ, (unsigned)__builtin_amdgcn_readfirstlane(vd1 + (off))); } } while (0)
#ifndef ATT_PRIO
#define ATT_PRIO 1
#endif
#define PRIO(x) do { if (ATT_PRIO == 1) __builtin_amdgcn_s_setprio(x); } while (0)
#define PRIO1(x) do { if (ATT_PRIO == 2) __builtin_amdgcn_s_setprio(x); } while (0)
#define VMW() asm volatile("s_waitcnt vmcnt(0)" ::: "memory")
#define BARW(n) do { asm volatile("s_waitcnt vmcnt(" #n ") lgkmcnt(0)" ::: "memory"); if constexpr (!(VAR & 32)) __builtin_amdgcn_s_barrier(); asm volatile("" ::: "memory"); } while (0)
  f32x16 pA0, pA1, pB0, pB1; u32x4 pw0 = {}, pw1 = {}, pw2 = {}, pw3 = {}; const int NT = nkeys / KVBLK; bool resc = false;
#define KF(KOFF, d0, half) ldk(kq[d0] + (KOFF) + 8192 * (half))
#define PKA(P, B, A0, A1) do { if constexpr (!(VAR & 1)) { A0 = cvt2bf(P[B + 0], P[B + 1]); A1 = cvt2bf(P[B + 2], P[B + 3]); sacc += P[B + 0]; sacc += P[B + 1]; sacc += P[B + 2]; sacc += P[B + 3]; } } while (0)
#define PKB(P, B, A0, A1, PW) do { if constexpr (!(VAR & 1)) { const unsigned b0_ = cvt2bf(P[B + 4], P[B + 5]), b1_ = cvt2bf(P[B + 6], P[B + 7]); \
    auto r0_ = __builtin_amdgcn_permlane32_swap(A0, b0_, false, false); auto r1_ = __builtin_amdgcn_permlane32_swap(A1, b1_, false, false); \
    PW = (u32x4){r0_[0], r1_[0], r0_[1], r1_[1]}; sacc += P[B + 4]; sacc += P[B + 5]; sacc += P[B + 6]; sacc += P[B + 7]; } } while (0)
#define H1(C0, C1, P0, P1, KOFF, FIN) do { \
    float sacc = 0.f; unsigned a0_ = 0, a1_ = 0; \
    bf16x8 f0 = KF(KOFF, 0, 0), f1 = KF(KOFF, 0, 1), f2 = KF(KOFF, 1, 0); SBAR(); \
    MF(C0, f0, qr[0], negm); { f0 = KF(KOFF, 1, 1); if (FIN) PKA(P0, 0, a0_, a1_); } SBAR(); \
    MF(C1, f1, qr[0], negm); { f1 = KF(KOFF, 2, 0); if (FIN) PKB(P0, 0, a0_, a1_, pw0); } SBAR(); \
    MF(C0, f2, qr[1], C0);   { f2 = KF(KOFF, 2, 1); if (FIN) PKA(P0, 8, a0_, a1_); } SBAR(); \
    MF(C1, f0, qr[1], C1);   { f0 = KF(KOFF, 3, 0); if (FIN) PKB(P0, 8, a0_, a1_, pw1); } SBAR(); \
    MF(C0, f1, qr[2], C0);   { f1 = KF(KOFF, 3, 1); if (FIN) PKA(P1, 0, a0_, a1_); } SBAR(); \
    MF(C1, f2, qr[2], C1);   { if (FIN) PKB(P1, 0, a0_, a1_, pw2); } SBAR(); \
    MF(C0, f0, qr[3], C0);   { if (FIN) PKA(P1, 8, a0_, a1_); } SBAR(); \
    MF(C1, f1, qr[3], C1);   { if (FIN) PKB(P1, 8, a0_, a1_, pw3); } SBAR(); \
    if (FIN) { auto rr_ = __builtin_amdgcn_permlane32_swap(__float_as_uint(sacc), __float_as_uint(sacc), false, false); l_reg += __uint_as_float(rr_[0]) + __uint_as_float(rr_[1]); } \
  } while (0)
#define VRD(VOFF, ks, d0, LO, HI) do { LO = vtr(vp0 + (VOFF) + v_rd_off(d0, ks, 0)); HI = vtr(vp0 + (VOFF) + v_rd_off(d0, ks, 1)); } while (0)
#define PAF(k) __builtin_bit_cast(bf16x8, pw##k)
#define MX3(a, b, c) ((VAR & 2) ? (a) : fmaxf(fmaxf((a), (b)), (c)))
#define EX(X, i) do { if constexpr (!(VAR & 2)) X[i] = __builtin_amdgcn_exp2f(X[i]); } while (0)
#define PIN2(X, Y) asm volatile("" : "+v"(X), "+v"(Y))
#define H2(C0, C1, VOFF, DOPV, FIRST) do { \
    s16x4 l0, h0, l1, h1, l2, h2; float ma, mb, rm; \
    if (DOPV) { VRD(VOFF, 0, 0, l0, h0); VRD(VOFF, 0, 1, l1, h1); VRD(VOFF, 0, 2, l2, h2); } SBAR(); \
    if (DOPV) { MF(o[0], PAF(0), VF(l0, h0), o[0]); VRD(VOFF, 0, 3, l0, h0); } ma = MX3(C0[0], C0[1], C1[0]); mb = MX3(C0[2], C0[3], C1[1]); ma = MX3(ma, C1[2], C1[3]); mb = MX3(mb, C0[4], C0[5]); SBAR(); \
    if (DOPV) { MF(o[1], PAF(0), VF(l1, h1), o[1]); VRD(VOFF, 1, 0, l1, h1); } ma = MX3(ma, C0[6], C0[7]); mb = MX3(mb, C1[4], C1[5]); ma = MX3(ma, C1[6], C1[7]); mb = MX3(mb, C0[8], C0[9]); SBAR(); \
    if (DOPV) { MF(o[2], PAF(0), VF(l2, h2), o[2]); VRD(VOFF, 1, 1, l2, h2); } ma = MX3(ma, C0[10], C0[11]); mb = MX3(mb, C1[8], C1[9]); ma = MX3(ma, C1[10], C1[11]); mb = MX3(mb, C0[12], C0[13]); SBAR(); \
    if (DOPV) { MF(o[3], PAF(0), VF(l0, h0), o[3]); VRD(VOFF, 1, 2, l0, h0); } ma = MX3(ma, C0[14], C0[15]); mb = MX3(mb, C1[12], C1[13]); ma = MX3(ma, C1[14], C1[15]); rm = fmaxf(ma, mb); SBAR(); \
    if (DOPV) { MF(o[0], PAF(1), VF(l1, h1), o[0]); VRD(VOFF, 1, 3, l1, h1); } \
    { auto rr_ = __builtin_amdgcn_permlane32_swap(__float_as_uint(rm), __float_as_uint(rm), false, false); rm = fmaxf(__uint_as_float(rr_[0]), __uint_as_float(rr_[1])); } SBAR(); \
    resc = false; \
    if (FIRST || __builtin_expect(__any(rm > THRL), 0)) { const float dl = FIRST ? rm : fmaxf(rm, 0.f); mhat += dl; \
      _Pragma("unroll") for (int r = 0; r < 16; ++r) { C0[r] -= dl; C1[r] -= dl; } \
      _Pragma("unroll") for (int r = 0; r < 16; ++r) negm[r] = -mhat; \
      if (!(FIRST)) { const float f = __builtin_amdgcn_exp2f(-dl); l_reg *= f; if (hi == 0) al_l[r32] = f; resc = true; } } \
    SBAR(); \
    if (DOPV) { MF(o[1], PAF(1), VF(l2, h2), o[1]); VRD(VOFF, 2, 0, l2, h2); } EX(C0, 0); EX(C0, 1); EX(C0, 2); PIN2(C0, C1); SBAR(); \
    if (DOPV) { MF(o[2], PAF(1), VF(l0, h0), o[2]); VRD(VOFF, 2, 1, l0, h0); } EX(C0, 3); EX(C0, 4); EX(C0, 5); PIN2(C0, C1); SBAR(); \
    if (DOPV) { MF(o[3], PAF(1), VF(l1, h1), o[3]); VRD(VOFF, 2, 2, l1, h1); } EX(C0, 6); EX(C0, 7); EX(C0, 8); PIN2(C0, C1); SBAR(); \
    if (DOPV) { MF(o[0], PAF(2), VF(l2, h2), o[0]); VRD(VOFF, 2, 3, l2, h2); } EX(C0, 9); EX(C0, 10); EX(C0, 11); PIN2(C0, C1); SBAR(); \
    if (DOPV) { MF(o[1], PAF(2), VF(l0, h0), o[1]); VRD(VOFF, 3, 0, l0, h0); } EX(C0, 12); EX(C0, 13); EX(C0, 14); PIN2(C0, C1); SBAR(); \
    if (DOPV) { MF(o[2], PAF(2), VF(l1, h1), o[2]); VRD(VOFF, 3, 1, l1, h1); } EX(C0, 15); EX(C1, 0); EX(C1, 1); PIN2(C0, C1); SBAR(); \
    if (DOPV) { MF(o[3], PAF(2), VF(l2, h2), o[3]); VRD(VOFF, 3, 2, l2, h2); } EX(C1, 2); EX(C1, 3); EX(C1, 4); PIN2(C0, C1); SBAR(); \
    if (DOPV) { MF(o[0], PAF(3), VF(l0, h0), o[0]); VRD(VOFF, 3, 3, l0, h0); } EX(C1, 5); EX(C1, 6); EX(C1, 7); PIN2(C0, C1); SBAR(); \
    if (DOPV) { MF(o[1], PAF(3), VF(l1, h1), o[1]); } EX(C1, 8); EX(C1, 9); EX(C1, 10); PIN2(C0, C1); SBAR(); \
    if (DOPV) { MF(o[2], PAF(3), VF(l2, h2), o[2]); } EX(C1, 11); EX(C1, 12); EX(C1, 13); PIN2(C0, C1); SBAR(); \
    if (DOPV) { MF(o[3], PAF(3), VF(l0, h0), o[3]); } EX(C1, 14); EX(C1, 15); PIN2(C0, C1); SBAR(); \
    if (resc) { asm volatile("s_waitcnt lgkmcnt(0)" ::: "memory"); \
      _Pragma("unroll") for (int d = 0; d < 4; ++d) _Pragma("unroll") for (int r = 0; r < 16; ++r) o[d][r] *= al_l[crow(r, hi)]; } \
  } while (0)
#define PVONLY(VOFF) do { _Pragma("unroll") for (int ks = 0; ks < 4; ++ks) _Pragma("unroll") for (int d0 = 0; d0 < 4; ++d0) { s16x4 l_, h_; VRD(VOFF, ks, d0, l_, h_); \
      const bf16x8 pa_ = ks == 0 ? PAF(0) : ks == 1 ? PAF(1) : ks == 2 ? PAF(2) : PAF(3); MF(o[d0], pa_, VF(l_, h_), o[d0]); } } while (0)

  DMAK(0, 0); DMAK(1, 1); DMAV(0, 0);
  BARW(0);
  if (ATT_STAGGER && comp == 1) __builtin_amdgcn_s_barrier();
  H1(pA0, pA1, pB0, pB1, 0, false);
  BARW(0);
  DMAK(2, 2); DMAV(1, SHM_V); SBAR();
  H2(pA0, pA1, 0, false, true);
  BARW(4);
  int va = 0, vb = SHM_V, vc = 2 * SHM_V;
  for (int j = 1; j + 1 < NT; j += 2) {
    PRIO1(1); H1(pB0, pB1, pA0, pA1, vb, true); PRIO1(0);
    BARW(0);
    DMAK(j + 2, va >> 14); DMAV(j + 1, vc); SBAR();
    PRIO(1); H2(pB0, pB1, va, true, false); PRIO(0);
    BARW(4);
    PRIO1(1); H1(pA0, pA1, pB0, pB1, vc, true); PRIO1(0);
    BARW(0);
    if (j + 3 < NT) DMAK(j + 3, vb >> 14);
    DMAV(j + 2, va); SBAR();
    PRIO(1); H2(pA0, pA1, vb, true, false); PRIO(0);
    BARW(4);
    { const int t = va; va = vc; vc = vb; vb = t; }
  }
  H1(pB0, pB1, pA0, pA1, vb, true);
  BARW(0);
  H2(pB0, pB1, va, true, false);
  BARW(0);
  { float sacc = 0.f; unsigned a0_ = 0, a1_ = 0;
    PKA(pB0, 0, a0_, a1_); PKB(pB0, 0, a0_, a1_, pw0); PKA(pB0, 8, a0_, a1_); PKB(pB0, 8, a0_, a1_, pw1); PKA(pB1, 0, a0_, a1_); PKB(pB1, 0, a0_, a1_, pw2); PKA(pB1, 8, a0_, a1_); PKB(pB1, 8, a0_, a1_, pw3);
    auto rr_ = __builtin_amdgcn_permlane32_swap(__float_as_uint(sacc), __float_as_uint(sacc), false, false); l_reg += __uint_as_float(rr_[0]) + __uint_as_float(rr_[1]); }
  SBAR(); PVONLY(vb);
  if (ATT_STAGGER && comp == 0) { asm volatile("s_waitcnt lgkmcnt(0)" ::: "memory"); __builtin_amdgcn_s_barrier(); }
  if (hi == 0) li_l[r32] = l_reg; asm volatile("s_waitcnt lgkmcnt(0)" ::: "memory");
  float rli[16];
#pragma unroll
  for (int r = 0; r < 16; ++r) rli[r] = __builtin_amdgcn_rcpf(li_l[crow(r, hi)]);
  __syncthreads();
  float* XO = (float*)lds + qw * (32 * 128);
  if (comp == 1) {
#pragma unroll
    for (int r = 0; r < 16; ++r)
#pragma unroll
      for (int d0 = 0; d0 < 4; ++d0) XO[crow(r, hi) * 128 + d0 * 32 + r32] = o[d0][r] * rli[r];
  }
  __syncthreads();
  if (comp == 0) {
    float ss[16];
#pragma unroll
    for (int r = 0; r < 16; ++r) { float s = 0.f;
#pragma unroll
      for (int d0 = 0; d0 < 4; ++d0) { const float v = o[d0][r] * rli[r] - lam * XO[crow(r, hi) * 128 + d0 * 32 + r32]; o[d0][r] = v; s += v * v; }
      ss[r] = s; }
#pragma unroll
    for (int r = 0; r < 16; ++r) { float s = ss[r]; s += swz_xor<1>(s); s += swz_xor<2>(s); s += swz_xor<4>(s); s += swz_xor<8>(s); s += swz_xor<16>(s);
      ss[r] = osc / sqrtf(s * (1.0f / 128.0f) + EPS); }
    float gam[4];
#pragma unroll
    for (int d0 = 0; d0 < 4; ++d0) gam[d0] = sg[d0 * 32 + r32];
    asm volatile("s_waitcnt lgkmcnt(0)" ::: "memory");
    bf16_t* stg = (bf16_t*)XO;
#pragma unroll
    for (int r = 0; r < 16; ++r)
#pragma unroll
      for (int d0 = 0; d0 < 4; ++d0) stg[crow(r, hi) * 128 + d0 * 32 + r32] = (bf16_t)(cvt2bf(o[d0][r] * ss[r] * gam[d0], 0.f) & 0xffffu);
    asm volatile("s_waitcnt lgkmcnt(0)" ::: "memory");
#pragma unroll
    for (int i = 0; i < 8; ++i) { const int row = i * 4 + (lane >> 4), ch = lane & 15; const u32x4 v = *(const u32x4*)(stg + row * 128 + ch * 8);
      if constexpr (VAR & 16) { asm volatile("" :: "v"(v.x), "v"(v.y), "v"(v.z), "v"(v.w)); } else *(u32x4*)(Ob + (long)(qw * QBLK + row) * LDO + ch * 8) = v; }
  }
  __syncthreads();
#undef GLDS
#undef DMAK
#undef DMAV
#undef VMW
#undef PRIO
#undef PRIO1
#undef BARW
#undef KF
#undef PKA
#undef PKB
#undef H1
#undef VRD
#undef PAF
#undef MX3
#undef EX
#undef PIN2
#undef H2
#undef PVONLY
}
#undef SBAR
#undef KSWZ
#undef MF
#undef VF
}
typedef GAS unsigned gu32;
#define RLX_AGENT __ATOMIC_RELAXED, __HIP_MEMORY_SCOPE_AGENT
constexpr int PT_OFF = LDSCTL_OFF + 1024;
__device__ __forceinline__ unsigned long long ldptr(volatile LAS unsigned long long* PT, int i) {
    const unsigned long long v = PT[i];
    const unsigned lo = __builtin_amdgcn_readfirstlane((unsigned)v), hi = __builtin_amdgcn_readfirstlane((unsigned)(v >> 32));
    return ((unsigned long long)hi << 32) | lo;
}
#define XB_TMO      128
#define XB_XCNT(j)  (256  + 64 * (j))
#define XB_XSUB(j)  (1280 + 64 * (j))
#define XB_XGEN(j)  (2304 + 64 * (j))
#define XB_TOP      3328
#define XB_TOPGEN   3392
#define XCD_BAR_WORDS 3456
#define XB_SPIN_CAP (1u << 18)

__device__ __forceinline__ unsigned xb_ld(unsigned* p)              { return __hip_atomic_load(p, __ATOMIC_RELAXED, __HIP_MEMORY_SCOPE_AGENT); }
__device__ __forceinline__ unsigned xb_add(unsigned* p, unsigned v) { return __hip_atomic_fetch_add(p, v, __ATOMIC_RELAXED, __HIP_MEMORY_SCOPE_AGENT); }
__device__ __forceinline__ unsigned xb_xcc_id() { return (unsigned)__builtin_amdgcn_s_getreg((3 << 11) | 20) & 0xFu; }
#define XB_SPIN(cond, bar) do { unsigned _sp = 0; while (cond) { __builtin_amdgcn_s_sleep(1); \
    if ((++_sp & 255u) == 0u) { if (xb_ld(&(bar)[XB_TMO])) break; if (_sp > XB_SPIN_CAP) { atomicAdd(&(bar)[XB_TMO], 1u); break; } } } } while (0)

struct XcdBarrier {
    unsigned* bar; unsigned x;
    volatile LAS unsigned* st;
};

__device__ __forceinline__ XcdBarrier xcd_barrier_post(unsigned* bar, volatile LAS unsigned* st) {
    XcdBarrier b; b.bar = bar; b.x = xb_xcc_id(); b.st = st;
    if (threadIdx.x == 0) (void)xb_add(&bar[XB_XCNT(b.x)], 1u);
    return b;
}
__device__ __forceinline__ void xcd_barrier_complete(unsigned* bar, unsigned x, unsigned& nloc, unsigned& nx) {
    const unsigned G = gridDim.x * gridDim.y * gridDim.z;
    unsigned sum, cnt, mine, sp = 0u;
    for (;;) {
        sum = 0u; cnt = 0u; mine = 0u;
#pragma unroll
        for (unsigned j = 0; j < 16; ++j) { const unsigned c = xb_ld(&bar[XB_XCNT(j)]); sum += c; cnt += (c > 0u) ? 1u : 0u; mine = (j == x) ? c : mine; }
        if (sum == G) break;
        __builtin_amdgcn_s_sleep(1);
        if ((++sp & 255u) == 0u) { if (xb_ld(&bar[XB_TMO])) break; if (sp > XB_SPIN_CAP) { atomicAdd(&bar[XB_TMO], 1u); break; } }
    }
    nloc = mine > 0u ? mine : 1u; nx = cnt > 0u ? cnt : 1u;
}

__device__ __forceinline__ void xcd_barrier(const XcdBarrier& b) {
    asm volatile("s_waitcnt vmcnt(0)" ::: "memory");
    __syncthreads();
    if (threadIdx.x == 0) {
        unsigned* bar = b.bar;
        __builtin_amdgcn_s_waitcnt(0);
        unsigned nloc = b.st[0], nx = b.st[1];
        if (nloc == 0u) { xcd_barrier_complete(bar, b.x, nloc, nx); b.st[0] = nloc; b.st[1] = nx; }
        const unsigned old = xb_add(&bar[XB_XSUB(b.x)], 1u);
        const unsigned gen = old / nloc;
        if (old + 1u == (gen + 1u) * nloc) {
            __builtin_amdgcn_fence(__ATOMIC_RELEASE, "agent");
            asm volatile("s_waitcnt vmcnt(0)" ::: "memory");
            const unsigned og = xb_add(&bar[XB_TOP], 1u);
            const unsigned tg = og / nx;
            if (og + 1u == (tg + 1u) * nx) xb_add(&bar[XB_TOPGEN], 1u);
            else XB_SPIN(xb_ld(&bar[XB_TOPGEN]) == tg, bar);
            __builtin_amdgcn_fence(__ATOMIC_ACQUIRE, "agent");
            xb_add(&bar[XB_XGEN(b.x)], 1u);
            asm volatile("s_waitcnt vmcnt(0)" ::: "memory");
        } else {
            XB_SPIN(xb_ld(&bar[XB_XGEN(b.x)]) == gen, bar);
            __builtin_amdgcn_fence(__ATOMIC_ACQUIRE, "agent");
            asm volatile("s_waitcnt vmcnt(0)" ::: "memory");
        }
    }
    __syncthreads();
}
__device__ __forceinline__ float wave_sum(float v) {
    v += swz_xor<1>(v); v += swz_xor<2>(v); v += swz_xor<4>(v); v += swz_xor<8>(v); v += swz_xor<16>(v);
    auto rr = __builtin_amdgcn_permlane32_swap(__float_as_uint(v), __float_as_uint(v), false, false);
    return __uint_as_float(rr[0]) + __uint_as_float(rr[1]);
}
__device__ __forceinline__ unsigned pk2(float lo, float hi) { return cvt2bf(lo, hi); }

template <int MAP  >
__device__ __forceinline__ void transpose_item(const float* W, int Nsrc, int coff, bf16_t* WT, int ldw, int koff, int nblk, LAS float* scr, int item, int lane) {
    const int kb = item / nblk, nb = item % nblk, k0 = 64 * kb, n0 = 32 * nb;
    const int nd = n0 + (lane & 31); const int scol = MAP ? in_map(nd) : nd + coff;
    float wv[32];
#pragma unroll
    for (int i = 0; i < 32; ++i) wv[i] = W[(size_t)(k0 + 2 * i + (lane >> 5)) * Nsrc + scol];
#pragma unroll
    for (int i = 0; i < 32; ++i) scr[(2 * i + (lane >> 5)) * 33 + (lane & 31)] = wv[i];
    asm volatile("s_waitcnt lgkmcnt(0)" ::: "memory");
    const int c = lane & 7;
#pragma unroll
    for (int j = 0; j < 4; ++j) { const int n = (lane >> 3) + 8 * j; const LAS float* s = scr + (8 * c) * 33 + n;
        u32x4 o; o.x = pk2(s[0 * 33], s[1 * 33]); o.y = pk2(s[2 * 33], s[3 * 33]); o.z = pk2(s[4 * 33], s[5 * 33]); o.w = pk2(s[6 * 33], s[7 * 33]);
        *(u32x4*)(WT + (size_t)(n0 + n) * ldw + koff + k0 + 8 * c) = o; }
    asm volatile("s_waitcnt lgkmcnt(0)" ::: "memory");
}
struct WSrc { const float *w_in, *wo_f, *wo_a, *wo_c, *wo_p, *w_out, *w_up, *w_down; };
constexpr int IT_A = 16 * 208;
constexpr int IT_B0 = 4 * 32, IT_B1 = 8 * 32, IT_B2 = 4 * 32, IT_B3 = 4 * 32, IT_B4 = 16 * 32, IT_B5 = 16 * 88, IT_B6 = 16 * 88, IT_B7 = 44 * 32;
constexpr int ITU_CAT = IT_A, ITU_DN = ITU_CAT + IT_B0 + IT_B1 + IT_B2 + IT_B3 + IT_B4, ITU_UPG = ITU_DN + IT_B7, ITU_UPV = ITU_UPG + IT_B5, ITU_END = ITU_UPV + IT_B6;
struct WDst { bf16_t *wa, *wcat, *wout, *wdn, *wupg, *wupv; };
template <int MASK  >
__device__ __forceinline__ void convert_items(const WSrc& S, const WDst& D, LAS float* scr, int lo, int hi, int wi, int nw, int lane) {
    for (int it = lo + wi; it < hi; it += nw) { int r = it;
        if (MASK & 1) { if (r < IT_A) { transpose_item<1>(S.w_in, NIN, 0, D.wa, 1024, 0, 208, scr, r, lane); continue; } } r -= IT_A;
        if (MASK & 2) {
            if (r < IT_B0) { transpose_item<0>(S.wo_f, 1024, 0, D.wcat, KCAT, 0, 32, scr, r, lane); continue; } r -= IT_B0;
            if (r < IT_B1) { transpose_item<0>(S.wo_a, 1024, 0, D.wcat, KCAT, 256, 32, scr, r, lane); continue; } r -= IT_B1;
            if (r < IT_B2) { transpose_item<0>(S.wo_c, 1024, 0, D.wcat, KCAT, 768, 32, scr, r, lane); continue; } r -= IT_B2;
            if (r < IT_B3) { transpose_item<0>(S.wo_p, 1024, 0, D.wcat, KCAT, 1024, 32, scr, r, lane); continue; } r -= IT_B3;
            if (r < IT_B4) { transpose_item<0>(S.w_out, 1024, 0, D.wout, 1024, 0, 32, scr, r, lane); continue; } r -= IT_B4;
        } else r -= IT_B0 + IT_B1 + IT_B2 + IT_B3 + IT_B4;
        if (MASK & 4) { if (r < IT_B7) { transpose_item<0>(S.w_down, 1024, 0, D.wdn, DFF, 0, 32, scr, r, lane); continue; } } r -= IT_B7;
        if (MASK & 8) { if (r < IT_B5) { transpose_item<0>(S.w_up, 2 * DFF, DFF, D.wupg, 1024, 0, 88, scr, r, lane); continue; } } r -= IT_B5;
        if (MASK & 16) { if (r < IT_B6) transpose_item<0>(S.w_up, 2 * DFF, 0, D.wupv, 1024, 0, 88, scr, r, lane); }
    }
}

__device__ __forceinline__ void mod_phase(const float* c, const float* c_ctx, const float* ada_w, const float* ada_b, float* MOD, LAS unsigned char* lds, int vcu, int G, int tid, int wave, int lane) {
    LAS float* sil = (LAS float*)lds;
    LAS float* red = (LAS float*)(lds + 12288);
    for (int i = tid; i < 3072; i += 512) { const float v = i < 2048 ? c[i] : c_ctx[i - 2048]; sil[i] = v * sigm(v); }
    __syncthreads();
    for (int item = vcu; item < 192; item += G) {
        const int l = item / 96, n = (item % 96) * 64 + lane;
        const float* W = ada_w + (size_t)l * 1024 * 6144 + n;
        float a0 = 0.f, a1 = 0.f, a2 = 0.f;
        for (int k = wave * 128; k < wave * 128 + 128; k += 64) { float w[64];
#pragma unroll
            for (int i = 0; i < 64; ++i) w[i] = W[(size_t)(k + i) * 6144];
#pragma unroll
            for (int i = 0; i < 64; ++i) { a0 += sil[k + i] * w[i]; a1 += sil[1024 + k + i] * w[i]; a2 += sil[2048 + k + i] * w[i]; } }
        red[(wave * 3 + 0) * 64 + lane] = a0; red[(wave * 3 + 1) * 64 + lane] = a1; red[(wave * 3 + 2) * 64 + lane] = a2;
        __syncthreads();
        if (wave < 3) { float s = ada_b[l * 6144 + n];
#pragma unroll
            for (int w = 0; w < 8; ++w) s += red[(w * 3 + wave) * 64 + lane];
            MOD[(size_t)(l * 3 + wave) * 6144 + n] = s; }
        __syncthreads();
    }
}
__device__ __forceinline__ void tables_phase(float* ROPE, f32x2* TW, int gt, int NGT) {
    for (int i = gt; i < 192 * 16; i += NGT) { const int pos = i >> 4, f = i & 15; const float inv = powf(10000.0f, -(float)f / 16.0f); const float ang = (float)(pos < 128 ? pos : pos - 128) * inv;
        float s, c; sincosf(ang, &s, &c); ROPE[pos * 32 + f] = c; ROPE[pos * 32 + 16 + f] = s; }
    for (int i = gt; i < 8192; i += NGT) { float s, c; sincospif((float)i * (1.0f / 4096.0f), &s, &c); TW[i] = (f32x2){c, -s}; }
}

template <bool LATBF>
__device__ __forceinline__ void norm_phase(const void* src_lat_, const float* src_ctx, int nrows, const float* gamma, const float* mod, int shoff, int scoff, bf16_t* HX, int gw, int NGW, int lane,
                                           const float* slab = nullptr, int nsl = 0, const float* cgate = nullptr, float* ctx_out = nullptr) {
    for (int m0 = gw; m0 < nrows; m0 += 4 * NGW) {
        f32x4 v[4][4]; float s[4];
#pragma unroll
        for (int u = 0; u < 4; ++u) { const int m = m0 + u * NGW; s[u] = 0.f;
            if (m < nrows) {
                if (LATBF && m < ML) { const u32x2* xb = (const u32x2*)((const bf16_t*)src_lat_ + (size_t)m * DM);
#pragma unroll
                    for (int j = 0; j < 4; ++j) { const u32x2 w = xb[lane + 64 * j]; v[u][j] = (f32x4){__uint_as_float(w.x << 16), __uint_as_float(w.x & 0xffff0000u), __uint_as_float(w.y << 16), __uint_as_float(w.y & 0xffff0000u)}; } }
                else { const float* xr = m < ML ? (const float*)src_lat_ + (size_t)m * DM : src_ctx + (size_t)(m - ML) * DM;
#pragma unroll
                    for (int j = 0; j < 4; ++j) v[u][j] = ((const f32x4*)xr)[lane + 64 * j]; }
                if (slab && m >= ML) {
#pragma unroll
                    for (int j = 0; j < 4; ++j) { f32x4 a = {0.f, 0.f, 0.f, 0.f};
                        for (int sl = 0; sl < nsl; ++sl) a += ((const f32x4*)(slab + (size_t)sl * 512 * 1024 + (size_t)(m - ML) * DM))[lane + 64 * j];
                        v[u][j] += ((const f32x4*)cgate)[lane + 64 * j] * a; ((f32x4*)(ctx_out + (size_t)(m - ML) * DM))[lane + 64 * j] = v[u][j]; } } } }
#pragma unroll
        for (int u = 0; u < 4; ++u) { const int m = m0 + u * NGW; if (m < nrows) {
#pragma unroll
            for (int j = 0; j < 4; ++j) s[u] += (v[u][j].x * v[u][j].x + v[u][j].y * v[u][j].y) + (v[u][j].z * v[u][j].z + v[u][j].w * v[u][j].w);
            const float rstd = 1.0f / sqrtf(wave_sum(s[u]) * (1.0f / DM) + EPS);
            const float* md = mod + (m < SEQ ? 0 : m < ML ? 1 : 2) * 6144;
#pragma unroll
            for (int j = 0; j < 4; ++j) { const int col = 4 * lane + 256 * j;
                const f32x4 g = *(const f32x4*)(gamma + col), sc = *(const f32x4*)(md + scoff + col), sh = *(const f32x4*)(md + shoff + col);
                const f32x4 o = v[u][j] * rstd * g * (sc + 1.0f) + sh;
                u32x2 w; w.x = pk2(o.x, o.y); w.y = pk2(o.z, o.w); *(u32x2*)(HX + (size_t)m * DM + col) = w; } } }
    }
}
__device__ __forceinline__ void final_norm_phase(const bf16_t* xb, float* out, const float* gamma, int gw, int NGW, int lane) {
    for (int m0 = gw; m0 < ML; m0 += 4 * NGW) {
        f32x4 v[4][4];
#pragma unroll
        for (int u = 0; u < 4; ++u) { const int m = m0 + u * NGW; if (m < ML) { const u32x2* xr = (const u32x2*)(xb + (size_t)m * DM);
#pragma unroll
            for (int j = 0; j < 4; ++j) { const u32x2 w = xr[lane + 64 * j]; v[u][j] = (f32x4){__uint_as_float(w.x << 16), __uint_as_float(w.x & 0xffff0000u), __uint_as_float(w.y << 16), __uint_as_float(w.y & 0xffff0000u)}; } } }
#pragma unroll
        for (int u = 0; u < 4; ++u) { const int m = m0 + u * NGW; if (m < ML) { float s = 0.f;
#pragma unroll
            for (int j = 0; j < 4; ++j) s += (v[u][j].x * v[u][j].x + v[u][j].y * v[u][j].y) + (v[u][j].z * v[u][j].z + v[u][j].w * v[u][j].w);
            const float rstd = 1.0f / sqrtf(wave_sum(s) * (1.0f / DM) + EPS);
#pragma unroll
            for (int j = 0; j < 4; ++j) { const f32x4 g = *(const f32x4*)(gamma + 4 * lane + 256 * j); ((f32x4*)(out + (size_t)m * DM))[lane + 64 * j] = v[u][j] * rstd * g; } } }
    }
}

#define SWZ(row, colB) ((row) * 256 + ((colB) ^ (((row) & 7) << 4)))
__device__ __forceinline__ int crow_(int r, int hi) { return (r & 3) + 8 * (r >> 2) + 4 * hi; }
__device__ __forceinline__ bf16x8 pack_bf8(const float* v) { u32x4 w; w.x = pk2(v[0], v[1]); w.y = pk2(v[2], v[3]); w.z = pk2(v[4], v[5]); w.w = pk2(v[6], v[7]); return __builtin_bit_cast(bf16x8, w); }
__device__ __forceinline__ void fft1_phase(const bf16_t* UF, const f32x2* TW, unsigned* FA, LAS unsigned char* lds, int vcu, int G, int tid, int wave, int lane) {
    const int tr = wave >> 1, tc = wave & 1, r32 = lane & 31, hi = lane >> 5;
    bf16x8 aRe[8], aIm[8];
#pragma unroll
    for (int ks = 0; ks < 8; ++ks) { float cv[8], sv[8];
#pragma unroll
        for (int j = 0; j < 8; ++j) { const int idx = ((32 * tr + r32) * (16 * ks + 8 * hi + j)) & 127; float s, c; sincospif((float)idx * (1.0f / 64.0f), &s, &c); cv[j] = c; sv[j] = -s; }
        aRe[ks] = pack_bf8(cv); aIm[ks] = pack_bf8(sv); }
    for (int item = vcu; item < 512; item += G) {
        const int b = item >> 8, g = (item >> 6) & 3, l2 = item & 63;
#pragma unroll
        for (int i = 0; i < 2; ++i) { const int q = tid + 512 * i, l1 = q >> 3, c8 = (q & 7) * 8;
            const u32x4 v = *(const u32x4*)(UF + (size_t)(b * SEQ + 64 * l1 + l2) * 256 + g * 64 + c8);
#pragma unroll
            for (int e = 0; e < 8; ++e) { const unsigned w = v[e >> 1]; *(LAS bf16_t*)(lds + SWZ(c8 + e, l1 * 2)) = (bf16_t)((e & 1) ? (w >> 16) : (w & 0xffffu)); } }
        __syncthreads();
        f32x16 re = {}, im = {};
#pragma unroll
        for (int ks = 0; ks < 8; ++ks) { const bf16x8 bx = *(const LAS bf16x8*)(lds + SWZ(32 * tc + r32, (16 * ks + 8 * hi) * 2));
            re = __builtin_amdgcn_mfma_f32_32x32x16_bf16(aRe[ks], bx, re, 0, 0, 0); im = __builtin_amdgcn_mfma_f32_32x32x16_bf16(aIm[ks], bx, im, 0, 0, 0); }
        unsigned* dst = FA + ((size_t)((b * 4 + g) * 64 + l2) * 128) * 64 + 32 * tc + r32;
#pragma unroll
        for (int r = 0; r < 16; ++r) { const int k1 = 32 * tr + crow_(r, hi); const f32x2 t = TW[k1 * l2];
            dst[(size_t)k1 * 64] = pk2(re[r] * t.x - im[r] * t.y, re[r] * t.y + im[r] * t.x); }
        __syncthreads();
    }
}
__device__ __forceinline__ void fft2_phase(const unsigned* FA, bf16_t* ACAT, LAS unsigned char* lds, int vcu, int G, int tid, int wave, int lane) {
    const int tr = wave >> 1, tc = wave & 1, r32 = lane & 31, hi = lane >> 5;
    bf16x8 a2[8], b3[8];
#pragma unroll
    for (int ks = 0; ks < 8; ++ks) { float av[8], bv[8];
#pragma unroll
        for (int j = 0; j < 8; ++j) { const int R = 32 * tr + r32, k = 16 * ks + 8 * hi + j, k2 = R & 63, ll = k & 63; float s, c; sincospif((float)((k2 * ll) & 63) * (1.0f / 32.0f), &s, &c);
            av[j] = (R < 64) ? ((k < 64) ? c : s) : ((k < 64) ? -s : c);
            const int m = 32 * tc + r32; float s2, c2; sincospif((float)((m * ll) & 63) * (1.0f / 32.0f), &s2, &c2); bv[j] = (k < 64) ? c2 : s2; }
        a2[ks] = pack_bf8(av); b3[ks] = pack_bf8(bv); }
    LAS unsigned char* Bt = lds;
    LAS unsigned char* Zt = lds + 16384;
    for (int item = vcu; item < 1024; item += G) {
        const int b = item >> 9, g = (item >> 7) & 3, k1 = item & 127;
#pragma unroll
        for (int i = 0; i < 2; ++i) { const int q = tid + 512 * i, l2 = q >> 4, c4 = (q & 15) * 4;
            const u32x4 v = *(const u32x4*)(FA + ((size_t)((b * 4 + g) * 64 + l2) * 128 + k1) * 64 + c4);
#pragma unroll
            for (int e = 0; e < 4; ++e) { *(LAS bf16_t*)(Bt + SWZ(c4 + e, l2 * 2)) = (bf16_t)(v[e] & 0xffffu); *(LAS bf16_t*)(Bt + SWZ(c4 + e, (64 + l2) * 2)) = (bf16_t)(v[e] >> 16); } }
        __syncthreads();
        f32x16 z = {};
#pragma unroll
        for (int ks = 0; ks < 8; ++ks) { const bf16x8 bx = *(const LAS bf16x8*)(Bt + SWZ(32 * tc + r32, (16 * ks + 8 * hi) * 2)); z = __builtin_amdgcn_mfma_f32_32x32x16_bf16(a2[ks], bx, z, 0, 0, 0); }
#pragma unroll
        for (int r = 0; r < 16; ++r) { const int R = 32 * tr + crow_(r, hi); *(LAS bf16_t*)(Zt + SWZ(R & 63, ((R >> 6) * 64 + 32 * tc + r32) * 2)) = (bf16_t)(pk2(z[r], 0.f) & 0xffffu); }
        __syncthreads();
        if (wave < 4) { f32x16 y = {};
#pragma unroll
            for (int ks = 0; ks < 8; ++ks) { const bf16x8 ax = *(const LAS bf16x8*)(Zt + SWZ(32 * tr + r32, (16 * ks + 8 * hi) * 2)); y = __builtin_amdgcn_mfma_f32_32x32x16_bf16(ax, b3[ks], y, 0, 0, 0); }
#pragma unroll
            for (int r = 0; r < 16; ++r) { const int k2 = 32 * tr + crow_(r, hi); ACAT[(size_t)(b * SEQ + k1 + 128 * k2) * KCAT + g * 64 + 32 * tc + r32] = (bf16_t)(pk2(y[r] * 0.001381067932f, 0.f) & 0xffffu); } }
        __syncthreads();
    }
}
__device__ __forceinline__ void ctxdft_item(int item, const bf16_t* UF, bf16_t* ACAT, LAS unsigned char* lds, int tid, int wave, int lane) {
    const int b = item >> 4, g = (item >> 2) & 3, kc = item & 3;
    const int tr = wave >> 1, tc = wave & 1, r32 = lane & 31, hi = lane >> 5;
    LAS unsigned char* Xt = lds;
    LAS unsigned char* Zt = lds + 32768;
#pragma unroll
    for (int i = 0; i < 4; ++i) { const int q = tid + 512 * i, l = q >> 3, c8 = (q & 7) * 8;
        const u32x4 v = *(const u32x4*)(UF + (size_t)(ML + b * CTXL + l) * 256 + g * 64 + c8);
#pragma unroll
        for (int e = 0; e < 8; ++e) { const unsigned w = v[e >> 1]; const int row = c8 + e; *(LAS bf16_t*)(Xt + row * 512 + ((((l >> 3) ^ (row & 7)) << 4) | ((l & 7) * 2))) = (bf16_t)((e & 1) ? (w >> 16) : (w & 0xffffu)); } }
    __syncthreads();
    f32x16 z = {};
    const int R = 32 * tr + r32, kk = 64 * kc + (R & 63);
#pragma unroll 4
    for (int ks = 0; ks < 16; ++ks) { float av[8];
#pragma unroll
        for (int j = 0; j < 8; ++j) { const int l = 16 * ks + 8 * hi + j; float s, c; sincospif((float)((kk * l) & 255) * (1.0f / 128.0f), &s, &c); av[j] = (R < 64) ? c : -s; }
        const int row = 32 * tc + r32, ch = (16 * ks + 8 * hi) >> 3;
        const bf16x8 bx = *(const LAS bf16x8*)(Xt + row * 512 + ((ch ^ (row & 7)) << 4));
        z = __builtin_amdgcn_mfma_f32_32x32x16_bf16(pack_bf8(av), bx, z, 0, 0, 0); }
#pragma unroll
    for (int r = 0; r < 16; ++r) { const int Rr = 32 * tr + crow_(r, hi); *(LAS bf16_t*)(Zt + SWZ(Rr & 63, ((Rr >> 6) * 64 + 32 * tc + r32) * 2)) = (bf16_t)(pk2(z[r], 0.f) & 0xffffu); }
    __syncthreads();
    if (wave < 4) { f32x16 y = {};
#pragma unroll
        for (int ks = 0; ks < 8; ++ks) { float bv[8];
#pragma unroll
            for (int j = 0; j < 8; ++j) { const int k = 16 * ks + 8 * hi + j, m = 32 * tc + r32; float s2, c2; sincospif((float)((m * (k & 63)) & 63) * (1.0f / 32.0f), &s2, &c2); bv[j] = (k < 64) ? c2 : s2; }
            const bf16x8 ax = *(const LAS bf16x8*)(Zt + SWZ(32 * tr + r32, (16 * ks + 8 * hi) * 2)); y = __builtin_amdgcn_mfma_f32_32x32x16_bf16(ax, pack_bf8(bv), y, 0, 0, 0); }
#pragma unroll
        for (int r = 0; r < 16; ++r) { const int k = 64 * kc + 32 * tr + crow_(r, hi); ACAT[(size_t)(ML + b * CTXL + k) * KCAT + g * 64 + 32 * tc + r32] = (bf16_t)(pk2(y[r] * (1.0f / 128.0f), 0.f) & 0xffffu); } }
    __syncthreads();
}

__device__ __forceinline__ void conv_item(int item, const bf16_t* ZG, const float* cw  , const float* cb, const float* lng, const float* lnb, bf16_t* ACAT, LAS unsigned char* lds, int tid, int wave, int lane) {
    const int row0 = item * 64; const bool lat = row0 < ML; const int s0 = lat ? (row0 & ~(SEQ - 1)) : (ML + ((row0 - ML) & ~(CTXL - 1))), s1 = s0 + (lat ? SEQ : CTXL);
    LAS float* zt = (LAS float*)lds;
#pragma unroll
    for (int i = 0; i < 6; ++i) { const int q = tid + 512 * i; if (q < 94 * 32) { const int rr = q >> 5, c8 = (q & 31) * 8, gr = row0 - 15 + rr;
        u32x4 v = {0u, 0u, 0u, 0u}; if (gr >= s0 && gr < s1) v = *(const u32x4*)(ZG + (size_t)gr * 256 + c8);
        *(LAS f32x4*)(zt + rr * 256 + c8) = (f32x4){bf2f(v.x & 0xffffu), __uint_as_float(v.x & 0xffff0000u), bf2f(v.y & 0xffffu), __uint_as_float(v.y & 0xffff0000u)};
        *(LAS f32x4*)(zt + rr * 256 + c8 + 4) = (f32x4){bf2f(v.z & 0xffffu), __uint_as_float(v.z & 0xffff0000u), bf2f(v.w & 0xffffu), __uint_as_float(v.w & 0xffff0000u)}; } }
    const int c = tid & 255, half = tid >> 8;
    float w[31];
#pragma unroll
    for (int t = 0; t < 31; ++t) w[t] = cw[t * 256 + c];
    float acc[32]; const float bias = cb[c];
    __syncthreads();
#pragma unroll
    for (int r0 = 0; r0 < 32; r0 += 4) { float v[34];
#pragma unroll
        for (int i = 0; i < 34; ++i) v[i] = zt[(half * 32 + r0 + i) * 256 + c];
        float a0 = bias, a1 = bias, a2 = bias, a3 = bias;
#pragma unroll
        for (int t = 0; t < 31; ++t) { a0 += w[t] * v[t]; a1 += w[t] * v[t + 1]; a2 += w[t] * v[t + 2]; a3 += w[t] * v[t + 3]; }
        acc[r0] = a0; acc[r0 + 1] = a1; acc[r0 + 2] = a2; acc[r0 + 3] = a3; }
    __syncthreads();
#pragma unroll
    for (int r = 0; r < 32; ++r) zt[(half * 32 + r) * 256 + c] = acc[r];
    __syncthreads();
    const f32x4 gg = *(const f32x4*)(lng + 4 * lane), bb = *(const f32x4*)(lnb + 4 * lane);
#pragma unroll
    for (int i = 0; i < 8; ++i) { const int r = wave * 8 + i; const f32x4 v = *(const LAS f32x4*)(zt + r * 256 + 4 * lane);
        const float mu = wave_sum((v.x + v.y) + (v.z + v.w)) * (1.0f / 256.0f); const f32x4 d = v - mu;
        const float var = wave_sum((d.x * d.x + d.y * d.y) + (d.z * d.z + d.w * d.w)) * (1.0f / 256.0f); const float rs = 1.0f / sqrtf(var + EPS);
        f32x4 o = d * rs * gg + bb; o.x *= sigm(o.x); o.y *= sigm(o.y); o.z *= sigm(o.z); o.w *= sigm(o.w);
        u32x2 pw; pw.x = pk2(o.x, o.y); pw.y = pk2(o.z, o.w); *(u32x2*)(ACAT + (size_t)(row0 + r) * KCAT + 768 + 4 * lane) = pw; }
    __syncthreads();
}
__device__ __forceinline__ void pool_phase(const bf16_t* UP, const float* pw  , const float* psc, bf16_t* ACAT, int nitems, int first, LAS unsigned char* lds, int G, int tid, int wave, int lane) {
    const int g = wave >> 1, tc = wave & 1, r32 = lane & 31, hi = lane >> 5;
    bf16x8 bw[4];
#pragma unroll
    for (int ks = 0; ks < 4; ++ks) { float v[8];
#pragma unroll
        for (int j = 0; j < 8; ++j) v[j] = pw[g * 4096 + (16 * ks + 8 * hi + j) * 64 + 32 * tc + r32];
        bw[ks] = pack_bf8(v); }
    const float osc = psc[g * 64 + 32 * tc + r32];
    LAS float* ut = (LAS float*)lds;
    LAS unsigned char* dt = lds + 81920;
    for (int item = first; item < nitems; item += G) {
        const int row0 = item * 64; const bool lat = row0 < ML; const int s0 = lat ? (row0 & ~(SEQ - 1)) : (ML + ((row0 - ML) & ~(CTXL - 1))), L = lat ? SEQ : CTXL, s1 = s0 + L;
#pragma unroll
        for (int i = 0; i < 5; ++i) { const int q = tid + 512 * i, rr = q >> 5, c8 = (q & 31) * 8, gr = row0 - 8 + rr;
            u32x4 v = {0u, 0u, 0u, 0u}; if (gr >= s0 && gr < s1) v = *(const u32x4*)(UP + (size_t)gr * 256 + c8);
            *(LAS f32x4*)(ut + rr * 256 + c8) = (f32x4){bf2f(v.x & 0xffffu), __uint_as_float(v.x & 0xffff0000u), bf2f(v.y & 0xffffu), __uint_as_float(v.y & 0xffff0000u)};
            *(LAS f32x4*)(ut + rr * 256 + c8 + 4) = (f32x4){bf2f(v.z & 0xffffu), __uint_as_float(v.z & 0xffff0000u), bf2f(v.w & 0xffffu), __uint_as_float(v.w & 0xffff0000u)}; }
        __syncthreads();
#pragma unroll
        for (int i = 0; i < 4; ++i) { const int q = tid + 512 * i, lr = q >> 5, c8 = (q & 31) * 8, gg = c8 >> 6, hw = 1 << gg, tt = row0 + lr - s0;
            f32x4 sa = {0.f, 0.f, 0.f, 0.f}, sb = {0.f, 0.f, 0.f, 0.f};
            for (int o = -hw; o < hw; ++o) { sa += *(const LAS f32x4*)(ut + (lr + 8 + o) * 256 + c8); sb += *(const LAS f32x4*)(ut + (lr + 8 + o) * 256 + c8 + 4); }
            const int lo = tt - hw < 0 ? 0 : tt - hw, hh = tt + hw - 1 > L - 1 ? L - 1 : tt + hw - 1; const float inv = 1.0f / (float)(hh - lo + 1);
            const f32x4 ua = *(const LAS f32x4*)(ut + (lr + 8) * 256 + c8), ub = *(const LAS f32x4*)(ut + (lr + 8) * 256 + c8 + 4);
            const f32x4 da = sa * inv - ua, db = sb * inv - ub;
            u32x4 w; w.x = pk2(da.x, da.y); w.y = pk2(da.z, da.w); w.z = pk2(db.x, db.y); w.w = pk2(db.z, db.w);
            *(LAS u32x4*)(dt + lr * 512 + ((((c8 >> 3) ^ (lr & 7)) << 4))) = w; }
        __syncthreads();
#pragma unroll
        for (int rt = 0; rt < 2; ++rt) { f32x16 y = {};
#pragma unroll
            for (int ks = 0; ks < 4; ++ks) { const int row = 32 * rt + r32, ch = (g * 64 + 16 * ks + 8 * hi) >> 3;
                const bf16x8 ax = *(const LAS bf16x8*)(dt + row * 512 + ((ch ^ (row & 7)) << 4)); y = __builtin_amdgcn_mfma_f32_32x32x16_bf16(ax, bw[ks], y, 0, 0, 0); }
#pragma unroll
            for (int r = 0; r < 16; ++r) ACAT[(size_t)(row0 + 32 * rt + crow_(r, hi)) * KCAT + 1024 + g * 64 + 32 * tc + r32] = (bf16_t)(pk2(y[r] * osc, 0.f) & 0xffffu); }
        __syncthreads();
    }
}

__device__ __forceinline__ void ctx_gate_combine(const float* slab, const unsigned char* Gc  , bf16_t* Yc, int gw, int NGW, int lane) {
    for (int r = gw; r < MC; r += NGW) {
#pragma unroll
        for (int j = 0; j < 4; ++j) { const int col = 4 * lane + 256 * j; f32x4 y = {0.f, 0.f, 0.f, 0.f};
#pragma unroll
            for (int sl = 0; sl < 5; ++sl) { const int b = sl == 0 ? 0 : sl <= 2 ? 1 : sl - 1;
                const f32x4 p = *(const f32x4*)(slab + (size_t)sl * 512 * 1024 + (size_t)r * 1024 + col); const unsigned q = *(const unsigned*)(Gc + (size_t)r * 4096 + b * 1024 + col);
                y[0] += p[0] * (float)(q & 255u); y[1] += p[1] * (float)((q >> 8) & 255u); y[2] += p[2] * (float)((q >> 16) & 255u); y[3] += p[3] * (float)(q >> 24); }
            y = y * (1.0f / 255.0f);
            u32x2 w; w.x = pk2(y[0], y[1]); w.y = pk2(y[2], y[3]); *(u32x2*)(Yc + (size_t)r * 1024 + col) = w; }
    }
}
constexpr int NPHASE = 22;
struct Args { const float* in[30]; float* out; unsigned char* ws; int ph_lo, ph_hi, li, pad; };
__global__ void __launch_bounds__(512, 2) __attribute__((amdgpu_waves_per_eu(2, 2))) fwd_kernel(Args args) {
    extern __shared__ __attribute__((aligned(16))) unsigned char lds[];
    LAS unsigned char* L = (LAS unsigned char*)lds;
    volatile LAS unsigned* MISC = (volatile LAS unsigned*)(L + MISC_OFF);
    const int tid0 = threadIdx.x; const int wave0 = __builtin_amdgcn_readfirstlane(tid0 >> 6);
    const int G = gridDim.x, bx0 = blockIdx.x, vcu0 = (G % 8 == 0) ? (bx0 % 8) * (G / 8) + bx0 / 8 : bx0;
    const int NGW = G * 8;
    gu32* ctl = (gu32*)(args.ws + WS_CTL);
    for (int u = tid0; u < (LDS_BYTES - LDSCTL_OFF) / 4; u += 512) ((LAS unsigned*)(L + LDSCTL_OFF))[u] = 0u;
    __syncthreads();
    volatile LAS unsigned long long* PT = (volatile LAS unsigned long long*)(L + PT_OFF);
    if (tid0 < 32) PT[tid0] = ((const __attribute__((address_space(4))) unsigned long long*)__builtin_amdgcn_kernarg_segment_ptr())[tid0];
    __syncthreads();
#define FRESH() int tid, vcu = vcu0, bx = bx0; asm volatile("v_mbcnt_lo_u32_b32 %0, -1, 0\n\tv_mbcnt_hi_u32_b32 %0, -1, %0" : "=v"(tid)); tid += wave0 * 64; asm volatile("" : "+v"(tid), "+s"(vcu), "+s"(bx)); const int lane = tid & 63, wave = __builtin_amdgcn_readfirstlane(tid >> 6), gw = vcu * 8 + wave; (void)lane; (void)gw; (void)bx; \
    LAS float* scr = (LAS float*)(L + wave * 16384); (void)scr;
#define PTR(i) ((const float*)(const GAS float*)ldptr(PT, (i)))
#define OUTP ((float*)(GAS float*)ldptr(PT, 30))
#define WSP ((unsigned char*)(GAS unsigned char*)ldptr(PT, 31))
    XcdBarrier bar; bar.bar = (unsigned*)(ctl + CW_BAR) + args.li * XCD_BAR_WORDS; bar.x = 0; bar.st = nullptr;
    if (MK_N_LAUNCHES != NPHASE) bar = xcd_barrier_post((unsigned*)(ctl + CW_BAR) + args.li * XCD_BAR_WORDS, MISC + 8);
#ifndef BARX2
#define BARX2 0
#endif
#define GRID_BAR() do { if (MK_N_LAUNCHES == NPHASE) { if (tid0 == 0) __hip_atomic_store(ctl + CW_TMO, 0xBADBA0u, RLX_AGENT); } else { xcd_barrier(bar); if (BARX2) xcd_barrier(bar); } } while (0)
    const int lo = args.ph_lo, hi = args.ph_hi;
#ifndef PHASE_MASK
#define PHASE_MASK 0xFFF
#endif
#ifndef ATTM
#define ATTM 3
#endif
#ifndef X1REP
#define X1REP 0
#endif
#ifndef X1M
#define X1M 31
#endif
#define PH_EN(kind) ((PHASE_MASK >> (kind)) & 1)
#ifndef REP_MASK
#define REP_MASK 0
#endif
#define NREP(kind) (((REP_MASK >> (kind)) & 1) ? 2 : 1)
#define IN(k) (lo <= (k) && (k) < hi)
#define BOTH(k) (IN(k) && IN((k) + 1))
#define WSRC(S, l) WSrc S; S.w_in = PTR(8) + (size_t)(l) * 1024 * NIN; S.wo_f = PTR(20) + (size_t)(l) * 256 * 1024; S.wo_a = PTR(21) + (size_t)(l) * 512 * 1024; \
    S.wo_c = PTR(22) + (size_t)(l) * 256 * 1024; S.wo_p = PTR(23) + (size_t)(l) * 256 * 1024; S.w_out = PTR(24) + (size_t)(l) * 1024 * 1024; \
    S.w_up = PTR(25) + (size_t)(l) * 1024 * 2 * DFF; S.w_down = PTR(28) + (size_t)(l) * DFF * 1024;
#define ws WSP
#define OUTHI ((unsigned char*)OUTP + 32 * MiB)
#define WA1 ((bf16_t*)OUTHI)
#define WUPG1 ((bf16_t*)(OUTHI + 13 * MiB))
#define WUPV1 ((bf16_t*)(OUTHI + 13 * MiB + (size_t)2816 * 1024 * 2))
#define WDST0 {(bf16_t*)(ws + WS_WA), (bf16_t*)(ws + WS_WCAT), (bf16_t*)(ws + WS_WOUT), (bf16_t*)(ws + WS_WDN), (bf16_t*)(ws + WS_WUPG), (bf16_t*)(ws + WS_WUPV)}
#define WDST1 {WA1, (bf16_t*)(ws + WS_WCAT), (bf16_t*)(ws + WS_WOUT), (bf16_t*)(ws + WS_WDN), WUPG1, WUPV1}
#define TAIL_CONVERT(MASK, nwg_, lo_, hi_) do { const int rem_ = (nwg_) % G; if (rem_ == 0 || bx >= rem_) { __syncthreads(); WSRC(S1, 1); const WDst D1 = WDST1; \
        convert_items<MASK>(S1, D1, scr, (lo_), (hi_), (rem_ ? bx - rem_ : bx) * 8 + wave, (rem_ ? G - rem_ : G) * 8, lane); } } while (0)
#define MOD ((float*)(WSP + WS_MOD))
#define ROPE ((float*)(WSP + WS_ROPE))
#define TW ((f32x2*)(WSP + WS_TW))
#define XC ((float*)(WSP + WS_XC))
#define HX ((bf16_t*)(WSP + WS_HX))
#define FA ((f32x2*)(WSP + WS_FA))
#define Qb ((bf16_t*)(WSP + WS_Q))
#define Kb ((bf16_t*)(WSP + WS_K))
#define Vb ((bf16_t*)(WSP + WS_V))
#define Yb ((bf16_t*)(WSP + WS_Y))
#define Gb (WSP + WS_G)
#define ACAT ((bf16_t*)(WSP + WS_ACAT))
#define UF ((bf16_t*)(WSP + WS_UF))
#define ZG ((bf16_t*)(WSP + WS_ZG))
#define UP ((bf16_t*)(WSP + WS_UP))
#define GT ((bf16_t*)(WSP + WS_GT))
#define Hb ((bf16_t*)(WSP + WS_H))

    for (int rep = 0; rep < NREP(0); ++rep) if (PH_EN(0) && IN(0)) { FRESH();
        mod_phase(PTR(1), PTR(3), PTR(6), PTR(7), MOD, L, vcu, G, tid, wave, lane);
        tables_phase(ROPE, TW, vcu * 512 + tid, G * 512);
        for (int i = vcu * 512 + tid; i < MC * DM / 4; i += G * 512) ((f32x4*)XC)[i] = ((const f32x4*)PTR(2))[i];
        WSRC(S0, 0); { const WDst D0 = WDST0; convert_items<31>(S0, D0, scr, 0, ITU_END, gw, NGW, lane); }
        if (BOTH(0)) GRID_BAR();
    }
#pragma nounroll
    for (int l = 0; l < 2; ++l) {
        const int pb = 1 + 10 * l;
#define mod (MOD + l * 3 * 6144)
#define XBF ((bf16_t*)OUTP)
#define xc ((l == 0) ? PTR(2) : (const float*)XC)
        const int Mact = (l == 0) ? MT : ML;
        for (int rep = 0; rep < NREP(1); ++rep) if (PH_EN(1) && IN(pb)) { FRESH(); if (l == 0) norm_phase<false>(PTR(0), xc, MT, PTR(4) + l * DM, mod, 0, 1024, HX, gw, NGW, lane);
            else norm_phase<true>(XBF, xc, MT, PTR(4) + l * DM, mod, 0, 1024, HX, gw, NGW, lane, (const float*)Gb, 11, MOD + 2 * 6144 + 5120, XC);
            if (BOTH(pb)) GRID_BAR(); }
        for (int rep = 0; rep < NREP(2); ++rep) if (PH_EN(2) && IN(pb + 1)) { FRESH();
            pg8::Gemm g{HX, l == 0 ? (const bf16_t*)(ws + WS_WA) : (const bf16_t*)WA1, MT, NIN, 1024}; pg8::StaticOrder S; S.init(MT, NIN, G, bx);
            pg8::EpiIn E{UF, ZG, UP, Qb, Kb, Vb, Gb, ROPE};
            pg8::gemm_phase<pg8::EpiIn, pg8::StaticOrder, true, true>(L, g, S, E, tid);
            TAIL_CONVERT(7, (MT / 256) * (NIN / 256), l == 0 ? 0 : ITU_CAT, l == 0 ? IT_A : ITU_UPG);
            if (BOTH(pb + 1)) GRID_BAR();
        }
        for (int rep = 0; rep < NREP(3); ++rep) if (PH_EN(3) && IN(pb + 2)) { FRESH();
            for (int r1 = 0; r1 < ((X1REP & 1) ? 2 : 1); ++r1) if (X1M & 1) fft1_phase(UF, TW, (unsigned*)FA, L, vcu, G, tid, wave, lane);
            for (int r1 = 0; r1 < ((X1REP & 2) ? 2 : 1); ++r1) if (X1M & 2) for (int it = vcu; it < Mact / 64; it += G) conv_item(it, ZG, PTR(14) + l * 31 * 256, PTR(15) + l * 256, PTR(16) + l * 256, PTR(17) + l * 256, ACAT, L, tid, wave, lane);
            for (int r1 = 0; r1 < ((X1REP & 4) ? 2 : 1); ++r1) if (X1M & 4) pool_phase(UP, PTR(18) + l * 4 * 4096, PTR(19) + l * 256, ACAT, Mact / 64, (vcu + 248) % G, L, G, tid, wave, lane);
            if ((X1M & 8) && l == 0) for (int it = (vcu + 224) % G; it < 32; it += G) ctxdft_item(it, UF, ACAT, L, tid, wave, lane);
            if (l == 0) {
                const float lam_init = 0.2f;
                const float d1 = wave_sum(PTR(9)[lane] * PTR(10)[lane]), d2 = wave_sum(PTR(11)[lane] * PTR(12)[lane]);
                const float lam = __builtin_bit_cast(float, __builtin_amdgcn_readfirstlane(__builtin_bit_cast(int, expf(d1) - expf(d2) + lam_init)));
                for (int v = (vcu + 200) % G; v < 16; v += G) { const int b = v >> 3, h = (v >> 1) & 3, row0 = ML + b * CTXL + (v & 1) * 128;
                    att2::attn_unit<0>(Qb + (size_t)row0 * 512 + h * 128, Kb + (size_t)b * KVL * 512 + h * 128, Vb + (size_t)b * KVL * 512 + h * 128, CTXL,
                                       ACAT + (size_t)row0 * KCAT + 256 + h * 128, lam, 1.0f - lam_init, PTR(13), (char*)lds, tid); }
            }
            if (BOTH(pb + 2)) GRID_BAR();
        }
        for (int rep = 0; rep < NREP(4); ++rep) if (PH_EN(4) && IN(pb + 3)) { FRESH();
            if (ATTM & 1) fft2_phase((const unsigned*)FA, ACAT, L, vcu, G, tid, wave, lane);
            const float lam_init = (l == 0) ? 0.2f : 0.35550906759096926f;
            const float d1 = wave_sum(PTR(9)[l * 64 + lane] * PTR(10)[l * 64 + lane]), d2 = wave_sum(PTR(11)[l * 64 + lane] * PTR(12)[l * 64 + lane]);
            const float lam = __builtin_bit_cast(float, __builtin_amdgcn_readfirstlane(__builtin_bit_cast(int, expf(d1) - expf(d2) + lam_init)));
            const int nun = 512;
            if (ATTM & 2) for (int u = vcu; u < nun; u += G) {
                int b, h, row0, nkeys;
                if (u < 512) { const int x = (u & 255) >> 5, qb = (u & 31) + 32 * (u >> 8); b = x >> 2; h = x & 3; row0 = b * SEQ + qb * 128; nkeys = KVL; }
                else { const int v = u - 512; b = v >> 3; h = (v >> 1) & 3; row0 = ML + b * CTXL + (v & 1) * 128; nkeys = CTXL; }
#if ATT_V == 2
                att2::attn_unit<0>(Qb + (size_t)row0 * 512 + h * 128,
#else
                att::attn_unit<0>(Qb + (size_t)row0 * 512 + h * 128,
#endif
                               Kb + (size_t)b * KVL * 512 + h * 128, Vb + (size_t)b * KVL * 512 + h * 128, nkeys,
                               ACAT + (size_t)row0 * KCAT + 256 + h * 128, lam, 1.0f - lam_init, PTR(13) + l * 128, (char*)lds, tid);
            }
            if (l == 0) {
                pg8::Gemm gc{ACAT + (size_t)ML * KCAT, (const bf16_t*)(ws + WS_WCAT), MC, 1024, 256, KCAT}; pg8::BranchSliceOrder Sc{G, bx};
                pg8::EpiSlab Ec{(float*)UF};
                pg8::gemm_phase<pg8::EpiSlab, pg8::BranchSliceOrder, true, true>(L, gc, Sc, Ec, tid);
            }
#if defined(ATT_PROBE)
            int tid2 = tid, vcu2 = vcu; asm volatile("" : "+v"(tid2), "+s"(vcu2));
            for (int u = vcu2; u < 512; u += G) {
                const int x = (u & 255) >> 5, qb = (u & 31) + 32 * (u >> 8), b = x >> 2, h = x & 3, row0 = b * SEQ + qb * 128;
                att2::attn_unit<ATT_PROBE>(Qb + (size_t)row0 * 512 + h * 128, Kb + (size_t)b * KVL * 512 + h * 128, Vb + (size_t)b * KVL * 512 + h * 128, KVL,
                               Hb + (size_t)row0 * KCAT + 256 + h * 128, lam, 1.0f - lam_init, PTR(13) + l * 128, (char*)lds, tid2);
            }
#endif
            if (BOTH(pb + 3)) GRID_BAR();
        }
        for (int rep = 0; rep < NREP(5); ++rep) if (PH_EN(5) && IN(pb + 4)) { FRESH();
            if (l == 0) ctx_gate_combine((const float*)UF, Gb + (size_t)ML * 4096, Yb + (size_t)ML * 1024, gw, NGW, lane);
            pg8::Gemm g{ACAT, (const bf16_t*)(ws + WS_WCAT), ML, 1024, KCAT}; pg8::StaticOrder S; S.init(ML, 1024, G, bx);
            pg8::EpiBranch E{Gb, Yb};
            pg8::gemm_phase<pg8::EpiBranch, pg8::StaticOrder, true, true>(L, g, S, E, tid);
            if (BOTH(pb + 4)) GRID_BAR();
        }
        for (int rep = 0; rep < (l == 0 ? NREP(6) : 1); ++rep) if (PH_EN(6) && IN(pb + 5)) { FRESH();
            pg8::Gemm g{Yb, (const bf16_t*)(ws + WS_WOUT), ML, 1024, 1024}; pg8::StaticOrder S; S.init(ML, 1024, G, bx);
            pg8::EpiRes E{l == 0 ? PTR(0) : (const float*)nullptr, XBF, xc, XBF, XC, mod, 2048};
            pg8::gemm_phase<pg8::EpiRes, pg8::StaticOrder, true, true>(L, g, S, E, tid);
            if (l == 0) {
                pg8::Gemm gc{Yb + (size_t)ML * 1024, (const bf16_t*)(ws + WS_WOUT), MC, 1024, 256, 1024}; pg8::SplitKOrder Sc{4, 256, G, bx};
                pg8::EpiSlab Ec{(float*)Gb};
                pg8::gemm_phase<pg8::EpiSlab, pg8::SplitKOrder, true, true>(L, gc, Sc, Ec, tid);
            }
            if (BOTH(pb + 5)) GRID_BAR();
        }
        for (int rep = 0; rep < NREP(7); ++rep) if (PH_EN(7) && IN(pb + 6)) { FRESH(); if (l == 0) norm_phase<true>(XBF, XC, Mact, PTR(5) + l * DM, mod, 3072, 4096, HX, gw, NGW, lane, (const float*)Gb, 4, mod + 2 * 6144 + 2048, XC);
            else norm_phase<true>(XBF, XC, Mact, PTR(5) + l * DM, mod, 3072, 4096, HX, gw, NGW, lane);
            if (BOTH(pb + 6)) GRID_BAR(); }
        for (int rep = 0; rep < NREP(8); ++rep) if (PH_EN(8) && IN(pb + 7)) { FRESH();
            pg8::Gemm g{HX, l == 0 ? (const bf16_t*)(ws + WS_WUPG) : (const bf16_t*)WUPG1, Mact, DFF, 1024}; pg8::StaticOrder S; S.init(Mact, DFF, G, bx);
            pg8::EpiBf E{GT, DFF};
            pg8::gemm_phase<pg8::EpiBf, pg8::StaticOrder, true, true>(L, g, S, E, tid);
            if (l == 0) TAIL_CONVERT(8, (MT / 256) * (DFF / 256), ITU_UPG, ITU_UPV);
            if (BOTH(pb + 7)) GRID_BAR();
        }
        for (int rep = 0; rep < NREP(9); ++rep) if (PH_EN(9) && IN(pb + 8)) { FRESH();
            pg8::Gemm g{HX, l == 0 ? (const bf16_t*)(ws + WS_WUPV) : (const bf16_t*)WUPV1, Mact, DFF, 1024}; pg8::StaticOrder S; S.init(Mact, DFF, G, bx);
            pg8::EpiVal E{GT, Hb, PTR(26) + l * 3 * DFF, PTR(27) + l * DFF};
            pg8::gemm_phase<pg8::EpiVal, pg8::StaticOrder, true, true>(L, g, S, E, tid);
            if (l == 0) TAIL_CONVERT(16, (MT / 256) * (DFF / 256), ITU_UPV, ITU_END);
            if (BOTH(pb + 8)) GRID_BAR();
        }
        if (PH_EN(10) && IN(pb + 9)) { FRESH();
            pg8::Gemm g{Hb, (const bf16_t*)(ws + WS_WDN), ML, 1024, DFF}; pg8::StaticOrder S; S.init(ML, 1024, G, bx);
            pg8::EpiRes E{(const float*)nullptr, XBF, XC, l == 0 ? XBF : HX, XC, mod, 5120};
            pg8::gemm_phase<pg8::EpiRes, pg8::StaticOrder, true, true>(L, g, S, E, tid);
            if (l == 0) {
                pg8::Gemm gc{Hb + (size_t)ML * DFF, (const bf16_t*)(ws + WS_WDN), MC, 1024, 256, DFF}; pg8::SplitKOrder Sc{11, 256, G, bx};
                pg8::EpiSlab Ec{(float*)Gb};
                pg8::gemm_phase<pg8::EpiSlab, pg8::SplitKOrder, true, true>(L, gc, Sc, Ec, tid);
            }
            if (BOTH(pb + 9)) GRID_BAR();
        }
    }
    if (PH_EN(11) && IN(21)) { FRESH(); final_norm_phase(HX, OUTP, PTR(29), gw, NGW, lane); }
#undef IN
#undef BOTH
#undef mod
#undef XBF
#undef xc
#undef ws
#undef OUTHI
#undef WA1
#undef WUPG1
#undef WUPV1
#undef WDST0
#undef WDST1
#undef TAIL_CONVERT
#undef MOD
#undef ROPE
#undef TW
#undef XC
#undef HX
#undef FA
#undef Qb
#undef Kb
#undef Vb
#undef Yb
#undef Gb
#undef ACAT
#undef UF
#undef ZG
#undef UP
#undef GT
#undef Hb
#undef PTR
#undef OUTP
#undef WSP
}

extern "C" void kernel_launch(void* const* d_in, const int* in_sizes, int n_in, void* d_out, int out_size, void* d_ws, size_t ws_size, hipStream_t stream) {
    static int grid = 0;
    if (grid == 0) {
        if (n_in != 30 || in_sizes[0] != ML * DM || out_size != ML * DM || ws_size < WS_END) {
            fprintf(stderr, "kernel_launch: unexpected shapes: n_in %d in0 %d out %d ws %zu (need >= %zu)\n", n_in, n_in > 0 ? in_sizes[0] : -1, out_size, ws_size, (size_t)WS_END); grid = -1; return; }
        int dev = 0, cus = 0, per_cu = 0;
        if (hipGetDevice(&dev) != hipSuccess || hipDeviceGetAttribute(&cus, hipDeviceAttributeMultiprocessorCount, dev) != hipSuccess) { grid = -1; return; }
        if (hipFuncSetAttribute((const void*)fwd_kernel, hipFuncAttributeMaxDynamicSharedMemorySize, LDS_BYTES) != hipSuccess) { fprintf(stderr, "kernel_launch: hipFuncSetAttribute failed\n"); grid = -1; return; }
        if (hipOccupancyMaxActiveBlocksPerMultiprocessor(&per_cu, (const void*)fwd_kernel, 512, LDS_BYTES) != hipSuccess || per_cu < 1) {
            fprintf(stderr, "kernel_launch: occupancy query reports %d blocks per CU\n", per_cu); (void)hipGetLastError(); grid = -1; return; }
        grid = cus;
    }
    if (grid < 0) return;
    (void)hipMemsetAsync((char*)d_ws + WS_CTL, 0, CTL_ZERO_BYTES, stream);
    Args a{};
    for (int i = 0; i < 30; ++i) a.in[i] = (const float*)d_in[i];
    a.out = (float*)d_out; a.ws = (unsigned char*)d_ws;
    for (int li = 0; li < MK_N_LAUNCHES; ++li) {
        if (MK_N_LAUNCHES == NPHASE) { a.ph_lo = li; a.ph_hi = li + 1; a.li = 0; }
        else { a.ph_lo = (int)((long)NPHASE * li / MK_N_LAUNCHES); a.ph_hi = (int)((long)NPHASE * (li + 1) / MK_N_LAUNCHES); a.li = li; }
        hipLaunchKernelGGL(fwd_kernel, dim3(grid), dim3(512), LDS_BYTES, stream, a);
    }
}
```

```cpp
#include <hip/hip_runtime.h>
#include <cstdio>
#include <cstdint>

#define LAS __attribute__((address_space(3)))
#define GAS __attribute__((address_space(1)))
typedef unsigned short bf16_t;
typedef short bf16x8 __attribute__((ext_vector_type(8)));
typedef short s16x4 __attribute__((ext_vector_type(4)));
typedef float f32x2 __attribute__((ext_vector_type(2)));
typedef float f32x4 __attribute__((ext_vector_type(4)));
typedef float f32x16 __attribute__((ext_vector_type(16)));
typedef unsigned u32x2 __attribute__((ext_vector_type(2)));
typedef unsigned u32x4 __attribute__((ext_vector_type(4)));

#ifndef ATT_V
#define ATT_V 2
#endif
#ifndef MK_N_LAUNCHES
#define MK_N_LAUNCHES 1
#endif

constexpr int DM = 1024, SEQ = 8192, NBATCH = 2, CTXL = 256;
constexpr int ML = NBATCH * SEQ;
constexpr int MC = NBATCH * CTXL;
constexpr int MT = ML + MC;
constexpr int NIN = 6656, DFF = 2816, KCAT = 1280;
constexpr int KVL = CTXL + SEQ;
constexpr float EPS = 1e-6f;

constexpr size_t MiB = 1u << 20;
constexpr size_t WS_CTL = 0, CTL_ZERO_BYTES = 1 * MiB;
constexpr size_t WS_MOD = 1 * MiB;
constexpr size_t WS_ROPE = WS_MOD + 2 * 3 * 6144 * 4;
constexpr size_t WS_TW = WS_ROPE + 192 * 32 * 4;
constexpr size_t WS_FT = WS_MOD + 512 * 1024;
constexpr size_t WS_XC = 2 * MiB;
constexpr size_t WS_WA = 4 * MiB;
constexpr size_t WS_WCAT = 17 * MiB;
constexpr size_t WS_WOUT = WS_WCAT + (size_t)1024 * 1280 * 2;
constexpr size_t WS_WUPG = WS_WOUT + (size_t)1024 * 1024 * 2;
constexpr size_t WS_WUPV = WS_WUPG + (size_t)2816 * 1024 * 2;
constexpr size_t WS_WDN = WS_WUPV + (size_t)2816 * 1024 * 2;
constexpr size_t WS_HX = 38 * MiB;
constexpr size_t WS_FA = WS_HX;
constexpr size_t WS_Q = 71 * MiB;
constexpr size_t WS_K = WS_Q + (size_t)MT * 512 * 2;
constexpr size_t WS_V = WS_K + (size_t)MT * 512 * 2;
constexpr size_t WS_Y = 71 * MiB;
constexpr size_t WS_G = 121 * MiB;
constexpr size_t WS_ACAT = 187 * MiB;
constexpr size_t WS_UF = 229 * MiB;
constexpr size_t WS_ZG = WS_UF + (size_t)MT * 256 * 2;
constexpr size_t WS_UP = WS_ZG + (size_t)MT * 256 * 2;
constexpr size_t WS_GT = 71 * MiB;
constexpr size_t WS_H = 162 * MiB;
constexpr size_t WS_END = 256 * MiB;
static_assert(WS_TW + 8192 * 8 <= WS_FT && WS_FT + 4 * 4096 * 16 <= WS_XC && WS_WDN + (size_t)1024 * 2816 * 2 <= WS_HX && WS_V + (size_t)MT * 512 * 2 <= WS_G && WS_G + (size_t)MT * 4096 <= WS_ACAT, "ws map 1");
static_assert(WS_ACAT + (size_t)MT * 1280 * 2 <= WS_UF && WS_UP + (size_t)MT * 256 * 2 <= WS_END && WS_GT + (size_t)MT * 2816 * 2 <= WS_H && WS_H + (size_t)MT * 2816 * 2 <= WS_END, "ws map 2");
static_assert(WS_HX + (size_t)MT * 1024 * 2 <= WS_Q && (size_t)2 * 4 * 128 * 64 * 64 * 8 <= (size_t)MT * 1024 * 2, "ws map 3");
constexpr int CW_TMO = 0, CW_CODE = 1, CW_BAR = 4096;

constexpr int RING_BYTES = 131072, LDSCTL_OFF = RING_BYTES, MISC_OFF = LDSCTL_OFF + 320, LDS_BYTES = 147456;

typedef __bf16 bf16x2_t __attribute__((ext_vector_type(2)));
__device__ __forceinline__ unsigned cvt2bf(float lo, float hi) { const f32x2 v = {lo, hi}; return __builtin_bit_cast(unsigned, __builtin_convertvector(v, bf16x2_t)); }
template <int M> __device__ __forceinline__ float swz_xor(float v) { return __int_as_float(__builtin_amdgcn_ds_swizzle(__float_as_int(v), (M << 10) | 0x1f)); }
__device__ __forceinline__ float bf2f(unsigned v) { return __uint_as_float(v << 16); }
__device__ __forceinline__ float sigm(float x) { return __builtin_amdgcn_rcpf(1.0f + __builtin_amdgcn_exp2f(x * -1.4426950408889634f)); }
__host__ __device__ __forceinline__ int in_map(int n) {
    if (n < 256) return n;
    if (n < 1280) { const int base = n < 768 ? 256 : 768, r = n - base, comp = r >> 6, p = r & 63, pp = p >> 1, e = p & 1;
        return base + comp * 64 + (pp < 16 ? 0 : 32) + (pp & 15) + 16 * e; }
    if (n < 1792) return n;
    if (n < 2304) { const int r = n - 1792; return 1792 + (r & 1) * 256 + (r >> 1); }
    return n;
}
namespace pg8 {
#define PG8_LAS __attribute__((address_space(3)))
typedef unsigned short bf16_t;
typedef short bf16x8 __attribute__((ext_vector_type(8)));
typedef float f32x4 __attribute__((ext_vector_type(4)));
typedef unsigned u32x4 __attribute__((ext_vector_type(4)));
constexpr int BM = 256, BK = 64, HALF = 128, HTB = HALF * BK * 2  , STAGE_BYTES = 8 * HTB, NXCD = 8, WGM = 8;

__host__ __device__ __forceinline__ int lds_byte(int r, int c) { const int st = (r >> 4) * 2 + (c >> 5), rr = r & 15, cc = c & 31, ob = rr * 64 + cc * 2; return st * 1024 + (ob ^ (((ob >> 9) & 1) << 5)); }
__host__ __device__ __forceinline__ void stage_rc(int b, int& R, int& C) { const int st = b / 1024, sb = b % 1024, swz = sb ^ (((sb >> 9) & 1) << 5); R = (st >> 1) * 16 + swz / 64; C = (st & 1) * 32 + (swz % 64) / 2; }
__host__ __device__ __forceinline__ int perm32(int rho) { const int n = rho >> 4, i = rho & 15; return 8 * (i >> 2) + 4 * n + (i & 3); }

struct Unit { int pm, pn, ko = 0, sl = 0; };
struct Gemm { const bf16_t* A; const bf16_t* Bt; int M, N, K, ld = 0; };

struct StaticOrder {
    int nM, nN, nwg, G, c;
    __host__ __device__ void init(int M, int N, int G_, int c_) { nM = M / BM; nN = N / BM; nwg = nM * nN; G = G_; c = c_; }
    __host__ __device__ bool next(int i, Unit& u) const {
        const long L = (long)i * G + c; if (L >= nwg) return false;
        int wgid = (int)L; { const int q = nwg / NXCD, r = nwg % NXCD, xcd = wgid % NXCD, off = wgid / NXCD; wgid = (xcd < r ? xcd * (q + 1) : r * (q + 1) + (xcd - r) * q) + off; }
        const int nig = WGM * nN, gid = wgid / nig, fm = gid * WGM, gsz = (nM - fm) < WGM ? (nM - fm) : WGM;
        u.pm = fm + ((wgid % nig) % gsz); u.pn = (wgid % nig) / gsz; return true;
    }
    __device__ __forceinline__ void a_ready(const Unit&) const {}
    __device__ __forceinline__ void done(const Unit&) const {}
};
__device__ __forceinline__ unsigned cvt_pk_bf16(float lo, float hi) { return cvt2bf(lo, hi); }
typedef float f32x2 __attribute__((ext_vector_type(2)));
__device__ __forceinline__ f32x2 gelu_pk(f32x2 v) {
    const f32x2 av = __builtin_elementwise_abs(v), d = av * 0.2316418882f + 1.0f;
    f32x2 t; t.x = __builtin_amdgcn_rcpf(d.x); t.y = __builtin_amdgcn_rcpf(d.y);
    f32x2 q = t * 0.5307027145f + (-0.7265760135f); q = q * t + 0.7107068705f; q = q * t + (-0.142248368f); q = q * t + 0.127414796f; q = q * t;
    const f32x2 s = (v * v) * (-0.72134752044f);
    f32x2 e; e.x = __builtin_amdgcn_exp2f(s.x); e.y = __builtin_amdgcn_exp2f(s.y);
    const f32x2 m = v * (q * e), r = v - m;
    f32x2 o; o.x = v.x < 0.f ? m.x : r.x; o.y = v.y < 0.f ? m.y : r.y; return o;
}

typedef unsigned u32x2 __attribute__((ext_vector_type(2)));
__device__ __forceinline__ u32x4 pack8(const f32x4 a, const f32x4 b) { u32x4 w; w.x = cvt_pk_bf16(a[0], a[1]); w.y = cvt_pk_bf16(a[2], a[3]); w.z = cvt_pk_bf16(b[0], b[1]); w.w = cvt_pk_bf16(b[2], b[3]); return w; }

struct EpiIn {
    static constexpr bool PERM = true, AFTER_DRAIN = false, RESCALE = false;
    bf16_t *UF, *ZG, *UP, *Q, *K, *V; unsigned char* G; const float* rope;
    __device__ __forceinline__ void operator()(const f32x4 (&acc)[2][2][4][2], const Unit& u, int wr, int wc, int fr, int fq) const {
        const int pm = u.pm, pn = u.pn; const bool lat = pm < 64; const int R0 = pm * 256;
        const int kv0 = lat ? ((pm >> 5) * 8448 + 256 + ((pm & 31) << 8)) : ((pm - 64) * 8448);
        const int rl = wr * 64 + fr, cl = wc * 32 + 8 * fq;
        if (pn == 0 || pn == 9) {
            bf16_t* dst = (pn == 0 ? UF : UP);
#pragma unroll
            for (int ai = 0; ai < 2; ++ai)
#pragma unroll
                for (int m = 0; m < 4; ++m) { const int rr = ai * 128 + m * 16 + rl;
#pragma unroll
                    for (int bj = 0; bj < 2; ++bj) *(u32x4*)(dst + (size_t)(R0 + rr) * 256 + bj * 128 + cl) = pack8(acc[ai][bj][m][0], acc[ai][bj][m][1]); }
        } else if (pn <= 4) {
            const bool isq = pn <= 2; bf16_t* dst = isq ? Q : K; const int rowbase = isq ? R0 : kv0, colbase = (isq ? pn - 1 : pn - 3) * 256; const float sc = isq ? (ATT_V == 2 ? 0.18033688011112042f : 0.125f) : 1.0f;
#pragma unroll
            for (int ai = 0; ai < 2; ++ai)
#pragma unroll
                for (int m = 0; m < 4; ++m) { const int rr = ai * 128 + m * 16 + rl;
                    f32x4 cs = {1.f, 1.f, 1.f, 1.f}, sn = {0.f, 0.f, 0.f, 0.f};
                    if (lat) { const int t = (R0 & 8191) + rr; const int pos = (wc & 1) ? 128 + (t & 63) : (t >> 6);
                        cs = *(const f32x4*)(rope + pos * 32 + 4 * fq); sn = *(const f32x4*)(rope + pos * 32 + 16 + 4 * fq); }
                    cs = cs * sc; sn = sn * sc;
#pragma unroll
                    for (int bj = 0; bj < 2; ++bj) { const f32x4 a = acc[ai][bj][m][0], b = acc[ai][bj][m][1]; f32x4 oa, ob;
                        oa[0] = a[0] * cs[0] - a[1] * sn[0]; oa[1] = a[1] * cs[0] + a[0] * sn[0]; oa[2] = a[2] * cs[1] - a[3] * sn[1]; oa[3] = a[3] * cs[1] + a[2] * sn[1];
                        ob[0] = b[0] * cs[2] - b[1] * sn[2]; ob[1] = b[1] * cs[2] + b[0] * sn[2]; ob[2] = b[2] * cs[3] - b[3] * sn[3]; ob[3] = b[3] * cs[3] + b[2] * sn[3];
                        *(u32x4*)(dst + (size_t)(rowbase + rr) * 512 + colbase + bj * 128 + cl) = pack8(oa, ob); } }
        } else if (pn <= 6) {
#pragma unroll
            for (int ai = 0; ai < 2; ++ai)
#pragma unroll
                for (int m = 0; m < 4; ++m) { const int rr = ai * 128 + m * 16 + rl;
#pragma unroll
                    for (int bj = 0; bj < 2; ++bj) *(u32x4*)(V + (size_t)(kv0 + rr) * 512 + (pn - 5) * 256 + bj * 128 + cl) = pack8(acc[ai][bj][m][0], acc[ai][bj][m][1]); }
        } else if (pn <= 8) {
#pragma unroll
            for (int ai = 0; ai < 2; ++ai)
#pragma unroll
                for (int m = 0; m < 4; ++m) { const int rr = ai * 128 + m * 16 + rl;
#pragma unroll
                    for (int bj = 0; bj < 2; ++bj) { const f32x4 a = acc[ai][bj][m][0], b = acc[ai][bj][m][1];
                        u32x2 w; w.x = cvt_pk_bf16(a[0] * sigm(a[1]), a[2] * sigm(a[3])); w.y = cvt_pk_bf16(b[0] * sigm(b[1]), b[2] * sigm(b[3]));
                        *(u32x2*)(ZG + (size_t)(R0 + rr) * 256 + (pn - 7) * 128 + bj * 64 + (cl >> 1)) = w; } }
        } else {
#pragma unroll
            for (int ai = 0; ai < 2; ++ai)
#pragma unroll
                for (int m = 0; m < 4; ++m) { const int rr = ai * 128 + m * 16 + rl;
#pragma unroll
                    for (int bj = 0; bj < 2; ++bj) { u32x2 w;
#pragma unroll
                        for (int n = 0; n < 2; ++n) { const f32x4 a = acc[ai][bj][m][n]; unsigned q = 0;
#pragma unroll
                            for (int j = 0; j < 4; ++j) { float s = sigm(a[j]) * 255.0f + 0.5f; s = s < 1.0f ? 1.0f : s; q |= ((unsigned)s) << (8 * j); }
                            if (n == 0) w.x = q; else w.y = q; }
                        *(u32x2*)(G + (size_t)(R0 + rr) * 4096 + (pn - 10) * 256 + bj * 128 + cl) = w; } }
        }
    }
};

struct EpiBf {
    static constexpr bool PERM = true, AFTER_DRAIN = false, RESCALE = false;
    bf16_t* O; int ldc;
    __device__ __forceinline__ void operator()(const f32x4 (&acc)[2][2][4][2], const Unit& u, int wr, int wc, int fr, int fq) const {
        const int row0 = u.pm * 256 + wr * 64 + fr, col0 = u.pn * 256 + wc * 32 + 8 * fq;
#pragma unroll
        for (int ai = 0; ai < 2; ++ai)
#pragma unroll
            for (int m = 0; m < 4; ++m)
#pragma unroll
                for (int bj = 0; bj < 2; ++bj) *(u32x4*)(O + (size_t)(row0 + ai * 128 + m * 16) * ldc + col0 + bj * 128) = pack8(acc[ai][bj][m][0], acc[ai][bj][m][1]);
    }
};

struct EpiRes {
    static constexpr bool PERM = true, AFTER_DRAIN = false, RESCALE = false;
    const float* base_f32; const bf16_t* base_bf; const float* base_ctx; bf16_t* out_bf; float* out_ctx; const float* mod; int goff;
    __device__ __forceinline__ void operator()(const f32x4 (&acc)[2][2][4][2], const Unit& u, int wr, int wc, int fr, int fq) const {
        const int pm = u.pm; const bool lat = pm < 64; const int mrow = lat ? (pm >> 5) : 2;
        const int col0 = u.pn * 256 + wc * 32 + 8 * fq;
        f32x4 gv[2][2];
#pragma unroll
        for (int bj = 0; bj < 2; ++bj)
#pragma unroll
            for (int n = 0; n < 2; ++n) gv[bj][n] = *(const f32x4*)(mod + mrow * 6144 + goff + col0 + bj * 128 + 4 * n);
#pragma unroll
        for (int ai = 0; ai < 2; ++ai)
#pragma unroll
            for (int m = 0; m < 4; ++m) { const size_t ro = (size_t)((lat ? pm : pm - 64) * 256 + ai * 128 + wr * 64 + m * 16 + fr) * 1024 + col0;
#pragma unroll
                for (int bj = 0; bj < 2; ++bj) { const size_t off = ro + bj * 128; f32x4 b0, b1;
                    if (!lat) { b0 = *(const f32x4*)(base_ctx + off); b1 = *(const f32x4*)(base_ctx + off + 4); }
                    else if (base_f32) { b0 = *(const f32x4*)(base_f32 + off); b1 = *(const f32x4*)(base_f32 + off + 4); }
                    else { const u32x4 w = *(const u32x4*)(base_bf + off);
                        b0 = (f32x4){__uint_as_float(w.x << 16), __uint_as_float(w.x & 0xffff0000u), __uint_as_float(w.y << 16), __uint_as_float(w.y & 0xffff0000u)};
                        b1 = (f32x4){__uint_as_float(w.z << 16), __uint_as_float(w.z & 0xffff0000u), __uint_as_float(w.w << 16), __uint_as_float(w.w & 0xffff0000u)}; }
                    const f32x4 o0 = b0 + gv[bj][0] * acc[ai][bj][m][0], o1 = b1 + gv[bj][1] * acc[ai][bj][m][1];
                    if (lat) *(u32x4*)(out_bf + off) = pack8(o0, o1); else { *(f32x4*)(out_ctx + off) = o0; *(f32x4*)(out_ctx + off + 4) = o1; } } }
    }
};

struct EpiVal {
    static constexpr bool PERM = true, AFTER_DRAIN = false, RESCALE = false;
    const bf16_t* GT; bf16_t* H; const float* dww; const float* dwb;
    __device__ __forceinline__ void operator()(const f32x4 (&acc)[2][2][4][2], const Unit& u, int wr, int wc, int fr, int fq) const {
        const int pm = u.pm; const bool lat = pm < 64; const int R0 = pm * 256, t0 = lat ? (R0 & 8191) : 0, L = lat ? 8192 : 256;
        const int rl = wr * 64 + fr;
#pragma unroll
        for (int bj = 0; bj < 2; ++bj) { const int col = u.pn * 256 + bj * 128 + wc * 32 + 8 * fq;
            f32x4 w0[2], w1[2], w2[2], bb[2];
#pragma unroll
            for (int n = 0; n < 2; ++n) { w0[n] = *(const f32x4*)(dww + col + 4 * n); w1[n] = *(const f32x4*)(dww + 2816 + col + 4 * n); w2[n] = *(const f32x4*)(dww + 5632 + col + 4 * n); bb[n] = *(const f32x4*)(dwb + col + 4 * n); }
#pragma unroll
            for (int ai = 0; ai < 2; ++ai) {
#pragma unroll
              for (int mh = 0; mh < 4; mh += 2) {
                u32x4 gm[4], g0[4], gq[4];
#pragma unroll
                for (int m = mh; m < mh + 2; ++m) { const int rr = ai * 128 + m * 16 + rl, t = t0 + rr; const bf16_t* gp = GT + (size_t)(R0 + rr) * 2816 + col;
                    gm[m] = (u32x4){0u, 0u, 0u, 0u}; gq[m] = (u32x4){0u, 0u, 0u, 0u}; g0[m] = *(const u32x4*)gp;
                    if (t > 0) gm[m] = *(const u32x4*)(gp - 2816);
                    if (t < L - 1) gq[m] = *(const u32x4*)(gp + 2816); }
                asm volatile("" ::: "memory");
#pragma unroll
                for (int m = mh; m < mh + 2; ++m) { const int rr = ai * 128 + m * 16 + rl;
                    f32x4 o[2];
#pragma unroll
                    for (int n = 0; n < 2; ++n) { f32x4 c;
#pragma unroll
                        for (int j = 0; j < 4; ++j) { const int e = 4 * n + j; const unsigned wm = gm[m][e >> 1], wz = g0[m][e >> 1], wp = gq[m][e >> 1];
                            const float xm = (e & 1) ? __uint_as_float(wm & 0xffff0000u) : __uint_as_float(wm << 16), xz = (e & 1) ? __uint_as_float(wz & 0xffff0000u) : __uint_as_float(wz << 16),
                                        xp = (e & 1) ? __uint_as_float(wp & 0xffff0000u) : __uint_as_float(wp << 16);
                            c[j] = w0[n][j] * xm + w1[n][j] * xz + w2[n][j] * xp + bb[n][j]; }
                        const f32x2 ga = gelu_pk((f32x2){c[0], c[1]}), gb = gelu_pk((f32x2){c[2], c[3]});
                        const f32x4 v = acc[ai][bj][m][n]; o[n] = (f32x4){v[0] * ga.x, v[1] * ga.y, v[2] * gb.x, v[3] * gb.y}; }
                    *(u32x4*)(H + (size_t)(R0 + rr) * 2816 + col) = pack8(o[0], o[1]); }
                asm volatile("" ::: "memory");
              }
            }
        }
    }
};

struct EpiBranch {
    static constexpr bool PERM = true, AFTER_DRAIN = false, RESCALE = true;
    const unsigned char* G; bf16_t* Y;
    __device__ __forceinline__ void rescale(f32x4 (&acc)[2][2][4][2], const Unit& u, int t, int wr, int wc, int fr, int fq) const {
        const int bp = (t == 4) ? 0 : (t == 12) ? 1 : 2;
        const __amdgpu_buffer_rsrc_t rs = __builtin_amdgcn_make_buffer_rsrc((void*)G, 0, MT * 4096, 0x00020000);
        const int voff = (u.pm * 256 + wr * 64 + fr) * 4096 + u.pn * 256 + wc * 32 + 8 * fq;
        u32x2 p[2][4][2], q[2][4][2];
#pragma unroll
        for (int ai = 0; ai < 2; ++ai)
#pragma unroll
            for (int m = 0; m < 4; ++m)
#pragma unroll
                for (int bj = 0; bj < 2; ++bj) { const int so = (ai * 128 + m * 16) * 4096 + bj * 128 + bp * 1024;
                    p[ai][m][bj] = __builtin_bit_cast(u32x2, __builtin_amdgcn_raw_buffer_load_b64(rs, voff, so, 0)); q[ai][m][bj] = __builtin_bit_cast(u32x2, __builtin_amdgcn_raw_buffer_load_b64(rs, voff, so + 1024, 0)); }
        asm volatile("" ::: "memory");
#pragma unroll
        for (int ai = 0; ai < 2; ++ai)
#pragma unroll
            for (int m = 0; m < 4; ++m)
#pragma unroll
                for (int bj = 0; bj < 2; ++bj)
#pragma unroll
                    for (int n = 0; n < 2; ++n) { const unsigned pw = n ? p[ai][m][bj].y : p[ai][m][bj].x, qw = n ? q[ai][m][bj].y : q[ai][m][bj].x;
#pragma unroll
                        for (int j = 0; j < 4; ++j) acc[ai][bj][m][n][j] *= (float)((pw >> (8 * j)) & 255u) * __builtin_amdgcn_rcpf((float)((qw >> (8 * j)) & 255u)); }
        asm volatile("" ::: "memory");
    }
    __device__ __forceinline__ void operator()(const f32x4 (&acc)[2][2][4][2], const Unit& u, int wr, int wc, int fr, int fq) const {
        const int row0 = u.pm * 256 + wr * 64 + fr, col0 = u.pn * 256 + wc * 32 + 8 * fq;
#pragma unroll
        for (int ai = 0; ai < 2; ++ai)
#pragma unroll
            for (int m = 0; m < 4; ++m)
#pragma unroll
                for (int bj = 0; bj < 2; ++bj) { const size_t r = (size_t)(row0 + ai * 128 + m * 16); const u32x2 p = *(const u32x2*)(G + r * 4096 + 3072 + col0 + bj * 128);
                    f32x4 o[2];
#pragma unroll
                    for (int n = 0; n < 2; ++n) { const unsigned pw = n ? p.y : p.x;
#pragma unroll
                        for (int j = 0; j < 4; ++j) o[n][j] = acc[ai][bj][m][n][j] * ((float)((pw >> (8 * j)) & 255u) * (1.0f / 255.0f)); }
                    *(u32x4*)(Y + r * 1024 + col0 + bj * 128) = pack8(o[0], o[1]); }
    }
};


struct SplitKOrder {
    int nsl, ksl, G, c;
    __device__ __forceinline__ bool next(int i, Unit& u) const { const int L = i * G + c; if (L >= 8 * nsl) return false; u.pm = (L >> 2) & 1; u.pn = L & 3; u.sl = L >> 3; u.ko = u.sl * ksl; return true; }
    __device__ __forceinline__ void a_ready(const Unit&) const {}
    __device__ __forceinline__ void done(const Unit&) const {}
};
struct EpiSlab {
    static constexpr bool PERM = false, AFTER_DRAIN = false, RESCALE = false;
    float* slab;
    __device__ __forceinline__ void operator()(const f32x4 (&acc)[2][2][4][2], const Unit& u, int wr, int wc, int, int) const {
        int ln; asm volatile("v_mbcnt_lo_u32_b32 %0, -1, 0\n\tv_mbcnt_hi_u32_b32 %0, -1, %0" : "=v"(ln));
        const int fr = ln & 15, fq = ln >> 4;
        float* o = slab + (size_t)u.sl * 512 * 1024 + (size_t)(u.pm * 256 + wr * 64 + fr) * 1024 + u.pn * 256 + wc * 32 + 4 * fq;
#pragma unroll
        for (int ai = 0; ai < 2; ++ai)
#pragma unroll
            for (int m = 0; m < 4; ++m)
#pragma unroll
                for (int bj = 0; bj < 2; ++bj)
#pragma unroll
                    for (int n = 0; n < 2; ++n) *(f32x4*)(o + (size_t)(ai * 128 + m * 16) * 1024 + bj * 128 + n * 16) = acc[ai][bj][m][n];
    }
};

struct BranchSliceOrder {
    int G, c;
    __device__ __forceinline__ bool next(int i, Unit& u) const { const int L = i * G + c; if (L >= 40) return false; u.pm = (L >> 2) & 1; u.pn = L & 3; u.sl = L >> 3; u.ko = u.sl * 256; return true; }
    __device__ __forceinline__ void a_ready(const Unit&) const {}
    __device__ __forceinline__ void done(const Unit&) const {}
};
template <class Epi, class Sched, bool ALIGN_EPI = false, bool SP2 = false>
__device__ __forceinline__ void gemm_phase(PG8_LAS unsigned char* lds, const Gemm g, const Sched& S, const Epi& E, const int tid) {
    const int wid = __builtin_amdgcn_readfirstlane(tid >> 6), lane = tid & 63, wr = wid >> 2, wc = wid & 3, fr = lane & 15, fq = lane >> 4;
    const int K = g.ld ? g.ld : g.K  , nt = g.K / BK;
    unsigned voffA[2], voffB[2];
#pragma unroll
    for (int i = 0; i < 2; ++i) { int R, C; stage_rc(tid * 16 + i * 8192, R, C); const int Rb = Epi::PERM ? ((R & ~31) + perm32(R & 31)) : R;
        voffA[i] = (unsigned)(R * K + C) * 2u; voffB[i] = (unsigned)(Rb * K + C) * 2u; }
    const size_t kstep = (size_t)(BK * 2);
    const size_t hstep = (size_t)HALF * K * 2;
    const size_t tstep = 2 * hstep;
    const unsigned ldsw = (unsigned)wid * 1024u;
    const int aoff = lds_byte(wr * 64 + fr, fq * 8), boff = lds_byte(wc * 32 + fr, fq * 8);
#define PG8_SA(b, h) (((b) * 2 + (h)) * HTB)
#define PG8_SB(b, h) ((4 + (b) * 2 + (h)) * HTB)
#define PG8_STAGE(bufoff, gbase, voff) do { _Pragma("unroll") for (int _i = 0; _i < 2; ++_i) \
        __builtin_amdgcn_global_load_lds((const unsigned*)((const char*)(gbase) + (voff)[_i]), (PG8_LAS unsigned*)(lds + (bufoff) + ldsw + _i * 8192), 16, 0, 0); } while (0)
#define PG8_LDA(dst, b, h) do { _Pragma("unroll") for (int m = 0; m < 4; ++m) _Pragma("unroll") for (int k = 0; k < 2; ++k) dst[m][k] = *(const PG8_LAS bf16x8*)(lds + PG8_SA(b, h) + aoff + m * 2048 + k * 1024); } while (0)
#define PG8_LDB(dst, b, h) do { _Pragma("unroll") for (int n = 0; n < 2; ++n) _Pragma("unroll") for (int k = 0; k < 2; ++k) dst[n][k] = *(const PG8_LAS bf16x8*)(lds + PG8_SB(b, h) + boff + n * 2048 + k * 1024); } while (0)
#define PG8_MMA(ai, bj, At, Bt) do { __builtin_amdgcn_s_setprio(1); _Pragma("unroll") for (int m = 0; m < 4; ++m) _Pragma("unroll") for (int n = 0; n < 2; ++n) _Pragma("unroll") for (int k = 0; k < 2; ++k) \
        acc[ai][bj][m][n] = __builtin_amdgcn_mfma_f32_16x16x32_bf16(Bt[n][k], At[m][k], acc[ai][bj][m][n], 0, 0, 0); __builtin_amdgcn_s_setprio(0); } while (0)
#define PG8_WAIT_V(n) asm volatile("s_waitcnt vmcnt(" #n ")" ::: "memory")
#define PG8_WAIT_L(n) asm volatile("s_waitcnt lgkmcnt(" #n ")" ::: "memory")
#define PG8_BAR __builtin_amdgcn_s_barrier()
#define PG8_SCHED __builtin_amdgcn_sched_barrier(0)
    Unit cur, nxt; int ui = 0;
    if (!S.next(0, cur)) return;
    f32x4 acc[2][2][4][2];
#pragma unroll
    for (int a = 0; a < 2; ++a)
#pragma unroll
        for (int b = 0; b < 2; ++b)
#pragma unroll
            for (int m = 0; m < 4; ++m)
#pragma unroll
                for (int n = 0; n < 2; ++n) acc[a][b][m][n] = (f32x4){0.f, 0.f, 0.f, 0.f};
    bf16x8 At[4][2], B0[2][2], B1[2][2];
    const char* cA = (const char*)g.A + (size_t)cur.pm * tstep + (size_t)cur.ko * 2; const char* cB = (const char*)g.Bt + (size_t)cur.pn * tstep + (size_t)cur.ko * 2;
    S.a_ready(cur);
    if constexpr (SP2) {
        PG8_STAGE(PG8_SB(0, 0), cB, voffB); PG8_STAGE(PG8_SB(0, 1), cB + hstep, voffB); PG8_STAGE(PG8_SA(0, 0), cA, voffA); PG8_STAGE(PG8_SA(0, 1), cA + hstep, voffA);
        if (wr == 1) PG8_BAR;
        PG8_WAIT_V(2); PG8_BAR;
        PG8_STAGE(PG8_SB(1, 0), cB + kstep, voffB); PG8_STAGE(PG8_SA(1, 0), cA + kstep, voffA); PG8_STAGE(PG8_SB(1, 1), cB + hstep + kstep, voffB);
        PG8_WAIT_V(6); PG8_BAR;
    } else {
        PG8_STAGE(PG8_SB(0, 0), cB, voffB); PG8_STAGE(PG8_SA(0, 0), cA, voffA); PG8_STAGE(PG8_SB(0, 1), cB + hstep, voffB); PG8_STAGE(PG8_SA(0, 1), cA + hstep, voffA);
        if (wr == 1) PG8_BAR;
        PG8_WAIT_V(4); PG8_BAR;
        PG8_STAGE(PG8_SB(1, 0), cB + kstep, voffB); PG8_STAGE(PG8_SA(1, 0), cA + kstep, voffA); PG8_STAGE(PG8_SB(1, 1), cB + hstep + kstep, voffB);
        PG8_WAIT_V(6); PG8_BAR;
    }
    for (;;) {
        const bool has_next = S.next(ui + 1, nxt);
        const char* nA = has_next ? (const char*)g.A + (size_t)nxt.pm * tstep + (size_t)nxt.ko * 2 : cA; const char* nB = has_next ? (const char*)g.Bt + (size_t)nxt.pn * tstep + (size_t)nxt.ko * 2 : cB;
        for (int t = 0; t < nt; t += 2) {
            if constexpr (Epi::RESCALE) { if (t == 4 || t == 12 || t == 16) E.rescale(acc, cur, t, wr, wc, fr, fq); }
            const bool last = (t == nt - 2);
            const char* a1 = cA + (size_t)(t + 1) * kstep;
            const char* a2 = last ? nA : cA + (size_t)(t + 2) * kstep; const char* b2 = last ? nB : cB + (size_t)(t + 2) * kstep;
            const char* a3 = a2 + kstep; const char* b3 = b2 + kstep;
            if (last && has_next) S.a_ready(nxt);
            if constexpr (SP2) {
            PG8_LDB(B0, 0, 0); PG8_LDB(B1, 0, 1); PG8_SCHED; PG8_LDA(At, 0, 0); PG8_STAGE(PG8_SA(1, 1), a1 + hstep, voffA);
            PG8_WAIT_V(8); PG8_WAIT_L(0); PG8_BAR; PG8_MMA(0, 0, At, B0); PG8_MMA(0, 1, At, B1); PG8_BAR; PG8_SCHED;
            PG8_LDA(At, 0, 1); PG8_STAGE(PG8_SB(0, 0), b2, voffB); PG8_STAGE(PG8_SB(0, 1), b2 + hstep, voffB); PG8_STAGE(PG8_SA(0, 0), a2, voffA);
            PG8_WAIT_V(8); PG8_WAIT_L(0); PG8_BAR; PG8_MMA(1, 0, At, B0); PG8_MMA(1, 1, At, B1); PG8_BAR; PG8_SCHED;
            PG8_LDB(B0, 1, 0); PG8_LDB(B1, 1, 1); PG8_SCHED; PG8_LDA(At, 1, 0); PG8_STAGE(PG8_SA(0, 1), a2 + hstep, voffA);
            PG8_WAIT_V(8); PG8_WAIT_L(0); PG8_BAR; PG8_MMA(0, 0, At, B0); PG8_MMA(0, 1, At, B1); PG8_BAR; PG8_SCHED;
            PG8_LDA(At, 1, 1); PG8_STAGE(PG8_SB(1, 0), b3, voffB); PG8_STAGE(PG8_SB(1, 1), b3 + hstep, voffB); PG8_STAGE(PG8_SA(1, 0), a3, voffA);
            PG8_WAIT_V(8); PG8_WAIT_L(0); PG8_BAR; PG8_MMA(1, 0, At, B0); PG8_MMA(1, 1, At, B1); PG8_BAR; PG8_SCHED;
            } else {
            PG8_LDB(B0, 0, 0); PG8_SCHED; PG8_LDA(At, 0, 0); PG8_STAGE(PG8_SA(1, 1), a1 + hstep, voffA);
            PG8_WAIT_L(8); PG8_BAR; PG8_WAIT_L(0); PG8_MMA(0, 0, At, B0); PG8_BAR; PG8_SCHED;
            PG8_LDB(B1, 0, 1); PG8_STAGE(PG8_SB(0, 0), b2, voffB);
            PG8_BAR; PG8_WAIT_L(0); PG8_MMA(0, 1, At, B1); PG8_BAR;
            PG8_LDA(At, 0, 1); PG8_STAGE(PG8_SA(0, 0), a2, voffA);
            PG8_BAR; PG8_WAIT_L(0); PG8_MMA(1, 0, At, B0); PG8_BAR; PG8_SCHED;
            PG8_STAGE(PG8_SB(0, 1), b2 + hstep, voffB);
            PG8_WAIT_V(6); PG8_BAR; PG8_MMA(1, 1, At, B1); PG8_BAR;
            PG8_LDB(B0, 1, 0); PG8_SCHED; PG8_LDA(At, 1, 0); PG8_STAGE(PG8_SA(0, 1), a2 + hstep, voffA);
            PG8_WAIT_L(8); PG8_BAR; PG8_WAIT_L(0); PG8_MMA(0, 0, At, B0); PG8_BAR; PG8_SCHED;
            PG8_LDB(B1, 1, 1); PG8_STAGE(PG8_SB(1, 0), b3, voffB);
            PG8_BAR; PG8_WAIT_L(0); PG8_MMA(0, 1, At, B1); PG8_BAR;
            PG8_LDA(At, 1, 1); PG8_STAGE(PG8_SA(1, 0), a3, voffA);
            PG8_BAR; PG8_WAIT_L(0); PG8_MMA(1, 0, At, B0); PG8_BAR; PG8_SCHED;
            PG8_STAGE(PG8_SB(1, 1), b3 + hstep, voffB);
            PG8_WAIT_V(6); PG8_BAR; PG8_MMA(1, 1, At, B1); PG8_BAR;
            }
        }
        if constexpr (ALIGN_EPI) { if (wr == 0) PG8_BAR; }
        if constexpr (!Epi::AFTER_DRAIN) { E(acc, cur, wr, wc, fr, fq); S.done(cur); }
        if (!has_next) break;
#pragma unroll
        for (int a = 0; a < 2; ++a)
#pragma unroll
            for (int b = 0; b < 2; ++b)
#pragma unroll
                for (int m = 0; m < 4; ++m)
#pragma unroll
                    for (int n = 0; n < 2; ++n) acc[a][b][m][n] = (f32x4){0.f, 0.f, 0.f, 0.f};
        cur = nxt; cA = nA; cB = nB; ++ui;
        if constexpr (ALIGN_EPI) { if (wr == 1) PG8_BAR; }
    }
    PG8_WAIT_V(0);
    if constexpr (!ALIGN_EPI) { if (wr == 0) PG8_BAR; }
    PG8_BAR;
    if constexpr (Epi::AFTER_DRAIN) { E.fused(acc, cur, wr, wc, fr, fq, lds, wid, lane); S.done(cur); }
#undef PG8_SA
#undef PG8_SB
#undef PG8_STAGE
#undef PG8_LDA
#undef PG8_LDB
#undef PG8_MMA
#undef PG8_WAIT_V
#undef PG8_WAIT_L
#undef PG8_BAR
#undef PG8_SCHED
}
}
namespace att {
constexpr int NW = 8, QBLK = 32, KVBLK = 64, LDQ = 512, LDO = KCAT;
constexpr int SHM_V = 16384, SHM_K = 16384, SHM_ATTN = 3 * SHM_V + 2 * SHM_K + NW * 64 * 4;
constexpr float THR = 8.f;
#ifndef ATT_SDEPTH
#define ATT_SDEPTH 1
#endif
constexpr int SDEPTH = ATT_SDEPTH;
#define KSWZ(row, colB) ((row) * 256 + ((colB) ^ (((row) & 7) << 4)))
#define SBAR() __builtin_amdgcn_sched_barrier(0)
__device__ __forceinline__ int crow(int r, int hi) { return (r & 3) + 8 * (r >> 2) + 4 * hi; }
__device__ __forceinline__ unsigned cvtpk(float lo, float hi) { return cvt2bf(lo, hi); }

__device__ __forceinline__ void partialSM(f32x16& p0, f32x16& p1, float& m_reg, float& mn, float& alpha) {
  constexpr float C = 1.4426950408889634f;
  float pmax = p0[0];
#pragma unroll
  for (int r = 1; r < 16; ++r) pmax = fmaxf(pmax, p0[r]);
#pragma unroll
  for (int r = 0; r < 16; ++r) pmax = fmaxf(pmax, p1[r]);
  { auto rr = __builtin_amdgcn_permlane32_swap(__float_as_uint(pmax), __float_as_uint(pmax), false, false);
    pmax = fmaxf(__uint_as_float(rr[0]), __uint_as_float(rr[1])); }
  if (__builtin_expect(__all(pmax - m_reg <= THR), 1)) { mn = m_reg; alpha = 1.f; }
  else { mn = fmaxf(m_reg, pmax); alpha = __builtin_amdgcn_exp2f((m_reg - mn) * C); m_reg = mn; }
  const float mnC = -mn * C;
#pragma unroll
  for (int r = 0; r < 16; ++r) p0[r] = fmaf(p0[r], C, mnC);
#pragma unroll
  for (int r = 0; r < 16; ++r) p1[r] = fmaf(p1[r], C, mnC);
#pragma unroll
  for (int r = 0; r < 16; ++r) p0[r] = __builtin_amdgcn_exp2f(p0[r]);
}
__device__ __forceinline__ void finishSM(f32x16& p0, f32x16& p1, float alpha, float& l_reg, bf16x8& pa0, bf16x8& pa1, bf16x8& pa2, bf16x8& pa3) {
#pragma unroll
  for (int r = 0; r < 16; ++r) p1[r] = __builtin_amdgcn_exp2f(p1[r]);
  float ps = 0;
#pragma unroll
  for (int r = 0; r < 16; ++r) ps += p0[r];
#pragma unroll
  for (int r = 0; r < 16; ++r) ps += p1[r];
  { auto rr = __builtin_amdgcn_permlane32_swap(__float_as_uint(ps), __float_as_uint(ps), false, false);
    ps = __uint_as_float(rr[0]) + __uint_as_float(rr[1]); }
  l_reg = l_reg * alpha + ps;
#define PK4(P, BASE, OUT) do { unsigned a0 = cvtpk(P[BASE + 0], P[BASE + 1]), a1 = cvtpk(P[BASE + 2], P[BASE + 3]);   \
    unsigned b0 = cvtpk(P[BASE + 4], P[BASE + 5]), b1 = cvtpk(P[BASE + 6], P[BASE + 7]);                              \
    auto r0 = __builtin_amdgcn_permlane32_swap(a0, b0, false, false); auto r1 = __builtin_amdgcn_permlane32_swap(a1, b1, false, false); \
    u32x4 w = {r0[0], r1[0], r0[1], r1[1]}; OUT = *reinterpret_cast<bf16x8*>(&w); } while (0)
  PK4(p0, 0, pa0); PK4(p0, 8, pa1); PK4(p1, 0, pa2); PK4(p1, 8, pa3);
#undef PK4
}
__device__ __forceinline__ void qkt(f32x16& p0, f32x16& p1, const char* Ks, const bf16x8* qr, int r32, int hi, int kcol) {
  p0 = f32x16{}; p1 = f32x16{};
#pragma unroll
  for (int d0 = 0; d0 < 4; ++d0) { const int cb = kcol + (d0 * 16 + hi * 8) * 2;
    const bf16x8 b0 = *reinterpret_cast<const bf16x8*>(Ks + KSWZ(r32, cb));
    const bf16x8 b1 = *reinterpret_cast<const bf16x8*>(Ks + KSWZ(32 + r32, cb));
    p0 = __builtin_amdgcn_mfma_f32_32x32x16_bf16(b0, qr[d0], p0, 0, 0, 0);
    p1 = __builtin_amdgcn_mfma_f32_32x32x16_bf16(b1, qr[d0], p1, 0, 0, 0); }
}
__device__ __forceinline__ int v_st(int k, int c) { const int kk = (k & ~0xC) | ((k & 4) << 1) | ((k & 8) >> 1); return ((kk >> 3) * 4 + (c >> 5)) * 512 + ((kk & 7) * 32 + (c & 31)) * 2; }
__device__ __forceinline__ int v_rd_base(int lane) { return ((lane & 3) << 3) | (((lane >> 2) & 3) << 6) | (((lane >> 4) & 1) << 5) | (((lane >> 5) & 1) << 8); }
constexpr int v_rd_off(int d0, int ks, int half) { return d0 * 512 + ks * 4096 + half * 2048; }
template <int OFF> __device__ __forceinline__ s16x4 tr_read(int vb) {
  s16x4 r; asm volatile("ds_read_b64_tr_b16 %0, %1 offset:%2" : "=&v"(r) : "v"(vb), "i"(OFF) : "memory"); return r;
}
template <int D0> __device__ __forceinline__ void pv_one(f32x16& od, int vb, bf16x8 pa0, bf16x8 pa1, bf16x8 pa2, bf16x8 pa3) {
  const s16x4 l0 = tr_read<v_rd_off(D0, 0, 0)>(vb), h0 = tr_read<v_rd_off(D0, 0, 1)>(vb), l1 = tr_read<v_rd_off(D0, 1, 0)>(vb), h1 = tr_read<v_rd_off(D0, 1, 1)>(vb);
  const s16x4 l2 = tr_read<v_rd_off(D0, 2, 0)>(vb), h2 = tr_read<v_rd_off(D0, 2, 1)>(vb), l3 = tr_read<v_rd_off(D0, 3, 0)>(vb), h3 = tr_read<v_rd_off(D0, 3, 1)>(vb);
  asm volatile("s_waitcnt lgkmcnt(0)" ::: "memory"); SBAR();
#define PK(L, H) (bf16x8){L[0], L[1], L[2], L[3], H[0], H[1], H[2], H[3]}
  od = __builtin_amdgcn_mfma_f32_32x32x16_bf16(pa0, PK(l0, h0), od, 0, 0, 0);
  od = __builtin_amdgcn_mfma_f32_32x32x16_bf16(pa1, PK(l1, h1), od, 0, 0, 0);
  od = __builtin_amdgcn_mfma_f32_32x32x16_bf16(pa2, PK(l2, h2), od, 0, 0, 0);
  od = __builtin_amdgcn_mfma_f32_32x32x16_bf16(pa3, PK(l3, h3), od, 0, 0, 0);
#undef PK
}
__device__ __forceinline__ void pv_d0(f32x16* o, int vb, bf16x8 pa0, bf16x8 pa1, bf16x8 pa2, bf16x8 pa3) {
  pv_one<0>(o[0], vb, pa0, pa1, pa2, pa3); pv_one<1>(o[1], vb, pa0, pa1, pa2, pa3); pv_one<2>(o[2], vb, pa0, pa1, pa2, pa3); pv_one<3>(o[3], vb, pa0, pa1, pa2, pa3);
}

template <int VAR>
__device__ __forceinline__ void attn_unit(const bf16_t* __restrict__ Qb, const bf16_t* __restrict__ Kh, const bf16_t* __restrict__ Vh, int nkeys,
                                          bf16_t* __restrict__ Ob, float lam, float osc, const float* __restrict__ sg, char* lds, const int tid) {
  const int wid = __builtin_amdgcn_readfirstlane(tid >> 6), lane = tid & 63, r32 = lane & 31, hi = lane >> 5;
  const int comp = wid >> 2, qw = wid & 3, kcol = comp * 128;
  char* K_lds = lds; char* V_lds = lds + 2 * SHM_K;
  float* ws = (float*)(lds + 2 * SHM_K + 3 * SHM_V) + wid * 64; float* li_l = ws; float* al_l = ws + 32;
  float m_reg = -1e30f, l_reg = 0; f32x16 o[4] = {}; bf16x8 qr[4];
  const bf16_t* Qw = Qb + (long)(qw * QBLK + r32) * LDQ + comp * 64 + hi * 8;
#pragma unroll
  for (int d0 = 0; d0 < 4; ++d0) qr[d0] = *reinterpret_cast<const bf16x8*>(Qw + d0 * 16);
  const int sr = tid >> 4, sc = (tid & 15) * 8, vst0 = v_st(sr, sc), vst1 = v_st(32 + sr, sc);
  const int vb0 = (int)(uintptr_t)V_lds + v_rd_base(lane);
  bf16x8 sk0 = {}, sk1 = {}, sv0 = {}, sv1 = {};
#define LOADK(t) do { if constexpr (!(VAR & 8)) { sk0 = *reinterpret_cast<const bf16x8*>(&Kh[(long)((t) * KVBLK + sr) * LDQ + sc]); sk1 = *reinterpret_cast<const bf16x8*>(&Kh[(long)((t) * KVBLK + 32 + sr) * LDQ + sc]); } } while (0)
#define LOADV(t) do { if constexpr (!(VAR & 8)) { sv0 = *reinterpret_cast<const bf16x8*>(&Vh[(long)((t) * KVBLK + sr) * LDQ + sc]); sv1 = *reinterpret_cast<const bf16x8*>(&Vh[(long)((t) * KVBLK + 32 + sr) * LDQ + sc]); } } while (0)
#define WRITEK(slot) do { if constexpr (!(VAR & 8)) { *(bf16x8*)(K_lds + (slot) * SHM_K + KSWZ(sr, sc * 2)) = sk0; *(bf16x8*)(K_lds + (slot) * SHM_K + KSWZ(32 + sr, sc * 2)) = sk1; } } while (0)
#define WRITEV(off) do { if constexpr (!(VAR & 8)) { *(bf16x8*)(V_lds + (off) + vst0) = sv0; *(bf16x8*)(V_lds + (off) + vst1) = sv1; } } while (0)
#define VMW() asm volatile("s_waitcnt vmcnt(0)" ::: "memory")
#define QKT(P0, P1, KS) do { if constexpr (VAR & 4) { P0 = f32x16{}; P1 = f32x16{}; asm volatile("" : "+v"(P0), "+v"(P1)); } else qkt(P0, P1, KS, qr, r32, hi, kcol); } while (0)
#define PSM(P0, P1, MN, AL) do { if constexpr (VAR & 1) { MN = m_reg; AL = 1.f; asm volatile("" : "+v"(P0), "+v"(P1)); } else partialSM(P0, P1, m_reg, MN, AL); } while (0)
#define FSM(P0, P1, AL) do { if constexpr (VAR & 1) { asm volatile("" : "+v"(P0), "+v"(P1)); pa0 = __builtin_bit_cast(bf16x8, (f32x4){P0[0], P0[1], P0[2], P0[3]}); pa1 = __builtin_bit_cast(bf16x8, (f32x4){P0[4], P0[5], P0[6], P0[7]}); pa2 = __builtin_bit_cast(bf16x8, (f32x4){P1[0], P1[1], P1[2], P1[3]}); pa3 = __builtin_bit_cast(bf16x8, (f32x4){P1[4], P1[5], P1[6], P1[7]}); } else finishSM(P0, P1, AL, l_reg, pa0, pa1, pa2, pa3); } while (0)
#define PV(OFF) do { if constexpr (VAR & 2) { asm volatile("" : "+v"(pa0), "+v"(pa1), "+v"(pa2), "+v"(pa3)); } else pv_d0(o, vb0 + (OFF), pa0, pa1, pa2, pa3); } while (0)
#define RESC(a) do { if (__any((a) < 1.f)) { if (hi == 0) al_l[r32] = (a); asm volatile("s_waitcnt lgkmcnt(0)" ::: "memory"); \
    _Pragma("unroll") for (int d = 0; d < 4; ++d) _Pragma("unroll") for (int r = 0; r < 16; ++r) o[d][r] *= al_l[crow(r, hi)]; } } while (0)
  f32x16 pA0, pA1, pB0, pB1; float mnA, mnB, alA, alB; bf16x8 pa0, pa1, pa2, pa3; const int NT = nkeys / KVBLK;
  LOADK(0); VMW(); WRITEK(0); LOADK(1); LOADV(0);
  __syncthreads();
  if (comp == 1) __syncthreads();
  VMW(); WRITEK(1); WRITEV(0);
  SBAR(); QKT(pA0, pA1, K_lds); SBAR();
  __syncthreads();
  LOADK(2); LOADV(1); SBAR();
  PSM(pA0, pA1, mnA, alA);
  __syncthreads();
  int va = 0, vb = SHM_V, vc = 2 * SHM_V;
  for (int j = 1; j + 1 < NT; j += 2) {
    VMW(); WRITEK(0); WRITEV(vb);
    SBAR(); QKT(pB0, pB1, K_lds + SHM_K);
    FSM(pA0, pA1, alA); SBAR();
    __syncthreads();
    LOADK(j + 2); LOADV(j + 1); SBAR();
    PV(va); PSM(pB0, pB1, mnB, alB);
    RESC(alB);
    __syncthreads();
    VMW(); WRITEK(1); WRITEV(vc);
    SBAR(); QKT(pA0, pA1, K_lds);
    FSM(pB0, pB1, alB); SBAR();
    __syncthreads();
    if (j + 3 < NT) LOADK(j + 3);
    LOADV(j + 2); SBAR();
    PV(vb); PSM(pA0, pA1, mnA, alA);
    RESC(alA);
    __syncthreads();
    { const int t = va; va = vc; vc = vb; vb = t; }
  }
  VMW(); WRITEV(vb);
  SBAR(); QKT(pB0, pB1, K_lds + SHM_K);
  FSM(pA0, pA1, alA); SBAR();
  __syncthreads();
  PV(va); PSM(pB0, pB1, mnB, alB);
  RESC(alB);
  __syncthreads();
  FSM(pB0, pB1, alB); SBAR();
  PV(vb);
  if (comp == 0) __syncthreads();
  if (hi == 0) li_l[r32] = l_reg; asm volatile("s_waitcnt lgkmcnt(0)" ::: "memory");
  float rli[16];
#pragma unroll
  for (int r = 0; r < 16; ++r) rli[r] = __builtin_amdgcn_rcpf(li_l[crow(r, hi)]);
  __syncthreads();
  float* XO = (float*)lds + qw * (32 * 128);
  if (comp == 1) {
#pragma unroll
    for (int r = 0; r < 16; ++r)
#pragma unroll
      for (int d0 = 0; d0 < 4; ++d0) XO[crow(r, hi) * 128 + d0 * 32 + r32] = o[d0][r] * rli[r];
  }
  __syncthreads();
  if (comp == 0) {
    float ss[16];
#pragma unroll
    for (int r = 0; r < 16; ++r) { float s = 0.f;
#pragma unroll
      for (int d0 = 0; d0 < 4; ++d0) { const float v = o[d0][r] * rli[r] - lam * XO[crow(r, hi) * 128 + d0 * 32 + r32]; o[d0][r] = v; s += v * v; }
      ss[r] = s; }
#pragma unroll
    for (int r = 0; r < 16; ++r) { float s = ss[r]; s += swz_xor<1>(s); s += swz_xor<2>(s); s += swz_xor<4>(s); s += swz_xor<8>(s); s += swz_xor<16>(s);
      ss[r] = osc / sqrtf(s * (1.0f / 128.0f) + EPS); }
    float gam[4];
#pragma unroll
    for (int d0 = 0; d0 < 4; ++d0) gam[d0] = sg[d0 * 32 + r32];
    asm volatile("s_waitcnt lgkmcnt(0)" ::: "memory");
    bf16_t* stg = (bf16_t*)XO;
#pragma unroll
    for (int r = 0; r < 16; ++r)
#pragma unroll
      for (int d0 = 0; d0 < 4; ++d0) stg[crow(r, hi) * 128 + d0 * 32 + r32] = (bf16_t)(cvtpk(o[d0][r] * ss[r] * gam[d0], 0.f) & 0xffffu);
    asm volatile("s_waitcnt lgkmcnt(0)" ::: "memory");
#pragma unroll
    for (int i = 0; i < 8; ++i) { const int row = i * 4 + (lane >> 4), ch = lane & 15; const u32x4 v = *(const u32x4*)(stg + row * 128 + ch * 8);
      if constexpr (VAR & 16) { asm volatile("" :: "v"(v.x), "v"(v.y), "v"(v.z), "v"(v.w)); } else *(u32x4*)(Ob + (long)(qw * QBLK + row) * LDO + ch * 8) = v; }
  }
  __syncthreads();
#undef LOADK
#undef LOADV
#undef WRITEK
#undef WRITEV
#undef VMW
#undef QKT
#undef PSM
#undef FSM
#undef PV
#undef RESC
}
#undef KSWZ
#undef SBAR
}
namespace att2 {
using att::crow; using att::v_st; using att::v_rd_base; using att::v_rd_off;
constexpr int NW = 8, QBLK = 32, KVBLK = 64, LDQ = 512, LDO = KCAT, SHM_K = 16384, SHM_V = 16384;
constexpr float THRL = 8.0f;
#ifndef ATT_STAGGER
#define ATT_STAGGER 1
#endif
typedef short v4i16_t __attribute__((ext_vector_type(4)));
typedef __attribute__((address_space(3))) const char* lds_cptr;
typedef __attribute__((address_space(3))) char* lds_ptr;
#define SBAR() __builtin_amdgcn_sched_barrier(0)
#define KSWZ(row, colB) ((row) * 256 + ((colB) ^ (((row) & 7) << 4)))
__device__ __forceinline__ s16x4 vtr(lds_cptr p) { return __builtin_bit_cast(s16x4, __builtin_amdgcn_ds_read_tr16_b64_v4i16((__attribute__((address_space(3))) v4i16_t*)p)); }
__device__ __forceinline__ bf16x8 ldk(lds_cptr p) { return *(const __attribute__((address_space(3))) bf16x8*)p; }
#define MF(D, A, B, C) do { if constexpr (VAR & 4) { asm volatile("" : "+v"(D)); } else D = __builtin_amdgcn_mfma_f32_32x32x16_bf16(A, B, C, 0, 0, 0); } while (0)
#define VF(L, H) (bf16x8){L[0], L[1], L[2], L[3], H[0], H[1], H[2], H[3]}

__device__ __forceinline__ int vkey(int g) { const int s_ = g >> 5, kk = ((s_ >> 2) << 3) | ((g >> 2) & 7); return (kk & ~0xC) | ((kk & 4) << 1) | ((kk & 8) >> 1); }
template <int VAR>
__device__ __forceinline__ void attn_unit(const bf16_t* __restrict__ Qb, const bf16_t* __restrict__ Kh, const bf16_t* __restrict__ Vh, int nkeys,
                                          bf16_t* __restrict__ Ob, float lam, float osc, const float* __restrict__ sg, char* lds, const int tid) {
  const int wid = __builtin_amdgcn_readfirstlane(tid >> 6), lane = tid & 63, r32 = lane & 31, hi = lane >> 5;
  const int comp = wid >> 2, qw = wid & 3, kcol = comp * 128;
  const lds_ptr L3 = (lds_ptr)(unsigned)(uintptr_t)lds;
  float* ws = (float*)(lds + 3 * SHM_K + 3 * SHM_V) + wid * 64; float* li_l = ws; float* al_l = ws + 32;
  float mhat = 0.f, l_reg = 0.f; f32x16 o[4] = {}; bf16x8 qr[4]; f32x16 negm = {};
  const bf16_t* Qw = Qb + (long)(qw * QBLK + r32) * LDQ + comp * 64 + hi * 8;
#pragma unroll
  for (int d0 = 0; d0 < 4; ++d0) qr[d0] = *reinterpret_cast<const bf16x8*>(Qw + d0 * 16);
  const int sr = tid >> 4, sc = (tid & 15) * 8;
  const int kr0 = 4 * wid + (lane >> 4), kr1 = kr0 + 32;
  const bf16_t* ksrc0 = Kh + (long)kr0 * LDQ + (((lane & 15) ^ (kr0 & 7)) << 3); const bf16_t* ksrc1 = Kh + (long)kr1 * LDQ + (((lane & 15) ^ (kr1 & 7)) << 3);
  const int g0_ = 64 * wid + lane, g1_ = g0_ + 512;
  const int vk0 = vkey(g0_), vk1 = vkey(g1_);
  const bf16_t* vsrc0 = Vh + (long)vk0 * LDQ + ((g0_ >> 5) & 3) * 32 + (g0_ & 3) * 8; const bf16_t* vsrc1 = Vh + (long)vk1 * LDQ + ((g1_ >> 5) & 3) * 32 + (g1_ & 3) * 8;
  const unsigned kd0 = (unsigned)(uintptr_t)lds + wid * 1024, kd1 = kd0 + 8192, vd0 = (unsigned)(uintptr_t)lds + 3 * SHM_K + wid * 1024, vd1 = vd0 + 8192;
  lds_cptr kq[4];
#pragma unroll
  for (int d0 = 0; d0 < 4; ++d0) kq[d0] = L3 + r32 * 256 + ((kcol + d0 * 32 + hi * 16) ^ ((r32 & 7) << 4));
  const lds_cptr vp0 = L3 + 3 * SHM_K + v_rd_base(lane);
#define GLDS(src, dst) __builtin_amdgcn_global_load_lds((const unsigned*)(src), (__attribute__((address_space(3))) unsigned*)(dst), 16, 0, 0)
#define DMAK(t, slot) do { if constexpr (!(VAR & 8)) { GLDS(ksrc0 + (long)(t) * KVBLK * LDQ, (unsigned)__builtin_amdgcn_readfirstlane(kd0 + (slot) * SHM_K)); GLDS(ksrc1 + (long)(t) * KVBLK * LDQ, (unsigned)__builtin_amdgcn_readfirstlane(kd1 + (slot) * SHM_K)); } } while (0)
#define DMAV(t, off) do { if constexpr (!(VAR & 8)) { GLDS(vsrc0 + (long)(t) * KVBLK * LDQ, (unsigned)__builtin_amdgcn_readfirstlane(vd0 + (off))); GLDS(vsrc1 + (long)(t) * KVBLK * LDQ, (unsigned)__builtin_amdgcn_readfirstlane(vd1 + (off))); } } while (0)
#ifndef ATT_PRIO
#define ATT_PRIO 1
#endif
#define PRIO(x) do { if (ATT_PRIO == 1) __builtin_amdgcn_s_setprio(x); } while (0)
#define PRIO1(x) do { if (ATT_PRIO == 2) __builtin_amdgcn_s_setprio(x); } while (0)
#define VMW() asm volatile("s_waitcnt vmcnt(0)" ::: "memory")
#define BARW(n) do { asm volatile("s_waitcnt vmcnt(" #n ") lgkmcnt(0)" ::: "memory"); if constexpr (!(VAR & 32)) __builtin_amdgcn_s_barrier(); asm volatile("" ::: "memory"); } while (0)
  f32x16 pA0, pA1, pB0, pB1; u32x4 pw0 = {}, pw1 = {}, pw2 = {}, pw3 = {}; const int NT = nkeys / KVBLK; bool resc = false;
#define KF(KOFF, d0, half) ldk(kq[d0] + (KOFF) + 8192 * (half))
#define PKA(P, B, A0, A1) do { if constexpr (!(VAR & 1)) { A0 = cvt2bf(P[B + 0], P[B + 1]); A1 = cvt2bf(P[B + 2], P[B + 3]); sacc += P[B + 0]; sacc += P[B + 1]; sacc += P[B + 2]; sacc += P[B + 3]; } } while (0)
#define PKB(P, B, A0, A1, PW) do { if constexpr (!(VAR & 1)) { const unsigned b0_ = cvt2bf(P[B + 4], P[B + 5]), b1_ = cvt2bf(P[B + 6], P[B + 7]); \
    auto r0_ = __builtin_amdgcn_permlane32_swap(A0, b0_, false, false); auto r1_ = __builtin_amdgcn_permlane32_swap(A1, b1_, false, false); \
    PW = (u32x4){r0_[0], r1_[0], r0_[1], r1_[1]}; sacc += P[B + 4]; sacc += P[B + 5]; sacc += P[B + 6]; sacc += P[B + 7]; } } while (0)
#define VRD(VOFF, ks, d0, LO, HI) do { LO = vtr(vp0 + (VOFF) + v_rd_off(d0, ks, 0)); HI = vtr(vp0 + (VOFF) + v_rd_off(d0, ks, 1)); } while (0)
#define PAF(k) __builtin_bit_cast(bf16x8, pw##k)
#define EX(X, i) do { if constexpr (!(VAR & 2)) X[i] = __builtin_amdgcn_exp2f(X[i]); } while (0)
#define PIN2(X, Y) asm volatile("" : "+v"(X), "+v"(Y))
#define H1(C0, C1, P0, P1, KOFF, VOFF, FIN) do { \
    float sacc = 0.f; unsigned a0_ = 0, a1_ = 0; s16x4 l0, h0, l1, h1; \
    bf16x8 f0 = KF(KOFF, 0, 0), f1 = KF(KOFF, 0, 1), f2 = KF(KOFF, 1, 0); SBAR(); \
    MF(C0, f0, qr[0], negm); { f0 = KF(KOFF, 1, 1); if (FIN) { EX(P1, 8); PKA(P0, 0, a0_, a1_); PIN2(P0, P1); } } SBAR(); \
    MF(C1, f1, qr[0], negm); { f1 = KF(KOFF, 2, 0); if (FIN) { EX(P1, 9); PKB(P0, 0, a0_, a1_, pw0); PIN2(P0, P1); } } SBAR(); \
    MF(C0, f2, qr[1], C0);   { f2 = KF(KOFF, 2, 1); if (FIN) { VRD(VOFF, 0, 0, l0, h0); EX(P1, 10); PKA(P0, 8, a0_, a1_); PIN2(P0, P1); } } SBAR(); \
    MF(C1, f0, qr[1], C1);   { f0 = KF(KOFF, 3, 0); if (FIN) { VRD(VOFF, 0, 1, l1, h1); EX(P1, 11); PKB(P0, 8, a0_, a1_, pw1); PIN2(P0, P1); } } SBAR(); \
    if (FIN) { MF(o[0], PAF(0), VF(l0, h0), o[0]); VRD(VOFF, 0, 2, l0, h0); EX(P1, 12); PKA(P1, 0, a0_, a1_); PIN2(P0, P1); } SBAR(); \
    MF(C0, f1, qr[2], C0);   { f1 = KF(KOFF, 3, 1); if (FIN) { EX(P1, 13); PKB(P1, 0, a0_, a1_, pw2); PIN2(P0, P1); } } SBAR(); \
    if (FIN) { MF(o[1], PAF(0), VF(l1, h1), o[1]); VRD(VOFF, 0, 3, l1, h1); EX(P1, 14); PIN2(P0, P1); } SBAR(); \
    MF(C1, f2, qr[2], C1);   { if (FIN) { EX(P1, 15); PKA(P1, 8, a0_, a1_); PIN2(P0, P1); } } SBAR(); \
    if (FIN) { MF(o[2], PAF(0), VF(l0, h0), o[2]); } SBAR(); \
    MF(C0, f0, qr[3], C0);   { if (FIN) PKB(P1, 8, a0_, a1_, pw3); } SBAR(); \
    if (FIN) { MF(o[3], PAF(0), VF(l1, h1), o[3]); } SBAR(); \
    MF(C1, f1, qr[3], C1); SBAR(); \
    if (FIN) { auto rr_ = __builtin_amdgcn_permlane32_swap(__float_as_uint(sacc), __float_as_uint(sacc), false, false); l_reg += __uint_as_float(rr_[0]) + __uint_as_float(rr_[1]); } \
  } while (0)
#define MX3(a, b, c) ((VAR & 2) ? (a) : fmaxf(fmaxf((a), (b)), (c)))
#define H2(C0, C1, VOFF, DOPV, FIRST) do { \
    s16x4 l0, h0, l1, h1, l2, h2; float ma, mb, rm; \
    if (DOPV) { VRD(VOFF, 1, 0, l0, h0); VRD(VOFF, 1, 1, l1, h1); VRD(VOFF, 1, 2, l2, h2); } SBAR(); \
    if (DOPV) { MF(o[0], PAF(1), VF(l0, h0), o[0]); VRD(VOFF, 1, 3, l0, h0); } ma = MX3(C0[0], C0[1], C1[0]); mb = MX3(C0[2], C0[3], C1[1]); ma = MX3(ma, C1[2], C1[3]); mb = MX3(mb, C0[4], C0[5]); SBAR(); \
    if (DOPV) { MF(o[1], PAF(1), VF(l1, h1), o[1]); VRD(VOFF, 2, 0, l1, h1); } ma = MX3(ma, C0[6], C0[7]); mb = MX3(mb, C1[4], C1[5]); ma = MX3(ma, C1[6], C1[7]); mb = MX3(mb, C0[8], C0[9]); SBAR(); \
    if (DOPV) { MF(o[2], PAF(1), VF(l2, h2), o[2]); VRD(VOFF, 2, 1, l2, h2); } ma = MX3(ma, C0[10], C0[11]); mb = MX3(mb, C1[8], C1[9]); ma = MX3(ma, C1[10], C1[11]); mb = MX3(mb, C0[12], C0[13]); SBAR(); \
    if (DOPV) { MF(o[3], PAF(1), VF(l0, h0), o[3]); VRD(VOFF, 2, 2, l0, h0); } ma = MX3(ma, C0[14], C0[15]); mb = MX3(mb, C1[12], C1[13]); ma = MX3(ma, C1[14], C1[15]); rm = fmaxf(ma, mb); SBAR(); \
    if (DOPV) { MF(o[0], PAF(2), VF(l1, h1), o[0]); VRD(VOFF, 2, 3, l1, h1); } \
    { auto rr_ = __builtin_amdgcn_permlane32_swap(__float_as_uint(rm), __float_as_uint(rm), false, false); rm = fmaxf(__uint_as_float(rr_[0]), __uint_as_float(rr_[1])); } SBAR(); \
    resc = false; \
    if (FIRST || __builtin_expect(__any(rm > THRL), 0)) { const float dl = FIRST ? rm : fmaxf(rm, 0.f); mhat += dl; \
      _Pragma("unroll") for (int r = 0; r < 16; ++r) { C0[r] -= dl; C1[r] -= dl; } \
      _Pragma("unroll") for (int r = 0; r < 16; ++r) negm[r] = -mhat; \
      if (!(FIRST)) { const float f = __builtin_amdgcn_exp2f(-dl); l_reg *= f; if (hi == 0) al_l[r32] = f; resc = true; } } \
    SBAR(); \
    if (DOPV) { MF(o[1], PAF(2), VF(l2, h2), o[1]); VRD(VOFF, 3, 0, l2, h2); } EX(C0, 0); EX(C0, 1); EX(C0, 2); EX(C0, 3); PIN2(C0, C1); SBAR(); \
    if (DOPV) { MF(o[2], PAF(2), VF(l0, h0), o[2]); VRD(VOFF, 3, 1, l0, h0); } EX(C0, 4); EX(C0, 5); EX(C0, 6); EX(C0, 7); PIN2(C0, C1); SBAR(); \
    if (DOPV) { MF(o[3], PAF(2), VF(l1, h1), o[3]); VRD(VOFF, 3, 2, l1, h1); } EX(C0, 8); EX(C0, 9); EX(C0, 10); EX(C0, 11); PIN2(C0, C1); SBAR(); \
    if (DOPV) { MF(o[0], PAF(3), VF(l2, h2), o[0]); VRD(VOFF, 3, 3, l2, h2); } EX(C0, 12); EX(C0, 13); EX(C0, 14); EX(C0, 15); PIN2(C0, C1); SBAR(); \
    if (DOPV) { MF(o[1], PAF(3), VF(l0, h0), o[1]); } EX(C1, 0); EX(C1, 1); EX(C1, 2); EX(C1, 3); PIN2(C0, C1); SBAR(); \
    if (DOPV) { MF(o[2], PAF(3), VF(l1, h1), o[2]); } EX(C1, 4); EX(C1, 5); EX(C1, 6); EX(C1, 7); PIN2(C0, C1); SBAR(); \
    if (DOPV) { MF(o[3], PAF(3), VF(l2, h2), o[3]); } SBAR(); \
    if (resc) { asm volatile("s_waitcnt lgkmcnt(0)" ::: "memory"); \
      _Pragma("unroll") for (int d = 0; d < 4; ++d) _Pragma("unroll") for (int r = 0; r < 16; ++r) o[d][r] *= al_l[crow(r, hi)]; } \
  } while (0)
#define PVONLY(VOFF) do { _Pragma("unroll") for (int ks = 0; ks < 4; ++ks) _Pragma("unroll") for (int d0 = 0; d0 < 4; ++d0) { s16x4 l_, h_; VRD(VOFF, ks, d0, l_, h_); \
      const bf16x8 pa_ = ks == 0 ? PAF(0) : ks == 1 ? PAF(1) : ks == 2 ? PAF(2) : PAF(3); MF(o[d0], pa_, VF(l_, h_), o[d0]); } } while (0)

  DMAK(0, 0); DMAK(1, 1); DMAV(0, 0);
  BARW(0);
  if (ATT_STAGGER && comp == 1) __builtin_amdgcn_s_barrier();
  H1(pA0, pA1, pB0, pB1, 0, 0, false);
  BARW(0);
  DMAK(2, 2); DMAV(1, SHM_V); SBAR();
  H2(pA0, pA1, 0, false, true);
  BARW(4);
  int va = 0, vb = SHM_V, vc = 2 * SHM_V;
  for (int j = 1; j + 1 < NT; j += 2) {
    PRIO1(1); H1(pB0, pB1, pA0, pA1, vb, va, true); PRIO1(0);
    BARW(0);
    DMAK(j + 2, va >> 14); DMAV(j + 1, vc); SBAR();
    PRIO(1); H2(pB0, pB1, va, true, false); PRIO(0);
    BARW(4);
    PRIO1(1); H1(pA0, pA1, pB0, pB1, vc, vb, true); PRIO1(0);
    BARW(0);
    if (j + 3 < NT) DMAK(j + 3, vb >> 14);
    DMAV(j + 2, va); SBAR();
    PRIO(1); H2(pA0, pA1, vb, true, false); PRIO(0);
    BARW(4);
    { const int t = va; va = vc; vc = vb; vb = t; }
  }
  H1(pB0, pB1, pA0, pA1, vb, va, true);
  BARW(0);
  H2(pB0, pB1, va, true, false);
  BARW(0);
  { float sacc = 0.f; unsigned a0_ = 0, a1_ = 0;
    EX(pB1, 8); EX(pB1, 9); EX(pB1, 10); EX(pB1, 11); EX(pB1, 12); EX(pB1, 13); EX(pB1, 14); EX(pB1, 15);
    PKA(pB0, 0, a0_, a1_); PKB(pB0, 0, a0_, a1_, pw0); PKA(pB0, 8, a0_, a1_); PKB(pB0, 8, a0_, a1_, pw1); PKA(pB1, 0, a0_, a1_); PKB(pB1, 0, a0_, a1_, pw2); PKA(pB1, 8, a0_, a1_); PKB(pB1, 8, a0_, a1_, pw3);
    auto rr_ = __builtin_amdgcn_permlane32_swap(__float_as_uint(sacc), __float_as_uint(sacc), false, false); l_reg += __uint_as_float(rr_[0]) + __uint_as_float(rr_[1]); }
  SBAR(); PVONLY(vb);
  if (ATT_STAGGER && comp == 0) { asm volatile("s_waitcnt lgkmcnt(0)" ::: "memory"); __builtin_amdgcn_s_barrier(); }
  if (hi == 0) li_l[r32] = l_reg; asm volatile("s_waitcnt lgkmcnt(0)" ::: "memory");
  float rli[16];
#pragma unroll
  for (int r = 0; r < 16; ++r) rli[r] = __builtin_amdgcn_rcpf(li_l[crow(r, hi)]);
  __syncthreads();
  float* XO = (float*)lds + qw * (32 * 128);
  if (comp == 1) {
#pragma unroll
    for (int r = 0; r < 16; ++r)
#pragma unroll
      for (int d0 = 0; d0 < 4; ++d0) XO[crow(r, hi) * 128 + d0 * 32 + r32] = o[d0][r] * rli[r];
  }
  __syncthreads();
  if (comp == 0) {
    float ss[16];
#pragma unroll
    for (int r = 0; r < 16; ++r) { float s = 0.f;
#pragma unroll
      for (int d0 = 0; d0 < 4; ++d0) { const float v = o[d0][r] * rli[r] - lam * XO[crow(r, hi) * 128 + d0 * 32 + r32]; o[d0][r] = v; s += v * v; }
      ss[r] = s; }
#pragma unroll
    for (int r = 0; r < 16; ++r) { float s = ss[r]; s += swz_xor<1>(s); s += swz_xor<2>(s); s += swz_xor<4>(s); s += swz_xor<8>(s); s += swz_xor<16>(s);
      ss[r] = osc / sqrtf(s * (1.0f / 128.0f) + EPS); }
    float gam[4];
#pragma unroll
    for (int d0 = 0; d0 < 4; ++d0) gam[d0] = sg[d0 * 32 + r32];
    asm volatile("s_waitcnt lgkmcnt(0)" ::: "memory");
    bf16_t* stg = (bf16_t*)XO;
#pragma unroll
    for (int r = 0; r < 16; ++r)
#pragma unroll
      for (int d0 = 0; d0 < 4; ++d0) stg[crow(r, hi) * 128 + d0 * 32 + r32] = (bf16_t)(cvt2bf(o[d0][r] * ss[r] * gam[d0], 0.f) & 0xffffu);
    asm volatile("s_waitcnt lgkmcnt(0)" ::: "memory");
#pragma unroll
    for (int i = 0; i < 8; ++i) { const int row = i * 4 + (lane >> 4), ch = lane & 15; const u32x4 v = *(const u32x4*)(stg + row * 128 + ch * 8);
      if constexpr (VAR & 16) { asm volatile("" :: "v"(v.x), "v"(v.y), "v"(v.z), "v"(v.w)); } else *(u32x4*)(Ob + (long)(qw * QBLK + row) * LDO + ch * 8) = v; }
  }
  __syncthreads();
#undef GLDS
#undef DMAK
#undef DMAV
#undef VMW
#undef PRIO
#undef PRIO1
#undef BARW
#undef KF
#undef PKA
#undef PKB
#undef H1
#undef VRD
#undef PAF
#undef MX3
#undef EX
#undef PIN2
#undef H2
#undef PVONLY
}
#undef SBAR
#undef KSWZ
#undef MF
#undef VF
}
typedef GAS unsigned gu32;
#define RLX_AGENT __ATOMIC_RELAXED, __HIP_MEMORY_SCOPE_AGENT
constexpr int PT_OFF = LDSCTL_OFF + 1024;
__device__ __forceinline__ unsigned long long ldptr(volatile LAS unsigned long long* PT, int i) {
    const unsigned long long v = PT[i];
    const unsigned lo = __builtin_amdgcn_readfirstlane((unsigned)v), hi = __builtin_amdgcn_readfirstlane((unsigned)(v >> 32));
    return ((unsigned long long)hi << 32) | lo;
}
#define XB_TMO      128
#define XB_XCNT(j)  (256  + 64 * (j))
#define XB_XSUB(j)  (1280 + 64 * (j))
#define XB_XGEN(j)  (2304 + 64 * (j))
#define XB_TOP      3328
#define XB_TOPGEN   3392
#define XCD_BAR_WORDS 3456
#define XB_SPIN_CAP (1u << 18)

__device__ __forceinline__ unsigned xb_ld(unsigned* p)              { return __hip_atomic_load(p, __ATOMIC_RELAXED, __HIP_MEMORY_SCOPE_AGENT); }
__device__ __forceinline__ unsigned xb_add(unsigned* p, unsigned v) { return __hip_atomic_fetch_add(p, v, __ATOMIC_RELAXED, __HIP_MEMORY_SCOPE_AGENT); }
__device__ __forceinline__ unsigned xb_xcc_id() { return (unsigned)__builtin_amdgcn_s_getreg((3 << 11) | 20) & 0xFu; }
#define XB_SPIN(cond, bar) do { unsigned _sp = 0; while (cond) { __builtin_amdgcn_s_sleep(1); \
    if ((++_sp & 255u) == 0u) { if (xb_ld(&(bar)[XB_TMO])) break; if (_sp > XB_SPIN_CAP) { atomicAdd(&(bar)[XB_TMO], 1u); break; } } } } while (0)

struct XcdBarrier {
    unsigned* bar; unsigned x;
    volatile LAS unsigned* st;
};

__device__ __forceinline__ XcdBarrier xcd_barrier_post(unsigned* bar, volatile LAS unsigned* st) {
    XcdBarrier b; b.bar = bar; b.x = xb_xcc_id(); b.st = st;
    if (threadIdx.x == 0) (void)xb_add(&bar[XB_XCNT(b.x)], 1u);
    return b;
}
__device__ __forceinline__ void xcd_barrier_complete(unsigned* bar, unsigned x, unsigned& nloc, unsigned& nx) {
    const unsigned G = gridDim.x * gridDim.y * gridDim.z;
    unsigned sum, cnt, mine, sp = 0u;
    for (;;) {
        sum = 0u; cnt = 0u; mine = 0u;
#pragma unroll
        for (unsigned j = 0; j < 16; ++j) { const unsigned c = xb_ld(&bar[XB_XCNT(j)]); sum += c; cnt += (c > 0u) ? 1u : 0u; mine = (j == x) ? c : mine; }
        if (sum == G) break;
        __builtin_amdgcn_s_sleep(1);
        if ((++sp & 255u) == 0u) { if (xb_ld(&bar[XB_TMO])) break; if (sp > XB_SPIN_CAP) { atomicAdd(&bar[XB_TMO], 1u); break; } }
    }
    nloc = mine > 0u ? mine : 1u; nx = cnt > 0u ? cnt : 1u;
}

__device__ __forceinline__ void xcd_barrier(const XcdBarrier& b) {
    asm volatile("s_waitcnt vmcnt(0)" ::: "memory");
    __syncthreads();
    if (threadIdx.x == 0) {
        unsigned* bar = b.bar;
        __builtin_amdgcn_s_waitcnt(0);
        unsigned nloc = b.st[0], nx = b.st[1];
        if (nloc == 0u) { xcd_barrier_complete(bar, b.x, nloc, nx); b.st[0] = nloc; b.st[1] = nx; }
        const unsigned old = xb_add(&bar[XB_XSUB(b.x)], 1u);
        const unsigned gen = old / nloc;
        if (old + 1u == (gen + 1u) * nloc) {
            __builtin_amdgcn_fence(__ATOMIC_RELEASE, "agent");
            asm volatile("s_waitcnt vmcnt(0)" ::: "memory");
            const unsigned og = xb_add(&bar[XB_TOP], 1u);
            const unsigned tg = og / nx;
            if (og + 1u == (tg + 1u) * nx) xb_add(&bar[XB_TOPGEN], 1u);
            else XB_SPIN(xb_ld(&bar[XB_TOPGEN]) == tg, bar);
            __builtin_amdgcn_fence(__ATOMIC_ACQUIRE, "agent");
            xb_add(&bar[XB_XGEN(b.x)], 1u);
            asm volatile("s_waitcnt vmcnt(0)" ::: "memory");
        } else {
            XB_SPIN(xb_ld(&bar[XB_XGEN(b.x)]) == gen, bar);
            __builtin_amdgcn_fence(__ATOMIC_ACQUIRE, "agent");
            asm volatile("s_waitcnt vmcnt(0)" ::: "memory");
        }
    }
    __syncthreads();
}
__device__ __forceinline__ float wave_sum(float v) {
    v += swz_xor<1>(v); v += swz_xor<2>(v); v += swz_xor<4>(v); v += swz_xor<8>(v); v += swz_xor<16>(v);
    auto rr = __builtin_amdgcn_permlane32_swap(__float_as_uint(v), __float_as_uint(v), false, false);
    return __uint_as_float(rr[0]) + __uint_as_float(rr[1]);
}
__device__ __forceinline__ unsigned pk2(float lo, float hi) { return cvt2bf(lo, hi); }

template <int MAP  >
__device__ __forceinline__ void transpose_item(const float* W, int Nsrc, int coff, bf16_t* WT, int ldw, int koff, int nblk, LAS float* scr, int item, int lane) {
    const int kb = item / nblk, nb = item % nblk, k0 = 64 * kb, n0 = 32 * nb;
    const int nd = n0 + (lane & 31); const int scol = MAP ? in_map(nd) : nd + coff;
    float wv[32];
#pragma unroll
    for (int i = 0; i < 32; ++i) wv[i] = W[(size_t)(k0 + 2 * i + (lane >> 5)) * Nsrc + scol];
#pragma unroll
    for (int i = 0; i < 32; ++i) scr[(2 * i + (lane >> 5)) * 33 + (lane & 31)] = wv[i];
    asm volatile("s_waitcnt lgkmcnt(0)" ::: "memory");
    const int c = lane & 7;
#pragma unroll
    for (int j = 0; j < 4; ++j) { const int n = (lane >> 3) + 8 * j; const LAS float* s = scr + (8 * c) * 33 + n;
        u32x4 o; o.x = pk2(s[0 * 33], s[1 * 33]); o.y = pk2(s[2 * 33], s[3 * 33]); o.z = pk2(s[4 * 33], s[5 * 33]); o.w = pk2(s[6 * 33], s[7 * 33]);
        *(u32x4*)(WT + (size_t)(n0 + n) * ldw + koff + k0 + 8 * c) = o; }
    asm volatile("s_waitcnt lgkmcnt(0)" ::: "memory");
}
struct WSrc { const float *w_in, *wo_f, *wo_a, *wo_c, *wo_p, *w_out, *w_up, *w_down; };
constexpr int IT_A = 16 * 208;
constexpr int IT_B0 = 4 * 32, IT_B1 = 8 * 32, IT_B2 = 4 * 32, IT_B3 = 4 * 32, IT_B4 = 16 * 32, IT_B5 = 16 * 88, IT_B6 = 16 * 88, IT_B7 = 44 * 32;
constexpr int ITU_CAT = IT_A, ITU_DN = ITU_CAT + IT_B0 + IT_B1 + IT_B2 + IT_B3 + IT_B4, ITU_UPG = ITU_DN + IT_B7, ITU_UPV = ITU_UPG + IT_B5, ITU_END = ITU_UPV + IT_B6;
struct WDst { bf16_t *wa, *wcat, *wout, *wdn, *wupg, *wupv; };
template <int MASK  >
__device__ __forceinline__ void convert_items(const WSrc& S, const WDst& D, LAS float* scr, int lo, int hi, int wi, int nw, int lane) {
    for (int it = lo + wi; it < hi; it += nw) { int r = it;
        if (MASK & 1) { if (r < IT_A) { transpose_item<1>(S.w_in, NIN, 0, D.wa, 1024, 0, 208, scr, r, lane); continue; } } r -= IT_A;
        if (MASK & 2) {
            if (r < IT_B0) { transpose_item<0>(S.wo_f, 1024, 0, D.wcat, KCAT, 0, 32, scr, r, lane); continue; } r -= IT_B0;
            if (r < IT_B1) { transpose_item<0>(S.wo_a, 1024, 0, D.wcat, KCAT, 256, 32, scr, r, lane); continue; } r -= IT_B1;
            if (r < IT_B2) { transpose_item<0>(S.wo_c, 1024, 0, D.wcat, KCAT, 768, 32, scr, r, lane); continue; } r -= IT_B2;
            if (r < IT_B3) { transpose_item<0>(S.wo_p, 1024, 0, D.wcat, KCAT, 1024, 32, scr, r, lane); continue; } r -= IT_B3;
            if (r < IT_B4) { transpose_item<0>(S.w_out, 1024, 0, D.wout, 1024, 0, 32, scr, r, lane); continue; } r -= IT_B4;
        } else r -= IT_B0 + IT_B1 + IT_B2 + IT_B3 + IT_B4;
        if (MASK & 4) { if (r < IT_B7) { transpose_item<0>(S.w_down, 1024, 0, D.wdn, DFF, 0, 32, scr, r, lane); continue; } } r -= IT_B7;
        if (MASK & 8) { if (r < IT_B5) { transpose_item<0>(S.w_up, 2 * DFF, DFF, D.wupg, 1024, 0, 88, scr, r, lane); continue; } } r -= IT_B5;
        if (MASK & 16) { if (r < IT_B6) transpose_item<0>(S.w_up, 2 * DFF, 0, D.wupv, 1024, 0, 88, scr, r, lane); }
    }
}

__device__ __forceinline__ void mod_phase(const float* c, const float* c_ctx, const float* ada_w, const float* ada_b, float* MOD, LAS unsigned char* lds, int vcu, int G, int tid, int wave, int lane) {
    LAS float* sil = (LAS float*)lds;
    LAS float* red = (LAS float*)(lds + 12288);
    for (int i = tid; i < 3072; i += 512) { const float v = i < 2048 ? c[i] : c_ctx[i - 2048]; sil[i] = v * sigm(v); }
    __syncthreads();
    for (int item = vcu; item < 192; item += G) {
        const int l = item / 96, n = (item % 96) * 64 + lane;
        const float* W = ada_w + (size_t)l * 1024 * 6144 + n;
        float a0 = 0.f, a1 = 0.f, a2 = 0.f;
        for (int k = wave * 128; k < wave * 128 + 128; k += 64) { float w[64];
#pragma unroll
            for (int i = 0; i < 64; ++i) w[i] = W[(size_t)(k + i) * 6144];
#pragma unroll
            for (int i = 0; i < 64; ++i) { a0 += sil[k + i] * w[i]; a1 += sil[1024 + k + i] * w[i]; a2 += sil[2048 + k + i] * w[i]; } }
        red[(wave * 3 + 0) * 64 + lane] = a0; red[(wave * 3 + 1) * 64 + lane] = a1; red[(wave * 3 + 2) * 64 + lane] = a2;
        __syncthreads();
        if (wave < 3) { float s = ada_b[l * 6144 + n];
#pragma unroll
            for (int w = 0; w < 8; ++w) s += red[(w * 3 + wave) * 64 + lane];
            MOD[(size_t)(l * 3 + wave) * 6144 + n] = s; }
        __syncthreads();
    }
}
__device__ __forceinline__ void tables_phase(float* ROPE, f32x2* TW, int gt, int NGT) {
    for (int i = gt; i < 192 * 16; i += NGT) { const int pos = i >> 4, f = i & 15; const float inv = powf(10000.0f, -(float)f / 16.0f); const float ang = (float)(pos < 128 ? pos : pos - 128) * inv;
        float s, c; sincosf(ang, &s, &c); ROPE[pos * 32 + f] = c; ROPE[pos * 32 + 16 + f] = s; }
    for (int i = gt; i < 8192; i += NGT) { float s, c; sincospif((float)i * (1.0f / 4096.0f), &s, &c); TW[i] = (f32x2){c, -s}; }
}

template <bool LATBF>
__device__ __forceinline__ void norm_phase(const void* src_lat_, const float* src_ctx, int nrows, const float* gamma, const float* mod, int shoff, int scoff, bf16_t* HX, int gw, int NGW, int lane,
                                           const float* slab = nullptr, int nsl = 0, const float* cgate = nullptr, float* ctx_out = nullptr) {
    for (int m0 = gw; m0 < nrows; m0 += 4 * NGW) {
        f32x4 v[4][4]; float s[4];
#pragma unroll
        for (int u = 0; u < 4; ++u) { const int m = m0 + u * NGW; s[u] = 0.f;
            if (m < nrows) {
                if (LATBF && m < ML) { const u32x2* xb = (const u32x2*)((const bf16_t*)src_lat_ + (size_t)m * DM);
#pragma unroll
                    for (int j = 0; j < 4; ++j) { const u32x2 w = xb[lane + 64 * j]; v[u][j] = (f32x4){__uint_as_float(w.x << 16), __uint_as_float(w.x & 0xffff0000u), __uint_as_float(w.y << 16), __uint_as_float(w.y & 0xffff0000u)}; } }
                else { const float* xr = m < ML ? (const float*)src_lat_ + (size_t)m * DM : src_ctx + (size_t)(m - ML) * DM;
#pragma unroll
                    for (int j = 0; j < 4; ++j) v[u][j] = ((const f32x4*)xr)[lane + 64 * j]; }
                if (slab && m >= ML) {
#pragma unroll
                    for (int j = 0; j < 4; ++j) { f32x4 a = {0.f, 0.f, 0.f, 0.f};
                        for (int sl = 0; sl < nsl; ++sl) a += ((const f32x4*)(slab + (size_t)sl * 512 * 1024 + (size_t)(m - ML) * DM))[lane + 64 * j];
                        v[u][j] += ((const f32x4*)cgate)[lane + 64 * j] * a; ((f32x4*)(ctx_out + (size_t)(m - ML) * DM))[lane + 64 * j] = v[u][j]; } } } }
#pragma unroll
        for (int u = 0; u < 4; ++u) { const int m = m0 + u * NGW; if (m < nrows) {
#pragma unroll
            for (int j = 0; j < 4; ++j) s[u] += (v[u][j].x * v[u][j].x + v[u][j].y * v[u][j].y) + (v[u][j].z * v[u][j].z + v[u][j].w * v[u][j].w);
            const float rstd = 1.0f / sqrtf(wave_sum(s[u]) * (1.0f / DM) + EPS);
            const float* md = mod + (m < SEQ ? 0 : m < ML ? 1 : 2) * 6144;
#pragma unroll
            for (int j = 0; j < 4; ++j) { const int col = 4 * lane + 256 * j;
                const f32x4 g = *(const f32x4*)(gamma + col), sc = *(const f32x4*)(md + scoff + col), sh = *(const f32x4*)(md + shoff + col);
                const f32x4 o = v[u][j] * rstd * g * (sc + 1.0f) + sh;
                u32x2 w; w.x = pk2(o.x, o.y); w.y = pk2(o.z, o.w); *(u32x2*)(HX + (size_t)m * DM + col) = w; } } }
    }
}
__device__ __forceinline__ void final_norm_phase(const bf16_t* xb, float* out, const float* gamma, int gw, int NGW, int lane) {
    for (int m0 = gw; m0 < ML; m0 += 4 * NGW) {
        f32x4 v[4][4];
#pragma unroll
        for (int u = 0; u < 4; ++u) { const int m = m0 + u * NGW; if (m < ML) { const u32x2* xr = (const u32x2*)(xb + (size_t)m * DM);
#pragma unroll
            for (int j = 0; j < 4; ++j) { const u32x2 w = xr[lane + 64 * j]; v[u][j] = (f32x4){__uint_as_float(w.x << 16), __uint_as_float(w.x & 0xffff0000u), __uint_as_float(w.y << 16), __uint_as_float(w.y & 0xffff0000u)}; } } }
#pragma unroll
        for (int u = 0; u < 4; ++u) { const int m = m0 + u * NGW; if (m < ML) { float s = 0.f;
#pragma unroll
            for (int j = 0; j < 4; ++j) s += (v[u][j].x * v[u][j].x + v[u][j].y * v[u][j].y) + (v[u][j].z * v[u][j].z + v[u][j].w * v[u][j].w);
            const float rstd = 1.0f / sqrtf(wave_sum(s) * (1.0f / DM) + EPS);
#pragma unroll
            for (int j = 0; j < 4; ++j) { const f32x4 g = *(const f32x4*)(gamma + 4 * lane + 256 * j); ((f32x4*)(out + (size_t)m * DM))[lane + 64 * j] = v[u][j] * rstd * g; } } }
    }
}

#define SWZ(row, colB) ((row) * 256 + ((colB) ^ (((row) & 7) << 4)))
__device__ __forceinline__ int crow_(int r, int hi) { return (r & 3) + 8 * (r >> 2) + 4 * hi; }
__device__ __forceinline__ bf16x8 pack_bf8(const float* v) { u32x4 w; w.x = pk2(v[0], v[1]); w.y = pk2(v[2], v[3]); w.z = pk2(v[4], v[5]); w.w = pk2(v[6], v[7]); return __builtin_bit_cast(bf16x8, w); }
__device__ __forceinline__ void fft_tables_phase(u32x4* FT, int gt, int NGT) {
    for (int i = gt; i < 4096; i += NGT) { const int ks = i >> 9, t = i & 511, wave = t >> 6, lane = t & 63, tr = wave >> 1, tc = wave & 1, r32 = lane & 31, hi = lane >> 5;
        float cv[8], sv[8], av[8], bv[8];
#pragma unroll
        for (int j = 0; j < 8; ++j) { const int idx = ((32 * tr + r32) * (16 * ks + 8 * hi + j)) & 127; float s, c; sincospif((float)idx * (1.0f / 64.0f), &s, &c); cv[j] = c; sv[j] = -s; }
#pragma unroll
        for (int j = 0; j < 8; ++j) { const int R = 32 * tr + r32, k = 16 * ks + 8 * hi + j, k2 = R & 63, ll = k & 63; float s, c; sincospif((float)((k2 * ll) & 63) * (1.0f / 32.0f), &s, &c);
            av[j] = (R < 64) ? ((k < 64) ? c : s) : ((k < 64) ? -s : c);
            const int m = 32 * tc + r32; float s2, c2; sincospif((float)((m * ll) & 63) * (1.0f / 32.0f), &s2, &c2); bv[j] = (k < 64) ? c2 : s2; }
        FT[i] = __builtin_bit_cast(u32x4, pack_bf8(cv)); FT[4096 + i] = __builtin_bit_cast(u32x4, pack_bf8(sv)); FT[8192 + i] = __builtin_bit_cast(u32x4, pack_bf8(av)); FT[12288 + i] = __builtin_bit_cast(u32x4, pack_bf8(bv)); }
}
__device__ __forceinline__ void fft1_phase(const bf16_t* UF, const f32x2* TW, const u32x4* FT, unsigned* FA, LAS unsigned char* lds, int vcu, int G, int tid, int wave, int lane) {
    const int tr = wave >> 1, tc = wave & 1, r32 = lane & 31, hi = lane >> 5;
    bf16x8 aRe[8], aIm[8];
#pragma unroll
    for (int ks = 0; ks < 8; ++ks) { aRe[ks] = __builtin_bit_cast(bf16x8, FT[ks * 512 + tid]); aIm[ks] = __builtin_bit_cast(bf16x8, FT[4096 + ks * 512 + tid]); }
    for (int item = vcu; item < 512; item += G) {
        const int b = item >> 8, g = (item >> 6) & 3, l2 = item & 63;
#pragma unroll
        for (int i = 0; i < 2; ++i) { const int q = tid + 512 * i, l1 = q >> 3, c8 = (q & 7) * 8;
            const u32x4 v = *(const u32x4*)(UF + (size_t)(b * SEQ + 64 * l1 + l2) * 256 + g * 64 + c8);
#pragma unroll
            for (int e = 0; e < 8; ++e) { const unsigned w = v[e >> 1]; *(LAS bf16_t*)(lds + SWZ(c8 + e, l1 * 2)) = (bf16_t)((e & 1) ? (w >> 16) : (w & 0xffffu)); } }
        __syncthreads();
        f32x16 re = {}, im = {};
#pragma unroll
        for (int ks = 0; ks < 8; ++ks) { const bf16x8 bx = *(const LAS bf16x8*)(lds + SWZ(32 * tc + r32, (16 * ks + 8 * hi) * 2));
            re = __builtin_amdgcn_mfma_f32_32x32x16_bf16(aRe[ks], bx, re, 0, 0, 0); im = __builtin_amdgcn_mfma_f32_32x32x16_bf16(aIm[ks], bx, im, 0, 0, 0); }
        unsigned* dst = FA + ((size_t)((b * 4 + g) * 64 + l2) * 128) * 64 + 32 * tc + r32;
#pragma unroll
        for (int r = 0; r < 16; ++r) { const int k1 = 32 * tr + crow_(r, hi); const f32x2 t = TW[k1 * l2];
            dst[(size_t)k1 * 64] = pk2(re[r] * t.x - im[r] * t.y, re[r] * t.y + im[r] * t.x); }
        __syncthreads();
    }
}
__device__ __forceinline__ void fft2_phase(const unsigned* FA, const u32x4* FT, bf16_t* ACAT, LAS unsigned char* lds, int vcu, int G, int tid, int wave, int lane) {
    const int tr = wave >> 1, tc = wave & 1, r32 = lane & 31, hi = lane >> 5;
    bf16x8 a2[8], b3[8];
#pragma unroll
    for (int ks = 0; ks < 8; ++ks) { a2[ks] = __builtin_bit_cast(bf16x8, FT[8192 + ks * 512 + tid]); b3[ks] = __builtin_bit_cast(bf16x8, FT[12288 + ks * 512 + tid]); }
    LAS unsigned char* Bt = lds;
    LAS unsigned char* Zt = lds + 16384;
    for (int item = vcu; item < 1024; item += G) {
        const int b = item >> 9, g = (item >> 7) & 3, k1 = item & 127;
#pragma unroll
        for (int i = 0; i < 2; ++i) { const int q = tid + 512 * i, l2 = q >> 4, c4 = (q & 15) * 4;
            const u32x4 v = *(const u32x4*)(FA + ((size_t)((b * 4 + g) * 64 + l2) * 128 + k1) * 64 + c4);
#pragma unroll
            for (int e = 0; e < 4; ++e) { *(LAS bf16_t*)(Bt + SWZ(c4 + e, l2 * 2)) = (bf16_t)(v[e] & 0xffffu); *(LAS bf16_t*)(Bt + SWZ(c4 + e, (64 + l2) * 2)) = (bf16_t)(v[e] >> 16); } }
        __syncthreads();
        f32x16 z = {};
#pragma unroll
        for (int ks = 0; ks < 8; ++ks) { const bf16x8 bx = *(const LAS bf16x8*)(Bt + SWZ(32 * tc + r32, (16 * ks + 8 * hi) * 2)); z = __builtin_amdgcn_mfma_f32_32x32x16_bf16(a2[ks], bx, z, 0, 0, 0); }
#pragma unroll
        for (int r = 0; r < 16; ++r) { const int R = 32 * tr + crow_(r, hi); *(LAS bf16_t*)(Zt + SWZ(R & 63, ((R >> 6) * 64 + 32 * tc + r32) * 2)) = (bf16_t)(pk2(z[r], 0.f) & 0xffffu); }
        __syncthreads();
        if (wave < 4) { f32x16 y = {};
#pragma unroll
            for (int ks = 0; ks < 8; ++ks) { const bf16x8 ax = *(const LAS bf16x8*)(Zt + SWZ(32 * tr + r32, (16 * ks + 8 * hi) * 2)); y = __builtin_amdgcn_mfma_f32_32x32x16_bf16(ax, b3[ks], y, 0, 0, 0); }
#pragma unroll
            for (int r = 0; r < 16; ++r) { const int k2 = 32 * tr + crow_(r, hi); ACAT[(size_t)(b * SEQ + k1 + 128 * k2) * KCAT + g * 64 + 32 * tc + r32] = (bf16_t)(pk2(y[r] * 0.001381067932f, 0.f) & 0xffffu); } }
        __syncthreads();
    }
}
__device__ __forceinline__ void ctxdft_item(int item, const bf16_t* UF, bf16_t* ACAT, LAS unsigned char* lds, int tid, int wave, int lane) {
    const int b = item >> 4, g = (item >> 2) & 3, kc = item & 3;
    const int tr = wave >> 1, tc = wave & 1, r32 = lane & 31, hi = lane >> 5;
    LAS unsigned char* Xt = lds;
    LAS unsigned char* Zt = lds + 32768;
#pragma unroll
    for (int i = 0; i < 4; ++i) { const int q = tid + 512 * i, l = q >> 3, c8 = (q & 7) * 8;
        const u32x4 v = *(const u32x4*)(UF + (size_t)(ML + b * CTXL + l) * 256 + g * 64 + c8);
#pragma unroll
        for (int e = 0; e < 8; ++e) { const unsigned w = v[e >> 1]; const int row = c8 + e; *(LAS bf16_t*)(Xt + row * 512 + ((((l >> 3) ^ (row & 7)) << 4) | ((l & 7) * 2))) = (bf16_t)((e & 1) ? (w >> 16) : (w & 0xffffu)); } }
    __syncthreads();
    f32x16 z = {};
    const int R = 32 * tr + r32, kk = 64 * kc + (R & 63);
#pragma unroll 4
    for (int ks = 0; ks < 16; ++ks) { float av[8];
#pragma unroll
        for (int j = 0; j < 8; ++j) { const int l = 16 * ks + 8 * hi + j; float s, c; sincospif((float)((kk * l) & 255) * (1.0f / 128.0f), &s, &c); av[j] = (R < 64) ? c : -s; }
        const int row = 32 * tc + r32, ch = (16 * ks + 8 * hi) >> 3;
        const bf16x8 bx = *(const LAS bf16x8*)(Xt + row * 512 + ((ch ^ (row & 7)) << 4));
        z = __builtin_amdgcn_mfma_f32_32x32x16_bf16(pack_bf8(av), bx, z, 0, 0, 0); }
#pragma unroll
    for (int r = 0; r < 16; ++r) { const int Rr = 32 * tr + crow_(r, hi); *(LAS bf16_t*)(Zt + SWZ(Rr & 63, ((Rr >> 6) * 64 + 32 * tc + r32) * 2)) = (bf16_t)(pk2(z[r], 0.f) & 0xffffu); }
    __syncthreads();
    if (wave < 4) { f32x16 y = {};
#pragma unroll
        for (int ks = 0; ks < 8; ++ks) { float bv[8];
#pragma unroll
            for (int j = 0; j < 8; ++j) { const int k = 16 * ks + 8 * hi + j, m = 32 * tc + r32; float s2, c2; sincospif((float)((m * (k & 63)) & 63) * (1.0f / 32.0f), &s2, &c2); bv[j] = (k < 64) ? c2 : s2; }
            const bf16x8 ax = *(const LAS bf16x8*)(Zt + SWZ(32 * tr + r32, (16 * ks + 8 * hi) * 2)); y = __builtin_amdgcn_mfma_f32_32x32x16_bf16(ax, pack_bf8(bv), y, 0, 0, 0); }
#pragma unroll
        for (int r = 0; r < 16; ++r) { const int k = 64 * kc + 32 * tr + crow_(r, hi); ACAT[(size_t)(ML + b * CTXL + k) * KCAT + g * 64 + 32 * tc + r32] = (bf16_t)(pk2(y[r] * (1.0f / 128.0f), 0.f) & 0xffffu); } }
    __syncthreads();
}

__device__ __forceinline__ void conv_item(int item, const bf16_t* ZG, const float* cw  , const float* cb, const float* lng, const float* lnb, bf16_t* ACAT, LAS unsigned char* lds, int tid, int wave, int lane) {
    const int row0 = item * 64; const bool lat = row0 < ML; const int s0 = lat ? (row0 & ~(SEQ - 1)) : (ML + ((row0 - ML) & ~(CTXL - 1))), s1 = s0 + (lat ? SEQ : CTXL);
    LAS float* zt = (LAS float*)lds;
#pragma unroll
    for (int i = 0; i < 6; ++i) { const int q = tid + 512 * i; if (q < 94 * 32) { const int rr = q >> 5, c8 = (q & 31) * 8, gr = row0 - 15 + rr;
        u32x4 v = {0u, 0u, 0u, 0u}; if (gr >= s0 && gr < s1) v = *(const u32x4*)(ZG + (size_t)gr * 256 + c8);
        *(LAS f32x4*)(zt + rr * 256 + c8) = (f32x4){bf2f(v.x & 0xffffu), __uint_as_float(v.x & 0xffff0000u), bf2f(v.y & 0xffffu), __uint_as_float(v.y & 0xffff0000u)};
        *(LAS f32x4*)(zt + rr * 256 + c8 + 4) = (f32x4){bf2f(v.z & 0xffffu), __uint_as_float(v.z & 0xffff0000u), bf2f(v.w & 0xffffu), __uint_as_float(v.w & 0xffff0000u)}; } }
    const int c = tid & 255, half = tid >> 8;
    float w[31];
#pragma unroll
    for (int t = 0; t < 31; ++t) w[t] = cw[t * 256 + c];
    float acc[32]; const float bias = cb[c];
    __syncthreads();
#pragma unroll
    for (int r0 = 0; r0 < 32; r0 += 4) { float v[34];
#pragma unroll
        for (int i = 0; i < 34; ++i) v[i] = zt[(half * 32 + r0 + i) * 256 + c];
        float a0 = bias, a1 = bias, a2 = bias, a3 = bias;
#pragma unroll
        for (int t = 0; t < 31; ++t) { a0 += w[t] * v[t]; a1 += w[t] * v[t + 1]; a2 += w[t] * v[t + 2]; a3 += w[t] * v[t + 3]; }
        acc[r0] = a0; acc[r0 + 1] = a1; acc[r0 + 2] = a2; acc[r0 + 3] = a3; }
    __syncthreads();
#pragma unroll
    for (int r = 0; r < 32; ++r) zt[(half * 32 + r) * 256 + c] = acc[r];
    __syncthreads();
    const f32x4 gg = *(const f32x4*)(lng + 4 * lane), bb = *(const f32x4*)(lnb + 4 * lane);
#pragma unroll
    for (int i = 0; i < 8; ++i) { const int r = wave * 8 + i; const f32x4 v = *(const LAS f32x4*)(zt + r * 256 + 4 * lane);
        const float mu = wave_sum((v.x + v.y) + (v.z + v.w)) * (1.0f / 256.0f); const f32x4 d = v - mu;
        const float var = wave_sum((d.x * d.x + d.y * d.y) + (d.z * d.z + d.w * d.w)) * (1.0f / 256.0f); const float rs = 1.0f / sqrtf(var + EPS);
        f32x4 o = d * rs * gg + bb; o.x *= sigm(o.x); o.y *= sigm(o.y); o.z *= sigm(o.z); o.w *= sigm(o.w);
        u32x2 pw; pw.x = pk2(o.x, o.y); pw.y = pk2(o.z, o.w); *(u32x2*)(ACAT + (size_t)(row0 + r) * KCAT + 768 + 4 * lane) = pw; }
    __syncthreads();
}
__device__ __forceinline__ void pool_phase(const bf16_t* UP, const float* pw  , const float* psc, bf16_t* ACAT, int nitems, int first, LAS unsigned char* lds, int G, int tid, int wave, int lane) {
    const int g = wave >> 1, tc = wave & 1, r32 = lane & 31, hi = lane >> 5;
    bf16x8 bw[4];
#pragma unroll
    for (int ks = 0; ks < 4; ++ks) { float v[8];
#pragma unroll
        for (int j = 0; j < 8; ++j) v[j] = pw[g * 4096 + (16 * ks + 8 * hi + j) * 64 + 32 * tc + r32];
        bw[ks] = pack_bf8(v); }
    const float osc = psc[g * 64 + 32 * tc + r32];
    LAS float* ut = (LAS float*)lds;
    LAS unsigned char* dt = lds + 81920;
    for (int item = first; item < nitems; item += G) {
        const int row0 = item * 64; const bool lat = row0 < ML; const int s0 = lat ? (row0 & ~(SEQ - 1)) : (ML + ((row0 - ML) & ~(CTXL - 1))), L = lat ? SEQ : CTXL, s1 = s0 + L;
#pragma unroll
        for (int i = 0; i < 5; ++i) { const int q = tid + 512 * i, rr = q >> 5, c8 = (q & 31) * 8, gr = row0 - 8 + rr;
            u32x4 v = {0u, 0u, 0u, 0u}; if (gr >= s0 && gr < s1) v = *(const u32x4*)(UP + (size_t)gr * 256 + c8);
            *(LAS f32x4*)(ut + rr * 256 + c8) = (f32x4){bf2f(v.x & 0xffffu), __uint_as_float(v.x & 0xffff0000u), bf2f(v.y & 0xffffu), __uint_as_float(v.y & 0xffff0000u)};
            *(LAS f32x4*)(ut + rr * 256 + c8 + 4) = (f32x4){bf2f(v.z & 0xffffu), __uint_as_float(v.z & 0xffff0000u), bf2f(v.w & 0xffffu), __uint_as_float(v.w & 0xffff0000u)}; }
        __syncthreads();
#pragma unroll
        for (int i = 0; i < 4; ++i) { const int q = tid + 512 * i, lr = q >> 5, c8 = (q & 31) * 8, gg = c8 >> 6, hw = 1 << gg, tt = row0 + lr - s0;
            f32x4 sa = {0.f, 0.f, 0.f, 0.f}, sb = {0.f, 0.f, 0.f, 0.f};
            for (int o = -hw; o < hw; ++o) { sa += *(const LAS f32x4*)(ut + (lr + 8 + o) * 256 + c8); sb += *(const LAS f32x4*)(ut + (lr + 8 + o) * 256 + c8 + 4); }
            const int lo = tt - hw < 0 ? 0 : tt - hw, hh = tt + hw - 1 > L - 1 ? L - 1 : tt + hw - 1; const float inv = 1.0f / (float)(hh - lo + 1);
            const f32x4 ua = *(const LAS f32x4*)(ut + (lr + 8) * 256 + c8), ub = *(const LAS f32x4*)(ut + (lr + 8) * 256 + c8 + 4);
            const f32x4 da = sa * inv - ua, db = sb * inv - ub;
            u32x4 w; w.x = pk2(da.x, da.y); w.y = pk2(da.z, da.w); w.z = pk2(db.x, db.y); w.w = pk2(db.z, db.w);
            *(LAS u32x4*)(dt + lr * 512 + ((((c8 >> 3) ^ (lr & 7)) << 4))) = w; }
        __syncthreads();
#pragma unroll
        for (int rt = 0; rt < 2; ++rt) { f32x16 y = {};
#pragma unroll
            for (int ks = 0; ks < 4; ++ks) { const int row = 32 * rt + r32, ch = (g * 64 + 16 * ks + 8 * hi) >> 3;
                const bf16x8 ax = *(const LAS bf16x8*)(dt + row * 512 + ((ch ^ (row & 7)) << 4)); y = __builtin_amdgcn_mfma_f32_32x32x16_bf16(ax, bw[ks], y, 0, 0, 0); }
#pragma unroll
            for (int r = 0; r < 16; ++r) ACAT[(size_t)(row0 + 32 * rt + crow_(r, hi)) * KCAT + 1024 + g * 64 + 32 * tc + r32] = (bf16_t)(pk2(y[r] * osc, 0.f) & 0xffffu); }
        __syncthreads();
    }
}

__device__ __forceinline__ void ctx_gate_combine(const float* slab, const unsigned char* Gc  , bf16_t* Yc, int gw, int NGW, int lane) {
    for (int r = gw; r < MC; r += NGW) {
#pragma unroll
        for (int j = 0; j < 4; ++j) { const int col = 4 * lane + 256 * j; f32x4 y = {0.f, 0.f, 0.f, 0.f};
#pragma unroll
            for (int sl = 0; sl < 5; ++sl) { const int b = sl == 0 ? 0 : sl <= 2 ? 1 : sl - 1;
                const f32x4 p = *(const f32x4*)(slab + (size_t)sl * 512 * 1024 + (size_t)r * 1024 + col); const unsigned q = *(const unsigned*)(Gc + (size_t)r * 4096 + b * 1024 + col);
                y[0] += p[0] * (float)(q & 255u); y[1] += p[1] * (float)((q >> 8) & 255u); y[2] += p[2] * (float)((q >> 16) & 255u); y[3] += p[3] * (float)(q >> 24); }
            y = y * (1.0f / 255.0f);
            u32x2 w; w.x = pk2(y[0], y[1]); w.y = pk2(y[2], y[3]); *(u32x2*)(Yc + (size_t)r * 1024 + col) = w; }
    }
}
constexpr int NPHASE = 22;
struct Args { const float* in[30]; float* out; unsigned char* ws; int ph_lo, ph_hi, li, pad; };
__global__ void __launch_bounds__(512, 2) __attribute__((amdgpu_waves_per_eu(2, 2))) fwd_kernel(Args args) {
    extern __shared__ __attribute__((aligned(16))) unsigned char lds[];
    LAS unsigned char* L = (LAS unsigned char*)lds;
    volatile LAS unsigned* MISC = (volatile LAS unsigned*)(L + MISC_OFF);
    const int tid0 = threadIdx.x; const int wave0 = __builtin_amdgcn_readfirstlane(tid0 >> 6);
    const int G = gridDim.x, bx0 = blockIdx.x, vcu0 = (G % 8 == 0) ? (bx0 % 8) * (G / 8) + bx0 / 8 : bx0;
    const int NGW = G * 8;
    gu32* ctl = (gu32*)(args.ws + WS_CTL);
    for (int u = tid0; u < (LDS_BYTES - LDSCTL_OFF) / 4; u += 512) ((LAS unsigned*)(L + LDSCTL_OFF))[u] = 0u;
    __syncthreads();
    volatile LAS unsigned long long* PT = (volatile LAS unsigned long long*)(L + PT_OFF);
    if (tid0 < 32) PT[tid0] = ((const __attribute__((address_space(4))) unsigned long long*)__builtin_amdgcn_kernarg_segment_ptr())[tid0];
    __syncthreads();
#define FRESH() int tid, vcu = vcu0, bx = bx0; asm volatile("v_mbcnt_lo_u32_b32 %0, -1, 0\n\tv_mbcnt_hi_u32_b32 %0, -1, %0" : "=v"(tid)); tid += wave0 * 64; asm volatile("" : "+v"(tid), "+s"(vcu), "+s"(bx)); const int lane = tid & 63, wave = __builtin_amdgcn_readfirstlane(tid >> 6), gw = vcu * 8 + wave; (void)lane; (void)gw; (void)bx; \
    LAS float* scr = (LAS float*)(L + wave * 16384); (void)scr;
#define PTR(i) ((const float*)(const GAS float*)ldptr(PT, (i)))
#define OUTP ((float*)(GAS float*)ldptr(PT, 30))
#define WSP ((unsigned char*)(GAS unsigned char*)ldptr(PT, 31))
    XcdBarrier bar; bar.bar = (unsigned*)(ctl + CW_BAR) + args.li * XCD_BAR_WORDS; bar.x = 0; bar.st = nullptr;
    if (MK_N_LAUNCHES != NPHASE) bar = xcd_barrier_post((unsigned*)(ctl + CW_BAR) + args.li * XCD_BAR_WORDS, MISC + 8);
#ifndef TAILREP
#define TAILREP 1
#endif
#ifndef BARX2
#define BARX2 0
#endif
#define GRID_BAR() do { if (MK_N_LAUNCHES == NPHASE) { if (tid0 == 0) __hip_atomic_store(ctl + CW_TMO, 0xBADBA0u, RLX_AGENT); } else { xcd_barrier(bar); if (BARX2) xcd_barrier(bar); } } while (0)
    const int lo = args.ph_lo, hi = args.ph_hi;
#ifndef PHASE_MASK
#define PHASE_MASK 0xFFF
#endif
#ifndef ATTM
#define ATTM 3
#endif
#ifndef X1REP
#define X1REP 0
#endif
#ifndef X1M
#define X1M 31
#endif
#define PH_EN(kind) ((PHASE_MASK >> (kind)) & 1)
#ifndef REP_MASK
#define REP_MASK 0
#endif
#define NREP(kind) (((REP_MASK >> (kind)) & 1) ? 2 : 1)
#define IN(k) (lo <= (k) && (k) < hi)
#define BOTH(k) (IN(k) && IN((k) + 1))
#define WSRC(S, l) WSrc S; S.w_in = PTR(8) + (size_t)(l) * 1024 * NIN; S.wo_f = PTR(20) + (size_t)(l) * 256 * 1024; S.wo_a = PTR(21) + (size_t)(l) * 512 * 1024; \
    S.wo_c = PTR(22) + (size_t)(l) * 256 * 1024; S.wo_p = PTR(23) + (size_t)(l) * 256 * 1024; S.w_out = PTR(24) + (size_t)(l) * 1024 * 1024; \
    S.w_up = PTR(25) + (size_t)(l) * 1024 * 2 * DFF; S.w_down = PTR(28) + (size_t)(l) * DFF * 1024;
#define ws WSP
#define OUTHI ((unsigned char*)OUTP + 32 * MiB)
#define WA1 ((bf16_t*)OUTHI)
#define WUPG1 ((bf16_t*)(OUTHI + 13 * MiB))
#define WUPV1 ((bf16_t*)(OUTHI + 13 * MiB + (size_t)2816 * 1024 * 2))
#define WDST0 {(bf16_t*)(ws + WS_WA), (bf16_t*)(ws + WS_WCAT), (bf16_t*)(ws + WS_WOUT), (bf16_t*)(ws + WS_WDN), (bf16_t*)(ws + WS_WUPG), (bf16_t*)(ws + WS_WUPV)}
#define WDST1 {WA1, (bf16_t*)(ws + WS_WCAT), (bf16_t*)(ws + WS_WOUT), (bf16_t*)(ws + WS_WDN), WUPG1, WUPV1}
#define TAIL_CONVERT(MASK, nwg_, lo_, hi_) do { const int rem_ = (nwg_) % G; if (rem_ == 0 || bx >= rem_) { __syncthreads(); WSRC(S1, 1); const WDst D1 = WDST1; \
        for (int tr_ = 0; tr_ < TAILREP; ++tr_) convert_items<MASK>(S1, D1, scr, (lo_), (hi_), (rem_ ? bx - rem_ : bx) * 8 + wave, (rem_ ? G - rem_ : G) * 8, lane); } } while (0)
#define MOD ((float*)(WSP + WS_MOD))
#define ROPE ((float*)(WSP + WS_ROPE))
#define TW ((f32x2*)(WSP + WS_TW))
#define FT ((u32x4*)(WSP + WS_FT))
#define XC ((float*)(WSP + WS_XC))
#define HX ((bf16_t*)(WSP + WS_HX))
#define FA ((f32x2*)(WSP + WS_FA))
#define Qb ((bf16_t*)(WSP + WS_Q))
#define Kb ((bf16_t*)(WSP + WS_K))
#define Vb ((bf16_t*)(WSP + WS_V))
#define Yb ((bf16_t*)(WSP + WS_Y))
#define Gb (WSP + WS_G)
#define ACAT ((bf16_t*)(WSP + WS_ACAT))
#define UF ((bf16_t*)(WSP + WS_UF))
#define ZG ((bf16_t*)(WSP + WS_ZG))
#define UP ((bf16_t*)(WSP + WS_UP))
#define GT ((bf16_t*)(WSP + WS_GT))
#define Hb ((bf16_t*)(WSP + WS_H))

    for (int rep = 0; rep < NREP(0); ++rep) if (PH_EN(0) && IN(0)) { FRESH();
        mod_phase(PTR(1), PTR(3), PTR(6), PTR(7), MOD, L, vcu, G, tid, wave, lane);
        tables_phase(ROPE, TW, vcu * 512 + tid, G * 512); fft_tables_phase(FT, ((vcu + 128) % G) * 512 + tid, G * 512);
        for (int i = vcu * 512 + tid; i < MC * DM / 4; i += G * 512) ((f32x4*)XC)[i] = ((const f32x4*)PTR(2))[i];
        WSRC(S0, 0); { const WDst D0 = WDST0; convert_items<31>(S0, D0, scr, 0, ITU_END, gw, NGW, lane); }
        if (BOTH(0)) GRID_BAR();
    }
#pragma nounroll
    for (int l = 0; l < 2; ++l) {
        const int pb = 1 + 10 * l;
#define mod (MOD + l * 3 * 6144)
#define XBF ((bf16_t*)OUTP)
#define xc ((l == 0) ? PTR(2) : (const float*)XC)
        const int Mact = (l == 0) ? MT : ML;
        for (int rep = 0; rep < NREP(1); ++rep) if (PH_EN(1) && IN(pb)) { FRESH(); if (l == 0) norm_phase<false>(PTR(0), xc, MT, PTR(4) + l * DM, mod, 0, 1024, HX, gw, NGW, lane);
            else norm_phase<true>(XBF, xc, MT, PTR(4) + l * DM, mod, 0, 1024, HX, gw, NGW, lane, (const float*)Gb, 11, MOD + 2 * 6144 + 5120, XC);
            if (BOTH(pb)) GRID_BAR(); }
        for (int rep = 0; rep < NREP(2); ++rep) if (PH_EN(2) && IN(pb + 1)) { FRESH();
            pg8::Gemm g{HX, l == 0 ? (const bf16_t*)(ws + WS_WA) : (const bf16_t*)WA1, MT, NIN, 1024}; pg8::StaticOrder S; S.init(MT, NIN, G, bx);
            pg8::EpiIn E{UF, ZG, UP, Qb, Kb, Vb, Gb, ROPE};
            pg8::gemm_phase<pg8::EpiIn, pg8::StaticOrder, true, true>(L, g, S, E, tid);
            TAIL_CONVERT(7, (MT / 256) * (NIN / 256), l == 0 ? 0 : ITU_CAT, l == 0 ? IT_A : ITU_UPG);
            if (BOTH(pb + 1)) GRID_BAR();
        }
        for (int rep = 0; rep < NREP(3); ++rep) if (PH_EN(3) && IN(pb + 2)) { FRESH();
            for (int r1 = 0; r1 < ((X1REP & 1) ? 2 : 1); ++r1) if (X1M & 1) fft1_phase(UF, TW, FT, (unsigned*)FA, L, vcu, G, tid, wave, lane);
            for (int r1 = 0; r1 < ((X1REP & 2) ? 2 : 1); ++r1) if (X1M & 2) for (int it = vcu; it < Mact / 64; it += G) conv_item(it, ZG, PTR(14) + l * 31 * 256, PTR(15) + l * 256, PTR(16) + l * 256, PTR(17) + l * 256, ACAT, L, tid, wave, lane);
            for (int r1 = 0; r1 < ((X1REP & 4) ? 2 : 1); ++r1) if (X1M & 4) pool_phase(UP, PTR(18) + l * 4 * 4096, PTR(19) + l * 256, ACAT, Mact / 64, (vcu + 248) % G, L, G, tid, wave, lane);
            if ((X1M & 8) && l == 0) for (int it = (vcu + 224) % G; it < 32; it += G) ctxdft_item(it, UF, ACAT, L, tid, wave, lane);
            if (l == 0) {
                const float lam_init = 0.2f;
                const float d1 = wave_sum(PTR(9)[lane] * PTR(10)[lane]), d2 = wave_sum(PTR(11)[lane] * PTR(12)[lane]);
                const float lam = __builtin_bit_cast(float, __builtin_amdgcn_readfirstlane(__builtin_bit_cast(int, expf(d1) - expf(d2) + lam_init)));
                for (int v = (vcu + 200) % G; v < 16; v += G) { const int b = v >> 3, h = (v >> 1) & 3, row0 = ML + b * CTXL + (v & 1) * 128;
                    att2::attn_unit<0>(Qb + (size_t)row0 * 512 + h * 128, Kb + (size_t)b * KVL * 512 + h * 128, Vb + (size_t)b * KVL * 512 + h * 128, CTXL,
                                       ACAT + (size_t)row0 * KCAT + 256 + h * 128, lam, 1.0f - lam_init, PTR(13), (char*)lds, tid); }
            }
            if (BOTH(pb + 2)) GRID_BAR();
        }
        for (int rep = 0; rep < NREP(4); ++rep) if (PH_EN(4) && IN(pb + 3)) { FRESH();
            if (ATTM & 1) fft2_phase((const unsigned*)FA, FT, ACAT, L, vcu, G, tid, wave, lane);
            const float lam_init = (l == 0) ? 0.2f : 0.35550906759096926f;
            const float d1 = wave_sum(PTR(9)[l * 64 + lane] * PTR(10)[l * 64 + lane]), d2 = wave_sum(PTR(11)[l * 64 + lane] * PTR(12)[l * 64 + lane]);
            const float lam = __builtin_bit_cast(float, __builtin_amdgcn_readfirstlane(__builtin_bit_cast(int, expf(d1) - expf(d2) + lam_init)));
            const int nun = 512;
            if (ATTM & 2) for (int u = vcu; u < nun; u += G) {
                int b, h, row0, nkeys;
                if (u < 512) { const int x = (u & 255) >> 5, qb = (u & 31) + 32 * (u >> 8); b = x >> 2; h = x & 3; row0 = b * SEQ + qb * 128; nkeys = KVL; }
                else { const int v = u - 512; b = v >> 3; h = (v >> 1) & 3; row0 = ML + b * CTXL + (v & 1) * 128; nkeys = CTXL; }
#if ATT_V == 2
                att2::attn_unit<0>(Qb + (size_t)row0 * 512 + h * 128,
#else
                att::attn_unit<0>(Qb + (size_t)row0 * 512 + h * 128,
#endif
                               Kb + (size_t)b * KVL * 512 + h * 128, Vb + (size_t)b * KVL * 512 + h * 128, nkeys,
                               ACAT + (size_t)row0 * KCAT + 256 + h * 128, lam, 1.0f - lam_init, PTR(13) + l * 128, (char*)lds, tid);
            }
            if (l == 0) {
                pg8::Gemm gc{ACAT + (size_t)ML * KCAT, (const bf16_t*)(ws + WS_WCAT), MC, 1024, 256, KCAT}; pg8::BranchSliceOrder Sc{G, bx};
                pg8::EpiSlab Ec{(float*)UF};
                pg8::gemm_phase<pg8::EpiSlab, pg8::BranchSliceOrder, true, true>(L, gc, Sc, Ec, tid);
            }
#if defined(ATT_PROBE)
            int tid2 = tid, vcu2 = vcu; asm volatile("" : "+v"(tid2), "+s"(vcu2));
            for (int u = vcu2; u < 512; u += G) {
                const int x = (u & 255) >> 5, qb = (u & 31) + 32 * (u >> 8), b = x >> 2, h = x & 3, row0 = b * SEQ + qb * 128;
                att2::attn_unit<ATT_PROBE>(Qb + (size_t)row0 * 512 + h * 128, Kb + (size_t)b * KVL * 512 + h * 128, Vb + (size_t)b * KVL * 512 + h * 128, KVL,
                               Hb + (size_t)row0 * KCAT + 256 + h * 128, lam, 1.0f - lam_init, PTR(13) + l * 128, (char*)lds, tid2);
            }
#endif
            if (BOTH(pb + 3)) GRID_BAR();
        }
        for (int rep = 0; rep < NREP(5); ++rep) if (PH_EN(5) && IN(pb + 4)) { FRESH();
            if (l == 0) ctx_gate_combine((const float*)UF, Gb + (size_t)ML * 4096, Yb + (size_t)ML * 1024, gw, NGW, lane);
            pg8::Gemm g{ACAT, (const bf16_t*)(ws + WS_WCAT), ML, 1024, KCAT}; pg8::StaticOrder S; S.init(ML, 1024, G, bx);
            pg8::EpiBranch E{Gb, Yb};
            pg8::gemm_phase<pg8::EpiBranch, pg8::StaticOrder, true, true>(L, g, S, E, tid);
            if (BOTH(pb + 4)) GRID_BAR();
        }
        for (int rep = 0; rep < (l == 0 ? NREP(6) : 1); ++rep) if (PH_EN(6) && IN(pb + 5)) { FRESH();
            pg8::Gemm g{Yb, (const bf16_t*)(ws + WS_WOUT), ML, 1024, 1024}; pg8::StaticOrder S; S.init(ML, 1024, G, bx);
            pg8::EpiRes E{l == 0 ? PTR(0) : (const float*)nullptr, XBF, xc, XBF, XC, mod, 2048};
            pg8::gemm_phase<pg8::EpiRes, pg8::StaticOrder, true, true>(L, g, S, E, tid);
            if (l == 0) {
                pg8::Gemm gc{Yb + (size_t)ML * 1024, (const bf16_t*)(ws + WS_WOUT), MC, 1024, 256, 1024}; pg8::SplitKOrder Sc{4, 256, G, bx};
                pg8::EpiSlab Ec{(float*)Gb};
                pg8::gemm_phase<pg8::EpiSlab, pg8::SplitKOrder, true, true>(L, gc, Sc, Ec, tid);
            }
            if (BOTH(pb + 5)) GRID_BAR();
        }
        for (int rep = 0; rep < NREP(7); ++rep) if (PH_EN(7) && IN(pb + 6)) { FRESH(); if (l == 0) norm_phase<true>(XBF, XC, Mact, PTR(5) + l * DM, mod, 3072, 4096, HX, gw, NGW, lane, (const float*)Gb, 4, mod + 2 * 6144 + 2048, XC);
            else norm_phase<true>(XBF, XC, Mact, PTR(5) + l * DM, mod, 3072, 4096, HX, gw, NGW, lane);
            if (BOTH(pb + 6)) GRID_BAR(); }
        for (int rep = 0; rep < NREP(8); ++rep) if (PH_EN(8) && IN(pb + 7)) { FRESH();
            pg8::Gemm g{HX, l == 0 ? (const bf16_t*)(ws + WS_WUPG) : (const bf16_t*)WUPG1, Mact, DFF, 1024}; pg8::StaticOrder S; S.init(Mact, DFF, G, bx);
            pg8::EpiBf E{GT, DFF};
            pg8::gemm_phase<pg8::EpiBf, pg8::StaticOrder, true, true>(L, g, S, E, tid);
            if (l == 0) TAIL_CONVERT(8, (MT / 256) * (DFF / 256), ITU_UPG, ITU_UPV);
            if (BOTH(pb + 7)) GRID_BAR();
        }
        for (int rep = 0; rep < NREP(9); ++rep) if (PH_EN(9) && IN(pb + 8)) { FRESH();
            pg8::Gemm g{HX, l == 0 ? (const bf16_t*)(ws + WS_WUPV) : (const bf16_t*)WUPV1, Mact, DFF, 1024}; pg8::StaticOrder S; S.init(Mact, DFF, G, bx);
            pg8::EpiVal E{GT, Hb, PTR(26) + l * 3 * DFF, PTR(27) + l * DFF};
            pg8::gemm_phase<pg8::EpiVal, pg8::StaticOrder, true, true>(L, g, S, E, tid);
            if (l == 0) TAIL_CONVERT(16, (MT / 256) * (DFF / 256), ITU_UPV, ITU_END);
            if (BOTH(pb + 8)) GRID_BAR();
        }
        if (PH_EN(10) && IN(pb + 9)) { FRESH();
            pg8::Gemm g{Hb, (const bf16_t*)(ws + WS_WDN), ML, 1024, DFF}; pg8::StaticOrder S; S.init(ML, 1024, G, bx);
            pg8::EpiRes E{(const float*)nullptr, XBF, XC, l == 0 ? XBF : HX, XC, mod, 5120};
            pg8::gemm_phase<pg8::EpiRes, pg8::StaticOrder, true, true>(L, g, S, E, tid);
            if (l == 0) {
                pg8::Gemm gc{Hb + (size_t)ML * DFF, (const bf16_t*)(ws + WS_WDN), MC, 1024, 256, DFF}; pg8::SplitKOrder Sc{11, 256, G, bx};
                pg8::EpiSlab Ec{(float*)Gb};
                pg8::gemm_phase<pg8::EpiSlab, pg8::SplitKOrder, true, true>(L, gc, Sc, Ec, tid);
            }
            if (BOTH(pb + 9)) GRID_BAR();
        }
    }
    if (PH_EN(11) && IN(21)) { FRESH(); final_norm_phase(HX, OUTP, PTR(29), gw, NGW, lane); }
#undef IN
#undef BOTH
#undef mod
#undef XBF
#undef xc
#undef ws
#undef OUTHI
#undef WA1
#undef WUPG1
#undef WUPV1
#undef WDST0
#undef WDST1
#undef TAIL_CONVERT
#undef MOD
#undef ROPE
#undef TW
#undef FT
#undef XC
#undef HX
#undef FA
#undef Qb
#undef Kb
#undef Vb
#undef Yb
#undef Gb
#undef ACAT
#undef UF
#undef ZG
#undef UP
#undef GT
#undef Hb
#undef PTR
#undef OUTP
#undef WSP
}

extern "C" void kernel_launch(void* const* d_in, const int* in_sizes, int n_in, void* d_out, int out_size, void* d_ws, size_t ws_size, hipStream_t stream) {
    static int grid = 0;
    if (grid == 0) {
        if (n_in != 30 || in_sizes[0] != ML * DM || out_size != ML * DM || ws_size < WS_END) {
            fprintf(stderr, "kernel_launch: unexpected shapes: n_in %d in0 %d out %d ws %zu (need >= %zu)\n", n_in, n_in > 0 ? in_sizes[0] : -1, out_size, ws_size, (size_t)WS_END); grid = -1; return; }
        int dev = 0, cus = 0, per_cu = 0;
        if (hipGetDevice(&dev) != hipSuccess || hipDeviceGetAttribute(&cus, hipDeviceAttributeMultiprocessorCount, dev) != hipSuccess) { grid = -1; return; }
        if (hipFuncSetAttribute((const void*)fwd_kernel, hipFuncAttributeMaxDynamicSharedMemorySize, LDS_BYTES) != hipSuccess) { fprintf(stderr, "kernel_launch: hipFuncSetAttribute failed\n"); grid = -1; return; }
        if (hipOccupancyMaxActiveBlocksPerMultiprocessor(&per_cu, (const void*)fwd_kernel, 512, LDS_BYTES) != hipSuccess || per_cu < 1) {
            fprintf(stderr, "kernel_launch: occupancy query reports %d blocks per CU\n", per_cu); (void)hipGetLastError(); grid = -1; return; }
        grid = cus;
    }
    if (grid < 0) return;
    (void)hipMemsetAsync((char*)d_ws + WS_CTL, 0, CTL_ZERO_BYTES, stream);
    Args a{};
    for (int i = 0; i < 30; ++i) a.in[i] = (const float*)d_in[i];
    a.out = (float*)d_out; a.ws = (unsigned char*)d_ws;
    for (int li = 0; li < MK_N_LAUNCHES; ++li) {
        if (MK_N_LAUNCHES == NPHASE) { a.ph_lo = li; a.ph_hi = li + 1; a.li = 0; }
        else { a.ph_lo = (int)((long)NPHASE * li / MK_N_LAUNCHES); a.ph_hi = (int)((long)NPHASE * (li + 1) / MK_N_LAUNCHES); a.li = li; }
        hipLaunchKernelGGL(fwd_kernel, dim3(grid), dim3(512), LDS_BYTES, stream, a);
    }
}
```

```cpp
#include <hip/hip_runtime.h>
#include <cstdio>
#include <cstdint>

#define LAS __attribute__((address_space(3)))
#define GAS __attribute__((address_space(1)))
typedef unsigned short bf16_t;
typedef short bf16x8 __attribute__((ext_vector_type(8)));
typedef short s16x4 __attribute__((ext_vector_type(4)));
typedef float f32x2 __attribute__((ext_vector_type(2)));
typedef float f32x4 __attribute__((ext_vector_type(4)));
typedef float f32x16 __attribute__((ext_vector_type(16)));
typedef unsigned u32x2 __attribute__((ext_vector_type(2)));
typedef unsigned u32x4 __attribute__((ext_vector_type(4)));

#ifndef ATT_V
#define ATT_V 2
#endif
#ifndef MK_N_LAUNCHES
#define MK_N_LAUNCHES 1
#endif

constexpr int DM = 1024, SEQ = 8192, NBATCH = 2, CTXL = 256;
constexpr int ML = NBATCH * SEQ;
constexpr int MC = NBATCH * CTXL;
constexpr int MT = ML + MC;
constexpr int NIN = 6656, DFF = 2816, KCAT = 1280;
constexpr int KVL = CTXL + SEQ;
constexpr float EPS = 1e-6f;

constexpr size_t MiB = 1u << 20;
constexpr size_t WS_CTL = 0, CTL_ZERO_BYTES = 1 * MiB;
constexpr size_t WS_MOD = 1 * MiB;
constexpr size_t WS_ROPE = WS_MOD + 2 * 3 * 6144 * 4;
constexpr size_t WS_TW = WS_ROPE + 192 * 32 * 4;
constexpr size_t WS_FT = WS_MOD + 512 * 1024;
constexpr size_t WS_XC = 2 * MiB;
constexpr size_t WS_WA = 4 * MiB;
constexpr size_t WS_WCAT = 17 * MiB;
constexpr size_t WS_WOUT = WS_WCAT + (size_t)1024 * 1280 * 2;
constexpr size_t WS_WUPG = WS_WOUT + (size_t)1024 * 1024 * 2;
constexpr size_t WS_WUPV = WS_WUPG + (size_t)2816 * 1024 * 2;
constexpr size_t WS_WDN = WS_WUPV + (size_t)2816 * 1024 * 2;
constexpr size_t WS_HX = 38 * MiB;
constexpr size_t WS_FA = WS_HX;
constexpr size_t WS_Q = 71 * MiB;
constexpr size_t WS_K = WS_Q + (size_t)MT * 512 * 2;
constexpr size_t WS_V = WS_K + (size_t)MT * 512 * 2;
constexpr size_t WS_Y = 71 * MiB;
constexpr size_t WS_G = 121 * MiB;
constexpr size_t WS_ACAT = 187 * MiB;
constexpr size_t WS_UF = 229 * MiB;
constexpr size_t WS_ZG = WS_UF + (size_t)MT * 256 * 2;
constexpr size_t WS_UP = WS_ZG + (size_t)MT * 256 * 2;
constexpr size_t WS_GT = 71 * MiB;
constexpr size_t WS_H = 162 * MiB;
constexpr size_t WS_END = 256 * MiB;
static_assert(WS_TW + 8192 * 8 <= WS_FT && WS_FT + 4 * 4096 * 16 <= WS_XC && WS_WDN + (size_t)1024 * 2816 * 2 <= WS_HX && WS_V + (size_t)MT * 512 * 2 <= WS_G && WS_G + (size_t)MT * 4096 <= WS_ACAT, "ws map 1");
static_assert(WS_ACAT + (size_t)MT * 1280 * 2 <= WS_UF && WS_UP + (size_t)MT * 256 * 2 <= WS_END && WS_GT + (size_t)MT * 2816 * 2 <= WS_H && WS_H + (size_t)MT * 2816 * 2 <= WS_END, "ws map 2");
static_assert(WS_HX + (size_t)MT * 1024 * 2 <= WS_Q && (size_t)2 * 4 * 128 * 64 * 64 * 8 <= (size_t)MT * 1024 * 2, "ws map 3");
constexpr int CW_TMO = 0, CW_CODE = 1, CW_BAR = 4096;

constexpr int RING_BYTES = 131072, LDSCTL_OFF = RING_BYTES, MISC_OFF = LDSCTL_OFF + 320, LDS_BYTES = 147456;

typedef __bf16 bf16x2_t __attribute__((ext_vector_type(2)));
__device__ __forceinline__ unsigned cvt2bf(float lo, float hi) { const f32x2 v = {lo, hi}; return __builtin_bit_cast(unsigned, __builtin_convertvector(v, bf16x2_t)); }
template <int M> __device__ __forceinline__ float swz_xor(float v) { return __int_as_float(__builtin_amdgcn_ds_swizzle(__float_as_int(v), (M << 10) | 0x1f)); }
__device__ __forceinline__ float bf2f(unsigned v) { return __uint_as_float(v << 16); }
__device__ __forceinline__ float sigm(float x) { return __builtin_amdgcn_rcpf(1.0f + __builtin_amdgcn_exp2f(x * -1.4426950408889634f)); }
__host__ __device__ __forceinline__ int in_map(int n) {
    if (n < 256) return n;
    if (n < 1280) { const int base = n < 768 ? 256 : 768, r = n - base, comp = r >> 6, p = r & 63, pp = p >> 1, e = p & 1;
        return base + comp * 64 + (pp < 16 ? 0 : 32) + (pp & 15) + 16 * e; }
    if (n < 1792) return n;
    if (n < 2304) { const int r = n - 1792; return 1792 + (r & 1) * 256 + (r >> 1); }
    return n;
}
namespace pg8 {
#define PG8_LAS __attribute__((address_space(3)))
typedef unsigned short bf16_t;
typedef short bf16x8 __attribute__((ext_vector_type(8)));
typedef float f32x4 __attribute__((ext_vector_type(4)));
typedef unsigned u32x4 __attribute__((ext_vector_type(4)));
constexpr int BM = 256, BK = 64, HALF = 128, HTB = HALF * BK * 2  , STAGE_BYTES = 8 * HTB, NXCD = 8, WGM = 8;

__host__ __device__ __forceinline__ int lds_byte(int r, int c) { const int st = (r >> 4) * 2 + (c >> 5), rr = r & 15, cc = c & 31, ob = rr * 64 + cc * 2; return st * 1024 + (ob ^ (((ob >> 9) & 1) << 5)); }
__host__ __device__ __forceinline__ void stage_rc(int b, int& R, int& C) { const int st = b / 1024, sb = b % 1024, swz = sb ^ (((sb >> 9) & 1) << 5); R = (st >> 1) * 16 + swz / 64; C = (st & 1) * 32 + (swz % 64) / 2; }
__host__ __device__ __forceinline__ int perm32(int rho) { const int n = rho >> 4, i = rho & 15; return 8 * (i >> 2) + 4 * n + (i & 3); }

struct Unit { int pm, pn, ko = 0, sl = 0; };
struct Gemm { const bf16_t* A; const bf16_t* Bt; int M, N, K, ld = 0; };

struct StaticOrder {
    int nM, nN, nwg, G, c, rev = 0;
    __host__ __device__ void init(int M, int N, int G_, int c_) { nM = M / BM; nN = N / BM; nwg = nM * nN; G = G_; c = c_; }
    __host__ __device__ bool next(int i, Unit& u) const {
        long L = (long)i * G + c;
        if (rev) { const int n_mine = (nwg - c + G - 1) / G; if (i >= n_mine) return false; L = (long)(n_mine - 1 - i) * G + c; }
        if (L >= nwg) return false;
        int wgid = (int)L; { const int q = nwg / NXCD, r = nwg % NXCD, xcd = wgid % NXCD, off = wgid / NXCD; wgid = (xcd < r ? xcd * (q + 1) : r * (q + 1) + (xcd - r) * q) + off; }
        const int nig = WGM * nN, gid = wgid / nig, fm = gid * WGM, gsz = (nM - fm) < WGM ? (nM - fm) : WGM;
        u.pm = fm + ((wgid % nig) % gsz); u.pn = (wgid % nig) / gsz; return true;
    }
    __device__ __forceinline__ void a_ready(const Unit&) const {}
    __device__ __forceinline__ void done(const Unit&) const {}
};
__device__ __forceinline__ unsigned cvt_pk_bf16(float lo, float hi) { return cvt2bf(lo, hi); }
typedef float f32x2 __attribute__((ext_vector_type(2)));
__device__ __forceinline__ float gelu_mul(float v, float val) {
    asm volatile("" : "+v"(v));
    const float av = __builtin_fabsf(v);
    const float t = __builtin_amdgcn_rcpf(__builtin_fmaf(av, 0.33267292f, 1.0f));
    float q = __builtin_fmaf(t, 0.3739278f, -0.0479399f); q = __builtin_fmaf(q, t, 0.1740121f); q = q * t;
    const float e = __builtin_amdgcn_exp2f((v * v) * (-0.72134752044f));
    const float h = __builtin_fmaf(-q, e, 0.5f);
    return val * __builtin_fmaf(av, h, 0.5f * v);
}
__device__ __forceinline__ float gelu_s(float v) {
    asm volatile("" : "+v"(v));
    const float t = __builtin_amdgcn_rcpf(__builtin_fabsf(v) * 0.2316418882f + 1.0f);
    float q = t * 0.5307027145f + (-0.7265760135f); q = q * t + 0.7107068705f; q = q * t + (-0.142248368f); q = q * t + 0.127414796f; q = q * t;
    const float e = __builtin_amdgcn_exp2f((v * v) * (-0.72134752044f));
    const float m = v * (q * e);
    return v < 0.f ? m : v - m;
}
__device__ __forceinline__ f32x2 gelu_pk(f32x2 v) {
    const f32x2 av = __builtin_elementwise_abs(v), d = av * 0.2316418882f + 1.0f;
    f32x2 t; t.x = __builtin_amdgcn_rcpf(d.x); t.y = __builtin_amdgcn_rcpf(d.y);
    f32x2 q = t * 0.5307027145f + (-0.7265760135f); q = q * t + 0.7107068705f; q = q * t + (-0.142248368f); q = q * t + 0.127414796f; q = q * t;
    const f32x2 s = (v * v) * (-0.72134752044f);
    f32x2 e; e.x = __builtin_amdgcn_exp2f(s.x); e.y = __builtin_amdgcn_exp2f(s.y);
    const f32x2 m = v * (q * e), r = v - m;
    f32x2 o; o.x = v.x < 0.f ? m.x : r.x; o.y = v.y < 0.f ? m.y : r.y; return o;
}

typedef unsigned u32x2 __attribute__((ext_vector_type(2)));
__device__ __forceinline__ u32x4 pack8(const f32x4 a, const f32x4 b) { u32x4 w; w.x = cvt_pk_bf16(a[0], a[1]); w.y = cvt_pk_bf16(a[2], a[3]); w.z = cvt_pk_bf16(b[0], b[1]); w.w = cvt_pk_bf16(b[2], b[3]); return w; }

struct EpiIn {
    static constexpr bool PERM = true, AFTER_DRAIN = false, RESCALE = false; static constexpr int NVM = 16;
    bf16_t *UF, *ZG, *UP, *Q, *K, *V; unsigned char* G; const float* rope;
    __device__ __forceinline__ void operator()(const f32x4 (&acc)[2][2][4][2], const Unit& u, int wr, int wc, int fr, int fq) const {
        const int pm = u.pm, pn = u.pn; const bool lat = pm < 64; const int R0 = pm * 256;
        const int kv0 = lat ? ((pm >> 5) * 8448 + 256 + ((pm & 31) << 8)) : ((pm - 64) * 8448);
        const int rl = wr * 64 + fr, cl = wc * 32 + 8 * fq;
        if (pn == 0 || pn == 9) {
            bf16_t* dst = (pn == 0 ? UF : UP);
#pragma unroll
            for (int ai = 0; ai < 2; ++ai)
#pragma unroll
                for (int m = 0; m < 4; ++m) { const int rr = ai * 128 + m * 16 + rl;
#pragma unroll
                    for (int bj = 0; bj < 2; ++bj) *(u32x4*)(dst + (size_t)(R0 + rr) * 256 + bj * 128 + cl) = pack8(acc[ai][bj][m][0], acc[ai][bj][m][1]); }
        } else if (pn <= 4) {
            const bool isq = pn <= 2; bf16_t* dst = isq ? Q : K; const int rowbase = isq ? R0 : kv0, colbase = (isq ? pn - 1 : pn - 3) * 256; const float sc = isq ? (ATT_V == 2 ? 0.18033688011112042f : 0.125f) : 1.0f;
#pragma unroll
            for (int ai = 0; ai < 2; ++ai)
#pragma unroll
                for (int m = 0; m < 4; ++m) { const int rr = ai * 128 + m * 16 + rl;
                    f32x4 cs = {1.f, 1.f, 1.f, 1.f}, sn = {0.f, 0.f, 0.f, 0.f};
                    if (lat) { const int t = (R0 & 8191) + rr; const int pos = (wc & 1) ? 128 + (t & 63) : (t >> 6);
                        cs = *(const f32x4*)(rope + pos * 32 + 4 * fq); sn = *(const f32x4*)(rope + pos * 32 + 16 + 4 * fq); }
                    cs = cs * sc; sn = sn * sc;
#pragma unroll
                    for (int bj = 0; bj < 2; ++bj) { const f32x4 a = acc[ai][bj][m][0], b = acc[ai][bj][m][1]; f32x4 oa, ob;
                        oa[0] = a[0] * cs[0] - a[1] * sn[0]; oa[1] = a[1] * cs[0] + a[0] * sn[0]; oa[2] = a[2] * cs[1] - a[3] * sn[1]; oa[3] = a[3] * cs[1] + a[2] * sn[1];
                        ob[0] = b[0] * cs[2] - b[1] * sn[2]; ob[1] = b[1] * cs[2] + b[0] * sn[2]; ob[2] = b[2] * cs[3] - b[3] * sn[3]; ob[3] = b[3] * cs[3] + b[2] * sn[3];
                        *(u32x4*)(dst + (size_t)(rowbase + rr) * 512 + colbase + bj * 128 + cl) = pack8(oa, ob); } }
        } else if (pn <= 6) {
#pragma unroll
            for (int ai = 0; ai < 2; ++ai)
#pragma unroll
                for (int m = 0; m < 4; ++m) { const int rr = ai * 128 + m * 16 + rl;
#pragma unroll
                    for (int bj = 0; bj < 2; ++bj) *(u32x4*)(V + (size_t)(kv0 + rr) * 512 + (pn - 5) * 256 + bj * 128 + cl) = pack8(acc[ai][bj][m][0], acc[ai][bj][m][1]); }
        } else if (pn <= 8) {
#pragma unroll
            for (int ai = 0; ai < 2; ++ai)
#pragma unroll
                for (int m = 0; m < 4; ++m) { const int rr = ai * 128 + m * 16 + rl;
#pragma unroll
                    for (int bj = 0; bj < 2; ++bj) { const f32x4 a = acc[ai][bj][m][0], b = acc[ai][bj][m][1];
                        u32x2 w; w.x = cvt_pk_bf16(a[0] * sigm(a[1]), a[2] * sigm(a[3])); w.y = cvt_pk_bf16(b[0] * sigm(b[1]), b[2] * sigm(b[3]));
                        *(u32x2*)(ZG + (size_t)(R0 + rr) * 256 + (pn - 7) * 128 + bj * 64 + (cl >> 1)) = w; } }
        } else {
#pragma unroll
            for (int ai = 0; ai < 2; ++ai)
#pragma unroll
                for (int m = 0; m < 4; ++m) { const int rr = ai * 128 + m * 16 + rl;
#pragma unroll
                    for (int bj = 0; bj < 2; ++bj) { u32x2 w;
#pragma unroll
                        for (int n = 0; n < 2; ++n) { const f32x4 a = acc[ai][bj][m][n]; unsigned q = 0;
#pragma unroll
                            for (int j = 0; j < 4; ++j) { float s = sigm(a[j]) * 255.0f + 0.5f; s = s < 1.0f ? 1.0f : s; q |= ((unsigned)s) << (8 * j); }
                            if (n == 0) w.x = q; else w.y = q; }
                        *(u32x2*)(G + (size_t)(R0 + rr) * 4096 + (pn - 10) * 256 + bj * 128 + cl) = w; } }
        }
    }
};

struct EpiBf {
    static constexpr bool PERM = true, AFTER_DRAIN = false, RESCALE = false; static constexpr int NVM = 16;
    bf16_t* O; int ldc;
    __device__ __forceinline__ void operator()(const f32x4 (&acc)[2][2][4][2], const Unit& u, int wr, int wc, int fr, int fq) const {
        const int row0 = u.pm * 256 + wr * 64 + fr, col0 = u.pn * 256 + wc * 32 + 8 * fq;
#pragma unroll
        for (int ai = 0; ai < 2; ++ai)
#pragma unroll
            for (int m = 0; m < 4; ++m)
#pragma unroll
                for (int bj = 0; bj < 2; ++bj) *(u32x4*)(O + (size_t)(row0 + ai * 128 + m * 16) * ldc + col0 + bj * 128) = pack8(acc[ai][bj][m][0], acc[ai][bj][m][1]);
    }
};

struct EpiNull {
    static constexpr bool PERM = true, AFTER_DRAIN = false, RESCALE = false; static constexpr int NVM = 0 ;
    __device__ __forceinline__ void operator()(const f32x4 (&acc)[2][2][4][2], const Unit&, int, int, int, int) const {
#pragma unroll
        for (int ai = 0; ai < 2; ++ai)
#pragma unroll
            for (int m = 0; m < 4; ++m)
#pragma unroll
                for (int bj = 0; bj < 2; ++bj) asm volatile("" :: "v"(acc[ai][bj][m][0]), "v"(acc[ai][bj][m][1]));
    }
};

struct EpiRes {
    static constexpr bool PERM = true, AFTER_DRAIN = false, RESCALE = false; static constexpr int NVM = 16;
    const float* base_f32; const bf16_t* base_bf; const float* base_ctx; bf16_t* out_bf; float* out_ctx; const float* mod; int goff;
    __device__ __forceinline__ void operator()(const f32x4 (&acc)[2][2][4][2], const Unit& u, int wr, int wc, int fr, int fq) const {
        const int pm = u.pm; const bool lat = pm < 64; const int mrow = lat ? (pm >> 5) : 2;
        const int col0 = u.pn * 256 + wc * 32 + 8 * fq;
        f32x4 gv[2][2];
#pragma unroll
        for (int bj = 0; bj < 2; ++bj)
#pragma unroll
            for (int n = 0; n < 2; ++n) gv[bj][n] = *(const f32x4*)(mod + mrow * 6144 + goff + col0 + bj * 128 + 4 * n);
#pragma unroll
        for (int ai = 0; ai < 2; ++ai)
#pragma unroll
            for (int m = 0; m < 4; ++m) { const size_t ro = (size_t)((lat ? pm : pm - 64) * 256 + ai * 128 + wr * 64 + m * 16 + fr) * 1024 + col0;
#pragma unroll
                for (int bj = 0; bj < 2; ++bj) { const size_t off = ro + bj * 128; f32x4 b0, b1;
                    if (!lat) { b0 = *(const f32x4*)(base_ctx + off); b1 = *(const f32x4*)(base_ctx + off + 4); }
                    else if (base_f32) { b0 = *(const f32x4*)(base_f32 + off); b1 = *(const f32x4*)(base_f32 + off + 4); }
                    else { const u32x4 w = *(const u32x4*)(base_bf + off);
                        b0 = (f32x4){__uint_as_float(w.x << 16), __uint_as_float(w.x & 0xffff0000u), __uint_as_float(w.y << 16), __uint_as_float(w.y & 0xffff0000u)};
                        b1 = (f32x4){__uint_as_float(w.z << 16), __uint_as_float(w.z & 0xffff0000u), __uint_as_float(w.w << 16), __uint_as_float(w.w & 0xffff0000u)}; }
                    const f32x4 o0 = b0 + gv[bj][0] * acc[ai][bj][m][0], o1 = b1 + gv[bj][1] * acc[ai][bj][m][1];
                    if (lat) *(u32x4*)(out_bf + off) = pack8(o0, o1); else { *(f32x4*)(out_ctx + off) = o0; *(f32x4*)(out_ctx + off + 4) = o1; } } }
    }
};

struct EpiVal {
    static constexpr bool PERM = true, AFTER_DRAIN = false, RESCALE = false; static constexpr int NVM = 16;
    const bf16_t* GT; bf16_t* H; const float* dww; const float* dwb;
    __device__ __forceinline__ void operator()(const f32x4 (&acc)[2][2][4][2], const Unit& u, int wr, int wc, int fr, int fq) const {
        const int pm = u.pm; const bool lat = pm < 64; const int R0 = pm * 256, t0 = lat ? (R0 & 8191) : 0, L = lat ? 8192 : 256;
#pragma unroll
        for (int bj = 0; bj < 2; ++bj) { const int col = u.pn * 256 + bj * 128 + wc * 32 + 8 * fq;
            f32x4 w0[2], w1[2], w2[2], bb[2];
#pragma unroll
            for (int n = 0; n < 2; ++n) { w0[n] = *(const f32x4*)(dww + col + 4 * n); w1[n] = *(const f32x4*)(dww + 2816 + col + 4 * n); w2[n] = *(const f32x4*)(dww + 5632 + col + 4 * n); bb[n] = *(const f32x4*)(dwb + col + 4 * n); }
#pragma unroll
            for (int ai = 0; ai < 2; ++ai) {
                const int rb = ai * 128 + wr * 64, tb = t0 + rb;
                const bf16_t* gp = GT + (size_t)(R0 + rb + fr) * 2816 + col;
                u32x4 g[4], elo = {0u, 0u, 0u, 0u}, ehi = {0u, 0u, 0u, 0u};
#pragma unroll
                for (int m = 0; m < 4; ++m) g[m] = *(const u32x4*)(gp + (size_t)(m * 16) * 2816);
                if (tb > 0) elo = *(const u32x4*)(GT + (size_t)(R0 + rb - 1) * 2816 + col);
                if (tb + 64 < L) ehi = *(const u32x4*)(GT + (size_t)(R0 + rb + 64) * 2816 + col);
                asm volatile("" ::: "memory");
#pragma unroll
                for (int m = 0; m < 4; ++m) { const int rr = rb + m * 16 + fr;
                    u32x4 gm, gq;
#pragma unroll
                    for (int d = 0; d < 4; ++d) {
                        const int pa = (m == 0) ? (int)elo[d] : __builtin_amdgcn_update_dpp(0, (int)g[m == 0 ? 0 : m - 1][d], 0x121  , 0xF, 0xF, true);
                        gm[d] = (unsigned)__builtin_amdgcn_update_dpp(pa, (int)g[m][d], 0x111  , 0xF, 0xF, false);
                        const int pb = (m == 3) ? (int)ehi[d] : __builtin_amdgcn_update_dpp(0, (int)g[m == 3 ? 3 : m + 1][d], 0x12F  , 0xF, 0xF, true);
                        gq[d] = (unsigned)__builtin_amdgcn_update_dpp(pb, (int)g[m][d], 0x101  , 0xF, 0xF, false); }
                    f32x4 o[2];
#pragma unroll
                    for (int n = 0; n < 2; ++n) { f32x4 c;
#pragma unroll
                        for (int j = 0; j < 4; ++j) { const int e = 4 * n + j; const unsigned wm = gm[e >> 1], wz = g[m][e >> 1], wp = gq[e >> 1];
                            const float xm = (e & 1) ? __uint_as_float(wm & 0xffff0000u) : __uint_as_float(wm << 16), xz = (e & 1) ? __uint_as_float(wz & 0xffff0000u) : __uint_as_float(wz << 16),
                                        xp = (e & 1) ? __uint_as_float(wp & 0xffff0000u) : __uint_as_float(wp << 16);
                            c[j] = __builtin_fmaf(w2[n][j], xp, __builtin_fmaf(w1[n][j], xz, __builtin_fmaf(w0[n][j], xm, bb[n][j]))); }
                        const f32x4 v = acc[ai][bj][m][n]; o[n] = (f32x4){gelu_mul(c[0], v[0]), gelu_mul(c[1], v[1]), gelu_mul(c[2], v[2]), gelu_mul(c[3], v[3])}; }
                    *(u32x4*)(H + (size_t)(R0 + rr) * 2816 + col) = pack8(o[0], o[1]); }
                asm volatile("" ::: "memory");
            }
        }
    }
};

struct EpiBranch {
    static constexpr bool PERM = true, AFTER_DRAIN = false, RESCALE = true; static constexpr int NVM = 16;
    const unsigned char* G; bf16_t* Y;
    __device__ __forceinline__ void rescale(f32x4 (&acc)[2][2][4][2], const Unit& u, int t, int wr, int wc, int fr, int fq) const {
        const int bp = (t == 4) ? 0 : (t == 12) ? 1 : 2;
        const __amdgpu_buffer_rsrc_t rs = __builtin_amdgcn_make_buffer_rsrc((void*)G, 0, MT * 4096, 0x00020000);
        const int voff = (u.pm * 256 + wr * 64 + fr) * 4096 + u.pn * 256 + wc * 32 + 8 * fq;
        u32x2 p[2][4][2], q[2][4][2];
#pragma unroll
        for (int ai = 0; ai < 2; ++ai)
#pragma unroll
            for (int m = 0; m < 4; ++m)
#pragma unroll
                for (int bj = 0; bj < 2; ++bj) { const int so = (ai * 128 + m * 16) * 4096 + bj * 128 + bp * 1024;
                    p[ai][m][bj] = __builtin_bit_cast(u32x2, __builtin_amdgcn_raw_buffer_load_b64(rs, voff, so, 0)); q[ai][m][bj] = __builtin_bit_cast(u32x2, __builtin_amdgcn_raw_buffer_load_b64(rs, voff, so + 1024, 0)); }
        asm volatile("" ::: "memory");
#pragma unroll
        for (int ai = 0; ai < 2; ++ai)
#pragma unroll
            for (int m = 0; m < 4; ++m)
#pragma unroll
                for (int bj = 0; bj < 2; ++bj)
#pragma unroll
                    for (int n = 0; n < 2; ++n) { const unsigned pw = n ? p[ai][m][bj].y : p[ai][m][bj].x, qw = n ? q[ai][m][bj].y : q[ai][m][bj].x;
#pragma unroll
                        for (int j = 0; j < 4; ++j) acc[ai][bj][m][n][j] *= (float)((pw >> (8 * j)) & 255u) * __builtin_amdgcn_rcpf((float)((qw >> (8 * j)) & 255u)); }
        asm volatile("" ::: "memory");
    }
    __device__ __forceinline__ void operator()(const f32x4 (&acc)[2][2][4][2], const Unit& u, int wr, int wc, int fr, int fq) const {
        const int row0 = u.pm * 256 + wr * 64 + fr, col0 = u.pn * 256 + wc * 32 + 8 * fq;
#pragma unroll
        for (int ai = 0; ai < 2; ++ai)
#pragma unroll
            for (int m = 0; m < 4; ++m)
#pragma unroll
                for (int bj = 0; bj < 2; ++bj) { const size_t r = (size_t)(row0 + ai * 128 + m * 16); const u32x2 p = *(const u32x2*)(G + r * 4096 + 3072 + col0 + bj * 128);
                    f32x4 o[2];
#pragma unroll
                    for (int n = 0; n < 2; ++n) { const unsigned pw = n ? p.y : p.x;
#pragma unroll
                        for (int j = 0; j < 4; ++j) o[n][j] = acc[ai][bj][m][n][j] * ((float)((pw >> (8 * j)) & 255u) * (1.0f / 255.0f)); }
                    *(u32x4*)(Y + r * 1024 + col0 + bj * 128) = pack8(o[0], o[1]); }
    }
};


struct SplitKOrder {
    int nsl, ksl, G, c;
    __device__ __forceinline__ bool next(int i, Unit& u) const { const int L = i * G + c; if (L >= 8 * nsl) return false; u.pm = (L >> 2) & 1; u.pn = L & 3; u.sl = L >> 3; u.ko = u.sl * ksl; return true; }
    __device__ __forceinline__ void a_ready(const Unit&) const {}
    __device__ __forceinline__ void done(const Unit&) const {}
};
struct EpiSlab {
    static constexpr bool PERM = false, AFTER_DRAIN = false, RESCALE = false; static constexpr int NVM = 16;
    float* slab;
    __device__ __forceinline__ void operator()(const f32x4 (&acc)[2][2][4][2], const Unit& u, int wr, int wc, int, int) const {
        int ln; asm volatile("v_mbcnt_lo_u32_b32 %0, -1, 0\n\tv_mbcnt_hi_u32_b32 %0, -1, %0" : "=v"(ln));
        const int fr = ln & 15, fq = ln >> 4;
        float* o = slab + (size_t)u.sl * 512 * 1024 + (size_t)(u.pm * 256 + wr * 64 + fr) * 1024 + u.pn * 256 + wc * 32 + 4 * fq;
#pragma unroll
        for (int ai = 0; ai < 2; ++ai)
#pragma unroll
            for (int m = 0; m < 4; ++m)
#pragma unroll
                for (int bj = 0; bj < 2; ++bj)
#pragma unroll
                    for (int n = 0; n < 2; ++n) *(f32x4*)(o + (size_t)(ai * 128 + m * 16) * 1024 + bj * 128 + n * 16) = acc[ai][bj][m][n];
    }
};

struct BranchSliceOrder {
    int G, c;
    __device__ __forceinline__ bool next(int i, Unit& u) const { const int L = i * G + c; if (L >= 40) return false; u.pm = (L >> 2) & 1; u.pn = L & 3; u.sl = L >> 3; u.ko = u.sl * 256; return true; }
    __device__ __forceinline__ void a_ready(const Unit&) const {}
    __device__ __forceinline__ void done(const Unit&) const {}
};
template <class Epi, class Sched, bool ALIGN_EPI = false, bool SP2 = false>
__device__ __forceinline__ void gemm_phase(PG8_LAS unsigned char* lds, const Gemm g, const Sched& S, const Epi& E, const int tid) {
    const int wid = __builtin_amdgcn_readfirstlane(tid >> 6), lane = tid & 63, wr = wid >> 2, wc = wid & 3, fr = lane & 15, fq = lane >> 4;
    const int K = g.ld ? g.ld : g.K  , nt = g.K / BK;
    unsigned voffA[2], voffB[2];
#pragma unroll
    for (int i = 0; i < 2; ++i) { int R, C; stage_rc(tid * 16 + i * 8192, R, C); const int Rb = Epi::PERM ? ((R & ~31) + perm32(R & 31)) : R;
        voffA[i] = (unsigned)(R * K + C) * 2u; voffB[i] = (unsigned)(Rb * K + C) * 2u; }
    const size_t kstep = (size_t)(BK * 2);
    const size_t hstep = (size_t)HALF * K * 2;
    const size_t tstep = 2 * hstep;
    const unsigned ldsw = (unsigned)wid * 1024u;
    const int aoff = lds_byte(wr * 64 + fr, fq * 8), boff = lds_byte(wc * 32 + fr, fq * 8);
#define PG8_SA(b, h) (((b) * 2 + (h)) * HTB)
#define PG8_SB(b, h) ((4 + (b) * 2 + (h)) * HTB)
#define PG8_STAGE(bufoff, gbase, voff) do { _Pragma("unroll") for (int _i = 0; _i < 2; ++_i) \
        __builtin_amdgcn_global_load_lds((const unsigned*)((const char*)(gbase) + (voff)[_i]), (PG8_LAS unsigned*)(lds + (bufoff) + ldsw + _i * 8192), 16, 0, 0); } while (0)
#define PG8_LDA(dst, b, h) do { _Pragma("unroll") for (int m = 0; m < 4; ++m) _Pragma("unroll") for (int k = 0; k < 2; ++k) dst[m][k] = *(const PG8_LAS bf16x8*)(lds + PG8_SA(b, h) + aoff + m * 2048 + k * 1024); } while (0)
#define PG8_LDB(dst, b, h) do { _Pragma("unroll") for (int n = 0; n < 2; ++n) _Pragma("unroll") for (int k = 0; k < 2; ++k) dst[n][k] = *(const PG8_LAS bf16x8*)(lds + PG8_SB(b, h) + boff + n * 2048 + k * 1024); } while (0)
#define PG8_MMA(ai, bj, At, Bt) do { __builtin_amdgcn_s_setprio(1); _Pragma("unroll") for (int m = 0; m < 4; ++m) _Pragma("unroll") for (int n = 0; n < 2; ++n) _Pragma("unroll") for (int k = 0; k < 2; ++k) \
        acc[ai][bj][m][n] = __builtin_amdgcn_mfma_f32_16x16x32_bf16(Bt[n][k], At[m][k], acc[ai][bj][m][n], 0, 0, 0); __builtin_amdgcn_s_setprio(0); } while (0)
#define PG8_WAIT_V(n) asm volatile("s_waitcnt vmcnt(" #n ")" ::: "memory")
#define PG8_WAIT_L(n) asm volatile("s_waitcnt lgkmcnt(" #n ")" ::: "memory")
#define PG8_BAR __builtin_amdgcn_s_barrier()
#define PG8_SCHED __builtin_amdgcn_sched_barrier(0)
    Unit cur, nxt; int ui = 0;
    if (!S.next(0, cur)) return;
    f32x4 acc[2][2][4][2];
#pragma unroll
    for (int a = 0; a < 2; ++a)
#pragma unroll
        for (int b = 0; b < 2; ++b)
#pragma unroll
            for (int m = 0; m < 4; ++m)
#pragma unroll
                for (int n = 0; n < 2; ++n) acc[a][b][m][n] = (f32x4){0.f, 0.f, 0.f, 0.f};
    bf16x8 At[4][2], B0[2][2], B1[2][2];
    const char* cA = (const char*)g.A + (size_t)cur.pm * tstep + (size_t)cur.ko * 2; const char* cB = (const char*)g.Bt + (size_t)cur.pn * tstep + (size_t)cur.ko * 2;
    S.a_ready(cur);
    if constexpr (SP2) {
        PG8_STAGE(PG8_SB(0, 0), cB, voffB); PG8_STAGE(PG8_SB(0, 1), cB + hstep, voffB); PG8_STAGE(PG8_SA(0, 0), cA, voffA); PG8_STAGE(PG8_SA(0, 1), cA + hstep, voffA);
        if (wr == 1) PG8_BAR;
        PG8_WAIT_V(2); PG8_BAR;
        PG8_STAGE(PG8_SB(1, 0), cB + kstep, voffB); PG8_STAGE(PG8_SA(1, 0), cA + kstep, voffA); PG8_STAGE(PG8_SB(1, 1), cB + hstep + kstep, voffB);
        PG8_WAIT_V(6); PG8_BAR;
    } else {
        PG8_STAGE(PG8_SB(0, 0), cB, voffB); PG8_STAGE(PG8_SA(0, 0), cA, voffA); PG8_STAGE(PG8_SB(0, 1), cB + hstep, voffB); PG8_STAGE(PG8_SA(0, 1), cA + hstep, voffA);
        if (wr == 1) PG8_BAR;
        PG8_WAIT_V(4); PG8_BAR;
        PG8_STAGE(PG8_SB(1, 0), cB + kstep, voffB); PG8_STAGE(PG8_SA(1, 0), cA + kstep, voffA); PG8_STAGE(PG8_SB(1, 1), cB + hstep + kstep, voffB);
        PG8_WAIT_V(6); PG8_BAR;
    }
    for (;;) {
        const bool has_next = S.next(ui + 1, nxt);
        const char* nA = has_next ? (const char*)g.A + (size_t)nxt.pm * tstep + (size_t)nxt.ko * 2 : cA; const char* nB = has_next ? (const char*)g.Bt + (size_t)nxt.pn * tstep + (size_t)nxt.ko * 2 : cB;
        for (int t = 0; t < nt; t += 2) {
            if constexpr (Epi::RESCALE) { if (t == 4 || t == 12 || t == 16) E.rescale(acc, cur, t, wr, wc, fr, fq); }
            const bool last = (t == nt - 2);
            const char* a1 = cA + (size_t)(t + 1) * kstep;
            const char* a2 = last ? nA : cA + (size_t)(t + 2) * kstep; const char* b2 = last ? nB : cB + (size_t)(t + 2) * kstep;
            const char* a3 = a2 + kstep; const char* b3 = b2 + kstep;
            if (last && has_next) S.a_ready(nxt);
            if constexpr (SP2) {
            PG8_LDB(B0, 0, 0); PG8_LDB(B1, 0, 1); PG8_SCHED; PG8_LDA(At, 0, 0); PG8_STAGE(PG8_SA(1, 1), a1 + hstep, voffA);
            PG8_WAIT_V(8); PG8_WAIT_L(0); PG8_BAR; PG8_MMA(0, 0, At, B0); PG8_MMA(0, 1, At, B1); PG8_BAR; PG8_SCHED;
            PG8_LDA(At, 0, 1); PG8_STAGE(PG8_SB(0, 0), b2, voffB); PG8_STAGE(PG8_SB(0, 1), b2 + hstep, voffB); PG8_STAGE(PG8_SA(0, 0), a2, voffA);
            PG8_WAIT_V(8); PG8_WAIT_L(0); PG8_BAR; PG8_MMA(1, 0, At, B0); PG8_MMA(1, 1, At, B1); PG8_BAR; PG8_SCHED;
            PG8_LDB(B0, 1, 0); PG8_LDB(B1, 1, 1); PG8_SCHED; PG8_LDA(At, 1, 0); PG8_STAGE(PG8_SA(0, 1), a2 + hstep, voffA);
            PG8_WAIT_V(8); PG8_WAIT_L(0); PG8_BAR; PG8_MMA(0, 0, At, B0); PG8_MMA(0, 1, At, B1); PG8_BAR; PG8_SCHED;
            PG8_LDA(At, 1, 1); PG8_STAGE(PG8_SB(1, 0), b3, voffB); PG8_STAGE(PG8_SB(1, 1), b3 + hstep, voffB); PG8_STAGE(PG8_SA(1, 0), a3, voffA);
            PG8_WAIT_V(8); PG8_WAIT_L(0); PG8_BAR; PG8_MMA(1, 0, At, B0); PG8_MMA(1, 1, At, B1); PG8_BAR; PG8_SCHED;
            } else {
            PG8_LDB(B0, 0, 0); PG8_SCHED; PG8_LDA(At, 0, 0); PG8_STAGE(PG8_SA(1, 1), a1 + hstep, voffA);
            PG8_WAIT_L(8); PG8_BAR; PG8_WAIT_L(0); PG8_MMA(0, 0, At, B0); PG8_BAR; PG8_SCHED;
            PG8_LDB(B1, 0, 1); PG8_STAGE(PG8_SB(0, 0), b2, voffB);
            PG8_BAR; PG8_WAIT_L(0); PG8_MMA(0, 1, At, B1); PG8_BAR;
            PG8_LDA(At, 0, 1); PG8_STAGE(PG8_SA(0, 0), a2, voffA);
            PG8_BAR; PG8_WAIT_L(0); PG8_MMA(1, 0, At, B0); PG8_BAR; PG8_SCHED;
            PG8_STAGE(PG8_SB(0, 1), b2 + hstep, voffB);
            PG8_WAIT_V(6); PG8_BAR; PG8_MMA(1, 1, At, B1); PG8_BAR;
            PG8_LDB(B0, 1, 0); PG8_SCHED; PG8_LDA(At, 1, 0); PG8_STAGE(PG8_SA(0, 1), a2 + hstep, voffA);
            PG8_WAIT_L(8); PG8_BAR; PG8_WAIT_L(0); PG8_MMA(0, 0, At, B0); PG8_BAR; PG8_SCHED;
            PG8_LDB(B1, 1, 1); PG8_STAGE(PG8_SB(1, 0), b3, voffB);
            PG8_BAR; PG8_WAIT_L(0); PG8_MMA(0, 1, At, B1); PG8_BAR;
            PG8_LDA(At, 1, 1); PG8_STAGE(PG8_SA(1, 0), a3, voffA);
            PG8_BAR; PG8_WAIT_L(0); PG8_MMA(1, 0, At, B0); PG8_BAR; PG8_SCHED;
            PG8_STAGE(PG8_SB(1, 1), b3 + hstep, voffB);
            PG8_WAIT_V(6); PG8_BAR; PG8_MMA(1, 1, At, B1); PG8_BAR;
            }
        }
        if constexpr (ALIGN_EPI) { if (wr == 0) PG8_BAR; }
        if constexpr (!Epi::AFTER_DRAIN) { E(acc, cur, wr, wc, fr, fq); S.done(cur); }
        if (!has_next) break;
#pragma unroll
        for (int a = 0; a < 2; ++a)
#pragma unroll
            for (int b = 0; b < 2; ++b)
#pragma unroll
                for (int m = 0; m < 4; ++m)
#pragma unroll
                    for (int n = 0; n < 2; ++n) acc[a][b][m][n] = (f32x4){0.f, 0.f, 0.f, 0.f};
        cur = nxt; cA = nA; cB = nB; ++ui;
        if constexpr (ALIGN_EPI) { if (wr == 1) PG8_BAR; }
    }
    PG8_WAIT_V(0);
    if constexpr (!ALIGN_EPI) { if (wr == 0) PG8_BAR; }
    PG8_BAR;
    if constexpr (Epi::AFTER_DRAIN) { E.fused(acc, cur, wr, wc, fr, fq, lds, wid, lane); S.done(cur); }
#undef PG8_SA
#undef PG8_SB
#undef PG8_STAGE
#undef PG8_LDA
#undef PG8_LDB
#undef PG8_MMA
#undef PG8_WAIT_V
#undef PG8_WAIT_L
#undef PG8_BAR
#undef PG8_SCHED
}
}
namespace att {
constexpr int NW = 8, QBLK = 32, KVBLK = 64, LDQ = 512, LDO = KCAT;
constexpr int SHM_V = 16384, SHM_K = 16384, SHM_ATTN = 3 * SHM_V + 2 * SHM_K + NW * 64 * 4;
constexpr float THR = 8.f;
#ifndef ATT_SDEPTH
#define ATT_SDEPTH 1
#endif
constexpr int SDEPTH = ATT_SDEPTH;
#define KSWZ(row, colB) ((row) * 256 + ((colB) ^ (((row) & 7) << 4)))
#define SBAR() __builtin_amdgcn_sched_barrier(0)
__device__ __forceinline__ int crow(int r, int hi) { return (r & 3) + 8 * (r >> 2) + 4 * hi; }
__device__ __forceinline__ unsigned cvtpk(float lo, float hi) { return cvt2bf(lo, hi); }

__device__ __forceinline__ void partialSM(f32x16& p0, f32x16& p1, float& m_reg, float& mn, float& alpha) {
  constexpr float C = 1.4426950408889634f;
  float pmax = p0[0];
#pragma unroll
  for (int r = 1; r < 16; ++r) pmax = fmaxf(pmax, p0[r]);
#pragma unroll
  for (int r = 0; r < 16; ++r) pmax = fmaxf(pmax, p1[r]);
  { auto rr = __builtin_amdgcn_permlane32_swap(__float_as_uint(pmax), __float_as_uint(pmax), false, false);
    pmax = fmaxf(__uint_as_float(rr[0]), __uint_as_float(rr[1])); }
  if (__builtin_expect(__all(pmax - m_reg <= THR), 1)) { mn = m_reg; alpha = 1.f; }
  else { mn = fmaxf(m_reg, pmax); alpha = __builtin_amdgcn_exp2f((m_reg - mn) * C); m_reg = mn; }
  const float mnC = -mn * C;
#pragma unroll
  for (int r = 0; r < 16; ++r) p0[r] = fmaf(p0[r], C, mnC);
#pragma unroll
  for (int r = 0; r < 16; ++r) p1[r] = fmaf(p1[r], C, mnC);
#pragma unroll
  for (int r = 0; r < 16; ++r) p0[r] = __builtin_amdgcn_exp2f(p0[r]);
}
__device__ __forceinline__ void finishSM(f32x16& p0, f32x16& p1, float alpha, float& l_reg, bf16x8& pa0, bf16x8& pa1, bf16x8& pa2, bf16x8& pa3) {
#pragma unroll
  for (int r = 0; r < 16; ++r) p1[r] = __builtin_amdgcn_exp2f(p1[r]);
  float ps = 0;
#pragma unroll
  for (int r = 0; r < 16; ++r) ps += p0[r];
#pragma unroll
  for (int r = 0; r < 16; ++r) ps += p1[r];
  { auto rr = __builtin_amdgcn_permlane32_swap(__float_as_uint(ps), __float_as_uint(ps), false, false);
    ps = __uint_as_float(rr[0]) + __uint_as_float(rr[1]); }
  l_reg = l_reg * alpha + ps;
#define PK4(P, BASE, OUT) do { unsigned a0 = cvtpk(P[BASE + 0], P[BASE + 1]), a1 = cvtpk(P[BASE + 2], P[BASE + 3]);   \
    unsigned b0 = cvtpk(P[BASE + 4], P[BASE + 5]), b1 = cvtpk(P[BASE + 6], P[BASE + 7]);                              \
    auto r0 = __builtin_amdgcn_permlane32_swap(a0, b0, false, false); auto r1 = __builtin_amdgcn_permlane32_swap(a1, b1, false, false); \
    u32x4 w = {r0[0], r1[0], r0[1], r1[1]}; OUT = *reinterpret_cast<bf16x8*>(&w); } while (0)
  PK4(p0, 0, pa0); PK4(p0, 8, pa1); PK4(p1, 0, pa2); PK4(p1, 8, pa3);
#undef PK4
}
__device__ __forceinline__ void qkt(f32x16& p0, f32x16& p1, const char* Ks, const bf16x8* qr, int r32, int hi, int kcol) {
  p0 = f32x16{}; p1 = f32x16{};
#pragma unroll
  for (int d0 = 0; d0 < 4; ++d0) { const int cb = kcol + (d0 * 16 + hi * 8) * 2;
    const bf16x8 b0 = *reinterpret_cast<const bf16x8*>(Ks + KSWZ(r32, cb));
    const bf16x8 b1 = *reinterpret_cast<const bf16x8*>(Ks + KSWZ(32 + r32, cb));
    p0 = __builtin_amdgcn_mfma_f32_32x32x16_bf16(b0, qr[d0], p0, 0, 0, 0);
    p1 = __builtin_amdgcn_mfma_f32_32x32x16_bf16(b1, qr[d0], p1, 0, 0, 0); }
}
__device__ __forceinline__ int v_st(int k, int c) { const int kk = (k & ~0xC) | ((k & 4) << 1) | ((k & 8) >> 1); return ((kk >> 3) * 4 + (c >> 5)) * 512 + ((kk & 7) * 32 + (c & 31)) * 2; }
__device__ __forceinline__ int v_rd_base(int lane) { return ((lane & 3) << 3) | (((lane >> 2) & 3) << 6) | (((lane >> 4) & 1) << 5) | (((lane >> 5) & 1) << 8); }
constexpr int v_rd_off(int d0, int ks, int half) { return d0 * 512 + ks * 4096 + half * 2048; }
template <int OFF> __device__ __forceinline__ s16x4 tr_read(int vb) {
  s16x4 r; asm volatile("ds_read_b64_tr_b16 %0, %1 offset:%2" : "=&v"(r) : "v"(vb), "i"(OFF) : "memory"); return r;
}
template <int D0> __device__ __forceinline__ void pv_one(f32x16& od, int vb, bf16x8 pa0, bf16x8 pa1, bf16x8 pa2, bf16x8 pa3) {
  const s16x4 l0 = tr_read<v_rd_off(D0, 0, 0)>(vb), h0 = tr_read<v_rd_off(D0, 0, 1)>(vb), l1 = tr_read<v_rd_off(D0, 1, 0)>(vb), h1 = tr_read<v_rd_off(D0, 1, 1)>(vb);
  const s16x4 l2 = tr_read<v_rd_off(D0, 2, 0)>(vb), h2 = tr_read<v_rd_off(D0, 2, 1)>(vb), l3 = tr_read<v_rd_off(D0, 3, 0)>(vb), h3 = tr_read<v_rd_off(D0, 3, 1)>(vb);
  asm volatile("s_waitcnt lgkmcnt(0)" ::: "memory"); SBAR();
#define PK(L, H) (bf16x8){L[0], L[1], L[2], L[3], H[0], H[1], H[2], H[3]}
  od = __builtin_amdgcn_mfma_f32_32x32x16_bf16(pa0, PK(l0, h0), od, 0, 0, 0);
  od = __builtin_amdgcn_mfma_f32_32x32x16_bf16(pa1, PK(l1, h1), od, 0, 0, 0);
  od = __builtin_amdgcn_mfma_f32_32x32x16_bf16(pa2, PK(l2, h2), od, 0, 0, 0);
  od = __builtin_amdgcn_mfma_f32_32x32x16_bf16(pa3, PK(l3, h3), od, 0, 0, 0);
#undef PK
}
__device__ __forceinline__ void pv_d0(f32x16* o, int vb, bf16x8 pa0, bf16x8 pa1, bf16x8 pa2, bf16x8 pa3) {
  pv_one<0>(o[0], vb, pa0, pa1, pa2, pa3); pv_one<1>(o[1], vb, pa0, pa1, pa2, pa3); pv_one<2>(o[2], vb, pa0, pa1, pa2, pa3); pv_one<3>(o[3], vb, pa0, pa1, pa2, pa3);
}

template <int VAR>
__device__ __forceinline__ void attn_unit(const bf16_t* __restrict__ Qb, const bf16_t* __restrict__ Kh, const bf16_t* __restrict__ Vh, int nkeys,
                                          bf16_t* __restrict__ Ob, float lam, float osc, const float* __restrict__ sg, char* lds, const int tid) {
  const int wid = __builtin_amdgcn_readfirstlane(tid >> 6), lane = tid & 63, r32 = lane & 31, hi = lane >> 5;
  const int comp = wid >> 2, qw = wid & 3, kcol = comp * 128;
  char* K_lds = lds; char* V_lds = lds + 2 * SHM_K;
  float* ws = (float*)(lds + 2 * SHM_K + 3 * SHM_V) + wid * 64; float* li_l = ws; float* al_l = ws + 32;
  float m_reg = -1e30f, l_reg = 0; f32x16 o[4] = {}; bf16x8 qr[4];
  const bf16_t* Qw = Qb + (long)(qw * QBLK + r32) * LDQ + comp * 64 + hi * 8;
#pragma unroll
  for (int d0 = 0; d0 < 4; ++d0) qr[d0] = *reinterpret_cast<const bf16x8*>(Qw + d0 * 16);
  const int sr = tid >> 4, sc = (tid & 15) * 8, vst0 = v_st(sr, sc), vst1 = v_st(32 + sr, sc);
  const int vb0 = (int)(uintptr_t)V_lds + v_rd_base(lane);
  bf16x8 sk0 = {}, sk1 = {}, sv0 = {}, sv1 = {};
#define LOADK(t) do { if constexpr (!(VAR & 8)) { sk0 = *reinterpret_cast<const bf16x8*>(&Kh[(long)((t) * KVBLK + sr) * LDQ + sc]); sk1 = *reinterpret_cast<const bf16x8*>(&Kh[(long)((t) * KVBLK + 32 + sr) * LDQ + sc]); } } while (0)
#define LOADV(t) do { if constexpr (!(VAR & 8)) { sv0 = *reinterpret_cast<const bf16x8*>(&Vh[(long)((t) * KVBLK + sr) * LDQ + sc]); sv1 = *reinterpret_cast<const bf16x8*>(&Vh[(long)((t) * KVBLK + 32 + sr) * LDQ + sc]); } } while (0)
#define WRITEK(slot) do { if constexpr (!(VAR & 8)) { *(bf16x8*)(K_lds + (slot) * SHM_K + KSWZ(sr, sc * 2)) = sk0; *(bf16x8*)(K_lds + (slot) * SHM_K + KSWZ(32 + sr, sc * 2)) = sk1; } } while (0)
#define WRITEV(off) do { if constexpr (!(VAR & 8)) { *(bf16x8*)(V_lds + (off) + vst0) = sv0; *(bf16x8*)(V_lds + (off) + vst1) = sv1; } } while (0)
#define VMW() asm volatile("s_waitcnt vmcnt(0)" ::: "memory")
#define QKT(P0, P1, KS) do { if constexpr (VAR & 4) { P0 = f32x16{}; P1 = f32x16{}; asm volatile("" : "+v"(P0), "+v"(P1)); } else qkt(P0, P1, KS, qr, r32, hi, kcol); } while (0)
#define PSM(P0, P1, MN, AL) do { if constexpr (VAR & 1) { MN = m_reg; AL = 1.f; asm volatile("" : "+v"(P0), "+v"(P1)); } else partialSM(P0, P1, m_reg, MN, AL); } while (0)
#define FSM(P0, P1, AL) do { if constexpr (VAR & 1) { asm volatile("" : "+v"(P0), "+v"(P1)); pa0 = __builtin_bit_cast(bf16x8, (f32x4){P0[0], P0[1], P0[2], P0[3]}); pa1 = __builtin_bit_cast(bf16x8, (f32x4){P0[4], P0[5], P0[6], P0[7]}); pa2 = __builtin_bit_cast(bf16x8, (f32x4){P1[0], P1[1], P1[2], P1[3]}); pa3 = __builtin_bit_cast(bf16x8, (f32x4){P1[4], P1[5], P1[6], P1[7]}); } else finishSM(P0, P1, AL, l_reg, pa0, pa1, pa2, pa3); } while (0)
#define PV(OFF) do { if constexpr (VAR & 2) { asm volatile("" : "+v"(pa0), "+v"(pa1), "+v"(pa2), "+v"(pa3)); } else pv_d0(o, vb0 + (OFF), pa0, pa1, pa2, pa3); } while (0)
#define RESC(a) do { if (__any((a) < 1.f)) { if (hi == 0) al_l[r32] = (a); asm volatile("s_waitcnt lgkmcnt(0)" ::: "memory"); \
    _Pragma("unroll") for (int d = 0; d < 4; ++d) _Pragma("unroll") for (int r = 0; r < 16; ++r) o[d][r] *= al_l[crow(r, hi)]; } } while (0)
  f32x16 pA0, pA1, pB0, pB1; float mnA, mnB, alA, alB; bf16x8 pa0, pa1, pa2, pa3; const int NT = nkeys / KVBLK;
  LOADK(0); VMW(); WRITEK(0); LOADK(1); LOADV(0);
  __syncthreads();
  if (comp == 1) __syncthreads();
  VMW(); WRITEK(1); WRITEV(0);
  SBAR(); QKT(pA0, pA1, K_lds); SBAR();
  __syncthreads();
  LOADK(2); LOADV(1); SBAR();
  PSM(pA0, pA1, mnA, alA);
  __syncthreads();
  int va = 0, vb = SHM_V, vc = 2 * SHM_V;
  for (int j = 1; j + 1 < NT; j += 2) {
    VMW(); WRITEK(0); WRITEV(vb);
    SBAR(); QKT(pB0, pB1, K_lds + SHM_K);
    FSM(pA0, pA1, alA); SBAR();
    __syncthreads();
    LOADK(j + 2); LOADV(j + 1); SBAR();
    PV(va); PSM(pB0, pB1, mnB, alB);
    RESC(alB);
    __syncthreads();
    VMW(); WRITEK(1); WRITEV(vc);
    SBAR(); QKT(pA0, pA1, K_lds);
    FSM(pB0, pB1, alB); SBAR();
    __syncthreads();
    if (j + 3 < NT) LOADK(j + 3);
    LOADV(j + 2); SBAR();
    PV(vb); PSM(pA0, pA1, mnA, alA);
    RESC(alA);
    __syncthreads();
    { const int t = va; va = vc; vc = vb; vb = t; }
  }
  VMW(); WRITEV(vb);
  SBAR(); QKT(pB0, pB1, K_lds + SHM_K);
  FSM(pA0, pA1, alA); SBAR();
  __syncthreads();
  PV(va); PSM(pB0, pB1, mnB, alB);
  RESC(alB);
  __syncthreads();
  FSM(pB0, pB1, alB); SBAR();
  PV(vb);
  if (comp == 0) __syncthreads();
  if (hi == 0) li_l[r32] = l_reg; asm volatile("s_waitcnt lgkmcnt(0)" ::: "memory");
  float rli[16];
#pragma unroll
  for (int r = 0; r < 16; ++r) rli[r] = __builtin_amdgcn_rcpf(li_l[crow(r, hi)]);
  __syncthreads();
  float* XO = (float*)lds + qw * (32 * 128);
  if (comp == 1) {
#pragma unroll
    for (int r = 0; r < 16; ++r)
#pragma unroll
      for (int d0 = 0; d0 < 4; ++d0) XO[crow(r, hi) * 128 + d0 * 32 + r32] = o[d0][r] * rli[r];
  }
  __syncthreads();
  if (comp == 0) {
    float ss[16];
#pragma unroll
    for (int r = 0; r < 16; ++r) { float s = 0.f;
#pragma unroll
      for (int d0 = 0; d0 < 4; ++d0) { const float v = o[d0][r] * rli[r] - lam * XO[crow(r, hi) * 128 + d0 * 32 + r32]; o[d0][r] = v; s += v * v; }
      ss[r] = s; }
#pragma unroll
    for (int r = 0; r < 16; ++r) { float s = ss[r]; s += swz_xor<1>(s); s += swz_xor<2>(s); s += swz_xor<4>(s); s += swz_xor<8>(s); s += swz_xor<16>(s);
      ss[r] = osc / sqrtf(s * (1.0f / 128.0f) + EPS); }
    float gam[4];
#pragma unroll
    for (int d0 = 0; d0 < 4; ++d0) gam[d0] = sg[d0 * 32 + r32];
    asm volatile("s_waitcnt lgkmcnt(0)" ::: "memory");
    bf16_t* stg = (bf16_t*)XO;
#pragma unroll
    for (int r = 0; r < 16; ++r)
#pragma unroll
      for (int d0 = 0; d0 < 4; ++d0) stg[crow(r, hi) * 128 + d0 * 32 + r32] = (bf16_t)(cvtpk(o[d0][r] * ss[r] * gam[d0], 0.f) & 0xffffu);
    asm volatile("s_waitcnt lgkmcnt(0)" ::: "memory");
#pragma unroll
    for (int i = 0; i < 8; ++i) { const int row = i * 4 + (lane >> 4), ch = lane & 15; const u32x4 v = *(const u32x4*)(stg + row * 128 + ch * 8);
      if constexpr (VAR & 16) { asm volatile("" :: "v"(v.x), "v"(v.y), "v"(v.z), "v"(v.w)); } else *(u32x4*)(Ob + (long)(qw * QBLK + row) * LDO + ch * 8) = v; }
  }
  __syncthreads();
#undef LOADK
#undef LOADV
#undef WRITEK
#undef WRITEV
#undef VMW
#undef QKT
#undef PSM
#undef FSM
#undef PV
#undef RESC
}
#undef KSWZ
#undef SBAR
}
namespace att2 {
using att::crow; using att::v_st; using att::v_rd_base; using att::v_rd_off;
constexpr int NW = 8, QBLK = 32, KVBLK = 64, LDQ = 512, LDO = KCAT, SHM_K = 16384, SHM_V = 16384;
constexpr float THRL = 8.0f;
#ifndef ATT_STAGGER
#define ATT_STAGGER 1
#endif
typedef short v4i16_t __attribute__((ext_vector_type(4)));
typedef __attribute__((address_space(3))) const char* lds_cptr;
typedef __attribute__((address_space(3))) char* lds_ptr;
#define SBAR() __builtin_amdgcn_sched_barrier(0)
#define KSWZ(row, colB) ((row) * 256 + ((colB) ^ (((row) & 7) << 4)))
__device__ __forceinline__ s16x4 vtr(lds_cptr p) { return __builtin_bit_cast(s16x4, __builtin_amdgcn_ds_read_tr16_b64_v4i16((__attribute__((address_space(3))) v4i16_t*)p)); }
__device__ __forceinline__ bf16x8 ldk(lds_cptr p) { return *(const __attribute__((address_space(3))) bf16x8*)p; }
#define MF(D, A, B, C) do { if constexpr (VAR & 4) { asm volatile("" : "+v"(D)); } else D = __builtin_amdgcn_mfma_f32_32x32x16_bf16(A, B, C, 0, 0, 0); } while (0)
#define VF(L, H) (bf16x8){L[0], L[1], L[2], L[3], H[0], H[1], H[2], H[3]}

__device__ __forceinline__ int vkey(int g) { const int s_ = g >> 5, kk = ((s_ >> 2) << 3) | ((g >> 2) & 7); return (kk & ~0xC) | ((kk & 4) << 1) | ((kk & 8) >> 1); }
template <int VAR>
__device__ __forceinline__ void attn_unit(const bf16_t* __restrict__ Qb, const bf16_t* __restrict__ Kh, const bf16_t* __restrict__ Vh, int nkeys,
                                          bf16_t* __restrict__ Ob, float lam, float osc, const float* __restrict__ sg, char* lds, const int tid) {
  const int wid = __builtin_amdgcn_readfirstlane(tid >> 6), lane = tid & 63, r32 = lane & 31, hi = lane >> 5;
  const int comp = wid >> 2, qw = wid & 3, kcol = comp * 128;
  const lds_ptr L3 = (lds_ptr)(unsigned)(uintptr_t)lds;
  float* ws = (float*)(lds + 3 * SHM_K + 3 * SHM_V) + wid * 64; float* li_l = ws; float* al_l = ws + 32;
  float mhat = 0.f, l_reg = 0.f; f32x16 o[4] = {}; bf16x8 qr[4]; f32x16 negm = {};
  const bf16_t* Qw = Qb + (long)(qw * QBLK + r32) * LDQ + comp * 64 + hi * 8;
#pragma unroll
  for (int d0 = 0; d0 < 4; ++d0) qr[d0] = *reinterpret_cast<const bf16x8*>(Qw + d0 * 16);
  const int sr = tid >> 4, sc = (tid & 15) * 8;
  const int kr0 = 4 * wid + (lane >> 4), kr1 = kr0 + 32;
  const bf16_t* ksrc0 = Kh + (long)kr0 * LDQ + (((lane & 15) ^ (kr0 & 7)) << 3); const bf16_t* ksrc1 = Kh + (long)kr1 * LDQ + (((lane & 15) ^ (kr1 & 7)) << 3);
  const int g0_ = 64 * wid + lane, g1_ = g0_ + 512;
  const int vk0 = vkey(g0_), vk1 = vkey(g1_);
  const bf16_t* vsrc0 = Vh + (long)vk0 * LDQ + ((g0_ >> 5) & 3) * 32 + (g0_ & 3) * 8; const bf16_t* vsrc1 = Vh + (long)vk1 * LDQ + ((g1_ >> 5) & 3) * 32 + (g1_ & 3) * 8;
  const unsigned kd0 = (unsigned)(uintptr_t)lds + wid * 1024, kd1 = kd0 + 8192, vd0 = (unsigned)(uintptr_t)lds + 3 * SHM_K + wid * 1024, vd1 = vd0 + 8192;
  lds_cptr kq[4];
#pragma unroll
  for (int d0 = 0; d0 < 4; ++d0) kq[d0] = L3 + r32 * 256 + ((kcol + d0 * 32 + hi * 16) ^ ((r32 & 7) << 4));
  const lds_cptr vp0 = L3 + 3 * SHM_K + v_rd_base(lane);
#define GLDS(src, dst) __builtin_amdgcn_global_load_lds((const unsigned*)(src), (__attribute__((address_space(3))) unsigned*)(dst), 16, 0, 0)
#define DMAK(t, slot) do { if constexpr (!(VAR & 8)) { GLDS(ksrc0 + (long)(t) * KVBLK * LDQ, (unsigned)__builtin_amdgcn_readfirstlane(kd0 + (slot) * SHM_K)); GLDS(ksrc1 + (long)(t) * KVBLK * LDQ, (unsigned)__builtin_amdgcn_readfirstlane(kd1 + (slot) * SHM_K)); } } while (0)
#define DMAV(t, off) do { if constexpr (!(VAR & 8)) { GLDS(vsrc0 + (long)(t) * KVBLK * LDQ, (unsigned)__builtin_amdgcn_readfirstlane(vd0 + (off))); GLDS(vsrc1 + (long)(t) * KVBLK * LDQ, (unsigned)__builtin_amdgcn_readfirstlane(vd1 + (off))); } } while (0)
#ifndef ATT_PRIO
#define ATT_PRIO 1
#endif
#define PRIO(x) do { if (ATT_PRIO == 1) __builtin_amdgcn_s_setprio(x); } while (0)
#define PRIO1(x) do { if (ATT_PRIO == 2) __builtin_amdgcn_s_setprio(x); } while (0)
#define VMW() asm volatile("s_waitcnt vmcnt(0)" ::: "memory")
#define BARW(n) do { asm volatile("s_waitcnt vmcnt(" #n ") lgkmcnt(0)" ::: "memory"); if constexpr (!(VAR & 32)) __builtin_amdgcn_s_barrier(); asm volatile("" ::: "memory"); } while (0)
  f32x16 pA0, pA1, pB0, pB1; u32x4 pw0 = {}, pw1 = {}, pw2 = {}, pw3 = {}; const int NT = nkeys / KVBLK; bool resc = false;
#define KF(KOFF, d0, half) ldk(kq[d0] + (KOFF) + 8192 * (half))
#define PKA(P, B, A0, A1) do { if constexpr (!(VAR & 1)) { A0 = cvt2bf(P[B + 0], P[B + 1]); A1 = cvt2bf(P[B + 2], P[B + 3]); sacc += P[B + 0]; sacc += P[B + 1]; sacc += P[B + 2]; sacc += P[B + 3]; } } while (0)
#define PKB(P, B, A0, A1, PW) do { if constexpr (!(VAR & 1)) { const unsigned b0_ = cvt2bf(P[B + 4], P[B + 5]), b1_ = cvt2bf(P[B + 6], P[B + 7]); \
    auto r0_ = __builtin_amdgcn_permlane32_swap(A0, b0_, false, false); auto r1_ = __builtin_amdgcn_permlane32_swap(A1, b1_, false, false); \
    PW = (u32x4){r0_[0], r1_[0], r0_[1], r1_[1]}; sacc += P[B + 4]; sacc += P[B + 5]; sacc += P[B + 6]; sacc += P[B + 7]; } } while (0)
#define VRD(VOFF, ks, d0, LO, HI) do { LO = vtr(vp0 + (VOFF) + v_rd_off(d0, ks, 0)); HI = vtr(vp0 + (VOFF) + v_rd_off(d0, ks, 1)); } while (0)
#define PAF(k) __builtin_bit_cast(bf16x8, pw##k)
#define EX(X, i) do { if constexpr (!(VAR & 2)) X[i] = __builtin_amdgcn_exp2f(X[i]); } while (0)
#define PIN2(X, Y) asm volatile("" : "+v"(X), "+v"(Y))
#define H1(C0, C1, P0, P1, KOFF, VOFF, FIN) do { \
    float sacc = 0.f; unsigned a0_ = 0, a1_ = 0; s16x4 l0, h0, l1, h1; \
    bf16x8 f0 = KF(KOFF, 0, 0), f1 = KF(KOFF, 0, 1), f2 = KF(KOFF, 1, 0); SBAR(); \
    MF(C0, f0, qr[0], negm); { f0 = KF(KOFF, 1, 1); if (FIN) { EX(P1, 8); PKA(P0, 0, a0_, a1_); PIN2(P0, P1); } } SBAR(); \
    MF(C1, f1, qr[0], negm); { f1 = KF(KOFF, 2, 0); if (FIN) { EX(P1, 9); PKB(P0, 0, a0_, a1_, pw0); PIN2(P0, P1); } } SBAR(); \
    MF(C0, f2, qr[1], C0);   { f2 = KF(KOFF, 2, 1); if (FIN) { VRD(VOFF, 0, 0, l0, h0); EX(P1, 10); PKA(P0, 8, a0_, a1_); PIN2(P0, P1); } } SBAR(); \
    MF(C1, f0, qr[1], C1);   { f0 = KF(KOFF, 3, 0); if (FIN) { VRD(VOFF, 0, 1, l1, h1); EX(P1, 11); PKB(P0, 8, a0_, a1_, pw1); PIN2(P0, P1); } } SBAR(); \
    if (FIN) { MF(o[0], PAF(0), VF(l0, h0), o[0]); VRD(VOFF, 0, 2, l0, h0); EX(P1, 12); PKA(P1, 0, a0_, a1_); PIN2(P0, P1); } SBAR(); \
    MF(C0, f1, qr[2], C0);   { f1 = KF(KOFF, 3, 1); if (FIN) { EX(P1, 13); PKB(P1, 0, a0_, a1_, pw2); PIN2(P0, P1); } } SBAR(); \
    if (FIN) { MF(o[1], PAF(0), VF(l1, h1), o[1]); VRD(VOFF, 0, 3, l1, h1); EX(P1, 14); PIN2(P0, P1); } SBAR(); \
    MF(C1, f2, qr[2], C1);   { if (FIN) { EX(P1, 15); PKA(P1, 8, a0_, a1_); PIN2(P0, P1); } } SBAR(); \
    if (FIN) { MF(o[2], PAF(0), VF(l0, h0), o[2]); } SBAR(); \
    MF(C0, f0, qr[3], C0);   { if (FIN) PKB(P1, 8, a0_, a1_, pw3); } SBAR(); \
    if (FIN) { MF(o[3], PAF(0), VF(l1, h1), o[3]); } SBAR(); \
    MF(C1, f1, qr[3], C1); SBAR(); \
    if (FIN) { auto rr_ = __builtin_amdgcn_permlane32_swap(__float_as_uint(sacc), __float_as_uint(sacc), false, false); l_reg += __uint_as_float(rr_[0]) + __uint_as_float(rr_[1]); } \
  } while (0)
#define MX3(a, b, c) ((VAR & 2) ? (a) : fmaxf(fmaxf((a), (b)), (c)))
#define H2(C0, C1, VOFF, DOPV, FIRST) do { \
    s16x4 l0, h0, l1, h1, l2, h2; float ma, mb, rm; \
    if (DOPV) { VRD(VOFF, 1, 0, l0, h0); VRD(VOFF, 1, 1, l1, h1); VRD(VOFF, 1, 2, l2, h2); } SBAR(); \
    if (DOPV) { MF(o[0], PAF(1), VF(l0, h0), o[0]); VRD(VOFF, 1, 3, l0, h0); } ma = MX3(C0[0], C0[1], C1[0]); mb = MX3(C0[2], C0[3], C1[1]); ma = MX3(ma, C1[2], C1[3]); mb = MX3(mb, C0[4], C0[5]); SBAR(); \
    if (DOPV) { MF(o[1], PAF(1), VF(l1, h1), o[1]); VRD(VOFF, 2, 0, l1, h1); } ma = MX3(ma, C0[6], C0[7]); mb = MX3(mb, C1[4], C1[5]); ma = MX3(ma, C1[6], C1[7]); mb = MX3(mb, C0[8], C0[9]); SBAR(); \
    if (DOPV) { MF(o[2], PAF(1), VF(l2, h2), o[2]); VRD(VOFF, 2, 1, l2, h2); } ma = MX3(ma, C0[10], C0[11]); mb = MX3(mb, C1[8], C1[9]); ma = MX3(ma, C1[10], C1[11]); mb = MX3(mb, C0[12], C0[13]); SBAR(); \
    if (DOPV) { MF(o[3], PAF(1), VF(l0, h0), o[3]); VRD(VOFF, 2, 2, l0, h0); } ma = MX3(ma, C0[14], C0[15]); mb = MX3(mb, C1[12], C1[13]); ma = MX3(ma, C1[14], C1[15]); rm = fmaxf(ma, mb); SBAR(); \
    if (DOPV) { MF(o[0], PAF(2), VF(l1, h1), o[0]); VRD(VOFF, 2, 3, l1, h1); } \
    { auto rr_ = __builtin_amdgcn_permlane32_swap(__float_as_uint(rm), __float_as_uint(rm), false, false); rm = fmaxf(__uint_as_float(rr_[0]), __uint_as_float(rr_[1])); } SBAR(); \
    resc = false; \
    if (FIRST || __builtin_expect(__any(rm > THRL), 0)) { const float dl = FIRST ? rm : fmaxf(rm, 0.f); mhat += dl; \
      _Pragma("unroll") for (int r = 0; r < 16; ++r) { C0[r] -= dl; C1[r] -= dl; } \
      _Pragma("unroll") for (int r = 0; r < 16; ++r) negm[r] = -mhat; \
      if (!(FIRST)) { const float f = __builtin_amdgcn_exp2f(-dl); l_reg *= f; if (hi == 0) al_l[r32] = f; resc = true; } } \
    SBAR(); \
    if (DOPV) { MF(o[1], PAF(2), VF(l2, h2), o[1]); VRD(VOFF, 3, 0, l2, h2); } EX(C0, 0); EX(C0, 1); EX(C0, 2); EX(C0, 3); PIN2(C0, C1); SBAR(); \
    if (DOPV) { MF(o[2], PAF(2), VF(l0, h0), o[2]); VRD(VOFF, 3, 1, l0, h0); } EX(C0, 4); EX(C0, 5); EX(C0, 6); EX(C0, 7); PIN2(C0, C1); SBAR(); \
    if (DOPV) { MF(o[3], PAF(2), VF(l1, h1), o[3]); VRD(VOFF, 3, 2, l1, h1); } EX(C0, 8); EX(C0, 9); EX(C0, 10); EX(C0, 11); PIN2(C0, C1); SBAR(); \
    if (DOPV) { MF(o[0], PAF(3), VF(l2, h2), o[0]); VRD(VOFF, 3, 3, l2, h2); } EX(C0, 12); EX(C0, 13); EX(C0, 14); EX(C0, 15); PIN2(C0, C1); SBAR(); \
    if (DOPV) { MF(o[1], PAF(3), VF(l0, h0), o[1]); } EX(C1, 0); EX(C1, 1); EX(C1, 2); EX(C1, 3); PIN2(C0, C1); SBAR(); \
    if (DOPV) { MF(o[2], PAF(3), VF(l1, h1), o[2]); } EX(C1, 4); EX(C1, 5); EX(C1, 6); EX(C1, 7); PIN2(C0, C1); SBAR(); \
    if (DOPV) { MF(o[3], PAF(3), VF(l2, h2), o[3]); } SBAR(); \
    if (resc) { asm volatile("s_waitcnt lgkmcnt(0)" ::: "memory"); \
      _Pragma("unroll") for (int d = 0; d < 4; ++d) _Pragma("unroll") for (int r = 0; r < 16; ++r) o[d][r] *= al_l[crow(r, hi)]; } \
  } while (0)
#define PVONLY(VOFF) do { _Pragma("unroll") for (int ks = 0; ks < 4; ++ks) _Pragma("unroll") for (int d0 = 0; d0 < 4; ++d0) { s16x4 l_, h_; VRD(VOFF, ks, d0, l_, h_); \
      const bf16x8 pa_ = ks == 0 ? PAF(0) : ks == 1 ? PAF(1) : ks == 2 ? PAF(2) : PAF(3); MF(o[d0], pa_, VF(l_, h_), o[d0]); } } while (0)

  DMAK(0, 0); DMAK(1, 1); DMAV(0, 0);
  BARW(0);
  if (ATT_STAGGER && comp == 1) __builtin_amdgcn_s_barrier();
  H1(pA0, pA1, pB0, pB1, 0, 0, false);
  BARW(0);
  DMAK(2, 2); DMAV(1, SHM_V); SBAR();
  H2(pA0, pA1, 0, false, true);
  BARW(4);
  int va = 0, vb = SHM_V, vc = 2 * SHM_V;
  for (int j = 1; j + 1 < NT; j += 2) {
    PRIO1(1); H1(pB0, pB1, pA0, pA1, vb, va, true); PRIO1(0);
    BARW(0);
    DMAK(j + 2, va >> 14); DMAV(j + 1, vc); SBAR();
    PRIO(1); H2(pB0, pB1, va, true, false); PRIO(0);
    BARW(4);
    PRIO1(1); H1(pA0, pA1, pB0, pB1, vc, vb, true); PRIO1(0);
    BARW(0);
    if (j + 3 < NT) DMAK(j + 3, vb >> 14);
    DMAV(j + 2, va); SBAR();
    PRIO(1); H2(pA0, pA1, vb, true, false); PRIO(0);
    BARW(4);
    { const int t = va; va = vc; vc = vb; vb = t; }
  }
  H1(pB0, pB1, pA0, pA1, vb, va, true);
  BARW(0);
  H2(pB0, pB1, va, true, false);
  BARW(0);
  { float sacc = 0.f; unsigned a0_ = 0, a1_ = 0;
    EX(pB1, 8); EX(pB1, 9); EX(pB1, 10); EX(pB1, 11); EX(pB1, 12); EX(pB1, 13); EX(pB1, 14); EX(pB1, 15);
    PKA(pB0, 0, a0_, a1_); PKB(pB0, 0, a0_, a1_, pw0); PKA(pB0, 8, a0_, a1_); PKB(pB0, 8, a0_, a1_, pw1); PKA(pB1, 0, a0_, a1_); PKB(pB1, 0, a0_, a1_, pw2); PKA(pB1, 8, a0_, a1_); PKB(pB1, 8, a0_, a1_, pw3);
    auto rr_ = __builtin_amdgcn_permlane32_swap(__float_as_uint(sacc), __float_as_uint(sacc), false, false); l_reg += __uint_as_float(rr_[0]) + __uint_as_float(rr_[1]); }
  SBAR(); PVONLY(vb);
  if (ATT_STAGGER && comp == 0) { asm volatile("s_waitcnt lgkmcnt(0)" ::: "memory"); __builtin_amdgcn_s_barrier(); }
  if (hi == 0) li_l[r32] = l_reg; asm volatile("s_waitcnt lgkmcnt(0)" ::: "memory");
  float rli[16];
#pragma unroll
  for (int r = 0; r < 16; ++r) rli[r] = __builtin_amdgcn_rcpf(li_l[crow(r, hi)]);
  __syncthreads();
  float* XO = (float*)lds + qw * (32 * 128);
  if (comp == 1) {
#pragma unroll
    for (int r = 0; r < 16; ++r)
#pragma unroll
      for (int d0 = 0; d0 < 4; ++d0) XO[crow(r, hi) * 128 + d0 * 32 + r32] = o[d0][r] * rli[r];
  }
  __syncthreads();
  if (comp == 0) {
    float ss[16];
#pragma unroll
    for (int r = 0; r < 16; ++r) { float s = 0.f;
#pragma unroll
      for (int d0 = 0; d0 < 4; ++d0) { const float v = o[d0][r] * rli[r] - lam * XO[crow(r, hi) * 128 + d0 * 32 + r32]; o[d0][r] = v; s += v * v; }
      ss[r] = s; }
#pragma unroll
    for (int r = 0; r < 16; ++r) { float s = ss[r]; s += swz_xor<1>(s); s += swz_xor<2>(s); s += swz_xor<4>(s); s += swz_xor<8>(s); s += swz_xor<16>(s);
      ss[r] = osc / sqrtf(s * (1.0f / 128.0f) + EPS); }
    float gam[4];
#pragma unroll
    for (int d0 = 0; d0 < 4; ++d0) gam[d0] = sg[d0 * 32 + r32];
    asm volatile("s_waitcnt lgkmcnt(0)" ::: "memory");
    bf16_t* stg = (bf16_t*)XO;
#pragma unroll
    for (int r = 0; r < 16; ++r)
#pragma unroll
      for (int d0 = 0; d0 < 4; ++d0) stg[crow(r, hi) * 128 + d0 * 32 + r32] = (bf16_t)(cvt2bf(o[d0][r] * ss[r] * gam[d0], 0.f) & 0xffffu);
    asm volatile("s_waitcnt lgkmcnt(0)" ::: "memory");
#pragma unroll
    for (int i = 0; i < 8; ++i) { const int row = i * 4 + (lane >> 4), ch = lane & 15; const u32x4 v = *(const u32x4*)(stg + row * 128 + ch * 8);
      if constexpr (VAR & 16) { asm volatile("" :: "v"(v.x), "v"(v.y), "v"(v.z), "v"(v.w)); } else *(u32x4*)(Ob + (long)(qw * QBLK + row) * LDO + ch * 8) = v; }
  }
  __syncthreads();
#undef GLDS
#undef DMAK
#undef DMAV
#undef VMW
#undef PRIO
#undef PRIO1
#undef BARW
#undef KF
#undef PKA
#undef PKB
#undef H1
#undef VRD
#undef PAF
#undef MX3
#undef EX
#undef PIN2
#undef H2
#undef PVONLY
}
#undef SBAR
#undef KSWZ
#undef MF
#undef VF
}
typedef GAS unsigned gu32;
#define RLX_AGENT __ATOMIC_RELAXED, __HIP_MEMORY_SCOPE_AGENT
constexpr int PT_OFF = LDSCTL_OFF + 1024;
__device__ __forceinline__ unsigned long long ldptr(volatile LAS unsigned long long* PT, int i) {
    const unsigned long long v = PT[i];
    const unsigned lo = __builtin_amdgcn_readfirstlane((unsigned)v), hi = __builtin_amdgcn_readfirstlane((unsigned)(v >> 32));
    return ((unsigned long long)hi << 32) | lo;
}
#define XB_TMO      128
#define XB_XCNT(j)  (256  + 64 * (j))
#define XB_XSUB(j)  (1280 + 64 * (j))
#define XB_XGEN(j)  (2304 + 64 * (j))
#define XB_TOP      3328
#define XB_TOPGEN   3392
#define XCD_BAR_WORDS 3456
#define XB_SPIN_CAP (1u << 18)

__device__ __forceinline__ unsigned xb_ld(unsigned* p)              { return __hip_atomic_load(p, __ATOMIC_RELAXED, __HIP_MEMORY_SCOPE_AGENT); }
__device__ __forceinline__ unsigned xb_add(unsigned* p, unsigned v) { return __hip_atomic_fetch_add(p, v, __ATOMIC_RELAXED, __HIP_MEMORY_SCOPE_AGENT); }
__device__ __forceinline__ unsigned xb_xcc_id() { return (unsigned)__builtin_amdgcn_s_getreg((3 << 11) | 20) & 0xFu; }
#define XB_SPIN(cond, bar) do { unsigned _sp = 0; while (cond) { __builtin_amdgcn_s_sleep(1); \
    if ((++_sp & 255u) == 0u) { if (xb_ld(&(bar)[XB_TMO])) break; if (_sp > XB_SPIN_CAP) { atomicAdd(&(bar)[XB_TMO], 1u); break; } } } } while (0)

struct XcdBarrier {
    unsigned* bar; unsigned x;
    volatile LAS unsigned* st;
};

__device__ __forceinline__ XcdBarrier xcd_barrier_post(unsigned* bar, volatile LAS unsigned* st) {
    XcdBarrier b; b.bar = bar; b.x = xb_xcc_id(); b.st = st;
    if (threadIdx.x == 0) (void)xb_add(&bar[XB_XCNT(b.x)], 1u);
    return b;
}
__device__ __forceinline__ void xcd_barrier_complete(unsigned* bar, unsigned x, unsigned& nloc, unsigned& nx) {
    const unsigned G = gridDim.x * gridDim.y * gridDim.z;
    unsigned sum, cnt, mine, sp = 0u;
    for (;;) {
        sum = 0u; cnt = 0u; mine = 0u;
#pragma unroll
        for (unsigned j = 0; j < 16; ++j) { const unsigned c = xb_ld(&bar[XB_XCNT(j)]); sum += c; cnt += (c > 0u) ? 1u : 0u; mine = (j == x) ? c : mine; }
        if (sum == G) break;
        __builtin_amdgcn_s_sleep(1);
        if ((++sp & 255u) == 0u) { if (xb_ld(&bar[XB_TMO])) break; if (sp > XB_SPIN_CAP) { atomicAdd(&bar[XB_TMO], 1u); break; } }
    }
    nloc = mine > 0u ? mine : 1u; nx = cnt > 0u ? cnt : 1u;
}

__device__ __forceinline__ void xcd_barrier(const XcdBarrier& b) {
    asm volatile("s_waitcnt vmcnt(0)" ::: "memory");
    __syncthreads();
    if (threadIdx.x == 0) {
        unsigned* bar = b.bar;
        __builtin_amdgcn_s_waitcnt(0);
        unsigned nloc = b.st[0], nx = b.st[1];
        if (nloc == 0u) { xcd_barrier_complete(bar, b.x, nloc, nx); b.st[0] = nloc; b.st[1] = nx; }
        const unsigned old = xb_add(&bar[XB_XSUB(b.x)], 1u);
        const unsigned gen = old / nloc;
        if (old + 1u == (gen + 1u) * nloc) {
            __builtin_amdgcn_fence(__ATOMIC_RELEASE, "agent");
            asm volatile("s_waitcnt vmcnt(0)" ::: "memory");
            const unsigned og = xb_add(&bar[XB_TOP], 1u);
            const unsigned tg = og / nx;
            if (og + 1u == (tg + 1u) * nx) xb_add(&bar[XB_TOPGEN], 1u);
            else XB_SPIN(xb_ld(&bar[XB_TOPGEN]) == tg, bar);
            __builtin_amdgcn_fence(__ATOMIC_ACQUIRE, "agent");
            xb_add(&bar[XB_XGEN(b.x)], 1u);
            asm volatile("s_waitcnt vmcnt(0)" ::: "memory");
        } else {
            XB_SPIN(xb_ld(&bar[XB_XGEN(b.x)]) == gen, bar);
            __builtin_amdgcn_fence(__ATOMIC_ACQUIRE, "agent");
            asm volatile("s_waitcnt vmcnt(0)" ::: "memory");
        }
    }
    __syncthreads();
}
__device__ __forceinline__ float wave_sum(float v) {
    v += swz_xor<1>(v); v += swz_xor<2>(v); v += swz_xor<4>(v); v += swz_xor<8>(v); v += swz_xor<16>(v);
    auto rr = __builtin_amdgcn_permlane32_swap(__float_as_uint(v), __float_as_uint(v), false, false);
    return __uint_as_float(rr[0]) + __uint_as_float(rr[1]);
}
__device__ __forceinline__ unsigned pk2(float lo, float hi) { return cvt2bf(lo, hi); }

template <int MAP  >
__device__ __forceinline__ void transpose_item(const float* W, int Nsrc, int coff, bf16_t* WT, int ldw, int koff, int nblk, LAS float* scr, int item, int lane) {
    const int kb = item / nblk, nb = item % nblk, k0 = 64 * kb, n0 = 32 * nb;
    const int nd = n0 + (lane & 31); const int scol = MAP ? in_map(nd) : nd + coff;
    float wv[32];
#pragma unroll
    for (int i = 0; i < 32; ++i) wv[i] = W[(size_t)(k0 + 2 * i + (lane >> 5)) * Nsrc + scol];
#pragma unroll
    for (int i = 0; i < 32; ++i) scr[(2 * i + (lane >> 5)) * 33 + (lane & 31)] = wv[i];
    asm volatile("s_waitcnt lgkmcnt(0)" ::: "memory");
    const int c = lane & 7;
#pragma unroll
    for (int j = 0; j < 4; ++j) { const int n = (lane >> 3) + 8 * j; const LAS float* s = scr + (8 * c) * 33 + n;
        u32x4 o; o.x = pk2(s[0 * 33], s[1 * 33]); o.y = pk2(s[2 * 33], s[3 * 33]); o.z = pk2(s[4 * 33], s[5 * 33]); o.w = pk2(s[6 * 33], s[7 * 33]);
        *(u32x4*)(WT + (size_t)(n0 + n) * ldw + koff + k0 + 8 * c) = o; }
    asm volatile("s_waitcnt lgkmcnt(0)" ::: "memory");
}
struct WSrc { const float *w_in, *wo_f, *wo_a, *wo_c, *wo_p, *w_out, *w_up, *w_down; };
constexpr int IT_A = 16 * 208;
constexpr int IT_B0 = 4 * 32, IT_B1 = 8 * 32, IT_B2 = 4 * 32, IT_B3 = 4 * 32, IT_B4 = 16 * 32, IT_B5 = 16 * 88, IT_B6 = 16 * 88, IT_B7 = 44 * 32;
constexpr int ITU_CAT = IT_A, ITU_DN = ITU_CAT + IT_B0 + IT_B1 + IT_B2 + IT_B3 + IT_B4, ITU_UPG = ITU_DN + IT_B7, ITU_UPV = ITU_UPG + IT_B5, ITU_END = ITU_UPV + IT_B6;
struct WDst { bf16_t *wa, *wcat, *wout, *wdn, *wupg, *wupv; };
template <int MASK  >
__device__ __forceinline__ void convert_items(const WSrc& S, const WDst& D, LAS float* scr, int lo, int hi, int wi, int nw, int lane) {
    for (int it = lo + wi; it < hi; it += nw) { int r = it;
        if (MASK & 1) { if (r < IT_A) { transpose_item<1>(S.w_in, NIN, 0, D.wa, 1024, 0, 208, scr, r, lane); continue; } } r -= IT_A;
        if (MASK & 2) {
            if (r < IT_B0) { transpose_item<0>(S.wo_f, 1024, 0, D.wcat, KCAT, 0, 32, scr, r, lane); continue; } r -= IT_B0;
            if (r < IT_B1) { transpose_item<0>(S.wo_a, 1024, 0, D.wcat, KCAT, 256, 32, scr, r, lane); continue; } r -= IT_B1;
            if (r < IT_B2) { transpose_item<0>(S.wo_c, 1024, 0, D.wcat, KCAT, 768, 32, scr, r, lane); continue; } r -= IT_B2;
            if (r < IT_B3) { transpose_item<0>(S.wo_p, 1024, 0, D.wcat, KCAT, 1024, 32, scr, r, lane); continue; } r -= IT_B3;
            if (r < IT_B4) { transpose_item<0>(S.w_out, 1024, 0, D.wout, 1024, 0, 32, scr, r, lane); continue; } r -= IT_B4;
        } else r -= IT_B0 + IT_B1 + IT_B2 + IT_B3 + IT_B4;
        if (MASK & 4) { if (r < IT_B7) { transpose_item<0>(S.w_down, 1024, 0, D.wdn, DFF, 0, 32, scr, r, lane); continue; } } r -= IT_B7;
        if (MASK & 8) { if (r < IT_B5) { transpose_item<0>(S.w_up, 2 * DFF, DFF, D.wupg, 1024, 0, 88, scr, r, lane); continue; } } r -= IT_B5;
        if (MASK & 16) { if (r < IT_B6) transpose_item<0>(S.w_up, 2 * DFF, 0, D.wupv, 1024, 0, 88, scr, r, lane); }
    }
}

__device__ __forceinline__ void mod_phase(const float* c, const float* c_ctx, const float* ada_w, const float* ada_b, float* MOD, LAS unsigned char* lds, int vcu, int G, int tid, int wave, int lane) {
    LAS float* sil = (LAS float*)lds;
    LAS float* red = (LAS float*)(lds + 12288);
    for (int i = tid; i < 3072; i += 512) { const float v = i < 2048 ? c[i] : c_ctx[i - 2048]; sil[i] = v * sigm(v); }
    __syncthreads();
    for (int item = vcu; item < 192; item += G) {
        const int l = item / 96, n = (item % 96) * 64 + lane;
        const float* W = ada_w + (size_t)l * 1024 * 6144 + n;
        float a0 = 0.f, a1 = 0.f, a2 = 0.f;
        for (int k = wave * 128; k < wave * 128 + 128; k += 64) { float w[64];
#pragma unroll
            for (int i = 0; i < 64; ++i) w[i] = W[(size_t)(k + i) * 6144];
#pragma unroll
            for (int i = 0; i < 64; ++i) { a0 += sil[k + i] * w[i]; a1 += sil[1024 + k + i] * w[i]; a2 += sil[2048 + k + i] * w[i]; } }
        red[(wave * 3 + 0) * 64 + lane] = a0; red[(wave * 3 + 1) * 64 + lane] = a1; red[(wave * 3 + 2) * 64 + lane] = a2;
        __syncthreads();
        if (wave < 3) { float s = ada_b[l * 6144 + n];
#pragma unroll
            for (int w = 0; w < 8; ++w) s += red[(w * 3 + wave) * 64 + lane];
            MOD[(size_t)(l * 3 + wave) * 6144 + n] = s; }
        __syncthreads();
    }
}
__device__ __forceinline__ void tables_phase(float* ROPE, f32x2* TW, int gt, int NGT) {
    for (int i = gt; i < 192 * 16; i += NGT) { const int pos = i >> 4, f = i & 15; const float inv = powf(10000.0f, -(float)f / 16.0f); const float ang = (float)(pos < 128 ? pos : pos - 128) * inv;
        float s, c; sincosf(ang, &s, &c); ROPE[pos * 32 + f] = c; ROPE[pos * 32 + 16 + f] = s; }
    for (int i = gt; i < 8192; i += NGT) { float s, c; sincospif((float)i * (1.0f / 4096.0f), &s, &c); TW[i] = (f32x2){c, -s}; }
}

template <bool LATBF>
__device__ __forceinline__ void norm_phase(const void* src_lat_, const float* src_ctx, int nrows, const float* gamma, const float* mod, int shoff, int scoff, bf16_t* HX, int gw, int NGW, int lane,
                                           const float* slab = nullptr, int nsl = 0, const float* cgate = nullptr, float* ctx_out = nullptr) {
    for (int m0 = gw; m0 < nrows; m0 += 4 * NGW) {
        f32x4 v[4][4]; float s[4];
#pragma unroll
        for (int u = 0; u < 4; ++u) { const int m = m0 + u * NGW; s[u] = 0.f;
            if (m < nrows) {
                if (LATBF && m < ML) { const u32x2* xb = (const u32x2*)((const bf16_t*)src_lat_ + (size_t)m * DM);
#pragma unroll
                    for (int j = 0; j < 4; ++j) { const u32x2 w = xb[lane + 64 * j]; v[u][j] = (f32x4){__uint_as_float(w.x << 16), __uint_as_float(w.x & 0xffff0000u), __uint_as_float(w.y << 16), __uint_as_float(w.y & 0xffff0000u)}; } }
                else { const float* xr = m < ML ? (const float*)src_lat_ + (size_t)m * DM : src_ctx + (size_t)(m - ML) * DM;
#pragma unroll
                    for (int j = 0; j < 4; ++j) v[u][j] = ((const f32x4*)xr)[lane + 64 * j]; }
                if (slab && m >= ML) {
#pragma unroll
                    for (int j = 0; j < 4; ++j) { f32x4 a = {0.f, 0.f, 0.f, 0.f};
                        for (int sl = 0; sl < nsl; ++sl) a += ((const f32x4*)(slab + (size_t)sl * 512 * 1024 + (size_t)(m - ML) * DM))[lane + 64 * j];
                        v[u][j] += ((const f32x4*)cgate)[lane + 64 * j] * a; ((f32x4*)(ctx_out + (size_t)(m - ML) * DM))[lane + 64 * j] = v[u][j]; } } } }
#pragma unroll
        for (int u = 0; u < 4; ++u) { const int m = m0 + u * NGW; if (m < nrows) {
#pragma unroll
            for (int j = 0; j < 4; ++j) s[u] += (v[u][j].x * v[u][j].x + v[u][j].y * v[u][j].y) + (v[u][j].z * v[u][j].z + v[u][j].w * v[u][j].w);
            const float rstd = 1.0f / sqrtf(wave_sum(s[u]) * (1.0f / DM) + EPS);
            const float* md = mod + (m < SEQ ? 0 : m < ML ? 1 : 2) * 6144;
#pragma unroll
            for (int j = 0; j < 4; ++j) { const int col = 4 * lane + 256 * j;
                const f32x4 g = *(const f32x4*)(gamma + col), sc = *(const f32x4*)(md + scoff + col), sh = *(const f32x4*)(md + shoff + col);
                const f32x4 o = v[u][j] * rstd * g * (sc + 1.0f) + sh;
                u32x2 w; w.x = pk2(o.x, o.y); w.y = pk2(o.z, o.w); *(u32x2*)(HX + (size_t)m * DM + col) = w; } } }
    }
}
__device__ __forceinline__ void final_norm_phase(const bf16_t* xb, float* out, const float* gamma, int gw, int NGW, int lane) {
    for (int m0 = gw; m0 < ML; m0 += 4 * NGW) {
        f32x4 v[4][4];
#pragma unroll
        for (int u = 0; u < 4; ++u) { const int m = m0 + u * NGW; if (m < ML) { const u32x2* xr = (const u32x2*)(xb + (size_t)m * DM);
#pragma unroll
            for (int j = 0; j < 4; ++j) { const u32x2 w = xr[lane + 64 * j]; v[u][j] = (f32x4){__uint_as_float(w.x << 16), __uint_as_float(w.x & 0xffff0000u), __uint_as_float(w.y << 16), __uint_as_float(w.y & 0xffff0000u)}; } } }
#pragma unroll
        for (int u = 0; u < 4; ++u) { const int m = m0 + u * NGW; if (m < ML) { float s = 0.f;
#pragma unroll
            for (int j = 0; j < 4; ++j) s += (v[u][j].x * v[u][j].x + v[u][j].y * v[u][j].y) + (v[u][j].z * v[u][j].z + v[u][j].w * v[u][j].w);
            const float rstd = 1.0f / sqrtf(wave_sum(s) * (1.0f / DM) + EPS);
#pragma unroll
            for (int j = 0; j < 4; ++j) { const f32x4 g = *(const f32x4*)(gamma + 4 * lane + 256 * j); ((f32x4*)(out + (size_t)m * DM))[lane + 64 * j] = v[u][j] * rstd * g; } } }
    }
}

#define SWZ(row, colB) ((row) * 256 + ((colB) ^ (((row) & 7) << 4)))
__device__ __forceinline__ int crow_(int r, int hi) { return (r & 3) + 8 * (r >> 2) + 4 * hi; }
__device__ __forceinline__ bf16x8 pack_bf8(const float* v) { u32x4 w; w.x = pk2(v[0], v[1]); w.y = pk2(v[2], v[3]); w.z = pk2(v[4], v[5]); w.w = pk2(v[6], v[7]); return __builtin_bit_cast(bf16x8, w); }
__device__ __forceinline__ void fft_tables_phase(u32x4* FT, int gt, int NGT) {
    for (int i = gt; i < 4096; i += NGT) { const int ks = i >> 9, t = i & 511, wave = t >> 6, lane = t & 63, tr = wave >> 1, tc = wave & 1, r32 = lane & 31, hi = lane >> 5;
        float cv[8], sv[8], av[8], bv[8];
#pragma unroll
        for (int j = 0; j < 8; ++j) { const int idx = ((32 * tr + r32) * (16 * ks + 8 * hi + j)) & 127; float s, c; sincospif((float)idx * (1.0f / 64.0f), &s, &c); cv[j] = c; sv[j] = -s; }
#pragma unroll
        for (int j = 0; j < 8; ++j) { const int R = 32 * tr + r32, k = 16 * ks + 8 * hi + j, k2 = R & 63, ll = k & 63; float s, c; sincospif((float)((k2 * ll) & 63) * (1.0f / 32.0f), &s, &c);
            av[j] = (R < 64) ? ((k < 64) ? c : s) : ((k < 64) ? -s : c);
            const int m = 32 * tc + r32; float s2, c2; sincospif((float)((m * ll) & 63) * (1.0f / 32.0f), &s2, &c2); bv[j] = (k < 64) ? c2 : s2; }
        FT[i] = __builtin_bit_cast(u32x4, pack_bf8(cv)); FT[4096 + i] = __builtin_bit_cast(u32x4, pack_bf8(sv)); FT[8192 + i] = __builtin_bit_cast(u32x4, pack_bf8(av)); FT[12288 + i] = __builtin_bit_cast(u32x4, pack_bf8(bv)); }
}
__device__ __forceinline__ void fft1_phase(const bf16_t* UF, const f32x2* TW, const u32x4* FT, unsigned* FA, LAS unsigned char* lds, int vcu, int G, int tid, int wave, int lane) {
    const int tr = wave >> 1, tc = wave & 1, r32 = lane & 31, hi = lane >> 5;
    bf16x8 aRe[8], aIm[8];
#pragma unroll
    for (int ks = 0; ks < 8; ++ks) { aRe[ks] = __builtin_bit_cast(bf16x8, FT[ks * 512 + tid]); aIm[ks] = __builtin_bit_cast(bf16x8, FT[4096 + ks * 512 + tid]); }
    for (int item = vcu; item < 512; item += G) {
        const int b = item >> 8, g = (item >> 6) & 3, l2 = item & 63;
#pragma unroll
        for (int i = 0; i < 2; ++i) { const int q = tid + 512 * i, l1 = q >> 3, c8 = (q & 7) * 8;
            const u32x4 v = *(const u32x4*)(UF + (size_t)(b * SEQ + 64 * l1 + l2) * 256 + g * 64 + c8);
#pragma unroll
            for (int e = 0; e < 8; ++e) { const unsigned w = v[e >> 1]; *(LAS bf16_t*)(lds + SWZ(c8 + e, l1 * 2)) = (bf16_t)((e & 1) ? (w >> 16) : (w & 0xffffu)); } }
        __syncthreads();
        f32x16 re = {}, im = {};
#pragma unroll
        for (int ks = 0; ks < 8; ++ks) { const bf16x8 bx = *(const LAS bf16x8*)(lds + SWZ(32 * tc + r32, (16 * ks + 8 * hi) * 2));
            re = __builtin_amdgcn_mfma_f32_32x32x16_bf16(aRe[ks], bx, re, 0, 0, 0); im = __builtin_amdgcn_mfma_f32_32x32x16_bf16(aIm[ks], bx, im, 0, 0, 0); }
        unsigned* dst = FA + ((size_t)((b * 4 + g) * 64 + l2) * 128) * 64 + 32 * tc + r32;
#pragma unroll
        for (int r = 0; r < 16; ++r) { const int k1 = 32 * tr + crow_(r, hi); const f32x2 t = TW[k1 * l2];
            dst[(size_t)k1 * 64] = pk2(re[r] * t.x - im[r] * t.y, re[r] * t.y + im[r] * t.x); }
        __syncthreads();
    }
}
__device__ __forceinline__ void fft2_phase(const unsigned* FA, const u32x4* FT, bf16_t* ACAT, LAS unsigned char* lds, int vcu, int G, int tid, int wave, int lane) {
    const int tr = wave >> 1, tc = wave & 1, r32 = lane & 31, hi = lane >> 5;
    bf16x8 a2[8], b3[8];
#pragma unroll
    for (int ks = 0; ks < 8; ++ks) { a2[ks] = __builtin_bit_cast(bf16x8, FT[8192 + ks * 512 + tid]); b3[ks] = __builtin_bit_cast(bf16x8, FT[12288 + ks * 512 + tid]); }
    LAS unsigned char* Bt = lds;
    LAS unsigned char* Zt = lds + 16384;
    for (int item = vcu; item < 1024; item += G) {
        const int b = item >> 9, g = (item >> 7) & 3, k1 = item & 127;
#pragma unroll
        for (int i = 0; i < 2; ++i) { const int q = tid + 512 * i, l2 = q >> 4, c4 = (q & 15) * 4;
            const u32x4 v = *(const u32x4*)(FA + ((size_t)((b * 4 + g) * 64 + l2) * 128 + k1) * 64 + c4);
#pragma unroll
            for (int e = 0; e < 4; ++e) { *(LAS bf16_t*)(Bt + SWZ(c4 + e, l2 * 2)) = (bf16_t)(v[e] & 0xffffu); *(LAS bf16_t*)(Bt + SWZ(c4 + e, (64 + l2) * 2)) = (bf16_t)(v[e] >> 16); } }
        __syncthreads();
        f32x16 z = {};
#pragma unroll
        for (int ks = 0; ks < 8; ++ks) { const bf16x8 bx = *(const LAS bf16x8*)(Bt + SWZ(32 * tc + r32, (16 * ks + 8 * hi) * 2)); z = __builtin_amdgcn_mfma_f32_32x32x16_bf16(a2[ks], bx, z, 0, 0, 0); }
#pragma unroll
        for (int r = 0; r < 16; ++r) { const int R = 32 * tr + crow_(r, hi); *(LAS bf16_t*)(Zt + SWZ(R & 63, ((R >> 6) * 64 + 32 * tc + r32) * 2)) = (bf16_t)(pk2(z[r], 0.f) & 0xffffu); }
        __syncthreads();
        if (wave < 4) { f32x16 y = {};
#pragma unroll
            for (int ks = 0; ks < 8; ++ks) { const bf16x8 ax = *(const LAS bf16x8*)(Zt + SWZ(32 * tr + r32, (16 * ks + 8 * hi) * 2)); y = __builtin_amdgcn_mfma_f32_32x32x16_bf16(ax, b3[ks], y, 0, 0, 0); }
#pragma unroll
            for (int r = 0; r < 16; ++r) { const int k2 = 32 * tr + crow_(r, hi); ACAT[(size_t)(b * SEQ + k1 + 128 * k2) * KCAT + g * 64 + 32 * tc + r32] = (bf16_t)(pk2(y[r] * 0.001381067932f, 0.f) & 0xffffu); } }
        __syncthreads();
    }
}
__device__ __forceinline__ void ctxdft_item(int item, const bf16_t* UF, bf16_t* ACAT, LAS unsigned char* lds, int tid, int wave, int lane) {
    const int b = item >> 4, g = (item >> 2) & 3, kc = item & 3;
    const int tr = wave >> 1, tc = wave & 1, r32 = lane & 31, hi = lane >> 5;
    LAS unsigned char* Xt = lds;
    LAS unsigned char* Zt = lds + 32768;
#pragma unroll
    for (int i = 0; i < 4; ++i) { const int q = tid + 512 * i, l = q >> 3, c8 = (q & 7) * 8;
        const u32x4 v = *(const u32x4*)(UF + (size_t)(ML + b * CTXL + l) * 256 + g * 64 + c8);
#pragma unroll
        for (int e = 0; e < 8; ++e) { const unsigned w = v[e >> 1]; const int row = c8 + e; *(LAS bf16_t*)(Xt + row * 512 + ((((l >> 3) ^ (row & 7)) << 4) | ((l & 7) * 2))) = (bf16_t)((e & 1) ? (w >> 16) : (w & 0xffffu)); } }
    __syncthreads();
    f32x16 z = {};
    const int R = 32 * tr + r32, kk = 64 * kc + (R & 63);
#pragma unroll 4
    for (int ks = 0; ks < 16; ++ks) { float av[8];
#pragma unroll
        for (int j = 0; j < 8; ++j) { const int l = 16 * ks + 8 * hi + j; float s, c; sincospif((float)((kk * l) & 255) * (1.0f / 128.0f), &s, &c); av[j] = (R < 64) ? c : -s; }
        const int row = 32 * tc + r32, ch = (16 * ks + 8 * hi) >> 3;
        const bf16x8 bx = *(const LAS bf16x8*)(Xt + row * 512 + ((ch ^ (row & 7)) << 4));
        z = __builtin_amdgcn_mfma_f32_32x32x16_bf16(pack_bf8(av), bx, z, 0, 0, 0); }
#pragma unroll
    for (int r = 0; r < 16; ++r) { const int Rr = 32 * tr + crow_(r, hi); *(LAS bf16_t*)(Zt + SWZ(Rr & 63, ((Rr >> 6) * 64 + 32 * tc + r32) * 2)) = (bf16_t)(pk2(z[r], 0.f) & 0xffffu); }
    __syncthreads();
    if (wave < 4) { f32x16 y = {};
#pragma unroll
        for (int ks = 0; ks < 8; ++ks) { float bv[8];
#pragma unroll
            for (int j = 0; j < 8; ++j) { const int k = 16 * ks + 8 * hi + j, m = 32 * tc + r32; float s2, c2; sincospif((float)((m * (k & 63)) & 63) * (1.0f / 32.0f), &s2, &c2); bv[j] = (k < 64) ? c2 : s2; }
            const bf16x8 ax = *(const LAS bf16x8*)(Zt + SWZ(32 * tr + r32, (16 * ks + 8 * hi) * 2)); y = __builtin_amdgcn_mfma_f32_32x32x16_bf16(ax, pack_bf8(bv), y, 0, 0, 0); }
#pragma unroll
        for (int r = 0; r < 16; ++r) { const int k = 64 * kc + 32 * tr + crow_(r, hi); ACAT[(size_t)(ML + b * CTXL + k) * KCAT + g * 64 + 32 * tc + r32] = (bf16_t)(pk2(y[r] * (1.0f / 128.0f), 0.f) & 0xffffu); } }
    __syncthreads();
}

__device__ __forceinline__ void conv_item(int item, const bf16_t* ZG, const float* cw  , const float* cb, const float* lng, const float* lnb, bf16_t* ACAT, LAS unsigned char* lds, int tid, int wave, int lane) {
    const int row0 = item * 64; const bool lat = row0 < ML; const int s0 = lat ? (row0 & ~(SEQ - 1)) : (ML + ((row0 - ML) & ~(CTXL - 1))), s1 = s0 + (lat ? SEQ : CTXL);
    LAS float* zt = (LAS float*)lds;
#pragma unroll
    for (int i = 0; i < 6; ++i) { const int q = tid + 512 * i; if (q < 94 * 32) { const int rr = q >> 5, c8 = (q & 31) * 8, gr = row0 - 15 + rr;
        u32x4 v = {0u, 0u, 0u, 0u}; if (gr >= s0 && gr < s1) v = *(const u32x4*)(ZG + (size_t)gr * 256 + c8);
        *(LAS f32x4*)(zt + rr * 256 + c8) = (f32x4){bf2f(v.x & 0xffffu), __uint_as_float(v.x & 0xffff0000u), bf2f(v.y & 0xffffu), __uint_as_float(v.y & 0xffff0000u)};
        *(LAS f32x4*)(zt + rr * 256 + c8 + 4) = (f32x4){bf2f(v.z & 0xffffu), __uint_as_float(v.z & 0xffff0000u), bf2f(v.w & 0xffffu), __uint_as_float(v.w & 0xffff0000u)}; } }
    const int c = tid & 255, half = tid >> 8;
    float w[31];
#pragma unroll
    for (int t = 0; t < 31; ++t) w[t] = cw[t * 256 + c];
    float acc[32]; const float bias = cb[c];
    __syncthreads();
#pragma unroll
    for (int r0 = 0; r0 < 32; r0 += 4) { float v[34];
#pragma unroll
        for (int i = 0; i < 34; ++i) v[i] = zt[(half * 32 + r0 + i) * 256 + c];
        float a0 = bias, a1 = bias, a2 = bias, a3 = bias;
#pragma unroll
        for (int t = 0; t < 31; ++t) { a0 += w[t] * v[t]; a1 += w[t] * v[t + 1]; a2 += w[t] * v[t + 2]; a3 += w[t] * v[t + 3]; }
        acc[r0] = a0; acc[r0 + 1] = a1; acc[r0 + 2] = a2; acc[r0 + 3] = a3; }
    __syncthreads();
#pragma unroll
    for (int r = 0; r < 32; ++r) zt[(half * 32 + r) * 256 + c] = acc[r];
    __syncthreads();
    const f32x4 gg = *(const f32x4*)(lng + 4 * lane), bb = *(const f32x4*)(lnb + 4 * lane);
#pragma unroll
    for (int i = 0; i < 8; ++i) { const int r = wave * 8 + i; const f32x4 v = *(const LAS f32x4*)(zt + r * 256 + 4 * lane);
        const float mu = wave_sum((v.x + v.y) + (v.z + v.w)) * (1.0f / 256.0f); const f32x4 d = v - mu;
        const float var = wave_sum((d.x * d.x + d.y * d.y) + (d.z * d.z + d.w * d.w)) * (1.0f / 256.0f); const float rs = 1.0f / sqrtf(var + EPS);
        f32x4 o = d * rs * gg + bb; o.x *= sigm(o.x); o.y *= sigm(o.y); o.z *= sigm(o.z); o.w *= sigm(o.w);
        u32x2 pw; pw.x = pk2(o.x, o.y); pw.y = pk2(o.z, o.w); *(u32x2*)(ACAT + (size_t)(row0 + r) * KCAT + 768 + 4 * lane) = pw; }
    __syncthreads();
}
__device__ __forceinline__ void pool_phase(const bf16_t* UP, const float* pw  , const float* psc, bf16_t* ACAT, int nitems, int first, LAS unsigned char* lds, int G, int tid, int wave, int lane) {
    const int g = wave >> 1, tc = wave & 1, r32 = lane & 31, hi = lane >> 5;
    bf16x8 bw[4];
#pragma unroll
    for (int ks = 0; ks < 4; ++ks) { float v[8];
#pragma unroll
        for (int j = 0; j < 8; ++j) v[j] = pw[g * 4096 + (16 * ks + 8 * hi + j) * 64 + 32 * tc + r32];
        bw[ks] = pack_bf8(v); }
    const float osc = psc[g * 64 + 32 * tc + r32];
    LAS float* ut = (LAS float*)lds;
    LAS unsigned char* dt = lds + 81920;
    for (int item = first; item < nitems; item += G) {
        const int row0 = item * 64; const bool lat = row0 < ML; const int s0 = lat ? (row0 & ~(SEQ - 1)) : (ML + ((row0 - ML) & ~(CTXL - 1))), L = lat ? SEQ : CTXL, s1 = s0 + L;
#pragma unroll
        for (int i = 0; i < 5; ++i) { const int q = tid + 512 * i, rr = q >> 5, c8 = (q & 31) * 8, gr = row0 - 8 + rr;
            u32x4 v = {0u, 0u, 0u, 0u}; if (gr >= s0 && gr < s1) v = *(const u32x4*)(UP + (size_t)gr * 256 + c8);
            *(LAS f32x4*)(ut + rr * 256 + c8) = (f32x4){bf2f(v.x & 0xffffu), __uint_as_float(v.x & 0xffff0000u), bf2f(v.y & 0xffffu), __uint_as_float(v.y & 0xffff0000u)};
            *(LAS f32x4*)(ut + rr * 256 + c8 + 4) = (f32x4){bf2f(v.z & 0xffffu), __uint_as_float(v.z & 0xffff0000u), bf2f(v.w & 0xffffu), __uint_as_float(v.w & 0xffff0000u)}; }
        __syncthreads();
#pragma unroll
        for (int i = 0; i < 4; ++i) { const int q = tid + 512 * i, lr = q >> 5, c8 = (q & 31) * 8, gg = c8 >> 6, hw = 1 << gg, tt = row0 + lr - s0;
            f32x4 sa = {0.f, 0.f, 0.f, 0.f}, sb = {0.f, 0.f, 0.f, 0.f};
            for (int o = -hw; o < hw; ++o) { sa += *(const LAS f32x4*)(ut + (lr + 8 + o) * 256 + c8); sb += *(const LAS f32x4*)(ut + (lr + 8 + o) * 256 + c8 + 4); }
            const int lo = tt - hw < 0 ? 0 : tt - hw, hh = tt + hw - 1 > L - 1 ? L - 1 : tt + hw - 1; const float inv = 1.0f / (float)(hh - lo + 1);
            const f32x4 ua = *(const LAS f32x4*)(ut + (lr + 8) * 256 + c8), ub = *(const LAS f32x4*)(ut + (lr + 8) * 256 + c8 + 4);
            const f32x4 da = sa * inv - ua, db = sb * inv - ub;
            u32x4 w; w.x = pk2(da.x, da.y); w.y = pk2(da.z, da.w); w.z = pk2(db.x, db.y); w.w = pk2(db.z, db.w);
            *(LAS u32x4*)(dt + lr * 512 + ((((c8 >> 3) ^ (lr & 7)) << 4))) = w; }
        __syncthreads();
#pragma unroll
        for (int rt = 0; rt < 2; ++rt) { f32x16 y = {};
#pragma unroll
            for (int ks = 0; ks < 4; ++ks) { const int row = 32 * rt + r32, ch = (g * 64 + 16 * ks + 8 * hi) >> 3;
                const bf16x8 ax = *(const LAS bf16x8*)(dt + row * 512 + ((ch ^ (row & 7)) << 4)); y = __builtin_amdgcn_mfma_f32_32x32x16_bf16(ax, bw[ks], y, 0, 0, 0); }
#pragma unroll
            for (int r = 0; r < 16; ++r) ACAT[(size_t)(row0 + 32 * rt + crow_(r, hi)) * KCAT + 1024 + g * 64 + 32 * tc + r32] = (bf16_t)(pk2(y[r] * osc, 0.f) & 0xffffu); }
        __syncthreads();
    }
}

__device__ __forceinline__ void ctx_gate_combine(const float* slab, const unsigned char* Gc  , bf16_t* Yc, int gw, int NGW, int lane) {
    for (int r = gw; r < MC; r += NGW) {
#pragma unroll
        for (int j = 0; j < 4; ++j) { const int col = 4 * lane + 256 * j; f32x4 y = {0.f, 0.f, 0.f, 0.f};
#pragma unroll
            for (int sl = 0; sl < 5; ++sl) { const int b = sl == 0 ? 0 : sl <= 2 ? 1 : sl - 1;
                const f32x4 p = *(const f32x4*)(slab + (size_t)sl * 512 * 1024 + (size_t)r * 1024 + col); const unsigned q = *(const unsigned*)(Gc + (size_t)r * 4096 + b * 1024 + col);
                y[0] += p[0] * (float)(q & 255u); y[1] += p[1] * (float)((q >> 8) & 255u); y[2] += p[2] * (float)((q >> 16) & 255u); y[3] += p[3] * (float)(q >> 24); }
            y = y * (1.0f / 255.0f);
            u32x2 w; w.x = pk2(y[0], y[1]); w.y = pk2(y[2], y[3]); *(u32x2*)(Yc + (size_t)r * 1024 + col) = w; }
    }
}
constexpr int NPHASE = 22;
struct Args { const float* in[30]; float* out; unsigned char* ws; int ph_lo, ph_hi, li, pad; };
__global__ void __launch_bounds__(512, 2) __attribute__((amdgpu_waves_per_eu(2, 2))) fwd_kernel(Args args) {
    extern __shared__ __attribute__((aligned(16))) unsigned char lds[];
    LAS unsigned char* L = (LAS unsigned char*)lds;
    volatile LAS unsigned* MISC = (volatile LAS unsigned*)(L + MISC_OFF);
    const int tid0 = threadIdx.x; const int wave0 = __builtin_amdgcn_readfirstlane(tid0 >> 6);
    const int G = gridDim.x, bx0 = blockIdx.x, vcu0 = (G % 8 == 0) ? (bx0 % 8) * (G / 8) + bx0 / 8 : bx0;
    const int NGW = G * 8;
    gu32* ctl = (gu32*)(args.ws + WS_CTL);
    for (int u = tid0; u < (LDS_BYTES - LDSCTL_OFF) / 4; u += 512) ((LAS unsigned*)(L + LDSCTL_OFF))[u] = 0u;
    __syncthreads();
    volatile LAS unsigned long long* PT = (volatile LAS unsigned long long*)(L + PT_OFF);
    if (tid0 < 32) PT[tid0] = ((const __attribute__((address_space(4))) unsigned long long*)__builtin_amdgcn_kernarg_segment_ptr())[tid0];
    __syncthreads();
#define FRESH() int tid, vcu = vcu0, bx = bx0; asm volatile("v_mbcnt_lo_u32_b32 %0, -1, 0\n\tv_mbcnt_hi_u32_b32 %0, -1, %0" : "=v"(tid)); tid += wave0 * 64; asm volatile("" : "+v"(tid), "+s"(vcu), "+s"(bx)); const int lane = tid & 63, wave = __builtin_amdgcn_readfirstlane(tid >> 6), gw = vcu * 8 + wave; (void)lane; (void)gw; (void)bx; \
    LAS float* scr = (LAS float*)(L + wave * 16384); (void)scr;
#define PTR(i) ((const float*)(const GAS float*)ldptr(PT, (i)))
#define OUTP ((float*)(GAS float*)ldptr(PT, 30))
#define WSP ((unsigned char*)(GAS unsigned char*)ldptr(PT, 31))
    XcdBarrier bar; bar.bar = (unsigned*)(ctl + CW_BAR) + args.li * XCD_BAR_WORDS; bar.x = 0; bar.st = nullptr;
    if (MK_N_LAUNCHES != NPHASE) bar = xcd_barrier_post((unsigned*)(ctl + CW_BAR) + args.li * XCD_BAR_WORDS, MISC + 8);
#ifndef TAILREP
#define TAILREP 1
#endif
#ifndef UPV_REV
#define UPV_REV 1
#endif
#ifndef BARX2
#define BARX2 0
#endif
#ifdef CLKPROBE
#define CK_START(k) do { if ((k) == CLKPROBE && l == 0 && tid == 0) { const unsigned long long a_ = __builtin_amdgcn_s_memtime(), b_ = __builtin_amdgcn_s_memrealtime(); MISC[12] = (unsigned)a_; MISC[13] = (unsigned)(a_ >> 32); MISC[14] = (unsigned)b_; MISC[15] = (unsigned)(b_ >> 32); } } while (0)
#define CK_STOP(k) do { if ((k) == CLKPROBE && l == 0 && tid == 0) { const unsigned long long t1_ = __builtin_amdgcn_s_memtime(), r1_ = __builtin_amdgcn_s_memrealtime(); \
        const unsigned long long t0_ = MISC[12] | ((unsigned long long)MISC[13] << 32), r0_ = MISC[14] | ((unsigned long long)MISC[15] << 32); MISC[16] = (unsigned)(((t1_ - t0_) * 100ull) / (r1_ - r0_)); } } while (0)
#else
#define CK_START(k) do {} while (0)
#define CK_STOP(k) do {} while (0)
#endif
#define GRID_BAR() do { if (MK_N_LAUNCHES == NPHASE) { if (tid0 == 0) __hip_atomic_store(ctl + CW_TMO, 0xBADBA0u, RLX_AGENT); } else { xcd_barrier(bar); if (BARX2) xcd_barrier(bar); } } while (0)
    const int lo = args.ph_lo, hi = args.ph_hi;
#ifndef PHASE_MASK
#define PHASE_MASK 0xFFF
#endif
#ifndef ATTM
#define ATTM 3
#endif
#ifndef X1REP
#define X1REP 0
#endif
#ifndef X1M
#define X1M 31
#endif
#define PH_EN(kind) ((PHASE_MASK >> (kind)) & 1)
#ifndef REP_MASK
#define REP_MASK 0
#endif
#define NREP(kind) (((REP_MASK >> (kind)) & 1) ? 2 : 1)
#define IN(k) (lo <= (k) && (k) < hi)
#define BOTH(k) (IN(k) && IN((k) + 1))
#define WSRC(S, l) WSrc S; S.w_in = PTR(8) + (size_t)(l) * 1024 * NIN; S.wo_f = PTR(20) + (size_t)(l) * 256 * 1024; S.wo_a = PTR(21) + (size_t)(l) * 512 * 1024; \
    S.wo_c = PTR(22) + (size_t)(l) * 256 * 1024; S.wo_p = PTR(23) + (size_t)(l) * 256 * 1024; S.w_out = PTR(24) + (size_t)(l) * 1024 * 1024; \
    S.w_up = PTR(25) + (size_t)(l) * 1024 * 2 * DFF; S.w_down = PTR(28) + (size_t)(l) * DFF * 1024;
#define ws WSP
#define OUTHI ((unsigned char*)OUTP + 32 * MiB)
#define WA1 ((bf16_t*)OUTHI)
#define WUPG1 ((bf16_t*)(OUTHI + 13 * MiB))
#define WUPV1 ((bf16_t*)(OUTHI + 13 * MiB + (size_t)2816 * 1024 * 2))
#define WDST0 {(bf16_t*)(ws + WS_WA), (bf16_t*)(ws + WS_WCAT), (bf16_t*)(ws + WS_WOUT), (bf16_t*)(ws + WS_WDN), (bf16_t*)(ws + WS_WUPG), (bf16_t*)(ws + WS_WUPV)}
#define WDST1 {WA1, (bf16_t*)(ws + WS_WCAT), (bf16_t*)(ws + WS_WOUT), (bf16_t*)(ws + WS_WDN), WUPG1, WUPV1}
#define TAIL_CONVERT(MASK, nwg_, lo_, hi_) do { const int rem_ = (nwg_) % G; if (rem_ == 0 || bx >= rem_) { __syncthreads(); WSRC(S1, 1); const WDst D1 = WDST1; \
        for (int tr_ = 0; tr_ < TAILREP; ++tr_) convert_items<MASK>(S1, D1, scr, (lo_), (hi_), (rem_ ? bx - rem_ : bx) * 8 + wave, (rem_ ? G - rem_ : G) * 8, lane); } } while (0)
#define MOD ((float*)(WSP + WS_MOD))
#define ROPE ((float*)(WSP + WS_ROPE))
#define TW ((f32x2*)(WSP + WS_TW))
#define FT ((u32x4*)(WSP + WS_FT))
#define XC ((float*)(WSP + WS_XC))
#define HX ((bf16_t*)(WSP + WS_HX))
#define FA ((f32x2*)(WSP + WS_FA))
#define Qb ((bf16_t*)(WSP + WS_Q))
#define Kb ((bf16_t*)(WSP + WS_K))
#define Vb ((bf16_t*)(WSP + WS_V))
#define Yb ((bf16_t*)(WSP + WS_Y))
#define Gb (WSP + WS_G)
#define ACAT ((bf16_t*)(WSP + WS_ACAT))
#define UF ((bf16_t*)(WSP + WS_UF))
#define ZG ((bf16_t*)(WSP + WS_ZG))
#define UP ((bf16_t*)(WSP + WS_UP))
#define GT ((bf16_t*)(WSP + WS_GT))
#define Hb ((bf16_t*)(WSP + WS_H))

    for (int rep = 0; rep < NREP(0); ++rep) if (PH_EN(0) && IN(0)) { FRESH();
        mod_phase(PTR(1), PTR(3), PTR(6), PTR(7), MOD, L, vcu, G, tid, wave, lane);
        tables_phase(ROPE, TW, vcu * 512 + tid, G * 512); fft_tables_phase(FT, ((vcu + 128) % G) * 512 + tid, G * 512);
        for (int i = vcu * 512 + tid; i < MC * DM / 4; i += G * 512) ((f32x4*)XC)[i] = ((const f32x4*)PTR(2))[i];
        WSRC(S0, 0); { const WDst D0 = WDST0; convert_items<31>(S0, D0, scr, 0, ITU_END, gw, NGW, lane); }
        if (BOTH(0)) GRID_BAR();
    }
#pragma nounroll
    for (int l = 0; l < 2; ++l) {
        const int pb = 1 + 10 * l;
#define mod (MOD + l * 3 * 6144)
#define XBF ((bf16_t*)OUTP)
#define xc ((l == 0) ? PTR(2) : (const float*)XC)
        const int Mact = (l == 0) ? MT : ML;
        for (int rep = 0; rep < NREP(1); ++rep) if (PH_EN(1) && IN(pb)) { FRESH(); if (l == 0) norm_phase<false>(PTR(0), xc, MT, PTR(4) + l * DM, mod, 0, 1024, HX, gw, NGW, lane);
            else norm_phase<true>(XBF, xc, MT, PTR(4) + l * DM, mod, 0, 1024, HX, gw, NGW, lane, (const float*)Gb, 11, MOD + 2 * 6144 + 5120, XC);
            if (BOTH(pb)) GRID_BAR(); }
        for (int rep = 0; rep < NREP(2); ++rep) if (PH_EN(2) && IN(pb + 1)) { FRESH();
            pg8::Gemm g{HX, l == 0 ? (const bf16_t*)(ws + WS_WA) : (const bf16_t*)WA1, MT, NIN, 1024}; pg8::StaticOrder S; S.init(MT, NIN, G, bx);
            pg8::EpiIn E{UF, ZG, UP, Qb, Kb, Vb, Gb, ROPE};
            CK_START(1);
            pg8::gemm_phase<pg8::EpiIn, pg8::StaticOrder, true, true>(L, g, S, E, tid);
            CK_STOP(1);
#ifdef KLOOP_PROBE
            if (KLOOP_PROBE == 1) { int tid3 = tid; asm volatile("" : "+v"(tid3)); pg8::EpiNull En; pg8::gemm_phase<pg8::EpiNull, pg8::StaticOrder, true, true>(L, g, S, En, tid3); }
#endif
            TAIL_CONVERT(7, (MT / 256) * (NIN / 256), l == 0 ? 0 : ITU_CAT, l == 0 ? IT_A : ITU_UPG);
            if (BOTH(pb + 1)) GRID_BAR();
        }
        for (int rep = 0; rep < NREP(3); ++rep) if (PH_EN(3) && IN(pb + 2)) { FRESH();
            for (int r1 = 0; r1 < ((X1REP & 1) ? 2 : 1); ++r1) if (X1M & 1) fft1_phase(UF, TW, FT, (unsigned*)FA, L, vcu, G, tid, wave, lane);
            for (int r1 = 0; r1 < ((X1REP & 2) ? 2 : 1); ++r1) if (X1M & 2) for (int it = vcu; it < Mact / 64; it += G) conv_item(it, ZG, PTR(14) + l * 31 * 256, PTR(15) + l * 256, PTR(16) + l * 256, PTR(17) + l * 256, ACAT, L, tid, wave, lane);
            for (int r1 = 0; r1 < ((X1REP & 4) ? 2 : 1); ++r1) if (X1M & 4) pool_phase(UP, PTR(18) + l * 4 * 4096, PTR(19) + l * 256, ACAT, Mact / 64, (vcu + 248) % G, L, G, tid, wave, lane);
            if ((X1M & 8) && l == 0) for (int it = (vcu + 224) % G; it < 32; it += G) ctxdft_item(it, UF, ACAT, L, tid, wave, lane);
            if (l == 0) {
                const float lam_init = 0.2f;
                const float d1 = wave_sum(PTR(9)[lane] * PTR(10)[lane]), d2 = wave_sum(PTR(11)[lane] * PTR(12)[lane]);
                const float lam = __builtin_bit_cast(float, __builtin_amdgcn_readfirstlane(__builtin_bit_cast(int, expf(d1) - expf(d2) + lam_init)));
                for (int v = (vcu + 200) % G; v < 16; v += G) { const int b = v >> 3, h = (v >> 1) & 3, row0 = ML + b * CTXL + (v & 1) * 128;
                    att2::attn_unit<0>(Qb + (size_t)row0 * 512 + h * 128, Kb + (size_t)b * KVL * 512 + h * 128, Vb + (size_t)b * KVL * 512 + h * 128, CTXL,
                                       ACAT + (size_t)row0 * KCAT + 256 + h * 128, lam, 1.0f - lam_init, PTR(13), (char*)lds, tid); }
            }
            if (BOTH(pb + 2)) GRID_BAR();
        }
        for (int rep = 0; rep < NREP(4); ++rep) if (PH_EN(4) && IN(pb + 3)) { FRESH();
            if (ATTM & 1) fft2_phase((const unsigned*)FA, FT, ACAT, L, vcu, G, tid, wave, lane);
            const float lam_init = (l == 0) ? 0.2f : 0.35550906759096926f;
            const float d1 = wave_sum(PTR(9)[l * 64 + lane] * PTR(10)[l * 64 + lane]), d2 = wave_sum(PTR(11)[l * 64 + lane] * PTR(12)[l * 64 + lane]);
            const float lam = __builtin_bit_cast(float, __builtin_amdgcn_readfirstlane(__builtin_bit_cast(int, expf(d1) - expf(d2) + lam_init)));
            const int nun = 512;
            CK_START(3);
            if (ATTM & 2) for (int u = vcu; u < nun; u += G) {
                int b, h, row0, nkeys;
                if (u < 512) { const int x = (u & 255) >> 5, qb = (u & 31) + 32 * (u >> 8); b = x >> 2; h = x & 3; row0 = b * SEQ + qb * 128; nkeys = KVL; }
                else { const int v = u - 512; b = v >> 3; h = (v >> 1) & 3; row0 = ML + b * CTXL + (v & 1) * 128; nkeys = CTXL; }
#if ATT_V == 2
                att2::attn_unit<0>(Qb + (size_t)row0 * 512 + h * 128,
#else
                att::attn_unit<0>(Qb + (size_t)row0 * 512 + h * 128,
#endif
                               Kb + (size_t)b * KVL * 512 + h * 128, Vb + (size_t)b * KVL * 512 + h * 128, nkeys,
                               ACAT + (size_t)row0 * KCAT + 256 + h * 128, lam, 1.0f - lam_init, PTR(13) + l * 128, (char*)lds, tid);
            }
            CK_STOP(3);
            if (l == 0) {
                pg8::Gemm gc{ACAT + (size_t)ML * KCAT, (const bf16_t*)(ws + WS_WCAT), MC, 1024, 256, KCAT}; pg8::BranchSliceOrder Sc{G, bx};
                pg8::EpiSlab Ec{(float*)UF};
                pg8::gemm_phase<pg8::EpiSlab, pg8::BranchSliceOrder, true, true>(L, gc, Sc, Ec, tid);
            }
#if defined(ATT_PROBE)
            int tid2 = tid, vcu2 = vcu; asm volatile("" : "+v"(tid2), "+s"(vcu2));
            for (int u = vcu2; u < 512; u += G) {
                const int x = (u & 255) >> 5, qb = (u & 31) + 32 * (u >> 8), b = x >> 2, h = x & 3, row0 = b * SEQ + qb * 128;
                att2::attn_unit<ATT_PROBE>(Qb + (size_t)row0 * 512 + h * 128, Kb + (size_t)b * KVL * 512 + h * 128, Vb + (size_t)b * KVL * 512 + h * 128, KVL,
                               Hb + (size_t)row0 * KCAT + 256 + h * 128, lam, 1.0f - lam_init, PTR(13) + l * 128, (char*)lds, tid2);
            }
#endif
            if (BOTH(pb + 3)) GRID_BAR();
        }
        for (int rep = 0; rep < NREP(5); ++rep) if (PH_EN(5) && IN(pb + 4)) { FRESH();
            if (l == 0) ctx_gate_combine((const float*)UF, Gb + (size_t)ML * 4096, Yb + (size_t)ML * 1024, gw, NGW, lane);
            pg8::Gemm g{ACAT, (const bf16_t*)(ws + WS_WCAT), ML, 1024, KCAT}; pg8::StaticOrder S; S.init(ML, 1024, G, bx);
            pg8::EpiBranch E{Gb, Yb};
            pg8::gemm_phase<pg8::EpiBranch, pg8::StaticOrder, true, true>(L, g, S, E, tid);
            if (BOTH(pb + 4)) GRID_BAR();
        }
        for (int rep = 0; rep < (l == 0 ? NREP(6) : 1); ++rep) if (PH_EN(6) && IN(pb + 5)) { FRESH();
            pg8::Gemm g{Yb, (const bf16_t*)(ws + WS_WOUT), ML, 1024, 1024}; pg8::StaticOrder S; S.init(ML, 1024, G, bx);
            pg8::EpiRes E{l == 0 ? PTR(0) : (const float*)nullptr, XBF, xc, XBF, XC, mod, 2048};
            pg8::gemm_phase<pg8::EpiRes, pg8::StaticOrder, true, true>(L, g, S, E, tid);
            if (l == 0) {
                pg8::Gemm gc{Yb + (size_t)ML * 1024, (const bf16_t*)(ws + WS_WOUT), MC, 1024, 256, 1024}; pg8::SplitKOrder Sc{4, 256, G, bx};
                pg8::EpiSlab Ec{(float*)Gb};
                pg8::gemm_phase<pg8::EpiSlab, pg8::SplitKOrder, true, true>(L, gc, Sc, Ec, tid);
            }
            if (BOTH(pb + 5)) GRID_BAR();
        }
        for (int rep = 0; rep < NREP(7); ++rep) if (PH_EN(7) && IN(pb + 6)) { FRESH(); if (l == 0) norm_phase<true>(XBF, XC, Mact, PTR(5) + l * DM, mod, 3072, 4096, HX, gw, NGW, lane, (const float*)Gb, 4, mod + 2 * 6144 + 2048, XC);
            else norm_phase<true>(XBF, XC, Mact, PTR(5) + l * DM, mod, 3072, 4096, HX, gw, NGW, lane);
            if (BOTH(pb + 6)) GRID_BAR(); }
        for (int rep = 0; rep < NREP(8); ++rep) if (PH_EN(8) && IN(pb + 7)) { FRESH();
            pg8::Gemm g{HX, l == 0 ? (const bf16_t*)(ws + WS_WUPG) : (const bf16_t*)WUPG1, Mact, DFF, 1024}; pg8::StaticOrder S; S.init(Mact, DFF, G, bx);
            pg8::EpiBf E{GT, DFF};
            pg8::gemm_phase<pg8::EpiBf, pg8::StaticOrder, true, true>(L, g, S, E, tid);
#ifdef KLOOP_PROBE
            if (KLOOP_PROBE == 7) { int tid3 = tid; asm volatile("" : "+v"(tid3)); pg8::EpiNull En; pg8::gemm_phase<pg8::EpiNull, pg8::StaticOrder, true, true>(L, g, S, En, tid3); }
            if (KLOOP_PROBE == 17) { int tid3 = tid; asm volatile("" : "+v"(tid3)); pg8::gemm_phase<pg8::EpiBf, pg8::StaticOrder, true, true>(L, g, S, E, tid3); }
#endif
            if (l == 0) TAIL_CONVERT(8, (MT / 256) * (DFF / 256), ITU_UPG, ITU_UPV);
            if (BOTH(pb + 7)) GRID_BAR();
        }
        for (int rep = 0; rep < NREP(9); ++rep) if (PH_EN(9) && IN(pb + 8)) { FRESH();
            pg8::Gemm g{HX, l == 0 ? (const bf16_t*)(ws + WS_WUPV) : (const bf16_t*)WUPV1, Mact, DFF, 1024}; pg8::StaticOrder S; S.init(Mact, DFF, G, bx); S.rev = UPV_REV;
            pg8::EpiVal E{GT, Hb, PTR(26) + l * 3 * DFF, PTR(27) + l * DFF};
            CK_START(8);
            pg8::gemm_phase<pg8::EpiVal, pg8::StaticOrder, true, true>(L, g, S, E, tid);
            CK_STOP(8);
#ifdef KLOOP_PROBE
            if (KLOOP_PROBE == 8) { int tid3 = tid; asm volatile("" : "+v"(tid3)); pg8::EpiNull En; pg8::gemm_phase<pg8::EpiNull, pg8::StaticOrder, true, true>(L, g, S, En, tid3); }
            if (KLOOP_PROBE == 18) { int tid3 = tid; asm volatile("" : "+v"(tid3)); pg8::gemm_phase<pg8::EpiVal, pg8::StaticOrder, true, true>(L, g, S, E, tid3); }
#endif
            if (l == 0) TAIL_CONVERT(16, (MT / 256) * (DFF / 256), ITU_UPV, ITU_END);
            if (BOTH(pb + 8)) GRID_BAR();
        }
        if (PH_EN(10) && IN(pb + 9)) { FRESH();
            pg8::Gemm g{Hb, (const bf16_t*)(ws + WS_WDN), ML, 1024, DFF}; pg8::StaticOrder S; S.init(ML, 1024, G, bx);
            pg8::EpiRes E{(const float*)nullptr, XBF, XC, l == 0 ? XBF : HX, XC, mod, 5120};
            pg8::gemm_phase<pg8::EpiRes, pg8::StaticOrder, true, true>(L, g, S, E, tid);
            if (l == 0) {
                pg8::Gemm gc{Hb + (size_t)ML * DFF, (const bf16_t*)(ws + WS_WDN), MC, 1024, 256, DFF}; pg8::SplitKOrder Sc{11, 256, G, bx};
                pg8::EpiSlab Ec{(float*)Gb};
                pg8::gemm_phase<pg8::EpiSlab, pg8::SplitKOrder, true, true>(L, gc, Sc, Ec, tid);
            }
            if (BOTH(pb + 9)) GRID_BAR();
        }
    }
    if (PH_EN(11) && IN(21)) { FRESH(); final_norm_phase(HX, OUTP, PTR(29), gw, NGW, lane); }
#ifdef KT_PROBE
    if (bx0 == 0 && wave0 == 0) { const unsigned us = (KT_PROBE == 1) ? (MISC[20] / (MISC[21] ? MISC[21] : 1u)) / 10u : (KT_PROBE == 2) ? (MISC[23] / (MISC[24] ? MISC[24] : 1u)) / 100u : (MISC[25] / (MISC[26] ? MISC[26] : 1u)) / 20u;
        const unsigned long long s0 = __builtin_amdgcn_s_memrealtime(); while (__builtin_amdgcn_s_memrealtime() - s0 < (unsigned long long)us * 100ull) __builtin_amdgcn_s_sleep(8); }
#endif
#ifdef CLKPROBE
    if (bx0 == 0 && wave0 == 0) { const unsigned mhz = MISC[16]; const unsigned long long s0 = __builtin_amdgcn_s_memrealtime(); while (__builtin_amdgcn_s_memrealtime() - s0 < (unsigned long long)mhz * 10ull) __builtin_amdgcn_s_sleep(8); }
#endif
#undef IN
#undef BOTH
#undef mod
#undef XBF
#undef xc
#undef ws
#undef OUTHI
#undef WA1
#undef WUPG1
#undef WUPV1
#undef WDST0
#undef WDST1
#undef TAIL_CONVERT
#undef MOD
#undef ROPE
#undef TW
#undef FT
#undef XC
#undef HX
#undef FA
#undef Qb
#undef Kb
#undef Vb
#undef Yb
#undef Gb
#undef ACAT
#undef UF
#undef ZG
#undef UP
#undef GT
#undef Hb
#undef PTR
#undef OUTP
#undef WSP
}

extern "C" void kernel_launch(void* const* d_in, const int* in_sizes, int n_in, void* d_out, int out_size, void* d_ws, size_t ws_size, hipStream_t stream) {
    static int grid = 0;
    if (grid == 0) {
        if (n_in != 30 || in_sizes[0] != ML * DM || out_size != ML * DM || ws_size < WS_END) {
            fprintf(stderr, "kernel_launch: unexpected shapes: n_in %d in0 %d out %d ws %zu (need >= %zu)\n", n_in, n_in > 0 ? in_sizes[0] : -1, out_size, ws_size, (size_t)WS_END); grid = -1; return; }
        int dev = 0, cus = 0, per_cu = 0;
        if (hipGetDevice(&dev) != hipSuccess || hipDeviceGetAttribute(&cus, hipDeviceAttributeMultiprocessorCount, dev) != hipSuccess) { grid = -1; return; }
        if (hipFuncSetAttribute((const void*)fwd_kernel, hipFuncAttributeMaxDynamicSharedMemorySize, LDS_BYTES) != hipSuccess) { fprintf(stderr, "kernel_launch: hipFuncSetAttribute failed\n"); grid = -1; return; }
        if (hipOccupancyMaxActiveBlocksPerMultiprocessor(&per_cu, (const void*)fwd_kernel, 512, LDS_BYTES) != hipSuccess || per_cu < 1) {
            fprintf(stderr, "kernel_launch: occupancy query reports %d blocks per CU\n", per_cu); (void)hipGetLastError(); grid = -1; return; }
        grid = cus;
    }
    if (grid < 0) return;
    (void)hipMemsetAsync((char*)d_ws + WS_CTL, 0, CTL_ZERO_BYTES, stream);
    Args a{};
    for (int i = 0; i < 30; ++i) a.in[i] = (const float*)d_in[i];
    a.out = (float*)d_out; a.ws = (unsigned char*)d_ws;
    for (int li = 0; li < MK_N_LAUNCHES; ++li) {
        if (MK_N_LAUNCHES == NPHASE) { a.ph_lo = li; a.ph_hi = li + 1; a.li = 0; }
        else { a.ph_lo = (int)((long)NPHASE * li / MK_N_LAUNCHES); a.ph_hi = (int)((long)NPHASE * (li + 1) / MK_N_LAUNCHES); a.li = li; }
        hipLaunchKernelGGL(fwd_kernel, dim3(grid), dim3(512), LDS_BYTES, stream, a);
    }
}
```

```cpp
#include <hip/hip_runtime.h>
#include <cstdio>
#include <cstdint>

#define LAS __attribute__((address_space(3)))
#define GAS __attribute__((address_space(1)))
typedef unsigned short bf16_t;
typedef short bf16x8 __attribute__((ext_vector_type(8)));
typedef short s16x4 __attribute__((ext_vector_type(4)));
typedef float f32x2 __attribute__((ext_vector_type(2)));
typedef float f32x4 __attribute__((ext_vector_type(4)));
typedef float f32x16 __attribute__((ext_vector_type(16)));
typedef unsigned u32x2 __attribute__((ext_vector_type(2)));
typedef unsigned u32x4 __attribute__((ext_vector_type(4)));

#ifndef ATT_V
#define ATT_V 2
#endif
#ifndef MK_N_LAUNCHES
#define MK_N_LAUNCHES 1
#endif

constexpr int DM = 1024, SEQ = 8192, NBATCH = 2, CTXL = 256;
constexpr int ML = NBATCH * SEQ;
constexpr int MC = NBATCH * CTXL;
constexpr int MT = ML + MC;
constexpr int NIN = 6656, DFF = 2816, KCAT = 1280;
constexpr int KVL = CTXL + SEQ;
constexpr float EPS = 1e-6f;

constexpr size_t MiB = 1u << 20;
constexpr size_t WS_CTL = 0, CTL_ZERO_BYTES = 1 * MiB;
constexpr size_t WS_MOD = 1 * MiB;
constexpr size_t WS_ROPE = WS_MOD + 2 * 3 * 6144 * 4;
constexpr size_t WS_TW = WS_ROPE + 192 * 32 * 4;
constexpr size_t WS_FT = WS_MOD + 512 * 1024;
constexpr size_t WS_XC = 2 * MiB;
constexpr size_t WS_WA = 4 * MiB;
constexpr size_t WS_WCAT = 17 * MiB;
constexpr size_t WS_WOUT = WS_WCAT + (size_t)1024 * 1280 * 2;
constexpr size_t WS_WUPG = WS_WOUT + (size_t)1024 * 1024 * 2;
constexpr size_t WS_WUPV = WS_WUPG + (size_t)2816 * 1024 * 2;
constexpr size_t WS_WDN = WS_WUPV + (size_t)2816 * 1024 * 2;
constexpr size_t WS_HX = 38 * MiB;
constexpr size_t WS_FA = WS_HX;
constexpr size_t WS_Q = 71 * MiB;
constexpr size_t WS_K = WS_Q + (size_t)MT * 512 * 2;
constexpr size_t WS_V = WS_K + (size_t)MT * 512 * 2;
constexpr size_t WS_Y = 71 * MiB;
constexpr size_t WS_G = 121 * MiB;
constexpr size_t WS_ACAT = 187 * MiB;
constexpr size_t WS_UF = 229 * MiB;
constexpr size_t WS_ZG = WS_UF + (size_t)MT * 256 * 2;
constexpr size_t WS_UP = WS_ZG + (size_t)MT * 256 * 2;
constexpr size_t WS_GT = 71 * MiB;
constexpr size_t WS_H = 162 * MiB;
constexpr size_t WS_END = 256 * MiB;
static_assert(WS_TW + 8192 * 8 <= WS_FT && WS_FT + 4 * 4096 * 16 <= WS_XC && WS_WDN + (size_t)1024 * 2816 * 2 <= WS_HX && WS_V + (size_t)MT * 512 * 2 <= WS_G && WS_G + (size_t)MT * 4096 <= WS_ACAT, "ws map 1");
static_assert(WS_ACAT + (size_t)MT * 1280 * 2 <= WS_UF && WS_UP + (size_t)MT * 256 * 2 <= WS_END && WS_GT + (size_t)MT * 2816 * 2 <= WS_H && WS_H + (size_t)MT * 2816 * 2 <= WS_END, "ws map 2");
static_assert(WS_HX + (size_t)MT * 1024 * 2 <= WS_Q && (size_t)2 * 4 * 128 * 64 * 64 * 8 <= (size_t)MT * 1024 * 2, "ws map 3");
constexpr int CW_TMO = 0, CW_CODE = 1, CW_BAR = 4096;

constexpr int RING_BYTES = 131072, LDSCTL_OFF = RING_BYTES, MISC_OFF = LDSCTL_OFF + 320, LDS_BYTES = 147456;

typedef __bf16 bf16x2_t __attribute__((ext_vector_type(2)));
__device__ __forceinline__ unsigned cvt2bf(float lo, float hi) { const f32x2 v = {lo, hi}; return __builtin_bit_cast(unsigned, __builtin_convertvector(v, bf16x2_t)); }
template <int M> __device__ __forceinline__ float swz_xor(float v) { return __int_as_float(__builtin_amdgcn_ds_swizzle(__float_as_int(v), (M << 10) | 0x1f)); }
__device__ __forceinline__ float bf2f(unsigned v) { return __uint_as_float(v << 16); }
__device__ __forceinline__ float sigm(float x) { return __builtin_amdgcn_rcpf(1.0f + __builtin_amdgcn_exp2f(x * -1.4426950408889634f)); }
__host__ __device__ __forceinline__ int in_map(int n) {
    if (n < 256) return n;
    if (n < 1280) { const int base = n < 768 ? 256 : 768, r = n - base, comp = r >> 6, p = r & 63, pp = p >> 1, e = p & 1;
        return base + comp * 64 + (pp < 16 ? 0 : 32) + (pp & 15) + 16 * e; }
    if (n < 1792) return n;
    if (n < 2304) { const int r = n - 1792; return 1792 + (r & 1) * 256 + (r >> 1); }
    return n;
}
namespace pg8 {
#define PG8_LAS __attribute__((address_space(3)))
typedef unsigned short bf16_t;
typedef short bf16x8 __attribute__((ext_vector_type(8)));
typedef float f32x4 __attribute__((ext_vector_type(4)));
typedef unsigned u32x4 __attribute__((ext_vector_type(4)));
constexpr int BM = 256, BK = 64, HALF = 128, HTB = HALF * BK * 2  , STAGE_BYTES = 8 * HTB, NXCD = 8, WGM = 8;

__host__ __device__ __forceinline__ int lds_byte(int r, int c) { const int st = (r >> 4) * 2 + (c >> 5), rr = r & 15, cc = c & 31, ob = rr * 64 + cc * 2; return st * 1024 + (ob ^ (((ob >> 9) & 1) << 5)); }
__host__ __device__ __forceinline__ void stage_rc(int b, int& R, int& C) { const int st = b / 1024, sb = b % 1024, swz = sb ^ (((sb >> 9) & 1) << 5); R = (st >> 1) * 16 + swz / 64; C = (st & 1) * 32 + (swz % 64) / 2; }
__host__ __device__ __forceinline__ int perm32(int rho) { const int n = rho >> 4, i = rho & 15; return 8 * (i >> 2) + 4 * n + (i & 3); }

struct Unit { int pm, pn, ko = 0, sl = 0; };
struct Gemm { const bf16_t* A; const bf16_t* Bt; int M, N, K, ld = 0; };

struct StaticOrder {
    int nM, nN, nwg, G, c, rev = 0, wgm = WGM;
    __host__ __device__ void init(int M, int N, int G_, int c_) { nM = M / BM; nN = N / BM; nwg = nM * nN; G = G_; c = c_; }
    __host__ __device__ bool next(int i, Unit& u) const {
        long L = (long)i * G + c;
        if (rev) { const int n_mine = (nwg - c + G - 1) / G; if (i >= n_mine) return false; L = (long)(n_mine - 1 - i) * G + c; }
        if (L >= nwg) return false;
        int wgid = (int)L; { const int q = nwg / NXCD, r = nwg % NXCD, xcd = wgid % NXCD, off = wgid / NXCD; wgid = (xcd < r ? xcd * (q + 1) : r * (q + 1) + (xcd - r) * q) + off; }
        const int nig = wgm * nN, gid = wgid / nig, fm = gid * wgm, gsz = (nM - fm) < wgm ? (nM - fm) : wgm;
        u.pm = fm + ((wgid % nig) % gsz); u.pn = (wgid % nig) / gsz; return true;
    }
    __device__ __forceinline__ void a_ready(const Unit&) const {}
    __device__ __forceinline__ void done(const Unit&) const {}
};
__device__ __forceinline__ unsigned cvt_pk_bf16(float lo, float hi) { return cvt2bf(lo, hi); }
typedef float f32x2 __attribute__((ext_vector_type(2)));
__device__ __forceinline__ float gelu_mul(float v, float val) {
    asm volatile("" : "+v"(v));
    const float av = __builtin_fabsf(v);
    const float t = __builtin_amdgcn_rcpf(__builtin_fmaf(av, 0.33267292f, 1.0f));
    float q = __builtin_fmaf(t, 0.3739278f, -0.0479399f); q = __builtin_fmaf(q, t, 0.1740121f); q = q * t;
    const float e = __builtin_amdgcn_exp2f((v * v) * (-0.72134752044f));
    const float h = __builtin_fmaf(-q, e, 0.5f);
    return val * __builtin_fmaf(av, h, 0.5f * v);
}
__device__ __forceinline__ float gelu_s(float v) {
    asm volatile("" : "+v"(v));
    const float t = __builtin_amdgcn_rcpf(__builtin_fabsf(v) * 0.2316418882f + 1.0f);
    float q = t * 0.5307027145f + (-0.7265760135f); q = q * t + 0.7107068705f; q = q * t + (-0.142248368f); q = q * t + 0.127414796f; q = q * t;
    const float e = __builtin_amdgcn_exp2f((v * v) * (-0.72134752044f));
    const float m = v * (q * e);
    return v < 0.f ? m : v - m;
}
__device__ __forceinline__ f32x2 gelu_pk(f32x2 v) {
    const f32x2 av = __builtin_elementwise_abs(v), d = av * 0.2316418882f + 1.0f;
    f32x2 t; t.x = __builtin_amdgcn_rcpf(d.x); t.y = __builtin_amdgcn_rcpf(d.y);
    f32x2 q = t * 0.5307027145f + (-0.7265760135f); q = q * t + 0.7107068705f; q = q * t + (-0.142248368f); q = q * t + 0.127414796f; q = q * t;
    const f32x2 s = (v * v) * (-0.72134752044f);
    f32x2 e; e.x = __builtin_amdgcn_exp2f(s.x); e.y = __builtin_amdgcn_exp2f(s.y);
    const f32x2 m = v * (q * e), r = v - m;
    f32x2 o; o.x = v.x < 0.f ? m.x : r.x; o.y = v.y < 0.f ? m.y : r.y; return o;
}

typedef unsigned u32x2 __attribute__((ext_vector_type(2)));
__device__ __forceinline__ u32x4 pack8(const f32x4 a, const f32x4 b) { u32x4 w; w.x = cvt_pk_bf16(a[0], a[1]); w.y = cvt_pk_bf16(a[2], a[3]); w.z = cvt_pk_bf16(b[0], b[1]); w.w = cvt_pk_bf16(b[2], b[3]); return w; }

__host__ __device__ __forceinline__ size_t gofs(int row, int col) { return ((size_t)((row >> 4) * 128 + (col >> 5)) << 9) + (size_t)((row & 15) * 32 + (col & 31)); }
__host__ __device__ __forceinline__ size_t gtofs(int row, int col) { return ((size_t)((row >> 4) * 88 + (col >> 5)) << 9) + (size_t)((row & 15) * 32 + (col & 31)); }
struct EpiIn {
    static constexpr bool PERM = true, AFTER_DRAIN = false, RESCALE = false; static constexpr int NVM = 16;
    bf16_t *UF, *ZG, *UP, *Q, *K, *V; unsigned char* G; const float* rope;
    __device__ __forceinline__ void operator()(const f32x4 (&acc)[2][2][4][2], const Unit& u, int wr, int wc, int fr, int fq) const {
        const int pm = u.pm, pn = u.pn; const bool lat = pm < 64; const int R0 = pm * 256;
        const int kv0 = lat ? ((pm >> 5) * 8448 + 256 + ((pm & 31) << 8)) : ((pm - 64) * 8448);
        const int rl = wr * 64 + fr, cl = wc * 32 + 8 * fq;
        if (pn == 0 || pn == 9) {
            bf16_t* dst = (pn == 0 ? UF : UP);
#pragma unroll
            for (int ai = 0; ai < 2; ++ai)
#pragma unroll
                for (int m = 0; m < 4; ++m) { const int rr = ai * 128 + m * 16 + rl;
#pragma unroll
                    for (int bj = 0; bj < 2; ++bj) *(u32x4*)(dst + (size_t)(R0 + rr) * 256 + bj * 128 + cl) = pack8(acc[ai][bj][m][0], acc[ai][bj][m][1]); }
        } else if (pn <= 4) {
            const bool isq = pn <= 2; bf16_t* dst = isq ? Q : K; const int rowbase = isq ? R0 : kv0, colbase = (isq ? pn - 1 : pn - 3) * 256; const float sc = isq ? (ATT_V == 2 ? 0.18033688011112042f : 0.125f) : 1.0f;
#pragma unroll
            for (int ai = 0; ai < 2; ++ai)
#pragma unroll
                for (int m = 0; m < 4; ++m) { const int rr = ai * 128 + m * 16 + rl;
                    f32x4 cs = {1.f, 1.f, 1.f, 1.f}, sn = {0.f, 0.f, 0.f, 0.f};
                    if (lat) { const int t = (R0 & 8191) + rr; const int pos = (wc & 1) ? 128 + (t & 63) : (t >> 6);
                        cs = *(const f32x4*)(rope + pos * 32 + 4 * fq); sn = *(const f32x4*)(rope + pos * 32 + 16 + 4 * fq); }
                    cs = cs * sc; sn = sn * sc;
#pragma unroll
                    for (int bj = 0; bj < 2; ++bj) { const f32x4 a = acc[ai][bj][m][0], b = acc[ai][bj][m][1]; f32x4 oa, ob;
                        oa[0] = a[0] * cs[0] - a[1] * sn[0]; oa[1] = a[1] * cs[0] + a[0] * sn[0]; oa[2] = a[2] * cs[1] - a[3] * sn[1]; oa[3] = a[3] * cs[1] + a[2] * sn[1];
                        ob[0] = b[0] * cs[2] - b[1] * sn[2]; ob[1] = b[1] * cs[2] + b[0] * sn[2]; ob[2] = b[2] * cs[3] - b[3] * sn[3]; ob[3] = b[3] * cs[3] + b[2] * sn[3];
                        *(u32x4*)(dst + (size_t)(rowbase + rr) * 512 + colbase + bj * 128 + cl) = pack8(oa, ob); } }
        } else if (pn <= 6) {
#pragma unroll
            for (int ai = 0; ai < 2; ++ai)
#pragma unroll
                for (int m = 0; m < 4; ++m) { const int rr = ai * 128 + m * 16 + rl;
#pragma unroll
                    for (int bj = 0; bj < 2; ++bj) *(u32x4*)(V + (size_t)(kv0 + rr) * 512 + (pn - 5) * 256 + bj * 128 + cl) = pack8(acc[ai][bj][m][0], acc[ai][bj][m][1]); }
        } else if (pn <= 8) {
#pragma unroll
            for (int ai = 0; ai < 2; ++ai)
#pragma unroll
                for (int m = 0; m < 4; ++m) { const int rr = ai * 128 + m * 16 + rl;
#pragma unroll
                    for (int bj = 0; bj < 2; ++bj) { const f32x4 a = acc[ai][bj][m][0], b = acc[ai][bj][m][1];
                        u32x2 w; w.x = cvt_pk_bf16(a[0] * sigm(a[1]), a[2] * sigm(a[3])); w.y = cvt_pk_bf16(b[0] * sigm(b[1]), b[2] * sigm(b[3]));
                        *(u32x2*)(ZG + (size_t)(R0 + rr) * 256 + (pn - 7) * 128 + bj * 64 + (cl >> 1)) = w; } }
        } else {
#pragma unroll
            for (int ai = 0; ai < 2; ++ai)
#pragma unroll
                for (int m = 0; m < 4; ++m) { const int rr = ai * 128 + m * 16 + rl;
#pragma unroll
                    for (int bj = 0; bj < 2; ++bj) { u32x2 w;
#pragma unroll
                        for (int n = 0; n < 2; ++n) { const f32x4 a = acc[ai][bj][m][n]; unsigned q = 0;
#pragma unroll
                            for (int j = 0; j < 4; ++j) { float s = sigm(a[j]) * 255.0f + 0.5f; s = s < 1.0f ? 1.0f : s; q |= ((unsigned)s) << (8 * j); }
                            if (n == 0) w.x = q; else w.y = q; }
                        *(u32x2*)(G + gofs(R0 + rr, (pn - 10) * 256 + bj * 128 + cl)) = w; } }
        }
    }
};

struct EpiBf {
    static constexpr bool PERM = true, AFTER_DRAIN = false, RESCALE = false; static constexpr int NVM = 16;
    bf16_t* O; int ldc;
    __device__ __forceinline__ void operator()(const f32x4 (&acc)[2][2][4][2], const Unit& u, int wr, int wc, int fr, int fq) const {
        const int row0 = u.pm * 256 + wr * 64 + fr, col0 = u.pn * 256 + wc * 32 + 8 * fq;
#pragma unroll
        for (int ai = 0; ai < 2; ++ai)
#pragma unroll
            for (int m = 0; m < 4; ++m)
#pragma unroll
                for (int bj = 0; bj < 2; ++bj) *(u32x4*)(O + gtofs(row0 + ai * 128 + m * 16, col0 + bj * 128)) = pack8(acc[ai][bj][m][0], acc[ai][bj][m][1]);
    }
};

struct EpiNull {
    static constexpr bool PERM = true, AFTER_DRAIN = false, RESCALE = false; static constexpr int NVM = 0 ;
    __device__ __forceinline__ void operator()(const f32x4 (&acc)[2][2][4][2], const Unit&, int, int, int, int) const {
#pragma unroll
        for (int ai = 0; ai < 2; ++ai)
#pragma unroll
            for (int m = 0; m < 4; ++m)
#pragma unroll
                for (int bj = 0; bj < 2; ++bj) asm volatile("" :: "v"(acc[ai][bj][m][0]), "v"(acc[ai][bj][m][1]));
    }
};

struct EpiRes {
    static constexpr bool PERM = true, AFTER_DRAIN = false, RESCALE = false; static constexpr int NVM = 16;
    const float* base_f32; const bf16_t* base_bf; const float* base_ctx; bf16_t* out_bf; float* out_ctx; const float* mod; int goff;
    __device__ __forceinline__ void operator()(const f32x4 (&acc)[2][2][4][2], const Unit& u, int wr, int wc, int fr, int fq) const {
        const int pm = u.pm; const bool lat = pm < 64; const int mrow = lat ? (pm >> 5) : 2;
        const int col0 = u.pn * 256 + wc * 32 + 8 * fq;
        f32x4 gv[2][2];
#pragma unroll
        for (int bj = 0; bj < 2; ++bj)
#pragma unroll
            for (int n = 0; n < 2; ++n) gv[bj][n] = *(const f32x4*)(mod + mrow * 6144 + goff + col0 + bj * 128 + 4 * n);
#pragma unroll
        for (int ai = 0; ai < 2; ++ai)
#pragma unroll
            for (int m = 0; m < 4; ++m) { const size_t ro = (size_t)((lat ? pm : pm - 64) * 256 + ai * 128 + wr * 64 + m * 16 + fr) * 1024 + col0;
#pragma unroll
                for (int bj = 0; bj < 2; ++bj) { const size_t off = ro + bj * 128; f32x4 b0, b1;
                    if (!lat) { b0 = *(const f32x4*)(base_ctx + off); b1 = *(const f32x4*)(base_ctx + off + 4); }
                    else if (base_f32) { b0 = *(const f32x4*)(base_f32 + off); b1 = *(const f32x4*)(base_f32 + off + 4); }
                    else { const u32x4 w = *(const u32x4*)(base_bf + off);
                        b0 = (f32x4){__uint_as_float(w.x << 16), __uint_as_float(w.x & 0xffff0000u), __uint_as_float(w.y << 16), __uint_as_float(w.y & 0xffff0000u)};
                        b1 = (f32x4){__uint_as_float(w.z << 16), __uint_as_float(w.z & 0xffff0000u), __uint_as_float(w.w << 16), __uint_as_float(w.w & 0xffff0000u)}; }
                    const f32x4 o0 = b0 + gv[bj][0] * acc[ai][bj][m][0], o1 = b1 + gv[bj][1] * acc[ai][bj][m][1];
                    if (lat) *(u32x4*)(out_bf + off) = pack8(o0, o1); else { *(f32x4*)(out_ctx + off) = o0; *(f32x4*)(out_ctx + off + 4) = o1; } } }
    }
};

struct EpiVal {
    static constexpr bool PERM = true, AFTER_DRAIN = false, RESCALE = false; static constexpr int NVM = 16;
    const bf16_t* GT; bf16_t* H; const float* dww; const float* dwb;
    __device__ __forceinline__ void operator()(const f32x4 (&acc)[2][2][4][2], const Unit& u, int wr, int wc, int fr, int fq) const {
        const int pm = u.pm; const bool lat = pm < 64; const int R0 = pm * 256, t0 = lat ? (R0 & 8191) : 0, L = lat ? 8192 : 256;
#pragma unroll
        for (int bj = 0; bj < 2; ++bj) { const int col = u.pn * 256 + bj * 128 + wc * 32 + 8 * fq;
            f32x4 w0[2], w1[2], w2[2], bb[2];
#pragma unroll
            for (int n = 0; n < 2; ++n) { w0[n] = *(const f32x4*)(dww + col + 4 * n); w1[n] = *(const f32x4*)(dww + 2816 + col + 4 * n); w2[n] = *(const f32x4*)(dww + 5632 + col + 4 * n); bb[n] = *(const f32x4*)(dwb + col + 4 * n); }
#pragma unroll
            for (int ai = 0; ai < 2; ++ai) {
                const int rb = ai * 128 + wr * 64, tb = t0 + rb;
                u32x4 g[4], elo = {0u, 0u, 0u, 0u}, ehi = {0u, 0u, 0u, 0u};
#pragma unroll
                for (int m = 0; m < 4; ++m) g[m] = *(const u32x4*)(GT + gtofs(R0 + rb + m * 16 + fr, col));
                if (tb > 0) elo = *(const u32x4*)(GT + gtofs(R0 + rb - 1, col));
                if (tb + 64 < L) ehi = *(const u32x4*)(GT + gtofs(R0 + rb + 64, col));
                asm volatile("" ::: "memory");
#pragma unroll
                for (int m = 0; m < 4; ++m) { const int rr = rb + m * 16 + fr;
                    u32x4 gm, gq;
#pragma unroll
                    for (int d = 0; d < 4; ++d) {
                        const int pa = (m == 0) ? (int)elo[d] : __builtin_amdgcn_update_dpp(0, (int)g[m == 0 ? 0 : m - 1][d], 0x121  , 0xF, 0xF, true);
                        gm[d] = (unsigned)__builtin_amdgcn_update_dpp(pa, (int)g[m][d], 0x111  , 0xF, 0xF, false);
                        const int pb = (m == 3) ? (int)ehi[d] : __builtin_amdgcn_update_dpp(0, (int)g[m == 3 ? 3 : m + 1][d], 0x12F  , 0xF, 0xF, true);
                        gq[d] = (unsigned)__builtin_amdgcn_update_dpp(pb, (int)g[m][d], 0x101  , 0xF, 0xF, false); }
                    f32x4 o[2];
#pragma unroll
                    for (int n = 0; n < 2; ++n) { f32x4 c;
#pragma unroll
                        for (int j = 0; j < 4; ++j) { const int e = 4 * n + j; const unsigned wm = gm[e >> 1], wz = g[m][e >> 1], wp = gq[e >> 1];
                            const float xm = (e & 1) ? __uint_as_float(wm & 0xffff0000u) : __uint_as_float(wm << 16), xz = (e & 1) ? __uint_as_float(wz & 0xffff0000u) : __uint_as_float(wz << 16),
                                        xp = (e & 1) ? __uint_as_float(wp & 0xffff0000u) : __uint_as_float(wp << 16);
                            c[j] = __builtin_fmaf(w2[n][j], xp, __builtin_fmaf(w1[n][j], xz, __builtin_fmaf(w0[n][j], xm, bb[n][j]))); }
                        const f32x4 v = acc[ai][bj][m][n]; o[n] = (f32x4){gelu_mul(c[0], v[0]), gelu_mul(c[1], v[1]), gelu_mul(c[2], v[2]), gelu_mul(c[3], v[3])}; }
                    *(u32x4*)(H + (size_t)(R0 + rr) * 2816 + col) = pack8(o[0], o[1]); }
                asm volatile("" ::: "memory");
            }
        }
    }
};

struct EpiBranch {
    static constexpr bool PERM = true, AFTER_DRAIN = false, RESCALE = true; static constexpr int NVM = 16;
    const unsigned char* G; bf16_t* Y;
    __device__ __forceinline__ void rescale(f32x4 (&acc)[2][2][4][2], const Unit& u, int t, int wr, int wc, int fr, int fq) const {
        const int bp = (t == 4) ? 0 : (t == 12) ? 1 : 2;
        const __amdgpu_buffer_rsrc_t rs = __builtin_amdgcn_make_buffer_rsrc((void*)G, 0, MT * 4096, 0x00020000);
        const int voff = fr * 32 + 8 * fq;
        u32x2 p[2][4][2], q[2][4][2];
#pragma unroll
        for (int ai = 0; ai < 2; ++ai)
#pragma unroll
            for (int m = 0; m < 4; ++m)
#pragma unroll
                for (int bj = 0; bj < 2; ++bj) { const int so = ((u.pm * 16 + ai * 8 + wr * 4 + m) * 128 + bp * 32 + u.pn * 8 + bj * 4 + wc) * 512;
                    p[ai][m][bj] = __builtin_bit_cast(u32x2, __builtin_amdgcn_raw_buffer_load_b64(rs, voff, so, 0)); q[ai][m][bj] = __builtin_bit_cast(u32x2, __builtin_amdgcn_raw_buffer_load_b64(rs, voff, so + 32 * 512, 0)); }
        asm volatile("" ::: "memory");
#pragma unroll
        for (int ai = 0; ai < 2; ++ai)
#pragma unroll
            for (int m = 0; m < 4; ++m)
#pragma unroll
                for (int bj = 0; bj < 2; ++bj)
#pragma unroll
                    for (int n = 0; n < 2; ++n) { const unsigned pw = n ? p[ai][m][bj].y : p[ai][m][bj].x, qw = n ? q[ai][m][bj].y : q[ai][m][bj].x;
#pragma unroll
                        for (int j = 0; j < 4; ++j) acc[ai][bj][m][n][j] *= (float)((pw >> (8 * j)) & 255u) * __builtin_amdgcn_rcpf((float)((qw >> (8 * j)) & 255u)); }
        asm volatile("" ::: "memory");
    }
    __device__ __forceinline__ void operator()(const f32x4 (&acc)[2][2][4][2], const Unit& u, int wr, int wc, int fr, int fq) const {
        const int row0 = u.pm * 256 + wr * 64 + fr, col0 = u.pn * 256 + wc * 32 + 8 * fq;
#pragma unroll
        for (int ai = 0; ai < 2; ++ai)
#pragma unroll
            for (int m = 0; m < 4; ++m)
#pragma unroll
                for (int bj = 0; bj < 2; ++bj) { const size_t r = (size_t)(row0 + ai * 128 + m * 16); const u32x2 p = *(const u32x2*)(G + gofs((int)r, 3072 + col0 + bj * 128));
                    f32x4 o[2];
#pragma unroll
                    for (int n = 0; n < 2; ++n) { const unsigned pw = n ? p.y : p.x;
#pragma unroll
                        for (int j = 0; j < 4; ++j) o[n][j] = acc[ai][bj][m][n][j] * ((float)((pw >> (8 * j)) & 255u) * (1.0f / 255.0f)); }
                    *(u32x4*)(Y + r * 1024 + col0 + bj * 128) = pack8(o[0], o[1]); }
    }
};


struct SplitKOrder {
    int nsl, ksl, G, c;
    __device__ __forceinline__ bool next(int i, Unit& u) const { const int L = i * G + c; if (L >= 8 * nsl) return false; u.pm = (L >> 2) & 1; u.pn = L & 3; u.sl = L >> 3; u.ko = u.sl * ksl; return true; }
    __device__ __forceinline__ void a_ready(const Unit&) const {}
    __device__ __forceinline__ void done(const Unit&) const {}
};
struct EpiSlab {
    static constexpr bool PERM = false, AFTER_DRAIN = false, RESCALE = false; static constexpr int NVM = 16;
    float* slab;
    __device__ __forceinline__ void operator()(const f32x4 (&acc)[2][2][4][2], const Unit& u, int wr, int wc, int, int) const {
        int ln; asm volatile("v_mbcnt_lo_u32_b32 %0, -1, 0\n\tv_mbcnt_hi_u32_b32 %0, -1, %0" : "=v"(ln));
        const int fr = ln & 15, fq = ln >> 4;
        float* o = slab + (size_t)u.sl * 512 * 1024 + (size_t)(u.pm * 256 + wr * 64 + fr) * 1024 + u.pn * 256 + wc * 32 + 4 * fq;
#pragma unroll
        for (int ai = 0; ai < 2; ++ai)
#pragma unroll
            for (int m = 0; m < 4; ++m)
#pragma unroll
                for (int bj = 0; bj < 2; ++bj)
#pragma unroll
                    for (int n = 0; n < 2; ++n) *(f32x4*)(o + (size_t)(ai * 128 + m * 16) * 1024 + bj * 128 + n * 16) = acc[ai][bj][m][n];
    }
};

struct BranchSliceOrder {
    int G, c;
    __device__ __forceinline__ bool next(int i, Unit& u) const { const int L = i * G + c; if (L >= 40) return false; u.pm = (L >> 2) & 1; u.pn = L & 3; u.sl = L >> 3; u.ko = u.sl * 256; return true; }
    __device__ __forceinline__ void a_ready(const Unit&) const {}
    __device__ __forceinline__ void done(const Unit&) const {}
};
template <class Epi, class Sched, bool ALIGN_EPI = false, bool SP2 = false>
__device__ __forceinline__ void gemm_phase(PG8_LAS unsigned char* lds, const Gemm g, const Sched& S, const Epi& E, const int tid) {
    const int wid = __builtin_amdgcn_readfirstlane(tid >> 6), lane = tid & 63, wr = wid >> 2, wc = wid & 3, fr = lane & 15, fq = lane >> 4;
    const int K = g.ld ? g.ld : g.K  , nt = g.K / BK;
    unsigned voffA[2], voffB[2];
#pragma unroll
    for (int i = 0; i < 2; ++i) { int R, C; stage_rc(tid * 16 + i * 8192, R, C); const int Rb = Epi::PERM ? ((R & ~31) + perm32(R & 31)) : R;
        voffA[i] = (unsigned)(R * K + C) * 2u; voffB[i] = (unsigned)(Rb * K + C) * 2u; }
    const size_t kstep = (size_t)(BK * 2);
    const size_t hstep = (size_t)HALF * K * 2;
    const size_t tstep = 2 * hstep;
    const unsigned ldsw = (unsigned)wid * 1024u;
    const int aoff = lds_byte(wr * 64 + fr, fq * 8), boff = lds_byte(wc * 32 + fr, fq * 8);
#define PG8_SA(b, h) (((b) * 2 + (h)) * HTB)
#define PG8_SB(b, h) ((4 + (b) * 2 + (h)) * HTB)
#define PG8_STAGE(bufoff, gbase, voff) do { _Pragma("unroll") for (int _i = 0; _i < 2; ++_i) \
        __builtin_amdgcn_global_load_lds((const unsigned*)((const char*)(gbase) + (voff)[_i]), (PG8_LAS unsigned*)(lds + (bufoff) + ldsw + _i * 8192), 16, 0, 0); } while (0)
#define PG8_LDA(dst, b, h) do { _Pragma("unroll") for (int m = 0; m < 4; ++m) _Pragma("unroll") for (int k = 0; k < 2; ++k) dst[m][k] = *(const PG8_LAS bf16x8*)(lds + PG8_SA(b, h) + aoff + m * 2048 + k * 1024); } while (0)
#define PG8_LDB(dst, b, h) do { _Pragma("unroll") for (int n = 0; n < 2; ++n) _Pragma("unroll") for (int k = 0; k < 2; ++k) dst[n][k] = *(const PG8_LAS bf16x8*)(lds + PG8_SB(b, h) + boff + n * 2048 + k * 1024); } while (0)
#define PG8_MMA(ai, bj, At, Bt) do { __builtin_amdgcn_s_setprio(1); _Pragma("unroll") for (int m = 0; m < 4; ++m) _Pragma("unroll") for (int n = 0; n < 2; ++n) _Pragma("unroll") for (int k = 0; k < 2; ++k) \
        acc[ai][bj][m][n] = __builtin_amdgcn_mfma_f32_16x16x32_bf16(Bt[n][k], At[m][k], acc[ai][bj][m][n], 0, 0, 0); __builtin_amdgcn_s_setprio(0); } while (0)
#define PG8_WAIT_V(n) asm volatile("s_waitcnt vmcnt(" #n ")" ::: "memory")
#define PG8_WAIT_L(n) asm volatile("s_waitcnt lgkmcnt(" #n ")" ::: "memory")
#define PG8_BAR __builtin_amdgcn_s_barrier()
#define PG8_SCHED __builtin_amdgcn_sched_barrier(0)
    Unit cur, nxt; int ui = 0;
    if (!S.next(0, cur)) return;
    f32x4 acc[2][2][4][2];
#pragma unroll
    for (int a = 0; a < 2; ++a)
#pragma unroll
        for (int b = 0; b < 2; ++b)
#pragma unroll
            for (int m = 0; m < 4; ++m)
#pragma unroll
                for (int n = 0; n < 2; ++n) acc[a][b][m][n] = (f32x4){0.f, 0.f, 0.f, 0.f};
    bf16x8 At[4][2], B0[2][2], B1[2][2];
    const char* cA = (const char*)g.A + (size_t)cur.pm * tstep + (size_t)cur.ko * 2; const char* cB = (const char*)g.Bt + (size_t)cur.pn * tstep + (size_t)cur.ko * 2;
    S.a_ready(cur);
    if constexpr (SP2) {
        PG8_STAGE(PG8_SB(0, 0), cB, voffB); PG8_STAGE(PG8_SB(0, 1), cB + hstep, voffB); PG8_STAGE(PG8_SA(0, 0), cA, voffA); PG8_STAGE(PG8_SA(0, 1), cA + hstep, voffA);
        if (wr == 1) PG8_BAR;
        PG8_WAIT_V(2); PG8_BAR;
        PG8_STAGE(PG8_SB(1, 0), cB + kstep, voffB); PG8_STAGE(PG8_SA(1, 0), cA + kstep, voffA); PG8_STAGE(PG8_SB(1, 1), cB + hstep + kstep, voffB);
        PG8_WAIT_V(6); PG8_BAR;
    } else {
        PG8_STAGE(PG8_SB(0, 0), cB, voffB); PG8_STAGE(PG8_SA(0, 0), cA, voffA); PG8_STAGE(PG8_SB(0, 1), cB + hstep, voffB); PG8_STAGE(PG8_SA(0, 1), cA + hstep, voffA);
        if (wr == 1) PG8_BAR;
        PG8_WAIT_V(4); PG8_BAR;
        PG8_STAGE(PG8_SB(1, 0), cB + kstep, voffB); PG8_STAGE(PG8_SA(1, 0), cA + kstep, voffA); PG8_STAGE(PG8_SB(1, 1), cB + hstep + kstep, voffB);
        PG8_WAIT_V(6); PG8_BAR;
    }
    for (;;) {
        const bool has_next = S.next(ui + 1, nxt);
        const char* nA = has_next ? (const char*)g.A + (size_t)nxt.pm * tstep + (size_t)nxt.ko * 2 : cA; const char* nB = has_next ? (const char*)g.Bt + (size_t)nxt.pn * tstep + (size_t)nxt.ko * 2 : cB;
        for (int t = 0; t < nt; t += 2) {
            if constexpr (Epi::RESCALE) { if (t == 4 || t == 12 || t == 16) E.rescale(acc, cur, t, wr, wc, fr, fq); }
            const bool last = (t == nt - 2);
            const char* a1 = cA + (size_t)(t + 1) * kstep;
            const char* a2 = last ? nA : cA + (size_t)(t + 2) * kstep; const char* b2 = last ? nB : cB + (size_t)(t + 2) * kstep;
            const char* a3 = a2 + kstep; const char* b3 = b2 + kstep;
            if (last && has_next) S.a_ready(nxt);
            if constexpr (SP2) {
            PG8_LDB(B0, 0, 0); PG8_LDB(B1, 0, 1); PG8_SCHED; PG8_LDA(At, 0, 0); PG8_STAGE(PG8_SA(1, 1), a1 + hstep, voffA);
            PG8_WAIT_V(8); PG8_WAIT_L(0); PG8_BAR; PG8_MMA(0, 0, At, B0); PG8_MMA(0, 1, At, B1); PG8_BAR; PG8_SCHED;
            PG8_LDA(At, 0, 1); PG8_STAGE(PG8_SB(0, 0), b2, voffB); PG8_STAGE(PG8_SB(0, 1), b2 + hstep, voffB); PG8_STAGE(PG8_SA(0, 0), a2, voffA);
            PG8_WAIT_V(8); PG8_WAIT_L(0); PG8_BAR; PG8_MMA(1, 0, At, B0); PG8_MMA(1, 1, At, B1); PG8_BAR; PG8_SCHED;
            PG8_LDB(B0, 1, 0); PG8_LDB(B1, 1, 1); PG8_SCHED; PG8_LDA(At, 1, 0); PG8_STAGE(PG8_SA(0, 1), a2 + hstep, voffA);
            PG8_WAIT_V(8); PG8_WAIT_L(0); PG8_BAR; PG8_MMA(0, 0, At, B0); PG8_MMA(0, 1, At, B1); PG8_BAR; PG8_SCHED;
            PG8_LDA(At, 1, 1); PG8_STAGE(PG8_SB(1, 0), b3, voffB); PG8_STAGE(PG8_SB(1, 1), b3 + hstep, voffB); PG8_STAGE(PG8_SA(1, 0), a3, voffA);
            PG8_WAIT_V(8); PG8_WAIT_L(0); PG8_BAR; PG8_MMA(1, 0, At, B0); PG8_MMA(1, 1, At, B1); PG8_BAR; PG8_SCHED;
            } else {
            PG8_LDB(B0, 0, 0); PG8_SCHED; PG8_LDA(At, 0, 0); PG8_STAGE(PG8_SA(1, 1), a1 + hstep, voffA);
            PG8_WAIT_L(8); PG8_BAR; PG8_WAIT_L(0); PG8_MMA(0, 0, At, B0); PG8_BAR; PG8_SCHED;
            PG8_LDB(B1, 0, 1); PG8_STAGE(PG8_SB(0, 0), b2, voffB);
            PG8_BAR; PG8_WAIT_L(0); PG8_MMA(0, 1, At, B1); PG8_BAR;
            PG8_LDA(At, 0, 1); PG8_STAGE(PG8_SA(0, 0), a2, voffA);
            PG8_BAR; PG8_WAIT_L(0); PG8_MMA(1, 0, At, B0); PG8_BAR; PG8_SCHED;
            PG8_STAGE(PG8_SB(0, 1), b2 + hstep, voffB);
            PG8_WAIT_V(6); PG8_BAR; PG8_MMA(1, 1, At, B1); PG8_BAR;
            PG8_LDB(B0, 1, 0); PG8_SCHED; PG8_LDA(At, 1, 0); PG8_STAGE(PG8_SA(0, 1), a2 + hstep, voffA);
            PG8_WAIT_L(8); PG8_BAR; PG8_WAIT_L(0); PG8_MMA(0, 0, At, B0); PG8_BAR; PG8_SCHED;
            PG8_LDB(B1, 1, 1); PG8_STAGE(PG8_SB(1, 0), b3, voffB);
            PG8_BAR; PG8_WAIT_L(0); PG8_MMA(0, 1, At, B1); PG8_BAR;
            PG8_LDA(At, 1, 1); PG8_STAGE(PG8_SA(1, 0), a3, voffA);
            PG8_BAR; PG8_WAIT_L(0); PG8_MMA(1, 0, At, B0); PG8_BAR; PG8_SCHED;
            PG8_STAGE(PG8_SB(1, 1), b3 + hstep, voffB);
            PG8_WAIT_V(6); PG8_BAR; PG8_MMA(1, 1, At, B1); PG8_BAR;
            }
        }
        if constexpr (ALIGN_EPI) { if (wr == 0) PG8_BAR; }
        if constexpr (!Epi::AFTER_DRAIN) { E(acc, cur, wr, wc, fr, fq); S.done(cur); }
        if (!has_next) break;
#pragma unroll
        for (int a = 0; a < 2; ++a)
#pragma unroll
            for (int b = 0; b < 2; ++b)
#pragma unroll
                for (int m = 0; m < 4; ++m)
#pragma unroll
                    for (int n = 0; n < 2; ++n) acc[a][b][m][n] = (f32x4){0.f, 0.f, 0.f, 0.f};
        cur = nxt; cA = nA; cB = nB; ++ui;
        if constexpr (ALIGN_EPI) { if (wr == 1) PG8_BAR; }
    }
    PG8_WAIT_V(0);
    if constexpr (!ALIGN_EPI) { if (wr == 0) PG8_BAR; }
    PG8_BAR;
    if constexpr (Epi::AFTER_DRAIN) { E.fused(acc, cur, wr, wc, fr, fq, lds, wid, lane); S.done(cur); }
#undef PG8_SA
#undef PG8_SB
#undef PG8_STAGE
#undef PG8_LDA
#undef PG8_LDB
#undef PG8_MMA
#undef PG8_WAIT_V
#undef PG8_WAIT_L
#undef PG8_BAR
#undef PG8_SCHED
}
}
namespace att {
constexpr int NW = 8, QBLK = 32, KVBLK = 64, LDQ = 512, LDO = KCAT;
constexpr int SHM_V = 16384, SHM_K = 16384, SHM_ATTN = 3 * SHM_V + 2 * SHM_K + NW * 64 * 4;
constexpr float THR = 8.f;
#ifndef ATT_SDEPTH
#define ATT_SDEPTH 1
#endif
constexpr int SDEPTH = ATT_SDEPTH;
#define KSWZ(row, colB) ((row) * 256 + ((colB) ^ (((row) & 7) << 4)))
#define SBAR() __builtin_amdgcn_sched_barrier(0)
__device__ __forceinline__ int crow(int r, int hi) { return (r & 3) + 8 * (r >> 2) + 4 * hi; }
__device__ __forceinline__ unsigned cvtpk(float lo, float hi) { return cvt2bf(lo, hi); }

__device__ __forceinline__ void partialSM(f32x16& p0, f32x16& p1, float& m_reg, float& mn, float& alpha) {
  constexpr float C = 1.4426950408889634f;
  float pmax = p0[0];
#pragma unroll
  for (int r = 1; r < 16; ++r) pmax = fmaxf(pmax, p0[r]);
#pragma unroll
  for (int r = 0; r < 16; ++r) pmax = fmaxf(pmax, p1[r]);
  { auto rr = __builtin_amdgcn_permlane32_swap(__float_as_uint(pmax), __float_as_uint(pmax), false, false);
    pmax = fmaxf(__uint_as_float(rr[0]), __uint_as_float(rr[1])); }
  if (__builtin_expect(__all(pmax - m_reg <= THR), 1)) { mn = m_reg; alpha = 1.f; }
  else { mn = fmaxf(m_reg, pmax); alpha = __builtin_amdgcn_exp2f((m_reg - mn) * C); m_reg = mn; }
  const float mnC = -mn * C;
#pragma unroll
  for (int r = 0; r < 16; ++r) p0[r] = fmaf(p0[r], C, mnC);
#pragma unroll
  for (int r = 0; r < 16; ++r) p1[r] = fmaf(p1[r], C, mnC);
#pragma unroll
  for (int r = 0; r < 16; ++r) p0[r] = __builtin_amdgcn_exp2f(p0[r]);
}
__device__ __forceinline__ void finishSM(f32x16& p0, f32x16& p1, float alpha, float& l_reg, bf16x8& pa0, bf16x8& pa1, bf16x8& pa2, bf16x8& pa3) {
#pragma unroll
  for (int r = 0; r < 16; ++r) p1[r] = __builtin_amdgcn_exp2f(p1[r]);
  float ps = 0;
#pragma unroll
  for (int r = 0; r < 16; ++r) ps += p0[r];
#pragma unroll
  for (int r = 0; r < 16; ++r) ps += p1[r];
  { auto rr = __builtin_amdgcn_permlane32_swap(__float_as_uint(ps), __float_as_uint(ps), false, false);
    ps = __uint_as_float(rr[0]) + __uint_as_float(rr[1]); }
  l_reg = l_reg * alpha + ps;
#define PK4(P, BASE, OUT) do { unsigned a0 = cvtpk(P[BASE + 0], P[BASE + 1]), a1 = cvtpk(P[BASE + 2], P[BASE + 3]);   \
    unsigned b0 = cvtpk(P[BASE + 4], P[BASE + 5]), b1 = cvtpk(P[BASE + 6], P[BASE + 7]);                              \
    auto r0 = __builtin_amdgcn_permlane32_swap(a0, b0, false, false); auto r1 = __builtin_amdgcn_permlane32_swap(a1, b1, false, false); \
    u32x4 w = {r0[0], r1[0], r0[1], r1[1]}; OUT = *reinterpret_cast<bf16x8*>(&w); } while (0)
  PK4(p0, 0, pa0); PK4(p0, 8, pa1); PK4(p1, 0, pa2); PK4(p1, 8, pa3);
#undef PK4
}
__device__ __forceinline__ void qkt(f32x16& p0, f32x16& p1, const char* Ks, const bf16x8* qr, int r32, int hi, int kcol) {
  p0 = f32x16{}; p1 = f32x16{};
#pragma unroll
  for (int d0 = 0; d0 < 4; ++d0) { const int cb = kcol + (d0 * 16 + hi * 8) * 2;
    const bf16x8 b0 = *reinterpret_cast<const bf16x8*>(Ks + KSWZ(r32, cb));
    const bf16x8 b1 = *reinterpret_cast<const bf16x8*>(Ks + KSWZ(32 + r32, cb));
    p0 = __builtin_amdgcn_mfma_f32_32x32x16_bf16(b0, qr[d0], p0, 0, 0, 0);
    p1 = __builtin_amdgcn_mfma_f32_32x32x16_bf16(b1, qr[d0], p1, 0, 0, 0); }
}
__device__ __forceinline__ int v_st(int k, int c) { const int kk = (k & ~0xC) | ((k & 4) << 1) | ((k & 8) >> 1); return ((kk >> 3) * 4 + (c >> 5)) * 512 + ((kk & 7) * 32 + (c & 31)) * 2; }
__device__ __forceinline__ int v_rd_base(int lane) { return ((lane & 3) << 3) | (((lane >> 2) & 3) << 6) | (((lane >> 4) & 1) << 5) | (((lane >> 5) & 1) << 8); }
constexpr int v_rd_off(int d0, int ks, int half) { return d0 * 512 + ks * 4096 + half * 2048; }
template <int OFF> __device__ __forceinline__ s16x4 tr_read(int vb) {
  s16x4 r; asm volatile("ds_read_b64_tr_b16 %0, %1 offset:%2" : "=&v"(r) : "v"(vb), "i"(OFF) : "memory"); return r;
}
template <int D0> __device__ __forceinline__ void pv_one(f32x16& od, int vb, bf16x8 pa0, bf16x8 pa1, bf16x8 pa2, bf16x8 pa3) {
  const s16x4 l0 = tr_read<v_rd_off(D0, 0, 0)>(vb), h0 = tr_read<v_rd_off(D0, 0, 1)>(vb), l1 = tr_read<v_rd_off(D0, 1, 0)>(vb), h1 = tr_read<v_rd_off(D0, 1, 1)>(vb);
  const s16x4 l2 = tr_read<v_rd_off(D0, 2, 0)>(vb), h2 = tr_read<v_rd_off(D0, 2, 1)>(vb), l3 = tr_read<v_rd_off(D0, 3, 0)>(vb), h3 = tr_read<v_rd_off(D0, 3, 1)>(vb);
  asm volatile("s_waitcnt lgkmcnt(0)" ::: "memory"); SBAR();
#define PK(L, H) (bf16x8){L[0], L[1], L[2], L[3], H[0], H[1], H[2], H[3]}
  od = __builtin_amdgcn_mfma_f32_32x32x16_bf16(pa0, PK(l0, h0), od, 0, 0, 0);
  od = __builtin_amdgcn_mfma_f32_32x32x16_bf16(pa1, PK(l1, h1), od, 0, 0, 0);
  od = __builtin_amdgcn_mfma_f32_32x32x16_bf16(pa2, PK(l2, h2), od, 0, 0, 0);
  od = __builtin_amdgcn_mfma_f32_32x32x16_bf16(pa3, PK(l3, h3), od, 0, 0, 0);
#undef PK
}
__device__ __forceinline__ void pv_d0(f32x16* o, int vb, bf16x8 pa0, bf16x8 pa1, bf16x8 pa2, bf16x8 pa3) {
  pv_one<0>(o[0], vb, pa0, pa1, pa2, pa3); pv_one<1>(o[1], vb, pa0, pa1, pa2, pa3); pv_one<2>(o[2], vb, pa0, pa1, pa2, pa3); pv_one<3>(o[3], vb, pa0, pa1, pa2, pa3);
}

template <int VAR>
__device__ __forceinline__ void attn_unit(const bf16_t* __restrict__ Qb, const bf16_t* __restrict__ Kh, const bf16_t* __restrict__ Vh, int nkeys,
                                          bf16_t* __restrict__ Ob, float lam, float osc, const float* __restrict__ sg, char* lds, const int tid) {
  const int wid = __builtin_amdgcn_readfirstlane(tid >> 6), lane = tid & 63, r32 = lane & 31, hi = lane >> 5;
  const int comp = wid >> 2, qw = wid & 3, kcol = comp * 128;
  char* K_lds = lds; char* V_lds = lds + 2 * SHM_K;
  float* ws = (float*)(lds + 2 * SHM_K + 3 * SHM_V) + wid * 64; float* li_l = ws; float* al_l = ws + 32;
  float m_reg = -1e30f, l_reg = 0; f32x16 o[4] = {}; bf16x8 qr[4];
  const bf16_t* Qw = Qb + (long)(qw * QBLK + r32) * LDQ + comp * 64 + hi * 8;
#pragma unroll
  for (int d0 = 0; d0 < 4; ++d0) qr[d0] = *reinterpret_cast<const bf16x8*>(Qw + d0 * 16);
  const int sr = tid >> 4, sc = (tid & 15) * 8, vst0 = v_st(sr, sc), vst1 = v_st(32 + sr, sc);
  const int vb0 = (int)(uintptr_t)V_lds + v_rd_base(lane);
  bf16x8 sk0 = {}, sk1 = {}, sv0 = {}, sv1 = {};
#define LOADK(t) do { if constexpr (!(VAR & 8)) { sk0 = *reinterpret_cast<const bf16x8*>(&Kh[(long)((t) * KVBLK + sr) * LDQ + sc]); sk1 = *reinterpret_cast<const bf16x8*>(&Kh[(long)((t) * KVBLK + 32 + sr) * LDQ + sc]); } } while (0)
#define LOADV(t) do { if constexpr (!(VAR & 8)) { sv0 = *reinterpret_cast<const bf16x8*>(&Vh[(long)((t) * KVBLK + sr) * LDQ + sc]); sv1 = *reinterpret_cast<const bf16x8*>(&Vh[(long)((t) * KVBLK + 32 + sr) * LDQ + sc]); } } while (0)
#define WRITEK(slot) do { if constexpr (!(VAR & 8)) { *(bf16x8*)(K_lds + (slot) * SHM_K + KSWZ(sr, sc * 2)) = sk0; *(bf16x8*)(K_lds + (slot) * SHM_K + KSWZ(32 + sr, sc * 2)) = sk1; } } while (0)
#define WRITEV(off) do { if constexpr (!(VAR & 8)) { *(bf16x8*)(V_lds + (off) + vst0) = sv0; *(bf16x8*)(V_lds + (off) + vst1) = sv1; } } while (0)
#define VMW() asm volatile("s_waitcnt vmcnt(0)" ::: "memory")
#define QKT(P0, P1, KS) do { if constexpr (VAR & 4) { P0 = f32x16{}; P1 = f32x16{}; asm volatile("" : "+v"(P0), "+v"(P1)); } else qkt(P0, P1, KS, qr, r32, hi, kcol); } while (0)
#define PSM(P0, P1, MN, AL) do { if constexpr (VAR & 1) { MN = m_reg; AL = 1.f; asm volatile("" : "+v"(P0), "+v"(P1)); } else partialSM(P0, P1, m_reg, MN, AL); } while (0)
#define FSM(P0, P1, AL) do { if constexpr (VAR & 1) { asm volatile("" : "+v"(P0), "+v"(P1)); pa0 = __builtin_bit_cast(bf16x8, (f32x4){P0[0], P0[1], P0[2], P0[3]}); pa1 = __builtin_bit_cast(bf16x8, (f32x4){P0[4], P0[5], P0[6], P0[7]}); pa2 = __builtin_bit_cast(bf16x8, (f32x4){P1[0], P1[1], P1[2], P1[3]}); pa3 = __builtin_bit_cast(bf16x8, (f32x4){P1[4], P1[5], P1[6], P1[7]}); } else finishSM(P0, P1, AL, l_reg, pa0, pa1, pa2, pa3); } while (0)
#define PV(OFF) do { if constexpr (VAR & 2) { asm volatile("" : "+v"(pa0), "+v"(pa1), "+v"(pa2), "+v"(pa3)); } else pv_d0(o, vb0 + (OFF), pa0, pa1, pa2, pa3); } while (0)
#define RESC(a) do { if (__any((a) < 1.f)) { if (hi == 0) al_l[r32] = (a); asm volatile("s_waitcnt lgkmcnt(0)" ::: "memory"); \
    _Pragma("unroll") for (int d = 0; d < 4; ++d) _Pragma("unroll") for (int r = 0; r < 16; ++r) o[d][r] *= al_l[crow(r, hi)]; } } while (0)
  f32x16 pA0, pA1, pB0, pB1; float mnA, mnB, alA, alB; bf16x8 pa0, pa1, pa2, pa3; const int NT = nkeys / KVBLK;
  LOADK(0); VMW(); WRITEK(0); LOADK(1); LOADV(0);
  __syncthreads();
  if (comp == 1) __syncthreads();
  VMW(); WRITEK(1); WRITEV(0);
  SBAR(); QKT(pA0, pA1, K_lds); SBAR();
  __syncthreads();
  LOADK(2); LOADV(1); SBAR();
  PSM(pA0, pA1, mnA, alA);
  __syncthreads();
  int va = 0, vb = SHM_V, vc = 2 * SHM_V;
  for (int j = 1; j + 1 < NT; j += 2) {
    VMW(); WRITEK(0); WRITEV(vb);
    SBAR(); QKT(pB0, pB1, K_lds + SHM_K);
    FSM(pA0, pA1, alA); SBAR();
    __syncthreads();
    LOADK(j + 2); LOADV(j + 1); SBAR();
    PV(va); PSM(pB0, pB1, mnB, alB);
    RESC(alB);
    __syncthreads();
    VMW(); WRITEK(1); WRITEV(vc);
    SBAR(); QKT(pA0, pA1, K_lds);
    FSM(pB0, pB1, alB); SBAR();
    __syncthreads();
    if (j + 3 < NT) LOADK(j + 3);
    LOADV(j + 2); SBAR();
    PV(vb); PSM(pA0, pA1, mnA, alA);
    RESC(alA);
    __syncthreads();
    { const int t = va; va = vc; vc = vb; vb = t; }
  }
  VMW(); WRITEV(vb);
  SBAR(); QKT(pB0, pB1, K_lds + SHM_K);
  FSM(pA0, pA1, alA); SBAR();
  __syncthreads();
  PV(va); PSM(pB0, pB1, mnB, alB);
  RESC(alB);
  __syncthreads();
  FSM(pB0, pB1, alB); SBAR();
  PV(vb);
  if (comp == 0) __syncthreads();
  if (hi == 0) li_l[r32] = l_reg; asm volatile("s_waitcnt lgkmcnt(0)" ::: "memory");
  float rli[16];
#pragma unroll
  for (int r = 0; r < 16; ++r) rli[r] = __builtin_amdgcn_rcpf(li_l[crow(r, hi)]);
  __syncthreads();
  float* XO = (float*)lds + qw * (32 * 128);
  if (comp == 1) {
#pragma unroll
    for (int r = 0; r < 16; ++r)
#pragma unroll
      for (int d0 = 0; d0 < 4; ++d0) XO[crow(r, hi) * 128 + d0 * 32 + r32] = o[d0][r] * rli[r];
  }
  __syncthreads();
  if (comp == 0) {
    float ss[16];
#pragma unroll
    for (int r = 0; r < 16; ++r) { float s = 0.f;
#pragma unroll
      for (int d0 = 0; d0 < 4; ++d0) { const float v = o[d0][r] * rli[r] - lam * XO[crow(r, hi) * 128 + d0 * 32 + r32]; o[d0][r] = v; s += v * v; }
      ss[r] = s; }
#pragma unroll
    for (int r = 0; r < 16; ++r) { float s = ss[r]; s += swz_xor<1>(s); s += swz_xor<2>(s); s += swz_xor<4>(s); s += swz_xor<8>(s); s += swz_xor<16>(s);
      ss[r] = osc / sqrtf(s * (1.0f / 128.0f) + EPS); }
    float gam[4];
#pragma unroll
    for (int d0 = 0; d0 < 4; ++d0) gam[d0] = sg[d0 * 32 + r32];
    asm volatile("s_waitcnt lgkmcnt(0)" ::: "memory");
    bf16_t* stg = (bf16_t*)XO;
#pragma unroll
    for (int r = 0; r < 16; ++r)
#pragma unroll
      for (int d0 = 0; d0 < 4; ++d0) stg[crow(r, hi) * 128 + d0 * 32 + r32] = (bf16_t)(cvtpk(o[d0][r] * ss[r] * gam[d0], 0.f) & 0xffffu);
    asm volatile("s_waitcnt lgkmcnt(0)" ::: "memory");
#pragma unroll
    for (int i = 0; i < 8; ++i) { const int row = i * 4 + (lane >> 4), ch = lane & 15; const u32x4 v = *(const u32x4*)(stg + row * 128 + ch * 8);
      if constexpr (VAR & 16) { asm volatile("" :: "v"(v.x), "v"(v.y), "v"(v.z), "v"(v.w)); } else *(u32x4*)(Ob + (long)(qw * QBLK + row) * LDO + ch * 8) = v; }
  }
  __syncthreads();
#undef LOADK
#undef LOADV
#undef WRITEK
#undef WRITEV
#undef VMW
#undef QKT
#undef PSM
#undef FSM
#undef PV
#undef RESC
}
#undef KSWZ
#undef SBAR
}
namespace att2 {
using att::crow; using att::v_st; using att::v_rd_base; using att::v_rd_off;
constexpr int NW = 8, QBLK = 32, KVBLK = 64, LDQ = 512, LDO = KCAT, SHM_K = 16384, SHM_V = 16384;
constexpr float THRL = 8.0f;
#ifndef ATT_STAGGER
#define ATT_STAGGER 1
#endif
typedef short v4i16_t __attribute__((ext_vector_type(4)));
typedef __attribute__((address_space(3))) const char* lds_cptr;
typedef __attribute__((address_space(3))) char* lds_ptr;
#define SBAR() __builtin_amdgcn_sched_barrier(0)
#define KSWZ(row, colB) ((row) * 256 + ((colB) ^ (((row) & 7) << 4)))
__device__ __forceinline__ s16x4 vtr(lds_cptr p) { return __builtin_bit_cast(s16x4, __builtin_amdgcn_ds_read_tr16_b64_v4i16((__attribute__((address_space(3))) v4i16_t*)p)); }
__device__ __forceinline__ bf16x8 ldk(lds_cptr p) { return *(const __attribute__((address_space(3))) bf16x8*)p; }
#define MF(D, A, B, C) do { if constexpr (VAR & 4) { asm volatile("" : "+v"(D)); } else D = __builtin_amdgcn_mfma_f32_32x32x16_bf16(A, B, C, 0, 0, 0); } while (0)
#define VF(L, H) (bf16x8){L[0], L[1], L[2], L[3], H[0], H[1], H[2], H[3]}

__device__ __forceinline__ int vkey(int g) { const int s_ = g >> 5, kk = ((s_ >> 2) << 3) | ((g >> 2) & 7); return (kk & ~0xC) | ((kk & 4) << 1) | ((kk & 8) >> 1); }
template <int VAR>
__device__ __forceinline__ void attn_unit(const bf16_t* __restrict__ Qb, const bf16_t* __restrict__ Kh, const bf16_t* __restrict__ Vh, int nkeys,
                                          bf16_t* __restrict__ Ob, float lam, float osc, const float* __restrict__ sg, char* lds, const int tid) {
  const int wid = __builtin_amdgcn_readfirstlane(tid >> 6), lane = tid & 63, r32 = lane & 31, hi = lane >> 5;
  const int comp = wid >> 2, qw = wid & 3, kcol = comp * 128;
  const lds_ptr L3 = (lds_ptr)(unsigned)(uintptr_t)lds;
  float* ws = (float*)(lds + 3 * SHM_K + 3 * SHM_V) + wid * 64; float* li_l = ws; float* al_l = ws + 32;
  float mhat = 0.f, l_reg = 0.f; f32x16 o[4] = {}; bf16x8 qr[4]; f32x16 negm = {};
  const bf16_t* Qw = Qb + (long)(qw * QBLK + r32) * LDQ + comp * 64 + hi * 8;
#pragma unroll
  for (int d0 = 0; d0 < 4; ++d0) qr[d0] = *reinterpret_cast<const bf16x8*>(Qw + d0 * 16);
  const int sr = tid >> 4, sc = (tid & 15) * 8;
  const int kr0 = 4 * wid + (lane >> 4), kr1 = kr0 + 32;
  const bf16_t* ksrc0 = Kh + (long)kr0 * LDQ + (((lane & 15) ^ (kr0 & 7)) << 3); const bf16_t* ksrc1 = Kh + (long)kr1 * LDQ + (((lane & 15) ^ (kr1 & 7)) << 3);
  const int g0_ = 64 * wid + lane, g1_ = g0_ + 512;
  const int vk0 = vkey(g0_), vk1 = vkey(g1_);
  const bf16_t* vsrc0 = Vh + (long)vk0 * LDQ + ((g0_ >> 5) & 3) * 32 + (g0_ & 3) * 8; const bf16_t* vsrc1 = Vh + (long)vk1 * LDQ + ((g1_ >> 5) & 3) * 32 + (g1_ & 3) * 8;
  const unsigned kd0 = (unsigned)(uintptr_t)lds + wid * 1024, kd1 = kd0 + 8192, vd0 = (unsigned)(uintptr_t)lds + 3 * SHM_K + wid * 1024, vd1 = vd0 + 8192;
  lds_cptr kq[4];
#pragma unroll
  for (int d0 = 0; d0 < 4; ++d0) kq[d0] = L3 + r32 * 256 + ((kcol + d0 * 32 + hi * 16) ^ ((r32 & 7) << 4));
  const lds_cptr vp0 = L3 + 3 * SHM_K + v_rd_base(lane);
#define GLDS(src, dst) __builtin_amdgcn_global_load_lds((const unsigned*)(src), (__attribute__((address_space(3))) unsigned*)(dst), 16, 0, 0)
#define DMAK(t, slot) do { if constexpr (!(VAR & 8)) { GLDS(ksrc0 + (long)(t) * KVBLK * LDQ, (unsigned)__builtin_amdgcn_readfirstlane(kd0 + (slot) * SHM_K)); GLDS(ksrc1 + (long)(t) * KVBLK * LDQ, (unsigned)__builtin_amdgcn_readfirstlane(kd1 + (slot) * SHM_K)); } } while (0)
#define DMAV(t, off) do { if constexpr (!(VAR & 8)) { GLDS(vsrc0 + (long)(t) * KVBLK * LDQ, (unsigned)__builtin_amdgcn_readfirstlane(vd0 + (off))); GLDS(vsrc1 + (long)(t) * KVBLK * LDQ, (unsigned)__builtin_amdgcn_readfirstlane(vd1 + (off))); } } while (0)
#ifndef ATT_PRIO
#define ATT_PRIO 1
#endif
#define PRIO(x) do { if (ATT_PRIO == 1) __builtin_amdgcn_s_setprio(x); } while (0)
#define PRIO1(x) do { if (ATT_PRIO == 2) __builtin_amdgcn_s_setprio(x); } while (0)
#define VMW() asm volatile("s_waitcnt vmcnt(0)" ::: "memory")
#define BARW(n) do { asm volatile("s_waitcnt vmcnt(" #n ") lgkmcnt(0)" ::: "memory"); if constexpr (!(VAR & 32)) __builtin_amdgcn_s_barrier(); asm volatile("" ::: "memory"); } while (0)
  f32x16 pA0, pA1, pB0, pB1; u32x4 pw0 = {}, pw1 = {}, pw2 = {}, pw3 = {}; const int NT = nkeys / KVBLK; bool resc = false;
#define KF(KOFF, d0, half) ldk(kq[d0] + (KOFF) + 8192 * (half))
#define PKA(P, B, A0, A1) do { if constexpr (!(VAR & 1)) { A0 = cvt2bf(P[B + 0], P[B + 1]); A1 = cvt2bf(P[B + 2], P[B + 3]); sacc += P[B + 0]; sacc += P[B + 1]; sacc += P[B + 2]; sacc += P[B + 3]; } } while (0)
#define PKB(P, B, A0, A1, PW) do { if constexpr (!(VAR & 1)) { const unsigned b0_ = cvt2bf(P[B + 4], P[B + 5]), b1_ = cvt2bf(P[B + 6], P[B + 7]); \
    auto r0_ = __builtin_amdgcn_permlane32_swap(A0, b0_, false, false); auto r1_ = __builtin_amdgcn_permlane32_swap(A1, b1_, false, false); \
    PW = (u32x4){r0_[0], r1_[0], r0_[1], r1_[1]}; sacc += P[B + 4]; sacc += P[B + 5]; sacc += P[B + 6]; sacc += P[B + 7]; } } while (0)
#define VRD(VOFF, ks, d0, LO, HI) do { LO = vtr(vp0 + (VOFF) + v_rd_off(d0, ks, 0)); HI = vtr(vp0 + (VOFF) + v_rd_off(d0, ks, 1)); } while (0)
#define PAF(k) __builtin_bit_cast(bf16x8, pw##k)
#define EX(X, i) do { if constexpr (!(VAR & 2)) X[i] = __builtin_amdgcn_exp2f(X[i]); } while (0)
#define PIN2(X, Y) asm volatile("" : "+v"(X), "+v"(Y))
#define H1(C0, C1, P0, P1, KOFF, VOFF, FIN) do { \
    float sacc = 0.f; unsigned a0_ = 0, a1_ = 0; s16x4 l0, h0, l1, h1; \
    bf16x8 f0 = KF(KOFF, 0, 0), f1 = KF(KOFF, 0, 1), f2 = KF(KOFF, 1, 0); SBAR(); \
    MF(C0, f0, qr[0], negm); { f0 = KF(KOFF, 1, 1); if (FIN) { EX(P1, 8); PKA(P0, 0, a0_, a1_); PIN2(P0, P1); } } SBAR(); \
    MF(C1, f1, qr[0], negm); { f1 = KF(KOFF, 2, 0); if (FIN) { EX(P1, 9); PKB(P0, 0, a0_, a1_, pw0); PIN2(P0, P1); } } SBAR(); \
    MF(C0, f2, qr[1], C0);   { f2 = KF(KOFF, 2, 1); if (FIN) { VRD(VOFF, 0, 0, l0, h0); EX(P1, 10); PKA(P0, 8, a0_, a1_); PIN2(P0, P1); } } SBAR(); \
    MF(C1, f0, qr[1], C1);   { f0 = KF(KOFF, 3, 0); if (FIN) { VRD(VOFF, 0, 1, l1, h1); EX(P1, 11); PKB(P0, 8, a0_, a1_, pw1); PIN2(P0, P1); } } SBAR(); \
    if (FIN) { MF(o[0], PAF(0), VF(l0, h0), o[0]); VRD(VOFF, 0, 2, l0, h0); EX(P1, 12); PKA(P1, 0, a0_, a1_); PIN2(P0, P1); } SBAR(); \
    MF(C0, f1, qr[2], C0);   { f1 = KF(KOFF, 3, 1); if (FIN) { EX(P1, 13); PKB(P1, 0, a0_, a1_, pw2); PIN2(P0, P1); } } SBAR(); \
    if (FIN) { MF(o[1], PAF(0), VF(l1, h1), o[1]); VRD(VOFF, 0, 3, l1, h1); EX(P1, 14); PIN2(P0, P1); } SBAR(); \
    MF(C1, f2, qr[2], C1);   { if (FIN) { EX(P1, 15); PKA(P1, 8, a0_, a1_); PIN2(P0, P1); } } SBAR(); \
    if (FIN) { MF(o[2], PAF(0), VF(l0, h0), o[2]); } SBAR(); \
    MF(C0, f0, qr[3], C0);   { if (FIN) PKB(P1, 8, a0_, a1_, pw3); } SBAR(); \
    if (FIN) { MF(o[3], PAF(0), VF(l1, h1), o[3]); } SBAR(); \
    MF(C1, f1, qr[3], C1); SBAR(); \
    if (FIN) { auto rr_ = __builtin_amdgcn_permlane32_swap(__float_as_uint(sacc), __float_as_uint(sacc), false, false); l_reg += __uint_as_float(rr_[0]) + __uint_as_float(rr_[1]); } \
  } while (0)
#define MX3(a, b, c) ((VAR & 2) ? (a) : fmaxf(fmaxf((a), (b)), (c)))
#define H2(C0, C1, VOFF, DOPV, FIRST) do { \
    s16x4 l0, h0, l1, h1, l2, h2; float ma, mb, rm; \
    if (DOPV) { VRD(VOFF, 1, 0, l0, h0); VRD(VOFF, 1, 1, l1, h1); VRD(VOFF, 1, 2, l2, h2); } SBAR(); \
    if (DOPV) { MF(o[0], PAF(1), VF(l0, h0), o[0]); VRD(VOFF, 1, 3, l0, h0); } ma = MX3(C0[0], C0[1], C1[0]); mb = MX3(C0[2], C0[3], C1[1]); ma = MX3(ma, C1[2], C1[3]); mb = MX3(mb, C0[4], C0[5]); SBAR(); \
    if (DOPV) { MF(o[1], PAF(1), VF(l1, h1), o[1]); VRD(VOFF, 2, 0, l1, h1); } ma = MX3(ma, C0[6], C0[7]); mb = MX3(mb, C1[4], C1[5]); ma = MX3(ma, C1[6], C1[7]); mb = MX3(mb, C0[8], C0[9]); SBAR(); \
    if (DOPV) { MF(o[2], PAF(1), VF(l2, h2), o[2]); VRD(VOFF, 2, 1, l2, h2); } ma = MX3(ma, C0[10], C0[11]); mb = MX3(mb, C1[8], C1[9]); ma = MX3(ma, C1[10], C1[11]); mb = MX3(mb, C0[12], C0[13]); SBAR(); \
    if (DOPV) { MF(o[3], PAF(1), VF(l0, h0), o[3]); VRD(VOFF, 2, 2, l0, h0); } ma = MX3(ma, C0[14], C0[15]); mb = MX3(mb, C1[12], C1[13]); ma = MX3(ma, C1[14], C1[15]); rm = fmaxf(ma, mb); SBAR(); \
    if (DOPV) { MF(o[0], PAF(2), VF(l1, h1), o[0]); VRD(VOFF, 2, 3, l1, h1); } \
    { auto rr_ = __builtin_amdgcn_permlane32_swap(__float_as_uint(rm), __float_as_uint(rm), false, false); rm = fmaxf(__uint_as_float(rr_[0]), __uint_as_float(rr_[1])); } SBAR(); \
    resc = false; \
    if (FIRST || __builtin_expect(__any(rm > THRL), 0)) { const float dl = FIRST ? rm : fmaxf(rm, 0.f); mhat += dl; \
      _Pragma("unroll") for (int r = 0; r < 16; ++r) { C0[r] -= dl; C1[r] -= dl; } \
      _Pragma("unroll") for (int r = 0; r < 16; ++r) negm[r] = -mhat; \
      if (!(FIRST)) { const float f = __builtin_amdgcn_exp2f(-dl); l_reg *= f; if (hi == 0) al_l[r32] = f; resc = true; } } \
    SBAR(); \
    if (DOPV) { MF(o[1], PAF(2), VF(l2, h2), o[1]); VRD(VOFF, 3, 0, l2, h2); } EX(C0, 0); EX(C0, 1); EX(C0, 2); EX(C0, 3); PIN2(C0, C1); SBAR(); \
    if (DOPV) { MF(o[2], PAF(2), VF(l0, h0), o[2]); VRD(VOFF, 3, 1, l0, h0); } EX(C0, 4); EX(C0, 5); EX(C0, 6); EX(C0, 7); PIN2(C0, C1); SBAR(); \
    if (DOPV) { MF(o[3], PAF(2), VF(l1, h1), o[3]); VRD(VOFF, 3, 2, l1, h1); } EX(C0, 8); EX(C0, 9); EX(C0, 10); EX(C0, 11); PIN2(C0, C1); SBAR(); \
    if (DOPV) { MF(o[0], PAF(3), VF(l2, h2), o[0]); VRD(VOFF, 3, 3, l2, h2); } EX(C0, 12); EX(C0, 13); EX(C0, 14); EX(C0, 15); PIN2(C0, C1); SBAR(); \
    if (DOPV) { MF(o[1], PAF(3), VF(l0, h0), o[1]); } EX(C1, 0); EX(C1, 1); EX(C1, 2); EX(C1, 3); PIN2(C0, C1); SBAR(); \
    if (DOPV) { MF(o[2], PAF(3), VF(l1, h1), o[2]); } EX(C1, 4); EX(C1, 5); EX(C1, 6); EX(C1, 7); PIN2(C0, C1); SBAR(); \
    if (DOPV) { MF(o[3], PAF(3), VF(l2, h2), o[3]); } SBAR(); \
    if (resc) { asm volatile("s_waitcnt lgkmcnt(0)" ::: "memory"); \
      _Pragma("unroll") for (int d = 0; d < 4; ++d) _Pragma("unroll") for (int r = 0; r < 16; ++r) o[d][r] *= al_l[crow(r, hi)]; } \
  } while (0)
#define PVONLY(VOFF) do { _Pragma("unroll") for (int ks = 0; ks < 4; ++ks) _Pragma("unroll") for (int d0 = 0; d0 < 4; ++d0) { s16x4 l_, h_; VRD(VOFF, ks, d0, l_, h_); \
      const bf16x8 pa_ = ks == 0 ? PAF(0) : ks == 1 ? PAF(1) : ks == 2 ? PAF(2) : PAF(3); MF(o[d0], pa_, VF(l_, h_), o[d0]); } } while (0)

  DMAK(0, 0); DMAK(1, 1); DMAV(0, 0);
  BARW(0);
  if (ATT_STAGGER && comp == 1) __builtin_amdgcn_s_barrier();
  H1(pA0, pA1, pB0, pB1, 0, 0, false);
  BARW(0);
  DMAK(2, 2); DMAV(1, SHM_V); SBAR();
  H2(pA0, pA1, 0, false, true);
  BARW(4);
  if (ATT_PRIO == 3 && comp == 1) __builtin_amdgcn_s_setprio(1);
  if (ATT_PRIO == 4 && comp == 0) __builtin_amdgcn_s_setprio(1);
  int va = 0, vb = SHM_V, vc = 2 * SHM_V;
  for (int j = 1; j + 1 < NT; j += 2) {
    PRIO1(1); H1(pB0, pB1, pA0, pA1, vb, va, true); PRIO1(0);
    BARW(0);
    DMAK(j + 2, va >> 14); DMAV(j + 1, vc); SBAR();
    PRIO(1); H2(pB0, pB1, va, true, false); PRIO(0);
    BARW(4);
    PRIO1(1); H1(pA0, pA1, pB0, pB1, vc, vb, true); PRIO1(0);
    BARW(0);
    if (j + 3 < NT) DMAK(j + 3, vb >> 14);
    DMAV(j + 2, va); SBAR();
    PRIO(1); H2(pA0, pA1, vb, true, false); PRIO(0);
    BARW(4);
    { const int t = va; va = vc; vc = vb; vb = t; }
  }
  if (ATT_PRIO >= 3) __builtin_amdgcn_s_setprio(0);
  H1(pB0, pB1, pA0, pA1, vb, va, true);
  BARW(0);
  H2(pB0, pB1, va, true, false);
  BARW(0);
  { float sacc = 0.f; unsigned a0_ = 0, a1_ = 0;
    EX(pB1, 8); EX(pB1, 9); EX(pB1, 10); EX(pB1, 11); EX(pB1, 12); EX(pB1, 13); EX(pB1, 14); EX(pB1, 15);
    PKA(pB0, 0, a0_, a1_); PKB(pB0, 0, a0_, a1_, pw0); PKA(pB0, 8, a0_, a1_); PKB(pB0, 8, a0_, a1_, pw1); PKA(pB1, 0, a0_, a1_); PKB(pB1, 0, a0_, a1_, pw2); PKA(pB1, 8, a0_, a1_); PKB(pB1, 8, a0_, a1_, pw3);
    auto rr_ = __builtin_amdgcn_permlane32_swap(__float_as_uint(sacc), __float_as_uint(sacc), false, false); l_reg += __uint_as_float(rr_[0]) + __uint_as_float(rr_[1]); }
  SBAR(); PVONLY(vb);
  if (ATT_STAGGER && comp == 0) { asm volatile("s_waitcnt lgkmcnt(0)" ::: "memory"); __builtin_amdgcn_s_barrier(); }
  if (hi == 0) li_l[r32] = l_reg; asm volatile("s_waitcnt lgkmcnt(0)" ::: "memory");
  float rli[16];
#pragma unroll
  for (int r = 0; r < 16; ++r) rli[r] = __builtin_amdgcn_rcpf(li_l[crow(r, hi)]);
  __syncthreads();
  float* XO = (float*)lds + qw * (32 * 128);
  if (comp == 1) {
#pragma unroll
    for (int r = 0; r < 16; ++r)
#pragma unroll
      for (int d0 = 0; d0 < 4; ++d0) XO[crow(r, hi) * 128 + d0 * 32 + r32] = o[d0][r] * rli[r];
  }
  __syncthreads();
  if (comp == 0) {
    float ss[16];
#pragma unroll
    for (int r = 0; r < 16; ++r) { float s = 0.f;
#pragma unroll
      for (int d0 = 0; d0 < 4; ++d0) { const float v = o[d0][r] * rli[r] - lam * XO[crow(r, hi) * 128 + d0 * 32 + r32]; o[d0][r] = v; s += v * v; }
      ss[r] = s; }
#pragma unroll
    for (int r = 0; r < 16; ++r) { float s = ss[r]; s += swz_xor<1>(s); s += swz_xor<2>(s); s += swz_xor<4>(s); s += swz_xor<8>(s); s += swz_xor<16>(s);
      ss[r] = osc / sqrtf(s * (1.0f / 128.0f) + EPS); }
    float gam[4];
#pragma unroll
    for (int d0 = 0; d0 < 4; ++d0) gam[d0] = sg[d0 * 32 + r32];
    asm volatile("s_waitcnt lgkmcnt(0)" ::: "memory");
    bf16_t* stg = (bf16_t*)XO;
#pragma unroll
    for (int r = 0; r < 16; ++r)
#pragma unroll
      for (int d0 = 0; d0 < 4; ++d0) stg[crow(r, hi) * 128 + d0 * 32 + r32] = (bf16_t)(cvt2bf(o[d0][r] * ss[r] * gam[d0], 0.f) & 0xffffu);
    asm volatile("s_waitcnt lgkmcnt(0)" ::: "memory");
#pragma unroll
    for (int i = 0; i < 8; ++i) { const int row = i * 4 + (lane >> 4), ch = lane & 15; const u32x4 v = *(const u32x4*)(stg + row * 128 + ch * 8);
      if constexpr (VAR & 16) { asm volatile("" :: "v"(v.x), "v"(v.y), "v"(v.z), "v"(v.w)); } else *(u32x4*)(Ob + (long)(qw * QBLK + row) * LDO + ch * 8) = v; }
  }
  __syncthreads();
#undef GLDS
#undef DMAK
#undef DMAV
#undef VMW
#undef PRIO
#undef PRIO1
#undef BARW
#undef KF
#undef PKA
#undef PKB
#undef H1
#undef VRD
#undef PAF
#undef MX3
#undef EX
#undef PIN2
#undef H2
#undef PVONLY
}
#undef SBAR
#undef KSWZ
#undef MF
#undef VF
}
typedef GAS unsigned gu32;
#define RLX_AGENT __ATOMIC_RELAXED, __HIP_MEMORY_SCOPE_AGENT
constexpr int PT_OFF = LDSCTL_OFF + 1024;
__device__ __forceinline__ unsigned long long ldptr(volatile LAS unsigned long long* PT, int i) {
    const unsigned long long v = PT[i];
    const unsigned lo = __builtin_amdgcn_readfirstlane((unsigned)v), hi = __builtin_amdgcn_readfirstlane((unsigned)(v >> 32));
    return ((unsigned long long)hi << 32) | lo;
}
#define XB_TMO      128
#define XB_XCNT(j)  (256  + 64 * (j))
#define XB_XSUB(j)  (1280 + 64 * (j))
#define XB_XGEN(j)  (2304 + 64 * (j))
#define XB_TOP      3328
#define XB_TOPGEN   3392
#define XCD_BAR_WORDS 3456
#define XB_SPIN_CAP (1u << 18)

__device__ __forceinline__ unsigned xb_ld(unsigned* p)              { return __hip_atomic_load(p, __ATOMIC_RELAXED, __HIP_MEMORY_SCOPE_AGENT); }
__device__ __forceinline__ unsigned xb_add(unsigned* p, unsigned v) { return __hip_atomic_fetch_add(p, v, __ATOMIC_RELAXED, __HIP_MEMORY_SCOPE_AGENT); }
__device__ __forceinline__ unsigned xb_xcc_id() { return (unsigned)__builtin_amdgcn_s_getreg((3 << 11) | 20) & 0xFu; }
#define XB_SPIN(cond, bar) do { unsigned _sp = 0; while (cond) { __builtin_amdgcn_s_sleep(1); \
    if ((++_sp & 255u) == 0u) { if (xb_ld(&(bar)[XB_TMO])) break; if (_sp > XB_SPIN_CAP) { atomicAdd(&(bar)[XB_TMO], 1u); break; } } } } while (0)

struct XcdBarrier {
    unsigned* bar; unsigned x;
    volatile LAS unsigned* st;
};

__device__ __forceinline__ XcdBarrier xcd_barrier_post(unsigned* bar, volatile LAS unsigned* st) {
    XcdBarrier b; b.bar = bar; b.x = xb_xcc_id(); b.st = st;
    if (threadIdx.x == 0) (void)xb_add(&bar[XB_XCNT(b.x)], 1u);
    return b;
}
__device__ __forceinline__ void xcd_barrier_complete(unsigned* bar, unsigned x, unsigned& nloc, unsigned& nx) {
    const unsigned G = gridDim.x * gridDim.y * gridDim.z;
    unsigned sum, cnt, mine, sp = 0u;
    for (;;) {
        sum = 0u; cnt = 0u; mine = 0u;
#pragma unroll
        for (unsigned j = 0; j < 16; ++j) { const unsigned c = xb_ld(&bar[XB_XCNT(j)]); sum += c; cnt += (c > 0u) ? 1u : 0u; mine = (j == x) ? c : mine; }
        if (sum == G) break;
        __builtin_amdgcn_s_sleep(1);
        if ((++sp & 255u) == 0u) { if (xb_ld(&bar[XB_TMO])) break; if (sp > XB_SPIN_CAP) { atomicAdd(&bar[XB_TMO], 1u); break; } }
    }
    nloc = mine > 0u ? mine : 1u; nx = cnt > 0u ? cnt : 1u;
}

__device__ __forceinline__ void xcd_barrier(const XcdBarrier& b) {
    asm volatile("s_waitcnt vmcnt(0)" ::: "memory");
    __syncthreads();
    if (threadIdx.x == 0) {
        unsigned* bar = b.bar;
        __builtin_amdgcn_s_waitcnt(0);
        unsigned nloc = b.st[0], nx = b.st[1];
        if (nloc == 0u) { xcd_barrier_complete(bar, b.x, nloc, nx); b.st[0] = nloc; b.st[1] = nx; }
        const unsigned old = xb_add(&bar[XB_XSUB(b.x)], 1u);
        const unsigned gen = old / nloc;
        if (old + 1u == (gen + 1u) * nloc) {
            __builtin_amdgcn_fence(__ATOMIC_RELEASE, "agent");
            asm volatile("s_waitcnt vmcnt(0)" ::: "memory");
            const unsigned og = xb_add(&bar[XB_TOP], 1u);
            const unsigned tg = og / nx;
            if (og + 1u == (tg + 1u) * nx) xb_add(&bar[XB_TOPGEN], 1u);
            else XB_SPIN(xb_ld(&bar[XB_TOPGEN]) == tg, bar);
            __builtin_amdgcn_fence(__ATOMIC_ACQUIRE, "agent");
            xb_add(&bar[XB_XGEN(b.x)], 1u);
            asm volatile("s_waitcnt vmcnt(0)" ::: "memory");
        } else {
            XB_SPIN(xb_ld(&bar[XB_XGEN(b.x)]) == gen, bar);
            __builtin_amdgcn_fence(__ATOMIC_ACQUIRE, "agent");
            asm volatile("s_waitcnt vmcnt(0)" ::: "memory");
        }
    }
    __syncthreads();
}
__device__ __forceinline__ float wave_sum(float v) {
    v += swz_xor<1>(v); v += swz_xor<2>(v); v += swz_xor<4>(v); v += swz_xor<8>(v); v += swz_xor<16>(v);
    auto rr = __builtin_amdgcn_permlane32_swap(__float_as_uint(v), __float_as_uint(v), false, false);
    return __uint_as_float(rr[0]) + __uint_as_float(rr[1]);
}
__device__ __forceinline__ unsigned pk2(float lo, float hi) { return cvt2bf(lo, hi); }

template <int MAP  >
__device__ __forceinline__ void transpose_item(const float* W, int Nsrc, int coff, bf16_t* WT, int ldw, int koff, int nblk, LAS float* scr, int item, int lane) {
    const int kb = item / nblk, nb = item % nblk, k0 = 64 * kb, n0 = 32 * nb;
    const int nd = n0 + (lane & 31); const int scol = MAP ? in_map(nd) : nd + coff;
    float wv[32];
#pragma unroll
    for (int i = 0; i < 32; ++i) wv[i] = W[(size_t)(k0 + 2 * i + (lane >> 5)) * Nsrc + scol];
#pragma unroll
    for (int i = 0; i < 32; ++i) scr[(2 * i + (lane >> 5)) * 33 + (lane & 31)] = wv[i];
    asm volatile("s_waitcnt lgkmcnt(0)" ::: "memory");
    const int c = lane & 7;
#pragma unroll
    for (int j = 0; j < 4; ++j) { const int n = (lane >> 3) + 8 * j; const LAS float* s = scr + (8 * c) * 33 + n;
        u32x4 o; o.x = pk2(s[0 * 33], s[1 * 33]); o.y = pk2(s[2 * 33], s[3 * 33]); o.z = pk2(s[4 * 33], s[5 * 33]); o.w = pk2(s[6 * 33], s[7 * 33]);
        *(u32x4*)(WT + (size_t)(n0 + n) * ldw + koff + k0 + 8 * c) = o; }
    asm volatile("s_waitcnt lgkmcnt(0)" ::: "memory");
}
struct WSrc { const float *w_in, *wo_f, *wo_a, *wo_c, *wo_p, *w_out, *w_up, *w_down; };
constexpr int IT_A = 16 * 208;
constexpr int IT_B0 = 4 * 32, IT_B1 = 8 * 32, IT_B2 = 4 * 32, IT_B3 = 4 * 32, IT_B4 = 16 * 32, IT_B5 = 16 * 88, IT_B6 = 16 * 88, IT_B7 = 44 * 32;
constexpr int ITU_CAT = IT_A, ITU_DN = ITU_CAT + IT_B0 + IT_B1 + IT_B2 + IT_B3 + IT_B4, ITU_UPG = ITU_DN + IT_B7, ITU_UPV = ITU_UPG + IT_B5, ITU_END = ITU_UPV + IT_B6;
struct WDst { bf16_t *wa, *wcat, *wout, *wdn, *wupg, *wupv; };
template <int MASK  >
__device__ __forceinline__ void convert_items(const WSrc& S, const WDst& D, LAS float* scr, int lo, int hi, int wi, int nw, int lane) {
    for (int it = lo + wi; it < hi; it += nw) { int r = it;
        if (MASK & 1) { if (r < IT_A) { transpose_item<1>(S.w_in, NIN, 0, D.wa, 1024, 0, 208, scr, r, lane); continue; } } r -= IT_A;
        if (MASK & 2) {
            if (r < IT_B0) { transpose_item<0>(S.wo_f, 1024, 0, D.wcat, KCAT, 0, 32, scr, r, lane); continue; } r -= IT_B0;
            if (r < IT_B1) { transpose_item<0>(S.wo_a, 1024, 0, D.wcat, KCAT, 256, 32, scr, r, lane); continue; } r -= IT_B1;
            if (r < IT_B2) { transpose_item<0>(S.wo_c, 1024, 0, D.wcat, KCAT, 768, 32, scr, r, lane); continue; } r -= IT_B2;
            if (r < IT_B3) { transpose_item<0>(S.wo_p, 1024, 0, D.wcat, KCAT, 1024, 32, scr, r, lane); continue; } r -= IT_B3;
            if (r < IT_B4) { transpose_item<0>(S.w_out, 1024, 0, D.wout, 1024, 0, 32, scr, r, lane); continue; } r -= IT_B4;
        } else r -= IT_B0 + IT_B1 + IT_B2 + IT_B3 + IT_B4;
        if (MASK & 4) { if (r < IT_B7) { transpose_item<0>(S.w_down, 1024, 0, D.wdn, DFF, 0, 32, scr, r, lane); continue; } } r -= IT_B7;
        if (MASK & 8) { if (r < IT_B5) { transpose_item<0>(S.w_up, 2 * DFF, DFF, D.wupg, 1024, 0, 88, scr, r, lane); continue; } } r -= IT_B5;
        if (MASK & 16) { if (r < IT_B6) transpose_item<0>(S.w_up, 2 * DFF, 0, D.wupv, 1024, 0, 88, scr, r, lane); }
    }
}

__device__ __forceinline__ void mod_phase(const float* c, const float* c_ctx, const float* ada_w, const float* ada_b, float* MOD, LAS unsigned char* lds, int vcu, int G, int tid, int wave, int lane) {
    LAS float* sil = (LAS float*)lds;
    LAS float* red = (LAS float*)(lds + 12288);
    for (int i = tid; i < 3072; i += 512) { const float v = i < 2048 ? c[i] : c_ctx[i - 2048]; sil[i] = v * sigm(v); }
    __syncthreads();
    for (int item = vcu; item < 192; item += G) {
        const int l = item / 96, n = (item % 96) * 64 + lane;
        const float* W = ada_w + (size_t)l * 1024 * 6144 + n;
        float a0 = 0.f, a1 = 0.f, a2 = 0.f;
        for (int k = wave * 128; k < wave * 128 + 128; k += 64) { float w[64];
#pragma unroll
            for (int i = 0; i < 64; ++i) w[i] = W[(size_t)(k + i) * 6144];
#pragma unroll
            for (int i = 0; i < 64; ++i) { a0 += sil[k + i] * w[i]; a1 += sil[1024 + k + i] * w[i]; a2 += sil[2048 + k + i] * w[i]; } }
        red[(wave * 3 + 0) * 64 + lane] = a0; red[(wave * 3 + 1) * 64 + lane] = a1; red[(wave * 3 + 2) * 64 + lane] = a2;
        __syncthreads();
        if (wave < 3) { float s = ada_b[l * 6144 + n];
#pragma unroll
            for (int w = 0; w < 8; ++w) s += red[(w * 3 + wave) * 64 + lane];
            MOD[(size_t)(l * 3 + wave) * 6144 + n] = s; }
        __syncthreads();
    }
}
__device__ __forceinline__ void tables_phase(float* ROPE, f32x2* TW, int gt, int NGT) {
    for (int i = gt; i < 192 * 16; i += NGT) { const int pos = i >> 4, f = i & 15; const float inv = powf(10000.0f, -(float)f / 16.0f); const float ang = (float)(pos < 128 ? pos : pos - 128) * inv;
        float s, c; sincosf(ang, &s, &c); ROPE[pos * 32 + f] = c; ROPE[pos * 32 + 16 + f] = s; }
    for (int i = gt; i < 8192; i += NGT) { float s, c; sincospif((float)i * (1.0f / 4096.0f), &s, &c); TW[i] = (f32x2){c, -s}; }
}

template <bool LATBF>
__device__ __forceinline__ void norm_phase(const void* src_lat_, const float* src_ctx, int nrows, const float* gamma, const float* mod, int shoff, int scoff, bf16_t* HX, int gw, int NGW, int lane,
                                           const float* slab = nullptr, int nsl = 0, const float* cgate = nullptr, float* ctx_out = nullptr) {
    for (int m0 = gw; m0 < nrows; m0 += 4 * NGW) {
        f32x4 v[4][4]; float s[4];
#pragma unroll
        for (int u = 0; u < 4; ++u) { const int m = m0 + u * NGW; s[u] = 0.f;
            if (m < nrows) {
                if (LATBF && m < ML) { const u32x2* xb = (const u32x2*)((const bf16_t*)src_lat_ + (size_t)m * DM);
#pragma unroll
                    for (int j = 0; j < 4; ++j) { const u32x2 w = xb[lane + 64 * j]; v[u][j] = (f32x4){__uint_as_float(w.x << 16), __uint_as_float(w.x & 0xffff0000u), __uint_as_float(w.y << 16), __uint_as_float(w.y & 0xffff0000u)}; } }
                else { const float* xr = m < ML ? (const float*)src_lat_ + (size_t)m * DM : src_ctx + (size_t)(m - ML) * DM;
#pragma unroll
                    for (int j = 0; j < 4; ++j) v[u][j] = ((const f32x4*)xr)[lane + 64 * j]; }
                if (slab && m >= ML) {
#pragma unroll
                    for (int j = 0; j < 4; ++j) { f32x4 a = {0.f, 0.f, 0.f, 0.f};
                        for (int sl = 0; sl < nsl; ++sl) a += ((const f32x4*)(slab + (size_t)sl * 512 * 1024 + (size_t)(m - ML) * DM))[lane + 64 * j];
                        v[u][j] += ((const f32x4*)cgate)[lane + 64 * j] * a; ((f32x4*)(ctx_out + (size_t)(m - ML) * DM))[lane + 64 * j] = v[u][j]; } } } }
#pragma unroll
        for (int u = 0; u < 4; ++u) { const int m = m0 + u * NGW; if (m < nrows) {
#pragma unroll
            for (int j = 0; j < 4; ++j) s[u] += (v[u][j].x * v[u][j].x + v[u][j].y * v[u][j].y) + (v[u][j].z * v[u][j].z + v[u][j].w * v[u][j].w);
            const float rstd = 1.0f / sqrtf(wave_sum(s[u]) * (1.0f / DM) + EPS);
            const float* md = mod + (m < SEQ ? 0 : m < ML ? 1 : 2) * 6144;
#pragma unroll
            for (int j = 0; j < 4; ++j) { const int col = 4 * lane + 256 * j;
                const f32x4 g = *(const f32x4*)(gamma + col), sc = *(const f32x4*)(md + scoff + col), sh = *(const f32x4*)(md + shoff + col);
                const f32x4 o = v[u][j] * rstd * g * (sc + 1.0f) + sh;
                u32x2 w; w.x = pk2(o.x, o.y); w.y = pk2(o.z, o.w); *(u32x2*)(HX + (size_t)m * DM + col) = w; } } }
    }
}
__device__ __forceinline__ void final_norm_phase(const bf16_t* xb, float* out, const float* gamma, int gw, int NGW, int lane) {
    for (int m0 = gw; m0 < ML; m0 += 4 * NGW) {
        f32x4 v[4][4];
#pragma unroll
        for (int u = 0; u < 4; ++u) { const int m = m0 + u * NGW; if (m < ML) { const u32x2* xr = (const u32x2*)(xb + (size_t)m * DM);
#pragma unroll
            for (int j = 0; j < 4; ++j) { const u32x2 w = xr[lane + 64 * j]; v[u][j] = (f32x4){__uint_as_float(w.x << 16), __uint_as_float(w.x & 0xffff0000u), __uint_as_float(w.y << 16), __uint_as_float(w.y & 0xffff0000u)}; } } }
#pragma unroll
        for (int u = 0; u < 4; ++u) { const int m = m0 + u * NGW; if (m < ML) { float s = 0.f;
#pragma unroll
            for (int j = 0; j < 4; ++j) s += (v[u][j].x * v[u][j].x + v[u][j].y * v[u][j].y) + (v[u][j].z * v[u][j].z + v[u][j].w * v[u][j].w);
            const float rstd = 1.0f / sqrtf(wave_sum(s) * (1.0f / DM) + EPS);
#pragma unroll
            for (int j = 0; j < 4; ++j) { const f32x4 g = *(const f32x4*)(gamma + 4 * lane + 256 * j); ((f32x4*)(out + (size_t)m * DM))[lane + 64 * j] = v[u][j] * rstd * g; } } }
    }
}

#define SWZ(row, colB) ((row) * 256 + ((colB) ^ (((row) & 7) << 4)))
__device__ __forceinline__ int crow_(int r, int hi) { return (r & 3) + 8 * (r >> 2) + 4 * hi; }
__device__ __forceinline__ bf16x8 pack_bf8(const float* v) { u32x4 w; w.x = pk2(v[0], v[1]); w.y = pk2(v[2], v[3]); w.z = pk2(v[4], v[5]); w.w = pk2(v[6], v[7]); return __builtin_bit_cast(bf16x8, w); }
__device__ __forceinline__ void fft_tables_phase(u32x4* FT, int gt, int NGT) {
    for (int i = gt; i < 4096; i += NGT) { const int ks = i >> 9, t = i & 511, wave = t >> 6, lane = t & 63, tr = wave >> 1, tc = wave & 1, r32 = lane & 31, hi = lane >> 5;
        float cv[8], sv[8], av[8], bv[8];
#pragma unroll
        for (int j = 0; j < 8; ++j) { const int idx = ((32 * tr + r32) * (16 * ks + 8 * hi + j)) & 127; float s, c; sincospif((float)idx * (1.0f / 64.0f), &s, &c); cv[j] = c; sv[j] = -s; }
#pragma unroll
        for (int j = 0; j < 8; ++j) { const int R = 32 * tr + r32, k = 16 * ks + 8 * hi + j, k2 = R & 63, ll = k & 63; float s, c; sincospif((float)((k2 * ll) & 63) * (1.0f / 32.0f), &s, &c);
            av[j] = (R < 64) ? ((k < 64) ? c : s) : ((k < 64) ? -s : c);
            const int m = 32 * tc + r32; float s2, c2; sincospif((float)((m * ll) & 63) * (1.0f / 32.0f), &s2, &c2); bv[j] = (k < 64) ? c2 : s2; }
        FT[i] = __builtin_bit_cast(u32x4, pack_bf8(cv)); FT[4096 + i] = __builtin_bit_cast(u32x4, pack_bf8(sv)); FT[8192 + i] = __builtin_bit_cast(u32x4, pack_bf8(av)); FT[12288 + i] = __builtin_bit_cast(u32x4, pack_bf8(bv)); }
}
__device__ __forceinline__ void fft1_phase(const bf16_t* UF, const f32x2* TW, const u32x4* FT, unsigned* FA, LAS unsigned char* lds, int vcu, int G, int tid, int wave, int lane) {
    const int tr = wave >> 1, tc = wave & 1, r32 = lane & 31, hi = lane >> 5;
    bf16x8 aRe[8], aIm[8];
#pragma unroll
    for (int ks = 0; ks < 8; ++ks) { aRe[ks] = __builtin_bit_cast(bf16x8, FT[ks * 512 + tid]); aIm[ks] = __builtin_bit_cast(bf16x8, FT[4096 + ks * 512 + tid]); }
    for (int item = vcu; item < 512; item += G) {
        const int b = item >> 8, g = (item >> 6) & 3, l2 = item & 63;
#pragma unroll
        for (int i = 0; i < 2; ++i) { const int q = tid + 512 * i, l1 = q >> 3, c8 = (q & 7) * 8;
            const u32x4 v = *(const u32x4*)(UF + (size_t)(b * SEQ + 64 * l1 + l2) * 256 + g * 64 + c8);
#pragma unroll
            for (int e = 0; e < 8; ++e) { const unsigned w = v[e >> 1]; *(LAS bf16_t*)(lds + SWZ(c8 + e, l1 * 2)) = (bf16_t)((e & 1) ? (w >> 16) : (w & 0xffffu)); } }
        __syncthreads();
        f32x16 re = {}, im = {};
#pragma unroll
        for (int ks = 0; ks < 8; ++ks) { const bf16x8 bx = *(const LAS bf16x8*)(lds + SWZ(32 * tc + r32, (16 * ks + 8 * hi) * 2));
            re = __builtin_amdgcn_mfma_f32_32x32x16_bf16(aRe[ks], bx, re, 0, 0, 0); im = __builtin_amdgcn_mfma_f32_32x32x16_bf16(aIm[ks], bx, im, 0, 0, 0); }
        unsigned* dst = FA + ((size_t)((b * 4 + g) * 64 + l2) * 128) * 64 + 32 * tc + r32;
#pragma unroll
        for (int r = 0; r < 16; ++r) { const int k1 = 32 * tr + crow_(r, hi); const f32x2 t = TW[k1 * l2];
            dst[(size_t)k1 * 64] = pk2(re[r] * t.x - im[r] * t.y, re[r] * t.y + im[r] * t.x); }
        __syncthreads();
    }
}
__device__ __forceinline__ void fft2_phase(const unsigned* FA, const u32x4* FT, bf16_t* ACAT, LAS unsigned char* lds, int vcu, int G, int tid, int wave, int lane) {
    const int tr = wave >> 1, tc = wave & 1, r32 = lane & 31, hi = lane >> 5;
    bf16x8 a2[8], b3[8];
#pragma unroll
    for (int ks = 0; ks < 8; ++ks) { a2[ks] = __builtin_bit_cast(bf16x8, FT[8192 + ks * 512 + tid]); b3[ks] = __builtin_bit_cast(bf16x8, FT[12288 + ks * 512 + tid]); }
    LAS unsigned char* Bt = lds;
    LAS unsigned char* Zt = lds + 16384;
    for (int item = vcu; item < 1024; item += G) {
        const int b = item >> 9, g = (item >> 7) & 3, k1 = item & 127;
#pragma unroll
        for (int i = 0; i < 2; ++i) { const int q = tid + 512 * i, l2 = q >> 4, c4 = (q & 15) * 4;
            const u32x4 v = *(const u32x4*)(FA + ((size_t)((b * 4 + g) * 64 + l2) * 128 + k1) * 64 + c4);
#pragma unroll
            for (int e = 0; e < 4; ++e) { *(LAS bf16_t*)(Bt + SWZ(c4 + e, l2 * 2)) = (bf16_t)(v[e] & 0xffffu); *(LAS bf16_t*)(Bt + SWZ(c4 + e, (64 + l2) * 2)) = (bf16_t)(v[e] >> 16); } }
        __syncthreads();
        f32x16 z = {};
#pragma unroll
        for (int ks = 0; ks < 8; ++ks) { const bf16x8 bx = *(const LAS bf16x8*)(Bt + SWZ(32 * tc + r32, (16 * ks + 8 * hi) * 2)); z = __builtin_amdgcn_mfma_f32_32x32x16_bf16(a2[ks], bx, z, 0, 0, 0); }
#pragma unroll
        for (int r = 0; r < 16; ++r) { const int R = 32 * tr + crow_(r, hi); *(LAS bf16_t*)(Zt + SWZ(R & 63, ((R >> 6) * 64 + 32 * tc + r32) * 2)) = (bf16_t)(pk2(z[r], 0.f) & 0xffffu); }
        __syncthreads();
        if (wave < 4) { f32x16 y = {};
#pragma unroll
            for (int ks = 0; ks < 8; ++ks) { const bf16x8 ax = *(const LAS bf16x8*)(Zt + SWZ(32 * tr + r32, (16 * ks + 8 * hi) * 2)); y = __builtin_amdgcn_mfma_f32_32x32x16_bf16(ax, b3[ks], y, 0, 0, 0); }
#pragma unroll
            for (int r = 0; r < 16; ++r) { const int k2 = 32 * tr + crow_(r, hi); ACAT[(size_t)(b * SEQ + k1 + 128 * k2) * KCAT + g * 64 + 32 * tc + r32] = (bf16_t)(pk2(y[r] * 0.001381067932f, 0.f) & 0xffffu); } }
        __syncthreads();
    }
}
__device__ __forceinline__ void ctxdft_item(int item, const bf16_t* UF, bf16_t* ACAT, LAS unsigned char* lds, int tid, int wave, int lane) {
    const int b = item >> 4, g = (item >> 2) & 3, kc = item & 3;
    const int tr = wave >> 1, tc = wave & 1, r32 = lane & 31, hi = lane >> 5;
    LAS unsigned char* Xt = lds;
    LAS unsigned char* Zt = lds + 32768;
#pragma unroll
    for (int i = 0; i < 4; ++i) { const int q = tid + 512 * i, l = q >> 3, c8 = (q & 7) * 8;
        const u32x4 v = *(const u32x4*)(UF + (size_t)(ML + b * CTXL + l) * 256 + g * 64 + c8);
#pragma unroll
        for (int e = 0; e < 8; ++e) { const unsigned w = v[e >> 1]; const int row = c8 + e; *(LAS bf16_t*)(Xt + row * 512 + ((((l >> 3) ^ (row & 7)) << 4) | ((l & 7) * 2))) = (bf16_t)((e & 1) ? (w >> 16) : (w & 0xffffu)); } }
    __syncthreads();
    f32x16 z = {};
    const int R = 32 * tr + r32, kk = 64 * kc + (R & 63);
#pragma unroll 4
    for (int ks = 0; ks < 16; ++ks) { float av[8];
#pragma unroll
        for (int j = 0; j < 8; ++j) { const int l = 16 * ks + 8 * hi + j; float s, c; sincospif((float)((kk * l) & 255) * (1.0f / 128.0f), &s, &c); av[j] = (R < 64) ? c : -s; }
        const int row = 32 * tc + r32, ch = (16 * ks + 8 * hi) >> 3;
        const bf16x8 bx = *(const LAS bf16x8*)(Xt + row * 512 + ((ch ^ (row & 7)) << 4));
        z = __builtin_amdgcn_mfma_f32_32x32x16_bf16(pack_bf8(av), bx, z, 0, 0, 0); }
#pragma unroll
    for (int r = 0; r < 16; ++r) { const int Rr = 32 * tr + crow_(r, hi); *(LAS bf16_t*)(Zt + SWZ(Rr & 63, ((Rr >> 6) * 64 + 32 * tc + r32) * 2)) = (bf16_t)(pk2(z[r], 0.f) & 0xffffu); }
    __syncthreads();
    if (wave < 4) { f32x16 y = {};
#pragma unroll
        for (int ks = 0; ks < 8; ++ks) { float bv[8];
#pragma unroll
            for (int j = 0; j < 8; ++j) { const int k = 16 * ks + 8 * hi + j, m = 32 * tc + r32; float s2, c2; sincospif((float)((m * (k & 63)) & 63) * (1.0f / 32.0f), &s2, &c2); bv[j] = (k < 64) ? c2 : s2; }
            const bf16x8 ax = *(const LAS bf16x8*)(Zt + SWZ(32 * tr + r32, (16 * ks + 8 * hi) * 2)); y = __builtin_amdgcn_mfma_f32_32x32x16_bf16(ax, pack_bf8(bv), y, 0, 0, 0); }
#pragma unroll
        for (int r = 0; r < 16; ++r) { const int k = 64 * kc + 32 * tr + crow_(r, hi); ACAT[(size_t)(ML + b * CTXL + k) * KCAT + g * 64 + 32 * tc + r32] = (bf16_t)(pk2(y[r] * (1.0f / 128.0f), 0.f) & 0xffffu); } }
    __syncthreads();
}

__device__ __forceinline__ void conv_item(int item, const bf16_t* ZG, const float* cw  , const float* cb, const float* lng, const float* lnb, bf16_t* ACAT, LAS unsigned char* lds, int tid, int wave, int lane) {
    const int row0 = item * 64; const bool lat = row0 < ML; const int s0 = lat ? (row0 & ~(SEQ - 1)) : (ML + ((row0 - ML) & ~(CTXL - 1))), s1 = s0 + (lat ? SEQ : CTXL);
    LAS float* zt = (LAS float*)lds;
#pragma unroll
    for (int i = 0; i < 6; ++i) { const int q = tid + 512 * i; if (q < 94 * 32) { const int rr = q >> 5, c8 = (q & 31) * 8, gr = row0 - 15 + rr;
        u32x4 v = {0u, 0u, 0u, 0u}; if (gr >= s0 && gr < s1) v = *(const u32x4*)(ZG + (size_t)gr * 256 + c8);
        *(LAS f32x4*)(zt + rr * 256 + c8) = (f32x4){bf2f(v.x & 0xffffu), __uint_as_float(v.x & 0xffff0000u), bf2f(v.y & 0xffffu), __uint_as_float(v.y & 0xffff0000u)};
        *(LAS f32x4*)(zt + rr * 256 + c8 + 4) = (f32x4){bf2f(v.z & 0xffffu), __uint_as_float(v.z & 0xffff0000u), bf2f(v.w & 0xffffu), __uint_as_float(v.w & 0xffff0000u)}; } }
    const int c = tid & 255, half = tid >> 8;
    float w[31];
#pragma unroll
    for (int t = 0; t < 31; ++t) w[t] = cw[t * 256 + c];
    float acc[32]; const float bias = cb[c];
    __syncthreads();
#pragma unroll
    for (int r0 = 0; r0 < 32; r0 += 4) { float v[34];
#pragma unroll
        for (int i = 0; i < 34; ++i) v[i] = zt[(half * 32 + r0 + i) * 256 + c];
        float a0 = bias, a1 = bias, a2 = bias, a3 = bias;
#pragma unroll
        for (int t = 0; t < 31; ++t) { a0 += w[t] * v[t]; a1 += w[t] * v[t + 1]; a2 += w[t] * v[t + 2]; a3 += w[t] * v[t + 3]; }
        acc[r0] = a0; acc[r0 + 1] = a1; acc[r0 + 2] = a2; acc[r0 + 3] = a3; }
    __syncthreads();
#pragma unroll
    for (int r = 0; r < 32; ++r) zt[(half * 32 + r) * 256 + c] = acc[r];
    __syncthreads();
    const f32x4 gg = *(const f32x4*)(lng + 4 * lane), bb = *(const f32x4*)(lnb + 4 * lane);
#pragma unroll
    for (int i = 0; i < 8; ++i) { const int r = wave * 8 + i; const f32x4 v = *(const LAS f32x4*)(zt + r * 256 + 4 * lane);
        const float mu = wave_sum((v.x + v.y) + (v.z + v.w)) * (1.0f / 256.0f); const f32x4 d = v - mu;
        const float var = wave_sum((d.x * d.x + d.y * d.y) + (d.z * d.z + d.w * d.w)) * (1.0f / 256.0f); const float rs = 1.0f / sqrtf(var + EPS);
        f32x4 o = d * rs * gg + bb; o.x *= sigm(o.x); o.y *= sigm(o.y); o.z *= sigm(o.z); o.w *= sigm(o.w);
        u32x2 pw; pw.x = pk2(o.x, o.y); pw.y = pk2(o.z, o.w); *(u32x2*)(ACAT + (size_t)(row0 + r) * KCAT + 768 + 4 * lane) = pw; }
    __syncthreads();
}
__device__ __forceinline__ void pool_phase(const bf16_t* UP, const float* pw  , const float* psc, bf16_t* ACAT, int nitems, int first, LAS unsigned char* lds, int G, int tid, int wave, int lane) {
    const int g = wave >> 1, tc = wave & 1, r32 = lane & 31, hi = lane >> 5;
    bf16x8 bw[4];
#pragma unroll
    for (int ks = 0; ks < 4; ++ks) { float v[8];
#pragma unroll
        for (int j = 0; j < 8; ++j) v[j] = pw[g * 4096 + (16 * ks + 8 * hi + j) * 64 + 32 * tc + r32];
        bw[ks] = pack_bf8(v); }
    const float osc = psc[g * 64 + 32 * tc + r32];
    LAS float* ut = (LAS float*)lds;
    LAS unsigned char* dt = lds + 81920;
    for (int item = first; item < nitems; item += G) {
        const int row0 = item * 64; const bool lat = row0 < ML; const int s0 = lat ? (row0 & ~(SEQ - 1)) : (ML + ((row0 - ML) & ~(CTXL - 1))), L = lat ? SEQ : CTXL, s1 = s0 + L;
#pragma unroll
        for (int i = 0; i < 5; ++i) { const int q = tid + 512 * i, rr = q >> 5, c8 = (q & 31) * 8, gr = row0 - 8 + rr;
            u32x4 v = {0u, 0u, 0u, 0u}; if (gr >= s0 && gr < s1) v = *(const u32x4*)(UP + (size_t)gr * 256 + c8);
            *(LAS f32x4*)(ut + rr * 256 + c8) = (f32x4){bf2f(v.x & 0xffffu), __uint_as_float(v.x & 0xffff0000u), bf2f(v.y & 0xffffu), __uint_as_float(v.y & 0xffff0000u)};
            *(LAS f32x4*)(ut + rr * 256 + c8 + 4) = (f32x4){bf2f(v.z & 0xffffu), __uint_as_float(v.z & 0xffff0000u), bf2f(v.w & 0xffffu), __uint_as_float(v.w & 0xffff0000u)}; }
        __syncthreads();
#pragma unroll
        for (int i = 0; i < 4; ++i) { const int q = tid + 512 * i, lr = q >> 5, c8 = (q & 31) * 8, gg = c8 >> 6, hw = 1 << gg, tt = row0 + lr - s0;
            f32x4 sa = {0.f, 0.f, 0.f, 0.f}, sb = {0.f, 0.f, 0.f, 0.f};
            for (int o = -hw; o < hw; ++o) { sa += *(const LAS f32x4*)(ut + (lr + 8 + o) * 256 + c8); sb += *(const LAS f32x4*)(ut + (lr + 8 + o) * 256 + c8 + 4); }
            const int lo = tt - hw < 0 ? 0 : tt - hw, hh = tt + hw - 1 > L - 1 ? L - 1 : tt + hw - 1; const float inv = 1.0f / (float)(hh - lo + 1);
            const f32x4 ua = *(const LAS f32x4*)(ut + (lr + 8) * 256 + c8), ub = *(const LAS f32x4*)(ut + (lr + 8) * 256 + c8 + 4);
            const f32x4 da = sa * inv - ua, db = sb * inv - ub;
            u32x4 w; w.x = pk2(da.x, da.y); w.y = pk2(da.z, da.w); w.z = pk2(db.x, db.y); w.w = pk2(db.z, db.w);
            *(LAS u32x4*)(dt + lr * 512 + ((((c8 >> 3) ^ (lr & 7)) << 4))) = w; }
        __syncthreads();
#pragma unroll
        for (int rt = 0; rt < 2; ++rt) { f32x16 y = {};
#pragma unroll
            for (int ks = 0; ks < 4; ++ks) { const int row = 32 * rt + r32, ch = (g * 64 + 16 * ks + 8 * hi) >> 3;
                const bf16x8 ax = *(const LAS bf16x8*)(dt + row * 512 + ((ch ^ (row & 7)) << 4)); y = __builtin_amdgcn_mfma_f32_32x32x16_bf16(ax, bw[ks], y, 0, 0, 0); }
#pragma unroll
            for (int r = 0; r < 16; ++r) ACAT[(size_t)(row0 + 32 * rt + crow_(r, hi)) * KCAT + 1024 + g * 64 + 32 * tc + r32] = (bf16_t)(pk2(y[r] * osc, 0.f) & 0xffffu); }
        __syncthreads();
    }
}

__device__ __forceinline__ void ctx_gate_combine(const float* slab, const unsigned char* Gc  , bf16_t* Yc, int gw, int NGW, int lane) {
    for (int r = gw; r < MC; r += NGW) {
#pragma unroll
        for (int j = 0; j < 4; ++j) { const int col = 4 * lane + 256 * j; f32x4 y = {0.f, 0.f, 0.f, 0.f};
#pragma unroll
            for (int sl = 0; sl < 5; ++sl) { const int b = sl == 0 ? 0 : sl <= 2 ? 1 : sl - 1;
                const f32x4 p = *(const f32x4*)(slab + (size_t)sl * 512 * 1024 + (size_t)r * 1024 + col); const unsigned q = *(const unsigned*)(Gc + pg8::gofs(r, b * 1024 + col));
                y[0] += p[0] * (float)(q & 255u); y[1] += p[1] * (float)((q >> 8) & 255u); y[2] += p[2] * (float)((q >> 16) & 255u); y[3] += p[3] * (float)(q >> 24); }
            y = y * (1.0f / 255.0f);
            u32x2 w; w.x = pk2(y[0], y[1]); w.y = pk2(y[2], y[3]); *(u32x2*)(Yc + (size_t)r * 1024 + col) = w; }
    }
}
constexpr int NPHASE = 22;
struct Args { const float* in[30]; float* out; unsigned char* ws; int ph_lo, ph_hi, li, pad; };
__global__ void __launch_bounds__(512, 2) __attribute__((amdgpu_waves_per_eu(2, 2))) fwd_kernel(Args args) {
    extern __shared__ __attribute__((aligned(16))) unsigned char lds[];
    LAS unsigned char* L = (LAS unsigned char*)lds;
    volatile LAS unsigned* MISC = (volatile LAS unsigned*)(L + MISC_OFF);
    const int tid0 = threadIdx.x; const int wave0 = __builtin_amdgcn_readfirstlane(tid0 >> 6);
    const int G = gridDim.x, bx0 = blockIdx.x, vcu0 = (G % 8 == 0) ? (bx0 % 8) * (G / 8) + bx0 / 8 : bx0;
    const int NGW = G * 8;
    gu32* ctl = (gu32*)(args.ws + WS_CTL);
    for (int u = tid0; u < (LDS_BYTES - LDSCTL_OFF) / 4; u += 512) ((LAS unsigned*)(L + LDSCTL_OFF))[u] = 0u;
    __syncthreads();
    volatile LAS unsigned long long* PT = (volatile LAS unsigned long long*)(L + PT_OFF);
    if (tid0 < 32) PT[tid0] = ((const __attribute__((address_space(4))) unsigned long long*)__builtin_amdgcn_kernarg_segment_ptr())[tid0];
    __syncthreads();
#define FRESH() int tid, vcu = vcu0, bx = bx0; asm volatile("v_mbcnt_lo_u32_b32 %0, -1, 0\n\tv_mbcnt_hi_u32_b32 %0, -1, %0" : "=v"(tid)); tid += wave0 * 64; asm volatile("" : "+v"(tid), "+s"(vcu), "+s"(bx)); const int lane = tid & 63, wave = __builtin_amdgcn_readfirstlane(tid >> 6), gw = vcu * 8 + wave; (void)lane; (void)gw; (void)bx; \
    LAS float* scr = (LAS float*)(L + wave * 16384); (void)scr;
#define PTR(i) ((const float*)(const GAS float*)ldptr(PT, (i)))
#define OUTP ((float*)(GAS float*)ldptr(PT, 30))
#define WSP ((unsigned char*)(GAS unsigned char*)ldptr(PT, 31))
    XcdBarrier bar; bar.bar = (unsigned*)(ctl + CW_BAR) + args.li * XCD_BAR_WORDS; bar.x = 0; bar.st = nullptr;
    if (MK_N_LAUNCHES != NPHASE) bar = xcd_barrier_post((unsigned*)(ctl + CW_BAR) + args.li * XCD_BAR_WORDS, MISC + 8);
#ifndef TAILREP
#define TAILREP 1
#endif
#ifndef WGM_IN
#define WGM_IN 8
#endif
#ifndef WGM_UP
#define WGM_UP 8
#endif
#ifndef FFT2REP
#define FFT2REP 1
#endif
#ifndef UPV_REV
#define UPV_REV 1
#endif
#ifndef BARX2
#define BARX2 0
#endif
#ifdef CLKPROBE
#define CK_START(k) do { if ((k) == CLKPROBE && l == 0 && tid == 0) { const unsigned long long a_ = __builtin_amdgcn_s_memtime(), b_ = __builtin_amdgcn_s_memrealtime(); MISC[12] = (unsigned)a_; MISC[13] = (unsigned)(a_ >> 32); MISC[14] = (unsigned)b_; MISC[15] = (unsigned)(b_ >> 32); } } while (0)
#define CK_STOP(k) do { if ((k) == CLKPROBE && l == 0 && tid == 0) { const unsigned long long t1_ = __builtin_amdgcn_s_memtime(), r1_ = __builtin_amdgcn_s_memrealtime(); \
        const unsigned long long t0_ = MISC[12] | ((unsigned long long)MISC[13] << 32), r0_ = MISC[14] | ((unsigned long long)MISC[15] << 32); MISC[16] = (unsigned)(((t1_ - t0_) * 100ull) / (r1_ - r0_)); } } while (0)
#else
#define CK_START(k) do {} while (0)
#define CK_STOP(k) do {} while (0)
#endif
#define GRID_BAR() do { if (MK_N_LAUNCHES == NPHASE) { if (tid0 == 0) __hip_atomic_store(ctl + CW_TMO, 0xBADBA0u, RLX_AGENT); } else { xcd_barrier(bar); if (BARX2) xcd_barrier(bar); } } while (0)
    const int lo = args.ph_lo, hi = args.ph_hi;
#ifndef PHASE_MASK
#define PHASE_MASK 0xFFF
#endif
#ifndef ATTM
#define ATTM 3
#endif
#ifndef X1REP
#define X1REP 0
#endif
#ifndef X1M
#define X1M 31
#endif
#define PH_EN(kind) ((PHASE_MASK >> (kind)) & 1)
#ifndef REP_MASK
#define REP_MASK 0
#endif
#define NREP(kind) (((REP_MASK >> (kind)) & 1) ? 2 : 1)
#define IN(k) (lo <= (k) && (k) < hi)
#define BOTH(k) (IN(k) && IN((k) + 1))
#define WSRC(S, l) WSrc S; S.w_in = PTR(8) + (size_t)(l) * 1024 * NIN; S.wo_f = PTR(20) + (size_t)(l) * 256 * 1024; S.wo_a = PTR(21) + (size_t)(l) * 512 * 1024; \
    S.wo_c = PTR(22) + (size_t)(l) * 256 * 1024; S.wo_p = PTR(23) + (size_t)(l) * 256 * 1024; S.w_out = PTR(24) + (size_t)(l) * 1024 * 1024; \
    S.w_up = PTR(25) + (size_t)(l) * 1024 * 2 * DFF; S.w_down = PTR(28) + (size_t)(l) * DFF * 1024;
#define ws WSP
#define OUTHI ((unsigned char*)OUTP + 32 * MiB)
#define WA1 ((bf16_t*)OUTHI)
#define WUPG1 ((bf16_t*)(OUTHI + 13 * MiB))
#define WUPV1 ((bf16_t*)(OUTHI + 13 * MiB + (size_t)2816 * 1024 * 2))
#define WDST0 {(bf16_t*)(ws + WS_WA), (bf16_t*)(ws + WS_WCAT), (bf16_t*)(ws + WS_WOUT), (bf16_t*)(ws + WS_WDN), (bf16_t*)(ws + WS_WUPG), (bf16_t*)(ws + WS_WUPV)}
#define WDST1 {WA1, (bf16_t*)(ws + WS_WCAT), (bf16_t*)(ws + WS_WOUT), (bf16_t*)(ws + WS_WDN), WUPG1, WUPV1}
#define TAIL_CONVERT(MASK, nwg_, lo_, hi_) do { const int rem_ = (nwg_) % G; if (rem_ == 0 || bx >= rem_) { __syncthreads(); WSRC(S1, 1); const WDst D1 = WDST1; \
        for (int tr_ = 0; tr_ < TAILREP; ++tr_) convert_items<MASK>(S1, D1, scr, (lo_), (hi_), (rem_ ? bx - rem_ : bx) * 8 + wave, (rem_ ? G - rem_ : G) * 8, lane); } } while (0)
#define MOD ((float*)(WSP + WS_MOD))
#define ROPE ((float*)(WSP + WS_ROPE))
#define TW ((f32x2*)(WSP + WS_TW))
#define FT ((u32x4*)(WSP + WS_FT))
#define XC ((float*)(WSP + WS_XC))
#define HX ((bf16_t*)(WSP + WS_HX))
#define FA ((f32x2*)(WSP + WS_FA))
#define Qb ((bf16_t*)(WSP + WS_Q))
#define Kb ((bf16_t*)(WSP + WS_K))
#define Vb ((bf16_t*)(WSP + WS_V))
#define Yb ((bf16_t*)(WSP + WS_Y))
#define Gb (WSP + WS_G)
#define ACAT ((bf16_t*)(WSP + WS_ACAT))
#define UF ((bf16_t*)(WSP + WS_UF))
#define ZG ((bf16_t*)(WSP + WS_ZG))
#define UP ((bf16_t*)(WSP + WS_UP))
#define GT ((bf16_t*)(WSP + WS_GT))
#define Hb ((bf16_t*)(WSP + WS_H))

    for (int rep = 0; rep < NREP(0); ++rep) if (PH_EN(0) && IN(0)) { FRESH();
        mod_phase(PTR(1), PTR(3), PTR(6), PTR(7), MOD, L, vcu, G, tid, wave, lane);
        tables_phase(ROPE, TW, vcu * 512 + tid, G * 512); fft_tables_phase(FT, ((vcu + 128) % G) * 512 + tid, G * 512);
        for (int i = vcu * 512 + tid; i < MC * DM / 4; i += G * 512) ((f32x4*)XC)[i] = ((const f32x4*)PTR(2))[i];
        WSRC(S0, 0); { const WDst D0 = WDST0; convert_items<31>(S0, D0, scr, 0, ITU_END, gw, NGW, lane); }
        if (BOTH(0)) GRID_BAR();
    }
#pragma nounroll
    for (int l = 0; l < 2; ++l) {
        const int pb = 1 + 10 * l;
#define mod (MOD + l * 3 * 6144)
#define XBF ((bf16_t*)OUTP)
#define xc ((l == 0) ? PTR(2) : (const float*)XC)
        const int Mact = (l == 0) ? MT : ML;
        for (int rep = 0; rep < NREP(1); ++rep) if (PH_EN(1) && IN(pb)) { FRESH(); if (l == 0) norm_phase<false>(PTR(0), xc, MT, PTR(4) + l * DM, mod, 0, 1024, HX, gw, NGW, lane);
            else norm_phase<true>(XBF, xc, MT, PTR(4) + l * DM, mod, 0, 1024, HX, gw, NGW, lane, (const float*)Gb, 11, MOD + 2 * 6144 + 5120, XC);
            if (BOTH(pb)) GRID_BAR(); }
        for (int rep = 0; rep < NREP(2); ++rep) if (PH_EN(2) && IN(pb + 1)) { FRESH();
            pg8::Gemm g{HX, l == 0 ? (const bf16_t*)(ws + WS_WA) : (const bf16_t*)WA1, MT, NIN, 1024}; pg8::StaticOrder S; S.init(MT, NIN, G, bx); S.wgm = WGM_IN;
            pg8::EpiIn E{UF, ZG, UP, Qb, Kb, Vb, Gb, ROPE};
            CK_START(1);
            pg8::gemm_phase<pg8::EpiIn, pg8::StaticOrder, true, true>(L, g, S, E, tid);
            CK_STOP(1);
#ifdef KLOOP_PROBE
            if (KLOOP_PROBE == 1) { int tid3 = tid; asm volatile("" : "+v"(tid3)); pg8::EpiNull En; pg8::gemm_phase<pg8::EpiNull, pg8::StaticOrder, true, true>(L, g, S, En, tid3); }
#endif
            TAIL_CONVERT(7, (MT / 256) * (NIN / 256), l == 0 ? 0 : ITU_CAT, l == 0 ? IT_A : ITU_UPG);
            if (BOTH(pb + 1)) GRID_BAR();
        }
        for (int rep = 0; rep < NREP(3); ++rep) if (PH_EN(3) && IN(pb + 2)) { FRESH();
            for (int r1 = 0; r1 < ((X1REP & 1) ? 2 : 1); ++r1) if (X1M & 1) fft1_phase(UF, TW, FT, (unsigned*)FA, L, vcu, G, tid, wave, lane);
            for (int r1 = 0; r1 < ((X1REP & 2) ? 2 : 1); ++r1) if (X1M & 2) for (int it = vcu; it < Mact / 64; it += G) conv_item(it, ZG, PTR(14) + l * 31 * 256, PTR(15) + l * 256, PTR(16) + l * 256, PTR(17) + l * 256, ACAT, L, tid, wave, lane);
            for (int r1 = 0; r1 < ((X1REP & 4) ? 2 : 1); ++r1) if (X1M & 4) pool_phase(UP, PTR(18) + l * 4 * 4096, PTR(19) + l * 256, ACAT, Mact / 64, (vcu + 248) % G, L, G, tid, wave, lane);
            if ((X1M & 8) && l == 0) for (int it = (vcu + 224) % G; it < 32; it += G) ctxdft_item(it, UF, ACAT, L, tid, wave, lane);
            if (l == 0) {
                const float lam_init = 0.2f;
                const float d1 = wave_sum(PTR(9)[lane] * PTR(10)[lane]), d2 = wave_sum(PTR(11)[lane] * PTR(12)[lane]);
                const float lam = __builtin_bit_cast(float, __builtin_amdgcn_readfirstlane(__builtin_bit_cast(int, expf(d1) - expf(d2) + lam_init)));
                for (int v = (vcu + 200) % G; v < 16; v += G) { const int b = v >> 3, h = (v >> 1) & 3, row0 = ML + b * CTXL + (v & 1) * 128;
                    att2::attn_unit<0>(Qb + (size_t)row0 * 512 + h * 128, Kb + (size_t)b * KVL * 512 + h * 128, Vb + (size_t)b * KVL * 512 + h * 128, CTXL,
                                       ACAT + (size_t)row0 * KCAT + 256 + h * 128, lam, 1.0f - lam_init, PTR(13), (char*)lds, tid); }
            }
            if (BOTH(pb + 2)) GRID_BAR();
        }
        for (int rep = 0; rep < NREP(4); ++rep) if (PH_EN(4) && IN(pb + 3)) { FRESH();
            if (ATTM & 1) fft2_phase((const unsigned*)FA, FT, ACAT, L, vcu, G, tid, wave, lane);
            if (FFT2REP == 2) { int tid4 = tid, vcu4 = vcu; asm volatile("" : "+v"(tid4), "+s"(vcu4)); fft2_phase((const unsigned*)FA, FT, ACAT, L, vcu4, G, tid4, __builtin_amdgcn_readfirstlane(tid4 >> 6), tid4 & 63); }
            const float lam_init = (l == 0) ? 0.2f : 0.35550906759096926f;
            const float d1 = wave_sum(PTR(9)[l * 64 + lane] * PTR(10)[l * 64 + lane]), d2 = wave_sum(PTR(11)[l * 64 + lane] * PTR(12)[l * 64 + lane]);
            const float lam = __builtin_bit_cast(float, __builtin_amdgcn_readfirstlane(__builtin_bit_cast(int, expf(d1) - expf(d2) + lam_init)));
            const int nun = 512;
            CK_START(3);
            if (ATTM & 2) for (int u = vcu; u < nun; u += G) {
                int b, h, row0, nkeys;
                if (u < 512) { const int x = (u & 255) >> 5, qb = (u & 31) + 32 * (u >> 8); b = x >> 2; h = x & 3; row0 = b * SEQ + qb * 128; nkeys = KVL; }
                else { const int v = u - 512; b = v >> 3; h = (v >> 1) & 3; row0 = ML + b * CTXL + (v & 1) * 128; nkeys = CTXL; }
#if ATT_V == 2
                att2::attn_unit<0>(Qb + (size_t)row0 * 512 + h * 128,
#else
                att::attn_unit<0>(Qb + (size_t)row0 * 512 + h * 128,
#endif
                               Kb + (size_t)b * KVL * 512 + h * 128, Vb + (size_t)b * KVL * 512 + h * 128, nkeys,
                               ACAT + (size_t)row0 * KCAT + 256 + h * 128, lam, 1.0f - lam_init, PTR(13) + l * 128, (char*)lds, tid);
            }
            CK_STOP(3);
            if (l == 0) {
                pg8::Gemm gc{ACAT + (size_t)ML * KCAT, (const bf16_t*)(ws + WS_WCAT), MC, 1024, 256, KCAT}; pg8::BranchSliceOrder Sc{G, bx};
                pg8::EpiSlab Ec{(float*)UF};
                pg8::gemm_phase<pg8::EpiSlab, pg8::BranchSliceOrder, true, true>(L, gc, Sc, Ec, tid);
            }
#if defined(ATT_PROBE)
            int tid2 = tid, vcu2 = vcu; asm volatile("" : "+v"(tid2), "+s"(vcu2));
            for (int u = vcu2; u < 512; u += G) {
                const int x = (u & 255) >> 5, qb = (u & 31) + 32 * (u >> 8), b = x >> 2, h = x & 3, row0 = b * SEQ + qb * 128;
                att2::attn_unit<ATT_PROBE>(Qb + (size_t)row0 * 512 + h * 128, Kb + (size_t)b * KVL * 512 + h * 128, Vb + (size_t)b * KVL * 512 + h * 128, KVL,
                               Hb + (size_t)row0 * KCAT + 256 + h * 128, lam, 1.0f - lam_init, PTR(13) + l * 128, (char*)lds, tid2);
            }
#endif
            if (BOTH(pb + 3)) GRID_BAR();
        }
        for (int rep = 0; rep < NREP(5); ++rep) if (PH_EN(5) && IN(pb + 4)) { FRESH();
            if (l == 0) ctx_gate_combine((const float*)UF, Gb + (size_t)ML * 4096, Yb + (size_t)ML * 1024, gw, NGW, lane);
            pg8::Gemm g{ACAT, (const bf16_t*)(ws + WS_WCAT), ML, 1024, KCAT}; pg8::StaticOrder S; S.init(ML, 1024, G, bx);
            pg8::EpiBranch E{Gb, Yb};
            pg8::gemm_phase<pg8::EpiBranch, pg8::StaticOrder, true, true>(L, g, S, E, tid);
            if (BOTH(pb + 4)) GRID_BAR();
        }
        for (int rep = 0; rep < (l == 0 ? NREP(6) : 1); ++rep) if (PH_EN(6) && IN(pb + 5)) { FRESH();
            pg8::Gemm g{Yb, (const bf16_t*)(ws + WS_WOUT), ML, 1024, 1024}; pg8::StaticOrder S; S.init(ML, 1024, G, bx);
            pg8::EpiRes E{l == 0 ? PTR(0) : (const float*)nullptr, XBF, xc, XBF, XC, mod, 2048};
            pg8::gemm_phase<pg8::EpiRes, pg8::StaticOrder, true, true>(L, g, S, E, tid);
            if (l == 0) {
                pg8::Gemm gc{Yb + (size_t)ML * 1024, (const bf16_t*)(ws + WS_WOUT), MC, 1024, 256, 1024}; pg8::SplitKOrder Sc{4, 256, G, bx};
                pg8::EpiSlab Ec{(float*)Gb};
                pg8::gemm_phase<pg8::EpiSlab, pg8::SplitKOrder, true, true>(L, gc, Sc, Ec, tid);
            }
            if (BOTH(pb + 5)) GRID_BAR();
        }
        for (int rep = 0; rep < NREP(7); ++rep) if (PH_EN(7) && IN(pb + 6)) { FRESH(); if (l == 0) norm_phase<true>(XBF, XC, Mact, PTR(5) + l * DM, mod, 3072, 4096, HX, gw, NGW, lane, (const float*)Gb, 4, mod + 2 * 6144 + 2048, XC);
            else norm_phase<true>(XBF, XC, Mact, PTR(5) + l * DM, mod, 3072, 4096, HX, gw, NGW, lane);
            if (BOTH(pb + 6)) GRID_BAR(); }
        for (int rep = 0; rep < NREP(8); ++rep) if (PH_EN(8) && IN(pb + 7)) { FRESH();
            pg8::Gemm g{HX, l == 0 ? (const bf16_t*)(ws + WS_WUPG) : (const bf16_t*)WUPG1, Mact, DFF, 1024}; pg8::StaticOrder S; S.init(Mact, DFF, G, bx); S.wgm = WGM_UP;
            pg8::EpiBf E{GT, DFF};
            pg8::gemm_phase<pg8::EpiBf, pg8::StaticOrder, true, true>(L, g, S, E, tid);
#ifdef KLOOP_PROBE
            if (KLOOP_PROBE == 7) { int tid3 = tid; asm volatile("" : "+v"(tid3)); pg8::EpiNull En; pg8::gemm_phase<pg8::EpiNull, pg8::StaticOrder, true, true>(L, g, S, En, tid3); }
            if (KLOOP_PROBE == 17) { int tid3 = tid; asm volatile("" : "+v"(tid3)); pg8::gemm_phase<pg8::EpiBf, pg8::StaticOrder, true, true>(L, g, S, E, tid3); }
#endif
            if (l == 0) TAIL_CONVERT(8, (MT / 256) * (DFF / 256), ITU_UPG, ITU_UPV);
            if (BOTH(pb + 7)) GRID_BAR();
        }
        for (int rep = 0; rep < NREP(9); ++rep) if (PH_EN(9) && IN(pb + 8)) { FRESH();
            pg8::Gemm g{HX, l == 0 ? (const bf16_t*)(ws + WS_WUPV) : (const bf16_t*)WUPV1, Mact, DFF, 1024}; pg8::StaticOrder S; S.init(Mact, DFF, G, bx); S.rev = UPV_REV; S.wgm = WGM_UP;
            pg8::EpiVal E{GT, Hb, PTR(26) + l * 3 * DFF, PTR(27) + l * DFF};
            CK_START(8);
            pg8::gemm_phase<pg8::EpiVal, pg8::StaticOrder, true, true>(L, g, S, E, tid);
            CK_STOP(8);
#ifdef KLOOP_PROBE
            if (KLOOP_PROBE == 8) { int tid3 = tid; asm volatile("" : "+v"(tid3)); pg8::EpiNull En; pg8::gemm_phase<pg8::EpiNull, pg8::StaticOrder, true, true>(L, g, S, En, tid3); }
            if (KLOOP_PROBE == 18) { int tid3 = tid; asm volatile("" : "+v"(tid3)); pg8::gemm_phase<pg8::EpiVal, pg8::StaticOrder, true, true>(L, g, S, E, tid3); }
#endif
            if (l == 0) TAIL_CONVERT(16, (MT / 256) * (DFF / 256), ITU_UPV, ITU_END);
            if (BOTH(pb + 8)) GRID_BAR();
        }
        if (PH_EN(10) && IN(pb + 9)) { FRESH();
            pg8::Gemm g{Hb, (const bf16_t*)(ws + WS_WDN), ML, 1024, DFF}; pg8::StaticOrder S; S.init(ML, 1024, G, bx);
            pg8::EpiRes E{(const float*)nullptr, XBF, XC, l == 0 ? XBF : HX, XC, mod, 5120};
            pg8::gemm_phase<pg8::EpiRes, pg8::StaticOrder, true, true>(L, g, S, E, tid);
            if (l == 0) {
                pg8::Gemm gc{Hb + (size_t)ML * DFF, (const bf16_t*)(ws + WS_WDN), MC, 1024, 256, DFF}; pg8::SplitKOrder Sc{11, 256, G, bx};
                pg8::EpiSlab Ec{(float*)Gb};
                pg8::gemm_phase<pg8::EpiSlab, pg8::SplitKOrder, true, true>(L, gc, Sc, Ec, tid);
            }
            if (BOTH(pb + 9)) GRID_BAR();
        }
    }
    if (PH_EN(11) && IN(21)) { FRESH(); final_norm_phase(HX, OUTP, PTR(29), gw, NGW, lane); }
#ifdef KT_PROBE
    if (bx0 == 0 && wave0 == 0) { const unsigned us = (KT_PROBE == 1) ? (MISC[20] / (MISC[21] ? MISC[21] : 1u)) / 10u : (KT_PROBE == 2) ? (MISC[23] / (MISC[24] ? MISC[24] : 1u)) / 100u : (MISC[25] / (MISC[26] ? MISC[26] : 1u)) / 20u;
        const unsigned long long s0 = __builtin_amdgcn_s_memrealtime(); while (__builtin_amdgcn_s_memrealtime() - s0 < (unsigned long long)us * 100ull) __builtin_amdgcn_s_sleep(8); }
#endif
#ifdef CLKPROBE
    if (bx0 == 0 && wave0 == 0) { const unsigned mhz = MISC[16]; const unsigned long long s0 = __builtin_amdgcn_s_memrealtime(); while (__builtin_amdgcn_s_memrealtime() - s0 < (unsigned long long)mhz * 10ull) __builtin_amdgcn_s_sleep(8); }
#endif
#undef IN
#undef BOTH
#undef mod
#undef XBF
#undef xc
#undef ws
#undef OUTHI
#undef WA1
#undef WUPG1
#undef WUPV1
#undef WDST0
#undef WDST1
#undef TAIL_CONVERT
#undef MOD
#undef ROPE
#undef TW
#undef FT
#undef XC
#undef HX
#undef FA
#undef Qb
#undef Kb
#undef Vb
#undef Yb
#undef Gb
#undef ACAT
#undef UF
#undef ZG
#undef UP
#undef GT
#undef Hb
#undef PTR
#undef OUTP
#undef WSP
}

extern "C" void kernel_launch(void* const* d_in, const int* in_sizes, int n_in, void* d_out, int out_size, void* d_ws, size_t ws_size, hipStream_t stream) {
    static int grid = 0;
    if (grid == 0) {
        if (n_in != 30 || in_sizes[0] != ML * DM || out_size != ML * DM || ws_size < WS_END) {
            fprintf(stderr, "kernel_launch: unexpected shapes: n_in %d in0 %d out %d ws %zu (need >= %zu)\n", n_in, n_in > 0 ? in_sizes[0] : -1, out_size, ws_size, (size_t)WS_END); grid = -1; return; }
        int dev = 0, cus = 0, per_cu = 0;
        if (hipGetDevice(&dev) != hipSuccess || hipDeviceGetAttribute(&cus, hipDeviceAttributeMultiprocessorCount, dev) != hipSuccess) { grid = -1; return; }
        if (hipFuncSetAttribute((const void*)fwd_kernel, hipFuncAttributeMaxDynamicSharedMemorySize, LDS_BYTES) != hipSuccess) { fprintf(stderr, "kernel_launch: hipFuncSetAttribute failed\n"); grid = -1; return; }
        if (hipOccupancyMaxActiveBlocksPerMultiprocessor(&per_cu, (const void*)fwd_kernel, 512, LDS_BYTES) != hipSuccess || per_cu < 1) {
            fprintf(stderr, "kernel_launch: occupancy query reports %d blocks per CU\n", per_cu); (void)hipGetLastError(); grid = -1; return; }
        grid = cus;
    }
    if (grid < 0) return;
    (void)hipMemsetAsync((char*)d_ws + WS_CTL, 0, CTL_ZERO_BYTES, stream);
    Args a{};
    for (int i = 0; i < 30; ++i) a.in[i] = (const float*)d_in[i];
    a.out = (float*)d_out; a.ws = (unsigned char*)d_ws;
    for (int li = 0; li < MK_N_LAUNCHES; ++li) {
        if (MK_N_LAUNCHES == NPHASE) { a.ph_lo = li; a.ph_hi = li + 1; a.li = 0; }
        else { a.ph_lo = (int)((long)NPHASE * li / MK_N_LAUNCHES); a.ph_hi = (int)((long)NPHASE * (li + 1) / MK_N_LAUNCHES); a.li = li; }
        hipLaunchKernelGGL(fwd_kernel, dim3(grid), dim3(512), LDS_BYTES, stream, a);
    }
}
```

```cpp
#include <hip/hip_runtime.h>
#include <cstdio>
#include <cstdint>

#define LAS __attribute__((address_space(3)))
#define GAS __attribute__((address_space(1)))
typedef unsigned short bf16_t;
typedef short bf16x8 __attribute__((ext_vector_type(8)));
typedef short s16x4 __attribute__((ext_vector_type(4)));
typedef float f32x2 __attribute__((ext_vector_type(2)));
typedef float f32x4 __attribute__((ext_vector_type(4)));
typedef float f32x16 __attribute__((ext_vector_type(16)));
typedef unsigned u32x2 __attribute__((ext_vector_type(2)));
typedef unsigned u32x4 __attribute__((ext_vector_type(4)));

#ifndef ATT_V
#define ATT_V 2
#endif
#ifndef MK_N_LAUNCHES
#define MK_N_LAUNCHES 1
#endif

constexpr int DM = 1024, SEQ = 8192, NBATCH = 2, CTXL = 256;
constexpr int ML = NBATCH * SEQ;
constexpr int MC = NBATCH * CTXL;
constexpr int MT = ML + MC;
constexpr int NIN = 6656, DFF = 2816, KCAT = 1280;
constexpr int KVL = CTXL + SEQ;
constexpr float EPS = 1e-6f;

constexpr size_t MiB = 1u << 20;
constexpr size_t WS_CTL = 0, CTL_ZERO_BYTES = 1 * MiB;
constexpr size_t WS_MOD = 1 * MiB;
constexpr size_t WS_ROPE = WS_MOD + 2 * 3 * 6144 * 4;
constexpr size_t WS_TW = WS_ROPE + 192 * 32 * 4;
constexpr size_t WS_FT = WS_MOD + 512 * 1024;
constexpr size_t WS_XC = 2 * MiB;
constexpr size_t WS_WA = 4 * MiB;
constexpr size_t WS_WCAT = 17 * MiB;
constexpr size_t WS_WOUT = WS_WCAT + (size_t)1024 * 1280 * 2;
constexpr size_t WS_WUPG = WS_WOUT + (size_t)1024 * 1024 * 2;
constexpr size_t WS_WUPV = WS_WUPG + (size_t)2816 * 1024 * 2;
constexpr size_t WS_WDN = WS_WUPV + (size_t)2816 * 1024 * 2;
constexpr size_t WS_HX = 38 * MiB;
constexpr size_t WS_FA = WS_HX;
constexpr size_t WS_Q = 71 * MiB;
constexpr size_t WS_K = WS_Q + (size_t)MT * 512 * 2;
constexpr size_t WS_V = WS_K + (size_t)MT * 512 * 2;
constexpr size_t WS_Y = 71 * MiB;
constexpr size_t WS_G = 121 * MiB;
constexpr size_t WS_ACAT = 187 * MiB;
constexpr size_t WS_UF = 229 * MiB;
constexpr size_t WS_ZG = WS_UF + (size_t)MT * 256 * 2;
constexpr size_t WS_UP = WS_ZG + (size_t)MT * 256 * 2;
constexpr size_t WS_GT = 71 * MiB;
constexpr size_t WS_H = 162 * MiB;
constexpr size_t WS_VE = 253 * MiB;
constexpr size_t WS_END = 256 * MiB;
static_assert(WS_TW + 8192 * 8 <= WS_FT && WS_FT + 4 * 4096 * 16 <= WS_XC && WS_WDN + (size_t)1024 * 2816 * 2 <= WS_HX && WS_V + (size_t)MT * 512 * 2 <= WS_G && WS_G + (size_t)MT * 4096 <= WS_ACAT, "ws map 1");
static_assert(WS_ACAT + (size_t)MT * 1280 * 2 <= WS_UF && WS_UP + (size_t)MT * 256 * 2 <= WS_END && WS_GT + (size_t)MT * 2816 * 2 <= WS_H && WS_H + (size_t)MT * 2816 * 2 <= WS_VE && WS_VE + (size_t)66 * 2 * 2816 * 4 <= WS_END, "ws map 2");
static_assert(WS_HX + (size_t)MT * 1024 * 2 <= WS_Q && (size_t)2 * 4 * 128 * 64 * 64 * 8 <= (size_t)MT * 1024 * 2, "ws map 3");
constexpr int CW_TMO = 0, CW_CODE = 1, CW_BAR = 4096;

constexpr int RING_BYTES = 131072, LDSCTL_OFF = RING_BYTES, MISC_OFF = LDSCTL_OFF + 320, LDS_BYTES = 147456;

typedef __bf16 bf16x2_t __attribute__((ext_vector_type(2)));
__device__ __forceinline__ unsigned cvt2bf(float lo, float hi) { const f32x2 v = {lo, hi}; return __builtin_bit_cast(unsigned, __builtin_convertvector(v, bf16x2_t)); }
template <int M> __device__ __forceinline__ float swz_xor(float v) { return __int_as_float(__builtin_amdgcn_ds_swizzle(__float_as_int(v), (M << 10) | 0x1f)); }
__device__ __forceinline__ float bf2f(unsigned v) { return __uint_as_float(v << 16); }
__device__ __forceinline__ float sigm(float x) { return __builtin_amdgcn_rcpf(1.0f + __builtin_amdgcn_exp2f(x * -1.4426950408889634f)); }
__host__ __device__ __forceinline__ int in_map(int n) {
    if (n < 256) return n;
    if (n < 1280) { const int base = n < 768 ? 256 : 768, r = n - base, comp = r >> 6, p = r & 63, pp = p >> 1, e = p & 1;
        return base + comp * 64 + (pp < 16 ? 0 : 32) + (pp & 15) + 16 * e; }
    if (n < 1792) return n;
    if (n < 2304) { const int r = n - 1792; return 1792 + (r & 1) * 256 + (r >> 1); }
    return n;
}
namespace pg8 {
#define PG8_LAS __attribute__((address_space(3)))
typedef unsigned short bf16_t;
typedef short bf16x8 __attribute__((ext_vector_type(8)));
typedef float f32x4 __attribute__((ext_vector_type(4)));
typedef unsigned u32x4 __attribute__((ext_vector_type(4)));
constexpr int BM = 256, BK = 64, HALF = 128, HTB = HALF * BK * 2  , STAGE_BYTES = 8 * HTB, NXCD = 8, WGM = 8;

__host__ __device__ __forceinline__ int lds_byte(int r, int c) { const int st = (r >> 4) * 2 + (c >> 5), rr = r & 15, cc = c & 31, ob = rr * 64 + cc * 2; return st * 1024 + (ob ^ (((ob >> 9) & 1) << 5)); }
__host__ __device__ __forceinline__ void stage_rc(int b, int& R, int& C) { const int st = b / 1024, sb = b % 1024, swz = sb ^ (((sb >> 9) & 1) << 5); R = (st >> 1) * 16 + swz / 64; C = (st & 1) * 32 + (swz % 64) / 2; }
__host__ __device__ __forceinline__ int perm32(int rho) { const int n = rho >> 4, i = rho & 15; return 8 * (i >> 2) + 4 * n + (i & 3); }

struct Unit { int pm, pn, ko = 0, sl = 0; };
struct Gemm { const bf16_t* A; const bf16_t* Bt; int M, N, K, ld = 0; const bf16_t* Bt2 = nullptr; };

struct StaticOrder {
    int nM, nN, nwg, G, c, rev = 0, wgm = WGM, revn = 0;
    __host__ __device__ void init(int M, int N, int G_, int c_) { nM = M / BM; nN = N / BM; nwg = nM * nN; G = G_; c = c_; }
    __host__ __device__ __forceinline__ bool next(int i, Unit& u) const {
        long L = (long)i * G + c;
        if (rev) { const int n_mine = (nwg - c + G - 1) / G; if (i >= n_mine) return false; L = (long)(n_mine - 1 - i) * G + c; }
        if (L >= nwg) return false;
        int wgid = (int)L; { const int q = nwg / NXCD, r = nwg % NXCD, xcd = wgid % NXCD, off = wgid / NXCD; wgid = (xcd < r ? xcd * (q + 1) : r * (q + 1) + (xcd - r) * q) + off; }
        const int nig = wgm * nN, gid = wgid / nig, fm = gid * wgm, gsz = (nM - fm) < wgm ? (nM - fm) : wgm;
        u.pm = fm + ((wgid % nig) % gsz); u.pn = (wgid % nig) / gsz; if (revn) u.pn = nN - 1 - u.pn; return true;
    }
    __device__ __forceinline__ void a_ready(const Unit&) const {}
    __device__ __forceinline__ void done(const Unit&) const {}
};
__device__ __forceinline__ unsigned cvt_pk_bf16(float lo, float hi) { return cvt2bf(lo, hi); }
typedef float f32x2 __attribute__((ext_vector_type(2)));
__device__ __forceinline__ float gelu_mul(float v, float val) {
    asm volatile("" : "+v"(v));
    const float av = __builtin_fabsf(v);
    const float t = __builtin_amdgcn_rcpf(__builtin_fmaf(av, 0.33267292f, 1.0f));
    float q = __builtin_fmaf(t, 0.3739278f, -0.0479399f); q = __builtin_fmaf(q, t, 0.1740121f); q = q * t;
    const float e = __builtin_amdgcn_exp2f((v * v) * (-0.72134752044f));
    const float h = __builtin_fmaf(-q, e, 0.5f);
    return val * __builtin_fmaf(av, h, 0.5f * v);
}
__device__ __forceinline__ float gelu_s(float v) {
    asm volatile("" : "+v"(v));
    const float t = __builtin_amdgcn_rcpf(__builtin_fabsf(v) * 0.2316418882f + 1.0f);
    float q = t * 0.5307027145f + (-0.7265760135f); q = q * t + 0.7107068705f; q = q * t + (-0.142248368f); q = q * t + 0.127414796f; q = q * t;
    const float e = __builtin_amdgcn_exp2f((v * v) * (-0.72134752044f));
    const float m = v * (q * e);
    return v < 0.f ? m : v - m;
}
__device__ __forceinline__ f32x2 gelu_pk(f32x2 v) {
    const f32x2 av = __builtin_elementwise_abs(v), d = av * 0.2316418882f + 1.0f;
    f32x2 t; t.x = __builtin_amdgcn_rcpf(d.x); t.y = __builtin_amdgcn_rcpf(d.y);
    f32x2 q = t * 0.5307027145f + (-0.7265760135f); q = q * t + 0.7107068705f; q = q * t + (-0.142248368f); q = q * t + 0.127414796f; q = q * t;
    const f32x2 s = (v * v) * (-0.72134752044f);
    f32x2 e; e.x = __builtin_amdgcn_exp2f(s.x); e.y = __builtin_amdgcn_exp2f(s.y);
    const f32x2 m = v * (q * e), r = v - m;
    f32x2 o; o.x = v.x < 0.f ? m.x : r.x; o.y = v.y < 0.f ? m.y : r.y; return o;
}

typedef unsigned u32x2 __attribute__((ext_vector_type(2)));
__device__ __forceinline__ u32x4 pack8(const f32x4 a, const f32x4 b) { u32x4 w; w.x = cvt_pk_bf16(a[0], a[1]); w.y = cvt_pk_bf16(a[2], a[3]); w.z = cvt_pk_bf16(b[0], b[1]); w.w = cvt_pk_bf16(b[2], b[3]); return w; }

__host__ __device__ __forceinline__ size_t gofs(int row, int col) { return ((size_t)((row >> 4) * 128 + (col >> 5)) << 9) + (size_t)((row & 15) * 32 + (col & 31)); }
__host__ __device__ __forceinline__ size_t gtofs(int row, int col) { return ((size_t)((row >> 4) * 88 + (col >> 5)) << 9) + (size_t)((row & 15) * 32 + (col & 31)); }
struct EpiIn {
    static constexpr bool PERM = true, AFTER_DRAIN = false, RESCALE = false; static constexpr int NVM = 16;
    bf16_t *UF, *ZG, *UP, *Q, *K, *V; unsigned char* G; const float* rope;
    __device__ __forceinline__ void operator()(const f32x4 (&acc)[2][2][4][2], const Unit& u, int wr, int wc, int fr, int fq) const {
        const int pm = u.pm, pn = u.pn; const bool lat = pm < 64; const int R0 = pm * 256;
        const int kv0 = lat ? ((pm >> 5) * 8448 + 256 + ((pm & 31) << 8)) : ((pm - 64) * 8448);
        const int rl = wr * 64 + fr, cl = wc * 32 + 8 * fq;
        if (pn == 0 || pn == 9) {
            bf16_t* dst = (pn == 0 ? UF : UP);
#pragma unroll
            for (int ai = 0; ai < 2; ++ai)
#pragma unroll
                for (int m = 0; m < 4; ++m) { const int rr = ai * 128 + m * 16 + rl;
#pragma unroll
                    for (int bj = 0; bj < 2; ++bj) *(u32x4*)(dst + (size_t)(R0 + rr) * 256 + bj * 128 + cl) = pack8(acc[ai][bj][m][0], acc[ai][bj][m][1]); }
        } else if (pn <= 4) {
            const bool isq = pn <= 2; bf16_t* dst = isq ? Q : K; const int rowbase = isq ? R0 : kv0, colbase = (isq ? pn - 1 : pn - 3) * 256; const float sc = isq ? (ATT_V == 2 ? 0.18033688011112042f : 0.125f) : 1.0f;
#pragma unroll
            for (int ai = 0; ai < 2; ++ai) {
                f32x4 csv[4], snv[4];
#pragma unroll
                for (int m = 0; m < 4; ++m) { const int rr = ai * 128 + m * 16 + rl; csv[m] = (f32x4){1.f, 1.f, 1.f, 1.f}; snv[m] = (f32x4){0.f, 0.f, 0.f, 0.f};
                    if (lat) { const int t = (R0 & 8191) + rr; const int pos = (wc & 1) ? 128 + (t & 63) : (t >> 6);
                        csv[m] = *(const f32x4*)(rope + pos * 32 + 4 * fq); snv[m] = *(const f32x4*)(rope + pos * 32 + 16 + 4 * fq); } }
                asm volatile("" ::: "memory");
#pragma unroll
                for (int m = 0; m < 4; ++m) { const int rr = ai * 128 + m * 16 + rl;
                    f32x4 cs = csv[m] * sc, sn = snv[m] * sc;
#pragma unroll
                    for (int bj = 0; bj < 2; ++bj) { const f32x4 a = acc[ai][bj][m][0], b = acc[ai][bj][m][1]; f32x4 oa, ob;
                        oa[0] = a[0] * cs[0] - a[1] * sn[0]; oa[1] = a[1] * cs[0] + a[0] * sn[0]; oa[2] = a[2] * cs[1] - a[3] * sn[1]; oa[3] = a[3] * cs[1] + a[2] * sn[1];
                        ob[0] = b[0] * cs[2] - b[1] * sn[2]; ob[1] = b[1] * cs[2] + b[0] * sn[2]; ob[2] = b[2] * cs[3] - b[3] * sn[3]; ob[3] = b[3] * cs[3] + b[2] * sn[3];
                        *(u32x4*)(dst + (size_t)(rowbase + rr) * 512 + colbase + bj * 128 + cl) = pack8(oa, ob); } } }
        } else if (pn <= 6) {
#pragma unroll
            for (int ai = 0; ai < 2; ++ai)
#pragma unroll
                for (int m = 0; m < 4; ++m) { const int rr = ai * 128 + m * 16 + rl;
#pragma unroll
                    for (int bj = 0; bj < 2; ++bj) *(u32x4*)(V + (size_t)(kv0 + rr) * 512 + (pn - 5) * 256 + bj * 128 + cl) = pack8(acc[ai][bj][m][0], acc[ai][bj][m][1]); }
        } else if (pn <= 8) {
#pragma unroll
            for (int ai = 0; ai < 2; ++ai)
#pragma unroll
                for (int m = 0; m < 4; ++m) { const int rr = ai * 128 + m * 16 + rl;
#pragma unroll
                    for (int bj = 0; bj < 2; ++bj) { const f32x4 a = acc[ai][bj][m][0], b = acc[ai][bj][m][1];
                        u32x2 w; w.x = cvt_pk_bf16(a[0] * sigm(a[1]), a[2] * sigm(a[3])); w.y = cvt_pk_bf16(b[0] * sigm(b[1]), b[2] * sigm(b[3]));
                        *(u32x2*)(ZG + (size_t)(R0 + rr) * 256 + (pn - 7) * 128 + bj * 64 + (cl >> 1)) = w; } }
        } else {
#pragma unroll
            for (int ai = 0; ai < 2; ++ai)
#pragma unroll
                for (int m = 0; m < 4; ++m) { const int rr = ai * 128 + m * 16 + rl;
#pragma unroll
                    for (int bj = 0; bj < 2; ++bj) { u32x2 w;
#pragma unroll
                        for (int n = 0; n < 2; ++n) { const f32x4 a = acc[ai][bj][m][n]; unsigned q = 0;
#pragma unroll
                            for (int j = 0; j < 4; ++j) { float s = sigm(a[j]) * 255.0f + 0.5f; s = s < 1.0f ? 1.0f : s; q |= ((unsigned)s) << (8 * j); }
                            if (n == 0) w.x = q; else w.y = q; }
                        *(u32x2*)(G + gofs(R0 + rr, (pn - 10) * 256 + bj * 128 + cl)) = w; } }
        }
    }
};

struct EpiBf {
    static constexpr bool PERM = true, AFTER_DRAIN = false, RESCALE = false; static constexpr int NVM = 16;
    bf16_t* O; int ldc;
    __device__ __forceinline__ void operator()(const f32x4 (&acc)[2][2][4][2], const Unit& u, int wr, int wc, int fr, int fq) const {
        const int row0 = u.pm * 256 + wr * 64 + fr, col0 = u.pn * 256 + wc * 32 + 8 * fq;
#pragma unroll
        for (int ai = 0; ai < 2; ++ai)
#pragma unroll
            for (int m = 0; m < 4; ++m)
#pragma unroll
                for (int bj = 0; bj < 2; ++bj) *(u32x4*)(O + gtofs(row0 + ai * 128 + m * 16, col0 + bj * 128)) = pack8(acc[ai][bj][m][0], acc[ai][bj][m][1]);
    }
};

struct EpiNull {
    static constexpr bool PERM = true, AFTER_DRAIN = false, RESCALE = false; static constexpr int NVM = 0 ;
    __device__ __forceinline__ void operator()(const f32x4 (&acc)[2][2][4][2], const Unit&, int, int, int, int) const {
#pragma unroll
        for (int ai = 0; ai < 2; ++ai)
#pragma unroll
            for (int m = 0; m < 4; ++m)
#pragma unroll
                for (int bj = 0; bj < 2; ++bj) asm volatile("" :: "v"(acc[ai][bj][m][0]), "v"(acc[ai][bj][m][1]));
    }
};

struct EpiRes {
    static constexpr bool PERM = true, AFTER_DRAIN = false, RESCALE = false; static constexpr int NVM = 16;
    const float* base_f32; const bf16_t* base_bf; const float* base_ctx; bf16_t* out_bf; float* out_ctx; const float* mod; int goff;
    __device__ __forceinline__ void operator()(const f32x4 (&acc)[2][2][4][2], const Unit& u, int wr, int wc, int fr, int fq) const {
        const int pm = u.pm; const bool lat = pm < 64; const int mrow = lat ? (pm >> 5) : 2;
        const int col0 = u.pn * 256 + wc * 32 + 8 * fq;
        f32x4 gv[2][2];
#pragma unroll
        for (int bj = 0; bj < 2; ++bj)
#pragma unroll
            for (int n = 0; n < 2; ++n) gv[bj][n] = *(const f32x4*)(mod + mrow * 6144 + goff + col0 + bj * 128 + 4 * n);
#pragma unroll
        for (int ai = 0; ai < 2; ++ai)
#pragma unroll
            for (int m = 0; m < 4; ++m) { const size_t ro = (size_t)((lat ? pm : pm - 64) * 256 + ai * 128 + wr * 64 + m * 16 + fr) * 1024 + col0;
#pragma unroll
                for (int bj = 0; bj < 2; ++bj) { const size_t off = ro + bj * 128; f32x4 b0, b1;
                    if (!lat) { b0 = *(const f32x4*)(base_ctx + off); b1 = *(const f32x4*)(base_ctx + off + 4); }
                    else if (base_f32) { b0 = __builtin_nontemporal_load((const f32x4*)(base_f32 + off)); b1 = __builtin_nontemporal_load((const f32x4*)(base_f32 + off + 4)); }
                    else { const u32x4 w = *(const u32x4*)(base_bf + off);
                        b0 = (f32x4){__uint_as_float(w.x << 16), __uint_as_float(w.x & 0xffff0000u), __uint_as_float(w.y << 16), __uint_as_float(w.y & 0xffff0000u)};
                        b1 = (f32x4){__uint_as_float(w.z << 16), __uint_as_float(w.z & 0xffff0000u), __uint_as_float(w.w << 16), __uint_as_float(w.w & 0xffff0000u)}; }
                    const f32x4 o0 = b0 + gv[bj][0] * acc[ai][bj][m][0], o1 = b1 + gv[bj][1] * acc[ai][bj][m][1];
                    if (lat) *(u32x4*)(out_bf + off) = pack8(o0, o1); else { *(f32x4*)(out_ctx + off) = o0; *(f32x4*)(out_ctx + off + 4) = o1; } } }
    }
};

struct EpiVal {
    static constexpr bool PERM = true, AFTER_DRAIN = false, RESCALE = false; static constexpr int NVM = 16;
    const bf16_t* GT; bf16_t* H; const float* dww; const float* dwb;
    __device__ __forceinline__ void operator()(const f32x4 (&acc)[2][2][4][2], const Unit& u, int wr, int wc, int fr, int fq) const {
        const int pm = u.pm; const bool lat = pm < 64; const int R0 = pm * 256, t0 = lat ? (R0 & 8191) : 0, L = lat ? 8192 : 256;
#pragma unroll
        for (int bj = 0; bj < 2; ++bj) { const int col = u.pn * 256 + bj * 128 + wc * 32 + 8 * fq;
            f32x4 w0[2], w1[2], w2[2], bb[2];
#pragma unroll
            for (int n = 0; n < 2; ++n) { w0[n] = *(const f32x4*)(dww + col + 4 * n); w1[n] = *(const f32x4*)(dww + 2816 + col + 4 * n); w2[n] = *(const f32x4*)(dww + 5632 + col + 4 * n); bb[n] = *(const f32x4*)(dwb + col + 4 * n); }
#pragma unroll
            for (int ai = 0; ai < 2; ++ai) {
                const int rb = ai * 128 + wr * 64, tb = t0 + rb;
                u32x4 g[4], elo = {0u, 0u, 0u, 0u}, ehi = {0u, 0u, 0u, 0u};
#pragma unroll
                for (int m = 0; m < 4; ++m) g[m] = *(const u32x4*)(GT + gtofs(R0 + rb + m * 16 + fr, col));
                if (tb > 0) elo = *(const u32x4*)(GT + gtofs(R0 + rb - 1, col));
                if (tb + 64 < L) ehi = *(const u32x4*)(GT + gtofs(R0 + rb + 64, col));
                asm volatile("" ::: "memory");
#pragma unroll
                for (int m = 0; m < 4; ++m) { const int rr = rb + m * 16 + fr;
                    u32x4 gm, gq;
#pragma unroll
                    for (int d = 0; d < 4; ++d) {
                        const int pa = (m == 0) ? (int)elo[d] : __builtin_amdgcn_update_dpp(0, (int)g[m == 0 ? 0 : m - 1][d], 0x121  , 0xF, 0xF, true);
                        gm[d] = (unsigned)__builtin_amdgcn_update_dpp(pa, (int)g[m][d], 0x111  , 0xF, 0xF, false);
                        const int pb = (m == 3) ? (int)ehi[d] : __builtin_amdgcn_update_dpp(0, (int)g[m == 3 ? 3 : m + 1][d], 0x12F  , 0xF, 0xF, true);
                        gq[d] = (unsigned)__builtin_amdgcn_update_dpp(pb, (int)g[m][d], 0x101  , 0xF, 0xF, false); }
                    f32x4 o[2];
#pragma unroll
                    for (int n = 0; n < 2; ++n) { f32x4 c;
#pragma unroll
                        for (int j = 0; j < 4; ++j) { const int e = 4 * n + j; const unsigned wm = gm[e >> 1], wz = g[m][e >> 1], wp = gq[e >> 1];
                            const float xm = (e & 1) ? __uint_as_float(wm & 0xffff0000u) : __uint_as_float(wm << 16), xz = (e & 1) ? __uint_as_float(wz & 0xffff0000u) : __uint_as_float(wz << 16),
                                        xp = (e & 1) ? __uint_as_float(wp & 0xffff0000u) : __uint_as_float(wp << 16);
                            c[j] = __builtin_fmaf(w2[n][j], xp, __builtin_fmaf(w1[n][j], xz, __builtin_fmaf(w0[n][j], xm, bb[n][j]))); }
                        const f32x4 v = acc[ai][bj][m][n]; o[n] = (f32x4){gelu_mul(c[0], v[0]), gelu_mul(c[1], v[1]), gelu_mul(c[2], v[2]), gelu_mul(c[3], v[3])}; }
                    *(u32x4*)(H + (size_t)(R0 + rr) * 2816 + col) = pack8(o[0], o[1]); }
                asm volatile("" ::: "memory");
            }
        }
    }
};

struct PairOrder {
    int nM, nN, np, G, c;
    __host__ __device__ void init(int M, int N, int G_, int c_) { nM = M / BM; nN = N / BM; np = nM * nN; G = G_; c = c_; }
    __host__ __device__ __forceinline__ bool next(int i, Unit& u) const {
        const long L = (long)(i >> 1) * G + c; if (L >= np) return false;
        int wgid = (int)L; { const int q = np / NXCD, r = np % NXCD, xcd = wgid % NXCD, off = wgid / NXCD; wgid = (xcd < r ? xcd * (q + 1) : r * (q + 1) + (xcd - r) * q) + off; }
        const int nig = WGM * nN, gid = wgid / nig, fm = gid * WGM, gsz = (nM - fm) < WGM ? (nM - fm) : WGM;
        u.pm = fm + ((wgid % nig) % gsz); u.pn = (wgid % nig) / gsz; u.sl = i & 1; u.ko = 0; return true;
    }
    __device__ __forceinline__ void a_ready(const Unit&) const {}
    __device__ __forceinline__ void done(const Unit&) const {}
};
struct EpiUp {
    static constexpr bool PERM = true, AFTER_DRAIN = false, RESCALE = false; static constexpr int NVM = 16;
    bf16_t* GT; bf16_t* H; const float* dww; const float* dwb; float* VE;
    __device__ __forceinline__ void operator()(const f32x4 (&acc)[2][2][4][2], const Unit& u, int wr, int wc, int fr, int fq) const {
        const int pm = u.pm, R0 = pm * 256;
        if (u.sl == 0) {
            const int row0 = R0 + wr * 64 + fr, col0 = u.pn * 256 + wc * 32 + 8 * fq;
#pragma unroll
            for (int ai = 0; ai < 2; ++ai)
#pragma unroll
                for (int m = 0; m < 4; ++m)
#pragma unroll
                    for (int bj = 0; bj < 2; ++bj) *(u32x4*)(GT + gtofs(row0 + ai * 128 + m * 16, col0 + bj * 128)) = pack8(acc[ai][bj][m][0], acc[ai][bj][m][1]);
            return;
        }
#pragma unroll
        for (int bj = 0; bj < 2; ++bj) { const int col = u.pn * 256 + bj * 128 + wc * 32 + 8 * fq;
            f32x4 w0[2], w1[2], w2[2], bb[2];
#pragma unroll
            for (int n = 0; n < 2; ++n) { w0[n] = *(const f32x4*)(dww + col + 4 * n); w1[n] = *(const f32x4*)(dww + 2816 + col + 4 * n); w2[n] = *(const f32x4*)(dww + 5632 + col + 4 * n); bb[n] = *(const f32x4*)(dwb + col + 4 * n); }
#pragma unroll
            for (int ai = 0; ai < 2; ++ai) {
                const int rb = ai * 128 + wr * 64;
                u32x4 g[4], elo = {0u, 0u, 0u, 0u}, ehi = {0u, 0u, 0u, 0u};
#pragma unroll
                for (int m = 0; m < 4; ++m) g[m] = *(const u32x4*)(GT + gtofs(R0 + rb + m * 16 + fr, col));
                if (rb > 0) elo = *(const u32x4*)(GT + gtofs(R0 + rb - 1, col));
                if (rb + 64 < 256) ehi = *(const u32x4*)(GT + gtofs(R0 + rb + 64, col));
                asm volatile("" ::: "memory");
#pragma unroll
                for (int m = 0; m < 4; ++m) { const int rr = rb + m * 16 + fr;
                    u32x4 gm, gq;
#pragma unroll
                    for (int d = 0; d < 4; ++d) {
                        const int pa = (m == 0) ? (int)elo[d] : __builtin_amdgcn_update_dpp(0, (int)g[m == 0 ? 0 : m - 1][d], 0x121  , 0xF, 0xF, true);
                        gm[d] = (unsigned)__builtin_amdgcn_update_dpp(pa, (int)g[m][d], 0x111  , 0xF, 0xF, false);
                        const int pb = (m == 3) ? (int)ehi[d] : __builtin_amdgcn_update_dpp(0, (int)g[m == 3 ? 3 : m + 1][d], 0x12F  , 0xF, 0xF, true);
                        gq[d] = (unsigned)__builtin_amdgcn_update_dpp(pb, (int)g[m][d], 0x101  , 0xF, 0xF, false); }
                    if ((m == 0 && rr == 0) || (m == 3 && rr == 255)) {
                        float* ve = VE + (size_t)(pm * 2 + (rr ? 1 : 0)) * 2816 + col; *(f32x4*)ve = acc[ai][bj][m][0]; *(f32x4*)(ve + 4) = acc[ai][bj][m][1];
                    } else {
                    f32x4 o[2];
#pragma unroll
                    for (int n = 0; n < 2; ++n) { f32x4 c;
#pragma unroll
                        for (int j = 0; j < 4; ++j) { const int e = 4 * n + j; const unsigned wm = gm[e >> 1], wz = g[m][e >> 1], wp = gq[e >> 1];
                            const float xm = (e & 1) ? __uint_as_float(wm & 0xffff0000u) : __uint_as_float(wm << 16), xz = (e & 1) ? __uint_as_float(wz & 0xffff0000u) : __uint_as_float(wz << 16),
                                        xp = (e & 1) ? __uint_as_float(wp & 0xffff0000u) : __uint_as_float(wp << 16);
                            c[j] = __builtin_fmaf(w2[n][j], xp, __builtin_fmaf(w1[n][j], xz, __builtin_fmaf(w0[n][j], xm, bb[n][j]))); }
                        const f32x4 v = acc[ai][bj][m][n]; o[n] = (f32x4){gelu_mul(c[0], v[0]), gelu_mul(c[1], v[1]), gelu_mul(c[2], v[2]), gelu_mul(c[3], v[3])}; }
                    *(u32x4*)(H + (size_t)(R0 + rr) * 2816 + col) = pack8(o[0], o[1]); }
                }
                asm volatile("" ::: "memory");
            }
        }
    }
};

struct EpiBranch {
    static constexpr bool PERM = true, AFTER_DRAIN = false, RESCALE = true; static constexpr int NVM = 16;
    const unsigned char* G; bf16_t* Y;
    __device__ __forceinline__ void rescale(f32x4 (&acc)[2][2][4][2], const Unit& u, int t, int wr, int wc, int fr, int fq) const {
        const int bp = (t == 4) ? 0 : (t == 12) ? 1 : 2;
        const __amdgpu_buffer_rsrc_t rs = __builtin_amdgcn_make_buffer_rsrc((void*)G, 0, MT * 4096, 0x00020000);
        const int voff = fr * 32 + 8 * fq;
        u32x2 p[2][4][2], q[2][4][2];
#pragma unroll
        for (int ai = 0; ai < 2; ++ai)
#pragma unroll
            for (int m = 0; m < 4; ++m)
#pragma unroll
                for (int bj = 0; bj < 2; ++bj) { const int so = ((u.pm * 16 + ai * 8 + wr * 4 + m) * 128 + bp * 32 + u.pn * 8 + bj * 4 + wc) * 512;
                    p[ai][m][bj] = __builtin_bit_cast(u32x2, __builtin_amdgcn_raw_buffer_load_b64(rs, voff, so, 0)); q[ai][m][bj] = __builtin_bit_cast(u32x2, __builtin_amdgcn_raw_buffer_load_b64(rs, voff, so + 32 * 512, 0)); }
        asm volatile("" ::: "memory");
#pragma unroll
        for (int ai = 0; ai < 2; ++ai)
#pragma unroll
            for (int m = 0; m < 4; ++m)
#pragma unroll
                for (int bj = 0; bj < 2; ++bj)
#pragma unroll
                    for (int n = 0; n < 2; ++n) { const unsigned pw = n ? p[ai][m][bj].y : p[ai][m][bj].x, qw = n ? q[ai][m][bj].y : q[ai][m][bj].x;
#pragma unroll
                        for (int j = 0; j < 4; ++j) acc[ai][bj][m][n][j] *= (float)((pw >> (8 * j)) & 255u) * __builtin_amdgcn_rcpf((float)((qw >> (8 * j)) & 255u)); }
        asm volatile("" ::: "memory");
    }
    __device__ __forceinline__ void operator()(const f32x4 (&acc)[2][2][4][2], const Unit& u, int wr, int wc, int fr, int fq) const {
        const int row0 = u.pm * 256 + wr * 64 + fr, col0 = u.pn * 256 + wc * 32 + 8 * fq;
#pragma unroll
        for (int ai = 0; ai < 2; ++ai)
#pragma unroll
            for (int m = 0; m < 4; ++m)
#pragma unroll
                for (int bj = 0; bj < 2; ++bj) { const size_t r = (size_t)(row0 + ai * 128 + m * 16); const u32x2 p = *(const u32x2*)(G + gofs((int)r, 3072 + col0 + bj * 128));
                    f32x4 o[2];
#pragma unroll
                    for (int n = 0; n < 2; ++n) { const unsigned pw = n ? p.y : p.x;
#pragma unroll
                        for (int j = 0; j < 4; ++j) o[n][j] = acc[ai][bj][m][n][j] * ((float)((pw >> (8 * j)) & 255u) * (1.0f / 255.0f)); }
                    *(u32x4*)(Y + r * 1024 + col0 + bj * 128) = pack8(o[0], o[1]); }
    }
};


struct SplitKOrder {
    int nsl, ksl, G, c;
    __device__ __forceinline__ bool next(int i, Unit& u) const { const int L = i * G + c; if (L >= 8 * nsl) return false; u.pm = (L >> 2) & 1; u.pn = L & 3; u.sl = L >> 3; u.ko = u.sl * ksl; return true; }
    __device__ __forceinline__ void a_ready(const Unit&) const {}
    __device__ __forceinline__ void done(const Unit&) const {}
};
struct EpiSlab {
    static constexpr bool PERM = false, AFTER_DRAIN = false, RESCALE = false; static constexpr int NVM = 16;
    float* slab;
    __device__ __forceinline__ void operator()(const f32x4 (&acc)[2][2][4][2], const Unit& u, int wr, int wc, int, int) const {
        int ln; asm volatile("v_mbcnt_lo_u32_b32 %0, -1, 0\n\tv_mbcnt_hi_u32_b32 %0, -1, %0" : "=v"(ln));
        const int fr = ln & 15, fq = ln >> 4;
        float* o = slab + (size_t)u.sl * 512 * 1024 + (size_t)(u.pm * 256 + wr * 64 + fr) * 1024 + u.pn * 256 + wc * 32 + 4 * fq;
#pragma unroll
        for (int ai = 0; ai < 2; ++ai)
#pragma unroll
            for (int m = 0; m < 4; ++m)
#pragma unroll
                for (int bj = 0; bj < 2; ++bj)
#pragma unroll
                    for (int n = 0; n < 2; ++n) *(f32x4*)(o + (size_t)(ai * 128 + m * 16) * 1024 + bj * 128 + n * 16) = acc[ai][bj][m][n];
    }
};

struct BranchSliceOrder {
    int G, c;
    __device__ __forceinline__ bool next(int i, Unit& u) const { const int L = i * G + c; if (L >= 40) return false; u.pm = (L >> 2) & 1; u.pn = L & 3; u.sl = L >> 3; u.ko = u.sl * 256; return true; }
    __device__ __forceinline__ void a_ready(const Unit&) const {}
    __device__ __forceinline__ void done(const Unit&) const {}
};
template <class Epi, class Sched, bool ALIGN_EPI = false, bool SP2 = false>
__device__ __forceinline__ void gemm_phase(PG8_LAS unsigned char* lds, const Gemm g, const Sched& S, const Epi& E, const int tid) {
    const int wid = __builtin_amdgcn_readfirstlane(tid >> 6), lane = tid & 63, wr = wid >> 2, wc = wid & 3, fr = lane & 15, fq = lane >> 4;
    const int K = g.ld ? g.ld : g.K  , nt = g.K / BK;
    unsigned voffA[2], voffB[2];
#pragma unroll
    for (int i = 0; i < 2; ++i) { int R, C; stage_rc(tid * 16 + i * 8192, R, C); const int Rb = Epi::PERM ? ((R & ~31) + perm32(R & 31)) : R;
        voffA[i] = (unsigned)(R * K + C) * 2u; voffB[i] = (unsigned)(Rb * K + C) * 2u; }
    const size_t kstep = (size_t)(BK * 2);
    const size_t hstep = (size_t)HALF * K * 2;
    const size_t tstep = 2 * hstep;
    const unsigned ldsw = (unsigned)wid * 1024u;
    const int aoff = lds_byte(wr * 64 + fr, fq * 8), boff = lds_byte(wc * 32 + fr, fq * 8);
#define PG8_SA(b, h) (((b) * 2 + (h)) * HTB)
#define PG8_SB(b, h) ((4 + (b) * 2 + (h)) * HTB)
#define PG8_STAGE(bufoff, gbase, voff) do { _Pragma("unroll") for (int _i = 0; _i < 2; ++_i) \
        __builtin_amdgcn_global_load_lds((const unsigned*)((const char*)(gbase) + (voff)[_i]), (PG8_LAS unsigned*)(lds + (bufoff) + ldsw + _i * 8192), 16, 0, 0); } while (0)
#define PG8_LDA(dst, b, h) do { _Pragma("unroll") for (int m = 0; m < 4; ++m) _Pragma("unroll") for (int k = 0; k < 2; ++k) dst[m][k] = *(const PG8_LAS bf16x8*)(lds + PG8_SA(b, h) + aoff + m * 2048 + k * 1024); } while (0)
#define PG8_LDB(dst, b, h) do { _Pragma("unroll") for (int n = 0; n < 2; ++n) _Pragma("unroll") for (int k = 0; k < 2; ++k) dst[n][k] = *(const PG8_LAS bf16x8*)(lds + PG8_SB(b, h) + boff + n * 2048 + k * 1024); } while (0)
#define PG8_MMA(ai, bj, At, Bt) do { __builtin_amdgcn_s_setprio(1); _Pragma("unroll") for (int m = 0; m < 4; ++m) _Pragma("unroll") for (int n = 0; n < 2; ++n) _Pragma("unroll") for (int k = 0; k < 2; ++k) \
        acc[ai][bj][m][n] = __builtin_amdgcn_mfma_f32_16x16x32_bf16(Bt[n][k], At[m][k], acc[ai][bj][m][n], 0, 0, 0); __builtin_amdgcn_s_setprio(0); } while (0)
#define PG8_WAIT_V(n) asm volatile("s_waitcnt vmcnt(" #n ")" ::: "memory")
#define PG8_WAIT_L(n) asm volatile("s_waitcnt lgkmcnt(" #n ")" ::: "memory")
#define PG8_BAR __builtin_amdgcn_s_barrier()
#define PG8_SCHED __builtin_amdgcn_sched_barrier(0)
    Unit cur, nxt; int ui = 0;
    if (!S.next(0, cur)) return;
    f32x4 acc[2][2][4][2];
#pragma unroll
    for (int a = 0; a < 2; ++a)
#pragma unroll
        for (int b = 0; b < 2; ++b)
#pragma unroll
            for (int m = 0; m < 4; ++m)
#pragma unroll
                for (int n = 0; n < 2; ++n) acc[a][b][m][n] = (f32x4){0.f, 0.f, 0.f, 0.f};
    bf16x8 At[4][2], B0[2][2], B1[2][2];
    const char* cA = (const char*)g.A + (size_t)cur.pm * tstep + (size_t)cur.ko * 2; const char* cB = (const char*)((cur.sl && g.Bt2) ? g.Bt2 : g.Bt) + (size_t)cur.pn * tstep + (size_t)cur.ko * 2;
    S.a_ready(cur);
    if constexpr (SP2) {
        PG8_STAGE(PG8_SB(0, 0), cB, voffB); PG8_STAGE(PG8_SB(0, 1), cB + hstep, voffB); PG8_STAGE(PG8_SA(0, 0), cA, voffA); PG8_STAGE(PG8_SA(0, 1), cA + hstep, voffA);
        if (wr == 1) PG8_BAR;
        PG8_WAIT_V(2); PG8_BAR;
        PG8_STAGE(PG8_SB(1, 0), cB + kstep, voffB); PG8_STAGE(PG8_SA(1, 0), cA + kstep, voffA); PG8_STAGE(PG8_SB(1, 1), cB + hstep + kstep, voffB);
        PG8_WAIT_V(6); PG8_BAR;
    } else {
        PG8_STAGE(PG8_SB(0, 0), cB, voffB); PG8_STAGE(PG8_SA(0, 0), cA, voffA); PG8_STAGE(PG8_SB(0, 1), cB + hstep, voffB); PG8_STAGE(PG8_SA(0, 1), cA + hstep, voffA);
        if (wr == 1) PG8_BAR;
        PG8_WAIT_V(4); PG8_BAR;
        PG8_STAGE(PG8_SB(1, 0), cB + kstep, voffB); PG8_STAGE(PG8_SA(1, 0), cA + kstep, voffA); PG8_STAGE(PG8_SB(1, 1), cB + hstep + kstep, voffB);
        PG8_WAIT_V(6); PG8_BAR;
    }
    for (;;) {
        const bool has_next = S.next(ui + 1, nxt);
        const char* nA = has_next ? (const char*)g.A + (size_t)nxt.pm * tstep + (size_t)nxt.ko * 2 : cA; const char* nB = has_next ? (const char*)((nxt.sl && g.Bt2) ? g.Bt2 : g.Bt) + (size_t)nxt.pn * tstep + (size_t)nxt.ko * 2 : cB;
        for (int t = 0; t < nt; t += 2) {
            if constexpr (Epi::RESCALE) { if (t == 4 || t == 12 || t == 16) E.rescale(acc, cur, t, wr, wc, fr, fq); }
            const bool last = (t == nt - 2);
            const char* a1 = cA + (size_t)(t + 1) * kstep;
            const char* a2 = last ? nA : cA + (size_t)(t + 2) * kstep; const char* b2 = last ? nB : cB + (size_t)(t + 2) * kstep;
            const char* a3 = a2 + kstep; const char* b3 = b2 + kstep;
            if (last && has_next) S.a_ready(nxt);
            if constexpr (SP2) {
            PG8_LDB(B0, 0, 0); PG8_LDB(B1, 0, 1); PG8_SCHED; PG8_LDA(At, 0, 0); PG8_STAGE(PG8_SA(1, 1), a1 + hstep, voffA);
            PG8_WAIT_V(8); PG8_WAIT_L(0); PG8_BAR; PG8_MMA(0, 0, At, B0); PG8_MMA(0, 1, At, B1); PG8_BAR; PG8_SCHED;
            PG8_LDA(At, 0, 1); PG8_STAGE(PG8_SB(0, 0), b2, voffB); PG8_STAGE(PG8_SB(0, 1), b2 + hstep, voffB); PG8_STAGE(PG8_SA(0, 0), a2, voffA);
            PG8_WAIT_V(8); PG8_WAIT_L(0); PG8_BAR; PG8_MMA(1, 0, At, B0); PG8_MMA(1, 1, At, B1); PG8_BAR; PG8_SCHED;
            PG8_LDB(B0, 1, 0); PG8_LDB(B1, 1, 1); PG8_SCHED; PG8_LDA(At, 1, 0); PG8_STAGE(PG8_SA(0, 1), a2 + hstep, voffA);
            PG8_WAIT_V(8); PG8_WAIT_L(0); PG8_BAR; PG8_MMA(0, 0, At, B0); PG8_MMA(0, 1, At, B1); PG8_BAR; PG8_SCHED;
            PG8_LDA(At, 1, 1); PG8_STAGE(PG8_SB(1, 0), b3, voffB); PG8_STAGE(PG8_SB(1, 1), b3 + hstep, voffB); PG8_STAGE(PG8_SA(1, 0), a3, voffA);
            PG8_WAIT_V(8); PG8_WAIT_L(0); PG8_BAR; PG8_MMA(1, 0, At, B0); PG8_MMA(1, 1, At, B1); PG8_BAR; PG8_SCHED;
            } else {
            PG8_LDB(B0, 0, 0); PG8_SCHED; PG8_LDA(At, 0, 0); PG8_STAGE(PG8_SA(1, 1), a1 + hstep, voffA);
            PG8_WAIT_L(8); PG8_BAR; PG8_WAIT_L(0); PG8_MMA(0, 0, At, B0); PG8_BAR; PG8_SCHED;
            PG8_LDB(B1, 0, 1); PG8_STAGE(PG8_SB(0, 0), b2, voffB);
            PG8_BAR; PG8_WAIT_L(0); PG8_MMA(0, 1, At, B1); PG8_BAR;
            PG8_LDA(At, 0, 1); PG8_STAGE(PG8_SA(0, 0), a2, voffA);
            PG8_BAR; PG8_WAIT_L(0); PG8_MMA(1, 0, At, B0); PG8_BAR; PG8_SCHED;
            PG8_STAGE(PG8_SB(0, 1), b2 + hstep, voffB);
            PG8_WAIT_V(6); PG8_BAR; PG8_MMA(1, 1, At, B1); PG8_BAR;
            PG8_LDB(B0, 1, 0); PG8_SCHED; PG8_LDA(At, 1, 0); PG8_STAGE(PG8_SA(0, 1), a2 + hstep, voffA);
            PG8_WAIT_L(8); PG8_BAR; PG8_WAIT_L(0); PG8_MMA(0, 0, At, B0); PG8_BAR; PG8_SCHED;
            PG8_LDB(B1, 1, 1); PG8_STAGE(PG8_SB(1, 0), b3, voffB);
            PG8_BAR; PG8_WAIT_L(0); PG8_MMA(0, 1, At, B1); PG8_BAR;
            PG8_LDA(At, 1, 1); PG8_STAGE(PG8_SA(1, 0), a3, voffA);
            PG8_BAR; PG8_WAIT_L(0); PG8_MMA(1, 0, At, B0); PG8_BAR; PG8_SCHED;
            PG8_STAGE(PG8_SB(1, 1), b3 + hstep, voffB);
            PG8_WAIT_V(6); PG8_BAR; PG8_MMA(1, 1, At, B1); PG8_BAR;
            }
        }
        if constexpr (ALIGN_EPI) { if (wr == 0) PG8_BAR; }
        if constexpr (!Epi::AFTER_DRAIN) { E(acc, cur, wr, wc, fr, fq); S.done(cur); }
        if (!has_next) break;
#pragma unroll
        for (int a = 0; a < 2; ++a)
#pragma unroll
            for (int b = 0; b < 2; ++b)
#pragma unroll
                for (int m = 0; m < 4; ++m)
#pragma unroll
                    for (int n = 0; n < 2; ++n) acc[a][b][m][n] = (f32x4){0.f, 0.f, 0.f, 0.f};
        cur = nxt; cA = nA; cB = nB; ++ui;
        if constexpr (ALIGN_EPI) { if (wr == 1) PG8_BAR; }
    }
    PG8_WAIT_V(0);
    if constexpr (!ALIGN_EPI) { if (wr == 0) PG8_BAR; }
    PG8_BAR;
    if constexpr (Epi::AFTER_DRAIN) { E.fused(acc, cur, wr, wc, fr, fq, lds, wid, lane); S.done(cur); }
#undef PG8_SA
#undef PG8_SB
#undef PG8_STAGE
#undef PG8_LDA
#undef PG8_LDB
#undef PG8_MMA
#undef PG8_WAIT_V
#undef PG8_WAIT_L
#undef PG8_BAR
#undef PG8_SCHED
}
}
namespace att {
constexpr int NW = 8, QBLK = 32, KVBLK = 64, LDQ = 512, LDO = KCAT;
constexpr int SHM_V = 16384, SHM_K = 16384, SHM_ATTN = 3 * SHM_V + 2 * SHM_K + NW * 64 * 4;
constexpr float THR = 8.f;
#ifndef ATT_SDEPTH
#define ATT_SDEPTH 1
#endif
constexpr int SDEPTH = ATT_SDEPTH;
#define KSWZ(row, colB) ((row) * 256 + ((colB) ^ (((row) & 7) << 4)))
#define SBAR() __builtin_amdgcn_sched_barrier(0)
__device__ __forceinline__ int crow(int r, int hi) { return (r & 3) + 8 * (r >> 2) + 4 * hi; }
__device__ __forceinline__ unsigned cvtpk(float lo, float hi) { return cvt2bf(lo, hi); }

__device__ __forceinline__ void partialSM(f32x16& p0, f32x16& p1, float& m_reg, float& mn, float& alpha) {
  constexpr float C = 1.4426950408889634f;
  float pmax = p0[0];
#pragma unroll
  for (int r = 1; r < 16; ++r) pmax = fmaxf(pmax, p0[r]);
#pragma unroll
  for (int r = 0; r < 16; ++r) pmax = fmaxf(pmax, p1[r]);
  { auto rr = __builtin_amdgcn_permlane32_swap(__float_as_uint(pmax), __float_as_uint(pmax), false, false);
    pmax = fmaxf(__uint_as_float(rr[0]), __uint_as_float(rr[1])); }
  if (__builtin_expect(__all(pmax - m_reg <= THR), 1)) { mn = m_reg; alpha = 1.f; }
  else { mn = fmaxf(m_reg, pmax); alpha = __builtin_amdgcn_exp2f((m_reg - mn) * C); m_reg = mn; }
  const float mnC = -mn * C;
#pragma unroll
  for (int r = 0; r < 16; ++r) p0[r] = fmaf(p0[r], C, mnC);
#pragma unroll
  for (int r = 0; r < 16; ++r) p1[r] = fmaf(p1[r], C, mnC);
#pragma unroll
  for (int r = 0; r < 16; ++r) p0[r] = __builtin_amdgcn_exp2f(p0[r]);
}
__device__ __forceinline__ void finishSM(f32x16& p0, f32x16& p1, float alpha, float& l_reg, bf16x8& pa0, bf16x8& pa1, bf16x8& pa2, bf16x8& pa3) {
#pragma unroll
  for (int r = 0; r < 16; ++r) p1[r] = __builtin_amdgcn_exp2f(p1[r]);
  float ps = 0;
#pragma unroll
  for (int r = 0; r < 16; ++r) ps += p0[r];
#pragma unroll
  for (int r = 0; r < 16; ++r) ps += p1[r];
  { auto rr = __builtin_amdgcn_permlane32_swap(__float_as_uint(ps), __float_as_uint(ps), false, false);
    ps = __uint_as_float(rr[0]) + __uint_as_float(rr[1]); }
  l_reg = l_reg * alpha + ps;
#define PK4(P, BASE, OUT) do { unsigned a0 = cvtpk(P[BASE + 0], P[BASE + 1]), a1 = cvtpk(P[BASE + 2], P[BASE + 3]);   \
    unsigned b0 = cvtpk(P[BASE + 4], P[BASE + 5]), b1 = cvtpk(P[BASE + 6], P[BASE + 7]);                              \
    auto r0 = __builtin_amdgcn_permlane32_swap(a0, b0, false, false); auto r1 = __builtin_amdgcn_permlane32_swap(a1, b1, false, false); \
    u32x4 w = {r0[0], r1[0], r0[1], r1[1]}; OUT = *reinterpret_cast<bf16x8*>(&w); } while (0)
  PK4(p0, 0, pa0); PK4(p0, 8, pa1); PK4(p1, 0, pa2); PK4(p1, 8, pa3);
#undef PK4
}
__device__ __forceinline__ void qkt(f32x16& p0, f32x16& p1, const char* Ks, const bf16x8* qr, int r32, int hi, int kcol) {
  p0 = f32x16{}; p1 = f32x16{};
#pragma unroll
  for (int d0 = 0; d0 < 4; ++d0) { const int cb = kcol + (d0 * 16 + hi * 8) * 2;
    const bf16x8 b0 = *reinterpret_cast<const bf16x8*>(Ks + KSWZ(r32, cb));
    const bf16x8 b1 = *reinterpret_cast<const bf16x8*>(Ks + KSWZ(32 + r32, cb));
    p0 = __builtin_amdgcn_mfma_f32_32x32x16_bf16(b0, qr[d0], p0, 0, 0, 0);
    p1 = __builtin_amdgcn_mfma_f32_32x32x16_bf16(b1, qr[d0], p1, 0, 0, 0); }
}
__device__ __forceinline__ int v_st(int k, int c) { const int kk = (k & ~0xC) | ((k & 4) << 1) | ((k & 8) >> 1); return ((kk >> 3) * 4 + (c >> 5)) * 512 + ((kk & 7) * 32 + (c & 31)) * 2; }
__device__ __forceinline__ int v_rd_base(int lane) { return ((lane & 3) << 3) | (((lane >> 2) & 3) << 6) | (((lane >> 4) & 1) << 5) | (((lane >> 5) & 1) << 8); }
constexpr int v_rd_off(int d0, int ks, int half) { return d0 * 512 + ks * 4096 + half * 2048; }
template <int OFF> __device__ __forceinline__ s16x4 tr_read(int vb) {
  s16x4 r; asm volatile("ds_read_b64_tr_b16 %0, %1 offset:%2" : "=&v"(r) : "v"(vb), "i"(OFF) : "memory"); return r;
}
template <int D0> __device__ __forceinline__ void pv_one(f32x16& od, int vb, bf16x8 pa0, bf16x8 pa1, bf16x8 pa2, bf16x8 pa3) {
  const s16x4 l0 = tr_read<v_rd_off(D0, 0, 0)>(vb), h0 = tr_read<v_rd_off(D0, 0, 1)>(vb), l1 = tr_read<v_rd_off(D0, 1, 0)>(vb), h1 = tr_read<v_rd_off(D0, 1, 1)>(vb);
  const s16x4 l2 = tr_read<v_rd_off(D0, 2, 0)>(vb), h2 = tr_read<v_rd_off(D0, 2, 1)>(vb), l3 = tr_read<v_rd_off(D0, 3, 0)>(vb), h3 = tr_read<v_rd_off(D0, 3, 1)>(vb);
  asm volatile("s_waitcnt lgkmcnt(0)" ::: "memory"); SBAR();
#define PK(L, H) (bf16x8){L[0], L[1], L[2], L[3], H[0], H[1], H[2], H[3]}
  od = __builtin_amdgcn_mfma_f32_32x32x16_bf16(pa0, PK(l0, h0), od, 0, 0, 0);
  od = __builtin_amdgcn_mfma_f32_32x32x16_bf16(pa1, PK(l1, h1), od, 0, 0, 0);
  od = __builtin_amdgcn_mfma_f32_32x32x16_bf16(pa2, PK(l2, h2), od, 0, 0, 0);
  od = __builtin_amdgcn_mfma_f32_32x32x16_bf16(pa3, PK(l3, h3), od, 0, 0, 0);
#undef PK
}
__device__ __forceinline__ void pv_d0(f32x16* o, int vb, bf16x8 pa0, bf16x8 pa1, bf16x8 pa2, bf16x8 pa3) {
  pv_one<0>(o[0], vb, pa0, pa1, pa2, pa3); pv_one<1>(o[1], vb, pa0, pa1, pa2, pa3); pv_one<2>(o[2], vb, pa0, pa1, pa2, pa3); pv_one<3>(o[3], vb, pa0, pa1, pa2, pa3);
}

template <int VAR>
__device__ __forceinline__ void attn_unit(const bf16_t* __restrict__ Qb, const bf16_t* __restrict__ Kh, const bf16_t* __restrict__ Vh, int nkeys,
                                          bf16_t* __restrict__ Ob, float lam, float osc, const float* __restrict__ sg, char* lds, const int tid) {
  const int wid = __builtin_amdgcn_readfirstlane(tid >> 6), lane = tid & 63, r32 = lane & 31, hi = lane >> 5;
  const int comp = wid >> 2, qw = wid & 3, kcol = comp * 128;
  char* K_lds = lds; char* V_lds = lds + 2 * SHM_K;
  float* ws = (float*)(lds + 2 * SHM_K + 3 * SHM_V) + wid * 64; float* li_l = ws; float* al_l = ws + 32;
  float m_reg = -1e30f, l_reg = 0; f32x16 o[4] = {}; bf16x8 qr[4];
  const bf16_t* Qw = Qb + (long)(qw * QBLK + r32) * LDQ + comp * 64 + hi * 8;
#pragma unroll
  for (int d0 = 0; d0 < 4; ++d0) qr[d0] = *reinterpret_cast<const bf16x8*>(Qw + d0 * 16);
  const int sr = tid >> 4, sc = (tid & 15) * 8, vst0 = v_st(sr, sc), vst1 = v_st(32 + sr, sc);
  const int vb0 = (int)(uintptr_t)V_lds + v_rd_base(lane);
  bf16x8 sk0 = {}, sk1 = {}, sv0 = {}, sv1 = {};
#define LOADK(t) do { if constexpr (!(VAR & 8)) { sk0 = *reinterpret_cast<const bf16x8*>(&Kh[(long)((t) * KVBLK + sr) * LDQ + sc]); sk1 = *reinterpret_cast<const bf16x8*>(&Kh[(long)((t) * KVBLK + 32 + sr) * LDQ + sc]); } } while (0)
#define LOADV(t) do { if constexpr (!(VAR & 8)) { sv0 = *reinterpret_cast<const bf16x8*>(&Vh[(long)((t) * KVBLK + sr) * LDQ + sc]); sv1 = *reinterpret_cast<const bf16x8*>(&Vh[(long)((t) * KVBLK + 32 + sr) * LDQ + sc]); } } while (0)
#define WRITEK(slot) do { if constexpr (!(VAR & 8)) { *(bf16x8*)(K_lds + (slot) * SHM_K + KSWZ(sr, sc * 2)) = sk0; *(bf16x8*)(K_lds + (slot) * SHM_K + KSWZ(32 + sr, sc * 2)) = sk1; } } while (0)
#define WRITEV(off) do { if constexpr (!(VAR & 8)) { *(bf16x8*)(V_lds + (off) + vst0) = sv0; *(bf16x8*)(V_lds + (off) + vst1) = sv1; } } while (0)
#define VMW() asm volatile("s_waitcnt vmcnt(0)" ::: "memory")
#define QKT(P0, P1, KS) do { if constexpr (VAR & 4) { P0 = f32x16{}; P1 = f32x16{}; asm volatile("" : "+v"(P0), "+v"(P1)); } else qkt(P0, P1, KS, qr, r32, hi, kcol); } while (0)
#define PSM(P0, P1, MN, AL) do { if constexpr (VAR & 1) { MN = m_reg; AL = 1.f; asm volatile("" : "+v"(P0), "+v"(P1)); } else partialSM(P0, P1, m_reg, MN, AL); } while (0)
#define FSM(P0, P1, AL) do { if constexpr (VAR & 1) { asm volatile("" : "+v"(P0), "+v"(P1)); pa0 = __builtin_bit_cast(bf16x8, (f32x4){P0[0], P0[1], P0[2], P0[3]}); pa1 = __builtin_bit_cast(bf16x8, (f32x4){P0[4], P0[5], P0[6], P0[7]}); pa2 = __builtin_bit_cast(bf16x8, (f32x4){P1[0], P1[1], P1[2], P1[3]}); pa3 = __builtin_bit_cast(bf16x8, (f32x4){P1[4], P1[5], P1[6], P1[7]}); } else finishSM(P0, P1, AL, l_reg, pa0, pa1, pa2, pa3); } while (0)
#define PV(OFF) do { if constexpr (VAR & 2) { asm volatile("" : "+v"(pa0), "+v"(pa1), "+v"(pa2), "+v"(pa3)); } else pv_d0(o, vb0 + (OFF), pa0, pa1, pa2, pa3); } while (0)
#define RESC(a) do { if (__any((a) < 1.f)) { if (hi == 0) al_l[r32] = (a); asm volatile("s_waitcnt lgkmcnt(0)" ::: "memory"); \
    _Pragma("unroll") for (int d = 0; d < 4; ++d) _Pragma("unroll") for (int r = 0; r < 16; ++r) o[d][r] *= al_l[crow(r, hi)]; } } while (0)
  f32x16 pA0, pA1, pB0, pB1; float mnA, mnB, alA, alB; bf16x8 pa0, pa1, pa2, pa3; const int NT = nkeys / KVBLK;
  LOADK(0); VMW(); WRITEK(0); LOADK(1); LOADV(0);
  __syncthreads();
  if (comp == 1) __syncthreads();
  VMW(); WRITEK(1); WRITEV(0);
  SBAR(); QKT(pA0, pA1, K_lds); SBAR();
  __syncthreads();
  LOADK(2); LOADV(1); SBAR();
  PSM(pA0, pA1, mnA, alA);
  __syncthreads();
  int va = 0, vb = SHM_V, vc = 2 * SHM_V;
  for (int j = 1; j + 1 < NT; j += 2) {
    VMW(); WRITEK(0); WRITEV(vb);
    SBAR(); QKT(pB0, pB1, K_lds + SHM_K);
    FSM(pA0, pA1, alA); SBAR();
    __syncthreads();
    LOADK(j + 2); LOADV(j + 1); SBAR();
    PV(va); PSM(pB0, pB1, mnB, alB);
    RESC(alB);
    __syncthreads();
    VMW(); WRITEK(1); WRITEV(vc);
    SBAR(); QKT(pA0, pA1, K_lds);
    FSM(pB0, pB1, alB); SBAR();
    __syncthreads();
    if (j + 3 < NT) LOADK(j + 3);
    LOADV(j + 2); SBAR();
    PV(vb); PSM(pA0, pA1, mnA, alA);
    RESC(alA);
    __syncthreads();
    { const int t = va; va = vc; vc = vb; vb = t; }
  }
  VMW(); WRITEV(vb);
  SBAR(); QKT(pB0, pB1, K_lds + SHM_K);
  FSM(pA0, pA1, alA); SBAR();
  __syncthreads();
  PV(va); PSM(pB0, pB1, mnB, alB);
  RESC(alB);
  __syncthreads();
  FSM(pB0, pB1, alB); SBAR();
  PV(vb);
  if (comp == 0) __syncthreads();
  if (hi == 0) li_l[r32] = l_reg; asm volatile("s_waitcnt lgkmcnt(0)" ::: "memory");
  float rli[16];
#pragma unroll
  for (int r = 0; r < 16; ++r) rli[r] = __builtin_amdgcn_rcpf(li_l[crow(r, hi)]);
  __syncthreads();
  float* XO = (float*)lds + qw * (32 * 128);
  if (comp == 1) {
#pragma unroll
    for (int r = 0; r < 16; ++r)
#pragma unroll
      for (int d0 = 0; d0 < 4; ++d0) XO[crow(r, hi) * 128 + d0 * 32 + r32] = o[d0][r] * rli[r];
  }
  __syncthreads();
  if (comp == 0) {
    float ss[16];
#pragma unroll
    for (int r = 0; r < 16; ++r) { float s = 0.f;
#pragma unroll
      for (int d0 = 0; d0 < 4; ++d0) { const float v = o[d0][r] * rli[r] - lam * XO[crow(r, hi) * 128 + d0 * 32 + r32]; o[d0][r] = v; s += v * v; }
      ss[r] = s; }
#pragma unroll
    for (int r = 0; r < 16; ++r) { float s = ss[r]; s += swz_xor<1>(s); s += swz_xor<2>(s); s += swz_xor<4>(s); s += swz_xor<8>(s); s += swz_xor<16>(s);
      ss[r] = osc / sqrtf(s * (1.0f / 128.0f) + EPS); }
    float gam[4];
#pragma unroll
    for (int d0 = 0; d0 < 4; ++d0) gam[d0] = sg[d0 * 32 + r32];
    asm volatile("s_waitcnt lgkmcnt(0)" ::: "memory");
    bf16_t* stg = (bf16_t*)XO;
#pragma unroll
    for (int r = 0; r < 16; ++r)
#pragma unroll
      for (int d0 = 0; d0 < 4; ++d0) stg[crow(r, hi) * 128 + d0 * 32 + r32] = (bf16_t)(cvtpk(o[d0][r] * ss[r] * gam[d0], 0.f) & 0xffffu);
    asm volatile("s_waitcnt lgkmcnt(0)" ::: "memory");
#pragma unroll
    for (int i = 0; i < 8; ++i) { const int row = i * 4 + (lane >> 4), ch = lane & 15; const u32x4 v = *(const u32x4*)(stg + row * 128 + ch * 8);
      if constexpr (VAR & 16) { asm volatile("" :: "v"(v.x), "v"(v.y), "v"(v.z), "v"(v.w)); } else *(u32x4*)(Ob + (long)(qw * QBLK + row) * LDO + ch * 8) = v; }
  }
  __syncthreads();
#undef LOADK
#undef LOADV
#undef WRITEK
#undef WRITEV
#undef VMW
#undef QKT
#undef PSM
#undef FSM
#undef PV
#undef RESC
}
#undef KSWZ
#undef SBAR
}
namespace att2 {
using att::crow; using att::v_st; using att::v_rd_base; using att::v_rd_off;
constexpr int NW = 8, QBLK = 32, KVBLK = 64, LDQ = 512, LDO = KCAT, SHM_K = 16384, SHM_V = 16384;
constexpr float THRL = 8.0f;
#ifndef ATT_SPREAD
#define ATT_SPREAD 2
#endif
#ifndef ATT_H1EX
#define ATT_H1EX 1
#endif
#ifndef ATT_VFIRST
#define ATT_VFIRST 1
#endif
#ifndef ATT_NC1
#define ATT_NC1 0
#endif
#ifndef ATT_VPRE
#define ATT_VPRE 1
#endif
#ifndef ATT_BARV
#define ATT_BARV 1
#endif
#ifndef ATT_KEARLY
#define ATT_KEARLY 0
#endif
#ifndef ATT_SPLIT
#define ATT_SPLIT 8
#endif
#ifndef ATT_STAGGER
#define ATT_STAGGER 1
#endif
typedef short v4i16_t __attribute__((ext_vector_type(4)));
typedef __attribute__((address_space(3))) const char* lds_cptr;
typedef __attribute__((address_space(3))) char* lds_ptr;
#define SBAR() __builtin_amdgcn_sched_barrier(0)
#define KSWZ(row, colB) ((row) * 256 + ((colB) ^ (((row) & 7) << 4)))
__device__ __forceinline__ s16x4 vtr(lds_cptr p) { return __builtin_bit_cast(s16x4, __builtin_amdgcn_ds_read_tr16_b64_v4i16((__attribute__((address_space(3))) v4i16_t*)p)); }
__device__ __forceinline__ bf16x8 ldk(lds_cptr p) { return *(const __attribute__((address_space(3))) bf16x8*)p; }
#define MF(D, A, B, C) do { if constexpr (VAR & 4) { asm volatile("" : "+v"(D)); } else D = __builtin_amdgcn_mfma_f32_32x32x16_bf16(A, B, C, 0, 0, 0); } while (0)
#define VF(L, H) (bf16x8){L[0], L[1], L[2], L[3], H[0], H[1], H[2], H[3]}

__device__ __forceinline__ int vkey(int g) { const int s_ = g >> 5, kk = ((s_ >> 2) << 3) | ((g >> 2) & 7); return (kk & ~0xC) | ((kk & 4) << 1) | ((kk & 8) >> 1); }
template <int VAR>
__device__ __forceinline__ void attn_unit(const bf16_t* __restrict__ Qb, const bf16_t* __restrict__ Kh, const bf16_t* __restrict__ Vh, int nkeys,
                                          bf16_t* __restrict__ Ob, float lam, float osc, const float* __restrict__ sg, char* lds, const int tid) {
  const int wid = __builtin_amdgcn_readfirstlane(tid >> 6), lane = tid & 63, r32 = lane & 31, hi = lane >> 5;
  const int comp = wid >> 2, qw = wid & 3, kcol = comp * 128;
  const lds_ptr L3 = (lds_ptr)(unsigned)(uintptr_t)lds;
  float* ws = (float*)(lds + 3 * SHM_K + 3 * SHM_V) + wid * 64; float* li_l = ws; float* al_l = ws + 32;
  float mhat = 0.f, l_reg = 0.f; f32x16 o[4] = {}; bf16x8 qr[4]; f32x16 negm = {};
  const bf16_t* Qw = Qb + (long)(qw * QBLK + r32) * LDQ + comp * 64 + hi * 8;
#pragma unroll
  for (int d0 = 0; d0 < 4; ++d0) qr[d0] = *reinterpret_cast<const bf16x8*>(Qw + d0 * 16);
  const int sr = tid >> 4, sc = (tid & 15) * 8;
  const int kr0 = 4 * wid + (lane >> 4), kr1 = kr0 + 32;
  const bf16_t* ksrc0 = Kh + (long)kr0 * LDQ + (((lane & 15) ^ (kr0 & 7)) << 3); const bf16_t* ksrc1 = Kh + (long)kr1 * LDQ + (((lane & 15) ^ (kr1 & 7)) << 3);
  const int g0_ = 64 * wid + lane, g1_ = g0_ + 512;
  const int vk0 = vkey(g0_), vk1 = vkey(g1_);
  const bf16_t* vsrc0 = Vh + (long)vk0 * LDQ + ((g0_ >> 5) & 3) * 32 + (g0_ & 3) * 8; const bf16_t* vsrc1 = Vh + (long)vk1 * LDQ + ((g1_ >> 5) & 3) * 32 + (g1_ & 3) * 8;
  const unsigned kd0 = (unsigned)(uintptr_t)lds + wid * 1024, kd1 = kd0 + 8192, vd0 = (unsigned)(uintptr_t)lds + 3 * SHM_K + wid * 1024, vd1 = vd0 + 8192;
  lds_cptr kq[4];
#pragma unroll
  for (int d0 = 0; d0 < 4; ++d0) kq[d0] = L3 + r32 * 256 + ((kcol + d0 * 32 + hi * 16) ^ ((r32 & 7) << 4));
  const lds_cptr vp0 = L3 + 3 * SHM_K + v_rd_base(lane);
#define GLDS(src, dst) __builtin_amdgcn_global_load_lds((const unsigned*)(src), (__attribute__((address_space(3))) unsigned*)(dst), 16, 0, 0)
#define DMAK(t, slot) do { if constexpr (!(VAR & 8)) { GLDS(ksrc0 + (long)(t) * KVBLK * LDQ, (unsigned)__builtin_amdgcn_readfirstlane(kd0 + (slot) * SHM_K)); GLDS(ksrc1 + (long)(t) * KVBLK * LDQ, (unsigned)__builtin_amdgcn_readfirstlane(kd1 + (slot) * SHM_K)); } } while (0)
#define DMAV(t, off) do { if constexpr (!(VAR & 8)) { GLDS(vsrc0 + (long)(t) * KVBLK * LDQ, (unsigned)__builtin_amdgcn_readfirstlane(vd0 + (off))); GLDS(vsrc1 + (long)(t) * KVBLK * LDQ, (unsigned)__builtin_amdgcn_readfirstlane(vd1 + (off))); } } while (0)
#ifndef ATT_PRIO
#define ATT_PRIO 1
#endif
#define PRIO(x) do { if (ATT_PRIO == 1) __builtin_amdgcn_s_setprio(x); } while (0)
#define PRIO1(x) do { if (ATT_PRIO == 2) __builtin_amdgcn_s_setprio(x); } while (0)
#define VMW() asm volatile("s_waitcnt vmcnt(0)" ::: "memory")
#define BARWV(n) do { if (ATT_BARV) { asm volatile("s_waitcnt vmcnt(" #n ")" ::: "memory"); if constexpr (!(VAR & 32)) __builtin_amdgcn_s_barrier(); asm volatile("" ::: "memory"); } else BARW(n); } while (0)
#define BARW(n) do { asm volatile("s_waitcnt vmcnt(" #n ") lgkmcnt(0)" ::: "memory"); if constexpr (!(VAR & 32)) __builtin_amdgcn_s_barrier(); asm volatile("" ::: "memory"); } while (0)
  s16x4 vl0 = {}, vh0 = {}, vl1 = {}, vh1 = {}, vl2 = {}, vh2 = {};
  f32x16 pA0, pA1, pB0, pB1; u32x4 pw0 = {}, pw1 = {}, pw2 = {}, pw3 = {}; const int NT = nkeys / KVBLK; bool resc = false;
#define KF(KOFF, d0, half) ldk(kq[d0] + (KOFF) + 8192 * (half))
#define PKA(P, B, A0, A1) do { if constexpr (!(VAR & 1)) { A0 = cvt2bf(P[B + 0], P[B + 1]); A1 = cvt2bf(P[B + 2], P[B + 3]); sacc += P[B + 0]; sacc += P[B + 1]; sacc += P[B + 2]; sacc += P[B + 3]; } } while (0)
#define PKB(P, B, A0, A1, PW) do { if constexpr (!(VAR & 1)) { const unsigned b0_ = cvt2bf(P[B + 4], P[B + 5]), b1_ = cvt2bf(P[B + 6], P[B + 7]); \
    auto r0_ = __builtin_amdgcn_permlane32_swap(A0, b0_, false, false); auto r1_ = __builtin_amdgcn_permlane32_swap(A1, b1_, false, false); \
    PW = (u32x4){r0_[0], r1_[0], r0_[1], r1_[1]}; sacc += P[B + 4]; sacc += P[B + 5]; sacc += P[B + 6]; sacc += P[B + 7]; } } while (0)
#define VRD(VOFF, ks, d0, LO, HI) do { LO = vtr(vp0 + (VOFF) + v_rd_off(d0, ks, 0)); HI = vtr(vp0 + (VOFF) + v_rd_off(d0, ks, 1)); } while (0)
#define PAF(k) __builtin_bit_cast(bf16x8, pw##k)
#define EX(X, i) do { if constexpr (!(VAR & 2)) X[i] = __builtin_amdgcn_exp2f(X[i]); } while (0)
#define PIN2(X, Y) asm volatile("" : "+v"(X), "+v"(Y))
#define H1(C0, C1, P0, P1, KOFF, VOFF, FIN) do { \
    float sacc = 0.f; unsigned a0_ = 0, a1_ = 0; s16x4 l0, h0, l1, h1; \
    bf16x8 f0 = KF(KOFF, 0, 0), f1 = KF(KOFF, 0, 1), f2 = KF(KOFF, 1, 0); SBAR(); \
    if (ATT_VFIRST) { if (FIN) { PKA(P0, 0, a0_, a1_); PIN2(P0, P1); } SBAR(); MF(C0, f0, qr[0], negm); f0 = KF(KOFF, 1, 1); } else { \
    MF(C0, f0, qr[0], negm); { f0 = KF(KOFF, 1, 1); if (FIN) { if (ATT_SPLIT == 12) EX(P1, 4); if (ATT_SPLIT >= 8 && !ATT_H1EX) EX(P1, 8); PKA(P0, 0, a0_, a1_); PIN2(P0, P1); } } } SBAR(); \
    if (ATT_NC1 && (FIN)) MF(C1, f1, qr[0], C1); else MF(C1, f1, qr[0], negm); { f1 = KF(KOFF, 2, 0); if (FIN) { if (ATT_SPLIT == 12) EX(P1, 5); if (ATT_SPLIT >= 8 && !ATT_H1EX) EX(P1, 9); PKB(P0, 0, a0_, a1_, pw0); PIN2(P0, P1); } } SBAR(); \
    MF(C0, f2, qr[1], C0);   { f2 = KF(KOFF, 2, 1); if (FIN) { VRD(VOFF, 0, 0, l0, h0); if (ATT_SPLIT == 12) EX(P1, 6); if (ATT_SPLIT >= 8 && !ATT_H1EX) EX(P1, 10); PKA(P0, 8, a0_, a1_); PIN2(P0, P1); } } SBAR(); \
    MF(C1, f0, qr[1], C1);   { f0 = KF(KOFF, 3, 0); if (FIN) { VRD(VOFF, 0, 1, l1, h1); if (ATT_SPLIT == 12) EX(P1, 7); if (ATT_SPLIT >= 8 && !ATT_H1EX) EX(P1, 11); PKB(P0, 8, a0_, a1_, pw1); PIN2(P0, P1); } } SBAR(); \
    if (FIN) { MF(o[0], PAF(0), VF(l0, h0), o[0]); VRD(VOFF, 0, 2, l0, h0); if (ATT_H1EX) { EX(P1, 8); EX(P1, 9); } else EX(P1, 12); PKA(P1, 0, a0_, a1_); PIN2(P0, P1); } SBAR(); \
    MF(C0, f1, qr[2], C0);   { f1 = KF(KOFF, 3, 1); if (FIN) { if (!ATT_H1EX) EX(P1, 13); PKB(P1, 0, a0_, a1_, pw2); PIN2(P0, P1); } } SBAR(); \
    if (FIN) { MF(o[1], PAF(0), VF(l1, h1), o[1]); VRD(VOFF, 0, 3, l1, h1); if (ATT_H1EX) { EX(P1, 10); EX(P1, 11); } else EX(P1, 14); PIN2(P0, P1); } SBAR(); \
    MF(C1, f2, qr[2], C1);   { if (FIN) { if (!ATT_H1EX) EX(P1, 15); PKA(P1, 8, a0_, a1_); PIN2(P0, P1); } } SBAR(); \
    if (FIN) { MF(o[2], PAF(0), VF(l0, h0), o[2]); if (ATT_H1EX == 3) { EX(P1, 12); EX(P1, 13); PIN2(P0, P1); } else if (ATT_H1EX) { EX(P1, 12); EX(P1, 13); EX(P1, 14); EX(P1, 15); PIN2(P0, P1); } } SBAR(); \
    MF(C0, f0, qr[3], C0);   { if (FIN) { if (ATT_H1EX == 3) { EX(P1, 14); EX(P1, 15); PIN2(P0, P1); } else PKB(P1, 8, a0_, a1_, pw3); } } SBAR(); \
    if (FIN) { MF(o[3], PAF(0), VF(l1, h1), o[3]); if (ATT_H1EX == 3) PKB(P1, 8, a0_, a1_, pw3); } SBAR(); \
    MF(C1, f1, qr[3], C1); if (ATT_VPRE && (FIN)) { VRD(VOFF, 1, 0, vl0, vh0); VRD(VOFF, 1, 1, vl1, vh1); VRD(VOFF, 1, 2, vl2, vh2); } SBAR(); \
    if (FIN) { auto rr_ = __builtin_amdgcn_permlane32_swap(__float_as_uint(sacc), __float_as_uint(sacc), false, false); l_reg += __uint_as_float(rr_[0]) + __uint_as_float(rr_[1]); } \
  } while (0)
#define H1C(C0, C1, P0, P1, KOFF, VOFF, FIN) do { \
    float sacc = 0.f; unsigned a0_ = 0, a1_ = 0; s16x4 l0, h0, l1, h1; \
    bf16x8 f0 = KF(KOFF, 0, 0), f1 = KF(KOFF, 0, 1), f2 = KF(KOFF, 1, 0); SBAR(); \
    MF(C0, f0, qr[0], negm); { f0 = KF(KOFF, 1, 1); if (FIN) { PKA(P0, 0, a0_, a1_); PIN2(P0, P1); } } SBAR(); \
    MF(C1, f1, qr[0], negm); { f1 = KF(KOFF, 2, 0); if (FIN) { PKB(P0, 0, a0_, a1_, pw0); PIN2(P0, P1); } } SBAR(); \
    MF(C0, f2, qr[1], C0);   { f2 = KF(KOFF, 2, 1); if (FIN) { VRD(VOFF, 0, 0, l0, h0); PKA(P0, 8, a0_, a1_); PIN2(P0, P1); } } SBAR(); \
    MF(C1, f0, qr[1], C1);   { f0 = KF(KOFF, 3, 0); if (FIN) { VRD(VOFF, 0, 1, l1, h1); PKB(P0, 8, a0_, a1_, pw1); PIN2(P0, P1); } } SBAR(); \
    if (FIN) { MF(o[0], PAF(0), VF(l0, h0), o[0]); VRD(VOFF, 0, 2, l0, h0); EX(P1, 8); EX(P1, 9); PIN2(P0, P1); } SBAR(); \
    MF(C0, f1, qr[2], C0);   { f1 = KF(KOFF, 3, 1); if (FIN) { PKA(P1, 0, a0_, a1_); PIN2(P0, P1); } } SBAR(); \
    if (FIN) { MF(o[1], PAF(0), VF(l1, h1), o[1]); VRD(VOFF, 0, 3, l1, h1); EX(P1, 10); EX(P1, 11); PIN2(P0, P1); } SBAR(); \
    MF(C1, f2, qr[2], C1);   { if (FIN) { PKB(P1, 0, a0_, a1_, pw2); PIN2(P0, P1); } } SBAR(); \
    if (FIN) { MF(o[2], PAF(0), VF(l0, h0), o[2]); EX(P1, 12); EX(P1, 13); PIN2(P0, P1); } SBAR(); \
    MF(C0, f0, qr[3], C0);   { if (FIN) { PKA(P1, 8, a0_, a1_); PIN2(P0, P1); } } SBAR(); \
    if (FIN) { MF(o[3], PAF(0), VF(l1, h1), o[3]); EX(P1, 14); EX(P1, 15); PIN2(P0, P1); } SBAR(); \
    MF(C1, f1, qr[3], C1);   { if (FIN) PKB(P1, 8, a0_, a1_, pw3); } SBAR(); \
    if (FIN) { auto rr_ = __builtin_amdgcn_permlane32_swap(__float_as_uint(sacc), __float_as_uint(sacc), false, false); l_reg += __uint_as_float(rr_[0]) + __uint_as_float(rr_[1]); } \
  } while (0)
#define CVA(P, B, A0, A1) do { if constexpr (!(VAR & 1)) { A0 = cvt2bf(P[B + 0], P[B + 1]); A1 = cvt2bf(P[B + 2], P[B + 3]); } } while (0)
#define CVB(P, B, A0, A1, PW) do { if constexpr (!(VAR & 1)) { const unsigned b0_ = cvt2bf(P[B + 4], P[B + 5]), b1_ = cvt2bf(P[B + 6], P[B + 7]); \
    auto r0_ = __builtin_amdgcn_permlane32_swap(A0, b0_, false, false); auto r1_ = __builtin_amdgcn_permlane32_swap(A1, b1_, false, false); PW = (u32x4){r0_[0], r1_[0], r0_[1], r1_[1]}; } } while (0)
#define AD4(P, i) do { if constexpr (!(VAR & 1)) { sacc += P[i]; sacc += P[(i) + 1]; sacc += P[(i) + 2]; sacc += P[(i) + 3]; } } while (0)
#define AD2(P, i) do { if constexpr (!(VAR & 1)) { sacc += P[i]; sacc += P[(i) + 1]; } } while (0)
#define H1B(C0, C1, P0, P1, KOFF, VOFF, FIN) do { \
    float sacc = 0.f; unsigned a0_ = 0, a1_ = 0; s16x4 l0, h0, l1, h1; \
    bf16x8 f0 = KF(KOFF, 0, 0), f1 = KF(KOFF, 0, 1), f2 = KF(KOFF, 1, 0); SBAR(); \
    MF(C0, f0, qr[0], negm); { f0 = KF(KOFF, 1, 1); if (FIN) { EX(P1, 8); CVA(P0, 0, a0_, a1_); AD4(P0, 0); PIN2(P0, P1); } } SBAR(); \
    MF(C1, f1, qr[0], negm); { f1 = KF(KOFF, 2, 0); if (FIN) { EX(P1, 9); CVB(P0, 0, a0_, a1_, pw0); PIN2(P0, P1); } } SBAR(); \
    MF(C0, f2, qr[1], C0);   { f2 = KF(KOFF, 2, 1); if (FIN) { VRD(VOFF, 0, 0, l0, h0); EX(P1, 10); CVA(P0, 8, a0_, a1_); AD4(P0, 4); PIN2(P0, P1); } } SBAR(); \
    MF(C1, f0, qr[1], C1);   { f0 = KF(KOFF, 3, 0); if (FIN) { VRD(VOFF, 0, 1, l1, h1); EX(P1, 11); CVB(P0, 8, a0_, a1_, pw1); AD2(P0, 8); PIN2(P0, P1); } } SBAR(); \
    if (FIN) { MF(o[0], PAF(0), VF(l0, h0), o[0]); VRD(VOFF, 0, 2, l0, h0); EX(P1, 12); CVA(P1, 0, a0_, a1_); AD4(P0, 10); PIN2(P0, P1); } SBAR(); \
    MF(C0, f1, qr[2], C0);   { f1 = KF(KOFF, 3, 1); if (FIN) { EX(P1, 13); CVB(P1, 0, a0_, a1_, pw2); AD2(P0, 14); PIN2(P0, P1); } } SBAR(); \
    if (FIN) { MF(o[1], PAF(0), VF(l1, h1), o[1]); VRD(VOFF, 0, 3, l1, h1); EX(P1, 14); EX(P1, 15); AD4(P1, 0); PIN2(P0, P1); } SBAR(); \
    MF(C1, f2, qr[2], C1);   { if (FIN) { CVA(P1, 8, a0_, a1_); AD4(P1, 4); PIN2(P0, P1); } } SBAR(); \
    if (FIN) { MF(o[2], PAF(0), VF(l0, h0), o[2]); CVB(P1, 8, a0_, a1_, pw3); AD2(P1, 8); PIN2(P0, P1); } SBAR(); \
    MF(C0, f0, qr[3], C0);   { if (FIN) { AD4(P1, 10); PIN2(P0, P1); } } SBAR(); \
    if (FIN) { MF(o[3], PAF(0), VF(l1, h1), o[3]); AD2(P1, 14); } SBAR(); \
    MF(C1, f1, qr[3], C1); SBAR(); \
    if (FIN) { auto rr_ = __builtin_amdgcn_permlane32_swap(__float_as_uint(sacc), __float_as_uint(sacc), false, false); l_reg += __uint_as_float(rr_[0]) + __uint_as_float(rr_[1]); } \
  } while (0)
#define H1X(C0, C1, P0, P1, KOFF, VOFF, FIN) do { if (ATT_SPREAD == 3) H1B(C0, C1, P0, P1, KOFF, VOFF, FIN); else if (ATT_H1EX == 2) H1C(C0, C1, P0, P1, KOFF, VOFF, FIN); else H1(C0, C1, P0, P1, KOFF, VOFF, FIN); } while (0)
#define MX3(a, b, c) ((VAR & 2) ? (a) : fmaxf(fmaxf((a), (b)), (c)))
#define H2(C0, C1, VOFF, DOPV, FIRST) do { \
    s16x4 l0, h0, l1, h1, l2, h2; float ma, mb, rm; \
    if (DOPV) { VRD(VOFF, 1, 0, l0, h0); VRD(VOFF, 1, 1, l1, h1); VRD(VOFF, 1, 2, l2, h2); } SBAR(); \
    if (DOPV) { MF(o[0], PAF(1), VF(l0, h0), o[0]); VRD(VOFF, 1, 3, l0, h0); } ma = MX3(C0[0], C0[1], C1[0]); mb = MX3(C0[2], C0[3], C1[1]); ma = MX3(ma, C1[2], C1[3]); mb = MX3(mb, C0[4], C0[5]); SBAR(); \
    if (DOPV) { MF(o[1], PAF(1), VF(l1, h1), o[1]); VRD(VOFF, 2, 0, l1, h1); } ma = MX3(ma, C0[6], C0[7]); mb = MX3(mb, C1[4], C1[5]); ma = MX3(ma, C1[6], C1[7]); mb = MX3(mb, C0[8], C0[9]); SBAR(); \
    if (DOPV) { MF(o[2], PAF(1), VF(l2, h2), o[2]); VRD(VOFF, 2, 1, l2, h2); } ma = MX3(ma, C0[10], C0[11]); mb = MX3(mb, C1[8], C1[9]); ma = MX3(ma, C1[10], C1[11]); mb = MX3(mb, C0[12], C0[13]); SBAR(); \
    if (DOPV) { MF(o[3], PAF(1), VF(l0, h0), o[3]); VRD(VOFF, 2, 2, l0, h0); } ma = MX3(ma, C0[14], C0[15]); mb = MX3(mb, C1[12], C1[13]); ma = MX3(ma, C1[14], C1[15]); rm = fmaxf(ma, mb); SBAR(); \
    if (DOPV) { MF(o[0], PAF(2), VF(l1, h1), o[0]); VRD(VOFF, 2, 3, l1, h1); } \
    { auto rr_ = __builtin_amdgcn_permlane32_swap(__float_as_uint(rm), __float_as_uint(rm), false, false); rm = fmaxf(__uint_as_float(rr_[0]), __uint_as_float(rr_[1])); } SBAR(); \
    resc = false; \
    if (FIRST || __builtin_expect(__any(rm > THRL), 0)) { const float dl = FIRST ? rm : fmaxf(rm, 0.f); mhat += dl; \
      _Pragma("unroll") for (int r = 0; r < 16; ++r) { C0[r] -= dl; C1[r] -= dl; } \
      _Pragma("unroll") for (int r = 0; r < 16; ++r) negm[r] = -mhat; \
      if (!(FIRST)) { const float f = __builtin_amdgcn_exp2f(-dl); l_reg *= f; if (hi == 0) al_l[r32] = f; resc = true; } } \
    SBAR(); \
    if (ATT_SPREAD) { \
    if (DOPV) { MF(o[1], PAF(2), VF(l2, h2), o[1]); VRD(VOFF, 3, 0, l2, h2); } EX(C0, 0); EX(C0, 1); EX(C0, 2); EX(C0, 3); PIN2(C0, C1); SBAR(); \
    if (DOPV) { MF(o[2], PAF(2), VF(l0, h0), o[2]); VRD(VOFF, 3, 1, l0, h0); } EX(C0, 4); EX(C0, 5); EX(C0, 6); EX(C0, 7); PIN2(C0, C1); SBAR(); \
    if (DOPV) { MF(o[3], PAF(2), VF(l1, h1), o[3]); VRD(VOFF, 3, 2, l1, h1); } EX(C0, 8); EX(C0, 9); EX(C0, 10); EX(C0, 11); PIN2(C0, C1); SBAR(); \
    if (DOPV) { MF(o[0], PAF(3), VF(l2, h2), o[0]); VRD(VOFF, 3, 3, l2, h2); } EX(C0, 12); EX(C0, 13); EX(C0, 14); PIN2(C0, C1); SBAR(); \
    if (DOPV) { MF(o[1], PAF(3), VF(l0, h0), o[1]); } EX(C0, 15); EX(C1, 0); EX(C1, 1); PIN2(C0, C1); SBAR(); \
    if (DOPV) { MF(o[2], PAF(3), VF(l1, h1), o[2]); } EX(C1, 2); EX(C1, 3); EX(C1, 4); PIN2(C0, C1); SBAR(); \
    if (DOPV) { MF(o[3], PAF(3), VF(l2, h2), o[3]); } EX(C1, 5); EX(C1, 6); EX(C1, 7); PIN2(C0, C1); SBAR(); \
    } else { \
    if (DOPV) { MF(o[1], PAF(2), VF(l2, h2), o[1]); VRD(VOFF, 3, 0, l2, h2); } EX(C0, 0); EX(C0, 1); EX(C0, 2); EX(C0, 3); PIN2(C0, C1); SBAR(); \
    if (DOPV) { MF(o[2], PAF(2), VF(l0, h0), o[2]); VRD(VOFF, 3, 1, l0, h0); } EX(C0, 4); EX(C0, 5); EX(C0, 6); EX(C0, 7); PIN2(C0, C1); SBAR(); \
    if (DOPV) { MF(o[3], PAF(2), VF(l1, h1), o[3]); VRD(VOFF, 3, 2, l1, h1); } EX(C0, 8); EX(C0, 9); EX(C0, 10); EX(C0, 11); PIN2(C0, C1); SBAR(); \
    if (DOPV) { MF(o[0], PAF(3), VF(l2, h2), o[0]); VRD(VOFF, 3, 3, l2, h2); } EX(C0, 12); EX(C0, 13); EX(C0, 14); EX(C0, 15); PIN2(C0, C1); SBAR(); \
    if (DOPV) { MF(o[1], PAF(3), VF(l0, h0), o[1]); } EX(C1, 0); EX(C1, 1); EX(C1, 2); EX(C1, 3); PIN2(C0, C1); SBAR(); \
    if (DOPV) { MF(o[2], PAF(3), VF(l1, h1), o[2]); } if (ATT_SPLIT != 12) { EX(C1, 4); EX(C1, 5); EX(C1, 6); EX(C1, 7); } PIN2(C0, C1); SBAR(); \
    if (DOPV) { MF(o[3], PAF(3), VF(l2, h2), o[3]); } if (ATT_SPLIT == 4) { EX(C1, 8); EX(C1, 9); EX(C1, 10); EX(C1, 11); PIN2(C0, C1); } SBAR(); \
    } \
    if (resc) { asm volatile("s_waitcnt lgkmcnt(0)" ::: "memory"); \
      _Pragma("unroll") for (int d = 0; d < 4; ++d) _Pragma("unroll") for (int r = 0; r < 16; ++r) o[d][r] *= al_l[crow(r, hi)]; } \
  } while (0)
#define NCP(N, i) do { if (ATT_NC1) { N[i] = negm[i]; N[(i) + 1] = negm[(i) + 1]; N[(i) + 2] = negm[(i) + 2]; N[(i) + 3] = negm[(i) + 3]; asm volatile("" : "+v"(N)); } } while (0)
#define H2B(C0, C1, VOFF, DOPV, FIRST, N) do { \
    s16x4 l0, h0, l1, h1, l2, h2; float ma, mb, rm; \
    if (DOPV) { if (ATT_VPRE) { l0 = vl0; h0 = vh0; l1 = vl1; h1 = vh1; l2 = vl2; h2 = vh2; } else { VRD(VOFF, 1, 0, l0, h0); VRD(VOFF, 1, 1, l1, h1); VRD(VOFF, 1, 2, l2, h2); } } SBAR(); \
    if (ATT_VFIRST) { ma = MX3(C0[0], C0[1], C1[0]); mb = MX3(C0[2], C0[3], C1[1]); ma = MX3(ma, C1[2], C1[3]); mb = MX3(mb, C0[4], C0[5]); ma = MX3(ma, C0[6], C0[7]); mb = MX3(mb, C1[4], C1[5]); asm volatile("" : "+v"(ma), "+v"(mb)); SBAR(); if (DOPV) { MF(o[0], PAF(1), VF(l0, h0), o[0]); VRD(VOFF, 1, 3, l0, h0); } } else { \
    if (DOPV) { MF(o[0], PAF(1), VF(l0, h0), o[0]); VRD(VOFF, 1, 3, l0, h0); } ma = MX3(C0[0], C0[1], C1[0]); mb = MX3(C0[2], C0[3], C1[1]); ma = MX3(ma, C1[2], C1[3]); mb = MX3(mb, C0[4], C0[5]); ma = MX3(ma, C0[6], C0[7]); mb = MX3(mb, C1[4], C1[5]); } SBAR(); \
    if (DOPV) { MF(o[1], PAF(1), VF(l1, h1), o[1]); VRD(VOFF, 2, 0, l1, h1); } ma = MX3(ma, C1[6], C1[7]); mb = MX3(mb, C0[8], C0[9]); ma = MX3(ma, C0[10], C0[11]); mb = MX3(mb, C1[8], C1[9]); ma = MX3(ma, C1[10], C1[11]); SBAR(); \
    if (DOPV) { MF(o[2], PAF(1), VF(l2, h2), o[2]); VRD(VOFF, 2, 1, l2, h2); } mb = MX3(mb, C0[12], C0[13]); ma = MX3(ma, C0[14], C0[15]); mb = MX3(mb, C1[12], C1[13]); ma = MX3(ma, C1[14], C1[15]); rm = fmaxf(ma, mb); SBAR(); \
    if (DOPV) { MF(o[3], PAF(1), VF(l0, h0), o[3]); VRD(VOFF, 2, 2, l0, h0); } \
    { auto rr_ = __builtin_amdgcn_permlane32_swap(__float_as_uint(rm), __float_as_uint(rm), false, false); rm = fmaxf(__uint_as_float(rr_[0]), __uint_as_float(rr_[1])); } SBAR(); \
    resc = false; \
    if (FIRST || __builtin_expect(__any(rm > THRL), 0)) { const float dl = FIRST ? rm : fmaxf(rm, 0.f); mhat += dl; \
      _Pragma("unroll") for (int r = 0; r < 16; ++r) { C0[r] -= dl; C1[r] -= dl; } \
      _Pragma("unroll") for (int r = 0; r < 16; ++r) negm[r] = -mhat; \
      if (!(FIRST)) { const float f = __builtin_amdgcn_exp2f(-dl); l_reg *= f; if (hi == 0) al_l[r32] = f; resc = true; } } \
    SBAR(); \
    if (DOPV) { MF(o[0], PAF(2), VF(l1, h1), o[0]); VRD(VOFF, 2, 3, l1, h1); } EX(C0, 0); EX(C0, 1); EX(C0, 2); PIN2(C0, C1); SBAR(); \
    if (DOPV) { MF(o[1], PAF(2), VF(l2, h2), o[1]); VRD(VOFF, 3, 0, l2, h2); } EX(C0, 3); EX(C0, 4); EX(C0, 5); PIN2(C0, C1); SBAR(); \
    if (DOPV) { MF(o[2], PAF(2), VF(l0, h0), o[2]); VRD(VOFF, 3, 1, l0, h0); } EX(C0, 6); EX(C0, 7); EX(C0, 8); PIN2(C0, C1); SBAR(); \
    if (DOPV) { MF(o[3], PAF(2), VF(l1, h1), o[3]); VRD(VOFF, 3, 2, l1, h1); } EX(C0, 9); EX(C0, 10); EX(C0, 11); PIN2(C0, C1); SBAR(); \
    if (DOPV) { MF(o[0], PAF(3), VF(l2, h2), o[0]); VRD(VOFF, 3, 3, l2, h2); } EX(C0, 12); EX(C0, 13); EX(C0, 14); PIN2(C0, C1); NCP(N, 0); SBAR(); \
    if (DOPV) { MF(o[1], PAF(3), VF(l0, h0), o[1]); } EX(C0, 15); EX(C1, 0); EX(C1, 1); PIN2(C0, C1); NCP(N, 4); SBAR(); \
    if (DOPV) { MF(o[2], PAF(3), VF(l1, h1), o[2]); } EX(C1, 2); EX(C1, 3); EX(C1, 4); PIN2(C0, C1); NCP(N, 8); SBAR(); \
    if (DOPV) { MF(o[3], PAF(3), VF(l2, h2), o[3]); } EX(C1, 5); EX(C1, 6); EX(C1, 7); PIN2(C0, C1); NCP(N, 12); SBAR(); \
    if (resc) { asm volatile("s_waitcnt lgkmcnt(0)" ::: "memory"); \
      _Pragma("unroll") for (int d = 0; d < 4; ++d) _Pragma("unroll") for (int r = 0; r < 16; ++r) o[d][r] *= al_l[crow(r, hi)]; } \
  } while (0)
#define H2X(C0, C1, VOFF, DOPV, FIRST, N) do { if (ATT_SPREAD >= 2) H2B(C0, C1, VOFF, DOPV, FIRST, N); else H2(C0, C1, VOFF, DOPV, FIRST); } while (0)
#define PVONLY(VOFF) do { _Pragma("unroll") for (int ks = 0; ks < 4; ++ks) _Pragma("unroll") for (int d0 = 0; d0 < 4; ++d0) { s16x4 l_, h_; VRD(VOFF, ks, d0, l_, h_); \
      const bf16x8 pa_ = ks == 0 ? PAF(0) : ks == 1 ? PAF(1) : ks == 2 ? PAF(2) : PAF(3); MF(o[d0], pa_, VF(l_, h_), o[d0]); } } while (0)

  DMAK(0, 0); DMAK(1, 1); DMAV(0, 0);
  BARW(0);
  if (ATT_STAGGER && comp == 1) __builtin_amdgcn_s_barrier();
  H1X(pA0, pA1, pB0, pB1, 0, 0, false);
  BARW(0);
  DMAK(2, 2); DMAV(1, SHM_V); SBAR();
  H2X(pA0, pA1, 0, false, true, pB1);
  BARW(4);
  if (ATT_PRIO == 3 && comp == 1) __builtin_amdgcn_s_setprio(1);
  if (ATT_PRIO == 4 && comp == 0) __builtin_amdgcn_s_setprio(1);
  int va = 0, vb = SHM_V, vc = 2 * SHM_V;
  for (int j = 1; j + 1 < NT; j += 2) {
    PRIO1(1); H1X(pB0, pB1, pA0, pA1, vb, va, true); PRIO1(0);
    if (ATT_KEARLY) { asm volatile("s_waitcnt vmcnt(0)" ::: "memory"); DMAK(j + 2, va >> 14); __builtin_amdgcn_s_barrier(); asm volatile("" ::: "memory"); } else BARWV(0);
    if (!ATT_KEARLY) DMAK(j + 2, va >> 14); DMAV(j + 1, vc); SBAR();
    PRIO(1); H2X(pB0, pB1, va, true, false, pA1); PRIO(0);
    BARW(4);
    PRIO1(1); H1X(pA0, pA1, pB0, pB1, vc, vb, true); PRIO1(0);
    if (ATT_KEARLY) { asm volatile("s_waitcnt vmcnt(0)" ::: "memory"); if (j + 3 < NT) DMAK(j + 3, vb >> 14); __builtin_amdgcn_s_barrier(); asm volatile("" ::: "memory"); } else BARWV(0);
    if (!ATT_KEARLY && j + 3 < NT) DMAK(j + 3, vb >> 14);
    DMAV(j + 2, va); SBAR();
    PRIO(1); H2X(pA0, pA1, vb, true, false, pB1); PRIO(0);
    BARW(4);
    { const int t = va; va = vc; vc = vb; vb = t; }
  }
  if (ATT_PRIO >= 3) __builtin_amdgcn_s_setprio(0);
  H1X(pB0, pB1, pA0, pA1, vb, va, true);
  BARWV(0);
  H2X(pB0, pB1, va, true, false, pA1);
  BARW(0);
  { float sacc = 0.f; unsigned a0_ = 0, a1_ = 0;
    if (ATT_SPLIT == 12) { EX(pB1, 4); EX(pB1, 5); EX(pB1, 6); EX(pB1, 7); } if (ATT_SPLIT >= 8) { EX(pB1, 8); EX(pB1, 9); EX(pB1, 10); EX(pB1, 11); } EX(pB1, 12); EX(pB1, 13); EX(pB1, 14); EX(pB1, 15);
    PKA(pB0, 0, a0_, a1_); PKB(pB0, 0, a0_, a1_, pw0); PKA(pB0, 8, a0_, a1_); PKB(pB0, 8, a0_, a1_, pw1); PKA(pB1, 0, a0_, a1_); PKB(pB1, 0, a0_, a1_, pw2); PKA(pB1, 8, a0_, a1_); PKB(pB1, 8, a0_, a1_, pw3);
    auto rr_ = __builtin_amdgcn_permlane32_swap(__float_as_uint(sacc), __float_as_uint(sacc), false, false); l_reg += __uint_as_float(rr_[0]) + __uint_as_float(rr_[1]); }
  SBAR(); PVONLY(vb);
  if (ATT_STAGGER && comp == 0) { asm volatile("s_waitcnt lgkmcnt(0)" ::: "memory"); __builtin_amdgcn_s_barrier(); }
  if (hi == 0) li_l[r32] = l_reg; asm volatile("s_waitcnt lgkmcnt(0)" ::: "memory");
  float rli[16];
#pragma unroll
  for (int r = 0; r < 16; ++r) rli[r] = __builtin_amdgcn_rcpf(li_l[crow(r, hi)]);
  __syncthreads();
  float* XO = (float*)lds + qw * (32 * 128);
  if (comp == 1) {
#pragma unroll
    for (int r = 0; r < 16; ++r)
#pragma unroll
      for (int d0 = 0; d0 < 4; ++d0) XO[crow(r, hi) * 128 + d0 * 32 + r32] = o[d0][r] * rli[r];
  }
  __syncthreads();
  if (comp == 0) {
    float ss[16];
#pragma unroll
    for (int r = 0; r < 16; ++r) { float s = 0.f;
#pragma unroll
      for (int d0 = 0; d0 < 4; ++d0) { const float v = o[d0][r] * rli[r] - lam * XO[crow(r, hi) * 128 + d0 * 32 + r32]; o[d0][r] = v; s += v * v; }
      ss[r] = s; }
#pragma unroll
    for (int r = 0; r < 16; ++r) { float s = ss[r]; s += swz_xor<1>(s); s += swz_xor<2>(s); s += swz_xor<4>(s); s += swz_xor<8>(s); s += swz_xor<16>(s);
      ss[r] = osc / sqrtf(s * (1.0f / 128.0f) + EPS); }
    float gam[4];
#pragma unroll
    for (int d0 = 0; d0 < 4; ++d0) gam[d0] = sg[d0 * 32 + r32];
    asm volatile("s_waitcnt lgkmcnt(0)" ::: "memory");
    bf16_t* stg = (bf16_t*)XO;
#pragma unroll
    for (int r = 0; r < 16; ++r)
#pragma unroll
      for (int d0 = 0; d0 < 4; ++d0) stg[crow(r, hi) * 128 + d0 * 32 + r32] = (bf16_t)(cvt2bf(o[d0][r] * ss[r] * gam[d0], 0.f) & 0xffffu);
    asm volatile("s_waitcnt lgkmcnt(0)" ::: "memory");
#pragma unroll
    for (int i = 0; i < 8; ++i) { const int row = i * 4 + (lane >> 4), ch = lane & 15; const u32x4 v = *(const u32x4*)(stg + row * 128 + ch * 8);
      if constexpr (VAR & 16) { asm volatile("" :: "v"(v.x), "v"(v.y), "v"(v.z), "v"(v.w)); } else *(u32x4*)(Ob + (long)(qw * QBLK + row) * LDO + ch * 8) = v; }
  }
  __syncthreads();
#undef GLDS
#undef DMAK
#undef DMAV
#undef VMW
#undef PRIO
#undef PRIO1
#undef BARW
#undef BARWV
#undef KF
#undef PKA
#undef PKB
#undef H1
#undef H1B
#undef H1C
#undef H1X
#undef CVA
#undef CVB
#undef AD4
#undef AD2
#undef VRD
#undef PAF
#undef MX3
#undef EX
#undef PIN2
#undef H2
#undef H2B
#undef NCP
#undef H2X
#undef PVONLY
}
#undef SBAR
#undef KSWZ
#undef MF
#undef VF
}
typedef GAS unsigned gu32;
#define RLX_AGENT __ATOMIC_RELAXED, __HIP_MEMORY_SCOPE_AGENT
constexpr int PT_OFF = LDSCTL_OFF + 1024;
__device__ __forceinline__ unsigned long long ldptr(volatile LAS unsigned long long* PT, int i) {
    const unsigned long long v = PT[i];
    const unsigned lo = __builtin_amdgcn_readfirstlane((unsigned)v), hi = __builtin_amdgcn_readfirstlane((unsigned)(v >> 32));
    return ((unsigned long long)hi << 32) | lo;
}
#define XB_TMO      128
#define XB_XCNT(j)  (256  + 64 * (j))
#define XB_XSUB(j)  (1280 + 64 * (j))
#define XB_XGEN(j)  (2304 + 64 * (j))
#define XB_TOP      3328
#define XB_TOPGEN   3392
#define XCD_BAR_WORDS 3456
#define XB_SPIN_CAP (1u << 18)

__device__ __forceinline__ unsigned xb_ld(unsigned* p)              { return __hip_atomic_load(p, __ATOMIC_RELAXED, __HIP_MEMORY_SCOPE_AGENT); }
__device__ __forceinline__ unsigned xb_add(unsigned* p, unsigned v) { return __hip_atomic_fetch_add(p, v, __ATOMIC_RELAXED, __HIP_MEMORY_SCOPE_AGENT); }
__device__ __forceinline__ unsigned xb_xcc_id() { return (unsigned)__builtin_amdgcn_s_getreg((3 << 11) | 20) & 0xFu; }
#define XB_SPIN(cond, bar) do { unsigned _sp = 0; while (cond) { __builtin_amdgcn_s_sleep(1); \
    if ((++_sp & 255u) == 0u) { if (xb_ld(&(bar)[XB_TMO])) break; if (_sp > XB_SPIN_CAP) { atomicAdd(&(bar)[XB_TMO], 1u); break; } } } } while (0)

struct XcdBarrier {
    unsigned* bar; unsigned x;
    volatile LAS unsigned* st;
};

__device__ __forceinline__ XcdBarrier xcd_barrier_post(unsigned* bar, volatile LAS unsigned* st) {
    XcdBarrier b; b.bar = bar; b.x = xb_xcc_id(); b.st = st;
    if (threadIdx.x == 0) (void)xb_add(&bar[XB_XCNT(b.x)], 1u);
    return b;
}
__device__ __forceinline__ void xcd_barrier_complete(unsigned* bar, unsigned x, unsigned& nloc, unsigned& nx) {
    const unsigned G = gridDim.x * gridDim.y * gridDim.z;
    unsigned sum, cnt, mine, sp = 0u;
    for (;;) {
        sum = 0u; cnt = 0u; mine = 0u;
#pragma unroll
        for (unsigned j = 0; j < 16; ++j) { const unsigned c = xb_ld(&bar[XB_XCNT(j)]); sum += c; cnt += (c > 0u) ? 1u : 0u; mine = (j == x) ? c : mine; }
        if (sum == G) break;
        __builtin_amdgcn_s_sleep(1);
        if ((++sp & 255u) == 0u) { if (xb_ld(&bar[XB_TMO])) break; if (sp > XB_SPIN_CAP) { atomicAdd(&bar[XB_TMO], 1u); break; } }
    }
    nloc = mine > 0u ? mine : 1u; nx = cnt > 0u ? cnt : 1u;
}

__device__ __forceinline__ void xcd_barrier(const XcdBarrier& b) {
    asm volatile("s_waitcnt vmcnt(0)" ::: "memory");
    __syncthreads();
    if (threadIdx.x == 0) {
        unsigned* bar = b.bar;
        __builtin_amdgcn_s_waitcnt(0);
        unsigned nloc = b.st[0], nx = b.st[1];
        if (nloc == 0u) { xcd_barrier_complete(bar, b.x, nloc, nx); b.st[0] = nloc; b.st[1] = nx; }
        const unsigned old = xb_add(&bar[XB_XSUB(b.x)], 1u);
        const unsigned gen = old / nloc;
        if (old + 1u == (gen + 1u) * nloc) {
            __builtin_amdgcn_fence(__ATOMIC_RELEASE, "agent");
            asm volatile("s_waitcnt vmcnt(0)" ::: "memory");
            const unsigned og = xb_add(&bar[XB_TOP], 1u);
            const unsigned tg = og / nx;
            if (og + 1u == (tg + 1u) * nx) xb_add(&bar[XB_TOPGEN], 1u);
            else XB_SPIN(xb_ld(&bar[XB_TOPGEN]) == tg, bar);
            __builtin_amdgcn_fence(__ATOMIC_ACQUIRE, "agent");
            xb_add(&bar[XB_XGEN(b.x)], 1u);
            asm volatile("s_waitcnt vmcnt(0)" ::: "memory");
        } else {
            XB_SPIN(xb_ld(&bar[XB_XGEN(b.x)]) == gen, bar);
            __builtin_amdgcn_fence(__ATOMIC_ACQUIRE, "agent");
            asm volatile("s_waitcnt vmcnt(0)" ::: "memory");
        }
    }
    __syncthreads();
}
__device__ __forceinline__ float wave_sum(float v) {
    v += swz_xor<1>(v); v += swz_xor<2>(v); v += swz_xor<4>(v); v += swz_xor<8>(v); v += swz_xor<16>(v);
    auto rr = __builtin_amdgcn_permlane32_swap(__float_as_uint(v), __float_as_uint(v), false, false);
    return __uint_as_float(rr[0]) + __uint_as_float(rr[1]);
}
__device__ __forceinline__ unsigned pk2(float lo, float hi) { return cvt2bf(lo, hi); }

template <int MAP  >
__device__ __forceinline__ void transpose_item(const float* W, int Nsrc, int coff, bf16_t* WT, int ldw, int koff, int nblk, LAS float* scr, int item, int lane) {
    const int kb = item / nblk, nb = item % nblk, k0 = 64 * kb, n0 = 32 * nb;
    const int nd = n0 + (lane & 31); const int scol = MAP ? in_map(nd) : nd + coff;
    float wv[32];
#pragma unroll
#if 1
    for (int i = 0; i < 32; ++i) wv[i] = __builtin_nontemporal_load(W + (size_t)(k0 + 2 * i + (lane >> 5)) * Nsrc + scol);
#else
    for (int i = 0; i < 32; ++i) wv[i] = W[(size_t)(k0 + 2 * i + (lane >> 5)) * Nsrc + scol];
#endif
#pragma unroll
    for (int i = 0; i < 32; ++i) scr[(2 * i + (lane >> 5)) * 33 + (lane & 31)] = wv[i];
    asm volatile("s_waitcnt lgkmcnt(0)" ::: "memory");
    const int c = lane & 7;
#pragma unroll
    for (int j = 0; j < 4; ++j) { const int n = (lane >> 3) + 8 * j; const LAS float* s = scr + (8 * c) * 33 + n;
        u32x4 o; o.x = pk2(s[0 * 33], s[1 * 33]); o.y = pk2(s[2 * 33], s[3 * 33]); o.z = pk2(s[4 * 33], s[5 * 33]); o.w = pk2(s[6 * 33], s[7 * 33]);
        *(u32x4*)(WT + (size_t)(n0 + n) * ldw + koff + k0 + 8 * c) = o; }
    asm volatile("s_waitcnt lgkmcnt(0)" ::: "memory");
}
struct WSrc { const float *w_in, *wo_f, *wo_a, *wo_c, *wo_p, *w_out, *w_up, *w_down; };
constexpr int IT_A = 16 * 208;
constexpr int IT_B0 = 4 * 32, IT_B1 = 8 * 32, IT_B2 = 4 * 32, IT_B3 = 4 * 32, IT_B4 = 16 * 32, IT_B5 = 16 * 88, IT_B6 = 16 * 88, IT_B7 = 44 * 32;
constexpr int ITU_CAT = IT_A, ITU_DN = ITU_CAT + IT_B0 + IT_B1 + IT_B2 + IT_B3 + IT_B4, ITU_UPG = ITU_DN + IT_B7, ITU_UPV = ITU_UPG + IT_B5, ITU_END = ITU_UPV + IT_B6;
struct WDst { bf16_t *wa, *wcat, *wout, *wdn, *wupg, *wupv; };
template <int MASK  >
__device__ __forceinline__ void convert_items(const WSrc& S, const WDst& D, LAS float* scr, int lo, int hi, int wi, int nw, int lane) {
    for (int it = lo + wi; it < hi; it += nw) { int r = it;
        if (MASK & 1) { if (r < IT_A) { transpose_item<1>(S.w_in, NIN, 0, D.wa, 1024, 0, 208, scr, r, lane); continue; } } r -= IT_A;
        if (MASK & 2) {
            if (r < IT_B0) { transpose_item<0>(S.wo_f, 1024, 0, D.wcat, KCAT, 0, 32, scr, r, lane); continue; } r -= IT_B0;
            if (r < IT_B1) { transpose_item<0>(S.wo_a, 1024, 0, D.wcat, KCAT, 256, 32, scr, r, lane); continue; } r -= IT_B1;
            if (r < IT_B2) { transpose_item<0>(S.wo_c, 1024, 0, D.wcat, KCAT, 768, 32, scr, r, lane); continue; } r -= IT_B2;
            if (r < IT_B3) { transpose_item<0>(S.wo_p, 1024, 0, D.wcat, KCAT, 1024, 32, scr, r, lane); continue; } r -= IT_B3;
            if (r < IT_B4) { transpose_item<0>(S.w_out, 1024, 0, D.wout, 1024, 0, 32, scr, r, lane); continue; } r -= IT_B4;
        } else r -= IT_B0 + IT_B1 + IT_B2 + IT_B3 + IT_B4;
        if (MASK & 4) { if (r < IT_B7) { transpose_item<0>(S.w_down, 1024, 0, D.wdn, DFF, 0, 32, scr, r, lane); continue; } } r -= IT_B7;
        if (MASK & 8) { if (r < IT_B5) { transpose_item<0>(S.w_up, 2 * DFF, DFF, D.wupg, 1024, 0, 88, scr, r, lane); continue; } } r -= IT_B5;
        if (MASK & 16) { if (r < IT_B6) transpose_item<0>(S.w_up, 2 * DFF, 0, D.wupv, 1024, 0, 88, scr, r, lane); }
    }
}

__device__ __forceinline__ void ffn_edge_fix(int pm, const bf16_t* GT, const float* VE, bf16_t* H, const float* dww, const float* dwb, int tid) {
    const bool lat = pm < 64; const int L = lat ? 8192 : 256, tb = lat ? ((pm * 256) & 8191) : 0;
    unsigned short gm[2][6], gz[2][6], gp[2][6]; float ve[2][6], w0[6], w1[6], w2[6], bb[6];
#pragma unroll
    for (int k = 0; k < 6; ++k) { const int c = tid + 512 * k; const bool ok = c < 2816; const int cc = ok ? c : 0;
        w0[k] = dww[cc]; w1[k] = dww[2816 + cc]; w2[k] = dww[5632 + cc]; bb[k] = dwb[cc];
#pragma unroll
        for (int e = 0; e < 2; ++e) { const int r = pm * 256 + (e ? 255 : 0), t = tb + (e ? 255 : 0);
            gm[e][k] = t > 0 ? GT[pg8::gtofs(r - 1, cc)] : (unsigned short)0; gz[e][k] = GT[pg8::gtofs(r, cc)]; gp[e][k] = t < L - 1 ? GT[pg8::gtofs(r + 1, cc)] : (unsigned short)0;
            ve[e][k] = VE[(size_t)(pm * 2 + e) * 2816 + cc]; } }
    asm volatile("" ::: "memory");
#pragma unroll
    for (int k = 0; k < 6; ++k) { const int c = tid + 512 * k;
        if (c < 2816) {
#pragma unroll
            for (int e = 0; e < 2; ++e) { const int r = pm * 256 + (e ? 255 : 0);
                const float cv = __builtin_fmaf(w2[k], bf2f(gp[e][k]), __builtin_fmaf(w1[k], bf2f(gz[e][k]), __builtin_fmaf(w0[k], bf2f(gm[e][k]), bb[k])));
                H[(size_t)r * 2816 + c] = (bf16_t)(cvt2bf(pg8::gelu_mul(cv, ve[e][k]), 0.f) & 0xffffu); } } }
}
__device__ __forceinline__ void mod_phase(const float* c, const float* c_ctx, const float* ada_w, const float* ada_b, float* MOD, LAS unsigned char* lds, int vcu, int G, int tid, int wave, int lane) {
    LAS float* sil = (LAS float*)lds;
    LAS float* red = (LAS float*)(lds + 12288);
    for (int i = tid; i < 3072; i += 512) { const float v = i < 2048 ? c[i] : c_ctx[i - 2048]; sil[i] = v * sigm(v); }
    __syncthreads();
    for (int item = vcu; item < 192; item += G) {
        const int l = item / 96, n = (item % 96) * 64 + lane;
        const float* W = ada_w + (size_t)l * 1024 * 6144 + n;
        float a0 = 0.f, a1 = 0.f, a2 = 0.f;
        for (int k = wave * 128; k < wave * 128 + 128; k += 64) { float w[64];
#pragma unroll
#if 1
            for (int i = 0; i < 64; ++i) w[i] = __builtin_nontemporal_load(W + (size_t)(k + i) * 6144);
#else
            for (int i = 0; i < 64; ++i) w[i] = W[(size_t)(k + i) * 6144];
#endif
#pragma unroll
            for (int i = 0; i < 64; ++i) { a0 += sil[k + i] * w[i]; a1 += sil[1024 + k + i] * w[i]; a2 += sil[2048 + k + i] * w[i]; } }
        red[(wave * 3 + 0) * 64 + lane] = a0; red[(wave * 3 + 1) * 64 + lane] = a1; red[(wave * 3 + 2) * 64 + lane] = a2;
        __syncthreads();
        if (wave < 3) { float s = ada_b[l * 6144 + n];
#pragma unroll
            for (int w = 0; w < 8; ++w) s += red[(w * 3 + wave) * 64 + lane];
            MOD[(size_t)(l * 3 + wave) * 6144 + n] = s; }
        __syncthreads();
    }
}
__device__ __forceinline__ void tables_phase(float* ROPE, f32x2* TW, int gt, int NGT) {
    for (int i = gt; i < 192 * 16; i += NGT) { const int pos = i >> 4, f = i & 15; const float inv = powf(10000.0f, -(float)f / 16.0f); const float ang = (float)(pos < 128 ? pos : pos - 128) * inv;
        float s, c; sincosf(ang, &s, &c); ROPE[pos * 32 + f] = c; ROPE[pos * 32 + 16 + f] = s; }
    for (int i = gt; i < 8192; i += NGT) { float s, c; sincospif((float)i * (1.0f / 4096.0f), &s, &c); TW[i] = (f32x2){c, -s}; }
}

template <bool LATBF>
__device__ __forceinline__ void norm_phase(const void* src_lat_, const float* src_ctx, int nrows, const float* gamma, const float* mod, int shoff, int scoff, bf16_t* HX, int gw, int NGW, int lane,
                                           const float* slab = nullptr, int nsl = 0, const float* cgate = nullptr, float* ctx_out = nullptr) {
    for (int m0 = gw; m0 < nrows; m0 += 4 * NGW) {
        f32x4 v[4][4]; float s[4];
#pragma unroll
        for (int u = 0; u < 4; ++u) { const int m = m0 + u * NGW; s[u] = 0.f;
            if (m < nrows) {
                if (LATBF && m < ML) { const u32x2* xb = (const u32x2*)((const bf16_t*)src_lat_ + (size_t)m * DM);
#pragma unroll
                    for (int j = 0; j < 4; ++j) { const u32x2 w = xb[lane + 64 * j]; v[u][j] = (f32x4){__uint_as_float(w.x << 16), __uint_as_float(w.x & 0xffff0000u), __uint_as_float(w.y << 16), __uint_as_float(w.y & 0xffff0000u)}; } }
                else { const float* xr = m < ML ? (const float*)src_lat_ + (size_t)m * DM : src_ctx + (size_t)(m - ML) * DM;
#pragma unroll
                    for (int j = 0; j < 4; ++j) v[u][j] = ((const f32x4*)xr)[lane + 64 * j]; }
                if (slab && m >= ML) {
#pragma unroll
                    for (int j = 0; j < 4; ++j) { f32x4 a = {0.f, 0.f, 0.f, 0.f};
                        for (int sl = 0; sl < nsl; ++sl) a += ((const f32x4*)(slab + (size_t)sl * 512 * 1024 + (size_t)(m - ML) * DM))[lane + 64 * j];
                        v[u][j] += ((const f32x4*)cgate)[lane + 64 * j] * a; ((f32x4*)(ctx_out + (size_t)(m - ML) * DM))[lane + 64 * j] = v[u][j]; } } } }
        const int ms0 = (m0 < SEQ ? 0 : m0 < ML ? 1 : 2); f32x4 gv[4], scv[4], shv[4];
#pragma unroll
        for (int j = 0; j < 4; ++j) { const int col = 4 * lane + 256 * j; const float* md = mod + ms0 * 6144;
            gv[j] = *(const f32x4*)(gamma + col); scv[j] = *(const f32x4*)(md + scoff + col); shv[j] = *(const f32x4*)(md + shoff + col); }
        asm volatile("" ::: "memory");
#pragma unroll
        for (int u = 0; u < 4; ++u) { const int m = m0 + u * NGW; if (m < nrows) {
#pragma unroll
            for (int j = 0; j < 4; ++j) s[u] += (v[u][j].x * v[u][j].x + v[u][j].y * v[u][j].y) + (v[u][j].z * v[u][j].z + v[u][j].w * v[u][j].w);
            const float rstd = 1.0f / sqrtf(wave_sum(s[u]) * (1.0f / DM) + EPS);
            const int ms = (m < SEQ ? 0 : m < ML ? 1 : 2);
            if (ms != ms0) {
                const float* md = mod + ms * 6144;
#pragma unroll
                for (int j = 0; j < 4; ++j) { const int col = 4 * lane + 256 * j;
                    const f32x4 g = *(const f32x4*)(gamma + col), sc = *(const f32x4*)(md + scoff + col), sh = *(const f32x4*)(md + shoff + col);
                    const f32x4 o = v[u][j] * rstd * g * (sc + 1.0f) + sh;
                    u32x2 w; w.x = pk2(o.x, o.y); w.y = pk2(o.z, o.w); *(u32x2*)(HX + (size_t)m * DM + col) = w; }
            } else {
#pragma unroll
                for (int j = 0; j < 4; ++j) { const int col = 4 * lane + 256 * j;
                    const f32x4 o = v[u][j] * rstd * gv[j] * (scv[j] + 1.0f) + shv[j];
                    u32x2 w; w.x = pk2(o.x, o.y); w.y = pk2(o.z, o.w); *(u32x2*)(HX + (size_t)m * DM + col) = w; } } } }
    }
}
__device__ __forceinline__ void final_norm_phase(const bf16_t* xb, float* out, const float* gamma, int gw, int NGW, int lane) {
    f32x4 gv[4];
#pragma unroll
    for (int j = 0; j < 4; ++j) gv[j] = *(const f32x4*)(gamma + 4 * lane + 256 * j);
    for (int m0 = gw; m0 < ML; m0 += 4 * NGW) {
        f32x4 v[4][4];
#pragma unroll
        for (int u = 0; u < 4; ++u) { const int m = m0 + u * NGW; if (m < ML) { const u32x2* xr = (const u32x2*)(xb + (size_t)m * DM);
#pragma unroll
            for (int j = 0; j < 4; ++j) { const u32x2 w = __builtin_nontemporal_load(xr + lane + 64 * j); v[u][j] = (f32x4){__uint_as_float(w.x << 16), __uint_as_float(w.x & 0xffff0000u), __uint_as_float(w.y << 16), __uint_as_float(w.y & 0xffff0000u)}; } } }
#pragma unroll
        for (int u = 0; u < 4; ++u) { const int m = m0 + u * NGW; if (m < ML) { float s = 0.f;
#pragma unroll
            for (int j = 0; j < 4; ++j) s += (v[u][j].x * v[u][j].x + v[u][j].y * v[u][j].y) + (v[u][j].z * v[u][j].z + v[u][j].w * v[u][j].w);
            const float rstd = 1.0f / sqrtf(wave_sum(s) * (1.0f / DM) + EPS);
#pragma unroll
            for (int j = 0; j < 4; ++j) { const f32x4 o = v[u][j] * rstd * gv[j];
#if 1
                __builtin_nontemporal_store(o, (f32x4*)(out + (size_t)m * DM) + lane + 64 * j);
#else
                ((f32x4*)(out + (size_t)m * DM))[lane + 64 * j] = o;
#endif
            } } }
    }
}

#define SWZ(row, colB) ((row) * 256 + ((colB) ^ (((row) & 7) << 4)))
__device__ __forceinline__ int crow_(int r, int hi) { return (r & 3) + 8 * (r >> 2) + 4 * hi; }
__device__ __forceinline__ bf16x8 pack_bf8(const float* v) { u32x4 w; w.x = pk2(v[0], v[1]); w.y = pk2(v[2], v[3]); w.z = pk2(v[4], v[5]); w.w = pk2(v[6], v[7]); return __builtin_bit_cast(bf16x8, w); }
__device__ __forceinline__ void fft_tables_phase(u32x4* FT, int gt, int NGT) {
    for (int i = gt; i < 4096; i += NGT) { const int ks = i >> 9, t = i & 511, wave = t >> 6, lane = t & 63, tr = wave >> 1, tc = wave & 1, r32 = lane & 31, hi = lane >> 5;
        float cv[8], sv[8], av[8], bv[8];
#pragma unroll
        for (int j = 0; j < 8; ++j) { const int idx = ((32 * tr + r32) * (16 * ks + 8 * hi + j)) & 127; float s, c; sincospif((float)idx * (1.0f / 64.0f), &s, &c); cv[j] = c; sv[j] = -s; }
#pragma unroll
        for (int j = 0; j < 8; ++j) { const int R = 32 * tr + r32, k = 16 * ks + 8 * hi + j, k2 = R & 63, ll = k & 63; float s, c; sincospif((float)((k2 * ll) & 63) * (1.0f / 32.0f), &s, &c);
            av[j] = (R < 64) ? ((k < 64) ? c : s) : ((k < 64) ? -s : c);
            const int m = 32 * tc + r32; float s2, c2; sincospif((float)((m * ll) & 63) * (1.0f / 32.0f), &s2, &c2); bv[j] = (k < 64) ? c2 : s2; }
        FT[i] = __builtin_bit_cast(u32x4, pack_bf8(cv)); FT[4096 + i] = __builtin_bit_cast(u32x4, pack_bf8(sv)); FT[8192 + i] = __builtin_bit_cast(u32x4, pack_bf8(av)); FT[12288 + i] = __builtin_bit_cast(u32x4, pack_bf8(bv)); }
}
__device__ __forceinline__ void fft1_phase(const bf16_t* UF, const f32x2* TW, const u32x4* FT, unsigned* FA, LAS unsigned char* lds, int vcu_, int G_, int tid, int wave, int lane, int skiplo = 0, int nskip = 0) {
    if (nskip && vcu_ >= skiplo && vcu_ < skiplo + nskip) return;
    const int vcu = (nskip && vcu_ >= skiplo + nskip) ? vcu_ - nskip : vcu_, G = G_ - nskip;
    const int tr = wave >> 1, tc = wave & 1, r32 = lane & 31, hi = lane >> 5;
    bf16x8 aRe[8], aIm[8];
#pragma unroll
    for (int ks = 0; ks < 8; ++ks) { aRe[ks] = __builtin_bit_cast(bf16x8, FT[ks * 512 + tid]); aIm[ks] = __builtin_bit_cast(bf16x8, FT[4096 + ks * 512 + tid]); }
    u32x4 nv[2];
#define FFT1_FETCH(it_) do { const int b_ = (it_) >> 8, g_ = ((it_) >> 6) & 3, l2_ = (it_) & 63; \
        _Pragma("unroll") for (int i = 0; i < 2; ++i) { const int q = tid + 512 * i, l1 = q >> 3, c8 = (q & 7) * 8; nv[i] = __builtin_nontemporal_load((const u32x4*)(UF + (size_t)(b_ * SEQ + 64 * l1 + l2_) * 256 + g_ * 64 + c8)); } } while (0)
    if (vcu < 512) FFT1_FETCH(vcu);
    for (int item = vcu; item < 512; item += G) {
        const int b = item >> 8, g = (item >> 6) & 3, l2 = item & 63;
        u32x4 vv[2];
#pragma unroll
        for (int i = 0; i < 2; ++i) vv[i] = nv[i];
        if (item + G < 512) FFT1_FETCH(item + G);
#pragma unroll
        for (int i = 0; i < 2; ++i) { const int q = tid + 512 * i, l1 = q >> 3, c8 = (q & 7) * 8;
            const u32x4 v = vv[i];
#pragma unroll
            for (int e = 0; e < 8; ++e) { const unsigned w = v[e >> 1]; *(LAS bf16_t*)(lds + SWZ(c8 + e, l1 * 2)) = (bf16_t)((e & 1) ? (w >> 16) : (w & 0xffffu)); } }
        __syncthreads();
        f32x2 tw[16];
#pragma unroll
        for (int r = 0; r < 16; ++r) tw[r] = TW[(32 * tr + crow_(r, hi)) * l2];
        asm volatile("" ::: "memory");
        f32x16 re = {}, im = {};
#pragma unroll
        for (int ks = 0; ks < 8; ++ks) { const bf16x8 bx = *(const LAS bf16x8*)(lds + SWZ(32 * tc + r32, (16 * ks + 8 * hi) * 2));
            re = __builtin_amdgcn_mfma_f32_32x32x16_bf16(aRe[ks], bx, re, 0, 0, 0); im = __builtin_amdgcn_mfma_f32_32x32x16_bf16(aIm[ks], bx, im, 0, 0, 0); }
        unsigned* dst = FA + ((size_t)((b * 4 + g) * 64 + l2) * 128) * 64 + 32 * tc + r32;
#pragma unroll
        for (int r = 0; r < 16; ++r) { const int k1 = 32 * tr + crow_(r, hi); const f32x2 t = tw[r];
            dst[(size_t)k1 * 64] = pk2(re[r] * t.x - im[r] * t.y, re[r] * t.y + im[r] * t.x); }
        __syncthreads();
    }
#undef FFT1_FETCH
}
__device__ __forceinline__ void fft2_phase(const unsigned* FA, const u32x4* FT, bf16_t* ACAT, LAS unsigned char* lds, int vcu, int G, int tid, int wave, int lane) {
    const int tr = wave >> 1, tc = wave & 1, r32 = lane & 31, hi = lane >> 5;
    bf16x8 a2[8], b3[8];
#pragma unroll
    for (int ks = 0; ks < 8; ++ks) { a2[ks] = __builtin_bit_cast(bf16x8, FT[8192 + ks * 512 + tid]); b3[ks] = __builtin_bit_cast(bf16x8, FT[12288 + ks * 512 + tid]); }
    LAS unsigned char* Bt = lds;
    LAS unsigned char* Zt = lds + 16384;
#ifndef FFT2_PF
#define FFT2_PF 1
#endif
    u32x4 nv[2];
#define FFT2_FETCH(it_) do { const int b_ = (it_) >> 9, g_ = ((it_) >> 7) & 3, k1_ = (it_) & 127; \
        _Pragma("unroll") for (int i = 0; i < 2; ++i) { const int q = tid + 512 * i, l2 = q >> 4, c4 = (q & 15) * 4; nv[i] = __builtin_nontemporal_load((const u32x4*)(FA + ((size_t)((b_ * 4 + g_) * 64 + l2) * 128 + k1_) * 64 + c4)); } } while (0)
    if (FFT2_PF && vcu < 1024) FFT2_FETCH(vcu);
    for (int item = vcu; item < 1024; item += G) {
        const int b = item >> 9, g = (item >> 7) & 3, k1 = item & 127;
        u32x4 vv[2];
        if (FFT2_PF) {
#pragma unroll
            for (int i = 0; i < 2; ++i) vv[i] = nv[i];
            if (item + G < 1024) FFT2_FETCH(item + G);
        }
#pragma unroll
        for (int i = 0; i < 2; ++i) { const int q = tid + 512 * i, l2 = q >> 4, c4 = (q & 15) * 4;
            const u32x4 v = FFT2_PF ? vv[i] : *(const u32x4*)(FA + ((size_t)((b * 4 + g) * 64 + l2) * 128 + k1) * 64 + c4);
#pragma unroll
            for (int e = 0; e < 4; ++e) { *(LAS bf16_t*)(Bt + SWZ(c4 + e, l2 * 2)) = (bf16_t)(v[e] & 0xffffu); *(LAS bf16_t*)(Bt + SWZ(c4 + e, (64 + l2) * 2)) = (bf16_t)(v[e] >> 16); } }
        __syncthreads();
        f32x16 z = {};
#pragma unroll
        for (int ks = 0; ks < 8; ++ks) { const bf16x8 bx = *(const LAS bf16x8*)(Bt + SWZ(32 * tc + r32, (16 * ks + 8 * hi) * 2)); z = __builtin_amdgcn_mfma_f32_32x32x16_bf16(a2[ks], bx, z, 0, 0, 0); }
#pragma unroll
        for (int r = 0; r < 16; ++r) { const int R = 32 * tr + crow_(r, hi); *(LAS bf16_t*)(Zt + SWZ(R & 63, ((R >> 6) * 64 + 32 * tc + r32) * 2)) = (bf16_t)(pk2(z[r], 0.f) & 0xffffu); }
        __syncthreads();
        if (wave < 4) { f32x16 y = {};
#pragma unroll
            for (int ks = 0; ks < 8; ++ks) { const bf16x8 ax = *(const LAS bf16x8*)(Zt + SWZ(32 * tr + r32, (16 * ks + 8 * hi) * 2)); y = __builtin_amdgcn_mfma_f32_32x32x16_bf16(ax, b3[ks], y, 0, 0, 0); }
#pragma unroll
            for (int r = 0; r < 16; ++r) { const int k2 = 32 * tr + crow_(r, hi); ACAT[(size_t)(b * SEQ + k1 + 128 * k2) * KCAT + g * 64 + 32 * tc + r32] = (bf16_t)(pk2(y[r] * 0.001381067932f, 0.f) & 0xffffu); } }
        __syncthreads();
    }
#undef FFT2_FETCH
}
__device__ __forceinline__ void ctxdft_item(int item, const bf16_t* UF, bf16_t* ACAT, LAS unsigned char* lds, int tid, int wave, int lane) {
    const int b = item >> 4, g = (item >> 2) & 3, kc = item & 3;
    const int tr = wave >> 1, tc = wave & 1, r32 = lane & 31, hi = lane >> 5;
    LAS unsigned char* Xt = lds;
    LAS unsigned char* Zt = lds + 32768;
#pragma unroll
    for (int i = 0; i < 4; ++i) { const int q = tid + 512 * i, l = q >> 3, c8 = (q & 7) * 8;
        const u32x4 v = *(const u32x4*)(UF + (size_t)(ML + b * CTXL + l) * 256 + g * 64 + c8);
#pragma unroll
        for (int e = 0; e < 8; ++e) { const unsigned w = v[e >> 1]; const int row = c8 + e; *(LAS bf16_t*)(Xt + row * 512 + ((((l >> 3) ^ (row & 7)) << 4) | ((l & 7) * 2))) = (bf16_t)((e & 1) ? (w >> 16) : (w & 0xffffu)); } }
    __syncthreads();
    f32x16 z = {};
    const int R = 32 * tr + r32, kk = 64 * kc + (R & 63);
#pragma unroll 4
    for (int ks = 0; ks < 16; ++ks) { float av[8];
#pragma unroll
        for (int j = 0; j < 8; ++j) { const int l = 16 * ks + 8 * hi + j; float s, c; sincospif((float)((kk * l) & 255) * (1.0f / 128.0f), &s, &c); av[j] = (R < 64) ? c : -s; }
        const int row = 32 * tc + r32, ch = (16 * ks + 8 * hi) >> 3;
        const bf16x8 bx = *(const LAS bf16x8*)(Xt + row * 512 + ((ch ^ (row & 7)) << 4));
        z = __builtin_amdgcn_mfma_f32_32x32x16_bf16(pack_bf8(av), bx, z, 0, 0, 0); }
#pragma unroll
    for (int r = 0; r < 16; ++r) { const int Rr = 32 * tr + crow_(r, hi); *(LAS bf16_t*)(Zt + SWZ(Rr & 63, ((Rr >> 6) * 64 + 32 * tc + r32) * 2)) = (bf16_t)(pk2(z[r], 0.f) & 0xffffu); }
    __syncthreads();
    if (wave < 4) { f32x16 y = {};
#pragma unroll
        for (int ks = 0; ks < 8; ++ks) { float bv[8];
#pragma unroll
            for (int j = 0; j < 8; ++j) { const int k = 16 * ks + 8 * hi + j, m = 32 * tc + r32; float s2, c2; sincospif((float)((m * (k & 63)) & 63) * (1.0f / 32.0f), &s2, &c2); bv[j] = (k < 64) ? c2 : s2; }
            const bf16x8 ax = *(const LAS bf16x8*)(Zt + SWZ(32 * tr + r32, (16 * ks + 8 * hi) * 2)); y = __builtin_amdgcn_mfma_f32_32x32x16_bf16(ax, pack_bf8(bv), y, 0, 0, 0); }
#pragma unroll
        for (int r = 0; r < 16; ++r) { const int k = 64 * kc + 32 * tr + crow_(r, hi); ACAT[(size_t)(ML + b * CTXL + k) * KCAT + g * 64 + 32 * tc + r32] = (bf16_t)(pk2(y[r] * (1.0f / 128.0f), 0.f) & 0xffffu); } }
    __syncthreads();
}

__device__ __forceinline__ void conv_item(int item, const bf16_t* ZG, const float* cw  , const float* cb, const float* lng, const float* lnb, bf16_t* ACAT, LAS unsigned char* lds, int tid, int wave, int lane) {
    const int row0 = item * 64; const bool lat = row0 < ML; const int s0 = lat ? (row0 & ~(SEQ - 1)) : (ML + ((row0 - ML) & ~(CTXL - 1))), s1 = s0 + (lat ? SEQ : CTXL);
    LAS float* zt = (LAS float*)lds;
#pragma unroll
    for (int i = 0; i < 6; ++i) { const int q = tid + 512 * i; if (q < 94 * 32) { const int rr = q >> 5, c8 = (q & 31) * 8, gr = row0 - 15 + rr;
        u32x4 v = {0u, 0u, 0u, 0u}; if (gr >= s0 && gr < s1) v = *(const u32x4*)(ZG + (size_t)gr * 256 + c8);
        *(LAS f32x4*)(zt + rr * 256 + c8) = (f32x4){bf2f(v.x & 0xffffu), __uint_as_float(v.x & 0xffff0000u), bf2f(v.y & 0xffffu), __uint_as_float(v.y & 0xffff0000u)};
        *(LAS f32x4*)(zt + rr * 256 + c8 + 4) = (f32x4){bf2f(v.z & 0xffffu), __uint_as_float(v.z & 0xffff0000u), bf2f(v.w & 0xffffu), __uint_as_float(v.w & 0xffff0000u)}; } }
    const int c = tid & 255, half = tid >> 8;
    float w[31];
#pragma unroll
    for (int t = 0; t < 31; ++t) w[t] = cw[t * 256 + c];
    float acc[32]; const float bias = cb[c];
    __syncthreads();
#pragma unroll
    for (int r0 = 0; r0 < 32; r0 += 4) { float v[34];
#pragma unroll
        for (int i = 0; i < 34; ++i) v[i] = zt[(half * 32 + r0 + i) * 256 + c];
        float a0 = bias, a1 = bias, a2 = bias, a3 = bias;
#pragma unroll
        for (int t = 0; t < 31; ++t) { a0 += w[t] * v[t]; a1 += w[t] * v[t + 1]; a2 += w[t] * v[t + 2]; a3 += w[t] * v[t + 3]; }
        acc[r0] = a0; acc[r0 + 1] = a1; acc[r0 + 2] = a2; acc[r0 + 3] = a3; }
    __syncthreads();
#pragma unroll
    for (int r = 0; r < 32; ++r) zt[(half * 32 + r) * 256 + c] = acc[r];
    __syncthreads();
    const f32x4 gg = *(const f32x4*)(lng + 4 * lane), bb = *(const f32x4*)(lnb + 4 * lane);
#pragma unroll
    for (int i = 0; i < 8; ++i) { const int r = wave * 8 + i; const f32x4 v = *(const LAS f32x4*)(zt + r * 256 + 4 * lane);
        const float mu = wave_sum((v.x + v.y) + (v.z + v.w)) * (1.0f / 256.0f); const f32x4 d = v - mu;
        const float var = wave_sum((d.x * d.x + d.y * d.y) + (d.z * d.z + d.w * d.w)) * (1.0f / 256.0f); const float rs = 1.0f / sqrtf(var + EPS);
        f32x4 o = d * rs * gg + bb; o.x *= sigm(o.x); o.y *= sigm(o.y); o.z *= sigm(o.z); o.w *= sigm(o.w);
        u32x2 pw; pw.x = pk2(o.x, o.y); pw.y = pk2(o.z, o.w); *(u32x2*)(ACAT + (size_t)(row0 + r) * KCAT + 768 + 4 * lane) = pw; }
    __syncthreads();
}
__device__ __forceinline__ void pool_phase(const bf16_t* UP, const float* pw  , const float* psc, bf16_t* ACAT, int nitems, int first, LAS unsigned char* lds, int G, int tid, int wave, int lane) {
    const int g = wave >> 1, tc = wave & 1, r32 = lane & 31, hi = lane >> 5;
    bf16x8 bw[4];
#pragma unroll
    for (int ks = 0; ks < 4; ++ks) { float v[8];
#pragma unroll
        for (int j = 0; j < 8; ++j) v[j] = pw[g * 4096 + (16 * ks + 8 * hi + j) * 64 + 32 * tc + r32];
        bw[ks] = pack_bf8(v); }
    const float osc = psc[g * 64 + 32 * tc + r32];
    LAS float* ut = (LAS float*)lds;
    LAS unsigned char* dt = lds + 81920;
    for (int item = first; item < nitems; item += G) {
        const int row0 = item * 64; const bool lat = row0 < ML; const int s0 = lat ? (row0 & ~(SEQ - 1)) : (ML + ((row0 - ML) & ~(CTXL - 1))), L = lat ? SEQ : CTXL, s1 = s0 + L;
#pragma unroll
        for (int i = 0; i < 5; ++i) { const int q = tid + 512 * i, rr = q >> 5, c8 = (q & 31) * 8, gr = row0 - 8 + rr;
            u32x4 v = {0u, 0u, 0u, 0u}; if (gr >= s0 && gr < s1) v = *(const u32x4*)(UP + (size_t)gr * 256 + c8);
            *(LAS f32x4*)(ut + rr * 256 + c8) = (f32x4){bf2f(v.x & 0xffffu), __uint_as_float(v.x & 0xffff0000u), bf2f(v.y & 0xffffu), __uint_as_float(v.y & 0xffff0000u)};
            *(LAS f32x4*)(ut + rr * 256 + c8 + 4) = (f32x4){bf2f(v.z & 0xffffu), __uint_as_float(v.z & 0xffff0000u), bf2f(v.w & 0xffffu), __uint_as_float(v.w & 0xffff0000u)}; }
        __syncthreads();
#pragma unroll
        for (int i = 0; i < 4; ++i) { const int q = tid + 512 * i, lr = q >> 5, c8 = (q & 31) * 8, gg = c8 >> 6, hw = 1 << gg, tt = row0 + lr - s0;
            f32x4 sa = {0.f, 0.f, 0.f, 0.f}, sb = {0.f, 0.f, 0.f, 0.f};
            for (int o = -hw; o < hw; ++o) { sa += *(const LAS f32x4*)(ut + (lr + 8 + o) * 256 + c8); sb += *(const LAS f32x4*)(ut + (lr + 8 + o) * 256 + c8 + 4); }
            const int lo = tt - hw < 0 ? 0 : tt - hw, hh = tt + hw - 1 > L - 1 ? L - 1 : tt + hw - 1; const float inv = 1.0f / (float)(hh - lo + 1);
            const f32x4 ua = *(const LAS f32x4*)(ut + (lr + 8) * 256 + c8), ub = *(const LAS f32x4*)(ut + (lr + 8) * 256 + c8 + 4);
            const f32x4 da = sa * inv - ua, db = sb * inv - ub;
            u32x4 w; w.x = pk2(da.x, da.y); w.y = pk2(da.z, da.w); w.z = pk2(db.x, db.y); w.w = pk2(db.z, db.w);
            *(LAS u32x4*)(dt + lr * 512 + ((((c8 >> 3) ^ (lr & 7)) << 4))) = w; }
        __syncthreads();
#pragma unroll
        for (int rt = 0; rt < 2; ++rt) { f32x16 y = {};
#pragma unroll
            for (int ks = 0; ks < 4; ++ks) { const int row = 32 * rt + r32, ch = (g * 64 + 16 * ks + 8 * hi) >> 3;
                const bf16x8 ax = *(const LAS bf16x8*)(dt + row * 512 + ((ch ^ (row & 7)) << 4)); y = __builtin_amdgcn_mfma_f32_32x32x16_bf16(ax, bw[ks], y, 0, 0, 0); }
#pragma unroll
            for (int r = 0; r < 16; ++r) ACAT[(size_t)(row0 + 32 * rt + crow_(r, hi)) * KCAT + 1024 + g * 64 + 32 * tc + r32] = (bf16_t)(pk2(y[r] * osc, 0.f) & 0xffffu); }
        __syncthreads();
    }
}

__device__ __forceinline__ void ctx_gate_combine(const float* slab, const unsigned char* Gc  , bf16_t* Yc, int gw, int NGW, int lane) {
    for (int r = gw; r < MC; r += NGW) {
#pragma unroll
        for (int j = 0; j < 4; ++j) { const int col = 4 * lane + 256 * j; f32x4 y = {0.f, 0.f, 0.f, 0.f};
#pragma unroll
            for (int sl = 0; sl < 5; ++sl) { const int b = sl == 0 ? 0 : sl <= 2 ? 1 : sl - 1;
                const f32x4 p = *(const f32x4*)(slab + (size_t)sl * 512 * 1024 + (size_t)r * 1024 + col); const unsigned q = *(const unsigned*)(Gc + pg8::gofs(r, b * 1024 + col));
                y[0] += p[0] * (float)(q & 255u); y[1] += p[1] * (float)((q >> 8) & 255u); y[2] += p[2] * (float)((q >> 16) & 255u); y[3] += p[3] * (float)(q >> 24); }
            y = y * (1.0f / 255.0f);
            u32x2 w; w.x = pk2(y[0], y[1]); w.y = pk2(y[2], y[3]); *(u32x2*)(Yc + (size_t)r * 1024 + col) = w; }
    }
}
constexpr int NPHASE = 22;
struct Args { const float* in[30]; float* out; unsigned char* ws; int ph_lo, ph_hi, li, pad; };
__global__ void __launch_bounds__(512, 2) __attribute__((amdgpu_waves_per_eu(2, 2))) fwd_kernel(Args args) {
    extern __shared__ __attribute__((aligned(16))) unsigned char lds[];
    LAS unsigned char* L = (LAS unsigned char*)lds;
    volatile LAS unsigned* MISC = (volatile LAS unsigned*)(L + MISC_OFF);
    const int tid0 = threadIdx.x; const int wave0 = __builtin_amdgcn_readfirstlane(tid0 >> 6);
    const int G = gridDim.x, bx0 = blockIdx.x, vcu0 = (G % 8 == 0) ? (bx0 % 8) * (G / 8) + bx0 / 8 : bx0;
    const int NGW = G * 8;
    gu32* ctl = (gu32*)(args.ws + WS_CTL);
    for (int u = tid0; u < (LDS_BYTES - LDSCTL_OFF) / 4; u += 512) ((LAS unsigned*)(L + LDSCTL_OFF))[u] = 0u;
    __syncthreads();
    volatile LAS unsigned long long* PT = (volatile LAS unsigned long long*)(L + PT_OFF);
    if (tid0 < 32) PT[tid0] = ((const __attribute__((address_space(4))) unsigned long long*)__builtin_amdgcn_kernarg_segment_ptr())[tid0];
    __syncthreads();
#define FRESH() int tid, vcu = vcu0, bx = bx0; asm volatile("v_mbcnt_lo_u32_b32 %0, -1, 0\n\tv_mbcnt_hi_u32_b32 %0, -1, %0" : "=v"(tid)); tid += wave0 * 64; asm volatile("" : "+v"(tid), "+s"(vcu), "+s"(bx)); const int lane = tid & 63, wave = __builtin_amdgcn_readfirstlane(tid >> 6), gw = vcu * 8 + wave; (void)lane; (void)gw; (void)bx; \
    LAS float* scr = (LAS float*)(L + wave * 16384); (void)scr;
#define PTR(i) ((const float*)(const GAS float*)ldptr(PT, (i)))
#define OUTP ((float*)(GAS float*)ldptr(PT, 30))
#define WSP ((unsigned char*)(GAS unsigned char*)ldptr(PT, 31))
    XcdBarrier bar; bar.bar = (unsigned*)(ctl + CW_BAR) + args.li * XCD_BAR_WORDS; bar.x = 0; bar.st = nullptr;
    if (MK_N_LAUNCHES != NPHASE) bar = xcd_barrier_post((unsigned*)(ctl + CW_BAR) + args.li * XCD_BAR_WORDS, MISC + 8);
#ifndef TAILREP
#define TAILREP 1
#endif
#ifndef IN_REVN
#define IN_REVN 0
#endif
#ifndef WOUT_NSL
#define WOUT_NSL 4
#endif
#ifndef WGM_IN
#define WGM_IN 8
#endif
#ifndef WGM_UP
#define WGM_UP 8
#endif
#ifndef FFT2REP
#define FFT2REP 1
#endif
#ifndef UPV_REV
#define UPV_REV 1
#endif
#ifndef BARX2
#define BARX2 0
#endif
#ifdef CLKPROBE
#define CK_START(k) do { if ((k) == CLKPROBE && l == 0 && tid == 0) { const unsigned long long a_ = __builtin_amdgcn_s_memtime(), b_ = __builtin_amdgcn_s_memrealtime(); MISC[12] = (unsigned)a_; MISC[13] = (unsigned)(a_ >> 32); MISC[14] = (unsigned)b_; MISC[15] = (unsigned)(b_ >> 32); } } while (0)
#define CK_STOP(k) do { if ((k) == CLKPROBE && l == 0 && tid == 0) { const unsigned long long t1_ = __builtin_amdgcn_s_memtime(), r1_ = __builtin_amdgcn_s_memrealtime(); \
        const unsigned long long t0_ = MISC[12] | ((unsigned long long)MISC[13] << 32), r0_ = MISC[14] | ((unsigned long long)MISC[15] << 32); MISC[16] = (unsigned)(((t1_ - t0_) * 100ull) / (r1_ - r0_)); } } while (0)
#else
#define CK_START(k) do {} while (0)
#define CK_STOP(k) do {} while (0)
#endif
#ifdef PHT_PROBE
#define PHT_IN() do { if (threadIdx.x == 0) { const unsigned k_ = MISC[30]; if (k_ < 24) MISC[32 + 2 * k_] = (unsigned)__builtin_amdgcn_s_memrealtime(); } } while (0)
#define PHT_OUT() do { if (threadIdx.x == 0) { const unsigned k_ = MISC[30]; if (k_ < 24) MISC[33 + 2 * k_] = (unsigned)__builtin_amdgcn_s_memrealtime(); MISC[30] = k_ + 1; } } while (0)
#else
#define PHT_IN() do {} while (0)
#define PHT_OUT() do {} while (0)
#endif
#define GRID_BAR() do { PHT_IN(); GRID_BAR_(); PHT_OUT(); } while (0)
#define GRID_BAR_() do { if (MK_N_LAUNCHES == NPHASE) { if (tid0 == 0) __hip_atomic_store(ctl + CW_TMO, 0xBADBA0u, RLX_AGENT); } else { xcd_barrier(bar); if (BARX2) xcd_barrier(bar); } } while (0)
#ifdef PHT_PROBE
    if (threadIdx.x == 0) MISC[31] = (unsigned)__builtin_amdgcn_s_memrealtime();
#endif
    const int lo = args.ph_lo, hi = args.ph_hi;
#ifndef PHASE_MASK
#define PHASE_MASK 0xFFF
#endif
#ifndef ATTM
#define ATTM 3
#endif
#ifndef X1REP
#define X1REP 0
#endif
#ifndef X1M
#define X1M 31
#endif
#define PH_EN(kind) ((PHASE_MASK >> (kind)) & 1)
#ifndef REP_MASK
#define REP_MASK 0
#endif
#define NREP(kind) (((REP_MASK >> (kind)) & 1) ? 2 : 1)
#define IN(k) (lo <= (k) && (k) < hi)
#define BOTH(k) (IN(k) && IN((k) + 1))
#define WSRC(S, l) WSrc S; S.w_in = PTR(8) + (size_t)(l) * 1024 * NIN; S.wo_f = PTR(20) + (size_t)(l) * 256 * 1024; S.wo_a = PTR(21) + (size_t)(l) * 512 * 1024; \
    S.wo_c = PTR(22) + (size_t)(l) * 256 * 1024; S.wo_p = PTR(23) + (size_t)(l) * 256 * 1024; S.w_out = PTR(24) + (size_t)(l) * 1024 * 1024; \
    S.w_up = PTR(25) + (size_t)(l) * 1024 * 2 * DFF; S.w_down = PTR(28) + (size_t)(l) * DFF * 1024;
#define ws WSP
#define OUTHI ((unsigned char*)OUTP + 32 * MiB)
#define WA1 ((bf16_t*)OUTHI)
#define WUPG1 ((bf16_t*)(OUTHI + 13 * MiB))
#define WUPV1 ((bf16_t*)(OUTHI + 13 * MiB + (size_t)2816 * 1024 * 2))
#define WDST0 {(bf16_t*)(ws + WS_WA), (bf16_t*)(ws + WS_WCAT), (bf16_t*)(ws + WS_WOUT), (bf16_t*)(ws + WS_WDN), (bf16_t*)(ws + WS_WUPG), (bf16_t*)(ws + WS_WUPV)}
#define WDST1 {WA1, (bf16_t*)(ws + WS_WCAT), (bf16_t*)(ws + WS_WOUT), (bf16_t*)(ws + WS_WDN), WUPG1, WUPV1}
#define TAIL_CONVERT(MASK, nwg_, lo_, hi_) do { const int rem_ = (nwg_) % G; if (rem_ == 0 || bx >= rem_) { __syncthreads(); WSRC(S1, 1); const WDst D1 = WDST1; \
        for (int tr_ = 0; tr_ < TAILREP; ++tr_) convert_items<MASK>(S1, D1, scr, (lo_), (hi_), (rem_ ? bx - rem_ : bx) * 8 + wave, (rem_ ? G - rem_ : G) * 8, lane); } } while (0)
#define MOD ((float*)(WSP + WS_MOD))
#define ROPE ((float*)(WSP + WS_ROPE))
#define TW ((f32x2*)(WSP + WS_TW))
#define FT ((u32x4*)(WSP + WS_FT))
#define XC ((float*)(WSP + WS_XC))
#define HX ((bf16_t*)(WSP + WS_HX))
#define FA ((f32x2*)(WSP + WS_FA))
#define Qb ((bf16_t*)(WSP + WS_Q))
#define Kb ((bf16_t*)(WSP + WS_K))
#define Vb ((bf16_t*)(WSP + WS_V))
#define Yb ((bf16_t*)(WSP + WS_Y))
#define Gb (WSP + WS_G)
#define ACAT ((bf16_t*)(WSP + WS_ACAT))
#define UF ((bf16_t*)(WSP + WS_UF))
#define ZG ((bf16_t*)(WSP + WS_ZG))
#define UP ((bf16_t*)(WSP + WS_UP))
#define GT ((bf16_t*)(WSP + WS_GT))
#define Hb ((bf16_t*)(WSP + WS_H))
#define VE ((float*)(WSP + WS_VE))

    for (int rep = 0; rep < NREP(0); ++rep) if (PH_EN(0) && IN(0)) { FRESH();
        mod_phase(PTR(1), PTR(3), PTR(6), PTR(7), MOD, L, vcu, G, tid, wave, lane);
        tables_phase(ROPE, TW, vcu * 512 + tid, G * 512); fft_tables_phase(FT, ((vcu + 128) % G) * 512 + tid, G * 512);
        for (int i = vcu * 512 + tid; i < MC * DM / 4; i += G * 512) ((f32x4*)XC)[i] = ((const f32x4*)PTR(2))[i];
        WSRC(S0, 0); { const WDst D0 = WDST0; convert_items<31>(S0, D0, scr, 0, ITU_END, gw, NGW, lane); }
        if (BOTH(0)) GRID_BAR();
    }
#pragma nounroll
    for (int l = 0; l < 2; ++l) {
        const int pb = 1 + 10 * l;
#define mod (MOD + l * 3 * 6144)
#define XBF ((bf16_t*)OUTP)
#define xc ((l == 0) ? PTR(2) : (const float*)XC)
        const int Mact = (l == 0) ? MT : ML;
        for (int rep = 0; rep < NREP(1); ++rep) if (PH_EN(1) && IN(pb)) { FRESH(); if (l == 0) norm_phase<false>(PTR(0), xc, MT, PTR(4) + l * DM, mod, 0, 1024, HX, gw, NGW, lane);
            else norm_phase<true>(XBF, xc, MT, PTR(4) + l * DM, mod, 0, 1024, HX, gw, NGW, lane, (const float*)Gb, 11, MOD + 2 * 6144 + 5120, XC);
            if (BOTH(pb)) GRID_BAR(); }
        for (int rep = 0; rep < NREP(2); ++rep) if (PH_EN(2) && IN(pb + 1)) { FRESH();
            pg8::Gemm g{HX, l == 0 ? (const bf16_t*)(ws + WS_WA) : (const bf16_t*)WA1, MT, NIN, 1024}; pg8::StaticOrder S; S.init(MT, NIN, G, bx); S.wgm = WGM_IN; S.revn = IN_REVN;
            pg8::EpiIn E{UF, ZG, UP, Qb, Kb, Vb, Gb, ROPE};
            CK_START(1);
            pg8::gemm_phase<pg8::EpiIn, pg8::StaticOrder, true, true>(L, g, S, E, tid);
            CK_STOP(1);
#ifdef KLOOP_PROBE
            if (KLOOP_PROBE == 1) { int tid3 = tid; asm volatile("" : "+v"(tid3)); pg8::EpiNull En; pg8::gemm_phase<pg8::EpiNull, pg8::StaticOrder, true, true>(L, g, S, En, tid3); }
#endif
            TAIL_CONVERT(7, (MT / 256) * (NIN / 256), l == 0 ? 0 : ITU_CAT, l == 0 ? IT_A : ITU_UPG);
            if (BOTH(pb + 1)) GRID_BAR();
        }
        for (int rep = 0; rep < NREP(3); ++rep) if (PH_EN(3) && IN(pb + 2)) { FRESH();
            for (int r1 = 0; r1 < ((X1REP & 1) ? 2 : 1); ++r1) if (X1M & 1) fft1_phase(UF, TW, FT, (unsigned*)FA, L, vcu, G, tid, wave, lane, (2 * G - 200) % G, (l == 0 && G >= 128 && (2 * G - 200) % G + 48 <= G) ? 48 : 0);
            for (int r1 = 0; r1 < ((X1REP & 2) ? 2 : 1); ++r1) if (X1M & 2) for (int it = vcu; it < Mact / 64; it += G) conv_item(it, ZG, PTR(14) + l * 31 * 256, PTR(15) + l * 256, PTR(16) + l * 256, PTR(17) + l * 256, ACAT, L, tid, wave, lane);
            for (int r1 = 0; r1 < ((X1REP & 4) ? 2 : 1); ++r1) if (X1M & 4) pool_phase(UP, PTR(18) + l * 4 * 4096, PTR(19) + l * 256, ACAT, Mact / 64, (vcu + 248) % G, L, G, tid, wave, lane);
            if ((X1M & 8) && l == 0) for (int it = (vcu + 184 + G) % G; it < 32; it += G) ctxdft_item(it, UF, ACAT, L, tid, wave, lane);
            if (l == 0) {
                const float lam_init = 0.2f;
                const float d1 = wave_sum(PTR(9)[lane] * PTR(10)[lane]), d2 = wave_sum(PTR(11)[lane] * PTR(12)[lane]);
                const float lam = __builtin_bit_cast(float, __builtin_amdgcn_readfirstlane(__builtin_bit_cast(int, expf(d1) - expf(d2) + lam_init)));
                for (int v = (vcu + 200) % G; v < 16; v += G) { const int b = v >> 3, h = (v >> 1) & 3, row0 = ML + b * CTXL + (v & 1) * 128;
                    att2::attn_unit<0>(Qb + (size_t)row0 * 512 + h * 128, Kb + (size_t)b * KVL * 512 + h * 128, Vb + (size_t)b * KVL * 512 + h * 128, CTXL,
                                       ACAT + (size_t)row0 * KCAT + 256 + h * 128, lam, 1.0f - lam_init, PTR(13), (char*)lds, tid); }
            }
            if (BOTH(pb + 2)) GRID_BAR();
        }
        for (int rep = 0; rep < NREP(4); ++rep) if (PH_EN(4) && IN(pb + 3)) { FRESH();
            if (ATTM & 1) fft2_phase((const unsigned*)FA, FT, ACAT, L, vcu, G, tid, wave, lane);
            if (FFT2REP == 2) { int tid4 = tid, vcu4 = vcu; asm volatile("" : "+v"(tid4), "+s"(vcu4)); fft2_phase((const unsigned*)FA, FT, ACAT, L, vcu4, G, tid4, __builtin_amdgcn_readfirstlane(tid4 >> 6), tid4 & 63); }
            const float lam_init = (l == 0) ? 0.2f : 0.35550906759096926f;
            const float d1 = wave_sum(PTR(9)[l * 64 + lane] * PTR(10)[l * 64 + lane]), d2 = wave_sum(PTR(11)[l * 64 + lane] * PTR(12)[l * 64 + lane]);
            const float lam = __builtin_bit_cast(float, __builtin_amdgcn_readfirstlane(__builtin_bit_cast(int, expf(d1) - expf(d2) + lam_init)));
            const int nun = 512;
            CK_START(3);
            if (ATTM & 2) for (int u = vcu; u < nun; u += G) {
                int b, h, row0, nkeys;
                if (u < 512) { const int x = (u & 255) >> 5, qb = (u & 31) + 32 * (u >> 8); b = x >> 2; h = x & 3; row0 = b * SEQ + qb * 128; nkeys = KVL; }
                else { const int v = u - 512; b = v >> 3; h = (v >> 1) & 3; row0 = ML + b * CTXL + (v & 1) * 128; nkeys = CTXL; }
#if ATT_V == 2
                att2::attn_unit<0>(Qb + (size_t)row0 * 512 + h * 128,
#else
                att::attn_unit<0>(Qb + (size_t)row0 * 512 + h * 128,
#endif
                               Kb + (size_t)b * KVL * 512 + h * 128, Vb + (size_t)b * KVL * 512 + h * 128, nkeys,
                               ACAT + (size_t)row0 * KCAT + 256 + h * 128, lam, 1.0f - lam_init, PTR(13) + l * 128, (char*)lds, tid);
            }
            CK_STOP(3);
            if (l == 0) {
                pg8::Gemm gc{ACAT + (size_t)ML * KCAT, (const bf16_t*)(ws + WS_WCAT), MC, 1024, 256, KCAT}; pg8::BranchSliceOrder Sc{G, bx};
                pg8::EpiSlab Ec{(float*)UF};
                pg8::gemm_phase<pg8::EpiSlab, pg8::BranchSliceOrder, true, true>(L, gc, Sc, Ec, tid);
            }
#if defined(ATT_PROBE)
            int tid2 = tid, vcu2 = vcu; asm volatile("" : "+v"(tid2), "+s"(vcu2));
            for (int u = vcu2; u < 512; u += G) {
                const int x = (u & 255) >> 5, qb = (u & 31) + 32 * (u >> 8), b = x >> 2, h = x & 3, row0 = b * SEQ + qb * 128;
                att2::attn_unit<ATT_PROBE>(Qb + (size_t)row0 * 512 + h * 128, Kb + (size_t)b * KVL * 512 + h * 128, Vb + (size_t)b * KVL * 512 + h * 128, KVL,
                               Hb + (size_t)row0 * KCAT + 256 + h * 128, lam, 1.0f - lam_init, PTR(13) + l * 128, (char*)lds, tid2);
            }
#endif
            if (BOTH(pb + 3)) GRID_BAR();
        }
        for (int rep = 0; rep < NREP(5); ++rep) if (PH_EN(5) && IN(pb + 4)) { FRESH();
            if (l == 0) ctx_gate_combine((const float*)UF, Gb + (size_t)ML * 4096, Yb + (size_t)ML * 1024, gw, NGW, lane);
            pg8::Gemm g{ACAT, (const bf16_t*)(ws + WS_WCAT), ML, 1024, KCAT}; pg8::StaticOrder S; S.init(ML, 1024, G, bx);
            pg8::EpiBranch E{Gb, Yb};
            pg8::gemm_phase<pg8::EpiBranch, pg8::StaticOrder, true, true>(L, g, S, E, tid);
#ifdef KLOOP_PROBE
            if (KLOOP_PROBE == 4) { int tid3 = tid; asm volatile("" : "+v"(tid3)); pg8::EpiNull En; pg8::gemm_phase<pg8::EpiNull, pg8::StaticOrder, true, true>(L, g, S, En, tid3); }
            if (KLOOP_PROBE == 14) { int tid3 = tid; asm volatile("" : "+v"(tid3)); pg8::gemm_phase<pg8::EpiBranch, pg8::StaticOrder, true, true>(L, g, S, E, tid3); }
#endif
            if (BOTH(pb + 4)) GRID_BAR();
        }
        for (int rep = 0; rep < (l == 0 ? NREP(6) : 1); ++rep) if (PH_EN(6) && IN(pb + 5)) { FRESH();
            pg8::Gemm g{Yb, (const bf16_t*)(ws + WS_WOUT), ML, 1024, 1024}; pg8::StaticOrder S; S.init(ML, 1024, G, bx);
            pg8::EpiRes E{l == 0 ? PTR(0) : (const float*)nullptr, XBF, xc, XBF, XC, mod, 2048};
            pg8::gemm_phase<pg8::EpiRes, pg8::StaticOrder, true, true>(L, g, S, E, tid);
            if (l == 0) {
                pg8::Gemm gc{Yb + (size_t)ML * 1024, (const bf16_t*)(ws + WS_WOUT), MC, 1024, 1024 / WOUT_NSL, 1024}; pg8::SplitKOrder Sc{WOUT_NSL, 1024 / WOUT_NSL, G, bx};
                pg8::EpiSlab Ec{(float*)Gb};
                pg8::gemm_phase<pg8::EpiSlab, pg8::SplitKOrder, true, true>(L, gc, Sc, Ec, tid);
            }
            if (BOTH(pb + 5)) GRID_BAR();
        }
        for (int rep = 0; rep < NREP(7); ++rep) if (PH_EN(7) && IN(pb + 6)) { FRESH(); if (l == 0) norm_phase<true>(XBF, XC, Mact, PTR(5) + l * DM, mod, 3072, 4096, HX, gw, NGW, lane, (const float*)Gb, WOUT_NSL, mod + 2 * 6144 + 2048, XC);
            else norm_phase<true>(XBF, XC, Mact, PTR(5) + l * DM, mod, 3072, 4096, HX, gw, NGW, lane);
            if (BOTH(pb + 6)) GRID_BAR(); }
        for (int rep = 0; rep < NREP(8); ++rep) if (PH_EN(8) && IN(pb + 7)) { FRESH();
            pg8::Gemm g{HX, l == 0 ? (const bf16_t*)(ws + WS_WUPG) : (const bf16_t*)WUPG1, Mact, DFF, 1024, 0, l == 0 ? (const bf16_t*)(ws + WS_WUPV) : (const bf16_t*)WUPV1};
            pg8::PairOrder S; S.init(Mact, DFF, G, bx);
            pg8::EpiUp E{GT, Hb, PTR(26) + l * 3 * DFF, PTR(27) + l * DFF, VE};
            pg8::gemm_phase<pg8::EpiUp, pg8::PairOrder, true, true>(L, g, S, E, tid);
            if (l == 0) TAIL_CONVERT(24, (MT / 256) * (DFF / 256), ITU_UPG, ITU_END);
            if (BOTH(pb + 7)) GRID_BAR();
        }
        if (PH_EN(10) && IN(pb + 9)) { FRESH();
            pg8::Gemm g{Hb, (const bf16_t*)(ws + WS_WDN), ML, 1024, DFF}; pg8::StaticOrder S; S.init(ML, 1024, G, bx);
            { pg8::Unit u0; for (int i0 = 0; S.next(i0, u0); ++i0) ffn_edge_fix(u0.pm, GT, VE, Hb, PTR(26) + l * 3 * DFF, PTR(27) + l * DFF, tid);
              if (l == 0) { ffn_edge_fix(64, GT, VE, Hb, PTR(26) + l * 3 * DFF, PTR(27) + l * DFF, tid); ffn_edge_fix(65, GT, VE, Hb, PTR(26) + l * 3 * DFF, PTR(27) + l * DFF, tid); }
              asm volatile("s_waitcnt vmcnt(0)" ::: "memory"); __syncthreads(); }
            pg8::EpiRes E{(const float*)nullptr, XBF, XC, l == 0 ? XBF : HX, XC, mod, 5120};
            pg8::gemm_phase<pg8::EpiRes, pg8::StaticOrder, true, true>(L, g, S, E, tid);
            if (l == 0) {
                pg8::Gemm gc{Hb + (size_t)ML * DFF, (const bf16_t*)(ws + WS_WDN), MC, 1024, 256, DFF}; pg8::SplitKOrder Sc{11, 256, G, bx};
                pg8::EpiSlab Ec{(float*)Gb};
                pg8::gemm_phase<pg8::EpiSlab, pg8::SplitKOrder, true, true>(L, gc, Sc, Ec, tid);
            }
            if (BOTH(pb + 9)) GRID_BAR();
        }
    }
    if (PH_EN(11) && IN(21)) { FRESH(); final_norm_phase(HX, OUTP, PTR(29), gw, NGW, lane); }
#ifdef PHT_PROBE
    if (bx0 == 0 && wave0 == 0) { const unsigned k_ = PHT_PROBE; const unsigned d_ = (PHT_PROBE == 19) ? ((unsigned)__builtin_amdgcn_s_memrealtime() - MISC[33 + 2 * 18]) : PHT_WHICH == 2 ? (MISC[33 + 2 * k_] - MISC[31 + 2 * k_]) : PHT_WHICH ? (MISC[33 + 2 * k_] - MISC[32 + 2 * k_]) : (MISC[32 + 2 * k_] - MISC[31 + 2 * k_]);
        const unsigned long long s0 = __builtin_amdgcn_s_memrealtime(); while (__builtin_amdgcn_s_memrealtime() - s0 < (unsigned long long)d_ * 10ull) __builtin_amdgcn_s_sleep(8); }
#endif
#ifdef KT_PROBE
    if (bx0 == 0 && wave0 == 0) { const unsigned us = (KT_PROBE == 1) ? (MISC[20] / (MISC[21] ? MISC[21] : 1u)) / 10u : (KT_PROBE == 2) ? (MISC[23] / (MISC[24] ? MISC[24] : 1u)) / 100u : (MISC[25] / (MISC[26] ? MISC[26] : 1u)) / 20u;
        const unsigned long long s0 = __builtin_amdgcn_s_memrealtime(); while (__builtin_amdgcn_s_memrealtime() - s0 < (unsigned long long)us * 100ull) __builtin_amdgcn_s_sleep(8); }
#endif
#ifdef CLKPROBE
    if (bx0 == 0 && wave0 == 0) { const unsigned mhz = MISC[16]; const unsigned long long s0 = __builtin_amdgcn_s_memrealtime(); while (__builtin_amdgcn_s_memrealtime() - s0 < (unsigned long long)mhz * 10ull) __builtin_amdgcn_s_sleep(8); }
#endif
#undef IN
#undef BOTH
#undef mod
#undef XBF
#undef xc
#undef ws
#undef OUTHI
#undef WA1
#undef WUPG1
#undef WUPV1
#undef WDST0
#undef WDST1
#undef TAIL_CONVERT
#undef MOD
#undef ROPE
#undef TW
#undef FT
#undef XC
#undef HX
#undef FA
#undef Qb
#undef Kb
#undef Vb
#undef Yb
#undef Gb
#undef ACAT
#undef UF
#undef ZG
#undef UP
#undef GT
#undef Hb
#undef VE
#undef PTR
#undef OUTP
#undef WSP
}

extern "C" void kernel_launch(void* const* d_in, const int* in_sizes, int n_in, void* d_out, int out_size, void* d_ws, size_t ws_size, hipStream_t stream) {
    static int grid = 0;
    if (grid == 0) {
        if (n_in != 30 || in_sizes[0] != ML * DM || out_size != ML * DM || ws_size < WS_END) {
            fprintf(stderr, "kernel_launch: unexpected shapes: n_in %d in0 %d out %d ws %zu (need >= %zu)\n", n_in, n_in > 0 ? in_sizes[0] : -1, out_size, ws_size, (size_t)WS_END); grid = -1; return; }
        int dev = 0, cus = 0, per_cu = 0;
        if (hipGetDevice(&dev) != hipSuccess || hipDeviceGetAttribute(&cus, hipDeviceAttributeMultiprocessorCount, dev) != hipSuccess) { grid = -1; return; }
        if (hipFuncSetAttribute((const void*)fwd_kernel, hipFuncAttributeMaxDynamicSharedMemorySize, LDS_BYTES) != hipSuccess) { fprintf(stderr, "kernel_launch: hipFuncSetAttribute failed\n"); grid = -1; return; }
        if (hipOccupancyMaxActiveBlocksPerMultiprocessor(&per_cu, (const void*)fwd_kernel, 512, LDS_BYTES) != hipSuccess || per_cu < 1) {
            fprintf(stderr, "kernel_launch: occupancy query reports %d blocks per CU\n", per_cu); (void)hipGetLastError(); grid = -1; return; }
#ifdef FORCE_GRID
        cus = FORCE_GRID;
#endif
        grid = cus;
    }
    if (grid < 0) return;
    (void)hipMemsetAsync((char*)d_ws + WS_CTL, 0, CTL_ZERO_BYTES, stream);
    Args a{};
    for (int i = 0; i < 30; ++i) a.in[i] = (const float*)d_in[i];
    a.out = (float*)d_out; a.ws = (unsigned char*)d_ws;
    for (int li = 0; li < MK_N_LAUNCHES; ++li) {
        if (MK_N_LAUNCHES == NPHASE) { a.ph_lo = li; a.ph_hi = li + 1; a.li = 0; }
        else { a.ph_lo = (int)((long)NPHASE * li / MK_N_LAUNCHES); a.ph_hi = (int)((long)NPHASE * (li + 1) / MK_N_LAUNCHES); a.li = li; }
        hipLaunchKernelGGL(fwd_kernel, dim3(grid), dim3(512), LDS_BYTES, stream, a);
    }
}
```
